# Optimizing an MI355X kernel written in HIP

```python
import math
import jax, jax.numpy as jnp
from jax import lax
import numpy as np

D_MODEL = 2048
BATCH = 2
SEQ = 16384
DEPTH = 2

CHUNK = 64
N_MIXERS = 2
N_GLA_LAYERS = (DEPTH + N_MIXERS - 1) // N_MIXERS
N_DIFF_LAYERS = DEPTH // N_MIXERS
RMS_EPS = 1e-6

GLA_HEADS = 4
GLA_DK_TOTAL = D_MODEL // 2
GLA_DV_TOTAL = D_MODEL
GLA_DK = GLA_DK_TOTAL // GLA_HEADS
GLA_DV = GLA_DV_TOTAL // GLA_HEADS
GLA_GATE_RANK = 16
GLA_GATE_TAU = 16.0
GLA_IN_WIDTH = 2 * GLA_DK_TOTAL + 2 * GLA_DV_TOTAL + GLA_GATE_RANK

DIFF_HEADS = 8
DIFF_HEAD_DIM = D_MODEL // DIFF_HEADS // 2
DIFF_V_DIM = 2 * DIFF_HEAD_DIM
Q_BLOCK = 128

MOE_GROUPS = 4
MOE_EXPERTS_PER_GROUP = 8
MOE_N_EXPERTS = MOE_GROUPS * MOE_EXPERTS_PER_GROUP
MOE_TOP_K = 2
MOE_D_FF = D_MODEL // 4
MOE_BLOCK = 128

kernel_name = "hybrid_gla_diffattn_hmoe_stream"


def _rmsnorm(x, g):
    xf = x.astype(jnp.float32)
    y = xf * lax.rsqrt(jnp.mean(xf * xf, axis=-1, keepdims=True) + RMS_EPS)
    return y.astype(x.dtype) * g.astype(x.dtype)


def _gla_mixer(h, w_in, w_gate_up, b_gate, norm_g, w_out):
    b, s, _ = h.shape
    n_chunks = s // CHUNK
    proj = h @ w_in
    q, k, v, r, gz = jnp.split(
        proj,
        [GLA_DK_TOTAL, 2 * GLA_DK_TOTAL, 2 * GLA_DK_TOTAL + GLA_DV_TOTAL,
         2 * GLA_DK_TOTAL + 2 * GLA_DV_TOTAL],
        axis=-1)
    log_alpha = jax.nn.log_sigmoid((gz @ w_gate_up + b_gate).astype(jnp.float32)) / GLA_GATE_TAU

    def to_chunks(t, d):
        return t.astype(jnp.float32).reshape(b, n_chunks, CHUNK, GLA_HEADS, d).transpose(1, 0, 3, 2, 4)

    qc = to_chunks(q, GLA_DK) * (GLA_DK ** -0.5)
    kc = to_chunks(k, GLA_DK)
    vc = to_chunks(v, GLA_DV)
    ac = to_chunks(log_alpha, GLA_DK)

    def step(state, xs):
        q_c, k_c, v_c, la_c = xs
        cum = jnp.cumsum(la_c, axis=2)
        cum_end = cum[:, :, -1:, :]
        k_dec = k_c * jnp.exp(cum_end - cum)
        state = (jnp.exp(cum_end[:, :, 0, :])[..., None] * state
                 + jnp.einsum('bhck,bhcv->bhkv', k_dec, v_c))
        o_c = jnp.einsum('bhck,bhkv->bhcv', q_c, state)
        return state, o_c

    state0 = jnp.zeros((b, GLA_HEADS, GLA_DK, GLA_DV), jnp.float32)
    _, o = lax.scan(step, state0, (qc, kc, vc, ac))
    o = o.transpose(1, 0, 3, 2, 4).reshape(b, s, GLA_HEADS, GLA_DV).astype(h.dtype)
    o = _rmsnorm(o, norm_g).reshape(b, s, GLA_DV_TOTAL) * jax.nn.silu(r)
    return o @ w_out


def _diff_attention(h, w_in, lq1, lk1, lq2, lk2, subln, w_out, layer_idx):
    b, s, _ = h.shape
    lambda_init = 0.8 - 0.6 * math.exp(-0.3 * layer_idx)
    qkv = h @ w_in
    q, k, v = jnp.split(qkv, 3, axis=-1)
    q = q.reshape(b, s, DIFF_HEADS, 2, DIFF_HEAD_DIM).transpose(3, 0, 2, 1, 4)
    k = k.reshape(b, s, DIFF_HEADS, 2, DIFF_HEAD_DIM).transpose(3, 0, 2, 1, 4)
    v = v.reshape(b, s, DIFF_HEADS, DIFF_V_DIM).transpose(0, 2, 1, 3)
    q1, q2 = q[0], q[1]
    k1, k2 = k[0], k[1]
    lam = (jnp.exp(jnp.sum(lq1.astype(jnp.float32) * lk1.astype(jnp.float32)))
           - jnp.exp(jnp.sum(lq2.astype(jnp.float32) * lk2.astype(jnp.float32)))
           + lambda_init)
    slopes = 2.0 ** (-8.0 * jnp.arange(1, DIFF_HEADS + 1, dtype=jnp.float32) / DIFF_HEADS)
    scale = DIFF_HEAD_DIM ** -0.5
    key_pos = jnp.arange(s, dtype=jnp.int32)
    key_chunk = key_pos // CHUNK

    def q_block(qi):
        start = qi * Q_BLOCK
        q1b = lax.dynamic_slice_in_dim(q1, start, Q_BLOCK, axis=2)
        q2b = lax.dynamic_slice_in_dim(q2, start, Q_BLOCK, axis=2)
        q_pos = start + jnp.arange(Q_BLOCK, dtype=jnp.int32)
        dist = jnp.abs(q_pos[:, None] - key_pos[None, :]).astype(jnp.float32)
        allowed = (q_pos // CHUNK)[:, None] >= key_chunk[None, :]
        bias = jnp.where(allowed[None], -slopes[:, None, None] * dist[None], -jnp.inf)
        s1 = jnp.einsum('bhqd,bhkd->bhqk', q1b, k1).astype(jnp.float32) * scale + bias
        s2 = jnp.einsum('bhqd,bhkd->bhqk', q2b, k2).astype(jnp.float32) * scale + bias
        attn = jax.nn.softmax(s1, axis=-1) - lam * jax.nn.softmax(s2, axis=-1)
        return jnp.einsum('bhqk,bhkv->bhqv', attn.astype(v.dtype), v)

    o = lax.map(q_block, jnp.arange(s // Q_BLOCK, dtype=jnp.int32))
    o = o.transpose(1, 0, 3, 2, 4).reshape(b, s, DIFF_HEADS, DIFF_V_DIM).astype(h.dtype)
    o = _rmsnorm(o, subln) * (1.0 - lambda_init)
    return o.reshape(b, s, D_MODEL) @ w_out


def _hier_moe(h, w_group, w_expert, w_gate, w_up, w_down):
    b, s, d = h.shape
    n_tok = b * s
    xf = h.reshape(n_tok, d)
    tok_ids = jnp.arange(n_tok, dtype=jnp.int32)
    group_logits = (xf @ w_group).astype(jnp.float32)
    group_prob = jax.nn.softmax(group_logits, axis=-1)
    g_idx = jnp.argmax(group_logits, axis=-1).astype(jnp.int32)
    g_w = group_prob[tok_ids, g_idx]
    exp_logits = (xf @ w_expert).astype(jnp.float32).reshape(n_tok, MOE_GROUPS, MOE_EXPERTS_PER_GROUP)
    sel_logits = exp_logits[tok_ids, g_idx]
    top_p, top_e = lax.top_k(jax.nn.softmax(sel_logits, axis=-1), MOE_TOP_K)
    top_p = top_p / jnp.sum(top_p, axis=-1, keepdims=True)
    weights = g_w[:, None] * top_p

    eid = (g_idx[:, None] * MOE_EXPERTS_PER_GROUP + top_e.astype(jnp.int32)).reshape(-1)
    tok = jnp.broadcast_to(tok_ids[:, None], (n_tok, MOE_TOP_K)).reshape(-1)
    wt = weights.reshape(-1)
    n_assign = n_tok * MOE_TOP_K
    order = jnp.argsort(eid, stable=True)
    s_eid, s_tok, s_wt = eid[order], tok[order], wt[order]
    counts = jnp.bincount(eid, length=MOE_N_EXPERTS).astype(jnp.int32)
    start = jnp.cumsum(counts) - counts
    padded = ((counts + MOE_BLOCK - 1) // MOE_BLOCK) * MOE_BLOCK
    pend = jnp.cumsum(padded)
    pstart = pend - padded
    dest = pstart[s_eid] + (jnp.arange(n_assign, dtype=jnp.int32) - start[s_eid])
    n_rows = n_assign + MOE_N_EXPERTS * MOE_BLOCK
    n_blocks = n_rows // MOE_BLOCK
    row_tok = jnp.zeros((n_rows,), jnp.int32).at[dest].set(s_tok)
    row_wt = jnp.zeros((n_rows,), jnp.float32).at[dest].set(s_wt)
    blk_start = jnp.arange(n_blocks, dtype=jnp.int32) * MOE_BLOCK
    blk_eid = jnp.clip(jnp.searchsorted(pend, blk_start, side='right'), 0, MOE_N_EXPERTS - 1)

    def step(y, xs):
        e, toks, wts = xs
        hb = xf[toks]
        ob = (jax.nn.silu(hb @ w_gate[e]) * (hb @ w_up[e])) @ w_down[e]
        return y.at[toks].add(ob * wts[:, None].astype(ob.dtype)), None

    y, _ = lax.scan(step, jnp.zeros_like(xf),
                    (blk_eid, row_tok.reshape(n_blocks, MOE_BLOCK), row_wt.reshape(n_blocks, MOE_BLOCK)))
    return y.reshape(b, s, d)


def _normal(k, shape, scale):
    return jax.random.normal(k, shape, jnp.float32) * scale


def _gain(k, shape):
    return 1.0 + 0.05 * jax.random.normal(k, shape, jnp.float32)


def setup_inputs(seed: int = 0) -> dict:
    key = jax.random.key(seed)
    ks = jax.random.split(key, 21)
    D = D_MODEL
    return {
        "x": _normal(ks[0], (BATCH, SEQ, D), 1.0),
        "norm_mix": _gain(ks[1], (DEPTH, D)),
        "norm_ffn": _gain(ks[2], (DEPTH, D)),
        "gla_w_in": _normal(ks[3], (N_GLA_LAYERS, D, GLA_IN_WIDTH), D ** -0.5),
        "gla_w_gate_up": _normal(ks[4], (N_GLA_LAYERS, GLA_GATE_RANK, GLA_DK_TOTAL), GLA_GATE_RANK ** -0.5),
        "gla_b_gate": _normal(ks[5], (N_GLA_LAYERS, GLA_DK_TOTAL), 0.1),
        "gla_norm": _gain(ks[6], (N_GLA_LAYERS, GLA_DV)),
        "gla_w_out": _normal(ks[7], (N_GLA_LAYERS, GLA_DV_TOTAL, D), GLA_DV_TOTAL ** -0.5),
        "diff_w_in": _normal(ks[8], (N_DIFF_LAYERS, D, 3 * D), D ** -0.5),
        "diff_lambda_q1": _normal(ks[9], (N_DIFF_LAYERS, DIFF_HEAD_DIM), 0.1),
        "diff_lambda_k1": _normal(ks[10], (N_DIFF_LAYERS, DIFF_HEAD_DIM), 0.1),
        "diff_lambda_q2": _normal(ks[11], (N_DIFF_LAYERS, DIFF_HEAD_DIM), 0.1),
        "diff_lambda_k2": _normal(ks[12], (N_DIFF_LAYERS, DIFF_HEAD_DIM), 0.1),
        "diff_subln": _gain(ks[13], (N_DIFF_LAYERS, DIFF_V_DIM)),
        "diff_w_out": _normal(ks[14], (N_DIFF_LAYERS, D, D), D ** -0.5),
        "moe_w_group": _normal(ks[15], (DEPTH, D, MOE_GROUPS), D ** -0.5),
        "moe_w_expert": _normal(ks[16], (DEPTH, D, MOE_N_EXPERTS), D ** -0.5),
        "moe_w_gate": _normal(ks[17], (DEPTH, MOE_N_EXPERTS, D, MOE_D_FF), D ** -0.5),
        "moe_w_up": _normal(ks[18], (DEPTH, MOE_N_EXPERTS, D, MOE_D_FF), D ** -0.5),
        "moe_w_down": _normal(ks[19], (DEPTH, MOE_N_EXPERTS, MOE_D_FF, D), MOE_D_FF ** -0.5),
        "final_norm": _gain(ks[20], (D,)),
    }


def reference(x, norm_mix, norm_ffn, gla_w_in, gla_w_gate_up, gla_b_gate, gla_norm, gla_w_out,
              diff_w_in, diff_lambda_q1, diff_lambda_k1, diff_lambda_q2, diff_lambda_k2,
              diff_subln, diff_w_out, moe_w_group, moe_w_expert, moe_w_gate, moe_w_up,
              moe_w_down, final_norm):
    for i in range(DEPTH):
        hn = _rmsnorm(x, norm_mix[i])
        j = i // N_MIXERS
        if i % N_MIXERS == 0:
            x = x + _gla_mixer(hn, gla_w_in[j], gla_w_gate_up[j], gla_b_gate[j], gla_norm[j], gla_w_out[j])
        else:
            x = x + _diff_attention(hn, diff_w_in[j], diff_lambda_q1[j], diff_lambda_k1[j],
                                    diff_lambda_q2[j], diff_lambda_k2[j], diff_subln[j],
                                    diff_w_out[j], i)
        hn = _rmsnorm(x, norm_ffn[i])
        x = x + _hier_moe(hn, moe_w_group[i], moe_w_expert[i], moe_w_gate[i], moe_w_up[i], moe_w_down[i])
    return _rmsnorm(x, final_norm)
```

```cpp
#ifndef DIAG
#define DIAG 0
#endif
#include <hip/hip_runtime.h>
#include <cstdio>
#include <cstdint>

#define LAS __attribute__((address_space(3)))
#define GAS __attribute__((address_space(1)))
typedef unsigned short bf16_t;
typedef short bf16x8 __attribute__((ext_vector_type(8)));
typedef short s16x4 __attribute__((ext_vector_type(4)));
typedef float f32x4 __attribute__((ext_vector_type(4)));
typedef float f32x2 __attribute__((ext_vector_type(2)));
typedef float f32x16 __attribute__((ext_vector_type(16)));
typedef unsigned u32x4 __attribute__((ext_vector_type(4)));
typedef unsigned u32x2 __attribute__((ext_vector_type(2)));

constexpr int D = 2048, SEQ = 16384, NBATCH = 2, T = NBATCH * SEQ, CHUNK = 64, NCH = SEQ / CHUNK;
constexpr int GLA_H = 4, GLA_DK = 256, GLA_DV = 512, GLA_DKT = 1024, GLA_INW = 6160, PROJW = 6144;
constexpr int DIFF_H = 8;
constexpr int NEXP = 32, DFF = 512;
constexpr float RMS_EPS = 1e-6f;
constexpr float LAMBDA_INIT = 0.35550906759f;
constexpr int MAX_TILES = 288;

constexpr size_t MiB = 1u << 20;
constexpr size_t WS_CTL = 0, CTL_ZERO_BYTES = 1 * MiB;
constexpr size_t WS_GZ = 2 * MiB;
constexpr size_t WS_TOKE = 4 * MiB;
constexpr size_t WS_TOKP = WS_TOKE + 256 * 1024;
constexpr size_t WS_TOKW = WS_TOKP + 256 * 1024;
constexpr size_t WS_SLOT = WS_TOKW + 256 * 1024;
constexpr size_t WS_ADEC = 8 * MiB;
constexpr size_t WS_WPGZ = 10 * MiB;
constexpr size_t WS_WPR0 = 10 * MiB + 256 * 1024;
constexpr size_t WS_WPR1 = 11 * MiB;
constexpr size_t WS_WGI = 16 * MiB, WS_WGO = 40 * MiB, WS_WDI = 48 * MiB, WS_WDO = 72 * MiB;
constexpr size_t WS_WMOE = 80 * MiB;
constexpr size_t WS_WMOE_D = WS_WMOE + 128 * MiB;
constexpr size_t WS_HN = 272 * MiB;
constexpr size_t WS_PROJ = 400 * MiB;
constexpr size_t WS_BUF1 = 784 * MiB;
constexpr size_t WS_BUF2 = 912 * MiB;
constexpr size_t WS_AG = 400 * MiB;
constexpr size_t WS_OB = 688 * MiB;
constexpr size_t WS_H = 976 * MiB;
constexpr size_t WS_END = 1048 * MiB;
constexpr int CW_BAR = 4096;
constexpr int CW_CNT0 = 16384, CW_CNT1 = 16384 + 32 * 64;

constexpr int RING_BYTES = 131072;
constexpr int LDSCTL_OFF = RING_BYTES;
constexpr int MISC_OFF = LDSCTL_OFF + 320;
constexpr int TAB_OFF = LDSCTL_OFF + 1024;
constexpr int LDS_BYTES = 147456;
constexpr int NWAVES = 8;

typedef __bf16 bf16x2_t __attribute__((ext_vector_type(2)));
__device__ __forceinline__ unsigned cvt_pk_bf16(float lo, float hi) { const f32x2 v = {lo, hi}; return __builtin_bit_cast(unsigned, __builtin_convertvector(v, bf16x2_t)); }
__device__ __forceinline__ float bf_lo(unsigned w) { return __uint_as_float(w << 16); }
__device__ __forceinline__ float bf_hi(unsigned w) { return __uint_as_float(w & 0xffff0000u); }
__device__ __forceinline__ float bf2f(bf16_t b) { return __uint_as_float(((unsigned)b) << 16); }
__device__ __forceinline__ float wave_sum(float v) {
#pragma unroll
    for (int o = 1; o < 64; o <<= 1) v += __shfl_xor(v, o);
    return v;
}
__device__ __forceinline__ int opq(int v) { asm volatile("" : "+v"(v)); return v; }
#define LDS_WAIT() asm volatile("s_waitcnt lgkmcnt(0)" ::: "memory")
#define VM_WAIT() asm volatile("s_waitcnt vmcnt(0)" ::: "memory")
#define WG_BAR() do { asm volatile("s_waitcnt lgkmcnt(0)" ::: "memory"); __builtin_amdgcn_s_barrier(); asm volatile("" ::: "memory"); } while (0)

namespace pg8 {
constexpr int BM = 256, BK = 64, HALF = 128, HTB = HALF * BK * 2, STAGE_BYTES = 8 * HTB, NXCD = 8, WGM = 8;
__host__ __device__ __forceinline__ int lds_byte(int r, int c) { const int st = (r >> 4) * 2 + (c >> 5), rr = r & 15, cc = c & 31, ob = rr * 64 + cc * 2; return st * 1024 + (ob ^ (((ob >> 9) & 1) << 5)); }
__host__ __device__ __forceinline__ void stage_rc(int b, int& R, int& C) { const int st = b / 1024, sb = b % 1024, swz = sb ^ (((sb >> 9) & 1) << 5); R = (st >> 1) * 16 + swz / 64; C = (st & 1) * 32 + (swz % 64) / 2; }
__host__ __device__ __forceinline__ int perm32(int rho) { const int n = rho >> 4, i = rho & 15; return 8 * (i >> 2) + 4 * n + (i & 3); }

struct Unit { int pm, pn; };
struct Gemm { const bf16_t* A; const bf16_t* Bt; int M, N, K; };

struct StaticOrder {
    int nM, nN, nwg, G, c;
    __device__ void init(int M, int N, int G_, int c_) { nM = M / BM; nN = N / BM; nwg = nM * nN; G = G_; c = c_; }
    __device__ bool next(int i, Unit& u) const {
        const long L = (long)i * G + c; if (L >= nwg) return false;
        int wgid = (int)L; { const int q = nwg / NXCD, r = nwg % NXCD, xcd = wgid % NXCD, off = wgid / NXCD; wgid = (xcd < r ? xcd * (q + 1) : r * (q + 1) + (xcd - r) * q) + off; }
        const int nig = WGM * nN, gid = wgid / nig, fm = gid * WGM, gsz = (nM - fm) < WGM ? (nM - fm) : WGM;
        u.pm = fm + ((wgid % nig) % gsz); u.pn = (wgid % nig) / gsz; return true;
    }
    __device__ __forceinline__ size_t bofs(const Unit&) const { return 0; }
};
struct MoeOrder : StaticOrder {
    const LAS int* te; size_t estride;
    __device__ __forceinline__ size_t bofs(const Unit& u) const { return (size_t)te[u.pm] * estride; }
};

struct EpiBf16 {
    static constexpr bool PERM = true;
    bf16_t* O; int ldc;
    __device__ __forceinline__ void operator()(const f32x4 (&acc)[2][2][4][2], const Unit& u, int wr, int wc, int fr, int fq) const {
        const int row0 = u.pm * BM + wr * 64 + fr, col0 = u.pn * BM + wc * 32 + 8 * fq;
#pragma unroll
        for (int ai = 0; ai < 2; ++ai)
#pragma unroll
            for (int m = 0; m < 4; ++m) { bf16_t* rowp = O + (size_t)(row0 + ai * HALF + m * 16) * ldc + col0;
#pragma unroll
                for (int bj = 0; bj < 2; ++bj) { const f32x4 v0 = acc[ai][bj][m][0], v1 = acc[ai][bj][m][1];
                    u32x4 w; w.x = cvt_pk_bf16(v0[0], v0[1]); w.y = cvt_pk_bf16(v0[2], v0[3]); w.z = cvt_pk_bf16(v1[0], v1[1]); w.w = cvt_pk_bf16(v1[2], v1[3]);
                    *(u32x4*)(rowp + bj * HALF) = w; } }
    }
};
struct EpiResF32 {
    static constexpr bool PERM = false;
    const float* base; float* C; int ldc;
    __device__ __forceinline__ void operator()(const f32x4 (&acc)[2][2][4][2], const Unit& u, int wr, int wc, int fr, int fq) const {
        const int row0 = u.pm * BM + wr * 64 + fr, col0 = u.pn * BM + wc * 32 + 4 * fq;
#pragma unroll
        for (int ai = 0; ai < 2; ++ai)
#pragma unroll
            for (int m = 0; m < 4; ++m) { const size_t off = (size_t)(row0 + ai * HALF + m * 16) * ldc + col0;
#pragma unroll
                for (int bj = 0; bj < 2; ++bj)
#pragma unroll
                    for (int n = 0; n < 2; ++n) { const f32x4 bs = *(const f32x4*)(base + off + bj * HALF + n * 16); *(f32x4*)(C + off + bj * HALF + n * 16) = bs + acc[ai][bj][m][n]; }
                asm volatile("" ::: "memory"); }
    }
};
struct EpiSiluMul {
    static constexpr bool PERM = true;
    bf16_t* Hh;
    __device__ __forceinline__ void operator()(const f32x4 (&acc)[2][2][4][2], const Unit& u, int wr, int wc, int fr, int fq) const {
        const int row0 = u.pm * BM + wr * 64 + fr, col0 = u.pn * HALF + wc * 32 + 8 * fq;
#pragma unroll
        for (int ai = 0; ai < 2; ++ai)
#pragma unroll
            for (int m = 0; m < 4; ++m) { bf16_t* rowp = Hh + (size_t)(row0 + ai * HALF + m * 16) * DFF + col0;
                float hv[8];
#pragma unroll
                for (int n = 0; n < 2; ++n)
#pragma unroll
                    for (int j = 0; j < 4; ++j) { const float g = acc[ai][0][m][n][j], up = acc[ai][1][m][n][j];
                        const float sg = g * __builtin_amdgcn_rcpf(1.0f + __builtin_amdgcn_exp2f(-1.4426950408889634f * g)); hv[n * 4 + j] = sg * up; }
                u32x4 w; w.x = cvt_pk_bf16(hv[0], hv[1]); w.y = cvt_pk_bf16(hv[2], hv[3]); w.z = cvt_pk_bf16(hv[4], hv[5]); w.w = cvt_pk_bf16(hv[6], hv[7]);
                *(u32x4*)rowp = w; }
    }
};

template <class Epi, class Sched>
__device__ __forceinline__ void gemm_phase(LAS unsigned char* lds, const Gemm g, const Sched& S, const Epi& E) {
    const int tid = opq((int)threadIdx.x), wid = __builtin_amdgcn_readfirstlane(tid >> 6), lane = tid & 63, wr = wid >> 2, wc = wid & 3, fr = lane & 15, fq = lane >> 4;
    const int K = g.K, nt = K / BK;
    unsigned voffA[2], voffB[2];
#pragma unroll
    for (int i = 0; i < 2; ++i) { int R, C; stage_rc(tid * 16 + i * 8192, R, C); const int Rb = Epi::PERM ? ((R & ~31) + perm32(R & 31)) : R;
        voffA[i] = (unsigned)(R * K + C) * 2u; voffB[i] = (unsigned)(Rb * K + C) * 2u; }
    const size_t kstep = (size_t)(BK * 2);
    const size_t hstep = (size_t)HALF * K * 2;
    const size_t tstep = 2 * hstep;
    const unsigned ldsw = (unsigned)wid * 1024u;
    const int aoff = lds_byte(wr * 64 + fr, fq * 8), boff = lds_byte(wc * 32 + fr, fq * 8);
#define PG8_SA(b, h) (((b) * 2 + (h)) * HTB)
#define PG8_SB(b, h) ((4 + (b) * 2 + (h)) * HTB)
#define PG8_STAGE(bufoff, gbase, voff) do { _Pragma("unroll") for (int _i = 0; _i < 2; ++_i) \
        __builtin_amdgcn_global_load_lds((const unsigned*)((const char*)(gbase) + (voff)[_i]), (LAS unsigned*)(lds + (bufoff) + ldsw + _i * 8192), 16, 0, 0); } while (0)
#define PG8_LDA(dst, b, h) do { _Pragma("unroll") for (int m = 0; m < 4; ++m) _Pragma("unroll") for (int k = 0; k < 2; ++k) dst[m][k] = *(const LAS bf16x8*)(lds + PG8_SA(b, h) + aoff + m * 2048 + k * 1024); } while (0)
#define PG8_LDB(dst, b, h) do { _Pragma("unroll") for (int n = 0; n < 2; ++n) _Pragma("unroll") for (int k = 0; k < 2; ++k) dst[n][k] = *(const LAS bf16x8*)(lds + PG8_SB(b, h) + boff + n * 2048 + k * 1024); } while (0)
#define PG8_MMA(ai, bj, At, Bt) do { __builtin_amdgcn_s_setprio(1); _Pragma("unroll") for (int m = 0; m < 4; ++m) _Pragma("unroll") for (int n = 0; n < 2; ++n) _Pragma("unroll") for (int k = 0; k < 2; ++k) \
        acc[ai][bj][m][n] = __builtin_amdgcn_mfma_f32_16x16x32_bf16(Bt[n][k], At[m][k], acc[ai][bj][m][n], 0, 0, 0); __builtin_amdgcn_s_setprio(0); } while (0)
#define PG8_WAIT_V(n) asm volatile("s_waitcnt vmcnt(" #n ")" ::: "memory")
#define PG8_WAIT_L(n) asm volatile("s_waitcnt lgkmcnt(" #n ")" ::: "memory")
#define PG8_BAR __builtin_amdgcn_s_barrier()
#define PG8_SCHED __builtin_amdgcn_sched_barrier(0)
    Unit cur, nxt; int ui = 0;
    if (!S.next(0, cur)) return;
    f32x4 acc[2][2][4][2];
#pragma unroll
    for (int a = 0; a < 2; ++a)
#pragma unroll
        for (int b = 0; b < 2; ++b)
#pragma unroll
            for (int m = 0; m < 4; ++m)
#pragma unroll
                for (int n = 0; n < 2; ++n) acc[a][b][m][n] = (f32x4){0.f, 0.f, 0.f, 0.f};
    bf16x8 At[4][2], B0[2][2], B1[2][2];
    const char* cA = (const char*)g.A + (size_t)cur.pm * tstep; const char* cB = (const char*)g.Bt + S.bofs(cur) + (size_t)cur.pn * tstep;
    PG8_STAGE(PG8_SB(0, 0), cB, voffB); PG8_STAGE(PG8_SB(0, 1), cB + hstep, voffB); PG8_STAGE(PG8_SA(0, 0), cA, voffA); PG8_STAGE(PG8_SA(0, 1), cA + hstep, voffA);
    if (wr == 1) PG8_BAR;
    PG8_WAIT_V(2); PG8_BAR;
    PG8_STAGE(PG8_SB(1, 0), cB + kstep, voffB); PG8_STAGE(PG8_SA(1, 0), cA + kstep, voffA); PG8_STAGE(PG8_SB(1, 1), cB + hstep + kstep, voffB);
    PG8_WAIT_V(6); PG8_BAR;
    for (;;) {
        const bool has_next = S.next(ui + 1, nxt);
        const char* nA = has_next ? (const char*)g.A + (size_t)nxt.pm * tstep : cA; const char* nB = has_next ? (const char*)g.Bt + S.bofs(nxt) + (size_t)nxt.pn * tstep : cB;
        for (int t = 0; t < nt; t += 2) {
            const bool last = (t == nt - 2);
            const char* a1 = cA + (size_t)(t + 1) * kstep;
            const char* a2 = last ? nA : cA + (size_t)(t + 2) * kstep; const char* b2 = last ? nB : cB + (size_t)(t + 2) * kstep;
            const char* a3 = a2 + kstep; const char* b3 = b2 + kstep;
            PG8_LDB(B0, 0, 0); PG8_LDB(B1, 0, 1); PG8_SCHED; PG8_LDA(At, 0, 0); PG8_STAGE(PG8_SA(1, 1), a1 + hstep, voffA);
            PG8_WAIT_V(8); PG8_WAIT_L(0); PG8_BAR; PG8_MMA(0, 0, At, B0); PG8_MMA(0, 1, At, B1); PG8_BAR; PG8_SCHED;
            PG8_LDA(At, 0, 1); PG8_STAGE(PG8_SB(0, 0), b2, voffB); PG8_STAGE(PG8_SB(0, 1), b2 + hstep, voffB); PG8_STAGE(PG8_SA(0, 0), a2, voffA);
            PG8_WAIT_V(8); PG8_WAIT_L(0); PG8_BAR; PG8_MMA(1, 0, At, B0); PG8_MMA(1, 1, At, B1); PG8_BAR; PG8_SCHED;
            PG8_LDB(B0, 1, 0); PG8_LDB(B1, 1, 1); PG8_SCHED; PG8_LDA(At, 1, 0); PG8_STAGE(PG8_SA(0, 1), a2 + hstep, voffA);
            PG8_WAIT_V(8); PG8_WAIT_L(0); PG8_BAR; PG8_MMA(0, 0, At, B0); PG8_MMA(0, 1, At, B1); PG8_BAR; PG8_SCHED;
            PG8_LDA(At, 1, 1); PG8_STAGE(PG8_SB(1, 0), b3, voffB); PG8_STAGE(PG8_SB(1, 1), b3 + hstep, voffB); PG8_STAGE(PG8_SA(1, 0), a3, voffA);
            PG8_WAIT_V(8); PG8_WAIT_L(0); PG8_BAR; PG8_MMA(1, 0, At, B0); PG8_MMA(1, 1, At, B1); PG8_BAR; PG8_SCHED;
        }
        if (wr == 0) PG8_BAR;
        E(acc, cur, wr, wc, fr, fq);
        if (!has_next) break;
#pragma unroll
        for (int a = 0; a < 2; ++a)
#pragma unroll
            for (int b = 0; b < 2; ++b)
#pragma unroll
                for (int m = 0; m < 4; ++m)
#pragma unroll
                    for (int n = 0; n < 2; ++n) acc[a][b][m][n] = (f32x4){0.f, 0.f, 0.f, 0.f};
        cur = nxt; cA = nA; cB = nB; ++ui;
        if (wr == 1) PG8_BAR;
    }
    PG8_WAIT_V(0);
    PG8_BAR;
#undef PG8_SA
#undef PG8_SB
#undef PG8_STAGE
#undef PG8_LDA
#undef PG8_LDB
#undef PG8_MMA
#undef PG8_WAIT_V
#undef PG8_WAIT_L
#undef PG8_BAR
#undef PG8_SCHED
}
}

#define XB_TMO      128
#define XB_XCNT(j)  (256  + 64 * (j))
#define XB_XSUB(j)  (1280 + 64 * (j))
#define XB_XGEN(j)  (2304 + 64 * (j))
#define XB_TOP      3328
#define XB_TOPGEN   3392
#define XCD_BAR_WORDS 3456
#define XB_SPIN_CAP (1u << 18)
__device__ __forceinline__ unsigned xb_ld(unsigned* p)              { return __hip_atomic_load(p, __ATOMIC_RELAXED, __HIP_MEMORY_SCOPE_AGENT); }
__device__ __forceinline__ unsigned xb_add(unsigned* p, unsigned v) { return __hip_atomic_fetch_add(p, v, __ATOMIC_RELAXED, __HIP_MEMORY_SCOPE_AGENT); }
__device__ __forceinline__ unsigned xb_xcc_id() { return (unsigned)__builtin_amdgcn_s_getreg((3 << 11) | 20) & 0xFu; }
#define XB_SPIN(cond, bar) do { unsigned _sp = 0; while (cond) { __builtin_amdgcn_s_sleep(1); \
    if ((++_sp & 255u) == 0u) { if (xb_ld(&(bar)[XB_TMO])) break; if (_sp > XB_SPIN_CAP) { atomicAdd(&(bar)[XB_TMO], 1u); break; } } } } while (0)
struct XcdBarrier { unsigned* bar; unsigned x; volatile LAS unsigned* st; };
__device__ __forceinline__ XcdBarrier xcd_barrier_post(unsigned* bar, volatile LAS unsigned* st) {
    XcdBarrier b; b.bar = bar; b.x = xb_xcc_id(); b.st = st;
    if (threadIdx.x == 0) (void)xb_add(&bar[XB_XCNT(b.x)], 1u);
    return b;
}
__device__ __forceinline__ void xcd_barrier_complete(unsigned* bar, unsigned x, unsigned& nloc, unsigned& nx) {
    const unsigned G = gridDim.x * gridDim.y * gridDim.z;
    unsigned sum, cnt, mine, sp = 0u;
    for (;;) {
        sum = 0u; cnt = 0u; mine = 0u;
#pragma unroll
        for (unsigned j = 0; j < 16; ++j) { const unsigned c = xb_ld(&bar[XB_XCNT(j)]); sum += c; cnt += (c > 0u) ? 1u : 0u; mine = (j == x) ? c : mine; }
        if (sum == G) break;
        __builtin_amdgcn_s_sleep(1);
        if ((++sp & 255u) == 0u) { if (xb_ld(&bar[XB_TMO])) break; if (sp > XB_SPIN_CAP) { atomicAdd(&bar[XB_TMO], 1u); break; } }
    }
    nloc = mine > 0u ? mine : 1u; nx = cnt > 0u ? cnt : 1u;
}
__device__ __forceinline__ void xcd_barrier(const XcdBarrier& b) {
    asm volatile("s_waitcnt vmcnt(0)" ::: "memory");
    __syncthreads();
    if (threadIdx.x == 0) {
        unsigned* bar = b.bar;
        __builtin_amdgcn_s_waitcnt(0);
        unsigned nloc = b.st[0], nx = b.st[1];
        if (nloc == 0u) { xcd_barrier_complete(bar, b.x, nloc, nx); b.st[0] = nloc; b.st[1] = nx; }
        const unsigned old = xb_add(&bar[XB_XSUB(b.x)], 1u);
        const unsigned gen = old / nloc;
        if (old + 1u == (gen + 1u) * nloc) {
            __builtin_amdgcn_fence(__ATOMIC_RELEASE, "agent");
            asm volatile("s_waitcnt vmcnt(0)" ::: "memory");
            const unsigned og = xb_add(&bar[XB_TOP], 1u);
            const unsigned tg = og / nx;
            if (og + 1u == (tg + 1u) * nx) xb_add(&bar[XB_TOPGEN], 1u);
            else XB_SPIN(xb_ld(&bar[XB_TOPGEN]) == tg, bar);
            __builtin_amdgcn_fence(__ATOMIC_ACQUIRE, "agent");
            xb_add(&bar[XB_XGEN(b.x)], 1u);
            asm volatile("s_waitcnt vmcnt(0)" ::: "memory");
        } else {
            XB_SPIN(xb_ld(&bar[XB_XGEN(b.x)]) == gen, bar);
            __builtin_amdgcn_fence(__ATOMIC_ACQUIRE, "agent");
            asm volatile("s_waitcnt vmcnt(0)" ::: "memory");
        }
    }
    __syncthreads();
}

struct Frame {
    LAS unsigned char* lds;
    int tid, lane, wave, vcu, G;
};
struct Args {
    const float* in[21]; float* out; unsigned char* ws; int upto, pad1;
};

__device__ __forceinline__ void transpose_item(const float* W, int ldw, int k0, int n0, bf16_t* WT, int ldk, int drow0, LAS float* scr, int lane) {
#pragma unroll 8
    for (int i = 0; i < 32; ++i) { const int kk = 2 * i + (lane >> 5); scr[kk * 33 + (lane & 31)] = W[(size_t)(k0 + kk) * ldw + n0 + (lane & 31)]; }
    LDS_WAIT(); asm volatile("" ::: "memory");
    const int c = lane & 7;
#pragma unroll
    for (int j = 0; j < 4; ++j) { const int n = (lane >> 3) + 8 * j; const LAS float* s = scr + (8 * c) * 33 + n;
        u32x4 o; o.x = cvt_pk_bf16(s[0 * 33], s[1 * 33]); o.y = cvt_pk_bf16(s[2 * 33], s[3 * 33]); o.z = cvt_pk_bf16(s[4 * 33], s[5 * 33]); o.w = cvt_pk_bf16(s[6 * 33], s[7 * 33]);
        *(u32x4*)(WT + (size_t)(drow0 + n) * ldk + k0 + 8 * c) = o; }
    LDS_WAIT(); asm volatile("" ::: "memory");
}
__device__ __forceinline__ void conv_plain(Frame& F, const float* W, int K, int N, int ldw, bf16_t* WT) {
    LAS float* scr = (LAS float*)(F.lds + F.wave * 16384);
    const int gw = F.vcu * NWAVES + F.wave, NGW = F.G * NWAVES, nblk = N / 32, nit = (K / 64) * nblk;
    for (int it = gw; it < nit; it += NGW) { const int kb = it / nblk, nb = it % nblk; transpose_item(W, ldw, 64 * kb, 32 * nb, WT, K, 32 * nb, scr, F.lane); }
}
__device__ __forceinline__ void conv_moe(Frame& F, const float* wg, const float* wu, const float* wd, bf16_t* GU, bf16_t* DT) {
    LAS float* scr = (LAS float*)(F.lds + F.wave * 16384);
    const int gw = F.vcu * NWAVES + F.wave, NGW = F.G * NWAVES;
    constexpr int PER_E = 1536, NIT = NEXP * PER_E;
    for (int it = gw; it < NIT; it += NGW) {
        const int e = it / PER_E; int r = it % PER_E;
        if (r < 1024) { const int up = r >> 9; r &= 511; const int kb = r >> 4, nb = r & 15, n0 = 32 * nb;
            const int drow = 256 * (n0 >> 7) + 128 * up + (n0 & 127);
            transpose_item((up ? wu : wg) + (size_t)e * D * DFF, DFF, 64 * kb, n0, GU + (size_t)e * 1024 * D, D, drow, scr, F.lane); }
        else { r -= 1024; const int kb = r >> 6, nb = r & 63;
            transpose_item(wd + (size_t)e * DFF * D, D, 64 * kb, 32 * nb, DT + (size_t)e * D * DFF, DFF, 32 * nb, scr, F.lane); }
    }
}
__device__ __forceinline__ void pack_proj(Frame& F, float* Wp, int NT, const float* gain, const float* Wa, int lda, int ca0, int na, const float* Wb, int ldb, int nb) {
    const int total = 128 * NT * 256;
    for (int idx = (F.vcu * NWAVES * 64) + F.tid; idx < total; idx += F.G * NWAVES * 64) {
        const int e = idx & 3, ln = (idx >> 2) & 63, rest = idx >> 8, nt = rest % NT, s = rest / NT;
        const int k = 16 * s + 4 * (ln >> 4) + e, col = 16 * nt + (ln & 15);
        float v = 0.f;
        if (col < na) v = Wa[(size_t)k * lda + ca0 + col]; else if (col < na + nb) v = Wb[(size_t)k * ldb + (col - na)];
        Wp[idx] = v * gain[k];
    }
}

template <int NT>
__device__ __forceinline__ float wave_proj16(const float* xin, int tok0, const float* Wp, int lane, f32x4 (&acc)[NT]) {
    const int tr = lane & 15, kq = lane >> 4;
    const f32x4* xp = (const f32x4*)(xin + (size_t)(tok0 + tr) * D) + kq;
    const f32x4* wp = (const f32x4*)Wp + lane;
    float ssq = 0.f;
#pragma unroll
    for (int n = 0; n < NT; ++n) acc[n] = (f32x4){0.f, 0.f, 0.f, 0.f};
#pragma unroll 2
    for (int s = 0; s < 128; ++s) {
        const f32x4 xv = xp[4 * s];
        ssq += (xv[0] * xv[0] + xv[1] * xv[1]) + (xv[2] * xv[2] + xv[3] * xv[3]);
#pragma unroll
        for (int n = 0; n < NT; ++n) { const f32x4 wv = wp[(s * NT + n) * 64];
#pragma unroll
            for (int e = 0; e < 4; ++e) acc[n] = __builtin_amdgcn_mfma_f32_16x16x4f32(xv[e], wv[e], acc[n], 0, 0, 0); }
    }
    ssq += __shfl_xor(ssq, 16); ssq += __shfl_xor(ssq, 32);
    return 1.0f / sqrtf(ssq * (1.0f / D) + RMS_EPS);
}
__device__ __forceinline__ void wave_write_hn16(const float* xin, int tok0, float rstd, const float* gain, bf16_t* hn, int lane) {
    f32x4 g4[8];
#pragma unroll
    for (int j = 0; j < 8; ++j) g4[j] = ((const f32x4*)gain)[lane + 64 * j];
    for (int i = 0; i < 16; ++i) {
        const float rr = __shfl(rstd, i);
        const f32x4* xr = (const f32x4*)(xin + (size_t)(tok0 + i) * D);
        u32x2* orow = (u32x2*)(hn + (size_t)(tok0 + i) * D);
#pragma unroll
        for (int j = 0; j < 8; ++j) { const f32x4 v = xr[lane + 64 * j] * rr * g4[j]; u32x2 w; w.x = cvt_pk_bf16(v[0], v[1]); w.y = cvt_pk_bf16(v[2], v[3]); orow[lane + 64 * j] = w; }
    }
}

__device__ __forceinline__ void phase_norm_gz(Frame& F, const float* xin, const float* gain, const float* Wp, bf16_t* hn, float* gz) {
    for (int tile = F.vcu; tile < T / 128; tile += F.G) {
        const int tok0 = tile * 128 + F.wave * 16;
        f32x4 acc[1];
        const float rstd = wave_proj16<1>(xin, tok0, Wp, F.lane, acc);
        const int j = F.lane & 15, q4 = F.lane >> 4;
#pragma unroll
        for (int r = 0; r < 4; ++r) { const float rr = __shfl(rstd, 4 * q4 + r); gz[(size_t)(tok0 + 4 * q4 + r) * 16 + j] = acc[0][r] * rr; }
        wave_write_hn16(xin, tok0, rstd, gain, hn, F.lane);
    }
}
__device__ __forceinline__ void phase_norm_route(Frame& F, const float* xin, const float* gain, const float* Wp, bf16_t* hn, int* tok_e, int* tok_p, float* tok_w, unsigned* cnt) {
    LAS float* lg = (LAS float*)(F.lds + F.wave * 4096);
    for (int tile = F.vcu; tile < T / 128; tile += F.G) {
        const int tok0 = tile * 128 + F.wave * 16;
        f32x4 acc[3];
        const float rstd = wave_proj16<3>(xin, tok0, Wp, F.lane, acc);
        const int j = F.lane & 15, q4 = F.lane >> 4;
#pragma unroll
        for (int r = 0; r < 4; ++r) { const float rr = __shfl(rstd, 4 * q4 + r);
#pragma unroll
            for (int n = 0; n < 3; ++n) lg[(4 * q4 + r) * 48 + 16 * n + j] = acc[n][r] * rr; }
        LDS_WAIT(); asm volatile("" ::: "memory");
        if (F.lane < 16) {
            const LAS float* l = lg + F.lane * 48;
            float gm = l[0]; int gi = 0;
#pragma unroll
            for (int q = 1; q < 4; ++q) { const float v = l[q]; if (v > gm) { gm = v; gi = q; } }
            float gs = 0.f;
#pragma unroll
            for (int q = 0; q < 4; ++q) gs += __expf(l[q] - gm);
            const float gw = 1.0f / gs;
            const LAS float* se = l + 4 + 8 * gi;
            float m1 = se[0]; int i1 = 0;
#pragma unroll
            for (int q = 1; q < 8; ++q) { const float v = se[q]; if (v > m1) { m1 = v; i1 = q; } }
            float m2 = -3.0e38f; int i2 = 0;
#pragma unroll
            for (int q = 0; q < 8; ++q) { const float v = se[q]; if (q != i1 && v > m2) { m2 = v; i2 = q; } }
            const float eb = __expf(m2 - m1), inv = 1.0f / (1.0f + eb);
            const int t = tok0 + F.lane, e1 = gi * 8 + i1, e2 = gi * 8 + i2;
            const unsigned p1 = __hip_atomic_fetch_add(cnt + 64 * e1, 1u, __ATOMIC_RELAXED, __HIP_MEMORY_SCOPE_AGENT);
            const unsigned p2 = __hip_atomic_fetch_add(cnt + 64 * e2, 1u, __ATOMIC_RELAXED, __HIP_MEMORY_SCOPE_AGENT);
            tok_e[2 * t] = e1; tok_e[2 * t + 1] = e2; tok_p[2 * t] = (int)p1; tok_p[2 * t + 1] = (int)p2;
            tok_w[2 * t] = gw * inv; tok_w[2 * t + 1] = gw * eb * inv;
        }
        wave_write_hn16(xin, tok0, rstd, gain, hn, F.lane);
        LDS_WAIT(); asm volatile("" ::: "memory");
    }
}

__device__ __forceinline__ void phase_gla_gate(Frame& F, const float* gz, const float* wgu, const float* bgate, const bf16_t* proj, bf16_t* kdT, float* adec) {
    LAS f32x4* gzs = (LAS f32x4*)F.lds;
    for (int u = F.vcu; u < NBATCH * NCH * 2; u += F.G) {
        const int half = u & 1, bc = u >> 1;
        const int tok0 = bc * 64, j = half * 512 + F.tid;
        if (F.tid < 256) gzs[F.tid] = ((const f32x4*)(gz + (size_t)tok0 * 16))[F.tid];
        float wg[16];
#pragma unroll
        for (int r = 0; r < 16; ++r) wg[r] = wgu[r * GLA_DKT + j];
        const float bg = bgate[j];
        WG_BAR();
        float cum[64]; float run = 0.f;
#pragma unroll
        for (int t = 0; t < 64; ++t) {
            float z = bg;
#pragma unroll
            for (int r4 = 0; r4 < 4; ++r4) { const f32x4 g4 = gzs[t * 4 + r4]; z += g4[0] * wg[4 * r4] + g4[1] * wg[4 * r4 + 1] + g4[2] * wg[4 * r4 + 2] + g4[3] * wg[4 * r4 + 3]; }
            const float ls = fminf(z, 0.f) - __logf(1.0f + __expf(-fabsf(z)));
            run += ls * (1.0f / 16.0f); cum[t] = run;
        }
        adec[(size_t)bc * GLA_DKT + j] = __expf(run);
        const bf16_t* kp = proj + (size_t)tok0 * PROJW + GLA_DKT + j;
        u32x4* dst = (u32x4*)(kdT + ((size_t)bc * GLA_DKT + j) * 64);
#pragma unroll
        for (int t8 = 0; t8 < 8; ++t8) {
            float kd[8];
#pragma unroll
            for (int q = 0; q < 8; ++q) { const int t = t8 * 8 + q; kd[q] = bf2f(kp[(size_t)t * PROJW]) * __expf(run - cum[t]); }
            u32x4 w; w.x = cvt_pk_bf16(kd[0], kd[1]); w.y = cvt_pk_bf16(kd[2], kd[3]); w.z = cvt_pk_bf16(kd[4], kd[5]); w.w = cvt_pk_bf16(kd[6], kd[7]);
            dst[t8] = w;
        }
        WG_BAR();
    }
}

__device__ __forceinline__ void phase_gla_scan(Frame& F, const bf16_t* proj, const bf16_t* kdT, const float* adec, bf16_t* oout) {
    const int lane = F.lane, w = F.wave, fr = lane & 15, kq = lane >> 4;
    LAS unsigned char* vbuf = F.lds;
    LAS float* red = (LAS float*)(F.lds + 4096);
    for (int u = F.vcu; u < 256; u += F.G) {
        const int bh = u >> 5, b = bh >> 2, h = bh & 3, sl = u & 31;
        const size_t tokb = (size_t)b * SEQ;
        f32x4 st[2] = {(f32x4){0.f, 0.f, 0.f, 0.f}, (f32x4){0.f, 0.f, 0.f, 0.f}};
        bf16x8 ka[2][2]; f32x4 dc[2]; u32x2 qa[4][2]; u32x4 vreg = (u32x4){0u, 0u, 0u, 0u};
#define SCAN_LOAD(c) do { const size_t bc_ = (size_t)b * NCH + (c); \
            _Pragma("unroll") for (int i = 0; i < 2; ++i) { \
                _Pragma("unroll") for (int s = 0; s < 2; ++s) ka[i][s] = *(const bf16x8*)(kdT + ((bc_ * GLA_DKT + h * 256 + 32 * w + 16 * i + fr) * 64 + 32 * s + 8 * kq)); \
                dc[i] = *(const f32x4*)(adec + bc_ * GLA_DKT + h * 256 + 32 * w + 16 * i + 4 * kq); } \
            _Pragma("unroll") for (int mt = 0; mt < 4; ++mt) { const bf16_t* qp = proj + (tokb + (size_t)(c) * 64 + 16 * mt + fr) * PROJW + h * 256 + 32 * w + 4 * kq; \
                qa[mt][0] = *(const u32x2*)qp; qa[mt][1] = *(const u32x2*)(qp + 16); } \
            if (F.tid < 128) vreg = *(const u32x4*)(proj + (tokb + (size_t)(c) * 64 + (F.tid >> 1)) * PROJW + 2048 + h * 512 + 16 * sl + 8 * (F.tid & 1)); \
        } while (0)
        SCAN_LOAD(0);
        if (F.tid < 128) *(LAS u32x4*)(vbuf + F.tid * 16) = vreg;
        WG_BAR();
        for (int c = 0; c < NCH; ++c) {
            bf16x8 cka[2][2]; f32x4 cdc[2]; u32x2 cqa[4][2];
#pragma unroll
            for (int i = 0; i < 2; ++i) { cka[i][0] = ka[i][0]; cka[i][1] = ka[i][1]; cdc[i] = dc[i]; }
#pragma unroll
            for (int mt = 0; mt < 4; ++mt) { cqa[mt][0] = qa[mt][0]; cqa[mt][1] = qa[mt][1]; }
            if (c + 1 < NCH) SCAN_LOAD(c + 1);
            const unsigned vb = (unsigned)(uintptr_t)(vbuf + (c & 1) * 2048) + (unsigned)((8 * kq + ((lane & 15) >> 2)) * 32 + 8 * (lane & 3));
            s16x4 v00, v01, v10, v11;
            asm volatile("ds_read_b64_tr_b16 %0, %4\n\tds_read_b64_tr_b16 %1, %4 offset:128\n\tds_read_b64_tr_b16 %2, %4 offset:1024\n\tds_read_b64_tr_b16 %3, %4 offset:1152\n\ts_waitcnt lgkmcnt(0)"
                         : "=&v"(v00), "=&v"(v01), "=&v"(v10), "=&v"(v11) : "v"(vb) : "memory");
            const bf16x8 vb0 = (bf16x8){v00[0], v00[1], v00[2], v00[3], v01[0], v01[1], v01[2], v01[3]};
            const bf16x8 vb1 = (bf16x8){v10[0], v10[1], v10[2], v10[3], v11[0], v11[1], v11[2], v11[3]};
#pragma unroll
            for (int i = 0; i < 2; ++i) {
                st[i] = st[i] * cdc[i];
                st[i] = __builtin_amdgcn_mfma_f32_16x16x32_bf16(cka[i][0], vb0, st[i], 0, 0, 0);
                st[i] = __builtin_amdgcn_mfma_f32_16x16x32_bf16(cka[i][1], vb1, st[i], 0, 0, 0);
            }
            u32x4 sw; sw.x = cvt_pk_bf16(st[0][0], st[0][1]); sw.y = cvt_pk_bf16(st[0][2], st[0][3]); sw.z = cvt_pk_bf16(st[1][0], st[1][1]); sw.w = cvt_pk_bf16(st[1][2], st[1][3]);
            const bf16x8 sb = __builtin_bit_cast(bf16x8, sw);
            LAS float* rw = red + ((size_t)((c & 1) * 8 + w) * 64) * 16;
#pragma unroll
            for (int mt = 0; mt < 4; ++mt) {
                u32x4 qw; qw.x = cqa[mt][0].x; qw.y = cqa[mt][0].y; qw.z = cqa[mt][1].x; qw.w = cqa[mt][1].y;
                const f32x4 po = __builtin_amdgcn_mfma_f32_16x16x32_bf16(__builtin_bit_cast(bf16x8, qw), sb, (f32x4){0.f, 0.f, 0.f, 0.f}, 0, 0, 0);
#pragma unroll
                for (int r = 0; r < 4; ++r) rw[(16 * mt + 4 * kq + r) * 16 + fr] = po[r];
            }
            if (c + 1 < NCH && F.tid < 128) *(LAS u32x4*)(vbuf + ((c + 1) & 1) * 2048 + F.tid * 16) = vreg;
            WG_BAR();
            {
                const int t = F.tid >> 3, vc2 = (F.tid & 7) * 2;
                float s0 = 0.f, s1 = 0.f;
#pragma unroll
                for (int ww = 0; ww < 8; ++ww) { const f32x2 p = *(const LAS f32x2*)(red + ((size_t)((c & 1) * 8 + ww) * 64 + t) * 16 + vc2); s0 += p.x; s1 += p.y; }
                *(unsigned*)(oout + (tokb + (size_t)c * 64 + t) * D + h * 512 + 16 * sl + vc2) = cvt_pk_bf16(s0 * 0.0625f, s1 * 0.0625f);
            }
        }
        WG_BAR();
#undef SCAN_LOAD
    }
}

__device__ __forceinline__ void phase_gla_gnorm(Frame& F, const bf16_t* o, const bf16_t* proj, const float* gn, bf16_t* y) {
    const int gw = F.vcu * NWAVES + F.wave, NGW = F.G * NWAVES, lane = F.lane;
    const f32x4 g0 = ((const f32x4*)gn)[2 * lane], g1 = ((const f32x4*)gn)[2 * lane + 1];
    for (int idx = gw; idx < T * GLA_H; idx += NGW) {
        const int tok = idx >> 2, h = idx & 3;
        const u32x4 ov = *(const u32x4*)(o + (size_t)tok * D + h * 512 + 8 * lane);
        const u32x4 rv = *(const u32x4*)(proj + (size_t)tok * PROJW + 4096 + h * 512 + 8 * lane);
        float a[8], r[8];
#pragma unroll
        for (int q = 0; q < 4; ++q) { a[2 * q] = bf_lo(ov[q]); a[2 * q + 1] = bf_hi(ov[q]); r[2 * q] = bf_lo(rv[q]); r[2 * q + 1] = bf_hi(rv[q]); }
        float ss = 0.f;
#pragma unroll
        for (int q = 0; q < 8; ++q) ss += a[q] * a[q];
        const float rstd = 1.0f / sqrtf(wave_sum(ss) * (1.0f / 512.0f) + RMS_EPS);
        float yv[8];
#pragma unroll
        for (int q = 0; q < 8; ++q) { const float g = q < 4 ? g0[q] : g1[q - 4]; const float sr = r[q] / (1.0f + __expf(-r[q])); yv[q] = a[q] * rstd * g * sr; }
        u32x4 w; w.x = cvt_pk_bf16(yv[0], yv[1]); w.y = cvt_pk_bf16(yv[2], yv[3]); w.z = cvt_pk_bf16(yv[4], yv[5]); w.w = cvt_pk_bf16(yv[6], yv[7]);
        *(u32x4*)(y + (size_t)tok * D + h * 512 + 8 * lane) = w;
    }
}

__device__ __forceinline__ void moe_tables(Frame& F, unsigned* cnt) {
    LAS int* pst = (LAS int*)(F.lds + TAB_OFF);
    LAS int* te = pst + 36;
    if (F.wave == 0) {
        const int e = F.lane & 31;
        const int c = (int)xb_ld(cnt + 64 * e);
        const int ntile = (c + 255) >> 8;
        int incl = ntile;
#pragma unroll
        for (int o = 1; o < 32; o <<= 1) { const int v = __shfl_up(incl, o); if ((F.lane & 31) >= o) incl += v; }
        const int excl = incl - ntile;
        if (F.lane < 32) { pst[e] = excl << 8; for (int q = 0; q < ntile; ++q) te[excl + q] = e; }
        if (F.lane == 31) { pst[32] = incl << 8; pst[33] = incl; }
    }
    WG_BAR();
}
__device__ __forceinline__ void phase_moe_gather(Frame& F, const int* tok_e, const int* tok_p, int* slot_of, const bf16_t* hn, bf16_t* ag) {
    const LAS int* pst = (const LAS int*)(F.lds + TAB_OFF);
    const int gw = F.vcu * NWAVES + F.wave, NGW = F.G * NWAVES, lane = F.lane;
    for (int a = gw; a < 2 * T; a += NGW) {
        const int e = tok_e[a], p = tok_p[a], slot = pst[e] + p, t = a >> 1;
        if (lane == 0) slot_of[a] = slot;
        const u32x4* src = (const u32x4*)(hn + (size_t)t * D); u32x4* dst = (u32x4*)(ag + (size_t)slot * D);
#pragma unroll
        for (int j = 0; j < 4; ++j) dst[lane + 64 * j] = src[lane + 64 * j];
    }
}
template <int MODE>
__device__ __forceinline__ void phase_moe_combine(Frame& F, float* x, const bf16_t* ob, const int* slot_of, const float* tok_w, const float* gain, bf16_t* hn) {
    const int gw = F.vcu * NWAVES + F.wave, NGW = F.G * NWAVES, lane = F.lane;
    f32x4 g4[8];
#pragma unroll
    for (int j = 0; j < 8; ++j) g4[j] = ((const f32x4*)gain)[lane + 64 * j];
    for (int t = gw; t < T; t += NGW) {
        const int s0 = slot_of[2 * t], s1 = slot_of[2 * t + 1]; const float w0 = tok_w[2 * t], w1 = tok_w[2 * t + 1];
        f32x4* xr = (f32x4*)(x + (size_t)t * D);
        const u32x2* a = (const u32x2*)(ob + (size_t)s0 * D); const u32x2* b = (const u32x2*)(ob + (size_t)s1 * D);
        f32x4 v[8]; float ss = 0.f;
#pragma unroll
        for (int j = 0; j < 8; ++j) { const u32x2 av = a[lane + 64 * j], bv = b[lane + 64 * j]; f32x4 xv = xr[lane + 64 * j];
            xv[0] += w0 * bf_lo(av.x) + w1 * bf_lo(bv.x); xv[1] += w0 * bf_hi(av.x) + w1 * bf_hi(bv.x);
            xv[2] += w0 * bf_lo(av.y) + w1 * bf_lo(bv.y); xv[3] += w0 * bf_hi(av.y) + w1 * bf_hi(bv.y);
            v[j] = xv; ss += (xv[0] * xv[0] + xv[1] * xv[1]) + (xv[2] * xv[2] + xv[3] * xv[3]); }
        const float rstd = 1.0f / sqrtf(wave_sum(ss) * (1.0f / D) + RMS_EPS);
        if (MODE == 0) {
            u32x2* orow = (u32x2*)(hn + (size_t)t * D);
#pragma unroll
            for (int j = 0; j < 8; ++j) { xr[lane + 64 * j] = v[j]; const f32x4 y = v[j] * rstd * g4[j]; u32x2 w; w.x = cvt_pk_bf16(y[0], y[1]); w.y = cvt_pk_bf16(y[2], y[3]); orow[lane + 64 * j] = w; }
        } else {
#pragma unroll
            for (int j = 0; j < 8; ++j) xr[lane + 64 * j] = v[j] * rstd * g4[j];
        }
    }
}

__device__ __forceinline__ void phase_subln(Frame& F, const bf16_t* o1, const bf16_t* o2, const float* lq1, const float* lk1, const float* lq2, const float* lk2, const float* sg, bf16_t* y) {
    const int gw = F.vcu * NWAVES + F.wave, NGW = F.G * NWAVES, lane = F.lane;
    const float d1 = wave_sum(lq1[lane] * lk1[lane] + lq1[lane + 64] * lk1[lane + 64]);
    const float d2 = wave_sum(lq2[lane] * lk2[lane] + lq2[lane + 64] * lk2[lane + 64]);
    const float lam = __expf(d1) - __expf(d2) + LAMBDA_INIT;
    const f32x4 g = ((const f32x4*)sg)[lane] * (1.0f - LAMBDA_INIT);
    for (int idx = gw; idx < T * DIFF_H; idx += NGW) {
        const int tok = idx >> 3, h = idx & 7;
        const u32x2 a = *(const u32x2*)(o1 + (size_t)tok * D + h * 256 + 4 * lane), b = *(const u32x2*)(o2 + (size_t)tok * D + h * 256 + 4 * lane);
        f32x4 d; d[0] = bf_lo(a.x) - lam * bf_lo(b.x); d[1] = bf_hi(a.x) - lam * bf_hi(b.x); d[2] = bf_lo(a.y) - lam * bf_lo(b.y); d[3] = bf_hi(a.y) - lam * bf_hi(b.y);
        const float ss = (d[0] * d[0] + d[1] * d[1]) + (d[2] * d[2] + d[3] * d[3]);
        const float rstd = 1.0f / sqrtf(wave_sum(ss) * (1.0f / 256.0f) + RMS_EPS);
        const f32x4 yv = d * rstd * g;
        u32x2 w; w.x = cvt_pk_bf16(yv[0], yv[1]); w.y = cvt_pk_bf16(yv[2], yv[3]);
        *(u32x2*)(y + (size_t)tok * D + h * 256 + 4 * lane) = w;
    }
}

namespace att {
constexpr int SHM_K = 64 * 128 * 2, SHM_V = 64 * 256 * 2;
constexpr int V_OFF = 0, K_OFF = 2 * SHM_V, SCR_OFF = 2 * SHM_V + 2 * SHM_K;
constexpr float SCALE = 0.08838834764831845f;
constexpr float C2 = 1.4426950408889634f * SCALE;
constexpr float THR = 8.f;
#define KSWZ(row, colB) ((row) * 256 + ((colB) ^ (((row) & 7) << 4)))
__device__ __forceinline__ int crow(int r, int hi) { return (r & 3) + 8 * (r >> 2) + 4 * hi; }
__device__ __forceinline__ int v_rd_base(int lane) { return ((lane & 3) << 3) | (((lane >> 2) & 3) << 6) | (((lane >> 4) & 1) << 5) | (((lane >> 5) & 1) << 8); }
constexpr int v_rd_off(int d0, int ks, int half) { return d0 * 512 + ks * 8192 + half * 4096; }

template <int KB>
__device__ __forceinline__ void qkt(f32x16& p0, f32x16& p1, LAS unsigned char* lds, int r32, int hi, const bf16x8 (&qr)[8]) {
    const LAS unsigned char* kb[4];
#pragma unroll
    for (int dd = 0; dd < 4; ++dd) kb[dd] = lds + K_OFF + KB * SHM_K + KSWZ(r32, (dd * 16 + hi * 8) * 2);
#pragma unroll
    for (int d0 = 0; d0 < 8; ++d0) { const LAS unsigned char* a = kb[d0 & 3] + (d0 >> 2) * 128;
        const bf16x8 b0 = *(const LAS bf16x8*)a;
        const bf16x8 b1 = *(const LAS bf16x8*)(a + 32 * 256);
        p0 = __builtin_amdgcn_mfma_f32_32x32x16_bf16(b0, qr[d0], p0, 0, 0, 0);
        p1 = __builtin_amdgcn_mfma_f32_32x32x16_bf16(b1, qr[d0], p1, 0, 0, 0); }
}
template <int VB>
__device__ __forceinline__ void pv_tile(f32x16 (&o)[8], unsigned vb0, bf16x8 pa0, bf16x8 pa1, bf16x8 pa2, bf16x8 pa3) {
#define TRRD(dst, off) asm volatile("ds_read_b64_tr_b16 %0, %1 offset:%2" : "=&v"(dst) : "v"(vb0), "i"(off) : "memory")
#define PV_D0(d0) do { s16x4 l0, l1, l2, l3, h0, h1, h2, h3; constexpr int b_ = V_OFF + VB * SHM_V + v_rd_off(d0, 0, 0); \
        TRRD(l0, b_); TRRD(h0, b_ + 4096); TRRD(l1, b_ + 8192); TRRD(h1, b_ + 12288); TRRD(l2, b_ + 16384); TRRD(h2, b_ + 20480); TRRD(l3, b_ + 24576); TRRD(h3, b_ + 28672); \
        asm volatile("s_waitcnt lgkmcnt(0)" ::: "memory"); __builtin_amdgcn_sched_barrier(0); \
        o[d0] = __builtin_amdgcn_mfma_f32_32x32x16_bf16(pa0, (bf16x8){l0[0], l0[1], l0[2], l0[3], h0[0], h0[1], h0[2], h0[3]}, o[d0], 0, 0, 0); \
        o[d0] = __builtin_amdgcn_mfma_f32_32x32x16_bf16(pa1, (bf16x8){l1[0], l1[1], l1[2], l1[3], h1[0], h1[1], h1[2], h1[3]}, o[d0], 0, 0, 0); \
        o[d0] = __builtin_amdgcn_mfma_f32_32x32x16_bf16(pa2, (bf16x8){l2[0], l2[1], l2[2], l2[3], h2[0], h2[1], h2[2], h2[3]}, o[d0], 0, 0, 0); \
        o[d0] = __builtin_amdgcn_mfma_f32_32x32x16_bf16(pa3, (bf16x8){l3[0], l3[1], l3[2], l3[3], h3[0], h3[1], h3[2], h3[3]}, o[d0], 0, 0, 0); } while (0)
    PV_D0(0); PV_D0(1); PV_D0(2); PV_D0(3); PV_D0(4); PV_D0(5); PV_D0(6); PV_D0(7);
#undef PV_D0
#undef TRRD
}

__device__ __forceinline__ void stage_offsets(int tid, unsigned (&koff)[2], unsigned (&voff)[4]) {
#pragma unroll
    for (int i = 0; i < 2; ++i) { const int P = tid * 16 + i * 8192, row = P >> 8, ch = ((P & 255) >> 4) ^ (row & 7); koff[i] = (unsigned)(row * PROJW + ch * 8) * 2u; }
#pragma unroll
    for (int i = 0; i < 4; ++i) { const int P = tid * 16 + i * 8192, st = P >> 9, kk = ((st >> 3) << 3) | ((P & 511) >> 6), cg = st & 7, cin = (P & 63) >> 1;
        const int key = (kk & ~0xC) | ((kk & 4) << 1) | ((kk & 8) >> 1); voff[i] = (unsigned)(key * PROJW + cg * 32 + cin) * 2u; }
}
__device__ __forceinline__ const char* uniform_ptr(const void* p) {
    const unsigned long long v = (unsigned long long)p;
    const unsigned lo = __builtin_amdgcn_readfirstlane((unsigned)v), hi = __builtin_amdgcn_readfirstlane((unsigned)(v >> 32));
    return (const char*)(((unsigned long long)hi << 32) | lo);
}
__device__ __forceinline__ void stage_tile(LAS unsigned char* lds, int bf, const bf16_t* kj_, const bf16_t* vj_, int tid_, int wid) {
    const char* kj = uniform_ptr(kj_); const char* vj = uniform_ptr(vj_);
    int tid = tid_; asm volatile("" : "+v"(tid));
    unsigned koff[2], voff[4]; stage_offsets(tid, koff, voff);
#pragma unroll
    for (int i = 0; i < 2; ++i) __builtin_amdgcn_global_load_lds((const unsigned*)(kj + koff[i]), (LAS unsigned*)(lds + K_OFF + bf * SHM_K + wid * 1024 + i * 8192), 16, 0, 0);
#pragma unroll
    for (int i = 0; i < 4; ++i) __builtin_amdgcn_global_load_lds((const unsigned*)(vj + voff[i]), (LAS unsigned*)(lds + V_OFF + bf * SHM_V + wid * 1024 + i * 8192), 16, 0, 0);
}

template <int BF>
__device__ __forceinline__ void tile_compute(LAS unsigned char* lds, int r32, int hi, unsigned vb0, LAS float* al_l, const bf16x8 (&qr)[8], f32x16 (&o)[8],
                                             float& m_reg, float& l_reg, float rawu, float sl2, bool diag, int qi) {
    f32x16 p0, p1;
#pragma unroll
    for (int r = 0; r < 16; ++r) { p0[r] = 0.f; p1[r] = 0.f; }
    qkt<BF>(p0, p1, lds, r32, hi, qr);
#pragma unroll
    for (int r = 0; r < 16; ++r) { const float cr = (float)((r & 3) + 8 * (r >> 2)); p0[r] = fmaf(cr, rawu, p0[r]); p1[r] = fmaf(cr, rawu, p1[r]); }
    if (diag) {
        const float k2raw = 2.f * rawu;
        int qi_ = qi - 4 * hi; asm volatile("" : "+v"(qi_));
#pragma unroll
        for (int r = 0; r < 16; ++r) { const int c = (r & 3) + 8 * (r >> 2); const int d0_ = c - qi_, d1_ = c + 32 - qi_;
            p0[r] -= k2raw * (float)(d0_ > 0 ? d0_ : 0); p1[r] -= k2raw * (float)(d1_ > 0 ? d1_ : 0); }
    }
    const float lane_raw = rawu * (float)(4 * hi), d32raw = 32.f * rawu;
    float pm0 = p0[0], pm1 = p1[0];
#pragma unroll
    for (int r = 1; r < 16; ++r) { pm0 = fmaxf(pm0, p0[r]); pm1 = fmaxf(pm1, p1[r]); }
    float pmax = fmaxf(pm0, pm1 + d32raw) + lane_raw;
    { auto rr = __builtin_amdgcn_permlane32_swap(__float_as_uint(pmax), __float_as_uint(pmax), false, false);
      pmax = fmaxf(__uint_as_float(rr[0]), __uint_as_float(rr[1])); }
    float mn, alpha;
    if (__all((pmax - m_reg) * SCALE <= THR)) { mn = m_reg; alpha = 1.f; }
    else { mn = fmaxf(m_reg, pmax); alpha = __builtin_amdgcn_exp2f((m_reg - mn) * C2); m_reg = mn; }
    const float mnL0 = (lane_raw - mn) * C2, mnL1 = mnL0 + 32.f * sl2;
#pragma unroll
    for (int r = 0; r < 16; ++r) { p0[r] = __builtin_amdgcn_exp2f(fmaf(p0[r], C2, mnL0)); p1[r] = __builtin_amdgcn_exp2f(fmaf(p1[r], C2, mnL1)); }
    if (__any(alpha < 1.f)) {
        if (hi == 0) al_l[r32] = alpha;
        LDS_WAIT();
#pragma unroll
        for (int r = 0; r < 16; ++r) { const float a = al_l[crow(r, hi)];
#pragma unroll
            for (int d = 0; d < 8; ++d) o[d][r] *= a; }
    }
    float ps = 0.f;
#pragma unroll
    for (int r = 0; r < 16; ++r) ps += p0[r] + p1[r];
    { auto rr = __builtin_amdgcn_permlane32_swap(__float_as_uint(ps), __float_as_uint(ps), false, false);
      ps = __uint_as_float(rr[0]) + __uint_as_float(rr[1]); }
    l_reg = l_reg * alpha + ps;
    bf16x8 pa0, pa1, pa2, pa3;
#define PK4(P, B_, OUT) do { unsigned a0 = cvt_pk_bf16(P[B_+0], P[B_+1]), a1 = cvt_pk_bf16(P[B_+2], P[B_+3]); \
        unsigned b0 = cvt_pk_bf16(P[B_+4], P[B_+5]), b1 = cvt_pk_bf16(P[B_+6], P[B_+7]); \
        auto r0 = __builtin_amdgcn_permlane32_swap(a0, b0, false, false); auto r1 = __builtin_amdgcn_permlane32_swap(a1, b1, false, false); \
        u32x4 w = {r0[0], r1[0], r0[1], r1[1]}; OUT = __builtin_bit_cast(bf16x8, w); } while (0)
    PK4(p0, 0, pa0); PK4(p0, 8, pa1); PK4(p1, 0, pa2); PK4(p1, 8, pa3);
#undef PK4
    pv_tile<BF>(o, vb0, pa0, pa1, pa2, pa3);
}

__device__ __forceinline__ void attn_item(LAS unsigned char* lds, const bf16_t* proj, bf16_t* oout, int b, int h, int sub, int qb, int tid, int wid, int lane) {
    const int r32 = lane & 31, hi = lane >> 5;
    const float slope = __builtin_amdgcn_exp2f(-(float)(h + 1));
    const float sl2 = slope * 1.4426950408889634f, rawu = sl2 / C2;
    LAS float* ws = (LAS float*)(lds + SCR_OFF) + wid * 64; LAS float* li_l = ws; LAS float* al_l = ws + 32;
    const size_t tokq = (size_t)b * SEQ + (size_t)qb * 256 + wid * 32;
    const bf16_t* kbase = proj + (size_t)b * SEQ * PROJW + 2048 + h * 256 + sub * 128;
    const bf16_t* vbase = proj + (size_t)b * SEQ * PROJW + 4096 + h * 256;
    bf16x8 qr[8];
#pragma unroll
    for (int d0 = 0; d0 < 8; ++d0) qr[d0] = *(const bf16x8*)(proj + (tokq + r32) * PROJW + h * 256 + sub * 128 + d0 * 16 + hi * 8);
    const float sh64 = 64.f * rawu;
    const int qi = 32 * (wid & 1) + r32;
    const unsigned vb0 = (unsigned)(uintptr_t)(lds + V_OFF) + (unsigned)v_rd_base(lane);
    float m_reg = -1e30f, l_reg = 0.f;
    f32x16 o[8];
#pragma unroll
    for (int d = 0; d < 8; ++d)
#pragma unroll
        for (int r = 0; r < 16; ++r) o[d][r] = 0.f;
    const int NT = 4 * qb + 4, myNT = 4 * qb + (wid >> 1) + 1;
    constexpr size_t TSTEP = (size_t)64 * PROJW;
    stage_tile(lds, 0, kbase, vbase, tid, wid);
    VM_WAIT(); WG_BAR();
    for (int j = 0; j < NT; j += 2) {
        stage_tile(lds, 1, kbase + (size_t)(j + 1) * TSTEP, vbase + (size_t)(j + 1) * TSTEP, tid, wid);
        if (j < myNT) { if (j > 0) m_reg -= sh64; tile_compute<0>(lds, r32, hi, vb0, al_l, qr, o, m_reg, l_reg, rawu, sl2, j == myNT - 1, qi); }
        VM_WAIT(); WG_BAR();
        if (j + 2 < NT) stage_tile(lds, 0, kbase + (size_t)(j + 2) * TSTEP, vbase + (size_t)(j + 2) * TSTEP, tid, wid);
        if (j + 1 < myNT) { m_reg -= sh64; tile_compute<1>(lds, r32, hi, vb0, al_l, qr, o, m_reg, l_reg, rawu, sl2, j + 1 == myNT - 1, qi); }
        VM_WAIT(); WG_BAR();
    }
    if (hi == 0) li_l[r32] = l_reg;
    LDS_WAIT();
    char* Ow = (char*)(oout + tokq * D + h * 256);
    const unsigned lofs = (unsigned)(hi * 4 * D + r32) * 2u;
#pragma unroll
    for (int r = 0; r < 16; ++r) { const float rl = __builtin_amdgcn_rcpf(li_l[crow(r, hi)]);
#pragma unroll
        for (int d0 = 0; d0 < 8; ++d0) { const float v = o[d0][r] * rl; const float vn = __shfl_xor(v, 1);
            if ((r32 & 1) == 0) *(unsigned*)(Ow + (lofs + (unsigned)((((r & 3) + 8 * (r >> 2)) * D + d0 * 32) * 2))) = cvt_pk_bf16(v, vn); } }
    WG_BAR();
}

__device__ __forceinline__ void attn_phase(Frame& F, const bf16_t* proj, bf16_t* o1, bf16_t* o2) {
    for (int r = 0; ; ++r) {
        int I;
        if (F.G == 256) { if (r >= 4) break; I = (F.vcu >> 5) * 128 + r * 32 + (F.vcu & 31); }
        else { I = r * F.G + F.vcu; if (I >= 1024) break; }
        const int bh = I >> 6, sub = (I >> 5) & 1, pi = I & 31, b = bh >> 3, h = bh & 7;
        bf16_t* oo = sub ? o2 : o1;
        for (int pass = 0; pass < 2; ++pass) attn_item(F.lds, proj, oo, b, h, sub, pass ? pi : 63 - pi, F.tid, F.wave, F.lane);
    }
}
}

__global__ void __launch_bounds__(NWAVES * 64, 2) hybrid_fwd(Args args) {
    extern __shared__ __attribute__((aligned(16))) unsigned char lds_raw[];
    Frame F;
    F.lds = (LAS unsigned char*)lds_raw;
    F.tid = threadIdx.x; F.lane = F.tid & 63; F.wave = __builtin_amdgcn_readfirstlane(F.tid >> 6);
    F.G = gridDim.x; { const int bx = blockIdx.x; F.vcu = (F.G % 8 == 0) ? (bx % 8) * (F.G / 8) + bx / 8 : bx; }
    unsigned char* ws = args.ws;
    unsigned* ctl = (unsigned*)(ws + WS_CTL);
    for (int u = F.tid; u < (LDS_BYTES - LDSCTL_OFF) / 4; u += NWAVES * 64) ((LAS unsigned*)(F.lds + LDSCTL_OFF))[u] = 0u;
    __syncthreads();
    volatile LAS unsigned* MISC = (volatile LAS unsigned*)(F.lds + MISC_OFF);
    XcdBarrier bar = xcd_barrier_post(ctl + CW_BAR, MISC + 8);
#define GRID_BAR() xcd_barrier(bar)
#ifdef ONLY_PHASE
#define PHON(n) ((n) == ONLY_PHASE)
#elif DIAG
#define PHON(n) ((n) <= args.upto)
#else
#define PHON(n) 1
#endif

    const float* x_in = args.in[0]; const float* norm_mix = args.in[1]; const float* norm_ffn = args.in[2];
    const float* gla_w_in = args.in[3]; const float* gla_wgu = args.in[4]; const float* gla_bg = args.in[5]; const float* gla_norm = args.in[6]; const float* gla_w_out = args.in[7];
    const float* diff_w_in = args.in[8]; const float* lq1 = args.in[9]; const float* lk1 = args.in[10]; const float* lq2 = args.in[11]; const float* lk2 = args.in[12];
    const float* diff_subln = args.in[13]; const float* diff_w_out = args.in[14];
    const float* moe_wgrp = args.in[15]; const float* moe_wexp = args.in[16]; const float* moe_wg = args.in[17]; const float* moe_wu = args.in[18]; const float* moe_wd = args.in[19];
    const float* final_norm = args.in[20];
    float* xres = args.out;
    float* gz = (float*)(ws + WS_GZ);
    int* tok_e = (int*)(ws + WS_TOKE); int* tok_p = (int*)(ws + WS_TOKP); float* tok_w = (float*)(ws + WS_TOKW); int* slot_of = (int*)(ws + WS_SLOT);
    float* adec = (float*)(ws + WS_ADEC);
    float* wp_gz = (float*)(ws + WS_WPGZ); float* wp_r0 = (float*)(ws + WS_WPR0); float* wp_r1 = (float*)(ws + WS_WPR1);
    bf16_t* wgi = (bf16_t*)(ws + WS_WGI); bf16_t* wgo = (bf16_t*)(ws + WS_WGO); bf16_t* wdi = (bf16_t*)(ws + WS_WDI); bf16_t* wdo = (bf16_t*)(ws + WS_WDO);
    bf16_t* wmoe_gu = (bf16_t*)(ws + WS_WMOE); bf16_t* wmoe_d = (bf16_t*)(ws + WS_WMOE_D);
    bf16_t* hn = (bf16_t*)(ws + WS_HN); bf16_t* proj = (bf16_t*)(ws + WS_PROJ); bf16_t* buf1 = (bf16_t*)(ws + WS_BUF1); bf16_t* buf2 = (bf16_t*)(ws + WS_BUF2);
    bf16_t* ag = (bf16_t*)(ws + WS_AG); bf16_t* ob = (bf16_t*)(ws + WS_OB); bf16_t* hh = (bf16_t*)(ws + WS_H);
    const LAS int* pst = (const LAS int*)(F.lds + TAB_OFF);

    if (PHON(0)) { Frame P = F; P.tid = opq(F.tid); P.lane = P.tid & 63;
    conv_plain(P, gla_w_in, D, PROJW, GLA_INW, wgi);
    conv_plain(P, gla_w_out, D, D, D, wgo);
    conv_plain(P, diff_w_in, D, PROJW, PROJW, wdi);
    conv_plain(P, diff_w_out, D, D, D, wdo);
    conv_moe(P, moe_wg, moe_wu, moe_wd, wmoe_gu, wmoe_d);
    pack_proj(P, wp_gz, 1, norm_mix, gla_w_in, GLA_INW, PROJW, 16, nullptr, 0, 0);
    pack_proj(P, wp_r0, 3, norm_ffn, moe_wgrp, 4, 0, 4, moe_wexp, 32, 32);
    pack_proj(P, wp_r1, 3, norm_ffn + D, moe_wgrp + (size_t)D * 4, 4, 0, 4, moe_wexp + (size_t)D * 32, 32, 32);
    }
    GRID_BAR();
    if (PHON(1)) { Frame P = F; P.tid = opq(F.tid); P.lane = P.tid & 63;
    phase_norm_gz(P, x_in, norm_mix, wp_gz, hn, gz);
    }
    GRID_BAR();
    if (PHON(2)) { Frame P = F; P.tid = opq(F.tid); P.lane = P.tid & 63;
    { pg8::Gemm g{hn, wgi, T, PROJW, D}; pg8::StaticOrder S; S.init(T, PROJW, P.G, (int)blockIdx.x); pg8::EpiBf16 E{proj, PROJW};
      pg8::gemm_phase<pg8::EpiBf16, pg8::StaticOrder>(P.lds, g, S, E); }
    }
    GRID_BAR();
    if (PHON(3)) { Frame P = F; P.tid = opq(F.tid); P.lane = P.tid & 63;
    phase_gla_gate(P, gz, gla_wgu, gla_bg, proj, buf1, adec);
    }
    GRID_BAR();
    if (PHON(4)) { Frame P = F; P.tid = opq(F.tid); P.lane = P.tid & 63;
    phase_gla_scan(P, proj, buf1, adec, buf2);
    }
    GRID_BAR();
    if (PHON(5)) { Frame P = F; P.tid = opq(F.tid); P.lane = P.tid & 63;
    phase_gla_gnorm(P, buf2, proj, gla_norm, hn);
    }
    GRID_BAR();
    if (PHON(6)) { Frame P = F; P.tid = opq(F.tid); P.lane = P.tid & 63;
    { pg8::Gemm g{hn, wgo, T, D, D}; pg8::StaticOrder S; S.init(T, D, P.G, (int)blockIdx.x); pg8::EpiResF32 E{x_in, xres, D};
      pg8::gemm_phase<pg8::EpiResF32, pg8::StaticOrder>(P.lds, g, S, E); }
    }
    GRID_BAR();
    if (PHON(7)) { Frame P = F; P.tid = opq(F.tid); P.lane = P.tid & 63;
    phase_norm_route(P, xres, norm_ffn, wp_r0, hn, tok_e, tok_p, tok_w, ctl + CW_CNT0);
    }
    GRID_BAR();
    if (PHON(8)) { Frame P = F; P.tid = opq(F.tid); P.lane = P.tid & 63;
    moe_tables(P, ctl + CW_CNT0);
    phase_moe_gather(P, tok_e, tok_p, slot_of, hn, ag);
    }
    GRID_BAR();
    if (PHON(9)) { Frame P = F; P.tid = opq(F.tid); P.lane = P.tid & 63;
    { const int Mr = pst[33] * 256; pg8::Gemm g{ag, wmoe_gu, Mr, 1024, D}; pg8::MoeOrder S; S.init(Mr, 1024, P.G, (int)blockIdx.x); S.te = pst + 36; S.estride = (size_t)1024 * D * 2; pg8::EpiSiluMul E{hh};
      pg8::gemm_phase<pg8::EpiSiluMul, pg8::MoeOrder>(P.lds, g, S, E); }
    }
    GRID_BAR();
    if (PHON(10)) { Frame P = F; P.tid = opq(F.tid); P.lane = P.tid & 63;
    { const int Mr = pst[33] * 256; pg8::Gemm g{hh, wmoe_d, Mr, D, DFF}; pg8::MoeOrder S; S.init(Mr, D, P.G, (int)blockIdx.x); S.te = pst + 36; S.estride = (size_t)D * DFF * 2; pg8::EpiBf16 E{ob, D};
      pg8::gemm_phase<pg8::EpiBf16, pg8::MoeOrder>(P.lds, g, S, E); }
    }
    GRID_BAR();
    if (PHON(11)) { Frame P = F; P.tid = opq(F.tid); P.lane = P.tid & 63;
    phase_moe_combine<0>(P, xres, ob, slot_of, tok_w, norm_mix + D, hn);
    conv_moe(P, moe_wg + (size_t)NEXP * D * DFF, moe_wu + (size_t)NEXP * D * DFF, moe_wd + (size_t)NEXP * DFF * D, wmoe_gu, wmoe_d);
    }
    GRID_BAR();
    if (PHON(12)) { Frame P = F; P.tid = opq(F.tid); P.lane = P.tid & 63;
    { pg8::Gemm g{hn, wdi, T, PROJW, D}; pg8::StaticOrder S; S.init(T, PROJW, P.G, (int)blockIdx.x); pg8::EpiBf16 E{proj, PROJW};
      pg8::gemm_phase<pg8::EpiBf16, pg8::StaticOrder>(P.lds, g, S, E); }
    }
    GRID_BAR();
    if (PHON(13)) { Frame P = F; P.tid = opq(F.tid); P.lane = P.tid & 63;
    att::attn_phase(P, proj, buf1, buf2);
    }
    GRID_BAR();
    if (PHON(14)) { Frame P = F; P.tid = opq(F.tid); P.lane = P.tid & 63;
    phase_subln(P, buf1, buf2, lq1, lk1, lq2, lk2, diff_subln, hn);
    }
    GRID_BAR();
    if (PHON(15)) { Frame P = F; P.tid = opq(F.tid); P.lane = P.tid & 63;
    { pg8::Gemm g{hn, wdo, T, D, D}; pg8::StaticOrder S; S.init(T, D, P.G, (int)blockIdx.x); pg8::EpiResF32 E{xres, xres, D};
      pg8::gemm_phase<pg8::EpiResF32, pg8::StaticOrder>(P.lds, g, S, E); }
    }
    GRID_BAR();
    if (PHON(16)) { Frame P = F; P.tid = opq(F.tid); P.lane = P.tid & 63;
    phase_norm_route(P, xres, norm_ffn + D, wp_r1, hn, tok_e, tok_p, tok_w, ctl + CW_CNT1);
    }
    GRID_BAR();
    if (PHON(17)) { Frame P = F; P.tid = opq(F.tid); P.lane = P.tid & 63;
    moe_tables(P, ctl + CW_CNT1);
    phase_moe_gather(P, tok_e, tok_p, slot_of, hn, ag);
    }
    GRID_BAR();
    if (PHON(18)) { Frame P = F; P.tid = opq(F.tid); P.lane = P.tid & 63;
    { const int Mr = pst[33] * 256; pg8::Gemm g{ag, wmoe_gu, Mr, 1024, D}; pg8::MoeOrder S; S.init(Mr, 1024, P.G, (int)blockIdx.x); S.te = pst + 36; S.estride = (size_t)1024 * D * 2; pg8::EpiSiluMul E{hh};
      pg8::gemm_phase<pg8::EpiSiluMul, pg8::MoeOrder>(P.lds, g, S, E); }
    }
    GRID_BAR();
    if (PHON(19)) { Frame P = F; P.tid = opq(F.tid); P.lane = P.tid & 63;
    { const int Mr = pst[33] * 256; pg8::Gemm g{hh, wmoe_d, Mr, D, DFF}; pg8::MoeOrder S; S.init(Mr, D, P.G, (int)blockIdx.x); S.te = pst + 36; S.estride = (size_t)D * DFF * 2; pg8::EpiBf16 E{ob, D};
      pg8::gemm_phase<pg8::EpiBf16, pg8::MoeOrder>(P.lds, g, S, E); }
    }
    GRID_BAR();
    if (PHON(20)) { Frame P = F; P.tid = opq(F.tid); P.lane = P.tid & 63;
    phase_moe_combine<1>(P, xres, ob, slot_of, tok_w, final_norm, hn);
    }
}

#if DIAG
constexpr size_t WS_DIAG = WS_END;
constexpr int NSAVE = 64;
__device__ inline unsigned hsh(unsigned x) { x ^= x >> 16; x *= 0x7feb352dU; x ^= x >> 15; x *= 0x846ca68bU; x ^= x >> 16; return x; }
__device__ inline void rep(unsigned* w, double got, double ref, double scale) { double e = fabs(got - ref) / (fabs(ref) + scale); float ef = (float)e; if (!(ef == ef) || ef > 1e30f) ef = 1e30f; atomicMax(w, __float_as_uint(ef)); }
__device__ inline double bfd(bf16_t v) { return (double)bf2f(v); }
#define GTID (blockIdx.x * blockDim.x + threadIdx.x)
#define GSTR (gridDim.x * blockDim.x)

__global__ void ck_weights(const float* gla_w_in, const float* gla_w_out, const float* diff_w_in, const float* diff_w_out, const bf16_t* wgi, const bf16_t* wgo, const bf16_t* wdi, const bf16_t* wdo,
                           const float* norm_mix, const float* norm_ffn, const float* wgrp, const float* wexp, const float* wp_gz, const float* wp_r0, const float* wp_r1, unsigned* w) {
    for (unsigned i = GTID; i < 65536u; i += GSTR) { const unsigned r = hsh(i * 3u + 1u), r2 = hsh(i * 7u + 5u);
        const int n = r % 6144u, k = r2 % 2048u, n2 = n % 2048;
        rep(w, bfd(wgi[(size_t)n * D + k]), gla_w_in[(size_t)k * GLA_INW + n], 0.02); rep(w, bfd(wdi[(size_t)n * D + k]), diff_w_in[(size_t)k * PROJW + n], 0.02);
        rep(w, bfd(wgo[(size_t)n2 * D + k]), gla_w_out[(size_t)k * D + n2], 0.02); rep(w, bfd(wdo[(size_t)n2 * D + k]), diff_w_out[(size_t)k * D + n2], 0.02);
        const int s = r % 128u, ln = (r >> 7) % 64u, e4 = (r >> 13) & 3, kk = 16 * s + 4 * (ln >> 4) + e4, col = ln & 15, nt = (r >> 15) % 3u, col3 = 16 * nt + col;
        rep(w, wp_gz[(s * 64 + ln) * 4 + e4], (double)norm_mix[kk] * gla_w_in[(size_t)kk * GLA_INW + PROJW + col], 0.02);
        for (int L = 0; L < 2; ++L) { const float* gr = wgrp + (size_t)L * D * 4; const float* ex = wexp + (size_t)L * D * 32; const float* nf = norm_ffn + L * D;
            const double ref = col3 < 4 ? gr[kk * 4 + col3] : (col3 < 36 ? ex[kk * 32 + col3 - 4] : 0.0);
            rep(w, (L ? wp_r1 : wp_r0)[((s * 3 + nt) * 64 + ln) * 4 + e4], (double)nf[kk] * ref, 0.02); } }
}
__global__ void ck_moew(const float* wg, const float* wu, const float* wd, const bf16_t* GU, const bf16_t* DT, unsigned* w) {
    for (unsigned i = GTID; i < 65536u; i += GSTR) { const unsigned r = hsh(i * 5u + 2u), r2 = hsh(i * 11u + 3u);
        const int e = r % 32u, f = (r >> 5) % 512u, k = r2 % 2048u, n2 = (r2 >> 11) % 2048u, rowg = 256 * (f >> 7) + (f & 127);
        rep(w, bfd(GU[((size_t)e * 1024 + rowg) * D + k]), wg[((size_t)e * D + k) * DFF + f], 0.02); rep(w, bfd(GU[((size_t)e * 1024 + rowg + 128) * D + k]), wu[((size_t)e * D + k) * DFF + f], 0.02);
        rep(w, bfd(DT[((size_t)e * D + n2) * DFF + f]), wd[((size_t)e * DFF + f) * D + n2], 0.05); }
}
__global__ void ck_norm(const float* x, const float* gain, const bf16_t* hn, unsigned* w) {
    for (unsigned i = GTID; i < 4096u; i += GSTR) { const unsigned r = hsh(i * 13u + 7u); const int t = r % (unsigned)T, j = (r >> 15) % 2048u;
        double ss = 0; for (int k = 0; k < D; ++k) { const double v = x[(size_t)t * D + k]; ss += v * v; }
        const double rstd = 1.0 / sqrt(ss / D + 1e-6); rep(w, bfd(hn[(size_t)t * D + j]), x[(size_t)t * D + j] * rstd * gain[j], 1.0); }
}
__global__ void ck_gz(const float* x, const float* gain, const float* gla_w_in, const float* gz, unsigned* w) {
    for (unsigned i = GTID; i < 4096u; i += GSTR) { const unsigned r = hsh(i * 17u + 9u); const int t = r % (unsigned)T, c = (r >> 15) % 16u;
        double ss = 0, dot = 0; for (int k = 0; k < D; ++k) { const double v = x[(size_t)t * D + k]; ss += v * v; dot += v * gain[k] * gla_w_in[(size_t)k * GLA_INW + PROJW + c]; }
        rep(w, gz[(size_t)t * 16 + c], dot / sqrt(ss / D + 1e-6), 1.0); }
}
__global__ void ck_gemm(const bf16_t* A, const bf16_t* Bt, const bf16_t* C, int M, int N, int K, int ldc, double scale, unsigned* w) {
    for (unsigned i = GTID; i < 16384u; i += GSTR) { const unsigned r = hsh(i * 19u + 11u), r2 = hsh(i * 23u + 1u); const int m = r % (unsigned)M, n = r2 % (unsigned)N;
        double s = 0; for (int k = 0; k < K; ++k) s += bfd(A[(size_t)m * K + k]) * bfd(Bt[(size_t)n * K + k]);
        rep(w, bfd(C[(size_t)m * ldc + n]), s, scale); }
}
__device__ inline int srow(int i) { return (int)(hsh(i * 29u + 13u) % (unsigned)T); }
__global__ void ck_save(const float* x, float* save) { for (unsigned i = GTID; i < (unsigned)NSAVE * D; i += GSTR) save[i] = x[(size_t)srow(i / D) * D + (i % D)]; }
__global__ void ck_gemm_res(const bf16_t* A, const bf16_t* Bt, const float* base, int saved, const float* out, unsigned* w) {
    for (unsigned i = GTID; i < (unsigned)NSAVE * 64u; i += GSTR) { const int si = i / 64, t = srow(si), n = hsh(i * 31u + 5u) % 2048u;
        double s = 0; for (int k = 0; k < D; ++k) s += bfd(A[(size_t)t * D + k]) * bfd(Bt[(size_t)n * D + k]);
        const double b = saved ? base[(size_t)si * D + n] : base[(size_t)t * D + n];
        rep(w, out[(size_t)t * D + n], b + s, 1.0); }
}
__global__ void ck_gate(const float* gz, const float* wgu, const float* bg, const bf16_t* proj, const bf16_t* kdT, const float* adec, unsigned* w) {
    for (unsigned i = GTID; i < 4096u; i += GSTR) { const unsigned r = hsh(i * 37u + 3u); const int bc = r % 512u, j = (r >> 9) % 1024u, tq = (r >> 19) % 64u;
        double run = 0, ct = 0;
        for (int t = 0; t < 64; ++t) { double z = bg[j]; for (int q = 0; q < 16; ++q) z += (double)gz[((size_t)bc * 64 + t) * 16 + q] * wgu[q * 1024 + j];
            const double ls = fmin(z, 0.0) - log1p(exp(-fabs(z))); run += ls / 16.0; if (t == tq) ct = run; }
        rep(w, adec[(size_t)bc * 1024 + j], exp(run), 1.0);
        rep(w, bfd(kdT[((size_t)bc * 1024 + j) * 64 + tq]), bfd(proj[((size_t)bc * 64 + tq) * PROJW + 1024 + j]) * exp(run - ct), 1.0); }
}
__global__ void ck_scan(const bf16_t* proj, const bf16_t* kdT, const float* adec, const bf16_t* o, unsigned* w) {
    const int wv = GTID / 64, lane = threadIdx.x & 63, nw = GSTR / 64;
    const int cl[8] = {0, 1, 3, 17, 100, 255, 2, 64};
    for (int s = wv; s < 96; s += nw) { const unsigned r = hsh(s * 41u + 17u); const int b = r & 1, c = cl[s % 8], tl = (r >> 1) % 64u, h = (r >> 7) % 4u, vc = (r >> 9) % 512u;
        float S[4] = {0.f, 0.f, 0.f, 0.f};
        for (int cc = 0; cc <= c; ++cc) { const size_t bc = (size_t)b * NCH + cc;
            for (int q = 0; q < 4; ++q) { const int kr = h * 256 + lane * 4 + q; float a = 0.f;
                for (int t = 0; t < 64; ++t) a += bf2f(kdT[(bc * 1024 + kr) * 64 + t]) * bf2f(proj[((size_t)b * SEQ + cc * 64 + t) * PROJW + 2048 + h * 512 + vc]);
                S[q] = adec[bc * 1024 + kr] * S[q] + a; } }
        float part = 0.f; const size_t tok = (size_t)b * SEQ + c * 64 + tl;
        for (int q = 0; q < 4; ++q) part += bf2f(proj[tok * PROJW + h * 256 + lane * 4 + q]) * S[q];
        for (int of = 1; of < 64; of <<= 1) part += __shfl_xor(part, of);
        if (lane == 0) rep(w, bfd(o[tok * D + h * 512 + vc]), part / 16.0, 2.0); }
}
__global__ void ck_gnorm(const bf16_t* o, const bf16_t* proj, const float* gn, const bf16_t* y, unsigned* w) {
    for (unsigned i = GTID; i < 8192u; i += GSTR) { const unsigned r = hsh(i * 43u + 19u); const int t = r % (unsigned)T, h = (r >> 15) % 4u, j = (r >> 17) % 512u;
        double ss = 0; for (int k = 0; k < 512; ++k) { const double v = bfd(o[(size_t)t * D + h * 512 + k]); ss += v * v; }
        const double rr = bfd(proj[(size_t)t * PROJW + 4096 + h * 512 + j]);
        rep(w, bfd(y[(size_t)t * D + h * 512 + j]), bfd(o[(size_t)t * D + h * 512 + j]) / sqrt(ss / 512 + 1e-6) * gn[j] * rr / (1.0 + exp(-rr)), 1.0); }
}
__global__ void ck_route(const float* x, const float* gain, const float* wgrp, const float* wexp, const int* tok_e, const int* tok_p, const float* tok_w, const unsigned* cnt, unsigned* w) {
    for (unsigned i = GTID; i < 512u; i += GSTR) { const int t = hsh(i * 47u + 23u) % (unsigned)T;
        double ss = 0; for (int k = 0; k < D; ++k) { const double v = x[(size_t)t * D + k]; ss += v * v; }
        const double rstd = 1.0 / sqrt(ss / D + 1e-6);
        double gl[4] = {0, 0, 0, 0};
        for (int k = 0; k < D; ++k) { const double v = x[(size_t)t * D + k] * rstd * gain[k]; for (int q = 0; q < 4; ++q) gl[q] += v * wgrp[k * 4 + q]; }
        int gi = 0; for (int q = 1; q < 4; ++q) if (gl[q] > gl[gi]) gi = q;
        double gs = 0; for (int q = 0; q < 4; ++q) gs += exp(gl[q] - gl[gi]);
        double el[8] = {0, 0, 0, 0, 0, 0, 0, 0};
        for (int k = 0; k < D; ++k) { const double v = x[(size_t)t * D + k] * rstd * gain[k]; for (int q = 0; q < 8; ++q) el[q] += v * wexp[k * 32 + gi * 8 + q]; }
        int i1 = 0; for (int q = 1; q < 8; ++q) if (el[q] > el[i1]) i1 = q;
        int i2 = (i1 == 0) ? 1 : 0; for (int q = 0; q < 8; ++q) if (q != i1 && el[q] > el[i2]) i2 = q;
        const double eb = exp(el[i2] - el[i1]);
        const int e1 = tok_e[2 * t], e2 = tok_e[2 * t + 1];
        double third = -1e30; for (int q = 0; q < 8; ++q) if (q != i1 && q != i2 && el[q] > third) third = el[q];
        const bool tie = (el[i2] - third) < 1e-4 || (el[i1] - el[i2]) < 1e-4;
        if (!tie) { rep(w, e1, gi * 8 + i1, 1.0); rep(w, e2, gi * 8 + i2, 1.0);
            rep(w, tok_w[2 * t], 1.0 / gs / (1.0 + eb), 0.3); rep(w, tok_w[2 * t + 1], eb / gs / (1.0 + eb), 0.3); }
        if ((unsigned)tok_p[2 * t] >= cnt[64 * (e1 & 31)] || (unsigned)tok_p[2 * t + 1] >= cnt[64 * (e2 & 31)]) rep(w, 9.0, 0.0, 1.0); }
}
__global__ void ck_gather(const int* tok_e, const int* tok_p, const int* slot_of, const unsigned* cnt, const bf16_t* hn, const bf16_t* ag, unsigned* w) {
    for (unsigned i = GTID; i < 8192u; i += GSTR) { const unsigned r = hsh(i * 53u + 29u); const int a = r % (2u * T), k = (r >> 16) % 2048u, e = tok_e[a] & 31;
        int ps = 0; for (int q = 0; q < e; ++q) ps += ((int)cnt[64 * q] + 255) & ~255;
        const int slot = slot_of[a];
        rep(w, slot, ps + tok_p[a], 1.0);
        if (slot >= 0 && slot < MAX_TILES * 256) rep(w, bfd(ag[(size_t)slot * D + k]), bfd(hn[(size_t)(a >> 1) * D + k]), 1.0); }
}
__global__ void ck_moe1(const int* tok_e, const int* slot_of, const bf16_t* ag, const float* wg, const float* wu, const bf16_t* hh, unsigned* w) {
    for (unsigned i = GTID; i < 8192u; i += GSTR) { const unsigned r = hsh(i * 59u + 31u); const int a = r % (2u * T), f = (r >> 16) % 512u, e = tok_e[a] & 31, slot = slot_of[a];
        if (slot < 0 || slot >= MAX_TILES * 256) { rep(w, 9.0, 0.0, 1.0); continue; }
        double g = 0, u = 0; for (int k = 0; k < D; ++k) { const double v = bfd(ag[(size_t)slot * D + k]); g += v * wg[((size_t)e * D + k) * DFF + f]; u += v * wu[((size_t)e * D + k) * DFF + f]; }
        rep(w, bfd(hh[(size_t)slot * DFF + f]), g / (1.0 + exp(-g)) * u, 0.5); }
}
__global__ void ck_moe2(const int* tok_e, const int* slot_of, const bf16_t* hh, const float* wd, const bf16_t* ob, unsigned* w) {
    for (unsigned i = GTID; i < 8192u; i += GSTR) { const unsigned r = hsh(i * 61u + 37u); const int a = r % (2u * T), n = (r >> 16) % 2048u, e = tok_e[a] & 31, slot = slot_of[a];
        if (slot < 0 || slot >= MAX_TILES * 256) { rep(w, 9.0, 0.0, 1.0); continue; }
        double s = 0; for (int f = 0; f < DFF; ++f) s += bfd(hh[(size_t)slot * DFF + f]) * wd[((size_t)e * DFF + f) * D + n];
        rep(w, bfd(ob[(size_t)slot * D + n]), s, 0.3); }
}
__global__ void ck_combine(const float* save, const bf16_t* ob, const int* slot_of, const float* tok_w, const float* gain, const float* x, const bf16_t* hn, int mode, unsigned* w) {
    for (unsigned i = GTID; i < (unsigned)NSAVE * 32u; i += GSTR) { const int si = i / 32, t = srow(si), j = hsh(i * 67u + 41u) % 2048u;
        const int s0 = slot_of[2 * t], s1 = slot_of[2 * t + 1]; const double w0 = tok_w[2 * t], w1 = tok_w[2 * t + 1];
        double ss = 0, xj = 0; for (int k = 0; k < D; ++k) { const double v = save[(size_t)si * D + k] + w0 * bfd(ob[(size_t)s0 * D + k]) + w1 * bfd(ob[(size_t)s1 * D + k]); ss += v * v; if (k == j) xj = v; }
        const double y = xj / sqrt(ss / D + 1e-6) * gain[j];
        if (mode == 0) { rep(w, x[(size_t)t * D + j], xj, 1.0); rep(w, bfd(hn[(size_t)t * D + j]), y, 1.0); } else rep(w, x[(size_t)t * D + j], y, 1.0); }
}
__global__ void ck_attn(const bf16_t* proj, const bf16_t* o1, const bf16_t* o2, unsigned* w) {
    const int wv = GTID / 64, lane = threadIdx.x & 63, nw = GSTR / 64;
    const int tl[12] = {0, 1, 63, 64, 100, 255, 256, 1000, 4095, 8191, 16320, 16383};
    for (int s = wv; s < 96; s += nw) { const unsigned r = hsh(s * 71u + 43u); const int b = r & 1, h = (r >> 1) % 8u, sub = (r >> 4) & 1, t = tl[s % 12], dv0 = (r >> 5) % 253u;
        const double slope = exp2(-(double)(h + 1)); const int kend = 64 * (t / 64 + 1);
        const bf16_t* qp = proj + ((size_t)b * SEQ + t) * PROJW + h * 256 + sub * 128;
        double mx = -1e300;
        for (int j = lane; j < kend; j += 64) { const bf16_t* kp = proj + ((size_t)b * SEQ + j) * PROJW + 2048 + h * 256 + sub * 128; double d = 0; for (int q = 0; q < 128; ++q) d += bfd(qp[q]) * bfd(kp[q]);
            const double sc = d * 0.08838834764831845 - slope * fabs((double)(t - j)); if (sc > mx) mx = sc; }
        for (int of = 1; of < 64; of <<= 1) { const double o_ = __shfl_xor(mx, of); if (o_ > mx) mx = o_; }
        double l = 0, acc[4] = {0, 0, 0, 0};
        for (int j = lane; j < kend; j += 64) { const bf16_t* kp = proj + ((size_t)b * SEQ + j) * PROJW + 2048 + h * 256 + sub * 128; double d = 0; for (int q = 0; q < 128; ++q) d += bfd(qp[q]) * bfd(kp[q]);
            const double p = exp(d * 0.08838834764831845 - slope * fabs((double)(t - j)) - mx); l += p;
            const bf16_t* vp = proj + ((size_t)b * SEQ + j) * PROJW + 4096 + h * 256 + dv0; for (int q = 0; q < 4; ++q) acc[q] += p * bfd(vp[q]); }
        for (int of = 1; of < 64; of <<= 1) { l += __shfl_xor(l, of); for (int q = 0; q < 4; ++q) acc[q] += __shfl_xor(acc[q], of); }
        if (lane == 0) for (int q = 0; q < 4; ++q) rep(w, bfd((sub ? o2 : o1)[((size_t)b * SEQ + t) * D + h * 256 + dv0 + q]), acc[q] / l, 0.2); }
}
__global__ void ck_subln(const bf16_t* o1, const bf16_t* o2, const float* lq1, const float* lk1, const float* lq2, const float* lk2, const float* sg, const bf16_t* y, unsigned* w) {
    double d1 = 0, d2 = 0; for (int k = 0; k < 128; ++k) { d1 += (double)lq1[k] * lk1[k]; d2 += (double)lq2[k] * lk2[k]; }
    const double li = 0.8 - 0.6 * exp(-0.3), lam = exp(d1) - exp(d2) + li;
    for (unsigned i = GTID; i < 8192u; i += GSTR) { const unsigned r = hsh(i * 73u + 47u); const int t = r % (unsigned)T, h = (r >> 15) % 8u, j = (r >> 18) % 256u;
        double ss = 0, dj = 0; for (int k = 0; k < 256; ++k) { const double v = bfd(o1[(size_t)t * D + h * 256 + k]) - lam * bfd(o2[(size_t)t * D + h * 256 + k]); ss += v * v; if (k == j) dj = v; }
        rep(w, bfd(y[(size_t)t * D + h * 256 + j]), dj / sqrt(ss / 256 + 1e-6) * sg[j] * (1.0 - li), 1.0); }
}
__global__ void ck_final(const unsigned* words, int nst, float* out, int n) {
    int val = 0;
    for (int s = 0; s < nst; ++s) { const float e = __uint_as_float(words[s]); if (e >= 0.03125f) { val = 4 * s + (e < 0.25f ? 1 : (e < 4.f ? 2 : 3)); break; } }
    const float c = sqrtf(0.1f * (float)val);
    for (int i = GTID; i < n; i += GSTR) out[i] = c;
}
#endif

extern "C" void kernel_launch(void* const* d_in, const int* in_sizes, int n_in, void* d_out, int out_size, void* d_ws, size_t ws_size, hipStream_t stream) {
    static int grid = 0;
    if (grid == 0) {
        if (n_in != 21 || out_size != T * D || ws_size < WS_END + 2 * MiB) { fprintf(stderr, "kernel_launch: unexpected shapes (n_in %d out %d ws %zu)\n", n_in, out_size, ws_size); grid = -1; return; }
        if (hipFuncSetAttribute((const void*)hybrid_fwd, hipFuncAttributeMaxDynamicSharedMemorySize, LDS_BYTES) != hipSuccess) { fprintf(stderr, "kernel_launch: hipFuncSetAttribute failed\n"); grid = -1; return; }
        int dev = 0, cus = 0, per_cu = 0;
        (void)hipGetDevice(&dev); (void)hipDeviceGetAttribute(&cus, hipDeviceAttributeMultiprocessorCount, dev);
        if (hipOccupancyMaxActiveBlocksPerMultiprocessor(&per_cu, (const void*)hybrid_fwd, NWAVES * 64, LDS_BYTES) != hipSuccess || per_cu < 1) fprintf(stderr, "kernel_launch: occupancy query says %d\n", per_cu);
        (void)hipGetLastError();
        grid = cus > 0 ? cus : 256;
    }
    if (grid < 0) return;
    Args a{};
    for (int i = 0; i < 21; ++i) a.in[i] = (const float*)d_in[i];
    a.out = (float*)d_out; a.ws = (unsigned char*)d_ws; a.upto = 99; a.pad1 = 0;
#if !DIAG
    (void)hipMemsetAsync((char*)d_ws + WS_CTL, 0, CTL_ZERO_BYTES, stream);
    hipLaunchKernelGGL(hybrid_fwd, dim3(grid), dim3(NWAVES * 64), LDS_BYTES, stream, a);
#else
    {
        unsigned char* ws = (unsigned char*)d_ws; const float* const* in = a.in;
        unsigned* words = (unsigned*)(ws + WS_DIAG); float* save = (float*)(ws + WS_DIAG + 65536);
        (void)hipMemsetAsync(words, 0, 65536, stream);
        float* gz = (float*)(ws + WS_GZ); int* tok_e = (int*)(ws + WS_TOKE); int* tok_p = (int*)(ws + WS_TOKP); float* tok_w = (float*)(ws + WS_TOKW); int* slot_of = (int*)(ws + WS_SLOT);
        float* adec = (float*)(ws + WS_ADEC); float* wp_gz = (float*)(ws + WS_WPGZ); float* wp_r0 = (float*)(ws + WS_WPR0); float* wp_r1 = (float*)(ws + WS_WPR1);
        bf16_t* wgi = (bf16_t*)(ws + WS_WGI); bf16_t* wgo = (bf16_t*)(ws + WS_WGO); bf16_t* wdi = (bf16_t*)(ws + WS_WDI); bf16_t* wdo = (bf16_t*)(ws + WS_WDO);
        bf16_t* gu = (bf16_t*)(ws + WS_WMOE); bf16_t* dt = (bf16_t*)(ws + WS_WMOE_D);
        bf16_t* hn = (bf16_t*)(ws + WS_HN); bf16_t* proj = (bf16_t*)(ws + WS_PROJ); bf16_t* buf1 = (bf16_t*)(ws + WS_BUF1); bf16_t* buf2 = (bf16_t*)(ws + WS_BUF2);
        bf16_t* ag = (bf16_t*)(ws + WS_AG); bf16_t* ob = (bf16_t*)(ws + WS_OB); bf16_t* hh = (bf16_t*)(ws + WS_H);
        unsigned* ctl = (unsigned*)(ws + WS_CTL); float* xres = (float*)d_out;
        const size_t L1W = (size_t)NEXP * D * DFF;
        for (int st = 0; st <= 20; ++st) {
            (void)hipMemsetAsync((char*)d_ws + WS_CTL, 0, CTL_ZERO_BYTES, stream);
            a.upto = st;
            hipLaunchKernelGGL(hybrid_fwd, dim3(grid), dim3(NWAVES * 64), LDS_BYTES, stream, a);
            unsigned* w = words + st;
            switch (st) {
            case 0: ck_weights<<<256, 256, 0, stream>>>(in[3], in[7], in[8], in[14], wgi, wgo, wdi, wdo, in[1], in[2], in[15], in[16], wp_gz, wp_r0, wp_r1, w);
                    ck_moew<<<256, 256, 0, stream>>>(in[17], in[18], in[19], gu, dt, w); break;
            case 1: ck_norm<<<64, 64, 0, stream>>>(in[0], in[1], hn, w); ck_gz<<<64, 64, 0, stream>>>(in[0], in[1], in[3], gz, w); break;
            case 2: ck_gemm<<<256, 64, 0, stream>>>(hn, wgi, proj, T, PROJW, D, PROJW, 1.0, w); break;
            case 3: ck_gate<<<64, 64, 0, stream>>>(gz, in[4], in[5], proj, buf1, adec, w); break;
            case 4: ck_scan<<<96, 64, 0, stream>>>(proj, buf1, adec, buf2, w); break;
            case 5: ck_gnorm<<<128, 64, 0, stream>>>(buf2, proj, in[6], hn, w); break;
            case 6: ck_gemm_res<<<64, 64, 0, stream>>>(hn, wgo, in[0], 0, xres, w); break;
            case 7: ck_norm<<<64, 64, 0, stream>>>(xres, in[2], hn, w); ck_route<<<8, 64, 0, stream>>>(xres, in[2], in[15], in[16], tok_e, tok_p, tok_w, ctl + CW_CNT0, w); break;
            case 8: ck_gather<<<128, 64, 0, stream>>>(tok_e, tok_p, slot_of, ctl + CW_CNT0, hn, ag, w); break;
            case 9: ck_moe1<<<128, 64, 0, stream>>>(tok_e, slot_of, ag, in[17], in[18], hh, w); break;
            case 10: ck_moe2<<<128, 64, 0, stream>>>(tok_e, slot_of, hh, in[19], ob, w); ck_save<<<64, 256, 0, stream>>>(xres, save); break;
            case 11: ck_combine<<<32, 64, 0, stream>>>(save, ob, slot_of, tok_w, in[1] + D, xres, hn, 0, w); ck_moew<<<256, 256, 0, stream>>>(in[17] + L1W, in[18] + L1W, in[19] + L1W, gu, dt, w); break;
            case 12: ck_gemm<<<256, 64, 0, stream>>>(hn, wdi, proj, T, PROJW, D, PROJW, 1.0, w); break;
            case 13: ck_attn<<<96, 64, 0, stream>>>(proj, buf1, buf2, w); break;
            case 14: ck_subln<<<128, 64, 0, stream>>>(buf1, buf2, in[9], in[10], in[11], in[12], in[13], hn, w); ck_save<<<64, 256, 0, stream>>>(xres, save); break;
            case 15: ck_gemm_res<<<64, 64, 0, stream>>>(hn, wdo, save, 1, xres, w); break;
            case 16: ck_norm<<<64, 64, 0, stream>>>(xres, in[2] + D, hn, w); ck_route<<<8, 64, 0, stream>>>(xres, in[2] + D, in[15] + (size_t)D * 4, in[16] + (size_t)D * 32, tok_e, tok_p, tok_w, ctl + CW_CNT1, w); break;
            case 17: ck_gather<<<128, 64, 0, stream>>>(tok_e, tok_p, slot_of, ctl + CW_CNT1, hn, ag, w); break;
            case 18: ck_moe1<<<128, 64, 0, stream>>>(tok_e, slot_of, ag, in[17] + L1W, in[18] + L1W, hh, w); break;
            case 19: ck_moe2<<<128, 64, 0, stream>>>(tok_e, slot_of, hh, in[19] + L1W, ob, w); ck_save<<<64, 256, 0, stream>>>(xres, save); break;
            case 20: ck_combine<<<32, 64, 0, stream>>>(save, ob, slot_of, tok_w, in[20], xres, hn, 1, w); break;
            }
        }
        ck_final<<<1024, 256, 0, stream>>>(words, 21, (float*)d_out, out_size);
    }
#endif
}
```

```cpp
#ifndef DIAG
#define DIAG 0
#endif
#ifndef REP_PHASE
#define REP_PHASE -1
#endif
#include <hip/hip_runtime.h>
#include <cstdio>
#include <cstdint>

#define LAS __attribute__((address_space(3)))
#define GAS __attribute__((address_space(1)))
typedef unsigned short bf16_t;
typedef short bf16x8 __attribute__((ext_vector_type(8)));
typedef short s16x4 __attribute__((ext_vector_type(4)));
typedef float f32x4 __attribute__((ext_vector_type(4)));
typedef float f32x2 __attribute__((ext_vector_type(2)));
typedef float f32x16 __attribute__((ext_vector_type(16)));
typedef unsigned u32x4 __attribute__((ext_vector_type(4)));
typedef unsigned u32x2 __attribute__((ext_vector_type(2)));

constexpr int D = 2048, SEQ = 16384, NBATCH = 2, T = NBATCH * SEQ, CHUNK = 64, NCH = SEQ / CHUNK;
constexpr int GLA_H = 4, GLA_DK = 256, GLA_DV = 512, GLA_DKT = 1024, GLA_INW = 6160, PROJW = 6144;
constexpr int DIFF_H = 8;
constexpr int NEXP = 32, DFF = 512;
constexpr float RMS_EPS = 1e-6f;
constexpr float LAMBDA_INIT = 0.35550906759f;
constexpr int MAX_TILES = 288;

constexpr size_t MiB = 1u << 20;
constexpr size_t WS_CTL = 0, CTL_ZERO_BYTES = 1 * MiB;
constexpr size_t WS_GZ = 2 * MiB;
constexpr size_t WS_TOKE = 4 * MiB;
constexpr size_t WS_TOKP = WS_TOKE + 256 * 1024;
constexpr size_t WS_TOKW = WS_TOKP + 256 * 1024;
constexpr size_t WS_SLOT = WS_TOKW + 256 * 1024;
constexpr size_t WS_ADEC = 8 * MiB;
constexpr size_t WS_WPGZ = 10 * MiB;
constexpr size_t WS_WPR0 = 10 * MiB + 256 * 1024;
constexpr size_t WS_WPR1 = 11 * MiB;
constexpr size_t WS_WGI = 16 * MiB, WS_WGO = 40 * MiB, WS_WDI = 48 * MiB, WS_WDO = 72 * MiB;
constexpr size_t WS_WMOE = 80 * MiB;
constexpr size_t WS_WMOE_D = WS_WMOE + 128 * MiB;
constexpr size_t WS_HN = 272 * MiB;
constexpr size_t WS_PROJ = 400 * MiB;
constexpr size_t WS_BUF1 = 784 * MiB;
constexpr size_t WS_BUF2 = 912 * MiB;
constexpr size_t WS_AG = 400 * MiB;
constexpr size_t WS_OB = 688 * MiB;
constexpr size_t WS_H = 976 * MiB;
constexpr size_t WS_END = 1048 * MiB;
constexpr int CW_BAR = 4096;
constexpr int CW_CNT0 = 16384, CW_CNT1 = 16384 + 32 * 64;


constexpr size_t GK0 = (size_t)T * 1024, GV0 = (size_t)T * 2048, GR0 = (size_t)T * 4096;
constexpr size_t DK0 = (size_t)T * 2048, DV0 = (size_t)T * 4096;
__host__ __device__ __forceinline__ size_t gq_off(int b, int t, int h) { return ((size_t)(b * 4 + h) * SEQ + t) * 256; }
__host__ __device__ __forceinline__ size_t gv_off(int b, int t, int h) { return GV0 + ((size_t)(b * 4 + h) * SEQ + t) * 512; }
__host__ __device__ __forceinline__ size_t dq_off(int b, int t, int h, int sub) { return ((size_t)((b * 8 + h) * 2 + sub) * SEQ + t) * 128; }
__host__ __device__ __forceinline__ size_t dv_off(int b, int t, int h) { return DV0 + ((size_t)(b * 8 + h) * SEQ + t) * 256; }

constexpr int RING_BYTES = 131072;
constexpr int LDSCTL_OFF = RING_BYTES;
constexpr int MISC_OFF = LDSCTL_OFF + 320;
constexpr int TAB_OFF = LDSCTL_OFF + 1024;
constexpr int LDS_BYTES = 147456;
constexpr int NWAVES = 8;

typedef __bf16 bf16x2_t __attribute__((ext_vector_type(2)));
__device__ __forceinline__ unsigned cvt_pk_bf16(float lo, float hi) { const f32x2 v = {lo, hi}; return __builtin_bit_cast(unsigned, __builtin_convertvector(v, bf16x2_t)); }
__device__ __forceinline__ float bf_lo(unsigned w) { return __uint_as_float(w << 16); }
__device__ __forceinline__ float bf_hi(unsigned w) { return __uint_as_float(w & 0xffff0000u); }
__device__ __forceinline__ float bf2f(bf16_t b) { return __uint_as_float(((unsigned)b) << 16); }
__device__ __forceinline__ float wave_sum(float v) {
#pragma unroll
    for (int o = 1; o < 64; o <<= 1) v += __shfl_xor(v, o);
    return v;
}
__device__ __forceinline__ int opq(int v) { asm volatile("" : "+v"(v)); return v; }
#define LDS_WAIT() asm volatile("s_waitcnt lgkmcnt(0)" ::: "memory")
#define VM_WAIT() asm volatile("s_waitcnt vmcnt(0)" ::: "memory")
#define WG_BAR() do { asm volatile("s_waitcnt lgkmcnt(0)" ::: "memory"); __builtin_amdgcn_s_barrier(); asm volatile("" ::: "memory"); } while (0)

namespace pg8 {
constexpr int BM = 256, BK = 64, HALF = 128, HTB = HALF * BK * 2, STAGE_BYTES = 8 * HTB, NXCD = 8, WGM = 8;
__host__ __device__ __forceinline__ int lds_byte(int r, int c) { const int st = (r >> 4) * 2 + (c >> 5), rr = r & 15, cc = c & 31, ob = rr * 64 + cc * 2; return st * 1024 + (ob ^ (((ob >> 9) & 1) << 5)); }
__host__ __device__ __forceinline__ void stage_rc(int b, int& R, int& C) { const int st = b / 1024, sb = b % 1024, swz = sb ^ (((sb >> 9) & 1) << 5); R = (st >> 1) * 16 + swz / 64; C = (st & 1) * 32 + (swz % 64) / 2; }
__host__ __device__ __forceinline__ int perm32(int rho) { const int n = rho >> 4, i = rho & 15; return 8 * (i >> 2) + 4 * n + (i & 3); }

struct Unit { int pm, pn; };
struct Gemm { const bf16_t* A; const bf16_t* Bt; int M, N, K; };

struct StaticOrder {
    int nM, nN, nwg, G, c;
    __device__ void init(int M, int N, int G_, int c_) { nM = M / BM; nN = N / BM; nwg = nM * nN; G = G_; c = c_; }
    __device__ bool next(int i, Unit& u) const {
        const long L = (long)i * G + c; if (L >= nwg) return false;
        int wgid = (int)L; { const int q = nwg / NXCD, r = nwg % NXCD, xcd = wgid % NXCD, off = wgid / NXCD; wgid = (xcd < r ? xcd * (q + 1) : r * (q + 1) + (xcd - r) * q) + off; }
        const int nig = WGM * nN, gid = wgid / nig, fm = gid * WGM, gsz = (nM - fm) < WGM ? (nM - fm) : WGM;
        u.pm = fm + ((wgid % nig) % gsz); u.pn = (wgid % nig) / gsz; return true;
    }
    __device__ __forceinline__ size_t bofs(const Unit&) const { return 0; }
};
struct MoeOrder : StaticOrder {
    const LAS int* te; size_t estride;
    __device__ __forceinline__ size_t bofs(const Unit& u) const { return (size_t)te[u.pm] * estride; }
};

struct EpiBf16 {
    static constexpr bool PERM = true;
    bf16_t* O; int ldc;
    __device__ __forceinline__ void operator()(const f32x4 (&acc)[2][2][4][2], const Unit& u, int wr, int wc, int fr, int fq) const {
        const int row0 = u.pm * BM + wr * 64 + fr, col0 = u.pn * BM + wc * 32 + 8 * fq;
#pragma unroll
        for (int ai = 0; ai < 2; ++ai)
#pragma unroll
            for (int m = 0; m < 4; ++m) { bf16_t* rowp = O + (size_t)(row0 + ai * HALF + m * 16) * ldc + col0;
#pragma unroll
                for (int bj = 0; bj < 2; ++bj) { const f32x4 v0 = acc[ai][bj][m][0], v1 = acc[ai][bj][m][1];
                    u32x4 w; w.x = cvt_pk_bf16(v0[0], v0[1]); w.y = cvt_pk_bf16(v0[2], v0[3]); w.z = cvt_pk_bf16(v1[0], v1[1]); w.w = cvt_pk_bf16(v1[2], v1[3]);
                    *(u32x4*)(rowp + bj * HALF) = w; } }
    }
};
template <int LAYER> struct EpiHeads {
    static constexpr bool PERM = true;
    bf16_t* O;
    __device__ __forceinline__ void operator()(const f32x4 (&acc)[2][2][4][2], const Unit& u, int wr, int wc, int fr, int fq) const {
        const int pn = u.pn, lc = wc * 32 + 8 * fq;
#pragma unroll
        for (int ai = 0; ai < 2; ++ai)
#pragma unroll
            for (int m = 0; m < 4; ++m) { const int row = u.pm * BM + ai * HALF + wr * 64 + m * 16 + fr, b = row >> 14, t = row & (SEQ - 1);
#pragma unroll
                for (int bj = 0; bj < 2; ++bj) { size_t off;
                    if (LAYER == 0) { if (pn < 4) off = gq_off(b, t, pn) + bj * 128 + lc; else if (pn < 8) off = GK0 + gq_off(b, t, pn - 4) + bj * 128 + lc;
                                      else if (pn < 16) off = gv_off(b, t, (pn - 8) >> 1) + ((pn - 8) & 1) * 256 + bj * 128 + lc; else off = GR0 + (size_t)row * 2048 + (pn - 16) * 256 + bj * 128 + lc; }
                    else { if (pn < 8) off = dq_off(b, t, pn, bj) + lc; else if (pn < 16) off = DK0 + dq_off(b, t, pn - 8, bj) + lc; else off = dv_off(b, t, pn - 16) + bj * 128 + lc; }
                    const f32x4 v0 = acc[ai][bj][m][0], v1 = acc[ai][bj][m][1];
                    u32x4 w; w.x = cvt_pk_bf16(v0[0], v0[1]); w.y = cvt_pk_bf16(v0[2], v0[3]); w.z = cvt_pk_bf16(v1[0], v1[1]); w.w = cvt_pk_bf16(v1[2], v1[3]);
                    *(u32x4*)(O + off) = w; } }
    }
};
struct EpiResF32 {
    static constexpr bool PERM = false;
    const float* base; float* C; int ldc;
    __device__ __forceinline__ void operator()(const f32x4 (&acc)[2][2][4][2], const Unit& u, int wr, int wc, int fr, int fq) const {
        const int row0 = u.pm * BM + wr * 64 + fr, col0 = u.pn * BM + wc * 32 + 4 * fq;
#pragma unroll
        for (int ai = 0; ai < 2; ++ai)
#pragma unroll
            for (int m = 0; m < 4; ++m) { const size_t off = (size_t)(row0 + ai * HALF + m * 16) * ldc + col0;
#pragma unroll
                for (int bj = 0; bj < 2; ++bj)
#pragma unroll
                    for (int n = 0; n < 2; ++n) { const f32x4 bs = *(const f32x4*)(base + off + bj * HALF + n * 16); *(f32x4*)(C + off + bj * HALF + n * 16) = bs + acc[ai][bj][m][n]; }
                asm volatile("" ::: "memory"); }
    }
};
struct EpiSiluMul {
    static constexpr bool PERM = true;
    bf16_t* Hh;
    __device__ __forceinline__ void operator()(const f32x4 (&acc)[2][2][4][2], const Unit& u, int wr, int wc, int fr, int fq) const {
        const int row0 = u.pm * BM + wr * 64 + fr, col0 = u.pn * HALF + wc * 32 + 8 * fq;
#pragma unroll
        for (int ai = 0; ai < 2; ++ai)
#pragma unroll
            for (int m = 0; m < 4; ++m) { bf16_t* rowp = Hh + (size_t)(row0 + ai * HALF + m * 16) * DFF + col0;
                float hv[8];
#pragma unroll
                for (int n = 0; n < 2; ++n)
#pragma unroll
                    for (int j = 0; j < 4; ++j) { const float g = acc[ai][0][m][n][j], up = acc[ai][1][m][n][j];
                        const float sg = g * __builtin_amdgcn_rcpf(1.0f + __builtin_amdgcn_exp2f(-1.4426950408889634f * g)); hv[n * 4 + j] = sg * up; }
                u32x4 w; w.x = cvt_pk_bf16(hv[0], hv[1]); w.y = cvt_pk_bf16(hv[2], hv[3]); w.z = cvt_pk_bf16(hv[4], hv[5]); w.w = cvt_pk_bf16(hv[6], hv[7]);
                *(u32x4*)rowp = w; }
    }
};

template <class Epi, class Sched>
__device__ __forceinline__ void gemm_phase(LAS unsigned char* lds, const Gemm g, const Sched& S, const Epi& E) {
    const int tid = opq((int)threadIdx.x), wid = __builtin_amdgcn_readfirstlane(tid >> 6), lane = tid & 63, wr = wid >> 2, wc = wid & 3, fr = lane & 15, fq = lane >> 4;
    const int K = g.K, nt = K / BK;
    unsigned voffA[2], voffB[2];
#pragma unroll
    for (int i = 0; i < 2; ++i) { int R, C; stage_rc(tid * 16 + i * 8192, R, C); const int Rb = Epi::PERM ? ((R & ~31) + perm32(R & 31)) : R;
        voffA[i] = (unsigned)(R * K + C) * 2u; voffB[i] = (unsigned)(Rb * K + C) * 2u; }
    const size_t kstep = (size_t)(BK * 2);
    const size_t hstep = (size_t)HALF * K * 2;
    const size_t tstep = 2 * hstep;
    const unsigned ldsw = (unsigned)wid * 1024u;
    const int aoff = lds_byte(wr * 64 + fr, fq * 8), boff = lds_byte(wc * 32 + fr, fq * 8);
#define PG8_SA(b, h) (((b) * 2 + (h)) * HTB)
#define PG8_SB(b, h) ((4 + (b) * 2 + (h)) * HTB)
#define PG8_STAGE(bufoff, gbase, voff) do { _Pragma("unroll") for (int _i = 0; _i < 2; ++_i) \
        __builtin_amdgcn_global_load_lds((const unsigned*)((const char*)(gbase) + (voff)[_i]), (LAS unsigned*)(lds + (bufoff) + ldsw + _i * 8192), 16, 0, 0); } while (0)
#define PG8_LDA(dst, b, h) do { _Pragma("unroll") for (int m = 0; m < 4; ++m) _Pragma("unroll") for (int k = 0; k < 2; ++k) dst[m][k] = *(const LAS bf16x8*)(lds + PG8_SA(b, h) + aoff + m * 2048 + k * 1024); } while (0)
#define PG8_LDB(dst, b, h) do { _Pragma("unroll") for (int n = 0; n < 2; ++n) _Pragma("unroll") for (int k = 0; k < 2; ++k) dst[n][k] = *(const LAS bf16x8*)(lds + PG8_SB(b, h) + boff + n * 2048 + k * 1024); } while (0)
#define PG8_MMA(ai, bj, At, Bt) do { __builtin_amdgcn_s_setprio(1); _Pragma("unroll") for (int m = 0; m < 4; ++m) _Pragma("unroll") for (int n = 0; n < 2; ++n) _Pragma("unroll") for (int k = 0; k < 2; ++k) \
        acc[ai][bj][m][n] = __builtin_amdgcn_mfma_f32_16x16x32_bf16(Bt[n][k], At[m][k], acc[ai][bj][m][n], 0, 0, 0); __builtin_amdgcn_s_setprio(0); } while (0)
#define PG8_WAIT_V(n) asm volatile("s_waitcnt vmcnt(" #n ")" ::: "memory")
#define PG8_WAIT_L(n) asm volatile("s_waitcnt lgkmcnt(" #n ")" ::: "memory")
#define PG8_BAR __builtin_amdgcn_s_barrier()
#define PG8_SCHED __builtin_amdgcn_sched_barrier(0)
    Unit cur, nxt; int ui = 0;
    if (!S.next(0, cur)) return;
    f32x4 acc[2][2][4][2];
#pragma unroll
    for (int a = 0; a < 2; ++a)
#pragma unroll
        for (int b = 0; b < 2; ++b)
#pragma unroll
            for (int m = 0; m < 4; ++m)
#pragma unroll
                for (int n = 0; n < 2; ++n) acc[a][b][m][n] = (f32x4){0.f, 0.f, 0.f, 0.f};
    bf16x8 At[4][2], B0[2][2], B1[2][2];
    const char* cA = (const char*)g.A + (size_t)cur.pm * tstep; const char* cB = (const char*)g.Bt + S.bofs(cur) + (size_t)cur.pn * tstep;
    PG8_STAGE(PG8_SB(0, 0), cB, voffB); PG8_STAGE(PG8_SB(0, 1), cB + hstep, voffB); PG8_STAGE(PG8_SA(0, 0), cA, voffA); PG8_STAGE(PG8_SA(0, 1), cA + hstep, voffA);
    if (wr == 1) PG8_BAR;
    PG8_WAIT_V(2); PG8_BAR;
    PG8_STAGE(PG8_SB(1, 0), cB + kstep, voffB); PG8_STAGE(PG8_SA(1, 0), cA + kstep, voffA); PG8_STAGE(PG8_SB(1, 1), cB + hstep + kstep, voffB);
    PG8_WAIT_V(6); PG8_BAR;
    for (;;) {
        const bool has_next = S.next(ui + 1, nxt);
        const char* nA = has_next ? (const char*)g.A + (size_t)nxt.pm * tstep : cA; const char* nB = has_next ? (const char*)g.Bt + S.bofs(nxt) + (size_t)nxt.pn * tstep : cB;
        for (int t = 0; t < nt; t += 2) {
            const bool last = (t == nt - 2);
            const char* a1 = cA + (size_t)(t + 1) * kstep;
            const char* a2 = last ? nA : cA + (size_t)(t + 2) * kstep; const char* b2 = last ? nB : cB + (size_t)(t + 2) * kstep;
            const char* a3 = a2 + kstep; const char* b3 = b2 + kstep;
            PG8_LDB(B0, 0, 0); PG8_LDB(B1, 0, 1); PG8_SCHED; PG8_LDA(At, 0, 0); PG8_STAGE(PG8_SA(1, 1), a1 + hstep, voffA);
            PG8_WAIT_V(8); PG8_WAIT_L(0); PG8_BAR; PG8_MMA(0, 0, At, B0); PG8_MMA(0, 1, At, B1); PG8_BAR; PG8_SCHED;
            PG8_LDA(At, 0, 1); PG8_STAGE(PG8_SB(0, 0), b2, voffB); PG8_STAGE(PG8_SB(0, 1), b2 + hstep, voffB); PG8_STAGE(PG8_SA(0, 0), a2, voffA);
            PG8_WAIT_V(8); PG8_WAIT_L(0); PG8_BAR; PG8_MMA(1, 0, At, B0); PG8_MMA(1, 1, At, B1); PG8_BAR; PG8_SCHED;
            PG8_LDB(B0, 1, 0); PG8_LDB(B1, 1, 1); PG8_SCHED; PG8_LDA(At, 1, 0); PG8_STAGE(PG8_SA(0, 1), a2 + hstep, voffA);
            PG8_WAIT_V(8); PG8_WAIT_L(0); PG8_BAR; PG8_MMA(0, 0, At, B0); PG8_MMA(0, 1, At, B1); PG8_BAR; PG8_SCHED;
            PG8_LDA(At, 1, 1); PG8_STAGE(PG8_SB(1, 0), b3, voffB); PG8_STAGE(PG8_SB(1, 1), b3 + hstep, voffB); PG8_STAGE(PG8_SA(1, 0), a3, voffA);
            PG8_WAIT_V(8); PG8_WAIT_L(0); PG8_BAR; PG8_MMA(1, 0, At, B0); PG8_MMA(1, 1, At, B1); PG8_BAR; PG8_SCHED;
        }
        if (wr == 0) PG8_BAR;
        E(acc, cur, wr, wc, fr, fq);
        if (!has_next) break;
#pragma unroll
        for (int a = 0; a < 2; ++a)
#pragma unroll
            for (int b = 0; b < 2; ++b)
#pragma unroll
                for (int m = 0; m < 4; ++m)
#pragma unroll
                    for (int n = 0; n < 2; ++n) acc[a][b][m][n] = (f32x4){0.f, 0.f, 0.f, 0.f};
        cur = nxt; cA = nA; cB = nB; ++ui;
        if (wr == 1) PG8_BAR;
    }
    PG8_WAIT_V(0);
    PG8_BAR;
#undef PG8_SA
#undef PG8_SB
#undef PG8_STAGE
#undef PG8_LDA
#undef PG8_LDB
#undef PG8_MMA
#undef PG8_WAIT_V
#undef PG8_WAIT_L
#undef PG8_BAR
#undef PG8_SCHED
}
}

#define XB_TMO      128
#define XB_XCNT(j)  (256  + 64 * (j))
#define XB_XSUB(j)  (1280 + 64 * (j))
#define XB_XGEN(j)  (2304 + 64 * (j))
#define XB_TOP      3328
#define XB_TOPGEN   3392
#define XCD_BAR_WORDS 3456
#define XB_SPIN_CAP (1u << 18)
__device__ __forceinline__ unsigned xb_ld(unsigned* p)              { return __hip_atomic_load(p, __ATOMIC_RELAXED, __HIP_MEMORY_SCOPE_AGENT); }
__device__ __forceinline__ unsigned xb_add(unsigned* p, unsigned v) { return __hip_atomic_fetch_add(p, v, __ATOMIC_RELAXED, __HIP_MEMORY_SCOPE_AGENT); }
__device__ __forceinline__ unsigned xb_xcc_id() { return (unsigned)__builtin_amdgcn_s_getreg((3 << 11) | 20) & 0xFu; }
#define XB_SPIN(cond, bar) do { unsigned _sp = 0; while (cond) { __builtin_amdgcn_s_sleep(1); \
    if ((++_sp & 255u) == 0u) { if (xb_ld(&(bar)[XB_TMO])) break; if (_sp > XB_SPIN_CAP) { atomicAdd(&(bar)[XB_TMO], 1u); break; } } } } while (0)
struct XcdBarrier { unsigned* bar; unsigned x; volatile LAS unsigned* st; };
__device__ __forceinline__ XcdBarrier xcd_barrier_post(unsigned* bar, volatile LAS unsigned* st) {
    XcdBarrier b; b.bar = bar; b.x = xb_xcc_id(); b.st = st;
    if (threadIdx.x == 0) (void)xb_add(&bar[XB_XCNT(b.x)], 1u);
    return b;
}
__device__ __forceinline__ void xcd_barrier_complete(unsigned* bar, unsigned x, unsigned& nloc, unsigned& nx) {
    const unsigned G = gridDim.x * gridDim.y * gridDim.z;
    unsigned sum, cnt, mine, sp = 0u;
    for (;;) {
        sum = 0u; cnt = 0u; mine = 0u;
#pragma unroll
        for (unsigned j = 0; j < 16; ++j) { const unsigned c = xb_ld(&bar[XB_XCNT(j)]); sum += c; cnt += (c > 0u) ? 1u : 0u; mine = (j == x) ? c : mine; }
        if (sum == G) break;
        __builtin_amdgcn_s_sleep(1);
        if ((++sp & 255u) == 0u) { if (xb_ld(&bar[XB_TMO])) break; if (sp > XB_SPIN_CAP) { atomicAdd(&bar[XB_TMO], 1u); break; } }
    }
    nloc = mine > 0u ? mine : 1u; nx = cnt > 0u ? cnt : 1u;
}
__device__ __forceinline__ void xcd_barrier(const XcdBarrier& b) {
    asm volatile("s_waitcnt vmcnt(0)" ::: "memory");
    __syncthreads();
    if (threadIdx.x == 0) {
        unsigned* bar = b.bar;
        __builtin_amdgcn_s_waitcnt(0);
        unsigned nloc = b.st[0], nx = b.st[1];
        if (nloc == 0u) { xcd_barrier_complete(bar, b.x, nloc, nx); b.st[0] = nloc; b.st[1] = nx; }
        const unsigned old = xb_add(&bar[XB_XSUB(b.x)], 1u);
        const unsigned gen = old / nloc;
        if (old + 1u == (gen + 1u) * nloc) {
            __builtin_amdgcn_fence(__ATOMIC_RELEASE, "agent");
            asm volatile("s_waitcnt vmcnt(0)" ::: "memory");
            const unsigned og = xb_add(&bar[XB_TOP], 1u);
            const unsigned tg = og / nx;
            if (og + 1u == (tg + 1u) * nx) xb_add(&bar[XB_TOPGEN], 1u);
            else XB_SPIN(xb_ld(&bar[XB_TOPGEN]) == tg, bar);
            __builtin_amdgcn_fence(__ATOMIC_ACQUIRE, "agent");
            xb_add(&bar[XB_XGEN(b.x)], 1u);
            asm volatile("s_waitcnt vmcnt(0)" ::: "memory");
        } else {
            XB_SPIN(xb_ld(&bar[XB_XGEN(b.x)]) == gen, bar);
            __builtin_amdgcn_fence(__ATOMIC_ACQUIRE, "agent");
            asm volatile("s_waitcnt vmcnt(0)" ::: "memory");
        }
    }
    __syncthreads();
}

struct Frame {
    LAS unsigned char* lds;
    int tid, lane, wave, vcu, G;
};
struct Args {
    const float* in[21]; float* out; unsigned char* ws; int upto, pad1;
};

__device__ __forceinline__ void transpose_item(const float* W, int ldw, int k0, int n0, bf16_t* WT, int ldk, int drow0, LAS float* scr, int lane) {
#pragma unroll 8
    for (int i = 0; i < 32; ++i) { const int kk = 2 * i + (lane >> 5); scr[kk * 33 + (lane & 31)] = W[(size_t)(k0 + kk) * ldw + n0 + (lane & 31)]; }
    LDS_WAIT(); asm volatile("" ::: "memory");
    const int c = lane & 7;
#pragma unroll
    for (int j = 0; j < 4; ++j) { const int n = (lane >> 3) + 8 * j; const LAS float* s = scr + (8 * c) * 33 + n;
        u32x4 o; o.x = cvt_pk_bf16(s[0 * 33], s[1 * 33]); o.y = cvt_pk_bf16(s[2 * 33], s[3 * 33]); o.z = cvt_pk_bf16(s[4 * 33], s[5 * 33]); o.w = cvt_pk_bf16(s[6 * 33], s[7 * 33]);
        *(u32x4*)(WT + (size_t)(drow0 + n) * ldk + k0 + 8 * c) = o; }
    LDS_WAIT(); asm volatile("" ::: "memory");
}
__device__ __forceinline__ void conv_plain(Frame& F, const float* W, int K, int N, int ldw, bf16_t* WT) {
    LAS float* scr = (LAS float*)(F.lds + F.wave * 16384);
    const int gw = F.vcu * NWAVES + F.wave, NGW = F.G * NWAVES, nblk = N / 32, nit = (K / 64) * nblk;
    for (int it = gw; it < nit; it += NGW) { const int kb = it / nblk, nb = it % nblk; transpose_item(W, ldw, 64 * kb, 32 * nb, WT, K, 32 * nb, scr, F.lane); }
}
__device__ __forceinline__ void conv_moe(Frame& F, const float* wg, const float* wu, const float* wd, bf16_t* GU, bf16_t* DT) {
    LAS float* scr = (LAS float*)(F.lds + F.wave * 16384);
    const int gw = F.vcu * NWAVES + F.wave, NGW = F.G * NWAVES;
    constexpr int PER_E = 1536, NIT = NEXP * PER_E;
    for (int it = gw; it < NIT; it += NGW) {
        const int e = it / PER_E; int r = it % PER_E;
        if (r < 1024) { const int up = r >> 9; r &= 511; const int kb = r >> 4, nb = r & 15, n0 = 32 * nb;
            const int drow = 256 * (n0 >> 7) + 128 * up + (n0 & 127);
            transpose_item((up ? wu : wg) + (size_t)e * D * DFF, DFF, 64 * kb, n0, GU + (size_t)e * 1024 * D, D, drow, scr, F.lane); }
        else { r -= 1024; const int kb = r >> 6, nb = r & 63;
            transpose_item(wd + (size_t)e * DFF * D, D, 64 * kb, 32 * nb, DT + (size_t)e * D * DFF, DFF, 32 * nb, scr, F.lane); }
    }
}
__device__ __forceinline__ void pack_proj(Frame& F, float* Wp, int NT, const float* gain, const float* Wa, int lda, int ca0, int na, const float* Wb, int ldb, int nb) {
    const int total = 128 * NT * 256;
    for (int idx = (F.vcu * NWAVES * 64) + F.tid; idx < total; idx += F.G * NWAVES * 64) {
        const int e = idx & 3, ln = (idx >> 2) & 63, rest = idx >> 8, nt = rest % NT, s = rest / NT;
        const int k = 16 * s + 4 * (ln >> 4) + e, col = 16 * nt + (ln & 15);
        float v = 0.f;
        if (col < na) v = Wa[(size_t)k * lda + ca0 + col]; else if (col < na + nb) v = Wb[(size_t)k * ldb + (col - na)];
        Wp[idx] = v * gain[k];
    }
}

template <int NT>
__device__ __forceinline__ float wave_proj16(const float* xin, int tok0, const float* Wp, int lane, f32x4 (&acc)[NT]) {
    const int tr = lane & 15, kq = lane >> 4;
    const f32x4* xp = (const f32x4*)(xin + (size_t)(tok0 + tr) * D) + kq;
    const f32x4* wp = (const f32x4*)Wp + lane;
    float ssq = 0.f;
#pragma unroll
    for (int n = 0; n < NT; ++n) acc[n] = (f32x4){0.f, 0.f, 0.f, 0.f};
#pragma unroll 2
    for (int s = 0; s < 128; ++s) {
        const f32x4 xv = xp[4 * s];
        ssq += (xv[0] * xv[0] + xv[1] * xv[1]) + (xv[2] * xv[2] + xv[3] * xv[3]);
#pragma unroll
        for (int n = 0; n < NT; ++n) { const f32x4 wv = wp[(s * NT + n) * 64];
#pragma unroll
            for (int e = 0; e < 4; ++e) acc[n] = __builtin_amdgcn_mfma_f32_16x16x4f32(xv[e], wv[e], acc[n], 0, 0, 0); }
    }
    ssq += __shfl_xor(ssq, 16); ssq += __shfl_xor(ssq, 32);
    return 1.0f / sqrtf(ssq * (1.0f / D) + RMS_EPS);
}
__device__ __forceinline__ void wave_write_hn16(const float* xin, int tok0, float rstd, const float* gain, bf16_t* hn, int lane) {
    f32x4 g4[8];
#pragma unroll
    for (int j = 0; j < 8; ++j) g4[j] = ((const f32x4*)gain)[lane + 64 * j];
    for (int i = 0; i < 16; ++i) {
        const float rr = __shfl(rstd, i);
        const f32x4* xr = (const f32x4*)(xin + (size_t)(tok0 + i) * D);
        u32x2* orow = (u32x2*)(hn + (size_t)(tok0 + i) * D);
#pragma unroll
        for (int j = 0; j < 8; ++j) { const f32x4 v = xr[lane + 64 * j] * rr * g4[j]; u32x2 w; w.x = cvt_pk_bf16(v[0], v[1]); w.y = cvt_pk_bf16(v[2], v[3]); orow[lane + 64 * j] = w; }
    }
}

__device__ __forceinline__ void phase_norm_gz(Frame& F, const float* xin, const float* gain, const float* Wp, bf16_t* hn, float* gz) {
    for (int tile = F.vcu; tile < T / 128; tile += F.G) {
        const int tok0 = tile * 128 + F.wave * 16;
        f32x4 acc[1];
        const float rstd = wave_proj16<1>(xin, tok0, Wp, F.lane, acc);
        const int j = F.lane & 15, q4 = F.lane >> 4;
#pragma unroll
        for (int r = 0; r < 4; ++r) { const float rr = __shfl(rstd, 4 * q4 + r); gz[(size_t)(tok0 + 4 * q4 + r) * 16 + j] = acc[0][r] * rr; }
        wave_write_hn16(xin, tok0, rstd, gain, hn, F.lane);
    }
}
__device__ __forceinline__ void phase_norm_route(Frame& F, const float* xin, const float* gain, const float* Wp, bf16_t* hn, int* tok_e, int* tok_p, float* tok_w, unsigned* cnt) {
    LAS float* lg = (LAS float*)(F.lds + F.wave * 4096);
    for (int tile = F.vcu; tile < T / 128; tile += F.G) {
        const int tok0 = tile * 128 + F.wave * 16;
        f32x4 acc[3];
        const float rstd = wave_proj16<3>(xin, tok0, Wp, F.lane, acc);
        const int j = F.lane & 15, q4 = F.lane >> 4;
#pragma unroll
        for (int r = 0; r < 4; ++r) { const float rr = __shfl(rstd, 4 * q4 + r);
#pragma unroll
            for (int n = 0; n < 3; ++n) lg[(4 * q4 + r) * 48 + 16 * n + j] = acc[n][r] * rr; }
        LDS_WAIT(); asm volatile("" ::: "memory");
        if (F.lane < 16) {
            const LAS float* l = lg + F.lane * 48;
            float gm = l[0]; int gi = 0;
#pragma unroll
            for (int q = 1; q < 4; ++q) { const float v = l[q]; if (v > gm) { gm = v; gi = q; } }
            float gs = 0.f;
#pragma unroll
            for (int q = 0; q < 4; ++q) gs += __expf(l[q] - gm);
            const float gw = 1.0f / gs;
            const LAS float* se = l + 4 + 8 * gi;
            float m1 = se[0]; int i1 = 0;
#pragma unroll
            for (int q = 1; q < 8; ++q) { const float v = se[q]; if (v > m1) { m1 = v; i1 = q; } }
            float m2 = -3.0e38f; int i2 = 0;
#pragma unroll
            for (int q = 0; q < 8; ++q) { const float v = se[q]; if (q != i1 && v > m2) { m2 = v; i2 = q; } }
            const float eb = __expf(m2 - m1), inv = 1.0f / (1.0f + eb);
            const int t = tok0 + F.lane, e1 = gi * 8 + i1, e2 = gi * 8 + i2;
            const unsigned p1 = __hip_atomic_fetch_add(cnt + 64 * e1, 1u, __ATOMIC_RELAXED, __HIP_MEMORY_SCOPE_AGENT);
            const unsigned p2 = __hip_atomic_fetch_add(cnt + 64 * e2, 1u, __ATOMIC_RELAXED, __HIP_MEMORY_SCOPE_AGENT);
            tok_e[2 * t] = e1; tok_e[2 * t + 1] = e2; tok_p[2 * t] = (int)p1; tok_p[2 * t + 1] = (int)p2;
            tok_w[2 * t] = gw * inv; tok_w[2 * t + 1] = gw * eb * inv;
        }
        wave_write_hn16(xin, tok0, rstd, gain, hn, F.lane);
        LDS_WAIT(); asm volatile("" ::: "memory");
    }
}

__device__ __forceinline__ void phase_gla_gate(Frame& F, const float* gz, const float* wgu, const float* bgate, const bf16_t* proj, bf16_t* kdT, float* adec) {
    LAS f32x4* gzs = (LAS f32x4*)F.lds;
    for (int u = F.vcu; u < NBATCH * NCH * 2; u += F.G) {
        const int half = u & 1, bc = u >> 1;
        const int tok0 = bc * 64, j = half * 512 + F.tid;
        if (F.tid < 256) gzs[F.tid] = ((const f32x4*)(gz + (size_t)tok0 * 16))[F.tid];
        float wg[16];
#pragma unroll
        for (int r = 0; r < 16; ++r) wg[r] = wgu[r * GLA_DKT + j];
        const float bg = bgate[j];
        WG_BAR();
        float cum[64]; float run = 0.f;
#pragma unroll
        for (int t = 0; t < 64; ++t) {
            float z = bg;
#pragma unroll
            for (int r4 = 0; r4 < 4; ++r4) { const f32x4 g4 = gzs[t * 4 + r4]; z += g4[0] * wg[4 * r4] + g4[1] * wg[4 * r4 + 1] + g4[2] * wg[4 * r4 + 2] + g4[3] * wg[4 * r4 + 3]; }
            const float ls = fminf(z, 0.f) - __logf(1.0f + __expf(-fabsf(z)));
            run += ls * (1.0f / 16.0f); cum[t] = run;
        }
        adec[(size_t)bc * GLA_DKT + j] = __expf(run);
        const bf16_t* kp = proj + GK0 + gq_off(bc >> 8, (bc & 255) * 64, j >> 8) + (j & 255);
        u32x4* dst = (u32x4*)(kdT + ((size_t)bc * GLA_DKT + j) * 64);
#pragma unroll
        for (int t8 = 0; t8 < 8; ++t8) {
            float kd[8];
#pragma unroll
            for (int q = 0; q < 8; ++q) { const int t = t8 * 8 + q; kd[q] = bf2f(kp[(size_t)t * 256]) * __expf(run - cum[t]); }
            u32x4 w; w.x = cvt_pk_bf16(kd[0], kd[1]); w.y = cvt_pk_bf16(kd[2], kd[3]); w.z = cvt_pk_bf16(kd[4], kd[5]); w.w = cvt_pk_bf16(kd[6], kd[7]);
            dst[t8] = w;
        }
        WG_BAR();
    }
}

struct ScanSet { bf16x8 ka[2][2]; f32x4 dc[2]; u32x2 qa[4][2]; u32x4 vreg; };
__device__ __forceinline__ void phase_gla_scan(Frame& F, const bf16_t* proj, const bf16_t* kdT, const float* adec, bf16_t* oout) {
    const int lane = F.lane, w = F.wave, fr = lane & 15, kq = lane >> 4;
    LAS unsigned char* vbuf = F.lds;
    LAS float* red = (LAS float*)(F.lds + 4096);
    for (int u = F.vcu; u < 256; u += F.G) {
        const int bh = u >> 5, b = bh >> 2, h = bh & 3, sl = u & 31;
        const size_t tokb = (size_t)b * SEQ;
        f32x4 st[2] = {(f32x4){0.f, 0.f, 0.f, 0.f}, (f32x4){0.f, 0.f, 0.f, 0.f}};
        ScanSet sA, sB; sA.vreg = (u32x4){0u, 0u, 0u, 0u}; sB.vreg = sA.vreg;
#define SCAN_LOAD(S_, c) do { const size_t bc_ = (size_t)b * NCH + (c); \
            _Pragma("unroll") for (int i = 0; i < 2; ++i) { \
                _Pragma("unroll") for (int s = 0; s < 2; ++s) S_.ka[i][s] = *(const bf16x8*)(kdT + ((bc_ * GLA_DKT + h * 256 + 32 * w + 16 * i + fr) * 64 + 32 * s + 8 * kq)); \
                S_.dc[i] = *(const f32x4*)(adec + bc_ * GLA_DKT + h * 256 + 32 * w + 16 * i + 4 * kq); } \
            _Pragma("unroll") for (int mt = 0; mt < 4; ++mt) { const bf16_t* qp = proj + gq_off(b, (c) * 64 + 16 * mt + fr, h) + 32 * w + 4 * kq; \
                S_.qa[mt][0] = *(const u32x2*)qp; S_.qa[mt][1] = *(const u32x2*)(qp + 16); } \
            S_.vreg = *(const u32x4*)(proj + gv_off(b, (c) * 64 + ((F.tid & 127) >> 1), h) + 16 * sl + 8 * (F.tid & 1));   \
        } while (0)
#define SCAN_STEP(MY, OTHER, c) do { \
            const ScanSet cur = MY; \
            { const int cn_ = (c) + 2 < NCH ? (c) + 2 : NCH - 1; SCAN_LOAD(MY, cn_); }     \
            const unsigned vb = (unsigned)(uintptr_t)(vbuf + ((c) & 1) * 2048) + (unsigned)((8 * kq + ((lane & 15) >> 2)) * 32 + 8 * (lane & 3)); \
            s16x4 v00, v01, v10, v11; \
            asm volatile("ds_read_b64_tr_b16 %0, %4\n\tds_read_b64_tr_b16 %1, %4 offset:128\n\tds_read_b64_tr_b16 %2, %4 offset:1024\n\tds_read_b64_tr_b16 %3, %4 offset:1152\n\ts_waitcnt lgkmcnt(0)" \
                         : "=&v"(v00), "=&v"(v01), "=&v"(v10), "=&v"(v11) : "v"(vb) : "memory"); \
            const bf16x8 vb0 = (bf16x8){v00[0], v00[1], v00[2], v00[3], v01[0], v01[1], v01[2], v01[3]}; \
            const bf16x8 vb1 = (bf16x8){v10[0], v10[1], v10[2], v10[3], v11[0], v11[1], v11[2], v11[3]}; \
            _Pragma("unroll") for (int i = 0; i < 2; ++i) { \
                st[i] = st[i] * cur.dc[i]; \
                st[i] = __builtin_amdgcn_mfma_f32_16x16x32_bf16(cur.ka[i][0], vb0, st[i], 0, 0, 0); \
                st[i] = __builtin_amdgcn_mfma_f32_16x16x32_bf16(cur.ka[i][1], vb1, st[i], 0, 0, 0); } \
            u32x4 sw; sw.x = cvt_pk_bf16(st[0][0], st[0][1]); sw.y = cvt_pk_bf16(st[0][2], st[0][3]); sw.z = cvt_pk_bf16(st[1][0], st[1][1]); sw.w = cvt_pk_bf16(st[1][2], st[1][3]); \
            const bf16x8 sb = __builtin_bit_cast(bf16x8, sw); \
            LAS float* rw = red + ((size_t)(((c) & 1) * 8 + w) * 64) * 16; \
            _Pragma("unroll") for (int mt = 0; mt < 4; ++mt) { \
                u32x4 qw; qw.x = cur.qa[mt][0].x; qw.y = cur.qa[mt][0].y; qw.z = cur.qa[mt][1].x; qw.w = cur.qa[mt][1].y; \
                const f32x4 po = __builtin_amdgcn_mfma_f32_16x16x32_bf16(__builtin_bit_cast(bf16x8, qw), sb, (f32x4){0.f, 0.f, 0.f, 0.f}, 0, 0, 0); \
                _Pragma("unroll") for (int r = 0; r < 4; ++r) rw[(16 * mt + 4 * kq + r) * 16 + fr] = po[r]; } \
            if ((c) + 1 < NCH && F.tid < 128) *(LAS u32x4*)(vbuf + (((c) + 1) & 1) * 2048 + F.tid * 16) = OTHER.vreg; \
            WG_BAR(); \
            { const int t = F.tid >> 3, vc2 = (F.tid & 7) * 2; float s0 = 0.f, s1 = 0.f; \
              _Pragma("unroll") for (int ww = 0; ww < 8; ++ww) { const f32x2 p = *(const LAS f32x2*)(red + ((size_t)(((c) & 1) * 8 + ww) * 64 + t) * 16 + vc2); s0 += p.x; s1 += p.y; } \
              *(unsigned*)(oout + (tokb + (size_t)(c) * 64 + t) * D + h * 512 + 16 * sl + vc2) = cvt_pk_bf16(s0 * 0.0625f, s1 * 0.0625f); } \
        } while (0)
        SCAN_LOAD(sA, 0); SCAN_LOAD(sB, 1);
        if (F.tid < 128) *(LAS u32x4*)(vbuf + F.tid * 16) = sA.vreg;
        WG_BAR();
        for (int c = 0; c < NCH; c += 2) { SCAN_STEP(sA, sB, c); SCAN_STEP(sB, sA, c + 1); }
        WG_BAR();
#undef SCAN_LOAD
#undef SCAN_STEP
    }
}

__device__ __forceinline__ void phase_gla_gnorm(Frame& F, const bf16_t* o, const bf16_t* proj, const float* gn, bf16_t* y) {
    const int gw = F.vcu * NWAVES + F.wave, NGW = F.G * NWAVES, lane = F.lane;
    const f32x4 g0 = ((const f32x4*)gn)[2 * lane], g1 = ((const f32x4*)gn)[2 * lane + 1];
    for (int idx = gw; idx < T * GLA_H; idx += NGW) {
        const int tok = idx >> 2, h = idx & 3;
        const u32x4 ov = *(const u32x4*)(o + (size_t)tok * D + h * 512 + 8 * lane);
        const u32x4 rv = *(const u32x4*)(proj + GR0 + (size_t)tok * 2048 + h * 512 + 8 * lane);
        float a[8], r[8];
#pragma unroll
        for (int q = 0; q < 4; ++q) { a[2 * q] = bf_lo(ov[q]); a[2 * q + 1] = bf_hi(ov[q]); r[2 * q] = bf_lo(rv[q]); r[2 * q + 1] = bf_hi(rv[q]); }
        float ss = 0.f;
#pragma unroll
        for (int q = 0; q < 8; ++q) ss += a[q] * a[q];
        const float rstd = 1.0f / sqrtf(wave_sum(ss) * (1.0f / 512.0f) + RMS_EPS);
        float yv[8];
#pragma unroll
        for (int q = 0; q < 8; ++q) { const float g = q < 4 ? g0[q] : g1[q - 4]; const float sr = r[q] / (1.0f + __expf(-r[q])); yv[q] = a[q] * rstd * g * sr; }
        u32x4 w; w.x = cvt_pk_bf16(yv[0], yv[1]); w.y = cvt_pk_bf16(yv[2], yv[3]); w.z = cvt_pk_bf16(yv[4], yv[5]); w.w = cvt_pk_bf16(yv[6], yv[7]);
        *(u32x4*)(y + (size_t)tok * D + h * 512 + 8 * lane) = w;
    }
}

__device__ __forceinline__ void moe_tables(Frame& F, unsigned* cnt) {
    LAS int* pst = (LAS int*)(F.lds + TAB_OFF);
    LAS int* te = pst + 36;
    if (F.wave == 0) {
        const int e = F.lane & 31;
        const int c = (int)xb_ld(cnt + 64 * e);
        const int ntile = (c + 255) >> 8;
        int incl = ntile;
#pragma unroll
        for (int o = 1; o < 32; o <<= 1) { const int v = __shfl_up(incl, o); if ((F.lane & 31) >= o) incl += v; }
        const int excl = incl - ntile;
        if (F.lane < 32) { pst[e] = excl << 8; for (int q = 0; q < ntile; ++q) te[excl + q] = e; }
        if (F.lane == 31) { pst[32] = incl << 8; pst[33] = incl; }
    }
    WG_BAR();
}
__device__ __forceinline__ void phase_moe_gather(Frame& F, const int* tok_e, const int* tok_p, int* slot_of, const bf16_t* hn, bf16_t* ag) {
    const LAS int* pst = (const LAS int*)(F.lds + TAB_OFF);
    const int gw = F.vcu * NWAVES + F.wave, NGW = F.G * NWAVES, lane = F.lane;
    for (int a = gw; a < 2 * T; a += NGW) {
        const int e = tok_e[a], p = tok_p[a], slot = pst[e] + p, t = a >> 1;
        if (lane == 0) slot_of[a] = slot;
        const u32x4* src = (const u32x4*)(hn + (size_t)t * D); u32x4* dst = (u32x4*)(ag + (size_t)slot * D);
#pragma unroll
        for (int j = 0; j < 4; ++j) dst[lane + 64 * j] = src[lane + 64 * j];
    }
}
template <int MODE>
__device__ __forceinline__ void phase_moe_combine(Frame& F, float* x, const bf16_t* ob, const int* slot_of, const float* tok_w, const float* gain, bf16_t* hn) {
    const int gw = F.vcu * NWAVES + F.wave, NGW = F.G * NWAVES, lane = F.lane;
    f32x4 g4[8];
#pragma unroll
    for (int j = 0; j < 8; ++j) g4[j] = ((const f32x4*)gain)[lane + 64 * j];
    for (int t = gw; t < T; t += NGW) {
        const int s0 = slot_of[2 * t], s1 = slot_of[2 * t + 1]; const float w0 = tok_w[2 * t], w1 = tok_w[2 * t + 1];
        f32x4* xr = (f32x4*)(x + (size_t)t * D);
        const u32x2* a = (const u32x2*)(ob + (size_t)s0 * D); const u32x2* b = (const u32x2*)(ob + (size_t)s1 * D);
        f32x4 v[8]; float ss = 0.f;
#pragma unroll
        for (int j = 0; j < 8; ++j) { const u32x2 av = a[lane + 64 * j], bv = b[lane + 64 * j]; f32x4 xv = xr[lane + 64 * j];
            xv[0] += w0 * bf_lo(av.x) + w1 * bf_lo(bv.x); xv[1] += w0 * bf_hi(av.x) + w1 * bf_hi(bv.x);
            xv[2] += w0 * bf_lo(av.y) + w1 * bf_lo(bv.y); xv[3] += w0 * bf_hi(av.y) + w1 * bf_hi(bv.y);
            v[j] = xv; ss += (xv[0] * xv[0] + xv[1] * xv[1]) + (xv[2] * xv[2] + xv[3] * xv[3]); }
        const float rstd = 1.0f / sqrtf(wave_sum(ss) * (1.0f / D) + RMS_EPS);
        if (MODE == 0) {
            u32x2* orow = (u32x2*)(hn + (size_t)t * D);
#pragma unroll
            for (int j = 0; j < 8; ++j) { xr[lane + 64 * j] = v[j]; const f32x4 y = v[j] * rstd * g4[j]; u32x2 w; w.x = cvt_pk_bf16(y[0], y[1]); w.y = cvt_pk_bf16(y[2], y[3]); orow[lane + 64 * j] = w; }
        } else {
#pragma unroll
            for (int j = 0; j < 8; ++j) xr[lane + 64 * j] = v[j] * rstd * g4[j];
        }
    }
}

__device__ __forceinline__ void phase_subln(Frame& F, const bf16_t* o1, const bf16_t* o2, const float* lq1, const float* lk1, const float* lq2, const float* lk2, const float* sg, bf16_t* y) {
    const int gw = F.vcu * NWAVES + F.wave, NGW = F.G * NWAVES, lane = F.lane;
    const float d1 = wave_sum(lq1[lane] * lk1[lane] + lq1[lane + 64] * lk1[lane + 64]);
    const float d2 = wave_sum(lq2[lane] * lk2[lane] + lq2[lane + 64] * lk2[lane + 64]);
    const float lam = __expf(d1) - __expf(d2) + LAMBDA_INIT;
    const f32x4 g = ((const f32x4*)sg)[lane] * (1.0f - LAMBDA_INIT);
    for (int idx = gw; idx < T * DIFF_H; idx += NGW) {
        const int tok = idx >> 3, h = idx & 7;
        const u32x2 a = *(const u32x2*)(o1 + (size_t)tok * D + h * 256 + 4 * lane), b = *(const u32x2*)(o2 + (size_t)tok * D + h * 256 + 4 * lane);
        f32x4 d; d[0] = bf_lo(a.x) - lam * bf_lo(b.x); d[1] = bf_hi(a.x) - lam * bf_hi(b.x); d[2] = bf_lo(a.y) - lam * bf_lo(b.y); d[3] = bf_hi(a.y) - lam * bf_hi(b.y);
        const float ss = (d[0] * d[0] + d[1] * d[1]) + (d[2] * d[2] + d[3] * d[3]);
        const float rstd = 1.0f / sqrtf(wave_sum(ss) * (1.0f / 256.0f) + RMS_EPS);
        const f32x4 yv = d * rstd * g;
        u32x2 w; w.x = cvt_pk_bf16(yv[0], yv[1]); w.y = cvt_pk_bf16(yv[2], yv[3]);
        *(u32x2*)(y + (size_t)tok * D + h * 256 + 4 * lane) = w;
    }
}

namespace att {
constexpr int SHM_K = 64 * 128 * 2, SHM_V = 64 * 256 * 2;
constexpr int V_OFF = 0, K_OFF = 2 * SHM_V, SCR_OFF = 2 * SHM_V + 2 * SHM_K;
constexpr float SCALE = 0.08838834764831845f;
constexpr float C2 = 1.4426950408889634f * SCALE;
constexpr float THR = 8.f;
#define KSWZ(row, colB) ((row) * 256 + ((colB) ^ (((row) & 7) << 4)))
__device__ __forceinline__ int crow(int r, int hi) { return (r & 3) + 8 * (r >> 2) + 4 * hi; }
__device__ __forceinline__ int v_rd_base(int lane) { return ((lane & 3) << 3) | (((lane >> 2) & 3) << 6) | (((lane >> 4) & 1) << 5) | (((lane >> 5) & 1) << 8); }
constexpr int v_rd_off(int d0, int ks, int half) { return d0 * 512 + ks * 8192 + half * 4096; }

template <int KB>
__device__ __forceinline__ void qkt(f32x16& p0, f32x16& p1, LAS unsigned char* lds, int r32, int hi, const bf16x8 (&qr)[8]) {
    const LAS unsigned char* kb[4];
#pragma unroll
    for (int dd = 0; dd < 4; ++dd) kb[dd] = lds + K_OFF + KB * SHM_K + KSWZ(r32, (dd * 16 + hi * 8) * 2);
#pragma unroll
    for (int d0 = 0; d0 < 8; ++d0) { const LAS unsigned char* a = kb[d0 & 3] + (d0 >> 2) * 128;
        const bf16x8 b0 = *(const LAS bf16x8*)a;
        const bf16x8 b1 = *(const LAS bf16x8*)(a + 32 * 256);
        p0 = __builtin_amdgcn_mfma_f32_32x32x16_bf16(b0, qr[d0], p0, 0, 0, 0);
        p1 = __builtin_amdgcn_mfma_f32_32x32x16_bf16(b1, qr[d0], p1, 0, 0, 0); }
}
template <int VB>
__device__ __forceinline__ void pv_tile(f32x16 (&o)[8], unsigned vb0, bf16x8 pa0, bf16x8 pa1, bf16x8 pa2, bf16x8 pa3) {
#define TRRD(dst, off) asm volatile("ds_read_b64_tr_b16 %0, %1 offset:%2" : "=&v"(dst) : "v"(vb0), "i"(off) : "memory")
#define PV_D0(d0) do { s16x4 l0, l1, l2, l3, h0, h1, h2, h3; constexpr int b_ = V_OFF + VB * SHM_V + v_rd_off(d0, 0, 0); \
        TRRD(l0, b_); TRRD(h0, b_ + 4096); TRRD(l1, b_ + 8192); TRRD(h1, b_ + 12288); TRRD(l2, b_ + 16384); TRRD(h2, b_ + 20480); TRRD(l3, b_ + 24576); TRRD(h3, b_ + 28672); \
        asm volatile("s_waitcnt lgkmcnt(0)" ::: "memory"); __builtin_amdgcn_sched_barrier(0); \
        o[d0] = __builtin_amdgcn_mfma_f32_32x32x16_bf16(pa0, (bf16x8){l0[0], l0[1], l0[2], l0[3], h0[0], h0[1], h0[2], h0[3]}, o[d0], 0, 0, 0); \
        o[d0] = __builtin_amdgcn_mfma_f32_32x32x16_bf16(pa1, (bf16x8){l1[0], l1[1], l1[2], l1[3], h1[0], h1[1], h1[2], h1[3]}, o[d0], 0, 0, 0); \
        o[d0] = __builtin_amdgcn_mfma_f32_32x32x16_bf16(pa2, (bf16x8){l2[0], l2[1], l2[2], l2[3], h2[0], h2[1], h2[2], h2[3]}, o[d0], 0, 0, 0); \
        o[d0] = __builtin_amdgcn_mfma_f32_32x32x16_bf16(pa3, (bf16x8){l3[0], l3[1], l3[2], l3[3], h3[0], h3[1], h3[2], h3[3]}, o[d0], 0, 0, 0); } while (0)
    PV_D0(0); PV_D0(1); PV_D0(2); PV_D0(3); PV_D0(4); PV_D0(5); PV_D0(6); PV_D0(7);
#undef PV_D0
#undef TRRD
}

__device__ __forceinline__ void stage_offsets(int tid, unsigned (&koff)[2], unsigned (&voff)[4]) {
#pragma unroll
    for (int i = 0; i < 2; ++i) { const int P = tid * 16 + i * 8192, row = P >> 8, ch = ((P & 255) >> 4) ^ (row & 7); koff[i] = (unsigned)(row * 128 + ch * 8) * 2u; }
#pragma unroll
    for (int i = 0; i < 4; ++i) { const int P = tid * 16 + i * 8192, st = P >> 9, kk = ((st >> 3) << 3) | ((P & 511) >> 6), cg = st & 7, cin = (P & 63) >> 1;
        const int key = (kk & ~0xC) | ((kk & 4) << 1) | ((kk & 8) >> 1); voff[i] = (unsigned)(key * 256 + cg * 32 + cin) * 2u; }
}
__device__ __forceinline__ const char* uniform_ptr(const void* p) {
    const unsigned long long v = (unsigned long long)p;
    const unsigned lo = __builtin_amdgcn_readfirstlane((unsigned)v), hi = __builtin_amdgcn_readfirstlane((unsigned)(v >> 32));
    return (const char*)(((unsigned long long)hi << 32) | lo);
}
__device__ __forceinline__ void stage_tile(LAS unsigned char* lds, int bf, const bf16_t* kj_, const bf16_t* vj_, int tid_, int wid) {
    const char* kj = uniform_ptr(kj_); const char* vj = uniform_ptr(vj_);
    int tid = tid_; asm volatile("" : "+v"(tid));
    unsigned koff[2], voff[4]; stage_offsets(tid, koff, voff);
#pragma unroll
    for (int i = 0; i < 2; ++i) __builtin_amdgcn_global_load_lds((const unsigned*)(kj + koff[i]), (LAS unsigned*)(lds + K_OFF + bf * SHM_K + wid * 1024 + i * 8192), 16, 0, 0);
#pragma unroll
    for (int i = 0; i < 4; ++i) __builtin_amdgcn_global_load_lds((const unsigned*)(vj + voff[i]), (LAS unsigned*)(lds + V_OFF + bf * SHM_V + wid * 1024 + i * 8192), 16, 0, 0);
}

template <int BF>
__device__ __forceinline__ void tile_compute(LAS unsigned char* lds, int r32, int hi, unsigned vb0, LAS float* al_l, const bf16x8 (&qr)[8], f32x16 (&o)[8],
                                             float& m_reg, float& l_reg, float rawu, float sl2, bool diag, int qi) {
    f32x16 p0, p1;
#pragma unroll
    for (int r = 0; r < 16; ++r) { p0[r] = 0.f; p1[r] = 0.f; }
    qkt<BF>(p0, p1, lds, r32, hi, qr);
#pragma unroll
    for (int r = 0; r < 16; ++r) { const float cr = (float)((r & 3) + 8 * (r >> 2)); p0[r] = fmaf(cr, rawu, p0[r]); p1[r] = fmaf(cr, rawu, p1[r]); }
    if (diag) {
        const float k2raw = 2.f * rawu;
        int qi_ = qi - 4 * hi; asm volatile("" : "+v"(qi_));
#pragma unroll
        for (int r = 0; r < 16; ++r) { const int c = (r & 3) + 8 * (r >> 2); const int d0_ = c - qi_, d1_ = c + 32 - qi_;
            p0[r] -= k2raw * (float)(d0_ > 0 ? d0_ : 0); p1[r] -= k2raw * (float)(d1_ > 0 ? d1_ : 0); }
    }
    const float lane_raw = rawu * (float)(4 * hi), d32raw = 32.f * rawu;
    float pm0 = p0[0], pm1 = p1[0];
#pragma unroll
    for (int r = 1; r < 16; ++r) { pm0 = fmaxf(pm0, p0[r]); pm1 = fmaxf(pm1, p1[r]); }
    float pmax = fmaxf(pm0, pm1 + d32raw) + lane_raw;
    { auto rr = __builtin_amdgcn_permlane32_swap(__float_as_uint(pmax), __float_as_uint(pmax), false, false);
      pmax = fmaxf(__uint_as_float(rr[0]), __uint_as_float(rr[1])); }
    float mn, alpha;
    if (__all((pmax - m_reg) * SCALE <= THR)) { mn = m_reg; alpha = 1.f; }
    else { mn = fmaxf(m_reg, pmax); alpha = __builtin_amdgcn_exp2f((m_reg - mn) * C2); m_reg = mn; }
    const float mnL0 = (lane_raw - mn) * C2, mnL1 = mnL0 + 32.f * sl2;
#pragma unroll
    for (int r = 0; r < 16; ++r) { p0[r] = __builtin_amdgcn_exp2f(fmaf(p0[r], C2, mnL0)); p1[r] = __builtin_amdgcn_exp2f(fmaf(p1[r], C2, mnL1)); }
    if (__any(alpha < 1.f)) {
        if (hi == 0) al_l[r32] = alpha;
        LDS_WAIT();
#pragma unroll
        for (int r = 0; r < 16; ++r) { const float a = al_l[crow(r, hi)];
#pragma unroll
            for (int d = 0; d < 8; ++d) o[d][r] *= a; }
    }
    float ps = 0.f;
#pragma unroll
    for (int r = 0; r < 16; ++r) ps += p0[r] + p1[r];
    { auto rr = __builtin_amdgcn_permlane32_swap(__float_as_uint(ps), __float_as_uint(ps), false, false);
      ps = __uint_as_float(rr[0]) + __uint_as_float(rr[1]); }
    l_reg = l_reg * alpha + ps;
    bf16x8 pa0, pa1, pa2, pa3;
#define PK4(P, B_, OUT) do { unsigned a0 = cvt_pk_bf16(P[B_+0], P[B_+1]), a1 = cvt_pk_bf16(P[B_+2], P[B_+3]); \
        unsigned b0 = cvt_pk_bf16(P[B_+4], P[B_+5]), b1 = cvt_pk_bf16(P[B_+6], P[B_+7]); \
        auto r0 = __builtin_amdgcn_permlane32_swap(a0, b0, false, false); auto r1 = __builtin_amdgcn_permlane32_swap(a1, b1, false, false); \
        u32x4 w = {r0[0], r1[0], r0[1], r1[1]}; OUT = __builtin_bit_cast(bf16x8, w); } while (0)
    PK4(p0, 0, pa0); PK4(p0, 8, pa1); PK4(p1, 0, pa2); PK4(p1, 8, pa3);
#undef PK4
    pv_tile<BF>(o, vb0, pa0, pa1, pa2, pa3);
}

__device__ __forceinline__ void attn_item(LAS unsigned char* lds, const bf16_t* proj, bf16_t* oout, int b, int h, int sub, int qb, int tid, int wid, int lane) {
    const int r32 = lane & 31, hi = lane >> 5;
    const float slope = __builtin_amdgcn_exp2f(-(float)(h + 1));
    const float sl2 = slope * 1.4426950408889634f, rawu = sl2 / C2;
    LAS float* ws = (LAS float*)(lds + SCR_OFF) + wid * 64; LAS float* li_l = ws; LAS float* al_l = ws + 32;
    const size_t tokq = (size_t)b * SEQ + (size_t)qb * 256 + wid * 32;
    const bf16_t* kbase = proj + DK0 + dq_off(b, 0, h, sub);
    const bf16_t* vbase = proj + dv_off(b, 0, h);
    bf16x8 qr[8];
#pragma unroll
    for (int d0 = 0; d0 < 8; ++d0) qr[d0] = *(const bf16x8*)(proj + dq_off(b, qb * 256 + wid * 32 + r32, h, sub) + d0 * 16 + hi * 8);
    const float sh64 = 64.f * rawu;
    const int qi = 32 * (wid & 1) + r32;
    const unsigned vb0 = (unsigned)(uintptr_t)(lds + V_OFF) + (unsigned)v_rd_base(lane);
    float m_reg = -1e30f, l_reg = 0.f;
    f32x16 o[8];
#pragma unroll
    for (int d = 0; d < 8; ++d)
#pragma unroll
        for (int r = 0; r < 16; ++r) o[d][r] = 0.f;
    const int NT = 4 * qb + 4, myNT = 4 * qb + (wid >> 1) + 1;
    constexpr size_t KSTEP = 64 * 128, VSTEP = 64 * 256;
    stage_tile(lds, 0, kbase, vbase, tid, wid);
    VM_WAIT(); WG_BAR();
    for (int j = 0; j < NT; j += 2) {
        stage_tile(lds, 1, kbase + (size_t)(j + 1) * KSTEP, vbase + (size_t)(j + 1) * VSTEP, tid, wid);
        if (j < myNT) { if (j > 0) m_reg -= sh64; tile_compute<0>(lds, r32, hi, vb0, al_l, qr, o, m_reg, l_reg, rawu, sl2, j == myNT - 1, qi); }
        VM_WAIT(); WG_BAR();
        if (j + 2 < NT) stage_tile(lds, 0, kbase + (size_t)(j + 2) * KSTEP, vbase + (size_t)(j + 2) * VSTEP, tid, wid);
        if (j + 1 < myNT) { m_reg -= sh64; tile_compute<1>(lds, r32, hi, vb0, al_l, qr, o, m_reg, l_reg, rawu, sl2, j + 1 == myNT - 1, qi); }
        VM_WAIT(); WG_BAR();
    }
    if (hi == 0) li_l[r32] = l_reg;
    LDS_WAIT();
    char* Ow = (char*)(oout + tokq * D + h * 256);
    const unsigned lofs = (unsigned)(hi * 4 * D + r32) * 2u;
#pragma unroll
    for (int r = 0; r < 16; ++r) { const float rl = __builtin_amdgcn_rcpf(li_l[crow(r, hi)]);
#pragma unroll
        for (int d0 = 0; d0 < 8; ++d0) { const float v = o[d0][r] * rl; const float vn = __shfl_xor(v, 1);
            if ((r32 & 1) == 0) *(unsigned*)(Ow + (lofs + (unsigned)((((r & 3) + 8 * (r >> 2)) * D + d0 * 32) * 2))) = cvt_pk_bf16(v, vn); } }
    WG_BAR();
}

__device__ __forceinline__ void attn_phase(Frame& F, const bf16_t* proj, bf16_t* o1, bf16_t* o2) {
    for (int r = 0; ; ++r) {
        int I;
        if (F.G == 256) { if (r >= 4) break; I = (F.vcu >> 5) * 128 + r * 32 + (F.vcu & 31); }
        else { I = r * F.G + F.vcu; if (I >= 1024) break; }
        const int bh = I >> 6, sub = (I >> 5) & 1, pi = I & 31, b = bh >> 3, h = bh & 7;
        bf16_t* oo = sub ? o2 : o1;
        for (int pass = 0; pass < 2; ++pass) attn_item(F.lds, proj, oo, b, h, sub, pass ? pi : 63 - pi, F.tid, F.wave, F.lane);
    }
}
}

__global__ void __launch_bounds__(NWAVES * 64, 2) hybrid_fwd(Args args) {
    extern __shared__ __attribute__((aligned(16))) unsigned char lds_raw[];
    Frame F;
    F.lds = (LAS unsigned char*)lds_raw;
    F.tid = threadIdx.x; F.lane = F.tid & 63; F.wave = __builtin_amdgcn_readfirstlane(F.tid >> 6);
    F.G = gridDim.x; { const int bx = blockIdx.x; F.vcu = (F.G % 8 == 0) ? (bx % 8) * (F.G / 8) + bx / 8 : bx; }
    unsigned char* ws = args.ws;
    unsigned* ctl = (unsigned*)(ws + WS_CTL);
    for (int u = F.tid; u < (LDS_BYTES - LDSCTL_OFF) / 4; u += NWAVES * 64) ((LAS unsigned*)(F.lds + LDSCTL_OFF))[u] = 0u;
    __syncthreads();
    volatile LAS unsigned* MISC = (volatile LAS unsigned*)(F.lds + MISC_OFF);
    XcdBarrier bar = xcd_barrier_post(ctl + CW_BAR, MISC + 8);
#define GRID_BAR() xcd_barrier(bar)
#ifdef ONLY_PHASE
#define PHON(n) ((n) == ONLY_PHASE)
#elif DIAG
#define PHON(n) ((n) <= args.upto)
#else
#define PHON(n) 1
#endif

    const float* x_in = args.in[0]; const float* norm_mix = args.in[1]; const float* norm_ffn = args.in[2];
    const float* gla_w_in = args.in[3]; const float* gla_wgu = args.in[4]; const float* gla_bg = args.in[5]; const float* gla_norm = args.in[6]; const float* gla_w_out = args.in[7];
    const float* diff_w_in = args.in[8]; const float* lq1 = args.in[9]; const float* lk1 = args.in[10]; const float* lq2 = args.in[11]; const float* lk2 = args.in[12];
    const float* diff_subln = args.in[13]; const float* diff_w_out = args.in[14];
    const float* moe_wgrp = args.in[15]; const float* moe_wexp = args.in[16]; const float* moe_wg = args.in[17]; const float* moe_wu = args.in[18]; const float* moe_wd = args.in[19];
    const float* final_norm = args.in[20];
    float* xres = args.out;
    float* gz = (float*)(ws + WS_GZ);
    int* tok_e = (int*)(ws + WS_TOKE); int* tok_p = (int*)(ws + WS_TOKP); float* tok_w = (float*)(ws + WS_TOKW); int* slot_of = (int*)(ws + WS_SLOT);
    float* adec = (float*)(ws + WS_ADEC);
    float* wp_gz = (float*)(ws + WS_WPGZ); float* wp_r0 = (float*)(ws + WS_WPR0); float* wp_r1 = (float*)(ws + WS_WPR1);
    bf16_t* wgi = (bf16_t*)(ws + WS_WGI); bf16_t* wgo = (bf16_t*)(ws + WS_WGO); bf16_t* wdi = (bf16_t*)(ws + WS_WDI); bf16_t* wdo = (bf16_t*)(ws + WS_WDO);
    bf16_t* wmoe_gu = (bf16_t*)(ws + WS_WMOE); bf16_t* wmoe_d = (bf16_t*)(ws + WS_WMOE_D);
    bf16_t* hn = (bf16_t*)(ws + WS_HN); bf16_t* proj = (bf16_t*)(ws + WS_PROJ); bf16_t* buf1 = (bf16_t*)(ws + WS_BUF1); bf16_t* buf2 = (bf16_t*)(ws + WS_BUF2);
    bf16_t* ag = (bf16_t*)(ws + WS_AG); bf16_t* ob = (bf16_t*)(ws + WS_OB); bf16_t* hh = (bf16_t*)(ws + WS_H);
    const LAS int* pst = (const LAS int*)(F.lds + TAB_OFF);

    _Pragma("unroll") for (int rep_ = 0; rep_ < (REP_PHASE == 0 ? 2 : 1); ++rep_) if (PHON(0)) { if (rep_) GRID_BAR(); Frame P = F; P.tid = opq(F.tid); P.lane = P.tid & 63;
    conv_plain(P, gla_w_in, D, PROJW, GLA_INW, wgi);
    conv_plain(P, gla_w_out, D, D, D, wgo);
    conv_plain(P, diff_w_in, D, PROJW, PROJW, wdi);
    conv_plain(P, diff_w_out, D, D, D, wdo);
    conv_moe(P, moe_wg, moe_wu, moe_wd, wmoe_gu, wmoe_d);
    pack_proj(P, wp_gz, 1, norm_mix, gla_w_in, GLA_INW, PROJW, 16, nullptr, 0, 0);
    pack_proj(P, wp_r0, 3, norm_ffn, moe_wgrp, 4, 0, 4, moe_wexp, 32, 32);
    pack_proj(P, wp_r1, 3, norm_ffn + D, moe_wgrp + (size_t)D * 4, 4, 0, 4, moe_wexp + (size_t)D * 32, 32, 32);
    }
    GRID_BAR();
    _Pragma("unroll") for (int rep_ = 0; rep_ < (REP_PHASE == 1 ? 2 : 1); ++rep_) if (PHON(1)) { if (rep_) GRID_BAR(); Frame P = F; P.tid = opq(F.tid); P.lane = P.tid & 63;
    phase_norm_gz(P, x_in, norm_mix, wp_gz, hn, gz);
    }
    GRID_BAR();
    _Pragma("unroll") for (int rep_ = 0; rep_ < (REP_PHASE == 2 ? 2 : 1); ++rep_) if (PHON(2)) { if (rep_) GRID_BAR(); Frame P = F; P.tid = opq(F.tid); P.lane = P.tid & 63;
    { pg8::Gemm g{hn, wgi, T, PROJW, D}; pg8::StaticOrder S; S.init(T, PROJW, P.G, (int)blockIdx.x); pg8::EpiHeads<0> E{proj};
      pg8::gemm_phase<pg8::EpiHeads<0>, pg8::StaticOrder>(P.lds, g, S, E); }
    }
    GRID_BAR();
    _Pragma("unroll") for (int rep_ = 0; rep_ < (REP_PHASE == 3 ? 2 : 1); ++rep_) if (PHON(3)) { if (rep_) GRID_BAR(); Frame P = F; P.tid = opq(F.tid); P.lane = P.tid & 63;
    phase_gla_gate(P, gz, gla_wgu, gla_bg, proj, buf1, adec);
    }
    GRID_BAR();
    _Pragma("unroll") for (int rep_ = 0; rep_ < (REP_PHASE == 4 ? 2 : 1); ++rep_) if (PHON(4)) { if (rep_) GRID_BAR(); Frame P = F; P.tid = opq(F.tid); P.lane = P.tid & 63;
    phase_gla_scan(P, proj, buf1, adec, buf2);
    }
    GRID_BAR();
    _Pragma("unroll") for (int rep_ = 0; rep_ < (REP_PHASE == 5 ? 2 : 1); ++rep_) if (PHON(5)) { if (rep_) GRID_BAR(); Frame P = F; P.tid = opq(F.tid); P.lane = P.tid & 63;
    phase_gla_gnorm(P, buf2, proj, gla_norm, hn);
    }
    GRID_BAR();
    _Pragma("unroll") for (int rep_ = 0; rep_ < (REP_PHASE == 6 ? 2 : 1); ++rep_) if (PHON(6)) { if (rep_) GRID_BAR(); Frame P = F; P.tid = opq(F.tid); P.lane = P.tid & 63;
    { pg8::Gemm g{hn, wgo, T, D, D}; pg8::StaticOrder S; S.init(T, D, P.G, (int)blockIdx.x); pg8::EpiResF32 E{x_in, xres, D};
      pg8::gemm_phase<pg8::EpiResF32, pg8::StaticOrder>(P.lds, g, S, E); }
    }
    GRID_BAR();
    _Pragma("unroll") for (int rep_ = 0; rep_ < (REP_PHASE == 7 ? 2 : 1); ++rep_) if (PHON(7)) { if (rep_) GRID_BAR(); Frame P = F; P.tid = opq(F.tid); P.lane = P.tid & 63;
    phase_norm_route(P, xres, norm_ffn, wp_r0, hn, tok_e, tok_p, tok_w, ctl + CW_CNT0);
    }
    GRID_BAR();
    _Pragma("unroll") for (int rep_ = 0; rep_ < (REP_PHASE == 8 ? 2 : 1); ++rep_) if (PHON(8)) { if (rep_) GRID_BAR(); Frame P = F; P.tid = opq(F.tid); P.lane = P.tid & 63;
    moe_tables(P, ctl + CW_CNT0);
    phase_moe_gather(P, tok_e, tok_p, slot_of, hn, ag);
    }
    GRID_BAR();
    _Pragma("unroll") for (int rep_ = 0; rep_ < (REP_PHASE == 9 ? 2 : 1); ++rep_) if (PHON(9)) { if (rep_) GRID_BAR(); Frame P = F; P.tid = opq(F.tid); P.lane = P.tid & 63;
    { const int Mr = pst[33] * 256; pg8::Gemm g{ag, wmoe_gu, Mr, 1024, D}; pg8::MoeOrder S; S.init(Mr, 1024, P.G, (int)blockIdx.x); S.te = pst + 36; S.estride = (size_t)1024 * D * 2; pg8::EpiSiluMul E{hh};
      pg8::gemm_phase<pg8::EpiSiluMul, pg8::MoeOrder>(P.lds, g, S, E); }
    }
    GRID_BAR();
    _Pragma("unroll") for (int rep_ = 0; rep_ < (REP_PHASE == 10 ? 2 : 1); ++rep_) if (PHON(10)) { if (rep_) GRID_BAR(); Frame P = F; P.tid = opq(F.tid); P.lane = P.tid & 63;
    { const int Mr = pst[33] * 256; pg8::Gemm g{hh, wmoe_d, Mr, D, DFF}; pg8::MoeOrder S; S.init(Mr, D, P.G, (int)blockIdx.x); S.te = pst + 36; S.estride = (size_t)D * DFF * 2; pg8::EpiBf16 E{ob, D};
      pg8::gemm_phase<pg8::EpiBf16, pg8::MoeOrder>(P.lds, g, S, E); }
    }
    GRID_BAR();
    _Pragma("unroll") for (int rep_ = 0; rep_ < (REP_PHASE == 11 ? 2 : 1); ++rep_) if (PHON(11)) { if (rep_) GRID_BAR(); Frame P = F; P.tid = opq(F.tid); P.lane = P.tid & 63;
    phase_moe_combine<0>(P, xres, ob, slot_of, tok_w, norm_mix + D, hn);
    conv_moe(P, moe_wg + (size_t)NEXP * D * DFF, moe_wu + (size_t)NEXP * D * DFF, moe_wd + (size_t)NEXP * DFF * D, wmoe_gu, wmoe_d);
    }
    GRID_BAR();
    _Pragma("unroll") for (int rep_ = 0; rep_ < (REP_PHASE == 12 ? 2 : 1); ++rep_) if (PHON(12)) { if (rep_) GRID_BAR(); Frame P = F; P.tid = opq(F.tid); P.lane = P.tid & 63;
    { pg8::Gemm g{hn, wdi, T, PROJW, D}; pg8::StaticOrder S; S.init(T, PROJW, P.G, (int)blockIdx.x); pg8::EpiHeads<1> E{proj};
      pg8::gemm_phase<pg8::EpiHeads<1>, pg8::StaticOrder>(P.lds, g, S, E); }
    }
    GRID_BAR();
    _Pragma("unroll") for (int rep_ = 0; rep_ < (REP_PHASE == 13 ? 2 : 1); ++rep_) if (PHON(13)) { if (rep_) GRID_BAR(); Frame P = F; P.tid = opq(F.tid); P.lane = P.tid & 63;
    att::attn_phase(P, proj, buf1, buf2);
    }
    GRID_BAR();
    _Pragma("unroll") for (int rep_ = 0; rep_ < (REP_PHASE == 14 ? 2 : 1); ++rep_) if (PHON(14)) { if (rep_) GRID_BAR(); Frame P = F; P.tid = opq(F.tid); P.lane = P.tid & 63;
    phase_subln(P, buf1, buf2, lq1, lk1, lq2, lk2, diff_subln, hn);
    }
    GRID_BAR();
    _Pragma("unroll") for (int rep_ = 0; rep_ < (REP_PHASE == 15 ? 2 : 1); ++rep_) if (PHON(15)) { if (rep_) GRID_BAR(); Frame P = F; P.tid = opq(F.tid); P.lane = P.tid & 63;
    { pg8::Gemm g{hn, wdo, T, D, D}; pg8::StaticOrder S; S.init(T, D, P.G, (int)blockIdx.x); pg8::EpiResF32 E{xres, xres, D};
      pg8::gemm_phase<pg8::EpiResF32, pg8::StaticOrder>(P.lds, g, S, E); }
    }
    GRID_BAR();
    _Pragma("unroll") for (int rep_ = 0; rep_ < (REP_PHASE == 16 ? 2 : 1); ++rep_) if (PHON(16)) { if (rep_) GRID_BAR(); Frame P = F; P.tid = opq(F.tid); P.lane = P.tid & 63;
    phase_norm_route(P, xres, norm_ffn + D, wp_r1, hn, tok_e, tok_p, tok_w, ctl + CW_CNT1);
    }
    GRID_BAR();
    _Pragma("unroll") for (int rep_ = 0; rep_ < (REP_PHASE == 17 ? 2 : 1); ++rep_) if (PHON(17)) { if (rep_) GRID_BAR(); Frame P = F; P.tid = opq(F.tid); P.lane = P.tid & 63;
    moe_tables(P, ctl + CW_CNT1);
    phase_moe_gather(P, tok_e, tok_p, slot_of, hn, ag);
    }
    GRID_BAR();
    _Pragma("unroll") for (int rep_ = 0; rep_ < (REP_PHASE == 18 ? 2 : 1); ++rep_) if (PHON(18)) { if (rep_) GRID_BAR(); Frame P = F; P.tid = opq(F.tid); P.lane = P.tid & 63;
    { const int Mr = pst[33] * 256; pg8::Gemm g{ag, wmoe_gu, Mr, 1024, D}; pg8::MoeOrder S; S.init(Mr, 1024, P.G, (int)blockIdx.x); S.te = pst + 36; S.estride = (size_t)1024 * D * 2; pg8::EpiSiluMul E{hh};
      pg8::gemm_phase<pg8::EpiSiluMul, pg8::MoeOrder>(P.lds, g, S, E); }
    }
    GRID_BAR();
    _Pragma("unroll") for (int rep_ = 0; rep_ < (REP_PHASE == 19 ? 2 : 1); ++rep_) if (PHON(19)) { if (rep_) GRID_BAR(); Frame P = F; P.tid = opq(F.tid); P.lane = P.tid & 63;
    { const int Mr = pst[33] * 256; pg8::Gemm g{hh, wmoe_d, Mr, D, DFF}; pg8::MoeOrder S; S.init(Mr, D, P.G, (int)blockIdx.x); S.te = pst + 36; S.estride = (size_t)D * DFF * 2; pg8::EpiBf16 E{ob, D};
      pg8::gemm_phase<pg8::EpiBf16, pg8::MoeOrder>(P.lds, g, S, E); }
    }
    GRID_BAR();
    _Pragma("unroll") for (int rep_ = 0; rep_ < (REP_PHASE == 20 ? 2 : 1); ++rep_) if (PHON(20)) { if (rep_) GRID_BAR(); Frame P = F; P.tid = opq(F.tid); P.lane = P.tid & 63;
    phase_moe_combine<1>(P, xres, ob, slot_of, tok_w, final_norm, hn);
    }
}

#if DIAG
constexpr size_t WS_DIAG = WS_END;
constexpr int NSAVE = 64;
__device__ inline unsigned hsh(unsigned x) { x ^= x >> 16; x *= 0x7feb352dU; x ^= x >> 15; x *= 0x846ca68bU; x ^= x >> 16; return x; }
__device__ inline void rep(unsigned* w, double got, double ref, double scale) { double e = fabs(got - ref) / (fabs(ref) + scale); float ef = (float)e; if (!(ef == ef) || ef > 1e30f) ef = 1e30f; atomicMax(w, __float_as_uint(ef)); }
__device__ inline double bfd(bf16_t v) { return (double)bf2f(v); }
#define GTID (blockIdx.x * blockDim.x + threadIdx.x)
#define GSTR (gridDim.x * blockDim.x)

__global__ void ck_weights(const float* gla_w_in, const float* gla_w_out, const float* diff_w_in, const float* diff_w_out, const bf16_t* wgi, const bf16_t* wgo, const bf16_t* wdi, const bf16_t* wdo,
                           const float* norm_mix, const float* norm_ffn, const float* wgrp, const float* wexp, const float* wp_gz, const float* wp_r0, const float* wp_r1, unsigned* w) {
    for (unsigned i = GTID; i < 65536u; i += GSTR) { const unsigned r = hsh(i * 3u + 1u), r2 = hsh(i * 7u + 5u);
        const int n = r % 6144u, k = r2 % 2048u, n2 = n % 2048;
        rep(w, bfd(wgi[(size_t)n * D + k]), gla_w_in[(size_t)k * GLA_INW + n], 0.02); rep(w, bfd(wdi[(size_t)n * D + k]), diff_w_in[(size_t)k * PROJW + n], 0.02);
        rep(w, bfd(wgo[(size_t)n2 * D + k]), gla_w_out[(size_t)k * D + n2], 0.02); rep(w, bfd(wdo[(size_t)n2 * D + k]), diff_w_out[(size_t)k * D + n2], 0.02);
        const int s = r % 128u, ln = (r >> 7) % 64u, e4 = (r >> 13) & 3, kk = 16 * s + 4 * (ln >> 4) + e4, col = ln & 15, nt = (r >> 15) % 3u, col3 = 16 * nt + col;
        rep(w, wp_gz[(s * 64 + ln) * 4 + e4], (double)norm_mix[kk] * gla_w_in[(size_t)kk * GLA_INW + PROJW + col], 0.02);
        for (int L = 0; L < 2; ++L) { const float* gr = wgrp + (size_t)L * D * 4; const float* ex = wexp + (size_t)L * D * 32; const float* nf = norm_ffn + L * D;
            const double ref = col3 < 4 ? gr[kk * 4 + col3] : (col3 < 36 ? ex[kk * 32 + col3 - 4] : 0.0);
            rep(w, (L ? wp_r1 : wp_r0)[((s * 3 + nt) * 64 + ln) * 4 + e4], (double)nf[kk] * ref, 0.02); } }
}
__global__ void ck_moew(const float* wg, const float* wu, const float* wd, const bf16_t* GU, const bf16_t* DT, unsigned* w) {
    for (unsigned i = GTID; i < 65536u; i += GSTR) { const unsigned r = hsh(i * 5u + 2u), r2 = hsh(i * 11u + 3u);
        const int e = r % 32u, f = (r >> 5) % 512u, k = r2 % 2048u, n2 = (r2 >> 11) % 2048u, rowg = 256 * (f >> 7) + (f & 127);
        rep(w, bfd(GU[((size_t)e * 1024 + rowg) * D + k]), wg[((size_t)e * D + k) * DFF + f], 0.02); rep(w, bfd(GU[((size_t)e * 1024 + rowg + 128) * D + k]), wu[((size_t)e * D + k) * DFF + f], 0.02);
        rep(w, bfd(DT[((size_t)e * D + n2) * DFF + f]), wd[((size_t)e * DFF + f) * D + n2], 0.05); }
}
__global__ void ck_norm(const float* x, const float* gain, const bf16_t* hn, unsigned* w) {
    for (unsigned i = GTID; i < 4096u; i += GSTR) { const unsigned r = hsh(i * 13u + 7u); const int t = r % (unsigned)T, j = (r >> 15) % 2048u;
        double ss = 0; for (int k = 0; k < D; ++k) { const double v = x[(size_t)t * D + k]; ss += v * v; }
        const double rstd = 1.0 / sqrt(ss / D + 1e-6); rep(w, bfd(hn[(size_t)t * D + j]), x[(size_t)t * D + j] * rstd * gain[j], 1.0); }
}
__global__ void ck_gz(const float* x, const float* gain, const float* gla_w_in, const float* gz, unsigned* w) {
    for (unsigned i = GTID; i < 4096u; i += GSTR) { const unsigned r = hsh(i * 17u + 9u); const int t = r % (unsigned)T, c = (r >> 15) % 16u;
        double ss = 0, dot = 0; for (int k = 0; k < D; ++k) { const double v = x[(size_t)t * D + k]; ss += v * v; dot += v * gain[k] * gla_w_in[(size_t)k * GLA_INW + PROJW + c]; }
        rep(w, gz[(size_t)t * 16 + c], dot / sqrt(ss / D + 1e-6), 1.0); }
}
__global__ void ck_gemm(const bf16_t* A, const bf16_t* Bt, const bf16_t* C, int M, int N, int K, int ldc, double scale, unsigned* w) {
    for (unsigned i = GTID; i < 16384u; i += GSTR) { const unsigned r = hsh(i * 19u + 11u), r2 = hsh(i * 23u + 1u); const int m = r % (unsigned)M, n = r2 % (unsigned)N;
        double s = 0; for (int k = 0; k < K; ++k) s += bfd(A[(size_t)m * K + k]) * bfd(Bt[(size_t)n * K + k]);
        rep(w, bfd(C[(size_t)m * ldc + n]), s, scale); }
}
__global__ void ck_proj(const bf16_t* A, const bf16_t* Bt, const bf16_t* proj, int layer, unsigned* w) {
    for (unsigned i = GTID; i < 16384u; i += GSTR) { const unsigned r = hsh(i * 19u + 11u), r2 = hsh(i * 23u + 1u); const int m = r % (unsigned)T, n = r2 % (unsigned)PROJW, b = m >> 14, t = m & (SEQ - 1);
        double s = 0; for (int k = 0; k < D; ++k) s += bfd(A[(size_t)m * D + k]) * bfd(Bt[(size_t)n * D + k]);
        size_t off;
        if (layer == 0) { if (n < 1024) off = gq_off(b, t, n >> 8) + (n & 255); else if (n < 2048) off = GK0 + gq_off(b, t, (n - 1024) >> 8) + (n & 255); else if (n < 4096) off = gv_off(b, t, (n - 2048) >> 9) + (n & 511); else off = GR0 + (size_t)m * 2048 + (n - 4096); }
        else { if (n < 2048) off = dq_off(b, t, n >> 8, (n >> 7) & 1) + (n & 127); else if (n < 4096) off = DK0 + dq_off(b, t, (n - 2048) >> 8, (n >> 7) & 1) + (n & 127); else off = dv_off(b, t, (n - 4096) >> 8) + (n & 255); }
        rep(w, bfd(proj[off]), s, 1.0); }
}
__device__ inline int srow(int i) { return (int)(hsh(i * 29u + 13u) % (unsigned)T); }
__global__ void ck_save(const float* x, float* save) { for (unsigned i = GTID; i < (unsigned)NSAVE * D; i += GSTR) save[i] = x[(size_t)srow(i / D) * D + (i % D)]; }
__global__ void ck_gemm_res(const bf16_t* A, const bf16_t* Bt, const float* base, int saved, const float* out, unsigned* w) {
    for (unsigned i = GTID; i < (unsigned)NSAVE * 64u; i += GSTR) { const int si = i / 64, t = srow(si), n = hsh(i * 31u + 5u) % 2048u;
        double s = 0; for (int k = 0; k < D; ++k) s += bfd(A[(size_t)t * D + k]) * bfd(Bt[(size_t)n * D + k]);
        const double b = saved ? base[(size_t)si * D + n] : base[(size_t)t * D + n];
        rep(w, out[(size_t)t * D + n], b + s, 1.0); }
}
__global__ void ck_gate(const float* gz, const float* wgu, const float* bg, const bf16_t* proj, const bf16_t* kdT, const float* adec, unsigned* w) {
    for (unsigned i = GTID; i < 4096u; i += GSTR) { const unsigned r = hsh(i * 37u + 3u); const int bc = r % 512u, j = (r >> 9) % 1024u, tq = (r >> 19) % 64u;
        double run = 0, ct = 0;
        for (int t = 0; t < 64; ++t) { double z = bg[j]; for (int q = 0; q < 16; ++q) z += (double)gz[((size_t)bc * 64 + t) * 16 + q] * wgu[q * 1024 + j];
            const double ls = fmin(z, 0.0) - log1p(exp(-fabs(z))); run += ls / 16.0; if (t == tq) ct = run; }
        rep(w, adec[(size_t)bc * 1024 + j], exp(run), 1.0);
        rep(w, bfd(kdT[((size_t)bc * 1024 + j) * 64 + tq]), bfd(proj[GK0 + gq_off(bc >> 8, (bc & 255) * 64 + tq, j >> 8) + (j & 255)]) * exp(run - ct), 1.0); }
}
__global__ void ck_scan(const bf16_t* proj, const bf16_t* kdT, const float* adec, const bf16_t* o, unsigned* w) {
    const int wv = GTID / 64, lane = threadIdx.x & 63, nw = GSTR / 64;
    const int cl[8] = {0, 1, 3, 17, 100, 255, 2, 64};
    for (int s = wv; s < 96; s += nw) { const unsigned r = hsh(s * 41u + 17u); const int b = r & 1, c = cl[s % 8], tl = (r >> 1) % 64u, h = (r >> 7) % 4u, vc = (r >> 9) % 512u;
        float S[4] = {0.f, 0.f, 0.f, 0.f};
        for (int cc = 0; cc <= c; ++cc) { const size_t bc = (size_t)b * NCH + cc;
            for (int q = 0; q < 4; ++q) { const int kr = h * 256 + lane * 4 + q; float a = 0.f;
                for (int t = 0; t < 64; ++t) a += bf2f(kdT[(bc * 1024 + kr) * 64 + t]) * bf2f(proj[gv_off(b, cc * 64 + t, h) + vc]);
                S[q] = adec[bc * 1024 + kr] * S[q] + a; } }
        float part = 0.f; const size_t tok = (size_t)b * SEQ + c * 64 + tl;
        for (int q = 0; q < 4; ++q) part += bf2f(proj[gq_off(b, c * 64 + tl, h) + lane * 4 + q]) * S[q];
        for (int of = 1; of < 64; of <<= 1) part += __shfl_xor(part, of);
        if (lane == 0) rep(w, bfd(o[tok * D + h * 512 + vc]), part / 16.0, 2.0); }
}
__global__ void ck_gnorm(const bf16_t* o, const bf16_t* proj, const float* gn, const bf16_t* y, unsigned* w) {
    for (unsigned i = GTID; i < 8192u; i += GSTR) { const unsigned r = hsh(i * 43u + 19u); const int t = r % (unsigned)T, h = (r >> 15) % 4u, j = (r >> 17) % 512u;
        double ss = 0; for (int k = 0; k < 512; ++k) { const double v = bfd(o[(size_t)t * D + h * 512 + k]); ss += v * v; }
        const double rr = bfd(proj[GR0 + (size_t)t * 2048 + h * 512 + j]);
        rep(w, bfd(y[(size_t)t * D + h * 512 + j]), bfd(o[(size_t)t * D + h * 512 + j]) / sqrt(ss / 512 + 1e-6) * gn[j] * rr / (1.0 + exp(-rr)), 1.0); }
}
__global__ void ck_route(const float* x, const float* gain, const float* wgrp, const float* wexp, const int* tok_e, const int* tok_p, const float* tok_w, const unsigned* cnt, unsigned* w) {
    for (unsigned i = GTID; i < 512u; i += GSTR) { const int t = hsh(i * 47u + 23u) % (unsigned)T;
        double ss = 0; for (int k = 0; k < D; ++k) { const double v = x[(size_t)t * D + k]; ss += v * v; }
        const double rstd = 1.0 / sqrt(ss / D + 1e-6);
        double gl[4] = {0, 0, 0, 0};
        for (int k = 0; k < D; ++k) { const double v = x[(size_t)t * D + k] * rstd * gain[k]; for (int q = 0; q < 4; ++q) gl[q] += v * wgrp[k * 4 + q]; }
        int gi = 0; for (int q = 1; q < 4; ++q) if (gl[q] > gl[gi]) gi = q;
        double gs = 0; for (int q = 0; q < 4; ++q) gs += exp(gl[q] - gl[gi]);
        double el[8] = {0, 0, 0, 0, 0, 0, 0, 0};
        for (int k = 0; k < D; ++k) { const double v = x[(size_t)t * D + k] * rstd * gain[k]; for (int q = 0; q < 8; ++q) el[q] += v * wexp[k * 32 + gi * 8 + q]; }
        int i1 = 0; for (int q = 1; q < 8; ++q) if (el[q] > el[i1]) i1 = q;
        int i2 = (i1 == 0) ? 1 : 0; for (int q = 0; q < 8; ++q) if (q != i1 && el[q] > el[i2]) i2 = q;
        const double eb = exp(el[i2] - el[i1]);
        const int e1 = tok_e[2 * t], e2 = tok_e[2 * t + 1];
        double third = -1e30; for (int q = 0; q < 8; ++q) if (q != i1 && q != i2 && el[q] > third) third = el[q];
        const bool tie = (el[i2] - third) < 1e-4 || (el[i1] - el[i2]) < 1e-4;
        if (!tie) { rep(w, e1, gi * 8 + i1, 1.0); rep(w, e2, gi * 8 + i2, 1.0);
            rep(w, tok_w[2 * t], 1.0 / gs / (1.0 + eb), 0.3); rep(w, tok_w[2 * t + 1], eb / gs / (1.0 + eb), 0.3); }
        if ((unsigned)tok_p[2 * t] >= cnt[64 * (e1 & 31)] || (unsigned)tok_p[2 * t + 1] >= cnt[64 * (e2 & 31)]) rep(w, 9.0, 0.0, 1.0); }
}
__global__ void ck_gather(const int* tok_e, const int* tok_p, const int* slot_of, const unsigned* cnt, const bf16_t* hn, const bf16_t* ag, unsigned* w) {
    for (unsigned i = GTID; i < 8192u; i += GSTR) { const unsigned r = hsh(i * 53u + 29u); const int a = r % (2u * T), k = (r >> 16) % 2048u, e = tok_e[a] & 31;
        int ps = 0; for (int q = 0; q < e; ++q) ps += ((int)cnt[64 * q] + 255) & ~255;
        const int slot = slot_of[a];
        rep(w, slot, ps + tok_p[a], 1.0);
        if (slot >= 0 && slot < MAX_TILES * 256) rep(w, bfd(ag[(size_t)slot * D + k]), bfd(hn[(size_t)(a >> 1) * D + k]), 1.0); }
}
__global__ void ck_moe1(const int* tok_e, const int* slot_of, const bf16_t* ag, const float* wg, const float* wu, const bf16_t* hh, unsigned* w) {
    for (unsigned i = GTID; i < 8192u; i += GSTR) { const unsigned r = hsh(i * 59u + 31u); const int a = r % (2u * T), f = (r >> 16) % 512u, e = tok_e[a] & 31, slot = slot_of[a];
        if (slot < 0 || slot >= MAX_TILES * 256) { rep(w, 9.0, 0.0, 1.0); continue; }
        double g = 0, u = 0; for (int k = 0; k < D; ++k) { const double v = bfd(ag[(size_t)slot * D + k]); g += v * wg[((size_t)e * D + k) * DFF + f]; u += v * wu[((size_t)e * D + k) * DFF + f]; }
        rep(w, bfd(hh[(size_t)slot * DFF + f]), g / (1.0 + exp(-g)) * u, 0.5); }
}
__global__ void ck_moe2(const int* tok_e, const int* slot_of, const bf16_t* hh, const float* wd, const bf16_t* ob, unsigned* w) {
    for (unsigned i = GTID; i < 8192u; i += GSTR) { const unsigned r = hsh(i * 61u + 37u); const int a = r % (2u * T), n = (r >> 16) % 2048u, e = tok_e[a] & 31, slot = slot_of[a];
        if (slot < 0 || slot >= MAX_TILES * 256) { rep(w, 9.0, 0.0, 1.0); continue; }
        double s = 0; for (int f = 0; f < DFF; ++f) s += bfd(hh[(size_t)slot * DFF + f]) * wd[((size_t)e * DFF + f) * D + n];
        rep(w, bfd(ob[(size_t)slot * D + n]), s, 0.3); }
}
__global__ void ck_combine(const float* save, const bf16_t* ob, const int* slot_of, const float* tok_w, const float* gain, const float* x, const bf16_t* hn, int mode, unsigned* w) {
    for (unsigned i = GTID; i < (unsigned)NSAVE * 32u; i += GSTR) { const int si = i / 32, t = srow(si), j = hsh(i * 67u + 41u) % 2048u;
        const int s0 = slot_of[2 * t], s1 = slot_of[2 * t + 1]; const double w0 = tok_w[2 * t], w1 = tok_w[2 * t + 1];
        double ss = 0, xj = 0; for (int k = 0; k < D; ++k) { const double v = save[(size_t)si * D + k] + w0 * bfd(ob[(size_t)s0 * D + k]) + w1 * bfd(ob[(size_t)s1 * D + k]); ss += v * v; if (k == j) xj = v; }
        const double y = xj / sqrt(ss / D + 1e-6) * gain[j];
        if (mode == 0) { rep(w, x[(size_t)t * D + j], xj, 1.0); rep(w, bfd(hn[(size_t)t * D + j]), y, 1.0); } else rep(w, x[(size_t)t * D + j], y, 1.0); }
}
__global__ void ck_attn(const bf16_t* proj, const bf16_t* o1, const bf16_t* o2, unsigned* w) {
    const int wv = GTID / 64, lane = threadIdx.x & 63, nw = GSTR / 64;
    const int tl[12] = {0, 1, 63, 64, 100, 255, 256, 1000, 4095, 8191, 16320, 16383};
    for (int s = wv; s < 96; s += nw) { const unsigned r = hsh(s * 71u + 43u); const int b = r & 1, h = (r >> 1) % 8u, sub = (r >> 4) & 1, t = tl[s % 12], dv0 = (r >> 5) % 253u;
        const double slope = exp2(-(double)(h + 1)); const int kend = 64 * (t / 64 + 1);
        const bf16_t* qp = proj + dq_off(b, t, h, sub);
        double mx = -1e300;
        for (int j = lane; j < kend; j += 64) { const bf16_t* kp = proj + DK0 + dq_off(b, j, h, sub); double d = 0; for (int q = 0; q < 128; ++q) d += bfd(qp[q]) * bfd(kp[q]);
            const double sc = d * 0.08838834764831845 - slope * fabs((double)(t - j)); if (sc > mx) mx = sc; }
        for (int of = 1; of < 64; of <<= 1) { const double o_ = __shfl_xor(mx, of); if (o_ > mx) mx = o_; }
        double l = 0, acc[4] = {0, 0, 0, 0};
        for (int j = lane; j < kend; j += 64) { const bf16_t* kp = proj + DK0 + dq_off(b, j, h, sub); double d = 0; for (int q = 0; q < 128; ++q) d += bfd(qp[q]) * bfd(kp[q]);
            const double p = exp(d * 0.08838834764831845 - slope * fabs((double)(t - j)) - mx); l += p;
            const bf16_t* vp = proj + dv_off(b, j, h) + dv0; for (int q = 0; q < 4; ++q) acc[q] += p * bfd(vp[q]); }
        for (int of = 1; of < 64; of <<= 1) { l += __shfl_xor(l, of); for (int q = 0; q < 4; ++q) acc[q] += __shfl_xor(acc[q], of); }
        if (lane == 0) for (int q = 0; q < 4; ++q) rep(w, bfd((sub ? o2 : o1)[((size_t)b * SEQ + t) * D + h * 256 + dv0 + q]), acc[q] / l, 0.2); }
}
__global__ void ck_subln(const bf16_t* o1, const bf16_t* o2, const float* lq1, const float* lk1, const float* lq2, const float* lk2, const float* sg, const bf16_t* y, unsigned* w) {
    double d1 = 0, d2 = 0; for (int k = 0; k < 128; ++k) { d1 += (double)lq1[k] * lk1[k]; d2 += (double)lq2[k] * lk2[k]; }
    const double li = 0.8 - 0.6 * exp(-0.3), lam = exp(d1) - exp(d2) + li;
    for (unsigned i = GTID; i < 8192u; i += GSTR) { const unsigned r = hsh(i * 73u + 47u); const int t = r % (unsigned)T, h = (r >> 15) % 8u, j = (r >> 18) % 256u;
        double ss = 0, dj = 0; for (int k = 0; k < 256; ++k) { const double v = bfd(o1[(size_t)t * D + h * 256 + k]) - lam * bfd(o2[(size_t)t * D + h * 256 + k]); ss += v * v; if (k == j) dj = v; }
        rep(w, bfd(y[(size_t)t * D + h * 256 + j]), dj / sqrt(ss / 256 + 1e-6) * sg[j] * (1.0 - li), 1.0); }
}
__global__ void ck_final(const unsigned* words, int nst, float* out, int n) {
    int val = 0;
    for (int s = 0; s < nst; ++s) { const float e = __uint_as_float(words[s]); if (e >= 0.03125f) { val = 4 * s + (e < 0.25f ? 1 : (e < 4.f ? 2 : 3)); break; } }
    const float c = sqrtf(0.1f * (float)val);
    for (int i = GTID; i < n; i += GSTR) out[i] = c;
}
#endif

extern "C" void kernel_launch(void* const* d_in, const int* in_sizes, int n_in, void* d_out, int out_size, void* d_ws, size_t ws_size, hipStream_t stream) {
    static int grid = 0;
    if (grid == 0) {
        if (n_in != 21 || out_size != T * D || ws_size < WS_END + 2 * MiB) { fprintf(stderr, "kernel_launch: unexpected shapes (n_in %d out %d ws %zu)\n", n_in, out_size, ws_size); grid = -1; return; }
        if (hipFuncSetAttribute((const void*)hybrid_fwd, hipFuncAttributeMaxDynamicSharedMemorySize, LDS_BYTES) != hipSuccess) { fprintf(stderr, "kernel_launch: hipFuncSetAttribute failed\n"); grid = -1; return; }
        int dev = 0, cus = 0, per_cu = 0;
        (void)hipGetDevice(&dev); (void)hipDeviceGetAttribute(&cus, hipDeviceAttributeMultiprocessorCount, dev);
        if (hipOccupancyMaxActiveBlocksPerMultiprocessor(&per_cu, (const void*)hybrid_fwd, NWAVES * 64, LDS_BYTES) != hipSuccess || per_cu < 1) fprintf(stderr, "kernel_launch: occupancy query says %d\n", per_cu);
        (void)hipGetLastError();
        grid = cus > 0 ? cus : 256;
    }
    if (grid < 0) return;
    Args a{};
    for (int i = 0; i < 21; ++i) a.in[i] = (const float*)d_in[i];
    a.out = (float*)d_out; a.ws = (unsigned char*)d_ws; a.upto = 99; a.pad1 = 0;
#if !DIAG
    (void)hipMemsetAsync((char*)d_ws + WS_CTL, 0, CTL_ZERO_BYTES, stream);
    hipLaunchKernelGGL(hybrid_fwd, dim3(grid), dim3(NWAVES * 64), LDS_BYTES, stream, a);
#else
    {
        unsigned char* ws = (unsigned char*)d_ws; const float* const* in = a.in;
        unsigned* words = (unsigned*)(ws + WS_DIAG); float* save = (float*)(ws + WS_DIAG + 65536);
        (void)hipMemsetAsync(words, 0, 65536, stream);
        float* gz = (float*)(ws + WS_GZ); int* tok_e = (int*)(ws + WS_TOKE); int* tok_p = (int*)(ws + WS_TOKP); float* tok_w = (float*)(ws + WS_TOKW); int* slot_of = (int*)(ws + WS_SLOT);
        float* adec = (float*)(ws + WS_ADEC); float* wp_gz = (float*)(ws + WS_WPGZ); float* wp_r0 = (float*)(ws + WS_WPR0); float* wp_r1 = (float*)(ws + WS_WPR1);
        bf16_t* wgi = (bf16_t*)(ws + WS_WGI); bf16_t* wgo = (bf16_t*)(ws + WS_WGO); bf16_t* wdi = (bf16_t*)(ws + WS_WDI); bf16_t* wdo = (bf16_t*)(ws + WS_WDO);
        bf16_t* gu = (bf16_t*)(ws + WS_WMOE); bf16_t* dt = (bf16_t*)(ws + WS_WMOE_D);
        bf16_t* hn = (bf16_t*)(ws + WS_HN); bf16_t* proj = (bf16_t*)(ws + WS_PROJ); bf16_t* buf1 = (bf16_t*)(ws + WS_BUF1); bf16_t* buf2 = (bf16_t*)(ws + WS_BUF2);
        bf16_t* ag = (bf16_t*)(ws + WS_AG); bf16_t* ob = (bf16_t*)(ws + WS_OB); bf16_t* hh = (bf16_t*)(ws + WS_H);
        unsigned* ctl = (unsigned*)(ws + WS_CTL); float* xres = (float*)d_out;
        const size_t L1W = (size_t)NEXP * D * DFF;
        for (int st = 0; st <= 20; ++st) {
            (void)hipMemsetAsync((char*)d_ws + WS_CTL, 0, CTL_ZERO_BYTES, stream);
            a.upto = st;
            hipLaunchKernelGGL(hybrid_fwd, dim3(grid), dim3(NWAVES * 64), LDS_BYTES, stream, a);
            unsigned* w = words + st;
            switch (st) {
            case 0: ck_weights<<<256, 256, 0, stream>>>(in[3], in[7], in[8], in[14], wgi, wgo, wdi, wdo, in[1], in[2], in[15], in[16], wp_gz, wp_r0, wp_r1, w);
                    ck_moew<<<256, 256, 0, stream>>>(in[17], in[18], in[19], gu, dt, w); break;
            case 1: ck_norm<<<64, 64, 0, stream>>>(in[0], in[1], hn, w); ck_gz<<<64, 64, 0, stream>>>(in[0], in[1], in[3], gz, w); break;
            case 2: ck_proj<<<256, 64, 0, stream>>>(hn, wgi, proj, 0, w); break;
            case 3: ck_gate<<<64, 64, 0, stream>>>(gz, in[4], in[5], proj, buf1, adec, w); break;
            case 4: ck_scan<<<96, 64, 0, stream>>>(proj, buf1, adec, buf2, w); break;
            case 5: ck_gnorm<<<128, 64, 0, stream>>>(buf2, proj, in[6], hn, w); break;
            case 6: ck_gemm_res<<<64, 64, 0, stream>>>(hn, wgo, in[0], 0, xres, w); break;
            case 7: ck_norm<<<64, 64, 0, stream>>>(xres, in[2], hn, w); ck_route<<<8, 64, 0, stream>>>(xres, in[2], in[15], in[16], tok_e, tok_p, tok_w, ctl + CW_CNT0, w); break;
            case 8: ck_gather<<<128, 64, 0, stream>>>(tok_e, tok_p, slot_of, ctl + CW_CNT0, hn, ag, w); break;
            case 9: ck_moe1<<<128, 64, 0, stream>>>(tok_e, slot_of, ag, in[17], in[18], hh, w); break;
            case 10: ck_moe2<<<128, 64, 0, stream>>>(tok_e, slot_of, hh, in[19], ob, w); ck_save<<<64, 256, 0, stream>>>(xres, save); break;
            case 11: ck_combine<<<32, 64, 0, stream>>>(save, ob, slot_of, tok_w, in[1] + D, xres, hn, 0, w); ck_moew<<<256, 256, 0, stream>>>(in[17] + L1W, in[18] + L1W, in[19] + L1W, gu, dt, w); break;
            case 12: ck_proj<<<256, 64, 0, stream>>>(hn, wdi, proj, 1, w); break;
            case 13: ck_attn<<<96, 64, 0, stream>>>(proj, buf1, buf2, w); break;
            case 14: ck_subln<<<128, 64, 0, stream>>>(buf1, buf2, in[9], in[10], in[11], in[12], in[13], hn, w); ck_save<<<64, 256, 0, stream>>>(xres, save); break;
            case 15: ck_gemm_res<<<64, 64, 0, stream>>>(hn, wdo, save, 1, xres, w); break;
            case 16: ck_norm<<<64, 64, 0, stream>>>(xres, in[2] + D, hn, w); ck_route<<<8, 64, 0, stream>>>(xres, in[2] + D, in[15] + (size_t)D * 4, in[16] + (size_t)D * 32, tok_e, tok_p, tok_w, ctl + CW_CNT1, w); break;
            case 17: ck_gather<<<128, 64, 0, stream>>>(tok_e, tok_p, slot_of, ctl + CW_CNT1, hn, ag, w); break;
            case 18: ck_moe1<<<128, 64, 0, stream>>>(tok_e, slot_of, ag, in[17] + L1W, in[18] + L1W, hh, w); break;
            case 19: ck_moe2<<<128, 64, 0, stream>>>(tok_e, slot_of, hh, in[19] + L1W, ob, w); ck_save<<<64, 256, 0, stream>>>(xres, save); break;
            case 20: ck_combine<<<32, 64, 0, stream>>>(save, ob, slot_of, tok_w, in[20], xres, hn, 1, w); break;
            }
        }
        ck_final<<<1024, 256, 0, stream>>>(words, 21, (float*)d_out, out_size);
    }
#endif
}
```

```cpp
#ifndef DIAG
#define DIAG 0
#endif
#ifndef REP_PHASE
#define REP_PHASE -1
#endif
#include <hip/hip_runtime.h>
#include <cstdio>
#include <cstdint>

#define LAS __attribute__((address_space(3)))
#define GAS __attribute__((address_space(1)))
typedef unsigned short bf16_t;
typedef short bf16x8 __attribute__((ext_vector_type(8)));
typedef short s16x4 __attribute__((ext_vector_type(4)));
typedef float f32x4 __attribute__((ext_vector_type(4)));
typedef float f32x2 __attribute__((ext_vector_type(2)));
typedef float f32x16 __attribute__((ext_vector_type(16)));
typedef unsigned u32x4 __attribute__((ext_vector_type(4)));
typedef unsigned u32x2 __attribute__((ext_vector_type(2)));

constexpr int D = 2048, SEQ = 16384, NBATCH = 2, T = NBATCH * SEQ, CHUNK = 64, NCH = SEQ / CHUNK;
constexpr int GLA_H = 4, GLA_DK = 256, GLA_DV = 512, GLA_DKT = 1024, GLA_INW = 6160, PROJW = 6144;
constexpr int DIFF_H = 8;
constexpr int NEXP = 32, DFF = 512;
constexpr float RMS_EPS = 1e-6f;
constexpr float LAMBDA_INIT = 0.35550906759f;
constexpr int MAX_TILES = 288;

constexpr size_t MiB = 1u << 20;
constexpr size_t WS_CTL = 0, CTL_ZERO_BYTES = 1 * MiB;
constexpr size_t WS_GZ = 2 * MiB;
constexpr size_t WS_TOKE = 4 * MiB;
constexpr size_t WS_TOKP = WS_TOKE + 256 * 1024;
constexpr size_t WS_TOKW = WS_TOKP + 256 * 1024;
constexpr size_t WS_SLOT = WS_TOKW + 256 * 1024;
constexpr size_t WS_ADEC = 8 * MiB;
constexpr size_t WS_WPGZ = 10 * MiB;
constexpr size_t WS_WPR0 = 10 * MiB + 256 * 1024;
constexpr size_t WS_WPR1 = 11 * MiB;
constexpr size_t WS_NRM = 12 * MiB;
constexpr size_t WS_WGI = 16 * MiB, WS_WGO = 40 * MiB, WS_WDI = 48 * MiB, WS_WDO = 72 * MiB;
constexpr size_t WS_WMOE = 80 * MiB;
constexpr size_t WS_WMOE_D = WS_WMOE + 128 * MiB;
constexpr size_t WS_HN = 272 * MiB;
constexpr size_t WS_PROJ = 400 * MiB;
constexpr size_t WS_BUF1 = 784 * MiB;
constexpr size_t WS_BUF2 = 912 * MiB;
constexpr size_t WS_AG = 400 * MiB;
constexpr size_t WS_OB = 688 * MiB;
constexpr size_t WS_H = 976 * MiB;
constexpr size_t WS_END = 1048 * MiB;
constexpr int CW_BAR = 4096;
constexpr int CW_QUEUE = 8192;
constexpr int CW_CNT0 = 16384, CW_CNT1 = 16384 + 32 * 64;


constexpr size_t GK0 = (size_t)T * 1024, GV0 = (size_t)T * 2048, GR0 = (size_t)T * 4096;
constexpr size_t DK0 = (size_t)T * 2048, DV0 = (size_t)T * 4096;
__host__ __device__ __forceinline__ size_t gq_off(int b, int t, int h) { return ((size_t)(b * 4 + h) * SEQ + t) * 256; }
__host__ __device__ __forceinline__ size_t gv_off(int b, int t, int h) { return GV0 + ((size_t)(b * 4 + h) * SEQ + t) * 512; }
__host__ __device__ __forceinline__ size_t dq_off(int b, int t, int h, int sub) { return ((size_t)((b * 8 + h) * 2 + sub) * SEQ + t) * 128; }
__host__ __device__ __forceinline__ size_t dv_off(int b, int t, int h) { return DV0 + ((size_t)(b * 8 + h) * SEQ + t) * 256; }

constexpr int RING_BYTES = 131072;
constexpr int LDSCTL_OFF = RING_BYTES;
constexpr int MISC_OFF = LDSCTL_OFF + 320;
constexpr int TAB_OFF = LDSCTL_OFF + 1024;
constexpr int LDS_BYTES = 147456;
constexpr int NWAVES = 8;

typedef __bf16 bf16x2_t __attribute__((ext_vector_type(2)));
__device__ __forceinline__ unsigned cvt_pk_bf16(float lo, float hi) { const f32x2 v = {lo, hi}; return __builtin_bit_cast(unsigned, __builtin_convertvector(v, bf16x2_t)); }
__device__ __forceinline__ float bf_lo(unsigned w) { return __uint_as_float(w << 16); }
__device__ __forceinline__ float bf_hi(unsigned w) { return __uint_as_float(w & 0xffff0000u); }
__device__ __forceinline__ float bf2f(bf16_t b) { return __uint_as_float(((unsigned)b) << 16); }
__device__ __forceinline__ float wave_sum(float v) {
#pragma unroll
    for (int o = 1; o < 64; o <<= 1) v += __shfl_xor(v, o);
    return v;
}
__device__ __forceinline__ int opq(int v) { asm volatile("" : "+v"(v)); return v; }
#define LDS_WAIT() asm volatile("s_waitcnt lgkmcnt(0)" ::: "memory")
#define VM_WAIT() asm volatile("s_waitcnt vmcnt(0)" ::: "memory")
#define WG_BAR() do { asm volatile("s_waitcnt lgkmcnt(0)" ::: "memory"); __builtin_amdgcn_s_barrier(); asm volatile("" ::: "memory"); } while (0)

namespace pg8 {
constexpr int BM = 256, BK = 64, HALF = 128, HTB = HALF * BK * 2, STAGE_BYTES = 8 * HTB, NXCD = 8, WGM = 8;
__host__ __device__ __forceinline__ int lds_byte(int r, int c) { const int st = (r >> 4) * 2 + (c >> 5), rr = r & 15, cc = c & 31, ob = rr * 64 + cc * 2; return st * 1024 + (ob ^ (((ob >> 9) & 1) << 5)); }
__host__ __device__ __forceinline__ void stage_rc(int b, int& R, int& C) { const int st = b / 1024, sb = b % 1024, swz = sb ^ (((sb >> 9) & 1) << 5); R = (st >> 1) * 16 + swz / 64; C = (st & 1) * 32 + (swz % 64) / 2; }
__host__ __device__ __forceinline__ int perm32(int rho) { const int n = rho >> 4, i = rho & 15; return 8 * (i >> 2) + 4 * n + (i & 3); }

struct Unit { int pm, pn; };
struct Gemm { const bf16_t* A; const bf16_t* Bt; int M, N, K; };

struct StaticOrder {
    int nM, nN, nwg, G, c;
    __device__ void init(int M, int N, int G_, int c_) { nM = M / BM; nN = N / BM; nwg = nM * nN; G = G_; c = c_; }
    __device__ bool next(int i, Unit& u) const {
        const long L = (long)i * G + c; if (L >= nwg) return false;
        int wgid = (int)L; { const int q = nwg / NXCD, r = nwg % NXCD, xcd = wgid % NXCD, off = wgid / NXCD; wgid = (xcd < r ? xcd * (q + 1) : r * (q + 1) + (xcd - r) * q) + off; }
        const int nig = WGM * nN, gid = wgid / nig, fm = gid * WGM, gsz = (nM - fm) < WGM ? (nM - fm) : WGM;
        u.pm = fm + ((wgid % nig) % gsz); u.pn = (wgid % nig) / gsz; return true;
    }
    __device__ __forceinline__ size_t bofs(const Unit&) const { return 0; }
};
struct MoeOrder : StaticOrder {
    const LAS int* te; size_t estride;
    __device__ __forceinline__ size_t bofs(const Unit& u) const { return (size_t)te[u.pm] * estride; }
};

struct EpiBf16 {
    static constexpr bool PERM = true;
    bf16_t* O; int ldc;
    __device__ __forceinline__ void operator()(const f32x4 (&acc)[2][2][4][2], const Unit& u, int wr, int wc, int fr, int fq) const {
        const int row0 = u.pm * BM + wr * 64 + fr, col0 = u.pn * BM + wc * 32 + 8 * fq;
#pragma unroll
        for (int ai = 0; ai < 2; ++ai)
#pragma unroll
            for (int m = 0; m < 4; ++m) { bf16_t* rowp = O + (size_t)(row0 + ai * HALF + m * 16) * ldc + col0;
#pragma unroll
                for (int bj = 0; bj < 2; ++bj) { const f32x4 v0 = acc[ai][bj][m][0], v1 = acc[ai][bj][m][1];
                    u32x4 w; w.x = cvt_pk_bf16(v0[0], v0[1]); w.y = cvt_pk_bf16(v0[2], v0[3]); w.z = cvt_pk_bf16(v1[0], v1[1]); w.w = cvt_pk_bf16(v1[2], v1[3]);
                    *(u32x4*)(rowp + bj * HALF) = w; } }
    }
};
template <int LAYER> struct EpiHeads {
    static constexpr bool PERM = true;
    bf16_t* O;
    __device__ __forceinline__ void operator()(const f32x4 (&acc)[2][2][4][2], const Unit& u, int wr, int wc, int fr, int fq) const {
        const int pn = u.pn, lc = wc * 32 + 8 * fq;
#pragma unroll
        for (int ai = 0; ai < 2; ++ai)
#pragma unroll
            for (int m = 0; m < 4; ++m) { const int row = u.pm * BM + ai * HALF + wr * 64 + m * 16 + fr, b = row >> 14, t = row & (SEQ - 1);
#pragma unroll
                for (int bj = 0; bj < 2; ++bj) { size_t off;
                    if (LAYER == 0) { if (pn < 4) off = gq_off(b, t, pn) + bj * 128 + lc; else if (pn < 8) off = GK0 + gq_off(b, t, pn - 4) + bj * 128 + lc;
                                      else if (pn < 16) off = gv_off(b, t, (pn - 8) >> 1) + ((pn - 8) & 1) * 256 + bj * 128 + lc; else off = GR0 + (size_t)row * 2048 + (pn - 16) * 256 + bj * 128 + lc; }
                    else { if (pn < 8) off = dq_off(b, t, pn, bj) + lc; else if (pn < 16) off = DK0 + dq_off(b, t, pn - 8, bj) + lc; else off = dv_off(b, t, pn - 16) + bj * 128 + lc; }
                    const f32x4 v0 = acc[ai][bj][m][0], v1 = acc[ai][bj][m][1];
                    u32x4 w; w.x = cvt_pk_bf16(v0[0], v0[1]); w.y = cvt_pk_bf16(v0[2], v0[3]); w.z = cvt_pk_bf16(v1[0], v1[1]); w.w = cvt_pk_bf16(v1[2], v1[3]);
                    *(u32x4*)(O + off) = w; } }
    }
};
struct EpiResF32 {
    static constexpr bool PERM = false;
    const float* base; float* C; int ldc;
    __device__ __forceinline__ void operator()(const f32x4 (&acc)[2][2][4][2], const Unit& u, int wr, int wc, int fr, int fq) const {
        const int row0 = u.pm * BM + wr * 64 + fr, col0 = u.pn * BM + wc * 32 + 4 * fq;
#pragma unroll
        for (int ai = 0; ai < 2; ++ai)
#pragma unroll
            for (int m = 0; m < 4; ++m) { const size_t off = (size_t)(row0 + ai * HALF + m * 16) * ldc + col0;
#pragma unroll
                for (int bj = 0; bj < 2; ++bj)
#pragma unroll
                    for (int n = 0; n < 2; ++n) { const f32x4 bs = *(const f32x4*)(base + off + bj * HALF + n * 16); *(f32x4*)(C + off + bj * HALF + n * 16) = bs + acc[ai][bj][m][n]; }
                asm volatile("" ::: "memory"); }
    }
};
struct EpiSiluMul {
    static constexpr bool PERM = true;
    bf16_t* Hh;
    __device__ __forceinline__ void operator()(const f32x4 (&acc)[2][2][4][2], const Unit& u, int wr, int wc, int fr, int fq) const {
        const int row0 = u.pm * BM + wr * 64 + fr, col0 = u.pn * HALF + wc * 32 + 8 * fq;
#pragma unroll
        for (int ai = 0; ai < 2; ++ai)
#pragma unroll
            for (int m = 0; m < 4; ++m) { bf16_t* rowp = Hh + (size_t)(row0 + ai * HALF + m * 16) * DFF + col0;
                float hv[8];
#pragma unroll
                for (int n = 0; n < 2; ++n)
#pragma unroll
                    for (int j = 0; j < 4; ++j) { const float g = acc[ai][0][m][n][j], up = acc[ai][1][m][n][j];
                        const float sg = g * __builtin_amdgcn_rcpf(1.0f + __builtin_amdgcn_exp2f(-1.4426950408889634f * g)); hv[n * 4 + j] = sg * up; }
                u32x4 w; w.x = cvt_pk_bf16(hv[0], hv[1]); w.y = cvt_pk_bf16(hv[2], hv[3]); w.z = cvt_pk_bf16(hv[4], hv[5]); w.w = cvt_pk_bf16(hv[6], hv[7]);
                *(u32x4*)rowp = w; }
    }
};

template <class Epi, class Sched>
__device__ __forceinline__ void gemm_phase(LAS unsigned char* lds, const Gemm g, const Sched& S, const Epi& E) {
    const int tid = opq((int)threadIdx.x), wid = __builtin_amdgcn_readfirstlane(tid >> 6), lane = tid & 63, wr = wid >> 2, wc = wid & 3, fr = lane & 15, fq = lane >> 4;
    const int K = g.K, nt = K / BK;
    unsigned voffA[2], voffB[2];
#pragma unroll
    for (int i = 0; i < 2; ++i) { int R, C; stage_rc(tid * 16 + i * 8192, R, C); const int Rb = Epi::PERM ? ((R & ~31) + perm32(R & 31)) : R;
        voffA[i] = (unsigned)(R * K + C) * 2u; voffB[i] = (unsigned)(Rb * K + C) * 2u; }
    const size_t kstep = (size_t)(BK * 2);
    const size_t hstep = (size_t)HALF * K * 2;
    const size_t tstep = 2 * hstep;
    const unsigned ldsw = (unsigned)wid * 1024u;
    const int aoff = lds_byte(wr * 64 + fr, fq * 8), boff = lds_byte(wc * 32 + fr, fq * 8);
#define PG8_SA(b, h) (((b) * 2 + (h)) * HTB)
#define PG8_SB(b, h) ((4 + (b) * 2 + (h)) * HTB)
#define PG8_STAGE(bufoff, gbase, voff) do { _Pragma("unroll") for (int _i = 0; _i < 2; ++_i) \
        __builtin_amdgcn_global_load_lds((const unsigned*)((const char*)(gbase) + (voff)[_i]), (LAS unsigned*)(lds + (bufoff) + ldsw + _i * 8192), 16, 0, 0); } while (0)
#define PG8_LDA(dst, b, h) do { _Pragma("unroll") for (int m = 0; m < 4; ++m) _Pragma("unroll") for (int k = 0; k < 2; ++k) dst[m][k] = *(const LAS bf16x8*)(lds + PG8_SA(b, h) + aoff + m * 2048 + k * 1024); } while (0)
#define PG8_LDB(dst, b, h) do { _Pragma("unroll") for (int n = 0; n < 2; ++n) _Pragma("unroll") for (int k = 0; k < 2; ++k) dst[n][k] = *(const LAS bf16x8*)(lds + PG8_SB(b, h) + boff + n * 2048 + k * 1024); } while (0)
#define PG8_MMA(ai, bj, At, Bt) do { __builtin_amdgcn_s_setprio(1); _Pragma("unroll") for (int m = 0; m < 4; ++m) _Pragma("unroll") for (int n = 0; n < 2; ++n) _Pragma("unroll") for (int k = 0; k < 2; ++k) \
        acc[ai][bj][m][n] = __builtin_amdgcn_mfma_f32_16x16x32_bf16(Bt[n][k], At[m][k], acc[ai][bj][m][n], 0, 0, 0); __builtin_amdgcn_s_setprio(0); } while (0)
#define PG8_WAIT_V(n) asm volatile("s_waitcnt vmcnt(" #n ")" ::: "memory")
#define PG8_WAIT_L(n) asm volatile("s_waitcnt lgkmcnt(" #n ")" ::: "memory")
#define PG8_BAR __builtin_amdgcn_s_barrier()
#define PG8_SCHED __builtin_amdgcn_sched_barrier(0)
    Unit cur, nxt; int ui = 0;
    if (!S.next(0, cur)) return;
    f32x4 acc[2][2][4][2];
#pragma unroll
    for (int a = 0; a < 2; ++a)
#pragma unroll
        for (int b = 0; b < 2; ++b)
#pragma unroll
            for (int m = 0; m < 4; ++m)
#pragma unroll
                for (int n = 0; n < 2; ++n) acc[a][b][m][n] = (f32x4){0.f, 0.f, 0.f, 0.f};
    bf16x8 At[4][2], B0[2][2], B1[2][2];
    const char* cA = (const char*)g.A + (size_t)cur.pm * tstep; const char* cB = (const char*)g.Bt + S.bofs(cur) + (size_t)cur.pn * tstep;
    PG8_STAGE(PG8_SB(0, 0), cB, voffB); PG8_STAGE(PG8_SB(0, 1), cB + hstep, voffB); PG8_STAGE(PG8_SA(0, 0), cA, voffA); PG8_STAGE(PG8_SA(0, 1), cA + hstep, voffA);
    if (wr == 1) PG8_BAR;
    PG8_WAIT_V(2); PG8_BAR;
    PG8_STAGE(PG8_SB(1, 0), cB + kstep, voffB); PG8_STAGE(PG8_SA(1, 0), cA + kstep, voffA); PG8_STAGE(PG8_SB(1, 1), cB + hstep + kstep, voffB);
    PG8_WAIT_V(6); PG8_BAR;
    for (;;) {
        const bool has_next = S.next(ui + 1, nxt);
        const char* nA = has_next ? (const char*)g.A + (size_t)nxt.pm * tstep : cA; const char* nB = has_next ? (const char*)g.Bt + S.bofs(nxt) + (size_t)nxt.pn * tstep : cB;
        for (int t = 0; t < nt; t += 2) {
            const bool last = (t == nt - 2);
            const char* a1 = cA + (size_t)(t + 1) * kstep;
            const char* a2 = last ? nA : cA + (size_t)(t + 2) * kstep; const char* b2 = last ? nB : cB + (size_t)(t + 2) * kstep;
            const char* a3 = a2 + kstep; const char* b3 = b2 + kstep;
            PG8_LDB(B0, 0, 0); PG8_LDB(B1, 0, 1); PG8_SCHED; PG8_LDA(At, 0, 0); PG8_STAGE(PG8_SA(1, 1), a1 + hstep, voffA);
            PG8_WAIT_V(8); PG8_WAIT_L(0); PG8_BAR; PG8_MMA(0, 0, At, B0); PG8_MMA(0, 1, At, B1); PG8_BAR; PG8_SCHED;
            PG8_LDA(At, 0, 1); PG8_STAGE(PG8_SB(0, 0), b2, voffB); PG8_STAGE(PG8_SB(0, 1), b2 + hstep, voffB); PG8_STAGE(PG8_SA(0, 0), a2, voffA);
            PG8_WAIT_V(8); PG8_WAIT_L(0); PG8_BAR; PG8_MMA(1, 0, At, B0); PG8_MMA(1, 1, At, B1); PG8_BAR; PG8_SCHED;
            PG8_LDB(B0, 1, 0); PG8_LDB(B1, 1, 1); PG8_SCHED; PG8_LDA(At, 1, 0); PG8_STAGE(PG8_SA(0, 1), a2 + hstep, voffA);
            PG8_WAIT_V(8); PG8_WAIT_L(0); PG8_BAR; PG8_MMA(0, 0, At, B0); PG8_MMA(0, 1, At, B1); PG8_BAR; PG8_SCHED;
            PG8_LDA(At, 1, 1); PG8_STAGE(PG8_SB(1, 0), b3, voffB); PG8_STAGE(PG8_SB(1, 1), b3 + hstep, voffB); PG8_STAGE(PG8_SA(1, 0), a3, voffA);
            PG8_WAIT_V(8); PG8_WAIT_L(0); PG8_BAR; PG8_MMA(1, 0, At, B0); PG8_MMA(1, 1, At, B1); PG8_BAR; PG8_SCHED;
        }
        if (wr == 0) PG8_BAR;
        E(acc, cur, wr, wc, fr, fq);
        if (!has_next) break;
#pragma unroll
        for (int a = 0; a < 2; ++a)
#pragma unroll
            for (int b = 0; b < 2; ++b)
#pragma unroll
                for (int m = 0; m < 4; ++m)
#pragma unroll
                    for (int n = 0; n < 2; ++n) acc[a][b][m][n] = (f32x4){0.f, 0.f, 0.f, 0.f};
        cur = nxt; cA = nA; cB = nB; ++ui;
        if (wr == 1) PG8_BAR;
    }
    PG8_WAIT_V(0);
    PG8_BAR;
#undef PG8_SA
#undef PG8_SB
#undef PG8_STAGE
#undef PG8_LDA
#undef PG8_LDB
#undef PG8_MMA
#undef PG8_WAIT_V
#undef PG8_WAIT_L
#undef PG8_BAR
#undef PG8_SCHED
}
}

#define XB_TMO      128
#define XB_XCNT(j)  (256  + 64 * (j))
#define XB_XSUB(j)  (1280 + 64 * (j))
#define XB_XGEN(j)  (2304 + 64 * (j))
#define XB_TOP      3328
#define XB_TOPGEN   3392
#define XCD_BAR_WORDS 3456
#define XB_SPIN_CAP (1u << 18)
__device__ __forceinline__ unsigned xb_ld(unsigned* p)              { return __hip_atomic_load(p, __ATOMIC_RELAXED, __HIP_MEMORY_SCOPE_AGENT); }
__device__ __forceinline__ unsigned xb_add(unsigned* p, unsigned v) { return __hip_atomic_fetch_add(p, v, __ATOMIC_RELAXED, __HIP_MEMORY_SCOPE_AGENT); }
__device__ __forceinline__ unsigned xb_xcc_id() { return (unsigned)__builtin_amdgcn_s_getreg((3 << 11) | 20) & 0xFu; }
#define XB_SPIN(cond, bar) do { unsigned _sp = 0; while (cond) { __builtin_amdgcn_s_sleep(1); \
    if ((++_sp & 255u) == 0u) { if (xb_ld(&(bar)[XB_TMO])) break; if (_sp > XB_SPIN_CAP) { atomicAdd(&(bar)[XB_TMO], 1u); break; } } } } while (0)
struct XcdBarrier { unsigned* bar; unsigned x; volatile LAS unsigned* st; };
__device__ __forceinline__ XcdBarrier xcd_barrier_post(unsigned* bar, volatile LAS unsigned* st) {
    XcdBarrier b; b.bar = bar; b.x = xb_xcc_id(); b.st = st;
    if (threadIdx.x == 0) (void)xb_add(&bar[XB_XCNT(b.x)], 1u);
    return b;
}
__device__ __forceinline__ void xcd_barrier_complete(unsigned* bar, unsigned x, unsigned& nloc, unsigned& nx) {
    const unsigned G = gridDim.x * gridDim.y * gridDim.z;
    unsigned sum, cnt, mine, sp = 0u;
    for (;;) {
        sum = 0u; cnt = 0u; mine = 0u;
#pragma unroll
        for (unsigned j = 0; j < 16; ++j) { const unsigned c = xb_ld(&bar[XB_XCNT(j)]); sum += c; cnt += (c > 0u) ? 1u : 0u; mine = (j == x) ? c : mine; }
        if (sum == G) break;
        __builtin_amdgcn_s_sleep(1);
        if ((++sp & 255u) == 0u) { if (xb_ld(&bar[XB_TMO])) break; if (sp > XB_SPIN_CAP) { atomicAdd(&bar[XB_TMO], 1u); break; } }
    }
    nloc = mine > 0u ? mine : 1u; nx = cnt > 0u ? cnt : 1u;
}
__device__ __forceinline__ void xcd_barrier(const XcdBarrier& b) {
    asm volatile("s_waitcnt vmcnt(0)" ::: "memory");
    __syncthreads();
    if (threadIdx.x == 0) {
        unsigned* bar = b.bar;
        __builtin_amdgcn_s_waitcnt(0);
        unsigned nloc = b.st[0], nx = b.st[1];
        if (nloc == 0u) { xcd_barrier_complete(bar, b.x, nloc, nx); b.st[0] = nloc; b.st[1] = nx; }
        const unsigned old = xb_add(&bar[XB_XSUB(b.x)], 1u);
        const unsigned gen = old / nloc;
        if (old + 1u == (gen + 1u) * nloc) {
            __builtin_amdgcn_fence(__ATOMIC_RELEASE, "agent");
            asm volatile("s_waitcnt vmcnt(0)" ::: "memory");
            const unsigned og = xb_add(&bar[XB_TOP], 1u);
            const unsigned tg = og / nx;
            if (og + 1u == (tg + 1u) * nx) xb_add(&bar[XB_TOPGEN], 1u);
            else XB_SPIN(xb_ld(&bar[XB_TOPGEN]) == tg, bar);
            __builtin_amdgcn_fence(__ATOMIC_ACQUIRE, "agent");
            xb_add(&bar[XB_XGEN(b.x)], 1u);
            asm volatile("s_waitcnt vmcnt(0)" ::: "memory");
        } else {
            XB_SPIN(xb_ld(&bar[XB_XGEN(b.x)]) == gen, bar);
            __builtin_amdgcn_fence(__ATOMIC_ACQUIRE, "agent");
            asm volatile("s_waitcnt vmcnt(0)" ::: "memory");
        }
    }
    __syncthreads();
}

struct Frame {
    LAS unsigned char* lds;
    int tid, lane, wave, vcu, G;
};
struct Args {
    const float* in[21]; float* out; unsigned char* ws; int upto, pad1;
};

__device__ __forceinline__ void transpose_item(const float* W, int ldw, int k0, int n0, bf16_t* WT, int ldk, int drow0, LAS float* scr, int lane) {
#pragma unroll 8
    for (int i = 0; i < 32; ++i) { const int kk = 2 * i + (lane >> 5); scr[kk * 33 + (lane & 31)] = W[(size_t)(k0 + kk) * ldw + n0 + (lane & 31)]; }
    LDS_WAIT(); asm volatile("" ::: "memory");
    const int c = lane & 7;
#pragma unroll
    for (int j = 0; j < 4; ++j) { const int n = (lane >> 3) + 8 * j; const LAS float* s = scr + (8 * c) * 33 + n;
        u32x4 o; o.x = cvt_pk_bf16(s[0 * 33], s[1 * 33]); o.y = cvt_pk_bf16(s[2 * 33], s[3 * 33]); o.z = cvt_pk_bf16(s[4 * 33], s[5 * 33]); o.w = cvt_pk_bf16(s[6 * 33], s[7 * 33]);
        *(u32x4*)(WT + (size_t)(drow0 + n) * ldk + k0 + 8 * c) = o; }
    LDS_WAIT(); asm volatile("" ::: "memory");
}
__device__ __forceinline__ void conv_plain(Frame& F, const float* W, int K, int N, int ldw, bf16_t* WT) {
    LAS float* scr = (LAS float*)(F.lds + F.wave * 16384);
    const int gw = F.vcu * NWAVES + F.wave, NGW = F.G * NWAVES, nblk = N / 32, nit = (K / 64) * nblk;
    for (int it = gw; it < nit; it += NGW) { const int kb = it / nblk, nb = it % nblk; transpose_item(W, ldw, 64 * kb, 32 * nb, WT, K, 32 * nb, scr, F.lane); }
}
__device__ __forceinline__ void conv_moe(Frame& F, const float* wg, const float* wu, const float* wd, bf16_t* GU, bf16_t* DT) {
    LAS float* scr = (LAS float*)(F.lds + F.wave * 16384);
    const int gw = F.vcu * NWAVES + F.wave, NGW = F.G * NWAVES;
    constexpr int PER_E = 1536, NIT = NEXP * PER_E;
    for (int it = gw; it < NIT; it += NGW) {
        const int e = it / PER_E; int r = it % PER_E;
        if (r < 1024) { const int up = r >> 9; r &= 511; const int kb = r >> 4, nb = r & 15, n0 = 32 * nb;
            const int drow = 256 * (n0 >> 7) + 128 * up + (n0 & 127);
            transpose_item((up ? wu : wg) + (size_t)e * D * DFF, DFF, 64 * kb, n0, GU + (size_t)e * 1024 * D, D, drow, scr, F.lane); }
        else { r -= 1024; const int kb = r >> 6, nb = r & 63;
            transpose_item(wd + (size_t)e * DFF * D, D, 64 * kb, 32 * nb, DT + (size_t)e * D * DFF, DFF, 32 * nb, scr, F.lane); }
    }
}
__device__ __forceinline__ void pack_proj(Frame& F, float* Wp, int NT, const float* gain, const float* Wa, int lda, int ca0, int na, const float* Wb, int ldb, int nb) {
    const int total = 128 * NT * 256;
    for (int idx = (F.vcu * NWAVES * 64) + F.tid; idx < total; idx += F.G * NWAVES * 64) {
        const int e = idx & 3, ln = (idx >> 2) & 63, rest = idx >> 8, nt = rest % NT, s = rest / NT;
        const int k = 16 * s + 4 * (ln >> 4) + e, col = 16 * nt + (ln & 15);
        float v = 0.f;
        if (col < na) v = Wa[(size_t)k * lda + ca0 + col]; else if (col < na + nb) v = Wb[(size_t)k * ldb + (col - na)];
        Wp[idx] = v * gain[k];
    }
}

template <int NT>
__device__ __forceinline__ float wave_proj16(const float* xin, int tok0, const float* Wp, int lane, f32x4 (&acc)[NT]) {
    const int tr = lane & 15, kq = lane >> 4;
    const f32x4* xp = (const f32x4*)(xin + (size_t)(tok0 + tr) * D) + kq;
    const f32x4* wp = (const f32x4*)Wp + lane;
    float ssq = 0.f;
#pragma unroll
    for (int n = 0; n < NT; ++n) acc[n] = (f32x4){0.f, 0.f, 0.f, 0.f};
#pragma unroll 2
    for (int s = 0; s < 128; ++s) {
        const f32x4 xv = xp[4 * s];
        ssq += (xv[0] * xv[0] + xv[1] * xv[1]) + (xv[2] * xv[2] + xv[3] * xv[3]);
#pragma unroll
        for (int n = 0; n < NT; ++n) { const f32x4 wv = wp[(s * NT + n) * 64];
#pragma unroll
            for (int e = 0; e < 4; ++e) acc[n] = __builtin_amdgcn_mfma_f32_16x16x4f32(xv[e], wv[e], acc[n], 0, 0, 0); }
    }
    ssq += __shfl_xor(ssq, 16); ssq += __shfl_xor(ssq, 32);
    return 1.0f / sqrtf(ssq * (1.0f / D) + RMS_EPS);
}
__device__ __forceinline__ void wave_write_hn16(const float* xin, int tok0, float rstd, const float* gain, bf16_t* hn, int lane) {
    f32x4 g4[8];
#pragma unroll
    for (int j = 0; j < 8; ++j) g4[j] = ((const f32x4*)gain)[lane + 64 * j];
    for (int i = 0; i < 16; ++i) {
        const float rr = __shfl(rstd, i);
        const f32x4* xr = (const f32x4*)(xin + (size_t)(tok0 + i) * D);
        u32x2* orow = (u32x2*)(hn + (size_t)(tok0 + i) * D);
#pragma unroll
        for (int j = 0; j < 8; ++j) { const f32x4 v = xr[lane + 64 * j] * rr * g4[j]; u32x2 w; w.x = cvt_pk_bf16(v[0], v[1]); w.y = cvt_pk_bf16(v[2], v[3]); orow[lane + 64 * j] = w; }
    }
}

__device__ __forceinline__ void phase_norm_gz(Frame& F, const float* xin, const float* gain, const float* Wp, bf16_t* hn, float* gz) {
    for (int tile = F.vcu; tile < T / 128; tile += F.G) {
        const int tok0 = tile * 128 + F.wave * 16;
        f32x4 acc[1];
        const float rstd = wave_proj16<1>(xin, tok0, Wp, F.lane, acc);
        const int j = F.lane & 15, q4 = F.lane >> 4;
#pragma unroll
        for (int r = 0; r < 4; ++r) { const float rr = __shfl(rstd, 4 * q4 + r); gz[(size_t)(tok0 + 4 * q4 + r) * 16 + j] = acc[0][r] * rr; }
        wave_write_hn16(xin, tok0, rstd, gain, hn, F.lane);
    }
}
__device__ __forceinline__ void phase_norm_route(Frame& F, const float* xin, const float* gain, const float* Wp, bf16_t* hn, int* tok_e, int* tok_p, float* tok_w, unsigned* cnt) {
    LAS float* lg = (LAS float*)(F.lds + F.wave * 4096);
    for (int tile = F.vcu; tile < T / 128; tile += F.G) {
        const int tok0 = tile * 128 + F.wave * 16;
        f32x4 acc[3];
        const float rstd = wave_proj16<3>(xin, tok0, Wp, F.lane, acc);
        const int j = F.lane & 15, q4 = F.lane >> 4;
#pragma unroll
        for (int r = 0; r < 4; ++r) { const float rr = __shfl(rstd, 4 * q4 + r);
#pragma unroll
            for (int n = 0; n < 3; ++n) lg[(4 * q4 + r) * 48 + 16 * n + j] = acc[n][r] * rr; }
        LDS_WAIT(); asm volatile("" ::: "memory");
        if (F.lane < 16) {
            const LAS float* l = lg + F.lane * 48;
            float gm = l[0]; int gi = 0;
#pragma unroll
            for (int q = 1; q < 4; ++q) { const float v = l[q]; if (v > gm) { gm = v; gi = q; } }
            float gs = 0.f;
#pragma unroll
            for (int q = 0; q < 4; ++q) gs += __expf(l[q] - gm);
            const float gw = 1.0f / gs;
            const LAS float* se = l + 4 + 8 * gi;
            float m1 = se[0]; int i1 = 0;
#pragma unroll
            for (int q = 1; q < 8; ++q) { const float v = se[q]; if (v > m1) { m1 = v; i1 = q; } }
            float m2 = -3.0e38f; int i2 = 0;
#pragma unroll
            for (int q = 0; q < 8; ++q) { const float v = se[q]; if (q != i1 && v > m2) { m2 = v; i2 = q; } }
            const float eb = __expf(m2 - m1), inv = 1.0f / (1.0f + eb);
            const int t = tok0 + F.lane, e1 = gi * 8 + i1, e2 = gi * 8 + i2;
            const unsigned p1 = __hip_atomic_fetch_add(cnt + 64 * e1, 1u, __ATOMIC_RELAXED, __HIP_MEMORY_SCOPE_AGENT);
            const unsigned p2 = __hip_atomic_fetch_add(cnt + 64 * e2, 1u, __ATOMIC_RELAXED, __HIP_MEMORY_SCOPE_AGENT);
            tok_e[2 * t] = e1; tok_e[2 * t + 1] = e2; tok_p[2 * t] = (int)p1; tok_p[2 * t + 1] = (int)p2;
            tok_w[2 * t] = gw * inv; tok_w[2 * t + 1] = gw * eb * inv;
        }
        wave_write_hn16(xin, tok0, rstd, gain, hn, F.lane);
        LDS_WAIT(); asm volatile("" ::: "memory");
    }
}

__device__ __forceinline__ void phase_gla_gate(Frame& F, const float* gz, const float* wgu, const float* bgate, const bf16_t* proj, bf16_t* kdT, float* adec) {
    LAS f32x4* gzs = (LAS f32x4*)F.lds;
    for (int u = F.vcu; u < NBATCH * NCH * 2; u += F.G) {
        const int half = u & 1, bc = u >> 1;
        const int tok0 = bc * 64, j = half * 512 + F.tid;
        if (F.tid < 256) gzs[F.tid] = ((const f32x4*)(gz + (size_t)tok0 * 16))[F.tid];
        float wg[16];
#pragma unroll
        for (int r = 0; r < 16; ++r) wg[r] = wgu[r * GLA_DKT + j];
        const float bg = bgate[j];
        WG_BAR();
        float cum[64]; float run = 0.f;
#pragma unroll
        for (int t = 0; t < 64; ++t) {
            float z = bg;
#pragma unroll
            for (int r4 = 0; r4 < 4; ++r4) { const f32x4 g4 = gzs[t * 4 + r4]; z += g4[0] * wg[4 * r4] + g4[1] * wg[4 * r4 + 1] + g4[2] * wg[4 * r4 + 2] + g4[3] * wg[4 * r4 + 3]; }
            const float ls = fminf(z, 0.f) - __logf(1.0f + __expf(-fabsf(z)));
            run += ls * (1.0f / 16.0f); cum[t] = run;
        }
        adec[(size_t)bc * GLA_DKT + j] = __expf(run);
        const bf16_t* kp = proj + GK0 + gq_off(bc >> 8, (bc & 255) * 64, j >> 8) + (j & 255);
        u32x4* dst = (u32x4*)(kdT + ((size_t)bc * GLA_DKT + j) * 64);
#pragma unroll
        for (int t8 = 0; t8 < 8; ++t8) {
            float kd[8];
#pragma unroll
            for (int q = 0; q < 8; ++q) { const int t = t8 * 8 + q; kd[q] = bf2f(kp[(size_t)t * 256]) * __expf(run - cum[t]); }
            u32x4 w; w.x = cvt_pk_bf16(kd[0], kd[1]); w.y = cvt_pk_bf16(kd[2], kd[3]); w.z = cvt_pk_bf16(kd[4], kd[5]); w.w = cvt_pk_bf16(kd[6], kd[7]);
            dst[t8] = w;
        }
        WG_BAR();
    }
}

struct ScanSet { bf16x8 ka[2][2]; f32x4 dc[2]; u32x2 qa[4][2]; u32x4 vreg; };
__device__ __forceinline__ void phase_gla_scan(Frame& F, const bf16_t* proj, const bf16_t* kdT, const float* adec, bf16_t* oout) {
    const int lane = F.lane, w = F.wave, fr = lane & 15, kq = lane >> 4;
    LAS unsigned char* vbuf = F.lds;
    LAS float* red = (LAS float*)(F.lds + 4096);
    for (int u = F.vcu; u < 256; u += F.G) {
        const int bh = u >> 5, b = bh >> 2, h = bh & 3, sl = u & 31;
        const size_t tokb = (size_t)b * SEQ;
        f32x4 st[2] = {(f32x4){0.f, 0.f, 0.f, 0.f}, (f32x4){0.f, 0.f, 0.f, 0.f}};
        ScanSet sA, sB; sA.vreg = (u32x4){0u, 0u, 0u, 0u}; sB.vreg = sA.vreg;
#define SCAN_LOAD(S_, c) do { const size_t bc_ = (size_t)b * NCH + (c); \
            _Pragma("unroll") for (int i = 0; i < 2; ++i) { \
                _Pragma("unroll") for (int s = 0; s < 2; ++s) S_.ka[i][s] = *(const bf16x8*)(kdT + ((bc_ * GLA_DKT + h * 256 + 32 * w + 16 * i + fr) * 64 + 32 * s + 8 * kq)); \
                S_.dc[i] = *(const f32x4*)(adec + bc_ * GLA_DKT + h * 256 + 32 * w + 16 * i + 4 * kq); } \
            _Pragma("unroll") for (int mt = 0; mt < 4; ++mt) { const bf16_t* qp = proj + gq_off(b, (c) * 64 + 16 * mt + fr, h) + 32 * w + 4 * kq; \
                S_.qa[mt][0] = *(const u32x2*)qp; S_.qa[mt][1] = *(const u32x2*)(qp + 16); } \
            S_.vreg = *(const u32x4*)(proj + gv_off(b, (c) * 64 + ((F.tid & 127) >> 1), h) + 16 * sl + 8 * (F.tid & 1));   \
        } while (0)
#define SCAN_STEP(MY, OTHER, c) do { \
            const ScanSet cur = MY; \
            { const int cn_ = (c) + 2 < NCH ? (c) + 2 : NCH - 1; SCAN_LOAD(MY, cn_); }     \
            const unsigned vb = (unsigned)(uintptr_t)(vbuf + ((c) & 1) * 2048) + (unsigned)((8 * kq + ((lane & 15) >> 2)) * 32 + 8 * (lane & 3)); \
            s16x4 v00, v01, v10, v11; \
            asm volatile("ds_read_b64_tr_b16 %0, %4\n\tds_read_b64_tr_b16 %1, %4 offset:128\n\tds_read_b64_tr_b16 %2, %4 offset:1024\n\tds_read_b64_tr_b16 %3, %4 offset:1152\n\ts_waitcnt lgkmcnt(0)" \
                         : "=&v"(v00), "=&v"(v01), "=&v"(v10), "=&v"(v11) : "v"(vb) : "memory"); \
            const bf16x8 vb0 = (bf16x8){v00[0], v00[1], v00[2], v00[3], v01[0], v01[1], v01[2], v01[3]}; \
            const bf16x8 vb1 = (bf16x8){v10[0], v10[1], v10[2], v10[3], v11[0], v11[1], v11[2], v11[3]}; \
            _Pragma("unroll") for (int i = 0; i < 2; ++i) { \
                st[i] = st[i] * cur.dc[i]; \
                st[i] = __builtin_amdgcn_mfma_f32_16x16x32_bf16(cur.ka[i][0], vb0, st[i], 0, 0, 0); \
                st[i] = __builtin_amdgcn_mfma_f32_16x16x32_bf16(cur.ka[i][1], vb1, st[i], 0, 0, 0); } \
            u32x4 sw; sw.x = cvt_pk_bf16(st[0][0], st[0][1]); sw.y = cvt_pk_bf16(st[0][2], st[0][3]); sw.z = cvt_pk_bf16(st[1][0], st[1][1]); sw.w = cvt_pk_bf16(st[1][2], st[1][3]); \
            const bf16x8 sb = __builtin_bit_cast(bf16x8, sw); \
            LAS float* rw = red + ((size_t)(((c) & 1) * 8 + w) * 64) * 16; \
            _Pragma("unroll") for (int mt = 0; mt < 4; ++mt) { \
                u32x4 qw; qw.x = cur.qa[mt][0].x; qw.y = cur.qa[mt][0].y; qw.z = cur.qa[mt][1].x; qw.w = cur.qa[mt][1].y; \
                const f32x4 po = __builtin_amdgcn_mfma_f32_16x16x32_bf16(__builtin_bit_cast(bf16x8, qw), sb, (f32x4){0.f, 0.f, 0.f, 0.f}, 0, 0, 0); \
                _Pragma("unroll") for (int r = 0; r < 4; ++r) rw[(16 * mt + 4 * kq + r) * 16 + fr] = po[r]; } \
            if ((c) + 1 < NCH && F.tid < 128) *(LAS u32x4*)(vbuf + (((c) + 1) & 1) * 2048 + F.tid * 16) = OTHER.vreg; \
            WG_BAR(); \
            { const int t = F.tid >> 3, vc2 = (F.tid & 7) * 2; float s0 = 0.f, s1 = 0.f; \
              _Pragma("unroll") for (int ww = 0; ww < 8; ++ww) { const f32x2 p = *(const LAS f32x2*)(red + ((size_t)(((c) & 1) * 8 + ww) * 64 + t) * 16 + vc2); s0 += p.x; s1 += p.y; } \
              *(unsigned*)(oout + (tokb + (size_t)(c) * 64 + t) * D + h * 512 + 16 * sl + vc2) = cvt_pk_bf16(s0 * 0.0625f, s1 * 0.0625f); } \
        } while (0)
        SCAN_LOAD(sA, 0); SCAN_LOAD(sB, 1);
        if (F.tid < 128) *(LAS u32x4*)(vbuf + F.tid * 16) = sA.vreg;
        WG_BAR();
        for (int c = 0; c < NCH; c += 2) { SCAN_STEP(sA, sB, c); SCAN_STEP(sB, sA, c + 1); }
        WG_BAR();
#undef SCAN_LOAD
#undef SCAN_STEP
    }
}

__device__ __forceinline__ void phase_gla_gnorm(Frame& F, const bf16_t* o, const bf16_t* proj, const float* gn, bf16_t* y) {
    const int gw = F.vcu * NWAVES + F.wave, NGW = F.G * NWAVES, lane = F.lane;
    const f32x4 g0 = ((const f32x4*)gn)[2 * lane], g1 = ((const f32x4*)gn)[2 * lane + 1];
    for (int idx = gw; idx < T * GLA_H; idx += NGW) {
        const int tok = idx >> 2, h = idx & 3;
        const u32x4 ov = *(const u32x4*)(o + (size_t)tok * D + h * 512 + 8 * lane);
        const u32x4 rv = *(const u32x4*)(proj + GR0 + (size_t)tok * 2048 + h * 512 + 8 * lane);
        float a[8], r[8];
#pragma unroll
        for (int q = 0; q < 4; ++q) { a[2 * q] = bf_lo(ov[q]); a[2 * q + 1] = bf_hi(ov[q]); r[2 * q] = bf_lo(rv[q]); r[2 * q + 1] = bf_hi(rv[q]); }
        float ss = 0.f;
#pragma unroll
        for (int q = 0; q < 8; ++q) ss += a[q] * a[q];
        const float rstd = 1.0f / sqrtf(wave_sum(ss) * (1.0f / 512.0f) + RMS_EPS);
        float yv[8];
#pragma unroll
        for (int q = 0; q < 8; ++q) { const float g = q < 4 ? g0[q] : g1[q - 4]; const float sr = r[q] / (1.0f + __expf(-r[q])); yv[q] = a[q] * rstd * g * sr; }
        u32x4 w; w.x = cvt_pk_bf16(yv[0], yv[1]); w.y = cvt_pk_bf16(yv[2], yv[3]); w.z = cvt_pk_bf16(yv[4], yv[5]); w.w = cvt_pk_bf16(yv[6], yv[7]);
        *(u32x4*)(y + (size_t)tok * D + h * 512 + 8 * lane) = w;
    }
}

__device__ __forceinline__ void moe_tables(Frame& F, unsigned* cnt) {
    LAS int* pst = (LAS int*)(F.lds + TAB_OFF);
    LAS int* te = pst + 36;
    if (F.wave == 0) {
        const int e = F.lane & 31;
        const int c = (int)xb_ld(cnt + 64 * e);
        const int ntile = (c + 255) >> 8;
        int incl = ntile;
#pragma unroll
        for (int o = 1; o < 32; o <<= 1) { const int v = __shfl_up(incl, o); if ((F.lane & 31) >= o) incl += v; }
        const int excl = incl - ntile;
        if (F.lane < 32) { pst[e] = excl << 8; for (int q = 0; q < ntile; ++q) te[excl + q] = e; }
        if (F.lane == 31) { pst[32] = incl << 8; pst[33] = incl; }
    }
    WG_BAR();
}
__device__ __forceinline__ void phase_moe_gather(Frame& F, const int* tok_e, const int* tok_p, int* slot_of, const bf16_t* hn, bf16_t* ag) {
    const LAS int* pst = (const LAS int*)(F.lds + TAB_OFF);
    const int gw = F.vcu * NWAVES + F.wave, NGW = F.G * NWAVES, lane = F.lane;
    for (int a = gw; a < 2 * T; a += NGW) {
        const int e = tok_e[a], p = tok_p[a], slot = pst[e] + p, t = a >> 1;
        if (lane == 0) slot_of[a] = slot;
        const u32x4* src = (const u32x4*)(hn + (size_t)t * D); u32x4* dst = (u32x4*)(ag + (size_t)slot * D);
#pragma unroll
        for (int j = 0; j < 4; ++j) dst[lane + 64 * j] = src[lane + 64 * j];
    }
}
template <int MODE>
__device__ __forceinline__ void phase_moe_combine(Frame& F, float* x, const bf16_t* ob, const int* slot_of, const float* tok_w, const float* gain, bf16_t* hn) {
    const int gw = F.vcu * NWAVES + F.wave, NGW = F.G * NWAVES, lane = F.lane;
    f32x4 g4[8];
#pragma unroll
    for (int j = 0; j < 8; ++j) g4[j] = ((const f32x4*)gain)[lane + 64 * j];
    for (int t = gw; t < T; t += NGW) {
        const int s0 = slot_of[2 * t], s1 = slot_of[2 * t + 1]; const float w0 = tok_w[2 * t], w1 = tok_w[2 * t + 1];
        f32x4* xr = (f32x4*)(x + (size_t)t * D);
        const u32x2* a = (const u32x2*)(ob + (size_t)s0 * D); const u32x2* b = (const u32x2*)(ob + (size_t)s1 * D);
        f32x4 v[8]; float ss = 0.f;
#pragma unroll
        for (int j = 0; j < 8; ++j) { const u32x2 av = a[lane + 64 * j], bv = b[lane + 64 * j]; f32x4 xv = xr[lane + 64 * j];
            xv[0] += w0 * bf_lo(av.x) + w1 * bf_lo(bv.x); xv[1] += w0 * bf_hi(av.x) + w1 * bf_hi(bv.x);
            xv[2] += w0 * bf_lo(av.y) + w1 * bf_lo(bv.y); xv[3] += w0 * bf_hi(av.y) + w1 * bf_hi(bv.y);
            v[j] = xv; ss += (xv[0] * xv[0] + xv[1] * xv[1]) + (xv[2] * xv[2] + xv[3] * xv[3]); }
        const float rstd = 1.0f / sqrtf(wave_sum(ss) * (1.0f / D) + RMS_EPS);
        if (MODE == 0) {
            u32x2* orow = (u32x2*)(hn + (size_t)t * D);
#pragma unroll
            for (int j = 0; j < 8; ++j) { xr[lane + 64 * j] = v[j]; const f32x4 y = v[j] * rstd * g4[j]; u32x2 w; w.x = cvt_pk_bf16(y[0], y[1]); w.y = cvt_pk_bf16(y[2], y[3]); orow[lane + 64 * j] = w; }
        } else {
#pragma unroll
            for (int j = 0; j < 8; ++j) xr[lane + 64 * j] = v[j] * rstd * g4[j];
        }
    }
}

__device__ __forceinline__ void phase_subln(Frame& F, const bf16_t* o1, const bf16_t* o2, const float* lq1, const float* lk1, const float* lq2, const float* lk2, const float* sg, bf16_t* y) {
    const int gw = F.vcu * NWAVES + F.wave, NGW = F.G * NWAVES, lane = F.lane;
    const float d1 = wave_sum(lq1[lane] * lk1[lane] + lq1[lane + 64] * lk1[lane + 64]);
    const float d2 = wave_sum(lq2[lane] * lk2[lane] + lq2[lane + 64] * lk2[lane + 64]);
    const float lam = __expf(d1) - __expf(d2) + LAMBDA_INIT;
    const f32x4 g = ((const f32x4*)sg)[lane] * (1.0f - LAMBDA_INIT);
    for (int idx = gw; idx < T * DIFF_H; idx += NGW) {
        const int tok = idx >> 3, h = idx & 7;
        const u32x2 a = *(const u32x2*)(o1 + (size_t)tok * D + h * 256 + 4 * lane), b = *(const u32x2*)(o2 + (size_t)tok * D + h * 256 + 4 * lane);
        f32x4 d; d[0] = bf_lo(a.x) - lam * bf_lo(b.x); d[1] = bf_hi(a.x) - lam * bf_hi(b.x); d[2] = bf_lo(a.y) - lam * bf_lo(b.y); d[3] = bf_hi(a.y) - lam * bf_hi(b.y);
        const float ss = (d[0] * d[0] + d[1] * d[1]) + (d[2] * d[2] + d[3] * d[3]);
        const float rstd = 1.0f / sqrtf(wave_sum(ss) * (1.0f / 256.0f) + RMS_EPS);
        const f32x4 yv = d * rstd * g;
        u32x2 w; w.x = cvt_pk_bf16(yv[0], yv[1]); w.y = cvt_pk_bf16(yv[2], yv[3]);
        *(u32x2*)(y + (size_t)tok * D + h * 256 + 4 * lane) = w;
    }
}

namespace att {
constexpr int SHM_K = 64 * 128 * 2, SHM_V = 64 * 256 * 2;
constexpr int V_OFF = 0, K_OFF = 2 * SHM_V, SCR_OFF = 2 * SHM_V + 2 * SHM_K;
constexpr float SCALE = 0.08838834764831845f;
constexpr float C2 = 1.4426950408889634f * SCALE;
constexpr float THR = 8.f;
#define KSWZ(row, colB) ((row) * 256 + ((colB) ^ (((row) & 7) << 4)))
__device__ __forceinline__ int crow(int r, int hi) { return (r & 3) + 8 * (r >> 2) + 4 * hi; }
__device__ __forceinline__ int v_rd_base(int lane) { return ((lane & 3) << 3) | (((lane >> 2) & 3) << 6) | (((lane >> 4) & 1) << 5) | (((lane >> 5) & 1) << 8); }
constexpr int v_rd_off(int d0, int ks, int half) { return d0 * 512 + ks * 8192 + half * 4096; }

template <int KB>
__device__ __forceinline__ void qkt(f32x16& p0, f32x16& p1, LAS unsigned char* lds, int r32, int hi, const bf16x8 (&qr)[8]) {
    const LAS unsigned char* kb[4];
#pragma unroll
    for (int dd = 0; dd < 4; ++dd) kb[dd] = lds + K_OFF + KB * SHM_K + KSWZ(r32, (dd * 16 + hi * 8) * 2);
#pragma unroll
    for (int d0 = 0; d0 < 8; ++d0) { const LAS unsigned char* a = kb[d0 & 3] + (d0 >> 2) * 128;
        const bf16x8 b0 = *(const LAS bf16x8*)a;
        const bf16x8 b1 = *(const LAS bf16x8*)(a + 32 * 256);
        p0 = __builtin_amdgcn_mfma_f32_32x32x16_bf16(b0, qr[d0], p0, 0, 0, 0);
        p1 = __builtin_amdgcn_mfma_f32_32x32x16_bf16(b1, qr[d0], p1, 0, 0, 0); }
}
template <int VB>
__device__ __forceinline__ void pv_tile(f32x16 (&o)[8], unsigned vb0, bf16x8 pa0, bf16x8 pa1, bf16x8 pa2, bf16x8 pa3) {
#define TRRD(dst, off) asm volatile("ds_read_b64_tr_b16 %0, %1 offset:%2" : "=&v"(dst) : "v"(vb0), "i"(off) : "memory")
#define PV_D0(d0) do { s16x4 l0, l1, l2, l3, h0, h1, h2, h3; constexpr int b_ = V_OFF + VB * SHM_V + v_rd_off(d0, 0, 0); \
        TRRD(l0, b_); TRRD(h0, b_ + 4096); TRRD(l1, b_ + 8192); TRRD(h1, b_ + 12288); TRRD(l2, b_ + 16384); TRRD(h2, b_ + 20480); TRRD(l3, b_ + 24576); TRRD(h3, b_ + 28672); \
        asm volatile("s_waitcnt lgkmcnt(0)" ::: "memory"); __builtin_amdgcn_sched_barrier(0); \
        o[d0] = __builtin_amdgcn_mfma_f32_32x32x16_bf16(pa0, (bf16x8){l0[0], l0[1], l0[2], l0[3], h0[0], h0[1], h0[2], h0[3]}, o[d0], 0, 0, 0); \
        o[d0] = __builtin_amdgcn_mfma_f32_32x32x16_bf16(pa1, (bf16x8){l1[0], l1[1], l1[2], l1[3], h1[0], h1[1], h1[2], h1[3]}, o[d0], 0, 0, 0); \
        o[d0] = __builtin_amdgcn_mfma_f32_32x32x16_bf16(pa2, (bf16x8){l2[0], l2[1], l2[2], l2[3], h2[0], h2[1], h2[2], h2[3]}, o[d0], 0, 0, 0); \
        o[d0] = __builtin_amdgcn_mfma_f32_32x32x16_bf16(pa3, (bf16x8){l3[0], l3[1], l3[2], l3[3], h3[0], h3[1], h3[2], h3[3]}, o[d0], 0, 0, 0); } while (0)
    PV_D0(0); PV_D0(1); PV_D0(2); PV_D0(3); PV_D0(4); PV_D0(5); PV_D0(6); PV_D0(7);
#undef PV_D0
#undef TRRD
}

__device__ __forceinline__ void stage_offsets(int tid, unsigned (&koff)[2], unsigned (&voff)[4]) {
#pragma unroll
    for (int i = 0; i < 2; ++i) { const int P = tid * 16 + i * 8192, row = P >> 8, ch = ((P & 255) >> 4) ^ (row & 7); koff[i] = (unsigned)(row * 128 + ch * 8) * 2u; }
#pragma unroll
    for (int i = 0; i < 4; ++i) { const int P = tid * 16 + i * 8192, st = P >> 9, kk = ((st >> 3) << 3) | ((P & 511) >> 6), cg = st & 7, cin = (P & 63) >> 1;
        const int key = (kk & ~0xC) | ((kk & 4) << 1) | ((kk & 8) >> 1); voff[i] = (unsigned)(key * 256 + cg * 32 + cin) * 2u; }
}
__device__ __forceinline__ const char* uniform_ptr(const void* p) {
    const unsigned long long v = (unsigned long long)p;
    const unsigned lo = __builtin_amdgcn_readfirstlane((unsigned)v), hi = __builtin_amdgcn_readfirstlane((unsigned)(v >> 32));
    return (const char*)(((unsigned long long)hi << 32) | lo);
}
__device__ __forceinline__ void stage_tile(LAS unsigned char* lds, int bf, const bf16_t* kj_, const bf16_t* vj_, int tid_, int wid) {
    const char* kj = uniform_ptr(kj_); const char* vj = uniform_ptr(vj_);
    int tid = tid_; asm volatile("" : "+v"(tid));
    unsigned koff[2], voff[4]; stage_offsets(tid, koff, voff);
#pragma unroll
    for (int i = 0; i < 2; ++i) __builtin_amdgcn_global_load_lds((const unsigned*)(kj + koff[i]), (LAS unsigned*)(lds + K_OFF + bf * SHM_K + wid * 1024 + i * 8192), 16, 0, 0);
#pragma unroll
    for (int i = 0; i < 4; ++i) __builtin_amdgcn_global_load_lds((const unsigned*)(vj + voff[i]), (LAS unsigned*)(lds + V_OFF + bf * SHM_V + wid * 1024 + i * 8192), 16, 0, 0);
}

template <int BF>
__device__ __forceinline__ void tile_compute(LAS unsigned char* lds, int r32, int hi, unsigned vb0, LAS float* al_l, const bf16x8 (&qr)[8], f32x16 (&o)[8],
                                             float& m_reg, float& l_reg, float rawu, float sl2, bool diag, int qi) {
    f32x16 p0, p1;
#pragma unroll
    for (int r = 0; r < 16; ++r) { p0[r] = 0.f; p1[r] = 0.f; }
    qkt<BF>(p0, p1, lds, r32, hi, qr);
#pragma unroll
    for (int r = 0; r < 16; ++r) { const float cr = (float)((r & 3) + 8 * (r >> 2)); p0[r] = fmaf(cr, rawu, p0[r]); p1[r] = fmaf(cr, rawu, p1[r]); }
    if (diag) {
        const float k2raw = 2.f * rawu;
        int qi_ = qi - 4 * hi; asm volatile("" : "+v"(qi_));
#pragma unroll
        for (int r = 0; r < 16; ++r) { const int c = (r & 3) + 8 * (r >> 2); const int d0_ = c - qi_, d1_ = c + 32 - qi_;
            p0[r] -= k2raw * (float)(d0_ > 0 ? d0_ : 0); p1[r] -= k2raw * (float)(d1_ > 0 ? d1_ : 0); }
    }
    const float lane_raw = rawu * (float)(4 * hi), d32raw = 32.f * rawu;
    float pm0 = p0[0], pm1 = p1[0];
#pragma unroll
    for (int r = 1; r < 16; ++r) { pm0 = fmaxf(pm0, p0[r]); pm1 = fmaxf(pm1, p1[r]); }
    float pmax = fmaxf(pm0, pm1 + d32raw) + lane_raw;
    { auto rr = __builtin_amdgcn_permlane32_swap(__float_as_uint(pmax), __float_as_uint(pmax), false, false);
      pmax = fmaxf(__uint_as_float(rr[0]), __uint_as_float(rr[1])); }
    float mn, alpha;
    if (__all((pmax - m_reg) * SCALE <= THR)) { mn = m_reg; alpha = 1.f; }
    else { mn = fmaxf(m_reg, pmax); alpha = __builtin_amdgcn_exp2f((m_reg - mn) * C2); m_reg = mn; }
    const float mnL0 = (lane_raw - mn) * C2, mnL1 = mnL0 + 32.f * sl2;
#pragma unroll
    for (int r = 0; r < 16; ++r) { p0[r] = __builtin_amdgcn_exp2f(fmaf(p0[r], C2, mnL0)); p1[r] = __builtin_amdgcn_exp2f(fmaf(p1[r], C2, mnL1)); }
    if (__any(alpha < 1.f)) {
        if (hi == 0) al_l[r32] = alpha;
        LDS_WAIT();
#pragma unroll
        for (int r = 0; r < 16; ++r) { const float a = al_l[crow(r, hi)];
#pragma unroll
            for (int d = 0; d < 8; ++d) o[d][r] *= a; }
    }
    float ps = 0.f;
#pragma unroll
    for (int r = 0; r < 16; ++r) ps += p0[r] + p1[r];
    { auto rr = __builtin_amdgcn_permlane32_swap(__float_as_uint(ps), __float_as_uint(ps), false, false);
      ps = __uint_as_float(rr[0]) + __uint_as_float(rr[1]); }
    l_reg = l_reg * alpha + ps;
    bf16x8 pa0, pa1, pa2, pa3;
#define PK4(P, B_, OUT) do { unsigned a0 = cvt_pk_bf16(P[B_+0], P[B_+1]), a1 = cvt_pk_bf16(P[B_+2], P[B_+3]); \
        unsigned b0 = cvt_pk_bf16(P[B_+4], P[B_+5]), b1 = cvt_pk_bf16(P[B_+6], P[B_+7]); \
        auto r0 = __builtin_amdgcn_permlane32_swap(a0, b0, false, false); auto r1 = __builtin_amdgcn_permlane32_swap(a1, b1, false, false); \
        u32x4 w = {r0[0], r1[0], r0[1], r1[1]}; OUT = __builtin_bit_cast(bf16x8, w); } while (0)
    PK4(p0, 0, pa0); PK4(p0, 8, pa1); PK4(p1, 0, pa2); PK4(p1, 8, pa3);
#undef PK4
    pv_tile<BF>(o, vb0, pa0, pa1, pa2, pa3);
}

__device__ __forceinline__ void norms_phase(Frame& F, const bf16_t* proj, float* nrm) {
    const int gw = F.vcu * NWAVES + F.wave, NGW = F.G * NWAVES, lane = F.lane;
    for (int idx = gw; idx < 2 * 32 * 256; idx += NGW) {
        const int tensor = idx >> 13, stream = (idx >> 8) & 31, grp = idx & 255;
        const u32x4* rp = (const u32x4*)(proj + (tensor ? DK0 : 0) + ((size_t)stream * SEQ + grp * 64 + lane) * 128);
        float ss = 0.f;
#pragma unroll
        for (int q = 0; q < 16; ++q) { const u32x4 v = rp[q];
#pragma unroll
            for (int e = 0; e < 4; ++e) { const float lo = bf_lo(v[e]), hi = bf_hi(v[e]); ss += lo * lo + hi * hi; } }
        float n = sqrtf(ss) * 1.001f;
#pragma unroll
        for (int o = 1; o < 64; o <<= 1) n = fmaxf(n, __shfl_xor(n, o));
        if (lane == 0) nrm[idx] = n;
    }
}

__device__ __forceinline__ void attn_item(LAS unsigned char* lds, const bf16_t* proj, const float* nrm, bf16_t* oout, int b, int h, int sub, int qb, int tid, int wid, int lane) {
    const int r32 = lane & 31, hi = lane >> 5;
    const float slope = __builtin_amdgcn_exp2f(-(float)(h + 1));
    const float sl2 = slope * 1.4426950408889634f, rawu = sl2 / C2;
    LAS float* ws = (LAS float*)(lds + SCR_OFF) + wid * 64; LAS float* li_l = ws; LAS float* al_l = ws + 32;
    const size_t tokq = (size_t)b * SEQ + (size_t)qb * 256 + wid * 32;
    const bf16_t* kbase = proj + DK0 + dq_off(b, 0, h, sub);
    const bf16_t* vbase = proj + dv_off(b, 0, h);
    int j_lo;
    { const int stream = (b * 8 + h) * 2 + sub; const float* qn = nrm + stream * 256; const float* kn = nrm + 8192 + stream * 256;
      const float Qn = fmaxf(fmaxf(qn[4 * qb], qn[4 * qb + 1]), fmaxf(qn[4 * qb + 2], qn[4 * qb + 3]));
      const float Kd = fmaxf(fmaxf(kn[4 * qb], kn[4 * qb + 1]), fmaxf(kn[4 * qb + 2], kn[4 * qb + 3]));
      int cand = 4 * qb;
      for (int jj = lane; jj < 4 * qb; jj += 64) { const float dmin = (float)(256 * qb - (64 * jj + 63)); const bool skip = slope * dmin > 110.f + SCALE * Qn * (kn[jj] + Kd); if (!skip) cand = cand < jj ? cand : jj; }
#pragma unroll
      for (int o = 1; o < 64; o <<= 1) { const int v = __shfl_xor(cand, o); cand = v < cand ? v : cand; }
      j_lo = __builtin_amdgcn_readfirstlane(cand); }
    bf16x8 qr[8];
#pragma unroll
    for (int d0 = 0; d0 < 8; ++d0) qr[d0] = *(const bf16x8*)(proj + dq_off(b, qb * 256 + wid * 32 + r32, h, sub) + d0 * 16 + hi * 8);
    const float sh64 = 64.f * rawu;
    const int qi = 32 * (wid & 1) + r32;
    const unsigned vb0 = (unsigned)(uintptr_t)(lds + V_OFF) + (unsigned)v_rd_base(lane);
    float m_reg = -1e30f, l_reg = 0.f;
    f32x16 o[8];
#pragma unroll
    for (int d = 0; d < 8; ++d)
#pragma unroll
        for (int r = 0; r < 16; ++r) o[d][r] = 0.f;
    const int NT = 4 * qb + 4, myNT = 4 * qb + (wid >> 1) + 1;
    constexpr size_t KSTEP = 64 * 128, VSTEP = 64 * 256;
    stage_tile(lds, 0, kbase + (size_t)j_lo * KSTEP, vbase + (size_t)j_lo * VSTEP, tid, wid);
    VM_WAIT(); WG_BAR();
    for (int j = j_lo; j < NT; j += 2) {
        if (j + 1 < NT) stage_tile(lds, 1, kbase + (size_t)(j + 1) * KSTEP, vbase + (size_t)(j + 1) * VSTEP, tid, wid);
        if (j < myNT) { if (j > j_lo) m_reg -= sh64; tile_compute<0>(lds, r32, hi, vb0, al_l, qr, o, m_reg, l_reg, rawu, sl2, j == myNT - 1, qi); }
        VM_WAIT(); WG_BAR();
        if (j + 2 < NT) stage_tile(lds, 0, kbase + (size_t)(j + 2) * KSTEP, vbase + (size_t)(j + 2) * VSTEP, tid, wid);
        if (j + 1 < myNT) { m_reg -= sh64; tile_compute<1>(lds, r32, hi, vb0, al_l, qr, o, m_reg, l_reg, rawu, sl2, j + 1 == myNT - 1, qi); }
        VM_WAIT(); WG_BAR();
    }
    if (hi == 0) li_l[r32] = l_reg;
    LDS_WAIT();
    char* Ow = (char*)(oout + tokq * D + h * 256);
    const unsigned lofs = (unsigned)(hi * 4 * D + r32) * 2u;
#pragma unroll
    for (int r = 0; r < 16; ++r) { const float rl = __builtin_amdgcn_rcpf(li_l[crow(r, hi)]);
#pragma unroll
        for (int d0 = 0; d0 < 8; ++d0) { const float v = o[d0][r] * rl; const float vn = __shfl_xor(v, 1);
            if ((r32 & 1) == 0) *(unsigned*)(Ow + (lofs + (unsigned)((((r & 3) + 8 * (r >> 2)) * D + d0 * 32) * 2))) = cvt_pk_bf16(v, vn); } }
    WG_BAR();
}

__device__ __forceinline__ void attn_phase(Frame& F, const bf16_t* proj, const float* nrm, unsigned* queue, bf16_t* o1, bf16_t* o2) {
    LAS int* qw = (LAS int*)(F.lds + SCR_OFF + 8 * 256);
    for (;;) {
        if (F.tid == 0) *qw = (int)__hip_atomic_fetch_add(queue, 1u, __ATOMIC_RELAXED, __HIP_MEMORY_SCOPE_AGENT);
        WG_BAR();
        const int I = __builtin_amdgcn_readfirstlane(*qw);
        if (I >= 2048) break;
        const int qb = 63 - (I >> 5), r = I & 31, h = 7 - (r >> 2), b = (r >> 1) & 1, sub = r & 1;
        attn_item(F.lds, proj, nrm, sub ? o2 : o1, b, h, sub, qb, F.tid, F.wave, F.lane);
    }
}
}

__global__ void __launch_bounds__(NWAVES * 64, 2) hybrid_fwd(Args args) {
    extern __shared__ __attribute__((aligned(16))) unsigned char lds_raw[];
    Frame F;
    F.lds = (LAS unsigned char*)lds_raw;
    F.tid = threadIdx.x; F.lane = F.tid & 63; F.wave = __builtin_amdgcn_readfirstlane(F.tid >> 6);
    F.G = gridDim.x; { const int bx = blockIdx.x; F.vcu = (F.G % 8 == 0) ? (bx % 8) * (F.G / 8) + bx / 8 : bx; }
    unsigned char* ws = args.ws;
    unsigned* ctl = (unsigned*)(ws + WS_CTL);
    for (int u = F.tid; u < (LDS_BYTES - LDSCTL_OFF) / 4; u += NWAVES * 64) ((LAS unsigned*)(F.lds + LDSCTL_OFF))[u] = 0u;
    __syncthreads();
    volatile LAS unsigned* MISC = (volatile LAS unsigned*)(F.lds + MISC_OFF);
    XcdBarrier bar = xcd_barrier_post(ctl + CW_BAR, MISC + 8);
#define GRID_BAR() xcd_barrier(bar)
#ifdef ONLY_PHASE
#define PHON(n) ((n) == ONLY_PHASE)
#elif DIAG
#define PHON(n) ((n) <= args.upto)
#else
#define PHON(n) 1
#endif

    const float* x_in = args.in[0]; const float* norm_mix = args.in[1]; const float* norm_ffn = args.in[2];
    const float* gla_w_in = args.in[3]; const float* gla_wgu = args.in[4]; const float* gla_bg = args.in[5]; const float* gla_norm = args.in[6]; const float* gla_w_out = args.in[7];
    const float* diff_w_in = args.in[8]; const float* lq1 = args.in[9]; const float* lk1 = args.in[10]; const float* lq2 = args.in[11]; const float* lk2 = args.in[12];
    const float* diff_subln = args.in[13]; const float* diff_w_out = args.in[14];
    const float* moe_wgrp = args.in[15]; const float* moe_wexp = args.in[16]; const float* moe_wg = args.in[17]; const float* moe_wu = args.in[18]; const float* moe_wd = args.in[19];
    const float* final_norm = args.in[20];
    float* xres = args.out;
    float* gz = (float*)(ws + WS_GZ);
    int* tok_e = (int*)(ws + WS_TOKE); int* tok_p = (int*)(ws + WS_TOKP); float* tok_w = (float*)(ws + WS_TOKW); int* slot_of = (int*)(ws + WS_SLOT);
    float* adec = (float*)(ws + WS_ADEC);
    float* wp_gz = (float*)(ws + WS_WPGZ); float* wp_r0 = (float*)(ws + WS_WPR0); float* wp_r1 = (float*)(ws + WS_WPR1);
    bf16_t* wgi = (bf16_t*)(ws + WS_WGI); bf16_t* wgo = (bf16_t*)(ws + WS_WGO); bf16_t* wdi = (bf16_t*)(ws + WS_WDI); bf16_t* wdo = (bf16_t*)(ws + WS_WDO);
    bf16_t* wmoe_gu = (bf16_t*)(ws + WS_WMOE); bf16_t* wmoe_d = (bf16_t*)(ws + WS_WMOE_D);
    bf16_t* hn = (bf16_t*)(ws + WS_HN); bf16_t* proj = (bf16_t*)(ws + WS_PROJ); bf16_t* buf1 = (bf16_t*)(ws + WS_BUF1); bf16_t* buf2 = (bf16_t*)(ws + WS_BUF2);
    bf16_t* ag = (bf16_t*)(ws + WS_AG); bf16_t* ob = (bf16_t*)(ws + WS_OB); bf16_t* hh = (bf16_t*)(ws + WS_H);
    const LAS int* pst = (const LAS int*)(F.lds + TAB_OFF);

    _Pragma("unroll") for (int rep_ = 0; rep_ < (REP_PHASE == 0 ? 2 : 1); ++rep_) if (PHON(0)) { if (rep_) GRID_BAR(); Frame P = F; P.tid = opq(F.tid); P.lane = P.tid & 63;
    conv_plain(P, gla_w_in, D, PROJW, GLA_INW, wgi);
    conv_plain(P, gla_w_out, D, D, D, wgo);
    conv_plain(P, diff_w_in, D, PROJW, PROJW, wdi);
    conv_plain(P, diff_w_out, D, D, D, wdo);
    conv_moe(P, moe_wg, moe_wu, moe_wd, wmoe_gu, wmoe_d);
    pack_proj(P, wp_gz, 1, norm_mix, gla_w_in, GLA_INW, PROJW, 16, nullptr, 0, 0);
    pack_proj(P, wp_r0, 3, norm_ffn, moe_wgrp, 4, 0, 4, moe_wexp, 32, 32);
    pack_proj(P, wp_r1, 3, norm_ffn + D, moe_wgrp + (size_t)D * 4, 4, 0, 4, moe_wexp + (size_t)D * 32, 32, 32);
    }
    GRID_BAR();
    _Pragma("unroll") for (int rep_ = 0; rep_ < (REP_PHASE == 1 ? 2 : 1); ++rep_) if (PHON(1)) { if (rep_) GRID_BAR(); Frame P = F; P.tid = opq(F.tid); P.lane = P.tid & 63;
    phase_norm_gz(P, x_in, norm_mix, wp_gz, hn, gz);
    }
    GRID_BAR();
    _Pragma("unroll") for (int rep_ = 0; rep_ < (REP_PHASE == 2 ? 2 : 1); ++rep_) if (PHON(2)) { if (rep_) GRID_BAR(); Frame P = F; P.tid = opq(F.tid); P.lane = P.tid & 63;
    { pg8::Gemm g{hn, wgi, T, PROJW, D}; pg8::StaticOrder S; S.init(T, PROJW, P.G, (int)blockIdx.x); pg8::EpiHeads<0> E{proj};
      pg8::gemm_phase<pg8::EpiHeads<0>, pg8::StaticOrder>(P.lds, g, S, E); }
    }
    GRID_BAR();
    _Pragma("unroll") for (int rep_ = 0; rep_ < (REP_PHASE == 3 ? 2 : 1); ++rep_) if (PHON(3)) { if (rep_) GRID_BAR(); Frame P = F; P.tid = opq(F.tid); P.lane = P.tid & 63;
    phase_gla_gate(P, gz, gla_wgu, gla_bg, proj, buf1, adec);
    }
    GRID_BAR();
    _Pragma("unroll") for (int rep_ = 0; rep_ < (REP_PHASE == 4 ? 2 : 1); ++rep_) if (PHON(4)) { if (rep_) GRID_BAR(); Frame P = F; P.tid = opq(F.tid); P.lane = P.tid & 63;
    phase_gla_scan(P, proj, buf1, adec, buf2);
    }
    GRID_BAR();
    _Pragma("unroll") for (int rep_ = 0; rep_ < (REP_PHASE == 5 ? 2 : 1); ++rep_) if (PHON(5)) { if (rep_) GRID_BAR(); Frame P = F; P.tid = opq(F.tid); P.lane = P.tid & 63;
    phase_gla_gnorm(P, buf2, proj, gla_norm, hn);
    }
    GRID_BAR();
    _Pragma("unroll") for (int rep_ = 0; rep_ < (REP_PHASE == 6 ? 2 : 1); ++rep_) if (PHON(6)) { if (rep_) GRID_BAR(); Frame P = F; P.tid = opq(F.tid); P.lane = P.tid & 63;
    { pg8::Gemm g{hn, wgo, T, D, D}; pg8::StaticOrder S; S.init(T, D, P.G, (int)blockIdx.x); pg8::EpiResF32 E{x_in, xres, D};
      pg8::gemm_phase<pg8::EpiResF32, pg8::StaticOrder>(P.lds, g, S, E); }
    }
    GRID_BAR();
    _Pragma("unroll") for (int rep_ = 0; rep_ < (REP_PHASE == 7 ? 2 : 1); ++rep_) if (PHON(7)) { if (rep_) GRID_BAR(); Frame P = F; P.tid = opq(F.tid); P.lane = P.tid & 63;
    phase_norm_route(P, xres, norm_ffn, wp_r0, hn, tok_e, tok_p, tok_w, ctl + CW_CNT0);
    }
    GRID_BAR();
    _Pragma("unroll") for (int rep_ = 0; rep_ < (REP_PHASE == 8 ? 2 : 1); ++rep_) if (PHON(8)) { if (rep_) GRID_BAR(); Frame P = F; P.tid = opq(F.tid); P.lane = P.tid & 63;
    moe_tables(P, ctl + CW_CNT0);
    phase_moe_gather(P, tok_e, tok_p, slot_of, hn, ag);
    }
    GRID_BAR();
    _Pragma("unroll") for (int rep_ = 0; rep_ < (REP_PHASE == 9 ? 2 : 1); ++rep_) if (PHON(9)) { if (rep_) GRID_BAR(); Frame P = F; P.tid = opq(F.tid); P.lane = P.tid & 63;
    { const int Mr = pst[33] * 256; pg8::Gemm g{ag, wmoe_gu, Mr, 1024, D}; pg8::MoeOrder S; S.init(Mr, 1024, P.G, (int)blockIdx.x); S.te = pst + 36; S.estride = (size_t)1024 * D * 2; pg8::EpiSiluMul E{hh};
      pg8::gemm_phase<pg8::EpiSiluMul, pg8::MoeOrder>(P.lds, g, S, E); }
    }
    GRID_BAR();
    _Pragma("unroll") for (int rep_ = 0; rep_ < (REP_PHASE == 10 ? 2 : 1); ++rep_) if (PHON(10)) { if (rep_) GRID_BAR(); Frame P = F; P.tid = opq(F.tid); P.lane = P.tid & 63;
    { const int Mr = pst[33] * 256; pg8::Gemm g{hh, wmoe_d, Mr, D, DFF}; pg8::MoeOrder S; S.init(Mr, D, P.G, (int)blockIdx.x); S.te = pst + 36; S.estride = (size_t)D * DFF * 2; pg8::EpiBf16 E{ob, D};
      pg8::gemm_phase<pg8::EpiBf16, pg8::MoeOrder>(P.lds, g, S, E); }
    }
    GRID_BAR();
    _Pragma("unroll") for (int rep_ = 0; rep_ < (REP_PHASE == 11 ? 2 : 1); ++rep_) if (PHON(11)) { if (rep_) GRID_BAR(); Frame P = F; P.tid = opq(F.tid); P.lane = P.tid & 63;
    phase_moe_combine<0>(P, xres, ob, slot_of, tok_w, norm_mix + D, hn);
    conv_moe(P, moe_wg + (size_t)NEXP * D * DFF, moe_wu + (size_t)NEXP * D * DFF, moe_wd + (size_t)NEXP * DFF * D, wmoe_gu, wmoe_d);
    }
    GRID_BAR();
    _Pragma("unroll") for (int rep_ = 0; rep_ < (REP_PHASE == 12 ? 2 : 1); ++rep_) if (PHON(12)) { if (rep_) GRID_BAR(); Frame P = F; P.tid = opq(F.tid); P.lane = P.tid & 63;
    { pg8::Gemm g{hn, wdi, T, PROJW, D}; pg8::StaticOrder S; S.init(T, PROJW, P.G, (int)blockIdx.x); pg8::EpiHeads<1> E{proj};
      pg8::gemm_phase<pg8::EpiHeads<1>, pg8::StaticOrder>(P.lds, g, S, E); }
    GRID_BAR();
    att::norms_phase(P, proj, (float*)(ws + WS_NRM));
    }
    GRID_BAR();
    _Pragma("unroll") for (int rep_ = 0; rep_ < (REP_PHASE == 13 ? 2 : 1); ++rep_) if (PHON(13)) { if (rep_) GRID_BAR(); Frame P = F; P.tid = opq(F.tid); P.lane = P.tid & 63;
    att::attn_phase(P, proj, (const float*)(ws + WS_NRM), ctl + CW_QUEUE, buf1, buf2);
    }
    GRID_BAR();
    _Pragma("unroll") for (int rep_ = 0; rep_ < (REP_PHASE == 14 ? 2 : 1); ++rep_) if (PHON(14)) { if (rep_) GRID_BAR(); Frame P = F; P.tid = opq(F.tid); P.lane = P.tid & 63;
    phase_subln(P, buf1, buf2, lq1, lk1, lq2, lk2, diff_subln, hn);
    }
    GRID_BAR();
    _Pragma("unroll") for (int rep_ = 0; rep_ < (REP_PHASE == 15 ? 2 : 1); ++rep_) if (PHON(15)) { if (rep_) GRID_BAR(); Frame P = F; P.tid = opq(F.tid); P.lane = P.tid & 63;
    { pg8::Gemm g{hn, wdo, T, D, D}; pg8::StaticOrder S; S.init(T, D, P.G, (int)blockIdx.x); pg8::EpiResF32 E{xres, xres, D};
      pg8::gemm_phase<pg8::EpiResF32, pg8::StaticOrder>(P.lds, g, S, E); }
    }
    GRID_BAR();
    _Pragma("unroll") for (int rep_ = 0; rep_ < (REP_PHASE == 16 ? 2 : 1); ++rep_) if (PHON(16)) { if (rep_) GRID_BAR(); Frame P = F; P.tid = opq(F.tid); P.lane = P.tid & 63;
    phase_norm_route(P, xres, norm_ffn + D, wp_r1, hn, tok_e, tok_p, tok_w, ctl + CW_CNT1);
    }
    GRID_BAR();
    _Pragma("unroll") for (int rep_ = 0; rep_ < (REP_PHASE == 17 ? 2 : 1); ++rep_) if (PHON(17)) { if (rep_) GRID_BAR(); Frame P = F; P.tid = opq(F.tid); P.lane = P.tid & 63;
    moe_tables(P, ctl + CW_CNT1);
    phase_moe_gather(P, tok_e, tok_p, slot_of, hn, ag);
    }
    GRID_BAR();
    _Pragma("unroll") for (int rep_ = 0; rep_ < (REP_PHASE == 18 ? 2 : 1); ++rep_) if (PHON(18)) { if (rep_) GRID_BAR(); Frame P = F; P.tid = opq(F.tid); P.lane = P.tid & 63;
    { const int Mr = pst[33] * 256; pg8::Gemm g{ag, wmoe_gu, Mr, 1024, D}; pg8::MoeOrder S; S.init(Mr, 1024, P.G, (int)blockIdx.x); S.te = pst + 36; S.estride = (size_t)1024 * D * 2; pg8::EpiSiluMul E{hh};
      pg8::gemm_phase<pg8::EpiSiluMul, pg8::MoeOrder>(P.lds, g, S, E); }
    }
    GRID_BAR();
    _Pragma("unroll") for (int rep_ = 0; rep_ < (REP_PHASE == 19 ? 2 : 1); ++rep_) if (PHON(19)) { if (rep_) GRID_BAR(); Frame P = F; P.tid = opq(F.tid); P.lane = P.tid & 63;
    { const int Mr = pst[33] * 256; pg8::Gemm g{hh, wmoe_d, Mr, D, DFF}; pg8::MoeOrder S; S.init(Mr, D, P.G, (int)blockIdx.x); S.te = pst + 36; S.estride = (size_t)D * DFF * 2; pg8::EpiBf16 E{ob, D};
      pg8::gemm_phase<pg8::EpiBf16, pg8::MoeOrder>(P.lds, g, S, E); }
    }
    GRID_BAR();
    _Pragma("unroll") for (int rep_ = 0; rep_ < (REP_PHASE == 20 ? 2 : 1); ++rep_) if (PHON(20)) { if (rep_) GRID_BAR(); Frame P = F; P.tid = opq(F.tid); P.lane = P.tid & 63;
    phase_moe_combine<1>(P, xres, ob, slot_of, tok_w, final_norm, hn);
    }
}

#if DIAG
constexpr size_t WS_DIAG = WS_END;
constexpr int NSAVE = 64;
__device__ inline unsigned hsh(unsigned x) { x ^= x >> 16; x *= 0x7feb352dU; x ^= x >> 15; x *= 0x846ca68bU; x ^= x >> 16; return x; }
__device__ inline void rep(unsigned* w, double got, double ref, double scale) { double e = fabs(got - ref) / (fabs(ref) + scale); float ef = (float)e; if (!(ef == ef) || ef > 1e30f) ef = 1e30f; atomicMax(w, __float_as_uint(ef)); }
__device__ inline double bfd(bf16_t v) { return (double)bf2f(v); }
#define GTID (blockIdx.x * blockDim.x + threadIdx.x)
#define GSTR (gridDim.x * blockDim.x)

__global__ void ck_weights(const float* gla_w_in, const float* gla_w_out, const float* diff_w_in, const float* diff_w_out, const bf16_t* wgi, const bf16_t* wgo, const bf16_t* wdi, const bf16_t* wdo,
                           const float* norm_mix, const float* norm_ffn, const float* wgrp, const float* wexp, const float* wp_gz, const float* wp_r0, const float* wp_r1, unsigned* w) {
    for (unsigned i = GTID; i < 65536u; i += GSTR) { const unsigned r = hsh(i * 3u + 1u), r2 = hsh(i * 7u + 5u);
        const int n = r % 6144u, k = r2 % 2048u, n2 = n % 2048;
        rep(w, bfd(wgi[(size_t)n * D + k]), gla_w_in[(size_t)k * GLA_INW + n], 0.02); rep(w, bfd(wdi[(size_t)n * D + k]), diff_w_in[(size_t)k * PROJW + n], 0.02);
        rep(w, bfd(wgo[(size_t)n2 * D + k]), gla_w_out[(size_t)k * D + n2], 0.02); rep(w, bfd(wdo[(size_t)n2 * D + k]), diff_w_out[(size_t)k * D + n2], 0.02);
        const int s = r % 128u, ln = (r >> 7) % 64u, e4 = (r >> 13) & 3, kk = 16 * s + 4 * (ln >> 4) + e4, col = ln & 15, nt = (r >> 15) % 3u, col3 = 16 * nt + col;
        rep(w, wp_gz[(s * 64 + ln) * 4 + e4], (double)norm_mix[kk] * gla_w_in[(size_t)kk * GLA_INW + PROJW + col], 0.02);
        for (int L = 0; L < 2; ++L) { const float* gr = wgrp + (size_t)L * D * 4; const float* ex = wexp + (size_t)L * D * 32; const float* nf = norm_ffn + L * D;
            const double ref = col3 < 4 ? gr[kk * 4 + col3] : (col3 < 36 ? ex[kk * 32 + col3 - 4] : 0.0);
            rep(w, (L ? wp_r1 : wp_r0)[((s * 3 + nt) * 64 + ln) * 4 + e4], (double)nf[kk] * ref, 0.02); } }
}
__global__ void ck_moew(const float* wg, const float* wu, const float* wd, const bf16_t* GU, const bf16_t* DT, unsigned* w) {
    for (unsigned i = GTID; i < 65536u; i += GSTR) { const unsigned r = hsh(i * 5u + 2u), r2 = hsh(i * 11u + 3u);
        const int e = r % 32u, f = (r >> 5) % 512u, k = r2 % 2048u, n2 = (r2 >> 11) % 2048u, rowg = 256 * (f >> 7) + (f & 127);
        rep(w, bfd(GU[((size_t)e * 1024 + rowg) * D + k]), wg[((size_t)e * D + k) * DFF + f], 0.02); rep(w, bfd(GU[((size_t)e * 1024 + rowg + 128) * D + k]), wu[((size_t)e * D + k) * DFF + f], 0.02);
        rep(w, bfd(DT[((size_t)e * D + n2) * DFF + f]), wd[((size_t)e * DFF + f) * D + n2], 0.05); }
}
__global__ void ck_norm(const float* x, const float* gain, const bf16_t* hn, unsigned* w) {
    for (unsigned i = GTID; i < 4096u; i += GSTR) { const unsigned r = hsh(i * 13u + 7u); const int t = r % (unsigned)T, j = (r >> 15) % 2048u;
        double ss = 0; for (int k = 0; k < D; ++k) { const double v = x[(size_t)t * D + k]; ss += v * v; }
        const double rstd = 1.0 / sqrt(ss / D + 1e-6); rep(w, bfd(hn[(size_t)t * D + j]), x[(size_t)t * D + j] * rstd * gain[j], 1.0); }
}
__global__ void ck_gz(const float* x, const float* gain, const float* gla_w_in, const float* gz, unsigned* w) {
    for (unsigned i = GTID; i < 4096u; i += GSTR) { const unsigned r = hsh(i * 17u + 9u); const int t = r % (unsigned)T, c = (r >> 15) % 16u;
        double ss = 0, dot = 0; for (int k = 0; k < D; ++k) { const double v = x[(size_t)t * D + k]; ss += v * v; dot += v * gain[k] * gla_w_in[(size_t)k * GLA_INW + PROJW + c]; }
        rep(w, gz[(size_t)t * 16 + c], dot / sqrt(ss / D + 1e-6), 1.0); }
}
__global__ void ck_gemm(const bf16_t* A, const bf16_t* Bt, const bf16_t* C, int M, int N, int K, int ldc, double scale, unsigned* w) {
    for (unsigned i = GTID; i < 16384u; i += GSTR) { const unsigned r = hsh(i * 19u + 11u), r2 = hsh(i * 23u + 1u); const int m = r % (unsigned)M, n = r2 % (unsigned)N;
        double s = 0; for (int k = 0; k < K; ++k) s += bfd(A[(size_t)m * K + k]) * bfd(Bt[(size_t)n * K + k]);
        rep(w, bfd(C[(size_t)m * ldc + n]), s, scale); }
}
__global__ void ck_proj(const bf16_t* A, const bf16_t* Bt, const bf16_t* proj, int layer, unsigned* w) {
    for (unsigned i = GTID; i < 16384u; i += GSTR) { const unsigned r = hsh(i * 19u + 11u), r2 = hsh(i * 23u + 1u); const int m = r % (unsigned)T, n = r2 % (unsigned)PROJW, b = m >> 14, t = m & (SEQ - 1);
        double s = 0; for (int k = 0; k < D; ++k) s += bfd(A[(size_t)m * D + k]) * bfd(Bt[(size_t)n * D + k]);
        size_t off;
        if (layer == 0) { if (n < 1024) off = gq_off(b, t, n >> 8) + (n & 255); else if (n < 2048) off = GK0 + gq_off(b, t, (n - 1024) >> 8) + (n & 255); else if (n < 4096) off = gv_off(b, t, (n - 2048) >> 9) + (n & 511); else off = GR0 + (size_t)m * 2048 + (n - 4096); }
        else { if (n < 2048) off = dq_off(b, t, n >> 8, (n >> 7) & 1) + (n & 127); else if (n < 4096) off = DK0 + dq_off(b, t, (n - 2048) >> 8, (n >> 7) & 1) + (n & 127); else off = dv_off(b, t, (n - 4096) >> 8) + (n & 255); }
        rep(w, bfd(proj[off]), s, 1.0); }
}
__device__ inline int srow(int i) { return (int)(hsh(i * 29u + 13u) % (unsigned)T); }
__global__ void ck_save(const float* x, float* save) { for (unsigned i = GTID; i < (unsigned)NSAVE * D; i += GSTR) save[i] = x[(size_t)srow(i / D) * D + (i % D)]; }
__global__ void ck_gemm_res(const bf16_t* A, const bf16_t* Bt, const float* base, int saved, const float* out, unsigned* w) {
    for (unsigned i = GTID; i < (unsigned)NSAVE * 64u; i += GSTR) { const int si = i / 64, t = srow(si), n = hsh(i * 31u + 5u) % 2048u;
        double s = 0; for (int k = 0; k < D; ++k) s += bfd(A[(size_t)t * D + k]) * bfd(Bt[(size_t)n * D + k]);
        const double b = saved ? base[(size_t)si * D + n] : base[(size_t)t * D + n];
        rep(w, out[(size_t)t * D + n], b + s, 1.0); }
}
__global__ void ck_gate(const float* gz, const float* wgu, const float* bg, const bf16_t* proj, const bf16_t* kdT, const float* adec, unsigned* w) {
    for (unsigned i = GTID; i < 4096u; i += GSTR) { const unsigned r = hsh(i * 37u + 3u); const int bc = r % 512u, j = (r >> 9) % 1024u, tq = (r >> 19) % 64u;
        double run = 0, ct = 0;
        for (int t = 0; t < 64; ++t) { double z = bg[j]; for (int q = 0; q < 16; ++q) z += (double)gz[((size_t)bc * 64 + t) * 16 + q] * wgu[q * 1024 + j];
            const double ls = fmin(z, 0.0) - log1p(exp(-fabs(z))); run += ls / 16.0; if (t == tq) ct = run; }
        rep(w, adec[(size_t)bc * 1024 + j], exp(run), 1.0);
        rep(w, bfd(kdT[((size_t)bc * 1024 + j) * 64 + tq]), bfd(proj[GK0 + gq_off(bc >> 8, (bc & 255) * 64 + tq, j >> 8) + (j & 255)]) * exp(run - ct), 1.0); }
}
__global__ void ck_scan(const bf16_t* proj, const bf16_t* kdT, const float* adec, const bf16_t* o, unsigned* w) {
    const int wv = GTID / 64, lane = threadIdx.x & 63, nw = GSTR / 64;
    const int cl[8] = {0, 1, 3, 17, 100, 255, 2, 64};
    for (int s = wv; s < 96; s += nw) { const unsigned r = hsh(s * 41u + 17u); const int b = r & 1, c = cl[s % 8], tl = (r >> 1) % 64u, h = (r >> 7) % 4u, vc = (r >> 9) % 512u;
        float S[4] = {0.f, 0.f, 0.f, 0.f};
        for (int cc = 0; cc <= c; ++cc) { const size_t bc = (size_t)b * NCH + cc;
            for (int q = 0; q < 4; ++q) { const int kr = h * 256 + lane * 4 + q; float a = 0.f;
                for (int t = 0; t < 64; ++t) a += bf2f(kdT[(bc * 1024 + kr) * 64 + t]) * bf2f(proj[gv_off(b, cc * 64 + t, h) + vc]);
                S[q] = adec[bc * 1024 + kr] * S[q] + a; } }
        float part = 0.f; const size_t tok = (size_t)b * SEQ + c * 64 + tl;
        for (int q = 0; q < 4; ++q) part += bf2f(proj[gq_off(b, c * 64 + tl, h) + lane * 4 + q]) * S[q];
        for (int of = 1; of < 64; of <<= 1) part += __shfl_xor(part, of);
        if (lane == 0) rep(w, bfd(o[tok * D + h * 512 + vc]), part / 16.0, 2.0); }
}
__global__ void ck_gnorm(const bf16_t* o, const bf16_t* proj, const float* gn, const bf16_t* y, unsigned* w) {
    for (unsigned i = GTID; i < 8192u; i += GSTR) { const unsigned r = hsh(i * 43u + 19u); const int t = r % (unsigned)T, h = (r >> 15) % 4u, j = (r >> 17) % 512u;
        double ss = 0; for (int k = 0; k < 512; ++k) { const double v = bfd(o[(size_t)t * D + h * 512 + k]); ss += v * v; }
        const double rr = bfd(proj[GR0 + (size_t)t * 2048 + h * 512 + j]);
        rep(w, bfd(y[(size_t)t * D + h * 512 + j]), bfd(o[(size_t)t * D + h * 512 + j]) / sqrt(ss / 512 + 1e-6) * gn[j] * rr / (1.0 + exp(-rr)), 1.0); }
}
__global__ void ck_route(const float* x, const float* gain, const float* wgrp, const float* wexp, const int* tok_e, const int* tok_p, const float* tok_w, const unsigned* cnt, unsigned* w) {
    for (unsigned i = GTID; i < 512u; i += GSTR) { const int t = hsh(i * 47u + 23u) % (unsigned)T;
        double ss = 0; for (int k = 0; k < D; ++k) { const double v = x[(size_t)t * D + k]; ss += v * v; }
        const double rstd = 1.0 / sqrt(ss / D + 1e-6);
        double gl[4] = {0, 0, 0, 0};
        for (int k = 0; k < D; ++k) { const double v = x[(size_t)t * D + k] * rstd * gain[k]; for (int q = 0; q < 4; ++q) gl[q] += v * wgrp[k * 4 + q]; }
        int gi = 0; for (int q = 1; q < 4; ++q) if (gl[q] > gl[gi]) gi = q;
        double gs = 0; for (int q = 0; q < 4; ++q) gs += exp(gl[q] - gl[gi]);
        double el[8] = {0, 0, 0, 0, 0, 0, 0, 0};
        for (int k = 0; k < D; ++k) { const double v = x[(size_t)t * D + k] * rstd * gain[k]; for (int q = 0; q < 8; ++q) el[q] += v * wexp[k * 32 + gi * 8 + q]; }
        int i1 = 0; for (int q = 1; q < 8; ++q) if (el[q] > el[i1]) i1 = q;
        int i2 = (i1 == 0) ? 1 : 0; for (int q = 0; q < 8; ++q) if (q != i1 && el[q] > el[i2]) i2 = q;
        const double eb = exp(el[i2] - el[i1]);
        const int e1 = tok_e[2 * t], e2 = tok_e[2 * t + 1];
        double third = -1e30; for (int q = 0; q < 8; ++q) if (q != i1 && q != i2 && el[q] > third) third = el[q];
        const bool tie = (el[i2] - third) < 1e-4 || (el[i1] - el[i2]) < 1e-4;
        if (!tie) { rep(w, e1, gi * 8 + i1, 1.0); rep(w, e2, gi * 8 + i2, 1.0);
            rep(w, tok_w[2 * t], 1.0 / gs / (1.0 + eb), 0.3); rep(w, tok_w[2 * t + 1], eb / gs / (1.0 + eb), 0.3); }
        if ((unsigned)tok_p[2 * t] >= cnt[64 * (e1 & 31)] || (unsigned)tok_p[2 * t + 1] >= cnt[64 * (e2 & 31)]) rep(w, 9.0, 0.0, 1.0); }
}
__global__ void ck_gather(const int* tok_e, const int* tok_p, const int* slot_of, const unsigned* cnt, const bf16_t* hn, const bf16_t* ag, unsigned* w) {
    for (unsigned i = GTID; i < 8192u; i += GSTR) { const unsigned r = hsh(i * 53u + 29u); const int a = r % (2u * T), k = (r >> 16) % 2048u, e = tok_e[a] & 31;
        int ps = 0; for (int q = 0; q < e; ++q) ps += ((int)cnt[64 * q] + 255) & ~255;
        const int slot = slot_of[a];
        rep(w, slot, ps + tok_p[a], 1.0);
        if (slot >= 0 && slot < MAX_TILES * 256) rep(w, bfd(ag[(size_t)slot * D + k]), bfd(hn[(size_t)(a >> 1) * D + k]), 1.0); }
}
__global__ void ck_moe1(const int* tok_e, const int* slot_of, const bf16_t* ag, const float* wg, const float* wu, const bf16_t* hh, unsigned* w) {
    for (unsigned i = GTID; i < 8192u; i += GSTR) { const unsigned r = hsh(i * 59u + 31u); const int a = r % (2u * T), f = (r >> 16) % 512u, e = tok_e[a] & 31, slot = slot_of[a];
        if (slot < 0 || slot >= MAX_TILES * 256) { rep(w, 9.0, 0.0, 1.0); continue; }
        double g = 0, u = 0; for (int k = 0; k < D; ++k) { const double v = bfd(ag[(size_t)slot * D + k]); g += v * wg[((size_t)e * D + k) * DFF + f]; u += v * wu[((size_t)e * D + k) * DFF + f]; }
        rep(w, bfd(hh[(size_t)slot * DFF + f]), g / (1.0 + exp(-g)) * u, 0.5); }
}
__global__ void ck_moe2(const int* tok_e, const int* slot_of, const bf16_t* hh, const float* wd, const bf16_t* ob, unsigned* w) {
    for (unsigned i = GTID; i < 8192u; i += GSTR) { const unsigned r = hsh(i * 61u + 37u); const int a = r % (2u * T), n = (r >> 16) % 2048u, e = tok_e[a] & 31, slot = slot_of[a];
        if (slot < 0 || slot >= MAX_TILES * 256) { rep(w, 9.0, 0.0, 1.0); continue; }
        double s = 0; for (int f = 0; f < DFF; ++f) s += bfd(hh[(size_t)slot * DFF + f]) * wd[((size_t)e * DFF + f) * D + n];
        rep(w, bfd(ob[(size_t)slot * D + n]), s, 0.3); }
}
__global__ void ck_combine(const float* save, const bf16_t* ob, const int* slot_of, const float* tok_w, const float* gain, const float* x, const bf16_t* hn, int mode, unsigned* w) {
    for (unsigned i = GTID; i < (unsigned)NSAVE * 32u; i += GSTR) { const int si = i / 32, t = srow(si), j = hsh(i * 67u + 41u) % 2048u;
        const int s0 = slot_of[2 * t], s1 = slot_of[2 * t + 1]; const double w0 = tok_w[2 * t], w1 = tok_w[2 * t + 1];
        double ss = 0, xj = 0; for (int k = 0; k < D; ++k) { const double v = save[(size_t)si * D + k] + w0 * bfd(ob[(size_t)s0 * D + k]) + w1 * bfd(ob[(size_t)s1 * D + k]); ss += v * v; if (k == j) xj = v; }
        const double y = xj / sqrt(ss / D + 1e-6) * gain[j];
        if (mode == 0) { rep(w, x[(size_t)t * D + j], xj, 1.0); rep(w, bfd(hn[(size_t)t * D + j]), y, 1.0); } else rep(w, x[(size_t)t * D + j], y, 1.0); }
}
__global__ void ck_attn(const bf16_t* proj, const bf16_t* o1, const bf16_t* o2, unsigned* w) {
    const int wv = GTID / 64, lane = threadIdx.x & 63, nw = GSTR / 64;
    const int tl[12] = {0, 1, 63, 64, 100, 255, 256, 1000, 4095, 8191, 16320, 16383};
    for (int s = wv; s < 96; s += nw) { const unsigned r = hsh(s * 71u + 43u); const int b = r & 1, h = (r >> 1) % 8u, sub = (r >> 4) & 1, t = tl[s % 12], dv0 = (r >> 5) % 253u;
        const double slope = exp2(-(double)(h + 1)); const int kend = 64 * (t / 64 + 1);
        const bf16_t* qp = proj + dq_off(b, t, h, sub);
        double mx = -1e300;
        for (int j = lane; j < kend; j += 64) { const bf16_t* kp = proj + DK0 + dq_off(b, j, h, sub); double d = 0; for (int q = 0; q < 128; ++q) d += bfd(qp[q]) * bfd(kp[q]);
            const double sc = d * 0.08838834764831845 - slope * fabs((double)(t - j)); if (sc > mx) mx = sc; }
        for (int of = 1; of < 64; of <<= 1) { const double o_ = __shfl_xor(mx, of); if (o_ > mx) mx = o_; }
        double l = 0, acc[4] = {0, 0, 0, 0};
        for (int j = lane; j < kend; j += 64) { const bf16_t* kp = proj + DK0 + dq_off(b, j, h, sub); double d = 0; for (int q = 0; q < 128; ++q) d += bfd(qp[q]) * bfd(kp[q]);
            const double p = exp(d * 0.08838834764831845 - slope * fabs((double)(t - j)) - mx); l += p;
            const bf16_t* vp = proj + dv_off(b, j, h) + dv0; for (int q = 0; q < 4; ++q) acc[q] += p * bfd(vp[q]); }
        for (int of = 1; of < 64; of <<= 1) { l += __shfl_xor(l, of); for (int q = 0; q < 4; ++q) acc[q] += __shfl_xor(acc[q], of); }
        if (lane == 0) for (int q = 0; q < 4; ++q) rep(w, bfd((sub ? o2 : o1)[((size_t)b * SEQ + t) * D + h * 256 + dv0 + q]), acc[q] / l, 0.2); }
}
__global__ void ck_subln(const bf16_t* o1, const bf16_t* o2, const float* lq1, const float* lk1, const float* lq2, const float* lk2, const float* sg, const bf16_t* y, unsigned* w) {
    double d1 = 0, d2 = 0; for (int k = 0; k < 128; ++k) { d1 += (double)lq1[k] * lk1[k]; d2 += (double)lq2[k] * lk2[k]; }
    const double li = 0.8 - 0.6 * exp(-0.3), lam = exp(d1) - exp(d2) + li;
    for (unsigned i = GTID; i < 8192u; i += GSTR) { const unsigned r = hsh(i * 73u + 47u); const int t = r % (unsigned)T, h = (r >> 15) % 8u, j = (r >> 18) % 256u;
        double ss = 0, dj = 0; for (int k = 0; k < 256; ++k) { const double v = bfd(o1[(size_t)t * D + h * 256 + k]) - lam * bfd(o2[(size_t)t * D + h * 256 + k]); ss += v * v; if (k == j) dj = v; }
        rep(w, bfd(y[(size_t)t * D + h * 256 + j]), dj / sqrt(ss / 256 + 1e-6) * sg[j] * (1.0 - li), 1.0); }
}
__global__ void ck_final(const unsigned* words, int nst, float* out, int n) {
    int val = 0;
    for (int s = 0; s < nst; ++s) { const float e = __uint_as_float(words[s]); if (e >= 0.03125f) { val = 4 * s + (e < 0.25f ? 1 : (e < 4.f ? 2 : 3)); break; } }
    const float c = sqrtf(0.1f * (float)val);
    for (int i = GTID; i < n; i += GSTR) out[i] = c;
}
#endif

extern "C" void kernel_launch(void* const* d_in, const int* in_sizes, int n_in, void* d_out, int out_size, void* d_ws, size_t ws_size, hipStream_t stream) {
    static int grid = 0;
    if (grid == 0) {
        if (n_in != 21 || out_size != T * D || ws_size < WS_END + 2 * MiB) { fprintf(stderr, "kernel_launch: unexpected shapes (n_in %d out %d ws %zu)\n", n_in, out_size, ws_size); grid = -1; return; }
        if (hipFuncSetAttribute((const void*)hybrid_fwd, hipFuncAttributeMaxDynamicSharedMemorySize, LDS_BYTES) != hipSuccess) { fprintf(stderr, "kernel_launch: hipFuncSetAttribute failed\n"); grid = -1; return; }
        int dev = 0, cus = 0, per_cu = 0;
        (void)hipGetDevice(&dev); (void)hipDeviceGetAttribute(&cus, hipDeviceAttributeMultiprocessorCount, dev);
        if (hipOccupancyMaxActiveBlocksPerMultiprocessor(&per_cu, (const void*)hybrid_fwd, NWAVES * 64, LDS_BYTES) != hipSuccess || per_cu < 1) fprintf(stderr, "kernel_launch: occupancy query says %d\n", per_cu);
        (void)hipGetLastError();
        grid = cus > 0 ? cus : 256;
    }
    if (grid < 0) return;
    Args a{};
    for (int i = 0; i < 21; ++i) a.in[i] = (const float*)d_in[i];
    a.out = (float*)d_out; a.ws = (unsigned char*)d_ws; a.upto = 99; a.pad1 = 0;
#if !DIAG
    (void)hipMemsetAsync((char*)d_ws + WS_CTL, 0, CTL_ZERO_BYTES, stream);
    hipLaunchKernelGGL(hybrid_fwd, dim3(grid), dim3(NWAVES * 64), LDS_BYTES, stream, a);
#else
    {
        unsigned char* ws = (unsigned char*)d_ws; const float* const* in = a.in;
        unsigned* words = (unsigned*)(ws + WS_DIAG); float* save = (float*)(ws + WS_DIAG + 65536);
        (void)hipMemsetAsync(words, 0, 65536, stream);
        float* gz = (float*)(ws + WS_GZ); int* tok_e = (int*)(ws + WS_TOKE); int* tok_p = (int*)(ws + WS_TOKP); float* tok_w = (float*)(ws + WS_TOKW); int* slot_of = (int*)(ws + WS_SLOT);
        float* adec = (float*)(ws + WS_ADEC); float* wp_gz = (float*)(ws + WS_WPGZ); float* wp_r0 = (float*)(ws + WS_WPR0); float* wp_r1 = (float*)(ws + WS_WPR1);
        bf16_t* wgi = (bf16_t*)(ws + WS_WGI); bf16_t* wgo = (bf16_t*)(ws + WS_WGO); bf16_t* wdi = (bf16_t*)(ws + WS_WDI); bf16_t* wdo = (bf16_t*)(ws + WS_WDO);
        bf16_t* gu = (bf16_t*)(ws + WS_WMOE); bf16_t* dt = (bf16_t*)(ws + WS_WMOE_D);
        bf16_t* hn = (bf16_t*)(ws + WS_HN); bf16_t* proj = (bf16_t*)(ws + WS_PROJ); bf16_t* buf1 = (bf16_t*)(ws + WS_BUF1); bf16_t* buf2 = (bf16_t*)(ws + WS_BUF2);
        bf16_t* ag = (bf16_t*)(ws + WS_AG); bf16_t* ob = (bf16_t*)(ws + WS_OB); bf16_t* hh = (bf16_t*)(ws + WS_H);
        unsigned* ctl = (unsigned*)(ws + WS_CTL); float* xres = (float*)d_out;
        const size_t L1W = (size_t)NEXP * D * DFF;
        for (int st = 0; st <= 20; ++st) {
            (void)hipMemsetAsync((char*)d_ws + WS_CTL, 0, CTL_ZERO_BYTES, stream);
            a.upto = st;
            hipLaunchKernelGGL(hybrid_fwd, dim3(grid), dim3(NWAVES * 64), LDS_BYTES, stream, a);
            unsigned* w = words + st;
            switch (st) {
            case 0: ck_weights<<<256, 256, 0, stream>>>(in[3], in[7], in[8], in[14], wgi, wgo, wdi, wdo, in[1], in[2], in[15], in[16], wp_gz, wp_r0, wp_r1, w);
                    ck_moew<<<256, 256, 0, stream>>>(in[17], in[18], in[19], gu, dt, w); break;
            case 1: ck_norm<<<64, 64, 0, stream>>>(in[0], in[1], hn, w); ck_gz<<<64, 64, 0, stream>>>(in[0], in[1], in[3], gz, w); break;
            case 2: ck_proj<<<256, 64, 0, stream>>>(hn, wgi, proj, 0, w); break;
            case 3: ck_gate<<<64, 64, 0, stream>>>(gz, in[4], in[5], proj, buf1, adec, w); break;
            case 4: ck_scan<<<96, 64, 0, stream>>>(proj, buf1, adec, buf2, w); break;
            case 5: ck_gnorm<<<128, 64, 0, stream>>>(buf2, proj, in[6], hn, w); break;
            case 6: ck_gemm_res<<<64, 64, 0, stream>>>(hn, wgo, in[0], 0, xres, w); break;
            case 7: ck_norm<<<64, 64, 0, stream>>>(xres, in[2], hn, w); ck_route<<<8, 64, 0, stream>>>(xres, in[2], in[15], in[16], tok_e, tok_p, tok_w, ctl + CW_CNT0, w); break;
            case 8: ck_gather<<<128, 64, 0, stream>>>(tok_e, tok_p, slot_of, ctl + CW_CNT0, hn, ag, w); break;
            case 9: ck_moe1<<<128, 64, 0, stream>>>(tok_e, slot_of, ag, in[17], in[18], hh, w); break;
            case 10: ck_moe2<<<128, 64, 0, stream>>>(tok_e, slot_of, hh, in[19], ob, w); ck_save<<<64, 256, 0, stream>>>(xres, save); break;
            case 11: ck_combine<<<32, 64, 0, stream>>>(save, ob, slot_of, tok_w, in[1] + D, xres, hn, 0, w); ck_moew<<<256, 256, 0, stream>>>(in[17] + L1W, in[18] + L1W, in[19] + L1W, gu, dt, w); break;
            case 12: ck_proj<<<256, 64, 0, stream>>>(hn, wdi, proj, 1, w); break;
            case 13: ck_attn<<<96, 64, 0, stream>>>(proj, buf1, buf2, w); break;
            case 14: ck_subln<<<128, 64, 0, stream>>>(buf1, buf2, in[9], in[10], in[11], in[12], in[13], hn, w); ck_save<<<64, 256, 0, stream>>>(xres, save); break;
            case 15: ck_gemm_res<<<64, 64, 0, stream>>>(hn, wdo, save, 1, xres, w); break;
            case 16: ck_norm<<<64, 64, 0, stream>>>(xres, in[2] + D, hn, w); ck_route<<<8, 64, 0, stream>>>(xres, in[2] + D, in[15] + (size_t)D * 4, in[16] + (size_t)D * 32, tok_e, tok_p, tok_w, ctl + CW_CNT1, w); break;
            case 17: ck_gather<<<128, 64, 0, stream>>>(tok_e, tok_p, slot_of, ctl + CW_CNT1, hn, ag, w); break;
            case 18: ck_moe1<<<128, 64, 0, stream>>>(tok_e, slot_of, ag, in[17] + L1W, in[18] + L1W, hh, w); break;
            case 19: ck_moe2<<<128, 64, 0, stream>>>(tok_e, slot_of, hh, in[19] + L1W, ob, w); ck_save<<<64, 256, 0, stream>>>(xres, save); break;
            case 20: ck_combine<<<32, 64, 0, stream>>>(save, ob, slot_of, tok_w, in[20], xres, hn, 1, w); break;
            }
        }
        ck_final<<<1024, 256, 0, stream>>>(words, 21, (float*)d_out, out_size);
    }
#endif
}
```

```cpp
#ifndef DIAG
#define DIAG 0
#endif
#ifndef PROBE
#define PROBE 0
#endif
#ifndef REP_PHASE
#define REP_PHASE -1
#endif
#include <hip/hip_runtime.h>
#include <cstdio>
#include <cstdint>

#define LAS __attribute__((address_space(3)))
#define GAS __attribute__((address_space(1)))
typedef unsigned short bf16_t;
typedef short bf16x8 __attribute__((ext_vector_type(8)));
typedef short s16x4 __attribute__((ext_vector_type(4)));
typedef float f32x4 __attribute__((ext_vector_type(4)));
typedef float f32x2 __attribute__((ext_vector_type(2)));
typedef float f32x16 __attribute__((ext_vector_type(16)));
typedef unsigned u32x4 __attribute__((ext_vector_type(4)));
typedef unsigned u32x2 __attribute__((ext_vector_type(2)));

constexpr int D = 2048, SEQ = 16384, NBATCH = 2, T = NBATCH * SEQ, CHUNK = 64, NCH = SEQ / CHUNK;
constexpr int GLA_H = 4, GLA_DK = 256, GLA_DV = 512, GLA_DKT = 1024, GLA_INW = 6160, PROJW = 6144;
constexpr int DIFF_H = 8;
constexpr int NEXP = 32, DFF = 512;
constexpr float RMS_EPS = 1e-6f;
constexpr float LAMBDA_INIT = 0.35550906759f;
constexpr int MAX_TILES = 288;

constexpr size_t MiB = 1u << 20;
constexpr size_t WS_CTL = 0, CTL_ZERO_BYTES = 1 * MiB;
constexpr size_t WS_GZ = 2 * MiB;
constexpr size_t WS_TOKE = 4 * MiB;
constexpr size_t WS_TOKP = WS_TOKE + 256 * 1024;
constexpr size_t WS_TOKW = WS_TOKP + 256 * 1024;
constexpr size_t WS_SLOT = WS_TOKW + 256 * 1024;
constexpr size_t WS_ADEC = 8 * MiB;
constexpr size_t WS_WPGZ = 10 * MiB;
constexpr size_t WS_WPR0 = 10 * MiB + 256 * 1024;
constexpr size_t WS_WPR1 = 11 * MiB;
constexpr size_t WS_NRM = 12 * MiB;
constexpr size_t WS_WGI = 16 * MiB, WS_WGO = 40 * MiB, WS_WDI = 48 * MiB, WS_WDO = 72 * MiB;
constexpr size_t WS_WMOE = 80 * MiB;
constexpr size_t WS_WMOE_D = WS_WMOE + 128 * MiB;
constexpr size_t WS_HN = 272 * MiB;
constexpr size_t WS_PROJ = 400 * MiB;
constexpr size_t WS_BUF1 = 784 * MiB;
constexpr size_t WS_BUF2 = 912 * MiB;
constexpr size_t WS_AG = 400 * MiB;
constexpr size_t WS_OB = 688 * MiB;
constexpr size_t WS_H = 976 * MiB;
constexpr size_t WS_END = 1048 * MiB;
constexpr int CW_BAR = 4096;
constexpr int CW_PROBE = 8320;
constexpr int CW_QUEUE = 8192;
constexpr int CW_CNT0 = 16384, CW_CNT1 = 16384 + 32 * 64;


constexpr size_t GK0 = (size_t)T * 1024, GV0 = (size_t)T * 2048, GR0 = (size_t)T * 4096;
constexpr size_t DK0 = (size_t)T * 2048, DV0 = (size_t)T * 4096;
__host__ __device__ __forceinline__ size_t gq_off(int b, int t, int h) { return ((size_t)(b * 4 + h) * SEQ + t) * 256; }
__host__ __device__ __forceinline__ size_t gv_off(int b, int t, int h) { return GV0 + ((size_t)(b * 4 + h) * SEQ + t) * 512; }
__host__ __device__ __forceinline__ size_t dq_off(int b, int t, int h, int sub) { return ((size_t)((b * 8 + h) * 2 + sub) * SEQ + t) * 128; }
__host__ __device__ __forceinline__ size_t dv_off(int b, int t, int h) { return DV0 + ((size_t)(b * 8 + h) * SEQ + t) * 256; }

constexpr int RING_BYTES = 131072;
constexpr int LDSCTL_OFF = RING_BYTES;
constexpr int MISC_OFF = LDSCTL_OFF + 320;
constexpr int TAB_OFF = LDSCTL_OFF + 1024;
constexpr int LDS_BYTES = 147456;
constexpr int NWAVES = 8;

typedef __bf16 bf16x2_t __attribute__((ext_vector_type(2)));
__device__ __forceinline__ unsigned cvt_pk_bf16(float lo, float hi) { const f32x2 v = {lo, hi}; return __builtin_bit_cast(unsigned, __builtin_convertvector(v, bf16x2_t)); }
__device__ __forceinline__ float bf_lo(unsigned w) { return __uint_as_float(w << 16); }
__device__ __forceinline__ float bf_hi(unsigned w) { return __uint_as_float(w & 0xffff0000u); }
__device__ __forceinline__ float bf2f(bf16_t b) { return __uint_as_float(((unsigned)b) << 16); }
__device__ __forceinline__ float wave_sum(float v) {
#pragma unroll
    for (int o = 1; o < 64; o <<= 1) v += __shfl_xor(v, o);
    return v;
}
__device__ __forceinline__ int opq(int v) { asm volatile("" : "+v"(v)); return v; }
#define LDS_WAIT() asm volatile("s_waitcnt lgkmcnt(0)" ::: "memory")
#define VM_WAIT() asm volatile("s_waitcnt vmcnt(0)" ::: "memory")
#define WG_BAR() do { asm volatile("s_waitcnt lgkmcnt(0)" ::: "memory"); __builtin_amdgcn_s_barrier(); asm volatile("" ::: "memory"); } while (0)

namespace pg8 {
constexpr int BM = 256, BK = 64, HALF = 128, HTB = HALF * BK * 2, STAGE_BYTES = 8 * HTB, NXCD = 8, WGM = 8;
__host__ __device__ __forceinline__ int lds_byte(int r, int c) { const int st = (r >> 4) * 2 + (c >> 5), rr = r & 15, cc = c & 31, ob = rr * 64 + cc * 2; return st * 1024 + (ob ^ (((ob >> 9) & 1) << 5)); }
__host__ __device__ __forceinline__ void stage_rc(int b, int& R, int& C) { const int st = b / 1024, sb = b % 1024, swz = sb ^ (((sb >> 9) & 1) << 5); R = (st >> 1) * 16 + swz / 64; C = (st & 1) * 32 + (swz % 64) / 2; }
__host__ __device__ __forceinline__ int perm32(int rho) { const int n = rho >> 4, i = rho & 15; return 8 * (i >> 2) + 4 * n + (i & 3); }

struct Unit { int pm, pn; };
struct Gemm { const bf16_t* A; const bf16_t* Bt; int M, N, K; };

struct StaticOrder {
    int nM, nN, nwg, G, c;
    __device__ void init(int M, int N, int G_, int c_) { nM = M / BM; nN = N / BM; nwg = nM * nN; G = G_; c = c_; }
    __device__ bool next(int i, Unit& u) const {
        const long L = (long)i * G + c; if (L >= nwg) return false;
        int wgid = (int)L; { const int q = nwg / NXCD, r = nwg % NXCD, xcd = wgid % NXCD, off = wgid / NXCD; wgid = (xcd < r ? xcd * (q + 1) : r * (q + 1) + (xcd - r) * q) + off; }
        const int nig = WGM * nN, gid = wgid / nig, fm = gid * WGM, gsz = (nM - fm) < WGM ? (nM - fm) : WGM;
        u.pm = fm + ((wgid % nig) % gsz); u.pn = (wgid % nig) / gsz; return true;
    }
    __device__ __forceinline__ size_t bofs(const Unit&) const { return 0; }
};
struct MoeOrder : StaticOrder {
    const LAS int* te; size_t estride;
    __device__ __forceinline__ size_t bofs(const Unit& u) const { return (size_t)te[u.pm] * estride; }
};

struct EpiBf16 {
    static constexpr bool PERM = true;
    bf16_t* O; int ldc;
    __device__ __forceinline__ void operator()(const f32x4 (&acc)[2][2][4][2], const Unit& u, int wr, int wc, int fr, int fq) const {
        const int row0 = u.pm * BM + wr * 64 + fr, col0 = u.pn * BM + wc * 32 + 8 * fq;
#pragma unroll
        for (int ai = 0; ai < 2; ++ai)
#pragma unroll
            for (int m = 0; m < 4; ++m) { bf16_t* rowp = O + (size_t)(row0 + ai * HALF + m * 16) * ldc + col0;
#pragma unroll
                for (int bj = 0; bj < 2; ++bj) { const f32x4 v0 = acc[ai][bj][m][0], v1 = acc[ai][bj][m][1];
                    u32x4 w; w.x = cvt_pk_bf16(v0[0], v0[1]); w.y = cvt_pk_bf16(v0[2], v0[3]); w.z = cvt_pk_bf16(v1[0], v1[1]); w.w = cvt_pk_bf16(v1[2], v1[3]);
                    *(u32x4*)(rowp + bj * HALF) = w; } }
    }
};
template <int LAYER> struct EpiHeads {
    static constexpr bool PERM = true;
    bf16_t* O;
    __device__ __forceinline__ void operator()(const f32x4 (&acc)[2][2][4][2], const Unit& u, int wr, int wc, int fr, int fq) const {
        const int pn = u.pn, lc = wc * 32 + 8 * fq;
#pragma unroll
        for (int ai = 0; ai < 2; ++ai)
#pragma unroll
            for (int m = 0; m < 4; ++m) { const int row = u.pm * BM + ai * HALF + wr * 64 + m * 16 + fr, b = row >> 14, t = row & (SEQ - 1);
#pragma unroll
                for (int bj = 0; bj < 2; ++bj) { size_t off;
                    if (LAYER == 0) { if (pn < 4) off = gq_off(b, t, pn) + bj * 128 + lc; else if (pn < 8) off = GK0 + gq_off(b, t, pn - 4) + bj * 128 + lc;
                                      else if (pn < 16) off = gv_off(b, t, (pn - 8) >> 1) + ((pn - 8) & 1) * 256 + bj * 128 + lc; else off = GR0 + (size_t)row * 2048 + (pn - 16) * 256 + bj * 128 + lc; }
                    else { if (pn < 8) off = dq_off(b, t, pn, bj) + lc; else if (pn < 16) off = DK0 + dq_off(b, t, pn - 8, bj) + lc; else off = dv_off(b, t, pn - 16) + bj * 128 + lc; }
                    const f32x4 v0 = acc[ai][bj][m][0], v1 = acc[ai][bj][m][1];
                    u32x4 w; w.x = cvt_pk_bf16(v0[0], v0[1]); w.y = cvt_pk_bf16(v0[2], v0[3]); w.z = cvt_pk_bf16(v1[0], v1[1]); w.w = cvt_pk_bf16(v1[2], v1[3]);
                    *(u32x4*)(O + off) = w; } }
    }
};
struct EpiResF32 {
    static constexpr bool PERM = false;
    const float* base; float* C; int ldc;
    __device__ __forceinline__ void operator()(const f32x4 (&acc)[2][2][4][2], const Unit& u, int wr, int wc, int fr, int fq) const {
        const int row0 = u.pm * BM + wr * 64 + fr, col0 = u.pn * BM + wc * 32 + 4 * fq;
#pragma unroll
        for (int ai = 0; ai < 2; ++ai)
#pragma unroll
            for (int m = 0; m < 4; ++m) { const size_t off = (size_t)(row0 + ai * HALF + m * 16) * ldc + col0;
#pragma unroll
                for (int bj = 0; bj < 2; ++bj)
#pragma unroll
                    for (int n = 0; n < 2; ++n) { const f32x4 bs = *(const f32x4*)(base + off + bj * HALF + n * 16); *(f32x4*)(C + off + bj * HALF + n * 16) = bs + acc[ai][bj][m][n]; }
                asm volatile("" ::: "memory"); }
    }
};
struct EpiSiluMul {
    static constexpr bool PERM = true;
    bf16_t* Hh;
    __device__ __forceinline__ void operator()(const f32x4 (&acc)[2][2][4][2], const Unit& u, int wr, int wc, int fr, int fq) const {
        const int row0 = u.pm * BM + wr * 64 + fr, col0 = u.pn * HALF + wc * 32 + 8 * fq;
#pragma unroll
        for (int ai = 0; ai < 2; ++ai)
#pragma unroll
            for (int m = 0; m < 4; ++m) { bf16_t* rowp = Hh + (size_t)(row0 + ai * HALF + m * 16) * DFF + col0;
                float hv[8];
#pragma unroll
                for (int n = 0; n < 2; ++n)
#pragma unroll
                    for (int j = 0; j < 4; ++j) { const float g = acc[ai][0][m][n][j], up = acc[ai][1][m][n][j];
                        const float sg = g * __builtin_amdgcn_rcpf(1.0f + __builtin_amdgcn_exp2f(-1.4426950408889634f * g)); hv[n * 4 + j] = sg * up; }
                u32x4 w; w.x = cvt_pk_bf16(hv[0], hv[1]); w.y = cvt_pk_bf16(hv[2], hv[3]); w.z = cvt_pk_bf16(hv[4], hv[5]); w.w = cvt_pk_bf16(hv[6], hv[7]);
                *(u32x4*)rowp = w; }
    }
};

template <class Epi, class Sched>
__device__ __forceinline__ void gemm_phase(LAS unsigned char* lds, const Gemm g, const Sched& S, const Epi& E) {
    const int tid = opq((int)threadIdx.x), wid = __builtin_amdgcn_readfirstlane(tid >> 6), lane = tid & 63, wr = wid >> 2, wc = wid & 3, fr = lane & 15, fq = lane >> 4;
    const int K = g.K, nt = K / BK;
    unsigned voffA[2], voffB[2];
#pragma unroll
    for (int i = 0; i < 2; ++i) { int R, C; stage_rc(tid * 16 + i * 8192, R, C); const int Rb = Epi::PERM ? ((R & ~31) + perm32(R & 31)) : R;
        voffA[i] = (unsigned)(R * K + C) * 2u; voffB[i] = (unsigned)(Rb * K + C) * 2u; }
    const size_t kstep = (size_t)(BK * 2);
    const size_t hstep = (size_t)HALF * K * 2;
    const size_t tstep = 2 * hstep;
    const unsigned ldsw = (unsigned)wid * 1024u;
    const int aoff = lds_byte(wr * 64 + fr, fq * 8), boff = lds_byte(wc * 32 + fr, fq * 8);
#define PG8_SA(b, h) (((b) * 2 + (h)) * HTB)
#define PG8_SB(b, h) ((4 + (b) * 2 + (h)) * HTB)
#define PG8_STAGE(bufoff, gbase, voff) do { _Pragma("unroll") for (int _i = 0; _i < 2; ++_i) \
        __builtin_amdgcn_global_load_lds((const unsigned*)((const char*)(gbase) + (voff)[_i]), (LAS unsigned*)(lds + (bufoff) + ldsw + _i * 8192), 16, 0, 0); } while (0)
#define PG8_LDA(dst, b, h) do { _Pragma("unroll") for (int m = 0; m < 4; ++m) _Pragma("unroll") for (int k = 0; k < 2; ++k) dst[m][k] = *(const LAS bf16x8*)(lds + PG8_SA(b, h) + aoff + m * 2048 + k * 1024); } while (0)
#define PG8_LDB(dst, b, h) do { _Pragma("unroll") for (int n = 0; n < 2; ++n) _Pragma("unroll") for (int k = 0; k < 2; ++k) dst[n][k] = *(const LAS bf16x8*)(lds + PG8_SB(b, h) + boff + n * 2048 + k * 1024); } while (0)
#define PG8_MMA(ai, bj, At, Bt) do { __builtin_amdgcn_s_setprio(1); _Pragma("unroll") for (int m = 0; m < 4; ++m) _Pragma("unroll") for (int n = 0; n < 2; ++n) _Pragma("unroll") for (int k = 0; k < 2; ++k) \
        acc[ai][bj][m][n] = __builtin_amdgcn_mfma_f32_16x16x32_bf16(Bt[n][k], At[m][k], acc[ai][bj][m][n], 0, 0, 0); __builtin_amdgcn_s_setprio(0); } while (0)
#define PG8_WAIT_V(n) asm volatile("s_waitcnt vmcnt(" #n ")" ::: "memory")
#define PG8_WAIT_L(n) asm volatile("s_waitcnt lgkmcnt(" #n ")" ::: "memory")
#define PG8_BAR __builtin_amdgcn_s_barrier()
#define PG8_SCHED __builtin_amdgcn_sched_barrier(0)
    Unit cur, nxt; int ui = 0;
    if (!S.next(0, cur)) return;
    f32x4 acc[2][2][4][2];
#pragma unroll
    for (int a = 0; a < 2; ++a)
#pragma unroll
        for (int b = 0; b < 2; ++b)
#pragma unroll
            for (int m = 0; m < 4; ++m)
#pragma unroll
                for (int n = 0; n < 2; ++n) acc[a][b][m][n] = (f32x4){0.f, 0.f, 0.f, 0.f};
    bf16x8 At[4][2], B0[2][2], B1[2][2];
    const char* cA = (const char*)g.A + (size_t)cur.pm * tstep; const char* cB = (const char*)g.Bt + S.bofs(cur) + (size_t)cur.pn * tstep;
    PG8_STAGE(PG8_SB(0, 0), cB, voffB); PG8_STAGE(PG8_SB(0, 1), cB + hstep, voffB); PG8_STAGE(PG8_SA(0, 0), cA, voffA); PG8_STAGE(PG8_SA(0, 1), cA + hstep, voffA);
    if (wr == 1) PG8_BAR;
    PG8_WAIT_V(2); PG8_BAR;
    PG8_STAGE(PG8_SB(1, 0), cB + kstep, voffB); PG8_STAGE(PG8_SA(1, 0), cA + kstep, voffA); PG8_STAGE(PG8_SB(1, 1), cB + hstep + kstep, voffB);
    PG8_WAIT_V(6); PG8_BAR;
    for (;;) {
        const bool has_next = S.next(ui + 1, nxt);
        const char* nA = has_next ? (const char*)g.A + (size_t)nxt.pm * tstep : cA; const char* nB = has_next ? (const char*)g.Bt + S.bofs(nxt) + (size_t)nxt.pn * tstep : cB;
        for (int t = 0; t < nt; t += 2) {
            const bool last = (t == nt - 2);
            const char* a1 = cA + (size_t)(t + 1) * kstep;
            const char* a2 = last ? nA : cA + (size_t)(t + 2) * kstep; const char* b2 = last ? nB : cB + (size_t)(t + 2) * kstep;
            const char* a3 = a2 + kstep; const char* b3 = b2 + kstep;
            PG8_LDB(B0, 0, 0); PG8_LDB(B1, 0, 1); PG8_SCHED; PG8_LDA(At, 0, 0); PG8_STAGE(PG8_SA(1, 1), a1 + hstep, voffA);
            PG8_WAIT_V(8); PG8_WAIT_L(0); PG8_BAR; PG8_MMA(0, 0, At, B0); PG8_MMA(0, 1, At, B1); PG8_BAR; PG8_SCHED;
            PG8_LDA(At, 0, 1); PG8_STAGE(PG8_SB(0, 0), b2, voffB); PG8_STAGE(PG8_SB(0, 1), b2 + hstep, voffB); PG8_STAGE(PG8_SA(0, 0), a2, voffA);
            PG8_WAIT_V(8); PG8_WAIT_L(0); PG8_BAR; PG8_MMA(1, 0, At, B0); PG8_MMA(1, 1, At, B1); PG8_BAR; PG8_SCHED;
            PG8_LDB(B0, 1, 0); PG8_LDB(B1, 1, 1); PG8_SCHED; PG8_LDA(At, 1, 0); PG8_STAGE(PG8_SA(0, 1), a2 + hstep, voffA);
            PG8_WAIT_V(8); PG8_WAIT_L(0); PG8_BAR; PG8_MMA(0, 0, At, B0); PG8_MMA(0, 1, At, B1); PG8_BAR; PG8_SCHED;
            PG8_LDA(At, 1, 1); PG8_STAGE(PG8_SB(1, 0), b3, voffB); PG8_STAGE(PG8_SB(1, 1), b3 + hstep, voffB); PG8_STAGE(PG8_SA(1, 0), a3, voffA);
            PG8_WAIT_V(8); PG8_WAIT_L(0); PG8_BAR; PG8_MMA(1, 0, At, B0); PG8_MMA(1, 1, At, B1); PG8_BAR; PG8_SCHED;
        }
        if (wr == 0) PG8_BAR;
        E(acc, cur, wr, wc, fr, fq);
        if (!has_next) break;
#pragma unroll
        for (int a = 0; a < 2; ++a)
#pragma unroll
            for (int b = 0; b < 2; ++b)
#pragma unroll
                for (int m = 0; m < 4; ++m)
#pragma unroll
                    for (int n = 0; n < 2; ++n) acc[a][b][m][n] = (f32x4){0.f, 0.f, 0.f, 0.f};
        cur = nxt; cA = nA; cB = nB; ++ui;
        if (wr == 1) PG8_BAR;
    }
    PG8_WAIT_V(0);
    PG8_BAR;
#undef PG8_SA
#undef PG8_SB
#undef PG8_STAGE
#undef PG8_LDA
#undef PG8_LDB
#undef PG8_MMA
#undef PG8_WAIT_V
#undef PG8_WAIT_L
#undef PG8_BAR
#undef PG8_SCHED
}
}

#define XB_TMO      128
#define XB_XCNT(j)  (256  + 64 * (j))
#define XB_XSUB(j)  (1280 + 64 * (j))
#define XB_XGEN(j)  (2304 + 64 * (j))
#define XB_TOP      3328
#define XB_TOPGEN   3392
#define XCD_BAR_WORDS 3456
#define XB_SPIN_CAP (1u << 18)
__device__ __forceinline__ unsigned xb_ld(unsigned* p)              { return __hip_atomic_load(p, __ATOMIC_RELAXED, __HIP_MEMORY_SCOPE_AGENT); }
__device__ __forceinline__ unsigned xb_add(unsigned* p, unsigned v) { return __hip_atomic_fetch_add(p, v, __ATOMIC_RELAXED, __HIP_MEMORY_SCOPE_AGENT); }
__device__ __forceinline__ unsigned xb_xcc_id() { return (unsigned)__builtin_amdgcn_s_getreg((3 << 11) | 20) & 0xFu; }
#define XB_SPIN(cond, bar) do { unsigned _sp = 0; while (cond) { __builtin_amdgcn_s_sleep(1); \
    if ((++_sp & 255u) == 0u) { if (xb_ld(&(bar)[XB_TMO])) break; if (_sp > XB_SPIN_CAP) { atomicAdd(&(bar)[XB_TMO], 1u); break; } } } } while (0)
struct XcdBarrier { unsigned* bar; unsigned x; volatile LAS unsigned* st; };
__device__ __forceinline__ XcdBarrier xcd_barrier_post(unsigned* bar, volatile LAS unsigned* st) {
    XcdBarrier b; b.bar = bar; b.x = xb_xcc_id(); b.st = st;
    if (threadIdx.x == 0) (void)xb_add(&bar[XB_XCNT(b.x)], 1u);
    return b;
}
__device__ __forceinline__ void xcd_barrier_complete(unsigned* bar, unsigned x, unsigned& nloc, unsigned& nx) {
    const unsigned G = gridDim.x * gridDim.y * gridDim.z;
    unsigned sum, cnt, mine, sp = 0u;
    for (;;) {
        sum = 0u; cnt = 0u; mine = 0u;
#pragma unroll
        for (unsigned j = 0; j < 16; ++j) { const unsigned c = xb_ld(&bar[XB_XCNT(j)]); sum += c; cnt += (c > 0u) ? 1u : 0u; mine = (j == x) ? c : mine; }
        if (sum == G) break;
        __builtin_amdgcn_s_sleep(1);
        if ((++sp & 255u) == 0u) { if (xb_ld(&bar[XB_TMO])) break; if (sp > XB_SPIN_CAP) { atomicAdd(&bar[XB_TMO], 1u); break; } }
    }
    nloc = mine > 0u ? mine : 1u; nx = cnt > 0u ? cnt : 1u;
}
__device__ __forceinline__ void xcd_barrier(const XcdBarrier& b) {
    asm volatile("s_waitcnt vmcnt(0)" ::: "memory");
    __syncthreads();
    if (threadIdx.x == 0) {
        unsigned* bar = b.bar;
        __builtin_amdgcn_s_waitcnt(0);
        unsigned nloc = b.st[0], nx = b.st[1];
        if (nloc == 0u) { xcd_barrier_complete(bar, b.x, nloc, nx); b.st[0] = nloc; b.st[1] = nx; }
        const unsigned old = xb_add(&bar[XB_XSUB(b.x)], 1u);
        const unsigned gen = old / nloc;
        if (old + 1u == (gen + 1u) * nloc) {
            __builtin_amdgcn_fence(__ATOMIC_RELEASE, "agent");
            asm volatile("s_waitcnt vmcnt(0)" ::: "memory");
            const unsigned og = xb_add(&bar[XB_TOP], 1u);
            const unsigned tg = og / nx;
            if (og + 1u == (tg + 1u) * nx) xb_add(&bar[XB_TOPGEN], 1u);
            else XB_SPIN(xb_ld(&bar[XB_TOPGEN]) == tg, bar);
            __builtin_amdgcn_fence(__ATOMIC_ACQUIRE, "agent");
            xb_add(&bar[XB_XGEN(b.x)], 1u);
            asm volatile("s_waitcnt vmcnt(0)" ::: "memory");
        } else {
            XB_SPIN(xb_ld(&bar[XB_XGEN(b.x)]) == gen, bar);
            __builtin_amdgcn_fence(__ATOMIC_ACQUIRE, "agent");
            asm volatile("s_waitcnt vmcnt(0)" ::: "memory");
        }
    }
    __syncthreads();
}

struct Frame {
    LAS unsigned char* lds;
    int tid, lane, wave, vcu, G;
};
struct Args {
    const float* in[21]; float* out; unsigned char* ws; int upto, pad1;
};

__device__ __forceinline__ void transpose_item(const float* W, int ldw, int k0, int n0, bf16_t* WT, int ldk, int drow0, LAS float* scr, int lane) {
#pragma unroll 8
    for (int i = 0; i < 32; ++i) { const int kk = 2 * i + (lane >> 5); scr[kk * 33 + (lane & 31)] = W[(size_t)(k0 + kk) * ldw + n0 + (lane & 31)]; }
    LDS_WAIT(); asm volatile("" ::: "memory");
    const int c = lane & 7;
#pragma unroll
    for (int j = 0; j < 4; ++j) { const int n = (lane >> 3) + 8 * j; const LAS float* s = scr + (8 * c) * 33 + n;
        u32x4 o; o.x = cvt_pk_bf16(s[0 * 33], s[1 * 33]); o.y = cvt_pk_bf16(s[2 * 33], s[3 * 33]); o.z = cvt_pk_bf16(s[4 * 33], s[5 * 33]); o.w = cvt_pk_bf16(s[6 * 33], s[7 * 33]);
        *(u32x4*)(WT + (size_t)(drow0 + n) * ldk + k0 + 8 * c) = o; }
    LDS_WAIT(); asm volatile("" ::: "memory");
}
__device__ __forceinline__ void conv_plain(Frame& F, const float* W, int K, int N, int ldw, bf16_t* WT) {
    LAS float* scr = (LAS float*)(F.lds + F.wave * 16384);
    const int gw = F.vcu * NWAVES + F.wave, NGW = F.G * NWAVES, nblk = N / 32, nit = (K / 64) * nblk;
    for (int it = gw; it < nit; it += NGW) { const int kb = it / nblk, nb = it % nblk; transpose_item(W, ldw, 64 * kb, 32 * nb, WT, K, 32 * nb, scr, F.lane); }
}
__device__ __forceinline__ void conv_moe(Frame& F, const float* wg, const float* wu, const float* wd, bf16_t* GU, bf16_t* DT, int rank = -1, int nrank = 0) {
    LAS float* scr = (LAS float*)(F.lds + F.wave * 16384);
    const int gw = (rank < 0 ? F.vcu : rank) * NWAVES + F.wave, NGW = (rank < 0 ? F.G : nrank) * NWAVES;
    constexpr int PER_E = 1536, NIT = NEXP * PER_E;
    for (int it = gw; it < NIT; it += NGW) {
        const int e = it / PER_E; int r = it % PER_E;
        if (r < 1024) { const int up = r >> 9; r &= 511; const int kb = r >> 4, nb = r & 15, n0 = 32 * nb;
            const int drow = 256 * (n0 >> 7) + 128 * up + (n0 & 127);
            transpose_item((up ? wu : wg) + (size_t)e * D * DFF, DFF, 64 * kb, n0, GU + (size_t)e * 1024 * D, D, drow, scr, F.lane); }
        else { r -= 1024; const int kb = r >> 6, nb = r & 63;
            transpose_item(wd + (size_t)e * DFF * D, D, 64 * kb, 32 * nb, DT + (size_t)e * D * DFF, DFF, 32 * nb, scr, F.lane); }
    }
}
__device__ __forceinline__ void pack_proj(Frame& F, float* Wp, int NT, const float* gain, const float* Wa, int lda, int ca0, int na, const float* Wb, int ldb, int nb) {
    const int total = 128 * NT * 256;
    for (int idx = (F.vcu * NWAVES * 64) + F.tid; idx < total; idx += F.G * NWAVES * 64) {
        const int e = idx & 3, ln = (idx >> 2) & 63, rest = idx >> 8, nt = rest % NT, s = rest / NT;
        const int k = 16 * s + 4 * (ln >> 4) + e, col = 16 * nt + (ln & 15);
        float v = 0.f;
        if (col < na) v = Wa[(size_t)k * lda + ca0 + col]; else if (col < na + nb) v = Wb[(size_t)k * ldb + (col - na)];
        Wp[idx] = v * gain[k];
    }
}

template <int NT>
__device__ __forceinline__ float wave_proj16(LAS unsigned char* lds, const float* xin, int tok0, const float* Wp, int tid, int wid, int lane, f32x4 (&acc)[NT]) {
    const int tr = lane & 15, kq = lane >> 4;
    const f32x4* xp = (const f32x4*)(xin + (size_t)(tok0 + tr) * D) + kq;
    constexpr int CH = 16 * NT * 1024;
    const char* wsrc = (const char*)Wp + tid * 16;
    float ssq = 0.f;
#pragma unroll
    for (int n = 0; n < NT; ++n) acc[n] = (f32x4){0.f, 0.f, 0.f, 0.f};
    f32x4 X[16];
#define NP_DMA(c, buf) do { _Pragma("unroll") for (int r = 0; r < 2 * NT; ++r) \
        __builtin_amdgcn_global_load_lds((const unsigned*)(wsrc + (size_t)(c) * CH + r * 8192), (LAS unsigned*)(lds + (buf) * CH + r * 8192 + wid * 1024), 16, 0, 0); } while (0)
#define NP_CHUNK(c, buf, more) do { \
        asm volatile("s_waitcnt vmcnt(16)" ::: "memory"); WG_BAR(); \
        if (more) NP_DMA((c) + 1, 1 - (buf)); \
        asm volatile("" ::: "memory");     \
        const f32x4* xn_ = xp + 64 * ((c) + 1); \
        _Pragma("unroll") for (int s = 0; s < 16; ++s) { const f32x4 xv = X[s]; if (more) X[s] = xn_[4 * s]; \
            ssq += (xv[0] * xv[0] + xv[1] * xv[1]) + (xv[2] * xv[2] + xv[3] * xv[3]); \
            _Pragma("unroll") for (int n = 0; n < NT; ++n) { const f32x4 wv = *(const LAS f32x4*)(lds + (buf) * CH + ((s * NT + n) * 64 + lane) * 16); \
                _Pragma("unroll") for (int e = 0; e < 4; ++e) acc[n] = __builtin_amdgcn_mfma_f32_16x16x4f32(xv[e], wv[e], acc[n], 0, 0, 0); } } } while (0)
    NP_DMA(0, 0);
    asm volatile("" ::: "memory");
#pragma unroll
    for (int s = 0; s < 16; ++s) X[s] = xp[4 * s];
    for (int c = 0; c < 6; c += 2) { NP_CHUNK(c, 0, true); NP_CHUNK(c + 1, 1, true); }
    NP_CHUNK(6, 0, true); NP_CHUNK(7, 1, false);
    WG_BAR();
#undef NP_DMA
#undef NP_CHUNK
    ssq += __shfl_xor(ssq, 16); ssq += __shfl_xor(ssq, 32);
    return 1.0f / sqrtf(ssq * (1.0f / D) + RMS_EPS);
}
__device__ __forceinline__ void wave_write_hn16(const float* xin, int tok0, float rstd, const float* gain, bf16_t* hn, int lane) {
    f32x4 g4[8];
#pragma unroll
    for (int j = 0; j < 8; ++j) g4[j] = ((const f32x4*)gain)[lane + 64 * j];
    for (int i = 0; i < 16; i += 2) {
        const float r0 = __shfl(rstd, i), r1 = __shfl(rstd, i + 1);
        const f32x4* x0 = (const f32x4*)(xin + (size_t)(tok0 + i) * D); const f32x4* x1 = x0 + D / 4;
        u32x2* o0 = (u32x2*)(hn + (size_t)(tok0 + i) * D); u32x2* o1 = o0 + D / 4;
        f32x4 a[8], c[8];
#pragma unroll
        for (int j = 0; j < 8; ++j) { a[j] = x0[lane + 64 * j]; c[j] = x1[lane + 64 * j]; }
#pragma unroll
        for (int j = 0; j < 8; ++j) { const f32x4 v = a[j] * r0 * g4[j], u = c[j] * r1 * g4[j]; u32x2 w; w.x = cvt_pk_bf16(v[0], v[1]); w.y = cvt_pk_bf16(v[2], v[3]); o0[lane + 64 * j] = w;
            u32x2 z; z.x = cvt_pk_bf16(u[0], u[1]); z.y = cvt_pk_bf16(u[2], u[3]); o1[lane + 64 * j] = z; }
    }
}

__device__ __forceinline__ void phase_norm_gz(Frame& F, const float* xin, const float* gain, const float* Wp, bf16_t* hn, float* gz) {
    for (int tile = F.vcu; tile < T / 128; tile += F.G) {
        const int tok0 = tile * 128 + F.wave * 16;
        f32x4 acc[1];
        const float rstd = wave_proj16<1>(F.lds, xin, tok0, Wp, F.tid, F.wave, F.lane, acc);
        const int j = F.lane & 15, q4 = F.lane >> 4;
#pragma unroll
        for (int r = 0; r < 4; ++r) { const float rr = __shfl(rstd, 4 * q4 + r); gz[(size_t)(tok0 + 4 * q4 + r) * 16 + j] = acc[0][r] * rr; }
        wave_write_hn16(xin, tok0, rstd, gain, hn, F.lane);
    }
}
__device__ __forceinline__ void phase_norm_route(Frame& F, const float* xin, const float* gain, const float* Wp, bf16_t* hn, int* tok_e, int* tok_p, float* tok_w, unsigned* cnt) {
    LAS float* lg = (LAS float*)(F.lds + 98304 + F.wave * 3072);
    for (int tile = F.vcu; tile < T / 128; tile += F.G) {
        const int tok0 = tile * 128 + F.wave * 16;
        f32x4 acc[3];
        const float rstd = wave_proj16<3>(F.lds, xin, tok0, Wp, F.tid, F.wave, F.lane, acc);
        const int j = F.lane & 15, q4 = F.lane >> 4;
#pragma unroll
        for (int r = 0; r < 4; ++r) { const float rr = __shfl(rstd, 4 * q4 + r);
#pragma unroll
            for (int n = 0; n < 3; ++n) lg[(4 * q4 + r) * 48 + 16 * n + j] = acc[n][r] * rr; }
        LDS_WAIT(); asm volatile("" ::: "memory");
        if (F.lane < 16) {
            const LAS float* l = lg + F.lane * 48;
            float gm = l[0]; int gi = 0;
#pragma unroll
            for (int q = 1; q < 4; ++q) { const float v = l[q]; if (v > gm) { gm = v; gi = q; } }
            float gs = 0.f;
#pragma unroll
            for (int q = 0; q < 4; ++q) gs += __expf(l[q] - gm);
            const float gw = 1.0f / gs;
            const LAS float* se = l + 4 + 8 * gi;
            float m1 = se[0]; int i1 = 0;
#pragma unroll
            for (int q = 1; q < 8; ++q) { const float v = se[q]; if (v > m1) { m1 = v; i1 = q; } }
            float m2 = -3.0e38f; int i2 = 0;
#pragma unroll
            for (int q = 0; q < 8; ++q) { const float v = se[q]; if (q != i1 && v > m2) { m2 = v; i2 = q; } }
            const float eb = __expf(m2 - m1), inv = 1.0f / (1.0f + eb);
            const int t = tok0 + F.lane, e1 = gi * 8 + i1, e2 = gi * 8 + i2;
            const unsigned p1 = __hip_atomic_fetch_add(cnt + 64 * e1, 1u, __ATOMIC_RELAXED, __HIP_MEMORY_SCOPE_AGENT);
            const unsigned p2 = __hip_atomic_fetch_add(cnt + 64 * e2, 1u, __ATOMIC_RELAXED, __HIP_MEMORY_SCOPE_AGENT);
            tok_e[2 * t] = e1; tok_e[2 * t + 1] = e2; tok_p[2 * t] = (int)p1; tok_p[2 * t + 1] = (int)p2;
            tok_w[2 * t] = gw * inv; tok_w[2 * t + 1] = gw * eb * inv;
        }
        wave_write_hn16(xin, tok0, rstd, gain, hn, F.lane);
        LDS_WAIT(); asm volatile("" ::: "memory");
    }
}

__device__ __forceinline__ void phase_gla_gate(Frame& F, const float* gz, const float* wgu, const float* bgate, const bf16_t* proj, bf16_t* kdT, float* adec) {
    LAS f32x4* gzs = (LAS f32x4*)F.lds;
    for (int u = F.vcu; u < NBATCH * NCH * 2; u += F.G) {
        const int half = u & 1, bc = u >> 1;
        const int tok0 = bc * 64, j = half * 512 + F.tid;
        if (F.tid < 256) gzs[F.tid] = ((const f32x4*)(gz + (size_t)tok0 * 16))[F.tid];
        float wg[16];
#pragma unroll
        for (int r = 0; r < 16; ++r) wg[r] = wgu[r * GLA_DKT + j];
        const float bg = bgate[j];
        WG_BAR();
        float cum[64]; float run = 0.f;
#pragma unroll
        for (int t = 0; t < 64; ++t) {
            float z = bg;
#pragma unroll
            for (int r4 = 0; r4 < 4; ++r4) { const f32x4 g4 = gzs[t * 4 + r4]; z += g4[0] * wg[4 * r4] + g4[1] * wg[4 * r4 + 1] + g4[2] * wg[4 * r4 + 2] + g4[3] * wg[4 * r4 + 3]; }
            const float ls = fminf(z, 0.f) - __logf(1.0f + __expf(-fabsf(z)));
            run += ls * (1.0f / 16.0f); cum[t] = run;
        }
        adec[(size_t)bc * GLA_DKT + j] = __expf(run);
        const bf16_t* kp = proj + GK0 + gq_off(bc >> 8, (bc & 255) * 64, j >> 8) + (j & 255);
        u32x4* dst = (u32x4*)(kdT + ((size_t)bc * GLA_DKT + j) * 64);
#pragma unroll
        for (int t8 = 0; t8 < 8; ++t8) {
            float kd[8];
#pragma unroll
            for (int q = 0; q < 8; ++q) { const int t = t8 * 8 + q; kd[q] = bf2f(kp[(size_t)t * 256]) * __expf(run - cum[t]); }
            u32x4 w; w.x = cvt_pk_bf16(kd[0], kd[1]); w.y = cvt_pk_bf16(kd[2], kd[3]); w.z = cvt_pk_bf16(kd[4], kd[5]); w.w = cvt_pk_bf16(kd[6], kd[7]);
            dst[t8] = w;
        }
        WG_BAR();
    }
}

constexpr int SCAN_VROW = 144, SCAN_SROW = 528, SCAN_VBUF = 64 * SCAN_VROW, SCAN_SBUF = 64 * SCAN_SROW;
__device__ __forceinline__ void phase_gla_scan(Frame& F, int it, const bf16_t* proj, const bf16_t* kdT, const float* adec, bf16_t* oout, unsigned* probe = nullptr) {
    const int lane = F.lane, w = F.wave, fr = lane & 15, kq = lane >> 4, tid = F.tid;
    LAS unsigned char* vbuf = F.lds;
    LAS unsigned char* sbuf = F.lds + 2 * SCAN_VBUF;
    const int bh = it >> 3, b = bh >> 2, h = bh & 3, sl = it & 7, mt = w & 3, ntp = w >> 2;
    const size_t tokb = (size_t)b * SEQ;
    f32x4 st[2][4];
#pragma unroll
    for (int i = 0; i < 2; ++i)
#pragma unroll
        for (int n = 0; n < 4; ++n) st[i][n] = (f32x4){0.f, 0.f, 0.f, 0.f};
    bf16x8 ka0[2][2], ka1[2][2], q0[8], q1[8]; f32x4 dc0[2], dc1[2]; u32x4 vr0, vr1;
#define CL(c) ((c) < NCH ? (c) : NCH - 1)
#define LOAD_KA(KA, DC, c) do { const size_t bc_ = (size_t)b * NCH + CL(c); \
        _Pragma("unroll") for (int i = 0; i < 2; ++i) { \
            _Pragma("unroll") for (int s = 0; s < 2; ++s) KA[i][s] = *(const bf16x8*)(kdT + ((bc_ * GLA_DKT + h * 256 + 32 * w + 16 * i + fr) * 64 + 32 * s + 8 * kq)); \
            DC[i] = *(const f32x4*)(adec + bc_ * GLA_DKT + h * 256 + 32 * w + 16 * i + 4 * kq); } } while (0)
#define LOAD_V(VR, c) do { VR = *(const u32x4*)(proj + gv_off(b, CL(c) * 64 + (tid >> 3), h) + 64 * sl + 8 * (tid & 7)); } while (0)
#define LOAD_Q(Q, c) do { const bf16_t* qp_ = proj + gq_off(b, CL(c) * 64 + 16 * mt + fr, h) + 8 * kq; \
        _Pragma("unroll") for (int s = 0; s < 8; ++s) Q[s] = *(const bf16x8*)(qp_ + 32 * s); } while (0)
#define STORE_V(VR, buf) do { *(LAS u32x4*)(vbuf + (buf) * SCAN_VBUF + (tid >> 3) * SCAN_VROW + (tid & 7) * 16) = VR; } while (0)
#if PROBE
    unsigned long long pacc[3] = {0ull, 0ull, 0ull}; unsigned long long pmark;
#define PMARK(k) do { const unsigned long long n_ = __builtin_amdgcn_s_memtime(); pacc[k] += n_ - pmark; pmark = n_; } while (0)
#define PSTART() do { pmark = __builtin_amdgcn_s_memtime(); } while (0)
#else
#define PMARK(k) do { } while (0)
#define PSTART() do { } while (0)
#endif
#define SCAN_STEP(KA, DC, VN, VM, QC, QN, c) do { \
        PSTART(); \
        const unsigned vb_ = (unsigned)(uintptr_t)(vbuf + ((c) & 1) * SCAN_VBUF) + (unsigned)((8 * kq + ((lane & 15) >> 2)) * SCAN_VROW + 8 * (lane & 3)); \
        s16x4 tv[4][4];     \
        asm volatile("ds_read_b64_tr_b16 %0, %16 offset:0\n\tds_read_b64_tr_b16 %1, %16 offset:576\n\tds_read_b64_tr_b16 %2, %16 offset:4608\n\tds_read_b64_tr_b16 %3, %16 offset:5184\n\t" \
                     "ds_read_b64_tr_b16 %4, %16 offset:32\n\tds_read_b64_tr_b16 %5, %16 offset:608\n\tds_read_b64_tr_b16 %6, %16 offset:4640\n\tds_read_b64_tr_b16 %7, %16 offset:5216\n\t" \
                     "ds_read_b64_tr_b16 %8, %16 offset:64\n\tds_read_b64_tr_b16 %9, %16 offset:640\n\tds_read_b64_tr_b16 %10, %16 offset:4672\n\tds_read_b64_tr_b16 %11, %16 offset:5248\n\t" \
                     "ds_read_b64_tr_b16 %12, %16 offset:96\n\tds_read_b64_tr_b16 %13, %16 offset:672\n\tds_read_b64_tr_b16 %14, %16 offset:4704\n\tds_read_b64_tr_b16 %15, %16 offset:5280\n\ts_waitcnt lgkmcnt(0)" \
                     : "=&v"(tv[0][0]), "=&v"(tv[0][1]), "=&v"(tv[0][2]), "=&v"(tv[0][3]), "=&v"(tv[1][0]), "=&v"(tv[1][1]), "=&v"(tv[1][2]), "=&v"(tv[1][3]), \
                       "=&v"(tv[2][0]), "=&v"(tv[2][1]), "=&v"(tv[2][2]), "=&v"(tv[2][3]), "=&v"(tv[3][0]), "=&v"(tv[3][1]), "=&v"(tv[3][2]), "=&v"(tv[3][3]) : "v"(vb_) : "memory"); \
        _Pragma("unroll") for (int n = 0; n < 4; ++n) { \
            const bf16x8 vf0 = (bf16x8){tv[n][0][0], tv[n][0][1], tv[n][0][2], tv[n][0][3], tv[n][1][0], tv[n][1][1], tv[n][1][2], tv[n][1][3]}; \
            const bf16x8 vf1 = (bf16x8){tv[n][2][0], tv[n][2][1], tv[n][2][2], tv[n][2][3], tv[n][3][0], tv[n][3][1], tv[n][3][2], tv[n][3][3]}; \
            _Pragma("unroll") for (int i = 0; i < 2; ++i) { \
                st[i][n] = st[i][n] * DC[i]; \
                st[i][n] = __builtin_amdgcn_mfma_f32_16x16x32_bf16(KA[i][0], vf0, st[i][n], 0, 0, 0); \
                st[i][n] = __builtin_amdgcn_mfma_f32_16x16x32_bf16(KA[i][1], vf1, st[i][n], 0, 0, 0); } } \
        LOAD_KA(KA, DC, (c) + 2); \
        PMARK(0); \
        { LAS unsigned char* sb_ = sbuf + ((c) & 1) * SCAN_SBUF + fr * SCAN_SROW + (32 * w + 4 * kq) * 2; \
          _Pragma("unroll") for (int i = 0; i < 2; ++i) _Pragma("unroll") for (int n = 0; n < 4; ++n) { \
              u32x2 pk; pk.x = cvt_pk_bf16(st[i][n][0], st[i][n][1]); pk.y = cvt_pk_bf16(st[i][n][2], st[i][n][3]); \
              *(LAS u32x2*)(sb_ + n * 16 * SCAN_SROW + i * 32) = pk; } } \
        STORE_V(VN, ((c) + 1) & 1); \
        LOAD_V(VN, (c) + 3); \
        WG_BAR(); \
        PMARK(1); \
        { f32x4 a0 = (f32x4){0.f, 0.f, 0.f, 0.f}, a1 = a0; \
          const LAS unsigned char* sr_ = sbuf + ((c) & 1) * SCAN_SBUF + (32 * ntp + fr) * SCAN_SROW + 16 * kq; \
          _Pragma("unroll") for (int hb = 0; hb < 2; ++hb) { bf16x8 bb[4][2];     \
              _Pragma("unroll") for (int s = 0; s < 4; ++s) { bb[s][0] = *(const LAS bf16x8*)(sr_ + 64 * (4 * hb + s)); bb[s][1] = *(const LAS bf16x8*)(sr_ + 16 * SCAN_SROW + 64 * (4 * hb + s)); } \
              asm volatile("s_waitcnt lgkmcnt(0)" ::: "memory"); __builtin_amdgcn_sched_barrier(0); \
              _Pragma("unroll") for (int s = 0; s < 4; ++s) { \
                  a0 = __builtin_amdgcn_mfma_f32_16x16x32_bf16(QC[4 * hb + s], bb[s][0], a0, 0, 0, 0); \
                  a1 = __builtin_amdgcn_mfma_f32_16x16x32_bf16(QC[4 * hb + s], bb[s][1], a1, 0, 0, 0); } } \
          bf16_t* op_ = oout + (tokb + (size_t)(c) * 64 + 16 * mt + 4 * kq) * D + h * 512 + 64 * sl + 32 * ntp + fr; \
          _Pragma("unroll") for (int r = 0; r < 4; ++r) { \
              const float x0 = a0[r] * 0.0625f, x1 = a1[r] * 0.0625f, y0 = __shfl_xor(x0, 1), y1 = __shfl_xor(x1, 1); \
              if ((fr & 1) == 0) { *(unsigned*)(op_ + (size_t)r * D) = cvt_pk_bf16(x0, y0); *(unsigned*)(op_ + (size_t)r * D + 16) = cvt_pk_bf16(x1, y1); } } } \
        LOAD_Q(QC, (c) + 2); \
        PMARK(2); \
    } while (0)
    LOAD_KA(ka0, dc0, 0); LOAD_KA(ka1, dc1, 1); LOAD_V(vr0, 0); LOAD_V(vr1, 1); LOAD_Q(q0, 0); LOAD_Q(q1, 1);
    STORE_V(vr0, 0); LOAD_V(vr0, 2);
    WG_BAR();
#if PROBE
    const unsigned long long pt0 = __builtin_amdgcn_s_memtime(), pr0 = __builtin_amdgcn_s_memrealtime();
#endif
    for (int c = 0; c < NCH; c += 2) {
        SCAN_STEP(ka0, dc0, vr1, vr0, q0, q1, c);
        SCAN_STEP(ka1, dc1, vr0, vr1, q1, q0, c + 1);
    }
    WG_BAR();
#if PROBE
    if (probe && it == 0 && tid == 0) { const unsigned long long dt = __builtin_amdgcn_s_memtime() - pt0, dr = __builtin_amdgcn_s_memrealtime() - pr0;
        const float val = floorf(2.f * log2f((PROBE == 1) ? (float)dt / 256.f : (PROBE == 2) ? (float)dr * 10.f / 256.f : (float)pacc[PROBE - 3] / 256.f));
        __hip_atomic_store(probe, __float_as_uint(val), __ATOMIC_RELAXED, __HIP_MEMORY_SCOPE_AGENT); }
#endif
#undef CL
#undef LOAD_KA
#undef LOAD_V
#undef LOAD_Q
#undef STORE_V
#undef SCAN_STEP
}

__device__ __forceinline__ void phase_gla_gnorm(Frame& F, const bf16_t* o, const bf16_t* proj, const float* gn, bf16_t* y) {
    const int gw = F.vcu * NWAVES + F.wave, NGW = F.G * NWAVES, lane = F.lane;
    const f32x4 g0 = ((const f32x4*)gn)[2 * lane], g1 = ((const f32x4*)gn)[2 * lane + 1];
    for (int idx = gw; idx < T * GLA_H; idx += NGW) {
        const int tok = idx >> 2, h = idx & 3;
        const u32x4 ov = *(const u32x4*)(o + (size_t)tok * D + h * 512 + 8 * lane);
        const u32x4 rv = *(const u32x4*)(proj + GR0 + (size_t)tok * 2048 + h * 512 + 8 * lane);
        float a[8], r[8];
#pragma unroll
        for (int q = 0; q < 4; ++q) { a[2 * q] = bf_lo(ov[q]); a[2 * q + 1] = bf_hi(ov[q]); r[2 * q] = bf_lo(rv[q]); r[2 * q + 1] = bf_hi(rv[q]); }
        float ss = 0.f;
#pragma unroll
        for (int q = 0; q < 8; ++q) ss += a[q] * a[q];
        const float rstd = 1.0f / sqrtf(wave_sum(ss) * (1.0f / 512.0f) + RMS_EPS);
        float yv[8];
#pragma unroll
        for (int q = 0; q < 8; ++q) { const float g = q < 4 ? g0[q] : g1[q - 4]; const float sr = r[q] / (1.0f + __expf(-r[q])); yv[q] = a[q] * rstd * g * sr; }
        u32x4 w; w.x = cvt_pk_bf16(yv[0], yv[1]); w.y = cvt_pk_bf16(yv[2], yv[3]); w.z = cvt_pk_bf16(yv[4], yv[5]); w.w = cvt_pk_bf16(yv[6], yv[7]);
        *(u32x4*)(y + (size_t)tok * D + h * 512 + 8 * lane) = w;
    }
}

__device__ __forceinline__ void moe_tables(Frame& F, unsigned* cnt) {
    LAS int* pst = (LAS int*)(F.lds + TAB_OFF);
    LAS int* te = pst + 36;
    if (F.wave == 0) {
        const int e = F.lane & 31;
        const int c = (int)xb_ld(cnt + 64 * e);
        const int ntile = (c + 255) >> 8;
        int incl = ntile;
#pragma unroll
        for (int o = 1; o < 32; o <<= 1) { const int v = __shfl_up(incl, o); if ((F.lane & 31) >= o) incl += v; }
        const int excl = incl - ntile;
        if (F.lane < 32) { pst[e] = excl << 8; for (int q = 0; q < ntile; ++q) te[excl + q] = e; }
        if (F.lane == 31) { pst[32] = incl << 8; pst[33] = incl; }
    }
    WG_BAR();
}
__device__ __forceinline__ void phase_moe_gather(Frame& F, const int* tok_e, const int* tok_p, int* slot_of, const bf16_t* hn, bf16_t* ag) {
    const LAS int* pst = (const LAS int*)(F.lds + TAB_OFF);
    const int gw = F.vcu * NWAVES + F.wave, NGW = F.G * NWAVES, lane = F.lane;
    for (int a = gw; a < 2 * T; a += NGW) {
        const int e = tok_e[a], p = tok_p[a], slot = pst[e] + p, t = a >> 1;
        if (lane == 0) slot_of[a] = slot;
        const u32x4* src = (const u32x4*)(hn + (size_t)t * D); u32x4* dst = (u32x4*)(ag + (size_t)slot * D);
#pragma unroll
        for (int j = 0; j < 4; ++j) dst[lane + 64 * j] = src[lane + 64 * j];
    }
}
template <int MODE>
__device__ __forceinline__ void phase_moe_combine(Frame& F, float* x, const bf16_t* ob, const int* slot_of, const float* tok_w, const float* gain, bf16_t* hn) {
    const int gw = F.vcu * NWAVES + F.wave, NGW = F.G * NWAVES, lane = F.lane;
    f32x4 g4[8];
#pragma unroll
    for (int j = 0; j < 8; ++j) g4[j] = ((const f32x4*)gain)[lane + 64 * j];
    for (int t = gw; t < T; t += NGW) {
        const int s0 = slot_of[2 * t], s1 = slot_of[2 * t + 1]; const float w0 = tok_w[2 * t], w1 = tok_w[2 * t + 1];
        f32x4* xr = (f32x4*)(x + (size_t)t * D);
        const u32x2* a = (const u32x2*)(ob + (size_t)s0 * D); const u32x2* b = (const u32x2*)(ob + (size_t)s1 * D);
        f32x4 v[8]; float ss = 0.f;
#pragma unroll
        for (int j = 0; j < 8; ++j) { const u32x2 av = a[lane + 64 * j], bv = b[lane + 64 * j]; f32x4 xv = xr[lane + 64 * j];
            xv[0] += w0 * bf_lo(av.x) + w1 * bf_lo(bv.x); xv[1] += w0 * bf_hi(av.x) + w1 * bf_hi(bv.x);
            xv[2] += w0 * bf_lo(av.y) + w1 * bf_lo(bv.y); xv[3] += w0 * bf_hi(av.y) + w1 * bf_hi(bv.y);
            v[j] = xv; ss += (xv[0] * xv[0] + xv[1] * xv[1]) + (xv[2] * xv[2] + xv[3] * xv[3]); }
        const float rstd = 1.0f / sqrtf(wave_sum(ss) * (1.0f / D) + RMS_EPS);
        if (MODE == 0) {
            u32x2* orow = (u32x2*)(hn + (size_t)t * D);
#pragma unroll
            for (int j = 0; j < 8; ++j) { xr[lane + 64 * j] = v[j]; const f32x4 y = v[j] * rstd * g4[j]; u32x2 w; w.x = cvt_pk_bf16(y[0], y[1]); w.y = cvt_pk_bf16(y[2], y[3]); orow[lane + 64 * j] = w; }
        } else {
#pragma unroll
            for (int j = 0; j < 8; ++j) xr[lane + 64 * j] = v[j] * rstd * g4[j];
        }
    }
}

__device__ __forceinline__ void phase_subln(Frame& F, const bf16_t* o1, const bf16_t* o2, const float* lq1, const float* lk1, const float* lq2, const float* lk2, const float* sg, bf16_t* y) {
    const int gw = F.vcu * NWAVES + F.wave, NGW = F.G * NWAVES, lane = F.lane;
    const float d1 = wave_sum(lq1[lane] * lk1[lane] + lq1[lane + 64] * lk1[lane + 64]);
    const float d2 = wave_sum(lq2[lane] * lk2[lane] + lq2[lane + 64] * lk2[lane + 64]);
    const float lam = __expf(d1) - __expf(d2) + LAMBDA_INIT;
    const f32x4 g = ((const f32x4*)sg)[lane] * (1.0f - LAMBDA_INIT);
    for (int idx = gw; idx < T * DIFF_H; idx += NGW) {
        const int tok = idx >> 3, h = idx & 7;
        const u32x2 a = *(const u32x2*)(o1 + (size_t)tok * D + h * 256 + 4 * lane), b = *(const u32x2*)(o2 + (size_t)tok * D + h * 256 + 4 * lane);
        f32x4 d; d[0] = bf_lo(a.x) - lam * bf_lo(b.x); d[1] = bf_hi(a.x) - lam * bf_hi(b.x); d[2] = bf_lo(a.y) - lam * bf_lo(b.y); d[3] = bf_hi(a.y) - lam * bf_hi(b.y);
        const float ss = (d[0] * d[0] + d[1] * d[1]) + (d[2] * d[2] + d[3] * d[3]);
        const float rstd = 1.0f / sqrtf(wave_sum(ss) * (1.0f / 256.0f) + RMS_EPS);
        const f32x4 yv = d * rstd * g;
        u32x2 w; w.x = cvt_pk_bf16(yv[0], yv[1]); w.y = cvt_pk_bf16(yv[2], yv[3]);
        *(u32x2*)(y + (size_t)tok * D + h * 256 + 4 * lane) = w;
    }
}

namespace att {
constexpr int SHM_K = 64 * 128 * 2, SHM_V = 64 * 256 * 2;
constexpr int V_OFF = 0, K_OFF = 2 * SHM_V, SCR_OFF = 2 * SHM_V + 2 * SHM_K;
constexpr float SCALE = 0.08838834764831845f;
constexpr float C2 = 1.4426950408889634f * SCALE;
constexpr float THR = 8.f;
#define KSWZ(row, colB) ((row) * 256 + ((colB) ^ (((row) & 7) << 4)))
__device__ __forceinline__ int crow(int r, int hi) { return (r & 3) + 8 * (r >> 2) + 4 * hi; }
__device__ __forceinline__ int v_rd_base(int lane) { return ((lane & 3) << 3) | (((lane >> 2) & 3) << 6) | (((lane >> 4) & 1) << 5) | (((lane >> 5) & 1) << 8); }
constexpr int v_rd_off(int d0, int ks, int half) { return d0 * 512 + ks * 8192 + half * 4096; }

template <int KB>
__device__ __forceinline__ void qkt(f32x16& p0, f32x16& p1, LAS unsigned char* lds, int r32, int hi, const bf16x8 (&qr)[8]) {
    const LAS unsigned char* kb[4];
#pragma unroll
    for (int dd = 0; dd < 4; ++dd) kb[dd] = lds + K_OFF + KB * SHM_K + KSWZ(r32, (dd * 16 + hi * 8) * 2);
#pragma unroll
    for (int d0 = 0; d0 < 8; ++d0) { const LAS unsigned char* a = kb[d0 & 3] + (d0 >> 2) * 128;
        const bf16x8 b0 = *(const LAS bf16x8*)a;
        const bf16x8 b1 = *(const LAS bf16x8*)(a + 32 * 256);
        p0 = __builtin_amdgcn_mfma_f32_32x32x16_bf16(b0, qr[d0], p0, 0, 0, 0);
        p1 = __builtin_amdgcn_mfma_f32_32x32x16_bf16(b1, qr[d0], p1, 0, 0, 0); }
}
template <int VB>
__device__ __forceinline__ void pv_tile(f32x16 (&o)[8], unsigned vb0, bf16x8 pa0, bf16x8 pa1, bf16x8 pa2, bf16x8 pa3) {
#define TRRD(dst, off) asm volatile("ds_read_b64_tr_b16 %0, %1 offset:%2" : "=&v"(dst) : "v"(vb0), "i"(off) : "memory")
#define PV_D0(d0) do { s16x4 l0, l1, l2, l3, h0, h1, h2, h3; constexpr int b_ = V_OFF + VB * SHM_V + v_rd_off(d0, 0, 0); \
        TRRD(l0, b_); TRRD(h0, b_ + 4096); TRRD(l1, b_ + 8192); TRRD(h1, b_ + 12288); TRRD(l2, b_ + 16384); TRRD(h2, b_ + 20480); TRRD(l3, b_ + 24576); TRRD(h3, b_ + 28672); \
        asm volatile("s_waitcnt lgkmcnt(0)" ::: "memory"); __builtin_amdgcn_sched_barrier(0); \
        o[d0] = __builtin_amdgcn_mfma_f32_32x32x16_bf16(pa0, (bf16x8){l0[0], l0[1], l0[2], l0[3], h0[0], h0[1], h0[2], h0[3]}, o[d0], 0, 0, 0); \
        o[d0] = __builtin_amdgcn_mfma_f32_32x32x16_bf16(pa1, (bf16x8){l1[0], l1[1], l1[2], l1[3], h1[0], h1[1], h1[2], h1[3]}, o[d0], 0, 0, 0); \
        o[d0] = __builtin_amdgcn_mfma_f32_32x32x16_bf16(pa2, (bf16x8){l2[0], l2[1], l2[2], l2[3], h2[0], h2[1], h2[2], h2[3]}, o[d0], 0, 0, 0); \
        o[d0] = __builtin_amdgcn_mfma_f32_32x32x16_bf16(pa3, (bf16x8){l3[0], l3[1], l3[2], l3[3], h3[0], h3[1], h3[2], h3[3]}, o[d0], 0, 0, 0); } while (0)
    PV_D0(0); PV_D0(1); PV_D0(2); PV_D0(3); PV_D0(4); PV_D0(5); PV_D0(6); PV_D0(7);
#undef PV_D0
#undef TRRD
}

__device__ __forceinline__ void stage_offsets(int tid, unsigned (&koff)[2], unsigned (&voff)[4]) {
#pragma unroll
    for (int i = 0; i < 2; ++i) { const int P = tid * 16 + i * 8192, row = P >> 8, ch = ((P & 255) >> 4) ^ (row & 7); koff[i] = (unsigned)(row * 128 + ch * 8) * 2u; }
#pragma unroll
    for (int i = 0; i < 4; ++i) { const int P = tid * 16 + i * 8192, st = P >> 9, kk = ((st >> 3) << 3) | ((P & 511) >> 6), cg = st & 7, cin = (P & 63) >> 1;
        const int key = (kk & ~0xC) | ((kk & 4) << 1) | ((kk & 8) >> 1); voff[i] = (unsigned)(key * 256 + cg * 32 + cin) * 2u; }
}
__device__ __forceinline__ const char* uniform_ptr(const void* p) {
    const unsigned long long v = (unsigned long long)p;
    const unsigned lo = __builtin_amdgcn_readfirstlane((unsigned)v), hi = __builtin_amdgcn_readfirstlane((unsigned)(v >> 32));
    return (const char*)(((unsigned long long)hi << 32) | lo);
}
__device__ __forceinline__ void stage_tile(LAS unsigned char* lds, int bf, const bf16_t* kj_, const bf16_t* vj_, int tid_, int wid) {
    const char* kj = uniform_ptr(kj_); const char* vj = uniform_ptr(vj_);
    int tid = tid_; asm volatile("" : "+v"(tid));
    unsigned koff[2], voff[4]; stage_offsets(tid, koff, voff);
#pragma unroll
    for (int i = 0; i < 2; ++i) __builtin_amdgcn_global_load_lds((const unsigned*)(kj + koff[i]), (LAS unsigned*)(lds + K_OFF + bf * SHM_K + wid * 1024 + i * 8192), 16, 0, 0);
#pragma unroll
    for (int i = 0; i < 4; ++i) __builtin_amdgcn_global_load_lds((const unsigned*)(vj + voff[i]), (LAS unsigned*)(lds + V_OFF + bf * SHM_V + wid * 1024 + i * 8192), 16, 0, 0);
}

template <int BF>
__device__ __forceinline__ void tile_compute(LAS unsigned char* lds, int r32, int hi, unsigned vb0, LAS float* al_l, const bf16x8 (&qr)[8], f32x16 (&o)[8],
                                             float& m_reg, float& l_reg, float rawu, float sl2, bool diag, int qi) {
    f32x16 p0, p1;
#pragma unroll
    for (int r = 0; r < 16; ++r) { p0[r] = 0.f; p1[r] = 0.f; }
    qkt<BF>(p0, p1, lds, r32, hi, qr);
#pragma unroll
    for (int r = 0; r < 16; ++r) { const float cr = (float)((r & 3) + 8 * (r >> 2)); p0[r] = fmaf(cr, rawu, p0[r]); p1[r] = fmaf(cr, rawu, p1[r]); }
    if (diag) {
        const float k2raw = 2.f * rawu;
        int qi_ = qi - 4 * hi; asm volatile("" : "+v"(qi_));
#pragma unroll
        for (int r = 0; r < 16; ++r) { const int c = (r & 3) + 8 * (r >> 2); const int d0_ = c - qi_, d1_ = c + 32 - qi_;
            p0[r] -= k2raw * (float)(d0_ > 0 ? d0_ : 0); p1[r] -= k2raw * (float)(d1_ > 0 ? d1_ : 0); }
    }
    const float lane_raw = rawu * (float)(4 * hi), d32raw = 32.f * rawu;
    float pm0 = p0[0], pm1 = p1[0];
#pragma unroll
    for (int r = 1; r < 16; ++r) { pm0 = fmaxf(pm0, p0[r]); pm1 = fmaxf(pm1, p1[r]); }
    float pmax = fmaxf(pm0, pm1 + d32raw) + lane_raw;
    { auto rr = __builtin_amdgcn_permlane32_swap(__float_as_uint(pmax), __float_as_uint(pmax), false, false);
      pmax = fmaxf(__uint_as_float(rr[0]), __uint_as_float(rr[1])); }
    float mn, alpha;
    if (__all((pmax - m_reg) * SCALE <= THR)) { mn = m_reg; alpha = 1.f; }
    else { mn = fmaxf(m_reg, pmax); alpha = __builtin_amdgcn_exp2f((m_reg - mn) * C2); m_reg = mn; }
    const float mnL0 = (lane_raw - mn) * C2, mnL1 = mnL0 + 32.f * sl2;
#pragma unroll
    for (int r = 0; r < 16; ++r) { p0[r] = __builtin_amdgcn_exp2f(fmaf(p0[r], C2, mnL0)); p1[r] = __builtin_amdgcn_exp2f(fmaf(p1[r], C2, mnL1)); }
    if (__any(alpha < 1.f)) {
        if (hi == 0) al_l[r32] = alpha;
        LDS_WAIT();
#pragma unroll
        for (int r = 0; r < 16; ++r) { const float a = al_l[crow(r, hi)];
#pragma unroll
            for (int d = 0; d < 8; ++d) o[d][r] *= a; }
    }
    float ps = 0.f;
#pragma unroll
    for (int r = 0; r < 16; ++r) ps += p0[r] + p1[r];
    { auto rr = __builtin_amdgcn_permlane32_swap(__float_as_uint(ps), __float_as_uint(ps), false, false);
      ps = __uint_as_float(rr[0]) + __uint_as_float(rr[1]); }
    l_reg = l_reg * alpha + ps;
    bf16x8 pa0, pa1, pa2, pa3;
#define PK4(P, B_, OUT) do { unsigned a0 = cvt_pk_bf16(P[B_+0], P[B_+1]), a1 = cvt_pk_bf16(P[B_+2], P[B_+3]); \
        unsigned b0 = cvt_pk_bf16(P[B_+4], P[B_+5]), b1 = cvt_pk_bf16(P[B_+6], P[B_+7]); \
        auto r0 = __builtin_amdgcn_permlane32_swap(a0, b0, false, false); auto r1 = __builtin_amdgcn_permlane32_swap(a1, b1, false, false); \
        u32x4 w = {r0[0], r1[0], r0[1], r1[1]}; OUT = __builtin_bit_cast(bf16x8, w); } while (0)
    PK4(p0, 0, pa0); PK4(p0, 8, pa1); PK4(p1, 0, pa2); PK4(p1, 8, pa3);
#undef PK4
    pv_tile<BF>(o, vb0, pa0, pa1, pa2, pa3);
}

__device__ __forceinline__ void norms_phase(Frame& F, const bf16_t* proj, float* nrm) {
    const int gw = F.vcu * NWAVES + F.wave, NGW = F.G * NWAVES, lane = F.lane;
    for (int idx = gw; idx < 2 * 32 * 256; idx += NGW) {
        const int tensor = idx >> 13, stream = (idx >> 8) & 31, grp = idx & 255;
        const u32x4* rp = (const u32x4*)(proj + (tensor ? DK0 : 0) + ((size_t)stream * SEQ + grp * 64 + lane) * 128);
        float ss = 0.f;
#pragma unroll
        for (int q = 0; q < 16; ++q) { const u32x4 v = rp[q];
#pragma unroll
            for (int e = 0; e < 4; ++e) { const float lo = bf_lo(v[e]), hi = bf_hi(v[e]); ss += lo * lo + hi * hi; } }
        float n = sqrtf(ss) * 1.001f;
#pragma unroll
        for (int o = 1; o < 64; o <<= 1) n = fmaxf(n, __shfl_xor(n, o));
        if (lane == 0) nrm[idx] = n;
    }
}

__device__ __forceinline__ void attn_item(LAS unsigned char* lds, const bf16_t* proj, const float* nrm, bf16_t* oout, int b, int h, int sub, int qb, int tid, int wid, int lane) {
    const int r32 = lane & 31, hi = lane >> 5;
    const float slope = __builtin_amdgcn_exp2f(-(float)(h + 1));
    const float sl2 = slope * 1.4426950408889634f, rawu = sl2 / C2;
    LAS float* ws = (LAS float*)(lds + SCR_OFF) + wid * 64; LAS float* li_l = ws; LAS float* al_l = ws + 32;
    const size_t tokq = (size_t)b * SEQ + (size_t)qb * 256 + wid * 32;
    const bf16_t* kbase = proj + DK0 + dq_off(b, 0, h, sub);
    const bf16_t* vbase = proj + dv_off(b, 0, h);
    int j_lo;
    { const int stream = (b * 8 + h) * 2 + sub; const float* qn = nrm + stream * 256; const float* kn = nrm + 8192 + stream * 256;
      const float Qn = fmaxf(fmaxf(qn[4 * qb], qn[4 * qb + 1]), fmaxf(qn[4 * qb + 2], qn[4 * qb + 3]));
      const float Kd = fmaxf(fmaxf(kn[4 * qb], kn[4 * qb + 1]), fmaxf(kn[4 * qb + 2], kn[4 * qb + 3]));
      int cand = 4 * qb;
      for (int jj = lane; jj < 4 * qb; jj += 64) { const float dmin = (float)(256 * qb - (64 * jj + 63)); const bool skip = slope * dmin > 110.f + SCALE * Qn * (kn[jj] + Kd); if (!skip) cand = cand < jj ? cand : jj; }
#pragma unroll
      for (int o = 1; o < 64; o <<= 1) { const int v = __shfl_xor(cand, o); cand = v < cand ? v : cand; }
      j_lo = __builtin_amdgcn_readfirstlane(cand); }
    bf16x8 qr[8];
#pragma unroll
    for (int d0 = 0; d0 < 8; ++d0) qr[d0] = *(const bf16x8*)(proj + dq_off(b, qb * 256 + wid * 32 + r32, h, sub) + d0 * 16 + hi * 8);
    const float sh64 = 64.f * rawu;
    const int qi = 32 * (wid & 1) + r32;
    const unsigned vb0 = (unsigned)(uintptr_t)(lds + V_OFF) + (unsigned)v_rd_base(lane);
    float m_reg = -1e30f, l_reg = 0.f;
    f32x16 o[8];
#pragma unroll
    for (int d = 0; d < 8; ++d)
#pragma unroll
        for (int r = 0; r < 16; ++r) o[d][r] = 0.f;
    const int NT = 4 * qb + 4, myNT = 4 * qb + (wid >> 1) + 1;
    constexpr size_t KSTEP = 64 * 128, VSTEP = 64 * 256;
    stage_tile(lds, 0, kbase + (size_t)j_lo * KSTEP, vbase + (size_t)j_lo * VSTEP, tid, wid);
    VM_WAIT(); WG_BAR();
    for (int j = j_lo; j < NT; j += 2) {
        if (j + 1 < NT) stage_tile(lds, 1, kbase + (size_t)(j + 1) * KSTEP, vbase + (size_t)(j + 1) * VSTEP, tid, wid);
        if (j < myNT) { if (j > j_lo) m_reg -= sh64; tile_compute<0>(lds, r32, hi, vb0, al_l, qr, o, m_reg, l_reg, rawu, sl2, j == myNT - 1, qi); }
        VM_WAIT(); WG_BAR();
        if (j + 2 < NT) stage_tile(lds, 0, kbase + (size_t)(j + 2) * KSTEP, vbase + (size_t)(j + 2) * VSTEP, tid, wid);
        if (j + 1 < myNT) { m_reg -= sh64; tile_compute<1>(lds, r32, hi, vb0, al_l, qr, o, m_reg, l_reg, rawu, sl2, j + 1 == myNT - 1, qi); }
        VM_WAIT(); WG_BAR();
    }
    if (hi == 0) li_l[r32] = l_reg;
    LDS_WAIT();
    char* Ow = (char*)(oout + tokq * D + h * 256);
    const unsigned lofs = (unsigned)(hi * 4 * D + r32) * 2u;
#pragma unroll
    for (int r = 0; r < 16; ++r) { const float rl = __builtin_amdgcn_rcpf(li_l[crow(r, hi)]);
#pragma unroll
        for (int d0 = 0; d0 < 8; ++d0) { const float v = o[d0][r] * rl; const float vn = __shfl_xor(v, 1);
            if ((r32 & 1) == 0) *(unsigned*)(Ow + (lofs + (unsigned)((((r & 3) + 8 * (r >> 2)) * D + d0 * 32) * 2))) = cvt_pk_bf16(v, vn); } }
    WG_BAR();
}

__device__ __forceinline__ void attn_phase(Frame& F, const bf16_t* proj, const float* nrm, unsigned* queue, bf16_t* o1, bf16_t* o2) {
    LAS int* qw = (LAS int*)(F.lds + SCR_OFF + 8 * 256);
    for (;;) {
        if (F.tid == 0) *qw = (int)__hip_atomic_fetch_add(queue, 1u, __ATOMIC_RELAXED, __HIP_MEMORY_SCOPE_AGENT);
        WG_BAR();
        const int I = __builtin_amdgcn_readfirstlane(*qw);
        if (I >= 2048) break;
        const int qb = 63 - (I >> 5), r = I & 31, h = 7 - (r >> 2), b = (r >> 1) & 1, sub = r & 1;
        attn_item(F.lds, proj, nrm, sub ? o2 : o1, b, h, sub, qb, F.tid, F.wave, F.lane);
    }
}
}

__global__ void __launch_bounds__(NWAVES * 64, 2) hybrid_fwd(Args args) {
    extern __shared__ __attribute__((aligned(16))) unsigned char lds_raw[];
    Frame F;
    F.lds = (LAS unsigned char*)lds_raw;
    F.tid = threadIdx.x; F.lane = F.tid & 63; F.wave = __builtin_amdgcn_readfirstlane(F.tid >> 6);
    F.G = gridDim.x; { const int bx = blockIdx.x; F.vcu = (F.G % 8 == 0) ? (bx % 8) * (F.G / 8) + bx / 8 : bx; }
    unsigned char* ws = args.ws;
    unsigned* ctl = (unsigned*)(ws + WS_CTL);
    for (int u = F.tid; u < (LDS_BYTES - LDSCTL_OFF) / 4; u += NWAVES * 64) ((LAS unsigned*)(F.lds + LDSCTL_OFF))[u] = 0u;
    __syncthreads();
    volatile LAS unsigned* MISC = (volatile LAS unsigned*)(F.lds + MISC_OFF);
    XcdBarrier bar = xcd_barrier_post(ctl + CW_BAR, MISC + 8);
#define GRID_BAR() xcd_barrier(bar)
#ifdef ONLY_PHASE
#define PHON(n) ((n) == ONLY_PHASE)
#elif DIAG
#define PHON(n) ((n) <= args.upto)
#else
#define PHON(n) 1
#endif

    const float* x_in = args.in[0]; const float* norm_mix = args.in[1]; const float* norm_ffn = args.in[2];
    const float* gla_w_in = args.in[3]; const float* gla_wgu = args.in[4]; const float* gla_bg = args.in[5]; const float* gla_norm = args.in[6]; const float* gla_w_out = args.in[7];
    const float* diff_w_in = args.in[8]; const float* lq1 = args.in[9]; const float* lk1 = args.in[10]; const float* lq2 = args.in[11]; const float* lk2 = args.in[12];
    const float* diff_subln = args.in[13]; const float* diff_w_out = args.in[14];
    const float* moe_wgrp = args.in[15]; const float* moe_wexp = args.in[16]; const float* moe_wg = args.in[17]; const float* moe_wu = args.in[18]; const float* moe_wd = args.in[19];
    const float* final_norm = args.in[20];
    float* xres = args.out;
    float* gz = (float*)(ws + WS_GZ);
    int* tok_e = (int*)(ws + WS_TOKE); int* tok_p = (int*)(ws + WS_TOKP); float* tok_w = (float*)(ws + WS_TOKW); int* slot_of = (int*)(ws + WS_SLOT);
    float* adec = (float*)(ws + WS_ADEC);
    float* wp_gz = (float*)(ws + WS_WPGZ); float* wp_r0 = (float*)(ws + WS_WPR0); float* wp_r1 = (float*)(ws + WS_WPR1);
    bf16_t* wgi = (bf16_t*)(ws + WS_WGI); bf16_t* wgo = (bf16_t*)(ws + WS_WGO); bf16_t* wdi = (bf16_t*)(ws + WS_WDI); bf16_t* wdo = (bf16_t*)(ws + WS_WDO);
    bf16_t* wmoe_gu = (bf16_t*)(ws + WS_WMOE); bf16_t* wmoe_d = (bf16_t*)(ws + WS_WMOE_D);
    bf16_t* hn = (bf16_t*)(ws + WS_HN); bf16_t* proj = (bf16_t*)(ws + WS_PROJ); bf16_t* buf1 = (bf16_t*)(ws + WS_BUF1); bf16_t* buf2 = (bf16_t*)(ws + WS_BUF2);
    bf16_t* ag = (bf16_t*)(ws + WS_AG); bf16_t* ob = (bf16_t*)(ws + WS_OB); bf16_t* hh = (bf16_t*)(ws + WS_H);
    const LAS int* pst = (const LAS int*)(F.lds + TAB_OFF);

    _Pragma("unroll") for (int rep_ = 0; rep_ < (REP_PHASE == 0 ? 2 : 1); ++rep_) if (PHON(0)) { if (rep_) GRID_BAR(); Frame P = F; P.tid = opq(F.tid); P.lane = P.tid & 63;
    conv_plain(P, gla_w_in, D, PROJW, GLA_INW, wgi);
    conv_plain(P, gla_w_out, D, D, D, wgo);
    conv_plain(P, diff_w_in, D, PROJW, PROJW, wdi);
    conv_plain(P, diff_w_out, D, D, D, wdo);
    pack_proj(P, wp_gz, 1, norm_mix, gla_w_in, GLA_INW, PROJW, 16, nullptr, 0, 0);
    pack_proj(P, wp_r0, 3, norm_ffn, moe_wgrp, 4, 0, 4, moe_wexp, 32, 32);
    pack_proj(P, wp_r1, 3, norm_ffn + D, moe_wgrp + (size_t)D * 4, 4, 0, 4, moe_wexp + (size_t)D * 32, 32, 32);
    }
    GRID_BAR();
    _Pragma("unroll") for (int rep_ = 0; rep_ < (REP_PHASE == 1 ? 2 : 1); ++rep_) if (PHON(1)) { if (rep_) GRID_BAR(); Frame P = F; P.tid = opq(F.tid); P.lane = P.tid & 63;
    phase_norm_gz(P, x_in, norm_mix, wp_gz, hn, gz);
    }
    GRID_BAR();
    _Pragma("unroll") for (int rep_ = 0; rep_ < (REP_PHASE == 2 ? 2 : 1); ++rep_) if (PHON(2)) { if (rep_) GRID_BAR(); Frame P = F; P.tid = opq(F.tid); P.lane = P.tid & 63;
    { pg8::Gemm g{hn, wgi, T, PROJW, D}; pg8::StaticOrder S; S.init(T, PROJW, P.G, (int)blockIdx.x); pg8::EpiHeads<0> E{proj};
      pg8::gemm_phase<pg8::EpiHeads<0>, pg8::StaticOrder>(P.lds, g, S, E); }
    }
    GRID_BAR();
    _Pragma("unroll") for (int rep_ = 0; rep_ < (REP_PHASE == 3 ? 2 : 1); ++rep_) if (PHON(3)) { if (rep_) GRID_BAR(); Frame P = F; P.tid = opq(F.tid); P.lane = P.tid & 63;
    phase_gla_gate(P, gz, gla_wgu, gla_bg, proj, buf1, adec);
    }
    GRID_BAR();
    _Pragma("unroll") for (int rep_ = 0; rep_ < (REP_PHASE == 4 ? 2 : 1); ++rep_) if (PHON(4)) { if (rep_) GRID_BAR(); Frame P = F; P.tid = opq(F.tid); P.lane = P.tid & 63;
    if (P.G == 256) { if ((P.vcu & 3) == 0) phase_gla_scan(P, P.vcu >> 2, proj, buf1, adec, buf2, ctl + CW_PROBE); else conv_moe(P, moe_wg, moe_wu, moe_wd, wmoe_gu, wmoe_d, (P.vcu >> 2) * 3 + (P.vcu & 3) - 1, 192); }
    else { for (int it = P.vcu; it < 64; it += P.G) phase_gla_scan(P, it, proj, buf1, adec, buf2); conv_moe(P, moe_wg, moe_wu, moe_wd, wmoe_gu, wmoe_d); }
    }
    GRID_BAR();
    _Pragma("unroll") for (int rep_ = 0; rep_ < (REP_PHASE == 5 ? 2 : 1); ++rep_) if (PHON(5)) { if (rep_) GRID_BAR(); Frame P = F; P.tid = opq(F.tid); P.lane = P.tid & 63;
    phase_gla_gnorm(P, buf2, proj, gla_norm, hn);
    }
    GRID_BAR();
    _Pragma("unroll") for (int rep_ = 0; rep_ < (REP_PHASE == 6 ? 2 : 1); ++rep_) if (PHON(6)) { if (rep_) GRID_BAR(); Frame P = F; P.tid = opq(F.tid); P.lane = P.tid & 63;
    { pg8::Gemm g{hn, wgo, T, D, D}; pg8::StaticOrder S; S.init(T, D, P.G, (int)blockIdx.x); pg8::EpiResF32 E{x_in, xres, D};
      pg8::gemm_phase<pg8::EpiResF32, pg8::StaticOrder>(P.lds, g, S, E); }
    }
    GRID_BAR();
    _Pragma("unroll") for (int rep_ = 0; rep_ < (REP_PHASE == 7 ? 2 : 1); ++rep_) if (PHON(7)) { if (rep_) GRID_BAR(); Frame P = F; P.tid = opq(F.tid); P.lane = P.tid & 63;
    phase_norm_route(P, xres, norm_ffn, wp_r0, hn, tok_e, tok_p, tok_w, ctl + CW_CNT0);
    }
    GRID_BAR();
    _Pragma("unroll") for (int rep_ = 0; rep_ < (REP_PHASE == 8 ? 2 : 1); ++rep_) if (PHON(8)) { if (rep_) GRID_BAR(); Frame P = F; P.tid = opq(F.tid); P.lane = P.tid & 63;
    moe_tables(P, ctl + CW_CNT0);
    phase_moe_gather(P, tok_e, tok_p, slot_of, hn, ag);
    }
    GRID_BAR();
    _Pragma("unroll") for (int rep_ = 0; rep_ < (REP_PHASE == 9 ? 2 : 1); ++rep_) if (PHON(9)) { if (rep_) GRID_BAR(); Frame P = F; P.tid = opq(F.tid); P.lane = P.tid & 63;
    { const int Mr = pst[33] * 256; pg8::Gemm g{ag, wmoe_gu, Mr, 1024, D}; pg8::MoeOrder S; S.init(Mr, 1024, P.G, (int)blockIdx.x); S.te = pst + 36; S.estride = (size_t)1024 * D * 2; pg8::EpiSiluMul E{hh};
      pg8::gemm_phase<pg8::EpiSiluMul, pg8::MoeOrder>(P.lds, g, S, E); }
    }
    GRID_BAR();
    _Pragma("unroll") for (int rep_ = 0; rep_ < (REP_PHASE == 10 ? 2 : 1); ++rep_) if (PHON(10)) { if (rep_) GRID_BAR(); Frame P = F; P.tid = opq(F.tid); P.lane = P.tid & 63;
    { const int Mr = pst[33] * 256; pg8::Gemm g{hh, wmoe_d, Mr, D, DFF}; pg8::MoeOrder S; S.init(Mr, D, P.G, (int)blockIdx.x); S.te = pst + 36; S.estride = (size_t)D * DFF * 2; pg8::EpiBf16 E{ob, D};
      pg8::gemm_phase<pg8::EpiBf16, pg8::MoeOrder>(P.lds, g, S, E); }
    }
    GRID_BAR();
    _Pragma("unroll") for (int rep_ = 0; rep_ < (REP_PHASE == 11 ? 2 : 1); ++rep_) if (PHON(11)) { if (rep_) GRID_BAR(); Frame P = F; P.tid = opq(F.tid); P.lane = P.tid & 63;
    phase_moe_combine<0>(P, xres, ob, slot_of, tok_w, norm_mix + D, hn);
    conv_moe(P, moe_wg + (size_t)NEXP * D * DFF, moe_wu + (size_t)NEXP * D * DFF, moe_wd + (size_t)NEXP * DFF * D, wmoe_gu, wmoe_d);
    }
    GRID_BAR();
    _Pragma("unroll") for (int rep_ = 0; rep_ < (REP_PHASE == 12 ? 2 : 1); ++rep_) if (PHON(12)) { if (rep_) GRID_BAR(); Frame P = F; P.tid = opq(F.tid); P.lane = P.tid & 63;
    { pg8::Gemm g{hn, wdi, T, PROJW, D}; pg8::StaticOrder S; S.init(T, PROJW, P.G, (int)blockIdx.x); pg8::EpiHeads<1> E{proj};
      pg8::gemm_phase<pg8::EpiHeads<1>, pg8::StaticOrder>(P.lds, g, S, E); }
    GRID_BAR();
    att::norms_phase(P, proj, (float*)(ws + WS_NRM));
    }
    GRID_BAR();
    _Pragma("unroll") for (int rep_ = 0; rep_ < (REP_PHASE == 13 ? 2 : 1); ++rep_) if (PHON(13)) { if (rep_) GRID_BAR(); Frame P = F; P.tid = opq(F.tid); P.lane = P.tid & 63;
    att::attn_phase(P, proj, (const float*)(ws + WS_NRM), ctl + CW_QUEUE, buf1, buf2);
    }
    GRID_BAR();
    _Pragma("unroll") for (int rep_ = 0; rep_ < (REP_PHASE == 14 ? 2 : 1); ++rep_) if (PHON(14)) { if (rep_) GRID_BAR(); Frame P = F; P.tid = opq(F.tid); P.lane = P.tid & 63;
    phase_subln(P, buf1, buf2, lq1, lk1, lq2, lk2, diff_subln, hn);
    }
    GRID_BAR();
    _Pragma("unroll") for (int rep_ = 0; rep_ < (REP_PHASE == 15 ? 2 : 1); ++rep_) if (PHON(15)) { if (rep_) GRID_BAR(); Frame P = F; P.tid = opq(F.tid); P.lane = P.tid & 63;
    { pg8::Gemm g{hn, wdo, T, D, D}; pg8::StaticOrder S; S.init(T, D, P.G, (int)blockIdx.x); pg8::EpiResF32 E{xres, xres, D};
      pg8::gemm_phase<pg8::EpiResF32, pg8::StaticOrder>(P.lds, g, S, E); }
    }
    GRID_BAR();
    _Pragma("unroll") for (int rep_ = 0; rep_ < (REP_PHASE == 16 ? 2 : 1); ++rep_) if (PHON(16)) { if (rep_) GRID_BAR(); Frame P = F; P.tid = opq(F.tid); P.lane = P.tid & 63;
    phase_norm_route(P, xres, norm_ffn + D, wp_r1, hn, tok_e, tok_p, tok_w, ctl + CW_CNT1);
    }
    GRID_BAR();
    _Pragma("unroll") for (int rep_ = 0; rep_ < (REP_PHASE == 17 ? 2 : 1); ++rep_) if (PHON(17)) { if (rep_) GRID_BAR(); Frame P = F; P.tid = opq(F.tid); P.lane = P.tid & 63;
    moe_tables(P, ctl + CW_CNT1);
    phase_moe_gather(P, tok_e, tok_p, slot_of, hn, ag);
    }
    GRID_BAR();
    _Pragma("unroll") for (int rep_ = 0; rep_ < (REP_PHASE == 18 ? 2 : 1); ++rep_) if (PHON(18)) { if (rep_) GRID_BAR(); Frame P = F; P.tid = opq(F.tid); P.lane = P.tid & 63;
    { const int Mr = pst[33] * 256; pg8::Gemm g{ag, wmoe_gu, Mr, 1024, D}; pg8::MoeOrder S; S.init(Mr, 1024, P.G, (int)blockIdx.x); S.te = pst + 36; S.estride = (size_t)1024 * D * 2; pg8::EpiSiluMul E{hh};
      pg8::gemm_phase<pg8::EpiSiluMul, pg8::MoeOrder>(P.lds, g, S, E); }
    }
    GRID_BAR();
    _Pragma("unroll") for (int rep_ = 0; rep_ < (REP_PHASE == 19 ? 2 : 1); ++rep_) if (PHON(19)) { if (rep_) GRID_BAR(); Frame P = F; P.tid = opq(F.tid); P.lane = P.tid & 63;
    { const int Mr = pst[33] * 256; pg8::Gemm g{hh, wmoe_d, Mr, D, DFF}; pg8::MoeOrder S; S.init(Mr, D, P.G, (int)blockIdx.x); S.te = pst + 36; S.estride = (size_t)D * DFF * 2; pg8::EpiBf16 E{ob, D};
      pg8::gemm_phase<pg8::EpiBf16, pg8::MoeOrder>(P.lds, g, S, E); }
    }
    GRID_BAR();
    _Pragma("unroll") for (int rep_ = 0; rep_ < (REP_PHASE == 20 ? 2 : 1); ++rep_) if (PHON(20)) { if (rep_) GRID_BAR(); Frame P = F; P.tid = opq(F.tid); P.lane = P.tid & 63;
    phase_moe_combine<1>(P, xres, ob, slot_of, tok_w, final_norm, hn);
    }
#if PROBE
    { GRID_BAR(); const float c = sqrtf(0.1f * __uint_as_float(xb_ld(ctl + CW_PROBE)));
      for (size_t i = (size_t)blockIdx.x * 512 + F.tid; i < (size_t)T * D; i += (size_t)gridDim.x * 512) xres[i] = c; }
#endif
}

#if DIAG
constexpr size_t WS_DIAG = WS_END;
constexpr int NSAVE = 64;
__device__ inline unsigned hsh(unsigned x) { x ^= x >> 16; x *= 0x7feb352dU; x ^= x >> 15; x *= 0x846ca68bU; x ^= x >> 16; return x; }
__device__ inline void rep(unsigned* w, double got, double ref, double scale) { double e = fabs(got - ref) / (fabs(ref) + scale); float ef = (float)e; if (!(ef == ef) || ef > 1e30f) ef = 1e30f; atomicMax(w, __float_as_uint(ef)); }
__device__ inline double bfd(bf16_t v) { return (double)bf2f(v); }
#define GTID (blockIdx.x * blockDim.x + threadIdx.x)
#define GSTR (gridDim.x * blockDim.x)

__global__ void ck_weights(const float* gla_w_in, const float* gla_w_out, const float* diff_w_in, const float* diff_w_out, const bf16_t* wgi, const bf16_t* wgo, const bf16_t* wdi, const bf16_t* wdo,
                           const float* norm_mix, const float* norm_ffn, const float* wgrp, const float* wexp, const float* wp_gz, const float* wp_r0, const float* wp_r1, unsigned* w) {
    for (unsigned i = GTID; i < 65536u; i += GSTR) { const unsigned r = hsh(i * 3u + 1u), r2 = hsh(i * 7u + 5u);
        const int n = r % 6144u, k = r2 % 2048u, n2 = n % 2048;
        rep(w, bfd(wgi[(size_t)n * D + k]), gla_w_in[(size_t)k * GLA_INW + n], 0.02); rep(w, bfd(wdi[(size_t)n * D + k]), diff_w_in[(size_t)k * PROJW + n], 0.02);
        rep(w, bfd(wgo[(size_t)n2 * D + k]), gla_w_out[(size_t)k * D + n2], 0.02); rep(w, bfd(wdo[(size_t)n2 * D + k]), diff_w_out[(size_t)k * D + n2], 0.02);
        const int s = r % 128u, ln = (r >> 7) % 64u, e4 = (r >> 13) & 3, kk = 16 * s + 4 * (ln >> 4) + e4, col = ln & 15, nt = (r >> 15) % 3u, col3 = 16 * nt + col;
        rep(w, wp_gz[(s * 64 + ln) * 4 + e4], (double)norm_mix[kk] * gla_w_in[(size_t)kk * GLA_INW + PROJW + col], 0.02);
        for (int L = 0; L < 2; ++L) { const float* gr = wgrp + (size_t)L * D * 4; const float* ex = wexp + (size_t)L * D * 32; const float* nf = norm_ffn + L * D;
            const double ref = col3 < 4 ? gr[kk * 4 + col3] : (col3 < 36 ? ex[kk * 32 + col3 - 4] : 0.0);
            rep(w, (L ? wp_r1 : wp_r0)[((s * 3 + nt) * 64 + ln) * 4 + e4], (double)nf[kk] * ref, 0.02); } }
}
__global__ void ck_moew(const float* wg, const float* wu, const float* wd, const bf16_t* GU, const bf16_t* DT, unsigned* w) {
    for (unsigned i = GTID; i < 65536u; i += GSTR) { const unsigned r = hsh(i * 5u + 2u), r2 = hsh(i * 11u + 3u);
        const int e = r % 32u, f = (r >> 5) % 512u, k = r2 % 2048u, n2 = (r2 >> 11) % 2048u, rowg = 256 * (f >> 7) + (f & 127);
        rep(w, bfd(GU[((size_t)e * 1024 + rowg) * D + k]), wg[((size_t)e * D + k) * DFF + f], 0.02); rep(w, bfd(GU[((size_t)e * 1024 + rowg + 128) * D + k]), wu[((size_t)e * D + k) * DFF + f], 0.02);
        rep(w, bfd(DT[((size_t)e * D + n2) * DFF + f]), wd[((size_t)e * DFF + f) * D + n2], 0.05); }
}
__global__ void ck_norm(const float* x, const float* gain, const bf16_t* hn, unsigned* w) {
    for (unsigned i = GTID; i < 4096u; i += GSTR) { const unsigned r = hsh(i * 13u + 7u); const int t = r % (unsigned)T, j = (r >> 15) % 2048u;
        double ss = 0; for (int k = 0; k < D; ++k) { const double v = x[(size_t)t * D + k]; ss += v * v; }
        const double rstd = 1.0 / sqrt(ss / D + 1e-6); rep(w, bfd(hn[(size_t)t * D + j]), x[(size_t)t * D + j] * rstd * gain[j], 1.0); }
}
__global__ void ck_gz(const float* x, const float* gain, const float* gla_w_in, const float* gz, unsigned* w) {
    for (unsigned i = GTID; i < 4096u; i += GSTR) { const unsigned r = hsh(i * 17u + 9u); const int t = r % (unsigned)T, c = (r >> 15) % 16u;
        double ss = 0, dot = 0; for (int k = 0; k < D; ++k) { const double v = x[(size_t)t * D + k]; ss += v * v; dot += v * gain[k] * gla_w_in[(size_t)k * GLA_INW + PROJW + c]; }
        rep(w, gz[(size_t)t * 16 + c], dot / sqrt(ss / D + 1e-6), 1.0); }
}
__global__ void ck_gemm(const bf16_t* A, const bf16_t* Bt, const bf16_t* C, int M, int N, int K, int ldc, double scale, unsigned* w) {
    for (unsigned i = GTID; i < 16384u; i += GSTR) { const unsigned r = hsh(i * 19u + 11u), r2 = hsh(i * 23u + 1u); const int m = r % (unsigned)M, n = r2 % (unsigned)N;
        double s = 0; for (int k = 0; k < K; ++k) s += bfd(A[(size_t)m * K + k]) * bfd(Bt[(size_t)n * K + k]);
        rep(w, bfd(C[(size_t)m * ldc + n]), s, scale); }
}
__global__ void ck_proj(const bf16_t* A, const bf16_t* Bt, const bf16_t* proj, int layer, unsigned* w) {
    for (unsigned i = GTID; i < 16384u; i += GSTR) { const unsigned r = hsh(i * 19u + 11u), r2 = hsh(i * 23u + 1u); const int m = r % (unsigned)T, n = r2 % (unsigned)PROJW, b = m >> 14, t = m & (SEQ - 1);
        double s = 0; for (int k = 0; k < D; ++k) s += bfd(A[(size_t)m * D + k]) * bfd(Bt[(size_t)n * D + k]);
        size_t off;
        if (layer == 0) { if (n < 1024) off = gq_off(b, t, n >> 8) + (n & 255); else if (n < 2048) off = GK0 + gq_off(b, t, (n - 1024) >> 8) + (n & 255); else if (n < 4096) off = gv_off(b, t, (n - 2048) >> 9) + (n & 511); else off = GR0 + (size_t)m * 2048 + (n - 4096); }
        else { if (n < 2048) off = dq_off(b, t, n >> 8, (n >> 7) & 1) + (n & 127); else if (n < 4096) off = DK0 + dq_off(b, t, (n - 2048) >> 8, (n >> 7) & 1) + (n & 127); else off = dv_off(b, t, (n - 4096) >> 8) + (n & 255); }
        rep(w, bfd(proj[off]), s, 1.0); }
}
__device__ inline int srow(int i) { return (int)(hsh(i * 29u + 13u) % (unsigned)T); }
__global__ void ck_save(const float* x, float* save) { for (unsigned i = GTID; i < (unsigned)NSAVE * D; i += GSTR) save[i] = x[(size_t)srow(i / D) * D + (i % D)]; }
__global__ void ck_gemm_res(const bf16_t* A, const bf16_t* Bt, const float* base, int saved, const float* out, unsigned* w) {
    for (unsigned i = GTID; i < (unsigned)NSAVE * 64u; i += GSTR) { const int si = i / 64, t = srow(si), n = hsh(i * 31u + 5u) % 2048u;
        double s = 0; for (int k = 0; k < D; ++k) s += bfd(A[(size_t)t * D + k]) * bfd(Bt[(size_t)n * D + k]);
        const double b = saved ? base[(size_t)si * D + n] : base[(size_t)t * D + n];
        rep(w, out[(size_t)t * D + n], b + s, 1.0); }
}
__global__ void ck_gate(const float* gz, const float* wgu, const float* bg, const bf16_t* proj, const bf16_t* kdT, const float* adec, unsigned* w) {
    for (unsigned i = GTID; i < 4096u; i += GSTR) { const unsigned r = hsh(i * 37u + 3u); const int bc = r % 512u, j = (r >> 9) % 1024u, tq = (r >> 19) % 64u;
        double run = 0, ct = 0;
        for (int t = 0; t < 64; ++t) { double z = bg[j]; for (int q = 0; q < 16; ++q) z += (double)gz[((size_t)bc * 64 + t) * 16 + q] * wgu[q * 1024 + j];
            const double ls = fmin(z, 0.0) - log1p(exp(-fabs(z))); run += ls / 16.0; if (t == tq) ct = run; }
        rep(w, adec[(size_t)bc * 1024 + j], exp(run), 1.0);
        rep(w, bfd(kdT[((size_t)bc * 1024 + j) * 64 + tq]), bfd(proj[GK0 + gq_off(bc >> 8, (bc & 255) * 64 + tq, j >> 8) + (j & 255)]) * exp(run - ct), 1.0); }
}
__global__ void ck_scan(const bf16_t* proj, const bf16_t* kdT, const float* adec, const bf16_t* o, unsigned* w) {
    const int wv = GTID / 64, lane = threadIdx.x & 63, nw = GSTR / 64;
    const int cl[8] = {0, 1, 3, 17, 100, 255, 2, 64};
    for (int s = wv; s < 96; s += nw) { const unsigned r = hsh(s * 41u + 17u); const int b = r & 1, c = cl[s % 8], tl = (r >> 1) % 64u, h = (r >> 7) % 4u, vc = (r >> 9) % 512u;
        float S[4] = {0.f, 0.f, 0.f, 0.f};
        for (int cc = 0; cc <= c; ++cc) { const size_t bc = (size_t)b * NCH + cc;
            for (int q = 0; q < 4; ++q) { const int kr = h * 256 + lane * 4 + q; float a = 0.f;
                for (int t = 0; t < 64; ++t) a += bf2f(kdT[(bc * 1024 + kr) * 64 + t]) * bf2f(proj[gv_off(b, cc * 64 + t, h) + vc]);
                S[q] = adec[bc * 1024 + kr] * S[q] + a; } }
        float part = 0.f; const size_t tok = (size_t)b * SEQ + c * 64 + tl;
        for (int q = 0; q < 4; ++q) part += bf2f(proj[gq_off(b, c * 64 + tl, h) + lane * 4 + q]) * S[q];
        for (int of = 1; of < 64; of <<= 1) part += __shfl_xor(part, of);
        if (lane == 0) rep(w, bfd(o[tok * D + h * 512 + vc]), part / 16.0, 2.0); }
}
__global__ void ck_gnorm(const bf16_t* o, const bf16_t* proj, const float* gn, const bf16_t* y, unsigned* w) {
    for (unsigned i = GTID; i < 8192u; i += GSTR) { const unsigned r = hsh(i * 43u + 19u); const int t = r % (unsigned)T, h = (r >> 15) % 4u, j = (r >> 17) % 512u;
        double ss = 0; for (int k = 0; k < 512; ++k) { const double v = bfd(o[(size_t)t * D + h * 512 + k]); ss += v * v; }
        const double rr = bfd(proj[GR0 + (size_t)t * 2048 + h * 512 + j]);
        rep(w, bfd(y[(size_t)t * D + h * 512 + j]), bfd(o[(size_t)t * D + h * 512 + j]) / sqrt(ss / 512 + 1e-6) * gn[j] * rr / (1.0 + exp(-rr)), 1.0); }
}
__global__ void ck_route(const float* x, const float* gain, const float* wgrp, const float* wexp, const int* tok_e, const int* tok_p, const float* tok_w, const unsigned* cnt, unsigned* w) {
    for (unsigned i = GTID; i < 512u; i += GSTR) { const int t = hsh(i * 47u + 23u) % (unsigned)T;
        double ss = 0; for (int k = 0; k < D; ++k) { const double v = x[(size_t)t * D + k]; ss += v * v; }
        const double rstd = 1.0 / sqrt(ss / D + 1e-6);
        double gl[4] = {0, 0, 0, 0};
        for (int k = 0; k < D; ++k) { const double v = x[(size_t)t * D + k] * rstd * gain[k]; for (int q = 0; q < 4; ++q) gl[q] += v * wgrp[k * 4 + q]; }
        int gi = 0; for (int q = 1; q < 4; ++q) if (gl[q] > gl[gi]) gi = q;
        double gs = 0; for (int q = 0; q < 4; ++q) gs += exp(gl[q] - gl[gi]);
        double el[8] = {0, 0, 0, 0, 0, 0, 0, 0};
        for (int k = 0; k < D; ++k) { const double v = x[(size_t)t * D + k] * rstd * gain[k]; for (int q = 0; q < 8; ++q) el[q] += v * wexp[k * 32 + gi * 8 + q]; }
        int i1 = 0; for (int q = 1; q < 8; ++q) if (el[q] > el[i1]) i1 = q;
        int i2 = (i1 == 0) ? 1 : 0; for (int q = 0; q < 8; ++q) if (q != i1 && el[q] > el[i2]) i2 = q;
        const double eb = exp(el[i2] - el[i1]);
        const int e1 = tok_e[2 * t], e2 = tok_e[2 * t + 1];
        double third = -1e30; for (int q = 0; q < 8; ++q) if (q != i1 && q != i2 && el[q] > third) third = el[q];
        const bool tie = (el[i2] - third) < 1e-4 || (el[i1] - el[i2]) < 1e-4;
        if (!tie) { rep(w, e1, gi * 8 + i1, 1.0); rep(w, e2, gi * 8 + i2, 1.0);
            rep(w, tok_w[2 * t], 1.0 / gs / (1.0 + eb), 0.3); rep(w, tok_w[2 * t + 1], eb / gs / (1.0 + eb), 0.3); }
        if ((unsigned)tok_p[2 * t] >= cnt[64 * (e1 & 31)] || (unsigned)tok_p[2 * t + 1] >= cnt[64 * (e2 & 31)]) rep(w, 9.0, 0.0, 1.0); }
}
__global__ void ck_gather(const int* tok_e, const int* tok_p, const int* slot_of, const unsigned* cnt, const bf16_t* hn, const bf16_t* ag, unsigned* w) {
    for (unsigned i = GTID; i < 8192u; i += GSTR) { const unsigned r = hsh(i * 53u + 29u); const int a = r % (2u * T), k = (r >> 16) % 2048u, e = tok_e[a] & 31;
        int ps = 0; for (int q = 0; q < e; ++q) ps += ((int)cnt[64 * q] + 255) & ~255;
        const int slot = slot_of[a];
        rep(w, slot, ps + tok_p[a], 1.0);
        if (slot >= 0 && slot < MAX_TILES * 256) rep(w, bfd(ag[(size_t)slot * D + k]), bfd(hn[(size_t)(a >> 1) * D + k]), 1.0); }
}
__global__ void ck_moe1(const int* tok_e, const int* slot_of, const bf16_t* ag, const float* wg, const float* wu, const bf16_t* hh, unsigned* w) {
    for (unsigned i = GTID; i < 8192u; i += GSTR) { const unsigned r = hsh(i * 59u + 31u); const int a = r % (2u * T), f = (r >> 16) % 512u, e = tok_e[a] & 31, slot = slot_of[a];
        if (slot < 0 || slot >= MAX_TILES * 256) { rep(w, 9.0, 0.0, 1.0); continue; }
        double g = 0, u = 0; for (int k = 0; k < D; ++k) { const double v = bfd(ag[(size_t)slot * D + k]); g += v * wg[((size_t)e * D + k) * DFF + f]; u += v * wu[((size_t)e * D + k) * DFF + f]; }
        rep(w, bfd(hh[(size_t)slot * DFF + f]), g / (1.0 + exp(-g)) * u, 0.5); }
}
__global__ void ck_moe2(const int* tok_e, const int* slot_of, const bf16_t* hh, const float* wd, const bf16_t* ob, unsigned* w) {
    for (unsigned i = GTID; i < 8192u; i += GSTR) { const unsigned r = hsh(i * 61u + 37u); const int a = r % (2u * T), n = (r >> 16) % 2048u, e = tok_e[a] & 31, slot = slot_of[a];
        if (slot < 0 || slot >= MAX_TILES * 256) { rep(w, 9.0, 0.0, 1.0); continue; }
        double s = 0; for (int f = 0; f < DFF; ++f) s += bfd(hh[(size_t)slot * DFF + f]) * wd[((size_t)e * DFF + f) * D + n];
        rep(w, bfd(ob[(size_t)slot * D + n]), s, 0.3); }
}
__global__ void ck_combine(const float* save, const bf16_t* ob, const int* slot_of, const float* tok_w, const float* gain, const float* x, const bf16_t* hn, int mode, unsigned* w) {
    for (unsigned i = GTID; i < (unsigned)NSAVE * 32u; i += GSTR) { const int si = i / 32, t = srow(si), j = hsh(i * 67u + 41u) % 2048u;
        const int s0 = slot_of[2 * t], s1 = slot_of[2 * t + 1]; const double w0 = tok_w[2 * t], w1 = tok_w[2 * t + 1];
        double ss = 0, xj = 0; for (int k = 0; k < D; ++k) { const double v = save[(size_t)si * D + k] + w0 * bfd(ob[(size_t)s0 * D + k]) + w1 * bfd(ob[(size_t)s1 * D + k]); ss += v * v; if (k == j) xj = v; }
        const double y = xj / sqrt(ss / D + 1e-6) * gain[j];
        if (mode == 0) { rep(w, x[(size_t)t * D + j], xj, 1.0); rep(w, bfd(hn[(size_t)t * D + j]), y, 1.0); } else rep(w, x[(size_t)t * D + j], y, 1.0); }
}
__global__ void ck_attn(const bf16_t* proj, const bf16_t* o1, const bf16_t* o2, unsigned* w) {
    const int wv = GTID / 64, lane = threadIdx.x & 63, nw = GSTR / 64;
    const int tl[12] = {0, 1, 63, 64, 100, 255, 256, 1000, 4095, 8191, 16320, 16383};
    for (int s = wv; s < 96; s += nw) { const unsigned r = hsh(s * 71u + 43u); const int b = r & 1, h = (r >> 1) % 8u, sub = (r >> 4) & 1, t = tl[s % 12], dv0 = (r >> 5) % 253u;
        const double slope = exp2(-(double)(h + 1)); const int kend = 64 * (t / 64 + 1);
        const bf16_t* qp = proj + dq_off(b, t, h, sub);
        double mx = -1e300;
        for (int j = lane; j < kend; j += 64) { const bf16_t* kp = proj + DK0 + dq_off(b, j, h, sub); double d = 0; for (int q = 0; q < 128; ++q) d += bfd(qp[q]) * bfd(kp[q]);
            const double sc = d * 0.08838834764831845 - slope * fabs((double)(t - j)); if (sc > mx) mx = sc; }
        for (int of = 1; of < 64; of <<= 1) { const double o_ = __shfl_xor(mx, of); if (o_ > mx) mx = o_; }
        double l = 0, acc[4] = {0, 0, 0, 0};
        for (int j = lane; j < kend; j += 64) { const bf16_t* kp = proj + DK0 + dq_off(b, j, h, sub); double d = 0; for (int q = 0; q < 128; ++q) d += bfd(qp[q]) * bfd(kp[q]);
            const double p = exp(d * 0.08838834764831845 - slope * fabs((double)(t - j)) - mx); l += p;
            const bf16_t* vp = proj + dv_off(b, j, h) + dv0; for (int q = 0; q < 4; ++q) acc[q] += p * bfd(vp[q]); }
        for (int of = 1; of < 64; of <<= 1) { l += __shfl_xor(l, of); for (int q = 0; q < 4; ++q) acc[q] += __shfl_xor(acc[q], of); }
        if (lane == 0) for (int q = 0; q < 4; ++q) rep(w, bfd((sub ? o2 : o1)[((size_t)b * SEQ + t) * D + h * 256 + dv0 + q]), acc[q] / l, 0.2); }
}
__global__ void ck_subln(const bf16_t* o1, const bf16_t* o2, const float* lq1, const float* lk1, const float* lq2, const float* lk2, const float* sg, const bf16_t* y, unsigned* w) {
    double d1 = 0, d2 = 0; for (int k = 0; k < 128; ++k) { d1 += (double)lq1[k] * lk1[k]; d2 += (double)lq2[k] * lk2[k]; }
    const double li = 0.8 - 0.6 * exp(-0.3), lam = exp(d1) - exp(d2) + li;
    for (unsigned i = GTID; i < 8192u; i += GSTR) { const unsigned r = hsh(i * 73u + 47u); const int t = r % (unsigned)T, h = (r >> 15) % 8u, j = (r >> 18) % 256u;
        double ss = 0, dj = 0; for (int k = 0; k < 256; ++k) { const double v = bfd(o1[(size_t)t * D + h * 256 + k]) - lam * bfd(o2[(size_t)t * D + h * 256 + k]); ss += v * v; if (k == j) dj = v; }
        rep(w, bfd(y[(size_t)t * D + h * 256 + j]), dj / sqrt(ss / 256 + 1e-6) * sg[j] * (1.0 - li), 1.0); }
}
__global__ void ck_final(const unsigned* words, int nst, float* out, int n) {
    int val = 0;
    for (int s = 0; s < nst; ++s) { const float e = __uint_as_float(words[s]); if (e >= 0.03125f) { val = 4 * s + (e < 0.25f ? 1 : (e < 4.f ? 2 : 3)); break; } }
    const float c = sqrtf(0.1f * (float)val);
    for (int i = GTID; i < n; i += GSTR) out[i] = c;
}
#endif

extern "C" void kernel_launch(void* const* d_in, const int* in_sizes, int n_in, void* d_out, int out_size, void* d_ws, size_t ws_size, hipStream_t stream) {
    static int grid = 0;
    if (grid == 0) {
        if (n_in != 21 || out_size != T * D || ws_size < WS_END + 2 * MiB) { fprintf(stderr, "kernel_launch: unexpected shapes (n_in %d out %d ws %zu)\n", n_in, out_size, ws_size); grid = -1; return; }
        if (hipFuncSetAttribute((const void*)hybrid_fwd, hipFuncAttributeMaxDynamicSharedMemorySize, LDS_BYTES) != hipSuccess) { fprintf(stderr, "kernel_launch: hipFuncSetAttribute failed\n"); grid = -1; return; }
        int dev = 0, cus = 0, per_cu = 0;
        (void)hipGetDevice(&dev); (void)hipDeviceGetAttribute(&cus, hipDeviceAttributeMultiprocessorCount, dev);
        if (hipOccupancyMaxActiveBlocksPerMultiprocessor(&per_cu, (const void*)hybrid_fwd, NWAVES * 64, LDS_BYTES) != hipSuccess || per_cu < 1) fprintf(stderr, "kernel_launch: occupancy query says %d\n", per_cu);
        (void)hipGetLastError();
        grid = cus > 0 ? cus : 256;
    }
    if (grid < 0) return;
    Args a{};
    for (int i = 0; i < 21; ++i) a.in[i] = (const float*)d_in[i];
    a.out = (float*)d_out; a.ws = (unsigned char*)d_ws; a.upto = 99; a.pad1 = 0;
#if !DIAG
    (void)hipMemsetAsync((char*)d_ws + WS_CTL, 0, CTL_ZERO_BYTES, stream);
    hipLaunchKernelGGL(hybrid_fwd, dim3(grid), dim3(NWAVES * 64), LDS_BYTES, stream, a);
#else
    {
        unsigned char* ws = (unsigned char*)d_ws; const float* const* in = a.in;
        unsigned* words = (unsigned*)(ws + WS_DIAG); float* save = (float*)(ws + WS_DIAG + 65536);
        (void)hipMemsetAsync(words, 0, 65536, stream);
        float* gz = (float*)(ws + WS_GZ); int* tok_e = (int*)(ws + WS_TOKE); int* tok_p = (int*)(ws + WS_TOKP); float* tok_w = (float*)(ws + WS_TOKW); int* slot_of = (int*)(ws + WS_SLOT);
        float* adec = (float*)(ws + WS_ADEC); float* wp_gz = (float*)(ws + WS_WPGZ); float* wp_r0 = (float*)(ws + WS_WPR0); float* wp_r1 = (float*)(ws + WS_WPR1);
        bf16_t* wgi = (bf16_t*)(ws + WS_WGI); bf16_t* wgo = (bf16_t*)(ws + WS_WGO); bf16_t* wdi = (bf16_t*)(ws + WS_WDI); bf16_t* wdo = (bf16_t*)(ws + WS_WDO);
        bf16_t* gu = (bf16_t*)(ws + WS_WMOE); bf16_t* dt = (bf16_t*)(ws + WS_WMOE_D);
        bf16_t* hn = (bf16_t*)(ws + WS_HN); bf16_t* proj = (bf16_t*)(ws + WS_PROJ); bf16_t* buf1 = (bf16_t*)(ws + WS_BUF1); bf16_t* buf2 = (bf16_t*)(ws + WS_BUF2);
        bf16_t* ag = (bf16_t*)(ws + WS_AG); bf16_t* ob = (bf16_t*)(ws + WS_OB); bf16_t* hh = (bf16_t*)(ws + WS_H);
        unsigned* ctl = (unsigned*)(ws + WS_CTL); float* xres = (float*)d_out;
        const size_t L1W = (size_t)NEXP * D * DFF;
        for (int st = 0; st <= 20; ++st) {
            (void)hipMemsetAsync((char*)d_ws + WS_CTL, 0, CTL_ZERO_BYTES, stream);
            a.upto = st;
            hipLaunchKernelGGL(hybrid_fwd, dim3(grid), dim3(NWAVES * 64), LDS_BYTES, stream, a);
            unsigned* w = words + st;
            switch (st) {
            case 0: ck_weights<<<256, 256, 0, stream>>>(in[3], in[7], in[8], in[14], wgi, wgo, wdi, wdo, in[1], in[2], in[15], in[16], wp_gz, wp_r0, wp_r1, w); break;
            case 1: ck_norm<<<64, 64, 0, stream>>>(in[0], in[1], hn, w); ck_gz<<<64, 64, 0, stream>>>(in[0], in[1], in[3], gz, w); break;
            case 2: ck_proj<<<256, 64, 0, stream>>>(hn, wgi, proj, 0, w); break;
            case 3: ck_gate<<<64, 64, 0, stream>>>(gz, in[4], in[5], proj, buf1, adec, w); break;
            case 4: ck_scan<<<96, 64, 0, stream>>>(proj, buf1, adec, buf2, w); ck_moew<<<256, 256, 0, stream>>>(in[17], in[18], in[19], gu, dt, w); break;
            case 5: ck_gnorm<<<128, 64, 0, stream>>>(buf2, proj, in[6], hn, w); break;
            case 6: ck_gemm_res<<<64, 64, 0, stream>>>(hn, wgo, in[0], 0, xres, w); break;
            case 7: ck_norm<<<64, 64, 0, stream>>>(xres, in[2], hn, w); ck_route<<<8, 64, 0, stream>>>(xres, in[2], in[15], in[16], tok_e, tok_p, tok_w, ctl + CW_CNT0, w); break;
            case 8: ck_gather<<<128, 64, 0, stream>>>(tok_e, tok_p, slot_of, ctl + CW_CNT0, hn, ag, w); break;
            case 9: ck_moe1<<<128, 64, 0, stream>>>(tok_e, slot_of, ag, in[17], in[18], hh, w); break;
            case 10: ck_moe2<<<128, 64, 0, stream>>>(tok_e, slot_of, hh, in[19], ob, w); ck_save<<<64, 256, 0, stream>>>(xres, save); break;
            case 11: ck_combine<<<32, 64, 0, stream>>>(save, ob, slot_of, tok_w, in[1] + D, xres, hn, 0, w); ck_moew<<<256, 256, 0, stream>>>(in[17] + L1W, in[18] + L1W, in[19] + L1W, gu, dt, w); break;
            case 12: ck_proj<<<256, 64, 0, stream>>>(hn, wdi, proj, 1, w); break;
            case 13: ck_attn<<<96, 64, 0, stream>>>(proj, buf1, buf2, w); break;
            case 14: ck_subln<<<128, 64, 0, stream>>>(buf1, buf2, in[9], in[10], in[11], in[12], in[13], hn, w); ck_save<<<64, 256, 0, stream>>>(xres, save); break;
            case 15: ck_gemm_res<<<64, 64, 0, stream>>>(hn, wdo, save, 1, xres, w); break;
            case 16: ck_norm<<<64, 64, 0, stream>>>(xres, in[2] + D, hn, w); ck_route<<<8, 64, 0, stream>>>(xres, in[2] + D, in[15] + (size_t)D * 4, in[16] + (size_t)D * 32, tok_e, tok_p, tok_w, ctl + CW_CNT1, w); break;
            case 17: ck_gather<<<128, 64, 0, stream>>>(tok_e, tok_p, slot_of, ctl + CW_CNT1, hn, ag, w); break;
            case 18: ck_moe1<<<128, 64, 0, stream>>>(tok_e, slot_of, ag, in[17] + L1W, in[18] + L1W, hh, w); break;
            case 19: ck_moe2<<<128, 64, 0, stream>>>(tok_e, slot_of, hh, in[19] + L1W, ob, w); ck_save<<<64, 256, 0, stream>>>(xres, save); break;
            case 20: ck_combine<<<32, 64, 0, stream>>>(save, ob, slot_of, tok_w, in[20], xres, hn, 1, w); break;
            }
        }
        ck_final<<<1024, 256, 0, stream>>>(words, 21, (float*)d_out, out_size);
    }
#endif
}
```

```cpp
#ifndef DIAG
#define DIAG 0
#endif
#ifndef PROBE
#define PROBE 0
#endif
#ifndef REP_PHASE
#define REP_PHASE -1
#endif
#include <hip/hip_runtime.h>
#include <cstdio>
#include <cstdint>

#define LAS __attribute__((address_space(3)))
#define GAS __attribute__((address_space(1)))
typedef unsigned short bf16_t;
typedef short bf16x8 __attribute__((ext_vector_type(8)));
typedef short s16x4 __attribute__((ext_vector_type(4)));
typedef float f32x4 __attribute__((ext_vector_type(4)));
typedef float f32x2 __attribute__((ext_vector_type(2)));
typedef float f32x16 __attribute__((ext_vector_type(16)));
typedef unsigned u32x4 __attribute__((ext_vector_type(4)));
typedef unsigned u32x2 __attribute__((ext_vector_type(2)));

constexpr int D = 2048, SEQ = 16384, NBATCH = 2, T = NBATCH * SEQ, CHUNK = 64, NCH = SEQ / CHUNK;
constexpr int GLA_H = 4, GLA_DK = 256, GLA_DV = 512, GLA_DKT = 1024, GLA_INW = 6160, PROJW = 6144;
constexpr int DIFF_H = 8;
constexpr int NEXP = 32, DFF = 512;
constexpr float RMS_EPS = 1e-6f;
constexpr float LAMBDA_INIT = 0.35550906759f;
constexpr int MAX_TILES = 288;

constexpr size_t MiB = 1u << 20;
constexpr size_t WS_CTL = 0, CTL_ZERO_BYTES = 1 * MiB;
constexpr size_t WS_GZ = 2 * MiB;
constexpr size_t WS_TOKE = 4 * MiB;
constexpr size_t WS_TOKP = WS_TOKE + 256 * 1024;
constexpr size_t WS_TOKW = WS_TOKP + 256 * 1024;
constexpr size_t WS_SLOT = WS_TOKW + 256 * 1024;
constexpr size_t WS_ADEC = 8 * MiB;
constexpr size_t WS_WPGZ = 10 * MiB;
constexpr size_t WS_WPR0 = 10 * MiB + 256 * 1024;
constexpr size_t WS_WPR1 = 11 * MiB;
constexpr size_t WS_NRM = 12 * MiB;
constexpr size_t WS_WGI = 16 * MiB, WS_WGO = 40 * MiB, WS_WDI = 48 * MiB, WS_WDO = 72 * MiB;
constexpr size_t WS_WMOE = 80 * MiB;
constexpr size_t WS_WMOE_D = WS_WMOE + 128 * MiB;
constexpr size_t WS_HN = 272 * MiB;
constexpr size_t WS_PROJ = 400 * MiB;
constexpr size_t WS_BUF1 = 784 * MiB;
constexpr size_t WS_BUF2 = 912 * MiB;
constexpr size_t WS_AG = 400 * MiB;
constexpr size_t WS_OB = 688 * MiB;
constexpr size_t WS_H = 976 * MiB;
constexpr size_t WS_END = 1048 * MiB;
constexpr int CW_BAR = 4096;
constexpr int CW_PROBE = 8320;
constexpr int CW_QUEUE = 8192;
constexpr int CW_CNT0 = 16384, CW_CNT1 = 16384 + 32 * 64;


constexpr size_t GK0 = (size_t)T * 1024, GV0 = (size_t)T * 2048, GR0 = (size_t)T * 4096;
constexpr size_t DK0 = (size_t)T * 2048, DV0 = (size_t)T * 4096;
__host__ __device__ __forceinline__ size_t gq_off(int b, int t, int h) { return ((size_t)(b * 4 + h) * SEQ + t) * 256; }
__host__ __device__ __forceinline__ size_t gv_off(int b, int t, int h) { return GV0 + ((size_t)(b * 4 + h) * SEQ + t) * 512; }
__host__ __device__ __forceinline__ size_t dq_off(int b, int t, int h, int sub) { return ((size_t)((b * 8 + h) * 2 + sub) * SEQ + t) * 128; }
__host__ __device__ __forceinline__ size_t dv_off(int b, int t, int h) { return DV0 + ((size_t)(b * 8 + h) * SEQ + t) * 256; }

constexpr int RING_BYTES = 131072;
constexpr int LDSCTL_OFF = RING_BYTES;
constexpr int MISC_OFF = LDSCTL_OFF + 320;
constexpr int TAB_OFF = LDSCTL_OFF + 1024;
constexpr int LDS_BYTES = 147456;
constexpr int NWAVES = 8;

typedef __bf16 bf16x2_t __attribute__((ext_vector_type(2)));
__device__ __forceinline__ unsigned cvt_pk_bf16(float lo, float hi) { const f32x2 v = {lo, hi}; return __builtin_bit_cast(unsigned, __builtin_convertvector(v, bf16x2_t)); }
__device__ __forceinline__ float bf_lo(unsigned w) { return __uint_as_float(w << 16); }
__device__ __forceinline__ float bf_hi(unsigned w) { return __uint_as_float(w & 0xffff0000u); }
__device__ __forceinline__ float bf2f(bf16_t b) { return __uint_as_float(((unsigned)b) << 16); }
__device__ __forceinline__ float wave_sum(float v) {
#pragma unroll
    for (int o = 1; o < 64; o <<= 1) v += __shfl_xor(v, o);
    return v;
}
__device__ __forceinline__ int opq(int v) { asm volatile("" : "+v"(v)); return v; }
#define LDS_WAIT() asm volatile("s_waitcnt lgkmcnt(0)" ::: "memory")
#define VM_WAIT() asm volatile("s_waitcnt vmcnt(0)" ::: "memory")
#define WG_BAR() do { asm volatile("s_waitcnt lgkmcnt(0)" ::: "memory"); __builtin_amdgcn_s_barrier(); asm volatile("" ::: "memory"); } while (0)

namespace pg8 {
constexpr int BM = 256, BK = 64, HALF = 128, HTB = HALF * BK * 2, STAGE_BYTES = 8 * HTB, NXCD = 8, WGM = 8;
__host__ __device__ __forceinline__ int lds_byte(int r, int c) { const int st = (r >> 4) * 2 + (c >> 5), rr = r & 15, cc = c & 31, ob = rr * 64 + cc * 2; return st * 1024 + (ob ^ (((ob >> 9) & 1) << 5)); }
__host__ __device__ __forceinline__ void stage_rc(int b, int& R, int& C) { const int st = b / 1024, sb = b % 1024, swz = sb ^ (((sb >> 9) & 1) << 5); R = (st >> 1) * 16 + swz / 64; C = (st & 1) * 32 + (swz % 64) / 2; }
__host__ __device__ __forceinline__ int perm32(int rho) { const int n = rho >> 4, i = rho & 15; return 8 * (i >> 2) + 4 * n + (i & 3); }

struct Unit { int pm, pn; };
struct Gemm { const bf16_t* A; const bf16_t* Bt; int M, N, K; };

struct StaticOrder {
    int nM, nN, nwg, G, c;
    __device__ void init(int M, int N, int G_, int c_) { nM = M / BM; nN = N / BM; nwg = nM * nN; G = G_; c = c_; }
    __device__ bool next(int i, Unit& u) const {
        const long L = (long)i * G + c; if (L >= nwg) return false;
        int wgid = (int)L; { const int q = nwg / NXCD, r = nwg % NXCD, xcd = wgid % NXCD, off = wgid / NXCD; wgid = (xcd < r ? xcd * (q + 1) : r * (q + 1) + (xcd - r) * q) + off; }
        const int nig = WGM * nN, gid = wgid / nig, fm = gid * WGM, gsz = (nM - fm) < WGM ? (nM - fm) : WGM;
        u.pm = fm + ((wgid % nig) % gsz); u.pn = (wgid % nig) / gsz; return true;
    }
    __device__ __forceinline__ size_t bofs(const Unit&) const { return 0; }
};
struct MoeOrder : StaticOrder {
    const LAS int* te; size_t estride;
    __device__ __forceinline__ size_t bofs(const Unit& u) const { return (size_t)te[u.pm] * estride; }
};

struct EpiBf16 {
    static constexpr bool PERM = true;
    bf16_t* O; int ldc;
    __device__ __forceinline__ void operator()(const f32x4 (&acc)[2][2][4][2], const Unit& u, int wr, int wc, int fr, int fq) const {
        const int row0 = u.pm * BM + wr * 64 + fr, col0 = u.pn * BM + wc * 32 + 8 * fq;
#pragma unroll
        for (int ai = 0; ai < 2; ++ai)
#pragma unroll
            for (int m = 0; m < 4; ++m) { bf16_t* rowp = O + (size_t)(row0 + ai * HALF + m * 16) * ldc + col0;
#pragma unroll
                for (int bj = 0; bj < 2; ++bj) { const f32x4 v0 = acc[ai][bj][m][0], v1 = acc[ai][bj][m][1];
                    u32x4 w; w.x = cvt_pk_bf16(v0[0], v0[1]); w.y = cvt_pk_bf16(v0[2], v0[3]); w.z = cvt_pk_bf16(v1[0], v1[1]); w.w = cvt_pk_bf16(v1[2], v1[3]);
                    *(u32x4*)(rowp + bj * HALF) = w; } }
    }
};
template <int LAYER> struct EpiHeads {
    static constexpr bool PERM = true;
    bf16_t* O;
    __device__ __forceinline__ void operator()(const f32x4 (&acc)[2][2][4][2], const Unit& u, int wr, int wc, int fr, int fq) const {
        const int pn = u.pn, lc = wc * 32 + 8 * fq;
#pragma unroll
        for (int ai = 0; ai < 2; ++ai)
#pragma unroll
            for (int m = 0; m < 4; ++m) { const int row = u.pm * BM + ai * HALF + wr * 64 + m * 16 + fr, b = row >> 14, t = row & (SEQ - 1);
#pragma unroll
                for (int bj = 0; bj < 2; ++bj) { size_t off;
                    if (LAYER == 0) { if (pn < 4) off = gq_off(b, t, pn) + bj * 128 + lc; else if (pn < 8) off = GK0 + gq_off(b, t, pn - 4) + bj * 128 + lc;
                                      else if (pn < 16) off = gv_off(b, t, (pn - 8) >> 1) + ((pn - 8) & 1) * 256 + bj * 128 + lc; else off = GR0 + (size_t)row * 2048 + (pn - 16) * 256 + bj * 128 + lc; }
                    else { if (pn < 8) off = dq_off(b, t, pn, bj) + lc; else if (pn < 16) off = DK0 + dq_off(b, t, pn - 8, bj) + lc; else off = dv_off(b, t, pn - 16) + bj * 128 + lc; }
                    const f32x4 v0 = acc[ai][bj][m][0], v1 = acc[ai][bj][m][1];
                    u32x4 w; w.x = cvt_pk_bf16(v0[0], v0[1]); w.y = cvt_pk_bf16(v0[2], v0[3]); w.z = cvt_pk_bf16(v1[0], v1[1]); w.w = cvt_pk_bf16(v1[2], v1[3]);
                    *(u32x4*)(O + off) = w; } }
    }
};
struct EpiResF32 {
    static constexpr bool PERM = false;
    const float* base; float* C; int ldc;
    __device__ __forceinline__ void operator()(const f32x4 (&acc)[2][2][4][2], const Unit& u, int wr, int wc, int fr, int fq) const {
        const int row0 = u.pm * BM + wr * 64 + fr, col0 = u.pn * BM + wc * 32 + 4 * fq;
#pragma unroll
        for (int ai = 0; ai < 2; ++ai)
#pragma unroll
            for (int m = 0; m < 4; ++m) { const size_t off = (size_t)(row0 + ai * HALF + m * 16) * ldc + col0;
#pragma unroll
                for (int bj = 0; bj < 2; ++bj)
#pragma unroll
                    for (int n = 0; n < 2; ++n) { const f32x4 bs = *(const f32x4*)(base + off + bj * HALF + n * 16); *(f32x4*)(C + off + bj * HALF + n * 16) = bs + acc[ai][bj][m][n]; }
                asm volatile("" ::: "memory"); }
    }
};
struct EpiSiluMul {
    static constexpr bool PERM = true;
    bf16_t* Hh;
    __device__ __forceinline__ void operator()(const f32x4 (&acc)[2][2][4][2], const Unit& u, int wr, int wc, int fr, int fq) const {
        const int row0 = u.pm * BM + wr * 64 + fr, col0 = u.pn * HALF + wc * 32 + 8 * fq;
#pragma unroll
        for (int ai = 0; ai < 2; ++ai)
#pragma unroll
            for (int m = 0; m < 4; ++m) { bf16_t* rowp = Hh + (size_t)(row0 + ai * HALF + m * 16) * DFF + col0;
                float hv[8];
#pragma unroll
                for (int n = 0; n < 2; ++n)
#pragma unroll
                    for (int j = 0; j < 4; ++j) { const float g = acc[ai][0][m][n][j], up = acc[ai][1][m][n][j];
                        const float sg = g * __builtin_amdgcn_rcpf(1.0f + __builtin_amdgcn_exp2f(-1.4426950408889634f * g)); hv[n * 4 + j] = sg * up; }
                u32x4 w; w.x = cvt_pk_bf16(hv[0], hv[1]); w.y = cvt_pk_bf16(hv[2], hv[3]); w.z = cvt_pk_bf16(hv[4], hv[5]); w.w = cvt_pk_bf16(hv[6], hv[7]);
                *(u32x4*)rowp = w; }
    }
};

template <class Epi, class Sched>
__device__ __forceinline__ void gemm_phase(LAS unsigned char* lds, const Gemm g, const Sched& S, const Epi& E) {
    const int tid = opq((int)threadIdx.x), wid = __builtin_amdgcn_readfirstlane(tid >> 6), lane = tid & 63, wr = wid >> 2, wc = wid & 3, fr = lane & 15, fq = lane >> 4;
    const int K = g.K, nt = K / BK;
    unsigned voffA[2], voffB[2];
#pragma unroll
    for (int i = 0; i < 2; ++i) { int R, C; stage_rc(tid * 16 + i * 8192, R, C); const int Rb = Epi::PERM ? ((R & ~31) + perm32(R & 31)) : R;
        voffA[i] = (unsigned)(R * K + C) * 2u; voffB[i] = (unsigned)(Rb * K + C) * 2u; }
    const size_t kstep = (size_t)(BK * 2);
    const size_t hstep = (size_t)HALF * K * 2;
    const size_t tstep = 2 * hstep;
    const unsigned ldsw = (unsigned)wid * 1024u;
    const int aoff = lds_byte(wr * 64 + fr, fq * 8), boff = lds_byte(wc * 32 + fr, fq * 8);
#define PG8_SA(b, h) (((b) * 2 + (h)) * HTB)
#define PG8_SB(b, h) ((4 + (b) * 2 + (h)) * HTB)
#define PG8_STAGE(bufoff, gbase, voff) do { _Pragma("unroll") for (int _i = 0; _i < 2; ++_i) \
        __builtin_amdgcn_global_load_lds((const unsigned*)((const char*)(gbase) + (voff)[_i]), (LAS unsigned*)(lds + (bufoff) + ldsw + _i * 8192), 16, 0, 0); } while (0)
#define PG8_LDA(dst, b, h) do { _Pragma("unroll") for (int m = 0; m < 4; ++m) _Pragma("unroll") for (int k = 0; k < 2; ++k) dst[m][k] = *(const LAS bf16x8*)(lds + PG8_SA(b, h) + aoff + m * 2048 + k * 1024); } while (0)
#define PG8_LDB(dst, b, h) do { _Pragma("unroll") for (int n = 0; n < 2; ++n) _Pragma("unroll") for (int k = 0; k < 2; ++k) dst[n][k] = *(const LAS bf16x8*)(lds + PG8_SB(b, h) + boff + n * 2048 + k * 1024); } while (0)
#define PG8_MMA(ai, bj, At, Bt) do { __builtin_amdgcn_s_setprio(1); _Pragma("unroll") for (int m = 0; m < 4; ++m) _Pragma("unroll") for (int n = 0; n < 2; ++n) _Pragma("unroll") for (int k = 0; k < 2; ++k) \
        acc[ai][bj][m][n] = __builtin_amdgcn_mfma_f32_16x16x32_bf16(Bt[n][k], At[m][k], acc[ai][bj][m][n], 0, 0, 0); __builtin_amdgcn_s_setprio(0); } while (0)
#define PG8_WAIT_V(n) asm volatile("s_waitcnt vmcnt(" #n ")" ::: "memory")
#define PG8_WAIT_L(n) asm volatile("s_waitcnt lgkmcnt(" #n ")" ::: "memory")
#define PG8_BAR __builtin_amdgcn_s_barrier()
#define PG8_SCHED __builtin_amdgcn_sched_barrier(0)
    Unit cur, nxt; int ui = 0;
    if (!S.next(0, cur)) return;
    f32x4 acc[2][2][4][2];
#pragma unroll
    for (int a = 0; a < 2; ++a)
#pragma unroll
        for (int b = 0; b < 2; ++b)
#pragma unroll
            for (int m = 0; m < 4; ++m)
#pragma unroll
                for (int n = 0; n < 2; ++n) acc[a][b][m][n] = (f32x4){0.f, 0.f, 0.f, 0.f};
    bf16x8 At[4][2], B0[2][2], B1[2][2];
    const char* cA = (const char*)g.A + (size_t)cur.pm * tstep; const char* cB = (const char*)g.Bt + S.bofs(cur) + (size_t)cur.pn * tstep;
    PG8_STAGE(PG8_SB(0, 0), cB, voffB); PG8_STAGE(PG8_SB(0, 1), cB + hstep, voffB); PG8_STAGE(PG8_SA(0, 0), cA, voffA); PG8_STAGE(PG8_SA(0, 1), cA + hstep, voffA);
    if (wr == 1) PG8_BAR;
    PG8_WAIT_V(2); PG8_BAR;
    PG8_STAGE(PG8_SB(1, 0), cB + kstep, voffB); PG8_STAGE(PG8_SA(1, 0), cA + kstep, voffA); PG8_STAGE(PG8_SB(1, 1), cB + hstep + kstep, voffB);
    PG8_WAIT_V(6); PG8_BAR;
    for (;;) {
        const bool has_next = S.next(ui + 1, nxt);
        const char* nA = has_next ? (const char*)g.A + (size_t)nxt.pm * tstep : cA; const char* nB = has_next ? (const char*)g.Bt + S.bofs(nxt) + (size_t)nxt.pn * tstep : cB;
        for (int t = 0; t < nt; t += 2) {
            const bool last = (t == nt - 2);
            const char* a1 = cA + (size_t)(t + 1) * kstep;
            const char* a2 = last ? nA : cA + (size_t)(t + 2) * kstep; const char* b2 = last ? nB : cB + (size_t)(t + 2) * kstep;
            const char* a3 = a2 + kstep; const char* b3 = b2 + kstep;
            PG8_LDB(B0, 0, 0); PG8_LDB(B1, 0, 1); PG8_SCHED; PG8_LDA(At, 0, 0); PG8_STAGE(PG8_SA(1, 1), a1 + hstep, voffA);
            PG8_WAIT_V(8); PG8_WAIT_L(0); PG8_BAR; PG8_MMA(0, 0, At, B0); PG8_MMA(0, 1, At, B1); PG8_BAR; PG8_SCHED;
            PG8_LDA(At, 0, 1); PG8_STAGE(PG8_SB(0, 0), b2, voffB); PG8_STAGE(PG8_SB(0, 1), b2 + hstep, voffB); PG8_STAGE(PG8_SA(0, 0), a2, voffA);
            PG8_WAIT_V(8); PG8_WAIT_L(0); PG8_BAR; PG8_MMA(1, 0, At, B0); PG8_MMA(1, 1, At, B1); PG8_BAR; PG8_SCHED;
            PG8_LDB(B0, 1, 0); PG8_LDB(B1, 1, 1); PG8_SCHED; PG8_LDA(At, 1, 0); PG8_STAGE(PG8_SA(0, 1), a2 + hstep, voffA);
            PG8_WAIT_V(8); PG8_WAIT_L(0); PG8_BAR; PG8_MMA(0, 0, At, B0); PG8_MMA(0, 1, At, B1); PG8_BAR; PG8_SCHED;
            PG8_LDA(At, 1, 1); PG8_STAGE(PG8_SB(1, 0), b3, voffB); PG8_STAGE(PG8_SB(1, 1), b3 + hstep, voffB); PG8_STAGE(PG8_SA(1, 0), a3, voffA);
            PG8_WAIT_V(8); PG8_WAIT_L(0); PG8_BAR; PG8_MMA(1, 0, At, B0); PG8_MMA(1, 1, At, B1); PG8_BAR; PG8_SCHED;
        }
        if (wr == 0) PG8_BAR;
        E(acc, cur, wr, wc, fr, fq);
        if (!has_next) break;
#pragma unroll
        for (int a = 0; a < 2; ++a)
#pragma unroll
            for (int b = 0; b < 2; ++b)
#pragma unroll
                for (int m = 0; m < 4; ++m)
#pragma unroll
                    for (int n = 0; n < 2; ++n) acc[a][b][m][n] = (f32x4){0.f, 0.f, 0.f, 0.f};
        cur = nxt; cA = nA; cB = nB; ++ui;
        if (wr == 1) PG8_BAR;
    }
    PG8_WAIT_V(0);
    PG8_BAR;
#undef PG8_SA
#undef PG8_SB
#undef PG8_STAGE
#undef PG8_LDA
#undef PG8_LDB
#undef PG8_MMA
#undef PG8_WAIT_V
#undef PG8_WAIT_L
#undef PG8_BAR
#undef PG8_SCHED
}
}

#define XB_TMO      128
#define XB_XCNT(j)  (256  + 64 * (j))
#define XB_XSUB(j)  (1280 + 64 * (j))
#define XB_XGEN(j)  (2304 + 64 * (j))
#define XB_TOP      3328
#define XB_TOPGEN   3392
#define XCD_BAR_WORDS 3456
#define XB_SPIN_CAP (1u << 18)
__device__ __forceinline__ unsigned xb_ld(unsigned* p)              { return __hip_atomic_load(p, __ATOMIC_RELAXED, __HIP_MEMORY_SCOPE_AGENT); }
__device__ __forceinline__ unsigned xb_add(unsigned* p, unsigned v) { return __hip_atomic_fetch_add(p, v, __ATOMIC_RELAXED, __HIP_MEMORY_SCOPE_AGENT); }
__device__ __forceinline__ unsigned xb_xcc_id() { return (unsigned)__builtin_amdgcn_s_getreg((3 << 11) | 20) & 0xFu; }
#define XB_SPIN(cond, bar) do { unsigned _sp = 0; while (cond) { __builtin_amdgcn_s_sleep(1); \
    if ((++_sp & 255u) == 0u) { if (xb_ld(&(bar)[XB_TMO])) break; if (_sp > XB_SPIN_CAP) { atomicAdd(&(bar)[XB_TMO], 1u); break; } } } } while (0)
struct XcdBarrier { unsigned* bar; unsigned x; volatile LAS unsigned* st; };
__device__ __forceinline__ XcdBarrier xcd_barrier_post(unsigned* bar, volatile LAS unsigned* st) {
    XcdBarrier b; b.bar = bar; b.x = xb_xcc_id(); b.st = st;
    if (threadIdx.x == 0) (void)xb_add(&bar[XB_XCNT(b.x)], 1u);
    return b;
}
__device__ __forceinline__ void xcd_barrier_complete(unsigned* bar, unsigned x, unsigned& nloc, unsigned& nx) {
    const unsigned G = gridDim.x * gridDim.y * gridDim.z;
    unsigned sum, cnt, mine, sp = 0u;
    for (;;) {
        sum = 0u; cnt = 0u; mine = 0u;
#pragma unroll
        for (unsigned j = 0; j < 16; ++j) { const unsigned c = xb_ld(&bar[XB_XCNT(j)]); sum += c; cnt += (c > 0u) ? 1u : 0u; mine = (j == x) ? c : mine; }
        if (sum == G) break;
        __builtin_amdgcn_s_sleep(1);
        if ((++sp & 255u) == 0u) { if (xb_ld(&bar[XB_TMO])) break; if (sp > XB_SPIN_CAP) { atomicAdd(&bar[XB_TMO], 1u); break; } }
    }
    nloc = mine > 0u ? mine : 1u; nx = cnt > 0u ? cnt : 1u;
}
__device__ __forceinline__ void xcd_barrier(const XcdBarrier& b) {
    asm volatile("s_waitcnt vmcnt(0)" ::: "memory");
    __syncthreads();
    if (threadIdx.x == 0) {
        unsigned* bar = b.bar;
        __builtin_amdgcn_s_waitcnt(0);
        unsigned nloc = b.st[0], nx = b.st[1];
        if (nloc == 0u) { xcd_barrier_complete(bar, b.x, nloc, nx); b.st[0] = nloc; b.st[1] = nx; }
        const unsigned old = xb_add(&bar[XB_XSUB(b.x)], 1u);
        const unsigned gen = old / nloc;
        if (old + 1u == (gen + 1u) * nloc) {
            __builtin_amdgcn_fence(__ATOMIC_RELEASE, "agent");
            asm volatile("s_waitcnt vmcnt(0)" ::: "memory");
            const unsigned og = xb_add(&bar[XB_TOP], 1u);
            const unsigned tg = og / nx;
            if (og + 1u == (tg + 1u) * nx) xb_add(&bar[XB_TOPGEN], 1u);
            else XB_SPIN(xb_ld(&bar[XB_TOPGEN]) == tg, bar);
            __builtin_amdgcn_fence(__ATOMIC_ACQUIRE, "agent");
            xb_add(&bar[XB_XGEN(b.x)], 1u);
            asm volatile("s_waitcnt vmcnt(0)" ::: "memory");
        } else {
            XB_SPIN(xb_ld(&bar[XB_XGEN(b.x)]) == gen, bar);
            __builtin_amdgcn_fence(__ATOMIC_ACQUIRE, "agent");
            asm volatile("s_waitcnt vmcnt(0)" ::: "memory");
        }
    }
    __syncthreads();
}

struct Frame {
    LAS unsigned char* lds;
    int tid, lane, wave, vcu, G;
};
struct Args {
    const float* in[21]; float* out; unsigned char* ws; int upto, pad1;
};

__device__ __forceinline__ void transpose_item(const float* W, int ldw, int k0, int n0, bf16_t* WT, int ldk, int drow0, LAS float* scr, int lane) {
    float tv[32];
    const float* wp_ = W + (size_t)(k0 + (lane >> 5)) * ldw + n0 + (lane & 31);
#pragma unroll
    for (int i = 0; i < 32; ++i) tv[i] = wp_[(size_t)(2 * i) * ldw];
#pragma unroll
    for (int i = 0; i < 32; ++i) scr[(2 * i + (lane >> 5)) * 33 + (lane & 31)] = tv[i];
    LDS_WAIT(); asm volatile("" ::: "memory");
    const int c = lane & 7;
#pragma unroll
    for (int j = 0; j < 4; ++j) { const int n = (lane >> 3) + 8 * j; const LAS float* s = scr + (8 * c) * 33 + n;
        u32x4 o; o.x = cvt_pk_bf16(s[0 * 33], s[1 * 33]); o.y = cvt_pk_bf16(s[2 * 33], s[3 * 33]); o.z = cvt_pk_bf16(s[4 * 33], s[5 * 33]); o.w = cvt_pk_bf16(s[6 * 33], s[7 * 33]);
        *(u32x4*)(WT + (size_t)(drow0 + n) * ldk + k0 + 8 * c) = o; }
    LDS_WAIT(); asm volatile("" ::: "memory");
}
__device__ __forceinline__ void conv_plain(Frame& F, const float* W, int K, int N, int ldw, bf16_t* WT) {
    LAS float* scr = (LAS float*)(F.lds + F.wave * 16384);
    const int gw = F.vcu * NWAVES + F.wave, NGW = F.G * NWAVES, nblk = N / 32, nit = (K / 64) * nblk;
    for (int it = gw; it < nit; it += NGW) { const int kb = it / nblk, nb = it % nblk; transpose_item(W, ldw, 64 * kb, 32 * nb, WT, K, 32 * nb, scr, F.lane); }
}
__device__ __forceinline__ void conv_moe(Frame& F, const float* wg, const float* wu, const float* wd, bf16_t* GU, bf16_t* DT, int rank = -1, int nrank = 0) {
    LAS float* scr = (LAS float*)(F.lds + F.wave * 16384);
    const int gw = (rank < 0 ? F.vcu : rank) * NWAVES + F.wave, NGW = (rank < 0 ? F.G : nrank) * NWAVES;
    constexpr int PER_E = 1536, NIT = NEXP * PER_E;
    for (int it = gw; it < NIT; it += NGW) {
        const int e = it / PER_E; int r = it % PER_E;
        if (r < 1024) { const int up = r >> 9; r &= 511; const int kb = r >> 4, nb = r & 15, n0 = 32 * nb;
            const int drow = 256 * (n0 >> 7) + 128 * up + (n0 & 127);
            transpose_item((up ? wu : wg) + (size_t)e * D * DFF, DFF, 64 * kb, n0, GU + (size_t)e * 1024 * D, D, drow, scr, F.lane); }
        else { r -= 1024; const int kb = r >> 6, nb = r & 63;
            transpose_item(wd + (size_t)e * DFF * D, D, 64 * kb, 32 * nb, DT + (size_t)e * D * DFF, DFF, 32 * nb, scr, F.lane); }
    }
}
__device__ __forceinline__ void pack_proj(Frame& F, float* Wp, int NT, const float* gain, const float* Wa, int lda, int ca0, int na, const float* Wb, int ldb, int nb) {
    const int total = 128 * NT * 256;
    for (int idx = (F.vcu * NWAVES * 64) + F.tid; idx < total; idx += F.G * NWAVES * 64) {
        const int e = idx & 3, ln = (idx >> 2) & 63, rest = idx >> 8, nt = rest % NT, s = rest / NT;
        const int k = 16 * s + 4 * (ln >> 4) + e, col = 16 * nt + (ln & 15);
        float v = 0.f;
        if (col < na) v = Wa[(size_t)k * lda + ca0 + col]; else if (col < na + nb) v = Wb[(size_t)k * ldb + (col - na)];
        Wp[idx] = v * gain[k];
    }
}

template <int NT>
__device__ __forceinline__ float wave_proj16(LAS unsigned char* lds, const float* xin, int tok0, const float* Wp, int tid, int wid, int lane, f32x4 (&acc)[NT]) {
    const int tr = lane & 15, kq = lane >> 4;
    const f32x4* xp = (const f32x4*)(xin + (size_t)(tok0 + tr) * D) + kq;
    constexpr int CH = 16 * NT * 1024;
    const char* wsrc = (const char*)Wp + tid * 16;
    float ssq = 0.f;
#pragma unroll
    for (int n = 0; n < NT; ++n) acc[n] = (f32x4){0.f, 0.f, 0.f, 0.f};
    f32x4 X[16];
#define NP_DMA(c, buf) do { _Pragma("unroll") for (int r = 0; r < 2 * NT; ++r) \
        __builtin_amdgcn_global_load_lds((const unsigned*)(wsrc + (size_t)(c) * CH + r * 8192), (LAS unsigned*)(lds + (buf) * CH + r * 8192 + wid * 1024), 16, 0, 0); } while (0)
#define NP_CHUNK(c, buf, more) do { \
        asm volatile("s_waitcnt vmcnt(16)" ::: "memory"); WG_BAR(); \
        if (more) NP_DMA((c) + 1, 1 - (buf)); \
        asm volatile("" ::: "memory");     \
        const f32x4* xn_ = xp + 64 * ((c) + 1); \
        _Pragma("unroll") for (int s = 0; s < 16; ++s) { const f32x4 xv = X[s]; if (more) X[s] = xn_[4 * s]; \
            ssq += (xv[0] * xv[0] + xv[1] * xv[1]) + (xv[2] * xv[2] + xv[3] * xv[3]); \
            _Pragma("unroll") for (int n = 0; n < NT; ++n) { const f32x4 wv = *(const LAS f32x4*)(lds + (buf) * CH + ((s * NT + n) * 64 + lane) * 16); \
                _Pragma("unroll") for (int e = 0; e < 4; ++e) acc[n] = __builtin_amdgcn_mfma_f32_16x16x4f32(xv[e], wv[e], acc[n], 0, 0, 0); } } } while (0)
    NP_DMA(0, 0);
    asm volatile("" ::: "memory");
#pragma unroll
    for (int s = 0; s < 16; ++s) X[s] = xp[4 * s];
    for (int c = 0; c < 6; c += 2) { NP_CHUNK(c, 0, true); NP_CHUNK(c + 1, 1, true); }
    NP_CHUNK(6, 0, true); NP_CHUNK(7, 1, false);
    WG_BAR();
#undef NP_DMA
#undef NP_CHUNK
    ssq += __shfl_xor(ssq, 16); ssq += __shfl_xor(ssq, 32);
    return 1.0f / sqrtf(ssq * (1.0f / D) + RMS_EPS);
}
__device__ __forceinline__ void wave_write_hn16(const float* xin, int tok0, float rstd, const float* gain, bf16_t* hn, int lane) {
    f32x4 g4[8];
#pragma unroll
    for (int j = 0; j < 8; ++j) g4[j] = ((const f32x4*)gain)[lane + 64 * j];
    for (int i = 0; i < 16; i += 2) {
        const float r0 = __shfl(rstd, i), r1 = __shfl(rstd, i + 1);
        const f32x4* x0 = (const f32x4*)(xin + (size_t)(tok0 + i) * D); const f32x4* x1 = x0 + D / 4;
        u32x2* o0 = (u32x2*)(hn + (size_t)(tok0 + i) * D); u32x2* o1 = o0 + D / 4;
        f32x4 a[8], c[8];
#pragma unroll
        for (int j = 0; j < 8; ++j) { a[j] = x0[lane + 64 * j]; c[j] = x1[lane + 64 * j]; }
#pragma unroll
        for (int j = 0; j < 8; ++j) { const f32x4 v = a[j] * r0 * g4[j], u = c[j] * r1 * g4[j]; u32x2 w; w.x = cvt_pk_bf16(v[0], v[1]); w.y = cvt_pk_bf16(v[2], v[3]); o0[lane + 64 * j] = w;
            u32x2 z; z.x = cvt_pk_bf16(u[0], u[1]); z.y = cvt_pk_bf16(u[2], u[3]); o1[lane + 64 * j] = z; }
    }
}

__device__ __forceinline__ void phase_norm_gz(Frame& F, const float* xin, const float* gain, const float* Wp, bf16_t* hn, float* gz) {
    for (int tile = F.vcu; tile < T / 128; tile += F.G) {
        const int tok0 = tile * 128 + F.wave * 16;
        f32x4 acc[1];
        const float rstd = wave_proj16<1>(F.lds, xin, tok0, Wp, F.tid, F.wave, F.lane, acc);
        const int j = F.lane & 15, q4 = F.lane >> 4;
#pragma unroll
        for (int r = 0; r < 4; ++r) { const float rr = __shfl(rstd, 4 * q4 + r); gz[(size_t)(tok0 + 4 * q4 + r) * 16 + j] = acc[0][r] * rr; }
        wave_write_hn16(xin, tok0, rstd, gain, hn, F.lane);
    }
}
__device__ __forceinline__ void phase_norm_route(Frame& F, const float* xin, const float* gain, const float* Wp, bf16_t* hn, int* tok_e, int* tok_p, float* tok_w, unsigned* cnt) {
    LAS float* lg = (LAS float*)(F.lds + 98304 + F.wave * 3072);
    for (int tile = F.vcu; tile < T / 128; tile += F.G) {
        const int tok0 = tile * 128 + F.wave * 16;
        f32x4 acc[3];
        const float rstd = wave_proj16<3>(F.lds, xin, tok0, Wp, F.tid, F.wave, F.lane, acc);
        const int j = F.lane & 15, q4 = F.lane >> 4;
#pragma unroll
        for (int r = 0; r < 4; ++r) { const float rr = __shfl(rstd, 4 * q4 + r);
#pragma unroll
            for (int n = 0; n < 3; ++n) lg[(4 * q4 + r) * 48 + 16 * n + j] = acc[n][r] * rr; }
        LDS_WAIT(); asm volatile("" ::: "memory");
        if (F.lane < 16) {
            const LAS float* l = lg + F.lane * 48;
            float gm = l[0]; int gi = 0;
#pragma unroll
            for (int q = 1; q < 4; ++q) { const float v = l[q]; if (v > gm) { gm = v; gi = q; } }
            float gs = 0.f;
#pragma unroll
            for (int q = 0; q < 4; ++q) gs += __expf(l[q] - gm);
            const float gw = 1.0f / gs;
            const LAS float* se = l + 4 + 8 * gi;
            float m1 = se[0]; int i1 = 0;
#pragma unroll
            for (int q = 1; q < 8; ++q) { const float v = se[q]; if (v > m1) { m1 = v; i1 = q; } }
            float m2 = -3.0e38f; int i2 = 0;
#pragma unroll
            for (int q = 0; q < 8; ++q) { const float v = se[q]; if (q != i1 && v > m2) { m2 = v; i2 = q; } }
            const float eb = __expf(m2 - m1), inv = 1.0f / (1.0f + eb);
            const int t = tok0 + F.lane, e1 = gi * 8 + i1, e2 = gi * 8 + i2;
            const unsigned p1 = __hip_atomic_fetch_add(cnt + 64 * e1, 1u, __ATOMIC_RELAXED, __HIP_MEMORY_SCOPE_AGENT);
            const unsigned p2 = __hip_atomic_fetch_add(cnt + 64 * e2, 1u, __ATOMIC_RELAXED, __HIP_MEMORY_SCOPE_AGENT);
            tok_e[2 * t] = e1; tok_e[2 * t + 1] = e2; tok_p[2 * t] = (int)p1; tok_p[2 * t + 1] = (int)p2;
            tok_w[2 * t] = gw * inv; tok_w[2 * t + 1] = gw * eb * inv;
        }
        wave_write_hn16(xin, tok0, rstd, gain, hn, F.lane);
        LDS_WAIT(); asm volatile("" ::: "memory");
    }
}

__device__ __forceinline__ void phase_gla_gate(Frame& F, const float* gz, const float* wgu, const float* bgate, const bf16_t* proj, bf16_t* kdT, float* adec) {
    LAS f32x4* gzs = (LAS f32x4*)F.lds;
    for (int u = F.vcu; u < NBATCH * NCH * 2; u += F.G) {
        const int half = u & 1, bc = u >> 1;
        const int tok0 = bc * 64, j = half * 512 + F.tid;
        if (F.tid < 256) gzs[F.tid] = ((const f32x4*)(gz + (size_t)tok0 * 16))[F.tid];
        float wg[16];
#pragma unroll
        for (int r = 0; r < 16; ++r) wg[r] = wgu[r * GLA_DKT + j];
        const float bg = bgate[j];
        WG_BAR();
        float cum[64]; float run = 0.f;
#pragma unroll
        for (int t = 0; t < 64; ++t) {
            float z = bg;
#pragma unroll
            for (int r4 = 0; r4 < 4; ++r4) { const f32x4 g4 = gzs[t * 4 + r4]; z += g4[0] * wg[4 * r4] + g4[1] * wg[4 * r4 + 1] + g4[2] * wg[4 * r4 + 2] + g4[3] * wg[4 * r4 + 3]; }
            const float ls = fminf(z, 0.f) - __logf(1.0f + __expf(-fabsf(z)));
            run += ls * (1.0f / 16.0f); cum[t] = run;
        }
        adec[(size_t)bc * GLA_DKT + j] = __expf(run);
        const bf16_t* kp = proj + GK0 + gq_off(bc >> 8, (bc & 255) * 64, j >> 8) + (j & 255);
        u32x4* dst = (u32x4*)(kdT + ((size_t)bc * GLA_DKT + j) * 64);
#pragma unroll
        for (int t8 = 0; t8 < 8; ++t8) {
            float kd[8];
#pragma unroll
            for (int q = 0; q < 8; ++q) { const int t = t8 * 8 + q; kd[q] = bf2f(kp[(size_t)t * 256]) * __expf(run - cum[t]); }
            u32x4 w; w.x = cvt_pk_bf16(kd[0], kd[1]); w.y = cvt_pk_bf16(kd[2], kd[3]); w.z = cvt_pk_bf16(kd[4], kd[5]); w.w = cvt_pk_bf16(kd[6], kd[7]);
            dst[t8] = w;
        }
        WG_BAR();
    }
}

constexpr int SCAN_VROW = 144, SCAN_SROW = 528, SCAN_VBUF = 64 * SCAN_VROW, SCAN_SBUF = 64 * SCAN_SROW;
__device__ __forceinline__ void phase_gla_scan(Frame& F, int it, const bf16_t* proj, const bf16_t* kdT, const float* adec, bf16_t* oout, unsigned* probe = nullptr) {
    const int lane = F.lane, w = F.wave, fr = lane & 15, kq = lane >> 4, tid = F.tid;
    LAS unsigned char* vbuf = F.lds;
    LAS unsigned char* sbuf = F.lds + 2 * SCAN_VBUF;
    const int bh = it >> 3, b = bh >> 2, h = bh & 3, sl = it & 7, mt = w & 3, ntp = w >> 2;
    const size_t tokb = (size_t)b * SEQ;
    f32x4 st[2][4];
#pragma unroll
    for (int i = 0; i < 2; ++i)
#pragma unroll
        for (int n = 0; n < 4; ++n) st[i][n] = (f32x4){0.f, 0.f, 0.f, 0.f};
    bf16x8 ka0[2][2], ka1[2][2], q0[8], q1[8]; f32x4 dc0[2], dc1[2]; u32x4 vr0, vr1;
#define CL(c) ((c) < NCH ? (c) : NCH - 1)
#define LOAD_KA(KA, DC, c) do { const size_t bc_ = (size_t)b * NCH + CL(c); \
        _Pragma("unroll") for (int i = 0; i < 2; ++i) { \
            _Pragma("unroll") for (int s = 0; s < 2; ++s) KA[i][s] = *(const bf16x8*)(kdT + ((bc_ * GLA_DKT + h * 256 + 32 * w + 16 * i + fr) * 64 + 32 * s + 8 * kq)); \
            DC[i] = *(const f32x4*)(adec + bc_ * GLA_DKT + h * 256 + 32 * w + 16 * i + 4 * kq); } } while (0)
#define LOAD_V(VR, c) do { VR = *(const u32x4*)(proj + gv_off(b, CL(c) * 64 + (tid >> 3), h) + 64 * sl + 8 * (tid & 7)); } while (0)
#define LOAD_Q(Q, c) do { const bf16_t* qp_ = proj + gq_off(b, CL(c) * 64 + 16 * mt + fr, h) + 8 * kq; \
        _Pragma("unroll") for (int s = 0; s < 8; ++s) Q[s] = *(const bf16x8*)(qp_ + 32 * s); } while (0)
#define STORE_V(VR, buf) do { *(LAS u32x4*)(vbuf + (buf) * SCAN_VBUF + (tid >> 3) * SCAN_VROW + (tid & 7) * 16) = VR; } while (0)
#if PROBE
    unsigned long long pacc[3] = {0ull, 0ull, 0ull}; unsigned long long pmark;
#define PMARK(k) do { const unsigned long long n_ = __builtin_amdgcn_s_memtime(); pacc[k] += n_ - pmark; pmark = n_; } while (0)
#define PSTART() do { pmark = __builtin_amdgcn_s_memtime(); } while (0)
#else
#define PMARK(k) do { } while (0)
#define PSTART() do { } while (0)
#endif
#define SCAN_STEP(KA, DC, VN, VM, QC, QN, c) do { \
        PSTART(); \
        const unsigned vb_ = (unsigned)(uintptr_t)(vbuf + ((c) & 1) * SCAN_VBUF) + (unsigned)((8 * kq + ((lane & 15) >> 2)) * SCAN_VROW + 8 * (lane & 3)); \
        s16x4 tv[4][4];     \
        asm volatile("ds_read_b64_tr_b16 %0, %16 offset:0\n\tds_read_b64_tr_b16 %1, %16 offset:576\n\tds_read_b64_tr_b16 %2, %16 offset:4608\n\tds_read_b64_tr_b16 %3, %16 offset:5184\n\t" \
                     "ds_read_b64_tr_b16 %4, %16 offset:32\n\tds_read_b64_tr_b16 %5, %16 offset:608\n\tds_read_b64_tr_b16 %6, %16 offset:4640\n\tds_read_b64_tr_b16 %7, %16 offset:5216\n\t" \
                     "ds_read_b64_tr_b16 %8, %16 offset:64\n\tds_read_b64_tr_b16 %9, %16 offset:640\n\tds_read_b64_tr_b16 %10, %16 offset:4672\n\tds_read_b64_tr_b16 %11, %16 offset:5248\n\t" \
                     "ds_read_b64_tr_b16 %12, %16 offset:96\n\tds_read_b64_tr_b16 %13, %16 offset:672\n\tds_read_b64_tr_b16 %14, %16 offset:4704\n\tds_read_b64_tr_b16 %15, %16 offset:5280\n\ts_waitcnt lgkmcnt(0)" \
                     : "=&v"(tv[0][0]), "=&v"(tv[0][1]), "=&v"(tv[0][2]), "=&v"(tv[0][3]), "=&v"(tv[1][0]), "=&v"(tv[1][1]), "=&v"(tv[1][2]), "=&v"(tv[1][3]), \
                       "=&v"(tv[2][0]), "=&v"(tv[2][1]), "=&v"(tv[2][2]), "=&v"(tv[2][3]), "=&v"(tv[3][0]), "=&v"(tv[3][1]), "=&v"(tv[3][2]), "=&v"(tv[3][3]) : "v"(vb_) : "memory"); \
        _Pragma("unroll") for (int n = 0; n < 4; ++n) { \
            const bf16x8 vf0 = (bf16x8){tv[n][0][0], tv[n][0][1], tv[n][0][2], tv[n][0][3], tv[n][1][0], tv[n][1][1], tv[n][1][2], tv[n][1][3]}; \
            const bf16x8 vf1 = (bf16x8){tv[n][2][0], tv[n][2][1], tv[n][2][2], tv[n][2][3], tv[n][3][0], tv[n][3][1], tv[n][3][2], tv[n][3][3]}; \
            _Pragma("unroll") for (int i = 0; i < 2; ++i) { \
                st[i][n] = st[i][n] * DC[i]; \
                st[i][n] = __builtin_amdgcn_mfma_f32_16x16x32_bf16(KA[i][0], vf0, st[i][n], 0, 0, 0); \
                st[i][n] = __builtin_amdgcn_mfma_f32_16x16x32_bf16(KA[i][1], vf1, st[i][n], 0, 0, 0); } } \
        LOAD_KA(KA, DC, (c) + 2); \
        PMARK(0); \
        { LAS unsigned char* sb_ = sbuf + ((c) & 1) * SCAN_SBUF + fr * SCAN_SROW + (32 * w + 4 * kq) * 2; \
          _Pragma("unroll") for (int i = 0; i < 2; ++i) _Pragma("unroll") for (int n = 0; n < 4; ++n) { \
              u32x2 pk; pk.x = cvt_pk_bf16(st[i][n][0], st[i][n][1]); pk.y = cvt_pk_bf16(st[i][n][2], st[i][n][3]); \
              *(LAS u32x2*)(sb_ + n * 16 * SCAN_SROW + i * 32) = pk; } } \
        STORE_V(VN, ((c) + 1) & 1); \
        LOAD_V(VN, (c) + 3); \
        WG_BAR(); \
        PMARK(1); \
        { f32x4 a0 = (f32x4){0.f, 0.f, 0.f, 0.f}, a1 = a0; \
          const LAS unsigned char* sr_ = sbuf + ((c) & 1) * SCAN_SBUF + (32 * ntp + fr) * SCAN_SROW + 16 * kq; \
          _Pragma("unroll") for (int hb = 0; hb < 2; ++hb) { bf16x8 bb[4][2];     \
              _Pragma("unroll") for (int s = 0; s < 4; ++s) { bb[s][0] = *(const LAS bf16x8*)(sr_ + 64 * (4 * hb + s)); bb[s][1] = *(const LAS bf16x8*)(sr_ + 16 * SCAN_SROW + 64 * (4 * hb + s)); } \
              asm volatile("s_waitcnt lgkmcnt(0)" ::: "memory"); __builtin_amdgcn_sched_barrier(0); \
              _Pragma("unroll") for (int s = 0; s < 4; ++s) { \
                  a0 = __builtin_amdgcn_mfma_f32_16x16x32_bf16(QC[4 * hb + s], bb[s][0], a0, 0, 0, 0); \
                  a1 = __builtin_amdgcn_mfma_f32_16x16x32_bf16(QC[4 * hb + s], bb[s][1], a1, 0, 0, 0); } } \
          bf16_t* op_ = oout + (tokb + (size_t)(c) * 64 + 16 * mt + 4 * kq) * D + h * 512 + 64 * sl + 32 * ntp + fr; \
          _Pragma("unroll") for (int r = 0; r < 4; ++r) { \
              const float x0 = a0[r] * 0.0625f, x1 = a1[r] * 0.0625f, y0 = __shfl_xor(x0, 1), y1 = __shfl_xor(x1, 1); \
              if ((fr & 1) == 0) { *(unsigned*)(op_ + (size_t)r * D) = cvt_pk_bf16(x0, y0); *(unsigned*)(op_ + (size_t)r * D + 16) = cvt_pk_bf16(x1, y1); } } } \
        LOAD_Q(QC, (c) + 2); \
        PMARK(2); \
    } while (0)
    LOAD_KA(ka0, dc0, 0); LOAD_KA(ka1, dc1, 1); LOAD_V(vr0, 0); LOAD_V(vr1, 1); LOAD_Q(q0, 0); LOAD_Q(q1, 1);
    STORE_V(vr0, 0); LOAD_V(vr0, 2);
    WG_BAR();
#if PROBE
    const unsigned long long pt0 = __builtin_amdgcn_s_memtime(), pr0 = __builtin_amdgcn_s_memrealtime();
#endif
    for (int c = 0; c < NCH; c += 2) {
        SCAN_STEP(ka0, dc0, vr1, vr0, q0, q1, c);
        SCAN_STEP(ka1, dc1, vr0, vr1, q1, q0, c + 1);
    }
    WG_BAR();
#if PROBE
    if (probe && it == 0 && tid == 0) { const unsigned long long dt = __builtin_amdgcn_s_memtime() - pt0, dr = __builtin_amdgcn_s_memrealtime() - pr0;
        const float val = floorf(2.f * log2f((PROBE == 1) ? (float)dt / 256.f : (PROBE == 2) ? (float)dr * 10.f / 256.f : (float)pacc[PROBE - 3] / 256.f));
        __hip_atomic_store(probe, __float_as_uint(val), __ATOMIC_RELAXED, __HIP_MEMORY_SCOPE_AGENT); }
#endif
#undef CL
#undef LOAD_KA
#undef LOAD_V
#undef LOAD_Q
#undef STORE_V
#undef SCAN_STEP
}

__device__ __forceinline__ void phase_gla_gnorm(Frame& F, const bf16_t* o, const bf16_t* proj, const float* gn, bf16_t* y) {
    const int gw = F.vcu * NWAVES + F.wave, NGW = F.G * NWAVES, lane = F.lane;
    const f32x4 g0 = ((const f32x4*)gn)[2 * lane], g1 = ((const f32x4*)gn)[2 * lane + 1];
    for (int tok = gw; tok < T; tok += NGW) {
        u32x4 ov[4], rv[4];
#pragma unroll
        for (int h = 0; h < 4; ++h) { ov[h] = *(const u32x4*)(o + (size_t)tok * D + h * 512 + 8 * lane); rv[h] = *(const u32x4*)(proj + GR0 + (size_t)tok * 2048 + h * 512 + 8 * lane); }
        float ss[4];
#pragma unroll
        for (int h = 0; h < 4; ++h) { float s = 0.f;
#pragma unroll
            for (int q = 0; q < 4; ++q) { const float lo = bf_lo(ov[h][q]), hi = bf_hi(ov[h][q]); s += lo * lo + hi * hi; }
            ss[h] = s; }
#pragma unroll
        for (int of = 1; of < 64; of <<= 1) {
#pragma unroll
            for (int h = 0; h < 4; ++h) ss[h] += __shfl_xor(ss[h], of); }
#pragma unroll
        for (int h = 0; h < 4; ++h) { const float rstd = 1.0f / sqrtf(ss[h] * (1.0f / 512.0f) + RMS_EPS);
            float yv[8];
#pragma unroll
            for (int q = 0; q < 4; ++q) { const float a0 = bf_lo(ov[h][q]), a1 = bf_hi(ov[h][q]), r0 = bf_lo(rv[h][q]), r1 = bf_hi(rv[h][q]);
                const float gA = q < 2 ? g0[2 * q] : g1[2 * q - 4], gB = q < 2 ? g0[2 * q + 1] : g1[2 * q - 3];
                yv[2 * q] = a0 * rstd * gA * (r0 / (1.0f + __expf(-r0))); yv[2 * q + 1] = a1 * rstd * gB * (r1 / (1.0f + __expf(-r1))); }
            u32x4 w; w.x = cvt_pk_bf16(yv[0], yv[1]); w.y = cvt_pk_bf16(yv[2], yv[3]); w.z = cvt_pk_bf16(yv[4], yv[5]); w.w = cvt_pk_bf16(yv[6], yv[7]);
            *(u32x4*)(y + (size_t)tok * D + h * 512 + 8 * lane) = w; }
    }
}

__device__ __forceinline__ void moe_tables(Frame& F, unsigned* cnt) {
    LAS int* pst = (LAS int*)(F.lds + TAB_OFF);
    LAS int* te = pst + 36;
    if (F.wave == 0) {
        const int e = F.lane & 31;
        const int c = (int)xb_ld(cnt + 64 * e);
        const int ntile = (c + 255) >> 8;
        int incl = ntile;
#pragma unroll
        for (int o = 1; o < 32; o <<= 1) { const int v = __shfl_up(incl, o); if ((F.lane & 31) >= o) incl += v; }
        const int excl = incl - ntile;
        if (F.lane < 32) { pst[e] = excl << 8; for (int q = 0; q < ntile; ++q) te[excl + q] = e; }
        if (F.lane == 31) { pst[32] = incl << 8; pst[33] = incl; }
    }
    WG_BAR();
}
__device__ __forceinline__ void phase_moe_gather(Frame& F, const int* tok_e, const int* tok_p, int* slot_of, const bf16_t* hn, bf16_t* ag) {
    const LAS int* pst = (const LAS int*)(F.lds + TAB_OFF);
    const int gw = F.vcu * NWAVES + F.wave, NGW = F.G * NWAVES, lane = F.lane;
    for (int t = gw; t < T; t += 2 * NGW) {
        const int t2 = t + NGW < T ? t + NGW : t;
        const int s0 = pst[tok_e[2 * t]] + tok_p[2 * t], s1 = pst[tok_e[2 * t + 1]] + tok_p[2 * t + 1], s2 = pst[tok_e[2 * t2]] + tok_p[2 * t2], s3 = pst[tok_e[2 * t2 + 1]] + tok_p[2 * t2 + 1];
        if (lane == 0) { slot_of[2 * t] = s0; slot_of[2 * t + 1] = s1; slot_of[2 * t2] = s2; slot_of[2 * t2 + 1] = s3; }
        const u32x4* srcA = (const u32x4*)(hn + (size_t)t * D); const u32x4* srcB = (const u32x4*)(hn + (size_t)t2 * D);
        u32x4 va[4], vb[4];
#pragma unroll
        for (int j = 0; j < 4; ++j) { va[j] = srcA[lane + 64 * j]; vb[j] = srcB[lane + 64 * j]; }
#pragma unroll
        for (int j = 0; j < 4; ++j) { ((u32x4*)(ag + (size_t)s0 * D))[lane + 64 * j] = va[j]; ((u32x4*)(ag + (size_t)s1 * D))[lane + 64 * j] = va[j];
                                      ((u32x4*)(ag + (size_t)s2 * D))[lane + 64 * j] = vb[j]; ((u32x4*)(ag + (size_t)s3 * D))[lane + 64 * j] = vb[j]; }
    }
}
template <int MODE>
__device__ __forceinline__ void phase_moe_combine(Frame& F, float* x, const bf16_t* ob, const int* slot_of, const float* tok_w, const float* gain, bf16_t* hn) {
    const int gw = F.vcu * NWAVES + F.wave, NGW = F.G * NWAVES, lane = F.lane;
    f32x4 g4[8];
#pragma unroll
    for (int j = 0; j < 8; ++j) g4[j] = ((const f32x4*)gain)[lane + 64 * j];
    for (int t = gw; t < T; t += NGW) {
        const int s0 = slot_of[2 * t], s1 = slot_of[2 * t + 1]; const float w0 = tok_w[2 * t], w1 = tok_w[2 * t + 1];
        f32x4* xr = (f32x4*)(x + (size_t)t * D);
        const u32x2* a = (const u32x2*)(ob + (size_t)s0 * D); const u32x2* b = (const u32x2*)(ob + (size_t)s1 * D);
        f32x4 v[8]; float ss = 0.f;
#pragma unroll
        for (int j = 0; j < 8; ++j) { const u32x2 av = a[lane + 64 * j], bv = b[lane + 64 * j]; f32x4 xv = xr[lane + 64 * j];
            xv[0] += w0 * bf_lo(av.x) + w1 * bf_lo(bv.x); xv[1] += w0 * bf_hi(av.x) + w1 * bf_hi(bv.x);
            xv[2] += w0 * bf_lo(av.y) + w1 * bf_lo(bv.y); xv[3] += w0 * bf_hi(av.y) + w1 * bf_hi(bv.y);
            v[j] = xv; ss += (xv[0] * xv[0] + xv[1] * xv[1]) + (xv[2] * xv[2] + xv[3] * xv[3]); }
        const float rstd = 1.0f / sqrtf(wave_sum(ss) * (1.0f / D) + RMS_EPS);
        if (MODE == 0) {
            u32x2* orow = (u32x2*)(hn + (size_t)t * D);
#pragma unroll
            for (int j = 0; j < 8; ++j) { xr[lane + 64 * j] = v[j]; const f32x4 y = v[j] * rstd * g4[j]; u32x2 w; w.x = cvt_pk_bf16(y[0], y[1]); w.y = cvt_pk_bf16(y[2], y[3]); orow[lane + 64 * j] = w; }
        } else {
#pragma unroll
            for (int j = 0; j < 8; ++j) xr[lane + 64 * j] = v[j] * rstd * g4[j];
        }
    }
}

__device__ __forceinline__ void phase_subln(Frame& F, const bf16_t* o1, const bf16_t* o2, const float* lq1, const float* lk1, const float* lq2, const float* lk2, const float* sg, bf16_t* y) {
    const int gw = F.vcu * NWAVES + F.wave, NGW = F.G * NWAVES, lane = F.lane;
    const float d1 = wave_sum(lq1[lane] * lk1[lane] + lq1[lane + 64] * lk1[lane + 64]);
    const float d2 = wave_sum(lq2[lane] * lk2[lane] + lq2[lane + 64] * lk2[lane + 64]);
    const float lam = __expf(d1) - __expf(d2) + LAMBDA_INIT;
    const f32x4 g = ((const f32x4*)sg)[lane] * (1.0f - LAMBDA_INIT);
    for (int tok = gw; tok < T; tok += NGW) {
        u32x2 a[8], b[8];
#pragma unroll
        for (int h = 0; h < 8; ++h) { a[h] = *(const u32x2*)(o1 + (size_t)tok * D + h * 256 + 4 * lane); b[h] = *(const u32x2*)(o2 + (size_t)tok * D + h * 256 + 4 * lane); }
        f32x4 d[8]; float ss[8];
#pragma unroll
        for (int h = 0; h < 8; ++h) { d[h][0] = bf_lo(a[h].x) - lam * bf_lo(b[h].x); d[h][1] = bf_hi(a[h].x) - lam * bf_hi(b[h].x); d[h][2] = bf_lo(a[h].y) - lam * bf_lo(b[h].y); d[h][3] = bf_hi(a[h].y) - lam * bf_hi(b[h].y);
            ss[h] = (d[h][0] * d[h][0] + d[h][1] * d[h][1]) + (d[h][2] * d[h][2] + d[h][3] * d[h][3]); }
#pragma unroll
        for (int of = 1; of < 64; of <<= 1) {
#pragma unroll
            for (int h = 0; h < 8; ++h) ss[h] += __shfl_xor(ss[h], of); }
#pragma unroll
        for (int h = 0; h < 8; ++h) { const float rstd = 1.0f / sqrtf(ss[h] * (1.0f / 256.0f) + RMS_EPS); const f32x4 yv = d[h] * rstd * g;
            u32x2 w; w.x = cvt_pk_bf16(yv[0], yv[1]); w.y = cvt_pk_bf16(yv[2], yv[3]);
            *(u32x2*)(y + (size_t)tok * D + h * 256 + 4 * lane) = w; }
    }
}

namespace att {
constexpr int SHM_K = 64 * 128 * 2, SHM_V = 64 * 256 * 2;
constexpr int V_OFF = 0, K_OFF = 2 * SHM_V, SCR_OFF = 2 * SHM_V + 2 * SHM_K;
constexpr float SCALE = 0.08838834764831845f;
constexpr float C2 = 1.4426950408889634f * SCALE;
constexpr float THR = 8.f;
#define KSWZ(row, colB) ((row) * 256 + ((colB) ^ (((row) & 7) << 4)))
__device__ __forceinline__ int crow(int r, int hi) { return (r & 3) + 8 * (r >> 2) + 4 * hi; }
__device__ __forceinline__ int v_rd_base(int lane) { return ((lane & 3) << 3) | (((lane >> 2) & 3) << 6) | (((lane >> 4) & 1) << 5) | (((lane >> 5) & 1) << 8); }
constexpr int v_rd_off(int d0, int ks, int half) { return d0 * 512 + ks * 8192 + half * 4096; }

template <int KB>
__device__ __forceinline__ void qkt(f32x16& p0, f32x16& p1, LAS unsigned char* lds, int r32, int hi, const bf16x8 (&qr)[8]) {
    const LAS unsigned char* kb[4];
#pragma unroll
    for (int dd = 0; dd < 4; ++dd) kb[dd] = lds + K_OFF + KB * SHM_K + KSWZ(r32, (dd * 16 + hi * 8) * 2);
#pragma unroll
    for (int d0 = 0; d0 < 8; ++d0) { const LAS unsigned char* a = kb[d0 & 3] + (d0 >> 2) * 128;
        const bf16x8 b0 = *(const LAS bf16x8*)a;
        const bf16x8 b1 = *(const LAS bf16x8*)(a + 32 * 256);
        p0 = __builtin_amdgcn_mfma_f32_32x32x16_bf16(b0, qr[d0], p0, 0, 0, 0);
        p1 = __builtin_amdgcn_mfma_f32_32x32x16_bf16(b1, qr[d0], p1, 0, 0, 0); }
}
template <int VB>
__device__ __forceinline__ void pv_tile(f32x16 (&o)[8], unsigned vb0, bf16x8 pa0, bf16x8 pa1, bf16x8 pa2, bf16x8 pa3) {
#define TRRD(dst, off) asm volatile("ds_read_b64_tr_b16 %0, %1 offset:%2" : "=&v"(dst) : "v"(vb0), "i"(off) : "memory")
#define PV_D0(d0) do { s16x4 l0, l1, l2, l3, h0, h1, h2, h3; constexpr int b_ = V_OFF + VB * SHM_V + v_rd_off(d0, 0, 0); \
        TRRD(l0, b_); TRRD(h0, b_ + 4096); TRRD(l1, b_ + 8192); TRRD(h1, b_ + 12288); TRRD(l2, b_ + 16384); TRRD(h2, b_ + 20480); TRRD(l3, b_ + 24576); TRRD(h3, b_ + 28672); \
        asm volatile("s_waitcnt lgkmcnt(0)" ::: "memory"); __builtin_amdgcn_sched_barrier(0); \
        o[d0] = __builtin_amdgcn_mfma_f32_32x32x16_bf16(pa0, (bf16x8){l0[0], l0[1], l0[2], l0[3], h0[0], h0[1], h0[2], h0[3]}, o[d0], 0, 0, 0); \
        o[d0] = __builtin_amdgcn_mfma_f32_32x32x16_bf16(pa1, (bf16x8){l1[0], l1[1], l1[2], l1[3], h1[0], h1[1], h1[2], h1[3]}, o[d0], 0, 0, 0); \
        o[d0] = __builtin_amdgcn_mfma_f32_32x32x16_bf16(pa2, (bf16x8){l2[0], l2[1], l2[2], l2[3], h2[0], h2[1], h2[2], h2[3]}, o[d0], 0, 0, 0); \
        o[d0] = __builtin_amdgcn_mfma_f32_32x32x16_bf16(pa3, (bf16x8){l3[0], l3[1], l3[2], l3[3], h3[0], h3[1], h3[2], h3[3]}, o[d0], 0, 0, 0); } while (0)
    PV_D0(0); PV_D0(1); PV_D0(2); PV_D0(3); PV_D0(4); PV_D0(5); PV_D0(6); PV_D0(7);
#undef PV_D0
#undef TRRD
}

__device__ __forceinline__ void stage_offsets(int tid, unsigned (&koff)[2], unsigned (&voff)[4]) {
#pragma unroll
    for (int i = 0; i < 2; ++i) { const int P = tid * 16 + i * 8192, row = P >> 8, ch = ((P & 255) >> 4) ^ (row & 7); koff[i] = (unsigned)(row * 128 + ch * 8) * 2u; }
#pragma unroll
    for (int i = 0; i < 4; ++i) { const int P = tid * 16 + i * 8192, st = P >> 9, kk = ((st >> 3) << 3) | ((P & 511) >> 6), cg = st & 7, cin = (P & 63) >> 1;
        const int key = (kk & ~0xC) | ((kk & 4) << 1) | ((kk & 8) >> 1); voff[i] = (unsigned)(key * 256 + cg * 32 + cin) * 2u; }
}
__device__ __forceinline__ const char* uniform_ptr(const void* p) {
    const unsigned long long v = (unsigned long long)p;
    const unsigned lo = __builtin_amdgcn_readfirstlane((unsigned)v), hi = __builtin_amdgcn_readfirstlane((unsigned)(v >> 32));
    return (const char*)(((unsigned long long)hi << 32) | lo);
}
__device__ __forceinline__ void stage_tile(LAS unsigned char* lds, int bf, const bf16_t* kj_, const bf16_t* vj_, int tid_, int wid) {
    const char* kj = uniform_ptr(kj_); const char* vj = uniform_ptr(vj_);
    int tid = tid_; asm volatile("" : "+v"(tid));
    unsigned koff[2], voff[4]; stage_offsets(tid, koff, voff);
#pragma unroll
    for (int i = 0; i < 2; ++i) __builtin_amdgcn_global_load_lds((const unsigned*)(kj + koff[i]), (LAS unsigned*)(lds + K_OFF + bf * SHM_K + wid * 1024 + i * 8192), 16, 0, 0);
#pragma unroll
    for (int i = 0; i < 4; ++i) __builtin_amdgcn_global_load_lds((const unsigned*)(vj + voff[i]), (LAS unsigned*)(lds + V_OFF + bf * SHM_V + wid * 1024 + i * 8192), 16, 0, 0);
}

template <int BF>
__device__ __forceinline__ void tile_compute(LAS unsigned char* lds, int r32, int hi, unsigned vb0, LAS float* al_l, const bf16x8 (&qr)[8], f32x16 (&o)[8],
                                             float& m_reg, float& l_reg, float rawu, float sl2, bool diag, int qi) {
    f32x16 p0, p1;
#pragma unroll
    for (int r = 0; r < 16; ++r) { p0[r] = 0.f; p1[r] = 0.f; }
    qkt<BF>(p0, p1, lds, r32, hi, qr);
#pragma unroll
    for (int r = 0; r < 16; ++r) { const float cr = (float)((r & 3) + 8 * (r >> 2)); p0[r] = fmaf(cr, rawu, p0[r]); p1[r] = fmaf(cr, rawu, p1[r]); }
    if (diag) {
        const float k2raw = 2.f * rawu;
        int qi_ = qi - 4 * hi; asm volatile("" : "+v"(qi_));
#pragma unroll
        for (int r = 0; r < 16; ++r) { const int c = (r & 3) + 8 * (r >> 2); const int d0_ = c - qi_, d1_ = c + 32 - qi_;
            p0[r] -= k2raw * (float)(d0_ > 0 ? d0_ : 0); p1[r] -= k2raw * (float)(d1_ > 0 ? d1_ : 0); }
    }
    const float lane_raw = rawu * (float)(4 * hi), d32raw = 32.f * rawu;
    float pm0 = p0[0], pm1 = p1[0];
#pragma unroll
    for (int r = 1; r < 16; ++r) { pm0 = fmaxf(pm0, p0[r]); pm1 = fmaxf(pm1, p1[r]); }
    float pmax = fmaxf(pm0, pm1 + d32raw) + lane_raw;
    { auto rr = __builtin_amdgcn_permlane32_swap(__float_as_uint(pmax), __float_as_uint(pmax), false, false);
      pmax = fmaxf(__uint_as_float(rr[0]), __uint_as_float(rr[1])); }
    float mn, alpha;
    if (__all((pmax - m_reg) * SCALE <= THR)) { mn = m_reg; alpha = 1.f; }
    else { mn = fmaxf(m_reg, pmax); alpha = __builtin_amdgcn_exp2f((m_reg - mn) * C2); m_reg = mn; }
    const float mnL0 = (lane_raw - mn) * C2, mnL1 = mnL0 + 32.f * sl2;
#pragma unroll
    for (int r = 0; r < 16; ++r) { p0[r] = __builtin_amdgcn_exp2f(fmaf(p0[r], C2, mnL0)); p1[r] = __builtin_amdgcn_exp2f(fmaf(p1[r], C2, mnL1)); }
    if (__any(alpha < 1.f)) {
        if (hi == 0) al_l[r32] = alpha;
        LDS_WAIT();
#pragma unroll
        for (int r = 0; r < 16; ++r) { const float a = al_l[crow(r, hi)];
#pragma unroll
            for (int d = 0; d < 8; ++d) o[d][r] *= a; }
    }
    float ps = 0.f;
#pragma unroll
    for (int r = 0; r < 16; ++r) ps += p0[r] + p1[r];
    { auto rr = __builtin_amdgcn_permlane32_swap(__float_as_uint(ps), __float_as_uint(ps), false, false);
      ps = __uint_as_float(rr[0]) + __uint_as_float(rr[1]); }
    l_reg = l_reg * alpha + ps;
    bf16x8 pa0, pa1, pa2, pa3;
#define PK4(P, B_, OUT) do { unsigned a0 = cvt_pk_bf16(P[B_+0], P[B_+1]), a1 = cvt_pk_bf16(P[B_+2], P[B_+3]); \
        unsigned b0 = cvt_pk_bf16(P[B_+4], P[B_+5]), b1 = cvt_pk_bf16(P[B_+6], P[B_+7]); \
        auto r0 = __builtin_amdgcn_permlane32_swap(a0, b0, false, false); auto r1 = __builtin_amdgcn_permlane32_swap(a1, b1, false, false); \
        u32x4 w = {r0[0], r1[0], r0[1], r1[1]}; OUT = __builtin_bit_cast(bf16x8, w); } while (0)
    PK4(p0, 0, pa0); PK4(p0, 8, pa1); PK4(p1, 0, pa2); PK4(p1, 8, pa3);
#undef PK4
    pv_tile<BF>(o, vb0, pa0, pa1, pa2, pa3);
}

__device__ __forceinline__ void norms_phase(Frame& F, const bf16_t* proj, float* nrm) {
    const int gw = F.vcu * NWAVES + F.wave, NGW = F.G * NWAVES, lane = F.lane;
    for (int idx = gw; idx < 2 * 32 * 256; idx += NGW) {
        const int tensor = idx >> 13, stream = (idx >> 8) & 31, grp = idx & 255;
        const u32x4* rp = (const u32x4*)(proj + (tensor ? DK0 : 0) + ((size_t)stream * SEQ + grp * 64 + lane) * 128);
        float ss = 0.f;
#pragma unroll
        for (int q = 0; q < 16; ++q) { const u32x4 v = rp[q];
#pragma unroll
            for (int e = 0; e < 4; ++e) { const float lo = bf_lo(v[e]), hi = bf_hi(v[e]); ss += lo * lo + hi * hi; } }
        float n = sqrtf(ss) * 1.001f;
#pragma unroll
        for (int o = 1; o < 64; o <<= 1) n = fmaxf(n, __shfl_xor(n, o));
        if (lane == 0) nrm[idx] = n;
    }
}

__device__ __forceinline__ void attn_item(LAS unsigned char* lds, const bf16_t* proj, const float* nrm, bf16_t* oout, int b, int h, int sub, int qb, int tid, int wid, int lane) {
    const int r32 = lane & 31, hi = lane >> 5;
    const float slope = __builtin_amdgcn_exp2f(-(float)(h + 1));
    const float sl2 = slope * 1.4426950408889634f, rawu = sl2 / C2;
    LAS float* ws = (LAS float*)(lds + SCR_OFF) + wid * 64; LAS float* li_l = ws; LAS float* al_l = ws + 32;
    const size_t tokq = (size_t)b * SEQ + (size_t)qb * 256 + wid * 32;
    const bf16_t* kbase = proj + DK0 + dq_off(b, 0, h, sub);
    const bf16_t* vbase = proj + dv_off(b, 0, h);
    int j_lo;
    { const int stream = (b * 8 + h) * 2 + sub; const float* qn = nrm + stream * 256; const float* kn = nrm + 8192 + stream * 256;
      const float Qn = fmaxf(fmaxf(qn[4 * qb], qn[4 * qb + 1]), fmaxf(qn[4 * qb + 2], qn[4 * qb + 3]));
      const float Kd = fmaxf(fmaxf(kn[4 * qb], kn[4 * qb + 1]), fmaxf(kn[4 * qb + 2], kn[4 * qb + 3]));
      int cand = 4 * qb;
      for (int jj = lane; jj < 4 * qb; jj += 64) { const float dmin = (float)(256 * qb - (64 * jj + 63)); const bool skip = slope * dmin > 110.f + SCALE * Qn * (kn[jj] + Kd); if (!skip) cand = cand < jj ? cand : jj; }
#pragma unroll
      for (int o = 1; o < 64; o <<= 1) { const int v = __shfl_xor(cand, o); cand = v < cand ? v : cand; }
      j_lo = __builtin_amdgcn_readfirstlane(cand); }
    bf16x8 qr[8];
#pragma unroll
    for (int d0 = 0; d0 < 8; ++d0) qr[d0] = *(const bf16x8*)(proj + dq_off(b, qb * 256 + wid * 32 + r32, h, sub) + d0 * 16 + hi * 8);
    const float sh64 = 64.f * rawu;
    const int qi = 32 * (wid & 1) + r32;
    const unsigned vb0 = (unsigned)(uintptr_t)(lds + V_OFF) + (unsigned)v_rd_base(lane);
    float m_reg = -1e30f, l_reg = 0.f;
    f32x16 o[8];
#pragma unroll
    for (int d = 0; d < 8; ++d)
#pragma unroll
        for (int r = 0; r < 16; ++r) o[d][r] = 0.f;
    const int NT = 4 * qb + 4, myNT = 4 * qb + (wid >> 1) + 1;
    constexpr size_t KSTEP = 64 * 128, VSTEP = 64 * 256;
    stage_tile(lds, 0, kbase + (size_t)j_lo * KSTEP, vbase + (size_t)j_lo * VSTEP, tid, wid);
    VM_WAIT(); WG_BAR();
    for (int j = j_lo; j < NT; j += 2) {
        if (j + 1 < NT) stage_tile(lds, 1, kbase + (size_t)(j + 1) * KSTEP, vbase + (size_t)(j + 1) * VSTEP, tid, wid);
        if (j < myNT) { if (j > j_lo) m_reg -= sh64; tile_compute<0>(lds, r32, hi, vb0, al_l, qr, o, m_reg, l_reg, rawu, sl2, j == myNT - 1, qi); }
        VM_WAIT(); WG_BAR();
        if (j + 2 < NT) stage_tile(lds, 0, kbase + (size_t)(j + 2) * KSTEP, vbase + (size_t)(j + 2) * VSTEP, tid, wid);
        if (j + 1 < myNT) { m_reg -= sh64; tile_compute<1>(lds, r32, hi, vb0, al_l, qr, o, m_reg, l_reg, rawu, sl2, j + 1 == myNT - 1, qi); }
        VM_WAIT(); WG_BAR();
    }
    if (hi == 0) li_l[r32] = l_reg;
    LDS_WAIT();
    char* Ow = (char*)(oout + tokq * D + h * 256);
    const unsigned lofs = (unsigned)(hi * 4 * D + r32) * 2u;
#pragma unroll
    for (int r = 0; r < 16; ++r) { const float rl = __builtin_amdgcn_rcpf(li_l[crow(r, hi)]);
#pragma unroll
        for (int d0 = 0; d0 < 8; ++d0) { const float v = o[d0][r] * rl; const float vn = __shfl_xor(v, 1);
            if ((r32 & 1) == 0) *(unsigned*)(Ow + (lofs + (unsigned)((((r & 3) + 8 * (r >> 2)) * D + d0 * 32) * 2))) = cvt_pk_bf16(v, vn); } }
    WG_BAR();
}

__device__ __forceinline__ void attn_phase(Frame& F, const bf16_t* proj, const float* nrm, unsigned* queue, bf16_t* o1, bf16_t* o2) {
    LAS int* qw = (LAS int*)(F.lds + SCR_OFF + 8 * 256);
    for (;;) {
        if (F.tid == 0) *qw = (int)__hip_atomic_fetch_add(queue, 1u, __ATOMIC_RELAXED, __HIP_MEMORY_SCOPE_AGENT);
        WG_BAR();
        const int I = __builtin_amdgcn_readfirstlane(*qw);
        if (I >= 2048) break;
        const int qb = 63 - (I >> 5), r = I & 31, h = 7 - (r >> 2), b = (r >> 1) & 1, sub = r & 1;
        attn_item(F.lds, proj, nrm, sub ? o2 : o1, b, h, sub, qb, F.tid, F.wave, F.lane);
    }
}
}

__global__ void __launch_bounds__(NWAVES * 64, 2) hybrid_fwd(Args args) {
    extern __shared__ __attribute__((aligned(16))) unsigned char lds_raw[];
    Frame F;
    F.lds = (LAS unsigned char*)lds_raw;
    F.tid = threadIdx.x; F.lane = F.tid & 63; F.wave = __builtin_amdgcn_readfirstlane(F.tid >> 6);
    F.G = gridDim.x; { const int bx = blockIdx.x; F.vcu = (F.G % 8 == 0) ? (bx % 8) * (F.G / 8) + bx / 8 : bx; }
    unsigned char* ws = args.ws;
    unsigned* ctl = (unsigned*)(ws + WS_CTL);
    for (int u = F.tid; u < (LDS_BYTES - LDSCTL_OFF) / 4; u += NWAVES * 64) ((LAS unsigned*)(F.lds + LDSCTL_OFF))[u] = 0u;
    __syncthreads();
    volatile LAS unsigned* MISC = (volatile LAS unsigned*)(F.lds + MISC_OFF);
    XcdBarrier bar = xcd_barrier_post(ctl + CW_BAR, MISC + 8);
#define GRID_BAR() xcd_barrier(bar)
#ifdef ONLY_PHASE
#define PHON(n) ((n) == ONLY_PHASE)
#elif DIAG
#define PHON(n) ((n) <= args.upto)
#else
#define PHON(n) 1
#endif

    const float* x_in = args.in[0]; const float* norm_mix = args.in[1]; const float* norm_ffn = args.in[2];
    const float* gla_w_in = args.in[3]; const float* gla_wgu = args.in[4]; const float* gla_bg = args.in[5]; const float* gla_norm = args.in[6]; const float* gla_w_out = args.in[7];
    const float* diff_w_in = args.in[8]; const float* lq1 = args.in[9]; const float* lk1 = args.in[10]; const float* lq2 = args.in[11]; const float* lk2 = args.in[12];
    const float* diff_subln = args.in[13]; const float* diff_w_out = args.in[14];
    const float* moe_wgrp = args.in[15]; const float* moe_wexp = args.in[16]; const float* moe_wg = args.in[17]; const float* moe_wu = args.in[18]; const float* moe_wd = args.in[19];
    const float* final_norm = args.in[20];
    float* xres = args.out;
    float* gz = (float*)(ws + WS_GZ);
    int* tok_e = (int*)(ws + WS_TOKE); int* tok_p = (int*)(ws + WS_TOKP); float* tok_w = (float*)(ws + WS_TOKW); int* slot_of = (int*)(ws + WS_SLOT);
    float* adec = (float*)(ws + WS_ADEC);
    float* wp_gz = (float*)(ws + WS_WPGZ); float* wp_r0 = (float*)(ws + WS_WPR0); float* wp_r1 = (float*)(ws + WS_WPR1);
    bf16_t* wgi = (bf16_t*)(ws + WS_WGI); bf16_t* wgo = (bf16_t*)(ws + WS_WGO); bf16_t* wdi = (bf16_t*)(ws + WS_WDI); bf16_t* wdo = (bf16_t*)(ws + WS_WDO);
    bf16_t* wmoe_gu = (bf16_t*)(ws + WS_WMOE); bf16_t* wmoe_d = (bf16_t*)(ws + WS_WMOE_D);
    bf16_t* hn = (bf16_t*)(ws + WS_HN); bf16_t* proj = (bf16_t*)(ws + WS_PROJ); bf16_t* buf1 = (bf16_t*)(ws + WS_BUF1); bf16_t* buf2 = (bf16_t*)(ws + WS_BUF2);
    bf16_t* ag = (bf16_t*)(ws + WS_AG); bf16_t* ob = (bf16_t*)(ws + WS_OB); bf16_t* hh = (bf16_t*)(ws + WS_H);
    const LAS int* pst = (const LAS int*)(F.lds + TAB_OFF);

    _Pragma("unroll") for (int rep_ = 0; rep_ < (REP_PHASE == 0 ? 2 : 1); ++rep_) if (PHON(0)) { if (rep_) GRID_BAR(); Frame P = F; P.tid = opq(F.tid); P.lane = P.tid & 63;
    conv_plain(P, gla_w_in, D, PROJW, GLA_INW, wgi);
    conv_plain(P, gla_w_out, D, D, D, wgo);
    conv_plain(P, diff_w_in, D, PROJW, PROJW, wdi);
    conv_plain(P, diff_w_out, D, D, D, wdo);
    pack_proj(P, wp_gz, 1, norm_mix, gla_w_in, GLA_INW, PROJW, 16, nullptr, 0, 0);
    pack_proj(P, wp_r0, 3, norm_ffn, moe_wgrp, 4, 0, 4, moe_wexp, 32, 32);
    pack_proj(P, wp_r1, 3, norm_ffn + D, moe_wgrp + (size_t)D * 4, 4, 0, 4, moe_wexp + (size_t)D * 32, 32, 32);
    }
    GRID_BAR();
    _Pragma("unroll") for (int rep_ = 0; rep_ < (REP_PHASE == 1 ? 2 : 1); ++rep_) if (PHON(1)) { if (rep_) GRID_BAR(); Frame P = F; P.tid = opq(F.tid); P.lane = P.tid & 63;
    phase_norm_gz(P, x_in, norm_mix, wp_gz, hn, gz);
    }
    GRID_BAR();
    _Pragma("unroll") for (int rep_ = 0; rep_ < (REP_PHASE == 2 ? 2 : 1); ++rep_) if (PHON(2)) { if (rep_) GRID_BAR(); Frame P = F; P.tid = opq(F.tid); P.lane = P.tid & 63;
    { pg8::Gemm g{hn, wgi, T, PROJW, D}; pg8::StaticOrder S; S.init(T, PROJW, P.G, (int)blockIdx.x); pg8::EpiHeads<0> E{proj};
      pg8::gemm_phase<pg8::EpiHeads<0>, pg8::StaticOrder>(P.lds, g, S, E); }
    }
    GRID_BAR();
    _Pragma("unroll") for (int rep_ = 0; rep_ < (REP_PHASE == 3 ? 2 : 1); ++rep_) if (PHON(3)) { if (rep_) GRID_BAR(); Frame P = F; P.tid = opq(F.tid); P.lane = P.tid & 63;
    phase_gla_gate(P, gz, gla_wgu, gla_bg, proj, buf1, adec);
    }
    GRID_BAR();
    _Pragma("unroll") for (int rep_ = 0; rep_ < (REP_PHASE == 4 ? 2 : 1); ++rep_) if (PHON(4)) { if (rep_) GRID_BAR(); Frame P = F; P.tid = opq(F.tid); P.lane = P.tid & 63;
    if (P.G == 256) { if ((P.vcu & 3) == 0) phase_gla_scan(P, P.vcu >> 2, proj, buf1, adec, buf2, ctl + CW_PROBE); else conv_moe(P, moe_wg, moe_wu, moe_wd, wmoe_gu, wmoe_d, (P.vcu >> 2) * 3 + (P.vcu & 3) - 1, 192); }
    else { for (int it = P.vcu; it < 64; it += P.G) phase_gla_scan(P, it, proj, buf1, adec, buf2); conv_moe(P, moe_wg, moe_wu, moe_wd, wmoe_gu, wmoe_d); }
    }
    GRID_BAR();
    _Pragma("unroll") for (int rep_ = 0; rep_ < (REP_PHASE == 5 ? 2 : 1); ++rep_) if (PHON(5)) { if (rep_) GRID_BAR(); Frame P = F; P.tid = opq(F.tid); P.lane = P.tid & 63;
    phase_gla_gnorm(P, buf2, proj, gla_norm, hn);
    }
    GRID_BAR();
    _Pragma("unroll") for (int rep_ = 0; rep_ < (REP_PHASE == 6 ? 2 : 1); ++rep_) if (PHON(6)) { if (rep_) GRID_BAR(); Frame P = F; P.tid = opq(F.tid); P.lane = P.tid & 63;
    { pg8::Gemm g{hn, wgo, T, D, D}; pg8::StaticOrder S; S.init(T, D, P.G, (int)blockIdx.x); pg8::EpiResF32 E{x_in, xres, D};
      pg8::gemm_phase<pg8::EpiResF32, pg8::StaticOrder>(P.lds, g, S, E); }
    }
    GRID_BAR();
    _Pragma("unroll") for (int rep_ = 0; rep_ < (REP_PHASE == 7 ? 2 : 1); ++rep_) if (PHON(7)) { if (rep_) GRID_BAR(); Frame P = F; P.tid = opq(F.tid); P.lane = P.tid & 63;
    phase_norm_route(P, xres, norm_ffn, wp_r0, hn, tok_e, tok_p, tok_w, ctl + CW_CNT0);
    }
    GRID_BAR();
    _Pragma("unroll") for (int rep_ = 0; rep_ < (REP_PHASE == 8 ? 2 : 1); ++rep_) if (PHON(8)) { if (rep_) GRID_BAR(); Frame P = F; P.tid = opq(F.tid); P.lane = P.tid & 63;
    moe_tables(P, ctl + CW_CNT0);
    phase_moe_gather(P, tok_e, tok_p, slot_of, hn, ag);
    }
    GRID_BAR();
    _Pragma("unroll") for (int rep_ = 0; rep_ < (REP_PHASE == 9 ? 2 : 1); ++rep_) if (PHON(9)) { if (rep_) GRID_BAR(); Frame P = F; P.tid = opq(F.tid); P.lane = P.tid & 63;
    { const int Mr = pst[33] * 256; pg8::Gemm g{ag, wmoe_gu, Mr, 1024, D}; pg8::MoeOrder S; S.init(Mr, 1024, P.G, (int)blockIdx.x); S.te = pst + 36; S.estride = (size_t)1024 * D * 2; pg8::EpiSiluMul E{hh};
      pg8::gemm_phase<pg8::EpiSiluMul, pg8::MoeOrder>(P.lds, g, S, E); }
    }
    GRID_BAR();
    _Pragma("unroll") for (int rep_ = 0; rep_ < (REP_PHASE == 10 ? 2 : 1); ++rep_) if (PHON(10)) { if (rep_) GRID_BAR(); Frame P = F; P.tid = opq(F.tid); P.lane = P.tid & 63;
    { const int Mr = pst[33] * 256; pg8::Gemm g{hh, wmoe_d, Mr, D, DFF}; pg8::MoeOrder S; S.init(Mr, D, P.G, (int)blockIdx.x); S.te = pst + 36; S.estride = (size_t)D * DFF * 2; pg8::EpiBf16 E{ob, D};
      pg8::gemm_phase<pg8::EpiBf16, pg8::MoeOrder>(P.lds, g, S, E); }
    }
    GRID_BAR();
    _Pragma("unroll") for (int rep_ = 0; rep_ < (REP_PHASE == 11 ? 2 : 1); ++rep_) if (PHON(11)) { if (rep_) GRID_BAR(); Frame P = F; P.tid = opq(F.tid); P.lane = P.tid & 63;
    phase_moe_combine<0>(P, xres, ob, slot_of, tok_w, norm_mix + D, hn);
    conv_moe(P, moe_wg + (size_t)NEXP * D * DFF, moe_wu + (size_t)NEXP * D * DFF, moe_wd + (size_t)NEXP * DFF * D, wmoe_gu, wmoe_d);
    }
    GRID_BAR();
    _Pragma("unroll") for (int rep_ = 0; rep_ < (REP_PHASE == 12 ? 2 : 1); ++rep_) if (PHON(12)) { if (rep_) GRID_BAR(); Frame P = F; P.tid = opq(F.tid); P.lane = P.tid & 63;
    { pg8::Gemm g{hn, wdi, T, PROJW, D}; pg8::StaticOrder S; S.init(T, PROJW, P.G, (int)blockIdx.x); pg8::EpiHeads<1> E{proj};
      pg8::gemm_phase<pg8::EpiHeads<1>, pg8::StaticOrder>(P.lds, g, S, E); }
    GRID_BAR();
    att::norms_phase(P, proj, (float*)(ws + WS_NRM));
    }
    GRID_BAR();
    _Pragma("unroll") for (int rep_ = 0; rep_ < (REP_PHASE == 13 ? 2 : 1); ++rep_) if (PHON(13)) { if (rep_) GRID_BAR(); Frame P = F; P.tid = opq(F.tid); P.lane = P.tid & 63;
    att::attn_phase(P, proj, (const float*)(ws + WS_NRM), ctl + CW_QUEUE, buf1, buf2);
    }
    GRID_BAR();
    _Pragma("unroll") for (int rep_ = 0; rep_ < (REP_PHASE == 14 ? 2 : 1); ++rep_) if (PHON(14)) { if (rep_) GRID_BAR(); Frame P = F; P.tid = opq(F.tid); P.lane = P.tid & 63;
    phase_subln(P, buf1, buf2, lq1, lk1, lq2, lk2, diff_subln, hn);
    }
    GRID_BAR();
    _Pragma("unroll") for (int rep_ = 0; rep_ < (REP_PHASE == 15 ? 2 : 1); ++rep_) if (PHON(15)) { if (rep_) GRID_BAR(); Frame P = F; P.tid = opq(F.tid); P.lane = P.tid & 63;
    { pg8::Gemm g{hn, wdo, T, D, D}; pg8::StaticOrder S; S.init(T, D, P.G, (int)blockIdx.x); pg8::EpiResF32 E{xres, xres, D};
      pg8::gemm_phase<pg8::EpiResF32, pg8::StaticOrder>(P.lds, g, S, E); }
    }
    GRID_BAR();
    _Pragma("unroll") for (int rep_ = 0; rep_ < (REP_PHASE == 16 ? 2 : 1); ++rep_) if (PHON(16)) { if (rep_) GRID_BAR(); Frame P = F; P.tid = opq(F.tid); P.lane = P.tid & 63;
    phase_norm_route(P, xres, norm_ffn + D, wp_r1, hn, tok_e, tok_p, tok_w, ctl + CW_CNT1);
    }
    GRID_BAR();
    _Pragma("unroll") for (int rep_ = 0; rep_ < (REP_PHASE == 17 ? 2 : 1); ++rep_) if (PHON(17)) { if (rep_) GRID_BAR(); Frame P = F; P.tid = opq(F.tid); P.lane = P.tid & 63;
    moe_tables(P, ctl + CW_CNT1);
    phase_moe_gather(P, tok_e, tok_p, slot_of, hn, ag);
    }
    GRID_BAR();
    _Pragma("unroll") for (int rep_ = 0; rep_ < (REP_PHASE == 18 ? 2 : 1); ++rep_) if (PHON(18)) { if (rep_) GRID_BAR(); Frame P = F; P.tid = opq(F.tid); P.lane = P.tid & 63;
    { const int Mr = pst[33] * 256; pg8::Gemm g{ag, wmoe_gu, Mr, 1024, D}; pg8::MoeOrder S; S.init(Mr, 1024, P.G, (int)blockIdx.x); S.te = pst + 36; S.estride = (size_t)1024 * D * 2; pg8::EpiSiluMul E{hh};
      pg8::gemm_phase<pg8::EpiSiluMul, pg8::MoeOrder>(P.lds, g, S, E); }
    }
    GRID_BAR();
    _Pragma("unroll") for (int rep_ = 0; rep_ < (REP_PHASE == 19 ? 2 : 1); ++rep_) if (PHON(19)) { if (rep_) GRID_BAR(); Frame P = F; P.tid = opq(F.tid); P.lane = P.tid & 63;
    { const int Mr = pst[33] * 256; pg8::Gemm g{hh, wmoe_d, Mr, D, DFF}; pg8::MoeOrder S; S.init(Mr, D, P.G, (int)blockIdx.x); S.te = pst + 36; S.estride = (size_t)D * DFF * 2; pg8::EpiBf16 E{ob, D};
      pg8::gemm_phase<pg8::EpiBf16, pg8::MoeOrder>(P.lds, g, S, E); }
    }
    GRID_BAR();
    _Pragma("unroll") for (int rep_ = 0; rep_ < (REP_PHASE == 20 ? 2 : 1); ++rep_) if (PHON(20)) { if (rep_) GRID_BAR(); Frame P = F; P.tid = opq(F.tid); P.lane = P.tid & 63;
    phase_moe_combine<1>(P, xres, ob, slot_of, tok_w, final_norm, hn);
    }
#if PROBE
    { GRID_BAR(); const float c = sqrtf(0.1f * __uint_as_float(xb_ld(ctl + CW_PROBE)));
      for (size_t i = (size_t)blockIdx.x * 512 + F.tid; i < (size_t)T * D; i += (size_t)gridDim.x * 512) xres[i] = c; }
#endif
}

#if DIAG
constexpr size_t WS_DIAG = WS_END;
constexpr int NSAVE = 64;
__device__ inline unsigned hsh(unsigned x) { x ^= x >> 16; x *= 0x7feb352dU; x ^= x >> 15; x *= 0x846ca68bU; x ^= x >> 16; return x; }
__device__ inline void rep(unsigned* w, double got, double ref, double scale) { double e = fabs(got - ref) / (fabs(ref) + scale); float ef = (float)e; if (!(ef == ef) || ef > 1e30f) ef = 1e30f; atomicMax(w, __float_as_uint(ef)); }
__device__ inline double bfd(bf16_t v) { return (double)bf2f(v); }
#define GTID (blockIdx.x * blockDim.x + threadIdx.x)
#define GSTR (gridDim.x * blockDim.x)

__global__ void ck_weights(const float* gla_w_in, const float* gla_w_out, const float* diff_w_in, const float* diff_w_out, const bf16_t* wgi, const bf16_t* wgo, const bf16_t* wdi, const bf16_t* wdo,
                           const float* norm_mix, const float* norm_ffn, const float* wgrp, const float* wexp, const float* wp_gz, const float* wp_r0, const float* wp_r1, unsigned* w) {
    for (unsigned i = GTID; i < 65536u; i += GSTR) { const unsigned r = hsh(i * 3u + 1u), r2 = hsh(i * 7u + 5u);
        const int n = r % 6144u, k = r2 % 2048u, n2 = n % 2048;
        rep(w, bfd(wgi[(size_t)n * D + k]), gla_w_in[(size_t)k * GLA_INW + n], 0.02); rep(w, bfd(wdi[(size_t)n * D + k]), diff_w_in[(size_t)k * PROJW + n], 0.02);
        rep(w, bfd(wgo[(size_t)n2 * D + k]), gla_w_out[(size_t)k * D + n2], 0.02); rep(w, bfd(wdo[(size_t)n2 * D + k]), diff_w_out[(size_t)k * D + n2], 0.02);
        const int s = r % 128u, ln = (r >> 7) % 64u, e4 = (r >> 13) & 3, kk = 16 * s + 4 * (ln >> 4) + e4, col = ln & 15, nt = (r >> 15) % 3u, col3 = 16 * nt + col;
        rep(w, wp_gz[(s * 64 + ln) * 4 + e4], (double)norm_mix[kk] * gla_w_in[(size_t)kk * GLA_INW + PROJW + col], 0.02);
        for (int L = 0; L < 2; ++L) { const float* gr = wgrp + (size_t)L * D * 4; const float* ex = wexp + (size_t)L * D * 32; const float* nf = norm_ffn + L * D;
            const double ref = col3 < 4 ? gr[kk * 4 + col3] : (col3 < 36 ? ex[kk * 32 + col3 - 4] : 0.0);
            rep(w, (L ? wp_r1 : wp_r0)[((s * 3 + nt) * 64 + ln) * 4 + e4], (double)nf[kk] * ref, 0.02); } }
}
__global__ void ck_moew(const float* wg, const float* wu, const float* wd, const bf16_t* GU, const bf16_t* DT, unsigned* w) {
    for (unsigned i = GTID; i < 65536u; i += GSTR) { const unsigned r = hsh(i * 5u + 2u), r2 = hsh(i * 11u + 3u);
        const int e = r % 32u, f = (r >> 5) % 512u, k = r2 % 2048u, n2 = (r2 >> 11) % 2048u, rowg = 256 * (f >> 7) + (f & 127);
        rep(w, bfd(GU[((size_t)e * 1024 + rowg) * D + k]), wg[((size_t)e * D + k) * DFF + f], 0.02); rep(w, bfd(GU[((size_t)e * 1024 + rowg + 128) * D + k]), wu[((size_t)e * D + k) * DFF + f], 0.02);
        rep(w, bfd(DT[((size_t)e * D + n2) * DFF + f]), wd[((size_t)e * DFF + f) * D + n2], 0.05); }
}
__global__ void ck_norm(const float* x, const float* gain, const bf16_t* hn, unsigned* w) {
    for (unsigned i = GTID; i < 4096u; i += GSTR) { const unsigned r = hsh(i * 13u + 7u); const int t = r % (unsigned)T, j = (r >> 15) % 2048u;
        double ss = 0; for (int k = 0; k < D; ++k) { const double v = x[(size_t)t * D + k]; ss += v * v; }
        const double rstd = 1.0 / sqrt(ss / D + 1e-6); rep(w, bfd(hn[(size_t)t * D + j]), x[(size_t)t * D + j] * rstd * gain[j], 1.0); }
}
__global__ void ck_gz(const float* x, const float* gain, const float* gla_w_in, const float* gz, unsigned* w) {
    for (unsigned i = GTID; i < 4096u; i += GSTR) { const unsigned r = hsh(i * 17u + 9u); const int t = r % (unsigned)T, c = (r >> 15) % 16u;
        double ss = 0, dot = 0; for (int k = 0; k < D; ++k) { const double v = x[(size_t)t * D + k]; ss += v * v; dot += v * gain[k] * gla_w_in[(size_t)k * GLA_INW + PROJW + c]; }
        rep(w, gz[(size_t)t * 16 + c], dot / sqrt(ss / D + 1e-6), 1.0); }
}
__global__ void ck_gemm(const bf16_t* A, const bf16_t* Bt, const bf16_t* C, int M, int N, int K, int ldc, double scale, unsigned* w) {
    for (unsigned i = GTID; i < 16384u; i += GSTR) { const unsigned r = hsh(i * 19u + 11u), r2 = hsh(i * 23u + 1u); const int m = r % (unsigned)M, n = r2 % (unsigned)N;
        double s = 0; for (int k = 0; k < K; ++k) s += bfd(A[(size_t)m * K + k]) * bfd(Bt[(size_t)n * K + k]);
        rep(w, bfd(C[(size_t)m * ldc + n]), s, scale); }
}
__global__ void ck_proj(const bf16_t* A, const bf16_t* Bt, const bf16_t* proj, int layer, unsigned* w) {
    for (unsigned i = GTID; i < 16384u; i += GSTR) { const unsigned r = hsh(i * 19u + 11u), r2 = hsh(i * 23u + 1u); const int m = r % (unsigned)T, n = r2 % (unsigned)PROJW, b = m >> 14, t = m & (SEQ - 1);
        double s = 0; for (int k = 0; k < D; ++k) s += bfd(A[(size_t)m * D + k]) * bfd(Bt[(size_t)n * D + k]);
        size_t off;
        if (layer == 0) { if (n < 1024) off = gq_off(b, t, n >> 8) + (n & 255); else if (n < 2048) off = GK0 + gq_off(b, t, (n - 1024) >> 8) + (n & 255); else if (n < 4096) off = gv_off(b, t, (n - 2048) >> 9) + (n & 511); else off = GR0 + (size_t)m * 2048 + (n - 4096); }
        else { if (n < 2048) off = dq_off(b, t, n >> 8, (n >> 7) & 1) + (n & 127); else if (n < 4096) off = DK0 + dq_off(b, t, (n - 2048) >> 8, (n >> 7) & 1) + (n & 127); else off = dv_off(b, t, (n - 4096) >> 8) + (n & 255); }
        rep(w, bfd(proj[off]), s, 1.0); }
}
__device__ inline int srow(int i) { return (int)(hsh(i * 29u + 13u) % (unsigned)T); }
__global__ void ck_save(const float* x, float* save) { for (unsigned i = GTID; i < (unsigned)NSAVE * D; i += GSTR) save[i] = x[(size_t)srow(i / D) * D + (i % D)]; }
__global__ void ck_gemm_res(const bf16_t* A, const bf16_t* Bt, const float* base, int saved, const float* out, unsigned* w) {
    for (unsigned i = GTID; i < (unsigned)NSAVE * 64u; i += GSTR) { const int si = i / 64, t = srow(si), n = hsh(i * 31u + 5u) % 2048u;
        double s = 0; for (int k = 0; k < D; ++k) s += bfd(A[(size_t)t * D + k]) * bfd(Bt[(size_t)n * D + k]);
        const double b = saved ? base[(size_t)si * D + n] : base[(size_t)t * D + n];
        rep(w, out[(size_t)t * D + n], b + s, 1.0); }
}
__global__ void ck_gate(const float* gz, const float* wgu, const float* bg, const bf16_t* proj, const bf16_t* kdT, const float* adec, unsigned* w) {
    for (unsigned i = GTID; i < 4096u; i += GSTR) { const unsigned r = hsh(i * 37u + 3u); const int bc = r % 512u, j = (r >> 9) % 1024u, tq = (r >> 19) % 64u;
        double run = 0, ct = 0;
        for (int t = 0; t < 64; ++t) { double z = bg[j]; for (int q = 0; q < 16; ++q) z += (double)gz[((size_t)bc * 64 + t) * 16 + q] * wgu[q * 1024 + j];
            const double ls = fmin(z, 0.0) - log1p(exp(-fabs(z))); run += ls / 16.0; if (t == tq) ct = run; }
        rep(w, adec[(size_t)bc * 1024 + j], exp(run), 1.0);
        rep(w, bfd(kdT[((size_t)bc * 1024 + j) * 64 + tq]), bfd(proj[GK0 + gq_off(bc >> 8, (bc & 255) * 64 + tq, j >> 8) + (j & 255)]) * exp(run - ct), 1.0); }
}
__global__ void ck_scan(const bf16_t* proj, const bf16_t* kdT, const float* adec, const bf16_t* o, unsigned* w) {
    const int wv = GTID / 64, lane = threadIdx.x & 63, nw = GSTR / 64;
    const int cl[8] = {0, 1, 3, 17, 100, 255, 2, 64};
    for (int s = wv; s < 96; s += nw) { const unsigned r = hsh(s * 41u + 17u); const int b = r & 1, c = cl[s % 8], tl = (r >> 1) % 64u, h = (r >> 7) % 4u, vc = (r >> 9) % 512u;
        float S[4] = {0.f, 0.f, 0.f, 0.f};
        for (int cc = 0; cc <= c; ++cc) { const size_t bc = (size_t)b * NCH + cc;
            for (int q = 0; q < 4; ++q) { const int kr = h * 256 + lane * 4 + q; float a = 0.f;
                for (int t = 0; t < 64; ++t) a += bf2f(kdT[(bc * 1024 + kr) * 64 + t]) * bf2f(proj[gv_off(b, cc * 64 + t, h) + vc]);
                S[q] = adec[bc * 1024 + kr] * S[q] + a; } }
        float part = 0.f; const size_t tok = (size_t)b * SEQ + c * 64 + tl;
        for (int q = 0; q < 4; ++q) part += bf2f(proj[gq_off(b, c * 64 + tl, h) + lane * 4 + q]) * S[q];
        for (int of = 1; of < 64; of <<= 1) part += __shfl_xor(part, of);
        if (lane == 0) rep(w, bfd(o[tok * D + h * 512 + vc]), part / 16.0, 2.0); }
}
__global__ void ck_gnorm(const bf16_t* o, const bf16_t* proj, const float* gn, const bf16_t* y, unsigned* w) {
    for (unsigned i = GTID; i < 8192u; i += GSTR) { const unsigned r = hsh(i * 43u + 19u); const int t = r % (unsigned)T, h = (r >> 15) % 4u, j = (r >> 17) % 512u;
        double ss = 0; for (int k = 0; k < 512; ++k) { const double v = bfd(o[(size_t)t * D + h * 512 + k]); ss += v * v; }
        const double rr = bfd(proj[GR0 + (size_t)t * 2048 + h * 512 + j]);
        rep(w, bfd(y[(size_t)t * D + h * 512 + j]), bfd(o[(size_t)t * D + h * 512 + j]) / sqrt(ss / 512 + 1e-6) * gn[j] * rr / (1.0 + exp(-rr)), 1.0); }
}
__global__ void ck_route(const float* x, const float* gain, const float* wgrp, const float* wexp, const int* tok_e, const int* tok_p, const float* tok_w, const unsigned* cnt, unsigned* w) {
    for (unsigned i = GTID; i < 512u; i += GSTR) { const int t = hsh(i * 47u + 23u) % (unsigned)T;
        double ss = 0; for (int k = 0; k < D; ++k) { const double v = x[(size_t)t * D + k]; ss += v * v; }
        const double rstd = 1.0 / sqrt(ss / D + 1e-6);
        double gl[4] = {0, 0, 0, 0};
        for (int k = 0; k < D; ++k) { const double v = x[(size_t)t * D + k] * rstd * gain[k]; for (int q = 0; q < 4; ++q) gl[q] += v * wgrp[k * 4 + q]; }
        int gi = 0; for (int q = 1; q < 4; ++q) if (gl[q] > gl[gi]) gi = q;
        double gs = 0; for (int q = 0; q < 4; ++q) gs += exp(gl[q] - gl[gi]);
        double el[8] = {0, 0, 0, 0, 0, 0, 0, 0};
        for (int k = 0; k < D; ++k) { const double v = x[(size_t)t * D + k] * rstd * gain[k]; for (int q = 0; q < 8; ++q) el[q] += v * wexp[k * 32 + gi * 8 + q]; }
        int i1 = 0; for (int q = 1; q < 8; ++q) if (el[q] > el[i1]) i1 = q;
        int i2 = (i1 == 0) ? 1 : 0; for (int q = 0; q < 8; ++q) if (q != i1 && el[q] > el[i2]) i2 = q;
        const double eb = exp(el[i2] - el[i1]);
        const int e1 = tok_e[2 * t], e2 = tok_e[2 * t + 1];
        double third = -1e30; for (int q = 0; q < 8; ++q) if (q != i1 && q != i2 && el[q] > third) third = el[q];
        const bool tie = (el[i2] - third) < 1e-4 || (el[i1] - el[i2]) < 1e-4;
        if (!tie) { rep(w, e1, gi * 8 + i1, 1.0); rep(w, e2, gi * 8 + i2, 1.0);
            rep(w, tok_w[2 * t], 1.0 / gs / (1.0 + eb), 0.3); rep(w, tok_w[2 * t + 1], eb / gs / (1.0 + eb), 0.3); }
        if ((unsigned)tok_p[2 * t] >= cnt[64 * (e1 & 31)] || (unsigned)tok_p[2 * t + 1] >= cnt[64 * (e2 & 31)]) rep(w, 9.0, 0.0, 1.0); }
}
__global__ void ck_gather(const int* tok_e, const int* tok_p, const int* slot_of, const unsigned* cnt, const bf16_t* hn, const bf16_t* ag, unsigned* w) {
    for (unsigned i = GTID; i < 8192u; i += GSTR) { const unsigned r = hsh(i * 53u + 29u); const int a = r % (2u * T), k = (r >> 16) % 2048u, e = tok_e[a] & 31;
        int ps = 0; for (int q = 0; q < e; ++q) ps += ((int)cnt[64 * q] + 255) & ~255;
        const int slot = slot_of[a];
        rep(w, slot, ps + tok_p[a], 1.0);
        if (slot >= 0 && slot < MAX_TILES * 256) rep(w, bfd(ag[(size_t)slot * D + k]), bfd(hn[(size_t)(a >> 1) * D + k]), 1.0); }
}
__global__ void ck_moe1(const int* tok_e, const int* slot_of, const bf16_t* ag, const float* wg, const float* wu, const bf16_t* hh, unsigned* w) {
    for (unsigned i = GTID; i < 8192u; i += GSTR) { const unsigned r = hsh(i * 59u + 31u); const int a = r % (2u * T), f = (r >> 16) % 512u, e = tok_e[a] & 31, slot = slot_of[a];
        if (slot < 0 || slot >= MAX_TILES * 256) { rep(w, 9.0, 0.0, 1.0); continue; }
        double g = 0, u = 0; for (int k = 0; k < D; ++k) { const double v = bfd(ag[(size_t)slot * D + k]); g += v * wg[((size_t)e * D + k) * DFF + f]; u += v * wu[((size_t)e * D + k) * DFF + f]; }
        rep(w, bfd(hh[(size_t)slot * DFF + f]), g / (1.0 + exp(-g)) * u, 0.5); }
}
__global__ void ck_moe2(const int* tok_e, const int* slot_of, const bf16_t* hh, const float* wd, const bf16_t* ob, unsigned* w) {
    for (unsigned i = GTID; i < 8192u; i += GSTR) { const unsigned r = hsh(i * 61u + 37u); const int a = r % (2u * T), n = (r >> 16) % 2048u, e = tok_e[a] & 31, slot = slot_of[a];
        if (slot < 0 || slot >= MAX_TILES * 256) { rep(w, 9.0, 0.0, 1.0); continue; }
        double s = 0; for (int f = 0; f < DFF; ++f) s += bfd(hh[(size_t)slot * DFF + f]) * wd[((size_t)e * DFF + f) * D + n];
        rep(w, bfd(ob[(size_t)slot * D + n]), s, 0.3); }
}
__global__ void ck_combine(const float* save, const bf16_t* ob, const int* slot_of, const float* tok_w, const float* gain, const float* x, const bf16_t* hn, int mode, unsigned* w) {
    for (unsigned i = GTID; i < (unsigned)NSAVE * 32u; i += GSTR) { const int si = i / 32, t = srow(si), j = hsh(i * 67u + 41u) % 2048u;
        const int s0 = slot_of[2 * t], s1 = slot_of[2 * t + 1]; const double w0 = tok_w[2 * t], w1 = tok_w[2 * t + 1];
        double ss = 0, xj = 0; for (int k = 0; k < D; ++k) { const double v = save[(size_t)si * D + k] + w0 * bfd(ob[(size_t)s0 * D + k]) + w1 * bfd(ob[(size_t)s1 * D + k]); ss += v * v; if (k == j) xj = v; }
        const double y = xj / sqrt(ss / D + 1e-6) * gain[j];
        if (mode == 0) { rep(w, x[(size_t)t * D + j], xj, 1.0); rep(w, bfd(hn[(size_t)t * D + j]), y, 1.0); } else rep(w, x[(size_t)t * D + j], y, 1.0); }
}
__global__ void ck_attn(const bf16_t* proj, const bf16_t* o1, const bf16_t* o2, unsigned* w) {
    const int wv = GTID / 64, lane = threadIdx.x & 63, nw = GSTR / 64;
    const int tl[12] = {0, 1, 63, 64, 100, 255, 256, 1000, 4095, 8191, 16320, 16383};
    for (int s = wv; s < 96; s += nw) { const unsigned r = hsh(s * 71u + 43u); const int b = r & 1, h = (r >> 1) % 8u, sub = (r >> 4) & 1, t = tl[s % 12], dv0 = (r >> 5) % 253u;
        const double slope = exp2(-(double)(h + 1)); const int kend = 64 * (t / 64 + 1);
        const bf16_t* qp = proj + dq_off(b, t, h, sub);
        double mx = -1e300;
        for (int j = lane; j < kend; j += 64) { const bf16_t* kp = proj + DK0 + dq_off(b, j, h, sub); double d = 0; for (int q = 0; q < 128; ++q) d += bfd(qp[q]) * bfd(kp[q]);
            const double sc = d * 0.08838834764831845 - slope * fabs((double)(t - j)); if (sc > mx) mx = sc; }
        for (int of = 1; of < 64; of <<= 1) { const double o_ = __shfl_xor(mx, of); if (o_ > mx) mx = o_; }
        double l = 0, acc[4] = {0, 0, 0, 0};
        for (int j = lane; j < kend; j += 64) { const bf16_t* kp = proj + DK0 + dq_off(b, j, h, sub); double d = 0; for (int q = 0; q < 128; ++q) d += bfd(qp[q]) * bfd(kp[q]);
            const double p = exp(d * 0.08838834764831845 - slope * fabs((double)(t - j)) - mx); l += p;
            const bf16_t* vp = proj + dv_off(b, j, h) + dv0; for (int q = 0; q < 4; ++q) acc[q] += p * bfd(vp[q]); }
        for (int of = 1; of < 64; of <<= 1) { l += __shfl_xor(l, of); for (int q = 0; q < 4; ++q) acc[q] += __shfl_xor(acc[q], of); }
        if (lane == 0) for (int q = 0; q < 4; ++q) rep(w, bfd((sub ? o2 : o1)[((size_t)b * SEQ + t) * D + h * 256 + dv0 + q]), acc[q] / l, 0.2); }
}
__global__ void ck_subln(const bf16_t* o1, const bf16_t* o2, const float* lq1, const float* lk1, const float* lq2, const float* lk2, const float* sg, const bf16_t* y, unsigned* w) {
    double d1 = 0, d2 = 0; for (int k = 0; k < 128; ++k) { d1 += (double)lq1[k] * lk1[k]; d2 += (double)lq2[k] * lk2[k]; }
    const double li = 0.8 - 0.6 * exp(-0.3), lam = exp(d1) - exp(d2) + li;
    for (unsigned i = GTID; i < 8192u; i += GSTR) { const unsigned r = hsh(i * 73u + 47u); const int t = r % (unsigned)T, h = (r >> 15) % 8u, j = (r >> 18) % 256u;
        double ss = 0, dj = 0; for (int k = 0; k < 256; ++k) { const double v = bfd(o1[(size_t)t * D + h * 256 + k]) - lam * bfd(o2[(size_t)t * D + h * 256 + k]); ss += v * v; if (k == j) dj = v; }
        rep(w, bfd(y[(size_t)t * D + h * 256 + j]), dj / sqrt(ss / 256 + 1e-6) * sg[j] * (1.0 - li), 1.0); }
}
__global__ void ck_final(const unsigned* words, int nst, float* out, int n) {
    int val = 0;
    for (int s = 0; s < nst; ++s) { const float e = __uint_as_float(words[s]); if (e >= 0.03125f) { val = 4 * s + (e < 0.25f ? 1 : (e < 4.f ? 2 : 3)); break; } }
    const float c = sqrtf(0.1f * (float)val);
    for (int i = GTID; i < n; i += GSTR) out[i] = c;
}
#endif

extern "C" void kernel_launch(void* const* d_in, const int* in_sizes, int n_in, void* d_out, int out_size, void* d_ws, size_t ws_size, hipStream_t stream) {
    static int grid = 0;
    if (grid == 0) {
        if (n_in != 21 || out_size != T * D || ws_size < WS_END + 2 * MiB) { fprintf(stderr, "kernel_launch: unexpected shapes (n_in %d out %d ws %zu)\n", n_in, out_size, ws_size); grid = -1; return; }
        if (hipFuncSetAttribute((const void*)hybrid_fwd, hipFuncAttributeMaxDynamicSharedMemorySize, LDS_BYTES) != hipSuccess) { fprintf(stderr, "kernel_launch: hipFuncSetAttribute failed\n"); grid = -1; return; }
        int dev = 0, cus = 0, per_cu = 0;
        (void)hipGetDevice(&dev); (void)hipDeviceGetAttribute(&cus, hipDeviceAttributeMultiprocessorCount, dev);
        if (hipOccupancyMaxActiveBlocksPerMultiprocessor(&per_cu, (const void*)hybrid_fwd, NWAVES * 64, LDS_BYTES) != hipSuccess || per_cu < 1) fprintf(stderr, "kernel_launch: occupancy query says %d\n", per_cu);
        (void)hipGetLastError();
        grid = cus > 0 ? cus : 256;
    }
    if (grid < 0) return;
    Args a{};
    for (int i = 0; i < 21; ++i) a.in[i] = (const float*)d_in[i];
    a.out = (float*)d_out; a.ws = (unsigned char*)d_ws; a.upto = 99; a.pad1 = 0;
#if !DIAG
    (void)hipMemsetAsync((char*)d_ws + WS_CTL, 0, CTL_ZERO_BYTES, stream);
    hipLaunchKernelGGL(hybrid_fwd, dim3(grid), dim3(NWAVES * 64), LDS_BYTES, stream, a);
#else
    {
        unsigned char* ws = (unsigned char*)d_ws; const float* const* in = a.in;
        unsigned* words = (unsigned*)(ws + WS_DIAG); float* save = (float*)(ws + WS_DIAG + 65536);
        (void)hipMemsetAsync(words, 0, 65536, stream);
        float* gz = (float*)(ws + WS_GZ); int* tok_e = (int*)(ws + WS_TOKE); int* tok_p = (int*)(ws + WS_TOKP); float* tok_w = (float*)(ws + WS_TOKW); int* slot_of = (int*)(ws + WS_SLOT);
        float* adec = (float*)(ws + WS_ADEC); float* wp_gz = (float*)(ws + WS_WPGZ); float* wp_r0 = (float*)(ws + WS_WPR0); float* wp_r1 = (float*)(ws + WS_WPR1);
        bf16_t* wgi = (bf16_t*)(ws + WS_WGI); bf16_t* wgo = (bf16_t*)(ws + WS_WGO); bf16_t* wdi = (bf16_t*)(ws + WS_WDI); bf16_t* wdo = (bf16_t*)(ws + WS_WDO);
        bf16_t* gu = (bf16_t*)(ws + WS_WMOE); bf16_t* dt = (bf16_t*)(ws + WS_WMOE_D);
        bf16_t* hn = (bf16_t*)(ws + WS_HN); bf16_t* proj = (bf16_t*)(ws + WS_PROJ); bf16_t* buf1 = (bf16_t*)(ws + WS_BUF1); bf16_t* buf2 = (bf16_t*)(ws + WS_BUF2);
        bf16_t* ag = (bf16_t*)(ws + WS_AG); bf16_t* ob = (bf16_t*)(ws + WS_OB); bf16_t* hh = (bf16_t*)(ws + WS_H);
        unsigned* ctl = (unsigned*)(ws + WS_CTL); float* xres = (float*)d_out;
        const size_t L1W = (size_t)NEXP * D * DFF;
        for (int st = 0; st <= 20; ++st) {
            (void)hipMemsetAsync((char*)d_ws + WS_CTL, 0, CTL_ZERO_BYTES, stream);
            a.upto = st;
            hipLaunchKernelGGL(hybrid_fwd, dim3(grid), dim3(NWAVES * 64), LDS_BYTES, stream, a);
            unsigned* w = words + st;
            switch (st) {
            case 0: ck_weights<<<256, 256, 0, stream>>>(in[3], in[7], in[8], in[14], wgi, wgo, wdi, wdo, in[1], in[2], in[15], in[16], wp_gz, wp_r0, wp_r1, w); break;
            case 1: ck_norm<<<64, 64, 0, stream>>>(in[0], in[1], hn, w); ck_gz<<<64, 64, 0, stream>>>(in[0], in[1], in[3], gz, w); break;
            case 2: ck_proj<<<256, 64, 0, stream>>>(hn, wgi, proj, 0, w); break;
            case 3: ck_gate<<<64, 64, 0, stream>>>(gz, in[4], in[5], proj, buf1, adec, w); break;
            case 4: ck_scan<<<96, 64, 0, stream>>>(proj, buf1, adec, buf2, w); ck_moew<<<256, 256, 0, stream>>>(in[17], in[18], in[19], gu, dt, w); break;
            case 5: ck_gnorm<<<128, 64, 0, stream>>>(buf2, proj, in[6], hn, w); break;
            case 6: ck_gemm_res<<<64, 64, 0, stream>>>(hn, wgo, in[0], 0, xres, w); break;
            case 7: ck_norm<<<64, 64, 0, stream>>>(xres, in[2], hn, w); ck_route<<<8, 64, 0, stream>>>(xres, in[2], in[15], in[16], tok_e, tok_p, tok_w, ctl + CW_CNT0, w); break;
            case 8: ck_gather<<<128, 64, 0, stream>>>(tok_e, tok_p, slot_of, ctl + CW_CNT0, hn, ag, w); break;
            case 9: ck_moe1<<<128, 64, 0, stream>>>(tok_e, slot_of, ag, in[17], in[18], hh, w); break;
            case 10: ck_moe2<<<128, 64, 0, stream>>>(tok_e, slot_of, hh, in[19], ob, w); ck_save<<<64, 256, 0, stream>>>(xres, save); break;
            case 11: ck_combine<<<32, 64, 0, stream>>>(save, ob, slot_of, tok_w, in[1] + D, xres, hn, 0, w); ck_moew<<<256, 256, 0, stream>>>(in[17] + L1W, in[18] + L1W, in[19] + L1W, gu, dt, w); break;
            case 12: ck_proj<<<256, 64, 0, stream>>>(hn, wdi, proj, 1, w); break;
            case 13: ck_attn<<<96, 64, 0, stream>>>(proj, buf1, buf2, w); break;
            case 14: ck_subln<<<128, 64, 0, stream>>>(buf1, buf2, in[9], in[10], in[11], in[12], in[13], hn, w); ck_save<<<64, 256, 0, stream>>>(xres, save); break;
            case 15: ck_gemm_res<<<64, 64, 0, stream>>>(hn, wdo, save, 1, xres, w); break;
            case 16: ck_norm<<<64, 64, 0, stream>>>(xres, in[2] + D, hn, w); ck_route<<<8, 64, 0, stream>>>(xres, in[2] + D, in[15] + (size_t)D * 4, in[16] + (size_t)D * 32, tok_e, tok_p, tok_w, ctl + CW_CNT1, w); break;
            case 17: ck_gather<<<128, 64, 0, stream>>>(tok_e, tok_p, slot_of, ctl + CW_CNT1, hn, ag, w); break;
            case 18: ck_moe1<<<128, 64, 0, stream>>>(tok_e, slot_of, ag, in[17] + L1W, in[18] + L1W, hh, w); break;
            case 19: ck_moe2<<<128, 64, 0, stream>>>(tok_e, slot_of, hh, in[19] + L1W, ob, w); ck_save<<<64, 256, 0, stream>>>(xres, save); break;
            case 20: ck_combine<<<32, 64, 0, stream>>>(save, ob, slot_of, tok_w, in[20], xres, hn, 1, w); break;
            }
        }
        ck_final<<<1024, 256, 0, stream>>>(words, 21, (float*)d_out, out_size);
    }
#endif
}
```

```cpp
#ifndef DIAG
#define DIAG 0
#endif
#ifndef PROBE
#define PROBE 0
#endif
#ifndef REP_PHASE
#define REP_PHASE -1
#endif
#include <hip/hip_runtime.h>
#include <cstdio>
#include <cstdint>

#define LAS __attribute__((address_space(3)))
#define GAS __attribute__((address_space(1)))
typedef unsigned short bf16_t;
typedef short bf16x8 __attribute__((ext_vector_type(8)));
typedef short s16x4 __attribute__((ext_vector_type(4)));
typedef float f32x4 __attribute__((ext_vector_type(4)));
typedef float f32x2 __attribute__((ext_vector_type(2)));
typedef float f32x16 __attribute__((ext_vector_type(16)));
typedef unsigned u32x4 __attribute__((ext_vector_type(4)));
typedef unsigned u32x2 __attribute__((ext_vector_type(2)));

constexpr int D = 2048, SEQ = 16384, NBATCH = 2, T = NBATCH * SEQ, CHUNK = 64, NCH = SEQ / CHUNK;
constexpr int GLA_H = 4, GLA_DK = 256, GLA_DV = 512, GLA_DKT = 1024, GLA_INW = 6160, PROJW = 6144;
constexpr int DIFF_H = 8;
constexpr int NEXP = 32, DFF = 512;
constexpr float RMS_EPS = 1e-6f;
constexpr float LAMBDA_INIT = 0.35550906759f;
constexpr int MAX_TILES = 288;

constexpr size_t MiB = 1u << 20;
constexpr size_t WS_CTL = 0, CTL_ZERO_BYTES = 1 * MiB;
constexpr size_t WS_GZ = 2 * MiB;
constexpr size_t WS_TOKE = 4 * MiB;
constexpr size_t WS_TOKP = WS_TOKE + 256 * 1024;
constexpr size_t WS_TOKW = WS_TOKP + 256 * 1024;
constexpr size_t WS_SLOT = WS_TOKW + 256 * 1024;
constexpr size_t WS_ADEC = 8 * MiB;
constexpr size_t WS_WPGZ = 10 * MiB;
constexpr size_t WS_WPR0 = 10 * MiB + 256 * 1024;
constexpr size_t WS_WPR1 = 11 * MiB;
constexpr size_t WS_NRM = 12 * MiB;
constexpr size_t WS_WGI = 16 * MiB, WS_WGO = 40 * MiB, WS_WDI = 48 * MiB, WS_WDO = 72 * MiB;
constexpr size_t WS_WMOE = 80 * MiB;
constexpr size_t WS_WMOE_D = WS_WMOE + 128 * MiB;
constexpr size_t WS_HN = 272 * MiB;
constexpr size_t WS_PROJ = 400 * MiB;
constexpr size_t WS_BUF1 = 784 * MiB;
constexpr size_t WS_BUF2 = 912 * MiB;
constexpr size_t WS_AG = 400 * MiB;
constexpr size_t WS_OB = 688 * MiB;
constexpr size_t WS_H = 976 * MiB;
constexpr size_t WS_END = 1048 * MiB;
constexpr int CW_BAR = 4096;
constexpr int CW_PROBE = 8320;
constexpr int CW_QUEUE = 8192;
constexpr int CW_CNT0 = 16384, CW_CNT1 = 16384 + 32 * 64;


constexpr size_t GK0 = (size_t)T * 1024, GV0 = (size_t)T * 2048, GR0 = (size_t)T * 4096;
constexpr size_t DK0 = (size_t)T * 2048, DV0 = (size_t)T * 4096;
__host__ __device__ __forceinline__ size_t gq_off(int b, int t, int h) { return ((size_t)(b * 4 + h) * SEQ + t) * 256; }
__host__ __device__ __forceinline__ size_t gv_off(int b, int t, int h) { return GV0 + ((size_t)(b * 4 + h) * SEQ + t) * 512; }
__host__ __device__ __forceinline__ size_t dq_off(int b, int t, int h, int sub) { return ((size_t)((b * 8 + h) * 2 + sub) * SEQ + t) * 128; }
__host__ __device__ __forceinline__ size_t dv_off(int b, int t, int h) { return DV0 + ((size_t)(b * 8 + h) * SEQ + t) * 256; }

constexpr int RING_BYTES = 131072;
constexpr int LDSCTL_OFF = RING_BYTES;
constexpr int MISC_OFF = LDSCTL_OFF + 320;
constexpr int TAB_OFF = LDSCTL_OFF + 1024;
constexpr int LDS_BYTES = 147456;
constexpr int NWAVES = 8;

typedef __bf16 bf16x2_t __attribute__((ext_vector_type(2)));
__device__ __forceinline__ unsigned cvt_pk_bf16(float lo, float hi) { const f32x2 v = {lo, hi}; return __builtin_bit_cast(unsigned, __builtin_convertvector(v, bf16x2_t)); }
__device__ __forceinline__ float bf_lo(unsigned w) { return __uint_as_float(w << 16); }
__device__ __forceinline__ float bf_hi(unsigned w) { return __uint_as_float(w & 0xffff0000u); }
__device__ __forceinline__ float bf2f(bf16_t b) { return __uint_as_float(((unsigned)b) << 16); }
__device__ __forceinline__ float wave_sum(float v) {
#pragma unroll
    for (int o = 1; o < 64; o <<= 1) v += __shfl_xor(v, o);
    return v;
}
__device__ __forceinline__ int opq(int v) { asm volatile("" : "+v"(v)); return v; }
#define LDS_WAIT() asm volatile("s_waitcnt lgkmcnt(0)" ::: "memory")
#define VM_WAIT() asm volatile("s_waitcnt vmcnt(0)" ::: "memory")
#define WG_BAR() do { asm volatile("s_waitcnt lgkmcnt(0)" ::: "memory"); __builtin_amdgcn_s_barrier(); asm volatile("" ::: "memory"); } while (0)

namespace pg8 {
constexpr int BM = 256, BK = 64, HALF = 128, HTB = HALF * BK * 2, STAGE_BYTES = 8 * HTB, NXCD = 8, WGM = 8;
__host__ __device__ __forceinline__ int lds_byte(int r, int c) { const int st = (r >> 4) * 2 + (c >> 5), rr = r & 15, cc = c & 31, ob = rr * 64 + cc * 2; return st * 1024 + (ob ^ (((ob >> 9) & 1) << 5)); }
__host__ __device__ __forceinline__ void stage_rc(int b, int& R, int& C) { const int st = b / 1024, sb = b % 1024, swz = sb ^ (((sb >> 9) & 1) << 5); R = (st >> 1) * 16 + swz / 64; C = (st & 1) * 32 + (swz % 64) / 2; }
__host__ __device__ __forceinline__ int perm32(int rho) { const int n = rho >> 4, i = rho & 15; return 8 * (i >> 2) + 4 * n + (i & 3); }

struct Unit { int pm, pn; };
struct Gemm { const bf16_t* A; const bf16_t* Bt; int M, N, K; };

struct StaticOrder {
    int nM, nN, nwg, G, c;
    __device__ void init(int M, int N, int G_, int c_) { nM = M / BM; nN = N / BM; nwg = nM * nN; G = G_; c = c_; }
    __device__ bool next(int i, Unit& u) const {
        const long L = (long)i * G + c; if (L >= nwg) return false;
        int wgid = (int)L; { const int q = nwg / NXCD, r = nwg % NXCD, xcd = wgid % NXCD, off = wgid / NXCD; wgid = (xcd < r ? xcd * (q + 1) : r * (q + 1) + (xcd - r) * q) + off; }
        const int nig = WGM * nN, gid = wgid / nig, fm = gid * WGM, gsz = (nM - fm) < WGM ? (nM - fm) : WGM;
        u.pm = fm + ((wgid % nig) % gsz); u.pn = (wgid % nig) / gsz; return true;
    }
    __device__ __forceinline__ size_t bofs(const Unit&) const { return 0; }
};
struct MoeOrder : StaticOrder {
    const LAS int* te; size_t estride;
    __device__ __forceinline__ size_t bofs(const Unit& u) const { return (size_t)te[u.pm] * estride; }
};

struct EpiBf16 {
    static constexpr bool PERM = true;
    bf16_t* O; int ldc;
    __device__ __forceinline__ void operator()(const f32x4 (&acc)[2][2][4][2], const Unit& u, int wr, int wc, int fr, int fq) const {
        const int row0 = u.pm * BM + wr * 64 + fr, col0 = u.pn * BM + wc * 32 + 8 * fq;
#pragma unroll
        for (int ai = 0; ai < 2; ++ai)
#pragma unroll
            for (int m = 0; m < 4; ++m) { bf16_t* rowp = O + (size_t)(row0 + ai * HALF + m * 16) * ldc + col0;
#pragma unroll
                for (int bj = 0; bj < 2; ++bj) { const f32x4 v0 = acc[ai][bj][m][0], v1 = acc[ai][bj][m][1];
                    u32x4 w; w.x = cvt_pk_bf16(v0[0], v0[1]); w.y = cvt_pk_bf16(v0[2], v0[3]); w.z = cvt_pk_bf16(v1[0], v1[1]); w.w = cvt_pk_bf16(v1[2], v1[3]);
                    *(u32x4*)(rowp + bj * HALF) = w; } }
    }
};
template <int LAYER> struct EpiHeads {
    static constexpr bool PERM = true;
    bf16_t* O;
    __device__ __forceinline__ void operator()(const f32x4 (&acc)[2][2][4][2], const Unit& u, int wr, int wc, int fr, int fq) const {
        const int pn = u.pn, lc = wc * 32 + 8 * fq;
#pragma unroll
        for (int ai = 0; ai < 2; ++ai)
#pragma unroll
            for (int m = 0; m < 4; ++m) { const int row = u.pm * BM + ai * HALF + wr * 64 + m * 16 + fr, b = row >> 14, t = row & (SEQ - 1);
#pragma unroll
                for (int bj = 0; bj < 2; ++bj) { size_t off;
                    if (LAYER == 0) { if (pn < 4) off = gq_off(b, t, pn) + bj * 128 + lc; else if (pn < 8) off = GK0 + gq_off(b, t, pn - 4) + bj * 128 + lc;
                                      else if (pn < 16) off = gv_off(b, t, (pn - 8) >> 1) + ((pn - 8) & 1) * 256 + bj * 128 + lc; else off = GR0 + (size_t)row * 2048 + (pn - 16) * 256 + bj * 128 + lc; }
                    else { if (pn < 8) off = dq_off(b, t, pn, bj) + lc; else if (pn < 16) off = DK0 + dq_off(b, t, pn - 8, bj) + lc; else off = dv_off(b, t, pn - 16) + bj * 128 + lc; }
                    const f32x4 v0 = acc[ai][bj][m][0], v1 = acc[ai][bj][m][1];
                    u32x4 w; w.x = cvt_pk_bf16(v0[0], v0[1]); w.y = cvt_pk_bf16(v0[2], v0[3]); w.z = cvt_pk_bf16(v1[0], v1[1]); w.w = cvt_pk_bf16(v1[2], v1[3]);
                    *(u32x4*)(O + off) = w; } }
    }
};
struct EpiResF32 {
    static constexpr bool PERM = false;
    const float* base; float* C; int ldc;
    __device__ __forceinline__ void operator()(const f32x4 (&acc)[2][2][4][2], const Unit& u, int wr, int wc, int fr, int fq) const {
        const int row0 = u.pm * BM + wr * 64 + fr, col0 = u.pn * BM + wc * 32 + 4 * fq;
#pragma unroll
        for (int ai = 0; ai < 2; ++ai)
#pragma unroll
            for (int m = 0; m < 4; ++m) { const size_t off = (size_t)(row0 + ai * HALF + m * 16) * ldc + col0;
#pragma unroll
                for (int bj = 0; bj < 2; ++bj)
#pragma unroll
                    for (int n = 0; n < 2; ++n) { const f32x4 bs = *(const f32x4*)(base + off + bj * HALF + n * 16); *(f32x4*)(C + off + bj * HALF + n * 16) = bs + acc[ai][bj][m][n]; }
                asm volatile("" ::: "memory"); }
    }
};
struct EpiSiluMul {
    static constexpr bool PERM = true;
    bf16_t* Hh;
    __device__ __forceinline__ void operator()(const f32x4 (&acc)[2][2][4][2], const Unit& u, int wr, int wc, int fr, int fq) const {
        const int row0 = u.pm * BM + wr * 64 + fr, col0 = u.pn * HALF + wc * 32 + 8 * fq;
#pragma unroll
        for (int ai = 0; ai < 2; ++ai)
#pragma unroll
            for (int m = 0; m < 4; ++m) { bf16_t* rowp = Hh + (size_t)(row0 + ai * HALF + m * 16) * DFF + col0;
                float hv[8];
#pragma unroll
                for (int n = 0; n < 2; ++n)
#pragma unroll
                    for (int j = 0; j < 4; ++j) { const float g = acc[ai][0][m][n][j], up = acc[ai][1][m][n][j];
                        const float sg = g * __builtin_amdgcn_rcpf(1.0f + __builtin_amdgcn_exp2f(-1.4426950408889634f * g)); hv[n * 4 + j] = sg * up; }
                u32x4 w; w.x = cvt_pk_bf16(hv[0], hv[1]); w.y = cvt_pk_bf16(hv[2], hv[3]); w.z = cvt_pk_bf16(hv[4], hv[5]); w.w = cvt_pk_bf16(hv[6], hv[7]);
                *(u32x4*)rowp = w; }
    }
};

template <class Epi, class Sched>
__device__ __forceinline__ void gemm_phase(LAS unsigned char* lds, const Gemm g, const Sched& S, const Epi& E) {
    const int tid = opq((int)threadIdx.x), wid = __builtin_amdgcn_readfirstlane(tid >> 6), lane = tid & 63, wr = wid >> 2, wc = wid & 3, fr = lane & 15, fq = lane >> 4;
    const int K = g.K, nt = K / BK;
    unsigned voffA[2], voffB[2];
#pragma unroll
    for (int i = 0; i < 2; ++i) { int R, C; stage_rc(tid * 16 + i * 8192, R, C); const int Rb = Epi::PERM ? ((R & ~31) + perm32(R & 31)) : R;
        voffA[i] = (unsigned)(R * K + C) * 2u; voffB[i] = (unsigned)(Rb * K + C) * 2u; }
    const size_t kstep = (size_t)(BK * 2);
    const size_t hstep = (size_t)HALF * K * 2;
    const size_t tstep = 2 * hstep;
    const unsigned ldsw = (unsigned)wid * 1024u;
    const int aoff = lds_byte(wr * 64 + fr, fq * 8), boff = lds_byte(wc * 32 + fr, fq * 8);
#define PG8_SA(b, h) (((b) * 2 + (h)) * HTB)
#define PG8_SB(b, h) ((4 + (b) * 2 + (h)) * HTB)
#define PG8_STAGE(bufoff, gbase, voff) do { _Pragma("unroll") for (int _i = 0; _i < 2; ++_i) \
        __builtin_amdgcn_global_load_lds((const unsigned*)((const char*)(gbase) + (voff)[_i]), (LAS unsigned*)(lds + (bufoff) + ldsw + _i * 8192), 16, 0, 0); } while (0)
#define PG8_LDA(dst, b, h) do { _Pragma("unroll") for (int m = 0; m < 4; ++m) _Pragma("unroll") for (int k = 0; k < 2; ++k) dst[m][k] = *(const LAS bf16x8*)(lds + PG8_SA(b, h) + aoff + m * 2048 + k * 1024); } while (0)
#define PG8_LDB(dst, b, h) do { _Pragma("unroll") for (int n = 0; n < 2; ++n) _Pragma("unroll") for (int k = 0; k < 2; ++k) dst[n][k] = *(const LAS bf16x8*)(lds + PG8_SB(b, h) + boff + n * 2048 + k * 1024); } while (0)
#define PG8_MMA(ai, bj, At, Bt) do { __builtin_amdgcn_s_setprio(1); _Pragma("unroll") for (int m = 0; m < 4; ++m) _Pragma("unroll") for (int n = 0; n < 2; ++n) _Pragma("unroll") for (int k = 0; k < 2; ++k) \
        acc[ai][bj][m][n] = __builtin_amdgcn_mfma_f32_16x16x32_bf16(Bt[n][k], At[m][k], acc[ai][bj][m][n], 0, 0, 0); __builtin_amdgcn_s_setprio(0); } while (0)
#define PG8_WAIT_V(n) asm volatile("s_waitcnt vmcnt(" #n ")" ::: "memory")
#define PG8_WAIT_L(n) asm volatile("s_waitcnt lgkmcnt(" #n ")" ::: "memory")
#define PG8_BAR __builtin_amdgcn_s_barrier()
#define PG8_SCHED __builtin_amdgcn_sched_barrier(0)
    Unit cur, nxt; int ui = 0;
    if (!S.next(0, cur)) return;
    f32x4 acc[2][2][4][2];
#pragma unroll
    for (int a = 0; a < 2; ++a)
#pragma unroll
        for (int b = 0; b < 2; ++b)
#pragma unroll
            for (int m = 0; m < 4; ++m)
#pragma unroll
                for (int n = 0; n < 2; ++n) acc[a][b][m][n] = (f32x4){0.f, 0.f, 0.f, 0.f};
    bf16x8 At[4][2], B0[2][2], B1[2][2];
    const char* cA = (const char*)g.A + (size_t)cur.pm * tstep; const char* cB = (const char*)g.Bt + S.bofs(cur) + (size_t)cur.pn * tstep;
    PG8_STAGE(PG8_SB(0, 0), cB, voffB); PG8_STAGE(PG8_SB(0, 1), cB + hstep, voffB); PG8_STAGE(PG8_SA(0, 0), cA, voffA); PG8_STAGE(PG8_SA(0, 1), cA + hstep, voffA);
    if (wr == 1) PG8_BAR;
    PG8_WAIT_V(2); PG8_BAR;
    PG8_STAGE(PG8_SB(1, 0), cB + kstep, voffB); PG8_STAGE(PG8_SA(1, 0), cA + kstep, voffA); PG8_STAGE(PG8_SB(1, 1), cB + hstep + kstep, voffB);
    PG8_WAIT_V(6); PG8_BAR;
    for (;;) {
        const bool has_next = S.next(ui + 1, nxt);
        const char* nA = has_next ? (const char*)g.A + (size_t)nxt.pm * tstep : cA; const char* nB = has_next ? (const char*)g.Bt + S.bofs(nxt) + (size_t)nxt.pn * tstep : cB;
        for (int t = 0; t < nt; t += 2) {
            const bool last = (t == nt - 2);
            const char* a1 = cA + (size_t)(t + 1) * kstep;
            const char* a2 = last ? nA : cA + (size_t)(t + 2) * kstep; const char* b2 = last ? nB : cB + (size_t)(t + 2) * kstep;
            const char* a3 = a2 + kstep; const char* b3 = b2 + kstep;
            PG8_LDB(B0, 0, 0); PG8_LDB(B1, 0, 1); PG8_SCHED; PG8_LDA(At, 0, 0); PG8_STAGE(PG8_SA(1, 1), a1 + hstep, voffA);
            PG8_WAIT_V(8); PG8_WAIT_L(0); PG8_BAR; PG8_MMA(0, 0, At, B0); PG8_MMA(0, 1, At, B1); PG8_BAR; PG8_SCHED;
            PG8_LDA(At, 0, 1); PG8_STAGE(PG8_SB(0, 0), b2, voffB); PG8_STAGE(PG8_SB(0, 1), b2 + hstep, voffB); PG8_STAGE(PG8_SA(0, 0), a2, voffA);
            PG8_WAIT_V(8); PG8_WAIT_L(0); PG8_BAR; PG8_MMA(1, 0, At, B0); PG8_MMA(1, 1, At, B1); PG8_BAR; PG8_SCHED;
            PG8_LDB(B0, 1, 0); PG8_LDB(B1, 1, 1); PG8_SCHED; PG8_LDA(At, 1, 0); PG8_STAGE(PG8_SA(0, 1), a2 + hstep, voffA);
            PG8_WAIT_V(8); PG8_WAIT_L(0); PG8_BAR; PG8_MMA(0, 0, At, B0); PG8_MMA(0, 1, At, B1); PG8_BAR; PG8_SCHED;
            PG8_LDA(At, 1, 1); PG8_STAGE(PG8_SB(1, 0), b3, voffB); PG8_STAGE(PG8_SB(1, 1), b3 + hstep, voffB); PG8_STAGE(PG8_SA(1, 0), a3, voffA);
            PG8_WAIT_V(8); PG8_WAIT_L(0); PG8_BAR; PG8_MMA(1, 0, At, B0); PG8_MMA(1, 1, At, B1); PG8_BAR; PG8_SCHED;
        }
        if (wr == 0) PG8_BAR;
        E(acc, cur, wr, wc, fr, fq);
        if (!has_next) break;
#pragma unroll
        for (int a = 0; a < 2; ++a)
#pragma unroll
            for (int b = 0; b < 2; ++b)
#pragma unroll
                for (int m = 0; m < 4; ++m)
#pragma unroll
                    for (int n = 0; n < 2; ++n) acc[a][b][m][n] = (f32x4){0.f, 0.f, 0.f, 0.f};
        cur = nxt; cA = nA; cB = nB; ++ui;
        if (wr == 1) PG8_BAR;
    }
    PG8_WAIT_V(0);
    PG8_BAR;
#undef PG8_SA
#undef PG8_SB
#undef PG8_STAGE
#undef PG8_LDA
#undef PG8_LDB
#undef PG8_MMA
#undef PG8_WAIT_V
#undef PG8_WAIT_L
#undef PG8_BAR
#undef PG8_SCHED
}
}

#define XB_TMO      128
#define XB_XCNT(j)  (256  + 64 * (j))
#define XB_XSUB(j)  (1280 + 64 * (j))
#define XB_XGEN(j)  (2304 + 64 * (j))
#define XB_TOP      3328
#define XB_TOPGEN   3392
#define XCD_BAR_WORDS 3456
#define XB_SPIN_CAP (1u << 18)
__device__ __forceinline__ unsigned xb_ld(unsigned* p)              { return __hip_atomic_load(p, __ATOMIC_RELAXED, __HIP_MEMORY_SCOPE_AGENT); }
__device__ __forceinline__ unsigned xb_add(unsigned* p, unsigned v) { return __hip_atomic_fetch_add(p, v, __ATOMIC_RELAXED, __HIP_MEMORY_SCOPE_AGENT); }
__device__ __forceinline__ unsigned xb_xcc_id() { return (unsigned)__builtin_amdgcn_s_getreg((3 << 11) | 20) & 0xFu; }
#define XB_SPIN(cond, bar) do { unsigned _sp = 0; while (cond) { __builtin_amdgcn_s_sleep(1); \
    if ((++_sp & 255u) == 0u) { if (xb_ld(&(bar)[XB_TMO])) break; if (_sp > XB_SPIN_CAP) { atomicAdd(&(bar)[XB_TMO], 1u); break; } } } } while (0)
struct XcdBarrier { unsigned* bar; unsigned x; volatile LAS unsigned* st; };
__device__ __forceinline__ XcdBarrier xcd_barrier_post(unsigned* bar, volatile LAS unsigned* st) {
    XcdBarrier b; b.bar = bar; b.x = xb_xcc_id(); b.st = st;
    if (threadIdx.x == 0) (void)xb_add(&bar[XB_XCNT(b.x)], 1u);
    return b;
}
__device__ __forceinline__ void xcd_barrier_complete(unsigned* bar, unsigned x, unsigned& nloc, unsigned& nx) {
    const unsigned G = gridDim.x * gridDim.y * gridDim.z;
    unsigned sum, cnt, mine, sp = 0u;
    for (;;) {
        sum = 0u; cnt = 0u; mine = 0u;
#pragma unroll
        for (unsigned j = 0; j < 16; ++j) { const unsigned c = xb_ld(&bar[XB_XCNT(j)]); sum += c; cnt += (c > 0u) ? 1u : 0u; mine = (j == x) ? c : mine; }
        if (sum == G) break;
        __builtin_amdgcn_s_sleep(1);
        if ((++sp & 255u) == 0u) { if (xb_ld(&bar[XB_TMO])) break; if (sp > XB_SPIN_CAP) { atomicAdd(&bar[XB_TMO], 1u); break; } }
    }
    nloc = mine > 0u ? mine : 1u; nx = cnt > 0u ? cnt : 1u;
}
__device__ __forceinline__ void xcd_barrier(const XcdBarrier& b) {
    asm volatile("s_waitcnt vmcnt(0)" ::: "memory");
    __syncthreads();
    if (threadIdx.x == 0) {
        unsigned* bar = b.bar;
        __builtin_amdgcn_s_waitcnt(0);
        unsigned nloc = b.st[0], nx = b.st[1];
        if (nloc == 0u) { xcd_barrier_complete(bar, b.x, nloc, nx); b.st[0] = nloc; b.st[1] = nx; }
        const unsigned old = xb_add(&bar[XB_XSUB(b.x)], 1u);
        const unsigned gen = old / nloc;
        if (old + 1u == (gen + 1u) * nloc) {
            __builtin_amdgcn_fence(__ATOMIC_RELEASE, "agent");
            asm volatile("s_waitcnt vmcnt(0)" ::: "memory");
            const unsigned og = xb_add(&bar[XB_TOP], 1u);
            const unsigned tg = og / nx;
            if (og + 1u == (tg + 1u) * nx) xb_add(&bar[XB_TOPGEN], 1u);
            else XB_SPIN(xb_ld(&bar[XB_TOPGEN]) == tg, bar);
            __builtin_amdgcn_fence(__ATOMIC_ACQUIRE, "agent");
            xb_add(&bar[XB_XGEN(b.x)], 1u);
            asm volatile("s_waitcnt vmcnt(0)" ::: "memory");
        } else {
            XB_SPIN(xb_ld(&bar[XB_XGEN(b.x)]) == gen, bar);
            __builtin_amdgcn_fence(__ATOMIC_ACQUIRE, "agent");
            asm volatile("s_waitcnt vmcnt(0)" ::: "memory");
        }
    }
    __syncthreads();
}

struct Frame {
    LAS unsigned char* lds;
    int tid, lane, wave, vcu, G;
};
struct Args {
    const float* in[21]; float* out; unsigned char* ws; int upto, pad1;
};

__device__ __forceinline__ void transpose_item(const float* W, int ldw, int k0, int n0, bf16_t* WT, int ldk, int drow0, LAS float* scr, int lane) {
    float tv[32];
    const float* wp_ = W + (size_t)(k0 + (lane >> 5)) * ldw + n0 + (lane & 31);
#pragma unroll
    for (int i = 0; i < 32; ++i) tv[i] = wp_[(size_t)(2 * i) * ldw];
#pragma unroll
    for (int i = 0; i < 32; ++i) scr[(2 * i + (lane >> 5)) * 33 + (lane & 31)] = tv[i];
    LDS_WAIT(); asm volatile("" ::: "memory");
    const int c = lane & 7;
#pragma unroll
    for (int j = 0; j < 4; ++j) { const int n = (lane >> 3) + 8 * j; const LAS float* s = scr + (8 * c) * 33 + n;
        u32x4 o; o.x = cvt_pk_bf16(s[0 * 33], s[1 * 33]); o.y = cvt_pk_bf16(s[2 * 33], s[3 * 33]); o.z = cvt_pk_bf16(s[4 * 33], s[5 * 33]); o.w = cvt_pk_bf16(s[6 * 33], s[7 * 33]);
        *(u32x4*)(WT + (size_t)(drow0 + n) * ldk + k0 + 8 * c) = o; }
    LDS_WAIT(); asm volatile("" ::: "memory");
}
__device__ __forceinline__ void conv_plain(Frame& F, const float* W, int K, int N, int ldw, bf16_t* WT) {
    LAS float* scr = (LAS float*)(F.lds + F.wave * 16384);
    const int gw = F.vcu * NWAVES + F.wave, NGW = F.G * NWAVES, nblk = N / 32, nit = (K / 64) * nblk;
    for (int it = gw; it < nit; it += NGW) { const int kb = it / nblk, nb = it % nblk; transpose_item(W, ldw, 64 * kb, 32 * nb, WT, K, 32 * nb, scr, F.lane); }
}
__device__ __forceinline__ void conv_moe(Frame& F, const float* wg, const float* wu, const float* wd, bf16_t* GU, bf16_t* DT, int rank = -1, int nrank = 0) {
    LAS float* scr = (LAS float*)(F.lds + F.wave * 16384);
    const int gw = (rank < 0 ? F.vcu : rank) * NWAVES + F.wave, NGW = (rank < 0 ? F.G : nrank) * NWAVES;
    constexpr int PER_E = 1536, NIT = NEXP * PER_E;
    for (int it = gw; it < NIT; it += NGW) {
        const int e = it / PER_E; int r = it % PER_E;
        if (r < 1024) { const int up = r >> 9; r &= 511; const int kb = r >> 4, nb = r & 15, n0 = 32 * nb;
            const int drow = 256 * (n0 >> 7) + 128 * up + (n0 & 127);
            transpose_item((up ? wu : wg) + (size_t)e * D * DFF, DFF, 64 * kb, n0, GU + (size_t)e * 1024 * D, D, drow, scr, F.lane); }
        else { r -= 1024; const int kb = r >> 6, nb = r & 63;
            transpose_item(wd + (size_t)e * DFF * D, D, 64 * kb, 32 * nb, DT + (size_t)e * D * DFF, DFF, 32 * nb, scr, F.lane); }
    }
}
__device__ __forceinline__ void pack_proj(Frame& F, float* Wp, int NT, const float* gain, const float* Wa, int lda, int ca0, int na, const float* Wb, int ldb, int nb) {
    const int total = 128 * NT * 256;
    for (int idx = (F.vcu * NWAVES * 64) + F.tid; idx < total; idx += F.G * NWAVES * 64) {
        const int e = idx & 3, ln = (idx >> 2) & 63, rest = idx >> 8, nt = rest % NT, s = rest / NT;
        const int k = 16 * s + 4 * (ln >> 4) + e, col = 16 * nt + (ln & 15);
        float v = 0.f;
        if (col < na) v = Wa[(size_t)k * lda + ca0 + col]; else if (col < na + nb) v = Wb[(size_t)k * ldb + (col - na)];
        Wp[idx] = v * gain[k];
    }
}

template <int NT>
__device__ __forceinline__ float wave_proj16(LAS unsigned char* lds, const float* xin, int tok0, const float* Wp, int tid, int wid, int lane, f32x4 (&acc)[NT]) {
    const int tr = lane & 15, kq = lane >> 4;
    const f32x4* xp = (const f32x4*)(xin + (size_t)(tok0 + tr) * D) + kq;
    constexpr int CH = 16 * NT * 1024;
    const char* wsrc = (const char*)Wp + tid * 16;
    float ssq = 0.f;
#pragma unroll
    for (int n = 0; n < NT; ++n) acc[n] = (f32x4){0.f, 0.f, 0.f, 0.f};
    f32x4 X[16];
#define NP_DMA(c, buf) do { _Pragma("unroll") for (int r = 0; r < 2 * NT; ++r) \
        __builtin_amdgcn_global_load_lds((const unsigned*)(wsrc + (size_t)(c) * CH + r * 8192), (LAS unsigned*)(lds + (buf) * CH + r * 8192 + wid * 1024), 16, 0, 0); } while (0)
#define NP_CHUNK(c, buf, more) do { \
        asm volatile("s_waitcnt vmcnt(16)" ::: "memory"); WG_BAR(); \
        if (more) NP_DMA((c) + 1, 1 - (buf)); \
        asm volatile("" ::: "memory");     \
        const f32x4* xn_ = xp + 64 * ((c) + 1); \
        _Pragma("unroll") for (int s = 0; s < 16; ++s) { const f32x4 xv = X[s]; if (more) X[s] = xn_[4 * s]; \
            ssq += (xv[0] * xv[0] + xv[1] * xv[1]) + (xv[2] * xv[2] + xv[3] * xv[3]); \
            _Pragma("unroll") for (int n = 0; n < NT; ++n) { const f32x4 wv = *(const LAS f32x4*)(lds + (buf) * CH + ((s * NT + n) * 64 + lane) * 16); \
                _Pragma("unroll") for (int e = 0; e < 4; ++e) acc[n] = __builtin_amdgcn_mfma_f32_16x16x4f32(xv[e], wv[e], acc[n], 0, 0, 0); } } } while (0)
    NP_DMA(0, 0);
    asm volatile("" ::: "memory");
#pragma unroll
    for (int s = 0; s < 16; ++s) X[s] = xp[4 * s];
    for (int c = 0; c < 6; c += 2) { NP_CHUNK(c, 0, true); NP_CHUNK(c + 1, 1, true); }
    NP_CHUNK(6, 0, true); NP_CHUNK(7, 1, false);
    WG_BAR();
#undef NP_DMA
#undef NP_CHUNK
    ssq += __shfl_xor(ssq, 16); ssq += __shfl_xor(ssq, 32);
    return 1.0f / sqrtf(ssq * (1.0f / D) + RMS_EPS);
}
__device__ __forceinline__ void wave_write_hn16(const float* xin, int tok0, float rstd, const float* gain, bf16_t* hn, int lane) {
    f32x4 g4[8];
#pragma unroll
    for (int j = 0; j < 8; ++j) g4[j] = ((const f32x4*)gain)[lane + 64 * j];
    for (int i = 0; i < 16; i += 2) {
        const float r0 = __shfl(rstd, i), r1 = __shfl(rstd, i + 1);
        const f32x4* x0 = (const f32x4*)(xin + (size_t)(tok0 + i) * D); const f32x4* x1 = x0 + D / 4;
        u32x2* o0 = (u32x2*)(hn + (size_t)(tok0 + i) * D); u32x2* o1 = o0 + D / 4;
        f32x4 a[8], c[8];
#pragma unroll
        for (int j = 0; j < 8; ++j) { a[j] = x0[lane + 64 * j]; c[j] = x1[lane + 64 * j]; }
#pragma unroll
        for (int j = 0; j < 8; ++j) { const f32x4 v = a[j] * r0 * g4[j], u = c[j] * r1 * g4[j]; u32x2 w; w.x = cvt_pk_bf16(v[0], v[1]); w.y = cvt_pk_bf16(v[2], v[3]); o0[lane + 64 * j] = w;
            u32x2 z; z.x = cvt_pk_bf16(u[0], u[1]); z.y = cvt_pk_bf16(u[2], u[3]); o1[lane + 64 * j] = z; }
    }
}

__device__ __forceinline__ void phase_norm_gz(Frame& F, const float* xin, const float* gain, const float* Wp, bf16_t* hn, float* gz) {
    for (int tile = F.vcu; tile < T / 128; tile += F.G) {
        const int tok0 = tile * 128 + F.wave * 16;
        f32x4 acc[1];
        const float rstd = wave_proj16<1>(F.lds, xin, tok0, Wp, F.tid, F.wave, F.lane, acc);
        const int j = F.lane & 15, q4 = F.lane >> 4;
#pragma unroll
        for (int r = 0; r < 4; ++r) { const float rr = __shfl(rstd, 4 * q4 + r); gz[(size_t)(tok0 + 4 * q4 + r) * 16 + j] = acc[0][r] * rr; }
        wave_write_hn16(xin, tok0, rstd, gain, hn, F.lane);
    }
}
__device__ __forceinline__ void phase_norm_route(Frame& F, const float* xin, const float* gain, const float* Wp, bf16_t* hn, int* tok_e, int* tok_p, float* tok_w, unsigned* cnt) {
    LAS float* lg = (LAS float*)(F.lds + 98304 + F.wave * 3072);
    for (int tile = F.vcu; tile < T / 128; tile += F.G) {
        const int tok0 = tile * 128 + F.wave * 16;
        f32x4 acc[3];
        const float rstd = wave_proj16<3>(F.lds, xin, tok0, Wp, F.tid, F.wave, F.lane, acc);
        const int j = F.lane & 15, q4 = F.lane >> 4;
#pragma unroll
        for (int r = 0; r < 4; ++r) { const float rr = __shfl(rstd, 4 * q4 + r);
#pragma unroll
            for (int n = 0; n < 3; ++n) lg[(4 * q4 + r) * 48 + 16 * n + j] = acc[n][r] * rr; }
        LDS_WAIT(); asm volatile("" ::: "memory");
        if (F.lane < 16) {
            const LAS float* l = lg + F.lane * 48;
            float gm = l[0]; int gi = 0;
#pragma unroll
            for (int q = 1; q < 4; ++q) { const float v = l[q]; if (v > gm) { gm = v; gi = q; } }
            float gs = 0.f;
#pragma unroll
            for (int q = 0; q < 4; ++q) gs += __expf(l[q] - gm);
            const float gw = 1.0f / gs;
            const LAS float* se = l + 4 + 8 * gi;
            float m1 = se[0]; int i1 = 0;
#pragma unroll
            for (int q = 1; q < 8; ++q) { const float v = se[q]; if (v > m1) { m1 = v; i1 = q; } }
            float m2 = -3.0e38f; int i2 = 0;
#pragma unroll
            for (int q = 0; q < 8; ++q) { const float v = se[q]; if (q != i1 && v > m2) { m2 = v; i2 = q; } }
            const float eb = __expf(m2 - m1), inv = 1.0f / (1.0f + eb);
            const int t = tok0 + F.lane, e1 = gi * 8 + i1, e2 = gi * 8 + i2;
            const unsigned p1 = __hip_atomic_fetch_add(cnt + 64 * e1, 1u, __ATOMIC_RELAXED, __HIP_MEMORY_SCOPE_AGENT);
            const unsigned p2 = __hip_atomic_fetch_add(cnt + 64 * e2, 1u, __ATOMIC_RELAXED, __HIP_MEMORY_SCOPE_AGENT);
            tok_e[2 * t] = e1; tok_e[2 * t + 1] = e2; tok_p[2 * t] = (int)p1; tok_p[2 * t + 1] = (int)p2;
            tok_w[2 * t] = gw * inv; tok_w[2 * t + 1] = gw * eb * inv;
        }
        wave_write_hn16(xin, tok0, rstd, gain, hn, F.lane);
        LDS_WAIT(); asm volatile("" ::: "memory");
    }
}

__device__ __forceinline__ void phase_gla_gate(Frame& F, const float* gz, const float* wgu, const float* bgate, const bf16_t* proj, bf16_t* kdT, float* adec) {
    LAS f32x4* gzs = (LAS f32x4*)F.lds;
    for (int u = F.vcu; u < NBATCH * NCH * 2; u += F.G) {
        const int half = u & 1, bc = u >> 1;
        const int tok0 = bc * 64, j = half * 512 + F.tid;
        if (F.tid < 256) gzs[F.tid] = ((const f32x4*)(gz + (size_t)tok0 * 16))[F.tid];
        float wg[16];
#pragma unroll
        for (int r = 0; r < 16; ++r) wg[r] = wgu[r * GLA_DKT + j];
        const float bg = bgate[j];
        WG_BAR();
        float cum[64]; float run = 0.f;
#pragma unroll
        for (int t = 0; t < 64; ++t) {
            float z = bg;
#pragma unroll
            for (int r4 = 0; r4 < 4; ++r4) { const f32x4 g4 = gzs[t * 4 + r4]; z += g4[0] * wg[4 * r4] + g4[1] * wg[4 * r4 + 1] + g4[2] * wg[4 * r4 + 2] + g4[3] * wg[4 * r4 + 3]; }
            const float ls = fminf(z, 0.f) - __logf(1.0f + __expf(-fabsf(z)));
            run += ls * (1.0f / 16.0f); cum[t] = run;
        }
        adec[(size_t)bc * GLA_DKT + j] = __expf(run);
        const bf16_t* kp = proj + GK0 + gq_off(bc >> 8, (bc & 255) * 64, j >> 8) + (j & 255);
        u32x4* dst = (u32x4*)(kdT + ((size_t)bc * GLA_DKT + j) * 64);
#pragma unroll
        for (int t8 = 0; t8 < 8; ++t8) {
            float kd[8];
#pragma unroll
            for (int q = 0; q < 8; ++q) { const int t = t8 * 8 + q; kd[q] = bf2f(kp[(size_t)t * 256]) * __expf(run - cum[t]); }
            u32x4 w; w.x = cvt_pk_bf16(kd[0], kd[1]); w.y = cvt_pk_bf16(kd[2], kd[3]); w.z = cvt_pk_bf16(kd[4], kd[5]); w.w = cvt_pk_bf16(kd[6], kd[7]);
            dst[t8] = w;
        }
        WG_BAR();
    }
}

constexpr int SCAN_VROW = 144, SCAN_SROW = 528, SCAN_VBUF = 64 * SCAN_VROW, SCAN_SBUF = 64 * SCAN_SROW;
__device__ __forceinline__ void phase_gla_scan(Frame& F, int it, const bf16_t* proj, const bf16_t* kdT, const float* adec, bf16_t* oout, unsigned* probe = nullptr) {
    const int lane = F.lane, w = F.wave, fr = lane & 15, kq = lane >> 4, tid = F.tid;
    LAS unsigned char* vbuf = F.lds;
    LAS unsigned char* sbuf = F.lds + 2 * SCAN_VBUF;
    const int bh = it >> 3, b = bh >> 2, h = bh & 3, sl = it & 7, mt = w & 3, ntp = w >> 2;
    const size_t tokb = (size_t)b * SEQ;
    f32x4 st[2][4];
#pragma unroll
    for (int i = 0; i < 2; ++i)
#pragma unroll
        for (int n = 0; n < 4; ++n) st[i][n] = (f32x4){0.f, 0.f, 0.f, 0.f};
    bf16x8 ka0[2][2], ka1[2][2], q0[8], q1[8]; f32x4 dc0[2], dc1[2]; u32x4 vr0, vr1;
#define CL(c) ((c) < NCH ? (c) : NCH - 1)
#define LOAD_KA(KA, DC, c) do { const size_t bc_ = (size_t)b * NCH + CL(c); \
        _Pragma("unroll") for (int i = 0; i < 2; ++i) { \
            _Pragma("unroll") for (int s = 0; s < 2; ++s) KA[i][s] = *(const bf16x8*)(kdT + ((bc_ * GLA_DKT + h * 256 + 32 * w + 16 * i + fr) * 64 + 32 * s + 8 * kq)); \
            DC[i] = *(const f32x4*)(adec + bc_ * GLA_DKT + h * 256 + 32 * w + 16 * i + 4 * kq); } } while (0)
#define LOAD_V(VR, c) do { VR = *(const u32x4*)(proj + gv_off(b, CL(c) * 64 + (tid >> 3), h) + 64 * sl + 8 * (tid & 7)); } while (0)
#define LOAD_Q(Q, c) do { const bf16_t* qp_ = proj + gq_off(b, CL(c) * 64 + 16 * mt + fr, h) + 8 * kq; \
        _Pragma("unroll") for (int s = 0; s < 8; ++s) Q[s] = *(const bf16x8*)(qp_ + 32 * s); } while (0)
#define STORE_V(VR, buf) do { *(LAS u32x4*)(vbuf + (buf) * SCAN_VBUF + (tid >> 3) * SCAN_VROW + (tid & 7) * 16) = VR; } while (0)
#if PROBE
    unsigned long long pacc[3] = {0ull, 0ull, 0ull}; unsigned long long pmark;
#define PMARK(k) do { const unsigned long long n_ = __builtin_amdgcn_s_memtime(); pacc[k] += n_ - pmark; pmark = n_; } while (0)
#define PSTART() do { pmark = __builtin_amdgcn_s_memtime(); } while (0)
#else
#define PMARK(k) do { } while (0)
#define PSTART() do { } while (0)
#endif
#define SCAN_STEP(KA, DC, VN, VM, QC, QN, c) do { \
        PSTART(); \
        const unsigned vb_ = (unsigned)(uintptr_t)(vbuf + ((c) & 1) * SCAN_VBUF) + (unsigned)((8 * kq + ((lane & 15) >> 2)) * SCAN_VROW + 8 * (lane & 3)); \
        s16x4 tv[4][4];     \
        asm volatile("ds_read_b64_tr_b16 %0, %16 offset:0\n\tds_read_b64_tr_b16 %1, %16 offset:576\n\tds_read_b64_tr_b16 %2, %16 offset:4608\n\tds_read_b64_tr_b16 %3, %16 offset:5184\n\t" \
                     "ds_read_b64_tr_b16 %4, %16 offset:32\n\tds_read_b64_tr_b16 %5, %16 offset:608\n\tds_read_b64_tr_b16 %6, %16 offset:4640\n\tds_read_b64_tr_b16 %7, %16 offset:5216\n\t" \
                     "ds_read_b64_tr_b16 %8, %16 offset:64\n\tds_read_b64_tr_b16 %9, %16 offset:640\n\tds_read_b64_tr_b16 %10, %16 offset:4672\n\tds_read_b64_tr_b16 %11, %16 offset:5248\n\t" \
                     "ds_read_b64_tr_b16 %12, %16 offset:96\n\tds_read_b64_tr_b16 %13, %16 offset:672\n\tds_read_b64_tr_b16 %14, %16 offset:4704\n\tds_read_b64_tr_b16 %15, %16 offset:5280\n\ts_waitcnt lgkmcnt(0)" \
                     : "=&v"(tv[0][0]), "=&v"(tv[0][1]), "=&v"(tv[0][2]), "=&v"(tv[0][3]), "=&v"(tv[1][0]), "=&v"(tv[1][1]), "=&v"(tv[1][2]), "=&v"(tv[1][3]), \
                       "=&v"(tv[2][0]), "=&v"(tv[2][1]), "=&v"(tv[2][2]), "=&v"(tv[2][3]), "=&v"(tv[3][0]), "=&v"(tv[3][1]), "=&v"(tv[3][2]), "=&v"(tv[3][3]) : "v"(vb_) : "memory"); \
        _Pragma("unroll") for (int n = 0; n < 4; ++n) { \
            const bf16x8 vf0 = (bf16x8){tv[n][0][0], tv[n][0][1], tv[n][0][2], tv[n][0][3], tv[n][1][0], tv[n][1][1], tv[n][1][2], tv[n][1][3]}; \
            const bf16x8 vf1 = (bf16x8){tv[n][2][0], tv[n][2][1], tv[n][2][2], tv[n][2][3], tv[n][3][0], tv[n][3][1], tv[n][3][2], tv[n][3][3]}; \
            _Pragma("unroll") for (int i = 0; i < 2; ++i) { \
                st[i][n] = st[i][n] * DC[i]; \
                st[i][n] = __builtin_amdgcn_mfma_f32_16x16x32_bf16(KA[i][0], vf0, st[i][n], 0, 0, 0); \
                st[i][n] = __builtin_amdgcn_mfma_f32_16x16x32_bf16(KA[i][1], vf1, st[i][n], 0, 0, 0); } } \
        LOAD_KA(KA, DC, (c) + 2); \
        PMARK(0); \
        { LAS unsigned char* sb_ = sbuf + ((c) & 1) * SCAN_SBUF + fr * SCAN_SROW + (32 * w + 4 * kq) * 2; \
          _Pragma("unroll") for (int i = 0; i < 2; ++i) _Pragma("unroll") for (int n = 0; n < 4; ++n) { \
              u32x2 pk; pk.x = cvt_pk_bf16(st[i][n][0], st[i][n][1]); pk.y = cvt_pk_bf16(st[i][n][2], st[i][n][3]); \
              *(LAS u32x2*)(sb_ + n * 16 * SCAN_SROW + i * 32) = pk; } } \
        STORE_V(VN, ((c) + 1) & 1); \
        LOAD_V(VN, (c) + 3); \
        WG_BAR(); \
        PMARK(1); \
        { f32x4 a0 = (f32x4){0.f, 0.f, 0.f, 0.f}, a1 = a0; \
          const LAS unsigned char* sr_ = sbuf + ((c) & 1) * SCAN_SBUF + (32 * ntp + fr) * SCAN_SROW + 16 * kq; \
          _Pragma("unroll") for (int hb = 0; hb < 2; ++hb) { bf16x8 bb[4][2];     \
              _Pragma("unroll") for (int s = 0; s < 4; ++s) { bb[s][0] = *(const LAS bf16x8*)(sr_ + 64 * (4 * hb + s)); bb[s][1] = *(const LAS bf16x8*)(sr_ + 16 * SCAN_SROW + 64 * (4 * hb + s)); } \
              asm volatile("s_waitcnt lgkmcnt(0)" ::: "memory"); __builtin_amdgcn_sched_barrier(0); \
              _Pragma("unroll") for (int s = 0; s < 4; ++s) { \
                  a0 = __builtin_amdgcn_mfma_f32_16x16x32_bf16(QC[4 * hb + s], bb[s][0], a0, 0, 0, 0); \
                  a1 = __builtin_amdgcn_mfma_f32_16x16x32_bf16(QC[4 * hb + s], bb[s][1], a1, 0, 0, 0); } } \
          bf16_t* op_ = oout + (tokb + (size_t)(c) * 64 + 16 * mt + 4 * kq) * D + h * 512 + 64 * sl + 32 * ntp + fr; \
          _Pragma("unroll") for (int r = 0; r < 4; ++r) { \
              const float x0 = a0[r] * 0.0625f, x1 = a1[r] * 0.0625f, y0 = __shfl_xor(x0, 1), y1 = __shfl_xor(x1, 1); \
              if ((fr & 1) == 0) { *(unsigned*)(op_ + (size_t)r * D) = cvt_pk_bf16(x0, y0); *(unsigned*)(op_ + (size_t)r * D + 16) = cvt_pk_bf16(x1, y1); } } } \
        LOAD_Q(QC, (c) + 2); \
        PMARK(2); \
    } while (0)
    LOAD_KA(ka0, dc0, 0); LOAD_KA(ka1, dc1, 1); LOAD_V(vr0, 0); LOAD_V(vr1, 1); LOAD_Q(q0, 0); LOAD_Q(q1, 1);
    STORE_V(vr0, 0); LOAD_V(vr0, 2);
    WG_BAR();
#if PROBE
    const unsigned long long pt0 = __builtin_amdgcn_s_memtime(), pr0 = __builtin_amdgcn_s_memrealtime();
#endif
    for (int c = 0; c < NCH; c += 2) {
        SCAN_STEP(ka0, dc0, vr1, vr0, q0, q1, c);
        SCAN_STEP(ka1, dc1, vr0, vr1, q1, q0, c + 1);
    }
    WG_BAR();
#if PROBE
    if (probe && it == 0 && tid == 0) { const unsigned long long dt = __builtin_amdgcn_s_memtime() - pt0, dr = __builtin_amdgcn_s_memrealtime() - pr0;
        const float val = floorf(2.f * log2f((PROBE == 1) ? (float)dt / 256.f : (PROBE == 2) ? (float)dr * 10.f / 256.f : (float)pacc[PROBE - 3] / 256.f));
        __hip_atomic_store(probe, __float_as_uint(val), __ATOMIC_RELAXED, __HIP_MEMORY_SCOPE_AGENT); }
#endif
#undef CL
#undef LOAD_KA
#undef LOAD_V
#undef LOAD_Q
#undef STORE_V
#undef SCAN_STEP
}

__device__ __forceinline__ void phase_gla_gnorm(Frame& F, const bf16_t* o, const bf16_t* proj, const float* gn, bf16_t* y) {
    const int gw = F.vcu * NWAVES + F.wave, NGW = F.G * NWAVES, lane = F.lane;
    const f32x4 g0 = ((const f32x4*)gn)[2 * lane], g1 = ((const f32x4*)gn)[2 * lane + 1];
    for (int tok = gw; tok < T; tok += NGW) {
        u32x4 ov[4], rv[4];
#pragma unroll
        for (int h = 0; h < 4; ++h) { ov[h] = *(const u32x4*)(o + (size_t)tok * D + h * 512 + 8 * lane); rv[h] = *(const u32x4*)(proj + GR0 + (size_t)tok * 2048 + h * 512 + 8 * lane); }
        float ss[4];
#pragma unroll
        for (int h = 0; h < 4; ++h) { float s = 0.f;
#pragma unroll
            for (int q = 0; q < 4; ++q) { const float lo = bf_lo(ov[h][q]), hi = bf_hi(ov[h][q]); s += lo * lo + hi * hi; }
            ss[h] = s; }
#pragma unroll
        for (int of = 1; of < 64; of <<= 1) {
#pragma unroll
            for (int h = 0; h < 4; ++h) ss[h] += __shfl_xor(ss[h], of); }
#pragma unroll
        for (int h = 0; h < 4; ++h) { const float rstd = 1.0f / sqrtf(ss[h] * (1.0f / 512.0f) + RMS_EPS);
            float yv[8];
#pragma unroll
            for (int q = 0; q < 4; ++q) { const float a0 = bf_lo(ov[h][q]), a1 = bf_hi(ov[h][q]), r0 = bf_lo(rv[h][q]), r1 = bf_hi(rv[h][q]);
                const float gA = q < 2 ? g0[2 * q] : g1[2 * q - 4], gB = q < 2 ? g0[2 * q + 1] : g1[2 * q - 3];
                yv[2 * q] = a0 * rstd * gA * (r0 / (1.0f + __expf(-r0))); yv[2 * q + 1] = a1 * rstd * gB * (r1 / (1.0f + __expf(-r1))); }
            u32x4 w; w.x = cvt_pk_bf16(yv[0], yv[1]); w.y = cvt_pk_bf16(yv[2], yv[3]); w.z = cvt_pk_bf16(yv[4], yv[5]); w.w = cvt_pk_bf16(yv[6], yv[7]);
            *(u32x4*)(y + (size_t)tok * D + h * 512 + 8 * lane) = w; }
    }
}

__device__ __forceinline__ void moe_tables(Frame& F, unsigned* cnt) {
    LAS int* pst = (LAS int*)(F.lds + TAB_OFF);
    LAS int* te = pst + 36;
    if (F.wave == 0) {
        const int e = F.lane & 31;
        const int c = (int)xb_ld(cnt + 64 * e);
        const int ntile = (c + 255) >> 8;
        int incl = ntile;
#pragma unroll
        for (int o = 1; o < 32; o <<= 1) { const int v = __shfl_up(incl, o); if ((F.lane & 31) >= o) incl += v; }
        const int excl = incl - ntile;
        if (F.lane < 32) { pst[e] = excl << 8; for (int q = 0; q < ntile; ++q) te[excl + q] = e; }
        if (F.lane == 31) { pst[32] = incl << 8; pst[33] = incl; }
    }
    WG_BAR();
}
__device__ __forceinline__ void phase_moe_gather(Frame& F, const int* tok_e, const int* tok_p, int* slot_of, const bf16_t* hn, bf16_t* ag) {
    const LAS int* pst = (const LAS int*)(F.lds + TAB_OFF);
    const int gw = F.vcu * NWAVES + F.wave, NGW = F.G * NWAVES, lane = F.lane;
    for (int t = gw; t < T; t += 2 * NGW) {
        const int t2 = t + NGW < T ? t + NGW : t;
        const int s0 = pst[tok_e[2 * t]] + tok_p[2 * t], s1 = pst[tok_e[2 * t + 1]] + tok_p[2 * t + 1], s2 = pst[tok_e[2 * t2]] + tok_p[2 * t2], s3 = pst[tok_e[2 * t2 + 1]] + tok_p[2 * t2 + 1];
        if (lane == 0) { slot_of[2 * t] = s0; slot_of[2 * t + 1] = s1; slot_of[2 * t2] = s2; slot_of[2 * t2 + 1] = s3; }
        const u32x4* srcA = (const u32x4*)(hn + (size_t)t * D); const u32x4* srcB = (const u32x4*)(hn + (size_t)t2 * D);
        u32x4 va[4], vb[4];
#pragma unroll
        for (int j = 0; j < 4; ++j) { va[j] = srcA[lane + 64 * j]; vb[j] = srcB[lane + 64 * j]; }
#pragma unroll
        for (int j = 0; j < 4; ++j) { ((u32x4*)(ag + (size_t)s0 * D))[lane + 64 * j] = va[j]; ((u32x4*)(ag + (size_t)s1 * D))[lane + 64 * j] = va[j];
                                      ((u32x4*)(ag + (size_t)s2 * D))[lane + 64 * j] = vb[j]; ((u32x4*)(ag + (size_t)s3 * D))[lane + 64 * j] = vb[j]; }
    }
}
template <int MODE>
__device__ __forceinline__ void phase_moe_combine(Frame& F, float* x, const bf16_t* ob, const int* slot_of, const float* tok_w, const float* gain, bf16_t* hn) {
    const int gw = F.vcu * NWAVES + F.wave, NGW = F.G * NWAVES, lane = F.lane;
    f32x4 g4[8];
#pragma unroll
    for (int j = 0; j < 8; ++j) g4[j] = ((const f32x4*)gain)[lane + 64 * j];
    for (int t = gw; t < T; t += NGW) {
        const int s0 = slot_of[2 * t], s1 = slot_of[2 * t + 1]; const float w0 = tok_w[2 * t], w1 = tok_w[2 * t + 1];
        f32x4* xr = (f32x4*)(x + (size_t)t * D);
        const u32x2* a = (const u32x2*)(ob + (size_t)s0 * D); const u32x2* b = (const u32x2*)(ob + (size_t)s1 * D);
        f32x4 v[8]; float ss = 0.f;
#pragma unroll
        for (int j = 0; j < 8; ++j) { const u32x2 av = a[lane + 64 * j], bv = b[lane + 64 * j]; f32x4 xv = xr[lane + 64 * j];
            xv[0] += w0 * bf_lo(av.x) + w1 * bf_lo(bv.x); xv[1] += w0 * bf_hi(av.x) + w1 * bf_hi(bv.x);
            xv[2] += w0 * bf_lo(av.y) + w1 * bf_lo(bv.y); xv[3] += w0 * bf_hi(av.y) + w1 * bf_hi(bv.y);
            v[j] = xv; ss += (xv[0] * xv[0] + xv[1] * xv[1]) + (xv[2] * xv[2] + xv[3] * xv[3]); }
        const float rstd = 1.0f / sqrtf(wave_sum(ss) * (1.0f / D) + RMS_EPS);
        if (MODE == 0) {
            u32x2* orow = (u32x2*)(hn + (size_t)t * D);
#pragma unroll
            for (int j = 0; j < 8; ++j) { xr[lane + 64 * j] = v[j]; const f32x4 y = v[j] * rstd * g4[j]; u32x2 w; w.x = cvt_pk_bf16(y[0], y[1]); w.y = cvt_pk_bf16(y[2], y[3]); orow[lane + 64 * j] = w; }
        } else {
#pragma unroll
            for (int j = 0; j < 8; ++j) xr[lane + 64 * j] = v[j] * rstd * g4[j];
        }
    }
}

__device__ __forceinline__ void phase_subln(Frame& F, const bf16_t* o1, const bf16_t* o2, const float* lq1, const float* lk1, const float* lq2, const float* lk2, const float* sg, bf16_t* y) {
    const int gw = F.vcu * NWAVES + F.wave, NGW = F.G * NWAVES, lane = F.lane;
    const float d1 = wave_sum(lq1[lane] * lk1[lane] + lq1[lane + 64] * lk1[lane + 64]);
    const float d2 = wave_sum(lq2[lane] * lk2[lane] + lq2[lane + 64] * lk2[lane + 64]);
    const float lam = __expf(d1) - __expf(d2) + LAMBDA_INIT;
    const f32x4 g = ((const f32x4*)sg)[lane] * (1.0f - LAMBDA_INIT);
    for (int tok = gw; tok < T; tok += NGW) {
        u32x2 a[8], b[8];
#pragma unroll
        for (int h = 0; h < 8; ++h) { a[h] = *(const u32x2*)(o1 + (size_t)tok * D + h * 256 + 4 * lane); b[h] = *(const u32x2*)(o2 + (size_t)tok * D + h * 256 + 4 * lane); }
        f32x4 d[8]; float ss[8];
#pragma unroll
        for (int h = 0; h < 8; ++h) { d[h][0] = bf_lo(a[h].x) - lam * bf_lo(b[h].x); d[h][1] = bf_hi(a[h].x) - lam * bf_hi(b[h].x); d[h][2] = bf_lo(a[h].y) - lam * bf_lo(b[h].y); d[h][3] = bf_hi(a[h].y) - lam * bf_hi(b[h].y);
            ss[h] = (d[h][0] * d[h][0] + d[h][1] * d[h][1]) + (d[h][2] * d[h][2] + d[h][3] * d[h][3]); }
#pragma unroll
        for (int of = 1; of < 64; of <<= 1) {
#pragma unroll
            for (int h = 0; h < 8; ++h) ss[h] += __shfl_xor(ss[h], of); }
#pragma unroll
        for (int h = 0; h < 8; ++h) { const float rstd = 1.0f / sqrtf(ss[h] * (1.0f / 256.0f) + RMS_EPS); const f32x4 yv = d[h] * rstd * g;
            u32x2 w; w.x = cvt_pk_bf16(yv[0], yv[1]); w.y = cvt_pk_bf16(yv[2], yv[3]);
            *(u32x2*)(y + (size_t)tok * D + h * 256 + 4 * lane) = w; }
    }
}

namespace att {
constexpr int SHM_K = 64 * 128 * 2, SHM_V = 64 * 256 * 2;
constexpr int V_OFF = 0, K_OFF = 3 * SHM_V, SCR_OFF = RING_BYTES + 4096;
constexpr float SCALE = 0.08838834764831845f;
constexpr float C2 = 1.4426950408889634f * SCALE;
constexpr float THR = 8.f;
#define KSWZ(row, colB) ((row) * 256 + ((colB) ^ (((row) & 7) << 4)))
__device__ __forceinline__ int crow(int r, int hi) { return (r & 3) + 8 * (r >> 2) + 4 * hi; }
__device__ __forceinline__ int v_rd_base(int lane) { return ((lane & 3) << 3) | (((lane >> 2) & 3) << 6) | (((lane >> 4) & 1) << 5) | (((lane >> 5) & 1) << 8); }
constexpr int v_rd_off(int d0, int ks, int half) { return d0 * 512 + ks * 8192 + half * 4096; }

__device__ __forceinline__ void qkt(f32x16& p0, f32x16& p1, const LAS unsigned char* kslot, int r32, int hi, const bf16x8 (&qr)[8]) {
    const LAS unsigned char* kb[4];
#pragma unroll
    for (int dd = 0; dd < 4; ++dd) kb[dd] = kslot + KSWZ(r32, (dd * 16 + hi * 8) * 2);
#pragma unroll
    for (int d0 = 0; d0 < 8; ++d0) { const LAS unsigned char* a = kb[d0 & 3] + (d0 >> 2) * 128;
        const bf16x8 b0 = *(const LAS bf16x8*)a;
        const bf16x8 b1 = *(const LAS bf16x8*)(a + 32 * 256);
        p0 = __builtin_amdgcn_mfma_f32_32x32x16_bf16(b0, qr[d0], p0, 0, 0, 0);
        p1 = __builtin_amdgcn_mfma_f32_32x32x16_bf16(b1, qr[d0], p1, 0, 0, 0); }
}
__device__ __forceinline__ void pv_tile(f32x16 (&o)[8], unsigned vb, const bf16x8 (&pa)[4]) {
#define TRRD(dst, off) asm volatile("ds_read_b64_tr_b16 %0, %1 offset:%2" : "=&v"(dst) : "v"(vb), "i"(off) : "memory")
#define PV_D0(d0) do { s16x4 l0, l1, l2, l3, h0, h1, h2, h3; constexpr int b_ = v_rd_off(d0, 0, 0); \
        TRRD(l0, b_); TRRD(h0, b_ + 4096); TRRD(l1, b_ + 8192); TRRD(h1, b_ + 12288); TRRD(l2, b_ + 16384); TRRD(h2, b_ + 20480); TRRD(l3, b_ + 24576); TRRD(h3, b_ + 28672); \
        asm volatile("s_waitcnt lgkmcnt(0)" ::: "memory"); __builtin_amdgcn_sched_barrier(0); \
        o[d0] = __builtin_amdgcn_mfma_f32_32x32x16_bf16(pa[0], (bf16x8){l0[0], l0[1], l0[2], l0[3], h0[0], h0[1], h0[2], h0[3]}, o[d0], 0, 0, 0); \
        o[d0] = __builtin_amdgcn_mfma_f32_32x32x16_bf16(pa[1], (bf16x8){l1[0], l1[1], l1[2], l1[3], h1[0], h1[1], h1[2], h1[3]}, o[d0], 0, 0, 0); \
        o[d0] = __builtin_amdgcn_mfma_f32_32x32x16_bf16(pa[2], (bf16x8){l2[0], l2[1], l2[2], l2[3], h2[0], h2[1], h2[2], h2[3]}, o[d0], 0, 0, 0); \
        o[d0] = __builtin_amdgcn_mfma_f32_32x32x16_bf16(pa[3], (bf16x8){l3[0], l3[1], l3[2], l3[3], h3[0], h3[1], h3[2], h3[3]}, o[d0], 0, 0, 0); } while (0)
    PV_D0(0); PV_D0(1); PV_D0(2); PV_D0(3); PV_D0(4); PV_D0(5); PV_D0(6); PV_D0(7);
#undef PV_D0
#undef TRRD
}

__device__ __forceinline__ void stage_offsets(int tid, unsigned (&koff)[2], unsigned (&voff)[4]) {
#pragma unroll
    for (int i = 0; i < 2; ++i) { const int P = tid * 16 + i * 8192, row = P >> 8, ch = ((P & 255) >> 4) ^ (row & 7); koff[i] = (unsigned)(row * 128 + ch * 8) * 2u; }
#pragma unroll
    for (int i = 0; i < 4; ++i) { const int P = tid * 16 + i * 8192, st = P >> 9, kk = ((st >> 3) << 3) | ((P & 511) >> 6), cg = st & 7, cin = (P & 63) >> 1;
        const int key = (kk & ~0xC) | ((kk & 4) << 1) | ((kk & 8) >> 1); voff[i] = (unsigned)(key * 256 + cg * 32 + cin) * 2u; }
}
__device__ __forceinline__ const char* uniform_ptr(const void* p) {
    const unsigned long long v = (unsigned long long)p;
    const unsigned lo = __builtin_amdgcn_readfirstlane((unsigned)v), hi = __builtin_amdgcn_readfirstlane((unsigned)(v >> 32));
    return (const char*)(((unsigned long long)hi << 32) | lo);
}
__device__ __forceinline__ void stage_tile(LAS unsigned char* lds, int kslot, int vslot, const bf16_t* kj_, const bf16_t* vj_, int tid_, int wid) {
    const char* kj = uniform_ptr(kj_); const char* vj = uniform_ptr(vj_);
    int tid = tid_; asm volatile("" : "+v"(tid));
    unsigned koff[2], voff[4]; stage_offsets(tid, koff, voff);
    LAS unsigned char* kd = lds + K_OFF + kslot * SHM_K + wid * 1024; LAS unsigned char* vd = lds + V_OFF + vslot * SHM_V + wid * 1024;
#pragma unroll
    for (int i = 0; i < 2; ++i) __builtin_amdgcn_global_load_lds((const unsigned*)(kj + koff[i]), (LAS unsigned*)(kd + i * 8192), 16, 0, 0);
#pragma unroll
    for (int i = 0; i < 4; ++i) __builtin_amdgcn_global_load_lds((const unsigned*)(vj + voff[i]), (LAS unsigned*)(vd + i * 8192), 16, 0, 0);
}

__device__ __forceinline__ void qk_softmax(const LAS unsigned char* kslot, int r32, int hi, LAS float* al_l, const bf16x8 (&qr)[8], f32x16 (&o)[8], bf16x8 (&pa)[4],
                                           float& m_reg, float& l_reg, float rawu, float sl2, bool diag, int qi) {
    f32x16 p0, p1;
#pragma unroll
    for (int r = 0; r < 16; ++r) { p0[r] = 0.f; p1[r] = 0.f; }
    qkt(p0, p1, kslot, r32, hi, qr);
#pragma unroll
    for (int r = 0; r < 16; ++r) { const float cr = (float)((r & 3) + 8 * (r >> 2)); p0[r] = fmaf(cr, rawu, p0[r]); p1[r] = fmaf(cr, rawu, p1[r]); }
    if (diag) {
        const float k2raw = 2.f * rawu;
        int qi_ = qi - 4 * hi; asm volatile("" : "+v"(qi_));
#pragma unroll
        for (int r = 0; r < 16; ++r) { const int c = (r & 3) + 8 * (r >> 2); const int d0_ = c - qi_, d1_ = c + 32 - qi_;
            p0[r] -= k2raw * (float)(d0_ > 0 ? d0_ : 0); p1[r] -= k2raw * (float)(d1_ > 0 ? d1_ : 0); }
    }
    const float lane_raw = rawu * (float)(4 * hi), d32raw = 32.f * rawu;
    float pm0 = p0[0], pm1 = p1[0];
#pragma unroll
    for (int r = 1; r < 16; ++r) { pm0 = fmaxf(pm0, p0[r]); pm1 = fmaxf(pm1, p1[r]); }
    float pmax = fmaxf(pm0, pm1 + d32raw) + lane_raw;
    { auto rr = __builtin_amdgcn_permlane32_swap(__float_as_uint(pmax), __float_as_uint(pmax), false, false);
      pmax = fmaxf(__uint_as_float(rr[0]), __uint_as_float(rr[1])); }
    float mn, alpha;
    if (__all((pmax - m_reg) * SCALE <= THR)) { mn = m_reg; alpha = 1.f; }
    else { mn = fmaxf(m_reg, pmax); alpha = __builtin_amdgcn_exp2f((m_reg - mn) * C2); m_reg = mn; }
    const float mnL0 = (lane_raw - mn) * C2, mnL1 = mnL0 + 32.f * sl2;
#pragma unroll
    for (int r = 0; r < 16; ++r) { p0[r] = __builtin_amdgcn_exp2f(fmaf(p0[r], C2, mnL0)); p1[r] = __builtin_amdgcn_exp2f(fmaf(p1[r], C2, mnL1)); }
    if (__any(alpha < 1.f)) {
        if (hi == 0) al_l[r32] = alpha;
        LDS_WAIT();
#pragma unroll
        for (int r = 0; r < 16; ++r) { const float a = al_l[crow(r, hi)];
#pragma unroll
            for (int d = 0; d < 8; ++d) o[d][r] *= a; }
    }
    float ps = 0.f;
#pragma unroll
    for (int r = 0; r < 16; ++r) ps += p0[r] + p1[r];
    { auto rr = __builtin_amdgcn_permlane32_swap(__float_as_uint(ps), __float_as_uint(ps), false, false);
      ps = __uint_as_float(rr[0]) + __uint_as_float(rr[1]); }
    l_reg = l_reg * alpha + ps;
#define PK4(P, B_, OUT) do { unsigned a0 = cvt_pk_bf16(P[B_+0], P[B_+1]), a1 = cvt_pk_bf16(P[B_+2], P[B_+3]); \
        unsigned b0 = cvt_pk_bf16(P[B_+4], P[B_+5]), b1 = cvt_pk_bf16(P[B_+6], P[B_+7]); \
        auto r0 = __builtin_amdgcn_permlane32_swap(a0, b0, false, false); auto r1 = __builtin_amdgcn_permlane32_swap(a1, b1, false, false); \
        u32x4 w = {r0[0], r1[0], r0[1], r1[1]}; OUT = __builtin_bit_cast(bf16x8, w); } while (0)
    PK4(p0, 0, pa[0]); PK4(p0, 8, pa[1]); PK4(p1, 0, pa[2]); PK4(p1, 8, pa[3]);
#undef PK4
}

__device__ __forceinline__ void norms_phase(Frame& F, const bf16_t* proj, float* nrm) {
    const int gw = F.vcu * NWAVES + F.wave, NGW = F.G * NWAVES, lane = F.lane;
    for (int idx = gw; idx < 2 * 32 * 256; idx += NGW) {
        const int tensor = idx >> 13, stream = (idx >> 8) & 31, grp = idx & 255;
        const u32x4* rp = (const u32x4*)(proj + (tensor ? DK0 : 0) + ((size_t)stream * SEQ + grp * 64 + lane) * 128);
        float ss = 0.f;
#pragma unroll
        for (int q = 0; q < 16; ++q) { const u32x4 v = rp[q];
#pragma unroll
            for (int e = 0; e < 4; ++e) { const float lo = bf_lo(v[e]), hi = bf_hi(v[e]); ss += lo * lo + hi * hi; } }
        float n = sqrtf(ss) * 1.001f;
#pragma unroll
        for (int o = 1; o < 64; o <<= 1) n = fmaxf(n, __shfl_xor(n, o));
        if (lane == 0) nrm[idx] = n;
    }
}

__device__ __forceinline__ void attn_item(LAS unsigned char* lds, const bf16_t* proj, const float* nrm, bf16_t* oout, int b, int h, int sub, int qb, int tid, int wid, int lane) {
    const int r32 = lane & 31, hi = lane >> 5;
    const float slope = __builtin_amdgcn_exp2f(-(float)(h + 1));
    const float sl2 = slope * 1.4426950408889634f, rawu = sl2 / C2;
    LAS float* ws = (LAS float*)(lds + SCR_OFF) + wid * 64; LAS float* li_l = ws; LAS float* al_l = ws + 32;
    const size_t tokq = (size_t)b * SEQ + (size_t)qb * 256 + wid * 32;
    const bf16_t* kbase = proj + DK0 + dq_off(b, 0, h, sub);
    const bf16_t* vbase = proj + dv_off(b, 0, h);
    int j_lo;
    { const int stream = (b * 8 + h) * 2 + sub; const float* qn = nrm + stream * 256; const float* kn = nrm + 8192 + stream * 256;
      const float Qn = fmaxf(fmaxf(qn[4 * qb], qn[4 * qb + 1]), fmaxf(qn[4 * qb + 2], qn[4 * qb + 3]));
      const float Kd = fmaxf(fmaxf(kn[4 * qb], kn[4 * qb + 1]), fmaxf(kn[4 * qb + 2], kn[4 * qb + 3]));
      int cand = 4 * qb;
      for (int jj = lane; jj < 4 * qb; jj += 64) { const float dmin = (float)(256 * qb - (64 * jj + 63)); const bool skip = slope * dmin > 110.f + SCALE * Qn * (kn[jj] + Kd); if (!skip) cand = cand < jj ? cand : jj; }
#pragma unroll
      for (int o = 1; o < 64; o <<= 1) { const int v = __shfl_xor(cand, o); cand = v < cand ? v : cand; }
      j_lo = __builtin_amdgcn_readfirstlane(cand); }
    bf16x8 qr[8];
#pragma unroll
    for (int d0 = 0; d0 < 8; ++d0) qr[d0] = *(const bf16x8*)(proj + dq_off(b, qb * 256 + wid * 32 + r32, h, sub) + d0 * 16 + hi * 8);
    const float sh64 = 64.f * rawu;
    const int qi = 32 * (wid & 1) + r32;
    const unsigned vb0 = (unsigned)(uintptr_t)(lds + V_OFF) + (unsigned)v_rd_base(lane);
    float m_reg = -1e30f, l_reg = 0.f;
    f32x16 o[8];
#pragma unroll
    for (int d = 0; d < 8; ++d)
#pragma unroll
        for (int r = 0; r < 16; ++r) o[d][r] = 0.f;
    const int NT = 4 * qb + 4, myNT = 4 * qb + (wid >> 1) + 1;
    constexpr size_t KSTEP = 64 * 128, VSTEP = 64 * 256;
    const bool late = wid >= 4;
    stage_tile(lds, j_lo & 1, j_lo % 3, kbase + (size_t)j_lo * KSTEP, vbase + (size_t)j_lo * VSTEP, tid, wid);
    VM_WAIT(); WG_BAR();
    if (!late) {
        int vs = j_lo % 3;
        for (int j = j_lo; j < NT; ++j) {
            const int vsn = vs == 2 ? 0 : vs + 1;
            if (j + 1 < NT) stage_tile(lds, (j + 1) & 1, vsn, kbase + (size_t)(j + 1) * KSTEP, vbase + (size_t)(j + 1) * VSTEP, tid, wid);
            if (j < myNT) { if (j > j_lo) m_reg -= sh64;
                bf16x8 pa[4];
                qk_softmax(lds + K_OFF + (j & 1) * SHM_K, r32, hi, al_l, qr, o, pa, m_reg, l_reg, rawu, sl2, j == myNT - 1, qi);
                pv_tile(o, vb0 + (unsigned)(vs * SHM_V), pa); }
            VM_WAIT(); WG_BAR();
            vs = vsn;
        }
    } else {
        bf16x8 pa[4];
        int vs = j_lo % 3, vsp = vs;
        for (int j = j_lo; j < NT; ++j) {
            const int vsn = vs == 2 ? 0 : vs + 1;
            if (j + 1 < NT) stage_tile(lds, (j + 1) & 1, vsn, kbase + (size_t)(j + 1) * KSTEP, vbase + (size_t)(j + 1) * VSTEP, tid, wid);
            if (j > j_lo && j - 1 < myNT) pv_tile(o, vb0 + (unsigned)(vsp * SHM_V), pa);
            if (j < myNT) { if (j > j_lo) m_reg -= sh64;
                qk_softmax(lds + K_OFF + (j & 1) * SHM_K, r32, hi, al_l, qr, o, pa, m_reg, l_reg, rawu, sl2, j == myNT - 1, qi); }
            VM_WAIT(); WG_BAR();
            vsp = vs; vs = vsn;
        }
        if (myNT == NT) pv_tile(o, vb0 + (unsigned)(vsp * SHM_V), pa);
    }
    if (hi == 0) li_l[r32] = l_reg;
    LDS_WAIT();
    char* Ow = (char*)(oout + tokq * D + h * 256);
    const unsigned lofs = (unsigned)(hi * 4 * D + r32) * 2u;
#pragma unroll
    for (int r = 0; r < 16; ++r) { const float rl = __builtin_amdgcn_rcpf(li_l[crow(r, hi)]);
#pragma unroll
        for (int d0 = 0; d0 < 8; ++d0) { const float v = o[d0][r] * rl; const float vn = __shfl_xor(v, 1);
            if ((r32 & 1) == 0) *(unsigned*)(Ow + (lofs + (unsigned)((((r & 3) + 8 * (r >> 2)) * D + d0 * 32) * 2))) = cvt_pk_bf16(v, vn); } }
    WG_BAR();
}

__device__ __forceinline__ void attn_phase(Frame& F, const bf16_t* proj, const float* nrm, unsigned* queue, bf16_t* o1, bf16_t* o2) {
    LAS int* qw = (LAS int*)(F.lds + SCR_OFF + 8 * 256);
    for (;;) {
        if (F.tid == 0) *qw = (int)__hip_atomic_fetch_add(queue, 1u, __ATOMIC_RELAXED, __HIP_MEMORY_SCOPE_AGENT);
        WG_BAR();
        const int I = __builtin_amdgcn_readfirstlane(*qw);
        if (I >= 2048) break;
        const int qb = 63 - (I >> 5), r = I & 31, h = 7 - (r >> 2), b = (r >> 1) & 1, sub = r & 1;
        attn_item(F.lds, proj, nrm, sub ? o2 : o1, b, h, sub, qb, F.tid, F.wave, F.lane);
    }
}
}

__global__ void __launch_bounds__(NWAVES * 64, 2) hybrid_fwd(Args args) {
    extern __shared__ __attribute__((aligned(16))) unsigned char lds_raw[];
    Frame F;
    F.lds = (LAS unsigned char*)lds_raw;
    F.tid = threadIdx.x; F.lane = F.tid & 63; F.wave = __builtin_amdgcn_readfirstlane(F.tid >> 6);
    F.G = gridDim.x; { const int bx = blockIdx.x; F.vcu = (F.G % 8 == 0) ? (bx % 8) * (F.G / 8) + bx / 8 : bx; }
    unsigned char* ws = args.ws;
    unsigned* ctl = (unsigned*)(ws + WS_CTL);
    for (int u = F.tid; u < (LDS_BYTES - LDSCTL_OFF) / 4; u += NWAVES * 64) ((LAS unsigned*)(F.lds + LDSCTL_OFF))[u] = 0u;
    __syncthreads();
    volatile LAS unsigned* MISC = (volatile LAS unsigned*)(F.lds + MISC_OFF);
    XcdBarrier bar = xcd_barrier_post(ctl + CW_BAR, MISC + 8);
#define GRID_BAR() xcd_barrier(bar)
#ifdef ONLY_PHASE
#define PHON(n) ((n) == ONLY_PHASE)
#elif DIAG
#define PHON(n) ((n) <= args.upto)
#else
#define PHON(n) 1
#endif

    const float* x_in = args.in[0]; const float* norm_mix = args.in[1]; const float* norm_ffn = args.in[2];
    const float* gla_w_in = args.in[3]; const float* gla_wgu = args.in[4]; const float* gla_bg = args.in[5]; const float* gla_norm = args.in[6]; const float* gla_w_out = args.in[7];
    const float* diff_w_in = args.in[8]; const float* lq1 = args.in[9]; const float* lk1 = args.in[10]; const float* lq2 = args.in[11]; const float* lk2 = args.in[12];
    const float* diff_subln = args.in[13]; const float* diff_w_out = args.in[14];
    const float* moe_wgrp = args.in[15]; const float* moe_wexp = args.in[16]; const float* moe_wg = args.in[17]; const float* moe_wu = args.in[18]; const float* moe_wd = args.in[19];
    const float* final_norm = args.in[20];
    float* xres = args.out;
    float* gz = (float*)(ws + WS_GZ);
    int* tok_e = (int*)(ws + WS_TOKE); int* tok_p = (int*)(ws + WS_TOKP); float* tok_w = (float*)(ws + WS_TOKW); int* slot_of = (int*)(ws + WS_SLOT);
    float* adec = (float*)(ws + WS_ADEC);
    float* wp_gz = (float*)(ws + WS_WPGZ); float* wp_r0 = (float*)(ws + WS_WPR0); float* wp_r1 = (float*)(ws + WS_WPR1);
    bf16_t* wgi = (bf16_t*)(ws + WS_WGI); bf16_t* wgo = (bf16_t*)(ws + WS_WGO); bf16_t* wdi = (bf16_t*)(ws + WS_WDI); bf16_t* wdo = (bf16_t*)(ws + WS_WDO);
    bf16_t* wmoe_gu = (bf16_t*)(ws + WS_WMOE); bf16_t* wmoe_d = (bf16_t*)(ws + WS_WMOE_D);
    bf16_t* hn = (bf16_t*)(ws + WS_HN); bf16_t* proj = (bf16_t*)(ws + WS_PROJ); bf16_t* buf1 = (bf16_t*)(ws + WS_BUF1); bf16_t* buf2 = (bf16_t*)(ws + WS_BUF2);
    bf16_t* ag = (bf16_t*)(ws + WS_AG); bf16_t* ob = (bf16_t*)(ws + WS_OB); bf16_t* hh = (bf16_t*)(ws + WS_H);
    const LAS int* pst = (const LAS int*)(F.lds + TAB_OFF);

    _Pragma("unroll") for (int rep_ = 0; rep_ < (REP_PHASE == 0 ? 2 : 1); ++rep_) if (PHON(0)) { if (rep_) GRID_BAR(); Frame P = F; P.tid = opq(F.tid); P.lane = P.tid & 63;
    conv_plain(P, gla_w_in, D, PROJW, GLA_INW, wgi);
    conv_plain(P, gla_w_out, D, D, D, wgo);
    conv_plain(P, diff_w_in, D, PROJW, PROJW, wdi);
    conv_plain(P, diff_w_out, D, D, D, wdo);
    pack_proj(P, wp_gz, 1, norm_mix, gla_w_in, GLA_INW, PROJW, 16, nullptr, 0, 0);
    pack_proj(P, wp_r0, 3, norm_ffn, moe_wgrp, 4, 0, 4, moe_wexp, 32, 32);
    pack_proj(P, wp_r1, 3, norm_ffn + D, moe_wgrp + (size_t)D * 4, 4, 0, 4, moe_wexp + (size_t)D * 32, 32, 32);
    }
    GRID_BAR();
    _Pragma("unroll") for (int rep_ = 0; rep_ < (REP_PHASE == 1 ? 2 : 1); ++rep_) if (PHON(1)) { if (rep_) GRID_BAR(); Frame P = F; P.tid = opq(F.tid); P.lane = P.tid & 63;
    phase_norm_gz(P, x_in, norm_mix, wp_gz, hn, gz);
    }
    GRID_BAR();
    _Pragma("unroll") for (int rep_ = 0; rep_ < (REP_PHASE == 2 ? 2 : 1); ++rep_) if (PHON(2)) { if (rep_) GRID_BAR(); Frame P = F; P.tid = opq(F.tid); P.lane = P.tid & 63;
    { pg8::Gemm g{hn, wgi, T, PROJW, D}; pg8::StaticOrder S; S.init(T, PROJW, P.G, (int)blockIdx.x); pg8::EpiHeads<0> E{proj};
      pg8::gemm_phase<pg8::EpiHeads<0>, pg8::StaticOrder>(P.lds, g, S, E); }
    }
    GRID_BAR();
    _Pragma("unroll") for (int rep_ = 0; rep_ < (REP_PHASE == 3 ? 2 : 1); ++rep_) if (PHON(3)) { if (rep_) GRID_BAR(); Frame P = F; P.tid = opq(F.tid); P.lane = P.tid & 63;
    phase_gla_gate(P, gz, gla_wgu, gla_bg, proj, buf1, adec);
    }
    GRID_BAR();
    _Pragma("unroll") for (int rep_ = 0; rep_ < (REP_PHASE == 4 ? 2 : 1); ++rep_) if (PHON(4)) { if (rep_) GRID_BAR(); Frame P = F; P.tid = opq(F.tid); P.lane = P.tid & 63;
    if (P.G == 256) { if ((P.vcu & 3) == 0) phase_gla_scan(P, P.vcu >> 2, proj, buf1, adec, buf2, ctl + CW_PROBE); else conv_moe(P, moe_wg, moe_wu, moe_wd, wmoe_gu, wmoe_d, (P.vcu >> 2) * 3 + (P.vcu & 3) - 1, 192); }
    else { for (int it = P.vcu; it < 64; it += P.G) phase_gla_scan(P, it, proj, buf1, adec, buf2); conv_moe(P, moe_wg, moe_wu, moe_wd, wmoe_gu, wmoe_d); }
    }
    GRID_BAR();
    _Pragma("unroll") for (int rep_ = 0; rep_ < (REP_PHASE == 5 ? 2 : 1); ++rep_) if (PHON(5)) { if (rep_) GRID_BAR(); Frame P = F; P.tid = opq(F.tid); P.lane = P.tid & 63;
    phase_gla_gnorm(P, buf2, proj, gla_norm, hn);
    }
    GRID_BAR();
    _Pragma("unroll") for (int rep_ = 0; rep_ < (REP_PHASE == 6 ? 2 : 1); ++rep_) if (PHON(6)) { if (rep_) GRID_BAR(); Frame P = F; P.tid = opq(F.tid); P.lane = P.tid & 63;
    { pg8::Gemm g{hn, wgo, T, D, D}; pg8::StaticOrder S; S.init(T, D, P.G, (int)blockIdx.x); pg8::EpiResF32 E{x_in, xres, D};
      pg8::gemm_phase<pg8::EpiResF32, pg8::StaticOrder>(P.lds, g, S, E); }
    }
    GRID_BAR();
    _Pragma("unroll") for (int rep_ = 0; rep_ < (REP_PHASE == 7 ? 2 : 1); ++rep_) if (PHON(7)) { if (rep_) GRID_BAR(); Frame P = F; P.tid = opq(F.tid); P.lane = P.tid & 63;
    phase_norm_route(P, xres, norm_ffn, wp_r0, hn, tok_e, tok_p, tok_w, ctl + CW_CNT0);
    }
    GRID_BAR();
    _Pragma("unroll") for (int rep_ = 0; rep_ < (REP_PHASE == 8 ? 2 : 1); ++rep_) if (PHON(8)) { if (rep_) GRID_BAR(); Frame P = F; P.tid = opq(F.tid); P.lane = P.tid & 63;
    moe_tables(P, ctl + CW_CNT0);
    phase_moe_gather(P, tok_e, tok_p, slot_of, hn, ag);
    }
    GRID_BAR();
    _Pragma("unroll") for (int rep_ = 0; rep_ < (REP_PHASE == 9 ? 2 : 1); ++rep_) if (PHON(9)) { if (rep_) GRID_BAR(); Frame P = F; P.tid = opq(F.tid); P.lane = P.tid & 63;
    { const int Mr = pst[33] * 256; pg8::Gemm g{ag, wmoe_gu, Mr, 1024, D}; pg8::MoeOrder S; S.init(Mr, 1024, P.G, (int)blockIdx.x); S.te = pst + 36; S.estride = (size_t)1024 * D * 2; pg8::EpiSiluMul E{hh};
      pg8::gemm_phase<pg8::EpiSiluMul, pg8::MoeOrder>(P.lds, g, S, E); }
    }
    GRID_BAR();
    _Pragma("unroll") for (int rep_ = 0; rep_ < (REP_PHASE == 10 ? 2 : 1); ++rep_) if (PHON(10)) { if (rep_) GRID_BAR(); Frame P = F; P.tid = opq(F.tid); P.lane = P.tid & 63;
    { const int Mr = pst[33] * 256; pg8::Gemm g{hh, wmoe_d, Mr, D, DFF}; pg8::MoeOrder S; S.init(Mr, D, P.G, (int)blockIdx.x); S.te = pst + 36; S.estride = (size_t)D * DFF * 2; pg8::EpiBf16 E{ob, D};
      pg8::gemm_phase<pg8::EpiBf16, pg8::MoeOrder>(P.lds, g, S, E); }
    }
    GRID_BAR();
    _Pragma("unroll") for (int rep_ = 0; rep_ < (REP_PHASE == 11 ? 2 : 1); ++rep_) if (PHON(11)) { if (rep_) GRID_BAR(); Frame P = F; P.tid = opq(F.tid); P.lane = P.tid & 63;
    phase_moe_combine<0>(P, xres, ob, slot_of, tok_w, norm_mix + D, hn);
    conv_moe(P, moe_wg + (size_t)NEXP * D * DFF, moe_wu + (size_t)NEXP * D * DFF, moe_wd + (size_t)NEXP * DFF * D, wmoe_gu, wmoe_d);
    }
    GRID_BAR();
    _Pragma("unroll") for (int rep_ = 0; rep_ < (REP_PHASE == 12 ? 2 : 1); ++rep_) if (PHON(12)) { if (rep_) GRID_BAR(); Frame P = F; P.tid = opq(F.tid); P.lane = P.tid & 63;
    { pg8::Gemm g{hn, wdi, T, PROJW, D}; pg8::StaticOrder S; S.init(T, PROJW, P.G, (int)blockIdx.x); pg8::EpiHeads<1> E{proj};
      pg8::gemm_phase<pg8::EpiHeads<1>, pg8::StaticOrder>(P.lds, g, S, E); }
    GRID_BAR();
    att::norms_phase(P, proj, (float*)(ws + WS_NRM));
    }
    GRID_BAR();
    _Pragma("unroll") for (int rep_ = 0; rep_ < (REP_PHASE == 13 ? 2 : 1); ++rep_) if (PHON(13)) { if (rep_) GRID_BAR(); Frame P = F; P.tid = opq(F.tid); P.lane = P.tid & 63;
    att::attn_phase(P, proj, (const float*)(ws + WS_NRM), ctl + CW_QUEUE, buf1, buf2);
    }
    GRID_BAR();
    _Pragma("unroll") for (int rep_ = 0; rep_ < (REP_PHASE == 14 ? 2 : 1); ++rep_) if (PHON(14)) { if (rep_) GRID_BAR(); Frame P = F; P.tid = opq(F.tid); P.lane = P.tid & 63;
    phase_subln(P, buf1, buf2, lq1, lk1, lq2, lk2, diff_subln, hn);
    }
    GRID_BAR();
    _Pragma("unroll") for (int rep_ = 0; rep_ < (REP_PHASE == 15 ? 2 : 1); ++rep_) if (PHON(15)) { if (rep_) GRID_BAR(); Frame P = F; P.tid = opq(F.tid); P.lane = P.tid & 63;
    { pg8::Gemm g{hn, wdo, T, D, D}; pg8::StaticOrder S; S.init(T, D, P.G, (int)blockIdx.x); pg8::EpiResF32 E{xres, xres, D};
      pg8::gemm_phase<pg8::EpiResF32, pg8::StaticOrder>(P.lds, g, S, E); }
    }
    GRID_BAR();
    _Pragma("unroll") for (int rep_ = 0; rep_ < (REP_PHASE == 16 ? 2 : 1); ++rep_) if (PHON(16)) { if (rep_) GRID_BAR(); Frame P = F; P.tid = opq(F.tid); P.lane = P.tid & 63;
    phase_norm_route(P, xres, norm_ffn + D, wp_r1, hn, tok_e, tok_p, tok_w, ctl + CW_CNT1);
    }
    GRID_BAR();
    _Pragma("unroll") for (int rep_ = 0; rep_ < (REP_PHASE == 17 ? 2 : 1); ++rep_) if (PHON(17)) { if (rep_) GRID_BAR(); Frame P = F; P.tid = opq(F.tid); P.lane = P.tid & 63;
    moe_tables(P, ctl + CW_CNT1);
    phase_moe_gather(P, tok_e, tok_p, slot_of, hn, ag);
    }
    GRID_BAR();
    _Pragma("unroll") for (int rep_ = 0; rep_ < (REP_PHASE == 18 ? 2 : 1); ++rep_) if (PHON(18)) { if (rep_) GRID_BAR(); Frame P = F; P.tid = opq(F.tid); P.lane = P.tid & 63;
    { const int Mr = pst[33] * 256; pg8::Gemm g{ag, wmoe_gu, Mr, 1024, D}; pg8::MoeOrder S; S.init(Mr, 1024, P.G, (int)blockIdx.x); S.te = pst + 36; S.estride = (size_t)1024 * D * 2; pg8::EpiSiluMul E{hh};
      pg8::gemm_phase<pg8::EpiSiluMul, pg8::MoeOrder>(P.lds, g, S, E); }
    }
    GRID_BAR();
    _Pragma("unroll") for (int rep_ = 0; rep_ < (REP_PHASE == 19 ? 2 : 1); ++rep_) if (PHON(19)) { if (rep_) GRID_BAR(); Frame P = F; P.tid = opq(F.tid); P.lane = P.tid & 63;
    { const int Mr = pst[33] * 256; pg8::Gemm g{hh, wmoe_d, Mr, D, DFF}; pg8::MoeOrder S; S.init(Mr, D, P.G, (int)blockIdx.x); S.te = pst + 36; S.estride = (size_t)D * DFF * 2; pg8::EpiBf16 E{ob, D};
      pg8::gemm_phase<pg8::EpiBf16, pg8::MoeOrder>(P.lds, g, S, E); }
    }
    GRID_BAR();
    _Pragma("unroll") for (int rep_ = 0; rep_ < (REP_PHASE == 20 ? 2 : 1); ++rep_) if (PHON(20)) { if (rep_) GRID_BAR(); Frame P = F; P.tid = opq(F.tid); P.lane = P.tid & 63;
    phase_moe_combine<1>(P, xres, ob, slot_of, tok_w, final_norm, hn);
    }
#if PROBE
    { GRID_BAR(); const float c = sqrtf(0.1f * __uint_as_float(xb_ld(ctl + CW_PROBE)));
      for (size_t i = (size_t)blockIdx.x * 512 + F.tid; i < (size_t)T * D; i += (size_t)gridDim.x * 512) xres[i] = c; }
#endif
}

#if DIAG
constexpr size_t WS_DIAG = WS_END;
constexpr int NSAVE = 64;
__device__ inline unsigned hsh(unsigned x) { x ^= x >> 16; x *= 0x7feb352dU; x ^= x >> 15; x *= 0x846ca68bU; x ^= x >> 16; return x; }
__device__ inline void rep(unsigned* w, double got, double ref, double scale) { double e = fabs(got - ref) / (fabs(ref) + scale); float ef = (float)e; if (!(ef == ef) || ef > 1e30f) ef = 1e30f; atomicMax(w, __float_as_uint(ef)); }
__device__ inline double bfd(bf16_t v) { return (double)bf2f(v); }
#define GTID (blockIdx.x * blockDim.x + threadIdx.x)
#define GSTR (gridDim.x * blockDim.x)

__global__ void ck_weights(const float* gla_w_in, const float* gla_w_out, const float* diff_w_in, const float* diff_w_out, const bf16_t* wgi, const bf16_t* wgo, const bf16_t* wdi, const bf16_t* wdo,
                           const float* norm_mix, const float* norm_ffn, const float* wgrp, const float* wexp, const float* wp_gz, const float* wp_r0, const float* wp_r1, unsigned* w) {
    for (unsigned i = GTID; i < 65536u; i += GSTR) { const unsigned r = hsh(i * 3u + 1u), r2 = hsh(i * 7u + 5u);
        const int n = r % 6144u, k = r2 % 2048u, n2 = n % 2048;
        rep(w, bfd(wgi[(size_t)n * D + k]), gla_w_in[(size_t)k * GLA_INW + n], 0.02); rep(w, bfd(wdi[(size_t)n * D + k]), diff_w_in[(size_t)k * PROJW + n], 0.02);
        rep(w, bfd(wgo[(size_t)n2 * D + k]), gla_w_out[(size_t)k * D + n2], 0.02); rep(w, bfd(wdo[(size_t)n2 * D + k]), diff_w_out[(size_t)k * D + n2], 0.02);
        const int s = r % 128u, ln = (r >> 7) % 64u, e4 = (r >> 13) & 3, kk = 16 * s + 4 * (ln >> 4) + e4, col = ln & 15, nt = (r >> 15) % 3u, col3 = 16 * nt + col;
        rep(w, wp_gz[(s * 64 + ln) * 4 + e4], (double)norm_mix[kk] * gla_w_in[(size_t)kk * GLA_INW + PROJW + col], 0.02);
        for (int L = 0; L < 2; ++L) { const float* gr = wgrp + (size_t)L * D * 4; const float* ex = wexp + (size_t)L * D * 32; const float* nf = norm_ffn + L * D;
            const double ref = col3 < 4 ? gr[kk * 4 + col3] : (col3 < 36 ? ex[kk * 32 + col3 - 4] : 0.0);
            rep(w, (L ? wp_r1 : wp_r0)[((s * 3 + nt) * 64 + ln) * 4 + e4], (double)nf[kk] * ref, 0.02); } }
}
__global__ void ck_moew(const float* wg, const float* wu, const float* wd, const bf16_t* GU, const bf16_t* DT, unsigned* w) {
    for (unsigned i = GTID; i < 65536u; i += GSTR) { const unsigned r = hsh(i * 5u + 2u), r2 = hsh(i * 11u + 3u);
        const int e = r % 32u, f = (r >> 5) % 512u, k = r2 % 2048u, n2 = (r2 >> 11) % 2048u, rowg = 256 * (f >> 7) + (f & 127);
        rep(w, bfd(GU[((size_t)e * 1024 + rowg) * D + k]), wg[((size_t)e * D + k) * DFF + f], 0.02); rep(w, bfd(GU[((size_t)e * 1024 + rowg + 128) * D + k]), wu[((size_t)e * D + k) * DFF + f], 0.02);
        rep(w, bfd(DT[((size_t)e * D + n2) * DFF + f]), wd[((size_t)e * DFF + f) * D + n2], 0.05); }
}
__global__ void ck_norm(const float* x, const float* gain, const bf16_t* hn, unsigned* w) {
    for (unsigned i = GTID; i < 4096u; i += GSTR) { const unsigned r = hsh(i * 13u + 7u); const int t = r % (unsigned)T, j = (r >> 15) % 2048u;
        double ss = 0; for (int k = 0; k < D; ++k) { const double v = x[(size_t)t * D + k]; ss += v * v; }
        const double rstd = 1.0 / sqrt(ss / D + 1e-6); rep(w, bfd(hn[(size_t)t * D + j]), x[(size_t)t * D + j] * rstd * gain[j], 1.0); }
}
__global__ void ck_gz(const float* x, const float* gain, const float* gla_w_in, const float* gz, unsigned* w) {
    for (unsigned i = GTID; i < 4096u; i += GSTR) { const unsigned r = hsh(i * 17u + 9u); const int t = r % (unsigned)T, c = (r >> 15) % 16u;
        double ss = 0, dot = 0; for (int k = 0; k < D; ++k) { const double v = x[(size_t)t * D + k]; ss += v * v; dot += v * gain[k] * gla_w_in[(size_t)k * GLA_INW + PROJW + c]; }
        rep(w, gz[(size_t)t * 16 + c], dot / sqrt(ss / D + 1e-6), 1.0); }
}
__global__ void ck_gemm(const bf16_t* A, const bf16_t* Bt, const bf16_t* C, int M, int N, int K, int ldc, double scale, unsigned* w) {
    for (unsigned i = GTID; i < 16384u; i += GSTR) { const unsigned r = hsh(i * 19u + 11u), r2 = hsh(i * 23u + 1u); const int m = r % (unsigned)M, n = r2 % (unsigned)N;
        double s = 0; for (int k = 0; k < K; ++k) s += bfd(A[(size_t)m * K + k]) * bfd(Bt[(size_t)n * K + k]);
        rep(w, bfd(C[(size_t)m * ldc + n]), s, scale); }
}
__global__ void ck_proj(const bf16_t* A, const bf16_t* Bt, const bf16_t* proj, int layer, unsigned* w) {
    for (unsigned i = GTID; i < 16384u; i += GSTR) { const unsigned r = hsh(i * 19u + 11u), r2 = hsh(i * 23u + 1u); const int m = r % (unsigned)T, n = r2 % (unsigned)PROJW, b = m >> 14, t = m & (SEQ - 1);
        double s = 0; for (int k = 0; k < D; ++k) s += bfd(A[(size_t)m * D + k]) * bfd(Bt[(size_t)n * D + k]);
        size_t off;
        if (layer == 0) { if (n < 1024) off = gq_off(b, t, n >> 8) + (n & 255); else if (n < 2048) off = GK0 + gq_off(b, t, (n - 1024) >> 8) + (n & 255); else if (n < 4096) off = gv_off(b, t, (n - 2048) >> 9) + (n & 511); else off = GR0 + (size_t)m * 2048 + (n - 4096); }
        else { if (n < 2048) off = dq_off(b, t, n >> 8, (n >> 7) & 1) + (n & 127); else if (n < 4096) off = DK0 + dq_off(b, t, (n - 2048) >> 8, (n >> 7) & 1) + (n & 127); else off = dv_off(b, t, (n - 4096) >> 8) + (n & 255); }
        rep(w, bfd(proj[off]), s, 1.0); }
}
__device__ inline int srow(int i) { return (int)(hsh(i * 29u + 13u) % (unsigned)T); }
__global__ void ck_save(const float* x, float* save) { for (unsigned i = GTID; i < (unsigned)NSAVE * D; i += GSTR) save[i] = x[(size_t)srow(i / D) * D + (i % D)]; }
__global__ void ck_gemm_res(const bf16_t* A, const bf16_t* Bt, const float* base, int saved, const float* out, unsigned* w) {
    for (unsigned i = GTID; i < (unsigned)NSAVE * 64u; i += GSTR) { const int si = i / 64, t = srow(si), n = hsh(i * 31u + 5u) % 2048u;
        double s = 0; for (int k = 0; k < D; ++k) s += bfd(A[(size_t)t * D + k]) * bfd(Bt[(size_t)n * D + k]);
        const double b = saved ? base[(size_t)si * D + n] : base[(size_t)t * D + n];
        rep(w, out[(size_t)t * D + n], b + s, 1.0); }
}
__global__ void ck_gate(const float* gz, const float* wgu, const float* bg, const bf16_t* proj, const bf16_t* kdT, const float* adec, unsigned* w) {
    for (unsigned i = GTID; i < 4096u; i += GSTR) { const unsigned r = hsh(i * 37u + 3u); const int bc = r % 512u, j = (r >> 9) % 1024u, tq = (r >> 19) % 64u;
        double run = 0, ct = 0;
        for (int t = 0; t < 64; ++t) { double z = bg[j]; for (int q = 0; q < 16; ++q) z += (double)gz[((size_t)bc * 64 + t) * 16 + q] * wgu[q * 1024 + j];
            const double ls = fmin(z, 0.0) - log1p(exp(-fabs(z))); run += ls / 16.0; if (t == tq) ct = run; }
        rep(w, adec[(size_t)bc * 1024 + j], exp(run), 1.0);
        rep(w, bfd(kdT[((size_t)bc * 1024 + j) * 64 + tq]), bfd(proj[GK0 + gq_off(bc >> 8, (bc & 255) * 64 + tq, j >> 8) + (j & 255)]) * exp(run - ct), 1.0); }
}
__global__ void ck_scan(const bf16_t* proj, const bf16_t* kdT, const float* adec, const bf16_t* o, unsigned* w) {
    const int wv = GTID / 64, lane = threadIdx.x & 63, nw = GSTR / 64;
    const int cl[8] = {0, 1, 3, 17, 100, 255, 2, 64};
    for (int s = wv; s < 96; s += nw) { const unsigned r = hsh(s * 41u + 17u); const int b = r & 1, c = cl[s % 8], tl = (r >> 1) % 64u, h = (r >> 7) % 4u, vc = (r >> 9) % 512u;
        float S[4] = {0.f, 0.f, 0.f, 0.f};
        for (int cc = 0; cc <= c; ++cc) { const size_t bc = (size_t)b * NCH + cc;
            for (int q = 0; q < 4; ++q) { const int kr = h * 256 + lane * 4 + q; float a = 0.f;
                for (int t = 0; t < 64; ++t) a += bf2f(kdT[(bc * 1024 + kr) * 64 + t]) * bf2f(proj[gv_off(b, cc * 64 + t, h) + vc]);
                S[q] = adec[bc * 1024 + kr] * S[q] + a; } }
        float part = 0.f; const size_t tok = (size_t)b * SEQ + c * 64 + tl;
        for (int q = 0; q < 4; ++q) part += bf2f(proj[gq_off(b, c * 64 + tl, h) + lane * 4 + q]) * S[q];
        for (int of = 1; of < 64; of <<= 1) part += __shfl_xor(part, of);
        if (lane == 0) rep(w, bfd(o[tok * D + h * 512 + vc]), part / 16.0, 2.0); }
}
__global__ void ck_gnorm(const bf16_t* o, const bf16_t* proj, const float* gn, const bf16_t* y, unsigned* w) {
    for (unsigned i = GTID; i < 8192u; i += GSTR) { const unsigned r = hsh(i * 43u + 19u); const int t = r % (unsigned)T, h = (r >> 15) % 4u, j = (r >> 17) % 512u;
        double ss = 0; for (int k = 0; k < 512; ++k) { const double v = bfd(o[(size_t)t * D + h * 512 + k]); ss += v * v; }
        const double rr = bfd(proj[GR0 + (size_t)t * 2048 + h * 512 + j]);
        rep(w, bfd(y[(size_t)t * D + h * 512 + j]), bfd(o[(size_t)t * D + h * 512 + j]) / sqrt(ss / 512 + 1e-6) * gn[j] * rr / (1.0 + exp(-rr)), 1.0); }
}
__global__ void ck_route(const float* x, const float* gain, const float* wgrp, const float* wexp, const int* tok_e, const int* tok_p, const float* tok_w, const unsigned* cnt, unsigned* w) {
    for (unsigned i = GTID; i < 512u; i += GSTR) { const int t = hsh(i * 47u + 23u) % (unsigned)T;
        double ss = 0; for (int k = 0; k < D; ++k) { const double v = x[(size_t)t * D + k]; ss += v * v; }
        const double rstd = 1.0 / sqrt(ss / D + 1e-6);
        double gl[4] = {0, 0, 0, 0};
        for (int k = 0; k < D; ++k) { const double v = x[(size_t)t * D + k] * rstd * gain[k]; for (int q = 0; q < 4; ++q) gl[q] += v * wgrp[k * 4 + q]; }
        int gi = 0; for (int q = 1; q < 4; ++q) if (gl[q] > gl[gi]) gi = q;
        double gs = 0; for (int q = 0; q < 4; ++q) gs += exp(gl[q] - gl[gi]);
        double el[8] = {0, 0, 0, 0, 0, 0, 0, 0};
        for (int k = 0; k < D; ++k) { const double v = x[(size_t)t * D + k] * rstd * gain[k]; for (int q = 0; q < 8; ++q) el[q] += v * wexp[k * 32 + gi * 8 + q]; }
        int i1 = 0; for (int q = 1; q < 8; ++q) if (el[q] > el[i1]) i1 = q;
        int i2 = (i1 == 0) ? 1 : 0; for (int q = 0; q < 8; ++q) if (q != i1 && el[q] > el[i2]) i2 = q;
        const double eb = exp(el[i2] - el[i1]);
        const int e1 = tok_e[2 * t], e2 = tok_e[2 * t + 1];
        double third = -1e30; for (int q = 0; q < 8; ++q) if (q != i1 && q != i2 && el[q] > third) third = el[q];
        const bool tie = (el[i2] - third) < 1e-4 || (el[i1] - el[i2]) < 1e-4;
        if (!tie) { rep(w, e1, gi * 8 + i1, 1.0); rep(w, e2, gi * 8 + i2, 1.0);
            rep(w, tok_w[2 * t], 1.0 / gs / (1.0 + eb), 0.3); rep(w, tok_w[2 * t + 1], eb / gs / (1.0 + eb), 0.3); }
        if ((unsigned)tok_p[2 * t] >= cnt[64 * (e1 & 31)] || (unsigned)tok_p[2 * t + 1] >= cnt[64 * (e2 & 31)]) rep(w, 9.0, 0.0, 1.0); }
}
__global__ void ck_gather(const int* tok_e, const int* tok_p, const int* slot_of, const unsigned* cnt, const bf16_t* hn, const bf16_t* ag, unsigned* w) {
    for (unsigned i = GTID; i < 8192u; i += GSTR) { const unsigned r = hsh(i * 53u + 29u); const int a = r % (2u * T), k = (r >> 16) % 2048u, e = tok_e[a] & 31;
        int ps = 0; for (int q = 0; q < e; ++q) ps += ((int)cnt[64 * q] + 255) & ~255;
        const int slot = slot_of[a];
        rep(w, slot, ps + tok_p[a], 1.0);
        if (slot >= 0 && slot < MAX_TILES * 256) rep(w, bfd(ag[(size_t)slot * D + k]), bfd(hn[(size_t)(a >> 1) * D + k]), 1.0); }
}
__global__ void ck_moe1(const int* tok_e, const int* slot_of, const bf16_t* ag, const float* wg, const float* wu, const bf16_t* hh, unsigned* w) {
    for (unsigned i = GTID; i < 8192u; i += GSTR) { const unsigned r = hsh(i * 59u + 31u); const int a = r % (2u * T), f = (r >> 16) % 512u, e = tok_e[a] & 31, slot = slot_of[a];
        if (slot < 0 || slot >= MAX_TILES * 256) { rep(w, 9.0, 0.0, 1.0); continue; }
        double g = 0, u = 0; for (int k = 0; k < D; ++k) { const double v = bfd(ag[(size_t)slot * D + k]); g += v * wg[((size_t)e * D + k) * DFF + f]; u += v * wu[((size_t)e * D + k) * DFF + f]; }
        rep(w, bfd(hh[(size_t)slot * DFF + f]), g / (1.0 + exp(-g)) * u, 0.5); }
}
__global__ void ck_moe2(const int* tok_e, const int* slot_of, const bf16_t* hh, const float* wd, const bf16_t* ob, unsigned* w) {
    for (unsigned i = GTID; i < 8192u; i += GSTR) { const unsigned r = hsh(i * 61u + 37u); const int a = r % (2u * T), n = (r >> 16) % 2048u, e = tok_e[a] & 31, slot = slot_of[a];
        if (slot < 0 || slot >= MAX_TILES * 256) { rep(w, 9.0, 0.0, 1.0); continue; }
        double s = 0; for (int f = 0; f < DFF; ++f) s += bfd(hh[(size_t)slot * DFF + f]) * wd[((size_t)e * DFF + f) * D + n];
        rep(w, bfd(ob[(size_t)slot * D + n]), s, 0.3); }
}
__global__ void ck_combine(const float* save, const bf16_t* ob, const int* slot_of, const float* tok_w, const float* gain, const float* x, const bf16_t* hn, int mode, unsigned* w) {
    for (unsigned i = GTID; i < (unsigned)NSAVE * 32u; i += GSTR) { const int si = i / 32, t = srow(si), j = hsh(i * 67u + 41u) % 2048u;
        const int s0 = slot_of[2 * t], s1 = slot_of[2 * t + 1]; const double w0 = tok_w[2 * t], w1 = tok_w[2 * t + 1];
        double ss = 0, xj = 0; for (int k = 0; k < D; ++k) { const double v = save[(size_t)si * D + k] + w0 * bfd(ob[(size_t)s0 * D + k]) + w1 * bfd(ob[(size_t)s1 * D + k]); ss += v * v; if (k == j) xj = v; }
        const double y = xj / sqrt(ss / D + 1e-6) * gain[j];
        if (mode == 0) { rep(w, x[(size_t)t * D + j], xj, 1.0); rep(w, bfd(hn[(size_t)t * D + j]), y, 1.0); } else rep(w, x[(size_t)t * D + j], y, 1.0); }
}
__global__ void ck_attn(const bf16_t* proj, const bf16_t* o1, const bf16_t* o2, unsigned* w) {
    const int wv = GTID / 64, lane = threadIdx.x & 63, nw = GSTR / 64;
    const int tl[12] = {0, 1, 63, 64, 100, 255, 256, 1000, 4095, 8191, 16320, 16383};
    for (int s = wv; s < 96; s += nw) { const unsigned r = hsh(s * 71u + 43u); const int b = r & 1, h = (r >> 1) % 8u, sub = (r >> 4) & 1, t = tl[s % 12], dv0 = (r >> 5) % 253u;
        const double slope = exp2(-(double)(h + 1)); const int kend = 64 * (t / 64 + 1);
        const bf16_t* qp = proj + dq_off(b, t, h, sub);
        double mx = -1e300;
        for (int j = lane; j < kend; j += 64) { const bf16_t* kp = proj + DK0 + dq_off(b, j, h, sub); double d = 0; for (int q = 0; q < 128; ++q) d += bfd(qp[q]) * bfd(kp[q]);
            const double sc = d * 0.08838834764831845 - slope * fabs((double)(t - j)); if (sc > mx) mx = sc; }
        for (int of = 1; of < 64; of <<= 1) { const double o_ = __shfl_xor(mx, of); if (o_ > mx) mx = o_; }
        double l = 0, acc[4] = {0, 0, 0, 0};
        for (int j = lane; j < kend; j += 64) { const bf16_t* kp = proj + DK0 + dq_off(b, j, h, sub); double d = 0; for (int q = 0; q < 128; ++q) d += bfd(qp[q]) * bfd(kp[q]);
            const double p = exp(d * 0.08838834764831845 - slope * fabs((double)(t - j)) - mx); l += p;
            const bf16_t* vp = proj + dv_off(b, j, h) + dv0; for (int q = 0; q < 4; ++q) acc[q] += p * bfd(vp[q]); }
        for (int of = 1; of < 64; of <<= 1) { l += __shfl_xor(l, of); for (int q = 0; q < 4; ++q) acc[q] += __shfl_xor(acc[q], of); }
        if (lane == 0) for (int q = 0; q < 4; ++q) rep(w, bfd((sub ? o2 : o1)[((size_t)b * SEQ + t) * D + h * 256 + dv0 + q]), acc[q] / l, 0.2); }
}
__global__ void ck_subln(const bf16_t* o1, const bf16_t* o2, const float* lq1, const float* lk1, const float* lq2, const float* lk2, const float* sg, const bf16_t* y, unsigned* w) {
    double d1 = 0, d2 = 0; for (int k = 0; k < 128; ++k) { d1 += (double)lq1[k] * lk1[k]; d2 += (double)lq2[k] * lk2[k]; }
    const double li = 0.8 - 0.6 * exp(-0.3), lam = exp(d1) - exp(d2) + li;
    for (unsigned i = GTID; i < 8192u; i += GSTR) { const unsigned r = hsh(i * 73u + 47u); const int t = r % (unsigned)T, h = (r >> 15) % 8u, j = (r >> 18) % 256u;
        double ss = 0, dj = 0; for (int k = 0; k < 256; ++k) { const double v = bfd(o1[(size_t)t * D + h * 256 + k]) - lam * bfd(o2[(size_t)t * D + h * 256 + k]); ss += v * v; if (k == j) dj = v; }
        rep(w, bfd(y[(size_t)t * D + h * 256 + j]), dj / sqrt(ss / 256 + 1e-6) * sg[j] * (1.0 - li), 1.0); }
}
__global__ void ck_final(const unsigned* words, int nst, float* out, int n) {
    int val = 0;
    for (int s = 0; s < nst; ++s) { const float e = __uint_as_float(words[s]); if (e >= 0.03125f) { val = 4 * s + (e < 0.25f ? 1 : (e < 4.f ? 2 : 3)); break; } }
    const float c = sqrtf(0.1f * (float)val);
    for (int i = GTID; i < n; i += GSTR) out[i] = c;
}
#endif

extern "C" void kernel_launch(void* const* d_in, const int* in_sizes, int n_in, void* d_out, int out_size, void* d_ws, size_t ws_size, hipStream_t stream) {
    static int grid = 0;
    if (grid == 0) {
        if (n_in != 21 || out_size != T * D || ws_size < WS_END + 2 * MiB) { fprintf(stderr, "kernel_launch: unexpected shapes (n_in %d out %d ws %zu)\n", n_in, out_size, ws_size); grid = -1; return; }
        if (hipFuncSetAttribute((const void*)hybrid_fwd, hipFuncAttributeMaxDynamicSharedMemorySize, LDS_BYTES) != hipSuccess) { fprintf(stderr, "kernel_launch: hipFuncSetAttribute failed\n"); grid = -1; return; }
        int dev = 0, cus = 0, per_cu = 0;
        (void)hipGetDevice(&dev); (void)hipDeviceGetAttribute(&cus, hipDeviceAttributeMultiprocessorCount, dev);
        if (hipOccupancyMaxActiveBlocksPerMultiprocessor(&per_cu, (const void*)hybrid_fwd, NWAVES * 64, LDS_BYTES) != hipSuccess || per_cu < 1) fprintf(stderr, "kernel_launch: occupancy query says %d\n", per_cu);
        (void)hipGetLastError();
        grid = cus > 0 ? cus : 256;
    }
    if (grid < 0) return;
    Args a{};
    for (int i = 0; i < 21; ++i) a.in[i] = (const float*)d_in[i];
    a.out = (float*)d_out; a.ws = (unsigned char*)d_ws; a.upto = 99; a.pad1 = 0;
#if !DIAG
    (void)hipMemsetAsync((char*)d_ws + WS_CTL, 0, CTL_ZERO_BYTES, stream);
    hipLaunchKernelGGL(hybrid_fwd, dim3(grid), dim3(NWAVES * 64), LDS_BYTES, stream, a);
#else
    {
        unsigned char* ws = (unsigned char*)d_ws; const float* const* in = a.in;
        unsigned* words = (unsigned*)(ws + WS_DIAG); float* save = (float*)(ws + WS_DIAG + 65536);
        (void)hipMemsetAsync(words, 0, 65536, stream);
        float* gz = (float*)(ws + WS_GZ); int* tok_e = (int*)(ws + WS_TOKE); int* tok_p = (int*)(ws + WS_TOKP); float* tok_w = (float*)(ws + WS_TOKW); int* slot_of = (int*)(ws + WS_SLOT);
        float* adec = (float*)(ws + WS_ADEC); float* wp_gz = (float*)(ws + WS_WPGZ); float* wp_r0 = (float*)(ws + WS_WPR0); float* wp_r1 = (float*)(ws + WS_WPR1);
        bf16_t* wgi = (bf16_t*)(ws + WS_WGI); bf16_t* wgo = (bf16_t*)(ws + WS_WGO); bf16_t* wdi = (bf16_t*)(ws + WS_WDI); bf16_t* wdo = (bf16_t*)(ws + WS_WDO);
        bf16_t* gu = (bf16_t*)(ws + WS_WMOE); bf16_t* dt = (bf16_t*)(ws + WS_WMOE_D);
        bf16_t* hn = (bf16_t*)(ws + WS_HN); bf16_t* proj = (bf16_t*)(ws + WS_PROJ); bf16_t* buf1 = (bf16_t*)(ws + WS_BUF1); bf16_t* buf2 = (bf16_t*)(ws + WS_BUF2);
        bf16_t* ag = (bf16_t*)(ws + WS_AG); bf16_t* ob = (bf16_t*)(ws + WS_OB); bf16_t* hh = (bf16_t*)(ws + WS_H);
        unsigned* ctl = (unsigned*)(ws + WS_CTL); float* xres = (float*)d_out;
        const size_t L1W = (size_t)NEXP * D * DFF;
        for (int st = 0; st <= 20; ++st) {
            (void)hipMemsetAsync((char*)d_ws + WS_CTL, 0, CTL_ZERO_BYTES, stream);
            a.upto = st;
            hipLaunchKernelGGL(hybrid_fwd, dim3(grid), dim3(NWAVES * 64), LDS_BYTES, stream, a);
            unsigned* w = words + st;
            switch (st) {
            case 0: ck_weights<<<256, 256, 0, stream>>>(in[3], in[7], in[8], in[14], wgi, wgo, wdi, wdo, in[1], in[2], in[15], in[16], wp_gz, wp_r0, wp_r1, w); break;
            case 1: ck_norm<<<64, 64, 0, stream>>>(in[0], in[1], hn, w); ck_gz<<<64, 64, 0, stream>>>(in[0], in[1], in[3], gz, w); break;
            case 2: ck_proj<<<256, 64, 0, stream>>>(hn, wgi, proj, 0, w); break;
            case 3: ck_gate<<<64, 64, 0, stream>>>(gz, in[4], in[5], proj, buf1, adec, w); break;
            case 4: ck_scan<<<96, 64, 0, stream>>>(proj, buf1, adec, buf2, w); ck_moew<<<256, 256, 0, stream>>>(in[17], in[18], in[19], gu, dt, w); break;
            case 5: ck_gnorm<<<128, 64, 0, stream>>>(buf2, proj, in[6], hn, w); break;
            case 6: ck_gemm_res<<<64, 64, 0, stream>>>(hn, wgo, in[0], 0, xres, w); break;
            case 7: ck_norm<<<64, 64, 0, stream>>>(xres, in[2], hn, w); ck_route<<<8, 64, 0, stream>>>(xres, in[2], in[15], in[16], tok_e, tok_p, tok_w, ctl + CW_CNT0, w); break;
            case 8: ck_gather<<<128, 64, 0, stream>>>(tok_e, tok_p, slot_of, ctl + CW_CNT0, hn, ag, w); break;
            case 9: ck_moe1<<<128, 64, 0, stream>>>(tok_e, slot_of, ag, in[17], in[18], hh, w); break;
            case 10: ck_moe2<<<128, 64, 0, stream>>>(tok_e, slot_of, hh, in[19], ob, w); ck_save<<<64, 256, 0, stream>>>(xres, save); break;
            case 11: ck_combine<<<32, 64, 0, stream>>>(save, ob, slot_of, tok_w, in[1] + D, xres, hn, 0, w); ck_moew<<<256, 256, 0, stream>>>(in[17] + L1W, in[18] + L1W, in[19] + L1W, gu, dt, w); break;
            case 12: ck_proj<<<256, 64, 0, stream>>>(hn, wdi, proj, 1, w); break;
            case 13: ck_attn<<<96, 64, 0, stream>>>(proj, buf1, buf2, w); break;
            case 14: ck_subln<<<128, 64, 0, stream>>>(buf1, buf2, in[9], in[10], in[11], in[12], in[13], hn, w); ck_save<<<64, 256, 0, stream>>>(xres, save); break;
            case 15: ck_gemm_res<<<64, 64, 0, stream>>>(hn, wdo, save, 1, xres, w); break;
            case 16: ck_norm<<<64, 64, 0, stream>>>(xres, in[2] + D, hn, w); ck_route<<<8, 64, 0, stream>>>(xres, in[2] + D, in[15] + (size_t)D * 4, in[16] + (size_t)D * 32, tok_e, tok_p, tok_w, ctl + CW_CNT1, w); break;
            case 17: ck_gather<<<128, 64, 0, stream>>>(tok_e, tok_p, slot_of, ctl + CW_CNT1, hn, ag, w); break;
            case 18: ck_moe1<<<128, 64, 0, stream>>>(tok_e, slot_of, ag, in[17] + L1W, in[18] + L1W, hh, w); break;
            case 19: ck_moe2<<<128, 64, 0, stream>>>(tok_e, slot_of, hh, in[19] + L1W, ob, w); ck_save<<<64, 256, 0, stream>>>(xres, save); break;
            case 20: ck_combine<<<32, 64, 0, stream>>>(save, ob, slot_of, tok_w, in[20], xres, hn, 1, w); break;
            }
        }
        ck_final<<<1024, 256, 0, stream>>>(words, 21, (float*)d_out, out_size);
    }
#endif
}
```

```cpp
#ifndef DIAG
#define DIAG 0
#endif
#ifndef PROBE
#define PROBE 0
#endif
#ifndef REP_PHASE
#define REP_PHASE -1
#endif
#include <hip/hip_runtime.h>
#include <cstdio>
#include <cstdint>

#define LAS __attribute__((address_space(3)))
#define GAS __attribute__((address_space(1)))
typedef unsigned short bf16_t;
typedef short bf16x8 __attribute__((ext_vector_type(8)));
typedef short s16x4 __attribute__((ext_vector_type(4)));
typedef float f32x4 __attribute__((ext_vector_type(4)));
typedef float f32x2 __attribute__((ext_vector_type(2)));
typedef float f32x16 __attribute__((ext_vector_type(16)));
typedef unsigned u32x4 __attribute__((ext_vector_type(4)));
typedef unsigned u32x2 __attribute__((ext_vector_type(2)));

constexpr int D = 2048, SEQ = 16384, NBATCH = 2, T = NBATCH * SEQ, CHUNK = 64, NCH = SEQ / CHUNK;
constexpr int GLA_H = 4, GLA_DK = 256, GLA_DV = 512, GLA_DKT = 1024, GLA_INW = 6160, PROJW = 6144;
constexpr int DIFF_H = 8;
constexpr int NEXP = 32, DFF = 512;
constexpr float RMS_EPS = 1e-6f;
constexpr float LAMBDA_INIT = 0.35550906759f;
constexpr int MAX_TILES = 288;

constexpr size_t MiB = 1u << 20;
constexpr size_t WS_CTL = 0, CTL_ZERO_BYTES = 1 * MiB;
constexpr size_t WS_GZ = 2 * MiB;
constexpr size_t WS_TOKE = 4 * MiB;
constexpr size_t WS_TOKP = WS_TOKE + 256 * 1024;
constexpr size_t WS_TOKW = WS_TOKP + 256 * 1024;
constexpr size_t WS_SLOT = WS_TOKW + 256 * 1024;
constexpr size_t WS_ADEC = 8 * MiB;
constexpr size_t WS_WPGZ = 10 * MiB;
constexpr size_t WS_WPR0 = 10 * MiB + 256 * 1024;
constexpr size_t WS_WPR1 = 11 * MiB;
constexpr size_t WS_NRM = 12 * MiB;
constexpr size_t WS_PCUM = 13 * MiB;
constexpr size_t WS_SFIN = 14 * MiB;
constexpr size_t WS_WGI = 16 * MiB, WS_WGO = 40 * MiB, WS_WDI = 48 * MiB, WS_WDO = 72 * MiB;
constexpr size_t WS_WMOE = 80 * MiB;
constexpr size_t WS_WMOE_D = WS_WMOE + 128 * MiB;
constexpr size_t WS_HN = 272 * MiB;
constexpr size_t WS_PROJ = 400 * MiB;
constexpr size_t WS_BUF1 = 784 * MiB;
constexpr size_t WS_BUF2 = 912 * MiB;
constexpr size_t WS_AG = 400 * MiB;
constexpr size_t WS_OB = 688 * MiB;
constexpr size_t WS_H = 976 * MiB;
constexpr size_t WS_END = 1048 * MiB;
constexpr int CW_BAR = 4096;
constexpr int CW_PROBE = 8320;
constexpr int CW_QUEUE = 8192;
constexpr int CW_CNT0 = 16384, CW_CNT1 = 16384 + 32 * 64;


constexpr size_t GK0 = (size_t)T * 1024, GV0 = (size_t)T * 2048, GR0 = (size_t)T * 4096;
constexpr size_t DK0 = (size_t)T * 2048, DV0 = (size_t)T * 4096;
__host__ __device__ __forceinline__ size_t gq_off(int b, int t, int h) { return ((size_t)(b * 4 + h) * SEQ + t) * 256; }
__host__ __device__ __forceinline__ size_t gv_off(int b, int t, int h) { return GV0 + ((size_t)(b * 4 + h) * SEQ + t) * 512; }
__host__ __device__ __forceinline__ size_t dq_off(int b, int t, int h, int sub) { return ((size_t)((b * 8 + h) * 2 + sub) * SEQ + t) * 128; }
__host__ __device__ __forceinline__ size_t dv_off(int b, int t, int h) { return DV0 + ((size_t)(b * 8 + h) * SEQ + t) * 256; }

constexpr int RING_BYTES = 131072;
constexpr int LDSCTL_OFF = RING_BYTES;
constexpr int MISC_OFF = LDSCTL_OFF + 320;
constexpr int TAB_OFF = LDSCTL_OFF + 1024;
constexpr int LDS_BYTES = 147456;
constexpr int NWAVES = 8;

typedef __bf16 bf16x2_t __attribute__((ext_vector_type(2)));
__device__ __forceinline__ unsigned cvt_pk_bf16(float lo, float hi) { const f32x2 v = {lo, hi}; return __builtin_bit_cast(unsigned, __builtin_convertvector(v, bf16x2_t)); }
__device__ __forceinline__ float bf_lo(unsigned w) { return __uint_as_float(w << 16); }
__device__ __forceinline__ float bf_hi(unsigned w) { return __uint_as_float(w & 0xffff0000u); }
__device__ __forceinline__ float bf2f(bf16_t b) { return __uint_as_float(((unsigned)b) << 16); }
__device__ __forceinline__ float wave_sum(float v) {
#pragma unroll
    for (int o = 1; o < 64; o <<= 1) v += __shfl_xor(v, o);
    return v;
}
__device__ __forceinline__ int opq(int v) { asm volatile("" : "+v"(v)); return v; }
#define LDS_WAIT() asm volatile("s_waitcnt lgkmcnt(0)" ::: "memory")
#define VM_WAIT() asm volatile("s_waitcnt vmcnt(0)" ::: "memory")
#define WG_BAR() do { asm volatile("s_waitcnt lgkmcnt(0)" ::: "memory"); __builtin_amdgcn_s_barrier(); asm volatile("" ::: "memory"); } while (0)

namespace pg8 {
constexpr int BM = 256, BK = 64, HALF = 128, HTB = HALF * BK * 2, STAGE_BYTES = 8 * HTB, NXCD = 8, WGM = 8;
__host__ __device__ __forceinline__ int lds_byte(int r, int c) { const int st = (r >> 4) * 2 + (c >> 5), rr = r & 15, cc = c & 31, ob = rr * 64 + cc * 2; return st * 1024 + (ob ^ (((ob >> 9) & 1) << 5)); }
__host__ __device__ __forceinline__ void stage_rc(int b, int& R, int& C) { const int st = b / 1024, sb = b % 1024, swz = sb ^ (((sb >> 9) & 1) << 5); R = (st >> 1) * 16 + swz / 64; C = (st & 1) * 32 + (swz % 64) / 2; }
__host__ __device__ __forceinline__ int perm32(int rho) { const int n = rho >> 4, i = rho & 15; return 8 * (i >> 2) + 4 * n + (i & 3); }

struct Unit { int pm, pn; };
struct Gemm { const bf16_t* A; const bf16_t* Bt; int M, N, K; };

struct StaticOrder {
    int nM, nN, nwg, G, c;
    __device__ void init(int M, int N, int G_, int c_) { nM = M / BM; nN = N / BM; nwg = nM * nN; G = G_; c = c_; }
    __device__ bool next(int i, Unit& u) const {
        const long L = (long)i * G + c; if (L >= nwg) return false;
        int wgid = (int)L; { const int q = nwg / NXCD, r = nwg % NXCD, xcd = wgid % NXCD, off = wgid / NXCD; wgid = (xcd < r ? xcd * (q + 1) : r * (q + 1) + (xcd - r) * q) + off; }
        const int nig = WGM * nN, gid = wgid / nig, fm = gid * WGM, gsz = (nM - fm) < WGM ? (nM - fm) : WGM;
        u.pm = fm + ((wgid % nig) % gsz); u.pn = (wgid % nig) / gsz; return true;
    }
    __device__ __forceinline__ size_t bofs(const Unit&) const { return 0; }
};
struct MoeOrder : StaticOrder {
    const LAS int* te; size_t estride;
    __device__ __forceinline__ size_t bofs(const Unit& u) const { return (size_t)te[u.pm] * estride; }
};

struct EpiBf16 {
    static constexpr bool PERM = true;
    bf16_t* O; int ldc;
    __device__ __forceinline__ void operator()(const f32x4 (&acc)[2][2][4][2], const Unit& u, int wr, int wc, int fr, int fq) const {
        const int row0 = u.pm * BM + wr * 64 + fr, col0 = u.pn * BM + wc * 32 + 8 * fq;
#pragma unroll
        for (int ai = 0; ai < 2; ++ai)
#pragma unroll
            for (int m = 0; m < 4; ++m) { bf16_t* rowp = O + (size_t)(row0 + ai * HALF + m * 16) * ldc + col0;
#pragma unroll
                for (int bj = 0; bj < 2; ++bj) { const f32x4 v0 = acc[ai][bj][m][0], v1 = acc[ai][bj][m][1];
                    u32x4 w; w.x = cvt_pk_bf16(v0[0], v0[1]); w.y = cvt_pk_bf16(v0[2], v0[3]); w.z = cvt_pk_bf16(v1[0], v1[1]); w.w = cvt_pk_bf16(v1[2], v1[3]);
                    *(u32x4*)(rowp + bj * HALF) = w; } }
    }
};
template <int LAYER> struct EpiHeads {
    static constexpr bool PERM = true;
    bf16_t* O;
    __device__ __forceinline__ void operator()(const f32x4 (&acc)[2][2][4][2], const Unit& u, int wr, int wc, int fr, int fq) const {
        const int pn = u.pn, lc = wc * 32 + 8 * fq;
#pragma unroll
        for (int ai = 0; ai < 2; ++ai)
#pragma unroll
            for (int m = 0; m < 4; ++m) { const int row = u.pm * BM + ai * HALF + wr * 64 + m * 16 + fr, b = row >> 14, t = row & (SEQ - 1);
#pragma unroll
                for (int bj = 0; bj < 2; ++bj) { size_t off;
                    if (LAYER == 0) { if (pn < 4) off = gq_off(b, t, pn) + bj * 128 + lc; else if (pn < 8) off = GK0 + gq_off(b, t, pn - 4) + bj * 128 + lc;
                                      else if (pn < 16) off = gv_off(b, t, (pn - 8) >> 1) + ((pn - 8) & 1) * 256 + bj * 128 + lc; else off = GR0 + (size_t)row * 2048 + (pn - 16) * 256 + bj * 128 + lc; }
                    else { if (pn < 8) off = dq_off(b, t, pn, bj) + lc; else if (pn < 16) off = DK0 + dq_off(b, t, pn - 8, bj) + lc; else off = dv_off(b, t, pn - 16) + bj * 128 + lc; }
                    const f32x4 v0 = acc[ai][bj][m][0], v1 = acc[ai][bj][m][1];
                    u32x4 w; w.x = cvt_pk_bf16(v0[0], v0[1]); w.y = cvt_pk_bf16(v0[2], v0[3]); w.z = cvt_pk_bf16(v1[0], v1[1]); w.w = cvt_pk_bf16(v1[2], v1[3]);
                    *(u32x4*)(O + off) = w; } }
    }
};
struct FixOrder : StaticOrder {
    __device__ __forceinline__ size_t bofs(const Unit& u) const { return (size_t)(u.pm >> 5) * (512 * 256 * 2); }
};
struct EpiAddO {
    static constexpr bool PERM = true;
    bf16_t* O;
    __device__ __forceinline__ void operator()(const f32x4 (&acc)[2][2][4][2], const Unit& u, int wr, int wc, int fr, int fq) const {
#pragma unroll
        for (int ai = 0; ai < 2; ++ai)
#pragma unroll
            for (int m = 0; m < 4; ++m) { const int row = u.pm * BM + ai * HALF + wr * 64 + m * 16 + fr, bhh = row >> 13, t = row & 8191;
                bf16_t* rowp = O + ((size_t)(bhh >> 2) * SEQ + SEQ / 2 + t) * D + (bhh & 3) * 512 + u.pn * BM + wc * 32 + 8 * fq;
#pragma unroll
                for (int bj = 0; bj < 2; ++bj) { const u32x4 old = *(const u32x4*)(rowp + bj * HALF); const f32x4 v0 = acc[ai][bj][m][0] * 0.0625f, v1 = acc[ai][bj][m][1] * 0.0625f;
                    u32x4 w; w.x = cvt_pk_bf16(bf_lo(old.x) + v0[0], bf_hi(old.x) + v0[1]); w.y = cvt_pk_bf16(bf_lo(old.y) + v0[2], bf_hi(old.y) + v0[3]);
                    w.z = cvt_pk_bf16(bf_lo(old.z) + v1[0], bf_hi(old.z) + v1[1]); w.w = cvt_pk_bf16(bf_lo(old.w) + v1[2], bf_hi(old.w) + v1[3]);
                    *(u32x4*)(rowp + bj * HALF) = w; } }
    }
};
struct EpiResF32 {
    static constexpr bool PERM = false;
    const float* base; float* C; int ldc;
    __device__ __forceinline__ void operator()(const f32x4 (&acc)[2][2][4][2], const Unit& u, int wr, int wc, int fr, int fq) const {
        const int row0 = u.pm * BM + wr * 64 + fr, col0 = u.pn * BM + wc * 32 + 4 * fq;
#pragma unroll
        for (int ai = 0; ai < 2; ++ai)
#pragma unroll
            for (int m = 0; m < 4; ++m) { const size_t off = (size_t)(row0 + ai * HALF + m * 16) * ldc + col0;
#pragma unroll
                for (int bj = 0; bj < 2; ++bj)
#pragma unroll
                    for (int n = 0; n < 2; ++n) { const f32x4 bs = *(const f32x4*)(base + off + bj * HALF + n * 16); *(f32x4*)(C + off + bj * HALF + n * 16) = bs + acc[ai][bj][m][n]; }
                asm volatile("" ::: "memory"); }
    }
};
struct EpiSiluMul {
    static constexpr bool PERM = true;
    bf16_t* Hh;
    __device__ __forceinline__ void operator()(const f32x4 (&acc)[2][2][4][2], const Unit& u, int wr, int wc, int fr, int fq) const {
        const int row0 = u.pm * BM + wr * 64 + fr, col0 = u.pn * HALF + wc * 32 + 8 * fq;
#pragma unroll
        for (int ai = 0; ai < 2; ++ai)
#pragma unroll
            for (int m = 0; m < 4; ++m) { bf16_t* rowp = Hh + (size_t)(row0 + ai * HALF + m * 16) * DFF + col0;
                float hv[8];
#pragma unroll
                for (int n = 0; n < 2; ++n)
#pragma unroll
                    for (int j = 0; j < 4; ++j) { const float g = acc[ai][0][m][n][j], up = acc[ai][1][m][n][j];
                        const float sg = g * __builtin_amdgcn_rcpf(1.0f + __builtin_amdgcn_exp2f(-1.4426950408889634f * g)); hv[n * 4 + j] = sg * up; }
                u32x4 w; w.x = cvt_pk_bf16(hv[0], hv[1]); w.y = cvt_pk_bf16(hv[2], hv[3]); w.z = cvt_pk_bf16(hv[4], hv[5]); w.w = cvt_pk_bf16(hv[6], hv[7]);
                *(u32x4*)rowp = w; }
    }
};

template <class Epi, class Sched>
__device__ __forceinline__ void gemm_phase(LAS unsigned char* lds, const Gemm g, const Sched& S, const Epi& E) {
    const int tid = opq((int)threadIdx.x), wid = __builtin_amdgcn_readfirstlane(tid >> 6), lane = tid & 63, wr = wid >> 2, wc = wid & 3, fr = lane & 15, fq = lane >> 4;
    const int K = g.K, nt = K / BK;
    unsigned voffA[2], voffB[2];
#pragma unroll
    for (int i = 0; i < 2; ++i) { int R, C; stage_rc(tid * 16 + i * 8192, R, C); const int Rb = Epi::PERM ? ((R & ~31) + perm32(R & 31)) : R;
        voffA[i] = (unsigned)(R * K + C) * 2u; voffB[i] = (unsigned)(Rb * K + C) * 2u; }
    const size_t kstep = (size_t)(BK * 2);
    const size_t hstep = (size_t)HALF * K * 2;
    const size_t tstep = 2 * hstep;
    const unsigned ldsw = (unsigned)wid * 1024u;
    const int aoff = lds_byte(wr * 64 + fr, fq * 8), boff = lds_byte(wc * 32 + fr, fq * 8);
#define PG8_SA(b, h) (((b) * 2 + (h)) * HTB)
#define PG8_SB(b, h) ((4 + (b) * 2 + (h)) * HTB)
#define PG8_STAGE(bufoff, gbase, voff) do { _Pragma("unroll") for (int _i = 0; _i < 2; ++_i) \
        __builtin_amdgcn_global_load_lds((const unsigned*)((const char*)(gbase) + (voff)[_i]), (LAS unsigned*)(lds + (bufoff) + ldsw + _i * 8192), 16, 0, 0); } while (0)
#define PG8_LDA(dst, b, h) do { _Pragma("unroll") for (int m = 0; m < 4; ++m) _Pragma("unroll") for (int k = 0; k < 2; ++k) dst[m][k] = *(const LAS bf16x8*)(lds + PG8_SA(b, h) + aoff + m * 2048 + k * 1024); } while (0)
#define PG8_LDB(dst, b, h) do { _Pragma("unroll") for (int n = 0; n < 2; ++n) _Pragma("unroll") for (int k = 0; k < 2; ++k) dst[n][k] = *(const LAS bf16x8*)(lds + PG8_SB(b, h) + boff + n * 2048 + k * 1024); } while (0)
#define PG8_MMA(ai, bj, At, Bt) do { __builtin_amdgcn_s_setprio(1); _Pragma("unroll") for (int m = 0; m < 4; ++m) _Pragma("unroll") for (int n = 0; n < 2; ++n) _Pragma("unroll") for (int k = 0; k < 2; ++k) \
        acc[ai][bj][m][n] = __builtin_amdgcn_mfma_f32_16x16x32_bf16(Bt[n][k], At[m][k], acc[ai][bj][m][n], 0, 0, 0); __builtin_amdgcn_s_setprio(0); } while (0)
#define PG8_WAIT_V(n) asm volatile("s_waitcnt vmcnt(" #n ")" ::: "memory")
#define PG8_WAIT_L(n) asm volatile("s_waitcnt lgkmcnt(" #n ")" ::: "memory")
#define PG8_BAR __builtin_amdgcn_s_barrier()
#define PG8_SCHED __builtin_amdgcn_sched_barrier(0)
    Unit cur, nxt; int ui = 0;
    if (!S.next(0, cur)) return;
    f32x4 acc[2][2][4][2];
#pragma unroll
    for (int a = 0; a < 2; ++a)
#pragma unroll
        for (int b = 0; b < 2; ++b)
#pragma unroll
            for (int m = 0; m < 4; ++m)
#pragma unroll
                for (int n = 0; n < 2; ++n) acc[a][b][m][n] = (f32x4){0.f, 0.f, 0.f, 0.f};
    bf16x8 At[4][2], B0[2][2], B1[2][2];
    const char* cA = (const char*)g.A + (size_t)cur.pm * tstep; const char* cB = (const char*)g.Bt + S.bofs(cur) + (size_t)cur.pn * tstep;
    PG8_STAGE(PG8_SB(0, 0), cB, voffB); PG8_STAGE(PG8_SB(0, 1), cB + hstep, voffB); PG8_STAGE(PG8_SA(0, 0), cA, voffA); PG8_STAGE(PG8_SA(0, 1), cA + hstep, voffA);
    if (wr == 1) PG8_BAR;
    PG8_WAIT_V(2); PG8_BAR;
    PG8_STAGE(PG8_SB(1, 0), cB + kstep, voffB); PG8_STAGE(PG8_SA(1, 0), cA + kstep, voffA); PG8_STAGE(PG8_SB(1, 1), cB + hstep + kstep, voffB);
    PG8_WAIT_V(6); PG8_BAR;
    for (;;) {
        const bool has_next = S.next(ui + 1, nxt);
        const char* nA = has_next ? (const char*)g.A + (size_t)nxt.pm * tstep : cA; const char* nB = has_next ? (const char*)g.Bt + S.bofs(nxt) + (size_t)nxt.pn * tstep : cB;
        for (int t = 0; t < nt; t += 2) {
            const bool last = (t == nt - 2);
            const char* a1 = cA + (size_t)(t + 1) * kstep;
            const char* a2 = last ? nA : cA + (size_t)(t + 2) * kstep; const char* b2 = last ? nB : cB + (size_t)(t + 2) * kstep;
            const char* a3 = a2 + kstep; const char* b3 = b2 + kstep;
            PG8_LDB(B0, 0, 0); PG8_LDB(B1, 0, 1); PG8_SCHED; PG8_LDA(At, 0, 0); PG8_STAGE(PG8_SA(1, 1), a1 + hstep, voffA);
            PG8_WAIT_V(8); PG8_WAIT_L(0); PG8_BAR; PG8_MMA(0, 0, At, B0); PG8_MMA(0, 1, At, B1); PG8_BAR; PG8_SCHED;
            PG8_LDA(At, 0, 1); PG8_STAGE(PG8_SB(0, 0), b2, voffB); PG8_STAGE(PG8_SB(0, 1), b2 + hstep, voffB); PG8_STAGE(PG8_SA(0, 0), a2, voffA);
            PG8_WAIT_V(8); PG8_WAIT_L(0); PG8_BAR; PG8_MMA(1, 0, At, B0); PG8_MMA(1, 1, At, B1); PG8_BAR; PG8_SCHED;
            PG8_LDB(B0, 1, 0); PG8_LDB(B1, 1, 1); PG8_SCHED; PG8_LDA(At, 1, 0); PG8_STAGE(PG8_SA(0, 1), a2 + hstep, voffA);
            PG8_WAIT_V(8); PG8_WAIT_L(0); PG8_BAR; PG8_MMA(0, 0, At, B0); PG8_MMA(0, 1, At, B1); PG8_BAR; PG8_SCHED;
            PG8_LDA(At, 1, 1); PG8_STAGE(PG8_SB(1, 0), b3, voffB); PG8_STAGE(PG8_SB(1, 1), b3 + hstep, voffB); PG8_STAGE(PG8_SA(1, 0), a3, voffA);
            PG8_WAIT_V(8); PG8_WAIT_L(0); PG8_BAR; PG8_MMA(1, 0, At, B0); PG8_MMA(1, 1, At, B1); PG8_BAR; PG8_SCHED;
        }
        if (wr == 0) PG8_BAR;
        E(acc, cur, wr, wc, fr, fq);
        if (!has_next) break;
#pragma unroll
        for (int a = 0; a < 2; ++a)
#pragma unroll
            for (int b = 0; b < 2; ++b)
#pragma unroll
                for (int m = 0; m < 4; ++m)
#pragma unroll
                    for (int n = 0; n < 2; ++n) acc[a][b][m][n] = (f32x4){0.f, 0.f, 0.f, 0.f};
        cur = nxt; cA = nA; cB = nB; ++ui;
        if (wr == 1) PG8_BAR;
    }
    PG8_WAIT_V(0);
    PG8_BAR;
#undef PG8_SA
#undef PG8_SB
#undef PG8_STAGE
#undef PG8_LDA
#undef PG8_LDB
#undef PG8_MMA
#undef PG8_WAIT_V
#undef PG8_WAIT_L
#undef PG8_BAR
#undef PG8_SCHED
}
}

#define XB_TMO      128
#define XB_XCNT(j)  (256  + 64 * (j))
#define XB_XSUB(j)  (1280 + 64 * (j))
#define XB_XGEN(j)  (2304 + 64 * (j))
#define XB_TOP      3328
#define XB_TOPGEN   3392
#define XCD_BAR_WORDS 3456
#define XB_SPIN_CAP (1u << 18)
__device__ __forceinline__ unsigned xb_ld(unsigned* p)              { return __hip_atomic_load(p, __ATOMIC_RELAXED, __HIP_MEMORY_SCOPE_AGENT); }
__device__ __forceinline__ unsigned xb_add(unsigned* p, unsigned v) { return __hip_atomic_fetch_add(p, v, __ATOMIC_RELAXED, __HIP_MEMORY_SCOPE_AGENT); }
__device__ __forceinline__ unsigned xb_xcc_id() { return (unsigned)__builtin_amdgcn_s_getreg((3 << 11) | 20) & 0xFu; }
#define XB_SPIN(cond, bar) do { unsigned _sp = 0; while (cond) { __builtin_amdgcn_s_sleep(1); \
    if ((++_sp & 255u) == 0u) { if (xb_ld(&(bar)[XB_TMO])) break; if (_sp > XB_SPIN_CAP) { atomicAdd(&(bar)[XB_TMO], 1u); break; } } } } while (0)
struct XcdBarrier { unsigned* bar; unsigned x; volatile LAS unsigned* st; };
__device__ __forceinline__ XcdBarrier xcd_barrier_post(unsigned* bar, volatile LAS unsigned* st) {
    XcdBarrier b; b.bar = bar; b.x = xb_xcc_id(); b.st = st;
    if (threadIdx.x == 0) (void)xb_add(&bar[XB_XCNT(b.x)], 1u);
    return b;
}
__device__ __forceinline__ void xcd_barrier_complete(unsigned* bar, unsigned x, unsigned& nloc, unsigned& nx) {
    const unsigned G = gridDim.x * gridDim.y * gridDim.z;
    unsigned sum, cnt, mine, sp = 0u;
    for (;;) {
        sum = 0u; cnt = 0u; mine = 0u;
#pragma unroll
        for (unsigned j = 0; j < 16; ++j) { const unsigned c = xb_ld(&bar[XB_XCNT(j)]); sum += c; cnt += (c > 0u) ? 1u : 0u; mine = (j == x) ? c : mine; }
        if (sum == G) break;
        __builtin_amdgcn_s_sleep(1);
        if ((++sp & 255u) == 0u) { if (xb_ld(&bar[XB_TMO])) break; if (sp > XB_SPIN_CAP) { atomicAdd(&bar[XB_TMO], 1u); break; } }
    }
    nloc = mine > 0u ? mine : 1u; nx = cnt > 0u ? cnt : 1u;
}
__device__ __forceinline__ void xcd_barrier(const XcdBarrier& b) {
    asm volatile("s_waitcnt vmcnt(0)" ::: "memory");
    __syncthreads();
    if (threadIdx.x == 0) {
        unsigned* bar = b.bar;
        __builtin_amdgcn_s_waitcnt(0);
        unsigned nloc = b.st[0], nx = b.st[1];
        if (nloc == 0u) { xcd_barrier_complete(bar, b.x, nloc, nx); b.st[0] = nloc; b.st[1] = nx; }
        const unsigned old = xb_add(&bar[XB_XSUB(b.x)], 1u);
        const unsigned gen = old / nloc;
        if (old + 1u == (gen + 1u) * nloc) {
            __builtin_amdgcn_fence(__ATOMIC_RELEASE, "agent");
            asm volatile("s_waitcnt vmcnt(0)" ::: "memory");
            const unsigned og = xb_add(&bar[XB_TOP], 1u);
            const unsigned tg = og / nx;
            if (og + 1u == (tg + 1u) * nx) xb_add(&bar[XB_TOPGEN], 1u);
            else XB_SPIN(xb_ld(&bar[XB_TOPGEN]) == tg, bar);
            __builtin_amdgcn_fence(__ATOMIC_ACQUIRE, "agent");
            xb_add(&bar[XB_XGEN(b.x)], 1u);
            asm volatile("s_waitcnt vmcnt(0)" ::: "memory");
        } else {
            XB_SPIN(xb_ld(&bar[XB_XGEN(b.x)]) == gen, bar);
            __builtin_amdgcn_fence(__ATOMIC_ACQUIRE, "agent");
            asm volatile("s_waitcnt vmcnt(0)" ::: "memory");
        }
    }
    __syncthreads();
}

struct Frame {
    LAS unsigned char* lds;
    int tid, lane, wave, vcu, G;
};
struct Args {
    const float* in[21]; float* out; unsigned char* ws; int upto, pad1;
};

__device__ __forceinline__ void transpose_item(const float* W, int ldw, int k0, int n0, bf16_t* WT, int ldk, int drow0, LAS float* scr, int lane) {
    float tv[32];
    const float* wp_ = W + (size_t)(k0 + (lane >> 5)) * ldw + n0 + (lane & 31);
#pragma unroll
    for (int i = 0; i < 32; ++i) tv[i] = wp_[(size_t)(2 * i) * ldw];
#pragma unroll
    for (int i = 0; i < 32; ++i) scr[(2 * i + (lane >> 5)) * 33 + (lane & 31)] = tv[i];
    LDS_WAIT(); asm volatile("" ::: "memory");
    const int c = lane & 7;
#pragma unroll
    for (int j = 0; j < 4; ++j) { const int n = (lane >> 3) + 8 * j; const LAS float* s = scr + (8 * c) * 33 + n;
        u32x4 o; o.x = cvt_pk_bf16(s[0 * 33], s[1 * 33]); o.y = cvt_pk_bf16(s[2 * 33], s[3 * 33]); o.z = cvt_pk_bf16(s[4 * 33], s[5 * 33]); o.w = cvt_pk_bf16(s[6 * 33], s[7 * 33]);
        *(u32x4*)(WT + (size_t)(drow0 + n) * ldk + k0 + 8 * c) = o; }
    LDS_WAIT(); asm volatile("" ::: "memory");
}
__device__ __forceinline__ void conv_plain(Frame& F, const float* W, int K, int N, int ldw, bf16_t* WT) {
    LAS float* scr = (LAS float*)(F.lds + F.wave * 16384);
    const int gw = F.vcu * NWAVES + F.wave, NGW = F.G * NWAVES, nblk = N / 32, nit = (K / 64) * nblk;
    for (int it = gw; it < nit; it += NGW) { const int kb = it / nblk, nb = it % nblk; transpose_item(W, ldw, 64 * kb, 32 * nb, WT, K, 32 * nb, scr, F.lane); }
}
__device__ __forceinline__ void conv_moe(Frame& F, const float* wg, const float* wu, const float* wd, bf16_t* GU, bf16_t* DT, int rank = -1, int nrank = 0) {
    LAS float* scr = (LAS float*)(F.lds + F.wave * 16384);
    const int gw = (rank < 0 ? F.vcu : rank) * NWAVES + F.wave, NGW = (rank < 0 ? F.G : nrank) * NWAVES;
    constexpr int PER_E = 1536, NIT = NEXP * PER_E;
    for (int it = gw; it < NIT; it += NGW) {
        const int e = it / PER_E; int r = it % PER_E;
        if (r < 1024) { const int up = r >> 9; r &= 511; const int kb = r >> 4, nb = r & 15, n0 = 32 * nb;
            const int drow = 256 * (n0 >> 7) + 128 * up + (n0 & 127);
            transpose_item((up ? wu : wg) + (size_t)e * D * DFF, DFF, 64 * kb, n0, GU + (size_t)e * 1024 * D, D, drow, scr, F.lane); }
        else { r -= 1024; const int kb = r >> 6, nb = r & 63;
            transpose_item(wd + (size_t)e * DFF * D, D, 64 * kb, 32 * nb, DT + (size_t)e * D * DFF, DFF, 32 * nb, scr, F.lane); }
    }
}
__device__ __forceinline__ void pack_proj(Frame& F, float* Wp, int NT, const float* gain, const float* Wa, int lda, int ca0, int na, const float* Wb, int ldb, int nb) {
    const int total = 128 * NT * 256;
    for (int idx = (F.vcu * NWAVES * 64) + F.tid; idx < total; idx += F.G * NWAVES * 64) {
        const int e = idx & 3, ln = (idx >> 2) & 63, rest = idx >> 8, nt = rest % NT, s = rest / NT;
        const int k = 16 * s + 4 * (ln >> 4) + e, col = 16 * nt + (ln & 15);
        float v = 0.f;
        if (col < na) v = Wa[(size_t)k * lda + ca0 + col]; else if (col < na + nb) v = Wb[(size_t)k * ldb + (col - na)];
        Wp[idx] = v * gain[k];
    }
}

template <int NT>
__device__ __forceinline__ float wave_proj16(LAS unsigned char* lds, const float* xin, int tok0, const float* Wp, int tid, int wid, int lane, f32x4 (&acc)[NT]) {
    const int tr = lane & 15, kq = lane >> 4;
    const f32x4* xp = (const f32x4*)(xin + (size_t)(tok0 + tr) * D) + kq;
    constexpr int CH = 16 * NT * 1024;
    const char* wsrc = (const char*)Wp + tid * 16;
    float ssq = 0.f;
#pragma unroll
    for (int n = 0; n < NT; ++n) acc[n] = (f32x4){0.f, 0.f, 0.f, 0.f};
    f32x4 X[16];
#define NP_DMA(c, buf) do { _Pragma("unroll") for (int r = 0; r < 2 * NT; ++r) \
        __builtin_amdgcn_global_load_lds((const unsigned*)(wsrc + (size_t)(c) * CH + r * 8192), (LAS unsigned*)(lds + (buf) * CH + r * 8192 + wid * 1024), 16, 0, 0); } while (0)
#define NP_CHUNK(c, buf, more) do { \
        asm volatile("s_waitcnt vmcnt(16)" ::: "memory"); WG_BAR(); \
        if (more) NP_DMA((c) + 1, 1 - (buf)); \
        asm volatile("" ::: "memory");     \
        const f32x4* xn_ = xp + 64 * ((c) + 1); \
        _Pragma("unroll") for (int s = 0; s < 16; ++s) { const f32x4 xv = X[s]; if (more) X[s] = xn_[4 * s]; \
            ssq += (xv[0] * xv[0] + xv[1] * xv[1]) + (xv[2] * xv[2] + xv[3] * xv[3]); \
            _Pragma("unroll") for (int n = 0; n < NT; ++n) { const f32x4 wv = *(const LAS f32x4*)(lds + (buf) * CH + ((s * NT + n) * 64 + lane) * 16); \
                _Pragma("unroll") for (int e = 0; e < 4; ++e) acc[n] = __builtin_amdgcn_mfma_f32_16x16x4f32(xv[e], wv[e], acc[n], 0, 0, 0); } } } while (0)
    NP_DMA(0, 0);
    asm volatile("" ::: "memory");
#pragma unroll
    for (int s = 0; s < 16; ++s) X[s] = xp[4 * s];
    for (int c = 0; c < 6; c += 2) { NP_CHUNK(c, 0, true); NP_CHUNK(c + 1, 1, true); }
    NP_CHUNK(6, 0, true); NP_CHUNK(7, 1, false);
    WG_BAR();
#undef NP_DMA
#undef NP_CHUNK
    ssq += __shfl_xor(ssq, 16); ssq += __shfl_xor(ssq, 32);
    return 1.0f / sqrtf(ssq * (1.0f / D) + RMS_EPS);
}
__device__ __forceinline__ void wave_write_hn16(const float* xin, int tok0, float rstd, const float* gain, bf16_t* hn, int lane) {
    f32x4 g4[8];
#pragma unroll
    for (int j = 0; j < 8; ++j) g4[j] = ((const f32x4*)gain)[lane + 64 * j];
    for (int i = 0; i < 16; i += 2) {
        const float r0 = __shfl(rstd, i), r1 = __shfl(rstd, i + 1);
        const f32x4* x0 = (const f32x4*)(xin + (size_t)(tok0 + i) * D); const f32x4* x1 = x0 + D / 4;
        u32x2* o0 = (u32x2*)(hn + (size_t)(tok0 + i) * D); u32x2* o1 = o0 + D / 4;
        f32x4 a[8], c[8];
#pragma unroll
        for (int j = 0; j < 8; ++j) { a[j] = x0[lane + 64 * j]; c[j] = x1[lane + 64 * j]; }
#pragma unroll
        for (int j = 0; j < 8; ++j) { const f32x4 v = a[j] * r0 * g4[j], u = c[j] * r1 * g4[j]; u32x2 w; w.x = cvt_pk_bf16(v[0], v[1]); w.y = cvt_pk_bf16(v[2], v[3]); o0[lane + 64 * j] = w;
            u32x2 z; z.x = cvt_pk_bf16(u[0], u[1]); z.y = cvt_pk_bf16(u[2], u[3]); o1[lane + 64 * j] = z; }
    }
}

__device__ __forceinline__ void phase_norm_gz(Frame& F, const float* xin, const float* gain, const float* Wp, bf16_t* hn, float* gz) {
    for (int tile = F.vcu; tile < T / 128; tile += F.G) {
        const int tok0 = tile * 128 + F.wave * 16;
        f32x4 acc[1];
        const float rstd = wave_proj16<1>(F.lds, xin, tok0, Wp, F.tid, F.wave, F.lane, acc);
        const int j = F.lane & 15, q4 = F.lane >> 4;
#pragma unroll
        for (int r = 0; r < 4; ++r) { const float rr = __shfl(rstd, 4 * q4 + r); gz[(size_t)(tok0 + 4 * q4 + r) * 16 + j] = acc[0][r] * rr; }
        wave_write_hn16(xin, tok0, rstd, gain, hn, F.lane);
    }
}
__device__ __forceinline__ void phase_norm_route(Frame& F, const float* xin, const float* gain, const float* Wp, bf16_t* hn, int* tok_e, int* tok_p, float* tok_w, unsigned* cnt) {
    LAS float* lg = (LAS float*)(F.lds + 98304 + F.wave * 3072);
    for (int tile = F.vcu; tile < T / 128; tile += F.G) {
        const int tok0 = tile * 128 + F.wave * 16;
        f32x4 acc[3];
        const float rstd = wave_proj16<3>(F.lds, xin, tok0, Wp, F.tid, F.wave, F.lane, acc);
        const int j = F.lane & 15, q4 = F.lane >> 4;
#pragma unroll
        for (int r = 0; r < 4; ++r) { const float rr = __shfl(rstd, 4 * q4 + r);
#pragma unroll
            for (int n = 0; n < 3; ++n) lg[(4 * q4 + r) * 48 + 16 * n + j] = acc[n][r] * rr; }
        LDS_WAIT(); asm volatile("" ::: "memory");
        if (F.lane < 16) {
            const LAS float* l = lg + F.lane * 48;
            float gm = l[0]; int gi = 0;
#pragma unroll
            for (int q = 1; q < 4; ++q) { const float v = l[q]; if (v > gm) { gm = v; gi = q; } }
            float gs = 0.f;
#pragma unroll
            for (int q = 0; q < 4; ++q) gs += __expf(l[q] - gm);
            const float gw = 1.0f / gs;
            const LAS float* se = l + 4 + 8 * gi;
            float m1 = se[0]; int i1 = 0;
#pragma unroll
            for (int q = 1; q < 8; ++q) { const float v = se[q]; if (v > m1) { m1 = v; i1 = q; } }
            float m2 = -3.0e38f; int i2 = 0;
#pragma unroll
            for (int q = 0; q < 8; ++q) { const float v = se[q]; if (q != i1 && v > m2) { m2 = v; i2 = q; } }
            const float eb = __expf(m2 - m1), inv = 1.0f / (1.0f + eb);
            const int t = tok0 + F.lane, e1 = gi * 8 + i1, e2 = gi * 8 + i2;
            const unsigned p1 = __hip_atomic_fetch_add(cnt + 64 * e1, 1u, __ATOMIC_RELAXED, __HIP_MEMORY_SCOPE_AGENT);
            const unsigned p2 = __hip_atomic_fetch_add(cnt + 64 * e2, 1u, __ATOMIC_RELAXED, __HIP_MEMORY_SCOPE_AGENT);
            tok_e[2 * t] = e1; tok_e[2 * t + 1] = e2; tok_p[2 * t] = (int)p1; tok_p[2 * t + 1] = (int)p2;
            tok_w[2 * t] = gw * inv; tok_w[2 * t + 1] = gw * eb * inv;
        }
        wave_write_hn16(xin, tok0, rstd, gain, hn, F.lane);
        LDS_WAIT(); asm volatile("" ::: "memory");
    }
}

__device__ __forceinline__ void phase_gla_gate(Frame& F, const float* gz, const float* wgu, const float* bgate, const bf16_t* proj, bf16_t* kdT, float* adec) {
    LAS f32x4* gzs = (LAS f32x4*)F.lds;
    for (int u = F.vcu; u < NBATCH * NCH * 2; u += F.G) {
        const int half = u & 1, bc = u >> 1;
        const int tok0 = bc * 64, j = half * 512 + F.tid;
        if (F.tid < 256) gzs[F.tid] = ((const f32x4*)(gz + (size_t)tok0 * 16))[F.tid];
        float wg[16];
#pragma unroll
        for (int r = 0; r < 16; ++r) wg[r] = wgu[r * GLA_DKT + j];
        const float bg = bgate[j];
        WG_BAR();
        float cum[64]; float run = 0.f;
#pragma unroll
        for (int t = 0; t < 64; ++t) {
            float z = bg;
#pragma unroll
            for (int r4 = 0; r4 < 4; ++r4) { const f32x4 g4 = gzs[t * 4 + r4]; z += g4[0] * wg[4 * r4] + g4[1] * wg[4 * r4 + 1] + g4[2] * wg[4 * r4 + 2] + g4[3] * wg[4 * r4 + 3]; }
            const float ls = fminf(z, 0.f) - __logf(1.0f + __expf(-fabsf(z)));
            run += ls * (1.0f / 16.0f); cum[t] = run;
        }
        adec[(size_t)bc * GLA_DKT + j] = __expf(run);
        const bf16_t* kp = proj + GK0 + gq_off(bc >> 8, (bc & 255) * 64, j >> 8) + (j & 255);
        u32x4* dst = (u32x4*)(kdT + ((size_t)bc * GLA_DKT + j) * 64);
#pragma unroll
        for (int t8 = 0; t8 < 8; ++t8) {
            float kd[8];
#pragma unroll
            for (int q = 0; q < 8; ++q) { const int t = t8 * 8 + q; kd[q] = bf2f(kp[(size_t)t * 256]) * __expf(run - cum[t]); }
            u32x4 w; w.x = cvt_pk_bf16(kd[0], kd[1]); w.y = cvt_pk_bf16(kd[2], kd[3]); w.z = cvt_pk_bf16(kd[4], kd[5]); w.w = cvt_pk_bf16(kd[6], kd[7]);
            dst[t8] = w;
        }
        WG_BAR();
    }
}

constexpr int SCAN_VROW = 144, SCAN_SROW = 528, SCAN_VBUF = 64 * SCAN_VROW, SCAN_SBUF = 64 * SCAN_SROW;
__device__ __forceinline__ void phase_gla_scan(Frame& F, int it, const bf16_t* proj, const bf16_t* kdT, const float* adec, bf16_t* oout, bf16_t* sfin, unsigned* probe = nullptr) {
    const int lane = F.lane, w = F.wave, fr = lane & 15, kq = lane >> 4, tid = F.tid;
    LAS unsigned char* vbuf = F.lds;
    LAS unsigned char* sbuf = F.lds + 2 * SCAN_VBUF;
    const int bh = it >> 4, seg = (it >> 3) & 1, b = bh >> 2, h = bh & 3, sl = it & 7, mt = w & 3, ntp = w >> 2, c0 = seg * (NCH / 2);
    const size_t tokb = (size_t)b * SEQ;
    f32x4 st[2][4];
#pragma unroll
    for (int i = 0; i < 2; ++i)
#pragma unroll
        for (int n = 0; n < 4; ++n) st[i][n] = (f32x4){0.f, 0.f, 0.f, 0.f};
    bf16x8 ka0[2][2], ka1[2][2], q0[8], q1[8]; f32x4 dc0[2], dc1[2]; u32x4 vr0, vr1;
#define CL(c) ((c) < NCH ? (c) : NCH - 1)
#define LOAD_KA(KA, DC, c) do { const size_t bc_ = (size_t)b * NCH + CL(c); \
        _Pragma("unroll") for (int i = 0; i < 2; ++i) { \
            _Pragma("unroll") for (int s = 0; s < 2; ++s) KA[i][s] = *(const bf16x8*)(kdT + ((bc_ * GLA_DKT + h * 256 + 32 * w + 16 * i + fr) * 64 + 32 * s + 8 * kq)); \
            DC[i] = *(const f32x4*)(adec + bc_ * GLA_DKT + h * 256 + 32 * w + 16 * i + 4 * kq); } } while (0)
#define LOAD_V(VR, c) do { VR = *(const u32x4*)(proj + gv_off(b, CL(c) * 64 + (tid >> 3), h) + 64 * sl + 8 * (tid & 7)); } while (0)
#define LOAD_Q(Q, c) do { const bf16_t* qp_ = proj + gq_off(b, CL(c) * 64 + 16 * mt + fr, h) + 8 * kq; \
        _Pragma("unroll") for (int s = 0; s < 8; ++s) Q[s] = *(const bf16x8*)(qp_ + 32 * s); } while (0)
#define STORE_V(VR, buf) do { *(LAS u32x4*)(vbuf + (buf) * SCAN_VBUF + (tid >> 3) * SCAN_VROW + (tid & 7) * 16) = VR; } while (0)
#if PROBE
    unsigned long long pacc[3] = {0ull, 0ull, 0ull}; unsigned long long pmark;
#define PMARK(k) do { const unsigned long long n_ = __builtin_amdgcn_s_memtime(); pacc[k] += n_ - pmark; pmark = n_; } while (0)
#define PSTART() do { pmark = __builtin_amdgcn_s_memtime(); } while (0)
#else
#define PMARK(k) do { } while (0)
#define PSTART() do { } while (0)
#endif
#define SCAN_STEP(KA, DC, VN, VM, QC, QN, c) do { \
        PSTART(); \
        const unsigned vb_ = (unsigned)(uintptr_t)(vbuf + ((c) & 1) * SCAN_VBUF) + (unsigned)((8 * kq + ((lane & 15) >> 2)) * SCAN_VROW + 8 * (lane & 3)); \
        s16x4 tv[4][4];     \
        asm volatile("ds_read_b64_tr_b16 %0, %16 offset:0\n\tds_read_b64_tr_b16 %1, %16 offset:576\n\tds_read_b64_tr_b16 %2, %16 offset:4608\n\tds_read_b64_tr_b16 %3, %16 offset:5184\n\t" \
                     "ds_read_b64_tr_b16 %4, %16 offset:32\n\tds_read_b64_tr_b16 %5, %16 offset:608\n\tds_read_b64_tr_b16 %6, %16 offset:4640\n\tds_read_b64_tr_b16 %7, %16 offset:5216\n\t" \
                     "ds_read_b64_tr_b16 %8, %16 offset:64\n\tds_read_b64_tr_b16 %9, %16 offset:640\n\tds_read_b64_tr_b16 %10, %16 offset:4672\n\tds_read_b64_tr_b16 %11, %16 offset:5248\n\t" \
                     "ds_read_b64_tr_b16 %12, %16 offset:96\n\tds_read_b64_tr_b16 %13, %16 offset:672\n\tds_read_b64_tr_b16 %14, %16 offset:4704\n\tds_read_b64_tr_b16 %15, %16 offset:5280\n\ts_waitcnt lgkmcnt(0)" \
                     : "=&v"(tv[0][0]), "=&v"(tv[0][1]), "=&v"(tv[0][2]), "=&v"(tv[0][3]), "=&v"(tv[1][0]), "=&v"(tv[1][1]), "=&v"(tv[1][2]), "=&v"(tv[1][3]), \
                       "=&v"(tv[2][0]), "=&v"(tv[2][1]), "=&v"(tv[2][2]), "=&v"(tv[2][3]), "=&v"(tv[3][0]), "=&v"(tv[3][1]), "=&v"(tv[3][2]), "=&v"(tv[3][3]) : "v"(vb_) : "memory"); \
        _Pragma("unroll") for (int n = 0; n < 4; ++n) { \
            const bf16x8 vf0 = (bf16x8){tv[n][0][0], tv[n][0][1], tv[n][0][2], tv[n][0][3], tv[n][1][0], tv[n][1][1], tv[n][1][2], tv[n][1][3]}; \
            const bf16x8 vf1 = (bf16x8){tv[n][2][0], tv[n][2][1], tv[n][2][2], tv[n][2][3], tv[n][3][0], tv[n][3][1], tv[n][3][2], tv[n][3][3]}; \
            _Pragma("unroll") for (int i = 0; i < 2; ++i) { \
                st[i][n] = st[i][n] * DC[i]; \
                st[i][n] = __builtin_amdgcn_mfma_f32_16x16x32_bf16(KA[i][0], vf0, st[i][n], 0, 0, 0); \
                st[i][n] = __builtin_amdgcn_mfma_f32_16x16x32_bf16(KA[i][1], vf1, st[i][n], 0, 0, 0); } } \
        LOAD_KA(KA, DC, (c) + 2); \
        PMARK(0); \
        { LAS unsigned char* sb_ = sbuf + ((c) & 1) * SCAN_SBUF + fr * SCAN_SROW + (32 * w + 4 * kq) * 2; \
          _Pragma("unroll") for (int i = 0; i < 2; ++i) _Pragma("unroll") for (int n = 0; n < 4; ++n) { \
              u32x2 pk; pk.x = cvt_pk_bf16(st[i][n][0], st[i][n][1]); pk.y = cvt_pk_bf16(st[i][n][2], st[i][n][3]); \
              *(LAS u32x2*)(sb_ + n * 16 * SCAN_SROW + i * 32) = pk; } } \
        STORE_V(VN, ((c) + 1) & 1); \
        LOAD_V(VN, (c) + 3); \
        WG_BAR(); \
        PMARK(1); \
        { f32x4 a0 = (f32x4){0.f, 0.f, 0.f, 0.f}, a1 = a0; \
          const LAS unsigned char* sr_ = sbuf + ((c) & 1) * SCAN_SBUF + (32 * ntp + fr) * SCAN_SROW + 16 * kq; \
          _Pragma("unroll") for (int hb = 0; hb < 2; ++hb) { bf16x8 bb[4][2];     \
              _Pragma("unroll") for (int s = 0; s < 4; ++s) { bb[s][0] = *(const LAS bf16x8*)(sr_ + 64 * (4 * hb + s)); bb[s][1] = *(const LAS bf16x8*)(sr_ + 16 * SCAN_SROW + 64 * (4 * hb + s)); } \
              asm volatile("s_waitcnt lgkmcnt(0)" ::: "memory"); __builtin_amdgcn_sched_barrier(0); \
              _Pragma("unroll") for (int s = 0; s < 4; ++s) { \
                  a0 = __builtin_amdgcn_mfma_f32_16x16x32_bf16(QC[4 * hb + s], bb[s][0], a0, 0, 0, 0); \
                  a1 = __builtin_amdgcn_mfma_f32_16x16x32_bf16(QC[4 * hb + s], bb[s][1], a1, 0, 0, 0); } } \
          bf16_t* op_ = oout + (tokb + (size_t)(c) * 64 + 16 * mt + 4 * kq) * D + h * 512 + 64 * sl + 32 * ntp + fr; \
          _Pragma("unroll") for (int r = 0; r < 4; ++r) { \
              const float x0 = a0[r] * 0.0625f, x1 = a1[r] * 0.0625f, y0 = __shfl_xor(x0, 1), y1 = __shfl_xor(x1, 1); \
              if ((fr & 1) == 0) { *(unsigned*)(op_ + (size_t)r * D) = cvt_pk_bf16(x0, y0); *(unsigned*)(op_ + (size_t)r * D + 16) = cvt_pk_bf16(x1, y1); } } } \
        LOAD_Q(QC, (c) + 2); \
        PMARK(2); \
    } while (0)
    LOAD_KA(ka0, dc0, c0); LOAD_KA(ka1, dc1, c0 + 1); LOAD_V(vr0, c0); LOAD_V(vr1, c0 + 1); LOAD_Q(q0, c0); LOAD_Q(q1, c0 + 1);
    STORE_V(vr0, 0); LOAD_V(vr0, c0 + 2);
    WG_BAR();
#if PROBE
    const unsigned long long pt0 = __builtin_amdgcn_s_memtime(), pr0 = __builtin_amdgcn_s_memrealtime();
#endif
    for (int c = c0; c < c0 + NCH / 2; c += 2) {
        SCAN_STEP(ka0, dc0, vr1, vr0, q0, q1, c);
        SCAN_STEP(ka1, dc1, vr0, vr1, q1, q0, c + 1);
    }
    if (seg == 0) {
#pragma unroll
        for (int i = 0; i < 2; ++i)
#pragma unroll
            for (int n = 0; n < 4; ++n) { u32x2 pk; pk.x = cvt_pk_bf16(st[i][n][0], st[i][n][1]); pk.y = cvt_pk_bf16(st[i][n][2], st[i][n][3]);
                *(u32x2*)(sfin + ((size_t)(bh * 512 + 64 * sl + 16 * n + fr)) * 256 + 32 * w + 16 * i + 4 * kq) = pk; }
    }
    WG_BAR();
#if PROBE
    if (probe && it == 0 && tid == 0) { const unsigned long long dt = __builtin_amdgcn_s_memtime() - pt0, dr = __builtin_amdgcn_s_memrealtime() - pr0;
        const float val = floorf(2.f * log2f((PROBE == 1) ? (float)dt / 256.f : (PROBE == 2) ? (float)dr * 10.f / 256.f : (float)pacc[PROBE - 3] / 256.f));
        __hip_atomic_store(probe, __float_as_uint(val), __ATOMIC_RELAXED, __HIP_MEMORY_SCOPE_AGENT); }
#endif
#undef CL
#undef LOAD_KA
#undef LOAD_V
#undef LOAD_Q
#undef STORE_V
#undef SCAN_STEP
}

__device__ __forceinline__ void gla_pcum(Frame& F, const float* adec, float* pcum, int rank, int nrank) {
    for (int idx = rank * (NWAVES * 64) + F.tid; idx < NBATCH * GLA_DKT; idx += nrank * NWAVES * 64) { const int b = idx >> 10, j = idx & 1023;
        const float* ap = adec + ((size_t)(b * NCH + NCH / 2)) * GLA_DKT + j; float* pp = pcum + (size_t)(b * (NCH / 2)) * GLA_DKT + j; float pr = 1.f;
#pragma unroll 16
        for (int cc = 0; cc < NCH / 2; ++cc) { pr *= ap[(size_t)cc * GLA_DKT]; pp[(size_t)cc * GLA_DKT] = pr; } }
}
__device__ __forceinline__ void phase_gla_qp(Frame& F, const bf16_t* proj, const float* pcum, bf16_t* qp) {
    const int gw = F.vcu * NWAVES + F.wave, NGW = F.G * NWAVES, lane = F.lane;
    for (int r = gw; r < NBATCH * (SEQ / 2); r += NGW) { const int b = r >> 13, t = r & 8191;
        u32x2 qv[4]; f32x4 pv[4];
#pragma unroll
        for (int h = 0; h < 4; ++h) { qv[h] = *(const u32x2*)(proj + gq_off(b, SEQ / 2 + t, h) + 4 * lane); pv[h] = *(const f32x4*)(pcum + ((size_t)(b * (NCH / 2) + (t >> 6)) * GLA_DKT + h * 256 + 4 * lane)); }
#pragma unroll
        for (int h = 0; h < 4; ++h) { u32x2 w; w.x = cvt_pk_bf16(bf_lo(qv[h].x) * pv[h][0], bf_hi(qv[h].x) * pv[h][1]); w.y = cvt_pk_bf16(bf_lo(qv[h].y) * pv[h][2], bf_hi(qv[h].y) * pv[h][3]);
            *(u32x2*)(qp + ((size_t)((b * 4 + h) * (SEQ / 2) + t)) * 256 + 4 * lane) = w; }
    }
}
__device__ __forceinline__ void phase_gla_gnorm(Frame& F, const bf16_t* o, const bf16_t* proj, const float* gn, bf16_t* y) {
    const int gw = F.vcu * NWAVES + F.wave, NGW = F.G * NWAVES, lane = F.lane;
    const f32x4 g0 = ((const f32x4*)gn)[2 * lane], g1 = ((const f32x4*)gn)[2 * lane + 1];
    for (int tok = gw; tok < T; tok += NGW) {
        u32x4 ov[4], rv[4];
#pragma unroll
        for (int h = 0; h < 4; ++h) { ov[h] = *(const u32x4*)(o + (size_t)tok * D + h * 512 + 8 * lane); rv[h] = *(const u32x4*)(proj + GR0 + (size_t)tok * 2048 + h * 512 + 8 * lane); }
        float ss[4];
#pragma unroll
        for (int h = 0; h < 4; ++h) { float s = 0.f;
#pragma unroll
            for (int q = 0; q < 4; ++q) { const float lo = bf_lo(ov[h][q]), hi = bf_hi(ov[h][q]); s += lo * lo + hi * hi; }
            ss[h] = s; }
#pragma unroll
        for (int of = 1; of < 64; of <<= 1) {
#pragma unroll
            for (int h = 0; h < 4; ++h) ss[h] += __shfl_xor(ss[h], of); }
#pragma unroll
        for (int h = 0; h < 4; ++h) { const float rstd = 1.0f / sqrtf(ss[h] * (1.0f / 512.0f) + RMS_EPS);
            float yv[8];
#pragma unroll
            for (int q = 0; q < 4; ++q) { const float a0 = bf_lo(ov[h][q]), a1 = bf_hi(ov[h][q]), r0 = bf_lo(rv[h][q]), r1 = bf_hi(rv[h][q]);
                const float gA = q < 2 ? g0[2 * q] : g1[2 * q - 4], gB = q < 2 ? g0[2 * q + 1] : g1[2 * q - 3];
                yv[2 * q] = a0 * rstd * gA * (r0 / (1.0f + __expf(-r0))); yv[2 * q + 1] = a1 * rstd * gB * (r1 / (1.0f + __expf(-r1))); }
            u32x4 w; w.x = cvt_pk_bf16(yv[0], yv[1]); w.y = cvt_pk_bf16(yv[2], yv[3]); w.z = cvt_pk_bf16(yv[4], yv[5]); w.w = cvt_pk_bf16(yv[6], yv[7]);
            *(u32x4*)(y + (size_t)tok * D + h * 512 + 8 * lane) = w; }
    }
}

__device__ __forceinline__ void moe_tables(Frame& F, unsigned* cnt) {
    LAS int* pst = (LAS int*)(F.lds + TAB_OFF);
    LAS int* te = pst + 36;
    if (F.wave == 0) {
        const int e = F.lane & 31;
        const int c = (int)xb_ld(cnt + 64 * e);
        const int ntile = (c + 255) >> 8;
        int incl = ntile;
#pragma unroll
        for (int o = 1; o < 32; o <<= 1) { const int v = __shfl_up(incl, o); if ((F.lane & 31) >= o) incl += v; }
        const int excl = incl - ntile;
        if (F.lane < 32) { pst[e] = excl << 8; for (int q = 0; q < ntile; ++q) te[excl + q] = e; }
        if (F.lane == 31) { pst[32] = incl << 8; pst[33] = incl; }
    }
    WG_BAR();
}
__device__ __forceinline__ void phase_moe_gather(Frame& F, const int* tok_e, const int* tok_p, int* slot_of, const bf16_t* hn, bf16_t* ag) {
    const LAS int* pst = (const LAS int*)(F.lds + TAB_OFF);
    const int gw = F.vcu * NWAVES + F.wave, NGW = F.G * NWAVES, lane = F.lane;
    for (int t = gw; t < T; t += 2 * NGW) {
        const int t2 = t + NGW < T ? t + NGW : t;
        const int s0 = pst[tok_e[2 * t]] + tok_p[2 * t], s1 = pst[tok_e[2 * t + 1]] + tok_p[2 * t + 1], s2 = pst[tok_e[2 * t2]] + tok_p[2 * t2], s3 = pst[tok_e[2 * t2 + 1]] + tok_p[2 * t2 + 1];
        if (lane == 0) { slot_of[2 * t] = s0; slot_of[2 * t + 1] = s1; slot_of[2 * t2] = s2; slot_of[2 * t2 + 1] = s3; }
        const u32x4* srcA = (const u32x4*)(hn + (size_t)t * D); const u32x4* srcB = (const u32x4*)(hn + (size_t)t2 * D);
        u32x4 va[4], vb[4];
#pragma unroll
        for (int j = 0; j < 4; ++j) { va[j] = srcA[lane + 64 * j]; vb[j] = srcB[lane + 64 * j]; }
#pragma unroll
        for (int j = 0; j < 4; ++j) { ((u32x4*)(ag + (size_t)s0 * D))[lane + 64 * j] = va[j]; ((u32x4*)(ag + (size_t)s1 * D))[lane + 64 * j] = va[j];
                                      ((u32x4*)(ag + (size_t)s2 * D))[lane + 64 * j] = vb[j]; ((u32x4*)(ag + (size_t)s3 * D))[lane + 64 * j] = vb[j]; }
    }
}
template <int MODE>
__device__ __forceinline__ void phase_moe_combine(Frame& F, float* x, const bf16_t* ob, const int* slot_of, const float* tok_w, const float* gain, bf16_t* hn) {
    const int gw = F.vcu * NWAVES + F.wave, NGW = F.G * NWAVES, lane = F.lane;
    f32x4 g4[8];
#pragma unroll
    for (int j = 0; j < 8; ++j) g4[j] = ((const f32x4*)gain)[lane + 64 * j];
    for (int t = gw; t < T; t += NGW) {
        const int s0 = slot_of[2 * t], s1 = slot_of[2 * t + 1]; const float w0 = tok_w[2 * t], w1 = tok_w[2 * t + 1];
        f32x4* xr = (f32x4*)(x + (size_t)t * D);
        const u32x2* a = (const u32x2*)(ob + (size_t)s0 * D); const u32x2* b = (const u32x2*)(ob + (size_t)s1 * D);
        f32x4 v[8]; float ss = 0.f;
#pragma unroll
        for (int j = 0; j < 8; ++j) { const u32x2 av = a[lane + 64 * j], bv = b[lane + 64 * j]; f32x4 xv = xr[lane + 64 * j];
            xv[0] += w0 * bf_lo(av.x) + w1 * bf_lo(bv.x); xv[1] += w0 * bf_hi(av.x) + w1 * bf_hi(bv.x);
            xv[2] += w0 * bf_lo(av.y) + w1 * bf_lo(bv.y); xv[3] += w0 * bf_hi(av.y) + w1 * bf_hi(bv.y);
            v[j] = xv; ss += (xv[0] * xv[0] + xv[1] * xv[1]) + (xv[2] * xv[2] + xv[3] * xv[3]); }
        const float rstd = 1.0f / sqrtf(wave_sum(ss) * (1.0f / D) + RMS_EPS);
        if (MODE == 0) {
            u32x2* orow = (u32x2*)(hn + (size_t)t * D);
#pragma unroll
            for (int j = 0; j < 8; ++j) { xr[lane + 64 * j] = v[j]; const f32x4 y = v[j] * rstd * g4[j]; u32x2 w; w.x = cvt_pk_bf16(y[0], y[1]); w.y = cvt_pk_bf16(y[2], y[3]); orow[lane + 64 * j] = w; }
        } else {
#pragma unroll
            for (int j = 0; j < 8; ++j) xr[lane + 64 * j] = v[j] * rstd * g4[j];
        }
    }
}

__device__ __forceinline__ void phase_subln(Frame& F, const bf16_t* o1, const bf16_t* o2, const float* lq1, const float* lk1, const float* lq2, const float* lk2, const float* sg, bf16_t* y) {
    const int gw = F.vcu * NWAVES + F.wave, NGW = F.G * NWAVES, lane = F.lane;
    const float d1 = wave_sum(lq1[lane] * lk1[lane] + lq1[lane + 64] * lk1[lane + 64]);
    const float d2 = wave_sum(lq2[lane] * lk2[lane] + lq2[lane + 64] * lk2[lane + 64]);
    const float lam = __expf(d1) - __expf(d2) + LAMBDA_INIT;
    const f32x4 g = ((const f32x4*)sg)[lane] * (1.0f - LAMBDA_INIT);
    for (int tok = gw; tok < T; tok += NGW) {
        u32x2 a[8], b[8];
#pragma unroll
        for (int h = 0; h < 8; ++h) { a[h] = *(const u32x2*)(o1 + (size_t)tok * D + h * 256 + 4 * lane); b[h] = *(const u32x2*)(o2 + (size_t)tok * D + h * 256 + 4 * lane); }
        f32x4 d[8]; float ss[8];
#pragma unroll
        for (int h = 0; h < 8; ++h) { d[h][0] = bf_lo(a[h].x) - lam * bf_lo(b[h].x); d[h][1] = bf_hi(a[h].x) - lam * bf_hi(b[h].x); d[h][2] = bf_lo(a[h].y) - lam * bf_lo(b[h].y); d[h][3] = bf_hi(a[h].y) - lam * bf_hi(b[h].y);
            ss[h] = (d[h][0] * d[h][0] + d[h][1] * d[h][1]) + (d[h][2] * d[h][2] + d[h][3] * d[h][3]); }
#pragma unroll
        for (int of = 1; of < 64; of <<= 1) {
#pragma unroll
            for (int h = 0; h < 8; ++h) ss[h] += __shfl_xor(ss[h], of); }
#pragma unroll
        for (int h = 0; h < 8; ++h) { const float rstd = 1.0f / sqrtf(ss[h] * (1.0f / 256.0f) + RMS_EPS); const f32x4 yv = d[h] * rstd * g;
            u32x2 w; w.x = cvt_pk_bf16(yv[0], yv[1]); w.y = cvt_pk_bf16(yv[2], yv[3]);
            *(u32x2*)(y + (size_t)tok * D + h * 256 + 4 * lane) = w; }
    }
}

namespace att {
constexpr int SHM_K = 64 * 128 * 2, SHM_V = 64 * 256 * 2;
constexpr int V_OFF = 0, K_OFF = 3 * SHM_V, SCR_OFF = RING_BYTES + 4096;
constexpr float SCALE = 0.08838834764831845f;
constexpr float C2 = 1.4426950408889634f * SCALE;
constexpr float THR = 8.f;
#define KSWZ(row, colB) ((row) * 256 + ((colB) ^ (((row) & 7) << 4)))
__device__ __forceinline__ int crow(int r, int hi) { return (r & 3) + 8 * (r >> 2) + 4 * hi; }
__device__ __forceinline__ int v_rd_base(int lane) { return ((lane & 3) << 3) | (((lane >> 2) & 3) << 6) | (((lane >> 4) & 1) << 5) | (((lane >> 5) & 1) << 8); }
constexpr int v_rd_off(int d0, int ks, int half) { return d0 * 512 + ks * 8192 + half * 4096; }

__device__ __forceinline__ void qkt(f32x16& p0, f32x16& p1, const LAS unsigned char* kslot, int r32, int hi, const bf16x8 (&qr)[8]) {
    const LAS unsigned char* kb[4];
#pragma unroll
    for (int dd = 0; dd < 4; ++dd) kb[dd] = kslot + KSWZ(r32, (dd * 16 + hi * 8) * 2);
#pragma unroll
    for (int d0 = 0; d0 < 8; ++d0) { const LAS unsigned char* a = kb[d0 & 3] + (d0 >> 2) * 128;
        const bf16x8 b0 = *(const LAS bf16x8*)a;
        const bf16x8 b1 = *(const LAS bf16x8*)(a + 32 * 256);
        p0 = __builtin_amdgcn_mfma_f32_32x32x16_bf16(b0, qr[d0], p0, 0, 0, 0);
        p1 = __builtin_amdgcn_mfma_f32_32x32x16_bf16(b1, qr[d0], p1, 0, 0, 0); }
}
__device__ __forceinline__ void pv_tile(f32x16 (&o)[8], unsigned vb, const bf16x8 (&pa)[4]) {
#define TRRD(dst, off) asm volatile("ds_read_b64_tr_b16 %0, %1 offset:%2" : "=&v"(dst) : "v"(vb), "i"(off) : "memory")
#define PV_D0(d0) do { s16x4 l0, l1, l2, l3, h0, h1, h2, h3; constexpr int b_ = v_rd_off(d0, 0, 0); \
        TRRD(l0, b_); TRRD(h0, b_ + 4096); TRRD(l1, b_ + 8192); TRRD(h1, b_ + 12288); TRRD(l2, b_ + 16384); TRRD(h2, b_ + 20480); TRRD(l3, b_ + 24576); TRRD(h3, b_ + 28672); \
        asm volatile("s_waitcnt lgkmcnt(0)" ::: "memory"); __builtin_amdgcn_sched_barrier(0); \
        o[d0] = __builtin_amdgcn_mfma_f32_32x32x16_bf16(pa[0], (bf16x8){l0[0], l0[1], l0[2], l0[3], h0[0], h0[1], h0[2], h0[3]}, o[d0], 0, 0, 0); \
        o[d0] = __builtin_amdgcn_mfma_f32_32x32x16_bf16(pa[1], (bf16x8){l1[0], l1[1], l1[2], l1[3], h1[0], h1[1], h1[2], h1[3]}, o[d0], 0, 0, 0); \
        o[d0] = __builtin_amdgcn_mfma_f32_32x32x16_bf16(pa[2], (bf16x8){l2[0], l2[1], l2[2], l2[3], h2[0], h2[1], h2[2], h2[3]}, o[d0], 0, 0, 0); \
        o[d0] = __builtin_amdgcn_mfma_f32_32x32x16_bf16(pa[3], (bf16x8){l3[0], l3[1], l3[2], l3[3], h3[0], h3[1], h3[2], h3[3]}, o[d0], 0, 0, 0); } while (0)
    PV_D0(0); PV_D0(1); PV_D0(2); PV_D0(3); PV_D0(4); PV_D0(5); PV_D0(6); PV_D0(7);
#undef PV_D0
#undef TRRD
}

__device__ __forceinline__ void stage_offsets(int tid, unsigned (&koff)[2], unsigned (&voff)[4]) {
#pragma unroll
    for (int i = 0; i < 2; ++i) { const int P = tid * 16 + i * 8192, row = P >> 8, ch = ((P & 255) >> 4) ^ (row & 7); koff[i] = (unsigned)(row * 128 + ch * 8) * 2u; }
#pragma unroll
    for (int i = 0; i < 4; ++i) { const int P = tid * 16 + i * 8192, st = P >> 9, kk = ((st >> 3) << 3) | ((P & 511) >> 6), cg = st & 7, cin = (P & 63) >> 1;
        const int key = (kk & ~0xC) | ((kk & 4) << 1) | ((kk & 8) >> 1); voff[i] = (unsigned)(key * 256 + cg * 32 + cin) * 2u; }
}
__device__ __forceinline__ const char* uniform_ptr(const void* p) {
    const unsigned long long v = (unsigned long long)p;
    const unsigned lo = __builtin_amdgcn_readfirstlane((unsigned)v), hi = __builtin_amdgcn_readfirstlane((unsigned)(v >> 32));
    return (const char*)(((unsigned long long)hi << 32) | lo);
}
__device__ __forceinline__ void stage_tile(LAS unsigned char* lds, int kslot, int vslot, const bf16_t* kj_, const bf16_t* vj_, int tid_, int wid) {
    const char* kj = uniform_ptr(kj_); const char* vj = uniform_ptr(vj_);
    int tid = tid_; asm volatile("" : "+v"(tid));
    unsigned koff[2], voff[4]; stage_offsets(tid, koff, voff);
    LAS unsigned char* kd = lds + K_OFF + kslot * SHM_K + wid * 1024; LAS unsigned char* vd = lds + V_OFF + vslot * SHM_V + wid * 1024;
#pragma unroll
    for (int i = 0; i < 2; ++i) __builtin_amdgcn_global_load_lds((const unsigned*)(kj + koff[i]), (LAS unsigned*)(kd + i * 8192), 16, 0, 0);
#pragma unroll
    for (int i = 0; i < 4; ++i) __builtin_amdgcn_global_load_lds((const unsigned*)(vj + voff[i]), (LAS unsigned*)(vd + i * 8192), 16, 0, 0);
}

__device__ __forceinline__ void qk_softmax(const LAS unsigned char* kslot, int r32, int hi, LAS float* al_l, const bf16x8 (&qr)[8], f32x16 (&o)[8], bf16x8 (&pa)[4],
                                           float& m_reg, float& l_reg, float rawu, float sl2, bool diag, int qi) {
    f32x16 p0, p1;
#pragma unroll
    for (int r = 0; r < 16; ++r) { p0[r] = 0.f; p1[r] = 0.f; }
    qkt(p0, p1, kslot, r32, hi, qr);
#pragma unroll
    for (int r = 0; r < 16; ++r) { const float cr = (float)((r & 3) + 8 * (r >> 2)); p0[r] = fmaf(cr, rawu, p0[r]); p1[r] = fmaf(cr, rawu, p1[r]); }
    if (diag) {
        const float k2raw = 2.f * rawu;
        int qi_ = qi - 4 * hi; asm volatile("" : "+v"(qi_));
#pragma unroll
        for (int r = 0; r < 16; ++r) { const int c = (r & 3) + 8 * (r >> 2); const int d0_ = c - qi_, d1_ = c + 32 - qi_;
            p0[r] -= k2raw * (float)(d0_ > 0 ? d0_ : 0); p1[r] -= k2raw * (float)(d1_ > 0 ? d1_ : 0); }
    }
    const float lane_raw = rawu * (float)(4 * hi), d32raw = 32.f * rawu;
    float pm0 = p0[0], pm1 = p1[0];
#pragma unroll
    for (int r = 1; r < 16; ++r) { pm0 = fmaxf(pm0, p0[r]); pm1 = fmaxf(pm1, p1[r]); }
    float pmax = fmaxf(pm0, pm1 + d32raw) + lane_raw;
    { auto rr = __builtin_amdgcn_permlane32_swap(__float_as_uint(pmax), __float_as_uint(pmax), false, false);
      pmax = fmaxf(__uint_as_float(rr[0]), __uint_as_float(rr[1])); }
    float mn, alpha;
    if (__all((pmax - m_reg) * SCALE <= THR)) { mn = m_reg; alpha = 1.f; }
    else { mn = fmaxf(m_reg, pmax); alpha = __builtin_amdgcn_exp2f((m_reg - mn) * C2); m_reg = mn; }
    const float mnL0 = (lane_raw - mn) * C2, mnL1 = mnL0 + 32.f * sl2;
#pragma unroll
    for (int r = 0; r < 16; ++r) { p0[r] = __builtin_amdgcn_exp2f(fmaf(p0[r], C2, mnL0)); p1[r] = __builtin_amdgcn_exp2f(fmaf(p1[r], C2, mnL1)); }
    if (__any(alpha < 1.f)) {
        if (hi == 0) al_l[r32] = alpha;
        LDS_WAIT();
#pragma unroll
        for (int r = 0; r < 16; ++r) { const float a = al_l[crow(r, hi)];
#pragma unroll
            for (int d = 0; d < 8; ++d) o[d][r] *= a; }
    }
    float ps = 0.f;
#pragma unroll
    for (int r = 0; r < 16; ++r) ps += p0[r] + p1[r];
    { auto rr = __builtin_amdgcn_permlane32_swap(__float_as_uint(ps), __float_as_uint(ps), false, false);
      ps = __uint_as_float(rr[0]) + __uint_as_float(rr[1]); }
    l_reg = l_reg * alpha + ps;
#define PK4(P, B_, OUT) do { unsigned a0 = cvt_pk_bf16(P[B_+0], P[B_+1]), a1 = cvt_pk_bf16(P[B_+2], P[B_+3]); \
        unsigned b0 = cvt_pk_bf16(P[B_+4], P[B_+5]), b1 = cvt_pk_bf16(P[B_+6], P[B_+7]); \
        auto r0 = __builtin_amdgcn_permlane32_swap(a0, b0, false, false); auto r1 = __builtin_amdgcn_permlane32_swap(a1, b1, false, false); \
        u32x4 w = {r0[0], r1[0], r0[1], r1[1]}; OUT = __builtin_bit_cast(bf16x8, w); } while (0)
    PK4(p0, 0, pa[0]); PK4(p0, 8, pa[1]); PK4(p1, 0, pa[2]); PK4(p1, 8, pa[3]);
#undef PK4
}

__device__ __forceinline__ void norms_phase(Frame& F, const bf16_t* proj, float* nrm) {
    const int gw = F.vcu * NWAVES + F.wave, NGW = F.G * NWAVES, lane = F.lane;
    for (int idx = gw; idx < 2 * 32 * 256; idx += NGW) {
        const int tensor = idx >> 13, stream = (idx >> 8) & 31, grp = idx & 255;
        const u32x4* rp = (const u32x4*)(proj + (tensor ? DK0 : 0) + ((size_t)stream * SEQ + grp * 64 + lane) * 128);
        float ss = 0.f;
#pragma unroll
        for (int q = 0; q < 16; ++q) { const u32x4 v = rp[q];
#pragma unroll
            for (int e = 0; e < 4; ++e) { const float lo = bf_lo(v[e]), hi = bf_hi(v[e]); ss += lo * lo + hi * hi; } }
        float n = sqrtf(ss) * 1.001f;
#pragma unroll
        for (int o = 1; o < 64; o <<= 1) n = fmaxf(n, __shfl_xor(n, o));
        if (lane == 0) nrm[idx] = n;
    }
}

__device__ __forceinline__ void attn_item(LAS unsigned char* lds, const bf16_t* proj, const float* nrm, bf16_t* oout, int b, int h, int sub, int qb, int tid, int wid, int lane) {
    const int r32 = lane & 31, hi = lane >> 5;
    const float slope = __builtin_amdgcn_exp2f(-(float)(h + 1));
    const float sl2 = slope * 1.4426950408889634f, rawu = sl2 / C2;
    LAS float* ws = (LAS float*)(lds + SCR_OFF) + wid * 64; LAS float* li_l = ws; LAS float* al_l = ws + 32;
    const size_t tokq = (size_t)b * SEQ + (size_t)qb * 256 + wid * 32;
    const bf16_t* kbase = proj + DK0 + dq_off(b, 0, h, sub);
    const bf16_t* vbase = proj + dv_off(b, 0, h);
    int j_lo;
    { const int stream = (b * 8 + h) * 2 + sub; const float* qn = nrm + stream * 256; const float* kn = nrm + 8192 + stream * 256;
      const float Qn = fmaxf(fmaxf(qn[4 * qb], qn[4 * qb + 1]), fmaxf(qn[4 * qb + 2], qn[4 * qb + 3]));
      const float Kd = fmaxf(fmaxf(kn[4 * qb], kn[4 * qb + 1]), fmaxf(kn[4 * qb + 2], kn[4 * qb + 3]));
      int cand = 4 * qb;
      for (int jj = lane; jj < 4 * qb; jj += 64) { const float dmin = (float)(256 * qb - (64 * jj + 63)); const bool skip = slope * dmin > 110.f + SCALE * Qn * (kn[jj] + Kd); if (!skip) cand = cand < jj ? cand : jj; }
#pragma unroll
      for (int o = 1; o < 64; o <<= 1) { const int v = __shfl_xor(cand, o); cand = v < cand ? v : cand; }
      j_lo = __builtin_amdgcn_readfirstlane(cand); }
    bf16x8 qr[8];
#pragma unroll
    for (int d0 = 0; d0 < 8; ++d0) qr[d0] = *(const bf16x8*)(proj + dq_off(b, qb * 256 + wid * 32 + r32, h, sub) + d0 * 16 + hi * 8);
    const float sh64 = 64.f * rawu;
    const int qi = 32 * (wid & 1) + r32;
    const unsigned vb0 = (unsigned)(uintptr_t)(lds + V_OFF) + (unsigned)v_rd_base(lane);
    float m_reg = -1e30f, l_reg = 0.f;
    f32x16 o[8];
#pragma unroll
    for (int d = 0; d < 8; ++d)
#pragma unroll
        for (int r = 0; r < 16; ++r) o[d][r] = 0.f;
    const int NT = 4 * qb + 4, myNT = 4 * qb + (wid >> 1) + 1;
    constexpr size_t KSTEP = 64 * 128, VSTEP = 64 * 256;
    const bool late = wid >= 4;
    stage_tile(lds, j_lo & 1, j_lo % 3, kbase + (size_t)j_lo * KSTEP, vbase + (size_t)j_lo * VSTEP, tid, wid);
    VM_WAIT(); WG_BAR();
    if (!late) {
        int vs = j_lo % 3;
        for (int j = j_lo; j < NT; ++j) {
            const int vsn = vs == 2 ? 0 : vs + 1;
            if (j + 1 < NT) stage_tile(lds, (j + 1) & 1, vsn, kbase + (size_t)(j + 1) * KSTEP, vbase + (size_t)(j + 1) * VSTEP, tid, wid);
            if (j < myNT) { if (j > j_lo) m_reg -= sh64;
                bf16x8 pa[4];
                qk_softmax(lds + K_OFF + (j & 1) * SHM_K, r32, hi, al_l, qr, o, pa, m_reg, l_reg, rawu, sl2, j == myNT - 1, qi);
                pv_tile(o, vb0 + (unsigned)(vs * SHM_V), pa); }
            VM_WAIT(); WG_BAR();
            vs = vsn;
        }
    } else {
        bf16x8 pa[4];
        int vs = j_lo % 3, vsp = vs;
        for (int j = j_lo; j < NT; ++j) {
            const int vsn = vs == 2 ? 0 : vs + 1;
            if (j + 1 < NT) stage_tile(lds, (j + 1) & 1, vsn, kbase + (size_t)(j + 1) * KSTEP, vbase + (size_t)(j + 1) * VSTEP, tid, wid);
            if (j > j_lo && j - 1 < myNT) pv_tile(o, vb0 + (unsigned)(vsp * SHM_V), pa);
            if (j < myNT) { if (j > j_lo) m_reg -= sh64;
                qk_softmax(lds + K_OFF + (j & 1) * SHM_K, r32, hi, al_l, qr, o, pa, m_reg, l_reg, rawu, sl2, j == myNT - 1, qi); }
            VM_WAIT(); WG_BAR();
            vsp = vs; vs = vsn;
        }
        if (myNT == NT) pv_tile(o, vb0 + (unsigned)(vsp * SHM_V), pa);
    }
    if (hi == 0) li_l[r32] = l_reg;
    LDS_WAIT();
    char* Ow = (char*)(oout + tokq * D + h * 256);
    const unsigned lofs = (unsigned)(hi * 4 * D + r32) * 2u;
#pragma unroll
    for (int r = 0; r < 16; ++r) { const float rl = __builtin_amdgcn_rcpf(li_l[crow(r, hi)]);
#pragma unroll
        for (int d0 = 0; d0 < 8; ++d0) { const float v = o[d0][r] * rl; const float vn = __shfl_xor(v, 1);
            if ((r32 & 1) == 0) *(unsigned*)(Ow + (lofs + (unsigned)((((r & 3) + 8 * (r >> 2)) * D + d0 * 32) * 2))) = cvt_pk_bf16(v, vn); } }
    WG_BAR();
}

__device__ __forceinline__ void attn_phase(Frame& F, const bf16_t* proj, const float* nrm, unsigned* queue, bf16_t* o1, bf16_t* o2) {
    LAS int* qw = (LAS int*)(F.lds + SCR_OFF + 8 * 256);
    for (;;) {
        if (F.tid == 0) *qw = (int)__hip_atomic_fetch_add(queue, 1u, __ATOMIC_RELAXED, __HIP_MEMORY_SCOPE_AGENT);
        WG_BAR();
        const int I = __builtin_amdgcn_readfirstlane(*qw);
        if (I >= 2048) break;
        const int qb = 63 - (I >> 5), r = I & 31, h = 7 - (r >> 2), b = (r >> 1) & 1, sub = r & 1;
        attn_item(F.lds, proj, nrm, sub ? o2 : o1, b, h, sub, qb, F.tid, F.wave, F.lane);
    }
}
}

__global__ void __launch_bounds__(NWAVES * 64, 2) hybrid_fwd(Args args) {
    extern __shared__ __attribute__((aligned(16))) unsigned char lds_raw[];
    Frame F;
    F.lds = (LAS unsigned char*)lds_raw;
    F.tid = threadIdx.x; F.lane = F.tid & 63; F.wave = __builtin_amdgcn_readfirstlane(F.tid >> 6);
    F.G = gridDim.x; { const int bx = blockIdx.x; F.vcu = (F.G % 8 == 0) ? (bx % 8) * (F.G / 8) + bx / 8 : bx; }
    unsigned char* ws = args.ws;
    unsigned* ctl = (unsigned*)(ws + WS_CTL);
    for (int u = F.tid; u < (LDS_BYTES - LDSCTL_OFF) / 4; u += NWAVES * 64) ((LAS unsigned*)(F.lds + LDSCTL_OFF))[u] = 0u;
    __syncthreads();
    volatile LAS unsigned* MISC = (volatile LAS unsigned*)(F.lds + MISC_OFF);
    XcdBarrier bar = xcd_barrier_post(ctl + CW_BAR, MISC + 8);
#define GRID_BAR() do { XcdBarrier bb_ = bar; unsigned x_ = bar.x; asm volatile("" : "+s"(x_)); bb_.x = x_; xcd_barrier(bb_); } while (0)
#ifdef ONLY_PHASE
#define PHON(n) ((n) == ONLY_PHASE)
#elif DIAG
#define PHON(n) ((n) <= args.upto)
#else
#define PHON(n) 1
#endif

#define x_in ((const float*)(args.in[0]))
#define norm_mix ((const float*)(args.in[1]))
#define norm_ffn ((const float*)(args.in[2]))
#define gla_w_in ((const float*)(args.in[3]))
#define gla_wgu ((const float*)(args.in[4]))
#define gla_bg ((const float*)(args.in[5]))
#define gla_norm ((const float*)(args.in[6]))
#define gla_w_out ((const float*)(args.in[7]))
#define diff_w_in ((const float*)(args.in[8]))
#define lq1 ((const float*)(args.in[9]))
#define lk1 ((const float*)(args.in[10]))
#define lq2 ((const float*)(args.in[11]))
#define lk2 ((const float*)(args.in[12]))
#define diff_subln ((const float*)(args.in[13]))
#define diff_w_out ((const float*)(args.in[14]))
#define moe_wgrp ((const float*)(args.in[15]))
#define moe_wexp ((const float*)(args.in[16]))
#define moe_wg ((const float*)(args.in[17]))
#define moe_wu ((const float*)(args.in[18]))
#define moe_wd ((const float*)(args.in[19]))
#define final_norm ((const float*)(args.in[20]))
#define xres ((float*)(args.out))
#define gz ((float*)((float*)(ws + WS_GZ)))
#define tok_e ((int*)((int*)(ws + WS_TOKE)))
#define tok_p ((int*)((int*)(ws + WS_TOKP)))
#define tok_w ((float*)((float*)(ws + WS_TOKW)))
#define slot_of ((int*)((int*)(ws + WS_SLOT)))
#define adec ((float*)((float*)(ws + WS_ADEC)))
#define pcum ((float*)((float*)(ws + WS_PCUM)))
#define sfin ((bf16_t*)((bf16_t*)(ws + WS_SFIN)))
#define wp_gz ((float*)((float*)(ws + WS_WPGZ)))
#define wp_r0 ((float*)((float*)(ws + WS_WPR0)))
#define wp_r1 ((float*)((float*)(ws + WS_WPR1)))
#define wgi ((bf16_t*)((bf16_t*)(ws + WS_WGI)))
#define wgo ((bf16_t*)((bf16_t*)(ws + WS_WGO)))
#define wdi ((bf16_t*)((bf16_t*)(ws + WS_WDI)))
#define wdo ((bf16_t*)((bf16_t*)(ws + WS_WDO)))
#define wmoe_gu ((bf16_t*)((bf16_t*)(ws + WS_WMOE)))
#define wmoe_d ((bf16_t*)((bf16_t*)(ws + WS_WMOE_D)))
#define hn ((bf16_t*)((bf16_t*)(ws + WS_HN)))
#define proj ((bf16_t*)((bf16_t*)(ws + WS_PROJ)))
#define buf1 ((bf16_t*)((bf16_t*)(ws + WS_BUF1)))
#define buf2 ((bf16_t*)((bf16_t*)(ws + WS_BUF2)))
#define ag ((bf16_t*)((bf16_t*)(ws + WS_AG)))
#define ob ((bf16_t*)((bf16_t*)(ws + WS_OB)))
#define hh ((bf16_t*)((bf16_t*)(ws + WS_H)))
    const LAS int* pst = (const LAS int*)(F.lds + TAB_OFF);

    _Pragma("unroll") for (int rep_ = 0; rep_ < (REP_PHASE == 0 ? 2 : 1); ++rep_) if (PHON(0)) { if (rep_) GRID_BAR(); Frame P = F; P.tid = opq(F.tid); P.lane = P.tid & 63;
    conv_plain(P, gla_w_in, D, PROJW, GLA_INW, wgi);
    conv_plain(P, gla_w_out, D, D, D, wgo);
    conv_plain(P, diff_w_in, D, PROJW, PROJW, wdi);
    conv_plain(P, diff_w_out, D, D, D, wdo);
    pack_proj(P, wp_gz, 1, norm_mix, gla_w_in, GLA_INW, PROJW, 16, nullptr, 0, 0);
    pack_proj(P, wp_r0, 3, norm_ffn, moe_wgrp, 4, 0, 4, moe_wexp, 32, 32);
    pack_proj(P, wp_r1, 3, norm_ffn + D, moe_wgrp + (size_t)D * 4, 4, 0, 4, moe_wexp + (size_t)D * 32, 32, 32);
    }
    GRID_BAR();
    _Pragma("unroll") for (int rep_ = 0; rep_ < (REP_PHASE == 1 ? 2 : 1); ++rep_) if (PHON(1)) { if (rep_) GRID_BAR(); Frame P = F; P.tid = opq(F.tid); P.lane = P.tid & 63;
    phase_norm_gz(P, x_in, norm_mix, wp_gz, hn, gz);
    }
    GRID_BAR();
    _Pragma("unroll") for (int rep_ = 0; rep_ < (REP_PHASE == 2 ? 2 : 1); ++rep_) if (PHON(2)) { if (rep_) GRID_BAR(); Frame P = F; P.tid = opq(F.tid); P.lane = P.tid & 63;
    { pg8::Gemm g{hn, wgi, T, PROJW, D}; pg8::StaticOrder S; S.init(T, PROJW, P.G, (int)blockIdx.x); pg8::EpiHeads<0> E{proj};
      pg8::gemm_phase<pg8::EpiHeads<0>, pg8::StaticOrder>(P.lds, g, S, E); }
    }
    GRID_BAR();
    _Pragma("unroll") for (int rep_ = 0; rep_ < (REP_PHASE == 3 ? 2 : 1); ++rep_) if (PHON(3)) { if (rep_) GRID_BAR(); Frame P = F; P.tid = opq(F.tid); P.lane = P.tid & 63;
    phase_gla_gate(P, gz, gla_wgu, gla_bg, proj, buf1, adec);
    }
    GRID_BAR();
    _Pragma("unroll") for (int rep_ = 0; rep_ < (REP_PHASE == 4 ? 2 : 1); ++rep_) if (PHON(4)) { if (rep_) GRID_BAR(); Frame P = F; P.tid = opq(F.tid); P.lane = P.tid & 63;
    if (P.G == 256) { if ((P.vcu & 1) == 0) phase_gla_scan(P, P.vcu >> 1, proj, buf1, adec, buf2, sfin, ctl + CW_PROBE); else { gla_pcum(P, adec, pcum, P.vcu >> 1, 128); conv_moe(P, moe_wg, moe_wu, moe_wd, wmoe_gu, wmoe_d, P.vcu >> 1, 128); } }
    else { for (int it = P.vcu; it < 128; it += P.G) phase_gla_scan(P, it, proj, buf1, adec, buf2, sfin); gla_pcum(P, adec, pcum, P.vcu, P.G); conv_moe(P, moe_wg, moe_wu, moe_wd, wmoe_gu, wmoe_d); }
    GRID_BAR();
    phase_gla_qp(P, proj, pcum, hn);
    GRID_BAR();
    { pg8::Gemm g{hn, sfin, 8 * (SEQ / 2), 512, 256}; pg8::FixOrder S; S.init(8 * (SEQ / 2), 512, P.G, (int)blockIdx.x); pg8::EpiAddO E{buf2};
      pg8::gemm_phase<pg8::EpiAddO, pg8::FixOrder>(P.lds, g, S, E); }
    }
    GRID_BAR();
    _Pragma("unroll") for (int rep_ = 0; rep_ < (REP_PHASE == 5 ? 2 : 1); ++rep_) if (PHON(5)) { if (rep_) GRID_BAR(); Frame P = F; P.tid = opq(F.tid); P.lane = P.tid & 63;
    phase_gla_gnorm(P, buf2, proj, gla_norm, hn);
    }
    GRID_BAR();
    _Pragma("unroll") for (int rep_ = 0; rep_ < (REP_PHASE == 6 ? 2 : 1); ++rep_) if (PHON(6)) { if (rep_) GRID_BAR(); Frame P = F; P.tid = opq(F.tid); P.lane = P.tid & 63;
    { pg8::Gemm g{hn, wgo, T, D, D}; pg8::StaticOrder S; S.init(T, D, P.G, (int)blockIdx.x); pg8::EpiResF32 E{x_in, xres, D};
      pg8::gemm_phase<pg8::EpiResF32, pg8::StaticOrder>(P.lds, g, S, E); }
    }
    GRID_BAR();
    _Pragma("unroll") for (int rep_ = 0; rep_ < (REP_PHASE == 7 ? 2 : 1); ++rep_) if (PHON(7)) { if (rep_) GRID_BAR(); Frame P = F; P.tid = opq(F.tid); P.lane = P.tid & 63;
    phase_norm_route(P, xres, norm_ffn, wp_r0, hn, tok_e, tok_p, tok_w, ctl + CW_CNT0);
    }
    GRID_BAR();
    _Pragma("unroll") for (int rep_ = 0; rep_ < (REP_PHASE == 8 ? 2 : 1); ++rep_) if (PHON(8)) { if (rep_) GRID_BAR(); Frame P = F; P.tid = opq(F.tid); P.lane = P.tid & 63;
    moe_tables(P, ctl + CW_CNT0);
    phase_moe_gather(P, tok_e, tok_p, slot_of, hn, ag);
    }
    GRID_BAR();
    _Pragma("unroll") for (int rep_ = 0; rep_ < (REP_PHASE == 9 ? 2 : 1); ++rep_) if (PHON(9)) { if (rep_) GRID_BAR(); Frame P = F; P.tid = opq(F.tid); P.lane = P.tid & 63;
    { const int Mr = pst[33] * 256; pg8::Gemm g{ag, wmoe_gu, Mr, 1024, D}; pg8::MoeOrder S; S.init(Mr, 1024, P.G, (int)blockIdx.x); S.te = pst + 36; S.estride = (size_t)1024 * D * 2; pg8::EpiSiluMul E{hh};
      pg8::gemm_phase<pg8::EpiSiluMul, pg8::MoeOrder>(P.lds, g, S, E); }
    }
    GRID_BAR();
    _Pragma("unroll") for (int rep_ = 0; rep_ < (REP_PHASE == 10 ? 2 : 1); ++rep_) if (PHON(10)) { if (rep_) GRID_BAR(); Frame P = F; P.tid = opq(F.tid); P.lane = P.tid & 63;
    { const int Mr = pst[33] * 256; pg8::Gemm g{hh, wmoe_d, Mr, D, DFF}; pg8::MoeOrder S; S.init(Mr, D, P.G, (int)blockIdx.x); S.te = pst + 36; S.estride = (size_t)D * DFF * 2; pg8::EpiBf16 E{ob, D};
      pg8::gemm_phase<pg8::EpiBf16, pg8::MoeOrder>(P.lds, g, S, E); }
    }
    GRID_BAR();
    _Pragma("unroll") for (int rep_ = 0; rep_ < (REP_PHASE == 11 ? 2 : 1); ++rep_) if (PHON(11)) { if (rep_) GRID_BAR(); Frame P = F; P.tid = opq(F.tid); P.lane = P.tid & 63;
    phase_moe_combine<0>(P, xres, ob, slot_of, tok_w, norm_mix + D, hn);
    conv_moe(P, moe_wg + (size_t)NEXP * D * DFF, moe_wu + (size_t)NEXP * D * DFF, moe_wd + (size_t)NEXP * DFF * D, wmoe_gu, wmoe_d);
    }
    GRID_BAR();
    _Pragma("unroll") for (int rep_ = 0; rep_ < (REP_PHASE == 12 ? 2 : 1); ++rep_) if (PHON(12)) { if (rep_) GRID_BAR(); Frame P = F; P.tid = opq(F.tid); P.lane = P.tid & 63;
    { pg8::Gemm g{hn, wdi, T, PROJW, D}; pg8::StaticOrder S; S.init(T, PROJW, P.G, (int)blockIdx.x); pg8::EpiHeads<1> E{proj};
      pg8::gemm_phase<pg8::EpiHeads<1>, pg8::StaticOrder>(P.lds, g, S, E); }
    GRID_BAR();
    att::norms_phase(P, proj, (float*)(ws + WS_NRM));
    }
    GRID_BAR();
    _Pragma("unroll") for (int rep_ = 0; rep_ < (REP_PHASE == 13 ? 2 : 1); ++rep_) if (PHON(13)) { if (rep_) GRID_BAR(); Frame P = F; P.tid = opq(F.tid); P.lane = P.tid & 63;
    att::attn_phase(P, proj, (const float*)(ws + WS_NRM), ctl + CW_QUEUE, buf1, buf2);
    }
    GRID_BAR();
    _Pragma("unroll") for (int rep_ = 0; rep_ < (REP_PHASE == 14 ? 2 : 1); ++rep_) if (PHON(14)) { if (rep_) GRID_BAR(); Frame P = F; P.tid = opq(F.tid); P.lane = P.tid & 63;
    phase_subln(P, buf1, buf2, lq1, lk1, lq2, lk2, diff_subln, hn);
    }
    GRID_BAR();
    _Pragma("unroll") for (int rep_ = 0; rep_ < (REP_PHASE == 15 ? 2 : 1); ++rep_) if (PHON(15)) { if (rep_) GRID_BAR(); Frame P = F; P.tid = opq(F.tid); P.lane = P.tid & 63;
    { pg8::Gemm g{hn, wdo, T, D, D}; pg8::StaticOrder S; S.init(T, D, P.G, (int)blockIdx.x); pg8::EpiResF32 E{xres, xres, D};
      pg8::gemm_phase<pg8::EpiResF32, pg8::StaticOrder>(P.lds, g, S, E); }
    }
    GRID_BAR();
    _Pragma("unroll") for (int rep_ = 0; rep_ < (REP_PHASE == 16 ? 2 : 1); ++rep_) if (PHON(16)) { if (rep_) GRID_BAR(); Frame P = F; P.tid = opq(F.tid); P.lane = P.tid & 63;
    phase_norm_route(P, xres, norm_ffn + D, wp_r1, hn, tok_e, tok_p, tok_w, ctl + CW_CNT1);
    }
    GRID_BAR();
    _Pragma("unroll") for (int rep_ = 0; rep_ < (REP_PHASE == 17 ? 2 : 1); ++rep_) if (PHON(17)) { if (rep_) GRID_BAR(); Frame P = F; P.tid = opq(F.tid); P.lane = P.tid & 63;
    moe_tables(P, ctl + CW_CNT1);
    phase_moe_gather(P, tok_e, tok_p, slot_of, hn, ag);
    }
    GRID_BAR();
    _Pragma("unroll") for (int rep_ = 0; rep_ < (REP_PHASE == 18 ? 2 : 1); ++rep_) if (PHON(18)) { if (rep_) GRID_BAR(); Frame P = F; P.tid = opq(F.tid); P.lane = P.tid & 63;
    { const int Mr = pst[33] * 256; pg8::Gemm g{ag, wmoe_gu, Mr, 1024, D}; pg8::MoeOrder S; S.init(Mr, 1024, P.G, (int)blockIdx.x); S.te = pst + 36; S.estride = (size_t)1024 * D * 2; pg8::EpiSiluMul E{hh};
      pg8::gemm_phase<pg8::EpiSiluMul, pg8::MoeOrder>(P.lds, g, S, E); }
    }
    GRID_BAR();
    _Pragma("unroll") for (int rep_ = 0; rep_ < (REP_PHASE == 19 ? 2 : 1); ++rep_) if (PHON(19)) { if (rep_) GRID_BAR(); Frame P = F; P.tid = opq(F.tid); P.lane = P.tid & 63;
    { const int Mr = pst[33] * 256; pg8::Gemm g{hh, wmoe_d, Mr, D, DFF}; pg8::MoeOrder S; S.init(Mr, D, P.G, (int)blockIdx.x); S.te = pst + 36; S.estride = (size_t)D * DFF * 2; pg8::EpiBf16 E{ob, D};
      pg8::gemm_phase<pg8::EpiBf16, pg8::MoeOrder>(P.lds, g, S, E); }
    }
    GRID_BAR();
    _Pragma("unroll") for (int rep_ = 0; rep_ < (REP_PHASE == 20 ? 2 : 1); ++rep_) if (PHON(20)) { if (rep_) GRID_BAR(); Frame P = F; P.tid = opq(F.tid); P.lane = P.tid & 63;
    phase_moe_combine<1>(P, xres, ob, slot_of, tok_w, final_norm, hn);
    }
#if PROBE
    { GRID_BAR(); const float c = sqrtf(0.1f * __uint_as_float(xb_ld(ctl + CW_PROBE)));
      for (size_t i = (size_t)blockIdx.x * 512 + F.tid; i < (size_t)T * D; i += (size_t)gridDim.x * 512) xres[i] = c; }
#endif
}

#undef x_in
#undef norm_mix
#undef norm_ffn
#undef gla_w_in
#undef gla_wgu
#undef gla_bg
#undef gla_norm
#undef gla_w_out
#undef diff_w_in
#undef lq1
#undef lk1
#undef lq2
#undef lk2
#undef diff_subln
#undef diff_w_out
#undef moe_wgrp
#undef moe_wexp
#undef moe_wg
#undef moe_wu
#undef moe_wd
#undef final_norm
#undef xres
#undef gz
#undef tok_e
#undef tok_p
#undef tok_w
#undef slot_of
#undef adec
#undef pcum
#undef sfin
#undef wp_gz
#undef wp_r0
#undef wp_r1
#undef wgi
#undef wgo
#undef wdi
#undef wdo
#undef wmoe_gu
#undef wmoe_d
#undef hn
#undef proj
#undef buf1
#undef buf2
#undef ag
#undef ob
#undef hh
#if DIAG
constexpr size_t WS_DIAG = WS_END;
constexpr int NSAVE = 64;
__device__ inline unsigned hsh(unsigned x) { x ^= x >> 16; x *= 0x7feb352dU; x ^= x >> 15; x *= 0x846ca68bU; x ^= x >> 16; return x; }
__device__ inline void rep(unsigned* w, double got, double ref, double scale) { double e = fabs(got - ref) / (fabs(ref) + scale); float ef = (float)e; if (!(ef == ef) || ef > 1e30f) ef = 1e30f; atomicMax(w, __float_as_uint(ef)); }
__device__ inline double bfd(bf16_t v) { return (double)bf2f(v); }
#define GTID (blockIdx.x * blockDim.x + threadIdx.x)
#define GSTR (gridDim.x * blockDim.x)

__global__ void ck_weights(const float* gla_w_in, const float* gla_w_out, const float* diff_w_in, const float* diff_w_out, const bf16_t* wgi, const bf16_t* wgo, const bf16_t* wdi, const bf16_t* wdo,
                           const float* norm_mix, const float* norm_ffn, const float* wgrp, const float* wexp, const float* wp_gz, const float* wp_r0, const float* wp_r1, unsigned* w) {
    for (unsigned i = GTID; i < 65536u; i += GSTR) { const unsigned r = hsh(i * 3u + 1u), r2 = hsh(i * 7u + 5u);
        const int n = r % 6144u, k = r2 % 2048u, n2 = n % 2048;
        rep(w, bfd(wgi[(size_t)n * D + k]), gla_w_in[(size_t)k * GLA_INW + n], 0.02); rep(w, bfd(wdi[(size_t)n * D + k]), diff_w_in[(size_t)k * PROJW + n], 0.02);
        rep(w, bfd(wgo[(size_t)n2 * D + k]), gla_w_out[(size_t)k * D + n2], 0.02); rep(w, bfd(wdo[(size_t)n2 * D + k]), diff_w_out[(size_t)k * D + n2], 0.02);
        const int s = r % 128u, ln = (r >> 7) % 64u, e4 = (r >> 13) & 3, kk = 16 * s + 4 * (ln >> 4) + e4, col = ln & 15, nt = (r >> 15) % 3u, col3 = 16 * nt + col;
        rep(w, wp_gz[(s * 64 + ln) * 4 + e4], (double)norm_mix[kk] * gla_w_in[(size_t)kk * GLA_INW + PROJW + col], 0.02);
        for (int L = 0; L < 2; ++L) { const float* gr = wgrp + (size_t)L * D * 4; const float* ex = wexp + (size_t)L * D * 32; const float* nf = norm_ffn + L * D;
            const double ref = col3 < 4 ? gr[kk * 4 + col3] : (col3 < 36 ? ex[kk * 32 + col3 - 4] : 0.0);
            rep(w, (L ? wp_r1 : wp_r0)[((s * 3 + nt) * 64 + ln) * 4 + e4], (double)nf[kk] * ref, 0.02); } }
}
__global__ void ck_moew(const float* wg, const float* wu, const float* wd, const bf16_t* GU, const bf16_t* DT, unsigned* w) {
    for (unsigned i = GTID; i < 65536u; i += GSTR) { const unsigned r = hsh(i * 5u + 2u), r2 = hsh(i * 11u + 3u);
        const int e = r % 32u, f = (r >> 5) % 512u, k = r2 % 2048u, n2 = (r2 >> 11) % 2048u, rowg = 256 * (f >> 7) + (f & 127);
        rep(w, bfd(GU[((size_t)e * 1024 + rowg) * D + k]), wg[((size_t)e * D + k) * DFF + f], 0.02); rep(w, bfd(GU[((size_t)e * 1024 + rowg + 128) * D + k]), wu[((size_t)e * D + k) * DFF + f], 0.02);
        rep(w, bfd(DT[((size_t)e * D + n2) * DFF + f]), wd[((size_t)e * DFF + f) * D + n2], 0.05); }
}
__global__ void ck_norm(const float* x, const float* gain, const bf16_t* hn, unsigned* w) {
    for (unsigned i = GTID; i < 4096u; i += GSTR) { const unsigned r = hsh(i * 13u + 7u); const int t = r % (unsigned)T, j = (r >> 15) % 2048u;
        double ss = 0; for (int k = 0; k < D; ++k) { const double v = x[(size_t)t * D + k]; ss += v * v; }
        const double rstd = 1.0 / sqrt(ss / D + 1e-6); rep(w, bfd(hn[(size_t)t * D + j]), x[(size_t)t * D + j] * rstd * gain[j], 1.0); }
}
__global__ void ck_gz(const float* x, const float* gain, const float* gla_w_in, const float* gz, unsigned* w) {
    for (unsigned i = GTID; i < 4096u; i += GSTR) { const unsigned r = hsh(i * 17u + 9u); const int t = r % (unsigned)T, c = (r >> 15) % 16u;
        double ss = 0, dot = 0; for (int k = 0; k < D; ++k) { const double v = x[(size_t)t * D + k]; ss += v * v; dot += v * gain[k] * gla_w_in[(size_t)k * GLA_INW + PROJW + c]; }
        rep(w, gz[(size_t)t * 16 + c], dot / sqrt(ss / D + 1e-6), 1.0); }
}
__global__ void ck_gemm(const bf16_t* A, const bf16_t* Bt, const bf16_t* C, int M, int N, int K, int ldc, double scale, unsigned* w) {
    for (unsigned i = GTID; i < 16384u; i += GSTR) { const unsigned r = hsh(i * 19u + 11u), r2 = hsh(i * 23u + 1u); const int m = r % (unsigned)M, n = r2 % (unsigned)N;
        double s = 0; for (int k = 0; k < K; ++k) s += bfd(A[(size_t)m * K + k]) * bfd(Bt[(size_t)n * K + k]);
        rep(w, bfd(C[(size_t)m * ldc + n]), s, scale); }
}
__global__ void ck_proj(const bf16_t* A, const bf16_t* Bt, const bf16_t* proj, int layer, unsigned* w) {
    for (unsigned i = GTID; i < 16384u; i += GSTR) { const unsigned r = hsh(i * 19u + 11u), r2 = hsh(i * 23u + 1u); const int m = r % (unsigned)T, n = r2 % (unsigned)PROJW, b = m >> 14, t = m & (SEQ - 1);
        double s = 0; for (int k = 0; k < D; ++k) s += bfd(A[(size_t)m * D + k]) * bfd(Bt[(size_t)n * D + k]);
        size_t off;
        if (layer == 0) { if (n < 1024) off = gq_off(b, t, n >> 8) + (n & 255); else if (n < 2048) off = GK0 + gq_off(b, t, (n - 1024) >> 8) + (n & 255); else if (n < 4096) off = gv_off(b, t, (n - 2048) >> 9) + (n & 511); else off = GR0 + (size_t)m * 2048 + (n - 4096); }
        else { if (n < 2048) off = dq_off(b, t, n >> 8, (n >> 7) & 1) + (n & 127); else if (n < 4096) off = DK0 + dq_off(b, t, (n - 2048) >> 8, (n >> 7) & 1) + (n & 127); else off = dv_off(b, t, (n - 4096) >> 8) + (n & 255); }
        rep(w, bfd(proj[off]), s, 1.0); }
}
__device__ inline int srow(int i) { return (int)(hsh(i * 29u + 13u) % (unsigned)T); }
__global__ void ck_save(const float* x, float* save) { for (unsigned i = GTID; i < (unsigned)NSAVE * D; i += GSTR) save[i] = x[(size_t)srow(i / D) * D + (i % D)]; }
__global__ void ck_gemm_res(const bf16_t* A, const bf16_t* Bt, const float* base, int saved, const float* out, unsigned* w) {
    for (unsigned i = GTID; i < (unsigned)NSAVE * 64u; i += GSTR) { const int si = i / 64, t = srow(si), n = hsh(i * 31u + 5u) % 2048u;
        double s = 0; for (int k = 0; k < D; ++k) s += bfd(A[(size_t)t * D + k]) * bfd(Bt[(size_t)n * D + k]);
        const double b = saved ? base[(size_t)si * D + n] : base[(size_t)t * D + n];
        rep(w, out[(size_t)t * D + n], b + s, 1.0); }
}
__global__ void ck_gate(const float* gz, const float* wgu, const float* bg, const bf16_t* proj, const bf16_t* kdT, const float* adec, unsigned* w) {
    for (unsigned i = GTID; i < 4096u; i += GSTR) { const unsigned r = hsh(i * 37u + 3u); const int bc = r % 512u, j = (r >> 9) % 1024u, tq = (r >> 19) % 64u;
        double run = 0, ct = 0;
        for (int t = 0; t < 64; ++t) { double z = bg[j]; for (int q = 0; q < 16; ++q) z += (double)gz[((size_t)bc * 64 + t) * 16 + q] * wgu[q * 1024 + j];
            const double ls = fmin(z, 0.0) - log1p(exp(-fabs(z))); run += ls / 16.0; if (t == tq) ct = run; }
        rep(w, adec[(size_t)bc * 1024 + j], exp(run), 1.0);
        rep(w, bfd(kdT[((size_t)bc * 1024 + j) * 64 + tq]), bfd(proj[GK0 + gq_off(bc >> 8, (bc & 255) * 64 + tq, j >> 8) + (j & 255)]) * exp(run - ct), 1.0); }
}
__global__ void ck_scan(const bf16_t* proj, const bf16_t* kdT, const float* adec, const bf16_t* o, unsigned* w) {
    const int wv = GTID / 64, lane = threadIdx.x & 63, nw = GSTR / 64;
    const int cl[8] = {0, 1, 3, 17, 100, 255, 2, 64};
    for (int s = wv; s < 96; s += nw) { const unsigned r = hsh(s * 41u + 17u); const int b = r & 1, c = cl[s % 8], tl = (r >> 1) % 64u, h = (r >> 7) % 4u, vc = (r >> 9) % 512u;
        float S[4] = {0.f, 0.f, 0.f, 0.f};
        for (int cc = 0; cc <= c; ++cc) { const size_t bc = (size_t)b * NCH + cc;
            for (int q = 0; q < 4; ++q) { const int kr = h * 256 + lane * 4 + q; float a = 0.f;
                for (int t = 0; t < 64; ++t) a += bf2f(kdT[(bc * 1024 + kr) * 64 + t]) * bf2f(proj[gv_off(b, cc * 64 + t, h) + vc]);
                S[q] = adec[bc * 1024 + kr] * S[q] + a; } }
        float part = 0.f; const size_t tok = (size_t)b * SEQ + c * 64 + tl;
        for (int q = 0; q < 4; ++q) part += bf2f(proj[gq_off(b, c * 64 + tl, h) + lane * 4 + q]) * S[q];
        for (int of = 1; of < 64; of <<= 1) part += __shfl_xor(part, of);
        if (lane == 0) rep(w, bfd(o[tok * D + h * 512 + vc]), part / 16.0, 2.0); }
}
__global__ void ck_gnorm(const bf16_t* o, const bf16_t* proj, const float* gn, const bf16_t* y, unsigned* w) {
    for (unsigned i = GTID; i < 8192u; i += GSTR) { const unsigned r = hsh(i * 43u + 19u); const int t = r % (unsigned)T, h = (r >> 15) % 4u, j = (r >> 17) % 512u;
        double ss = 0; for (int k = 0; k < 512; ++k) { const double v = bfd(o[(size_t)t * D + h * 512 + k]); ss += v * v; }
        const double rr = bfd(proj[GR0 + (size_t)t * 2048 + h * 512 + j]);
        rep(w, bfd(y[(size_t)t * D + h * 512 + j]), bfd(o[(size_t)t * D + h * 512 + j]) / sqrt(ss / 512 + 1e-6) * gn[j] * rr / (1.0 + exp(-rr)), 1.0); }
}
__global__ void ck_route(const float* x, const float* gain, const float* wgrp, const float* wexp, const int* tok_e, const int* tok_p, const float* tok_w, const unsigned* cnt, unsigned* w) {
    for (unsigned i = GTID; i < 512u; i += GSTR) { const int t = hsh(i * 47u + 23u) % (unsigned)T;
        double ss = 0; for (int k = 0; k < D; ++k) { const double v = x[(size_t)t * D + k]; ss += v * v; }
        const double rstd = 1.0 / sqrt(ss / D + 1e-6);
        double gl[4] = {0, 0, 0, 0};
        for (int k = 0; k < D; ++k) { const double v = x[(size_t)t * D + k] * rstd * gain[k]; for (int q = 0; q < 4; ++q) gl[q] += v * wgrp[k * 4 + q]; }
        int gi = 0; for (int q = 1; q < 4; ++q) if (gl[q] > gl[gi]) gi = q;
        double gs = 0; for (int q = 0; q < 4; ++q) gs += exp(gl[q] - gl[gi]);
        double el[8] = {0, 0, 0, 0, 0, 0, 0, 0};
        for (int k = 0; k < D; ++k) { const double v = x[(size_t)t * D + k] * rstd * gain[k]; for (int q = 0; q < 8; ++q) el[q] += v * wexp[k * 32 + gi * 8 + q]; }
        int i1 = 0; for (int q = 1; q < 8; ++q) if (el[q] > el[i1]) i1 = q;
        int i2 = (i1 == 0) ? 1 : 0; for (int q = 0; q < 8; ++q) if (q != i1 && el[q] > el[i2]) i2 = q;
        const double eb = exp(el[i2] - el[i1]);
        const int e1 = tok_e[2 * t], e2 = tok_e[2 * t + 1];
        double third = -1e30; for (int q = 0; q < 8; ++q) if (q != i1 && q != i2 && el[q] > third) third = el[q];
        const bool tie = (el[i2] - third) < 1e-4 || (el[i1] - el[i2]) < 1e-4;
        if (!tie) { rep(w, e1, gi * 8 + i1, 1.0); rep(w, e2, gi * 8 + i2, 1.0);
            rep(w, tok_w[2 * t], 1.0 / gs / (1.0 + eb), 0.3); rep(w, tok_w[2 * t + 1], eb / gs / (1.0 + eb), 0.3); }
        if ((unsigned)tok_p[2 * t] >= cnt[64 * (e1 & 31)] || (unsigned)tok_p[2 * t + 1] >= cnt[64 * (e2 & 31)]) rep(w, 9.0, 0.0, 1.0); }
}
__global__ void ck_gather(const int* tok_e, const int* tok_p, const int* slot_of, const unsigned* cnt, const bf16_t* hn, const bf16_t* ag, unsigned* w) {
    for (unsigned i = GTID; i < 8192u; i += GSTR) { const unsigned r = hsh(i * 53u + 29u); const int a = r % (2u * T), k = (r >> 16) % 2048u, e = tok_e[a] & 31;
        int ps = 0; for (int q = 0; q < e; ++q) ps += ((int)cnt[64 * q] + 255) & ~255;
        const int slot = slot_of[a];
        rep(w, slot, ps + tok_p[a], 1.0);
        if (slot >= 0 && slot < MAX_TILES * 256) rep(w, bfd(ag[(size_t)slot * D + k]), bfd(hn[(size_t)(a >> 1) * D + k]), 1.0); }
}
__global__ void ck_moe1(const int* tok_e, const int* slot_of, const bf16_t* ag, const float* wg, const float* wu, const bf16_t* hh, unsigned* w) {
    for (unsigned i = GTID; i < 8192u; i += GSTR) { const unsigned r = hsh(i * 59u + 31u); const int a = r % (2u * T), f = (r >> 16) % 512u, e = tok_e[a] & 31, slot = slot_of[a];
        if (slot < 0 || slot >= MAX_TILES * 256) { rep(w, 9.0, 0.0, 1.0); continue; }
        double g = 0, u = 0; for (int k = 0; k < D; ++k) { const double v = bfd(ag[(size_t)slot * D + k]); g += v * wg[((size_t)e * D + k) * DFF + f]; u += v * wu[((size_t)e * D + k) * DFF + f]; }
        rep(w, bfd(hh[(size_t)slot * DFF + f]), g / (1.0 + exp(-g)) * u, 0.5); }
}
__global__ void ck_moe2(const int* tok_e, const int* slot_of, const bf16_t* hh, const float* wd, const bf16_t* ob, unsigned* w) {
    for (unsigned i = GTID; i < 8192u; i += GSTR) { const unsigned r = hsh(i * 61u + 37u); const int a = r % (2u * T), n = (r >> 16) % 2048u, e = tok_e[a] & 31, slot = slot_of[a];
        if (slot < 0 || slot >= MAX_TILES * 256) { rep(w, 9.0, 0.0, 1.0); continue; }
        double s = 0; for (int f = 0; f < DFF; ++f) s += bfd(hh[(size_t)slot * DFF + f]) * wd[((size_t)e * DFF + f) * D + n];
        rep(w, bfd(ob[(size_t)slot * D + n]), s, 0.3); }
}
__global__ void ck_combine(const float* save, const bf16_t* ob, const int* slot_of, const float* tok_w, const float* gain, const float* x, const bf16_t* hn, int mode, unsigned* w) {
    for (unsigned i = GTID; i < (unsigned)NSAVE * 32u; i += GSTR) { const int si = i / 32, t = srow(si), j = hsh(i * 67u + 41u) % 2048u;
        const int s0 = slot_of[2 * t], s1 = slot_of[2 * t + 1]; const double w0 = tok_w[2 * t], w1 = tok_w[2 * t + 1];
        double ss = 0, xj = 0; for (int k = 0; k < D; ++k) { const double v = save[(size_t)si * D + k] + w0 * bfd(ob[(size_t)s0 * D + k]) + w1 * bfd(ob[(size_t)s1 * D + k]); ss += v * v; if (k == j) xj = v; }
        const double y = xj / sqrt(ss / D + 1e-6) * gain[j];
        if (mode == 0) { rep(w, x[(size_t)t * D + j], xj, 1.0); rep(w, bfd(hn[(size_t)t * D + j]), y, 1.0); } else rep(w, x[(size_t)t * D + j], y, 1.0); }
}
__global__ void ck_attn(const bf16_t* proj, const bf16_t* o1, const bf16_t* o2, unsigned* w) {
    const int wv = GTID / 64, lane = threadIdx.x & 63, nw = GSTR / 64;
    const int tl[12] = {0, 1, 63, 64, 100, 255, 256, 1000, 4095, 8191, 16320, 16383};
    for (int s = wv; s < 96; s += nw) { const unsigned r = hsh(s * 71u + 43u); const int b = r & 1, h = (r >> 1) % 8u, sub = (r >> 4) & 1, t = tl[s % 12], dv0 = (r >> 5) % 253u;
        const double slope = exp2(-(double)(h + 1)); const int kend = 64 * (t / 64 + 1);
        const bf16_t* qp = proj + dq_off(b, t, h, sub);
        double mx = -1e300;
        for (int j = lane; j < kend; j += 64) { const bf16_t* kp = proj + DK0 + dq_off(b, j, h, sub); double d = 0; for (int q = 0; q < 128; ++q) d += bfd(qp[q]) * bfd(kp[q]);
            const double sc = d * 0.08838834764831845 - slope * fabs((double)(t - j)); if (sc > mx) mx = sc; }
        for (int of = 1; of < 64; of <<= 1) { const double o_ = __shfl_xor(mx, of); if (o_ > mx) mx = o_; }
        double l = 0, acc[4] = {0, 0, 0, 0};
        for (int j = lane; j < kend; j += 64) { const bf16_t* kp = proj + DK0 + dq_off(b, j, h, sub); double d = 0; for (int q = 0; q < 128; ++q) d += bfd(qp[q]) * bfd(kp[q]);
            const double p = exp(d * 0.08838834764831845 - slope * fabs((double)(t - j)) - mx); l += p;
            const bf16_t* vp = proj + dv_off(b, j, h) + dv0; for (int q = 0; q < 4; ++q) acc[q] += p * bfd(vp[q]); }
        for (int of = 1; of < 64; of <<= 1) { l += __shfl_xor(l, of); for (int q = 0; q < 4; ++q) acc[q] += __shfl_xor(acc[q], of); }
        if (lane == 0) for (int q = 0; q < 4; ++q) rep(w, bfd((sub ? o2 : o1)[((size_t)b * SEQ + t) * D + h * 256 + dv0 + q]), acc[q] / l, 0.2); }
}
__global__ void ck_subln(const bf16_t* o1, const bf16_t* o2, const float* lq1, const float* lk1, const float* lq2, const float* lk2, const float* sg, const bf16_t* y, unsigned* w) {
    double d1 = 0, d2 = 0; for (int k = 0; k < 128; ++k) { d1 += (double)lq1[k] * lk1[k]; d2 += (double)lq2[k] * lk2[k]; }
    const double li = 0.8 - 0.6 * exp(-0.3), lam = exp(d1) - exp(d2) + li;
    for (unsigned i = GTID; i < 8192u; i += GSTR) { const unsigned r = hsh(i * 73u + 47u); const int t = r % (unsigned)T, h = (r >> 15) % 8u, j = (r >> 18) % 256u;
        double ss = 0, dj = 0; for (int k = 0; k < 256; ++k) { const double v = bfd(o1[(size_t)t * D + h * 256 + k]) - lam * bfd(o2[(size_t)t * D + h * 256 + k]); ss += v * v; if (k == j) dj = v; }
        rep(w, bfd(y[(size_t)t * D + h * 256 + j]), dj / sqrt(ss / 256 + 1e-6) * sg[j] * (1.0 - li), 1.0); }
}
__global__ void ck_final(const unsigned* words, int nst, float* out, int n) {
    int val = 0;
    for (int s = 0; s < nst; ++s) { const float e = __uint_as_float(words[s]); if (e >= 0.03125f) { val = 4 * s + (e < 0.25f ? 1 : (e < 4.f ? 2 : 3)); break; } }
    const float c = sqrtf(0.1f * (float)val);
    for (int i = GTID; i < n; i += GSTR) out[i] = c;
}
#endif

extern "C" void kernel_launch(void* const* d_in, const int* in_sizes, int n_in, void* d_out, int out_size, void* d_ws, size_t ws_size, hipStream_t stream) {
    static int grid = 0;
    if (grid == 0) {
        if (n_in != 21 || out_size != T * D || ws_size < WS_END + 2 * MiB) { fprintf(stderr, "kernel_launch: unexpected shapes (n_in %d out %d ws %zu)\n", n_in, out_size, ws_size); grid = -1; return; }
        if (hipFuncSetAttribute((const void*)hybrid_fwd, hipFuncAttributeMaxDynamicSharedMemorySize, LDS_BYTES) != hipSuccess) { fprintf(stderr, "kernel_launch: hipFuncSetAttribute failed\n"); grid = -1; return; }
        int dev = 0, cus = 0, per_cu = 0;
        (void)hipGetDevice(&dev); (void)hipDeviceGetAttribute(&cus, hipDeviceAttributeMultiprocessorCount, dev);
        if (hipOccupancyMaxActiveBlocksPerMultiprocessor(&per_cu, (const void*)hybrid_fwd, NWAVES * 64, LDS_BYTES) != hipSuccess || per_cu < 1) fprintf(stderr, "kernel_launch: occupancy query says %d\n", per_cu);
        (void)hipGetLastError();
        grid = cus > 0 ? cus : 256;
    }
    if (grid < 0) return;
    Args a{};
    for (int i = 0; i < 21; ++i) a.in[i] = (const float*)d_in[i];
    a.out = (float*)d_out; a.ws = (unsigned char*)d_ws; a.upto = 99; a.pad1 = 0;
#if !DIAG
    (void)hipMemsetAsync((char*)d_ws + WS_CTL, 0, CTL_ZERO_BYTES, stream);
    hipLaunchKernelGGL(hybrid_fwd, dim3(grid), dim3(NWAVES * 64), LDS_BYTES, stream, a);
#else
    {
        unsigned char* ws = (unsigned char*)d_ws; const float* const* in = a.in;
        unsigned* words = (unsigned*)(ws + WS_DIAG); float* save = (float*)(ws + WS_DIAG + 65536);
        (void)hipMemsetAsync(words, 0, 65536, stream);
        float* gz = (float*)(ws + WS_GZ); int* tok_e = (int*)(ws + WS_TOKE); int* tok_p = (int*)(ws + WS_TOKP); float* tok_w = (float*)(ws + WS_TOKW); int* slot_of = (int*)(ws + WS_SLOT);
        float* adec = (float*)(ws + WS_ADEC); float* wp_gz = (float*)(ws + WS_WPGZ); float* wp_r0 = (float*)(ws + WS_WPR0); float* wp_r1 = (float*)(ws + WS_WPR1);
        bf16_t* wgi = (bf16_t*)(ws + WS_WGI); bf16_t* wgo = (bf16_t*)(ws + WS_WGO); bf16_t* wdi = (bf16_t*)(ws + WS_WDI); bf16_t* wdo = (bf16_t*)(ws + WS_WDO);
        bf16_t* gu = (bf16_t*)(ws + WS_WMOE); bf16_t* dt = (bf16_t*)(ws + WS_WMOE_D);
        bf16_t* hn = (bf16_t*)(ws + WS_HN); bf16_t* proj = (bf16_t*)(ws + WS_PROJ); bf16_t* buf1 = (bf16_t*)(ws + WS_BUF1); bf16_t* buf2 = (bf16_t*)(ws + WS_BUF2);
        bf16_t* ag = (bf16_t*)(ws + WS_AG); bf16_t* ob = (bf16_t*)(ws + WS_OB); bf16_t* hh = (bf16_t*)(ws + WS_H);
        unsigned* ctl = (unsigned*)(ws + WS_CTL); float* xres = (float*)d_out;
        const size_t L1W = (size_t)NEXP * D * DFF;
        for (int st = 0; st <= 20; ++st) {
            (void)hipMemsetAsync((char*)d_ws + WS_CTL, 0, CTL_ZERO_BYTES, stream);
            a.upto = st;
            hipLaunchKernelGGL(hybrid_fwd, dim3(grid), dim3(NWAVES * 64), LDS_BYTES, stream, a);
            unsigned* w = words + st;
            switch (st) {
            case 0: ck_weights<<<256, 256, 0, stream>>>(in[3], in[7], in[8], in[14], wgi, wgo, wdi, wdo, in[1], in[2], in[15], in[16], wp_gz, wp_r0, wp_r1, w); break;
            case 1: ck_norm<<<64, 64, 0, stream>>>(in[0], in[1], hn, w); ck_gz<<<64, 64, 0, stream>>>(in[0], in[1], in[3], gz, w); break;
            case 2: ck_proj<<<256, 64, 0, stream>>>(hn, wgi, proj, 0, w); break;
            case 3: ck_gate<<<64, 64, 0, stream>>>(gz, in[4], in[5], proj, buf1, adec, w); break;
            case 4: ck_scan<<<96, 64, 0, stream>>>(proj, buf1, adec, buf2, w); ck_moew<<<256, 256, 0, stream>>>(in[17], in[18], in[19], gu, dt, w); break;
            case 5: ck_gnorm<<<128, 64, 0, stream>>>(buf2, proj, in[6], hn, w); break;
            case 6: ck_gemm_res<<<64, 64, 0, stream>>>(hn, wgo, in[0], 0, xres, w); break;
            case 7: ck_norm<<<64, 64, 0, stream>>>(xres, in[2], hn, w); ck_route<<<8, 64, 0, stream>>>(xres, in[2], in[15], in[16], tok_e, tok_p, tok_w, ctl + CW_CNT0, w); break;
            case 8: ck_gather<<<128, 64, 0, stream>>>(tok_e, tok_p, slot_of, ctl + CW_CNT0, hn, ag, w); break;
            case 9: ck_moe1<<<128, 64, 0, stream>>>(tok_e, slot_of, ag, in[17], in[18], hh, w); break;
            case 10: ck_moe2<<<128, 64, 0, stream>>>(tok_e, slot_of, hh, in[19], ob, w); ck_save<<<64, 256, 0, stream>>>(xres, save); break;
            case 11: ck_combine<<<32, 64, 0, stream>>>(save, ob, slot_of, tok_w, in[1] + D, xres, hn, 0, w); ck_moew<<<256, 256, 0, stream>>>(in[17] + L1W, in[18] + L1W, in[19] + L1W, gu, dt, w); break;
            case 12: ck_proj<<<256, 64, 0, stream>>>(hn, wdi, proj, 1, w); break;
            case 13: ck_attn<<<96, 64, 0, stream>>>(proj, buf1, buf2, w); break;
            case 14: ck_subln<<<128, 64, 0, stream>>>(buf1, buf2, in[9], in[10], in[11], in[12], in[13], hn, w); ck_save<<<64, 256, 0, stream>>>(xres, save); break;
            case 15: ck_gemm_res<<<64, 64, 0, stream>>>(hn, wdo, save, 1, xres, w); break;
            case 16: ck_norm<<<64, 64, 0, stream>>>(xres, in[2] + D, hn, w); ck_route<<<8, 64, 0, stream>>>(xres, in[2] + D, in[15] + (size_t)D * 4, in[16] + (size_t)D * 32, tok_e, tok_p, tok_w, ctl + CW_CNT1, w); break;
            case 17: ck_gather<<<128, 64, 0, stream>>>(tok_e, tok_p, slot_of, ctl + CW_CNT1, hn, ag, w); break;
            case 18: ck_moe1<<<128, 64, 0, stream>>>(tok_e, slot_of, ag, in[17] + L1W, in[18] + L1W, hh, w); break;
            case 19: ck_moe2<<<128, 64, 0, stream>>>(tok_e, slot_of, hh, in[19] + L1W, ob, w); ck_save<<<64, 256, 0, stream>>>(xres, save); break;
            case 20: ck_combine<<<32, 64, 0, stream>>>(save, ob, slot_of, tok_w, in[20], xres, hn, 1, w); break;
            }
        }
        ck_final<<<1024, 256, 0, stream>>>(words, 21, (float*)d_out, out_size);
    }
#endif
}
```

```cpp
#ifndef DIAG
#define DIAG 0
#endif
#ifndef PROBE
#define PROBE 0
#endif
#ifndef REP_PHASE
#define REP_PHASE -1
#endif
#include <hip/hip_runtime.h>
#include <cstdio>
#include <cstdint>

#define LAS __attribute__((address_space(3)))
#define GAS __attribute__((address_space(1)))
typedef unsigned short bf16_t;
typedef short bf16x8 __attribute__((ext_vector_type(8)));
typedef short s16x4 __attribute__((ext_vector_type(4)));
typedef float f32x4 __attribute__((ext_vector_type(4)));
typedef float f32x2 __attribute__((ext_vector_type(2)));
typedef float f32x16 __attribute__((ext_vector_type(16)));
typedef unsigned u32x4 __attribute__((ext_vector_type(4)));
typedef unsigned u32x2 __attribute__((ext_vector_type(2)));

constexpr int D = 2048, SEQ = 16384, NBATCH = 2, T = NBATCH * SEQ, CHUNK = 64, NCH = SEQ / CHUNK;
constexpr int GLA_H = 4, GLA_DK = 256, GLA_DV = 512, GLA_DKT = 1024, GLA_INW = 6160, PROJW = 6144;
constexpr int DIFF_H = 8;
constexpr int NEXP = 32, DFF = 512;
constexpr float RMS_EPS = 1e-6f;
constexpr float LAMBDA_INIT = 0.35550906759f;
constexpr int MAX_TILES = 288;

constexpr size_t MiB = 1u << 20;
constexpr size_t WS_CTL = 0, CTL_ZERO_BYTES = 1 * MiB;
constexpr size_t WS_GZ = 2 * MiB;
constexpr size_t WS_TOKE = 4 * MiB;
constexpr size_t WS_TOKP = WS_TOKE + 256 * 1024;
constexpr size_t WS_TOKW = WS_TOKP + 256 * 1024;
constexpr size_t WS_SLOT = WS_TOKW + 256 * 1024;
constexpr size_t WS_STOK = 5 * MiB;
constexpr size_t WS_ADEC = 8 * MiB;
constexpr size_t WS_WPGZ = 10 * MiB;
constexpr size_t WS_WPR0 = 10 * MiB + 256 * 1024;
constexpr size_t WS_WPR1 = 11 * MiB;
constexpr size_t WS_NRM = 12 * MiB;
constexpr size_t WS_PCUM = 13 * MiB;
constexpr size_t WS_SFIN = 14 * MiB;
constexpr size_t WS_WGI = 16 * MiB, WS_WGO = 40 * MiB, WS_WDI = 48 * MiB, WS_WDO = 72 * MiB;
constexpr size_t WS_WMOE = 80 * MiB;
constexpr size_t WS_WMOE_D = WS_WMOE + 128 * MiB;
constexpr size_t WS_HN = 272 * MiB;
constexpr size_t WS_PROJ = 400 * MiB;
constexpr size_t WS_BUF1 = 784 * MiB;
constexpr size_t WS_BUF2 = 912 * MiB;
constexpr size_t WS_AG = 400 * MiB;
constexpr size_t WS_OB = 688 * MiB;
constexpr size_t WS_H = 976 * MiB;
constexpr size_t WS_END = 1048 * MiB;
constexpr int CW_BAR = 4096;
constexpr int CW_PROBE = 8320;
constexpr int CW_QUEUE = 8192;
constexpr int CW_CNT0 = 16384, CW_CNT1 = 16384 + 32 * 64;


constexpr size_t GK0 = (size_t)T * 1024, GV0 = (size_t)T * 2048, GR0 = (size_t)T * 4096;
constexpr size_t DK0 = (size_t)T * 2048, DV0 = (size_t)T * 4096;
__host__ __device__ __forceinline__ size_t gq_off(int b, int t, int h) { return ((size_t)(b * 4 + h) * SEQ + t) * 256; }
__host__ __device__ __forceinline__ size_t gv_off(int b, int t, int h) { return GV0 + ((size_t)(b * 4 + h) * SEQ + t) * 512; }
__host__ __device__ __forceinline__ size_t dq_off(int b, int t, int h, int sub) { return ((size_t)((b * 8 + h) * 2 + sub) * SEQ + t) * 128; }
__host__ __device__ __forceinline__ size_t dv_off(int b, int t, int h) { return DV0 + ((size_t)(b * 8 + h) * SEQ + t) * 256; }

constexpr int RING_BYTES = 131072;
constexpr int LDSCTL_OFF = RING_BYTES;
constexpr int MISC_OFF = LDSCTL_OFF + 320;
constexpr int TAB_OFF = LDSCTL_OFF + 1024;
constexpr int LDS_BYTES = 147456;
constexpr int NWAVES = 8;

typedef __bf16 bf16x2_t __attribute__((ext_vector_type(2)));
__device__ __forceinline__ unsigned cvt_pk_bf16(float lo, float hi) { const f32x2 v = {lo, hi}; return __builtin_bit_cast(unsigned, __builtin_convertvector(v, bf16x2_t)); }
__device__ __forceinline__ float bf_lo(unsigned w) { return __uint_as_float(w << 16); }
__device__ __forceinline__ float bf_hi(unsigned w) { return __uint_as_float(w & 0xffff0000u); }
__device__ __forceinline__ float bf2f(bf16_t b) { return __uint_as_float(((unsigned)b) << 16); }
__device__ __forceinline__ float wave_sum(float v) {
#pragma unroll
    for (int o = 1; o < 64; o <<= 1) v += __shfl_xor(v, o);
    return v;
}
__device__ __forceinline__ int opq(int v) { asm volatile("" : "+v"(v)); return v; }
#define LDS_WAIT() asm volatile("s_waitcnt lgkmcnt(0)" ::: "memory")
#define VM_WAIT() asm volatile("s_waitcnt vmcnt(0)" ::: "memory")
#define WG_BAR() do { asm volatile("s_waitcnt lgkmcnt(0)" ::: "memory"); __builtin_amdgcn_s_barrier(); asm volatile("" ::: "memory"); } while (0)

namespace pg8 {
constexpr int BM = 256, BK = 64, HALF = 128, HTB = HALF * BK * 2, STAGE_BYTES = 8 * HTB, NXCD = 8, WGM = 8;
__host__ __device__ __forceinline__ int lds_byte(int r, int c) { const int st = (r >> 4) * 2 + (c >> 5), rr = r & 15, cc = c & 31, ob = rr * 64 + cc * 2; return st * 1024 + (ob ^ (((ob >> 9) & 1) << 5)); }
__host__ __device__ __forceinline__ void stage_rc(int b, int& R, int& C) { const int st = b / 1024, sb = b % 1024, swz = sb ^ (((sb >> 9) & 1) << 5); R = (st >> 1) * 16 + swz / 64; C = (st & 1) * 32 + (swz % 64) / 2; }
__host__ __device__ __forceinline__ int perm32(int rho) { const int n = rho >> 4, i = rho & 15; return 8 * (i >> 2) + 4 * n + (i & 3); }

struct Unit { int pm, pn; };
struct Gemm { const bf16_t* A; const bf16_t* Bt; int M, N, K; };

struct StaticOrder {
    int nM, nN, nwg, G, c;
    __device__ void init(int M, int N, int G_, int c_) { nM = M / BM; nN = N / BM; nwg = nM * nN; G = G_; c = c_; }
    __device__ bool next(int i, Unit& u) const {
        const long L = (long)i * G + c; if (L >= nwg) return false;
        int wgid = (int)L; { const int q = nwg / NXCD, r = nwg % NXCD, xcd = wgid % NXCD, off = wgid / NXCD; wgid = (xcd < r ? xcd * (q + 1) : r * (q + 1) + (xcd - r) * q) + off; }
        const int nig = WGM * nN, gid = wgid / nig, fm = gid * WGM, gsz = (nM - fm) < WGM ? (nM - fm) : WGM;
        u.pm = fm + ((wgid % nig) % gsz); u.pn = (wgid % nig) / gsz; return true;
    }
    __device__ __forceinline__ size_t bofs(const Unit&) const { return 0; }
};
struct MoeOrder : StaticOrder {
    const LAS int* te; size_t estride; const int* stok;
    __device__ __forceinline__ size_t bofs(const Unit& u) const { return (size_t)te[u.pm] * estride; }
    __device__ __forceinline__ int arow(int pm, int r) const { const int t = stok[pm * BM + r]; return t < 0 ? 0 : t; }
};

struct EpiBf16 {
    static constexpr bool PERM = true;
    bf16_t* O; int ldc;
    __device__ __forceinline__ void operator()(const f32x4 (&acc)[2][2][4][2], const Unit& u, int wr, int wc, int fr, int fq) const {
        const int row0 = u.pm * BM + wr * 64 + fr, col0 = u.pn * BM + wc * 32 + 8 * fq;
#pragma unroll
        for (int ai = 0; ai < 2; ++ai)
#pragma unroll
            for (int m = 0; m < 4; ++m) { bf16_t* rowp = O + (size_t)(row0 + ai * HALF + m * 16) * ldc + col0;
#pragma unroll
                for (int bj = 0; bj < 2; ++bj) { const f32x4 v0 = acc[ai][bj][m][0], v1 = acc[ai][bj][m][1];
                    u32x4 w; w.x = cvt_pk_bf16(v0[0], v0[1]); w.y = cvt_pk_bf16(v0[2], v0[3]); w.z = cvt_pk_bf16(v1[0], v1[1]); w.w = cvt_pk_bf16(v1[2], v1[3]);
                    *(u32x4*)(rowp + bj * HALF) = w; } }
    }
};
template <int LAYER> struct EpiHeads {
    static constexpr bool PERM = true;
    bf16_t* O;
    __device__ __forceinline__ void operator()(const f32x4 (&acc)[2][2][4][2], const Unit& u, int wr, int wc, int fr, int fq) const {
        const int pn = u.pn, lc = wc * 32 + 8 * fq;
#pragma unroll
        for (int ai = 0; ai < 2; ++ai)
#pragma unroll
            for (int m = 0; m < 4; ++m) { const int row = u.pm * BM + ai * HALF + wr * 64 + m * 16 + fr, b = row >> 14, t = row & (SEQ - 1);
#pragma unroll
                for (int bj = 0; bj < 2; ++bj) { size_t off;
                    if (LAYER == 0) { if (pn < 4) off = gq_off(b, t, pn) + bj * 128 + lc; else if (pn < 8) off = GK0 + gq_off(b, t, pn - 4) + bj * 128 + lc;
                                      else if (pn < 16) off = gv_off(b, t, (pn - 8) >> 1) + ((pn - 8) & 1) * 256 + bj * 128 + lc; else off = GR0 + (size_t)row * 2048 + (pn - 16) * 256 + bj * 128 + lc; }
                    else { if (pn < 8) off = dq_off(b, t, pn, bj) + lc; else if (pn < 16) off = DK0 + dq_off(b, t, pn - 8, bj) + lc; else off = dv_off(b, t, pn - 16) + bj * 128 + lc; }
                    const f32x4 v0 = acc[ai][bj][m][0], v1 = acc[ai][bj][m][1];
                    u32x4 w; w.x = cvt_pk_bf16(v0[0], v0[1]); w.y = cvt_pk_bf16(v0[2], v0[3]); w.z = cvt_pk_bf16(v1[0], v1[1]); w.w = cvt_pk_bf16(v1[2], v1[3]);
                    *(u32x4*)(O + off) = w; } }
    }
};
struct FixOrder : StaticOrder {
    __device__ __forceinline__ size_t bofs(const Unit& u) const { return (size_t)(u.pm >> 5) * (512 * 256 * 2); }
};
struct EpiAddO {
    static constexpr bool PERM = true;
    bf16_t* O;
    __device__ __forceinline__ void operator()(const f32x4 (&acc)[2][2][4][2], const Unit& u, int wr, int wc, int fr, int fq) const {
#pragma unroll
        for (int ai = 0; ai < 2; ++ai)
#pragma unroll
            for (int m = 0; m < 4; ++m) { const int row = u.pm * BM + ai * HALF + wr * 64 + m * 16 + fr, bhh = row >> 13, t = row & 8191;
                bf16_t* rowp = O + ((size_t)(bhh >> 2) * SEQ + SEQ / 2 + t) * D + (bhh & 3) * 512 + u.pn * BM + wc * 32 + 8 * fq;
#pragma unroll
                for (int bj = 0; bj < 2; ++bj) { const u32x4 old = *(const u32x4*)(rowp + bj * HALF); const f32x4 v0 = acc[ai][bj][m][0] * 0.0625f, v1 = acc[ai][bj][m][1] * 0.0625f;
                    u32x4 w; w.x = cvt_pk_bf16(bf_lo(old.x) + v0[0], bf_hi(old.x) + v0[1]); w.y = cvt_pk_bf16(bf_lo(old.y) + v0[2], bf_hi(old.y) + v0[3]);
                    w.z = cvt_pk_bf16(bf_lo(old.z) + v1[0], bf_hi(old.z) + v1[1]); w.w = cvt_pk_bf16(bf_lo(old.w) + v1[2], bf_hi(old.w) + v1[3]);
                    *(u32x4*)(rowp + bj * HALF) = w; } }
    }
};
struct EpiResF32 {
    static constexpr bool PERM = false;
    const float* base; float* C; int ldc;
    __device__ __forceinline__ void operator()(const f32x4 (&acc)[2][2][4][2], const Unit& u, int wr, int wc, int fr, int fq) const {
        const int row0 = u.pm * BM + wr * 64 + fr, col0 = u.pn * BM + wc * 32 + 4 * fq;
#pragma unroll
        for (int ai = 0; ai < 2; ++ai)
#pragma unroll
            for (int m = 0; m < 4; ++m) { const size_t off = (size_t)(row0 + ai * HALF + m * 16) * ldc + col0;
#pragma unroll
                for (int bj = 0; bj < 2; ++bj)
#pragma unroll
                    for (int n = 0; n < 2; ++n) { const f32x4 bs = *(const f32x4*)(base + off + bj * HALF + n * 16); *(f32x4*)(C + off + bj * HALF + n * 16) = bs + acc[ai][bj][m][n]; }
                asm volatile("" ::: "memory"); }
    }
};
struct EpiSiluMul {
    static constexpr bool PERM = true;
    bf16_t* Hh;
    __device__ __forceinline__ void operator()(const f32x4 (&acc)[2][2][4][2], const Unit& u, int wr, int wc, int fr, int fq) const {
        const int row0 = u.pm * BM + wr * 64 + fr, col0 = u.pn * HALF + wc * 32 + 8 * fq;
#pragma unroll
        for (int ai = 0; ai < 2; ++ai)
#pragma unroll
            for (int m = 0; m < 4; ++m) { bf16_t* rowp = Hh + (size_t)(row0 + ai * HALF + m * 16) * DFF + col0;
                float hv[8];
#pragma unroll
                for (int n = 0; n < 2; ++n)
#pragma unroll
                    for (int j = 0; j < 4; ++j) { const float g = acc[ai][0][m][n][j], up = acc[ai][1][m][n][j];
                        const float sg = g * __builtin_amdgcn_rcpf(1.0f + __builtin_amdgcn_exp2f(-1.4426950408889634f * g)); hv[n * 4 + j] = sg * up; }
                u32x4 w; w.x = cvt_pk_bf16(hv[0], hv[1]); w.y = cvt_pk_bf16(hv[2], hv[3]); w.z = cvt_pk_bf16(hv[4], hv[5]); w.w = cvt_pk_bf16(hv[6], hv[7]);
                *(u32x4*)rowp = w; }
    }
};

template <class Epi, class Sched, bool GATHER = false>
__device__ __forceinline__ void gemm_phase(LAS unsigned char* lds, const Gemm g, const Sched& S, const Epi& E) {
    const int tid = opq((int)threadIdx.x), wid = __builtin_amdgcn_readfirstlane(tid >> 6), lane = tid & 63, wr = wid >> 2, wc = wid & 3, fr = lane & 15, fq = lane >> 4;
    const int K = g.K, nt = K / BK;
    unsigned voffA[2], voffB[2]; int rA[2]; unsigned cA2[2];
#pragma unroll
    for (int i = 0; i < 2; ++i) { int R, C; stage_rc(tid * 16 + i * 8192, R, C); const int Rb = Epi::PERM ? ((R & ~31) + perm32(R & 31)) : R;
        voffA[i] = (unsigned)(R * K + C) * 2u; voffB[i] = (unsigned)(Rb * K + C) * 2u; rA[i] = R; cA2[i] = (unsigned)C * 2u; }
    const size_t kstep = (size_t)(BK * 2);
    const size_t hstep = (size_t)HALF * K * 2;
    const size_t tstep = 2 * hstep;
    const unsigned ldsw = (unsigned)wid * 1024u;
    const int aoff = lds_byte(wr * 64 + fr, fq * 8), boff = lds_byte(wc * 32 + fr, fq * 8);
#define PG8_SA(b, h) (((b) * 2 + (h)) * HTB)
#define PG8_SB(b, h) ((4 + (b) * 2 + (h)) * HTB)
#define PG8_STAGE(bufoff, gbase, voff) do { _Pragma("unroll") for (int _i = 0; _i < 2; ++_i) \
        __builtin_amdgcn_global_load_lds((const unsigned*)((const char*)(gbase) + (voff)[_i]), (LAS unsigned*)(lds + (bufoff) + ldsw + _i * 8192), 16, 0, 0); } while (0)
#define PG8_STAGE_A(bufoff, nx, koff, h) do { if constexpr (GATHER) { unsigned vs_[2]; _Pragma("unroll") for (int _i = 0; _i < 2; ++_i) vs_[_i] = (nx) ? vAn[h][_i] : vAc[h][_i]; \
            PG8_STAGE(bufoff, (const char*)g.A + (koff), vs_); } \
        else { PG8_STAGE(bufoff, ((nx) ? nA : cA) + (koff) + (h) * hstep, voffA); } } while (0)
#define PG8_LDA(dst, b, h) do { _Pragma("unroll") for (int m = 0; m < 4; ++m) _Pragma("unroll") for (int k = 0; k < 2; ++k) dst[m][k] = *(const LAS bf16x8*)(lds + PG8_SA(b, h) + aoff + m * 2048 + k * 1024); } while (0)
#define PG8_LDB(dst, b, h) do { _Pragma("unroll") for (int n = 0; n < 2; ++n) _Pragma("unroll") for (int k = 0; k < 2; ++k) dst[n][k] = *(const LAS bf16x8*)(lds + PG8_SB(b, h) + boff + n * 2048 + k * 1024); } while (0)
#define PG8_MMA(ai, bj, At, Bt) do { __builtin_amdgcn_s_setprio(1); _Pragma("unroll") for (int m = 0; m < 4; ++m) _Pragma("unroll") for (int n = 0; n < 2; ++n) _Pragma("unroll") for (int k = 0; k < 2; ++k) \
        acc[ai][bj][m][n] = __builtin_amdgcn_mfma_f32_16x16x32_bf16(Bt[n][k], At[m][k], acc[ai][bj][m][n], 0, 0, 0); __builtin_amdgcn_s_setprio(0); } while (0)
#define PG8_WAIT_V(n) asm volatile("s_waitcnt vmcnt(" #n ")" ::: "memory")
#define PG8_WAIT_L(n) asm volatile("s_waitcnt lgkmcnt(" #n ")" ::: "memory")
#define PG8_BAR __builtin_amdgcn_s_barrier()
#define PG8_SCHED __builtin_amdgcn_sched_barrier(0)
#define PG8_ROWOFFS(V, U) do { if constexpr (GATHER) { _Pragma("unroll") for (int h_ = 0; h_ < 2; ++h_) _Pragma("unroll") for (int i_ = 0; i_ < 2; ++i_) \
        V[h_][i_] = (unsigned)S.arow((U).pm, h_ * HALF + rA[i_]) * (unsigned)(K * 2) + cA2[i_]; } } while (0)
    Unit cur, nxt; int ui = 0;
    if (!S.next(0, cur)) return;
    f32x4 acc[2][2][4][2];
#pragma unroll
    for (int a = 0; a < 2; ++a)
#pragma unroll
        for (int b = 0; b < 2; ++b)
#pragma unroll
            for (int m = 0; m < 4; ++m)
#pragma unroll
                for (int n = 0; n < 2; ++n) acc[a][b][m][n] = (f32x4){0.f, 0.f, 0.f, 0.f};
    bf16x8 At[4][2], B0[2][2], B1[2][2];
    unsigned vAc[2][2] = {{0u, 0u}, {0u, 0u}}, vAn[2][2] = {{0u, 0u}, {0u, 0u}};
    const char* cA = (const char*)g.A + (GATHER ? (size_t)0 : (size_t)cur.pm * tstep); const char* nA = cA; const char* cB = (const char*)g.Bt + S.bofs(cur) + (size_t)cur.pn * tstep;
    PG8_ROWOFFS(vAc, cur);
    PG8_STAGE(PG8_SB(0, 0), cB, voffB); PG8_STAGE(PG8_SB(0, 1), cB + hstep, voffB); PG8_STAGE_A(PG8_SA(0, 0), false, (size_t)0, 0); PG8_STAGE_A(PG8_SA(0, 1), false, (size_t)0, 1);
    if (wr == 1) PG8_BAR;
    PG8_WAIT_V(2); PG8_BAR;
    PG8_STAGE(PG8_SB(1, 0), cB + kstep, voffB); PG8_STAGE_A(PG8_SA(1, 0), false, kstep, 0); PG8_STAGE(PG8_SB(1, 1), cB + hstep + kstep, voffB);
    PG8_WAIT_V(6); PG8_BAR;
    for (;;) {
        const bool has_next = S.next(ui + 1, nxt);
        nA = (has_next && !GATHER) ? (const char*)g.A + (size_t)nxt.pm * tstep : cA; const char* nB = has_next ? (const char*)g.Bt + S.bofs(nxt) + (size_t)nxt.pn * tstep : cB;
        if (has_next) PG8_ROWOFFS(vAn, nxt); else { if constexpr (GATHER) { _Pragma("unroll") for (int h_ = 0; h_ < 2; ++h_) _Pragma("unroll") for (int i_ = 0; i_ < 2; ++i_) vAn[h_][i_] = vAc[h_][i_]; } }
        for (int t = 0; t < nt; t += 2) {
            const bool last = (t == nt - 2);
            const size_t k1 = (size_t)(t + 1) * kstep, k2 = last ? (size_t)0 : (size_t)(t + 2) * kstep, k3 = k2 + kstep;
            const char* b2 = last ? nB : cB + (size_t)(t + 2) * kstep; const char* b3 = b2 + kstep;
            PG8_LDB(B0, 0, 0); PG8_LDB(B1, 0, 1); PG8_SCHED; PG8_LDA(At, 0, 0); PG8_STAGE_A(PG8_SA(1, 1), false, k1, 1);
            PG8_WAIT_V(8); PG8_WAIT_L(0); PG8_BAR; PG8_MMA(0, 0, At, B0); PG8_MMA(0, 1, At, B1); PG8_BAR; PG8_SCHED;
            PG8_LDA(At, 0, 1); PG8_STAGE(PG8_SB(0, 0), b2, voffB); PG8_STAGE(PG8_SB(0, 1), b2 + hstep, voffB); PG8_STAGE_A(PG8_SA(0, 0), last, k2, 0);
            PG8_WAIT_V(8); PG8_WAIT_L(0); PG8_BAR; PG8_MMA(1, 0, At, B0); PG8_MMA(1, 1, At, B1); PG8_BAR; PG8_SCHED;
            PG8_LDB(B0, 1, 0); PG8_LDB(B1, 1, 1); PG8_SCHED; PG8_LDA(At, 1, 0); PG8_STAGE_A(PG8_SA(0, 1), last, k2, 1);
            PG8_WAIT_V(8); PG8_WAIT_L(0); PG8_BAR; PG8_MMA(0, 0, At, B0); PG8_MMA(0, 1, At, B1); PG8_BAR; PG8_SCHED;
            PG8_LDA(At, 1, 1); PG8_STAGE(PG8_SB(1, 0), b3, voffB); PG8_STAGE(PG8_SB(1, 1), b3 + hstep, voffB); PG8_STAGE_A(PG8_SA(1, 0), last, k3, 0);
            PG8_WAIT_V(8); PG8_WAIT_L(0); PG8_BAR; PG8_MMA(1, 0, At, B0); PG8_MMA(1, 1, At, B1); PG8_BAR; PG8_SCHED;
        }
        if (wr == 0) PG8_BAR;
        E(acc, cur, wr, wc, fr, fq);
        if (!has_next) break;
#pragma unroll
        for (int a = 0; a < 2; ++a)
#pragma unroll
            for (int b = 0; b < 2; ++b)
#pragma unroll
                for (int m = 0; m < 4; ++m)
#pragma unroll
                    for (int n = 0; n < 2; ++n) acc[a][b][m][n] = (f32x4){0.f, 0.f, 0.f, 0.f};
        cur = nxt; cA = nA; cB = nB; ++ui;
        if constexpr (GATHER) { _Pragma("unroll") for (int h_ = 0; h_ < 2; ++h_) _Pragma("unroll") for (int i_ = 0; i_ < 2; ++i_) vAc[h_][i_] = vAn[h_][i_]; }
        if (wr == 1) PG8_BAR;
    }
    PG8_WAIT_V(0);
    PG8_BAR;
#undef PG8_SA
#undef PG8_SB
#undef PG8_STAGE
#undef PG8_STAGE_A
#undef PG8_ROWOFFS
#undef PG8_LDA
#undef PG8_LDB
#undef PG8_MMA
#undef PG8_WAIT_V
#undef PG8_WAIT_L
#undef PG8_BAR
#undef PG8_SCHED
}
}

#define XB_TMO      128
#define XB_XCNT(j)  (256  + 64 * (j))
#define XB_XSUB(j)  (1280 + 64 * (j))
#define XB_XGEN(j)  (2304 + 64 * (j))
#define XB_TOP      3328
#define XB_TOPGEN   3392
#define XCD_BAR_WORDS 3456
#define XB_SPIN_CAP (1u << 18)
__device__ __forceinline__ unsigned xb_ld(unsigned* p)              { return __hip_atomic_load(p, __ATOMIC_RELAXED, __HIP_MEMORY_SCOPE_AGENT); }
__device__ __forceinline__ unsigned xb_add(unsigned* p, unsigned v) { return __hip_atomic_fetch_add(p, v, __ATOMIC_RELAXED, __HIP_MEMORY_SCOPE_AGENT); }
__device__ __forceinline__ unsigned xb_xcc_id() { return (unsigned)__builtin_amdgcn_s_getreg((3 << 11) | 20) & 0xFu; }
#define XB_SPIN(cond, bar) do { unsigned _sp = 0; while (cond) { __builtin_amdgcn_s_sleep(1); \
    if ((++_sp & 255u) == 0u) { if (xb_ld(&(bar)[XB_TMO])) break; if (_sp > XB_SPIN_CAP) { atomicAdd(&(bar)[XB_TMO], 1u); break; } } } } while (0)
struct XcdBarrier { unsigned* bar; unsigned x; volatile LAS unsigned* st; };
__device__ __forceinline__ XcdBarrier xcd_barrier_post(unsigned* bar, volatile LAS unsigned* st) {
    XcdBarrier b; b.bar = bar; b.x = xb_xcc_id(); b.st = st;
    if (threadIdx.x == 0) (void)xb_add(&bar[XB_XCNT(b.x)], 1u);
    return b;
}
__device__ __forceinline__ void xcd_barrier_complete(unsigned* bar, unsigned x, unsigned& nloc, unsigned& nx) {
    const unsigned G = gridDim.x * gridDim.y * gridDim.z;
    unsigned sum, cnt, mine, sp = 0u;
    for (;;) {
        sum = 0u; cnt = 0u; mine = 0u;
#pragma unroll
        for (unsigned j = 0; j < 16; ++j) { const unsigned c = xb_ld(&bar[XB_XCNT(j)]); sum += c; cnt += (c > 0u) ? 1u : 0u; mine = (j == x) ? c : mine; }
        if (sum == G) break;
        __builtin_amdgcn_s_sleep(1);
        if ((++sp & 255u) == 0u) { if (xb_ld(&bar[XB_TMO])) break; if (sp > XB_SPIN_CAP) { atomicAdd(&bar[XB_TMO], 1u); break; } }
    }
    nloc = mine > 0u ? mine : 1u; nx = cnt > 0u ? cnt : 1u;
}
__device__ __forceinline__ void xcd_barrier(const XcdBarrier& b) {
    asm volatile("s_waitcnt vmcnt(0)" ::: "memory");
    __syncthreads();
    if (threadIdx.x == 0) {
        unsigned* bar = b.bar;
        __builtin_amdgcn_s_waitcnt(0);
        unsigned nloc = b.st[0], nx = b.st[1];
        if (nloc == 0u) { xcd_barrier_complete(bar, b.x, nloc, nx); b.st[0] = nloc; b.st[1] = nx; }
        const unsigned old = xb_add(&bar[XB_XSUB(b.x)], 1u);
        const unsigned gen = old / nloc;
        if (old + 1u == (gen + 1u) * nloc) {
            __builtin_amdgcn_fence(__ATOMIC_RELEASE, "agent");
            asm volatile("s_waitcnt vmcnt(0)" ::: "memory");
            const unsigned og = xb_add(&bar[XB_TOP], 1u);
            const unsigned tg = og / nx;
            if (og + 1u == (tg + 1u) * nx) xb_add(&bar[XB_TOPGEN], 1u);
            else XB_SPIN(xb_ld(&bar[XB_TOPGEN]) == tg, bar);
            __builtin_amdgcn_fence(__ATOMIC_ACQUIRE, "agent");
            xb_add(&bar[XB_XGEN(b.x)], 1u);
            asm volatile("s_waitcnt vmcnt(0)" ::: "memory");
        } else {
            XB_SPIN(xb_ld(&bar[XB_XGEN(b.x)]) == gen, bar);
            __builtin_amdgcn_fence(__ATOMIC_ACQUIRE, "agent");
            asm volatile("s_waitcnt vmcnt(0)" ::: "memory");
        }
    }
    __syncthreads();
}

struct Frame {
    LAS unsigned char* lds;
    int tid, lane, wave, vcu, G;
};
struct Args {
    const float* in[21]; float* out; unsigned char* ws; int upto, pad1;
};

__device__ __forceinline__ void transpose_item(const float* W, int ldw, int k0, int n0, bf16_t* WT, int ldk, int drow0, LAS float* scr, int lane) {
    float tv[32];
    const float* wp_ = W + (size_t)(k0 + (lane >> 5)) * ldw + n0 + (lane & 31);
#pragma unroll
    for (int i = 0; i < 32; ++i) tv[i] = wp_[(size_t)(2 * i) * ldw];
#pragma unroll
    for (int i = 0; i < 32; ++i) scr[(2 * i + (lane >> 5)) * 33 + (lane & 31)] = tv[i];
    LDS_WAIT(); asm volatile("" ::: "memory");
    const int c = lane & 7;
#pragma unroll
    for (int j = 0; j < 4; ++j) { const int n = (lane >> 3) + 8 * j; const LAS float* s = scr + (8 * c) * 33 + n;
        u32x4 o; o.x = cvt_pk_bf16(s[0 * 33], s[1 * 33]); o.y = cvt_pk_bf16(s[2 * 33], s[3 * 33]); o.z = cvt_pk_bf16(s[4 * 33], s[5 * 33]); o.w = cvt_pk_bf16(s[6 * 33], s[7 * 33]);
        *(u32x4*)(WT + (size_t)(drow0 + n) * ldk + k0 + 8 * c) = o; }
    LDS_WAIT(); asm volatile("" ::: "memory");
}
__device__ __forceinline__ void conv_plain(Frame& F, const float* W, int K, int N, int ldw, bf16_t* WT) {
    LAS float* scr = (LAS float*)(F.lds + F.wave * 16384);
    const int gw = F.vcu * NWAVES + F.wave, NGW = F.G * NWAVES, nblk = N / 32, nit = (K / 64) * nblk;
    for (int it = gw; it < nit; it += NGW) { const int kb = it / nblk, nb = it % nblk; transpose_item(W, ldw, 64 * kb, 32 * nb, WT, K, 32 * nb, scr, F.lane); }
}
__device__ __forceinline__ void conv_moe(Frame& F, const float* wg, const float* wu, const float* wd, bf16_t* GU, bf16_t* DT, int rank = -1, int nrank = 0) {
    LAS float* scr = (LAS float*)(F.lds + F.wave * 16384);
    const int gw = (rank < 0 ? F.vcu : rank) * NWAVES + F.wave, NGW = (rank < 0 ? F.G : nrank) * NWAVES;
    constexpr int PER_E = 1536, NIT = NEXP * PER_E;
    for (int it = gw; it < NIT; it += NGW) {
        const int e = it / PER_E; int r = it % PER_E;
        if (r < 1024) { const int up = r >> 9; r &= 511; const int kb = r >> 4, nb = r & 15, n0 = 32 * nb;
            const int drow = 256 * (n0 >> 7) + 128 * up + (n0 & 127);
            transpose_item((up ? wu : wg) + (size_t)e * D * DFF, DFF, 64 * kb, n0, GU + (size_t)e * 1024 * D, D, drow, scr, F.lane); }
        else { r -= 1024; const int kb = r >> 6, nb = r & 63;
            transpose_item(wd + (size_t)e * DFF * D, D, 64 * kb, 32 * nb, DT + (size_t)e * D * DFF, DFF, 32 * nb, scr, F.lane); }
    }
}
__device__ __forceinline__ void pack_proj(Frame& F, float* Wp, int NT, const float* gain, const float* Wa, int lda, int ca0, int na, const float* Wb, int ldb, int nb) {
    const int total = 128 * NT * 256;
    for (int idx = (F.vcu * NWAVES * 64) + F.tid; idx < total; idx += F.G * NWAVES * 64) {
        const int e = idx & 3, ln = (idx >> 2) & 63, rest = idx >> 8, nt = rest % NT, s = rest / NT;
        const int k = 16 * s + 4 * (ln >> 4) + e, col = 16 * nt + (ln & 15);
        float v = 0.f;
        if (col < na) v = Wa[(size_t)k * lda + ca0 + col]; else if (col < na + nb) v = Wb[(size_t)k * ldb + (col - na)];
        Wp[idx] = v * gain[k];
    }
}

template <int NT>
__device__ __forceinline__ float wave_proj16(LAS unsigned char* lds, const float* xin, int tok0, const float* Wp, int tid, int wid, int lane, f32x4 (&acc)[NT]) {
    const int tr = lane & 15, kq = lane >> 4;
    const f32x4* xp = (const f32x4*)(xin + (size_t)(tok0 + tr) * D) + kq;
    constexpr int CH = 16 * NT * 1024;
    const char* wsrc = (const char*)Wp + tid * 16;
    float ssq = 0.f;
#pragma unroll
    for (int n = 0; n < NT; ++n) acc[n] = (f32x4){0.f, 0.f, 0.f, 0.f};
    f32x4 X[16];
#define NP_DMA(c, buf) do { _Pragma("unroll") for (int r = 0; r < 2 * NT; ++r) \
        __builtin_amdgcn_global_load_lds((const unsigned*)(wsrc + (size_t)(c) * CH + r * 8192), (LAS unsigned*)(lds + (buf) * CH + r * 8192 + wid * 1024), 16, 0, 0); } while (0)
#define NP_CHUNK(c, buf, more) do { \
        asm volatile("s_waitcnt vmcnt(16)" ::: "memory"); WG_BAR(); \
        if (more) NP_DMA((c) + 1, 1 - (buf)); \
        asm volatile("" ::: "memory");     \
        const f32x4* xn_ = xp + 64 * ((c) + 1); \
        _Pragma("unroll") for (int s = 0; s < 16; ++s) { const f32x4 xv = X[s]; if (more) X[s] = xn_[4 * s]; \
            ssq += (xv[0] * xv[0] + xv[1] * xv[1]) + (xv[2] * xv[2] + xv[3] * xv[3]); \
            _Pragma("unroll") for (int n = 0; n < NT; ++n) { const f32x4 wv = *(const LAS f32x4*)(lds + (buf) * CH + ((s * NT + n) * 64 + lane) * 16); \
                _Pragma("unroll") for (int e = 0; e < 4; ++e) acc[n] = __builtin_amdgcn_mfma_f32_16x16x4f32(xv[e], wv[e], acc[n], 0, 0, 0); } } } while (0)
    NP_DMA(0, 0);
    asm volatile("" ::: "memory");
#pragma unroll
    for (int s = 0; s < 16; ++s) X[s] = xp[4 * s];
    for (int c = 0; c < 6; c += 2) { NP_CHUNK(c, 0, true); NP_CHUNK(c + 1, 1, true); }
    NP_CHUNK(6, 0, true); NP_CHUNK(7, 1, false);
    WG_BAR();
#undef NP_DMA
#undef NP_CHUNK
    ssq += __shfl_xor(ssq, 16); ssq += __shfl_xor(ssq, 32);
    return 1.0f / sqrtf(ssq * (1.0f / D) + RMS_EPS);
}
__device__ __forceinline__ void wave_write_hn16(const float* xin, int tok0, float rstd, const float* gain, bf16_t* hn, int lane) {
    f32x4 g4[8];
#pragma unroll
    for (int j = 0; j < 8; ++j) g4[j] = ((const f32x4*)gain)[lane + 64 * j];
    for (int i = 0; i < 16; i += 2) {
        const float r0 = __shfl(rstd, i), r1 = __shfl(rstd, i + 1);
        const f32x4* x0 = (const f32x4*)(xin + (size_t)(tok0 + i) * D); const f32x4* x1 = x0 + D / 4;
        u32x2* o0 = (u32x2*)(hn + (size_t)(tok0 + i) * D); u32x2* o1 = o0 + D / 4;
        f32x4 a[8], c[8];
#pragma unroll
        for (int j = 0; j < 8; ++j) { a[j] = x0[lane + 64 * j]; c[j] = x1[lane + 64 * j]; }
#pragma unroll
        for (int j = 0; j < 8; ++j) { const f32x4 v = a[j] * r0 * g4[j], u = c[j] * r1 * g4[j]; u32x2 w; w.x = cvt_pk_bf16(v[0], v[1]); w.y = cvt_pk_bf16(v[2], v[3]); o0[lane + 64 * j] = w;
            u32x2 z; z.x = cvt_pk_bf16(u[0], u[1]); z.y = cvt_pk_bf16(u[2], u[3]); o1[lane + 64 * j] = z; }
    }
}

__device__ __forceinline__ void phase_norm_gz(Frame& F, const float* xin, const float* gain, const float* Wp, bf16_t* hn, float* gz) {
    for (int tile = F.vcu; tile < T / 128; tile += F.G) {
        const int tok0 = tile * 128 + F.wave * 16;
        f32x4 acc[1];
        const float rstd = wave_proj16<1>(F.lds, xin, tok0, Wp, F.tid, F.wave, F.lane, acc);
        const int j = F.lane & 15, q4 = F.lane >> 4;
#pragma unroll
        for (int r = 0; r < 4; ++r) { const float rr = __shfl(rstd, 4 * q4 + r); gz[(size_t)(tok0 + 4 * q4 + r) * 16 + j] = acc[0][r] * rr; }
        wave_write_hn16(xin, tok0, rstd, gain, hn, F.lane);
    }
}
__device__ __forceinline__ void phase_norm_route(Frame& F, const float* xin, const float* gain, const float* Wp, bf16_t* hn, int* tok_e, int* tok_p, float* tok_w, unsigned* cnt) {
    LAS float* lg = (LAS float*)(F.lds + 98304 + F.wave * 3072);
    for (int tile = F.vcu; tile < T / 128; tile += F.G) {
        const int tok0 = tile * 128 + F.wave * 16;
        f32x4 acc[3];
        const float rstd = wave_proj16<3>(F.lds, xin, tok0, Wp, F.tid, F.wave, F.lane, acc);
        const int j = F.lane & 15, q4 = F.lane >> 4;
#pragma unroll
        for (int r = 0; r < 4; ++r) { const float rr = __shfl(rstd, 4 * q4 + r);
#pragma unroll
            for (int n = 0; n < 3; ++n) lg[(4 * q4 + r) * 48 + 16 * n + j] = acc[n][r] * rr; }
        LDS_WAIT(); asm volatile("" ::: "memory");
        if (F.lane < 16) {
            const LAS float* l = lg + F.lane * 48;
            float gm = l[0]; int gi = 0;
#pragma unroll
            for (int q = 1; q < 4; ++q) { const float v = l[q]; if (v > gm) { gm = v; gi = q; } }
            float gs = 0.f;
#pragma unroll
            for (int q = 0; q < 4; ++q) gs += __expf(l[q] - gm);
            const float gw = 1.0f / gs;
            const LAS float* se = l + 4 + 8 * gi;
            float m1 = se[0]; int i1 = 0;
#pragma unroll
            for (int q = 1; q < 8; ++q) { const float v = se[q]; if (v > m1) { m1 = v; i1 = q; } }
            float m2 = -3.0e38f; int i2 = 0;
#pragma unroll
            for (int q = 0; q < 8; ++q) { const float v = se[q]; if (q != i1 && v > m2) { m2 = v; i2 = q; } }
            const float eb = __expf(m2 - m1), inv = 1.0f / (1.0f + eb);
            const int t = tok0 + F.lane, e1 = gi * 8 + i1, e2 = gi * 8 + i2;
            const unsigned p1 = __hip_atomic_fetch_add(cnt + 64 * e1, 1u, __ATOMIC_RELAXED, __HIP_MEMORY_SCOPE_AGENT);
            const unsigned p2 = __hip_atomic_fetch_add(cnt + 64 * e2, 1u, __ATOMIC_RELAXED, __HIP_MEMORY_SCOPE_AGENT);
            tok_e[2 * t] = e1; tok_e[2 * t + 1] = e2; tok_p[2 * t] = (int)p1; tok_p[2 * t + 1] = (int)p2;
            tok_w[2 * t] = gw * inv; tok_w[2 * t + 1] = gw * eb * inv;
        }
        wave_write_hn16(xin, tok0, rstd, gain, hn, F.lane);
        LDS_WAIT(); asm volatile("" ::: "memory");
    }
}

__device__ __forceinline__ void phase_gla_gate(Frame& F, const float* gz, const float* wgu, const float* bgate, const bf16_t* proj, bf16_t* kdT, float* adec) {
    LAS f32x4* gzs = (LAS f32x4*)F.lds;
    for (int u = F.vcu; u < NBATCH * NCH * 2; u += F.G) {
        const int half = u & 1, bc = u >> 1;
        const int tok0 = bc * 64, j = half * 512 + F.tid;
        if (F.tid < 256) gzs[F.tid] = ((const f32x4*)(gz + (size_t)tok0 * 16))[F.tid];
        float wg[16];
#pragma unroll
        for (int r = 0; r < 16; ++r) wg[r] = wgu[r * GLA_DKT + j];
        const float bg = bgate[j];
        WG_BAR();
        float cum[64]; float run = 0.f;
#pragma unroll
        for (int t = 0; t < 64; ++t) {
            float z = bg;
#pragma unroll
            for (int r4 = 0; r4 < 4; ++r4) { const f32x4 g4 = gzs[t * 4 + r4]; z += g4[0] * wg[4 * r4] + g4[1] * wg[4 * r4 + 1] + g4[2] * wg[4 * r4 + 2] + g4[3] * wg[4 * r4 + 3]; }
            const float ls = fminf(z, 0.f) - __logf(1.0f + __expf(-fabsf(z)));
            run += ls * (1.0f / 16.0f); cum[t] = run;
        }
        adec[(size_t)bc * GLA_DKT + j] = __expf(run);
        const bf16_t* kp = proj + GK0 + gq_off(bc >> 8, (bc & 255) * 64, j >> 8) + (j & 255);
        u32x4* dst = (u32x4*)(kdT + ((size_t)bc * GLA_DKT + j) * 64);
#pragma unroll
        for (int t8 = 0; t8 < 8; ++t8) {
            float kd[8];
#pragma unroll
            for (int q = 0; q < 8; ++q) { const int t = t8 * 8 + q; kd[q] = bf2f(kp[(size_t)t * 256]) * __expf(run - cum[t]); }
            u32x4 w; w.x = cvt_pk_bf16(kd[0], kd[1]); w.y = cvt_pk_bf16(kd[2], kd[3]); w.z = cvt_pk_bf16(kd[4], kd[5]); w.w = cvt_pk_bf16(kd[6], kd[7]);
            dst[t8] = w;
        }
        WG_BAR();
    }
}

constexpr int SCAN_VROW = 144, SCAN_SROW = 528, SCAN_VBUF = 64 * SCAN_VROW, SCAN_SBUF = 64 * SCAN_SROW;
__device__ __forceinline__ void phase_gla_scan(Frame& F, int it, const bf16_t* proj, const bf16_t* kdT, const float* adec, bf16_t* oout, bf16_t* sfin, unsigned* probe = nullptr) {
    const int lane = F.lane, w = F.wave, fr = lane & 15, kq = lane >> 4, tid = F.tid;
    LAS unsigned char* vbuf = F.lds;
    LAS unsigned char* sbuf = F.lds + 2 * SCAN_VBUF;
    const int bh = it >> 4, seg = (it >> 3) & 1, b = bh >> 2, h = bh & 3, sl = it & 7, mt = w & 3, ntp = w >> 2, c0 = seg * (NCH / 2);
    const size_t tokb = (size_t)b * SEQ;
    f32x4 st[2][4];
#pragma unroll
    for (int i = 0; i < 2; ++i)
#pragma unroll
        for (int n = 0; n < 4; ++n) st[i][n] = (f32x4){0.f, 0.f, 0.f, 0.f};
    bf16x8 ka0[2][2], ka1[2][2], q0[8], q1[8]; f32x4 dc0[2], dc1[2]; u32x4 vr0, vr1;
#define CL(c) ((c) < NCH ? (c) : NCH - 1)
#define LOAD_KA(KA, DC, c) do { const size_t bc_ = (size_t)b * NCH + CL(c); \
        _Pragma("unroll") for (int i = 0; i < 2; ++i) { \
            _Pragma("unroll") for (int s = 0; s < 2; ++s) KA[i][s] = *(const bf16x8*)(kdT + ((bc_ * GLA_DKT + h * 256 + 32 * w + 16 * i + fr) * 64 + 32 * s + 8 * kq)); \
            DC[i] = *(const f32x4*)(adec + bc_ * GLA_DKT + h * 256 + 32 * w + 16 * i + 4 * kq); } } while (0)
#define LOAD_V(VR, c) do { VR = *(const u32x4*)(proj + gv_off(b, CL(c) * 64 + (tid >> 3), h) + 64 * sl + 8 * (tid & 7)); } while (0)
#define LOAD_Q(Q, c) do { const bf16_t* qp_ = proj + gq_off(b, CL(c) * 64 + 16 * mt + fr, h) + 8 * kq; \
        _Pragma("unroll") for (int s = 0; s < 8; ++s) Q[s] = *(const bf16x8*)(qp_ + 32 * s); } while (0)
#define STORE_V(VR, buf) do { *(LAS u32x4*)(vbuf + (buf) * SCAN_VBUF + (tid >> 3) * SCAN_VROW + (tid & 7) * 16) = VR; } while (0)
#if PROBE
    unsigned long long pacc[3] = {0ull, 0ull, 0ull}; unsigned long long pmark;
#define PMARK(k) do { const unsigned long long n_ = __builtin_amdgcn_s_memtime(); pacc[k] += n_ - pmark; pmark = n_; } while (0)
#define PSTART() do { pmark = __builtin_amdgcn_s_memtime(); } while (0)
#else
#define PMARK(k) do { } while (0)
#define PSTART() do { } while (0)
#endif
#define SCAN_STEP(KA, DC, VN, VM, QC, QN, c) do { \
        PSTART(); \
        const unsigned vb_ = (unsigned)(uintptr_t)(vbuf + ((c) & 1) * SCAN_VBUF) + (unsigned)((8 * kq + ((lane & 15) >> 2)) * SCAN_VROW + 8 * (lane & 3)); \
        s16x4 tv[4][4];     \
        asm volatile("ds_read_b64_tr_b16 %0, %16 offset:0\n\tds_read_b64_tr_b16 %1, %16 offset:576\n\tds_read_b64_tr_b16 %2, %16 offset:4608\n\tds_read_b64_tr_b16 %3, %16 offset:5184\n\t" \
                     "ds_read_b64_tr_b16 %4, %16 offset:32\n\tds_read_b64_tr_b16 %5, %16 offset:608\n\tds_read_b64_tr_b16 %6, %16 offset:4640\n\tds_read_b64_tr_b16 %7, %16 offset:5216\n\t" \
                     "ds_read_b64_tr_b16 %8, %16 offset:64\n\tds_read_b64_tr_b16 %9, %16 offset:640\n\tds_read_b64_tr_b16 %10, %16 offset:4672\n\tds_read_b64_tr_b16 %11, %16 offset:5248\n\t" \
                     "ds_read_b64_tr_b16 %12, %16 offset:96\n\tds_read_b64_tr_b16 %13, %16 offset:672\n\tds_read_b64_tr_b16 %14, %16 offset:4704\n\tds_read_b64_tr_b16 %15, %16 offset:5280\n\ts_waitcnt lgkmcnt(0)" \
                     : "=&v"(tv[0][0]), "=&v"(tv[0][1]), "=&v"(tv[0][2]), "=&v"(tv[0][3]), "=&v"(tv[1][0]), "=&v"(tv[1][1]), "=&v"(tv[1][2]), "=&v"(tv[1][3]), \
                       "=&v"(tv[2][0]), "=&v"(tv[2][1]), "=&v"(tv[2][2]), "=&v"(tv[2][3]), "=&v"(tv[3][0]), "=&v"(tv[3][1]), "=&v"(tv[3][2]), "=&v"(tv[3][3]) : "v"(vb_) : "memory"); \
        _Pragma("unroll") for (int n = 0; n < 4; ++n) { \
            const bf16x8 vf0 = (bf16x8){tv[n][0][0], tv[n][0][1], tv[n][0][2], tv[n][0][3], tv[n][1][0], tv[n][1][1], tv[n][1][2], tv[n][1][3]}; \
            const bf16x8 vf1 = (bf16x8){tv[n][2][0], tv[n][2][1], tv[n][2][2], tv[n][2][3], tv[n][3][0], tv[n][3][1], tv[n][3][2], tv[n][3][3]}; \
            _Pragma("unroll") for (int i = 0; i < 2; ++i) { \
                st[i][n] = st[i][n] * DC[i]; \
                st[i][n] = __builtin_amdgcn_mfma_f32_16x16x32_bf16(KA[i][0], vf0, st[i][n], 0, 0, 0); \
                st[i][n] = __builtin_amdgcn_mfma_f32_16x16x32_bf16(KA[i][1], vf1, st[i][n], 0, 0, 0); } } \
        LOAD_KA(KA, DC, (c) + 2); \
        PMARK(0); \
        { LAS unsigned char* sb_ = sbuf + ((c) & 1) * SCAN_SBUF + fr * SCAN_SROW + (32 * w + 4 * kq) * 2; \
          _Pragma("unroll") for (int i = 0; i < 2; ++i) _Pragma("unroll") for (int n = 0; n < 4; ++n) { \
              u32x2 pk; pk.x = cvt_pk_bf16(st[i][n][0], st[i][n][1]); pk.y = cvt_pk_bf16(st[i][n][2], st[i][n][3]); \
              *(LAS u32x2*)(sb_ + n * 16 * SCAN_SROW + i * 32) = pk; } } \
        STORE_V(VN, ((c) + 1) & 1); \
        LOAD_V(VN, (c) + 3); \
        WG_BAR(); \
        PMARK(1); \
        { f32x4 a0 = (f32x4){0.f, 0.f, 0.f, 0.f}, a1 = a0; \
          const LAS unsigned char* sr_ = sbuf + ((c) & 1) * SCAN_SBUF + (32 * ntp + fr) * SCAN_SROW + 16 * kq; \
          _Pragma("unroll") for (int hb = 0; hb < 2; ++hb) { bf16x8 bb[4][2];     \
              _Pragma("unroll") for (int s = 0; s < 4; ++s) { bb[s][0] = *(const LAS bf16x8*)(sr_ + 64 * (4 * hb + s)); bb[s][1] = *(const LAS bf16x8*)(sr_ + 16 * SCAN_SROW + 64 * (4 * hb + s)); } \
              asm volatile("s_waitcnt lgkmcnt(0)" ::: "memory"); __builtin_amdgcn_sched_barrier(0); \
              _Pragma("unroll") for (int s = 0; s < 4; ++s) { \
                  a0 = __builtin_amdgcn_mfma_f32_16x16x32_bf16(QC[4 * hb + s], bb[s][0], a0, 0, 0, 0); \
                  a1 = __builtin_amdgcn_mfma_f32_16x16x32_bf16(QC[4 * hb + s], bb[s][1], a1, 0, 0, 0); } } \
          bf16_t* op_ = oout + (tokb + (size_t)(c) * 64 + 16 * mt + 4 * kq) * D + h * 512 + 64 * sl + 32 * ntp + fr; \
          _Pragma("unroll") for (int r = 0; r < 4; ++r) { \
              const float x0 = a0[r] * 0.0625f, x1 = a1[r] * 0.0625f, y0 = __shfl_xor(x0, 1), y1 = __shfl_xor(x1, 1); \
              if ((fr & 1) == 0) { *(unsigned*)(op_ + (size_t)r * D) = cvt_pk_bf16(x0, y0); *(unsigned*)(op_ + (size_t)r * D + 16) = cvt_pk_bf16(x1, y1); } } } \
        LOAD_Q(QC, (c) + 2); \
        PMARK(2); \
    } while (0)
    LOAD_KA(ka0, dc0, c0); LOAD_KA(ka1, dc1, c0 + 1); LOAD_V(vr0, c0); LOAD_V(vr1, c0 + 1); LOAD_Q(q0, c0); LOAD_Q(q1, c0 + 1);
    STORE_V(vr0, 0); LOAD_V(vr0, c0 + 2);
    WG_BAR();
#if PROBE
    const unsigned long long pt0 = __builtin_amdgcn_s_memtime(), pr0 = __builtin_amdgcn_s_memrealtime();
#endif
    for (int c = c0; c < c0 + NCH / 2; c += 2) {
        SCAN_STEP(ka0, dc0, vr1, vr0, q0, q1, c);
        SCAN_STEP(ka1, dc1, vr0, vr1, q1, q0, c + 1);
    }
    if (seg == 0) {
#pragma unroll
        for (int i = 0; i < 2; ++i)
#pragma unroll
            for (int n = 0; n < 4; ++n) { u32x2 pk; pk.x = cvt_pk_bf16(st[i][n][0], st[i][n][1]); pk.y = cvt_pk_bf16(st[i][n][2], st[i][n][3]);
                *(u32x2*)(sfin + ((size_t)(bh * 512 + 64 * sl + 16 * n + fr)) * 256 + 32 * w + 16 * i + 4 * kq) = pk; }
    }
    WG_BAR();
#if PROBE
    if (probe && it == 0 && tid == 0) { const unsigned long long dt = __builtin_amdgcn_s_memtime() - pt0, dr = __builtin_amdgcn_s_memrealtime() - pr0;
        const float val = floorf(2.f * log2f((PROBE == 1) ? (float)dt / 256.f : (PROBE == 2) ? (float)dr * 10.f / 256.f : (float)pacc[PROBE - 3] / 256.f));
        __hip_atomic_store(probe, __float_as_uint(val), __ATOMIC_RELAXED, __HIP_MEMORY_SCOPE_AGENT); }
#endif
#undef CL
#undef LOAD_KA
#undef LOAD_V
#undef LOAD_Q
#undef STORE_V
#undef SCAN_STEP
}

__device__ __forceinline__ void gla_pcum(Frame& F, const float* adec, float* pcum, int rank, int nrank) {
    for (int idx = rank * (NWAVES * 64) + F.tid; idx < NBATCH * GLA_DKT; idx += nrank * NWAVES * 64) { const int b = idx >> 10, j = idx & 1023;
        const float* ap = adec + ((size_t)(b * NCH + NCH / 2)) * GLA_DKT + j; float* pp = pcum + (size_t)(b * (NCH / 2)) * GLA_DKT + j; float pr = 1.f;
#pragma unroll 16
        for (int cc = 0; cc < NCH / 2; ++cc) { pr *= ap[(size_t)cc * GLA_DKT]; pp[(size_t)cc * GLA_DKT] = pr; } }
}
__device__ __forceinline__ void phase_gla_qp(Frame& F, const bf16_t* proj, const float* pcum, bf16_t* qp) {
    const int gw = F.vcu * NWAVES + F.wave, NGW = F.G * NWAVES, lane = F.lane;
    for (int r = gw; r < NBATCH * (SEQ / 2); r += NGW) { const int b = r >> 13, t = r & 8191;
        u32x2 qv[4]; f32x4 pv[4];
#pragma unroll
        for (int h = 0; h < 4; ++h) { qv[h] = *(const u32x2*)(proj + gq_off(b, SEQ / 2 + t, h) + 4 * lane); pv[h] = *(const f32x4*)(pcum + ((size_t)(b * (NCH / 2) + (t >> 6)) * GLA_DKT + h * 256 + 4 * lane)); }
#pragma unroll
        for (int h = 0; h < 4; ++h) { u32x2 w; w.x = cvt_pk_bf16(bf_lo(qv[h].x) * pv[h][0], bf_hi(qv[h].x) * pv[h][1]); w.y = cvt_pk_bf16(bf_lo(qv[h].y) * pv[h][2], bf_hi(qv[h].y) * pv[h][3]);
            *(u32x2*)(qp + ((size_t)((b * 4 + h) * (SEQ / 2) + t)) * 256 + 4 * lane) = w; }
    }
}
__device__ __forceinline__ void phase_gla_gnorm(Frame& F, const bf16_t* o, const bf16_t* proj, const float* gn, bf16_t* y) {
    const int gw = F.vcu * NWAVES + F.wave, NGW = F.G * NWAVES, lane = F.lane;
    const f32x4 g0 = ((const f32x4*)gn)[2 * lane], g1 = ((const f32x4*)gn)[2 * lane + 1];
    for (int tok = gw; tok < T; tok += NGW) {
        u32x4 ov[4], rv[4];
#pragma unroll
        for (int h = 0; h < 4; ++h) { ov[h] = *(const u32x4*)(o + (size_t)tok * D + h * 512 + 8 * lane); rv[h] = *(const u32x4*)(proj + GR0 + (size_t)tok * 2048 + h * 512 + 8 * lane); }
        float ss[4];
#pragma unroll
        for (int h = 0; h < 4; ++h) { float s = 0.f;
#pragma unroll
            for (int q = 0; q < 4; ++q) { const float lo = bf_lo(ov[h][q]), hi = bf_hi(ov[h][q]); s += lo * lo + hi * hi; }
            ss[h] = s; }
#pragma unroll
        for (int of = 1; of < 64; of <<= 1) {
#pragma unroll
            for (int h = 0; h < 4; ++h) ss[h] += __shfl_xor(ss[h], of); }
#pragma unroll
        for (int h = 0; h < 4; ++h) { const float rstd = 1.0f / sqrtf(ss[h] * (1.0f / 512.0f) + RMS_EPS);
            float yv[8];
#pragma unroll
            for (int q = 0; q < 4; ++q) { const float a0 = bf_lo(ov[h][q]), a1 = bf_hi(ov[h][q]), r0 = bf_lo(rv[h][q]), r1 = bf_hi(rv[h][q]);
                const float gA = q < 2 ? g0[2 * q] : g1[2 * q - 4], gB = q < 2 ? g0[2 * q + 1] : g1[2 * q - 3];
                yv[2 * q] = a0 * rstd * gA * (r0 / (1.0f + __expf(-r0))); yv[2 * q + 1] = a1 * rstd * gB * (r1 / (1.0f + __expf(-r1))); }
            u32x4 w; w.x = cvt_pk_bf16(yv[0], yv[1]); w.y = cvt_pk_bf16(yv[2], yv[3]); w.z = cvt_pk_bf16(yv[4], yv[5]); w.w = cvt_pk_bf16(yv[6], yv[7]);
            *(u32x4*)(y + (size_t)tok * D + h * 512 + 8 * lane) = w; }
    }
}

__device__ __forceinline__ void moe_tables(Frame& F, unsigned* cnt) {
    LAS int* pst = (LAS int*)(F.lds + TAB_OFF);
    LAS int* te = pst + 36;
    if (F.wave == 0) {
        const int e = F.lane & 31;
        const int c = (int)xb_ld(cnt + 64 * e);
        const int ntile = (c + 255) >> 8;
        int incl = ntile;
#pragma unroll
        for (int o = 1; o < 32; o <<= 1) { const int v = __shfl_up(incl, o); if ((F.lane & 31) >= o) incl += v; }
        const int excl = incl - ntile;
        if (F.lane < 32) { pst[e] = excl << 8; for (int q = 0; q < ntile; ++q) te[excl + q] = e; }
        if (F.lane == 31) { pst[32] = incl << 8; pst[33] = incl; }
    }
    WG_BAR();
}
__device__ __forceinline__ void phase_moe_slots(Frame& F, const int* tok_e, const int* tok_p, unsigned* cnt, int* slot_of, int* slot_tok) {
    const LAS int* pst = (const LAS int*)(F.lds + TAB_OFF);
    for (int e = F.vcu; e < NEXP; e += F.G) { const int c = (int)xb_ld(cnt + 64 * e), lo = pst[e] + c, hi = pst[e] + (((c + 255) >> 8) << 8);
        for (int s = lo + F.tid; s < hi; s += NWAVES * 64) slot_tok[s] = -1; }
    for (int a = F.vcu * NWAVES * 64 + F.tid; a < 2 * T; a += F.G * NWAVES * 64) { const int slot = pst[tok_e[a]] + tok_p[a]; slot_of[a] = slot; slot_tok[slot] = a >> 1; }
}
template <int MODE>
__device__ __forceinline__ void phase_moe_combine(Frame& F, float* x, const bf16_t* ob, const int* slot_of, const float* tok_w, const float* gain, bf16_t* hn) {
    const int gw = F.vcu * NWAVES + F.wave, NGW = F.G * NWAVES, lane = F.lane;
    f32x4 g4[8];
#pragma unroll
    for (int j = 0; j < 8; ++j) g4[j] = ((const f32x4*)gain)[lane + 64 * j];
    for (int t = gw; t < T; t += NGW) {
        const int s0 = slot_of[2 * t], s1 = slot_of[2 * t + 1]; const float w0 = tok_w[2 * t], w1 = tok_w[2 * t + 1];
        f32x4* xr = (f32x4*)(x + (size_t)t * D);
        const u32x2* a = (const u32x2*)(ob + (size_t)s0 * D); const u32x2* b = (const u32x2*)(ob + (size_t)s1 * D);
        f32x4 v[8]; float ss = 0.f;
#pragma unroll
        for (int j = 0; j < 8; ++j) { const u32x2 av = a[lane + 64 * j], bv = b[lane + 64 * j]; f32x4 xv = xr[lane + 64 * j];
            xv[0] += w0 * bf_lo(av.x) + w1 * bf_lo(bv.x); xv[1] += w0 * bf_hi(av.x) + w1 * bf_hi(bv.x);
            xv[2] += w0 * bf_lo(av.y) + w1 * bf_lo(bv.y); xv[3] += w0 * bf_hi(av.y) + w1 * bf_hi(bv.y);
            v[j] = xv; ss += (xv[0] * xv[0] + xv[1] * xv[1]) + (xv[2] * xv[2] + xv[3] * xv[3]); }
        const float rstd = 1.0f / sqrtf(wave_sum(ss) * (1.0f / D) + RMS_EPS);
        if (MODE == 0) {
            u32x2* orow = (u32x2*)(hn + (size_t)t * D);
#pragma unroll
            for (int j = 0; j < 8; ++j) { xr[lane + 64 * j] = v[j]; const f32x4 y = v[j] * rstd * g4[j]; u32x2 w; w.x = cvt_pk_bf16(y[0], y[1]); w.y = cvt_pk_bf16(y[2], y[3]); orow[lane + 64 * j] = w; }
        } else {
#pragma unroll
            for (int j = 0; j < 8; ++j) xr[lane + 64 * j] = v[j] * rstd * g4[j];
        }
    }
}

__device__ __forceinline__ void phase_subln(Frame& F, const bf16_t* o1, const bf16_t* o2, const float* lq1, const float* lk1, const float* lq2, const float* lk2, const float* sg, bf16_t* y) {
    const int gw = F.vcu * NWAVES + F.wave, NGW = F.G * NWAVES, lane = F.lane;
    const float d1 = wave_sum(lq1[lane] * lk1[lane] + lq1[lane + 64] * lk1[lane + 64]);
    const float d2 = wave_sum(lq2[lane] * lk2[lane] + lq2[lane + 64] * lk2[lane + 64]);
    const float lam = __expf(d1) - __expf(d2) + LAMBDA_INIT;
    const f32x4 g = ((const f32x4*)sg)[lane] * (1.0f - LAMBDA_INIT);
    for (int tok = gw; tok < T; tok += NGW) {
        u32x2 a[8], b[8];
#pragma unroll
        for (int h = 0; h < 8; ++h) { a[h] = *(const u32x2*)(o1 + (size_t)tok * D + h * 256 + 4 * lane); b[h] = *(const u32x2*)(o2 + (size_t)tok * D + h * 256 + 4 * lane); }
        f32x4 d[8]; float ss[8];
#pragma unroll
        for (int h = 0; h < 8; ++h) { d[h][0] = bf_lo(a[h].x) - lam * bf_lo(b[h].x); d[h][1] = bf_hi(a[h].x) - lam * bf_hi(b[h].x); d[h][2] = bf_lo(a[h].y) - lam * bf_lo(b[h].y); d[h][3] = bf_hi(a[h].y) - lam * bf_hi(b[h].y);
            ss[h] = (d[h][0] * d[h][0] + d[h][1] * d[h][1]) + (d[h][2] * d[h][2] + d[h][3] * d[h][3]); }
#pragma unroll
        for (int of = 1; of < 64; of <<= 1) {
#pragma unroll
            for (int h = 0; h < 8; ++h) ss[h] += __shfl_xor(ss[h], of); }
#pragma unroll
        for (int h = 0; h < 8; ++h) { const float rstd = 1.0f / sqrtf(ss[h] * (1.0f / 256.0f) + RMS_EPS); const f32x4 yv = d[h] * rstd * g;
            u32x2 w; w.x = cvt_pk_bf16(yv[0], yv[1]); w.y = cvt_pk_bf16(yv[2], yv[3]);
            *(u32x2*)(y + (size_t)tok * D + h * 256 + 4 * lane) = w; }
    }
}

namespace att {
constexpr int SHM_K = 64 * 128 * 2, SHM_V = 64 * 256 * 2;
constexpr int V_OFF = 0, K_OFF = 3 * SHM_V, SCR_OFF = RING_BYTES + 4096;
constexpr float SCALE = 0.08838834764831845f;
constexpr float C2 = 1.4426950408889634f * SCALE;
constexpr float THR = 8.f;
#define KSWZ(row, colB) ((row) * 256 + ((colB) ^ (((row) & 7) << 4)))
__device__ __forceinline__ int crow(int r, int hi) { return (r & 3) + 8 * (r >> 2) + 4 * hi; }
__device__ __forceinline__ int v_rd_base(int lane) { return ((lane & 3) << 3) | (((lane >> 2) & 3) << 6) | (((lane >> 4) & 1) << 5) | (((lane >> 5) & 1) << 8); }
constexpr int v_rd_off(int d0, int ks, int half) { return d0 * 512 + ks * 8192 + half * 4096; }

__device__ __forceinline__ void qkt(f32x16& p0, f32x16& p1, const LAS unsigned char* kslot, int r32, int hi, const bf16x8 (&qr)[8]) {
    const LAS unsigned char* kb[4];
#pragma unroll
    for (int dd = 0; dd < 4; ++dd) kb[dd] = kslot + KSWZ(r32, (dd * 16 + hi * 8) * 2);
#pragma unroll
    for (int d0 = 0; d0 < 8; ++d0) { const LAS unsigned char* a = kb[d0 & 3] + (d0 >> 2) * 128;
        const bf16x8 b0 = *(const LAS bf16x8*)a;
        const bf16x8 b1 = *(const LAS bf16x8*)(a + 32 * 256);
        p0 = __builtin_amdgcn_mfma_f32_32x32x16_bf16(b0, qr[d0], p0, 0, 0, 0);
        p1 = __builtin_amdgcn_mfma_f32_32x32x16_bf16(b1, qr[d0], p1, 0, 0, 0); }
}
__device__ __forceinline__ void pv_tile(f32x16 (&o)[8], unsigned vb, const bf16x8 (&pa)[4]) {
#define TRRD(dst, off) asm volatile("ds_read_b64_tr_b16 %0, %1 offset:%2" : "=&v"(dst) : "v"(vb), "i"(off) : "memory")
#define PV_D0(d0) do { s16x4 l0, l1, l2, l3, h0, h1, h2, h3; constexpr int b_ = v_rd_off(d0, 0, 0); \
        TRRD(l0, b_); TRRD(h0, b_ + 4096); TRRD(l1, b_ + 8192); TRRD(h1, b_ + 12288); TRRD(l2, b_ + 16384); TRRD(h2, b_ + 20480); TRRD(l3, b_ + 24576); TRRD(h3, b_ + 28672); \
        asm volatile("s_waitcnt lgkmcnt(0)" ::: "memory"); __builtin_amdgcn_sched_barrier(0); \
        o[d0] = __builtin_amdgcn_mfma_f32_32x32x16_bf16(pa[0], (bf16x8){l0[0], l0[1], l0[2], l0[3], h0[0], h0[1], h0[2], h0[3]}, o[d0], 0, 0, 0); \
        o[d0] = __builtin_amdgcn_mfma_f32_32x32x16_bf16(pa[1], (bf16x8){l1[0], l1[1], l1[2], l1[3], h1[0], h1[1], h1[2], h1[3]}, o[d0], 0, 0, 0); \
        o[d0] = __builtin_amdgcn_mfma_f32_32x32x16_bf16(pa[2], (bf16x8){l2[0], l2[1], l2[2], l2[3], h2[0], h2[1], h2[2], h2[3]}, o[d0], 0, 0, 0); \
        o[d0] = __builtin_amdgcn_mfma_f32_32x32x16_bf16(pa[3], (bf16x8){l3[0], l3[1], l3[2], l3[3], h3[0], h3[1], h3[2], h3[3]}, o[d0], 0, 0, 0); } while (0)
    PV_D0(0); PV_D0(1); PV_D0(2); PV_D0(3); PV_D0(4); PV_D0(5); PV_D0(6); PV_D0(7);
#undef PV_D0
#undef TRRD
}

__device__ __forceinline__ void stage_offsets(int tid, unsigned (&koff)[2], unsigned (&voff)[4]) {
#pragma unroll
    for (int i = 0; i < 2; ++i) { const int P = tid * 16 + i * 8192, row = P >> 8, ch = ((P & 255) >> 4) ^ (row & 7); koff[i] = (unsigned)(row * 128 + ch * 8) * 2u; }
#pragma unroll
    for (int i = 0; i < 4; ++i) { const int P = tid * 16 + i * 8192, st = P >> 9, kk = ((st >> 3) << 3) | ((P & 511) >> 6), cg = st & 7, cin = (P & 63) >> 1;
        const int key = (kk & ~0xC) | ((kk & 4) << 1) | ((kk & 8) >> 1); voff[i] = (unsigned)(key * 256 + cg * 32 + cin) * 2u; }
}
__device__ __forceinline__ const char* uniform_ptr(const void* p) {
    const unsigned long long v = (unsigned long long)p;
    const unsigned lo = __builtin_amdgcn_readfirstlane((unsigned)v), hi = __builtin_amdgcn_readfirstlane((unsigned)(v >> 32));
    return (const char*)(((unsigned long long)hi << 32) | lo);
}
__device__ __forceinline__ void stage_tile(LAS unsigned char* lds, int kslot, int vslot, const bf16_t* kj_, const bf16_t* vj_, int tid_, int wid) {
    const char* kj = uniform_ptr(kj_); const char* vj = uniform_ptr(vj_);
    int tid = tid_; asm volatile("" : "+v"(tid));
    unsigned koff[2], voff[4]; stage_offsets(tid, koff, voff);
    LAS unsigned char* kd = lds + K_OFF + kslot * SHM_K + wid * 1024; LAS unsigned char* vd = lds + V_OFF + vslot * SHM_V + wid * 1024;
#pragma unroll
    for (int i = 0; i < 2; ++i) __builtin_amdgcn_global_load_lds((const unsigned*)(kj + koff[i]), (LAS unsigned*)(kd + i * 8192), 16, 0, 0);
#pragma unroll
    for (int i = 0; i < 4; ++i) __builtin_amdgcn_global_load_lds((const unsigned*)(vj + voff[i]), (LAS unsigned*)(vd + i * 8192), 16, 0, 0);
}

__device__ __forceinline__ void qk_softmax(const LAS unsigned char* kslot, int r32, int hi, LAS float* al_l, const bf16x8 (&qr)[8], f32x16 (&o)[8], bf16x8 (&pa)[4],
                                           float& m_reg, float& l_reg, float rawu, float sl2, bool diag, int qi) {
    f32x16 p0, p1;
#pragma unroll
    for (int r = 0; r < 16; ++r) { p0[r] = 0.f; p1[r] = 0.f; }
    qkt(p0, p1, kslot, r32, hi, qr);
#pragma unroll
    for (int r = 0; r < 16; ++r) { const float cr = (float)((r & 3) + 8 * (r >> 2)); p0[r] = fmaf(cr, rawu, p0[r]); p1[r] = fmaf(cr, rawu, p1[r]); }
    if (diag) {
        const float k2raw = 2.f * rawu;
        int qi_ = qi - 4 * hi; asm volatile("" : "+v"(qi_));
#pragma unroll
        for (int r = 0; r < 16; ++r) { const int c = (r & 3) + 8 * (r >> 2); const int d0_ = c - qi_, d1_ = c + 32 - qi_;
            p0[r] -= k2raw * (float)(d0_ > 0 ? d0_ : 0); p1[r] -= k2raw * (float)(d1_ > 0 ? d1_ : 0); }
    }
    const float lane_raw = rawu * (float)(4 * hi), d32raw = 32.f * rawu;
    float pm0 = p0[0], pm1 = p1[0];
#pragma unroll
    for (int r = 1; r < 16; ++r) { pm0 = fmaxf(pm0, p0[r]); pm1 = fmaxf(pm1, p1[r]); }
    float pmax = fmaxf(pm0, pm1 + d32raw) + lane_raw;
    { auto rr = __builtin_amdgcn_permlane32_swap(__float_as_uint(pmax), __float_as_uint(pmax), false, false);
      pmax = fmaxf(__uint_as_float(rr[0]), __uint_as_float(rr[1])); }
    float mn, alpha;
    if (__all((pmax - m_reg) * SCALE <= THR)) { mn = m_reg; alpha = 1.f; }
    else { mn = fmaxf(m_reg, pmax); alpha = __builtin_amdgcn_exp2f((m_reg - mn) * C2); m_reg = mn; }
    const float mnL0 = (lane_raw - mn) * C2, mnL1 = mnL0 + 32.f * sl2;
#pragma unroll
    for (int r = 0; r < 16; ++r) { p0[r] = __builtin_amdgcn_exp2f(fmaf(p0[r], C2, mnL0)); p1[r] = __builtin_amdgcn_exp2f(fmaf(p1[r], C2, mnL1)); }
    if (__any(alpha < 1.f)) {
        if (hi == 0) al_l[r32] = alpha;
        LDS_WAIT();
#pragma unroll
        for (int r = 0; r < 16; ++r) { const float a = al_l[crow(r, hi)];
#pragma unroll
            for (int d = 0; d < 8; ++d) o[d][r] *= a; }
    }
    float ps = 0.f;
#pragma unroll
    for (int r = 0; r < 16; ++r) ps += p0[r] + p1[r];
    { auto rr = __builtin_amdgcn_permlane32_swap(__float_as_uint(ps), __float_as_uint(ps), false, false);
      ps = __uint_as_float(rr[0]) + __uint_as_float(rr[1]); }
    l_reg = l_reg * alpha + ps;
#define PK4(P, B_, OUT) do { unsigned a0 = cvt_pk_bf16(P[B_+0], P[B_+1]), a1 = cvt_pk_bf16(P[B_+2], P[B_+3]); \
        unsigned b0 = cvt_pk_bf16(P[B_+4], P[B_+5]), b1 = cvt_pk_bf16(P[B_+6], P[B_+7]); \
        auto r0 = __builtin_amdgcn_permlane32_swap(a0, b0, false, false); auto r1 = __builtin_amdgcn_permlane32_swap(a1, b1, false, false); \
        u32x4 w = {r0[0], r1[0], r0[1], r1[1]}; OUT = __builtin_bit_cast(bf16x8, w); } while (0)
    PK4(p0, 0, pa[0]); PK4(p0, 8, pa[1]); PK4(p1, 0, pa[2]); PK4(p1, 8, pa[3]);
#undef PK4
}

__device__ __forceinline__ void norms_phase(Frame& F, const bf16_t* proj, float* nrm) {
    const int gw = F.vcu * NWAVES + F.wave, NGW = F.G * NWAVES, lane = F.lane;
    for (int idx = gw; idx < 2 * 32 * 256; idx += NGW) {
        const int tensor = idx >> 13, stream = (idx >> 8) & 31, grp = idx & 255;
        const u32x4* rp = (const u32x4*)(proj + (tensor ? DK0 : 0) + ((size_t)stream * SEQ + grp * 64 + lane) * 128);
        float ss = 0.f;
#pragma unroll
        for (int q = 0; q < 16; ++q) { const u32x4 v = rp[q];
#pragma unroll
            for (int e = 0; e < 4; ++e) { const float lo = bf_lo(v[e]), hi = bf_hi(v[e]); ss += lo * lo + hi * hi; } }
        float n = sqrtf(ss) * 1.001f;
#pragma unroll
        for (int o = 1; o < 64; o <<= 1) n = fmaxf(n, __shfl_xor(n, o));
        if (lane == 0) nrm[idx] = n;
    }
}

__device__ __forceinline__ void attn_item(LAS unsigned char* lds, const bf16_t* proj, const float* nrm, bf16_t* oout, int b, int h, int sub, int qb, int tid, int wid, int lane) {
    const int r32 = lane & 31, hi = lane >> 5;
    const float slope = __builtin_amdgcn_exp2f(-(float)(h + 1));
    const float sl2 = slope * 1.4426950408889634f, rawu = sl2 / C2;
    LAS float* ws = (LAS float*)(lds + SCR_OFF) + wid * 64; LAS float* li_l = ws; LAS float* al_l = ws + 32;
    const size_t tokq = (size_t)b * SEQ + (size_t)qb * 256 + wid * 32;
    const bf16_t* kbase = proj + DK0 + dq_off(b, 0, h, sub);
    const bf16_t* vbase = proj + dv_off(b, 0, h);
    int j_lo;
    { const int stream = (b * 8 + h) * 2 + sub; const float* qn = nrm + stream * 256; const float* kn = nrm + 8192 + stream * 256;
      const float Qn = fmaxf(fmaxf(qn[4 * qb], qn[4 * qb + 1]), fmaxf(qn[4 * qb + 2], qn[4 * qb + 3]));
      const float Kd = fmaxf(fmaxf(kn[4 * qb], kn[4 * qb + 1]), fmaxf(kn[4 * qb + 2], kn[4 * qb + 3]));
      int cand = 4 * qb;
      for (int jj = lane; jj < 4 * qb; jj += 64) { const float dmin = (float)(256 * qb - (64 * jj + 63)); const bool skip = slope * dmin > 110.f + SCALE * Qn * (kn[jj] + Kd); if (!skip) cand = cand < jj ? cand : jj; }
#pragma unroll
      for (int o = 1; o < 64; o <<= 1) { const int v = __shfl_xor(cand, o); cand = v < cand ? v : cand; }
      j_lo = __builtin_amdgcn_readfirstlane(cand); }
    bf16x8 qr[8];
#pragma unroll
    for (int d0 = 0; d0 < 8; ++d0) qr[d0] = *(const bf16x8*)(proj + dq_off(b, qb * 256 + wid * 32 + r32, h, sub) + d0 * 16 + hi * 8);
    const float sh64 = 64.f * rawu;
    const int qi = 32 * (wid & 1) + r32;
    const unsigned vb0 = (unsigned)(uintptr_t)(lds + V_OFF) + (unsigned)v_rd_base(lane);
    float m_reg = -1e30f, l_reg = 0.f;
    f32x16 o[8];
#pragma unroll
    for (int d = 0; d < 8; ++d)
#pragma unroll
        for (int r = 0; r < 16; ++r) o[d][r] = 0.f;
    const int NT = 4 * qb + 4, myNT = 4 * qb + (wid >> 1) + 1;
    constexpr size_t KSTEP = 64 * 128, VSTEP = 64 * 256;
    const bool late = wid >= 4;
    stage_tile(lds, j_lo & 1, j_lo % 3, kbase + (size_t)j_lo * KSTEP, vbase + (size_t)j_lo * VSTEP, tid, wid);
    VM_WAIT(); WG_BAR();
    if (!late) {
        int vs = j_lo % 3;
        for (int j = j_lo; j < NT; ++j) {
            const int vsn = vs == 2 ? 0 : vs + 1;
            if (j + 1 < NT) stage_tile(lds, (j + 1) & 1, vsn, kbase + (size_t)(j + 1) * KSTEP, vbase + (size_t)(j + 1) * VSTEP, tid, wid);
            if (j < myNT) { if (j > j_lo) m_reg -= sh64;
                bf16x8 pa[4];
                qk_softmax(lds + K_OFF + (j & 1) * SHM_K, r32, hi, al_l, qr, o, pa, m_reg, l_reg, rawu, sl2, j == myNT - 1, qi);
                pv_tile(o, vb0 + (unsigned)(vs * SHM_V), pa); }
            VM_WAIT(); WG_BAR();
            vs = vsn;
        }
    } else {
        bf16x8 pa[4];
        int vs = j_lo % 3, vsp = vs;
        for (int j = j_lo; j < NT; ++j) {
            const int vsn = vs == 2 ? 0 : vs + 1;
            if (j + 1 < NT) stage_tile(lds, (j + 1) & 1, vsn, kbase + (size_t)(j + 1) * KSTEP, vbase + (size_t)(j + 1) * VSTEP, tid, wid);
            if (j > j_lo && j - 1 < myNT) pv_tile(o, vb0 + (unsigned)(vsp * SHM_V), pa);
            if (j < myNT) { if (j > j_lo) m_reg -= sh64;
                qk_softmax(lds + K_OFF + (j & 1) * SHM_K, r32, hi, al_l, qr, o, pa, m_reg, l_reg, rawu, sl2, j == myNT - 1, qi); }
            VM_WAIT(); WG_BAR();
            vsp = vs; vs = vsn;
        }
        if (myNT == NT) pv_tile(o, vb0 + (unsigned)(vsp * SHM_V), pa);
    }
    if (hi == 0) li_l[r32] = l_reg;
    LDS_WAIT();
    char* Ow = (char*)(oout + tokq * D + h * 256);
    const unsigned lofs = (unsigned)(hi * 4 * D + r32) * 2u;
#pragma unroll
    for (int r = 0; r < 16; ++r) { const float rl = __builtin_amdgcn_rcpf(li_l[crow(r, hi)]);
#pragma unroll
        for (int d0 = 0; d0 < 8; ++d0) { const float v = o[d0][r] * rl; const float vn = __shfl_xor(v, 1);
            if ((r32 & 1) == 0) *(unsigned*)(Ow + (lofs + (unsigned)((((r & 3) + 8 * (r >> 2)) * D + d0 * 32) * 2))) = cvt_pk_bf16(v, vn); } }
    WG_BAR();
}

__device__ __forceinline__ void attn_phase(Frame& F, const bf16_t* proj, const float* nrm, unsigned* queue, bf16_t* o1, bf16_t* o2) {
    LAS int* qw = (LAS int*)(F.lds + SCR_OFF + 8 * 256);
    for (;;) {
        if (F.tid == 0) *qw = (int)__hip_atomic_fetch_add(queue, 1u, __ATOMIC_RELAXED, __HIP_MEMORY_SCOPE_AGENT);
        WG_BAR();
        const int I = __builtin_amdgcn_readfirstlane(*qw);
        if (I >= 2048) break;
        const int qb = 63 - (I >> 5), r = I & 31, h = 7 - (r >> 2), b = (r >> 1) & 1, sub = r & 1;
        attn_item(F.lds, proj, nrm, sub ? o2 : o1, b, h, sub, qb, F.tid, F.wave, F.lane);
    }
}
}

__global__ void __launch_bounds__(NWAVES * 64, 2) hybrid_fwd(Args args) {
    extern __shared__ __attribute__((aligned(16))) unsigned char lds_raw[];
    Frame F;
    F.lds = (LAS unsigned char*)lds_raw;
    F.tid = threadIdx.x; F.lane = F.tid & 63; F.wave = __builtin_amdgcn_readfirstlane(F.tid >> 6);
    F.G = gridDim.x; { const int bx = blockIdx.x; F.vcu = (F.G % 8 == 0) ? (bx % 8) * (F.G / 8) + bx / 8 : bx; }
    unsigned char* ws = args.ws;
    unsigned* ctl = (unsigned*)(ws + WS_CTL);
    for (int u = F.tid; u < (LDS_BYTES - LDSCTL_OFF) / 4; u += NWAVES * 64) ((LAS unsigned*)(F.lds + LDSCTL_OFF))[u] = 0u;
    __syncthreads();
    volatile LAS unsigned* MISC = (volatile LAS unsigned*)(F.lds + MISC_OFF);
    XcdBarrier bar = xcd_barrier_post(ctl + CW_BAR, MISC + 8);
#define GRID_BAR() do { XcdBarrier bb_ = bar; unsigned x_ = bar.x; asm volatile("" : "+s"(x_)); bb_.x = x_; xcd_barrier(bb_); } while (0)
#ifdef ONLY_PHASE
#define PHON(n) ((n) == ONLY_PHASE)
#elif DIAG
#define PHON(n) ((n) <= args.upto)
#else
#define PHON(n) 1
#endif

#define x_in ((const float*)(args.in[0]))
#define norm_mix ((const float*)(args.in[1]))
#define norm_ffn ((const float*)(args.in[2]))
#define gla_w_in ((const float*)(args.in[3]))
#define gla_wgu ((const float*)(args.in[4]))
#define gla_bg ((const float*)(args.in[5]))
#define gla_norm ((const float*)(args.in[6]))
#define gla_w_out ((const float*)(args.in[7]))
#define diff_w_in ((const float*)(args.in[8]))
#define lq1 ((const float*)(args.in[9]))
#define lk1 ((const float*)(args.in[10]))
#define lq2 ((const float*)(args.in[11]))
#define lk2 ((const float*)(args.in[12]))
#define diff_subln ((const float*)(args.in[13]))
#define diff_w_out ((const float*)(args.in[14]))
#define moe_wgrp ((const float*)(args.in[15]))
#define moe_wexp ((const float*)(args.in[16]))
#define moe_wg ((const float*)(args.in[17]))
#define moe_wu ((const float*)(args.in[18]))
#define moe_wd ((const float*)(args.in[19]))
#define final_norm ((const float*)(args.in[20]))
#define xres ((float*)(args.out))
#define gz ((float*)((float*)(ws + WS_GZ)))
#define tok_e ((int*)((int*)(ws + WS_TOKE)))
#define tok_p ((int*)((int*)(ws + WS_TOKP)))
#define tok_w ((float*)((float*)(ws + WS_TOKW)))
#define slot_of ((int*)((int*)(ws + WS_SLOT)))
#define slot_tok ((int*)(ws + WS_STOK))
#define adec ((float*)((float*)(ws + WS_ADEC)))
#define pcum ((float*)((float*)(ws + WS_PCUM)))
#define sfin ((bf16_t*)((bf16_t*)(ws + WS_SFIN)))
#define wp_gz ((float*)((float*)(ws + WS_WPGZ)))
#define wp_r0 ((float*)((float*)(ws + WS_WPR0)))
#define wp_r1 ((float*)((float*)(ws + WS_WPR1)))
#define wgi ((bf16_t*)((bf16_t*)(ws + WS_WGI)))
#define wgo ((bf16_t*)((bf16_t*)(ws + WS_WGO)))
#define wdi ((bf16_t*)((bf16_t*)(ws + WS_WDI)))
#define wdo ((bf16_t*)((bf16_t*)(ws + WS_WDO)))
#define wmoe_gu ((bf16_t*)((bf16_t*)(ws + WS_WMOE)))
#define wmoe_d ((bf16_t*)((bf16_t*)(ws + WS_WMOE_D)))
#define hn ((bf16_t*)((bf16_t*)(ws + WS_HN)))
#define proj ((bf16_t*)((bf16_t*)(ws + WS_PROJ)))
#define buf1 ((bf16_t*)((bf16_t*)(ws + WS_BUF1)))
#define buf2 ((bf16_t*)((bf16_t*)(ws + WS_BUF2)))
#define ag ((bf16_t*)((bf16_t*)(ws + WS_AG)))
#define ob ((bf16_t*)((bf16_t*)(ws + WS_OB)))
#define hh ((bf16_t*)((bf16_t*)(ws + WS_H)))
    const LAS int* pst = (const LAS int*)(F.lds + TAB_OFF);

    _Pragma("unroll") for (int rep_ = 0; rep_ < (REP_PHASE == 0 ? 2 : 1); ++rep_) if (PHON(0)) { if (rep_) GRID_BAR(); Frame P = F; P.tid = opq(F.tid); P.lane = P.tid & 63;
    conv_plain(P, gla_w_in, D, PROJW, GLA_INW, wgi);
    conv_plain(P, gla_w_out, D, D, D, wgo);
    conv_plain(P, diff_w_in, D, PROJW, PROJW, wdi);
    conv_plain(P, diff_w_out, D, D, D, wdo);
    pack_proj(P, wp_gz, 1, norm_mix, gla_w_in, GLA_INW, PROJW, 16, nullptr, 0, 0);
    pack_proj(P, wp_r0, 3, norm_ffn, moe_wgrp, 4, 0, 4, moe_wexp, 32, 32);
    pack_proj(P, wp_r1, 3, norm_ffn + D, moe_wgrp + (size_t)D * 4, 4, 0, 4, moe_wexp + (size_t)D * 32, 32, 32);
    }
    GRID_BAR();
    _Pragma("unroll") for (int rep_ = 0; rep_ < (REP_PHASE == 1 ? 2 : 1); ++rep_) if (PHON(1)) { if (rep_) GRID_BAR(); Frame P = F; P.tid = opq(F.tid); P.lane = P.tid & 63;
    phase_norm_gz(P, x_in, norm_mix, wp_gz, hn, gz);
    }
    GRID_BAR();
    _Pragma("unroll") for (int rep_ = 0; rep_ < (REP_PHASE == 2 ? 2 : 1); ++rep_) if (PHON(2)) { if (rep_) GRID_BAR(); Frame P = F; P.tid = opq(F.tid); P.lane = P.tid & 63;
    { pg8::Gemm g{hn, wgi, T, PROJW, D}; pg8::StaticOrder S; S.init(T, PROJW, P.G, (int)blockIdx.x); pg8::EpiHeads<0> E{proj};
      pg8::gemm_phase<pg8::EpiHeads<0>, pg8::StaticOrder>(P.lds, g, S, E); }
    }
    GRID_BAR();
    _Pragma("unroll") for (int rep_ = 0; rep_ < (REP_PHASE == 3 ? 2 : 1); ++rep_) if (PHON(3)) { if (rep_) GRID_BAR(); Frame P = F; P.tid = opq(F.tid); P.lane = P.tid & 63;
    phase_gla_gate(P, gz, gla_wgu, gla_bg, proj, buf1, adec);
    }
    GRID_BAR();
    _Pragma("unroll") for (int rep_ = 0; rep_ < (REP_PHASE == 4 ? 2 : 1); ++rep_) if (PHON(4)) { if (rep_) GRID_BAR(); Frame P = F; P.tid = opq(F.tid); P.lane = P.tid & 63;
    if (P.G == 256) { if ((P.vcu & 1) == 0) phase_gla_scan(P, P.vcu >> 1, proj, buf1, adec, buf2, sfin, ctl + CW_PROBE); else { gla_pcum(P, adec, pcum, P.vcu >> 1, 128); conv_moe(P, moe_wg, moe_wu, moe_wd, wmoe_gu, wmoe_d, P.vcu >> 1, 128); } }
    else { for (int it = P.vcu; it < 128; it += P.G) phase_gla_scan(P, it, proj, buf1, adec, buf2, sfin); gla_pcum(P, adec, pcum, P.vcu, P.G); conv_moe(P, moe_wg, moe_wu, moe_wd, wmoe_gu, wmoe_d); }
    GRID_BAR();
    phase_gla_qp(P, proj, pcum, hn);
    GRID_BAR();
    { pg8::Gemm g{hn, sfin, 8 * (SEQ / 2), 512, 256}; pg8::FixOrder S; S.init(8 * (SEQ / 2), 512, P.G, (int)blockIdx.x); pg8::EpiAddO E{buf2};
      pg8::gemm_phase<pg8::EpiAddO, pg8::FixOrder>(P.lds, g, S, E); }
    }
    GRID_BAR();
    _Pragma("unroll") for (int rep_ = 0; rep_ < (REP_PHASE == 5 ? 2 : 1); ++rep_) if (PHON(5)) { if (rep_) GRID_BAR(); Frame P = F; P.tid = opq(F.tid); P.lane = P.tid & 63;
    phase_gla_gnorm(P, buf2, proj, gla_norm, hn);
    }
    GRID_BAR();
    _Pragma("unroll") for (int rep_ = 0; rep_ < (REP_PHASE == 6 ? 2 : 1); ++rep_) if (PHON(6)) { if (rep_) GRID_BAR(); Frame P = F; P.tid = opq(F.tid); P.lane = P.tid & 63;
    { pg8::Gemm g{hn, wgo, T, D, D}; pg8::StaticOrder S; S.init(T, D, P.G, (int)blockIdx.x); pg8::EpiResF32 E{x_in, xres, D};
      pg8::gemm_phase<pg8::EpiResF32, pg8::StaticOrder>(P.lds, g, S, E); }
    }
    GRID_BAR();
    _Pragma("unroll") for (int rep_ = 0; rep_ < (REP_PHASE == 7 ? 2 : 1); ++rep_) if (PHON(7)) { if (rep_) GRID_BAR(); Frame P = F; P.tid = opq(F.tid); P.lane = P.tid & 63;
    phase_norm_route(P, xres, norm_ffn, wp_r0, hn, tok_e, tok_p, tok_w, ctl + CW_CNT0);
    }
    GRID_BAR();
    _Pragma("unroll") for (int rep_ = 0; rep_ < (REP_PHASE == 8 ? 2 : 1); ++rep_) if (PHON(8)) { if (rep_) GRID_BAR(); Frame P = F; P.tid = opq(F.tid); P.lane = P.tid & 63;
    moe_tables(P, ctl + CW_CNT0);
    phase_moe_slots(P, tok_e, tok_p, ctl + CW_CNT0, slot_of, slot_tok);
    }
    GRID_BAR();
    _Pragma("unroll") for (int rep_ = 0; rep_ < (REP_PHASE == 9 ? 2 : 1); ++rep_) if (PHON(9)) { if (rep_) GRID_BAR(); Frame P = F; P.tid = opq(F.tid); P.lane = P.tid & 63;
    { const int Mr = pst[33] * 256; pg8::Gemm g{hn, wmoe_gu, Mr, 1024, D}; pg8::MoeOrder S; S.init(Mr, 1024, P.G, (int)blockIdx.x); S.te = pst + 36; S.estride = (size_t)1024 * D * 2; S.stok = slot_tok; pg8::EpiSiluMul E{hh};
      pg8::gemm_phase<pg8::EpiSiluMul, pg8::MoeOrder, true>(P.lds, g, S, E); }
    }
    GRID_BAR();
    _Pragma("unroll") for (int rep_ = 0; rep_ < (REP_PHASE == 10 ? 2 : 1); ++rep_) if (PHON(10)) { if (rep_) GRID_BAR(); Frame P = F; P.tid = opq(F.tid); P.lane = P.tid & 63;
    { const int Mr = pst[33] * 256; pg8::Gemm g{hh, wmoe_d, Mr, D, DFF}; pg8::MoeOrder S; S.init(Mr, D, P.G, (int)blockIdx.x); S.te = pst + 36; S.estride = (size_t)D * DFF * 2; S.stok = slot_tok; pg8::EpiBf16 E{ob, D};
      pg8::gemm_phase<pg8::EpiBf16, pg8::MoeOrder>(P.lds, g, S, E); }
    }
    GRID_BAR();
    _Pragma("unroll") for (int rep_ = 0; rep_ < (REP_PHASE == 11 ? 2 : 1); ++rep_) if (PHON(11)) { if (rep_) GRID_BAR(); Frame P = F; P.tid = opq(F.tid); P.lane = P.tid & 63;
    phase_moe_combine<0>(P, xres, ob, slot_of, tok_w, norm_mix + D, hn);
    conv_moe(P, moe_wg + (size_t)NEXP * D * DFF, moe_wu + (size_t)NEXP * D * DFF, moe_wd + (size_t)NEXP * DFF * D, wmoe_gu, wmoe_d);
    }
    GRID_BAR();
    _Pragma("unroll") for (int rep_ = 0; rep_ < (REP_PHASE == 12 ? 2 : 1); ++rep_) if (PHON(12)) { if (rep_) GRID_BAR(); Frame P = F; P.tid = opq(F.tid); P.lane = P.tid & 63;
    { pg8::Gemm g{hn, wdi, T, PROJW, D}; pg8::StaticOrder S; S.init(T, PROJW, P.G, (int)blockIdx.x); pg8::EpiHeads<1> E{proj};
      pg8::gemm_phase<pg8::EpiHeads<1>, pg8::StaticOrder>(P.lds, g, S, E); }
    GRID_BAR();
    att::norms_phase(P, proj, (float*)(ws + WS_NRM));
    }
    GRID_BAR();
    _Pragma("unroll") for (int rep_ = 0; rep_ < (REP_PHASE == 13 ? 2 : 1); ++rep_) if (PHON(13)) { if (rep_) GRID_BAR(); Frame P = F; P.tid = opq(F.tid); P.lane = P.tid & 63;
    att::attn_phase(P, proj, (const float*)(ws + WS_NRM), ctl + CW_QUEUE, buf1, buf2);
    }
    GRID_BAR();
    _Pragma("unroll") for (int rep_ = 0; rep_ < (REP_PHASE == 14 ? 2 : 1); ++rep_) if (PHON(14)) { if (rep_) GRID_BAR(); Frame P = F; P.tid = opq(F.tid); P.lane = P.tid & 63;
    phase_subln(P, buf1, buf2, lq1, lk1, lq2, lk2, diff_subln, hn);
    }
    GRID_BAR();
    _Pragma("unroll") for (int rep_ = 0; rep_ < (REP_PHASE == 15 ? 2 : 1); ++rep_) if (PHON(15)) { if (rep_) GRID_BAR(); Frame P = F; P.tid = opq(F.tid); P.lane = P.tid & 63;
    { pg8::Gemm g{hn, wdo, T, D, D}; pg8::StaticOrder S; S.init(T, D, P.G, (int)blockIdx.x); pg8::EpiResF32 E{xres, xres, D};
      pg8::gemm_phase<pg8::EpiResF32, pg8::StaticOrder>(P.lds, g, S, E); }
    }
    GRID_BAR();
    _Pragma("unroll") for (int rep_ = 0; rep_ < (REP_PHASE == 16 ? 2 : 1); ++rep_) if (PHON(16)) { if (rep_) GRID_BAR(); Frame P = F; P.tid = opq(F.tid); P.lane = P.tid & 63;
    phase_norm_route(P, xres, norm_ffn + D, wp_r1, hn, tok_e, tok_p, tok_w, ctl + CW_CNT1);
    }
    GRID_BAR();
    _Pragma("unroll") for (int rep_ = 0; rep_ < (REP_PHASE == 17 ? 2 : 1); ++rep_) if (PHON(17)) { if (rep_) GRID_BAR(); Frame P = F; P.tid = opq(F.tid); P.lane = P.tid & 63;
    moe_tables(P, ctl + CW_CNT1);
    phase_moe_slots(P, tok_e, tok_p, ctl + CW_CNT1, slot_of, slot_tok);
    }
    GRID_BAR();
    _Pragma("unroll") for (int rep_ = 0; rep_ < (REP_PHASE == 18 ? 2 : 1); ++rep_) if (PHON(18)) { if (rep_) GRID_BAR(); Frame P = F; P.tid = opq(F.tid); P.lane = P.tid & 63;
    { const int Mr = pst[33] * 256; pg8::Gemm g{hn, wmoe_gu, Mr, 1024, D}; pg8::MoeOrder S; S.init(Mr, 1024, P.G, (int)blockIdx.x); S.te = pst + 36; S.estride = (size_t)1024 * D * 2; S.stok = slot_tok; pg8::EpiSiluMul E{hh};
      pg8::gemm_phase<pg8::EpiSiluMul, pg8::MoeOrder, true>(P.lds, g, S, E); }
    }
    GRID_BAR();
    _Pragma("unroll") for (int rep_ = 0; rep_ < (REP_PHASE == 19 ? 2 : 1); ++rep_) if (PHON(19)) { if (rep_) GRID_BAR(); Frame P = F; P.tid = opq(F.tid); P.lane = P.tid & 63;
    { const int Mr = pst[33] * 256; pg8::Gemm g{hh, wmoe_d, Mr, D, DFF}; pg8::MoeOrder S; S.init(Mr, D, P.G, (int)blockIdx.x); S.te = pst + 36; S.estride = (size_t)D * DFF * 2; S.stok = slot_tok; pg8::EpiBf16 E{ob, D};
      pg8::gemm_phase<pg8::EpiBf16, pg8::MoeOrder>(P.lds, g, S, E); }
    }
    GRID_BAR();
    _Pragma("unroll") for (int rep_ = 0; rep_ < (REP_PHASE == 20 ? 2 : 1); ++rep_) if (PHON(20)) { if (rep_) GRID_BAR(); Frame P = F; P.tid = opq(F.tid); P.lane = P.tid & 63;
    phase_moe_combine<1>(P, xres, ob, slot_of, tok_w, final_norm, hn);
    }
#if PROBE
    { GRID_BAR(); const float c = sqrtf(0.1f * __uint_as_float(xb_ld(ctl + CW_PROBE)));
      for (size_t i = (size_t)blockIdx.x * 512 + F.tid; i < (size_t)T * D; i += (size_t)gridDim.x * 512) xres[i] = c; }
#endif
}

#undef x_in
#undef norm_mix
#undef norm_ffn
#undef gla_w_in
#undef gla_wgu
#undef gla_bg
#undef gla_norm
#undef gla_w_out
#undef diff_w_in
#undef lq1
#undef lk1
#undef lq2
#undef lk2
#undef diff_subln
#undef diff_w_out
#undef moe_wgrp
#undef moe_wexp
#undef moe_wg
#undef moe_wu
#undef moe_wd
#undef final_norm
#undef xres
#undef gz
#undef tok_e
#undef tok_p
#undef tok_w
#undef slot_of
#undef slot_tok
#undef adec
#undef pcum
#undef sfin
#undef wp_gz
#undef wp_r0
#undef wp_r1
#undef wgi
#undef wgo
#undef wdi
#undef wdo
#undef wmoe_gu
#undef wmoe_d
#undef hn
#undef proj
#undef buf1
#undef buf2
#undef ag
#undef ob
#undef hh
#if DIAG
constexpr size_t WS_DIAG = WS_END;
constexpr int NSAVE = 64;
__device__ inline unsigned hsh(unsigned x) { x ^= x >> 16; x *= 0x7feb352dU; x ^= x >> 15; x *= 0x846ca68bU; x ^= x >> 16; return x; }
__device__ inline void rep(unsigned* w, double got, double ref, double scale) { double e = fabs(got - ref) / (fabs(ref) + scale); float ef = (float)e; if (!(ef == ef) || ef > 1e30f) ef = 1e30f; atomicMax(w, __float_as_uint(ef)); }
__device__ inline double bfd(bf16_t v) { return (double)bf2f(v); }
#define GTID (blockIdx.x * blockDim.x + threadIdx.x)
#define GSTR (gridDim.x * blockDim.x)

__global__ void ck_weights(const float* gla_w_in, const float* gla_w_out, const float* diff_w_in, const float* diff_w_out, const bf16_t* wgi, const bf16_t* wgo, const bf16_t* wdi, const bf16_t* wdo,
                           const float* norm_mix, const float* norm_ffn, const float* wgrp, const float* wexp, const float* wp_gz, const float* wp_r0, const float* wp_r1, unsigned* w) {
    for (unsigned i = GTID; i < 65536u; i += GSTR) { const unsigned r = hsh(i * 3u + 1u), r2 = hsh(i * 7u + 5u);
        const int n = r % 6144u, k = r2 % 2048u, n2 = n % 2048;
        rep(w, bfd(wgi[(size_t)n * D + k]), gla_w_in[(size_t)k * GLA_INW + n], 0.02); rep(w, bfd(wdi[(size_t)n * D + k]), diff_w_in[(size_t)k * PROJW + n], 0.02);
        rep(w, bfd(wgo[(size_t)n2 * D + k]), gla_w_out[(size_t)k * D + n2], 0.02); rep(w, bfd(wdo[(size_t)n2 * D + k]), diff_w_out[(size_t)k * D + n2], 0.02);
        const int s = r % 128u, ln = (r >> 7) % 64u, e4 = (r >> 13) & 3, kk = 16 * s + 4 * (ln >> 4) + e4, col = ln & 15, nt = (r >> 15) % 3u, col3 = 16 * nt + col;
        rep(w, wp_gz[(s * 64 + ln) * 4 + e4], (double)norm_mix[kk] * gla_w_in[(size_t)kk * GLA_INW + PROJW + col], 0.02);
        for (int L = 0; L < 2; ++L) { const float* gr = wgrp + (size_t)L * D * 4; const float* ex = wexp + (size_t)L * D * 32; const float* nf = norm_ffn + L * D;
            const double ref = col3 < 4 ? gr[kk * 4 + col3] : (col3 < 36 ? ex[kk * 32 + col3 - 4] : 0.0);
            rep(w, (L ? wp_r1 : wp_r0)[((s * 3 + nt) * 64 + ln) * 4 + e4], (double)nf[kk] * ref, 0.02); } }
}
__global__ void ck_moew(const float* wg, const float* wu, const float* wd, const bf16_t* GU, const bf16_t* DT, unsigned* w) {
    for (unsigned i = GTID; i < 65536u; i += GSTR) { const unsigned r = hsh(i * 5u + 2u), r2 = hsh(i * 11u + 3u);
        const int e = r % 32u, f = (r >> 5) % 512u, k = r2 % 2048u, n2 = (r2 >> 11) % 2048u, rowg = 256 * (f >> 7) + (f & 127);
        rep(w, bfd(GU[((size_t)e * 1024 + rowg) * D + k]), wg[((size_t)e * D + k) * DFF + f], 0.02); rep(w, bfd(GU[((size_t)e * 1024 + rowg + 128) * D + k]), wu[((size_t)e * D + k) * DFF + f], 0.02);
        rep(w, bfd(DT[((size_t)e * D + n2) * DFF + f]), wd[((size_t)e * DFF + f) * D + n2], 0.05); }
}
__global__ void ck_norm(const float* x, const float* gain, const bf16_t* hn, unsigned* w) {
    for (unsigned i = GTID; i < 4096u; i += GSTR) { const unsigned r = hsh(i * 13u + 7u); const int t = r % (unsigned)T, j = (r >> 15) % 2048u;
        double ss = 0; for (int k = 0; k < D; ++k) { const double v = x[(size_t)t * D + k]; ss += v * v; }
        const double rstd = 1.0 / sqrt(ss / D + 1e-6); rep(w, bfd(hn[(size_t)t * D + j]), x[(size_t)t * D + j] * rstd * gain[j], 1.0); }
}
__global__ void ck_gz(const float* x, const float* gain, const float* gla_w_in, const float* gz, unsigned* w) {
    for (unsigned i = GTID; i < 4096u; i += GSTR) { const unsigned r = hsh(i * 17u + 9u); const int t = r % (unsigned)T, c = (r >> 15) % 16u;
        double ss = 0, dot = 0; for (int k = 0; k < D; ++k) { const double v = x[(size_t)t * D + k]; ss += v * v; dot += v * gain[k] * gla_w_in[(size_t)k * GLA_INW + PROJW + c]; }
        rep(w, gz[(size_t)t * 16 + c], dot / sqrt(ss / D + 1e-6), 1.0); }
}
__global__ void ck_gemm(const bf16_t* A, const bf16_t* Bt, const bf16_t* C, int M, int N, int K, int ldc, double scale, unsigned* w) {
    for (unsigned i = GTID; i < 16384u; i += GSTR) { const unsigned r = hsh(i * 19u + 11u), r2 = hsh(i * 23u + 1u); const int m = r % (unsigned)M, n = r2 % (unsigned)N;
        double s = 0; for (int k = 0; k < K; ++k) s += bfd(A[(size_t)m * K + k]) * bfd(Bt[(size_t)n * K + k]);
        rep(w, bfd(C[(size_t)m * ldc + n]), s, scale); }
}
__global__ void ck_proj(const bf16_t* A, const bf16_t* Bt, const bf16_t* proj, int layer, unsigned* w) {
    for (unsigned i = GTID; i < 16384u; i += GSTR) { const unsigned r = hsh(i * 19u + 11u), r2 = hsh(i * 23u + 1u); const int m = r % (unsigned)T, n = r2 % (unsigned)PROJW, b = m >> 14, t = m & (SEQ - 1);
        double s = 0; for (int k = 0; k < D; ++k) s += bfd(A[(size_t)m * D + k]) * bfd(Bt[(size_t)n * D + k]);
        size_t off;
        if (layer == 0) { if (n < 1024) off = gq_off(b, t, n >> 8) + (n & 255); else if (n < 2048) off = GK0 + gq_off(b, t, (n - 1024) >> 8) + (n & 255); else if (n < 4096) off = gv_off(b, t, (n - 2048) >> 9) + (n & 511); else off = GR0 + (size_t)m * 2048 + (n - 4096); }
        else { if (n < 2048) off = dq_off(b, t, n >> 8, (n >> 7) & 1) + (n & 127); else if (n < 4096) off = DK0 + dq_off(b, t, (n - 2048) >> 8, (n >> 7) & 1) + (n & 127); else off = dv_off(b, t, (n - 4096) >> 8) + (n & 255); }
        rep(w, bfd(proj[off]), s, 1.0); }
}
__device__ inline int srow(int i) { return (int)(hsh(i * 29u + 13u) % (unsigned)T); }
__global__ void ck_save(const float* x, float* save) { for (unsigned i = GTID; i < (unsigned)NSAVE * D; i += GSTR) save[i] = x[(size_t)srow(i / D) * D + (i % D)]; }
__global__ void ck_gemm_res(const bf16_t* A, const bf16_t* Bt, const float* base, int saved, const float* out, unsigned* w) {
    for (unsigned i = GTID; i < (unsigned)NSAVE * 64u; i += GSTR) { const int si = i / 64, t = srow(si), n = hsh(i * 31u + 5u) % 2048u;
        double s = 0; for (int k = 0; k < D; ++k) s += bfd(A[(size_t)t * D + k]) * bfd(Bt[(size_t)n * D + k]);
        const double b = saved ? base[(size_t)si * D + n] : base[(size_t)t * D + n];
        rep(w, out[(size_t)t * D + n], b + s, 1.0); }
}
__global__ void ck_gate(const float* gz, const float* wgu, const float* bg, const bf16_t* proj, const bf16_t* kdT, const float* adec, unsigned* w) {
    for (unsigned i = GTID; i < 4096u; i += GSTR) { const unsigned r = hsh(i * 37u + 3u); const int bc = r % 512u, j = (r >> 9) % 1024u, tq = (r >> 19) % 64u;
        double run = 0, ct = 0;
        for (int t = 0; t < 64; ++t) { double z = bg[j]; for (int q = 0; q < 16; ++q) z += (double)gz[((size_t)bc * 64 + t) * 16 + q] * wgu[q * 1024 + j];
            const double ls = fmin(z, 0.0) - log1p(exp(-fabs(z))); run += ls / 16.0; if (t == tq) ct = run; }
        rep(w, adec[(size_t)bc * 1024 + j], exp(run), 1.0);
        rep(w, bfd(kdT[((size_t)bc * 1024 + j) * 64 + tq]), bfd(proj[GK0 + gq_off(bc >> 8, (bc & 255) * 64 + tq, j >> 8) + (j & 255)]) * exp(run - ct), 1.0); }
}
__global__ void ck_scan(const bf16_t* proj, const bf16_t* kdT, const float* adec, const bf16_t* o, unsigned* w) {
    const int wv = GTID / 64, lane = threadIdx.x & 63, nw = GSTR / 64;
    const int cl[8] = {0, 1, 3, 17, 100, 255, 2, 64};
    for (int s = wv; s < 96; s += nw) { const unsigned r = hsh(s * 41u + 17u); const int b = r & 1, c = cl[s % 8], tl = (r >> 1) % 64u, h = (r >> 7) % 4u, vc = (r >> 9) % 512u;
        float S[4] = {0.f, 0.f, 0.f, 0.f};
        for (int cc = 0; cc <= c; ++cc) { const size_t bc = (size_t)b * NCH + cc;
            for (int q = 0; q < 4; ++q) { const int kr = h * 256 + lane * 4 + q; float a = 0.f;
                for (int t = 0; t < 64; ++t) a += bf2f(kdT[(bc * 1024 + kr) * 64 + t]) * bf2f(proj[gv_off(b, cc * 64 + t, h) + vc]);
                S[q] = adec[bc * 1024 + kr] * S[q] + a; } }
        float part = 0.f; const size_t tok = (size_t)b * SEQ + c * 64 + tl;
        for (int q = 0; q < 4; ++q) part += bf2f(proj[gq_off(b, c * 64 + tl, h) + lane * 4 + q]) * S[q];
        for (int of = 1; of < 64; of <<= 1) part += __shfl_xor(part, of);
        if (lane == 0) rep(w, bfd(o[tok * D + h * 512 + vc]), part / 16.0, 2.0); }
}
__global__ void ck_gnorm(const bf16_t* o, const bf16_t* proj, const float* gn, const bf16_t* y, unsigned* w) {
    for (unsigned i = GTID; i < 8192u; i += GSTR) { const unsigned r = hsh(i * 43u + 19u); const int t = r % (unsigned)T, h = (r >> 15) % 4u, j = (r >> 17) % 512u;
        double ss = 0; for (int k = 0; k < 512; ++k) { const double v = bfd(o[(size_t)t * D + h * 512 + k]); ss += v * v; }
        const double rr = bfd(proj[GR0 + (size_t)t * 2048 + h * 512 + j]);
        rep(w, bfd(y[(size_t)t * D + h * 512 + j]), bfd(o[(size_t)t * D + h * 512 + j]) / sqrt(ss / 512 + 1e-6) * gn[j] * rr / (1.0 + exp(-rr)), 1.0); }
}
__global__ void ck_route(const float* x, const float* gain, const float* wgrp, const float* wexp, const int* tok_e, const int* tok_p, const float* tok_w, const unsigned* cnt, unsigned* w) {
    for (unsigned i = GTID; i < 512u; i += GSTR) { const int t = hsh(i * 47u + 23u) % (unsigned)T;
        double ss = 0; for (int k = 0; k < D; ++k) { const double v = x[(size_t)t * D + k]; ss += v * v; }
        const double rstd = 1.0 / sqrt(ss / D + 1e-6);
        double gl[4] = {0, 0, 0, 0};
        for (int k = 0; k < D; ++k) { const double v = x[(size_t)t * D + k] * rstd * gain[k]; for (int q = 0; q < 4; ++q) gl[q] += v * wgrp[k * 4 + q]; }
        int gi = 0; for (int q = 1; q < 4; ++q) if (gl[q] > gl[gi]) gi = q;
        double gs = 0; for (int q = 0; q < 4; ++q) gs += exp(gl[q] - gl[gi]);
        double el[8] = {0, 0, 0, 0, 0, 0, 0, 0};
        for (int k = 0; k < D; ++k) { const double v = x[(size_t)t * D + k] * rstd * gain[k]; for (int q = 0; q < 8; ++q) el[q] += v * wexp[k * 32 + gi * 8 + q]; }
        int i1 = 0; for (int q = 1; q < 8; ++q) if (el[q] > el[i1]) i1 = q;
        int i2 = (i1 == 0) ? 1 : 0; for (int q = 0; q < 8; ++q) if (q != i1 && el[q] > el[i2]) i2 = q;
        const double eb = exp(el[i2] - el[i1]);
        const int e1 = tok_e[2 * t], e2 = tok_e[2 * t + 1];
        double third = -1e30; for (int q = 0; q < 8; ++q) if (q != i1 && q != i2 && el[q] > third) third = el[q];
        const bool tie = (el[i2] - third) < 1e-4 || (el[i1] - el[i2]) < 1e-4;
        if (!tie) { rep(w, e1, gi * 8 + i1, 1.0); rep(w, e2, gi * 8 + i2, 1.0);
            rep(w, tok_w[2 * t], 1.0 / gs / (1.0 + eb), 0.3); rep(w, tok_w[2 * t + 1], eb / gs / (1.0 + eb), 0.3); }
        if ((unsigned)tok_p[2 * t] >= cnt[64 * (e1 & 31)] || (unsigned)tok_p[2 * t + 1] >= cnt[64 * (e2 & 31)]) rep(w, 9.0, 0.0, 1.0); }
}
__global__ void ck_gather(const int* tok_e, const int* tok_p, const int* slot_of, const unsigned* cnt, const bf16_t* hn, const int* ag  , unsigned* w) {
    for (unsigned i = GTID; i < 8192u; i += GSTR) { const unsigned r = hsh(i * 53u + 29u); const int a = r % (2u * T), k = (r >> 16) % 2048u, e = tok_e[a] & 31;
        int ps = 0; for (int q = 0; q < e; ++q) ps += ((int)cnt[64 * q] + 255) & ~255;
        const int slot = slot_of[a];
        rep(w, slot, ps + tok_p[a], 1.0);
        if (slot >= 0 && slot < MAX_TILES * 256) rep(w, (double)ag[slot], (double)(a >> 1), 1.0); (void)hn; (void)k; }
}
__global__ void ck_moe1(const int* tok_e, const int* slot_of, const bf16_t* ag, const float* wg, const float* wu, const bf16_t* hh, unsigned* w) {
    for (unsigned i = GTID; i < 8192u; i += GSTR) { const unsigned r = hsh(i * 59u + 31u); const int a = r % (2u * T), f = (r >> 16) % 512u, e = tok_e[a] & 31, slot = slot_of[a];
        if (slot < 0 || slot >= MAX_TILES * 256) { rep(w, 9.0, 0.0, 1.0); continue; }
        double g = 0, u = 0; for (int k = 0; k < D; ++k) { const double v = bfd(ag[(size_t)(a >> 1) * D + k]); g += v * wg[((size_t)e * D + k) * DFF + f]; u += v * wu[((size_t)e * D + k) * DFF + f]; }
        rep(w, bfd(hh[(size_t)slot * DFF + f]), g / (1.0 + exp(-g)) * u, 0.5); }
}
__global__ void ck_moe2(const int* tok_e, const int* slot_of, const bf16_t* hh, const float* wd, const bf16_t* ob, unsigned* w) {
    for (unsigned i = GTID; i < 8192u; i += GSTR) { const unsigned r = hsh(i * 61u + 37u); const int a = r % (2u * T), n = (r >> 16) % 2048u, e = tok_e[a] & 31, slot = slot_of[a];
        if (slot < 0 || slot >= MAX_TILES * 256) { rep(w, 9.0, 0.0, 1.0); continue; }
        double s = 0; for (int f = 0; f < DFF; ++f) s += bfd(hh[(size_t)slot * DFF + f]) * wd[((size_t)e * DFF + f) * D + n];
        rep(w, bfd(ob[(size_t)slot * D + n]), s, 0.3); }
}
__global__ void ck_combine(const float* save, const bf16_t* ob, const int* slot_of, const float* tok_w, const float* gain, const float* x, const bf16_t* hn, int mode, unsigned* w) {
    for (unsigned i = GTID; i < (unsigned)NSAVE * 32u; i += GSTR) { const int si = i / 32, t = srow(si), j = hsh(i * 67u + 41u) % 2048u;
        const int s0 = slot_of[2 * t], s1 = slot_of[2 * t + 1]; const double w0 = tok_w[2 * t], w1 = tok_w[2 * t + 1];
        double ss = 0, xj = 0; for (int k = 0; k < D; ++k) { const double v = save[(size_t)si * D + k] + w0 * bfd(ob[(size_t)s0 * D + k]) + w1 * bfd(ob[(size_t)s1 * D + k]); ss += v * v; if (k == j) xj = v; }
        const double y = xj / sqrt(ss / D + 1e-6) * gain[j];
        if (mode == 0) { rep(w, x[(size_t)t * D + j], xj, 1.0); rep(w, bfd(hn[(size_t)t * D + j]), y, 1.0); } else rep(w, x[(size_t)t * D + j], y, 1.0); }
}
__global__ void ck_attn(const bf16_t* proj, const bf16_t* o1, const bf16_t* o2, unsigned* w) {
    const int wv = GTID / 64, lane = threadIdx.x & 63, nw = GSTR / 64;
    const int tl[12] = {0, 1, 63, 64, 100, 255, 256, 1000, 4095, 8191, 16320, 16383};
    for (int s = wv; s < 96; s += nw) { const unsigned r = hsh(s * 71u + 43u); const int b = r & 1, h = (r >> 1) % 8u, sub = (r >> 4) & 1, t = tl[s % 12], dv0 = (r >> 5) % 253u;
        const double slope = exp2(-(double)(h + 1)); const int kend = 64 * (t / 64 + 1);
        const bf16_t* qp = proj + dq_off(b, t, h, sub);
        double mx = -1e300;
        for (int j = lane; j < kend; j += 64) { const bf16_t* kp = proj + DK0 + dq_off(b, j, h, sub); double d = 0; for (int q = 0; q < 128; ++q) d += bfd(qp[q]) * bfd(kp[q]);
            const double sc = d * 0.08838834764831845 - slope * fabs((double)(t - j)); if (sc > mx) mx = sc; }
        for (int of = 1; of < 64; of <<= 1) { const double o_ = __shfl_xor(mx, of); if (o_ > mx) mx = o_; }
        double l = 0, acc[4] = {0, 0, 0, 0};
        for (int j = lane; j < kend; j += 64) { const bf16_t* kp = proj + DK0 + dq_off(b, j, h, sub); double d = 0; for (int q = 0; q < 128; ++q) d += bfd(qp[q]) * bfd(kp[q]);
            const double p = exp(d * 0.08838834764831845 - slope * fabs((double)(t - j)) - mx); l += p;
            const bf16_t* vp = proj + dv_off(b, j, h) + dv0; for (int q = 0; q < 4; ++q) acc[q] += p * bfd(vp[q]); }
        for (int of = 1; of < 64; of <<= 1) { l += __shfl_xor(l, of); for (int q = 0; q < 4; ++q) acc[q] += __shfl_xor(acc[q], of); }
        if (lane == 0) for (int q = 0; q < 4; ++q) rep(w, bfd((sub ? o2 : o1)[((size_t)b * SEQ + t) * D + h * 256 + dv0 + q]), acc[q] / l, 0.2); }
}
__global__ void ck_subln(const bf16_t* o1, const bf16_t* o2, const float* lq1, const float* lk1, const float* lq2, const float* lk2, const float* sg, const bf16_t* y, unsigned* w) {
    double d1 = 0, d2 = 0; for (int k = 0; k < 128; ++k) { d1 += (double)lq1[k] * lk1[k]; d2 += (double)lq2[k] * lk2[k]; }
    const double li = 0.8 - 0.6 * exp(-0.3), lam = exp(d1) - exp(d2) + li;
    for (unsigned i = GTID; i < 8192u; i += GSTR) { const unsigned r = hsh(i * 73u + 47u); const int t = r % (unsigned)T, h = (r >> 15) % 8u, j = (r >> 18) % 256u;
        double ss = 0, dj = 0; for (int k = 0; k < 256; ++k) { const double v = bfd(o1[(size_t)t * D + h * 256 + k]) - lam * bfd(o2[(size_t)t * D + h * 256 + k]); ss += v * v; if (k == j) dj = v; }
        rep(w, bfd(y[(size_t)t * D + h * 256 + j]), dj / sqrt(ss / 256 + 1e-6) * sg[j] * (1.0 - li), 1.0); }
}
__global__ void ck_final(const unsigned* words, int nst, float* out, int n) {
    int val = 0;
    for (int s = 0; s < nst; ++s) { const float e = __uint_as_float(words[s]); if (e >= 0.03125f) { val = 4 * s + (e < 0.25f ? 1 : (e < 4.f ? 2 : 3)); break; } }
    const float c = sqrtf(0.1f * (float)val);
    for (int i = GTID; i < n; i += GSTR) out[i] = c;
}
#endif

extern "C" void kernel_launch(void* const* d_in, const int* in_sizes, int n_in, void* d_out, int out_size, void* d_ws, size_t ws_size, hipStream_t stream) {
    static int grid = 0;
    if (grid == 0) {
        if (n_in != 21 || out_size != T * D || ws_size < WS_END + 2 * MiB) { fprintf(stderr, "kernel_launch: unexpected shapes (n_in %d out %d ws %zu)\n", n_in, out_size, ws_size); grid = -1; return; }
        if (hipFuncSetAttribute((const void*)hybrid_fwd, hipFuncAttributeMaxDynamicSharedMemorySize, LDS_BYTES) != hipSuccess) { fprintf(stderr, "kernel_launch: hipFuncSetAttribute failed\n"); grid = -1; return; }
        int dev = 0, cus = 0, per_cu = 0;
        (void)hipGetDevice(&dev); (void)hipDeviceGetAttribute(&cus, hipDeviceAttributeMultiprocessorCount, dev);
        if (hipOccupancyMaxActiveBlocksPerMultiprocessor(&per_cu, (const void*)hybrid_fwd, NWAVES * 64, LDS_BYTES) != hipSuccess || per_cu < 1) fprintf(stderr, "kernel_launch: occupancy query says %d\n", per_cu);
        (void)hipGetLastError();
        grid = cus > 0 ? cus : 256;
    }
    if (grid < 0) return;
    Args a{};
    for (int i = 0; i < 21; ++i) a.in[i] = (const float*)d_in[i];
    a.out = (float*)d_out; a.ws = (unsigned char*)d_ws; a.upto = 99; a.pad1 = 0;
#if !DIAG
    (void)hipMemsetAsync((char*)d_ws + WS_CTL, 0, CTL_ZERO_BYTES, stream);
    hipLaunchKernelGGL(hybrid_fwd, dim3(grid), dim3(NWAVES * 64), LDS_BYTES, stream, a);
#else
    {
        unsigned char* ws = (unsigned char*)d_ws; const float* const* in = a.in;
        unsigned* words = (unsigned*)(ws + WS_DIAG); float* save = (float*)(ws + WS_DIAG + 65536);
        (void)hipMemsetAsync(words, 0, 65536, stream);
        float* gz = (float*)(ws + WS_GZ); int* tok_e = (int*)(ws + WS_TOKE); int* tok_p = (int*)(ws + WS_TOKP); float* tok_w = (float*)(ws + WS_TOKW); int* slot_of = (int*)(ws + WS_SLOT);
        float* adec = (float*)(ws + WS_ADEC); float* wp_gz = (float*)(ws + WS_WPGZ); float* wp_r0 = (float*)(ws + WS_WPR0); float* wp_r1 = (float*)(ws + WS_WPR1);
        bf16_t* wgi = (bf16_t*)(ws + WS_WGI); bf16_t* wgo = (bf16_t*)(ws + WS_WGO); bf16_t* wdi = (bf16_t*)(ws + WS_WDI); bf16_t* wdo = (bf16_t*)(ws + WS_WDO);
        bf16_t* gu = (bf16_t*)(ws + WS_WMOE); bf16_t* dt = (bf16_t*)(ws + WS_WMOE_D);
        bf16_t* hn = (bf16_t*)(ws + WS_HN); bf16_t* proj = (bf16_t*)(ws + WS_PROJ); bf16_t* buf1 = (bf16_t*)(ws + WS_BUF1); bf16_t* buf2 = (bf16_t*)(ws + WS_BUF2);
        bf16_t* ag = (bf16_t*)(ws + WS_AG); bf16_t* ob = (bf16_t*)(ws + WS_OB); bf16_t* hh = (bf16_t*)(ws + WS_H);
        unsigned* ctl = (unsigned*)(ws + WS_CTL); float* xres = (float*)d_out;
        const size_t L1W = (size_t)NEXP * D * DFF;
        for (int st = 0; st <= 20; ++st) {
            (void)hipMemsetAsync((char*)d_ws + WS_CTL, 0, CTL_ZERO_BYTES, stream);
            a.upto = st;
            hipLaunchKernelGGL(hybrid_fwd, dim3(grid), dim3(NWAVES * 64), LDS_BYTES, stream, a);
            unsigned* w = words + st;
            switch (st) {
            case 0: ck_weights<<<256, 256, 0, stream>>>(in[3], in[7], in[8], in[14], wgi, wgo, wdi, wdo, in[1], in[2], in[15], in[16], wp_gz, wp_r0, wp_r1, w); break;
            case 1: ck_norm<<<64, 64, 0, stream>>>(in[0], in[1], hn, w); ck_gz<<<64, 64, 0, stream>>>(in[0], in[1], in[3], gz, w); break;
            case 2: ck_proj<<<256, 64, 0, stream>>>(hn, wgi, proj, 0, w); break;
            case 3: ck_gate<<<64, 64, 0, stream>>>(gz, in[4], in[5], proj, buf1, adec, w); break;
            case 4: ck_scan<<<96, 64, 0, stream>>>(proj, buf1, adec, buf2, w); ck_moew<<<256, 256, 0, stream>>>(in[17], in[18], in[19], gu, dt, w); break;
            case 5: ck_gnorm<<<128, 64, 0, stream>>>(buf2, proj, in[6], hn, w); break;
            case 6: ck_gemm_res<<<64, 64, 0, stream>>>(hn, wgo, in[0], 0, xres, w); break;
            case 7: ck_norm<<<64, 64, 0, stream>>>(xres, in[2], hn, w); ck_route<<<8, 64, 0, stream>>>(xres, in[2], in[15], in[16], tok_e, tok_p, tok_w, ctl + CW_CNT0, w); break;
            case 8: ck_gather<<<128, 64, 0, stream>>>(tok_e, tok_p, slot_of, ctl + CW_CNT0, hn, (const int*)(ws + WS_STOK), w); break;
            case 9: ck_moe1<<<128, 64, 0, stream>>>(tok_e, slot_of, hn, in[17], in[18], hh, w); break;
            case 10: ck_moe2<<<128, 64, 0, stream>>>(tok_e, slot_of, hh, in[19], ob, w); ck_save<<<64, 256, 0, stream>>>(xres, save); break;
            case 11: ck_combine<<<32, 64, 0, stream>>>(save, ob, slot_of, tok_w, in[1] + D, xres, hn, 0, w); ck_moew<<<256, 256, 0, stream>>>(in[17] + L1W, in[18] + L1W, in[19] + L1W, gu, dt, w); break;
            case 12: ck_proj<<<256, 64, 0, stream>>>(hn, wdi, proj, 1, w); break;
            case 13: ck_attn<<<96, 64, 0, stream>>>(proj, buf1, buf2, w); break;
            case 14: ck_subln<<<128, 64, 0, stream>>>(buf1, buf2, in[9], in[10], in[11], in[12], in[13], hn, w); ck_save<<<64, 256, 0, stream>>>(xres, save); break;
            case 15: ck_gemm_res<<<64, 64, 0, stream>>>(hn, wdo, save, 1, xres, w); break;
            case 16: ck_norm<<<64, 64, 0, stream>>>(xres, in[2] + D, hn, w); ck_route<<<8, 64, 0, stream>>>(xres, in[2] + D, in[15] + (size_t)D * 4, in[16] + (size_t)D * 32, tok_e, tok_p, tok_w, ctl + CW_CNT1, w); break;
            case 17: ck_gather<<<128, 64, 0, stream>>>(tok_e, tok_p, slot_of, ctl + CW_CNT1, hn, (const int*)(ws + WS_STOK), w); break;
            case 18: ck_moe1<<<128, 64, 0, stream>>>(tok_e, slot_of, hn, in[17] + L1W, in[18] + L1W, hh, w); break;
            case 19: ck_moe2<<<128, 64, 0, stream>>>(tok_e, slot_of, hh, in[19] + L1W, ob, w); ck_save<<<64, 256, 0, stream>>>(xres, save); break;
            case 20: ck_combine<<<32, 64, 0, stream>>>(save, ob, slot_of, tok_w, in[20], xres, hn, 1, w); break;
            }
        }
        ck_final<<<1024, 256, 0, stream>>>(words, 21, (float*)d_out, out_size);
    }
#endif
}
```

```cpp
#ifndef DIAG
#define DIAG 0
#endif
#ifndef PROBE
#define PROBE 0
#endif
#ifndef REP_PHASE
#define REP_PHASE -1
#endif
#include <hip/hip_runtime.h>
#include <cstdio>
#include <cstdint>

#define LAS __attribute__((address_space(3)))
#define GAS __attribute__((address_space(1)))
typedef unsigned short bf16_t;
typedef short bf16x8 __attribute__((ext_vector_type(8)));
typedef short s16x4 __attribute__((ext_vector_type(4)));
typedef float f32x4 __attribute__((ext_vector_type(4)));
typedef float f32x2 __attribute__((ext_vector_type(2)));
typedef float f32x16 __attribute__((ext_vector_type(16)));
typedef unsigned u32x4 __attribute__((ext_vector_type(4)));
typedef unsigned u32x2 __attribute__((ext_vector_type(2)));

constexpr int D = 2048, SEQ = 16384, NBATCH = 2, T = NBATCH * SEQ, CHUNK = 64, NCH = SEQ / CHUNK;
constexpr int GLA_H = 4, GLA_DK = 256, GLA_DV = 512, GLA_DKT = 1024, GLA_INW = 6160, PROJW = 6144;
constexpr int DIFF_H = 8;
constexpr int NEXP = 32, DFF = 512;
constexpr float RMS_EPS = 1e-6f;
constexpr float LAMBDA_INIT = 0.35550906759f;
constexpr int MAX_TILES = 288;

constexpr size_t MiB = 1u << 20;
constexpr size_t WS_CTL = 0, CTL_ZERO_BYTES = 1 * MiB;
constexpr size_t WS_GZ = 2 * MiB;
constexpr size_t WS_TOKE = 4 * MiB;
constexpr size_t WS_TOKP = WS_TOKE + 256 * 1024;
constexpr size_t WS_TOKW = WS_TOKP + 256 * 1024;
constexpr size_t WS_SLOT = WS_TOKW + 256 * 1024;
constexpr size_t WS_STOK = 5 * MiB;
constexpr size_t WS_ADEC = 8 * MiB;
constexpr size_t WS_WPGZ = 10 * MiB;
constexpr size_t WS_WPR0 = 10 * MiB + 256 * 1024;
constexpr size_t WS_WPR1 = 11 * MiB;
constexpr size_t WS_NRM = 12 * MiB;
constexpr size_t WS_PCUM = 13 * MiB;
constexpr size_t WS_SFIN = 14 * MiB;
constexpr size_t WS_WGI = 16 * MiB, WS_WGO = 40 * MiB, WS_WDI = 48 * MiB, WS_WDO = 72 * MiB;
constexpr size_t WS_WMOE = 80 * MiB;
constexpr size_t WS_WMOE_D = WS_WMOE + 128 * MiB;
constexpr size_t WS_HN = 272 * MiB;
constexpr size_t WS_PROJ = 400 * MiB;
constexpr size_t WS_BUF1 = 784 * MiB;
constexpr size_t WS_BUF2 = 912 * MiB;
constexpr size_t WS_AG = 400 * MiB;
constexpr size_t WS_OB = 688 * MiB;
constexpr size_t WS_H = 976 * MiB;
constexpr size_t WS_END = 1048 * MiB;
constexpr int CW_BAR = 4096;
constexpr int CW_PROBE = 8320;
constexpr int CW_QUEUE = 8192;
constexpr int CW_CNT0 = 16384, CW_CNT1 = 16384 + 32 * 64;


constexpr size_t GK0 = (size_t)T * 1024, GV0 = (size_t)T * 2048, GR0 = (size_t)T * 4096;
constexpr size_t DK0 = (size_t)T * 2048, DV0 = (size_t)T * 4096;
__host__ __device__ __forceinline__ size_t gq_off(int b, int t, int h) { return ((size_t)(b * 4 + h) * SEQ + t) * 256; }
__host__ __device__ __forceinline__ size_t gv_off(int b, int t, int h) { return GV0 + ((size_t)(b * 4 + h) * SEQ + t) * 512; }
__host__ __device__ __forceinline__ size_t dq_off(int b, int t, int h, int sub) { return ((size_t)((b * 8 + h) * 2 + sub) * SEQ + t) * 128; }
__host__ __device__ __forceinline__ size_t dv_off(int b, int t, int h) { return DV0 + ((size_t)(b * 8 + h) * SEQ + t) * 256; }

constexpr int RING_BYTES = 131072;
constexpr int LDSCTL_OFF = RING_BYTES;
constexpr int MISC_OFF = LDSCTL_OFF + 320;
constexpr int TIDS_OFF = LDSCTL_OFF + 8192;
constexpr int TAB_OFF = LDSCTL_OFF + 1024;
constexpr int LDS_BYTES = 147456;
constexpr int NWAVES = 8;

typedef __bf16 bf16x2_t __attribute__((ext_vector_type(2)));
__device__ __forceinline__ unsigned cvt_pk_bf16(float lo, float hi) { const f32x2 v = {lo, hi}; return __builtin_bit_cast(unsigned, __builtin_convertvector(v, bf16x2_t)); }
__device__ __forceinline__ unsigned cvt4_fp8(float a, float b, float c, float d) { int v = __builtin_amdgcn_cvt_pk_fp8_f32(a, b, 0, false); return (unsigned)__builtin_amdgcn_cvt_pk_fp8_f32(c, d, v, true); }
constexpr float W8_SCALE = 64.f;
__device__ __forceinline__ float bf_lo(unsigned w) { return __uint_as_float(w << 16); }
__device__ __forceinline__ float bf_hi(unsigned w) { return __uint_as_float(w & 0xffff0000u); }
__device__ __forceinline__ float bf2f(bf16_t b) { return __uint_as_float(((unsigned)b) << 16); }
__device__ __forceinline__ float wave_sum(float v) {
#pragma unroll
    for (int o = 1; o < 64; o <<= 1) v += __shfl_xor(v, o);
    return v;
}
__device__ __forceinline__ int lane_id() { return (int)__builtin_amdgcn_mbcnt_hi(~0u, __builtin_amdgcn_mbcnt_lo(~0u, 0u)); }
__device__ __forceinline__ int lane_id_volatile() { int l; asm volatile("v_mbcnt_lo_u32_b32 %0, -1, 0\n\tv_mbcnt_hi_u32_b32 %0, -1, %0" : "=v"(l)); return l; }
__device__ __forceinline__ int opq(int v) { asm volatile("" : "+v"(v)); return v; }
#define LDS_WAIT() asm volatile("s_waitcnt lgkmcnt(0)" ::: "memory")
#define VM_WAIT() asm volatile("s_waitcnt vmcnt(0)" ::: "memory")
#define WG_BAR() do { asm volatile("s_waitcnt lgkmcnt(0)" ::: "memory"); __builtin_amdgcn_s_barrier(); asm volatile("" ::: "memory"); } while (0)

namespace pg8 {
constexpr int BM = 256, BK = 64, HALF = 128, HTB = HALF * BK * 2, STAGE_BYTES = 8 * HTB, NXCD = 8, WGM = 8;
__host__ __device__ __forceinline__ int lds_byte(int r, int c) { const int st = (r >> 4) * 2 + (c >> 5), rr = r & 15, cc = c & 31, ob = rr * 64 + cc * 2; return st * 1024 + (ob ^ (((ob >> 9) & 1) << 5)); }
__host__ __device__ __forceinline__ void stage_rc(int b, int& R, int& C) { const int st = b / 1024, sb = b % 1024, swz = sb ^ (((sb >> 9) & 1) << 5); R = (st >> 1) * 16 + swz / 64; C = (st & 1) * 32 + (swz % 64) / 2; }
__host__ __device__ __forceinline__ int perm32(int rho) { const int n = rho >> 4, i = rho & 15; return 8 * (i >> 2) + 4 * n + (i & 3); }

struct Unit { int pm, pn; };
struct Gemm { const bf16_t* A; const bf16_t* Bt; int M, N, K; };

struct StaticOrder {
    int nM, nN, nwg, G, c;
    __device__ void init(int M, int N, int G_, int c_) { nM = M / BM; nN = N / BM; nwg = nM * nN; G = G_; c = c_; }
    __device__ bool next(int i, Unit& u) const {
        const long L = (long)i * G + c; if (L >= nwg) return false;
        int wgid = (int)L; { const int q = nwg / NXCD, r = nwg % NXCD, xcd = wgid % NXCD, off = wgid / NXCD; wgid = (xcd < r ? xcd * (q + 1) : r * (q + 1) + (xcd - r) * q) + off; }
        const int nig = WGM * nN, gid = wgid / nig, fm = gid * WGM, gsz = (nM - fm) < WGM ? (nM - fm) : WGM;
        u.pm = fm + ((wgid % nig) % gsz); u.pn = (wgid % nig) / gsz; return true;
    }
    __device__ __forceinline__ size_t bofs(const Unit&) const { return 0; }
};
struct MoeOrder : StaticOrder {
    const LAS int* te; size_t estride; const int* stok;
    __device__ __forceinline__ size_t bofs(const Unit& u) const { return (size_t)te[u.pm] * estride; }
    __device__ __forceinline__ int arow(int pm, int r) const { const int t = stok[pm * BM + r]; return t < 0 ? 0 : t; }
};

struct EpiBf16 {
    static constexpr bool PERM = true;
    bf16_t* O; int ldc;
    __device__ __forceinline__ void operator()(const f32x4 (&acc)[2][2][4][2], const Unit& u, int wr, int wc, int fr, int fq) const {
        const int row0 = u.pm * BM + wr * 64 + fr, col0 = u.pn * BM + wc * 32 + 8 * fq;
#pragma unroll
        for (int ai = 0; ai < 2; ++ai)
#pragma unroll
            for (int m = 0; m < 4; ++m) { bf16_t* rowp = O + (size_t)(row0 + ai * HALF + m * 16) * ldc + col0;
#pragma unroll
                for (int bj = 0; bj < 2; ++bj) { const f32x4 v0 = acc[ai][bj][m][0], v1 = acc[ai][bj][m][1];
                    u32x4 w; w.x = cvt_pk_bf16(v0[0], v0[1]); w.y = cvt_pk_bf16(v0[2], v0[3]); w.z = cvt_pk_bf16(v1[0], v1[1]); w.w = cvt_pk_bf16(v1[2], v1[3]);
                    *(u32x4*)(rowp + bj * HALF) = w; } }
    }
};
template <int LAYER> struct EpiHeads {
    static constexpr bool PERM = true;
    bf16_t* O;
    __device__ __forceinline__ void operator()(const f32x4 (&acc)[2][2][4][2], const Unit& u, int wr, int wc, int fr, int fq) const {
        const int pn = u.pn, lc = wc * 32 + 8 * fq;
#pragma unroll
        for (int ai = 0; ai < 2; ++ai)
#pragma unroll
            for (int m = 0; m < 4; ++m) { const int row = u.pm * BM + ai * HALF + wr * 64 + m * 16 + fr, b = row >> 14, t = row & (SEQ - 1);
#pragma unroll
                for (int bj = 0; bj < 2; ++bj) { size_t off;
                    if (LAYER == 0) { if (pn < 4) off = gq_off(b, t, pn) + bj * 128 + lc; else if (pn < 8) off = GK0 + gq_off(b, t, pn - 4) + bj * 128 + lc;
                                      else if (pn < 16) off = gv_off(b, t, (pn - 8) >> 1) + ((pn - 8) & 1) * 256 + bj * 128 + lc; else off = GR0 + (size_t)row * 2048 + (pn - 16) * 256 + bj * 128 + lc; }
                    else { if (pn < 8) off = dq_off(b, t, pn, bj) + lc; else if (pn < 16) off = DK0 + dq_off(b, t, pn - 8, bj) + lc; else off = dv_off(b, t, pn - 16) + bj * 128 + lc; }
                    const f32x4 v0 = acc[ai][bj][m][0], v1 = acc[ai][bj][m][1];
                    u32x4 w; w.x = cvt_pk_bf16(v0[0], v0[1]); w.y = cvt_pk_bf16(v0[2], v0[3]); w.z = cvt_pk_bf16(v1[0], v1[1]); w.w = cvt_pk_bf16(v1[2], v1[3]);
                    *(u32x4*)(O + off) = w; } }
    }
};
struct FixOrder : StaticOrder {
    __device__ __forceinline__ size_t bofs(const Unit& u) const { return (size_t)(u.pm >> 5) * (512 * 256 * 2); }
};
struct EpiAddO {
    static constexpr bool PERM = true;
    bf16_t* O;
    __device__ __forceinline__ void operator()(const f32x4 (&acc)[2][2][4][2], const Unit& u, int wr, int wc, int fr, int fq) const {
#pragma unroll
        for (int ai = 0; ai < 2; ++ai)
#pragma unroll
            for (int m = 0; m < 4; ++m) { const int row = u.pm * BM + ai * HALF + wr * 64 + m * 16 + fr, bhh = row >> 13, t = row & 8191;
                bf16_t* rowp = O + ((size_t)(bhh >> 2) * SEQ + SEQ / 2 + t) * D + (bhh & 3) * 512 + u.pn * BM + wc * 32 + 8 * fq;
#pragma unroll
                for (int bj = 0; bj < 2; ++bj) { const u32x4 old = *(const u32x4*)(rowp + bj * HALF); const f32x4 v0 = acc[ai][bj][m][0] * 0.0625f, v1 = acc[ai][bj][m][1] * 0.0625f;
                    u32x4 w; w.x = cvt_pk_bf16(bf_lo(old.x) + v0[0], bf_hi(old.x) + v0[1]); w.y = cvt_pk_bf16(bf_lo(old.y) + v0[2], bf_hi(old.y) + v0[3]);
                    w.z = cvt_pk_bf16(bf_lo(old.z) + v1[0], bf_hi(old.z) + v1[1]); w.w = cvt_pk_bf16(bf_lo(old.w) + v1[2], bf_hi(old.w) + v1[3]);
                    *(u32x4*)(rowp + bj * HALF) = w; } }
    }
};
struct EpiResF32 {
    static constexpr bool PERM = false;
    const float* base; float* C; int ldc;
    __device__ __forceinline__ void operator()(const f32x4 (&acc)[2][2][4][2], const Unit& u, int wr, int wc, int fr, int fq) const {
        const int row0 = u.pm * BM + wr * 64 + fr, col0 = u.pn * BM + wc * 32 + 4 * fq;
#pragma unroll
        for (int ai = 0; ai < 2; ++ai)
#pragma unroll
            for (int m = 0; m < 4; ++m) { const size_t off = (size_t)(row0 + ai * HALF + m * 16) * ldc + col0;
#pragma unroll
                for (int bj = 0; bj < 2; ++bj)
#pragma unroll
                    for (int n = 0; n < 2; ++n) { const f32x4 bs = *(const f32x4*)(base + off + bj * HALF + n * 16); *(f32x4*)(C + off + bj * HALF + n * 16) = bs + acc[ai][bj][m][n]; }
                asm volatile("" ::: "memory"); }
    }
};
struct EpiSiluMul {
    static constexpr bool PERM = true;
    unsigned char* Hh;
    __device__ __forceinline__ void operator()(const f32x4 (&acc)[2][2][4][2], const Unit& u, int wr, int wc, int fr, int fq) const {
        const int row0 = u.pm * BM + wr * 64 + fr, col0 = u.pn * HALF + wc * 32 + 8 * fq;
#pragma unroll
        for (int ai = 0; ai < 2; ++ai)
#pragma unroll
            for (int m = 0; m < 4; ++m) { unsigned char* rowp = Hh + (size_t)(row0 + ai * HALF + m * 16) * DFF + col0;
                float hv[8];
#pragma unroll
                for (int n = 0; n < 2; ++n)
#pragma unroll
                    for (int j = 0; j < 4; ++j) { const float g = acc[ai][0][m][n][j], up = acc[ai][1][m][n][j];
                        const float sg = g * __builtin_amdgcn_rcpf(1.0f + __builtin_amdgcn_exp2f(-1.4426950408889634f * g)); hv[n * 4 + j] = sg * up; }
                u32x2 w; w.x = cvt4_fp8(hv[0], hv[1], hv[2], hv[3]); w.y = cvt4_fp8(hv[4], hv[5], hv[6], hv[7]);
                *(u32x2*)rowp = w; }
    }
};

typedef int v8i32 __attribute__((ext_vector_type(8)));
typedef int v4i32 __attribute__((ext_vector_type(4)));
template <class Epi, class Sched, bool GATHER = false, bool FP8 = false>
__device__ __forceinline__ void gemm_phase(LAS unsigned char* lds, const Gemm g, const Sched& S, const Epi& E, int tid_in) {
    const int tid = opq(tid_in), wid = __builtin_amdgcn_readfirstlane(tid >> 6), lane = tid & 63, wr = wid >> 2, wc = wid & 3, fr = lane & 15, fq = lane >> 4;
    const int K = g.K, RP = FP8 ? K : 2 * K  , nt = RP / (BK * 2);
    unsigned voffA[2], voffB[2];
#pragma unroll
    for (int i = 0; i < 2; ++i) { int R, C; stage_rc(tid * 16 + i * 8192, R, C); const int Rb = Epi::PERM ? ((R & ~31) + perm32(R & 31)) : R;
        voffA[i] = (unsigned)(R * RP + 2 * C); voffB[i] = (unsigned)(Rb * RP + 2 * C); }
    const unsigned kstep = (unsigned)(BK * 2);
    const unsigned hstep = (unsigned)HALF * (unsigned)RP;
    const size_t tstep = 2 * (size_t)hstep;
    const unsigned ldsw = (unsigned)wid * 1024u;
    const int aoff = lds_byte(wr * 64 + fr, fq * 8), boff = lds_byte(wc * 32 + fr, fq * 8);
    const LAS unsigned char* ldsB = lds + 4 * HTB + boff;
#define PG8_SA(b, h) (((b) * 2 + (h)) * HTB)
#define PG8_SB(b, h) ((4 + (b) * 2 + (h)) * HTB)
#define PG8_STAGE(bufoff, gbase, voff) do { const unsigned long long gv_ = (unsigned long long)(gbase); \
        const unsigned glo_ = (unsigned)__builtin_amdgcn_readfirstlane((unsigned)gv_), ghi_ = (unsigned)__builtin_amdgcn_readfirstlane((unsigned)(gv_ >> 32)); const char* gb_ = (const char*)(((unsigned long long)ghi_ << 32) | (unsigned long long)glo_);     \
        _Pragma("unroll") for (int _i = 0; _i < 2; ++_i) \
        __builtin_amdgcn_global_load_lds((const unsigned*)(gb_ + (voff)[_i]), (LAS unsigned*)(lds + (bufoff) + ldsw + _i * 8192), 16, 0, 0); } while (0)
#define PG8_STAGE_A(bufoff, nx, koff, h) do { if constexpr (GATHER) { unsigned vs_[2]; _Pragma("unroll") for (int _i = 0; _i < 2; ++_i) vs_[_i] = (nx) ? vAn[h][_i] : vAc[h][_i]; \
            PG8_STAGE(bufoff, (const char*)g.A + (koff), vs_); } \
        else { PG8_STAGE(bufoff, ((nx) ? nA : cA) + (koff) + (h) * hstep, voffA); } } while (0)
#define PG8_LD8(off) __builtin_shufflevector(*(const LAS v4i32*)(lds + (off)), *(const LAS v4i32*)(lds + (off) + 1024), 0, 1, 2, 3, 4, 5, 6, 7)
#define PG8_LDA(dst, b, h) do { if constexpr (FP8) { _Pragma("unroll") for (int m = 0; m < 4; ++m) dst##8[m] = PG8_LD8(PG8_SA(b, h) + aoff + m * 2048); } \
        else { _Pragma("unroll") for (int m = 0; m < 4; ++m) _Pragma("unroll") for (int k = 0; k < 2; ++k) dst[m][k] = *(const LAS bf16x8*)(lds + PG8_SA(b, h) + aoff + m * 2048 + k * 1024); } } while (0)
#define PG8_LD8B(off) __builtin_shufflevector(*(const LAS v4i32*)(ldsB + (off)), *(const LAS v4i32*)(ldsB + (off) + 1024), 0, 1, 2, 3, 4, 5, 6, 7)
#define PG8_LDB(dst, b, h) do { if constexpr (FP8) { _Pragma("unroll") for (int n = 0; n < 2; ++n) dst##8[n] = PG8_LD8B(PG8_SA(b, h) + n * 2048); }     \
        else { _Pragma("unroll") for (int n = 0; n < 2; ++n) _Pragma("unroll") for (int k = 0; k < 2; ++k) dst[n][k] = *(const LAS bf16x8*)(lds + PG8_SB(b, h) + boff + n * 2048 + k * 1024); } } while (0)
#define PG8_MMA(ai, bj, At, Bt) do { __builtin_amdgcn_s_setprio(1); if constexpr (FP8) { _Pragma("unroll") for (int m = 0; m < 4; ++m) _Pragma("unroll") for (int n = 0; n < 2; ++n) \
              \
            asm volatile("v_mfma_scale_f32_16x16x128_f8f6f4 %0, %1, %2, %0, %3, %3 op_sel:[0,1,0] op_sel_hi:[0,0,0]" : "+v"(acc[ai][bj][m][n]) : "v"(Bt##8[n]), "v"(At##8[m]), "v"(scl8)); } \
        else { _Pragma("unroll") for (int m = 0; m < 4; ++m) _Pragma("unroll") for (int n = 0; n < 2; ++n) _Pragma("unroll") for (int k = 0; k < 2; ++k) \
            acc[ai][bj][m][n] = __builtin_amdgcn_mfma_f32_16x16x32_bf16(Bt[n][k], At[m][k], acc[ai][bj][m][n], 0, 0, 0); } __builtin_amdgcn_s_setprio(0); } while (0)
#define PG8_WAIT_V(n) asm volatile("s_waitcnt vmcnt(" #n ")" ::: "memory")
#define PG8_WAIT_L(n) asm volatile("s_waitcnt lgkmcnt(" #n ")" ::: "memory")
#define PG8_BAR __builtin_amdgcn_s_barrier()
#define PG8_SCHED __builtin_amdgcn_sched_barrier(0)
#define PG8_ROWOFFS(V, U) do { if constexpr (GATHER) { const int t_ = opq(wid * 64 + lane_id());     \
        _Pragma("unroll") for (int i_ = 0; i_ < 2; ++i_) { int R_, C_; stage_rc(t_ * 16 + i_ * 8192, R_, C_); \
        _Pragma("unroll") for (int h_ = 0; h_ < 2; ++h_) V[h_][i_] = (unsigned)S.arow((U).pm, h_ * HALF + R_) * (unsigned)RP + 2u * (unsigned)C_; } } } while (0)
    Unit cur, nxt; int ui = 0;
    if (!S.next(0, cur)) return;
    f32x4 acc[2][2][4][2];
#pragma unroll
    for (int a = 0; a < 2; ++a)
#pragma unroll
        for (int b = 0; b < 2; ++b)
#pragma unroll
            for (int m = 0; m < 4; ++m)
#pragma unroll
                for (int n = 0; n < 2; ++n) acc[a][b][m][n] = (f32x4){0.f, 0.f, 0.f, 0.f};
    const unsigned scl8 = 0x7f797f79u;
    bf16x8 At[4][2], B0[2][2], B1[2][2]; v8i32 At8[4], B08[2], B18[2];
    unsigned vAc[2][2] = {{0u, 0u}, {0u, 0u}}, vAn[2][2] = {{0u, 0u}, {0u, 0u}};
    const char* cA = (const char*)g.A + (GATHER ? (size_t)0 : (size_t)cur.pm * tstep); const char* nA = cA; const char* cB = (const char*)g.Bt + S.bofs(cur) + (size_t)cur.pn * tstep;
    PG8_ROWOFFS(vAc, cur);
    PG8_STAGE(PG8_SB(0, 0), cB, voffB); PG8_STAGE(PG8_SB(0, 1), cB + hstep, voffB); PG8_STAGE_A(PG8_SA(0, 0), false, 0u, 0); PG8_STAGE_A(PG8_SA(0, 1), false, 0u, 1);
    if (wr == 1) PG8_BAR;
    PG8_WAIT_V(2); PG8_BAR;
    PG8_STAGE(PG8_SB(1, 0), cB + kstep, voffB); PG8_STAGE_A(PG8_SA(1, 0), false, kstep, 0); PG8_STAGE(PG8_SB(1, 1), cB + hstep + kstep, voffB);
    PG8_WAIT_V(6); PG8_BAR;
    for (;;) {
        const bool has_next = S.next(ui + 1, nxt);
        nA = (has_next && !GATHER) ? (const char*)g.A + (size_t)nxt.pm * tstep : cA; const char* nB = has_next ? (const char*)g.Bt + S.bofs(nxt) + (size_t)nxt.pn * tstep : cB;

        for (int t = 0; t < nt; t += 2) {
            const bool last = (t == nt - 2);
            if constexpr (GATHER) { if (last) {
                if (has_next) PG8_ROWOFFS(vAn, nxt); else { _Pragma("unroll") for (int h_ = 0; h_ < 2; ++h_) _Pragma("unroll") for (int i_ = 0; i_ < 2; ++i_) vAn[h_][i_] = vAc[h_][i_]; } } }
            const unsigned k1 = (unsigned)(t + 1) * kstep, k2 = last ? 0u : (unsigned)(t + 2) * kstep, k3 = k2 + kstep;
            const char* b2 = last ? nB : cB + k2; const char* b3 = b2 + kstep;
            PG8_LDB(B0, 0, 0); PG8_LDB(B1, 0, 1); PG8_SCHED; PG8_LDA(At, 0, 0); PG8_STAGE_A(PG8_SA(1, 1), false, k1, 1);
            PG8_WAIT_V(8); PG8_WAIT_L(0); PG8_BAR; PG8_MMA(0, 0, At, B0); PG8_MMA(0, 1, At, B1); PG8_BAR; PG8_SCHED;
            PG8_LDA(At, 0, 1); PG8_STAGE(PG8_SB(0, 0), b2, voffB); PG8_STAGE(PG8_SB(0, 1), b2 + hstep, voffB); PG8_STAGE_A(PG8_SA(0, 0), last, k2, 0);
            PG8_WAIT_V(8); PG8_WAIT_L(0); PG8_BAR; PG8_MMA(1, 0, At, B0); PG8_MMA(1, 1, At, B1); PG8_BAR; PG8_SCHED;
            PG8_LDB(B0, 1, 0); PG8_LDB(B1, 1, 1); PG8_SCHED; PG8_LDA(At, 1, 0); PG8_STAGE_A(PG8_SA(0, 1), last, k2, 1);
            PG8_WAIT_V(8); PG8_WAIT_L(0); PG8_BAR; PG8_MMA(0, 0, At, B0); PG8_MMA(0, 1, At, B1); PG8_BAR; PG8_SCHED;
            PG8_LDA(At, 1, 1); PG8_STAGE(PG8_SB(1, 0), b3, voffB); PG8_STAGE(PG8_SB(1, 1), b3 + hstep, voffB); PG8_STAGE_A(PG8_SA(1, 0), last, k3, 0);
            PG8_WAIT_V(8); PG8_WAIT_L(0); PG8_BAR; PG8_MMA(1, 0, At, B0); PG8_MMA(1, 1, At, B1); PG8_BAR; PG8_SCHED;
        }
        if (wr == 0) PG8_BAR;
        E(acc, cur, wr, wc, fr, fq);
        if (!has_next) break;
#pragma unroll
        for (int a = 0; a < 2; ++a)
#pragma unroll
            for (int b = 0; b < 2; ++b)
#pragma unroll
                for (int m = 0; m < 4; ++m)
#pragma unroll
                    for (int n = 0; n < 2; ++n) acc[a][b][m][n] = (f32x4){0.f, 0.f, 0.f, 0.f};
        cur = nxt; cA = nA; cB = nB; ++ui;
        if constexpr (GATHER) { _Pragma("unroll") for (int h_ = 0; h_ < 2; ++h_) _Pragma("unroll") for (int i_ = 0; i_ < 2; ++i_) vAc[h_][i_] = vAn[h_][i_]; }
        if (wr == 1) PG8_BAR;
    }
    PG8_WAIT_V(0);
    PG8_BAR;
#undef PG8_SA
#undef PG8_SB
#undef PG8_STAGE
#undef PG8_STAGE_A
#undef PG8_ROWOFFS
#undef PG8_LDA
#undef PG8_LDB
#undef PG8_MMA
#undef PG8_LD8
#undef PG8_LD8B
#undef PG8_WAIT_V
#undef PG8_WAIT_L
#undef PG8_BAR
#undef PG8_SCHED
}
}

#define XB_TMO      128
#define XB_XCNT(j)  (256  + 64 * (j))
#define XB_XSUB(j)  (1280 + 64 * (j))
#define XB_XGEN(j)  (2304 + 64 * (j))
#define XB_TOP      3328
#define XB_TOPGEN   3392
#define XCD_BAR_WORDS 3456
#define XB_SPIN_CAP (1u << 18)
__device__ __forceinline__ unsigned xb_ld(unsigned* p)              { return __hip_atomic_load(p, __ATOMIC_RELAXED, __HIP_MEMORY_SCOPE_AGENT); }
__device__ __forceinline__ unsigned xb_add(unsigned* p, unsigned v) { return __hip_atomic_fetch_add(p, v, __ATOMIC_RELAXED, __HIP_MEMORY_SCOPE_AGENT); }
__device__ __forceinline__ unsigned xb_xcc_id() { return (unsigned)__builtin_amdgcn_s_getreg((3 << 11) | 20) & 0xFu; }
#define XB_SPIN(cond, bar) do { unsigned _sp = 0; while (cond) { __builtin_amdgcn_s_sleep(1); \
    if ((++_sp & 255u) == 0u) { if (xb_ld(&(bar)[XB_TMO])) break; if (_sp > XB_SPIN_CAP) { atomicAdd(&(bar)[XB_TMO], 1u); break; } } } } while (0)
struct XcdBarrier { unsigned* bar; unsigned x; volatile LAS unsigned* st; int wave; };
__device__ __forceinline__ XcdBarrier xcd_barrier_post(unsigned* bar, volatile LAS unsigned* st) {
    XcdBarrier b; b.bar = bar; b.x = xb_xcc_id(); b.st = st; b.wave = __builtin_amdgcn_readfirstlane((int)threadIdx.x >> 6);
    if (threadIdx.x == 0) (void)xb_add(&bar[XB_XCNT(b.x)], 1u);
    return b;
}
__device__ __forceinline__ void xcd_barrier_complete(unsigned* bar, unsigned x, unsigned& nloc, unsigned& nx) {
    const unsigned G = gridDim.x * gridDim.y * gridDim.z;
    unsigned sum, cnt, mine, sp = 0u;
    for (;;) {
        sum = 0u; cnt = 0u; mine = 0u;
#pragma unroll
        for (unsigned j = 0; j < 16; ++j) { const unsigned c = xb_ld(&bar[XB_XCNT(j)]); sum += c; cnt += (c > 0u) ? 1u : 0u; mine = (j == x) ? c : mine; }
        if (sum == G) break;
        __builtin_amdgcn_s_sleep(1);
        if ((++sp & 255u) == 0u) { if (xb_ld(&bar[XB_TMO])) break; if (sp > XB_SPIN_CAP) { atomicAdd(&bar[XB_TMO], 1u); break; } }
    }
    nloc = mine > 0u ? mine : 1u; nx = cnt > 0u ? cnt : 1u;
}
__device__ __forceinline__ void xcd_barrier(const XcdBarrier& b, bool leader  ) {
    asm volatile("s_waitcnt vmcnt(0)" ::: "memory");
    __syncthreads();
    if (leader) {
        unsigned* bar = b.bar;
        __builtin_amdgcn_s_waitcnt(0);
        unsigned nloc = b.st[0], nx = b.st[1];
        if (nloc == 0u) { xcd_barrier_complete(bar, b.x, nloc, nx); b.st[0] = nloc; b.st[1] = nx; }
        const unsigned old = xb_add(&bar[XB_XSUB(b.x)], 1u);
        const unsigned gen = old / nloc;
        if (old + 1u == (gen + 1u) * nloc) {
            __builtin_amdgcn_fence(__ATOMIC_RELEASE, "agent");
            asm volatile("s_waitcnt vmcnt(0)" ::: "memory");
            const unsigned og = xb_add(&bar[XB_TOP], 1u);
            const unsigned tg = og / nx;
            if (og + 1u == (tg + 1u) * nx) xb_add(&bar[XB_TOPGEN], 1u);
            else XB_SPIN(xb_ld(&bar[XB_TOPGEN]) == tg, bar);
            __builtin_amdgcn_fence(__ATOMIC_ACQUIRE, "agent");
            xb_add(&bar[XB_XGEN(b.x)], 1u);
            asm volatile("s_waitcnt vmcnt(0)" ::: "memory");
        } else {
            XB_SPIN(xb_ld(&bar[XB_XGEN(b.x)]) == gen, bar);
            __builtin_amdgcn_fence(__ATOMIC_ACQUIRE, "agent");
            asm volatile("s_waitcnt vmcnt(0)" ::: "memory");
        }
    }
    __syncthreads();
}

struct Frame {
    LAS unsigned char* lds;
    int tid, lane, wave, vcu, G;
};
struct Args {
    const float* in[21]; float* out; unsigned char* ws; int upto, pad1;
};

template <bool FP8 = false>
__device__ __forceinline__ void transpose_item(const float* W, int ldw, int k0, int n0, bf16_t* WT, int ldk, int drow0, LAS float* scr, int lane) {
    float tv[32];
    const float* wp_ = W + (size_t)(k0 + (lane >> 5)) * ldw + n0 + (lane & 31);
#pragma unroll
    for (int i = 0; i < 32; ++i) tv[i] = wp_[(size_t)(2 * i) * ldw];
#pragma unroll
    for (int i = 0; i < 32; ++i) scr[(2 * i + (lane >> 5)) * 33 + (lane & 31)] = tv[i];
    LDS_WAIT(); asm volatile("" ::: "memory");
    const int c = lane & 7;
#pragma unroll
    for (int j = 0; j < 4; ++j) { const int n = (lane >> 3) + 8 * j; const LAS float* s = scr + (8 * c) * 33 + n;
        if constexpr (FP8) { u32x2 o; o.x = cvt4_fp8(s[0 * 33] * W8_SCALE, s[1 * 33] * W8_SCALE, s[2 * 33] * W8_SCALE, s[3 * 33] * W8_SCALE); o.y = cvt4_fp8(s[4 * 33] * W8_SCALE, s[5 * 33] * W8_SCALE, s[6 * 33] * W8_SCALE, s[7 * 33] * W8_SCALE);
            *(u32x2*)((unsigned char*)WT + (size_t)(drow0 + n) * ldk + k0 + 8 * c) = o; }
        else { u32x4 o; o.x = cvt_pk_bf16(s[0 * 33], s[1 * 33]); o.y = cvt_pk_bf16(s[2 * 33], s[3 * 33]); o.z = cvt_pk_bf16(s[4 * 33], s[5 * 33]); o.w = cvt_pk_bf16(s[6 * 33], s[7 * 33]);
            *(u32x4*)(WT + (size_t)(drow0 + n) * ldk + k0 + 8 * c) = o; } }
    LDS_WAIT(); asm volatile("" ::: "memory");
}
__device__ __forceinline__ void conv_plain(Frame& F, const float* W, int K, int N, int ldw, bf16_t* WT) {
    LAS float* scr = (LAS float*)(F.lds + F.wave * 16384);
    const int gw = F.vcu * NWAVES + F.wave, NGW = F.G * NWAVES, nblk = N / 32, nit = (K / 64) * nblk;
    for (int it = gw; it < nit; it += NGW) { const int kb = it / nblk, nb = it % nblk; transpose_item(W, ldw, 64 * kb, 32 * nb, WT, K, 32 * nb, scr, F.lane); }
}
__device__ __forceinline__ void conv_moe(Frame& F, const float* wg, const float* wu, const float* wd, bf16_t* GU, bf16_t* DT, int rank = -1, int nrank = 0) {
    LAS float* scr = (LAS float*)(F.lds + F.wave * 16384);
    const int gw = (rank < 0 ? F.vcu : rank) * NWAVES + F.wave, NGW = (rank < 0 ? F.G : nrank) * NWAVES;
    constexpr int PER_E = 1536, NIT = NEXP * PER_E;
    for (int it = gw; it < NIT; it += NGW) {
        const int e = it / PER_E; int r = it % PER_E;
        if (r < 1024) { const int up = r >> 9; r &= 511; const int kb = r >> 4, nb = r & 15, n0 = 32 * nb;
            const int drow = 256 * (n0 >> 7) + 128 * up + (n0 & 127);
            transpose_item<true>((up ? wu : wg) + (size_t)e * D * DFF, DFF, 64 * kb, n0, (bf16_t*)((unsigned char*)GU + (size_t)e * 1024 * D), D, drow, scr, F.lane); }
        else { r -= 1024; const int kb = r >> 6, nb = r & 63;
            transpose_item<true>(wd + (size_t)e * DFF * D, D, 64 * kb, 32 * nb, (bf16_t*)((unsigned char*)DT + (size_t)e * D * DFF), DFF, 32 * nb, scr, F.lane); }
    }
}
__device__ __forceinline__ void pack_proj(Frame& F, float* Wp, int NT, const float* gain, const float* Wa, int lda, int ca0, int na, const float* Wb, int ldb, int nb) {
    const int total = 128 * NT * 256;
    for (int idx = (F.vcu * NWAVES * 64) + F.tid; idx < total; idx += F.G * NWAVES * 64) {
        const int e = idx & 3, ln = (idx >> 2) & 63, rest = idx >> 8, nt = rest % NT, s = rest / NT;
        const int k = 16 * s + 4 * (ln >> 4) + e, col = 16 * nt + (ln & 15);
        float v = 0.f;
        if (col < na) v = Wa[(size_t)k * lda + ca0 + col]; else if (col < na + nb) v = Wb[(size_t)k * ldb + (col - na)];
        Wp[idx] = v * gain[k];
    }
}

template <int NT>
__device__ __forceinline__ float wave_proj16(LAS unsigned char* lds, const float* xin, int tok0, const float* Wp, int tid, int wid, int lane, f32x4 (&acc)[NT]) {
    const int tr = lane & 15, kq = lane >> 4;
    const f32x4* xp = (const f32x4*)(xin + (size_t)(tok0 + tr) * D) + kq;
    constexpr int CH = 16 * NT * 1024;
    const char* wsrc = (const char*)Wp + tid * 16;
    float ssq = 0.f;
#pragma unroll
    for (int n = 0; n < NT; ++n) acc[n] = (f32x4){0.f, 0.f, 0.f, 0.f};
    f32x4 X[16];
#define NP_DMA(c, buf) do { _Pragma("unroll") for (int r = 0; r < 2 * NT; ++r) \
        __builtin_amdgcn_global_load_lds((const unsigned*)(wsrc + (size_t)(c) * CH + r * 8192), (LAS unsigned*)(lds + (buf) * CH + r * 8192 + wid * 1024), 16, 0, 0); } while (0)
#define NP_CHUNK(c, buf, more) do { \
        asm volatile("s_waitcnt vmcnt(16)" ::: "memory"); WG_BAR(); \
        if (more) NP_DMA((c) + 1, 1 - (buf)); \
        asm volatile("" ::: "memory");     \
        const f32x4* xn_ = xp + 64 * ((c) + 1); \
        _Pragma("unroll") for (int s = 0; s < 16; ++s) { const f32x4 xv = X[s]; if (more) X[s] = xn_[4 * s]; \
            ssq += (xv[0] * xv[0] + xv[1] * xv[1]) + (xv[2] * xv[2] + xv[3] * xv[3]); \
            _Pragma("unroll") for (int n = 0; n < NT; ++n) { const f32x4 wv = *(const LAS f32x4*)(lds + (buf) * CH + ((s * NT + n) * 64 + lane) * 16); \
                _Pragma("unroll") for (int e = 0; e < 4; ++e) acc[n] = __builtin_amdgcn_mfma_f32_16x16x4f32(xv[e], wv[e], acc[n], 0, 0, 0); } } } while (0)
    NP_DMA(0, 0);
    asm volatile("" ::: "memory");
#pragma unroll
    for (int s = 0; s < 16; ++s) X[s] = xp[4 * s];
    for (int c = 0; c < 6; c += 2) { NP_CHUNK(c, 0, true); NP_CHUNK(c + 1, 1, true); }
    NP_CHUNK(6, 0, true); NP_CHUNK(7, 1, false);
    WG_BAR();
#undef NP_DMA
#undef NP_CHUNK
    ssq += __shfl_xor(ssq, 16); ssq += __shfl_xor(ssq, 32);
    return 1.0f / sqrtf(ssq * (1.0f / D) + RMS_EPS);
}
template <bool FP8 = false>
__device__ __forceinline__ void wave_write_hn16(const float* xin, int tok0, float rstd, const float* gain, bf16_t* hn, int lane) {
    f32x4 g4[8];
#pragma unroll
    for (int j = 0; j < 8; ++j) g4[j] = ((const f32x4*)gain)[lane + 64 * j];
    for (int i = 0; i < 16; i += 2) {
        const float r0 = __shfl(rstd, i), r1 = __shfl(rstd, i + 1);
        const f32x4* x0 = (const f32x4*)(xin + (size_t)(tok0 + i) * D); const f32x4* x1 = x0 + D / 4;
        u32x2* o0 = (u32x2*)(hn + (size_t)(tok0 + i) * D); u32x2* o1 = o0 + D / 4;
        unsigned* p0 = (unsigned*)((unsigned char*)hn + (size_t)(tok0 + i) * D); unsigned* p1 = p0 + D / 4;
        f32x4 a[8], c[8];
#pragma unroll
        for (int j = 0; j < 8; ++j) { a[j] = x0[lane + 64 * j]; c[j] = x1[lane + 64 * j]; }
#pragma unroll
        for (int j = 0; j < 8; ++j) { const f32x4 v = a[j] * r0 * g4[j], u = c[j] * r1 * g4[j];
            if constexpr (FP8) { p0[lane + 64 * j] = cvt4_fp8(v[0], v[1], v[2], v[3]); p1[lane + 64 * j] = cvt4_fp8(u[0], u[1], u[2], u[3]); }
            else { u32x2 w; w.x = cvt_pk_bf16(v[0], v[1]); w.y = cvt_pk_bf16(v[2], v[3]); o0[lane + 64 * j] = w;
                u32x2 z; z.x = cvt_pk_bf16(u[0], u[1]); z.y = cvt_pk_bf16(u[2], u[3]); o1[lane + 64 * j] = z; } }
    }
}

__device__ __forceinline__ void phase_norm_gz(Frame& F, const float* xin, const float* gain, const float* Wp, bf16_t* hn, float* gz) {
    for (int tile = F.vcu; tile < T / 128; tile += F.G) {
        const int tok0 = tile * 128 + F.wave * 16;
        f32x4 acc[1];
        const float rstd = wave_proj16<1>(F.lds, xin, tok0, Wp, F.tid, F.wave, F.lane, acc);
        const int j = F.lane & 15, q4 = F.lane >> 4;
#pragma unroll
        for (int r = 0; r < 4; ++r) { const float rr = __shfl(rstd, 4 * q4 + r); gz[(size_t)(tok0 + 4 * q4 + r) * 16 + j] = acc[0][r] * rr; }
        wave_write_hn16(xin, tok0, rstd, gain, hn, F.lane);
    }
}
__device__ __forceinline__ void phase_norm_route(Frame& F, const float* xin, const float* gain, const float* Wp, bf16_t* hn, int* tok_e, int* tok_p, float* tok_w, unsigned* cnt) {
    LAS float* lg = (LAS float*)(F.lds + 98304 + F.wave * 3072);
    for (int tile = F.vcu; tile < T / 128; tile += F.G) {
        const int tok0 = tile * 128 + F.wave * 16;
        f32x4 acc[3];
        const float rstd = wave_proj16<3>(F.lds, xin, tok0, Wp, F.tid, F.wave, F.lane, acc);
        const int j = F.lane & 15, q4 = F.lane >> 4;
#pragma unroll
        for (int r = 0; r < 4; ++r) { const float rr = __shfl(rstd, 4 * q4 + r);
#pragma unroll
            for (int n = 0; n < 3; ++n) lg[(4 * q4 + r) * 48 + 16 * n + j] = acc[n][r] * rr; }
        LDS_WAIT(); asm volatile("" ::: "memory");
        if (F.lane < 16) {
            const LAS float* l = lg + F.lane * 48;
            float gm = l[0]; int gi = 0;
#pragma unroll
            for (int q = 1; q < 4; ++q) { const float v = l[q]; if (v > gm) { gm = v; gi = q; } }
            float gs = 0.f;
#pragma unroll
            for (int q = 0; q < 4; ++q) gs += __expf(l[q] - gm);
            const float gw = 1.0f / gs;
            const LAS float* se = l + 4 + 8 * gi;
            float m1 = se[0]; int i1 = 0;
#pragma unroll
            for (int q = 1; q < 8; ++q) { const float v = se[q]; if (v > m1) { m1 = v; i1 = q; } }
            float m2 = -3.0e38f; int i2 = 0;
#pragma unroll
            for (int q = 0; q < 8; ++q) { const float v = se[q]; if (q != i1 && v > m2) { m2 = v; i2 = q; } }
            const float eb = __expf(m2 - m1), inv = 1.0f / (1.0f + eb);
            const int t = tok0 + F.lane, e1 = gi * 8 + i1, e2 = gi * 8 + i2;
            const unsigned p1 = __hip_atomic_fetch_add(cnt + 64 * e1, 1u, __ATOMIC_RELAXED, __HIP_MEMORY_SCOPE_AGENT);
            const unsigned p2 = __hip_atomic_fetch_add(cnt + 64 * e2, 1u, __ATOMIC_RELAXED, __HIP_MEMORY_SCOPE_AGENT);
            tok_e[2 * t] = e1; tok_e[2 * t + 1] = e2; tok_p[2 * t] = (int)p1; tok_p[2 * t + 1] = (int)p2;
            tok_w[2 * t] = gw * inv; tok_w[2 * t + 1] = gw * eb * inv;
        }
        wave_write_hn16<true>(xin, tok0, rstd, gain, hn, F.lane);
        LDS_WAIT(); asm volatile("" ::: "memory");
    }
}

__device__ __forceinline__ void phase_gla_gate(Frame& F, const float* gz, const float* wgu, const float* bgate, const bf16_t* proj, bf16_t* kdT, float* adec) {
    LAS f32x4* gzs = (LAS f32x4*)F.lds;
    for (int u = F.vcu; u < NBATCH * NCH * 2; u += F.G) {
        const int half = u & 1, bc = u >> 1;
        const int tok0 = bc * 64, j = half * 512 + F.tid;
        if (F.tid < 256) gzs[F.tid] = ((const f32x4*)(gz + (size_t)tok0 * 16))[F.tid];
        float wg[16];
#pragma unroll
        for (int r = 0; r < 16; ++r) wg[r] = wgu[r * GLA_DKT + j];
        const float bg = bgate[j];
        WG_BAR();
        float cum[64]; float run = 0.f;
#pragma unroll
        for (int t = 0; t < 64; ++t) {
            float z = bg;
#pragma unroll
            for (int r4 = 0; r4 < 4; ++r4) { const f32x4 g4 = gzs[t * 4 + r4]; z += g4[0] * wg[4 * r4] + g4[1] * wg[4 * r4 + 1] + g4[2] * wg[4 * r4 + 2] + g4[3] * wg[4 * r4 + 3]; }
            const float ls = fminf(z, 0.f) - __logf(1.0f + __expf(-fabsf(z)));
            run += ls * (1.0f / 16.0f); cum[t] = run;
        }
        adec[(size_t)bc * GLA_DKT + j] = __expf(run);
        const bf16_t* kp = proj + GK0 + gq_off(bc >> 8, (bc & 255) * 64, j >> 8) + (j & 255);
        u32x4* dst = (u32x4*)(kdT + ((size_t)bc * GLA_DKT + j) * 64);
#pragma unroll
        for (int t8 = 0; t8 < 8; ++t8) {
            float kd[8];
#pragma unroll
            for (int q = 0; q < 8; ++q) { const int t = t8 * 8 + q; kd[q] = bf2f(kp[(size_t)t * 256]) * __expf(run - cum[t]); }
            u32x4 w; w.x = cvt_pk_bf16(kd[0], kd[1]); w.y = cvt_pk_bf16(kd[2], kd[3]); w.z = cvt_pk_bf16(kd[4], kd[5]); w.w = cvt_pk_bf16(kd[6], kd[7]);
            dst[t8] = w;
        }
        WG_BAR();
    }
}

constexpr int SCAN_VROW = 144, SCAN_SROW = 528, SCAN_VBUF = 64 * SCAN_VROW, SCAN_SBUF = 64 * SCAN_SROW;
__device__ __forceinline__ void phase_gla_scan(Frame& F, int it, const bf16_t* proj, const bf16_t* kdT, const float* adec, bf16_t* oout, bf16_t* sfin, unsigned* probe = nullptr) {
    const int lane = F.lane, w = F.wave, fr = lane & 15, kq = lane >> 4, tid = F.tid;
    LAS unsigned char* vbuf = F.lds;
    LAS unsigned char* sbuf = F.lds + 2 * SCAN_VBUF;
    const int bh = it >> 4, seg = (it >> 3) & 1, b = bh >> 2, h = bh & 3, sl = it & 7, mt = w & 3, ntp = w >> 2, c0 = seg * (NCH / 2);
    const size_t tokb = (size_t)b * SEQ;
    f32x4 st[2][4];
#pragma unroll
    for (int i = 0; i < 2; ++i)
#pragma unroll
        for (int n = 0; n < 4; ++n) st[i][n] = (f32x4){0.f, 0.f, 0.f, 0.f};
    bf16x8 ka0[2][2], ka1[2][2], q0[8], q1[8]; f32x4 dc0[2], dc1[2]; u32x4 vr0, vr1;
#define CL(c) ((c) < NCH ? (c) : NCH - 1)
#define LOAD_KA(KA, DC, c) do { const size_t bc_ = (size_t)b * NCH + CL(c); \
        _Pragma("unroll") for (int i = 0; i < 2; ++i) { \
            _Pragma("unroll") for (int s = 0; s < 2; ++s) KA[i][s] = *(const bf16x8*)(kdT + ((bc_ * GLA_DKT + h * 256 + 32 * w + 16 * i + fr) * 64 + 32 * s + 8 * kq)); \
            DC[i] = *(const f32x4*)(adec + bc_ * GLA_DKT + h * 256 + 32 * w + 16 * i + 4 * kq); } } while (0)
#define LOAD_V(VR, c) do { VR = *(const u32x4*)(proj + gv_off(b, CL(c) * 64 + (tid >> 3), h) + 64 * sl + 8 * (tid & 7)); } while (0)
#define LOAD_Q(Q, c) do { const bf16_t* qp_ = proj + gq_off(b, CL(c) * 64 + 16 * mt + fr, h) + 8 * kq; \
        _Pragma("unroll") for (int s = 0; s < 8; ++s) Q[s] = *(const bf16x8*)(qp_ + 32 * s); } while (0)
#define STORE_V(VR, buf) do { *(LAS u32x4*)(vbuf + (buf) * SCAN_VBUF + (tid >> 3) * SCAN_VROW + (tid & 7) * 16) = VR; } while (0)
#if PROBE
    unsigned long long pacc[3] = {0ull, 0ull, 0ull}; unsigned long long pmark;
#define PMARK(k) do { const unsigned long long n_ = __builtin_amdgcn_s_memtime(); pacc[k] += n_ - pmark; pmark = n_; } while (0)
#define PSTART() do { pmark = __builtin_amdgcn_s_memtime(); } while (0)
#else
#define PMARK(k) do { } while (0)
#define PSTART() do { } while (0)
#endif
#define SCAN_STEP(KA, DC, VN, VM, QC, QN, c) do { \
        PSTART(); \
        const unsigned vb_ = (unsigned)(uintptr_t)(vbuf + ((c) & 1) * SCAN_VBUF) + (unsigned)((8 * kq + ((lane & 15) >> 2)) * SCAN_VROW + 8 * (lane & 3)); \
        s16x4 tv[4][4];     \
        asm volatile("ds_read_b64_tr_b16 %0, %16 offset:0\n\tds_read_b64_tr_b16 %1, %16 offset:576\n\tds_read_b64_tr_b16 %2, %16 offset:4608\n\tds_read_b64_tr_b16 %3, %16 offset:5184\n\t" \
                     "ds_read_b64_tr_b16 %4, %16 offset:32\n\tds_read_b64_tr_b16 %5, %16 offset:608\n\tds_read_b64_tr_b16 %6, %16 offset:4640\n\tds_read_b64_tr_b16 %7, %16 offset:5216\n\t" \
                     "ds_read_b64_tr_b16 %8, %16 offset:64\n\tds_read_b64_tr_b16 %9, %16 offset:640\n\tds_read_b64_tr_b16 %10, %16 offset:4672\n\tds_read_b64_tr_b16 %11, %16 offset:5248\n\t" \
                     "ds_read_b64_tr_b16 %12, %16 offset:96\n\tds_read_b64_tr_b16 %13, %16 offset:672\n\tds_read_b64_tr_b16 %14, %16 offset:4704\n\tds_read_b64_tr_b16 %15, %16 offset:5280\n\ts_waitcnt lgkmcnt(0)" \
                     : "=&v"(tv[0][0]), "=&v"(tv[0][1]), "=&v"(tv[0][2]), "=&v"(tv[0][3]), "=&v"(tv[1][0]), "=&v"(tv[1][1]), "=&v"(tv[1][2]), "=&v"(tv[1][3]), \
                       "=&v"(tv[2][0]), "=&v"(tv[2][1]), "=&v"(tv[2][2]), "=&v"(tv[2][3]), "=&v"(tv[3][0]), "=&v"(tv[3][1]), "=&v"(tv[3][2]), "=&v"(tv[3][3]) : "v"(vb_) : "memory"); \
        _Pragma("unroll") for (int n = 0; n < 4; ++n) { \
            const bf16x8 vf0 = (bf16x8){tv[n][0][0], tv[n][0][1], tv[n][0][2], tv[n][0][3], tv[n][1][0], tv[n][1][1], tv[n][1][2], tv[n][1][3]}; \
            const bf16x8 vf1 = (bf16x8){tv[n][2][0], tv[n][2][1], tv[n][2][2], tv[n][2][3], tv[n][3][0], tv[n][3][1], tv[n][3][2], tv[n][3][3]}; \
            _Pragma("unroll") for (int i = 0; i < 2; ++i) { \
                st[i][n] = st[i][n] * DC[i]; \
                st[i][n] = __builtin_amdgcn_mfma_f32_16x16x32_bf16(KA[i][0], vf0, st[i][n], 0, 0, 0); \
                st[i][n] = __builtin_amdgcn_mfma_f32_16x16x32_bf16(KA[i][1], vf1, st[i][n], 0, 0, 0); } } \
        LOAD_KA(KA, DC, (c) + 2); \
        PMARK(0); \
        { LAS unsigned char* sb_ = sbuf + ((c) & 1) * SCAN_SBUF + fr * SCAN_SROW + (32 * w + 4 * kq) * 2; \
          _Pragma("unroll") for (int i = 0; i < 2; ++i) _Pragma("unroll") for (int n = 0; n < 4; ++n) { \
              u32x2 pk; pk.x = cvt_pk_bf16(st[i][n][0], st[i][n][1]); pk.y = cvt_pk_bf16(st[i][n][2], st[i][n][3]); \
              *(LAS u32x2*)(sb_ + n * 16 * SCAN_SROW + i * 32) = pk; } } \
        STORE_V(VN, ((c) + 1) & 1); \
        LOAD_V(VN, (c) + 3); \
        WG_BAR(); \
        PMARK(1); \
        { f32x4 a0 = (f32x4){0.f, 0.f, 0.f, 0.f}, a1 = a0; \
          const LAS unsigned char* sr_ = sbuf + ((c) & 1) * SCAN_SBUF + (32 * ntp + fr) * SCAN_SROW + 16 * kq; \
          _Pragma("unroll") for (int hb = 0; hb < 2; ++hb) { bf16x8 bb[4][2];     \
              _Pragma("unroll") for (int s = 0; s < 4; ++s) { bb[s][0] = *(const LAS bf16x8*)(sr_ + 64 * (4 * hb + s)); bb[s][1] = *(const LAS bf16x8*)(sr_ + 16 * SCAN_SROW + 64 * (4 * hb + s)); } \
              asm volatile("s_waitcnt lgkmcnt(0)" ::: "memory"); __builtin_amdgcn_sched_barrier(0); \
              _Pragma("unroll") for (int s = 0; s < 4; ++s) { \
                  a0 = __builtin_amdgcn_mfma_f32_16x16x32_bf16(QC[4 * hb + s], bb[s][0], a0, 0, 0, 0); \
                  a1 = __builtin_amdgcn_mfma_f32_16x16x32_bf16(QC[4 * hb + s], bb[s][1], a1, 0, 0, 0); } } \
          bf16_t* op_ = oout + (tokb + (size_t)(c) * 64 + 16 * mt + 4 * kq) * D + h * 512 + 64 * sl + 32 * ntp + fr; \
          _Pragma("unroll") for (int r = 0; r < 4; ++r) { \
              const float x0 = a0[r] * 0.0625f, x1 = a1[r] * 0.0625f, y0 = __shfl_xor(x0, 1), y1 = __shfl_xor(x1, 1); \
              if ((fr & 1) == 0) { *(unsigned*)(op_ + (size_t)r * D) = cvt_pk_bf16(x0, y0); *(unsigned*)(op_ + (size_t)r * D + 16) = cvt_pk_bf16(x1, y1); } } } \
        LOAD_Q(QC, (c) + 2); \
        PMARK(2); \
    } while (0)
    LOAD_KA(ka0, dc0, c0); LOAD_KA(ka1, dc1, c0 + 1); LOAD_V(vr0, c0); LOAD_V(vr1, c0 + 1); LOAD_Q(q0, c0); LOAD_Q(q1, c0 + 1);
    STORE_V(vr0, 0); LOAD_V(vr0, c0 + 2);
    WG_BAR();
#if PROBE
    const unsigned long long pt0 = __builtin_amdgcn_s_memtime(), pr0 = __builtin_amdgcn_s_memrealtime();
#endif
    for (int c = c0; c < c0 + NCH / 2; c += 2) {
        SCAN_STEP(ka0, dc0, vr1, vr0, q0, q1, c);
        SCAN_STEP(ka1, dc1, vr0, vr1, q1, q0, c + 1);
    }
    if (seg == 0) {
#pragma unroll
        for (int i = 0; i < 2; ++i)
#pragma unroll
            for (int n = 0; n < 4; ++n) { u32x2 pk; pk.x = cvt_pk_bf16(st[i][n][0], st[i][n][1]); pk.y = cvt_pk_bf16(st[i][n][2], st[i][n][3]);
                *(u32x2*)(sfin + ((size_t)(bh * 512 + 64 * sl + 16 * n + fr)) * 256 + 32 * w + 16 * i + 4 * kq) = pk; }
    }
    WG_BAR();
#if PROBE
    if (probe && it == 0 && tid == 0) { const unsigned long long dt = __builtin_amdgcn_s_memtime() - pt0, dr = __builtin_amdgcn_s_memrealtime() - pr0;
        const float val = floorf(2.f * log2f((PROBE == 1) ? (float)dt / 256.f : (PROBE == 2) ? (float)dr * 10.f / 256.f : (float)pacc[PROBE - 3] / 256.f));
        __hip_atomic_store(probe, __float_as_uint(val), __ATOMIC_RELAXED, __HIP_MEMORY_SCOPE_AGENT); }
#endif
#undef CL
#undef LOAD_KA
#undef LOAD_V
#undef LOAD_Q
#undef STORE_V
#undef SCAN_STEP
}

__device__ __forceinline__ void gla_pcum(Frame& F, const float* adec, float* pcum, int rank, int nrank) {
    for (int idx = rank * (NWAVES * 64) + F.tid; idx < NBATCH * GLA_DKT; idx += nrank * NWAVES * 64) { const int b = idx >> 10, j = idx & 1023;
        const float* ap = adec + ((size_t)(b * NCH + NCH / 2)) * GLA_DKT + j; float* pp = pcum + (size_t)(b * (NCH / 2)) * GLA_DKT + j; float pr = 1.f;
#pragma unroll 16
        for (int cc = 0; cc < NCH / 2; ++cc) { pr *= ap[(size_t)cc * GLA_DKT]; pp[(size_t)cc * GLA_DKT] = pr; } }
}
__device__ __forceinline__ void phase_gla_qp(Frame& F, const bf16_t* proj, const float* pcum, bf16_t* qp) {
    const int gw = F.vcu * NWAVES + F.wave, NGW = F.G * NWAVES, lane = F.lane;
    for (int r = gw; r < NBATCH * (SEQ / 2); r += NGW) { const int b = r >> 13, t = r & 8191;
        u32x2 qv[4]; f32x4 pv[4];
#pragma unroll
        for (int h = 0; h < 4; ++h) { qv[h] = *(const u32x2*)(proj + gq_off(b, SEQ / 2 + t, h) + 4 * lane); pv[h] = *(const f32x4*)(pcum + ((size_t)(b * (NCH / 2) + (t >> 6)) * GLA_DKT + h * 256 + 4 * lane)); }
#pragma unroll
        for (int h = 0; h < 4; ++h) { u32x2 w; w.x = cvt_pk_bf16(bf_lo(qv[h].x) * pv[h][0], bf_hi(qv[h].x) * pv[h][1]); w.y = cvt_pk_bf16(bf_lo(qv[h].y) * pv[h][2], bf_hi(qv[h].y) * pv[h][3]);
            *(u32x2*)(qp + ((size_t)((b * 4 + h) * (SEQ / 2) + t)) * 256 + 4 * lane) = w; }
    }
}
__device__ __forceinline__ void phase_gla_gnorm(Frame& F, const bf16_t* o, const bf16_t* proj, const float* gn, bf16_t* y) {
    const int gw = F.vcu * NWAVES + F.wave, NGW = F.G * NWAVES, lane = F.lane;
    const f32x4 g0 = ((const f32x4*)gn)[2 * lane], g1 = ((const f32x4*)gn)[2 * lane + 1];
    for (int tok = gw; tok < T; tok += NGW) {
        u32x4 ov[4], rv[4];
#pragma unroll
        for (int h = 0; h < 4; ++h) { ov[h] = *(const u32x4*)(o + (size_t)tok * D + h * 512 + 8 * lane); rv[h] = *(const u32x4*)(proj + GR0 + (size_t)tok * 2048 + h * 512 + 8 * lane); }
        float ss[4];
#pragma unroll
        for (int h = 0; h < 4; ++h) { float s = 0.f;
#pragma unroll
            for (int q = 0; q < 4; ++q) { const float lo = bf_lo(ov[h][q]), hi = bf_hi(ov[h][q]); s += lo * lo + hi * hi; }
            ss[h] = s; }
#pragma unroll
        for (int of = 1; of < 64; of <<= 1) {
#pragma unroll
            for (int h = 0; h < 4; ++h) ss[h] += __shfl_xor(ss[h], of); }
#pragma unroll
        for (int h = 0; h < 4; ++h) { const float rstd = 1.0f / sqrtf(ss[h] * (1.0f / 512.0f) + RMS_EPS);
            float yv[8];
#pragma unroll
            for (int q = 0; q < 4; ++q) { const float a0 = bf_lo(ov[h][q]), a1 = bf_hi(ov[h][q]), r0 = bf_lo(rv[h][q]), r1 = bf_hi(rv[h][q]);
                const float gA = q < 2 ? g0[2 * q] : g1[2 * q - 4], gB = q < 2 ? g0[2 * q + 1] : g1[2 * q - 3];
                yv[2 * q] = a0 * rstd * gA * (r0 / (1.0f + __expf(-r0))); yv[2 * q + 1] = a1 * rstd * gB * (r1 / (1.0f + __expf(-r1))); }
            u32x4 w; w.x = cvt_pk_bf16(yv[0], yv[1]); w.y = cvt_pk_bf16(yv[2], yv[3]); w.z = cvt_pk_bf16(yv[4], yv[5]); w.w = cvt_pk_bf16(yv[6], yv[7]);
            *(u32x4*)(y + (size_t)tok * D + h * 512 + 8 * lane) = w; }
    }
}

__device__ __forceinline__ void moe_tables(Frame& F, unsigned* cnt) {
    LAS int* pst = (LAS int*)(F.lds + TAB_OFF);
    LAS int* te = pst + 36;
    if (F.wave == 0) {
        const int e = F.lane & 31;
        const int c = (int)xb_ld(cnt + 64 * e);
        const int ntile = (c + 255) >> 8;
        int incl = ntile;
#pragma unroll
        for (int o = 1; o < 32; o <<= 1) { const int v = __shfl_up(incl, o); if ((F.lane & 31) >= o) incl += v; }
        const int excl = incl - ntile;
        if (F.lane < 32) { pst[e] = excl << 8; for (int q = 0; q < ntile; ++q) te[excl + q] = e; }
        if (F.lane == 31) { pst[32] = incl << 8; pst[33] = incl; }
    }
    WG_BAR();
}
__device__ __forceinline__ void phase_moe_slots(Frame& F, const int* tok_e, const int* tok_p, unsigned* cnt, int* slot_of, int* slot_tok) {
    const LAS int* pst = (const LAS int*)(F.lds + TAB_OFF);
    for (int e = F.vcu; e < NEXP; e += F.G) { const int c = (int)xb_ld(cnt + 64 * e), lo = pst[e] + c, hi = pst[e] + (((c + 255) >> 8) << 8);
        for (int s = lo + F.tid; s < hi; s += NWAVES * 64) slot_tok[s] = -1; }
    for (int a = F.vcu * NWAVES * 64 + F.tid; a < 2 * T; a += F.G * NWAVES * 64) { const int slot = pst[tok_e[a]] + tok_p[a]; slot_of[a] = slot; slot_tok[slot] = a >> 1; }
}
__device__ __forceinline__ void phase_moe_copy8(Frame& F, const int* tok_e, const int* tok_p, const unsigned char* hn8, unsigned char* ag8) {
    const LAS int* pst = (const LAS int*)(F.lds + TAB_OFF);
    const int gw = F.vcu * NWAVES + F.wave, NGW = F.G * NWAVES, lane = F.lane;
    for (int t = gw; t < T; t += NGW) {
        const int s0 = pst[tok_e[2 * t]] + tok_p[2 * t], s1 = pst[tok_e[2 * t + 1]] + tok_p[2 * t + 1];
        const u32x4* src = (const u32x4*)(hn8 + (size_t)t * D); const u32x4 v0 = src[lane], v1 = src[lane + 64];
        u32x4* d0 = (u32x4*)(ag8 + (size_t)s0 * D); u32x4* d1 = (u32x4*)(ag8 + (size_t)s1 * D);
        d0[lane] = v0; d0[lane + 64] = v1; d1[lane] = v0; d1[lane + 64] = v1;
    }
}
template <int MODE>
__device__ __forceinline__ void phase_moe_combine(Frame& F, float* x, const bf16_t* ob, const int* slot_of, const float* tok_w, const float* gain, bf16_t* hn) {
    const int gw = F.vcu * NWAVES + F.wave, NGW = F.G * NWAVES, lane = F.lane;
    f32x4 g4[8];
#pragma unroll
    for (int j = 0; j < 8; ++j) g4[j] = ((const f32x4*)gain)[lane + 64 * j];
    for (int t = gw; t < T; t += NGW) {
        const int s0 = slot_of[2 * t], s1 = slot_of[2 * t + 1]; const float w0 = tok_w[2 * t], w1 = tok_w[2 * t + 1];
        f32x4* xr = (f32x4*)(x + (size_t)t * D);
        const u32x2* a = (const u32x2*)(ob + (size_t)s0 * D); const u32x2* b = (const u32x2*)(ob + (size_t)s1 * D);
        f32x4 v[8]; float ss = 0.f;
#pragma unroll
        for (int j = 0; j < 8; ++j) { const u32x2 av = a[lane + 64 * j], bv = b[lane + 64 * j]; f32x4 xv = xr[lane + 64 * j];
            xv[0] += w0 * bf_lo(av.x) + w1 * bf_lo(bv.x); xv[1] += w0 * bf_hi(av.x) + w1 * bf_hi(bv.x);
            xv[2] += w0 * bf_lo(av.y) + w1 * bf_lo(bv.y); xv[3] += w0 * bf_hi(av.y) + w1 * bf_hi(bv.y);
            v[j] = xv; ss += (xv[0] * xv[0] + xv[1] * xv[1]) + (xv[2] * xv[2] + xv[3] * xv[3]); }
        const float rstd = 1.0f / sqrtf(wave_sum(ss) * (1.0f / D) + RMS_EPS);
        if (MODE == 0) {
            u32x2* orow = (u32x2*)(hn + (size_t)t * D);
#pragma unroll
            for (int j = 0; j < 8; ++j) { xr[lane + 64 * j] = v[j]; const f32x4 y = v[j] * rstd * g4[j]; u32x2 w; w.x = cvt_pk_bf16(y[0], y[1]); w.y = cvt_pk_bf16(y[2], y[3]); orow[lane + 64 * j] = w; }
        } else {
#pragma unroll
            for (int j = 0; j < 8; ++j) xr[lane + 64 * j] = v[j] * rstd * g4[j];
        }
    }
}

__device__ __forceinline__ void phase_subln(Frame& F, const bf16_t* o1, const bf16_t* o2, const float* lq1, const float* lk1, const float* lq2, const float* lk2, const float* sg, bf16_t* y) {
    const int gw = F.vcu * NWAVES + F.wave, NGW = F.G * NWAVES, lane = F.lane;
    const float d1 = wave_sum(lq1[lane] * lk1[lane] + lq1[lane + 64] * lk1[lane + 64]);
    const float d2 = wave_sum(lq2[lane] * lk2[lane] + lq2[lane + 64] * lk2[lane + 64]);
    const float lam = __expf(d1) - __expf(d2) + LAMBDA_INIT;
    const f32x4 g = ((const f32x4*)sg)[lane] * (1.0f - LAMBDA_INIT);
    for (int tok = gw; tok < T; tok += NGW) {
        u32x2 a[8], b[8];
#pragma unroll
        for (int h = 0; h < 8; ++h) { a[h] = *(const u32x2*)(o1 + (size_t)tok * D + h * 256 + 4 * lane); b[h] = *(const u32x2*)(o2 + (size_t)tok * D + h * 256 + 4 * lane); }
        f32x4 d[8]; float ss[8];
#pragma unroll
        for (int h = 0; h < 8; ++h) { d[h][0] = bf_lo(a[h].x) - lam * bf_lo(b[h].x); d[h][1] = bf_hi(a[h].x) - lam * bf_hi(b[h].x); d[h][2] = bf_lo(a[h].y) - lam * bf_lo(b[h].y); d[h][3] = bf_hi(a[h].y) - lam * bf_hi(b[h].y);
            ss[h] = (d[h][0] * d[h][0] + d[h][1] * d[h][1]) + (d[h][2] * d[h][2] + d[h][3] * d[h][3]); }
#pragma unroll
        for (int of = 1; of < 64; of <<= 1) {
#pragma unroll
            for (int h = 0; h < 8; ++h) ss[h] += __shfl_xor(ss[h], of); }
#pragma unroll
        for (int h = 0; h < 8; ++h) { const float rstd = 1.0f / sqrtf(ss[h] * (1.0f / 256.0f) + RMS_EPS); const f32x4 yv = d[h] * rstd * g;
            u32x2 w; w.x = cvt_pk_bf16(yv[0], yv[1]); w.y = cvt_pk_bf16(yv[2], yv[3]);
            *(u32x2*)(y + (size_t)tok * D + h * 256 + 4 * lane) = w; }
    }
}

namespace att {
constexpr int SHM_K = 64 * 128 * 2, SHM_V = 64 * 256 * 2;
constexpr int V_OFF = 0, K_OFF = 3 * SHM_V, SCR_OFF = RING_BYTES + 4096;
constexpr float SCALE = 0.08838834764831845f;
constexpr float C2 = 1.4426950408889634f * SCALE;
constexpr float THR = 8.f;
#define KSWZ(row, colB) ((row) * 256 + ((colB) ^ (((row) & 7) << 4)))
__device__ __forceinline__ int crow(int r, int hi) { return (r & 3) + 8 * (r >> 2) + 4 * hi; }
__device__ __forceinline__ int v_rd_base(int lane) { return ((lane & 3) << 3) | (((lane >> 2) & 3) << 6) | (((lane >> 4) & 1) << 5) | (((lane >> 5) & 1) << 8); }
constexpr int v_rd_off(int d0, int ks, int half) { return d0 * 512 + ks * 8192 + half * 4096; }

__device__ __forceinline__ void qkt(f32x16& p0, f32x16& p1, const LAS unsigned char* kslot, int r32, int hi, const bf16x8 (&qr)[8]) {
    const LAS unsigned char* kb[4];
#pragma unroll
    for (int dd = 0; dd < 4; ++dd) kb[dd] = kslot + KSWZ(r32, (dd * 16 + hi * 8) * 2);
#pragma unroll
    for (int d0 = 0; d0 < 8; ++d0) { const LAS unsigned char* a = kb[d0 & 3] + (d0 >> 2) * 128;
        const bf16x8 b0 = *(const LAS bf16x8*)a;
        const bf16x8 b1 = *(const LAS bf16x8*)(a + 32 * 256);
        p0 = __builtin_amdgcn_mfma_f32_32x32x16_bf16(b0, qr[d0], p0, 0, 0, 0);
        p1 = __builtin_amdgcn_mfma_f32_32x32x16_bf16(b1, qr[d0], p1, 0, 0, 0); }
}
__device__ __forceinline__ void pv_tile(f32x16 (&o)[8], unsigned vb, const bf16x8 (&pa)[4]) {
#define TRRD(dst, off) asm volatile("ds_read_b64_tr_b16 %0, %1 offset:%2" : "=&v"(dst) : "v"(vb), "i"(off) : "memory")
#define PV_D0(d0) do { s16x4 l0, l1, l2, l3, h0, h1, h2, h3; constexpr int b_ = v_rd_off(d0, 0, 0); \
        TRRD(l0, b_); TRRD(h0, b_ + 4096); TRRD(l1, b_ + 8192); TRRD(h1, b_ + 12288); TRRD(l2, b_ + 16384); TRRD(h2, b_ + 20480); TRRD(l3, b_ + 24576); TRRD(h3, b_ + 28672); \
        asm volatile("s_waitcnt lgkmcnt(0)" ::: "memory"); __builtin_amdgcn_sched_barrier(0); \
        o[d0] = __builtin_amdgcn_mfma_f32_32x32x16_bf16(pa[0], (bf16x8){l0[0], l0[1], l0[2], l0[3], h0[0], h0[1], h0[2], h0[3]}, o[d0], 0, 0, 0); \
        o[d0] = __builtin_amdgcn_mfma_f32_32x32x16_bf16(pa[1], (bf16x8){l1[0], l1[1], l1[2], l1[3], h1[0], h1[1], h1[2], h1[3]}, o[d0], 0, 0, 0); \
        o[d0] = __builtin_amdgcn_mfma_f32_32x32x16_bf16(pa[2], (bf16x8){l2[0], l2[1], l2[2], l2[3], h2[0], h2[1], h2[2], h2[3]}, o[d0], 0, 0, 0); \
        o[d0] = __builtin_amdgcn_mfma_f32_32x32x16_bf16(pa[3], (bf16x8){l3[0], l3[1], l3[2], l3[3], h3[0], h3[1], h3[2], h3[3]}, o[d0], 0, 0, 0); } while (0)
    PV_D0(0); PV_D0(1); PV_D0(2); PV_D0(3); PV_D0(4); PV_D0(5); PV_D0(6); PV_D0(7);
#undef PV_D0
#undef TRRD
}

__device__ __forceinline__ void stage_offsets(int tid, unsigned (&koff)[2], unsigned (&voff)[4]) {
#pragma unroll
    for (int i = 0; i < 2; ++i) { const int P = tid * 16 + i * 8192, row = P >> 8, ch = ((P & 255) >> 4) ^ (row & 7); koff[i] = (unsigned)(row * 128 + ch * 8) * 2u; }
#pragma unroll
    for (int i = 0; i < 4; ++i) { const int P = tid * 16 + i * 8192, st = P >> 9, kk = ((st >> 3) << 3) | ((P & 511) >> 6), cg = st & 7, cin = (P & 63) >> 1;
        const int key = (kk & ~0xC) | ((kk & 4) << 1) | ((kk & 8) >> 1); voff[i] = (unsigned)(key * 256 + cg * 32 + cin) * 2u; }
}
__device__ __forceinline__ const char* uniform_ptr(const void* p) {
    const unsigned long long v = (unsigned long long)p;
    const unsigned lo = __builtin_amdgcn_readfirstlane((unsigned)v), hi = __builtin_amdgcn_readfirstlane((unsigned)(v >> 32));
    return (const char*)(((unsigned long long)hi << 32) | lo);
}
__device__ __forceinline__ void stage_tile(LAS unsigned char* lds, int kslot, int vslot, const bf16_t* kj_, const bf16_t* vj_, int tid_, int wid) {
    const char* kj = uniform_ptr(kj_); const char* vj = uniform_ptr(vj_);
    int tid = tid_; asm volatile("" : "+v"(tid));
    unsigned koff[2], voff[4]; stage_offsets(tid, koff, voff);
    LAS unsigned char* kd = lds + K_OFF + kslot * SHM_K + wid * 1024; LAS unsigned char* vd = lds + V_OFF + vslot * SHM_V + wid * 1024;
#pragma unroll
    for (int i = 0; i < 2; ++i) __builtin_amdgcn_global_load_lds((const unsigned*)(kj + koff[i]), (LAS unsigned*)(kd + i * 8192), 16, 0, 0);
#pragma unroll
    for (int i = 0; i < 4; ++i) __builtin_amdgcn_global_load_lds((const unsigned*)(vj + voff[i]), (LAS unsigned*)(vd + i * 8192), 16, 0, 0);
}

__device__ __forceinline__ void qk_softmax(const LAS unsigned char* kslot, int r32, int hi, LAS float* al_l, const bf16x8 (&qr)[8], f32x16 (&o)[8], bf16x8 (&pa)[4],
                                           float& m_reg, float& l_reg, float rawu, float sl2, bool diag, int qi) {
    f32x16 p0, p1;
#pragma unroll
    for (int r = 0; r < 16; ++r) { p0[r] = 0.f; p1[r] = 0.f; }
    qkt(p0, p1, kslot, r32, hi, qr);
#pragma unroll
    for (int r = 0; r < 16; ++r) { const float cr = (float)((r & 3) + 8 * (r >> 2)); p0[r] = fmaf(cr, rawu, p0[r]); p1[r] = fmaf(cr, rawu, p1[r]); }
    if (diag) {
        const float k2raw = 2.f * rawu;
        int qi_ = qi - 4 * hi; asm volatile("" : "+v"(qi_));
#pragma unroll
        for (int r = 0; r < 16; ++r) { const int c = (r & 3) + 8 * (r >> 2); const int d0_ = c - qi_, d1_ = c + 32 - qi_;
            p0[r] -= k2raw * (float)(d0_ > 0 ? d0_ : 0); p1[r] -= k2raw * (float)(d1_ > 0 ? d1_ : 0); }
    }
    const float lane_raw = rawu * (float)(4 * hi), d32raw = 32.f * rawu;
    float pm0 = p0[0], pm1 = p1[0];
#pragma unroll
    for (int r = 1; r < 16; ++r) { pm0 = fmaxf(pm0, p0[r]); pm1 = fmaxf(pm1, p1[r]); }
    float pmax = fmaxf(pm0, pm1 + d32raw) + lane_raw;
    { auto rr = __builtin_amdgcn_permlane32_swap(__float_as_uint(pmax), __float_as_uint(pmax), false, false);
      pmax = fmaxf(__uint_as_float(rr[0]), __uint_as_float(rr[1])); }
    float mn, alpha;
    if (__all((pmax - m_reg) * SCALE <= THR)) { mn = m_reg; alpha = 1.f; }
    else { mn = fmaxf(m_reg, pmax); alpha = __builtin_amdgcn_exp2f((m_reg - mn) * C2); m_reg = mn; }
    const float mnL0 = (lane_raw - mn) * C2, mnL1 = mnL0 + 32.f * sl2;
#pragma unroll
    for (int r = 0; r < 16; ++r) { p0[r] = __builtin_amdgcn_exp2f(fmaf(p0[r], C2, mnL0)); p1[r] = __builtin_amdgcn_exp2f(fmaf(p1[r], C2, mnL1)); }
    if (__any(alpha < 1.f)) {
        if (hi == 0) al_l[r32] = alpha;
        LDS_WAIT();
#pragma unroll
        for (int r = 0; r < 16; ++r) { const float a = al_l[crow(r, hi)];
#pragma unroll
            for (int d = 0; d < 8; ++d) o[d][r] *= a; }
    }
    float ps = 0.f;
#pragma unroll
    for (int r = 0; r < 16; ++r) ps += p0[r] + p1[r];
    { auto rr = __builtin_amdgcn_permlane32_swap(__float_as_uint(ps), __float_as_uint(ps), false, false);
      ps = __uint_as_float(rr[0]) + __uint_as_float(rr[1]); }
    l_reg = l_reg * alpha + ps;
#define PK4(P, B_, OUT) do { unsigned a0 = cvt_pk_bf16(P[B_+0], P[B_+1]), a1 = cvt_pk_bf16(P[B_+2], P[B_+3]); \
        unsigned b0 = cvt_pk_bf16(P[B_+4], P[B_+5]), b1 = cvt_pk_bf16(P[B_+6], P[B_+7]); \
        auto r0 = __builtin_amdgcn_permlane32_swap(a0, b0, false, false); auto r1 = __builtin_amdgcn_permlane32_swap(a1, b1, false, false); \
        u32x4 w = {r0[0], r1[0], r0[1], r1[1]}; OUT = __builtin_bit_cast(bf16x8, w); } while (0)
    PK4(p0, 0, pa[0]); PK4(p0, 8, pa[1]); PK4(p1, 0, pa[2]); PK4(p1, 8, pa[3]);
#undef PK4
}

__device__ __forceinline__ void norms_phase(Frame& F, const bf16_t* proj, float* nrm) {
    const int gw = F.vcu * NWAVES + F.wave, NGW = F.G * NWAVES, lane = F.lane;
    for (int idx = gw; idx < 2 * 32 * 256; idx += NGW) {
        const int tensor = idx >> 13, stream = (idx >> 8) & 31, grp = idx & 255;
        const u32x4* rp = (const u32x4*)(proj + (tensor ? DK0 : 0) + ((size_t)stream * SEQ + grp * 64 + lane) * 128);
        float ss = 0.f;
#pragma unroll
        for (int q = 0; q < 16; ++q) { const u32x4 v = rp[q];
#pragma unroll
            for (int e = 0; e < 4; ++e) { const float lo = bf_lo(v[e]), hi = bf_hi(v[e]); ss += lo * lo + hi * hi; } }
        float n = sqrtf(ss) * 1.001f;
#pragma unroll
        for (int o = 1; o < 64; o <<= 1) n = fmaxf(n, __shfl_xor(n, o));
        if (lane == 0) nrm[idx] = n;
    }
}

__device__ __forceinline__ void attn_item(LAS unsigned char* lds, const bf16_t* proj, const float* nrm, bf16_t* oout, int b, int h, int sub, int qb, int tid, int wid, int lane) {
    const int r32 = lane & 31, hi = lane >> 5;
    const float slope = __builtin_amdgcn_exp2f(-(float)(h + 1));
    const float sl2 = slope * 1.4426950408889634f, rawu = sl2 / C2;
    LAS float* ws = (LAS float*)(lds + SCR_OFF) + wid * 64; LAS float* li_l = ws; LAS float* al_l = ws + 32;
    const size_t tokq = (size_t)b * SEQ + (size_t)qb * 256 + wid * 32;
    const bf16_t* kbase = proj + DK0 + dq_off(b, 0, h, sub);
    const bf16_t* vbase = proj + dv_off(b, 0, h);
    int j_lo;
    { const int stream = (b * 8 + h) * 2 + sub; const float* qn = nrm + stream * 256; const float* kn = nrm + 8192 + stream * 256;
      const float Qn = fmaxf(fmaxf(qn[4 * qb], qn[4 * qb + 1]), fmaxf(qn[4 * qb + 2], qn[4 * qb + 3]));
      const float Kd = fmaxf(fmaxf(kn[4 * qb], kn[4 * qb + 1]), fmaxf(kn[4 * qb + 2], kn[4 * qb + 3]));
      int cand = 4 * qb;
      for (int jj = lane; jj < 4 * qb; jj += 64) { const float dmin = (float)(256 * qb - (64 * jj + 63)); const bool skip = slope * dmin > 110.f + SCALE * Qn * (kn[jj] + Kd); if (!skip) cand = cand < jj ? cand : jj; }
#pragma unroll
      for (int o = 1; o < 64; o <<= 1) { const int v = __shfl_xor(cand, o); cand = v < cand ? v : cand; }
      j_lo = __builtin_amdgcn_readfirstlane(cand); }
    bf16x8 qr[8];
#pragma unroll
    for (int d0 = 0; d0 < 8; ++d0) qr[d0] = *(const bf16x8*)(proj + dq_off(b, qb * 256 + wid * 32 + r32, h, sub) + d0 * 16 + hi * 8);
    const float sh64 = 64.f * rawu;
    const int qi = 32 * (wid & 1) + r32;
    const unsigned vb0 = (unsigned)(uintptr_t)(lds + V_OFF) + (unsigned)v_rd_base(lane);
    float m_reg = -1e30f, l_reg = 0.f;
    f32x16 o[8];
#pragma unroll
    for (int d = 0; d < 8; ++d)
#pragma unroll
        for (int r = 0; r < 16; ++r) o[d][r] = 0.f;
    const int NT = 4 * qb + 4, myNT = 4 * qb + (wid >> 1) + 1;
    constexpr size_t KSTEP = 64 * 128, VSTEP = 64 * 256;
    const bool late = wid >= 4;
    stage_tile(lds, j_lo & 1, j_lo % 3, kbase + (size_t)j_lo * KSTEP, vbase + (size_t)j_lo * VSTEP, tid, wid);
    VM_WAIT(); WG_BAR();
    if (!late) {
        int vs = j_lo % 3;
        for (int j = j_lo; j < NT; ++j) {
            const int vsn = vs == 2 ? 0 : vs + 1;
            if (j + 1 < NT) stage_tile(lds, (j + 1) & 1, vsn, kbase + (size_t)(j + 1) * KSTEP, vbase + (size_t)(j + 1) * VSTEP, tid, wid);
            if (j < myNT) { if (j > j_lo) m_reg -= sh64;
                bf16x8 pa[4];
                qk_softmax(lds + K_OFF + (j & 1) * SHM_K, r32, hi, al_l, qr, o, pa, m_reg, l_reg, rawu, sl2, j == myNT - 1, qi);
                pv_tile(o, vb0 + (unsigned)(vs * SHM_V), pa); }
            VM_WAIT(); WG_BAR();
            vs = vsn;
        }
    } else {
        bf16x8 pa[4];
        int vs = j_lo % 3, vsp = vs;
        for (int j = j_lo; j < NT; ++j) {
            const int vsn = vs == 2 ? 0 : vs + 1;
            if (j + 1 < NT) stage_tile(lds, (j + 1) & 1, vsn, kbase + (size_t)(j + 1) * KSTEP, vbase + (size_t)(j + 1) * VSTEP, tid, wid);
            if (j > j_lo && j - 1 < myNT) pv_tile(o, vb0 + (unsigned)(vsp * SHM_V), pa);
            if (j < myNT) { if (j > j_lo) m_reg -= sh64;
                qk_softmax(lds + K_OFF + (j & 1) * SHM_K, r32, hi, al_l, qr, o, pa, m_reg, l_reg, rawu, sl2, j == myNT - 1, qi); }
            VM_WAIT(); WG_BAR();
            vsp = vs; vs = vsn;
        }
        if (myNT == NT) pv_tile(o, vb0 + (unsigned)(vsp * SHM_V), pa);
    }
    if (hi == 0) li_l[r32] = l_reg;
    LDS_WAIT();
    char* Ow = (char*)(oout + tokq * D + h * 256);
    const unsigned lofs = (unsigned)(hi * 4 * D + r32) * 2u;
#pragma unroll
    for (int r = 0; r < 16; ++r) { const float rl = __builtin_amdgcn_rcpf(li_l[crow(r, hi)]);
#pragma unroll
        for (int d0 = 0; d0 < 8; ++d0) { const float v = o[d0][r] * rl; const float vn = __shfl_xor(v, 1);
            if ((r32 & 1) == 0) *(unsigned*)(Ow + (lofs + (unsigned)((((r & 3) + 8 * (r >> 2)) * D + d0 * 32) * 2))) = cvt_pk_bf16(v, vn); } }
    WG_BAR();
}

__device__ __forceinline__ void attn_phase(Frame& F, const bf16_t* proj, const float* nrm, unsigned* queue, bf16_t* o1, bf16_t* o2) {
    LAS int* qw = (LAS int*)(F.lds + SCR_OFF + 8 * 256);
    for (;;) {
        if (F.tid == 0) *qw = (int)__hip_atomic_fetch_add(queue, 1u, __ATOMIC_RELAXED, __HIP_MEMORY_SCOPE_AGENT);
        WG_BAR();
        const int I = __builtin_amdgcn_readfirstlane(*qw);
        if (I >= 2048) break;
        const int qb = 63 - (I >> 5), r = I & 31, h = 7 - (r >> 2), b = (r >> 1) & 1, sub = r & 1;
        attn_item(F.lds, proj, nrm, sub ? o2 : o1, b, h, sub, qb, F.tid, F.wave, F.lane);
    }
}
}

__device__ __forceinline__ const void* karg(int i) { int j = i; asm volatile("" : "+s"(j)); return ((const void* const __attribute__((address_space(4)))*)__builtin_amdgcn_kernarg_segment_ptr())[j]; }
__global__ void __launch_bounds__(NWAVES * 64, 2) hybrid_fwd(Args args) {
    extern __shared__ __attribute__((aligned(16))) unsigned char lds_raw[];
    Frame F;
    F.lds = (LAS unsigned char*)lds_raw;
    F.tid = threadIdx.x; F.lane = F.tid & 63; F.wave = __builtin_amdgcn_readfirstlane(F.tid >> 6);
    F.G = gridDim.x; { const int bx = blockIdx.x; F.vcu = (F.G % 8 == 0) ? (bx % 8) * (F.G / 8) + bx / 8 : bx; }
#define ws ((unsigned char*)karg(22))
#define ctl ((unsigned*)(ws + WS_CTL))
    for (int u = F.tid; u < (LDS_BYTES - LDSCTL_OFF) / 4; u += NWAVES * 64) ((LAS unsigned*)(F.lds + LDSCTL_OFF))[u] = 0u;
    __syncthreads();
    ((LAS int*)(F.lds + TIDS_OFF))[F.tid] = F.tid;
    __syncthreads();
    volatile LAS unsigned* MISC = (volatile LAS unsigned*)(F.lds + MISC_OFF);
    XcdBarrier bar = xcd_barrier_post(ctl + CW_BAR, MISC + 8);
#define GRID_BAR() do { XcdBarrier bb_ = bar; unsigned x_ = bar.x; unsigned long long bp_ = (unsigned long long)bar.bar; asm volatile("" : "+s"(x_), "+s"(bp_)); bb_.x = x_; bb_.bar = (unsigned*)bp_; xcd_barrier(bb_, TID_RELOAD() == 0); } while (0)
#define TID_RELOAD() (F.wave * 64 + lane_id_volatile())
#ifdef ONLY_PHASE
#define PHON(n) ((n) == ONLY_PHASE)
#elif DIAG
#define PHON(n) ((n) <= args.upto)
#else
#define PHON(n) 1
#endif

#define x_in ((const float*)(karg(0)))
#define norm_mix ((const float*)(karg(1)))
#define norm_ffn ((const float*)(karg(2)))
#define gla_w_in ((const float*)(karg(3)))
#define gla_wgu ((const float*)(karg(4)))
#define gla_bg ((const float*)(karg(5)))
#define gla_norm ((const float*)(karg(6)))
#define gla_w_out ((const float*)(karg(7)))
#define diff_w_in ((const float*)(karg(8)))
#define lq1 ((const float*)(karg(9)))
#define lk1 ((const float*)(karg(10)))
#define lq2 ((const float*)(karg(11)))
#define lk2 ((const float*)(karg(12)))
#define diff_subln ((const float*)(karg(13)))
#define diff_w_out ((const float*)(karg(14)))
#define moe_wgrp ((const float*)(karg(15)))
#define moe_wexp ((const float*)(karg(16)))
#define moe_wg ((const float*)(karg(17)))
#define moe_wu ((const float*)(karg(18)))
#define moe_wd ((const float*)(karg(19)))
#define final_norm ((const float*)(karg(20)))
#define xres ((float*)(karg(21)))
#define gz ((float*)((float*)(ws + WS_GZ)))
#define tok_e ((int*)((int*)(ws + WS_TOKE)))
#define tok_p ((int*)((int*)(ws + WS_TOKP)))
#define tok_w ((float*)((float*)(ws + WS_TOKW)))
#define slot_of ((int*)((int*)(ws + WS_SLOT)))
#define slot_tok ((int*)(ws + WS_STOK))
#define adec ((float*)((float*)(ws + WS_ADEC)))
#define pcum ((float*)((float*)(ws + WS_PCUM)))
#define sfin ((bf16_t*)((bf16_t*)(ws + WS_SFIN)))
#define wp_gz ((float*)((float*)(ws + WS_WPGZ)))
#define wp_r0 ((float*)((float*)(ws + WS_WPR0)))
#define wp_r1 ((float*)((float*)(ws + WS_WPR1)))
#define wgi ((bf16_t*)((bf16_t*)(ws + WS_WGI)))
#define wgo ((bf16_t*)((bf16_t*)(ws + WS_WGO)))
#define wdi ((bf16_t*)((bf16_t*)(ws + WS_WDI)))
#define wdo ((bf16_t*)((bf16_t*)(ws + WS_WDO)))
#define wmoe_gu ((bf16_t*)((bf16_t*)(ws + WS_WMOE)))
#define wmoe_d ((bf16_t*)((bf16_t*)(ws + WS_WMOE_D)))
#define hn ((bf16_t*)((bf16_t*)(ws + WS_HN)))
#define proj ((bf16_t*)((bf16_t*)(ws + WS_PROJ)))
#define buf1 ((bf16_t*)((bf16_t*)(ws + WS_BUF1)))
#define buf2 ((bf16_t*)((bf16_t*)(ws + WS_BUF2)))
#define ag ((bf16_t*)((bf16_t*)(ws + WS_AG)))
#define ob ((bf16_t*)((bf16_t*)(ws + WS_OB)))
#define hh ((bf16_t*)((bf16_t*)(ws + WS_H)))
    const LAS int* pst = (const LAS int*)(F.lds + TAB_OFF);

    _Pragma("unroll") for (int rep_ = 0; rep_ < (REP_PHASE == 0 ? 2 : 1); ++rep_) if (PHON(0)) { if (rep_) GRID_BAR(); Frame P = F; P.tid = TID_RELOAD(); P.lane = P.tid & 63;
    conv_plain(P, gla_w_in, D, PROJW, GLA_INW, wgi);
    conv_plain(P, gla_w_out, D, D, D, wgo);
    conv_plain(P, diff_w_in, D, PROJW, PROJW, wdi);
    conv_plain(P, diff_w_out, D, D, D, wdo);
    pack_proj(P, wp_gz, 1, norm_mix, gla_w_in, GLA_INW, PROJW, 16, nullptr, 0, 0);
    pack_proj(P, wp_r0, 3, norm_ffn, moe_wgrp, 4, 0, 4, moe_wexp, 32, 32);
    pack_proj(P, wp_r1, 3, norm_ffn + D, moe_wgrp + (size_t)D * 4, 4, 0, 4, moe_wexp + (size_t)D * 32, 32, 32);
    }
    GRID_BAR();
    _Pragma("unroll") for (int rep_ = 0; rep_ < (REP_PHASE == 1 ? 2 : 1); ++rep_) if (PHON(1)) { if (rep_) GRID_BAR(); Frame P = F; P.tid = TID_RELOAD(); P.lane = P.tid & 63;
    phase_norm_gz(P, x_in, norm_mix, wp_gz, hn, gz);
    }
    GRID_BAR();
    _Pragma("unroll") for (int rep_ = 0; rep_ < (REP_PHASE == 2 ? 2 : 1); ++rep_) if (PHON(2)) { if (rep_) GRID_BAR(); Frame P = F; P.tid = TID_RELOAD(); P.lane = P.tid & 63;
    { pg8::Gemm g{hn, wgi, T, PROJW, D}; pg8::StaticOrder S; S.init(T, PROJW, P.G, (int)blockIdx.x); pg8::EpiHeads<0> E{proj};
      pg8::gemm_phase<pg8::EpiHeads<0>, pg8::StaticOrder>(P.lds, g, S, E, P.tid); }
    }
    GRID_BAR();
    _Pragma("unroll") for (int rep_ = 0; rep_ < (REP_PHASE == 3 ? 2 : 1); ++rep_) if (PHON(3)) { if (rep_) GRID_BAR(); Frame P = F; P.tid = TID_RELOAD(); P.lane = P.tid & 63;
    phase_gla_gate(P, gz, gla_wgu, gla_bg, proj, buf1, adec);
    }
    GRID_BAR();
    _Pragma("unroll") for (int rep_ = 0; rep_ < (REP_PHASE == 4 ? 2 : 1); ++rep_) if (PHON(4)) { if (rep_) GRID_BAR(); Frame P = F; P.tid = TID_RELOAD(); P.lane = P.tid & 63;
    if (P.G == 256) { if ((P.vcu & 1) == 0) phase_gla_scan(P, P.vcu >> 1, proj, buf1, adec, buf2, sfin, ctl + CW_PROBE); else { gla_pcum(P, adec, pcum, P.vcu >> 1, 128); conv_moe(P, moe_wg, moe_wu, moe_wd, wmoe_gu, wmoe_d, P.vcu >> 1, 128); } }
    else { for (int it = P.vcu; it < 128; it += P.G) phase_gla_scan(P, it, proj, buf1, adec, buf2, sfin); gla_pcum(P, adec, pcum, P.vcu, P.G); conv_moe(P, moe_wg, moe_wu, moe_wd, wmoe_gu, wmoe_d); }
    GRID_BAR();
    phase_gla_qp(P, proj, pcum, hn);
    GRID_BAR();
    { pg8::Gemm g{hn, sfin, 8 * (SEQ / 2), 512, 256}; pg8::FixOrder S; S.init(8 * (SEQ / 2), 512, P.G, (int)blockIdx.x); pg8::EpiAddO E{buf2};
      pg8::gemm_phase<pg8::EpiAddO, pg8::FixOrder>(P.lds, g, S, E, P.tid); }
    }
    GRID_BAR();
    _Pragma("unroll") for (int rep_ = 0; rep_ < (REP_PHASE == 5 ? 2 : 1); ++rep_) if (PHON(5)) { if (rep_) GRID_BAR(); Frame P = F; P.tid = TID_RELOAD(); P.lane = P.tid & 63;
    phase_gla_gnorm(P, buf2, proj, gla_norm, hn);
    }
    GRID_BAR();
    _Pragma("unroll") for (int rep_ = 0; rep_ < (REP_PHASE == 6 ? 2 : 1); ++rep_) if (PHON(6)) { if (rep_) GRID_BAR(); Frame P = F; P.tid = TID_RELOAD(); P.lane = P.tid & 63;
    { pg8::Gemm g{hn, wgo, T, D, D}; pg8::StaticOrder S; S.init(T, D, P.G, (int)blockIdx.x); pg8::EpiResF32 E{x_in, xres, D};
      pg8::gemm_phase<pg8::EpiResF32, pg8::StaticOrder>(P.lds, g, S, E, P.tid); }
    }
    GRID_BAR();
    _Pragma("unroll") for (int rep_ = 0; rep_ < (REP_PHASE == 7 ? 2 : 1); ++rep_) if (PHON(7)) { if (rep_) GRID_BAR(); Frame P = F; P.tid = TID_RELOAD(); P.lane = P.tid & 63;
    phase_norm_route(P, xres, norm_ffn, wp_r0, hn, tok_e, tok_p, tok_w, ctl + CW_CNT0);
    }
    GRID_BAR();
    _Pragma("unroll") for (int rep_ = 0; rep_ < (REP_PHASE == 8 ? 2 : 1); ++rep_) if (PHON(8)) { if (rep_) GRID_BAR(); Frame P = F; P.tid = TID_RELOAD(); P.lane = P.tid & 63;
    moe_tables(P, ctl + CW_CNT0);
    phase_moe_slots(P, tok_e, tok_p, ctl + CW_CNT0, slot_of, slot_tok);
    }
    GRID_BAR();
    _Pragma("unroll") for (int rep_ = 0; rep_ < (REP_PHASE == 9 ? 2 : 1); ++rep_) if (PHON(9)) { if (rep_) GRID_BAR(); Frame P = F; P.tid = TID_RELOAD(); P.lane = P.tid & 63;
    { const int Mr = pst[33] * 256; pg8::Gemm g{hn, wmoe_gu, Mr, 1024, D}; pg8::MoeOrder S; S.init(Mr, 1024, P.G, (int)blockIdx.x); S.te = pst + 36; S.estride = (size_t)1024 * D; S.stok = slot_tok; pg8::EpiSiluMul E{(unsigned char*)hh};
      pg8::gemm_phase<pg8::EpiSiluMul, pg8::MoeOrder, true, true>(P.lds, g, S, E, P.tid); }
    }
    GRID_BAR();
    _Pragma("unroll") for (int rep_ = 0; rep_ < (REP_PHASE == 10 ? 2 : 1); ++rep_) if (PHON(10)) { if (rep_) GRID_BAR(); Frame P = F; P.tid = TID_RELOAD(); P.lane = P.tid & 63;
    { const int Mr = pst[33] * 256; pg8::Gemm g{hh, wmoe_d, Mr, D, DFF}; pg8::MoeOrder S; S.init(Mr, D, P.G, (int)blockIdx.x); S.te = pst + 36; S.estride = (size_t)D * DFF; S.stok = slot_tok; pg8::EpiBf16 E{ob, D};
      pg8::gemm_phase<pg8::EpiBf16, pg8::MoeOrder, false, true>(P.lds, g, S, E, P.tid); }
    }
    GRID_BAR();
    _Pragma("unroll") for (int rep_ = 0; rep_ < (REP_PHASE == 11 ? 2 : 1); ++rep_) if (PHON(11)) { if (rep_) GRID_BAR(); Frame P = F; P.tid = TID_RELOAD(); P.lane = P.tid & 63;
    phase_moe_combine<0>(P, xres, ob, slot_of, tok_w, norm_mix + D, hn);
    conv_moe(P, moe_wg + (size_t)NEXP * D * DFF, moe_wu + (size_t)NEXP * D * DFF, moe_wd + (size_t)NEXP * DFF * D, wmoe_gu, wmoe_d);
    }
    GRID_BAR();
    _Pragma("unroll") for (int rep_ = 0; rep_ < (REP_PHASE == 12 ? 2 : 1); ++rep_) if (PHON(12)) { if (rep_) GRID_BAR(); Frame P = F; P.tid = TID_RELOAD(); P.lane = P.tid & 63;
    { pg8::Gemm g{hn, wdi, T, PROJW, D}; pg8::StaticOrder S; S.init(T, PROJW, P.G, (int)blockIdx.x); pg8::EpiHeads<1> E{proj};
      pg8::gemm_phase<pg8::EpiHeads<1>, pg8::StaticOrder>(P.lds, g, S, E, P.tid); }
    GRID_BAR();
    att::norms_phase(P, proj, (float*)(ws + WS_NRM));
    }
    GRID_BAR();
    _Pragma("unroll") for (int rep_ = 0; rep_ < (REP_PHASE == 13 ? 2 : 1); ++rep_) if (PHON(13)) { if (rep_) GRID_BAR(); Frame P = F; P.tid = TID_RELOAD(); P.lane = P.tid & 63;
    att::attn_phase(P, proj, (const float*)(ws + WS_NRM), ctl + CW_QUEUE, buf1, buf2);
    }
    GRID_BAR();
    _Pragma("unroll") for (int rep_ = 0; rep_ < (REP_PHASE == 14 ? 2 : 1); ++rep_) if (PHON(14)) { if (rep_) GRID_BAR(); Frame P = F; P.tid = TID_RELOAD(); P.lane = P.tid & 63;
    phase_subln(P, buf1, buf2, lq1, lk1, lq2, lk2, diff_subln, hn);
    }
    GRID_BAR();
    _Pragma("unroll") for (int rep_ = 0; rep_ < (REP_PHASE == 15 ? 2 : 1); ++rep_) if (PHON(15)) { if (rep_) GRID_BAR(); Frame P = F; P.tid = TID_RELOAD(); P.lane = P.tid & 63;
    { pg8::Gemm g{hn, wdo, T, D, D}; pg8::StaticOrder S; S.init(T, D, P.G, (int)blockIdx.x); pg8::EpiResF32 E{xres, xres, D};
      pg8::gemm_phase<pg8::EpiResF32, pg8::StaticOrder>(P.lds, g, S, E, P.tid); }
    }
    GRID_BAR();
    _Pragma("unroll") for (int rep_ = 0; rep_ < (REP_PHASE == 16 ? 2 : 1); ++rep_) if (PHON(16)) { if (rep_) GRID_BAR(); Frame P = F; P.tid = TID_RELOAD(); P.lane = P.tid & 63;
    phase_norm_route(P, xres, norm_ffn + D, wp_r1, hn, tok_e, tok_p, tok_w, ctl + CW_CNT1);
    }
    GRID_BAR();
    _Pragma("unroll") for (int rep_ = 0; rep_ < (REP_PHASE == 17 ? 2 : 1); ++rep_) if (PHON(17)) { if (rep_) GRID_BAR(); Frame P = F; P.tid = TID_RELOAD(); P.lane = P.tid & 63;
    moe_tables(P, ctl + CW_CNT1);
    phase_moe_slots(P, tok_e, tok_p, ctl + CW_CNT1, slot_of, slot_tok);
    }
    GRID_BAR();
    _Pragma("unroll") for (int rep_ = 0; rep_ < (REP_PHASE == 18 ? 2 : 1); ++rep_) if (PHON(18)) { if (rep_) GRID_BAR(); Frame P = F; P.tid = TID_RELOAD(); P.lane = P.tid & 63;
    { const int Mr = pst[33] * 256; pg8::Gemm g{hn, wmoe_gu, Mr, 1024, D}; pg8::MoeOrder S; S.init(Mr, 1024, P.G, (int)blockIdx.x); S.te = pst + 36; S.estride = (size_t)1024 * D; S.stok = slot_tok; pg8::EpiSiluMul E{(unsigned char*)hh};
      pg8::gemm_phase<pg8::EpiSiluMul, pg8::MoeOrder, true, true>(P.lds, g, S, E, P.tid); }
    }
    GRID_BAR();
    _Pragma("unroll") for (int rep_ = 0; rep_ < (REP_PHASE == 19 ? 2 : 1); ++rep_) if (PHON(19)) { if (rep_) GRID_BAR(); Frame P = F; P.tid = TID_RELOAD(); P.lane = P.tid & 63;
    { const int Mr = pst[33] * 256; pg8::Gemm g{hh, wmoe_d, Mr, D, DFF}; pg8::MoeOrder S; S.init(Mr, D, P.G, (int)blockIdx.x); S.te = pst + 36; S.estride = (size_t)D * DFF; S.stok = slot_tok; pg8::EpiBf16 E{ob, D};
      pg8::gemm_phase<pg8::EpiBf16, pg8::MoeOrder, false, true>(P.lds, g, S, E, P.tid); }
    }
    GRID_BAR();
    _Pragma("unroll") for (int rep_ = 0; rep_ < (REP_PHASE == 20 ? 2 : 1); ++rep_) if (PHON(20)) { if (rep_) GRID_BAR(); Frame P = F; P.tid = TID_RELOAD(); P.lane = P.tid & 63;
    phase_moe_combine<1>(P, xres, ob, slot_of, tok_w, final_norm, hn);
    }
#if PROBE
    { GRID_BAR(); const float c = sqrtf(0.1f * __uint_as_float(xb_ld(ctl + CW_PROBE)));
      for (size_t i = (size_t)blockIdx.x * 512 + F.tid; i < (size_t)T * D; i += (size_t)gridDim.x * 512) xres[i] = c; }
#endif
}

#undef x_in
#undef norm_mix
#undef norm_ffn
#undef gla_w_in
#undef gla_wgu
#undef gla_bg
#undef gla_norm
#undef gla_w_out
#undef diff_w_in
#undef lq1
#undef lk1
#undef lq2
#undef lk2
#undef diff_subln
#undef diff_w_out
#undef moe_wgrp
#undef moe_wexp
#undef moe_wg
#undef moe_wu
#undef moe_wd
#undef final_norm
#undef xres
#undef gz
#undef tok_e
#undef tok_p
#undef tok_w
#undef slot_of
#undef slot_tok
#undef ws
#undef ctl
#undef adec
#undef pcum
#undef sfin
#undef wp_gz
#undef wp_r0
#undef wp_r1
#undef wgi
#undef wgo
#undef wdi
#undef wdo
#undef wmoe_gu
#undef wmoe_d
#undef hn
#undef proj
#undef buf1
#undef buf2
#undef ag
#undef ob
#undef hh
#if DIAG
constexpr size_t WS_DIAG = WS_END;
constexpr int NSAVE = 64;
__device__ inline unsigned hsh(unsigned x) { x ^= x >> 16; x *= 0x7feb352dU; x ^= x >> 15; x *= 0x846ca68bU; x ^= x >> 16; return x; }
__device__ inline void rep(unsigned* w, double got, double ref, double scale) { double e = fabs(got - ref) / (fabs(ref) + scale); float ef = (float)e; if (!(ef == ef) || ef > 1e30f) ef = 1e30f; atomicMax(w, __float_as_uint(ef)); }
__device__ inline double bfd(bf16_t v) { return (double)bf2f(v); }
#define GTID (blockIdx.x * blockDim.x + threadIdx.x)
#define GSTR (gridDim.x * blockDim.x)

__global__ void ck_weights(const float* gla_w_in, const float* gla_w_out, const float* diff_w_in, const float* diff_w_out, const bf16_t* wgi, const bf16_t* wgo, const bf16_t* wdi, const bf16_t* wdo,
                           const float* norm_mix, const float* norm_ffn, const float* wgrp, const float* wexp, const float* wp_gz, const float* wp_r0, const float* wp_r1, unsigned* w) {
    for (unsigned i = GTID; i < 65536u; i += GSTR) { const unsigned r = hsh(i * 3u + 1u), r2 = hsh(i * 7u + 5u);
        const int n = r % 6144u, k = r2 % 2048u, n2 = n % 2048;
        rep(w, bfd(wgi[(size_t)n * D + k]), gla_w_in[(size_t)k * GLA_INW + n], 0.02); rep(w, bfd(wdi[(size_t)n * D + k]), diff_w_in[(size_t)k * PROJW + n], 0.02);
        rep(w, bfd(wgo[(size_t)n2 * D + k]), gla_w_out[(size_t)k * D + n2], 0.02); rep(w, bfd(wdo[(size_t)n2 * D + k]), diff_w_out[(size_t)k * D + n2], 0.02);
        const int s = r % 128u, ln = (r >> 7) % 64u, e4 = (r >> 13) & 3, kk = 16 * s + 4 * (ln >> 4) + e4, col = ln & 15, nt = (r >> 15) % 3u, col3 = 16 * nt + col;
        rep(w, wp_gz[(s * 64 + ln) * 4 + e4], (double)norm_mix[kk] * gla_w_in[(size_t)kk * GLA_INW + PROJW + col], 0.02);
        for (int L = 0; L < 2; ++L) { const float* gr = wgrp + (size_t)L * D * 4; const float* ex = wexp + (size_t)L * D * 32; const float* nf = norm_ffn + L * D;
            const double ref = col3 < 4 ? gr[kk * 4 + col3] : (col3 < 36 ? ex[kk * 32 + col3 - 4] : 0.0);
            rep(w, (L ? wp_r1 : wp_r0)[((s * 3 + nt) * 64 + ln) * 4 + e4], (double)nf[kk] * ref, 0.02); } }
}
__global__ void ck_moew(const float* wg, const float* wu, const float* wd, const bf16_t* GU, const bf16_t* DT, unsigned* w) {
    for (unsigned i = GTID; i < 65536u; i += GSTR) { const unsigned r = hsh(i * 5u + 2u), r2 = hsh(i * 11u + 3u);
        const int e = r % 32u, f = (r >> 5) % 512u, k = r2 % 2048u, n2 = (r2 >> 11) % 2048u, rowg = 256 * (f >> 7) + (f & 127);
        rep(w, bfd(GU[((size_t)e * 1024 + rowg) * D + k]), wg[((size_t)e * D + k) * DFF + f], 0.02); rep(w, bfd(GU[((size_t)e * 1024 + rowg + 128) * D + k]), wu[((size_t)e * D + k) * DFF + f], 0.02);
        rep(w, bfd(DT[((size_t)e * D + n2) * DFF + f]), wd[((size_t)e * DFF + f) * D + n2], 0.05); }
}
__global__ void ck_norm(const float* x, const float* gain, const bf16_t* hn, unsigned* w) {
    for (unsigned i = GTID; i < 4096u; i += GSTR) { const unsigned r = hsh(i * 13u + 7u); const int t = r % (unsigned)T, j = (r >> 15) % 2048u;
        double ss = 0; for (int k = 0; k < D; ++k) { const double v = x[(size_t)t * D + k]; ss += v * v; }
        const double rstd = 1.0 / sqrt(ss / D + 1e-6); rep(w, bfd(hn[(size_t)t * D + j]), x[(size_t)t * D + j] * rstd * gain[j], 1.0); }
}
__global__ void ck_gz(const float* x, const float* gain, const float* gla_w_in, const float* gz, unsigned* w) {
    for (unsigned i = GTID; i < 4096u; i += GSTR) { const unsigned r = hsh(i * 17u + 9u); const int t = r % (unsigned)T, c = (r >> 15) % 16u;
        double ss = 0, dot = 0; for (int k = 0; k < D; ++k) { const double v = x[(size_t)t * D + k]; ss += v * v; dot += v * gain[k] * gla_w_in[(size_t)k * GLA_INW + PROJW + c]; }
        rep(w, gz[(size_t)t * 16 + c], dot / sqrt(ss / D + 1e-6), 1.0); }
}
__global__ void ck_gemm(const bf16_t* A, const bf16_t* Bt, const bf16_t* C, int M, int N, int K, int ldc, double scale, unsigned* w) {
    for (unsigned i = GTID; i < 16384u; i += GSTR) { const unsigned r = hsh(i * 19u + 11u), r2 = hsh(i * 23u + 1u); const int m = r % (unsigned)M, n = r2 % (unsigned)N;
        double s = 0; for (int k = 0; k < K; ++k) s += bfd(A[(size_t)m * K + k]) * bfd(Bt[(size_t)n * K + k]);
        rep(w, bfd(C[(size_t)m * ldc + n]), s, scale); }
}
__global__ void ck_proj(const bf16_t* A, const bf16_t* Bt, const bf16_t* proj, int layer, unsigned* w) {
    for (unsigned i = GTID; i < 16384u; i += GSTR) { const unsigned r = hsh(i * 19u + 11u), r2 = hsh(i * 23u + 1u); const int m = r % (unsigned)T, n = r2 % (unsigned)PROJW, b = m >> 14, t = m & (SEQ - 1);
        double s = 0; for (int k = 0; k < D; ++k) s += bfd(A[(size_t)m * D + k]) * bfd(Bt[(size_t)n * D + k]);
        size_t off;
        if (layer == 0) { if (n < 1024) off = gq_off(b, t, n >> 8) + (n & 255); else if (n < 2048) off = GK0 + gq_off(b, t, (n - 1024) >> 8) + (n & 255); else if (n < 4096) off = gv_off(b, t, (n - 2048) >> 9) + (n & 511); else off = GR0 + (size_t)m * 2048 + (n - 4096); }
        else { if (n < 2048) off = dq_off(b, t, n >> 8, (n >> 7) & 1) + (n & 127); else if (n < 4096) off = DK0 + dq_off(b, t, (n - 2048) >> 8, (n >> 7) & 1) + (n & 127); else off = dv_off(b, t, (n - 4096) >> 8) + (n & 255); }
        rep(w, bfd(proj[off]), s, 1.0); }
}
__device__ inline int srow(int i) { return (int)(hsh(i * 29u + 13u) % (unsigned)T); }
__global__ void ck_save(const float* x, float* save) { for (unsigned i = GTID; i < (unsigned)NSAVE * D; i += GSTR) save[i] = x[(size_t)srow(i / D) * D + (i % D)]; }
__global__ void ck_gemm_res(const bf16_t* A, const bf16_t* Bt, const float* base, int saved, const float* out, unsigned* w) {
    for (unsigned i = GTID; i < (unsigned)NSAVE * 64u; i += GSTR) { const int si = i / 64, t = srow(si), n = hsh(i * 31u + 5u) % 2048u;
        double s = 0; for (int k = 0; k < D; ++k) s += bfd(A[(size_t)t * D + k]) * bfd(Bt[(size_t)n * D + k]);
        const double b = saved ? base[(size_t)si * D + n] : base[(size_t)t * D + n];
        rep(w, out[(size_t)t * D + n], b + s, 1.0); }
}
__global__ void ck_gate(const float* gz, const float* wgu, const float* bg, const bf16_t* proj, const bf16_t* kdT, const float* adec, unsigned* w) {
    for (unsigned i = GTID; i < 4096u; i += GSTR) { const unsigned r = hsh(i * 37u + 3u); const int bc = r % 512u, j = (r >> 9) % 1024u, tq = (r >> 19) % 64u;
        double run = 0, ct = 0;
        for (int t = 0; t < 64; ++t) { double z = bg[j]; for (int q = 0; q < 16; ++q) z += (double)gz[((size_t)bc * 64 + t) * 16 + q] * wgu[q * 1024 + j];
            const double ls = fmin(z, 0.0) - log1p(exp(-fabs(z))); run += ls / 16.0; if (t == tq) ct = run; }
        rep(w, adec[(size_t)bc * 1024 + j], exp(run), 1.0);
        rep(w, bfd(kdT[((size_t)bc * 1024 + j) * 64 + tq]), bfd(proj[GK0 + gq_off(bc >> 8, (bc & 255) * 64 + tq, j >> 8) + (j & 255)]) * exp(run - ct), 1.0); }
}
__global__ void ck_scan(const bf16_t* proj, const bf16_t* kdT, const float* adec, const bf16_t* o, unsigned* w) {
    const int wv = GTID / 64, lane = threadIdx.x & 63, nw = GSTR / 64;
    const int cl[8] = {0, 1, 3, 17, 100, 255, 2, 64};
    for (int s = wv; s < 96; s += nw) { const unsigned r = hsh(s * 41u + 17u); const int b = r & 1, c = cl[s % 8], tl = (r >> 1) % 64u, h = (r >> 7) % 4u, vc = (r >> 9) % 512u;
        float S[4] = {0.f, 0.f, 0.f, 0.f};
        for (int cc = 0; cc <= c; ++cc) { const size_t bc = (size_t)b * NCH + cc;
            for (int q = 0; q < 4; ++q) { const int kr = h * 256 + lane * 4 + q; float a = 0.f;
                for (int t = 0; t < 64; ++t) a += bf2f(kdT[(bc * 1024 + kr) * 64 + t]) * bf2f(proj[gv_off(b, cc * 64 + t, h) + vc]);
                S[q] = adec[bc * 1024 + kr] * S[q] + a; } }
        float part = 0.f; const size_t tok = (size_t)b * SEQ + c * 64 + tl;
        for (int q = 0; q < 4; ++q) part += bf2f(proj[gq_off(b, c * 64 + tl, h) + lane * 4 + q]) * S[q];
        for (int of = 1; of < 64; of <<= 1) part += __shfl_xor(part, of);
        if (lane == 0) rep(w, bfd(o[tok * D + h * 512 + vc]), part / 16.0, 2.0); }
}
__global__ void ck_gnorm(const bf16_t* o, const bf16_t* proj, const float* gn, const bf16_t* y, unsigned* w) {
    for (unsigned i = GTID; i < 8192u; i += GSTR) { const unsigned r = hsh(i * 43u + 19u); const int t = r % (unsigned)T, h = (r >> 15) % 4u, j = (r >> 17) % 512u;
        double ss = 0; for (int k = 0; k < 512; ++k) { const double v = bfd(o[(size_t)t * D + h * 512 + k]); ss += v * v; }
        const double rr = bfd(proj[GR0 + (size_t)t * 2048 + h * 512 + j]);
        rep(w, bfd(y[(size_t)t * D + h * 512 + j]), bfd(o[(size_t)t * D + h * 512 + j]) / sqrt(ss / 512 + 1e-6) * gn[j] * rr / (1.0 + exp(-rr)), 1.0); }
}
__global__ void ck_route(const float* x, const float* gain, const float* wgrp, const float* wexp, const int* tok_e, const int* tok_p, const float* tok_w, const unsigned* cnt, unsigned* w) {
    for (unsigned i = GTID; i < 512u; i += GSTR) { const int t = hsh(i * 47u + 23u) % (unsigned)T;
        double ss = 0; for (int k = 0; k < D; ++k) { const double v = x[(size_t)t * D + k]; ss += v * v; }
        const double rstd = 1.0 / sqrt(ss / D + 1e-6);
        double gl[4] = {0, 0, 0, 0};
        for (int k = 0; k < D; ++k) { const double v = x[(size_t)t * D + k] * rstd * gain[k]; for (int q = 0; q < 4; ++q) gl[q] += v * wgrp[k * 4 + q]; }
        int gi = 0; for (int q = 1; q < 4; ++q) if (gl[q] > gl[gi]) gi = q;
        double gs = 0; for (int q = 0; q < 4; ++q) gs += exp(gl[q] - gl[gi]);
        double el[8] = {0, 0, 0, 0, 0, 0, 0, 0};
        for (int k = 0; k < D; ++k) { const double v = x[(size_t)t * D + k] * rstd * gain[k]; for (int q = 0; q < 8; ++q) el[q] += v * wexp[k * 32 + gi * 8 + q]; }
        int i1 = 0; for (int q = 1; q < 8; ++q) if (el[q] > el[i1]) i1 = q;
        int i2 = (i1 == 0) ? 1 : 0; for (int q = 0; q < 8; ++q) if (q != i1 && el[q] > el[i2]) i2 = q;
        const double eb = exp(el[i2] - el[i1]);
        const int e1 = tok_e[2 * t], e2 = tok_e[2 * t + 1];
        double third = -1e30; for (int q = 0; q < 8; ++q) if (q != i1 && q != i2 && el[q] > third) third = el[q];
        const bool tie = (el[i2] - third) < 1e-4 || (el[i1] - el[i2]) < 1e-4;
        if (!tie) { rep(w, e1, gi * 8 + i1, 1.0); rep(w, e2, gi * 8 + i2, 1.0);
            rep(w, tok_w[2 * t], 1.0 / gs / (1.0 + eb), 0.3); rep(w, tok_w[2 * t + 1], eb / gs / (1.0 + eb), 0.3); }
        if ((unsigned)tok_p[2 * t] >= cnt[64 * (e1 & 31)] || (unsigned)tok_p[2 * t + 1] >= cnt[64 * (e2 & 31)]) rep(w, 9.0, 0.0, 1.0); }
}
__global__ void ck_gather(const int* tok_e, const int* tok_p, const int* slot_of, const unsigned* cnt, const bf16_t* hn, const int* ag  , unsigned* w) {
    for (unsigned i = GTID; i < 8192u; i += GSTR) { const unsigned r = hsh(i * 53u + 29u); const int a = r % (2u * T), k = (r >> 16) % 2048u, e = tok_e[a] & 31;
        int ps = 0; for (int q = 0; q < e; ++q) ps += ((int)cnt[64 * q] + 255) & ~255;
        const int slot = slot_of[a];
        rep(w, slot, ps + tok_p[a], 1.0);
        if (slot >= 0 && slot < MAX_TILES * 256) rep(w, (double)ag[slot], (double)(a >> 1), 1.0); (void)hn; (void)k; }
}
__global__ void ck_moe1(const int* tok_e, const int* slot_of, const bf16_t* ag, const float* wg, const float* wu, const bf16_t* hh, unsigned* w) {
    for (unsigned i = GTID; i < 8192u; i += GSTR) { const unsigned r = hsh(i * 59u + 31u); const int a = r % (2u * T), f = (r >> 16) % 512u, e = tok_e[a] & 31, slot = slot_of[a];
        if (slot < 0 || slot >= MAX_TILES * 256) { rep(w, 9.0, 0.0, 1.0); continue; }
        double g = 0, u = 0; for (int k = 0; k < D; ++k) { const double v = bfd(ag[(size_t)(a >> 1) * D + k]); g += v * wg[((size_t)e * D + k) * DFF + f]; u += v * wu[((size_t)e * D + k) * DFF + f]; }
        rep(w, bfd(hh[(size_t)slot * DFF + f]), g / (1.0 + exp(-g)) * u, 0.5); }
}
__global__ void ck_moe2(const int* tok_e, const int* slot_of, const bf16_t* hh, const float* wd, const bf16_t* ob, unsigned* w) {
    for (unsigned i = GTID; i < 8192u; i += GSTR) { const unsigned r = hsh(i * 61u + 37u); const int a = r % (2u * T), n = (r >> 16) % 2048u, e = tok_e[a] & 31, slot = slot_of[a];
        if (slot < 0 || slot >= MAX_TILES * 256) { rep(w, 9.0, 0.0, 1.0); continue; }
        double s = 0; for (int f = 0; f < DFF; ++f) s += bfd(hh[(size_t)slot * DFF + f]) * wd[((size_t)e * DFF + f) * D + n];
        rep(w, bfd(ob[(size_t)slot * D + n]), s, 0.3); }
}
__global__ void ck_combine(const float* save, const bf16_t* ob, const int* slot_of, const float* tok_w, const float* gain, const float* x, const bf16_t* hn, int mode, unsigned* w) {
    for (unsigned i = GTID; i < (unsigned)NSAVE * 32u; i += GSTR) { const int si = i / 32, t = srow(si), j = hsh(i * 67u + 41u) % 2048u;
        const int s0 = slot_of[2 * t], s1 = slot_of[2 * t + 1]; const double w0 = tok_w[2 * t], w1 = tok_w[2 * t + 1];
        double ss = 0, xj = 0; for (int k = 0; k < D; ++k) { const double v = save[(size_t)si * D + k] + w0 * bfd(ob[(size_t)s0 * D + k]) + w1 * bfd(ob[(size_t)s1 * D + k]); ss += v * v; if (k == j) xj = v; }
        const double y = xj / sqrt(ss / D + 1e-6) * gain[j];
        if (mode == 0) { rep(w, x[(size_t)t * D + j], xj, 1.0); rep(w, bfd(hn[(size_t)t * D + j]), y, 1.0); } else rep(w, x[(size_t)t * D + j], y, 1.0); }
}
__global__ void ck_attn(const bf16_t* proj, const bf16_t* o1, const bf16_t* o2, unsigned* w) {
    const int wv = GTID / 64, lane = threadIdx.x & 63, nw = GSTR / 64;
    const int tl[12] = {0, 1, 63, 64, 100, 255, 256, 1000, 4095, 8191, 16320, 16383};
    for (int s = wv; s < 96; s += nw) { const unsigned r = hsh(s * 71u + 43u); const int b = r & 1, h = (r >> 1) % 8u, sub = (r >> 4) & 1, t = tl[s % 12], dv0 = (r >> 5) % 253u;
        const double slope = exp2(-(double)(h + 1)); const int kend = 64 * (t / 64 + 1);
        const bf16_t* qp = proj + dq_off(b, t, h, sub);
        double mx = -1e300;
        for (int j = lane; j < kend; j += 64) { const bf16_t* kp = proj + DK0 + dq_off(b, j, h, sub); double d = 0; for (int q = 0; q < 128; ++q) d += bfd(qp[q]) * bfd(kp[q]);
            const double sc = d * 0.08838834764831845 - slope * fabs((double)(t - j)); if (sc > mx) mx = sc; }
        for (int of = 1; of < 64; of <<= 1) { const double o_ = __shfl_xor(mx, of); if (o_ > mx) mx = o_; }
        double l = 0, acc[4] = {0, 0, 0, 0};
        for (int j = lane; j < kend; j += 64) { const bf16_t* kp = proj + DK0 + dq_off(b, j, h, sub); double d = 0; for (int q = 0; q < 128; ++q) d += bfd(qp[q]) * bfd(kp[q]);
            const double p = exp(d * 0.08838834764831845 - slope * fabs((double)(t - j)) - mx); l += p;
            const bf16_t* vp = proj + dv_off(b, j, h) + dv0; for (int q = 0; q < 4; ++q) acc[q] += p * bfd(vp[q]); }
        for (int of = 1; of < 64; of <<= 1) { l += __shfl_xor(l, of); for (int q = 0; q < 4; ++q) acc[q] += __shfl_xor(acc[q], of); }
        if (lane == 0) for (int q = 0; q < 4; ++q) rep(w, bfd((sub ? o2 : o1)[((size_t)b * SEQ + t) * D + h * 256 + dv0 + q]), acc[q] / l, 0.2); }
}
__global__ void ck_subln(const bf16_t* o1, const bf16_t* o2, const float* lq1, const float* lk1, const float* lq2, const float* lk2, const float* sg, const bf16_t* y, unsigned* w) {
    double d1 = 0, d2 = 0; for (int k = 0; k < 128; ++k) { d1 += (double)lq1[k] * lk1[k]; d2 += (double)lq2[k] * lk2[k]; }
    const double li = 0.8 - 0.6 * exp(-0.3), lam = exp(d1) - exp(d2) + li;
    for (unsigned i = GTID; i < 8192u; i += GSTR) { const unsigned r = hsh(i * 73u + 47u); const int t = r % (unsigned)T, h = (r >> 15) % 8u, j = (r >> 18) % 256u;
        double ss = 0, dj = 0; for (int k = 0; k < 256; ++k) { const double v = bfd(o1[(size_t)t * D + h * 256 + k]) - lam * bfd(o2[(size_t)t * D + h * 256 + k]); ss += v * v; if (k == j) dj = v; }
        rep(w, bfd(y[(size_t)t * D + h * 256 + j]), dj / sqrt(ss / 256 + 1e-6) * sg[j] * (1.0 - li), 1.0); }
}
__global__ void ck_final(const unsigned* words, int nst, float* out, int n) {
    int val = 0;
    for (int s = 0; s < nst; ++s) { const float e = __uint_as_float(words[s]); if (e >= 0.03125f) { val = 4 * s + (e < 0.25f ? 1 : (e < 4.f ? 2 : 3)); break; } }
    const float c = sqrtf(0.1f * (float)val);
    for (int i = GTID; i < n; i += GSTR) out[i] = c;
}
#endif

extern "C" void kernel_launch(void* const* d_in, const int* in_sizes, int n_in, void* d_out, int out_size, void* d_ws, size_t ws_size, hipStream_t stream) {
    static int grid = 0;
    if (grid == 0) {
        if (n_in != 21 || out_size != T * D || ws_size < WS_END + 2 * MiB) { fprintf(stderr, "kernel_launch: unexpected shapes (n_in %d out %d ws %zu)\n", n_in, out_size, ws_size); grid = -1; return; }
        if (hipFuncSetAttribute((const void*)hybrid_fwd, hipFuncAttributeMaxDynamicSharedMemorySize, LDS_BYTES) != hipSuccess) { fprintf(stderr, "kernel_launch: hipFuncSetAttribute failed\n"); grid = -1; return; }
        int dev = 0, cus = 0, per_cu = 0;
        (void)hipGetDevice(&dev); (void)hipDeviceGetAttribute(&cus, hipDeviceAttributeMultiprocessorCount, dev);
        if (hipOccupancyMaxActiveBlocksPerMultiprocessor(&per_cu, (const void*)hybrid_fwd, NWAVES * 64, LDS_BYTES) != hipSuccess || per_cu < 1) fprintf(stderr, "kernel_launch: occupancy query says %d\n", per_cu);
        (void)hipGetLastError();
        grid = cus > 0 ? cus : 256;
    }
    if (grid < 0) return;
    Args a{};
    for (int i = 0; i < 21; ++i) a.in[i] = (const float*)d_in[i];
    a.out = (float*)d_out; a.ws = (unsigned char*)d_ws; a.upto = 99; a.pad1 = 0;
#if !DIAG
    (void)hipMemsetAsync((char*)d_ws + WS_CTL, 0, CTL_ZERO_BYTES, stream);
    hipLaunchKernelGGL(hybrid_fwd, dim3(grid), dim3(NWAVES * 64), LDS_BYTES, stream, a);
#else
    {
        unsigned char* ws = (unsigned char*)d_ws; const float* const* in = a.in;
        unsigned* words = (unsigned*)(ws + WS_DIAG); float* save = (float*)(ws + WS_DIAG + 65536);
        (void)hipMemsetAsync(words, 0, 65536, stream);
        float* gz = (float*)(ws + WS_GZ); int* tok_e = (int*)(ws + WS_TOKE); int* tok_p = (int*)(ws + WS_TOKP); float* tok_w = (float*)(ws + WS_TOKW); int* slot_of = (int*)(ws + WS_SLOT);
        float* adec = (float*)(ws + WS_ADEC); float* wp_gz = (float*)(ws + WS_WPGZ); float* wp_r0 = (float*)(ws + WS_WPR0); float* wp_r1 = (float*)(ws + WS_WPR1);
        bf16_t* wgi = (bf16_t*)(ws + WS_WGI); bf16_t* wgo = (bf16_t*)(ws + WS_WGO); bf16_t* wdi = (bf16_t*)(ws + WS_WDI); bf16_t* wdo = (bf16_t*)(ws + WS_WDO);
        bf16_t* gu = (bf16_t*)(ws + WS_WMOE); bf16_t* dt = (bf16_t*)(ws + WS_WMOE_D);
        bf16_t* hn = (bf16_t*)(ws + WS_HN); bf16_t* proj = (bf16_t*)(ws + WS_PROJ); bf16_t* buf1 = (bf16_t*)(ws + WS_BUF1); bf16_t* buf2 = (bf16_t*)(ws + WS_BUF2);
        bf16_t* ag = (bf16_t*)(ws + WS_AG); bf16_t* ob = (bf16_t*)(ws + WS_OB); bf16_t* hh = (bf16_t*)(ws + WS_H);
        unsigned* ctl = (unsigned*)(ws + WS_CTL); float* xres = (float*)d_out;
        const size_t L1W = (size_t)NEXP * D * DFF;
        for (int st = 0; st <= 20; ++st) {
            (void)hipMemsetAsync((char*)d_ws + WS_CTL, 0, CTL_ZERO_BYTES, stream);
            a.upto = st;
            hipLaunchKernelGGL(hybrid_fwd, dim3(grid), dim3(NWAVES * 64), LDS_BYTES, stream, a);
            unsigned* w = words + st;
            switch (st) {
            case 0: ck_weights<<<256, 256, 0, stream>>>(in[3], in[7], in[8], in[14], wgi, wgo, wdi, wdo, in[1], in[2], in[15], in[16], wp_gz, wp_r0, wp_r1, w); break;
            case 1: ck_norm<<<64, 64, 0, stream>>>(in[0], in[1], hn, w); ck_gz<<<64, 64, 0, stream>>>(in[0], in[1], in[3], gz, w); break;
            case 2: ck_proj<<<256, 64, 0, stream>>>(hn, wgi, proj, 0, w); break;
            case 3: ck_gate<<<64, 64, 0, stream>>>(gz, in[4], in[5], proj, buf1, adec, w); break;
            case 4: ck_scan<<<96, 64, 0, stream>>>(proj, buf1, adec, buf2, w); ck_moew<<<256, 256, 0, stream>>>(in[17], in[18], in[19], gu, dt, w); break;
            case 5: ck_gnorm<<<128, 64, 0, stream>>>(buf2, proj, in[6], hn, w); break;
            case 6: ck_gemm_res<<<64, 64, 0, stream>>>(hn, wgo, in[0], 0, xres, w); break;
            case 7: ck_norm<<<64, 64, 0, stream>>>(xres, in[2], hn, w); ck_route<<<8, 64, 0, stream>>>(xres, in[2], in[15], in[16], tok_e, tok_p, tok_w, ctl + CW_CNT0, w); break;
            case 8: ck_gather<<<128, 64, 0, stream>>>(tok_e, tok_p, slot_of, ctl + CW_CNT0, hn, (const int*)(ws + WS_STOK), w); break;
            case 9: ck_moe1<<<128, 64, 0, stream>>>(tok_e, slot_of, hn, in[17], in[18], hh, w); break;
            case 10: ck_moe2<<<128, 64, 0, stream>>>(tok_e, slot_of, hh, in[19], ob, w); ck_save<<<64, 256, 0, stream>>>(xres, save); break;
            case 11: ck_combine<<<32, 64, 0, stream>>>(save, ob, slot_of, tok_w, in[1] + D, xres, hn, 0, w); ck_moew<<<256, 256, 0, stream>>>(in[17] + L1W, in[18] + L1W, in[19] + L1W, gu, dt, w); break;
            case 12: ck_proj<<<256, 64, 0, stream>>>(hn, wdi, proj, 1, w); break;
            case 13: ck_attn<<<96, 64, 0, stream>>>(proj, buf1, buf2, w); break;
            case 14: ck_subln<<<128, 64, 0, stream>>>(buf1, buf2, in[9], in[10], in[11], in[12], in[13], hn, w); ck_save<<<64, 256, 0, stream>>>(xres, save); break;
            case 15: ck_gemm_res<<<64, 64, 0, stream>>>(hn, wdo, save, 1, xres, w); break;
            case 16: ck_norm<<<64, 64, 0, stream>>>(xres, in[2] + D, hn, w); ck_route<<<8, 64, 0, stream>>>(xres, in[2] + D, in[15] + (size_t)D * 4, in[16] + (size_t)D * 32, tok_e, tok_p, tok_w, ctl + CW_CNT1, w); break;
            case 17: ck_gather<<<128, 64, 0, stream>>>(tok_e, tok_p, slot_of, ctl + CW_CNT1, hn, (const int*)(ws + WS_STOK), w); break;
            case 18: ck_moe1<<<128, 64, 0, stream>>>(tok_e, slot_of, hn, in[17] + L1W, in[18] + L1W, hh, w); break;
            case 19: ck_moe2<<<128, 64, 0, stream>>>(tok_e, slot_of, hh, in[19] + L1W, ob, w); ck_save<<<64, 256, 0, stream>>>(xres, save); break;
            case 20: ck_combine<<<32, 64, 0, stream>>>(save, ob, slot_of, tok_w, in[20], xres, hn, 1, w); break;
            }
        }
        ck_final<<<1024, 256, 0, stream>>>(words, 21, (float*)d_out, out_size);
    }
#endif
}
```

```cpp
#ifndef DIAG
#define DIAG 0
#endif
#ifndef PROBE
#define PROBE 0
#endif
#ifndef REP_PHASE
#define REP_PHASE -1
#endif
#include <hip/hip_runtime.h>
#include <cstdio>
#include <cstdint>

#define LAS __attribute__((address_space(3)))
#define GAS __attribute__((address_space(1)))
typedef unsigned short bf16_t;
typedef short bf16x8 __attribute__((ext_vector_type(8)));
typedef short s16x4 __attribute__((ext_vector_type(4)));
typedef float f32x4 __attribute__((ext_vector_type(4)));
typedef float f32x2 __attribute__((ext_vector_type(2)));
typedef float f32x16 __attribute__((ext_vector_type(16)));
typedef unsigned u32x4 __attribute__((ext_vector_type(4)));
typedef unsigned u32x2 __attribute__((ext_vector_type(2)));

constexpr int D = 2048, SEQ = 16384, NBATCH = 2, T = NBATCH * SEQ, CHUNK = 64, NCH = SEQ / CHUNK;
constexpr int GLA_H = 4, GLA_DK = 256, GLA_DV = 512, GLA_DKT = 1024, GLA_INW = 6160, PROJW = 6144;
constexpr int DIFF_H = 8;
constexpr int NEXP = 32, DFF = 512;
constexpr float RMS_EPS = 1e-6f;
constexpr float LAMBDA_INIT = 0.35550906759f;
constexpr int MAX_TILES = 288;

constexpr size_t MiB = 1u << 20;
constexpr size_t WS_CTL = 0, CTL_ZERO_BYTES = 1 * MiB;
constexpr size_t WS_GZ = 2 * MiB;
constexpr size_t WS_TOKE = 4 * MiB;
constexpr size_t WS_TOKP = WS_TOKE + 256 * 1024;
constexpr size_t WS_TOKW = WS_TOKP + 256 * 1024;
constexpr size_t WS_SLOT = WS_TOKW + 256 * 1024;
constexpr size_t WS_STOK = 5 * MiB;
constexpr size_t WS_ADEC = 8 * MiB;
constexpr size_t WS_WPGZ = 10 * MiB;
constexpr size_t WS_WPR0 = 10 * MiB + 256 * 1024;
constexpr size_t WS_WPR1 = 11 * MiB;
constexpr size_t WS_NRM = 12 * MiB;
constexpr size_t WS_PCUM = 13 * MiB;
constexpr size_t WS_SFIN = 14 * MiB;
constexpr size_t WS_WGI = 16 * MiB, WS_WGO = 40 * MiB, WS_WDI = 48 * MiB, WS_WDO = 72 * MiB;
constexpr size_t WS_WMOE = 80 * MiB;
constexpr size_t WS_WMOE_D = WS_WMOE + 128 * MiB;
constexpr size_t WS_HN = 272 * MiB;
constexpr size_t WS_PROJ = 400 * MiB;
constexpr size_t WS_BUF1 = 784 * MiB;
constexpr size_t WS_BUF2 = 912 * MiB;
constexpr size_t WS_AG = 400 * MiB;
constexpr size_t WS_OB = 688 * MiB;
constexpr size_t WS_H = 976 * MiB;
constexpr size_t WS_END = 1048 * MiB;
constexpr int CW_BAR = 4096;
constexpr int CW_PROBE = 8320;
constexpr int CW_QUEUE = 8192;
constexpr int CW_CNT0 = 16384, CW_CNT1 = 16384 + 32 * 64;


constexpr size_t GK0 = (size_t)T * 1024, GV0 = (size_t)T * 2048, GR0 = (size_t)T * 4096;
constexpr size_t DK0 = (size_t)T * 2048, DV0 = (size_t)T * 4096;
__host__ __device__ __forceinline__ size_t gq_off(int b, int t, int h) { return ((size_t)(b * 4 + h) * SEQ + t) * 256; }
__host__ __device__ __forceinline__ size_t gv_off(int b, int t, int h) { return GV0 + ((size_t)(b * 4 + h) * SEQ + t) * 512; }
__host__ __device__ __forceinline__ size_t dq_off(int b, int t, int h, int sub) { return ((size_t)((b * 8 + h) * 2 + sub) * SEQ + t) * 128; }
__host__ __device__ __forceinline__ size_t dv_off(int b, int t, int h) { return DV0 + ((size_t)(b * 8 + h) * SEQ + t) * 256; }

constexpr int RING_BYTES = 131072;
constexpr int LDSCTL_OFF = RING_BYTES;
constexpr int MISC_OFF = LDSCTL_OFF + 320;
constexpr int TIDS_OFF = LDSCTL_OFF + 8192;
constexpr int TAB_OFF = LDSCTL_OFF + 1024;
constexpr int LDS_BYTES = 147456;
constexpr int NWAVES = 8;

typedef __bf16 bf16x2_t __attribute__((ext_vector_type(2)));
__device__ __forceinline__ unsigned cvt_pk_bf16(float lo, float hi) { const f32x2 v = {lo, hi}; return __builtin_bit_cast(unsigned, __builtin_convertvector(v, bf16x2_t)); }
__device__ __forceinline__ unsigned cvt4_fp8(float a, float b, float c, float d) { int v = __builtin_amdgcn_cvt_pk_fp8_f32(a, b, 0, false); return (unsigned)__builtin_amdgcn_cvt_pk_fp8_f32(c, d, v, true); }
constexpr float W8_SCALE = 64.f;
__device__ __forceinline__ float bf_lo(unsigned w) { return __uint_as_float(w << 16); }
__device__ __forceinline__ float bf_hi(unsigned w) { return __uint_as_float(w & 0xffff0000u); }
__device__ __forceinline__ float bf2f(bf16_t b) { return __uint_as_float(((unsigned)b) << 16); }
__device__ __forceinline__ float wave_sum(float v) {
#pragma unroll
    for (int o = 1; o < 64; o <<= 1) v += __shfl_xor(v, o);
    return v;
}
__device__ __forceinline__ int lane_id() { return (int)__builtin_amdgcn_mbcnt_hi(~0u, __builtin_amdgcn_mbcnt_lo(~0u, 0u)); }
__device__ __forceinline__ int lane_id_volatile() { int l; asm volatile("v_mbcnt_lo_u32_b32 %0, -1, 0\n\tv_mbcnt_hi_u32_b32 %0, -1, %0" : "=v"(l)); return l; }
__device__ __forceinline__ int opq(int v) { asm volatile("" : "+v"(v)); return v; }
#define LDS_WAIT() asm volatile("s_waitcnt lgkmcnt(0)" ::: "memory")
#define VM_WAIT() asm volatile("s_waitcnt vmcnt(0)" ::: "memory")
#define WG_BAR() do { asm volatile("s_waitcnt lgkmcnt(0)" ::: "memory"); __builtin_amdgcn_s_barrier(); asm volatile("" ::: "memory"); } while (0)

namespace pg8 {
constexpr int BM = 256, BK = 64, HALF = 128, HTB = HALF * BK * 2, STAGE_BYTES = 8 * HTB, NXCD = 8, WGM = 8;
__host__ __device__ __forceinline__ int lds_byte(int r, int c) { const int st = (r >> 4) * 2 + (c >> 5), rr = r & 15, cc = c & 31, ob = rr * 64 + cc * 2; return st * 1024 + (ob ^ (((ob >> 9) & 1) << 5)); }
__host__ __device__ __forceinline__ void stage_rc(int b, int& R, int& C) { const int st = b / 1024, sb = b % 1024, swz = sb ^ (((sb >> 9) & 1) << 5); R = (st >> 1) * 16 + swz / 64; C = (st & 1) * 32 + (swz % 64) / 2; }
__host__ __device__ __forceinline__ int perm32(int rho) { const int n = rho >> 4, i = rho & 15; return 8 * (i >> 2) + 4 * n + (i & 3); }

struct Unit { int pm, pn; };
struct Gemm { const bf16_t* A; const bf16_t* Bt; int M, N, K; };

struct StaticOrder {
    int nM, nN, nwg, G, c;
    __device__ void init(int M, int N, int G_, int c_) { nM = M / BM; nN = N / BM; nwg = nM * nN; G = G_; c = c_; }
    __device__ bool next(int i, Unit& u) const {
        const long L = (long)i * G + c; if (L >= nwg) return false;
        int wgid = (int)L; { const int q = nwg / NXCD, r = nwg % NXCD, xcd = wgid % NXCD, off = wgid / NXCD; wgid = (xcd < r ? xcd * (q + 1) : r * (q + 1) + (xcd - r) * q) + off; }
        const int nig = WGM * nN, gid = wgid / nig, fm = gid * WGM, gsz = (nM - fm) < WGM ? (nM - fm) : WGM;
        u.pm = fm + ((wgid % nig) % gsz); u.pn = (wgid % nig) / gsz; return true;
    }
    __device__ __forceinline__ size_t bofs(const Unit&) const { return 0; }
};
struct MoeOrder : StaticOrder {
    const LAS int* te; size_t estride; const int* stok;
    __device__ __forceinline__ size_t bofs(const Unit& u) const { return (size_t)te[u.pm] * estride; }
    __device__ __forceinline__ int arow(int pm, int r) const { const int t = stok[pm * BM + r]; return t < 0 ? 0 : t; }
};

struct EpiBf16 {
    static constexpr bool PERM = true;
    bf16_t* O; int ldc;
    __device__ __forceinline__ void operator()(const f32x4 (&acc)[2][2][4][2], const Unit& u, int wr, int wc, int fr, int fq) const {
        const int row0 = u.pm * BM + wr * 64 + fr, col0 = u.pn * BM + wc * 32 + 8 * fq;
#pragma unroll
        for (int ai = 0; ai < 2; ++ai)
#pragma unroll
            for (int m = 0; m < 4; ++m) { bf16_t* rowp = O + (size_t)(row0 + ai * HALF + m * 16) * ldc + col0;
#pragma unroll
                for (int bj = 0; bj < 2; ++bj) { const f32x4 v0 = acc[ai][bj][m][0], v1 = acc[ai][bj][m][1];
                    u32x4 w; w.x = cvt_pk_bf16(v0[0], v0[1]); w.y = cvt_pk_bf16(v0[2], v0[3]); w.z = cvt_pk_bf16(v1[0], v1[1]); w.w = cvt_pk_bf16(v1[2], v1[3]);
                    *(u32x4*)(rowp + bj * HALF) = w; } }
    }
};
template <int LAYER> struct EpiHeads {
    static constexpr bool PERM = true;
    bf16_t* O;
    __device__ __forceinline__ void operator()(const f32x4 (&acc)[2][2][4][2], const Unit& u, int wr, int wc, int fr, int fq) const {
        const int pn = u.pn, lc = wc * 32 + 8 * fq;
#pragma unroll
        for (int ai = 0; ai < 2; ++ai)
#pragma unroll
            for (int m = 0; m < 4; ++m) { const int row = u.pm * BM + ai * HALF + wr * 64 + m * 16 + fr, b = row >> 14, t = row & (SEQ - 1);
#pragma unroll
                for (int bj = 0; bj < 2; ++bj) { size_t off;
                    if (LAYER == 0) { if (pn < 4) off = gq_off(b, t, pn) + bj * 128 + lc; else if (pn < 8) off = GK0 + gq_off(b, t, pn - 4) + bj * 128 + lc;
                                      else if (pn < 16) off = gv_off(b, t, (pn - 8) >> 1) + ((pn - 8) & 1) * 256 + bj * 128 + lc; else off = GR0 + (size_t)row * 2048 + (pn - 16) * 256 + bj * 128 + lc; }
                    else { if (pn < 8) off = dq_off(b, t, pn, bj) + lc; else if (pn < 16) off = DK0 + dq_off(b, t, pn - 8, bj) + lc; else off = dv_off(b, t, pn - 16) + bj * 128 + lc; }
                    const f32x4 v0 = acc[ai][bj][m][0], v1 = acc[ai][bj][m][1];
                    u32x4 w; w.x = cvt_pk_bf16(v0[0], v0[1]); w.y = cvt_pk_bf16(v0[2], v0[3]); w.z = cvt_pk_bf16(v1[0], v1[1]); w.w = cvt_pk_bf16(v1[2], v1[3]);
                    *(u32x4*)(O + off) = w; } }
    }
};
struct FixOrder : StaticOrder {
    __device__ __forceinline__ size_t bofs(const Unit& u) const { return (size_t)(u.pm >> 5) * (512 * 256 * 2); }
};
struct EpiAddO {
    static constexpr bool PERM = true;
    bf16_t* O;
    __device__ __forceinline__ void operator()(const f32x4 (&acc)[2][2][4][2], const Unit& u, int wr, int wc, int fr, int fq) const {
#pragma unroll
        for (int ai = 0; ai < 2; ++ai)
#pragma unroll
            for (int m = 0; m < 4; ++m) { const int row = u.pm * BM + ai * HALF + wr * 64 + m * 16 + fr, bhh = row >> 13, t = row & 8191;
                bf16_t* rowp = O + ((size_t)(bhh >> 2) * SEQ + SEQ / 2 + t) * D + (bhh & 3) * 512 + u.pn * BM + wc * 32 + 8 * fq;
#pragma unroll
                for (int bj = 0; bj < 2; ++bj) { const u32x4 old = *(const u32x4*)(rowp + bj * HALF); const f32x4 v0 = acc[ai][bj][m][0] * 0.0625f, v1 = acc[ai][bj][m][1] * 0.0625f;
                    u32x4 w; w.x = cvt_pk_bf16(bf_lo(old.x) + v0[0], bf_hi(old.x) + v0[1]); w.y = cvt_pk_bf16(bf_lo(old.y) + v0[2], bf_hi(old.y) + v0[3]);
                    w.z = cvt_pk_bf16(bf_lo(old.z) + v1[0], bf_hi(old.z) + v1[1]); w.w = cvt_pk_bf16(bf_lo(old.w) + v1[2], bf_hi(old.w) + v1[3]);
                    *(u32x4*)(rowp + bj * HALF) = w; } }
    }
};
struct EpiResF32 {
    static constexpr bool PERM = false;
    const float* base; float* C; int ldc;
    __device__ __forceinline__ void operator()(const f32x4 (&acc)[2][2][4][2], const Unit& u, int wr, int wc, int fr, int fq) const {
        const int row0 = u.pm * BM + wr * 64 + fr, col0 = u.pn * BM + wc * 32 + 4 * fq;
#pragma unroll
        for (int ai = 0; ai < 2; ++ai)
#pragma unroll
            for (int m = 0; m < 4; ++m) { const size_t off = (size_t)(row0 + ai * HALF + m * 16) * ldc + col0;
#pragma unroll
                for (int bj = 0; bj < 2; ++bj)
#pragma unroll
                    for (int n = 0; n < 2; ++n) { const f32x4 bs = *(const f32x4*)(base + off + bj * HALF + n * 16); *(f32x4*)(C + off + bj * HALF + n * 16) = bs + acc[ai][bj][m][n]; }
                asm volatile("" ::: "memory"); }
    }
};
struct EpiSiluMul {
    static constexpr bool PERM = true;
    unsigned char* Hh;
    __device__ __forceinline__ void operator()(const f32x4 (&acc)[2][2][4][2], const Unit& u, int wr, int wc, int fr, int fq) const {
        const int row0 = u.pm * BM + wr * 64 + fr, col0 = u.pn * HALF + wc * 32 + 8 * fq;
#pragma unroll
        for (int ai = 0; ai < 2; ++ai)
#pragma unroll
            for (int m = 0; m < 4; ++m) { unsigned char* rowp = Hh + (size_t)(row0 + ai * HALF + m * 16) * DFF + col0;
                float hv[8];
#pragma unroll
                for (int n = 0; n < 2; ++n)
#pragma unroll
                    for (int j = 0; j < 4; ++j) { const float g = acc[ai][0][m][n][j], up = acc[ai][1][m][n][j];
                        const float sg = g * __builtin_amdgcn_rcpf(1.0f + __builtin_amdgcn_exp2f(-1.4426950408889634f * g)); hv[n * 4 + j] = sg * up; }
                u32x2 w; w.x = cvt4_fp8(hv[0], hv[1], hv[2], hv[3]); w.y = cvt4_fp8(hv[4], hv[5], hv[6], hv[7]);
                *(u32x2*)rowp = w; }
    }
};

typedef int v8i32 __attribute__((ext_vector_type(8)));
typedef int v4i32 __attribute__((ext_vector_type(4)));
template <class Epi, class Sched, bool GATHER = false, bool FP8 = false>
__device__ __forceinline__ void gemm_phase(LAS unsigned char* lds, const Gemm g, const Sched& S, const Epi& E, int tid_in) {
    const int tid = opq(tid_in), wid = __builtin_amdgcn_readfirstlane(tid >> 6), lane = tid & 63, wr = wid >> 2, wc = wid & 3, fr = lane & 15, fq = lane >> 4;
    const int K = g.K, RP = FP8 ? K : 2 * K  , nt = RP / (BK * 2);
    unsigned voffA[2], voffB[2];
#pragma unroll
    for (int i = 0; i < 2; ++i) { int R, C; stage_rc(tid * 16 + i * 8192, R, C); const int Rb = Epi::PERM ? ((R & ~31) + perm32(R & 31)) : R;
        voffA[i] = (unsigned)(R * RP + 2 * C); voffB[i] = (unsigned)(Rb * RP + 2 * C); }
    const unsigned kstep = (unsigned)(BK * 2);
    const unsigned hstep = (unsigned)HALF * (unsigned)RP;
    const size_t tstep = 2 * (size_t)hstep;
    const unsigned ldsw = (unsigned)wid * 1024u;
    const int aoff = lds_byte(wr * 64 + fr, fq * 8), boff = lds_byte(wc * 32 + fr, fq * 8);
    const LAS unsigned char* ldsB = lds + 4 * HTB + boff;
#define PG8_SA(b, h) (((b) * 2 + (h)) * HTB)
#define PG8_SB(b, h) ((4 + (b) * 2 + (h)) * HTB)
#define PG8_STAGE(bufoff, gbase, voff) do { const unsigned long long gv_ = (unsigned long long)(gbase); \
        const unsigned glo_ = (unsigned)__builtin_amdgcn_readfirstlane((unsigned)gv_), ghi_ = (unsigned)__builtin_amdgcn_readfirstlane((unsigned)(gv_ >> 32)); const char* gb_ = (const char*)(((unsigned long long)ghi_ << 32) | (unsigned long long)glo_);     \
        _Pragma("unroll") for (int _i = 0; _i < 2; ++_i) \
        __builtin_amdgcn_global_load_lds((const unsigned*)(gb_ + (voff)[_i]), (LAS unsigned*)(lds + (bufoff) + ldsw + _i * 8192), 16, 0, 0); } while (0)
#define PG8_STAGE_A(bufoff, nx, koff, h) do { if constexpr (GATHER) { unsigned vs_[2]; _Pragma("unroll") for (int _i = 0; _i < 2; ++_i) vs_[_i] = (nx) ? vAn[h][_i] : vAc[h][_i]; \
            PG8_STAGE(bufoff, (const char*)g.A + (koff), vs_); } \
        else { PG8_STAGE(bufoff, ((nx) ? nA : cA) + (koff) + (h) * hstep, voffA); } } while (0)
#define PG8_LD8(off) __builtin_shufflevector(*(const LAS v4i32*)(lds + (off)), *(const LAS v4i32*)(lds + (off) + 1024), 0, 1, 2, 3, 4, 5, 6, 7)
#define PG8_LDA(dst, b, h) do { if constexpr (FP8) { _Pragma("unroll") for (int m = 0; m < 4; ++m) dst##8[m] = PG8_LD8(PG8_SA(b, h) + aoff + m * 2048); } \
        else { _Pragma("unroll") for (int m = 0; m < 4; ++m) _Pragma("unroll") for (int k = 0; k < 2; ++k) dst[m][k] = *(const LAS bf16x8*)(lds + PG8_SA(b, h) + aoff + m * 2048 + k * 1024); } } while (0)
#define PG8_LD8B(off) __builtin_shufflevector(*(const LAS v4i32*)(ldsB + (off)), *(const LAS v4i32*)(ldsB + (off) + 1024), 0, 1, 2, 3, 4, 5, 6, 7)
#define PG8_LDB(dst, b, h) do { if constexpr (FP8) { _Pragma("unroll") for (int n = 0; n < 2; ++n) dst##8[n] = PG8_LD8B(PG8_SA(b, h) + n * 2048); }     \
        else { _Pragma("unroll") for (int n = 0; n < 2; ++n) _Pragma("unroll") for (int k = 0; k < 2; ++k) dst[n][k] = *(const LAS bf16x8*)(lds + PG8_SB(b, h) + boff + n * 2048 + k * 1024); } } while (0)
#define PG8_MMA(ai, bj, At, Bt) do { __builtin_amdgcn_s_setprio(1); if constexpr (FP8) { _Pragma("unroll") for (int m = 0; m < 4; ++m) _Pragma("unroll") for (int n = 0; n < 2; ++n) \
              \
            asm volatile("v_mfma_scale_f32_16x16x128_f8f6f4 %0, %1, %2, %0, %3, %3 op_sel:[0,1,0] op_sel_hi:[0,0,0]" : "+v"(acc[ai][bj][m][n]) : "v"(Bt##8[n]), "v"(At##8[m]), "v"(scl8)); } \
        else { _Pragma("unroll") for (int m = 0; m < 4; ++m) _Pragma("unroll") for (int n = 0; n < 2; ++n) _Pragma("unroll") for (int k = 0; k < 2; ++k) \
            acc[ai][bj][m][n] = __builtin_amdgcn_mfma_f32_16x16x32_bf16(Bt[n][k], At[m][k], acc[ai][bj][m][n], 0, 0, 0); } __builtin_amdgcn_s_setprio(0); } while (0)
#define PG8_WAIT_V(n) asm volatile("s_waitcnt vmcnt(" #n ")" ::: "memory")
#define PG8_WAIT_L(n) asm volatile("s_waitcnt lgkmcnt(" #n ")" ::: "memory")
#define PG8_BAR __builtin_amdgcn_s_barrier()
#define PG8_SCHED __builtin_amdgcn_sched_barrier(0)
#define PG8_ROWOFFS(V, U) do { if constexpr (GATHER) { const int t_ = opq(wid * 64 + lane_id());     \
        _Pragma("unroll") for (int i_ = 0; i_ < 2; ++i_) { int R_, C_; stage_rc(t_ * 16 + i_ * 8192, R_, C_); \
        _Pragma("unroll") for (int h_ = 0; h_ < 2; ++h_) V[h_][i_] = (unsigned)S.arow((U).pm, h_ * HALF + R_) * (unsigned)RP + 2u * (unsigned)C_; } } } while (0)
    Unit cur, nxt; int ui = 0;
    if (!S.next(0, cur)) return;
    f32x4 acc[2][2][4][2];
#pragma unroll
    for (int a = 0; a < 2; ++a)
#pragma unroll
        for (int b = 0; b < 2; ++b)
#pragma unroll
            for (int m = 0; m < 4; ++m)
#pragma unroll
                for (int n = 0; n < 2; ++n) acc[a][b][m][n] = (f32x4){0.f, 0.f, 0.f, 0.f};
    const unsigned scl8 = 0x7f797f79u;
    bf16x8 At[4][2], B0[2][2], B1[2][2]; v8i32 At8[4], B08[2], B18[2];
    unsigned vAc[2][2] = {{0u, 0u}, {0u, 0u}}, vAn[2][2] = {{0u, 0u}, {0u, 0u}};
    const char* cA = (const char*)g.A + (GATHER ? (size_t)0 : (size_t)cur.pm * tstep); const char* nA = cA; const char* cB = (const char*)g.Bt + S.bofs(cur) + (size_t)cur.pn * tstep;
    PG8_ROWOFFS(vAc, cur);
    PG8_STAGE(PG8_SB(0, 0), cB, voffB); PG8_STAGE(PG8_SB(0, 1), cB + hstep, voffB); PG8_STAGE_A(PG8_SA(0, 0), false, 0u, 0); PG8_STAGE_A(PG8_SA(0, 1), false, 0u, 1);
    if (wr == 1) PG8_BAR;
    PG8_WAIT_V(2); PG8_BAR;
    PG8_STAGE(PG8_SB(1, 0), cB + kstep, voffB); PG8_STAGE_A(PG8_SA(1, 0), false, kstep, 0); PG8_STAGE(PG8_SB(1, 1), cB + hstep + kstep, voffB);
    PG8_WAIT_V(6); PG8_BAR;
    for (;;) {
        const bool has_next = S.next(ui + 1, nxt);
        nA = (has_next && !GATHER) ? (const char*)g.A + (size_t)nxt.pm * tstep : cA; const char* nB = has_next ? (const char*)g.Bt + S.bofs(nxt) + (size_t)nxt.pn * tstep : cB;

        for (int t = 0; t < nt; t += 2) {
            const bool last = (t == nt - 2);
            if constexpr (GATHER) { if (last) {
                if (has_next) PG8_ROWOFFS(vAn, nxt); else { _Pragma("unroll") for (int h_ = 0; h_ < 2; ++h_) _Pragma("unroll") for (int i_ = 0; i_ < 2; ++i_) vAn[h_][i_] = vAc[h_][i_]; } } }
            const unsigned k1 = (unsigned)(t + 1) * kstep, k2 = last ? 0u : (unsigned)(t + 2) * kstep, k3 = k2 + kstep;
            const char* b2 = last ? nB : cB + k2; const char* b3 = b2 + kstep;
            PG8_LDB(B0, 0, 0); PG8_LDB(B1, 0, 1); PG8_SCHED; PG8_LDA(At, 0, 0); PG8_STAGE_A(PG8_SA(1, 1), false, k1, 1);
            PG8_WAIT_V(8); PG8_WAIT_L(0); PG8_BAR; PG8_MMA(0, 0, At, B0); PG8_MMA(0, 1, At, B1); PG8_BAR; PG8_SCHED;
            PG8_LDA(At, 0, 1); PG8_STAGE(PG8_SB(0, 0), b2, voffB); PG8_STAGE(PG8_SB(0, 1), b2 + hstep, voffB); PG8_STAGE_A(PG8_SA(0, 0), last, k2, 0);
            PG8_WAIT_V(8); PG8_WAIT_L(0); PG8_BAR; PG8_MMA(1, 0, At, B0); PG8_MMA(1, 1, At, B1); PG8_BAR; PG8_SCHED;
            PG8_LDB(B0, 1, 0); PG8_LDB(B1, 1, 1); PG8_SCHED; PG8_LDA(At, 1, 0); PG8_STAGE_A(PG8_SA(0, 1), last, k2, 1);
            PG8_WAIT_V(8); PG8_WAIT_L(0); PG8_BAR; PG8_MMA(0, 0, At, B0); PG8_MMA(0, 1, At, B1); PG8_BAR; PG8_SCHED;
            PG8_LDA(At, 1, 1); PG8_STAGE(PG8_SB(1, 0), b3, voffB); PG8_STAGE(PG8_SB(1, 1), b3 + hstep, voffB); PG8_STAGE_A(PG8_SA(1, 0), last, k3, 0);
            PG8_WAIT_V(8); PG8_WAIT_L(0); PG8_BAR; PG8_MMA(1, 0, At, B0); PG8_MMA(1, 1, At, B1); PG8_BAR; PG8_SCHED;
        }
        if (wr == 0) PG8_BAR;
        E(acc, cur, wr, wc, fr, fq);
        if (!has_next) break;
#pragma unroll
        for (int a = 0; a < 2; ++a)
#pragma unroll
            for (int b = 0; b < 2; ++b)
#pragma unroll
                for (int m = 0; m < 4; ++m)
#pragma unroll
                    for (int n = 0; n < 2; ++n) acc[a][b][m][n] = (f32x4){0.f, 0.f, 0.f, 0.f};
        cur = nxt; cA = nA; cB = nB; ++ui;
        if constexpr (GATHER) { _Pragma("unroll") for (int h_ = 0; h_ < 2; ++h_) _Pragma("unroll") for (int i_ = 0; i_ < 2; ++i_) vAc[h_][i_] = vAn[h_][i_]; }
        if (wr == 1) PG8_BAR;
    }
    PG8_WAIT_V(0);
    PG8_BAR;
#undef PG8_SA
#undef PG8_SB
#undef PG8_STAGE
#undef PG8_STAGE_A
#undef PG8_ROWOFFS
#undef PG8_LDA
#undef PG8_LDB
#undef PG8_MMA
#undef PG8_LD8
#undef PG8_LD8B
#undef PG8_WAIT_V
#undef PG8_WAIT_L
#undef PG8_BAR
#undef PG8_SCHED
}
}

#define XB_TMO      128
#define XB_XCNT(j)  (256  + 64 * (j))
#define XB_XSUB(j)  (1280 + 64 * (j))
#define XB_XGEN(j)  (2304 + 64 * (j))
#define XB_TOP      3328
#define XB_TOPGEN   3392
#define XCD_BAR_WORDS 3456
#define XB_SPIN_CAP (1u << 18)
__device__ __forceinline__ unsigned xb_ld(unsigned* p)              { return __hip_atomic_load(p, __ATOMIC_RELAXED, __HIP_MEMORY_SCOPE_AGENT); }
__device__ __forceinline__ unsigned xb_add(unsigned* p, unsigned v) { return __hip_atomic_fetch_add(p, v, __ATOMIC_RELAXED, __HIP_MEMORY_SCOPE_AGENT); }
__device__ __forceinline__ unsigned xb_xcc_id() { return (unsigned)__builtin_amdgcn_s_getreg((3 << 11) | 20) & 0xFu; }
#define XB_SPIN(cond, bar) do { unsigned _sp = 0; while (cond) { __builtin_amdgcn_s_sleep(1); \
    if ((++_sp & 255u) == 0u) { if (xb_ld(&(bar)[XB_TMO])) break; if (_sp > XB_SPIN_CAP) { atomicAdd(&(bar)[XB_TMO], 1u); break; } } } } while (0)
struct XcdBarrier { unsigned* bar; unsigned x; volatile LAS unsigned* st; int wave; };
__device__ __forceinline__ XcdBarrier xcd_barrier_post(unsigned* bar, volatile LAS unsigned* st) {
    XcdBarrier b; b.bar = bar; b.x = xb_xcc_id(); b.st = st; b.wave = __builtin_amdgcn_readfirstlane((int)threadIdx.x >> 6);
    if (threadIdx.x == 0) (void)xb_add(&bar[XB_XCNT(b.x)], 1u);
    return b;
}
__device__ __forceinline__ void xcd_barrier_complete(unsigned* bar, unsigned x, unsigned& nloc, unsigned& nx) {
    const unsigned G = gridDim.x * gridDim.y * gridDim.z;
    unsigned sum, cnt, mine, sp = 0u;
    for (;;) {
        sum = 0u; cnt = 0u; mine = 0u;
#pragma unroll
        for (unsigned j = 0; j < 16; ++j) { const unsigned c = xb_ld(&bar[XB_XCNT(j)]); sum += c; cnt += (c > 0u) ? 1u : 0u; mine = (j == x) ? c : mine; }
        if (sum == G) break;
        __builtin_amdgcn_s_sleep(1);
        if ((++sp & 255u) == 0u) { if (xb_ld(&bar[XB_TMO])) break; if (sp > XB_SPIN_CAP) { atomicAdd(&bar[XB_TMO], 1u); break; } }
    }
    nloc = mine > 0u ? mine : 1u; nx = cnt > 0u ? cnt : 1u;
}
__device__ __forceinline__ void xcd_barrier(const XcdBarrier& b, bool leader  ) {
    asm volatile("s_waitcnt vmcnt(0)" ::: "memory");
    __syncthreads();
    if (leader) {
        unsigned* bar = b.bar;
        __builtin_amdgcn_s_waitcnt(0);
        unsigned nloc = b.st[0], nx = b.st[1];
        if (nloc == 0u) { xcd_barrier_complete(bar, b.x, nloc, nx); b.st[0] = nloc; b.st[1] = nx; }
        const unsigned old = xb_add(&bar[XB_XSUB(b.x)], 1u);
        const unsigned gen = old / nloc;
        if (old + 1u == (gen + 1u) * nloc) {
            __builtin_amdgcn_fence(__ATOMIC_RELEASE, "agent");
            asm volatile("s_waitcnt vmcnt(0)" ::: "memory");
            const unsigned og = xb_add(&bar[XB_TOP], 1u);
            const unsigned tg = og / nx;
            if (og + 1u == (tg + 1u) * nx) xb_add(&bar[XB_TOPGEN], 1u);
            else XB_SPIN(xb_ld(&bar[XB_TOPGEN]) == tg, bar);
            __builtin_amdgcn_fence(__ATOMIC_ACQUIRE, "agent");
            xb_add(&bar[XB_XGEN(b.x)], 1u);
            asm volatile("s_waitcnt vmcnt(0)" ::: "memory");
        } else {
            XB_SPIN(xb_ld(&bar[XB_XGEN(b.x)]) == gen, bar);
            __builtin_amdgcn_fence(__ATOMIC_ACQUIRE, "agent");
            asm volatile("s_waitcnt vmcnt(0)" ::: "memory");
        }
    }
    __syncthreads();
}

struct Frame {
    LAS unsigned char* lds;
    int tid, lane, wave, vcu, G;
};
struct Args {
    const float* in[21]; float* out; unsigned char* ws; int upto, pad1;
};

template <bool FP8 = false>
__device__ __forceinline__ void transpose_item(const float* W, int ldw, int k0, int n0, bf16_t* WT, int ldk, int drow0, LAS float* scr, int lane) {
    float tv[32];
    const float* wp_ = W + (size_t)(k0 + (lane >> 5)) * ldw + n0 + (lane & 31);
#pragma unroll
    for (int i = 0; i < 32; ++i) tv[i] = wp_[(size_t)(2 * i) * ldw];
#pragma unroll
    for (int i = 0; i < 32; ++i) scr[(2 * i + (lane >> 5)) * 33 + (lane & 31)] = tv[i];
    LDS_WAIT(); asm volatile("" ::: "memory");
    const int c = lane & 7;
#pragma unroll
    for (int j = 0; j < 4; ++j) { const int n = (lane >> 3) + 8 * j; const LAS float* s = scr + (8 * c) * 33 + n;
        if constexpr (FP8) { u32x2 o; o.x = cvt4_fp8(s[0 * 33] * W8_SCALE, s[1 * 33] * W8_SCALE, s[2 * 33] * W8_SCALE, s[3 * 33] * W8_SCALE); o.y = cvt4_fp8(s[4 * 33] * W8_SCALE, s[5 * 33] * W8_SCALE, s[6 * 33] * W8_SCALE, s[7 * 33] * W8_SCALE);
            *(u32x2*)((unsigned char*)WT + (size_t)(drow0 + n) * ldk + k0 + 8 * c) = o; }
        else { u32x4 o; o.x = cvt_pk_bf16(s[0 * 33], s[1 * 33]); o.y = cvt_pk_bf16(s[2 * 33], s[3 * 33]); o.z = cvt_pk_bf16(s[4 * 33], s[5 * 33]); o.w = cvt_pk_bf16(s[6 * 33], s[7 * 33]);
            *(u32x4*)(WT + (size_t)(drow0 + n) * ldk + k0 + 8 * c) = o; } }
    LDS_WAIT(); asm volatile("" ::: "memory");
}
template <bool FP8 = false>
__device__ __forceinline__ void conv_plain(Frame& F, const float* W, int K, int N, int ldw, bf16_t* WT) {
    LAS float* scr = (LAS float*)(F.lds + F.wave * 16384);
    const int gw = F.vcu * NWAVES + F.wave, NGW = F.G * NWAVES, nblk = N / 32, nit = (K / 64) * nblk;
    for (int it = gw; it < nit; it += NGW) { const int kb = it / nblk, nb = it % nblk; transpose_item<FP8>(W, ldw, 64 * kb, 32 * nb, WT, K, 32 * nb, scr, F.lane); }
}
__device__ __forceinline__ void conv_moe(Frame& F, const float* wg, const float* wu, const float* wd, bf16_t* GU, bf16_t* DT, int rank = -1, int nrank = 0) {
    LAS float* scr = (LAS float*)(F.lds + F.wave * 16384);
    const int gw = (rank < 0 ? F.vcu : rank) * NWAVES + F.wave, NGW = (rank < 0 ? F.G : nrank) * NWAVES;
    constexpr int PER_E = 1536, NIT = NEXP * PER_E;
    for (int it = gw; it < NIT; it += NGW) {
        const int e = it / PER_E; int r = it % PER_E;
        if (r < 1024) { const int up = r >> 9; r &= 511; const int kb = r >> 4, nb = r & 15, n0 = 32 * nb;
            const int drow = 256 * (n0 >> 7) + 128 * up + (n0 & 127);
            transpose_item<true>((up ? wu : wg) + (size_t)e * D * DFF, DFF, 64 * kb, n0, (bf16_t*)((unsigned char*)GU + (size_t)e * 1024 * D), D, drow, scr, F.lane); }
        else { r -= 1024; const int kb = r >> 6, nb = r & 63;
            transpose_item<true>(wd + (size_t)e * DFF * D, D, 64 * kb, 32 * nb, (bf16_t*)((unsigned char*)DT + (size_t)e * D * DFF), DFF, 32 * nb, scr, F.lane); }
    }
}
__device__ __forceinline__ void pack_proj(Frame& F, float* Wp, int NT, const float* gain, const float* Wa, int lda, int ca0, int na, const float* Wb, int ldb, int nb) {
    const int total = 128 * NT * 256;
    for (int idx = (F.vcu * NWAVES * 64) + F.tid; idx < total; idx += F.G * NWAVES * 64) {
        const int e = idx & 3, ln = (idx >> 2) & 63, rest = idx >> 8, nt = rest % NT, s = rest / NT;
        const int k = 16 * s + 4 * (ln >> 4) + e, col = 16 * nt + (ln & 15);
        float v = 0.f;
        if (col < na) v = Wa[(size_t)k * lda + ca0 + col]; else if (col < na + nb) v = Wb[(size_t)k * ldb + (col - na)];
        Wp[idx] = v * gain[k];
    }
}

template <int NT>
__device__ __forceinline__ float wave_proj16(LAS unsigned char* lds, const float* xin, int tok0, const float* Wp, int tid, int wid, int lane, f32x4 (&acc)[NT]) {
    const int tr = lane & 15, kq = lane >> 4;
    const f32x4* xp = (const f32x4*)(xin + (size_t)(tok0 + tr) * D) + kq;
    constexpr int CH = 16 * NT * 1024;
    const char* wsrc = (const char*)Wp + tid * 16;
    float ssq = 0.f;
#pragma unroll
    for (int n = 0; n < NT; ++n) acc[n] = (f32x4){0.f, 0.f, 0.f, 0.f};
    f32x4 X[16];
#define NP_DMA(c, buf) do { _Pragma("unroll") for (int r = 0; r < 2 * NT; ++r) \
        __builtin_amdgcn_global_load_lds((const unsigned*)(wsrc + (size_t)(c) * CH + r * 8192), (LAS unsigned*)(lds + (buf) * CH + r * 8192 + wid * 1024), 16, 0, 0); } while (0)
#define NP_CHUNK(c, buf, more) do { \
        asm volatile("s_waitcnt vmcnt(16)" ::: "memory"); WG_BAR(); \
        if (more) NP_DMA((c) + 1, 1 - (buf)); \
        asm volatile("" ::: "memory");     \
        const f32x4* xn_ = xp + 64 * ((c) + 1); \
        _Pragma("unroll") for (int s = 0; s < 16; ++s) { const f32x4 xv = X[s]; if (more) X[s] = xn_[4 * s]; \
            ssq += (xv[0] * xv[0] + xv[1] * xv[1]) + (xv[2] * xv[2] + xv[3] * xv[3]); \
            _Pragma("unroll") for (int n = 0; n < NT; ++n) { const f32x4 wv = *(const LAS f32x4*)(lds + (buf) * CH + ((s * NT + n) * 64 + lane) * 16); \
                _Pragma("unroll") for (int e = 0; e < 4; ++e) acc[n] = __builtin_amdgcn_mfma_f32_16x16x4f32(xv[e], wv[e], acc[n], 0, 0, 0); } } } while (0)
    NP_DMA(0, 0);
    asm volatile("" ::: "memory");
#pragma unroll
    for (int s = 0; s < 16; ++s) X[s] = xp[4 * s];
    for (int c = 0; c < 6; c += 2) { NP_CHUNK(c, 0, true); NP_CHUNK(c + 1, 1, true); }
    NP_CHUNK(6, 0, true); NP_CHUNK(7, 1, false);
    WG_BAR();
#undef NP_DMA
#undef NP_CHUNK
    ssq += __shfl_xor(ssq, 16); ssq += __shfl_xor(ssq, 32);
    return 1.0f / sqrtf(ssq * (1.0f / D) + RMS_EPS);
}
template <bool FP8 = false>
__device__ __forceinline__ void wave_write_hn16(const float* xin, int tok0, float rstd, const float* gain, bf16_t* hn, int lane) {
    f32x4 g4[8];
#pragma unroll
    for (int j = 0; j < 8; ++j) g4[j] = ((const f32x4*)gain)[lane + 64 * j];
    for (int i = 0; i < 16; i += 2) {
        const float r0 = __shfl(rstd, i), r1 = __shfl(rstd, i + 1);
        const f32x4* x0 = (const f32x4*)(xin + (size_t)(tok0 + i) * D); const f32x4* x1 = x0 + D / 4;
        u32x2* o0 = (u32x2*)(hn + (size_t)(tok0 + i) * D); u32x2* o1 = o0 + D / 4;
        unsigned* p0 = (unsigned*)((unsigned char*)hn + (size_t)(tok0 + i) * D); unsigned* p1 = p0 + D / 4;
        f32x4 a[8], c[8];
#pragma unroll
        for (int j = 0; j < 8; ++j) { a[j] = x0[lane + 64 * j]; c[j] = x1[lane + 64 * j]; }
#pragma unroll
        for (int j = 0; j < 8; ++j) { const f32x4 v = a[j] * r0 * g4[j], u = c[j] * r1 * g4[j];
            if constexpr (FP8) { p0[lane + 64 * j] = cvt4_fp8(v[0], v[1], v[2], v[3]); p1[lane + 64 * j] = cvt4_fp8(u[0], u[1], u[2], u[3]); }
            else { u32x2 w; w.x = cvt_pk_bf16(v[0], v[1]); w.y = cvt_pk_bf16(v[2], v[3]); o0[lane + 64 * j] = w;
                u32x2 z; z.x = cvt_pk_bf16(u[0], u[1]); z.y = cvt_pk_bf16(u[2], u[3]); o1[lane + 64 * j] = z; } }
    }
}

__device__ __forceinline__ void phase_norm_gz(Frame& F, const float* xin, const float* gain, const float* Wp, bf16_t* hn, float* gz) {
    for (int tile = F.vcu; tile < T / 128; tile += F.G) {
        const int tok0 = tile * 128 + F.wave * 16;
        f32x4 acc[1];
        const float rstd = wave_proj16<1>(F.lds, xin, tok0, Wp, F.tid, F.wave, F.lane, acc);
        const int j = F.lane & 15, q4 = F.lane >> 4;
#pragma unroll
        for (int r = 0; r < 4; ++r) { const float rr = __shfl(rstd, 4 * q4 + r); gz[(size_t)(tok0 + 4 * q4 + r) * 16 + j] = acc[0][r] * rr; }
        wave_write_hn16(xin, tok0, rstd, gain, hn, F.lane);
    }
}
__device__ __forceinline__ void phase_norm_route(Frame& F, const float* xin, const float* gain, const float* Wp, bf16_t* hn, int* tok_e, int* tok_p, float* tok_w, unsigned* cnt) {
    LAS float* lg = (LAS float*)(F.lds + 98304 + F.wave * 3072);
    for (int tile = F.vcu; tile < T / 128; tile += F.G) {
        const int tok0 = tile * 128 + F.wave * 16;
        f32x4 acc[3];
        const float rstd = wave_proj16<3>(F.lds, xin, tok0, Wp, F.tid, F.wave, F.lane, acc);
        const int j = F.lane & 15, q4 = F.lane >> 4;
#pragma unroll
        for (int r = 0; r < 4; ++r) { const float rr = __shfl(rstd, 4 * q4 + r);
#pragma unroll
            for (int n = 0; n < 3; ++n) lg[(4 * q4 + r) * 48 + 16 * n + j] = acc[n][r] * rr; }
        LDS_WAIT(); asm volatile("" ::: "memory");
        if (F.lane < 16) {
            const LAS float* l = lg + F.lane * 48;
            float gm = l[0]; int gi = 0;
#pragma unroll
            for (int q = 1; q < 4; ++q) { const float v = l[q]; if (v > gm) { gm = v; gi = q; } }
            float gs = 0.f;
#pragma unroll
            for (int q = 0; q < 4; ++q) gs += __expf(l[q] - gm);
            const float gw = 1.0f / gs;
            const LAS float* se = l + 4 + 8 * gi;
            float m1 = se[0]; int i1 = 0;
#pragma unroll
            for (int q = 1; q < 8; ++q) { const float v = se[q]; if (v > m1) { m1 = v; i1 = q; } }
            float m2 = -3.0e38f; int i2 = 0;
#pragma unroll
            for (int q = 0; q < 8; ++q) { const float v = se[q]; if (q != i1 && v > m2) { m2 = v; i2 = q; } }
            const float eb = __expf(m2 - m1), inv = 1.0f / (1.0f + eb);
            const int t = tok0 + F.lane, e1 = gi * 8 + i1, e2 = gi * 8 + i2;
            const unsigned p1 = __hip_atomic_fetch_add(cnt + 64 * e1, 1u, __ATOMIC_RELAXED, __HIP_MEMORY_SCOPE_AGENT);
            const unsigned p2 = __hip_atomic_fetch_add(cnt + 64 * e2, 1u, __ATOMIC_RELAXED, __HIP_MEMORY_SCOPE_AGENT);
            tok_e[2 * t] = e1; tok_e[2 * t + 1] = e2; tok_p[2 * t] = (int)p1; tok_p[2 * t + 1] = (int)p2;
            tok_w[2 * t] = gw * inv; tok_w[2 * t + 1] = gw * eb * inv;
        }
        wave_write_hn16<true>(xin, tok0, rstd, gain, hn, F.lane);
        LDS_WAIT(); asm volatile("" ::: "memory");
    }
}

__device__ __forceinline__ void phase_gla_gate(Frame& F, const float* gz, const float* wgu, const float* bgate, const bf16_t* proj, bf16_t* kdT, float* adec) {
    LAS f32x4* gzs = (LAS f32x4*)F.lds;
    for (int u = F.vcu; u < NBATCH * NCH * 2; u += F.G) {
        const int half = u & 1, bc = u >> 1;
        const int tok0 = bc * 64, j = half * 512 + F.tid;
        if (F.tid < 256) gzs[F.tid] = ((const f32x4*)(gz + (size_t)tok0 * 16))[F.tid];
        float wg[16];
#pragma unroll
        for (int r = 0; r < 16; ++r) wg[r] = wgu[r * GLA_DKT + j];
        const float bg = bgate[j];
        WG_BAR();
        float cum[64]; float run = 0.f;
#pragma unroll
        for (int t = 0; t < 64; ++t) {
            float z = bg;
#pragma unroll
            for (int r4 = 0; r4 < 4; ++r4) { const f32x4 g4 = gzs[t * 4 + r4]; z += g4[0] * wg[4 * r4] + g4[1] * wg[4 * r4 + 1] + g4[2] * wg[4 * r4 + 2] + g4[3] * wg[4 * r4 + 3]; }
            const float ls = fminf(z, 0.f) - __logf(1.0f + __expf(-fabsf(z)));
            run += ls * (1.0f / 16.0f); cum[t] = run;
        }
        adec[(size_t)bc * GLA_DKT + j] = __expf(run);
        const bf16_t* kp = proj + GK0 + gq_off(bc >> 8, (bc & 255) * 64, j >> 8) + (j & 255);
        u32x4* dst = (u32x4*)(kdT + ((size_t)bc * GLA_DKT + j) * 64);
#pragma unroll
        for (int t8 = 0; t8 < 8; ++t8) {
            float kd[8];
#pragma unroll
            for (int q = 0; q < 8; ++q) { const int t = t8 * 8 + q; kd[q] = bf2f(kp[(size_t)t * 256]) * __expf(run - cum[t]); }
            u32x4 w; w.x = cvt_pk_bf16(kd[0], kd[1]); w.y = cvt_pk_bf16(kd[2], kd[3]); w.z = cvt_pk_bf16(kd[4], kd[5]); w.w = cvt_pk_bf16(kd[6], kd[7]);
            dst[t8] = w;
        }
        WG_BAR();
    }
}

constexpr int SCAN_VROW = 144, SCAN_SROW = 528, SCAN_VBUF = 64 * SCAN_VROW, SCAN_SBUF = 64 * SCAN_SROW;
__device__ __forceinline__ void phase_gla_scan(Frame& F, int it, const bf16_t* proj, const bf16_t* kdT, const float* adec, bf16_t* oout, bf16_t* sfin, unsigned* probe = nullptr) {
    const int lane = F.lane, w = F.wave, fr = lane & 15, kq = lane >> 4, tid = F.tid;
    LAS unsigned char* vbuf = F.lds;
    LAS unsigned char* sbuf = F.lds + 2 * SCAN_VBUF;
    const int bh = it >> 4, seg = (it >> 3) & 1, b = bh >> 2, h = bh & 3, sl = it & 7, mt = w & 3, ntp = w >> 2, c0 = seg * (NCH / 2);
    const size_t tokb = (size_t)b * SEQ;
    f32x4 st[2][4];
#pragma unroll
    for (int i = 0; i < 2; ++i)
#pragma unroll
        for (int n = 0; n < 4; ++n) st[i][n] = (f32x4){0.f, 0.f, 0.f, 0.f};
    bf16x8 ka0[2][2], ka1[2][2], q0[8], q1[8]; f32x4 dc0[2], dc1[2]; u32x4 vr0, vr1;
#define CL(c) ((c) < NCH ? (c) : NCH - 1)
#define LOAD_KA(KA, DC, c) do { const size_t bc_ = (size_t)b * NCH + CL(c); \
        _Pragma("unroll") for (int i = 0; i < 2; ++i) { \
            _Pragma("unroll") for (int s = 0; s < 2; ++s) KA[i][s] = *(const bf16x8*)(kdT + ((bc_ * GLA_DKT + h * 256 + 32 * w + 16 * i + fr) * 64 + 32 * s + 8 * kq)); \
            DC[i] = *(const f32x4*)(adec + bc_ * GLA_DKT + h * 256 + 32 * w + 16 * i + 4 * kq); } } while (0)
#define LOAD_V(VR, c) do { VR = *(const u32x4*)(proj + gv_off(b, CL(c) * 64 + (tid >> 3), h) + 64 * sl + 8 * (tid & 7)); } while (0)
#define LOAD_Q(Q, c) do { const bf16_t* qp_ = proj + gq_off(b, CL(c) * 64 + 16 * mt + fr, h) + 8 * kq; \
        _Pragma("unroll") for (int s = 0; s < 8; ++s) Q[s] = *(const bf16x8*)(qp_ + 32 * s); } while (0)
#define STORE_V(VR, buf) do { *(LAS u32x4*)(vbuf + (buf) * SCAN_VBUF + (tid >> 3) * SCAN_VROW + (tid & 7) * 16) = VR; } while (0)
#if PROBE
    unsigned long long pacc[3] = {0ull, 0ull, 0ull}; unsigned long long pmark;
#define PMARK(k) do { const unsigned long long n_ = __builtin_amdgcn_s_memtime(); pacc[k] += n_ - pmark; pmark = n_; } while (0)
#define PSTART() do { pmark = __builtin_amdgcn_s_memtime(); } while (0)
#else
#define PMARK(k) do { } while (0)
#define PSTART() do { } while (0)
#endif
#define SCAN_STEP(KA, DC, VN, VM, QC, QN, c) do { \
        PSTART(); \
        const unsigned vb_ = (unsigned)(uintptr_t)(vbuf + ((c) & 1) * SCAN_VBUF) + (unsigned)((8 * kq + ((lane & 15) >> 2)) * SCAN_VROW + 8 * (lane & 3)); \
        s16x4 tv[4][4];     \
        asm volatile("ds_read_b64_tr_b16 %0, %16 offset:0\n\tds_read_b64_tr_b16 %1, %16 offset:576\n\tds_read_b64_tr_b16 %2, %16 offset:4608\n\tds_read_b64_tr_b16 %3, %16 offset:5184\n\t" \
                     "ds_read_b64_tr_b16 %4, %16 offset:32\n\tds_read_b64_tr_b16 %5, %16 offset:608\n\tds_read_b64_tr_b16 %6, %16 offset:4640\n\tds_read_b64_tr_b16 %7, %16 offset:5216\n\t" \
                     "ds_read_b64_tr_b16 %8, %16 offset:64\n\tds_read_b64_tr_b16 %9, %16 offset:640\n\tds_read_b64_tr_b16 %10, %16 offset:4672\n\tds_read_b64_tr_b16 %11, %16 offset:5248\n\t" \
                     "ds_read_b64_tr_b16 %12, %16 offset:96\n\tds_read_b64_tr_b16 %13, %16 offset:672\n\tds_read_b64_tr_b16 %14, %16 offset:4704\n\tds_read_b64_tr_b16 %15, %16 offset:5280\n\ts_waitcnt lgkmcnt(0)" \
                     : "=&v"(tv[0][0]), "=&v"(tv[0][1]), "=&v"(tv[0][2]), "=&v"(tv[0][3]), "=&v"(tv[1][0]), "=&v"(tv[1][1]), "=&v"(tv[1][2]), "=&v"(tv[1][3]), \
                       "=&v"(tv[2][0]), "=&v"(tv[2][1]), "=&v"(tv[2][2]), "=&v"(tv[2][3]), "=&v"(tv[3][0]), "=&v"(tv[3][1]), "=&v"(tv[3][2]), "=&v"(tv[3][3]) : "v"(vb_) : "memory"); \
        _Pragma("unroll") for (int n = 0; n < 4; ++n) { \
            const bf16x8 vf0 = (bf16x8){tv[n][0][0], tv[n][0][1], tv[n][0][2], tv[n][0][3], tv[n][1][0], tv[n][1][1], tv[n][1][2], tv[n][1][3]}; \
            const bf16x8 vf1 = (bf16x8){tv[n][2][0], tv[n][2][1], tv[n][2][2], tv[n][2][3], tv[n][3][0], tv[n][3][1], tv[n][3][2], tv[n][3][3]}; \
            _Pragma("unroll") for (int i = 0; i < 2; ++i) { \
                st[i][n] = st[i][n] * DC[i]; \
                st[i][n] = __builtin_amdgcn_mfma_f32_16x16x32_bf16(KA[i][0], vf0, st[i][n], 0, 0, 0); \
                st[i][n] = __builtin_amdgcn_mfma_f32_16x16x32_bf16(KA[i][1], vf1, st[i][n], 0, 0, 0); } } \
        LOAD_KA(KA, DC, (c) + 2); \
        PMARK(0); \
        { LAS unsigned char* sb_ = sbuf + ((c) & 1) * SCAN_SBUF + fr * SCAN_SROW + (32 * w + 4 * kq) * 2; \
          _Pragma("unroll") for (int i = 0; i < 2; ++i) _Pragma("unroll") for (int n = 0; n < 4; ++n) { \
              u32x2 pk; pk.x = cvt_pk_bf16(st[i][n][0], st[i][n][1]); pk.y = cvt_pk_bf16(st[i][n][2], st[i][n][3]); \
              *(LAS u32x2*)(sb_ + n * 16 * SCAN_SROW + i * 32) = pk; } } \
        STORE_V(VN, ((c) + 1) & 1); \
        LOAD_V(VN, (c) + 3); \
        WG_BAR(); \
        PMARK(1); \
        { f32x4 a0 = (f32x4){0.f, 0.f, 0.f, 0.f}, a1 = a0; \
          const LAS unsigned char* sr_ = sbuf + ((c) & 1) * SCAN_SBUF + (32 * ntp + fr) * SCAN_SROW + 16 * kq; \
          _Pragma("unroll") for (int hb = 0; hb < 2; ++hb) { bf16x8 bb[4][2];     \
              _Pragma("unroll") for (int s = 0; s < 4; ++s) { bb[s][0] = *(const LAS bf16x8*)(sr_ + 64 * (4 * hb + s)); bb[s][1] = *(const LAS bf16x8*)(sr_ + 16 * SCAN_SROW + 64 * (4 * hb + s)); } \
              asm volatile("s_waitcnt lgkmcnt(0)" ::: "memory"); __builtin_amdgcn_sched_barrier(0); \
              _Pragma("unroll") for (int s = 0; s < 4; ++s) { \
                  a0 = __builtin_amdgcn_mfma_f32_16x16x32_bf16(QC[4 * hb + s], bb[s][0], a0, 0, 0, 0); \
                  a1 = __builtin_amdgcn_mfma_f32_16x16x32_bf16(QC[4 * hb + s], bb[s][1], a1, 0, 0, 0); } } \
          bf16_t* op_ = oout + (tokb + (size_t)(c) * 64 + 16 * mt + 4 * kq) * D + h * 512 + 64 * sl + 32 * ntp + fr; \
          _Pragma("unroll") for (int r = 0; r < 4; ++r) { \
              const float x0 = a0[r] * 0.0625f, x1 = a1[r] * 0.0625f, y0 = __shfl_xor(x0, 1), y1 = __shfl_xor(x1, 1); \
              if ((fr & 1) == 0) { *(unsigned*)(op_ + (size_t)r * D) = cvt_pk_bf16(x0, y0); *(unsigned*)(op_ + (size_t)r * D + 16) = cvt_pk_bf16(x1, y1); } } } \
        LOAD_Q(QC, (c) + 2); \
        PMARK(2); \
    } while (0)
    LOAD_KA(ka0, dc0, c0); LOAD_KA(ka1, dc1, c0 + 1); LOAD_V(vr0, c0); LOAD_V(vr1, c0 + 1); LOAD_Q(q0, c0); LOAD_Q(q1, c0 + 1);
    STORE_V(vr0, 0); LOAD_V(vr0, c0 + 2);
    WG_BAR();
#if PROBE
    const unsigned long long pt0 = __builtin_amdgcn_s_memtime(), pr0 = __builtin_amdgcn_s_memrealtime();
#endif
    for (int c = c0; c < c0 + NCH / 2; c += 2) {
        SCAN_STEP(ka0, dc0, vr1, vr0, q0, q1, c);
        SCAN_STEP(ka1, dc1, vr0, vr1, q1, q0, c + 1);
    }
    if (seg == 0) {
#pragma unroll
        for (int i = 0; i < 2; ++i)
#pragma unroll
            for (int n = 0; n < 4; ++n) { u32x2 pk; pk.x = cvt_pk_bf16(st[i][n][0], st[i][n][1]); pk.y = cvt_pk_bf16(st[i][n][2], st[i][n][3]);
                *(u32x2*)(sfin + ((size_t)(bh * 512 + 64 * sl + 16 * n + fr)) * 256 + 32 * w + 16 * i + 4 * kq) = pk; }
    }
    WG_BAR();
#if PROBE
    if (probe && it == 0 && tid == 0) { const unsigned long long dt = __builtin_amdgcn_s_memtime() - pt0, dr = __builtin_amdgcn_s_memrealtime() - pr0;
        const float val = floorf(2.f * log2f((PROBE == 1) ? (float)dt / 256.f : (PROBE == 2) ? (float)dr * 10.f / 256.f : (float)pacc[PROBE - 3] / 256.f));
        __hip_atomic_store(probe, __float_as_uint(val), __ATOMIC_RELAXED, __HIP_MEMORY_SCOPE_AGENT); }
#endif
#undef CL
#undef LOAD_KA
#undef LOAD_V
#undef LOAD_Q
#undef STORE_V
#undef SCAN_STEP
}

__device__ __forceinline__ void gla_pcum(Frame& F, const float* adec, float* pcum, int rank, int nrank) {
    for (int idx = rank * (NWAVES * 64) + F.tid; idx < NBATCH * GLA_DKT; idx += nrank * NWAVES * 64) { const int b = idx >> 10, j = idx & 1023;
        const float* ap = adec + ((size_t)(b * NCH + NCH / 2)) * GLA_DKT + j; float* pp = pcum + (size_t)(b * (NCH / 2)) * GLA_DKT + j; float pr = 1.f;
#pragma unroll 16
        for (int cc = 0; cc < NCH / 2; ++cc) { pr *= ap[(size_t)cc * GLA_DKT]; pp[(size_t)cc * GLA_DKT] = pr; } }
}
__device__ __forceinline__ void phase_gla_qp(Frame& F, const bf16_t* proj, const float* pcum, bf16_t* qp) {
    const int gw = F.vcu * NWAVES + F.wave, NGW = F.G * NWAVES, lane = F.lane;
    for (int r = gw; r < NBATCH * (SEQ / 2); r += NGW) { const int b = r >> 13, t = r & 8191;
        u32x2 qv[4]; f32x4 pv[4];
#pragma unroll
        for (int h = 0; h < 4; ++h) { qv[h] = *(const u32x2*)(proj + gq_off(b, SEQ / 2 + t, h) + 4 * lane); pv[h] = *(const f32x4*)(pcum + ((size_t)(b * (NCH / 2) + (t >> 6)) * GLA_DKT + h * 256 + 4 * lane)); }
#pragma unroll
        for (int h = 0; h < 4; ++h) { u32x2 w; w.x = cvt_pk_bf16(bf_lo(qv[h].x) * pv[h][0], bf_hi(qv[h].x) * pv[h][1]); w.y = cvt_pk_bf16(bf_lo(qv[h].y) * pv[h][2], bf_hi(qv[h].y) * pv[h][3]);
            *(u32x2*)(qp + ((size_t)((b * 4 + h) * (SEQ / 2) + t)) * 256 + 4 * lane) = w; }
    }
}
__device__ __forceinline__ void phase_gla_gnorm(Frame& F, const bf16_t* o, const bf16_t* proj, const float* gn, bf16_t* y) {
    const int gw = F.vcu * NWAVES + F.wave, NGW = F.G * NWAVES, lane = F.lane;
    const f32x4 g0 = ((const f32x4*)gn)[2 * lane], g1 = ((const f32x4*)gn)[2 * lane + 1];
    for (int tok = gw; tok < T; tok += NGW) {
        u32x4 ov[4], rv[4];
#pragma unroll
        for (int h = 0; h < 4; ++h) { ov[h] = *(const u32x4*)(o + (size_t)tok * D + h * 512 + 8 * lane); rv[h] = *(const u32x4*)(proj + GR0 + (size_t)tok * 2048 + h * 512 + 8 * lane); }
        float ss[4];
#pragma unroll
        for (int h = 0; h < 4; ++h) { float s = 0.f;
#pragma unroll
            for (int q = 0; q < 4; ++q) { const float lo = bf_lo(ov[h][q]), hi = bf_hi(ov[h][q]); s += lo * lo + hi * hi; }
            ss[h] = s; }
#pragma unroll
        for (int of = 1; of < 64; of <<= 1) {
#pragma unroll
            for (int h = 0; h < 4; ++h) ss[h] += __shfl_xor(ss[h], of); }
#pragma unroll
        for (int h = 0; h < 4; ++h) { const float rstd = 1.0f / sqrtf(ss[h] * (1.0f / 512.0f) + RMS_EPS);
            float yv[8];
#pragma unroll
            for (int q = 0; q < 4; ++q) { const float a0 = bf_lo(ov[h][q]), a1 = bf_hi(ov[h][q]), r0 = bf_lo(rv[h][q]), r1 = bf_hi(rv[h][q]);
                const float gA = q < 2 ? g0[2 * q] : g1[2 * q - 4], gB = q < 2 ? g0[2 * q + 1] : g1[2 * q - 3];
                yv[2 * q] = a0 * rstd * gA * (r0 / (1.0f + __expf(-r0))); yv[2 * q + 1] = a1 * rstd * gB * (r1 / (1.0f + __expf(-r1))); }
            u32x4 w; w.x = cvt_pk_bf16(yv[0], yv[1]); w.y = cvt_pk_bf16(yv[2], yv[3]); w.z = cvt_pk_bf16(yv[4], yv[5]); w.w = cvt_pk_bf16(yv[6], yv[7]);
            *(u32x4*)(y + (size_t)tok * D + h * 512 + 8 * lane) = w; }
    }
}

__device__ __forceinline__ void moe_tables(Frame& F, unsigned* cnt) {
    LAS int* pst = (LAS int*)(F.lds + TAB_OFF);
    LAS int* te = pst + 36;
    if (F.wave == 0) {
        const int e = F.lane & 31;
        const int c = (int)xb_ld(cnt + 64 * e);
        const int ntile = (c + 255) >> 8;
        int incl = ntile;
#pragma unroll
        for (int o = 1; o < 32; o <<= 1) { const int v = __shfl_up(incl, o); if ((F.lane & 31) >= o) incl += v; }
        const int excl = incl - ntile;
        if (F.lane < 32) { pst[e] = excl << 8; for (int q = 0; q < ntile; ++q) te[excl + q] = e; }
        if (F.lane == 31) { pst[32] = incl << 8; pst[33] = incl; }
    }
    WG_BAR();
}
__device__ __forceinline__ void phase_moe_slots(Frame& F, const int* tok_e, const int* tok_p, unsigned* cnt, int* slot_of, int* slot_tok) {
    const LAS int* pst = (const LAS int*)(F.lds + TAB_OFF);
    for (int e = F.vcu; e < NEXP; e += F.G) { const int c = (int)xb_ld(cnt + 64 * e), lo = pst[e] + c, hi = pst[e] + (((c + 255) >> 8) << 8);
        for (int s = lo + F.tid; s < hi; s += NWAVES * 64) slot_tok[s] = -1; }
    for (int a = F.vcu * NWAVES * 64 + F.tid; a < 2 * T; a += F.G * NWAVES * 64) { const int slot = pst[tok_e[a]] + tok_p[a]; slot_of[a] = slot; slot_tok[slot] = a >> 1; }
}
__device__ __forceinline__ void phase_moe_copy8(Frame& F, const int* tok_e, const int* tok_p, const unsigned char* hn8, unsigned char* ag8) {
    const LAS int* pst = (const LAS int*)(F.lds + TAB_OFF);
    const int gw = F.vcu * NWAVES + F.wave, NGW = F.G * NWAVES, lane = F.lane;
    for (int t = gw; t < T; t += NGW) {
        const int s0 = pst[tok_e[2 * t]] + tok_p[2 * t], s1 = pst[tok_e[2 * t + 1]] + tok_p[2 * t + 1];
        const u32x4* src = (const u32x4*)(hn8 + (size_t)t * D); const u32x4 v0 = src[lane], v1 = src[lane + 64];
        u32x4* d0 = (u32x4*)(ag8 + (size_t)s0 * D); u32x4* d1 = (u32x4*)(ag8 + (size_t)s1 * D);
        d0[lane] = v0; d0[lane + 64] = v1; d1[lane] = v0; d1[lane + 64] = v1;
    }
}
template <int MODE>
__device__ __forceinline__ void phase_moe_combine(Frame& F, float* x, const bf16_t* ob, const int* slot_of, const float* tok_w, const float* gain, bf16_t* hn) {
    const int gw = F.vcu * NWAVES + F.wave, NGW = F.G * NWAVES, lane = F.lane;
    f32x4 g4[8];
#pragma unroll
    for (int j = 0; j < 8; ++j) g4[j] = ((const f32x4*)gain)[lane + 64 * j];
    for (int t = gw; t < T; t += NGW) {
        const int s0 = slot_of[2 * t], s1 = slot_of[2 * t + 1]; const float w0 = tok_w[2 * t], w1 = tok_w[2 * t + 1];
        f32x4* xr = (f32x4*)(x + (size_t)t * D);
        const u32x2* a = (const u32x2*)(ob + (size_t)s0 * D); const u32x2* b = (const u32x2*)(ob + (size_t)s1 * D);
        f32x4 v[8]; float ss = 0.f;
#pragma unroll
        for (int j = 0; j < 8; ++j) { const u32x2 av = a[lane + 64 * j], bv = b[lane + 64 * j]; f32x4 xv = xr[lane + 64 * j];
            xv[0] += w0 * bf_lo(av.x) + w1 * bf_lo(bv.x); xv[1] += w0 * bf_hi(av.x) + w1 * bf_hi(bv.x);
            xv[2] += w0 * bf_lo(av.y) + w1 * bf_lo(bv.y); xv[3] += w0 * bf_hi(av.y) + w1 * bf_hi(bv.y);
            v[j] = xv; ss += (xv[0] * xv[0] + xv[1] * xv[1]) + (xv[2] * xv[2] + xv[3] * xv[3]); }
        const float rstd = 1.0f / sqrtf(wave_sum(ss) * (1.0f / D) + RMS_EPS);
        if (MODE == 0) {
            unsigned* orow = (unsigned*)((unsigned char*)hn + (size_t)t * D);
#pragma unroll
            for (int j = 0; j < 8; ++j) { xr[lane + 64 * j] = v[j]; const f32x4 y = v[j] * rstd * g4[j]; orow[lane + 64 * j] = cvt4_fp8(y[0], y[1], y[2], y[3]); }
        } else {
#pragma unroll
            for (int j = 0; j < 8; ++j) xr[lane + 64 * j] = v[j] * rstd * g4[j];
        }
    }
}

__device__ __forceinline__ void phase_subln(Frame& F, const bf16_t* o1, const bf16_t* o2, const float* lq1, const float* lk1, const float* lq2, const float* lk2, const float* sg, bf16_t* y) {
    const int gw = F.vcu * NWAVES + F.wave, NGW = F.G * NWAVES, lane = F.lane;
    const float d1 = wave_sum(lq1[lane] * lk1[lane] + lq1[lane + 64] * lk1[lane + 64]);
    const float d2 = wave_sum(lq2[lane] * lk2[lane] + lq2[lane + 64] * lk2[lane + 64]);
    const float lam = __expf(d1) - __expf(d2) + LAMBDA_INIT;
    const f32x4 g = ((const f32x4*)sg)[lane] * (1.0f - LAMBDA_INIT);
    for (int tok = gw; tok < T; tok += NGW) {
        u32x2 a[8], b[8];
#pragma unroll
        for (int h = 0; h < 8; ++h) { a[h] = *(const u32x2*)(o1 + (size_t)tok * D + h * 256 + 4 * lane); b[h] = *(const u32x2*)(o2 + (size_t)tok * D + h * 256 + 4 * lane); }
        f32x4 d[8]; float ss[8];
#pragma unroll
        for (int h = 0; h < 8; ++h) { d[h][0] = bf_lo(a[h].x) - lam * bf_lo(b[h].x); d[h][1] = bf_hi(a[h].x) - lam * bf_hi(b[h].x); d[h][2] = bf_lo(a[h].y) - lam * bf_lo(b[h].y); d[h][3] = bf_hi(a[h].y) - lam * bf_hi(b[h].y);
            ss[h] = (d[h][0] * d[h][0] + d[h][1] * d[h][1]) + (d[h][2] * d[h][2] + d[h][3] * d[h][3]); }
#pragma unroll
        for (int of = 1; of < 64; of <<= 1) {
#pragma unroll
            for (int h = 0; h < 8; ++h) ss[h] += __shfl_xor(ss[h], of); }
#pragma unroll
        for (int h = 0; h < 8; ++h) { const float rstd = 1.0f / sqrtf(ss[h] * (1.0f / 256.0f) + RMS_EPS); const f32x4 yv = d[h] * rstd * g;
            u32x2 w; w.x = cvt_pk_bf16(yv[0], yv[1]); w.y = cvt_pk_bf16(yv[2], yv[3]);
            *(u32x2*)(y + (size_t)tok * D + h * 256 + 4 * lane) = w; }
    }
}

namespace att {
constexpr int SHM_K = 64 * 128 * 2, SHM_V = 64 * 256 * 2;
constexpr int V_OFF = 0, K_OFF = 3 * SHM_V, SCR_OFF = RING_BYTES + 4096;
constexpr float SCALE = 0.08838834764831845f;
constexpr float C2 = 1.4426950408889634f * SCALE;
constexpr float THR = 8.f;
#define KSWZ(row, colB) ((row) * 256 + ((colB) ^ (((row) & 7) << 4)))
__device__ __forceinline__ int crow(int r, int hi) { return (r & 3) + 8 * (r >> 2) + 4 * hi; }
__device__ __forceinline__ int v_rd_base(int lane) { return ((lane & 3) << 3) | (((lane >> 2) & 3) << 6) | (((lane >> 4) & 1) << 5) | (((lane >> 5) & 1) << 8); }
constexpr int v_rd_off(int d0, int ks, int half) { return d0 * 512 + ks * 8192 + half * 4096; }

__device__ __forceinline__ void qkt(f32x16& p0, f32x16& p1, const LAS unsigned char* kslot, int r32, int hi, const bf16x8 (&qr)[8]) {
    const LAS unsigned char* kb[4];
#pragma unroll
    for (int dd = 0; dd < 4; ++dd) kb[dd] = kslot + KSWZ(r32, (dd * 16 + hi * 8) * 2);
#pragma unroll
    for (int d0 = 0; d0 < 8; ++d0) { const LAS unsigned char* a = kb[d0 & 3] + (d0 >> 2) * 128;
        const bf16x8 b0 = *(const LAS bf16x8*)a;
        const bf16x8 b1 = *(const LAS bf16x8*)(a + 32 * 256);
        p0 = __builtin_amdgcn_mfma_f32_32x32x16_bf16(b0, qr[d0], p0, 0, 0, 0);
        p1 = __builtin_amdgcn_mfma_f32_32x32x16_bf16(b1, qr[d0], p1, 0, 0, 0); }
}
__device__ __forceinline__ void pv_tile(f32x16 (&o)[8], unsigned vb, const bf16x8 (&pa)[4]) {
#define TRRD(dst, off) asm volatile("ds_read_b64_tr_b16 %0, %1 offset:%2" : "=&v"(dst) : "v"(vb), "i"(off) : "memory")
#define PV_D0(d0) do { s16x4 l0, l1, l2, l3, h0, h1, h2, h3; constexpr int b_ = v_rd_off(d0, 0, 0); \
        TRRD(l0, b_); TRRD(h0, b_ + 4096); TRRD(l1, b_ + 8192); TRRD(h1, b_ + 12288); TRRD(l2, b_ + 16384); TRRD(h2, b_ + 20480); TRRD(l3, b_ + 24576); TRRD(h3, b_ + 28672); \
        asm volatile("s_waitcnt lgkmcnt(0)" ::: "memory"); __builtin_amdgcn_sched_barrier(0); \
        o[d0] = __builtin_amdgcn_mfma_f32_32x32x16_bf16(pa[0], (bf16x8){l0[0], l0[1], l0[2], l0[3], h0[0], h0[1], h0[2], h0[3]}, o[d0], 0, 0, 0); \
        o[d0] = __builtin_amdgcn_mfma_f32_32x32x16_bf16(pa[1], (bf16x8){l1[0], l1[1], l1[2], l1[3], h1[0], h1[1], h1[2], h1[3]}, o[d0], 0, 0, 0); \
        o[d0] = __builtin_amdgcn_mfma_f32_32x32x16_bf16(pa[2], (bf16x8){l2[0], l2[1], l2[2], l2[3], h2[0], h2[1], h2[2], h2[3]}, o[d0], 0, 0, 0); \
        o[d0] = __builtin_amdgcn_mfma_f32_32x32x16_bf16(pa[3], (bf16x8){l3[0], l3[1], l3[2], l3[3], h3[0], h3[1], h3[2], h3[3]}, o[d0], 0, 0, 0); } while (0)
    PV_D0(0); PV_D0(1); PV_D0(2); PV_D0(3); PV_D0(4); PV_D0(5); PV_D0(6); PV_D0(7);
#undef PV_D0
#undef TRRD
}

__device__ __forceinline__ void stage_offsets(int tid, unsigned (&koff)[2], unsigned (&voff)[4]) {
#pragma unroll
    for (int i = 0; i < 2; ++i) { const int P = tid * 16 + i * 8192, row = P >> 8, ch = ((P & 255) >> 4) ^ (row & 7); koff[i] = (unsigned)(row * 128 + ch * 8) * 2u; }
#pragma unroll
    for (int i = 0; i < 4; ++i) { const int P = tid * 16 + i * 8192, st = P >> 9, kk = ((st >> 3) << 3) | ((P & 511) >> 6), cg = st & 7, cin = (P & 63) >> 1;
        const int key = (kk & ~0xC) | ((kk & 4) << 1) | ((kk & 8) >> 1); voff[i] = (unsigned)(key * 256 + cg * 32 + cin) * 2u; }
}
__device__ __forceinline__ const char* uniform_ptr(const void* p) {
    const unsigned long long v = (unsigned long long)p;
    const unsigned lo = __builtin_amdgcn_readfirstlane((unsigned)v), hi = __builtin_amdgcn_readfirstlane((unsigned)(v >> 32));
    return (const char*)(((unsigned long long)hi << 32) | lo);
}
__device__ __forceinline__ void stage_tile(LAS unsigned char* lds, int kslot, int vslot, const bf16_t* kj_, const bf16_t* vj_, int tid_, int wid) {
    const char* kj = uniform_ptr(kj_); const char* vj = uniform_ptr(vj_);
    int tid = tid_; asm volatile("" : "+v"(tid));
    unsigned koff[2], voff[4]; stage_offsets(tid, koff, voff);
    LAS unsigned char* kd = lds + K_OFF + kslot * SHM_K + wid * 1024; LAS unsigned char* vd = lds + V_OFF + vslot * SHM_V + wid * 1024;
#pragma unroll
    for (int i = 0; i < 2; ++i) __builtin_amdgcn_global_load_lds((const unsigned*)(kj + koff[i]), (LAS unsigned*)(kd + i * 8192), 16, 0, 0);
#pragma unroll
    for (int i = 0; i < 4; ++i) __builtin_amdgcn_global_load_lds((const unsigned*)(vj + voff[i]), (LAS unsigned*)(vd + i * 8192), 16, 0, 0);
}

__device__ __forceinline__ void qk_softmax(const LAS unsigned char* kslot, int r32, int hi, LAS float* al_l, const bf16x8 (&qr)[8], f32x16 (&o)[8], bf16x8 (&pa)[4],
                                           float& m_reg, float& l_reg, float rawu, float sl2, bool diag, int qi) {
    f32x16 p0, p1;
#pragma unroll
    for (int r = 0; r < 16; ++r) { p0[r] = 0.f; p1[r] = 0.f; }
    qkt(p0, p1, kslot, r32, hi, qr);
#pragma unroll
    for (int r = 0; r < 16; ++r) { const float cr = (float)((r & 3) + 8 * (r >> 2)); p0[r] = fmaf(cr, rawu, p0[r]); p1[r] = fmaf(cr, rawu, p1[r]); }
    if (diag) {
        const float k2raw = 2.f * rawu;
        int qi_ = qi - 4 * hi; asm volatile("" : "+v"(qi_));
#pragma unroll
        for (int r = 0; r < 16; ++r) { const int c = (r & 3) + 8 * (r >> 2); const int d0_ = c - qi_, d1_ = c + 32 - qi_;
            p0[r] -= k2raw * (float)(d0_ > 0 ? d0_ : 0); p1[r] -= k2raw * (float)(d1_ > 0 ? d1_ : 0); }
    }
    const float lane_raw = rawu * (float)(4 * hi), d32raw = 32.f * rawu;
    float pm0 = p0[0], pm1 = p1[0];
#pragma unroll
    for (int r = 1; r < 16; ++r) { pm0 = fmaxf(pm0, p0[r]); pm1 = fmaxf(pm1, p1[r]); }
    float pmax = fmaxf(pm0, pm1 + d32raw) + lane_raw;
    { auto rr = __builtin_amdgcn_permlane32_swap(__float_as_uint(pmax), __float_as_uint(pmax), false, false);
      pmax = fmaxf(__uint_as_float(rr[0]), __uint_as_float(rr[1])); }
    float mn, alpha;
    if (__all((pmax - m_reg) * SCALE <= THR)) { mn = m_reg; alpha = 1.f; }
    else { mn = fmaxf(m_reg, pmax); alpha = __builtin_amdgcn_exp2f((m_reg - mn) * C2); m_reg = mn; }
    const float mnL0 = (lane_raw - mn) * C2, mnL1 = mnL0 + 32.f * sl2;
#pragma unroll
    for (int r = 0; r < 16; ++r) { p0[r] = __builtin_amdgcn_exp2f(fmaf(p0[r], C2, mnL0)); p1[r] = __builtin_amdgcn_exp2f(fmaf(p1[r], C2, mnL1)); }
    if (__any(alpha < 1.f)) {
        if (hi == 0) al_l[r32] = alpha;
        LDS_WAIT();
#pragma unroll
        for (int r = 0; r < 16; ++r) { const float a = al_l[crow(r, hi)];
#pragma unroll
            for (int d = 0; d < 8; ++d) o[d][r] *= a; }
    }
    float ps = 0.f;
#pragma unroll
    for (int r = 0; r < 16; ++r) ps += p0[r] + p1[r];
    { auto rr = __builtin_amdgcn_permlane32_swap(__float_as_uint(ps), __float_as_uint(ps), false, false);
      ps = __uint_as_float(rr[0]) + __uint_as_float(rr[1]); }
    l_reg = l_reg * alpha + ps;
#define PK4(P, B_, OUT) do { unsigned a0 = cvt_pk_bf16(P[B_+0], P[B_+1]), a1 = cvt_pk_bf16(P[B_+2], P[B_+3]); \
        unsigned b0 = cvt_pk_bf16(P[B_+4], P[B_+5]), b1 = cvt_pk_bf16(P[B_+6], P[B_+7]); \
        auto r0 = __builtin_amdgcn_permlane32_swap(a0, b0, false, false); auto r1 = __builtin_amdgcn_permlane32_swap(a1, b1, false, false); \
        u32x4 w = {r0[0], r1[0], r0[1], r1[1]}; OUT = __builtin_bit_cast(bf16x8, w); } while (0)
    PK4(p0, 0, pa[0]); PK4(p0, 8, pa[1]); PK4(p1, 0, pa[2]); PK4(p1, 8, pa[3]);
#undef PK4
}

__device__ __forceinline__ void norms_phase(Frame& F, const bf16_t* proj, float* nrm) {
    const int gw = F.vcu * NWAVES + F.wave, NGW = F.G * NWAVES, lane = F.lane;
    for (int idx = gw; idx < 2 * 32 * 256; idx += NGW) {
        const int tensor = idx >> 13, stream = (idx >> 8) & 31, grp = idx & 255;
        const u32x4* rp = (const u32x4*)(proj + (tensor ? DK0 : 0) + ((size_t)stream * SEQ + grp * 64 + lane) * 128);
        float ss = 0.f;
#pragma unroll
        for (int q = 0; q < 16; ++q) { const u32x4 v = rp[q];
#pragma unroll
            for (int e = 0; e < 4; ++e) { const float lo = bf_lo(v[e]), hi = bf_hi(v[e]); ss += lo * lo + hi * hi; } }
        float n = sqrtf(ss) * 1.001f;
#pragma unroll
        for (int o = 1; o < 64; o <<= 1) n = fmaxf(n, __shfl_xor(n, o));
        if (lane == 0) nrm[idx] = n;
    }
}

__device__ __forceinline__ void attn_item(LAS unsigned char* lds, const bf16_t* proj, const float* nrm, bf16_t* oout, int b, int h, int sub, int qb, int tid, int wid, int lane) {
    const int r32 = lane & 31, hi = lane >> 5;
    const float slope = __builtin_amdgcn_exp2f(-(float)(h + 1));
    const float sl2 = slope * 1.4426950408889634f, rawu = sl2 / C2;
    LAS float* ws = (LAS float*)(lds + SCR_OFF) + wid * 64; LAS float* li_l = ws; LAS float* al_l = ws + 32;
    const size_t tokq = (size_t)b * SEQ + (size_t)qb * 256 + wid * 32;
    const bf16_t* kbase = proj + DK0 + dq_off(b, 0, h, sub);
    const bf16_t* vbase = proj + dv_off(b, 0, h);
    int j_lo;
    { const int stream = (b * 8 + h) * 2 + sub; const float* qn = nrm + stream * 256; const float* kn = nrm + 8192 + stream * 256;
      const float Qn = fmaxf(fmaxf(qn[4 * qb], qn[4 * qb + 1]), fmaxf(qn[4 * qb + 2], qn[4 * qb + 3]));
      const float Kd = fmaxf(fmaxf(kn[4 * qb], kn[4 * qb + 1]), fmaxf(kn[4 * qb + 2], kn[4 * qb + 3]));
      int cand = 4 * qb;
      for (int jj = lane; jj < 4 * qb; jj += 64) { const float dmin = (float)(256 * qb - (64 * jj + 63)); const bool skip = slope * dmin > 110.f + SCALE * Qn * (kn[jj] + Kd); if (!skip) cand = cand < jj ? cand : jj; }
#pragma unroll
      for (int o = 1; o < 64; o <<= 1) { const int v = __shfl_xor(cand, o); cand = v < cand ? v : cand; }
      j_lo = __builtin_amdgcn_readfirstlane(cand); }
    bf16x8 qr[8];
#pragma unroll
    for (int d0 = 0; d0 < 8; ++d0) qr[d0] = *(const bf16x8*)(proj + dq_off(b, qb * 256 + wid * 32 + r32, h, sub) + d0 * 16 + hi * 8);
    const float sh64 = 64.f * rawu;
    const int qi = 32 * (wid & 1) + r32;
    const unsigned vb0 = (unsigned)(uintptr_t)(lds + V_OFF) + (unsigned)v_rd_base(lane);
    float m_reg = -1e30f, l_reg = 0.f;
    f32x16 o[8];
#pragma unroll
    for (int d = 0; d < 8; ++d)
#pragma unroll
        for (int r = 0; r < 16; ++r) o[d][r] = 0.f;
    const int NT = 4 * qb + 4, myNT = 4 * qb + (wid >> 1) + 1;
    constexpr size_t KSTEP = 64 * 128, VSTEP = 64 * 256;
    const bool late = wid >= 4;
    stage_tile(lds, j_lo & 1, j_lo % 3, kbase + (size_t)j_lo * KSTEP, vbase + (size_t)j_lo * VSTEP, tid, wid);
    VM_WAIT(); WG_BAR();
    if (!late) {
        int vs = j_lo % 3;
        for (int j = j_lo; j < NT; ++j) {
            const int vsn = vs == 2 ? 0 : vs + 1;
            if (j + 1 < NT) stage_tile(lds, (j + 1) & 1, vsn, kbase + (size_t)(j + 1) * KSTEP, vbase + (size_t)(j + 1) * VSTEP, tid, wid);
            if (j < myNT) { if (j > j_lo) m_reg -= sh64;
                bf16x8 pa[4];
                qk_softmax(lds + K_OFF + (j & 1) * SHM_K, r32, hi, al_l, qr, o, pa, m_reg, l_reg, rawu, sl2, j == myNT - 1, qi);
                pv_tile(o, vb0 + (unsigned)(vs * SHM_V), pa); }
            VM_WAIT(); WG_BAR();
            vs = vsn;
        }
    } else {
        bf16x8 pa[4];
        int vs = j_lo % 3, vsp = vs;
        for (int j = j_lo; j < NT; ++j) {
            const int vsn = vs == 2 ? 0 : vs + 1;
            if (j + 1 < NT) stage_tile(lds, (j + 1) & 1, vsn, kbase + (size_t)(j + 1) * KSTEP, vbase + (size_t)(j + 1) * VSTEP, tid, wid);
            if (j > j_lo && j - 1 < myNT) pv_tile(o, vb0 + (unsigned)(vsp * SHM_V), pa);
            if (j < myNT) { if (j > j_lo) m_reg -= sh64;
                qk_softmax(lds + K_OFF + (j & 1) * SHM_K, r32, hi, al_l, qr, o, pa, m_reg, l_reg, rawu, sl2, j == myNT - 1, qi); }
            VM_WAIT(); WG_BAR();
            vsp = vs; vs = vsn;
        }
        if (myNT == NT) pv_tile(o, vb0 + (unsigned)(vsp * SHM_V), pa);
    }
    if (hi == 0) li_l[r32] = l_reg;
    LDS_WAIT();
    char* Ow = (char*)(oout + tokq * D + h * 256);
    const unsigned lofs = (unsigned)(hi * 4 * D + r32) * 2u;
#pragma unroll
    for (int r = 0; r < 16; ++r) { const float rl = __builtin_amdgcn_rcpf(li_l[crow(r, hi)]);
#pragma unroll
        for (int d0 = 0; d0 < 8; ++d0) { const float v = o[d0][r] * rl; const float vn = __shfl_xor(v, 1);
            if ((r32 & 1) == 0) *(unsigned*)(Ow + (lofs + (unsigned)((((r & 3) + 8 * (r >> 2)) * D + d0 * 32) * 2))) = cvt_pk_bf16(v, vn); } }
    WG_BAR();
}

__device__ __forceinline__ void attn_phase(Frame& F, const bf16_t* proj, const float* nrm, unsigned* queue, bf16_t* o1, bf16_t* o2) {
    LAS int* qw = (LAS int*)(F.lds + SCR_OFF + 8 * 256);
    for (;;) {
        if (F.tid == 0) *qw = (int)__hip_atomic_fetch_add(queue, 1u, __ATOMIC_RELAXED, __HIP_MEMORY_SCOPE_AGENT);
        WG_BAR();
        const int I = __builtin_amdgcn_readfirstlane(*qw);
        if (I >= 2048) break;
        const int qb = 63 - (I >> 5), r = I & 31, h = 7 - (r >> 2), b = (r >> 1) & 1, sub = r & 1;
        attn_item(F.lds, proj, nrm, sub ? o2 : o1, b, h, sub, qb, F.tid, F.wave, F.lane);
    }
}
}

__device__ __forceinline__ const void* karg(int i) { int j = i; asm volatile("" : "+s"(j)); return ((const void* const __attribute__((address_space(4)))*)__builtin_amdgcn_kernarg_segment_ptr())[j]; }
__global__ void __launch_bounds__(NWAVES * 64, 2) hybrid_fwd(Args args) {
    extern __shared__ __attribute__((aligned(16))) unsigned char lds_raw[];
    Frame F;
    F.lds = (LAS unsigned char*)lds_raw;
    F.tid = threadIdx.x; F.lane = F.tid & 63; F.wave = __builtin_amdgcn_readfirstlane(F.tid >> 6);
    F.G = gridDim.x; { const int bx = blockIdx.x; F.vcu = (F.G % 8 == 0) ? (bx % 8) * (F.G / 8) + bx / 8 : bx; }
#define ws ((unsigned char*)karg(22))
#define ctl ((unsigned*)(ws + WS_CTL))
    for (int u = F.tid; u < (LDS_BYTES - LDSCTL_OFF) / 4; u += NWAVES * 64) ((LAS unsigned*)(F.lds + LDSCTL_OFF))[u] = 0u;
    __syncthreads();
    ((LAS int*)(F.lds + TIDS_OFF))[F.tid] = F.tid;
    __syncthreads();
    volatile LAS unsigned* MISC = (volatile LAS unsigned*)(F.lds + MISC_OFF);
    XcdBarrier bar = xcd_barrier_post(ctl + CW_BAR, MISC + 8);
#define GRID_BAR() do { XcdBarrier bb_ = bar; unsigned x_ = bar.x; unsigned long long bp_ = (unsigned long long)bar.bar; asm volatile("" : "+s"(x_), "+s"(bp_)); bb_.x = x_; bb_.bar = (unsigned*)bp_; xcd_barrier(bb_, TID_RELOAD() == 0); } while (0)
#define TID_RELOAD() (F.wave * 64 + lane_id_volatile())
#ifdef ONLY_PHASE
#define PHON(n) ((n) == ONLY_PHASE)
#elif DIAG
#define PHON(n) ((n) <= args.upto)
#else
#define PHON(n) 1
#endif

#define x_in ((const float*)(karg(0)))
#define norm_mix ((const float*)(karg(1)))
#define norm_ffn ((const float*)(karg(2)))
#define gla_w_in ((const float*)(karg(3)))
#define gla_wgu ((const float*)(karg(4)))
#define gla_bg ((const float*)(karg(5)))
#define gla_norm ((const float*)(karg(6)))
#define gla_w_out ((const float*)(karg(7)))
#define diff_w_in ((const float*)(karg(8)))
#define lq1 ((const float*)(karg(9)))
#define lk1 ((const float*)(karg(10)))
#define lq2 ((const float*)(karg(11)))
#define lk2 ((const float*)(karg(12)))
#define diff_subln ((const float*)(karg(13)))
#define diff_w_out ((const float*)(karg(14)))
#define moe_wgrp ((const float*)(karg(15)))
#define moe_wexp ((const float*)(karg(16)))
#define moe_wg ((const float*)(karg(17)))
#define moe_wu ((const float*)(karg(18)))
#define moe_wd ((const float*)(karg(19)))
#define final_norm ((const float*)(karg(20)))
#define xres ((float*)(karg(21)))
#define gz ((float*)((float*)(ws + WS_GZ)))
#define tok_e ((int*)((int*)(ws + WS_TOKE)))
#define tok_p ((int*)((int*)(ws + WS_TOKP)))
#define tok_w ((float*)((float*)(ws + WS_TOKW)))
#define slot_of ((int*)((int*)(ws + WS_SLOT)))
#define slot_tok ((int*)(ws + WS_STOK))
#define adec ((float*)((float*)(ws + WS_ADEC)))
#define pcum ((float*)((float*)(ws + WS_PCUM)))
#define sfin ((bf16_t*)((bf16_t*)(ws + WS_SFIN)))
#define wp_gz ((float*)((float*)(ws + WS_WPGZ)))
#define wp_r0 ((float*)((float*)(ws + WS_WPR0)))
#define wp_r1 ((float*)((float*)(ws + WS_WPR1)))
#define wgi ((bf16_t*)((bf16_t*)(ws + WS_WGI)))
#define wgo ((bf16_t*)((bf16_t*)(ws + WS_WGO)))
#define wdi ((bf16_t*)((bf16_t*)(ws + WS_WDI)))
#define wdo ((bf16_t*)((bf16_t*)(ws + WS_WDO)))
#define wmoe_gu ((bf16_t*)((bf16_t*)(ws + WS_WMOE)))
#define wmoe_d ((bf16_t*)((bf16_t*)(ws + WS_WMOE_D)))
#define hn ((bf16_t*)((bf16_t*)(ws + WS_HN)))
#define proj ((bf16_t*)((bf16_t*)(ws + WS_PROJ)))
#define buf1 ((bf16_t*)((bf16_t*)(ws + WS_BUF1)))
#define buf2 ((bf16_t*)((bf16_t*)(ws + WS_BUF2)))
#define ag ((bf16_t*)((bf16_t*)(ws + WS_AG)))
#define ob ((bf16_t*)((bf16_t*)(ws + WS_OB)))
#define hh ((bf16_t*)((bf16_t*)(ws + WS_H)))
    const LAS int* pst = (const LAS int*)(F.lds + TAB_OFF);

    _Pragma("unroll") for (int rep_ = 0; rep_ < (REP_PHASE == 0 ? 2 : 1); ++rep_) if (PHON(0)) { if (rep_) GRID_BAR(); Frame P = F; P.tid = TID_RELOAD(); P.lane = P.tid & 63;
    conv_plain(P, gla_w_in, D, PROJW, GLA_INW, wgi);
    conv_plain(P, gla_w_out, D, D, D, wgo);
    conv_plain<true>(P, diff_w_in, D, PROJW, PROJW, wdi);
    conv_plain(P, diff_w_out, D, D, D, wdo);
    pack_proj(P, wp_gz, 1, norm_mix, gla_w_in, GLA_INW, PROJW, 16, nullptr, 0, 0);
    pack_proj(P, wp_r0, 3, norm_ffn, moe_wgrp, 4, 0, 4, moe_wexp, 32, 32);
    pack_proj(P, wp_r1, 3, norm_ffn + D, moe_wgrp + (size_t)D * 4, 4, 0, 4, moe_wexp + (size_t)D * 32, 32, 32);
    }
    GRID_BAR();
    _Pragma("unroll") for (int rep_ = 0; rep_ < (REP_PHASE == 1 ? 2 : 1); ++rep_) if (PHON(1)) { if (rep_) GRID_BAR(); Frame P = F; P.tid = TID_RELOAD(); P.lane = P.tid & 63;
    phase_norm_gz(P, x_in, norm_mix, wp_gz, hn, gz);
    }
    GRID_BAR();
    _Pragma("unroll") for (int rep_ = 0; rep_ < (REP_PHASE == 2 ? 2 : 1); ++rep_) if (PHON(2)) { if (rep_) GRID_BAR(); Frame P = F; P.tid = TID_RELOAD(); P.lane = P.tid & 63;
    { pg8::Gemm g{hn, wgi, T, PROJW, D}; pg8::StaticOrder S; S.init(T, PROJW, P.G, (int)blockIdx.x); pg8::EpiHeads<0> E{proj};
      pg8::gemm_phase<pg8::EpiHeads<0>, pg8::StaticOrder>(P.lds, g, S, E, P.tid); }
    }
    GRID_BAR();
    _Pragma("unroll") for (int rep_ = 0; rep_ < (REP_PHASE == 3 ? 2 : 1); ++rep_) if (PHON(3)) { if (rep_) GRID_BAR(); Frame P = F; P.tid = TID_RELOAD(); P.lane = P.tid & 63;
    phase_gla_gate(P, gz, gla_wgu, gla_bg, proj, buf1, adec);
    }
    GRID_BAR();
    _Pragma("unroll") for (int rep_ = 0; rep_ < (REP_PHASE == 4 ? 2 : 1); ++rep_) if (PHON(4)) { if (rep_) GRID_BAR(); Frame P = F; P.tid = TID_RELOAD(); P.lane = P.tid & 63;
    if (P.G == 256) { if ((P.vcu & 1) == 0) phase_gla_scan(P, P.vcu >> 1, proj, buf1, adec, buf2, sfin, ctl + CW_PROBE); else { gla_pcum(P, adec, pcum, P.vcu >> 1, 128); conv_moe(P, moe_wg, moe_wu, moe_wd, wmoe_gu, wmoe_d, P.vcu >> 1, 128); } }
    else { for (int it = P.vcu; it < 128; it += P.G) phase_gla_scan(P, it, proj, buf1, adec, buf2, sfin); gla_pcum(P, adec, pcum, P.vcu, P.G); conv_moe(P, moe_wg, moe_wu, moe_wd, wmoe_gu, wmoe_d); }
    GRID_BAR();
    phase_gla_qp(P, proj, pcum, hn);
    GRID_BAR();
    { pg8::Gemm g{hn, sfin, 8 * (SEQ / 2), 512, 256}; pg8::FixOrder S; S.init(8 * (SEQ / 2), 512, P.G, (int)blockIdx.x); pg8::EpiAddO E{buf2};
      pg8::gemm_phase<pg8::EpiAddO, pg8::FixOrder>(P.lds, g, S, E, P.tid); }
    }
    GRID_BAR();
    _Pragma("unroll") for (int rep_ = 0; rep_ < (REP_PHASE == 5 ? 2 : 1); ++rep_) if (PHON(5)) { if (rep_) GRID_BAR(); Frame P = F; P.tid = TID_RELOAD(); P.lane = P.tid & 63;
    phase_gla_gnorm(P, buf2, proj, gla_norm, hn);
    }
    GRID_BAR();
    _Pragma("unroll") for (int rep_ = 0; rep_ < (REP_PHASE == 6 ? 2 : 1); ++rep_) if (PHON(6)) { if (rep_) GRID_BAR(); Frame P = F; P.tid = TID_RELOAD(); P.lane = P.tid & 63;
    { pg8::Gemm g{hn, wgo, T, D, D}; pg8::StaticOrder S; S.init(T, D, P.G, (int)blockIdx.x); pg8::EpiResF32 E{x_in, xres, D};
      pg8::gemm_phase<pg8::EpiResF32, pg8::StaticOrder>(P.lds, g, S, E, P.tid); }
    }
    GRID_BAR();
    _Pragma("unroll") for (int rep_ = 0; rep_ < (REP_PHASE == 7 ? 2 : 1); ++rep_) if (PHON(7)) { if (rep_) GRID_BAR(); Frame P = F; P.tid = TID_RELOAD(); P.lane = P.tid & 63;
    phase_norm_route(P, xres, norm_ffn, wp_r0, hn, tok_e, tok_p, tok_w, ctl + CW_CNT0);
    }
    GRID_BAR();
    _Pragma("unroll") for (int rep_ = 0; rep_ < (REP_PHASE == 8 ? 2 : 1); ++rep_) if (PHON(8)) { if (rep_) GRID_BAR(); Frame P = F; P.tid = TID_RELOAD(); P.lane = P.tid & 63;
    moe_tables(P, ctl + CW_CNT0);
    phase_moe_slots(P, tok_e, tok_p, ctl + CW_CNT0, slot_of, slot_tok);
    }
    GRID_BAR();
    _Pragma("unroll") for (int rep_ = 0; rep_ < (REP_PHASE == 9 ? 2 : 1); ++rep_) if (PHON(9)) { if (rep_) GRID_BAR(); Frame P = F; P.tid = TID_RELOAD(); P.lane = P.tid & 63;
    { const int Mr = pst[33] * 256; pg8::Gemm g{hn, wmoe_gu, Mr, 1024, D}; pg8::MoeOrder S; S.init(Mr, 1024, P.G, (int)blockIdx.x); S.te = pst + 36; S.estride = (size_t)1024 * D; S.stok = slot_tok; pg8::EpiSiluMul E{(unsigned char*)hh};
      pg8::gemm_phase<pg8::EpiSiluMul, pg8::MoeOrder, true, true>(P.lds, g, S, E, P.tid); }
    }
    GRID_BAR();
    _Pragma("unroll") for (int rep_ = 0; rep_ < (REP_PHASE == 10 ? 2 : 1); ++rep_) if (PHON(10)) { if (rep_) GRID_BAR(); Frame P = F; P.tid = TID_RELOAD(); P.lane = P.tid & 63;
    { const int Mr = pst[33] * 256; pg8::Gemm g{hh, wmoe_d, Mr, D, DFF}; pg8::MoeOrder S; S.init(Mr, D, P.G, (int)blockIdx.x); S.te = pst + 36; S.estride = (size_t)D * DFF; S.stok = slot_tok; pg8::EpiBf16 E{ob, D};
      pg8::gemm_phase<pg8::EpiBf16, pg8::MoeOrder, false, true>(P.lds, g, S, E, P.tid); }
    }
    GRID_BAR();
    _Pragma("unroll") for (int rep_ = 0; rep_ < (REP_PHASE == 11 ? 2 : 1); ++rep_) if (PHON(11)) { if (rep_) GRID_BAR(); Frame P = F; P.tid = TID_RELOAD(); P.lane = P.tid & 63;
    phase_moe_combine<0>(P, xres, ob, slot_of, tok_w, norm_mix + D, hn);
    conv_moe(P, moe_wg + (size_t)NEXP * D * DFF, moe_wu + (size_t)NEXP * D * DFF, moe_wd + (size_t)NEXP * DFF * D, wmoe_gu, wmoe_d);
    }
    GRID_BAR();
    _Pragma("unroll") for (int rep_ = 0; rep_ < (REP_PHASE == 12 ? 2 : 1); ++rep_) if (PHON(12)) { if (rep_) GRID_BAR(); Frame P = F; P.tid = TID_RELOAD(); P.lane = P.tid & 63;
    { pg8::Gemm g{hn, wdi, T, PROJW, D}; pg8::StaticOrder S; S.init(T, PROJW, P.G, (int)blockIdx.x); pg8::EpiHeads<1> E{proj};
      pg8::gemm_phase<pg8::EpiHeads<1>, pg8::StaticOrder, false, true>(P.lds, g, S, E, P.tid); }
    GRID_BAR();
    att::norms_phase(P, proj, (float*)(ws + WS_NRM));
    }
    GRID_BAR();
    _Pragma("unroll") for (int rep_ = 0; rep_ < (REP_PHASE == 13 ? 2 : 1); ++rep_) if (PHON(13)) { if (rep_) GRID_BAR(); Frame P = F; P.tid = TID_RELOAD(); P.lane = P.tid & 63;
    att::attn_phase(P, proj, (const float*)(ws + WS_NRM), ctl + CW_QUEUE, buf1, buf2);
    }
    GRID_BAR();
    _Pragma("unroll") for (int rep_ = 0; rep_ < (REP_PHASE == 14 ? 2 : 1); ++rep_) if (PHON(14)) { if (rep_) GRID_BAR(); Frame P = F; P.tid = TID_RELOAD(); P.lane = P.tid & 63;
    phase_subln(P, buf1, buf2, lq1, lk1, lq2, lk2, diff_subln, hn);
    }
    GRID_BAR();
    _Pragma("unroll") for (int rep_ = 0; rep_ < (REP_PHASE == 15 ? 2 : 1); ++rep_) if (PHON(15)) { if (rep_) GRID_BAR(); Frame P = F; P.tid = TID_RELOAD(); P.lane = P.tid & 63;
    { pg8::Gemm g{hn, wdo, T, D, D}; pg8::StaticOrder S; S.init(T, D, P.G, (int)blockIdx.x); pg8::EpiResF32 E{xres, xres, D};
      pg8::gemm_phase<pg8::EpiResF32, pg8::StaticOrder>(P.lds, g, S, E, P.tid); }
    }
    GRID_BAR();
    _Pragma("unroll") for (int rep_ = 0; rep_ < (REP_PHASE == 16 ? 2 : 1); ++rep_) if (PHON(16)) { if (rep_) GRID_BAR(); Frame P = F; P.tid = TID_RELOAD(); P.lane = P.tid & 63;
    phase_norm_route(P, xres, norm_ffn + D, wp_r1, hn, tok_e, tok_p, tok_w, ctl + CW_CNT1);
    }
    GRID_BAR();
    _Pragma("unroll") for (int rep_ = 0; rep_ < (REP_PHASE == 17 ? 2 : 1); ++rep_) if (PHON(17)) { if (rep_) GRID_BAR(); Frame P = F; P.tid = TID_RELOAD(); P.lane = P.tid & 63;
    moe_tables(P, ctl + CW_CNT1);
    phase_moe_slots(P, tok_e, tok_p, ctl + CW_CNT1, slot_of, slot_tok);
    }
    GRID_BAR();
    _Pragma("unroll") for (int rep_ = 0; rep_ < (REP_PHASE == 18 ? 2 : 1); ++rep_) if (PHON(18)) { if (rep_) GRID_BAR(); Frame P = F; P.tid = TID_RELOAD(); P.lane = P.tid & 63;
    { const int Mr = pst[33] * 256; pg8::Gemm g{hn, wmoe_gu, Mr, 1024, D}; pg8::MoeOrder S; S.init(Mr, 1024, P.G, (int)blockIdx.x); S.te = pst + 36; S.estride = (size_t)1024 * D; S.stok = slot_tok; pg8::EpiSiluMul E{(unsigned char*)hh};
      pg8::gemm_phase<pg8::EpiSiluMul, pg8::MoeOrder, true, true>(P.lds, g, S, E, P.tid); }
    }
    GRID_BAR();
    _Pragma("unroll") for (int rep_ = 0; rep_ < (REP_PHASE == 19 ? 2 : 1); ++rep_) if (PHON(19)) { if (rep_) GRID_BAR(); Frame P = F; P.tid = TID_RELOAD(); P.lane = P.tid & 63;
    { const int Mr = pst[33] * 256; pg8::Gemm g{hh, wmoe_d, Mr, D, DFF}; pg8::MoeOrder S; S.init(Mr, D, P.G, (int)blockIdx.x); S.te = pst + 36; S.estride = (size_t)D * DFF; S.stok = slot_tok; pg8::EpiBf16 E{ob, D};
      pg8::gemm_phase<pg8::EpiBf16, pg8::MoeOrder, false, true>(P.lds, g, S, E, P.tid); }
    }
    GRID_BAR();
    _Pragma("unroll") for (int rep_ = 0; rep_ < (REP_PHASE == 20 ? 2 : 1); ++rep_) if (PHON(20)) { if (rep_) GRID_BAR(); Frame P = F; P.tid = TID_RELOAD(); P.lane = P.tid & 63;
    phase_moe_combine<1>(P, xres, ob, slot_of, tok_w, final_norm, hn);
    }
#if PROBE
    { GRID_BAR(); const float c = sqrtf(0.1f * __uint_as_float(xb_ld(ctl + CW_PROBE)));
      for (size_t i = (size_t)blockIdx.x * 512 + F.tid; i < (size_t)T * D; i += (size_t)gridDim.x * 512) xres[i] = c; }
#endif
}

#undef x_in
#undef norm_mix
#undef norm_ffn
#undef gla_w_in
#undef gla_wgu
#undef gla_bg
#undef gla_norm
#undef gla_w_out
#undef diff_w_in
#undef lq1
#undef lk1
#undef lq2
#undef lk2
#undef diff_subln
#undef diff_w_out
#undef moe_wgrp
#undef moe_wexp
#undef moe_wg
#undef moe_wu
#undef moe_wd
#undef final_norm
#undef xres
#undef gz
#undef tok_e
#undef tok_p
#undef tok_w
#undef slot_of
#undef slot_tok
#undef ws
#undef ctl
#undef adec
#undef pcum
#undef sfin
#undef wp_gz
#undef wp_r0
#undef wp_r1
#undef wgi
#undef wgo
#undef wdi
#undef wdo
#undef wmoe_gu
#undef wmoe_d
#undef hn
#undef proj
#undef buf1
#undef buf2
#undef ag
#undef ob
#undef hh
#if DIAG
constexpr size_t WS_DIAG = WS_END;
constexpr int NSAVE = 64;
__device__ inline unsigned hsh(unsigned x) { x ^= x >> 16; x *= 0x7feb352dU; x ^= x >> 15; x *= 0x846ca68bU; x ^= x >> 16; return x; }
__device__ inline void rep(unsigned* w, double got, double ref, double scale) { double e = fabs(got - ref) / (fabs(ref) + scale); float ef = (float)e; if (!(ef == ef) || ef > 1e30f) ef = 1e30f; atomicMax(w, __float_as_uint(ef)); }
__device__ inline double bfd(bf16_t v) { return (double)bf2f(v); }
#define GTID (blockIdx.x * blockDim.x + threadIdx.x)
#define GSTR (gridDim.x * blockDim.x)

__global__ void ck_weights(const float* gla_w_in, const float* gla_w_out, const float* diff_w_in, const float* diff_w_out, const bf16_t* wgi, const bf16_t* wgo, const bf16_t* wdi, const bf16_t* wdo,
                           const float* norm_mix, const float* norm_ffn, const float* wgrp, const float* wexp, const float* wp_gz, const float* wp_r0, const float* wp_r1, unsigned* w) {
    for (unsigned i = GTID; i < 65536u; i += GSTR) { const unsigned r = hsh(i * 3u + 1u), r2 = hsh(i * 7u + 5u);
        const int n = r % 6144u, k = r2 % 2048u, n2 = n % 2048;
        rep(w, bfd(wgi[(size_t)n * D + k]), gla_w_in[(size_t)k * GLA_INW + n], 0.02); rep(w, bfd(wdi[(size_t)n * D + k]), diff_w_in[(size_t)k * PROJW + n], 0.02);
        rep(w, bfd(wgo[(size_t)n2 * D + k]), gla_w_out[(size_t)k * D + n2], 0.02); rep(w, bfd(wdo[(size_t)n2 * D + k]), diff_w_out[(size_t)k * D + n2], 0.02);
        const int s = r % 128u, ln = (r >> 7) % 64u, e4 = (r >> 13) & 3, kk = 16 * s + 4 * (ln >> 4) + e4, col = ln & 15, nt = (r >> 15) % 3u, col3 = 16 * nt + col;
        rep(w, wp_gz[(s * 64 + ln) * 4 + e4], (double)norm_mix[kk] * gla_w_in[(size_t)kk * GLA_INW + PROJW + col], 0.02);
        for (int L = 0; L < 2; ++L) { const float* gr = wgrp + (size_t)L * D * 4; const float* ex = wexp + (size_t)L * D * 32; const float* nf = norm_ffn + L * D;
            const double ref = col3 < 4 ? gr[kk * 4 + col3] : (col3 < 36 ? ex[kk * 32 + col3 - 4] : 0.0);
            rep(w, (L ? wp_r1 : wp_r0)[((s * 3 + nt) * 64 + ln) * 4 + e4], (double)nf[kk] * ref, 0.02); } }
}
__global__ void ck_moew(const float* wg, const float* wu, const float* wd, const bf16_t* GU, const bf16_t* DT, unsigned* w) {
    for (unsigned i = GTID; i < 65536u; i += GSTR) { const unsigned r = hsh(i * 5u + 2u), r2 = hsh(i * 11u + 3u);
        const int e = r % 32u, f = (r >> 5) % 512u, k = r2 % 2048u, n2 = (r2 >> 11) % 2048u, rowg = 256 * (f >> 7) + (f & 127);
        rep(w, bfd(GU[((size_t)e * 1024 + rowg) * D + k]), wg[((size_t)e * D + k) * DFF + f], 0.02); rep(w, bfd(GU[((size_t)e * 1024 + rowg + 128) * D + k]), wu[((size_t)e * D + k) * DFF + f], 0.02);
        rep(w, bfd(DT[((size_t)e * D + n2) * DFF + f]), wd[((size_t)e * DFF + f) * D + n2], 0.05); }
}
__global__ void ck_norm(const float* x, const float* gain, const bf16_t* hn, unsigned* w) {
    for (unsigned i = GTID; i < 4096u; i += GSTR) { const unsigned r = hsh(i * 13u + 7u); const int t = r % (unsigned)T, j = (r >> 15) % 2048u;
        double ss = 0; for (int k = 0; k < D; ++k) { const double v = x[(size_t)t * D + k]; ss += v * v; }
        const double rstd = 1.0 / sqrt(ss / D + 1e-6); rep(w, bfd(hn[(size_t)t * D + j]), x[(size_t)t * D + j] * rstd * gain[j], 1.0); }
}
__global__ void ck_gz(const float* x, const float* gain, const float* gla_w_in, const float* gz, unsigned* w) {
    for (unsigned i = GTID; i < 4096u; i += GSTR) { const unsigned r = hsh(i * 17u + 9u); const int t = r % (unsigned)T, c = (r >> 15) % 16u;
        double ss = 0, dot = 0; for (int k = 0; k < D; ++k) { const double v = x[(size_t)t * D + k]; ss += v * v; dot += v * gain[k] * gla_w_in[(size_t)k * GLA_INW + PROJW + c]; }
        rep(w, gz[(size_t)t * 16 + c], dot / sqrt(ss / D + 1e-6), 1.0); }
}
__global__ void ck_gemm(const bf16_t* A, const bf16_t* Bt, const bf16_t* C, int M, int N, int K, int ldc, double scale, unsigned* w) {
    for (unsigned i = GTID; i < 16384u; i += GSTR) { const unsigned r = hsh(i * 19u + 11u), r2 = hsh(i * 23u + 1u); const int m = r % (unsigned)M, n = r2 % (unsigned)N;
        double s = 0; for (int k = 0; k < K; ++k) s += bfd(A[(size_t)m * K + k]) * bfd(Bt[(size_t)n * K + k]);
        rep(w, bfd(C[(size_t)m * ldc + n]), s, scale); }
}
__global__ void ck_proj(const bf16_t* A, const bf16_t* Bt, const bf16_t* proj, int layer, unsigned* w) {
    for (unsigned i = GTID; i < 16384u; i += GSTR) { const unsigned r = hsh(i * 19u + 11u), r2 = hsh(i * 23u + 1u); const int m = r % (unsigned)T, n = r2 % (unsigned)PROJW, b = m >> 14, t = m & (SEQ - 1);
        double s = 0; for (int k = 0; k < D; ++k) s += bfd(A[(size_t)m * D + k]) * bfd(Bt[(size_t)n * D + k]);
        size_t off;
        if (layer == 0) { if (n < 1024) off = gq_off(b, t, n >> 8) + (n & 255); else if (n < 2048) off = GK0 + gq_off(b, t, (n - 1024) >> 8) + (n & 255); else if (n < 4096) off = gv_off(b, t, (n - 2048) >> 9) + (n & 511); else off = GR0 + (size_t)m * 2048 + (n - 4096); }
        else { if (n < 2048) off = dq_off(b, t, n >> 8, (n >> 7) & 1) + (n & 127); else if (n < 4096) off = DK0 + dq_off(b, t, (n - 2048) >> 8, (n >> 7) & 1) + (n & 127); else off = dv_off(b, t, (n - 4096) >> 8) + (n & 255); }
        rep(w, bfd(proj[off]), s, 1.0); }
}
__device__ inline int srow(int i) { return (int)(hsh(i * 29u + 13u) % (unsigned)T); }
__global__ void ck_save(const float* x, float* save) { for (unsigned i = GTID; i < (unsigned)NSAVE * D; i += GSTR) save[i] = x[(size_t)srow(i / D) * D + (i % D)]; }
__global__ void ck_gemm_res(const bf16_t* A, const bf16_t* Bt, const float* base, int saved, const float* out, unsigned* w) {
    for (unsigned i = GTID; i < (unsigned)NSAVE * 64u; i += GSTR) { const int si = i / 64, t = srow(si), n = hsh(i * 31u + 5u) % 2048u;
        double s = 0; for (int k = 0; k < D; ++k) s += bfd(A[(size_t)t * D + k]) * bfd(Bt[(size_t)n * D + k]);
        const double b = saved ? base[(size_t)si * D + n] : base[(size_t)t * D + n];
        rep(w, out[(size_t)t * D + n], b + s, 1.0); }
}
__global__ void ck_gate(const float* gz, const float* wgu, const float* bg, const bf16_t* proj, const bf16_t* kdT, const float* adec, unsigned* w) {
    for (unsigned i = GTID; i < 4096u; i += GSTR) { const unsigned r = hsh(i * 37u + 3u); const int bc = r % 512u, j = (r >> 9) % 1024u, tq = (r >> 19) % 64u;
        double run = 0, ct = 0;
        for (int t = 0; t < 64; ++t) { double z = bg[j]; for (int q = 0; q < 16; ++q) z += (double)gz[((size_t)bc * 64 + t) * 16 + q] * wgu[q * 1024 + j];
            const double ls = fmin(z, 0.0) - log1p(exp(-fabs(z))); run += ls / 16.0; if (t == tq) ct = run; }
        rep(w, adec[(size_t)bc * 1024 + j], exp(run), 1.0);
        rep(w, bfd(kdT[((size_t)bc * 1024 + j) * 64 + tq]), bfd(proj[GK0 + gq_off(bc >> 8, (bc & 255) * 64 + tq, j >> 8) + (j & 255)]) * exp(run - ct), 1.0); }
}
__global__ void ck_scan(const bf16_t* proj, const bf16_t* kdT, const float* adec, const bf16_t* o, unsigned* w) {
    const int wv = GTID / 64, lane = threadIdx.x & 63, nw = GSTR / 64;
    const int cl[8] = {0, 1, 3, 17, 100, 255, 2, 64};
    for (int s = wv; s < 96; s += nw) { const unsigned r = hsh(s * 41u + 17u); const int b = r & 1, c = cl[s % 8], tl = (r >> 1) % 64u, h = (r >> 7) % 4u, vc = (r >> 9) % 512u;
        float S[4] = {0.f, 0.f, 0.f, 0.f};
        for (int cc = 0; cc <= c; ++cc) { const size_t bc = (size_t)b * NCH + cc;
            for (int q = 0; q < 4; ++q) { const int kr = h * 256 + lane * 4 + q; float a = 0.f;
                for (int t = 0; t < 64; ++t) a += bf2f(kdT[(bc * 1024 + kr) * 64 + t]) * bf2f(proj[gv_off(b, cc * 64 + t, h) + vc]);
                S[q] = adec[bc * 1024 + kr] * S[q] + a; } }
        float part = 0.f; const size_t tok = (size_t)b * SEQ + c * 64 + tl;
        for (int q = 0; q < 4; ++q) part += bf2f(proj[gq_off(b, c * 64 + tl, h) + lane * 4 + q]) * S[q];
        for (int of = 1; of < 64; of <<= 1) part += __shfl_xor(part, of);
        if (lane == 0) rep(w, bfd(o[tok * D + h * 512 + vc]), part / 16.0, 2.0); }
}
__global__ void ck_gnorm(const bf16_t* o, const bf16_t* proj, const float* gn, const bf16_t* y, unsigned* w) {
    for (unsigned i = GTID; i < 8192u; i += GSTR) { const unsigned r = hsh(i * 43u + 19u); const int t = r % (unsigned)T, h = (r >> 15) % 4u, j = (r >> 17) % 512u;
        double ss = 0; for (int k = 0; k < 512; ++k) { const double v = bfd(o[(size_t)t * D + h * 512 + k]); ss += v * v; }
        const double rr = bfd(proj[GR0 + (size_t)t * 2048 + h * 512 + j]);
        rep(w, bfd(y[(size_t)t * D + h * 512 + j]), bfd(o[(size_t)t * D + h * 512 + j]) / sqrt(ss / 512 + 1e-6) * gn[j] * rr / (1.0 + exp(-rr)), 1.0); }
}
__global__ void ck_route(const float* x, const float* gain, const float* wgrp, const float* wexp, const int* tok_e, const int* tok_p, const float* tok_w, const unsigned* cnt, unsigned* w) {
    for (unsigned i = GTID; i < 512u; i += GSTR) { const int t = hsh(i * 47u + 23u) % (unsigned)T;
        double ss = 0; for (int k = 0; k < D; ++k) { const double v = x[(size_t)t * D + k]; ss += v * v; }
        const double rstd = 1.0 / sqrt(ss / D + 1e-6);
        double gl[4] = {0, 0, 0, 0};
        for (int k = 0; k < D; ++k) { const double v = x[(size_t)t * D + k] * rstd * gain[k]; for (int q = 0; q < 4; ++q) gl[q] += v * wgrp[k * 4 + q]; }
        int gi = 0; for (int q = 1; q < 4; ++q) if (gl[q] > gl[gi]) gi = q;
        double gs = 0; for (int q = 0; q < 4; ++q) gs += exp(gl[q] - gl[gi]);
        double el[8] = {0, 0, 0, 0, 0, 0, 0, 0};
        for (int k = 0; k < D; ++k) { const double v = x[(size_t)t * D + k] * rstd * gain[k]; for (int q = 0; q < 8; ++q) el[q] += v * wexp[k * 32 + gi * 8 + q]; }
        int i1 = 0; for (int q = 1; q < 8; ++q) if (el[q] > el[i1]) i1 = q;
        int i2 = (i1 == 0) ? 1 : 0; for (int q = 0; q < 8; ++q) if (q != i1 && el[q] > el[i2]) i2 = q;
        const double eb = exp(el[i2] - el[i1]);
        const int e1 = tok_e[2 * t], e2 = tok_e[2 * t + 1];
        double third = -1e30; for (int q = 0; q < 8; ++q) if (q != i1 && q != i2 && el[q] > third) third = el[q];
        const bool tie = (el[i2] - third) < 1e-4 || (el[i1] - el[i2]) < 1e-4;
        if (!tie) { rep(w, e1, gi * 8 + i1, 1.0); rep(w, e2, gi * 8 + i2, 1.0);
            rep(w, tok_w[2 * t], 1.0 / gs / (1.0 + eb), 0.3); rep(w, tok_w[2 * t + 1], eb / gs / (1.0 + eb), 0.3); }
        if ((unsigned)tok_p[2 * t] >= cnt[64 * (e1 & 31)] || (unsigned)tok_p[2 * t + 1] >= cnt[64 * (e2 & 31)]) rep(w, 9.0, 0.0, 1.0); }
}
__global__ void ck_gather(const int* tok_e, const int* tok_p, const int* slot_of, const unsigned* cnt, const bf16_t* hn, const int* ag  , unsigned* w) {
    for (unsigned i = GTID; i < 8192u; i += GSTR) { const unsigned r = hsh(i * 53u + 29u); const int a = r % (2u * T), k = (r >> 16) % 2048u, e = tok_e[a] & 31;
        int ps = 0; for (int q = 0; q < e; ++q) ps += ((int)cnt[64 * q] + 255) & ~255;
        const int slot = slot_of[a];
        rep(w, slot, ps + tok_p[a], 1.0);
        if (slot >= 0 && slot < MAX_TILES * 256) rep(w, (double)ag[slot], (double)(a >> 1), 1.0); (void)hn; (void)k; }
}
__global__ void ck_moe1(const int* tok_e, const int* slot_of, const bf16_t* ag, const float* wg, const float* wu, const bf16_t* hh, unsigned* w) {
    for (unsigned i = GTID; i < 8192u; i += GSTR) { const unsigned r = hsh(i * 59u + 31u); const int a = r % (2u * T), f = (r >> 16) % 512u, e = tok_e[a] & 31, slot = slot_of[a];
        if (slot < 0 || slot >= MAX_TILES * 256) { rep(w, 9.0, 0.0, 1.0); continue; }
        double g = 0, u = 0; for (int k = 0; k < D; ++k) { const double v = bfd(ag[(size_t)(a >> 1) * D + k]); g += v * wg[((size_t)e * D + k) * DFF + f]; u += v * wu[((size_t)e * D + k) * DFF + f]; }
        rep(w, bfd(hh[(size_t)slot * DFF + f]), g / (1.0 + exp(-g)) * u, 0.5); }
}
__global__ void ck_moe2(const int* tok_e, const int* slot_of, const bf16_t* hh, const float* wd, const bf16_t* ob, unsigned* w) {
    for (unsigned i = GTID; i < 8192u; i += GSTR) { const unsigned r = hsh(i * 61u + 37u); const int a = r % (2u * T), n = (r >> 16) % 2048u, e = tok_e[a] & 31, slot = slot_of[a];
        if (slot < 0 || slot >= MAX_TILES * 256) { rep(w, 9.0, 0.0, 1.0); continue; }
        double s = 0; for (int f = 0; f < DFF; ++f) s += bfd(hh[(size_t)slot * DFF + f]) * wd[((size_t)e * DFF + f) * D + n];
        rep(w, bfd(ob[(size_t)slot * D + n]), s, 0.3); }
}
__global__ void ck_combine(const float* save, const bf16_t* ob, const int* slot_of, const float* tok_w, const float* gain, const float* x, const bf16_t* hn, int mode, unsigned* w) {
    for (unsigned i = GTID; i < (unsigned)NSAVE * 32u; i += GSTR) { const int si = i / 32, t = srow(si), j = hsh(i * 67u + 41u) % 2048u;
        const int s0 = slot_of[2 * t], s1 = slot_of[2 * t + 1]; const double w0 = tok_w[2 * t], w1 = tok_w[2 * t + 1];
        double ss = 0, xj = 0; for (int k = 0; k < D; ++k) { const double v = save[(size_t)si * D + k] + w0 * bfd(ob[(size_t)s0 * D + k]) + w1 * bfd(ob[(size_t)s1 * D + k]); ss += v * v; if (k == j) xj = v; }
        const double y = xj / sqrt(ss / D + 1e-6) * gain[j];
        if (mode == 0) { rep(w, x[(size_t)t * D + j], xj, 1.0); rep(w, bfd(hn[(size_t)t * D + j]), y, 1.0); } else rep(w, x[(size_t)t * D + j], y, 1.0); }
}
__global__ void ck_attn(const bf16_t* proj, const bf16_t* o1, const bf16_t* o2, unsigned* w) {
    const int wv = GTID / 64, lane = threadIdx.x & 63, nw = GSTR / 64;
    const int tl[12] = {0, 1, 63, 64, 100, 255, 256, 1000, 4095, 8191, 16320, 16383};
    for (int s = wv; s < 96; s += nw) { const unsigned r = hsh(s * 71u + 43u); const int b = r & 1, h = (r >> 1) % 8u, sub = (r >> 4) & 1, t = tl[s % 12], dv0 = (r >> 5) % 253u;
        const double slope = exp2(-(double)(h + 1)); const int kend = 64 * (t / 64 + 1);
        const bf16_t* qp = proj + dq_off(b, t, h, sub);
        double mx = -1e300;
        for (int j = lane; j < kend; j += 64) { const bf16_t* kp = proj + DK0 + dq_off(b, j, h, sub); double d = 0; for (int q = 0; q < 128; ++q) d += bfd(qp[q]) * bfd(kp[q]);
            const double sc = d * 0.08838834764831845 - slope * fabs((double)(t - j)); if (sc > mx) mx = sc; }
        for (int of = 1; of < 64; of <<= 1) { const double o_ = __shfl_xor(mx, of); if (o_ > mx) mx = o_; }
        double l = 0, acc[4] = {0, 0, 0, 0};
        for (int j = lane; j < kend; j += 64) { const bf16_t* kp = proj + DK0 + dq_off(b, j, h, sub); double d = 0; for (int q = 0; q < 128; ++q) d += bfd(qp[q]) * bfd(kp[q]);
            const double p = exp(d * 0.08838834764831845 - slope * fabs((double)(t - j)) - mx); l += p;
            const bf16_t* vp = proj + dv_off(b, j, h) + dv0; for (int q = 0; q < 4; ++q) acc[q] += p * bfd(vp[q]); }
        for (int of = 1; of < 64; of <<= 1) { l += __shfl_xor(l, of); for (int q = 0; q < 4; ++q) acc[q] += __shfl_xor(acc[q], of); }
        if (lane == 0) for (int q = 0; q < 4; ++q) rep(w, bfd((sub ? o2 : o1)[((size_t)b * SEQ + t) * D + h * 256 + dv0 + q]), acc[q] / l, 0.2); }
}
__global__ void ck_subln(const bf16_t* o1, const bf16_t* o2, const float* lq1, const float* lk1, const float* lq2, const float* lk2, const float* sg, const bf16_t* y, unsigned* w) {
    double d1 = 0, d2 = 0; for (int k = 0; k < 128; ++k) { d1 += (double)lq1[k] * lk1[k]; d2 += (double)lq2[k] * lk2[k]; }
    const double li = 0.8 - 0.6 * exp(-0.3), lam = exp(d1) - exp(d2) + li;
    for (unsigned i = GTID; i < 8192u; i += GSTR) { const unsigned r = hsh(i * 73u + 47u); const int t = r % (unsigned)T, h = (r >> 15) % 8u, j = (r >> 18) % 256u;
        double ss = 0, dj = 0; for (int k = 0; k < 256; ++k) { const double v = bfd(o1[(size_t)t * D + h * 256 + k]) - lam * bfd(o2[(size_t)t * D + h * 256 + k]); ss += v * v; if (k == j) dj = v; }
        rep(w, bfd(y[(size_t)t * D + h * 256 + j]), dj / sqrt(ss / 256 + 1e-6) * sg[j] * (1.0 - li), 1.0); }
}
__global__ void ck_final(const unsigned* words, int nst, float* out, int n) {
    int val = 0;
    for (int s = 0; s < nst; ++s) { const float e = __uint_as_float(words[s]); if (e >= 0.03125f) { val = 4 * s + (e < 0.25f ? 1 : (e < 4.f ? 2 : 3)); break; } }
    const float c = sqrtf(0.1f * (float)val);
    for (int i = GTID; i < n; i += GSTR) out[i] = c;
}
#endif

extern "C" void kernel_launch(void* const* d_in, const int* in_sizes, int n_in, void* d_out, int out_size, void* d_ws, size_t ws_size, hipStream_t stream) {
    static int grid = 0;
    if (grid == 0) {
        if (n_in != 21 || out_size != T * D || ws_size < WS_END + 2 * MiB) { fprintf(stderr, "kernel_launch: unexpected shapes (n_in %d out %d ws %zu)\n", n_in, out_size, ws_size); grid = -1; return; }
        if (hipFuncSetAttribute((const void*)hybrid_fwd, hipFuncAttributeMaxDynamicSharedMemorySize, LDS_BYTES) != hipSuccess) { fprintf(stderr, "kernel_launch: hipFuncSetAttribute failed\n"); grid = -1; return; }
        int dev = 0, cus = 0, per_cu = 0;
        (void)hipGetDevice(&dev); (void)hipDeviceGetAttribute(&cus, hipDeviceAttributeMultiprocessorCount, dev);
        if (hipOccupancyMaxActiveBlocksPerMultiprocessor(&per_cu, (const void*)hybrid_fwd, NWAVES * 64, LDS_BYTES) != hipSuccess || per_cu < 1) fprintf(stderr, "kernel_launch: occupancy query says %d\n", per_cu);
        (void)hipGetLastError();
        grid = cus > 0 ? cus : 256;
    }
    if (grid < 0) return;
    Args a{};
    for (int i = 0; i < 21; ++i) a.in[i] = (const float*)d_in[i];
    a.out = (float*)d_out; a.ws = (unsigned char*)d_ws; a.upto = 99; a.pad1 = 0;
#if !DIAG
    (void)hipMemsetAsync((char*)d_ws + WS_CTL, 0, CTL_ZERO_BYTES, stream);
    hipLaunchKernelGGL(hybrid_fwd, dim3(grid), dim3(NWAVES * 64), LDS_BYTES, stream, a);
#else
    {
        unsigned char* ws = (unsigned char*)d_ws; const float* const* in = a.in;
        unsigned* words = (unsigned*)(ws + WS_DIAG); float* save = (float*)(ws + WS_DIAG + 65536);
        (void)hipMemsetAsync(words, 0, 65536, stream);
        float* gz = (float*)(ws + WS_GZ); int* tok_e = (int*)(ws + WS_TOKE); int* tok_p = (int*)(ws + WS_TOKP); float* tok_w = (float*)(ws + WS_TOKW); int* slot_of = (int*)(ws + WS_SLOT);
        float* adec = (float*)(ws + WS_ADEC); float* wp_gz = (float*)(ws + WS_WPGZ); float* wp_r0 = (float*)(ws + WS_WPR0); float* wp_r1 = (float*)(ws + WS_WPR1);
        bf16_t* wgi = (bf16_t*)(ws + WS_WGI); bf16_t* wgo = (bf16_t*)(ws + WS_WGO); bf16_t* wdi = (bf16_t*)(ws + WS_WDI); bf16_t* wdo = (bf16_t*)(ws + WS_WDO);
        bf16_t* gu = (bf16_t*)(ws + WS_WMOE); bf16_t* dt = (bf16_t*)(ws + WS_WMOE_D);
        bf16_t* hn = (bf16_t*)(ws + WS_HN); bf16_t* proj = (bf16_t*)(ws + WS_PROJ); bf16_t* buf1 = (bf16_t*)(ws + WS_BUF1); bf16_t* buf2 = (bf16_t*)(ws + WS_BUF2);
        bf16_t* ag = (bf16_t*)(ws + WS_AG); bf16_t* ob = (bf16_t*)(ws + WS_OB); bf16_t* hh = (bf16_t*)(ws + WS_H);
        unsigned* ctl = (unsigned*)(ws + WS_CTL); float* xres = (float*)d_out;
        const size_t L1W = (size_t)NEXP * D * DFF;
        for (int st = 0; st <= 20; ++st) {
            (void)hipMemsetAsync((char*)d_ws + WS_CTL, 0, CTL_ZERO_BYTES, stream);
            a.upto = st;
            hipLaunchKernelGGL(hybrid_fwd, dim3(grid), dim3(NWAVES * 64), LDS_BYTES, stream, a);
            unsigned* w = words + st;
            switch (st) {
            case 0: ck_weights<<<256, 256, 0, stream>>>(in[3], in[7], in[8], in[14], wgi, wgo, wdi, wdo, in[1], in[2], in[15], in[16], wp_gz, wp_r0, wp_r1, w); break;
            case 1: ck_norm<<<64, 64, 0, stream>>>(in[0], in[1], hn, w); ck_gz<<<64, 64, 0, stream>>>(in[0], in[1], in[3], gz, w); break;
            case 2: ck_proj<<<256, 64, 0, stream>>>(hn, wgi, proj, 0, w); break;
            case 3: ck_gate<<<64, 64, 0, stream>>>(gz, in[4], in[5], proj, buf1, adec, w); break;
            case 4: ck_scan<<<96, 64, 0, stream>>>(proj, buf1, adec, buf2, w); ck_moew<<<256, 256, 0, stream>>>(in[17], in[18], in[19], gu, dt, w); break;
            case 5: ck_gnorm<<<128, 64, 0, stream>>>(buf2, proj, in[6], hn, w); break;
            case 6: ck_gemm_res<<<64, 64, 0, stream>>>(hn, wgo, in[0], 0, xres, w); break;
            case 7: ck_norm<<<64, 64, 0, stream>>>(xres, in[2], hn, w); ck_route<<<8, 64, 0, stream>>>(xres, in[2], in[15], in[16], tok_e, tok_p, tok_w, ctl + CW_CNT0, w); break;
            case 8: ck_gather<<<128, 64, 0, stream>>>(tok_e, tok_p, slot_of, ctl + CW_CNT0, hn, (const int*)(ws + WS_STOK), w); break;
            case 9: ck_moe1<<<128, 64, 0, stream>>>(tok_e, slot_of, hn, in[17], in[18], hh, w); break;
            case 10: ck_moe2<<<128, 64, 0, stream>>>(tok_e, slot_of, hh, in[19], ob, w); ck_save<<<64, 256, 0, stream>>>(xres, save); break;
            case 11: ck_combine<<<32, 64, 0, stream>>>(save, ob, slot_of, tok_w, in[1] + D, xres, hn, 0, w); ck_moew<<<256, 256, 0, stream>>>(in[17] + L1W, in[18] + L1W, in[19] + L1W, gu, dt, w); break;
            case 12: ck_proj<<<256, 64, 0, stream>>>(hn, wdi, proj, 1, w); break;
            case 13: ck_attn<<<96, 64, 0, stream>>>(proj, buf1, buf2, w); break;
            case 14: ck_subln<<<128, 64, 0, stream>>>(buf1, buf2, in[9], in[10], in[11], in[12], in[13], hn, w); ck_save<<<64, 256, 0, stream>>>(xres, save); break;
            case 15: ck_gemm_res<<<64, 64, 0, stream>>>(hn, wdo, save, 1, xres, w); break;
            case 16: ck_norm<<<64, 64, 0, stream>>>(xres, in[2] + D, hn, w); ck_route<<<8, 64, 0, stream>>>(xres, in[2] + D, in[15] + (size_t)D * 4, in[16] + (size_t)D * 32, tok_e, tok_p, tok_w, ctl + CW_CNT1, w); break;
            case 17: ck_gather<<<128, 64, 0, stream>>>(tok_e, tok_p, slot_of, ctl + CW_CNT1, hn, (const int*)(ws + WS_STOK), w); break;
            case 18: ck_moe1<<<128, 64, 0, stream>>>(tok_e, slot_of, hn, in[17] + L1W, in[18] + L1W, hh, w); break;
            case 19: ck_moe2<<<128, 64, 0, stream>>>(tok_e, slot_of, hh, in[19] + L1W, ob, w); ck_save<<<64, 256, 0, stream>>>(xres, save); break;
            case 20: ck_combine<<<32, 64, 0, stream>>>(save, ob, slot_of, tok_w, in[20], xres, hn, 1, w); break;
            }
        }
        ck_final<<<1024, 256, 0, stream>>>(words, 21, (float*)d_out, out_size);
    }
#endif
}
```

```cpp
#ifndef DIAG
#define DIAG 0
#endif
#ifndef PROBE
#define PROBE 0
#endif
#ifndef REP_PHASE
#define REP_PHASE -1
#endif
#include <hip/hip_runtime.h>
#include <cstdio>
#include <cstdint>

#define LAS __attribute__((address_space(3)))
#define GAS __attribute__((address_space(1)))
typedef unsigned short bf16_t;
typedef short bf16x8 __attribute__((ext_vector_type(8)));
typedef short s16x4 __attribute__((ext_vector_type(4)));
typedef float f32x4 __attribute__((ext_vector_type(4)));
typedef float f32x2 __attribute__((ext_vector_type(2)));
typedef float f32x16 __attribute__((ext_vector_type(16)));
typedef unsigned u32x4 __attribute__((ext_vector_type(4)));
typedef unsigned u32x2 __attribute__((ext_vector_type(2)));

constexpr int D = 2048, SEQ = 16384, NBATCH = 2, T = NBATCH * SEQ, CHUNK = 64, NCH = SEQ / CHUNK;
constexpr int GLA_H = 4, GLA_DK = 256, GLA_DV = 512, GLA_DKT = 1024, GLA_INW = 6160, PROJW = 6144;
constexpr int DIFF_H = 8;
constexpr int NEXP = 32, DFF = 512;
constexpr float RMS_EPS = 1e-6f;
constexpr float LAMBDA_INIT = 0.35550906759f;
constexpr int MAX_TILES = 288;

constexpr size_t MiB = 1u << 20;
constexpr size_t WS_CTL = 0, CTL_ZERO_BYTES = 1 * MiB;
constexpr size_t WS_GZ = 2 * MiB;
constexpr size_t WS_TOKE = 4 * MiB;
constexpr size_t WS_TOKP = WS_TOKE + 256 * 1024;
constexpr size_t WS_TOKW = WS_TOKP + 256 * 1024;
constexpr size_t WS_SLOT = WS_TOKW + 256 * 1024;
constexpr size_t WS_STOK = 5 * MiB;
constexpr size_t WS_ADEC = 8 * MiB;
constexpr size_t WS_WPGZ = 10 * MiB;
constexpr size_t WS_WPR0 = 10 * MiB + 256 * 1024;
constexpr size_t WS_WPR1 = 11 * MiB;
constexpr size_t WS_NRM = 12 * MiB;
constexpr size_t WS_PCUM = 13 * MiB;
constexpr size_t WS_SFIN = 14 * MiB;
constexpr size_t WS_WGI = 16 * MiB, WS_WGO = 40 * MiB, WS_WDI = 48 * MiB, WS_WDO = 72 * MiB;
constexpr size_t WS_WMOE = 80 * MiB;
constexpr size_t WS_WMOE_D = WS_WMOE + 128 * MiB;
constexpr size_t WS_WMOE1 = WS_WMOE + 64 * MiB, WS_WMOE1_D = WS_WMOE + 160 * MiB;
constexpr size_t WS_HN = 272 * MiB;
constexpr size_t WS_PROJ = 400 * MiB;
constexpr size_t WS_BUF1 = 784 * MiB;
constexpr size_t WS_BUF2 = 912 * MiB;
constexpr size_t WS_AG = 400 * MiB;
constexpr size_t WS_OB = 688 * MiB;
constexpr size_t WS_H = 976 * MiB;
constexpr size_t WS_END = 1048 * MiB;
constexpr int CW_BAR = 4096;
constexpr int CW_PROBE = 8320;
constexpr int CW_QUEUE = 8192;
constexpr int CW_CNT0 = 16384, CW_CNT1 = 16384 + 32 * 64;


constexpr size_t GK0 = (size_t)T * 1024, GV0 = (size_t)T * 2048, GR0 = (size_t)T * 4096;
constexpr size_t DK0 = (size_t)T * 2048, DV0 = (size_t)T * 4096;
__host__ __device__ __forceinline__ size_t gq_off(int b, int t, int h) { return ((size_t)(b * 4 + h) * SEQ + t) * 256; }
__host__ __device__ __forceinline__ size_t gv_off(int b, int t, int h) { return GV0 + ((size_t)(b * 4 + h) * SEQ + t) * 512; }
__host__ __device__ __forceinline__ size_t dq_off(int b, int t, int h, int sub) { return ((size_t)((b * 8 + h) * 2 + sub) * SEQ + t) * 128; }
__host__ __device__ __forceinline__ size_t dv_off(int b, int t, int h) { return DV0 + ((size_t)(b * 8 + h) * SEQ + t) * 256; }

constexpr int RING_BYTES = 131072;
constexpr int LDSCTL_OFF = RING_BYTES;
constexpr int MISC_OFF = LDSCTL_OFF + 320;
constexpr int TIDS_OFF = LDSCTL_OFF + 8192;
constexpr int TAB_OFF = LDSCTL_OFF + 1024;
constexpr int LDS_BYTES = 147456;
constexpr int NWAVES = 8;

typedef __bf16 bf16x2_t __attribute__((ext_vector_type(2)));
__device__ __forceinline__ unsigned cvt_pk_bf16(float lo, float hi) { const f32x2 v = {lo, hi}; return __builtin_bit_cast(unsigned, __builtin_convertvector(v, bf16x2_t)); }
__device__ __forceinline__ unsigned cvt4_fp8(float a, float b, float c, float d) { int v = __builtin_amdgcn_cvt_pk_fp8_f32(a, b, 0, false); return (unsigned)__builtin_amdgcn_cvt_pk_fp8_f32(c, d, v, true); }
constexpr float W8_SCALE = 64.f;
__device__ __forceinline__ float bf_lo(unsigned w) { return __uint_as_float(w << 16); }
__device__ __forceinline__ float bf_hi(unsigned w) { return __uint_as_float(w & 0xffff0000u); }
__device__ __forceinline__ float bf2f(bf16_t b) { return __uint_as_float(((unsigned)b) << 16); }
__device__ __forceinline__ float wave_sum(float v) {
#pragma unroll
    for (int o = 1; o < 64; o <<= 1) v += __shfl_xor(v, o);
    return v;
}
__device__ __forceinline__ int lane_id() { return (int)__builtin_amdgcn_mbcnt_hi(~0u, __builtin_amdgcn_mbcnt_lo(~0u, 0u)); }
__device__ __forceinline__ int lane_id_volatile() { int l; asm volatile("v_mbcnt_lo_u32_b32 %0, -1, 0\n\tv_mbcnt_hi_u32_b32 %0, -1, %0" : "=v"(l)); return l; }
__device__ __forceinline__ int opq(int v) { asm volatile("" : "+v"(v)); return v; }
#define LDS_WAIT() asm volatile("s_waitcnt lgkmcnt(0)" ::: "memory")
#define VM_WAIT() asm volatile("s_waitcnt vmcnt(0)" ::: "memory")
#define WG_BAR() do { asm volatile("s_waitcnt lgkmcnt(0)" ::: "memory"); __builtin_amdgcn_s_barrier(); asm volatile("" ::: "memory"); } while (0)

namespace pg8 {
constexpr int BM = 256, BK = 64, HALF = 128, HTB = HALF * BK * 2, STAGE_BYTES = 8 * HTB, NXCD = 8, WGM = 8;
__host__ __device__ __forceinline__ int lds_byte(int r, int c) { const int st = (r >> 4) * 2 + (c >> 5), rr = r & 15, cc = c & 31, ob = rr * 64 + cc * 2; return st * 1024 + (ob ^ (((ob >> 9) & 1) << 5)); }
__host__ __device__ __forceinline__ void stage_rc(int b, int& R, int& C) { const int st = b / 1024, sb = b % 1024, swz = sb ^ (((sb >> 9) & 1) << 5); R = (st >> 1) * 16 + swz / 64; C = (st & 1) * 32 + (swz % 64) / 2; }
__host__ __device__ __forceinline__ int perm32(int rho) { const int n = rho >> 4, i = rho & 15; return 8 * (i >> 2) + 4 * n + (i & 3); }

struct Unit { int pm, pn; };
struct Gemm { const bf16_t* A; const bf16_t* Bt; int M, N, K; };

struct StaticOrder {
    int nM, nN, nwg, G, c;
    __device__ void init(int M, int N, int G_, int c_) { nM = M / BM; nN = N / BM; nwg = nM * nN; G = G_; c = c_; }
    __device__ bool next(int i, Unit& u) const {
        const long L = (long)i * G + c; if (L >= nwg) return false;
        int wgid = (int)L; { const int q = nwg / NXCD, r = nwg % NXCD, xcd = wgid % NXCD, off = wgid / NXCD; wgid = (xcd < r ? xcd * (q + 1) : r * (q + 1) + (xcd - r) * q) + off; }
        const int nig = WGM * nN, gid = wgid / nig, fm = gid * WGM, gsz = (nM - fm) < WGM ? (nM - fm) : WGM;
        u.pm = fm + ((wgid % nig) % gsz); u.pn = (wgid % nig) / gsz; return true;
    }
    __device__ __forceinline__ size_t bofs(const Unit&) const { return 0; }
};
struct MoeOrder : StaticOrder {
    const LAS int* te; size_t estride; const int* stok;
    __device__ __forceinline__ size_t bofs(const Unit& u) const { return (size_t)te[u.pm] * estride; }
    __device__ __forceinline__ int arow(int pm, int r) const { const int t = stok[pm * BM + r]; return t < 0 ? 0 : t; }
};

struct EpiBf16 {
    static constexpr bool PERM = true;
    bf16_t* O; int ldc;
    __device__ __forceinline__ void operator()(const f32x4 (&acc)[2][2][4][2], const Unit& u, int wr, int wc, int fr, int fq) const {
        const int row0 = u.pm * BM + wr * 64 + fr, col0 = u.pn * BM + wc * 32 + 8 * fq;
#pragma unroll
        for (int ai = 0; ai < 2; ++ai)
#pragma unroll
            for (int m = 0; m < 4; ++m) { bf16_t* rowp = O + (size_t)(row0 + ai * HALF + m * 16) * ldc + col0;
#pragma unroll
                for (int bj = 0; bj < 2; ++bj) { const f32x4 v0 = acc[ai][bj][m][0], v1 = acc[ai][bj][m][1];
                    u32x4 w; w.x = cvt_pk_bf16(v0[0], v0[1]); w.y = cvt_pk_bf16(v0[2], v0[3]); w.z = cvt_pk_bf16(v1[0], v1[1]); w.w = cvt_pk_bf16(v1[2], v1[3]);
                    *(u32x4*)(rowp + bj * HALF) = w; } }
    }
};
template <int LAYER> struct EpiHeads {
    static constexpr bool PERM = true;
    bf16_t* O;
    __device__ __forceinline__ void operator()(const f32x4 (&acc)[2][2][4][2], const Unit& u, int wr, int wc, int fr, int fq) const {
        const int pn = u.pn, lc = wc * 32 + 8 * fq;
#pragma unroll
        for (int ai = 0; ai < 2; ++ai)
#pragma unroll
            for (int m = 0; m < 4; ++m) { const int row = u.pm * BM + ai * HALF + wr * 64 + m * 16 + fr, b = row >> 14, t = row & (SEQ - 1);
#pragma unroll
                for (int bj = 0; bj < 2; ++bj) { size_t off;
                    if (LAYER == 0) { if (pn < 4) off = gq_off(b, t, pn) + bj * 128 + lc; else if (pn < 8) off = GK0 + gq_off(b, t, pn - 4) + bj * 128 + lc;
                                      else if (pn < 16) off = gv_off(b, t, (pn - 8) >> 1) + ((pn - 8) & 1) * 256 + bj * 128 + lc; else off = GR0 + (size_t)row * 2048 + (pn - 16) * 256 + bj * 128 + lc; }
                    else { if (pn < 8) off = dq_off(b, t, pn, bj) + lc; else if (pn < 16) off = DK0 + dq_off(b, t, pn - 8, bj) + lc; else off = dv_off(b, t, pn - 16) + bj * 128 + lc; }
                    const f32x4 v0 = acc[ai][bj][m][0], v1 = acc[ai][bj][m][1];
                    u32x4 w; w.x = cvt_pk_bf16(v0[0], v0[1]); w.y = cvt_pk_bf16(v0[2], v0[3]); w.z = cvt_pk_bf16(v1[0], v1[1]); w.w = cvt_pk_bf16(v1[2], v1[3]);
                    *(u32x4*)(O + off) = w; } }
    }
};
struct FixOrder : StaticOrder {
    __device__ __forceinline__ size_t bofs(const Unit& u) const { return (size_t)(u.pm >> 5) * (512 * 256 * 2); }
};
struct EpiAddO {
    static constexpr bool PERM = true;
    bf16_t* O;
    __device__ __forceinline__ void operator()(const f32x4 (&acc)[2][2][4][2], const Unit& u, int wr, int wc, int fr, int fq) const {
#pragma unroll
        for (int ai = 0; ai < 2; ++ai)
#pragma unroll
            for (int m = 0; m < 4; ++m) { const int row = u.pm * BM + ai * HALF + wr * 64 + m * 16 + fr, bhh = row >> 13, t = row & 8191;
                bf16_t* rowp = O + ((size_t)(bhh >> 2) * SEQ + SEQ / 2 + t) * D + (bhh & 3) * 512 + u.pn * BM + wc * 32 + 8 * fq;
#pragma unroll
                for (int bj = 0; bj < 2; ++bj) { const u32x4 old = *(const u32x4*)(rowp + bj * HALF); const f32x4 v0 = acc[ai][bj][m][0] * 0.0625f, v1 = acc[ai][bj][m][1] * 0.0625f;
                    u32x4 w; w.x = cvt_pk_bf16(bf_lo(old.x) + v0[0], bf_hi(old.x) + v0[1]); w.y = cvt_pk_bf16(bf_lo(old.y) + v0[2], bf_hi(old.y) + v0[3]);
                    w.z = cvt_pk_bf16(bf_lo(old.z) + v1[0], bf_hi(old.z) + v1[1]); w.w = cvt_pk_bf16(bf_lo(old.w) + v1[2], bf_hi(old.w) + v1[3]);
                    *(u32x4*)(rowp + bj * HALF) = w; } }
    }
};
struct EpiResF32 {
    static constexpr bool PERM = false;
    const float* base; float* C; int ldc;
    __device__ __forceinline__ void operator()(const f32x4 (&acc)[2][2][4][2], const Unit& u, int wr, int wc, int fr, int fq) const {
        const int row0 = u.pm * BM + wr * 64 + fr, col0 = u.pn * BM + wc * 32 + 4 * fq;
#pragma unroll
        for (int ai = 0; ai < 2; ++ai)
#pragma unroll
            for (int m = 0; m < 4; ++m) { const size_t off = (size_t)(row0 + ai * HALF + m * 16) * ldc + col0;
#pragma unroll
                for (int bj = 0; bj < 2; ++bj)
#pragma unroll
                    for (int n = 0; n < 2; ++n) { const f32x4 bs = *(const f32x4*)(base + off + bj * HALF + n * 16); *(f32x4*)(C + off + bj * HALF + n * 16) = bs + acc[ai][bj][m][n]; }
                asm volatile("" ::: "memory"); }
    }
};
struct EpiSiluMul {
    static constexpr bool PERM = true;
    unsigned char* Hh;
    __device__ __forceinline__ void operator()(const f32x4 (&acc)[2][2][4][2], const Unit& u, int wr, int wc, int fr, int fq) const {
        const int row0 = u.pm * BM + wr * 64 + fr, col0 = u.pn * HALF + wc * 32 + 8 * fq;
#pragma unroll
        for (int ai = 0; ai < 2; ++ai)
#pragma unroll
            for (int m = 0; m < 4; ++m) { unsigned char* rowp = Hh + (size_t)(row0 + ai * HALF + m * 16) * DFF + col0;
                float hv[8];
#pragma unroll
                for (int n = 0; n < 2; ++n)
#pragma unroll
                    for (int j = 0; j < 4; ++j) { const float g = acc[ai][0][m][n][j], up = acc[ai][1][m][n][j];
                        const float sg = g * __builtin_amdgcn_rcpf(1.0f + __builtin_amdgcn_exp2f(-1.4426950408889634f * g)); hv[n * 4 + j] = sg * up; }
                u32x2 w; w.x = cvt4_fp8(hv[0], hv[1], hv[2], hv[3]); w.y = cvt4_fp8(hv[4], hv[5], hv[6], hv[7]);
                *(u32x2*)rowp = w; }
    }
};

typedef int v8i32 __attribute__((ext_vector_type(8)));
typedef int v4i32 __attribute__((ext_vector_type(4)));
template <class Epi, class Sched, bool GATHER = false, bool FP8 = false>
__device__ __forceinline__ void gemm_phase(LAS unsigned char* lds, const Gemm g, const Sched& S, const Epi& E, int tid_in) {
    const int tid = opq(tid_in), wid = __builtin_amdgcn_readfirstlane(tid >> 6), lane = tid & 63, wr = wid >> 2, wc = wid & 3, fr = lane & 15, fq = lane >> 4;
    const int K = g.K, RP = FP8 ? K : 2 * K  , nt = RP / (BK * 2);
    unsigned voffA[2], voffB[2];
#pragma unroll
    for (int i = 0; i < 2; ++i) { int R, C; stage_rc(tid * 16 + i * 8192, R, C); const int Rb = Epi::PERM ? ((R & ~31) + perm32(R & 31)) : R;
        voffA[i] = (unsigned)(R * RP + 2 * C); voffB[i] = (unsigned)(Rb * RP + 2 * C); }
    const unsigned kstep = (unsigned)(BK * 2);
    const unsigned hstep = (unsigned)HALF * (unsigned)RP;
    const size_t tstep = 2 * (size_t)hstep;
    const unsigned ldsw = (unsigned)wid * 1024u;
    const int aoff = lds_byte(wr * 64 + fr, fq * 8), boff = lds_byte(wc * 32 + fr, fq * 8);
    const LAS unsigned char* ldsB = lds + 4 * HTB + boff;
#define PG8_SA(b, h) (((b) * 2 + (h)) * HTB)
#define PG8_SB(b, h) ((4 + (b) * 2 + (h)) * HTB)
#define PG8_STAGE(bufoff, gbase, voff) do { const unsigned long long gv_ = (unsigned long long)(gbase); \
        const unsigned glo_ = (unsigned)__builtin_amdgcn_readfirstlane((unsigned)gv_), ghi_ = (unsigned)__builtin_amdgcn_readfirstlane((unsigned)(gv_ >> 32)); const char* gb_ = (const char*)(((unsigned long long)ghi_ << 32) | (unsigned long long)glo_);     \
        _Pragma("unroll") for (int _i = 0; _i < 2; ++_i) \
        __builtin_amdgcn_global_load_lds((const unsigned*)(gb_ + (voff)[_i]), (LAS unsigned*)(lds + (bufoff) + ldsw + _i * 8192), 16, 0, 0); } while (0)
#define PG8_STAGE_A(bufoff, nx, koff, h) do { if constexpr (GATHER) { unsigned vs_[2]; _Pragma("unroll") for (int _i = 0; _i < 2; ++_i) vs_[_i] = (nx) ? vAn[h][_i] : vAc[h][_i]; \
            PG8_STAGE(bufoff, (const char*)g.A + (koff), vs_); } \
        else { PG8_STAGE(bufoff, ((nx) ? nA : cA) + (koff) + (h) * hstep, voffA); } } while (0)
#define PG8_LD8(off) __builtin_shufflevector(*(const LAS v4i32*)(lds + (off)), *(const LAS v4i32*)(lds + (off) + 1024), 0, 1, 2, 3, 4, 5, 6, 7)
#define PG8_LDA(dst, b, h) do { if constexpr (FP8) { _Pragma("unroll") for (int m = 0; m < 4; ++m) dst##8[m] = PG8_LD8(PG8_SA(b, h) + aoff + m * 2048); } \
        else { _Pragma("unroll") for (int m = 0; m < 4; ++m) _Pragma("unroll") for (int k = 0; k < 2; ++k) dst[m][k] = *(const LAS bf16x8*)(lds + PG8_SA(b, h) + aoff + m * 2048 + k * 1024); } } while (0)
#define PG8_LD8B(off) __builtin_shufflevector(*(const LAS v4i32*)(ldsB + (off)), *(const LAS v4i32*)(ldsB + (off) + 1024), 0, 1, 2, 3, 4, 5, 6, 7)
#define PG8_LDB(dst, b, h) do { if constexpr (FP8) { _Pragma("unroll") for (int n = 0; n < 2; ++n) dst##8[n] = PG8_LD8B(PG8_SA(b, h) + n * 2048); }     \
        else { _Pragma("unroll") for (int n = 0; n < 2; ++n) _Pragma("unroll") for (int k = 0; k < 2; ++k) dst[n][k] = *(const LAS bf16x8*)(lds + PG8_SB(b, h) + boff + n * 2048 + k * 1024); } } while (0)
#define PG8_MMA(ai, bj, At, Bt) do { __builtin_amdgcn_s_setprio(1); if constexpr (FP8) { _Pragma("unroll") for (int m = 0; m < 4; ++m) _Pragma("unroll") for (int n = 0; n < 2; ++n) \
              \
            asm volatile("v_mfma_scale_f32_16x16x128_f8f6f4 %0, %1, %2, %0, %3, %3 op_sel:[0,1,0] op_sel_hi:[0,0,0]" : "+v"(acc[ai][bj][m][n]) : "v"(Bt##8[n]), "v"(At##8[m]), "v"(scl8)); } \
        else { _Pragma("unroll") for (int m = 0; m < 4; ++m) _Pragma("unroll") for (int n = 0; n < 2; ++n) _Pragma("unroll") for (int k = 0; k < 2; ++k) \
            acc[ai][bj][m][n] = __builtin_amdgcn_mfma_f32_16x16x32_bf16(Bt[n][k], At[m][k], acc[ai][bj][m][n], 0, 0, 0); } __builtin_amdgcn_s_setprio(0); } while (0)
#define PG8_WAIT_V(n) asm volatile("s_waitcnt vmcnt(" #n ")" ::: "memory")
#define PG8_WAIT_L(n) asm volatile("s_waitcnt lgkmcnt(" #n ")" ::: "memory")
#define PG8_BAR __builtin_amdgcn_s_barrier()
#define PG8_SCHED __builtin_amdgcn_sched_barrier(0)
#define PG8_ROWOFFS(V, U) do { if constexpr (GATHER) { const int t_ = opq(wid * 64 + lane_id());     \
        _Pragma("unroll") for (int i_ = 0; i_ < 2; ++i_) { int R_, C_; stage_rc(t_ * 16 + i_ * 8192, R_, C_); \
        _Pragma("unroll") for (int h_ = 0; h_ < 2; ++h_) V[h_][i_] = (unsigned)S.arow((U).pm, h_ * HALF + R_) * (unsigned)RP + 2u * (unsigned)C_; } } } while (0)
    Unit cur, nxt; int ui = 0;
    if (!S.next(0, cur)) return;
    f32x4 acc[2][2][4][2];
#pragma unroll
    for (int a = 0; a < 2; ++a)
#pragma unroll
        for (int b = 0; b < 2; ++b)
#pragma unroll
            for (int m = 0; m < 4; ++m)
#pragma unroll
                for (int n = 0; n < 2; ++n) acc[a][b][m][n] = (f32x4){0.f, 0.f, 0.f, 0.f};
    const unsigned scl8 = 0x7f797f79u;
    bf16x8 At[4][2], B0[2][2], B1[2][2]; v8i32 At8[4], B08[2], B18[2];
    unsigned vAc[2][2] = {{0u, 0u}, {0u, 0u}}, vAn[2][2] = {{0u, 0u}, {0u, 0u}};
    const char* cA = (const char*)g.A + (GATHER ? (size_t)0 : (size_t)cur.pm * tstep); const char* nA = cA; const char* cB = (const char*)g.Bt + S.bofs(cur) + (size_t)cur.pn * tstep;
    PG8_ROWOFFS(vAc, cur);
    PG8_STAGE(PG8_SB(0, 0), cB, voffB); PG8_STAGE(PG8_SB(0, 1), cB + hstep, voffB); PG8_STAGE_A(PG8_SA(0, 0), false, 0u, 0); PG8_STAGE_A(PG8_SA(0, 1), false, 0u, 1);
    if (wr == 1) PG8_BAR;
    PG8_WAIT_V(2); PG8_BAR;
    PG8_STAGE(PG8_SB(1, 0), cB + kstep, voffB); PG8_STAGE_A(PG8_SA(1, 0), false, kstep, 0); PG8_STAGE(PG8_SB(1, 1), cB + hstep + kstep, voffB);
    PG8_WAIT_V(6); PG8_BAR;
    for (;;) {
        const bool has_next = S.next(ui + 1, nxt);
        nA = (has_next && !GATHER) ? (const char*)g.A + (size_t)nxt.pm * tstep : cA; const char* nB = has_next ? (const char*)g.Bt + S.bofs(nxt) + (size_t)nxt.pn * tstep : cB;

        for (int t = 0; t < nt; t += 2) {
            const bool last = (t == nt - 2);
            if constexpr (GATHER) { if (last) {
                if (has_next) PG8_ROWOFFS(vAn, nxt); else { _Pragma("unroll") for (int h_ = 0; h_ < 2; ++h_) _Pragma("unroll") for (int i_ = 0; i_ < 2; ++i_) vAn[h_][i_] = vAc[h_][i_]; } } }
            const unsigned k1 = (unsigned)(t + 1) * kstep, k2 = last ? 0u : (unsigned)(t + 2) * kstep, k3 = k2 + kstep;
            const char* b2 = last ? nB : cB + k2; const char* b3 = b2 + kstep;
            PG8_LDB(B0, 0, 0); PG8_LDB(B1, 0, 1); PG8_SCHED; PG8_LDA(At, 0, 0); PG8_STAGE_A(PG8_SA(1, 1), false, k1, 1);
            PG8_WAIT_V(8); PG8_WAIT_L(0); PG8_BAR; PG8_MMA(0, 0, At, B0); PG8_MMA(0, 1, At, B1); PG8_BAR; PG8_SCHED;
            PG8_LDA(At, 0, 1); PG8_STAGE(PG8_SB(0, 0), b2, voffB); PG8_STAGE(PG8_SB(0, 1), b2 + hstep, voffB); PG8_STAGE_A(PG8_SA(0, 0), last, k2, 0);
            PG8_WAIT_V(8); PG8_WAIT_L(0); PG8_BAR; PG8_MMA(1, 0, At, B0); PG8_MMA(1, 1, At, B1); PG8_BAR; PG8_SCHED;
            PG8_LDB(B0, 1, 0); PG8_LDB(B1, 1, 1); PG8_SCHED; PG8_LDA(At, 1, 0); PG8_STAGE_A(PG8_SA(0, 1), last, k2, 1);
            PG8_WAIT_V(8); PG8_WAIT_L(0); PG8_BAR; PG8_MMA(0, 0, At, B0); PG8_MMA(0, 1, At, B1); PG8_BAR; PG8_SCHED;
            PG8_LDA(At, 1, 1); PG8_STAGE(PG8_SB(1, 0), b3, voffB); PG8_STAGE(PG8_SB(1, 1), b3 + hstep, voffB); PG8_STAGE_A(PG8_SA(1, 0), last, k3, 0);
            PG8_WAIT_V(8); PG8_WAIT_L(0); PG8_BAR; PG8_MMA(1, 0, At, B0); PG8_MMA(1, 1, At, B1); PG8_BAR; PG8_SCHED;
        }
        if (wr == 0) PG8_BAR;
        E(acc, cur, wr, wc, fr, fq);
        if (!has_next) break;
#pragma unroll
        for (int a = 0; a < 2; ++a)
#pragma unroll
            for (int b = 0; b < 2; ++b)
#pragma unroll
                for (int m = 0; m < 4; ++m)
#pragma unroll
                    for (int n = 0; n < 2; ++n) acc[a][b][m][n] = (f32x4){0.f, 0.f, 0.f, 0.f};
        cur = nxt; cA = nA; cB = nB; ++ui;
        if constexpr (GATHER) { _Pragma("unroll") for (int h_ = 0; h_ < 2; ++h_) _Pragma("unroll") for (int i_ = 0; i_ < 2; ++i_) vAc[h_][i_] = vAn[h_][i_]; }
        if (wr == 1) PG8_BAR;
    }
    PG8_WAIT_V(0);
    PG8_BAR;
#undef PG8_SA
#undef PG8_SB
#undef PG8_STAGE
#undef PG8_STAGE_A
#undef PG8_ROWOFFS
#undef PG8_LDA
#undef PG8_LDB
#undef PG8_MMA
#undef PG8_LD8
#undef PG8_LD8B
#undef PG8_WAIT_V
#undef PG8_WAIT_L
#undef PG8_BAR
#undef PG8_SCHED
}
}

#define XB_TMO      128
#define XB_XCNT(j)  (256  + 64 * (j))
#define XB_XSUB(j)  (1280 + 64 * (j))
#define XB_XGEN(j)  (2304 + 64 * (j))
#define XB_TOP      3328
#define XB_TOPGEN   3392
#define XCD_BAR_WORDS 3456
#define XB_SPIN_CAP (1u << 18)
__device__ __forceinline__ unsigned xb_ld(unsigned* p)              { return __hip_atomic_load(p, __ATOMIC_RELAXED, __HIP_MEMORY_SCOPE_AGENT); }
__device__ __forceinline__ unsigned xb_add(unsigned* p, unsigned v) { return __hip_atomic_fetch_add(p, v, __ATOMIC_RELAXED, __HIP_MEMORY_SCOPE_AGENT); }
__device__ __forceinline__ unsigned xb_xcc_id() { return (unsigned)__builtin_amdgcn_s_getreg((3 << 11) | 20) & 0xFu; }
#define XB_SPIN(cond, bar) do { unsigned _sp = 0; while (cond) { __builtin_amdgcn_s_sleep(1); \
    if ((++_sp & 255u) == 0u) { if (xb_ld(&(bar)[XB_TMO])) break; if (_sp > XB_SPIN_CAP) { atomicAdd(&(bar)[XB_TMO], 1u); break; } } } } while (0)
struct XcdBarrier { unsigned* bar; unsigned x; volatile LAS unsigned* st; int wave; };
__device__ __forceinline__ XcdBarrier xcd_barrier_post(unsigned* bar, volatile LAS unsigned* st) {
    XcdBarrier b; b.bar = bar; b.x = xb_xcc_id(); b.st = st; b.wave = __builtin_amdgcn_readfirstlane((int)threadIdx.x >> 6);
    if (threadIdx.x == 0) (void)xb_add(&bar[XB_XCNT(b.x)], 1u);
    return b;
}
__device__ __forceinline__ void xcd_barrier_complete(unsigned* bar, unsigned x, unsigned& nloc, unsigned& nx) {
    const unsigned G = gridDim.x * gridDim.y * gridDim.z;
    unsigned sum, cnt, mine, sp = 0u;
    for (;;) {
        sum = 0u; cnt = 0u; mine = 0u;
#pragma unroll
        for (unsigned j = 0; j < 16; ++j) { const unsigned c = xb_ld(&bar[XB_XCNT(j)]); sum += c; cnt += (c > 0u) ? 1u : 0u; mine = (j == x) ? c : mine; }
        if (sum == G) break;
        __builtin_amdgcn_s_sleep(1);
        if ((++sp & 255u) == 0u) { if (xb_ld(&bar[XB_TMO])) break; if (sp > XB_SPIN_CAP) { atomicAdd(&bar[XB_TMO], 1u); break; } }
    }
    nloc = mine > 0u ? mine : 1u; nx = cnt > 0u ? cnt : 1u;
}
__device__ __forceinline__ void xcd_barrier(const XcdBarrier& b, bool leader  ) {
    asm volatile("s_waitcnt vmcnt(0)" ::: "memory");
    __syncthreads();
    if (leader) {
        unsigned* bar = b.bar;
        __builtin_amdgcn_s_waitcnt(0);
        unsigned nloc = b.st[0], nx = b.st[1];
        if (nloc == 0u) { xcd_barrier_complete(bar, b.x, nloc, nx); b.st[0] = nloc; b.st[1] = nx; }
        const unsigned old = xb_add(&bar[XB_XSUB(b.x)], 1u);
        const unsigned gen = old / nloc;
        if (old + 1u == (gen + 1u) * nloc) {
            __builtin_amdgcn_fence(__ATOMIC_RELEASE, "agent");
            asm volatile("s_waitcnt vmcnt(0)" ::: "memory");
            const unsigned og = xb_add(&bar[XB_TOP], 1u);
            const unsigned tg = og / nx;
            if (og + 1u == (tg + 1u) * nx) xb_add(&bar[XB_TOPGEN], 1u);
            else XB_SPIN(xb_ld(&bar[XB_TOPGEN]) == tg, bar);
            __builtin_amdgcn_fence(__ATOMIC_ACQUIRE, "agent");
            xb_add(&bar[XB_XGEN(b.x)], 1u);
            asm volatile("s_waitcnt vmcnt(0)" ::: "memory");
        } else {
            XB_SPIN(xb_ld(&bar[XB_XGEN(b.x)]) == gen, bar);
            __builtin_amdgcn_fence(__ATOMIC_ACQUIRE, "agent");
            asm volatile("s_waitcnt vmcnt(0)" ::: "memory");
        }
    }
    __syncthreads();
}

struct Frame {
    LAS unsigned char* lds;
    int tid, lane, wave, vcu, G;
};
struct Args {
    const float* in[21]; float* out; unsigned char* ws; int upto, pad1;
};

template <bool FP8 = false>
__device__ __forceinline__ void transpose_item(const float* W, int ldw, int k0, int n0, bf16_t* WT, int ldk, int drow0, LAS float* scr, int lane) {
    float tv[32];
    const float* wp_ = W + (size_t)(k0 + (lane >> 5)) * ldw + n0 + (lane & 31);
#pragma unroll
    for (int i = 0; i < 32; ++i) tv[i] = wp_[(size_t)(2 * i) * ldw];
#pragma unroll
    for (int i = 0; i < 32; ++i) scr[(2 * i + (lane >> 5)) * 33 + (lane & 31)] = tv[i];
    LDS_WAIT(); asm volatile("" ::: "memory");
    const int c = lane & 7;
#pragma unroll
    for (int j = 0; j < 4; ++j) { const int n = (lane >> 3) + 8 * j; const LAS float* s = scr + (8 * c) * 33 + n;
        if constexpr (FP8) { u32x2 o; o.x = cvt4_fp8(s[0 * 33] * W8_SCALE, s[1 * 33] * W8_SCALE, s[2 * 33] * W8_SCALE, s[3 * 33] * W8_SCALE); o.y = cvt4_fp8(s[4 * 33] * W8_SCALE, s[5 * 33] * W8_SCALE, s[6 * 33] * W8_SCALE, s[7 * 33] * W8_SCALE);
            *(u32x2*)((unsigned char*)WT + (size_t)(drow0 + n) * ldk + k0 + 8 * c) = o; }
        else { u32x4 o; o.x = cvt_pk_bf16(s[0 * 33], s[1 * 33]); o.y = cvt_pk_bf16(s[2 * 33], s[3 * 33]); o.z = cvt_pk_bf16(s[4 * 33], s[5 * 33]); o.w = cvt_pk_bf16(s[6 * 33], s[7 * 33]);
            *(u32x4*)(WT + (size_t)(drow0 + n) * ldk + k0 + 8 * c) = o; } }
    LDS_WAIT(); asm volatile("" ::: "memory");
}
template <bool FP8 = false>
__device__ __forceinline__ void conv_plain(Frame& F, const float* W, int K, int N, int ldw, bf16_t* WT, int rank = -1, int nrank = 0) {
    LAS float* scr = (LAS float*)(F.lds + F.wave * 16384);
    const int gw = (rank < 0 ? F.vcu : rank) * NWAVES + F.wave, NGW = (rank < 0 ? F.G : nrank) * NWAVES, nblk = N / 32, nit = (K / 64) * nblk;
    for (int it = gw; it < nit; it += NGW) { const int kb = it / nblk, nb = it % nblk; transpose_item<FP8>(W, ldw, 64 * kb, 32 * nb, WT, K, 32 * nb, scr, F.lane); }
}
__device__ __forceinline__ void conv_moe(Frame& F, const float* wg, const float* wu, const float* wd, bf16_t* GU, bf16_t* DT, int rank = -1, int nrank = 0) {
    LAS float* scr = (LAS float*)(F.lds + F.wave * 16384);
    const int gw = (rank < 0 ? F.vcu : rank) * NWAVES + F.wave, NGW = (rank < 0 ? F.G : nrank) * NWAVES;
    constexpr int PER_E = 1536, NIT = NEXP * PER_E;
    for (int it = gw; it < NIT; it += NGW) {
        const int e = it / PER_E; int r = it % PER_E;
        if (r < 1024) { const int up = r >> 9; r &= 511; const int kb = r >> 4, nb = r & 15, n0 = 32 * nb;
            const int drow = 256 * (n0 >> 7) + 128 * up + (n0 & 127);
            transpose_item<true>((up ? wu : wg) + (size_t)e * D * DFF, DFF, 64 * kb, n0, (bf16_t*)((unsigned char*)GU + (size_t)e * 1024 * D), D, drow, scr, F.lane); }
        else { r -= 1024; const int kb = r >> 6, nb = r & 63;
            transpose_item<true>(wd + (size_t)e * DFF * D, D, 64 * kb, 32 * nb, (bf16_t*)((unsigned char*)DT + (size_t)e * D * DFF), DFF, 32 * nb, scr, F.lane); }
    }
}
__device__ __forceinline__ void pack_proj(Frame& F, float* Wp, int NT, const float* gain, const float* Wa, int lda, int ca0, int na, const float* Wb, int ldb, int nb) {
    const int total = 128 * NT * 256;
    for (int idx = (F.vcu * NWAVES * 64) + F.tid; idx < total; idx += F.G * NWAVES * 64) {
        const int e = idx & 3, ln = (idx >> 2) & 63, rest = idx >> 8, nt = rest % NT, s = rest / NT;
        const int k = 16 * s + 4 * (ln >> 4) + e, col = 16 * nt + (ln & 15);
        float v = 0.f;
        if (col < na) v = Wa[(size_t)k * lda + ca0 + col]; else if (col < na + nb) v = Wb[(size_t)k * ldb + (col - na)];
        Wp[idx] = v * gain[k];
    }
}

template <int NT>
__device__ __forceinline__ float wave_proj16(LAS unsigned char* lds, const float* xin, int tok0, const float* Wp, int tid, int wid, int lane, f32x4 (&acc)[NT]) {
    const int tr = lane & 15, kq = lane >> 4;
    const f32x4* xp = (const f32x4*)(xin + (size_t)(tok0 + tr) * D) + kq;
    constexpr int CH = 16 * NT * 1024;
    const char* wsrc = (const char*)Wp + tid * 16;
    float ssq = 0.f;
#pragma unroll
    for (int n = 0; n < NT; ++n) acc[n] = (f32x4){0.f, 0.f, 0.f, 0.f};
    f32x4 X[16];
#define NP_DMA(c, buf) do { _Pragma("unroll") for (int r = 0; r < 2 * NT; ++r) \
        __builtin_amdgcn_global_load_lds((const unsigned*)(wsrc + (size_t)(c) * CH + r * 8192), (LAS unsigned*)(lds + (buf) * CH + r * 8192 + wid * 1024), 16, 0, 0); } while (0)
#define NP_CHUNK(c, buf, more) do { \
        asm volatile("s_waitcnt vmcnt(16)" ::: "memory"); WG_BAR(); \
        if (more) NP_DMA((c) + 1, 1 - (buf)); \
        asm volatile("" ::: "memory");     \
        const f32x4* xn_ = xp + 64 * ((c) + 1); \
        _Pragma("unroll") for (int s = 0; s < 16; ++s) { const f32x4 xv = X[s]; if (more) X[s] = xn_[4 * s]; \
            ssq += (xv[0] * xv[0] + xv[1] * xv[1]) + (xv[2] * xv[2] + xv[3] * xv[3]); \
            _Pragma("unroll") for (int n = 0; n < NT; ++n) { const f32x4 wv = *(const LAS f32x4*)(lds + (buf) * CH + ((s * NT + n) * 64 + lane) * 16); \
                _Pragma("unroll") for (int e = 0; e < 4; ++e) acc[n] = __builtin_amdgcn_mfma_f32_16x16x4f32(xv[e], wv[e], acc[n], 0, 0, 0); } } } while (0)
    NP_DMA(0, 0);
    asm volatile("" ::: "memory");
#pragma unroll
    for (int s = 0; s < 16; ++s) X[s] = xp[4 * s];
    for (int c = 0; c < 6; c += 2) { NP_CHUNK(c, 0, true); NP_CHUNK(c + 1, 1, true); }
    NP_CHUNK(6, 0, true); NP_CHUNK(7, 1, false);
    WG_BAR();
#undef NP_DMA
#undef NP_CHUNK
    ssq += __shfl_xor(ssq, 16); ssq += __shfl_xor(ssq, 32);
    return 1.0f / sqrtf(ssq * (1.0f / D) + RMS_EPS);
}
template <bool FP8 = false>
__device__ __forceinline__ void wave_write_hn16(const float* xin, int tok0, float rstd, const float* gain, bf16_t* hn, int lane) {
    f32x4 g4[8];
#pragma unroll
    for (int j = 0; j < 8; ++j) g4[j] = ((const f32x4*)gain)[lane + 64 * j];
    for (int i = 0; i < 16; i += 2) {
        const float r0 = __shfl(rstd, i), r1 = __shfl(rstd, i + 1);
        const f32x4* x0 = (const f32x4*)(xin + (size_t)(tok0 + i) * D); const f32x4* x1 = x0 + D / 4;
        u32x2* o0 = (u32x2*)(hn + (size_t)(tok0 + i) * D); u32x2* o1 = o0 + D / 4;
        unsigned* p0 = (unsigned*)((unsigned char*)hn + (size_t)(tok0 + i) * D); unsigned* p1 = p0 + D / 4;
        f32x4 a[8], c[8];
#pragma unroll
        for (int j = 0; j < 8; ++j) { a[j] = x0[lane + 64 * j]; c[j] = x1[lane + 64 * j]; }
#pragma unroll
        for (int j = 0; j < 8; ++j) { const f32x4 v = a[j] * r0 * g4[j], u = c[j] * r1 * g4[j];
            if constexpr (FP8) { p0[lane + 64 * j] = cvt4_fp8(v[0], v[1], v[2], v[3]); p1[lane + 64 * j] = cvt4_fp8(u[0], u[1], u[2], u[3]); }
            else { u32x2 w; w.x = cvt_pk_bf16(v[0], v[1]); w.y = cvt_pk_bf16(v[2], v[3]); o0[lane + 64 * j] = w;
                u32x2 z; z.x = cvt_pk_bf16(u[0], u[1]); z.y = cvt_pk_bf16(u[2], u[3]); o1[lane + 64 * j] = z; } }
    }
}

__device__ __forceinline__ void phase_norm_gz(Frame& F, const float* xin, const float* gain, const float* Wp, bf16_t* hn, float* gz) {
    for (int tile = F.vcu; tile < T / 128; tile += F.G) {
        const int tok0 = tile * 128 + F.wave * 16;
        f32x4 acc[1];
        const float rstd = wave_proj16<1>(F.lds, xin, tok0, Wp, F.tid, F.wave, F.lane, acc);
        const int j = F.lane & 15, q4 = F.lane >> 4;
#pragma unroll
        for (int r = 0; r < 4; ++r) { const float rr = __shfl(rstd, 4 * q4 + r); gz[(size_t)(tok0 + 4 * q4 + r) * 16 + j] = acc[0][r] * rr; }
        wave_write_hn16(xin, tok0, rstd, gain, hn, F.lane);
    }
}
__device__ __forceinline__ void phase_norm_route(Frame& F, const float* xin, const float* gain, const float* Wp, bf16_t* hn, int* tok_e, int* tok_p, float* tok_w, unsigned* cnt) {
    LAS float* lg = (LAS float*)(F.lds + 98304 + F.wave * 3072);
    for (int tile = F.vcu; tile < T / 128; tile += F.G) {
        const int tok0 = tile * 128 + F.wave * 16;
        f32x4 acc[3];
        const float rstd = wave_proj16<3>(F.lds, xin, tok0, Wp, F.tid, F.wave, F.lane, acc);
        const int j = F.lane & 15, q4 = F.lane >> 4;
#pragma unroll
        for (int r = 0; r < 4; ++r) { const float rr = __shfl(rstd, 4 * q4 + r);
#pragma unroll
            for (int n = 0; n < 3; ++n) lg[(4 * q4 + r) * 48 + 16 * n + j] = acc[n][r] * rr; }
        LDS_WAIT(); asm volatile("" ::: "memory");
        if (F.lane < 16) {
            const LAS float* l = lg + F.lane * 48;
            float gm = l[0]; int gi = 0;
#pragma unroll
            for (int q = 1; q < 4; ++q) { const float v = l[q]; if (v > gm) { gm = v; gi = q; } }
            float gs = 0.f;
#pragma unroll
            for (int q = 0; q < 4; ++q) gs += __expf(l[q] - gm);
            const float gw = 1.0f / gs;
            const LAS float* se = l + 4 + 8 * gi;
            float m1 = se[0]; int i1 = 0;
#pragma unroll
            for (int q = 1; q < 8; ++q) { const float v = se[q]; if (v > m1) { m1 = v; i1 = q; } }
            float m2 = -3.0e38f; int i2 = 0;
#pragma unroll
            for (int q = 0; q < 8; ++q) { const float v = se[q]; if (q != i1 && v > m2) { m2 = v; i2 = q; } }
            const float eb = __expf(m2 - m1), inv = 1.0f / (1.0f + eb);
            const int t = tok0 + F.lane, e1 = gi * 8 + i1, e2 = gi * 8 + i2;
            const unsigned p1 = __hip_atomic_fetch_add(cnt + 64 * e1, 1u, __ATOMIC_RELAXED, __HIP_MEMORY_SCOPE_AGENT);
            const unsigned p2 = __hip_atomic_fetch_add(cnt + 64 * e2, 1u, __ATOMIC_RELAXED, __HIP_MEMORY_SCOPE_AGENT);
            tok_e[2 * t] = e1; tok_e[2 * t + 1] = e2; tok_p[2 * t] = (int)p1; tok_p[2 * t + 1] = (int)p2;
            tok_w[2 * t] = gw * inv; tok_w[2 * t + 1] = gw * eb * inv;
        }
        wave_write_hn16<true>(xin, tok0, rstd, gain, hn, F.lane);
        LDS_WAIT(); asm volatile("" ::: "memory");
    }
}

__device__ __forceinline__ void phase_gla_gate(Frame& F, const float* gz, const float* wgu, const float* bgate, const bf16_t* proj, bf16_t* kdT, float* adec) {
    LAS f32x4* gzs = (LAS f32x4*)F.lds;
    for (int u = F.vcu; u < NBATCH * NCH * 2; u += F.G) {
        const int half = u & 1, bc = u >> 1;
        const int tok0 = bc * 64, j = half * 512 + F.tid;
        if (F.tid < 256) gzs[F.tid] = ((const f32x4*)(gz + (size_t)tok0 * 16))[F.tid];
        float wg[16];
#pragma unroll
        for (int r = 0; r < 16; ++r) wg[r] = wgu[r * GLA_DKT + j];
        const float bg = bgate[j];
        WG_BAR();
        float cum[64]; float run = 0.f;
#pragma unroll
        for (int t = 0; t < 64; ++t) {
            float z = bg;
#pragma unroll
            for (int r4 = 0; r4 < 4; ++r4) { const f32x4 g4 = gzs[t * 4 + r4]; z += g4[0] * wg[4 * r4] + g4[1] * wg[4 * r4 + 1] + g4[2] * wg[4 * r4 + 2] + g4[3] * wg[4 * r4 + 3]; }
            const float ls = fminf(z, 0.f) - __logf(1.0f + __expf(-fabsf(z)));
            run += ls * (1.0f / 16.0f); cum[t] = run;
        }
        adec[(size_t)bc * GLA_DKT + j] = __expf(run);
        const bf16_t* kp = proj + GK0 + gq_off(bc >> 8, (bc & 255) * 64, j >> 8) + (j & 255);
        u32x4* dst = (u32x4*)(kdT + ((size_t)bc * GLA_DKT + j) * 64);
#pragma unroll
        for (int t8 = 0; t8 < 8; ++t8) {
            float kd[8];
#pragma unroll
            for (int q = 0; q < 8; ++q) { const int t = t8 * 8 + q; kd[q] = bf2f(kp[(size_t)t * 256]) * __expf(run - cum[t]); }
            u32x4 w; w.x = cvt_pk_bf16(kd[0], kd[1]); w.y = cvt_pk_bf16(kd[2], kd[3]); w.z = cvt_pk_bf16(kd[4], kd[5]); w.w = cvt_pk_bf16(kd[6], kd[7]);
            dst[t8] = w;
        }
        WG_BAR();
    }
}

constexpr int SCAN_VROW = 144, SCAN_SROW = 528, SCAN_VBUF = 64 * SCAN_VROW, SCAN_SBUF = 64 * SCAN_SROW;
__device__ __forceinline__ void phase_gla_scan(Frame& F, int it, const bf16_t* proj, const bf16_t* kdT, const float* adec, bf16_t* oout, bf16_t* sfin, unsigned* probe = nullptr) {
    const int lane = F.lane, w = F.wave, fr = lane & 15, kq = lane >> 4, tid = F.tid;
    LAS unsigned char* vbuf = F.lds;
    LAS unsigned char* sbuf = F.lds + 2 * SCAN_VBUF;
    const int bh = it >> 4, seg = (it >> 3) & 1, b = bh >> 2, h = bh & 3, sl = it & 7, mt = w & 3, ntp = w >> 2, c0 = seg * (NCH / 2);
    const size_t tokb = (size_t)b * SEQ;
    f32x4 st[2][4];
#pragma unroll
    for (int i = 0; i < 2; ++i)
#pragma unroll
        for (int n = 0; n < 4; ++n) st[i][n] = (f32x4){0.f, 0.f, 0.f, 0.f};
    bf16x8 ka0[2][2], ka1[2][2], q0[8], q1[8]; f32x4 dc0[2], dc1[2]; u32x4 vr0, vr1;
#define CL(c) ((c) < NCH ? (c) : NCH - 1)
#define LOAD_KA(KA, DC, c) do { const size_t bc_ = (size_t)b * NCH + CL(c); \
        _Pragma("unroll") for (int i = 0; i < 2; ++i) { \
            _Pragma("unroll") for (int s = 0; s < 2; ++s) KA[i][s] = *(const bf16x8*)(kdT + ((bc_ * GLA_DKT + h * 256 + 32 * w + 16 * i + fr) * 64 + 32 * s + 8 * kq)); \
            DC[i] = *(const f32x4*)(adec + bc_ * GLA_DKT + h * 256 + 32 * w + 16 * i + 4 * kq); } } while (0)
#define LOAD_V(VR, c) do { VR = *(const u32x4*)(proj + gv_off(b, CL(c) * 64 + (tid >> 3), h) + 64 * sl + 8 * (tid & 7)); } while (0)
#define LOAD_Q(Q, c) do { const bf16_t* qp_ = proj + gq_off(b, CL(c) * 64 + 16 * mt + fr, h) + 8 * kq; \
        _Pragma("unroll") for (int s = 0; s < 8; ++s) Q[s] = *(const bf16x8*)(qp_ + 32 * s); } while (0)
#define STORE_V(VR, buf) do { *(LAS u32x4*)(vbuf + (buf) * SCAN_VBUF + (tid >> 3) * SCAN_VROW + (tid & 7) * 16) = VR; } while (0)
#if PROBE
    unsigned long long pacc[3] = {0ull, 0ull, 0ull}; unsigned long long pmark;
#define PMARK(k) do { const unsigned long long n_ = __builtin_amdgcn_s_memtime(); pacc[k] += n_ - pmark; pmark = n_; } while (0)
#define PSTART() do { pmark = __builtin_amdgcn_s_memtime(); } while (0)
#else
#define PMARK(k) do { } while (0)
#define PSTART() do { } while (0)
#endif
#define SCAN_STEP(KA, DC, VN, VM, QC, QN, c) do { \
        PSTART(); \
        const unsigned vb_ = (unsigned)(uintptr_t)(vbuf + ((c) & 1) * SCAN_VBUF) + (unsigned)((8 * kq + ((lane & 15) >> 2)) * SCAN_VROW + 8 * (lane & 3)); \
        s16x4 tv[4][4];     \
        asm volatile("ds_read_b64_tr_b16 %0, %16 offset:0\n\tds_read_b64_tr_b16 %1, %16 offset:576\n\tds_read_b64_tr_b16 %2, %16 offset:4608\n\tds_read_b64_tr_b16 %3, %16 offset:5184\n\t" \
                     "ds_read_b64_tr_b16 %4, %16 offset:32\n\tds_read_b64_tr_b16 %5, %16 offset:608\n\tds_read_b64_tr_b16 %6, %16 offset:4640\n\tds_read_b64_tr_b16 %7, %16 offset:5216\n\t" \
                     "ds_read_b64_tr_b16 %8, %16 offset:64\n\tds_read_b64_tr_b16 %9, %16 offset:640\n\tds_read_b64_tr_b16 %10, %16 offset:4672\n\tds_read_b64_tr_b16 %11, %16 offset:5248\n\t" \
                     "ds_read_b64_tr_b16 %12, %16 offset:96\n\tds_read_b64_tr_b16 %13, %16 offset:672\n\tds_read_b64_tr_b16 %14, %16 offset:4704\n\tds_read_b64_tr_b16 %15, %16 offset:5280\n\ts_waitcnt lgkmcnt(0)" \
                     : "=&v"(tv[0][0]), "=&v"(tv[0][1]), "=&v"(tv[0][2]), "=&v"(tv[0][3]), "=&v"(tv[1][0]), "=&v"(tv[1][1]), "=&v"(tv[1][2]), "=&v"(tv[1][3]), \
                       "=&v"(tv[2][0]), "=&v"(tv[2][1]), "=&v"(tv[2][2]), "=&v"(tv[2][3]), "=&v"(tv[3][0]), "=&v"(tv[3][1]), "=&v"(tv[3][2]), "=&v"(tv[3][3]) : "v"(vb_) : "memory"); \
        _Pragma("unroll") for (int n = 0; n < 4; ++n) { \
            const bf16x8 vf0 = (bf16x8){tv[n][0][0], tv[n][0][1], tv[n][0][2], tv[n][0][3], tv[n][1][0], tv[n][1][1], tv[n][1][2], tv[n][1][3]}; \
            const bf16x8 vf1 = (bf16x8){tv[n][2][0], tv[n][2][1], tv[n][2][2], tv[n][2][3], tv[n][3][0], tv[n][3][1], tv[n][3][2], tv[n][3][3]}; \
            _Pragma("unroll") for (int i = 0; i < 2; ++i) { \
                st[i][n] = st[i][n] * DC[i]; \
                st[i][n] = __builtin_amdgcn_mfma_f32_16x16x32_bf16(KA[i][0], vf0, st[i][n], 0, 0, 0); \
                st[i][n] = __builtin_amdgcn_mfma_f32_16x16x32_bf16(KA[i][1], vf1, st[i][n], 0, 0, 0); } } \
        LOAD_KA(KA, DC, (c) + 2); \
        PMARK(0); \
        { LAS unsigned char* sb_ = sbuf + ((c) & 1) * SCAN_SBUF + fr * SCAN_SROW + (32 * w + 4 * kq) * 2; \
          _Pragma("unroll") for (int i = 0; i < 2; ++i) _Pragma("unroll") for (int n = 0; n < 4; ++n) { \
              u32x2 pk; pk.x = cvt_pk_bf16(st[i][n][0], st[i][n][1]); pk.y = cvt_pk_bf16(st[i][n][2], st[i][n][3]); \
              *(LAS u32x2*)(sb_ + n * 16 * SCAN_SROW + i * 32) = pk; } } \
        STORE_V(VN, ((c) + 1) & 1); \
        LOAD_V(VN, (c) + 3); \
        WG_BAR(); \
        PMARK(1); \
        { f32x4 a0 = (f32x4){0.f, 0.f, 0.f, 0.f}, a1 = a0; \
          const LAS unsigned char* sr_ = sbuf + ((c) & 1) * SCAN_SBUF + (32 * ntp + fr) * SCAN_SROW + 16 * kq; \
          _Pragma("unroll") for (int hb = 0; hb < 2; ++hb) { bf16x8 bb[4][2];     \
              _Pragma("unroll") for (int s = 0; s < 4; ++s) { bb[s][0] = *(const LAS bf16x8*)(sr_ + 64 * (4 * hb + s)); bb[s][1] = *(const LAS bf16x8*)(sr_ + 16 * SCAN_SROW + 64 * (4 * hb + s)); } \
              asm volatile("s_waitcnt lgkmcnt(0)" ::: "memory"); __builtin_amdgcn_sched_barrier(0); \
              _Pragma("unroll") for (int s = 0; s < 4; ++s) { \
                  a0 = __builtin_amdgcn_mfma_f32_16x16x32_bf16(QC[4 * hb + s], bb[s][0], a0, 0, 0, 0); \
                  a1 = __builtin_amdgcn_mfma_f32_16x16x32_bf16(QC[4 * hb + s], bb[s][1], a1, 0, 0, 0); } } \
          bf16_t* op_ = oout + (tokb + (size_t)(c) * 64 + 16 * mt + 4 * kq) * D + h * 512 + 64 * sl + 32 * ntp + fr; \
          _Pragma("unroll") for (int r = 0; r < 4; ++r) { \
              const float x0 = a0[r] * 0.0625f, x1 = a1[r] * 0.0625f, y0 = __shfl_xor(x0, 1), y1 = __shfl_xor(x1, 1); \
              if ((fr & 1) == 0) { *(unsigned*)(op_ + (size_t)r * D) = cvt_pk_bf16(x0, y0); *(unsigned*)(op_ + (size_t)r * D + 16) = cvt_pk_bf16(x1, y1); } } } \
        LOAD_Q(QC, (c) + 2); \
        PMARK(2); \
    } while (0)
    LOAD_KA(ka0, dc0, c0); LOAD_KA(ka1, dc1, c0 + 1); LOAD_V(vr0, c0); LOAD_V(vr1, c0 + 1); LOAD_Q(q0, c0); LOAD_Q(q1, c0 + 1);
    STORE_V(vr0, 0); LOAD_V(vr0, c0 + 2);
    WG_BAR();
#if PROBE
    const unsigned long long pt0 = __builtin_amdgcn_s_memtime(), pr0 = __builtin_amdgcn_s_memrealtime();
#endif
    for (int c = c0; c < c0 + NCH / 2; c += 2) {
        SCAN_STEP(ka0, dc0, vr1, vr0, q0, q1, c);
        SCAN_STEP(ka1, dc1, vr0, vr1, q1, q0, c + 1);
    }
    if (seg == 0) {
#pragma unroll
        for (int i = 0; i < 2; ++i)
#pragma unroll
            for (int n = 0; n < 4; ++n) { u32x2 pk; pk.x = cvt_pk_bf16(st[i][n][0], st[i][n][1]); pk.y = cvt_pk_bf16(st[i][n][2], st[i][n][3]);
                *(u32x2*)(sfin + ((size_t)(bh * 512 + 64 * sl + 16 * n + fr)) * 256 + 32 * w + 16 * i + 4 * kq) = pk; }
    }
    WG_BAR();
#if PROBE
    if (probe && it == 0 && tid == 0) { const unsigned long long dt = __builtin_amdgcn_s_memtime() - pt0, dr = __builtin_amdgcn_s_memrealtime() - pr0;
        const float val = floorf(2.f * log2f((PROBE == 1) ? (float)dt / 256.f : (PROBE == 2) ? (float)dr * 10.f / 256.f : (float)pacc[PROBE - 3] / 256.f));
        __hip_atomic_store(probe, __float_as_uint(val), __ATOMIC_RELAXED, __HIP_MEMORY_SCOPE_AGENT); }
#endif
#undef CL
#undef LOAD_KA
#undef LOAD_V
#undef LOAD_Q
#undef STORE_V
#undef SCAN_STEP
}

__device__ __forceinline__ void gla_pcum(Frame& F, const float* adec, float* pcum, int rank, int nrank) {
    for (int idx = rank * (NWAVES * 64) + F.tid; idx < NBATCH * GLA_DKT; idx += nrank * NWAVES * 64) { const int b = idx >> 10, j = idx & 1023;
        const float* ap = adec + ((size_t)(b * NCH + NCH / 2)) * GLA_DKT + j; float* pp = pcum + (size_t)(b * (NCH / 2)) * GLA_DKT + j; float pr = 1.f;
#pragma unroll 16
        for (int cc = 0; cc < NCH / 2; ++cc) { pr *= ap[(size_t)cc * GLA_DKT]; pp[(size_t)cc * GLA_DKT] = pr; } }
}
__device__ __forceinline__ void phase_gla_qp(Frame& F, const bf16_t* proj, const float* pcum, bf16_t* qp) {
    const int gw = F.vcu * NWAVES + F.wave, NGW = F.G * NWAVES, lane = F.lane;
    for (int r = gw; r < NBATCH * (SEQ / 2); r += NGW) { const int b = r >> 13, t = r & 8191;
        u32x2 qv[4]; f32x4 pv[4];
#pragma unroll
        for (int h = 0; h < 4; ++h) { qv[h] = *(const u32x2*)(proj + gq_off(b, SEQ / 2 + t, h) + 4 * lane); pv[h] = *(const f32x4*)(pcum + ((size_t)(b * (NCH / 2) + (t >> 6)) * GLA_DKT + h * 256 + 4 * lane)); }
#pragma unroll
        for (int h = 0; h < 4; ++h) { u32x2 w; w.x = cvt_pk_bf16(bf_lo(qv[h].x) * pv[h][0], bf_hi(qv[h].x) * pv[h][1]); w.y = cvt_pk_bf16(bf_lo(qv[h].y) * pv[h][2], bf_hi(qv[h].y) * pv[h][3]);
            *(u32x2*)(qp + ((size_t)((b * 4 + h) * (SEQ / 2) + t)) * 256 + 4 * lane) = w; }
    }
}
__device__ __forceinline__ void phase_gla_gnorm(Frame& F, const bf16_t* o, const bf16_t* proj, const float* gn, bf16_t* y) {
    const int gw = F.vcu * NWAVES + F.wave, NGW = F.G * NWAVES, lane = F.lane;
    const f32x4 g0 = ((const f32x4*)gn)[2 * lane], g1 = ((const f32x4*)gn)[2 * lane + 1];
    for (int tok = gw; tok < T; tok += NGW) {
        u32x4 ov[4], rv[4];
#pragma unroll
        for (int h = 0; h < 4; ++h) { ov[h] = *(const u32x4*)(o + (size_t)tok * D + h * 512 + 8 * lane); rv[h] = *(const u32x4*)(proj + GR0 + (size_t)tok * 2048 + h * 512 + 8 * lane); }
        float ss[4];
#pragma unroll
        for (int h = 0; h < 4; ++h) { float s = 0.f;
#pragma unroll
            for (int q = 0; q < 4; ++q) { const float lo = bf_lo(ov[h][q]), hi = bf_hi(ov[h][q]); s += lo * lo + hi * hi; }
            ss[h] = s; }
#pragma unroll
        for (int of = 1; of < 64; of <<= 1) {
#pragma unroll
            for (int h = 0; h < 4; ++h) ss[h] += __shfl_xor(ss[h], of); }
#pragma unroll
        for (int h = 0; h < 4; ++h) { const float rstd = 1.0f / sqrtf(ss[h] * (1.0f / 512.0f) + RMS_EPS);
            float yv[8];
#pragma unroll
            for (int q = 0; q < 4; ++q) { const float a0 = bf_lo(ov[h][q]), a1 = bf_hi(ov[h][q]), r0 = bf_lo(rv[h][q]), r1 = bf_hi(rv[h][q]);
                const float gA = q < 2 ? g0[2 * q] : g1[2 * q - 4], gB = q < 2 ? g0[2 * q + 1] : g1[2 * q - 3];
                yv[2 * q] = a0 * rstd * gA * (r0 / (1.0f + __expf(-r0))); yv[2 * q + 1] = a1 * rstd * gB * (r1 / (1.0f + __expf(-r1))); }
            u32x4 w; w.x = cvt_pk_bf16(yv[0], yv[1]); w.y = cvt_pk_bf16(yv[2], yv[3]); w.z = cvt_pk_bf16(yv[4], yv[5]); w.w = cvt_pk_bf16(yv[6], yv[7]);
            *(u32x4*)(y + (size_t)tok * D + h * 512 + 8 * lane) = w; }
    }
}

__device__ __forceinline__ void moe_tables(Frame& F, unsigned* cnt) {
    LAS int* pst = (LAS int*)(F.lds + TAB_OFF);
    LAS int* te = pst + 36;
    if (F.wave == 0) {
        const int e = F.lane & 31;
        const int c = (int)xb_ld(cnt + 64 * e);
        const int ntile = (c + 255) >> 8;
        int incl = ntile;
#pragma unroll
        for (int o = 1; o < 32; o <<= 1) { const int v = __shfl_up(incl, o); if ((F.lane & 31) >= o) incl += v; }
        const int excl = incl - ntile;
        if (F.lane < 32) { pst[e] = excl << 8; for (int q = 0; q < ntile; ++q) te[excl + q] = e; }
        if (F.lane == 31) { pst[32] = incl << 8; pst[33] = incl; }
    }
    WG_BAR();
}
__device__ __forceinline__ void phase_moe_slots(Frame& F, const int* tok_e, const int* tok_p, unsigned* cnt, int* slot_of, int* slot_tok) {
    const LAS int* pst = (const LAS int*)(F.lds + TAB_OFF);
    for (int e = F.vcu; e < NEXP; e += F.G) { const int c = (int)xb_ld(cnt + 64 * e), lo = pst[e] + c, hi = pst[e] + (((c + 255) >> 8) << 8);
        for (int s = lo + F.tid; s < hi; s += NWAVES * 64) slot_tok[s] = -1; }
    for (int a = F.vcu * NWAVES * 64 + F.tid; a < 2 * T; a += F.G * NWAVES * 64) { const int slot = pst[tok_e[a]] + tok_p[a]; slot_of[a] = slot; slot_tok[slot] = a >> 1; }
}
__device__ __forceinline__ void phase_moe_copy8(Frame& F, const int* tok_e, const int* tok_p, const unsigned char* hn8, unsigned char* ag8) {
    const LAS int* pst = (const LAS int*)(F.lds + TAB_OFF);
    const int gw = F.vcu * NWAVES + F.wave, NGW = F.G * NWAVES, lane = F.lane;
    for (int t = gw; t < T; t += NGW) {
        const int s0 = pst[tok_e[2 * t]] + tok_p[2 * t], s1 = pst[tok_e[2 * t + 1]] + tok_p[2 * t + 1];
        const u32x4* src = (const u32x4*)(hn8 + (size_t)t * D); const u32x4 v0 = src[lane], v1 = src[lane + 64];
        u32x4* d0 = (u32x4*)(ag8 + (size_t)s0 * D); u32x4* d1 = (u32x4*)(ag8 + (size_t)s1 * D);
        d0[lane] = v0; d0[lane + 64] = v1; d1[lane] = v0; d1[lane + 64] = v1;
    }
}
template <int MODE>
__device__ __forceinline__ void phase_moe_combine(Frame& F, float* x, const bf16_t* ob, const int* slot_of, const float* tok_w, const float* gain, bf16_t* hn) {
    const int gw = F.vcu * NWAVES + F.wave, NGW = F.G * NWAVES, lane = F.lane;
    f32x4 g4[8];
#pragma unroll
    for (int j = 0; j < 8; ++j) g4[j] = ((const f32x4*)gain)[lane + 64 * j];
    for (int t = gw; t < T; t += NGW) {
        const int s0 = slot_of[2 * t], s1 = slot_of[2 * t + 1]; const float w0 = tok_w[2 * t], w1 = tok_w[2 * t + 1];
        f32x4* xr = (f32x4*)(x + (size_t)t * D);
        const u32x2* a = (const u32x2*)(ob + (size_t)s0 * D); const u32x2* b = (const u32x2*)(ob + (size_t)s1 * D);
        f32x4 v[8]; float ss = 0.f;
#pragma unroll
        for (int j = 0; j < 8; ++j) { const u32x2 av = a[lane + 64 * j], bv = b[lane + 64 * j]; f32x4 xv = xr[lane + 64 * j];
            xv[0] += w0 * bf_lo(av.x) + w1 * bf_lo(bv.x); xv[1] += w0 * bf_hi(av.x) + w1 * bf_hi(bv.x);
            xv[2] += w0 * bf_lo(av.y) + w1 * bf_lo(bv.y); xv[3] += w0 * bf_hi(av.y) + w1 * bf_hi(bv.y);
            v[j] = xv; ss += (xv[0] * xv[0] + xv[1] * xv[1]) + (xv[2] * xv[2] + xv[3] * xv[3]); }
        const float rstd = 1.0f / sqrtf(wave_sum(ss) * (1.0f / D) + RMS_EPS);
        if (MODE == 0) {
            unsigned* orow = (unsigned*)((unsigned char*)hn + (size_t)t * D);
#pragma unroll
            for (int j = 0; j < 8; ++j) { xr[lane + 64 * j] = v[j]; const f32x4 y = v[j] * rstd * g4[j]; orow[lane + 64 * j] = cvt4_fp8(y[0], y[1], y[2], y[3]); }
        } else {
#pragma unroll
            for (int j = 0; j < 8; ++j) xr[lane + 64 * j] = v[j] * rstd * g4[j];
        }
    }
}

__device__ __forceinline__ void phase_subln(Frame& F, const bf16_t* o1, const bf16_t* o2, const float* lq1, const float* lk1, const float* lq2, const float* lk2, const float* sg, bf16_t* y) {
    const int gw = F.vcu * NWAVES + F.wave, NGW = F.G * NWAVES, lane = F.lane;
    const float d1 = wave_sum(lq1[lane] * lk1[lane] + lq1[lane + 64] * lk1[lane + 64]);
    const float d2 = wave_sum(lq2[lane] * lk2[lane] + lq2[lane + 64] * lk2[lane + 64]);
    const float lam = __expf(d1) - __expf(d2) + LAMBDA_INIT;
    const f32x4 g = ((const f32x4*)sg)[lane] * (1.0f - LAMBDA_INIT);
    for (int tok = gw; tok < T; tok += NGW) {
        u32x2 a[8], b[8];
#pragma unroll
        for (int h = 0; h < 8; ++h) { a[h] = *(const u32x2*)(o1 + (size_t)tok * D + h * 256 + 4 * lane); b[h] = *(const u32x2*)(o2 + (size_t)tok * D + h * 256 + 4 * lane); }
        f32x4 d[8]; float ss[8];
#pragma unroll
        for (int h = 0; h < 8; ++h) { d[h][0] = bf_lo(a[h].x) - lam * bf_lo(b[h].x); d[h][1] = bf_hi(a[h].x) - lam * bf_hi(b[h].x); d[h][2] = bf_lo(a[h].y) - lam * bf_lo(b[h].y); d[h][3] = bf_hi(a[h].y) - lam * bf_hi(b[h].y);
            ss[h] = (d[h][0] * d[h][0] + d[h][1] * d[h][1]) + (d[h][2] * d[h][2] + d[h][3] * d[h][3]); }
#pragma unroll
        for (int of = 1; of < 64; of <<= 1) {
#pragma unroll
            for (int h = 0; h < 8; ++h) ss[h] += __shfl_xor(ss[h], of); }
#pragma unroll
        for (int h = 0; h < 8; ++h) { const float rstd = 1.0f / sqrtf(ss[h] * (1.0f / 256.0f) + RMS_EPS); const f32x4 yv = d[h] * rstd * g;
            *(unsigned*)((unsigned char*)y + (size_t)tok * D + h * 256 + 4 * lane) = cvt4_fp8(yv[0], yv[1], yv[2], yv[3]); }
    }
}

namespace att {
constexpr int SHM_K = 64 * 128 * 2, SHM_V = 64 * 256 * 2;
constexpr int V_OFF = 0, K_OFF = 3 * SHM_V, SCR_OFF = RING_BYTES + 4096;
constexpr float SCALE = 0.08838834764831845f;
constexpr float C2 = 1.4426950408889634f * SCALE;
constexpr float THR = 8.f;
#define KSWZ(row, colB) ((row) * 256 + ((colB) ^ (((row) & 7) << 4)))
__device__ __forceinline__ int crow(int r, int hi) { return (r & 3) + 8 * (r >> 2) + 4 * hi; }
__device__ __forceinline__ int v_rd_base(int lane) { return ((lane & 3) << 3) | (((lane >> 2) & 3) << 6) | (((lane >> 4) & 1) << 5) | (((lane >> 5) & 1) << 8); }
constexpr int v_rd_off(int d0, int ks, int half) { return d0 * 512 + ks * 8192 + half * 4096; }

__device__ __forceinline__ void qkt(f32x16& p0, f32x16& p1, const LAS unsigned char* kslot, int r32, int hi, const bf16x8 (&qr)[8]) {
    const LAS unsigned char* kb[4];
#pragma unroll
    for (int dd = 0; dd < 4; ++dd) kb[dd] = kslot + KSWZ(r32, (dd * 16 + hi * 8) * 2);
#pragma unroll
    for (int d0 = 0; d0 < 8; ++d0) { const LAS unsigned char* a = kb[d0 & 3] + (d0 >> 2) * 128;
        const bf16x8 b0 = *(const LAS bf16x8*)a;
        const bf16x8 b1 = *(const LAS bf16x8*)(a + 32 * 256);
        p0 = __builtin_amdgcn_mfma_f32_32x32x16_bf16(b0, qr[d0], p0, 0, 0, 0);
        p1 = __builtin_amdgcn_mfma_f32_32x32x16_bf16(b1, qr[d0], p1, 0, 0, 0); }
}
__device__ __forceinline__ void pv_tile(f32x16 (&o)[8], unsigned vb, const bf16x8 (&pa)[4]) {
#define TRRD(dst, off) asm volatile("ds_read_b64_tr_b16 %0, %1 offset:%2" : "=&v"(dst) : "v"(vb), "i"(off) : "memory")
#define PV_D0(d0) do { s16x4 l0, l1, l2, l3, h0, h1, h2, h3; constexpr int b_ = v_rd_off(d0, 0, 0); \
        TRRD(l0, b_); TRRD(h0, b_ + 4096); TRRD(l1, b_ + 8192); TRRD(h1, b_ + 12288); TRRD(l2, b_ + 16384); TRRD(h2, b_ + 20480); TRRD(l3, b_ + 24576); TRRD(h3, b_ + 28672); \
        asm volatile("s_waitcnt lgkmcnt(0)" ::: "memory"); __builtin_amdgcn_sched_barrier(0); \
        o[d0] = __builtin_amdgcn_mfma_f32_32x32x16_bf16(pa[0], (bf16x8){l0[0], l0[1], l0[2], l0[3], h0[0], h0[1], h0[2], h0[3]}, o[d0], 0, 0, 0); \
        o[d0] = __builtin_amdgcn_mfma_f32_32x32x16_bf16(pa[1], (bf16x8){l1[0], l1[1], l1[2], l1[3], h1[0], h1[1], h1[2], h1[3]}, o[d0], 0, 0, 0); \
        o[d0] = __builtin_amdgcn_mfma_f32_32x32x16_bf16(pa[2], (bf16x8){l2[0], l2[1], l2[2], l2[3], h2[0], h2[1], h2[2], h2[3]}, o[d0], 0, 0, 0); \
        o[d0] = __builtin_amdgcn_mfma_f32_32x32x16_bf16(pa[3], (bf16x8){l3[0], l3[1], l3[2], l3[3], h3[0], h3[1], h3[2], h3[3]}, o[d0], 0, 0, 0); } while (0)
    PV_D0(0); PV_D0(1); PV_D0(2); PV_D0(3); PV_D0(4); PV_D0(5); PV_D0(6); PV_D0(7);
#undef PV_D0
#undef TRRD
}

__device__ __forceinline__ void stage_offsets(int tid, unsigned (&koff)[2], unsigned (&voff)[4]) {
#pragma unroll
    for (int i = 0; i < 2; ++i) { const int P = tid * 16 + i * 8192, row = P >> 8, ch = ((P & 255) >> 4) ^ (row & 7); koff[i] = (unsigned)(row * 128 + ch * 8) * 2u; }
#pragma unroll
    for (int i = 0; i < 4; ++i) { const int P = tid * 16 + i * 8192, st = P >> 9, kk = ((st >> 3) << 3) | ((P & 511) >> 6), cg = st & 7, cin = (P & 63) >> 1;
        const int key = (kk & ~0xC) | ((kk & 4) << 1) | ((kk & 8) >> 1); voff[i] = (unsigned)(key * 256 + cg * 32 + cin) * 2u; }
}
__device__ __forceinline__ const char* uniform_ptr(const void* p) {
    const unsigned long long v = (unsigned long long)p;
    const unsigned lo = __builtin_amdgcn_readfirstlane((unsigned)v), hi = __builtin_amdgcn_readfirstlane((unsigned)(v >> 32));
    return (const char*)(((unsigned long long)hi << 32) | lo);
}
__device__ __forceinline__ void stage_tile(LAS unsigned char* lds, int kslot, int vslot, const bf16_t* kj_, const bf16_t* vj_, int tid_, int wid) {
    const char* kj = uniform_ptr(kj_); const char* vj = uniform_ptr(vj_);
    int tid = tid_; asm volatile("" : "+v"(tid));
    unsigned koff[2], voff[4]; stage_offsets(tid, koff, voff);
    LAS unsigned char* kd = lds + K_OFF + kslot * SHM_K + wid * 1024; LAS unsigned char* vd = lds + V_OFF + vslot * SHM_V + wid * 1024;
#pragma unroll
    for (int i = 0; i < 2; ++i) __builtin_amdgcn_global_load_lds((const unsigned*)(kj + koff[i]), (LAS unsigned*)(kd + i * 8192), 16, 0, 0);
#pragma unroll
    for (int i = 0; i < 4; ++i) __builtin_amdgcn_global_load_lds((const unsigned*)(vj + voff[i]), (LAS unsigned*)(vd + i * 8192), 16, 0, 0);
}

__device__ __forceinline__ void qk_softmax(const LAS unsigned char* kslot, int r32, int hi, LAS float* al_l, const bf16x8 (&qr)[8], f32x16 (&o)[8], bf16x8 (&pa)[4],
                                           float& m_reg, float& l_reg, float rawu, float sl2, bool diag, int qi) {
    f32x16 p0, p1;
#pragma unroll
    for (int r = 0; r < 16; ++r) { p0[r] = 0.f; p1[r] = 0.f; }
    qkt(p0, p1, kslot, r32, hi, qr);
#pragma unroll
    for (int r = 0; r < 16; ++r) { const float cr = (float)((r & 3) + 8 * (r >> 2)); p0[r] = fmaf(cr, rawu, p0[r]); p1[r] = fmaf(cr, rawu, p1[r]); }
    if (diag) {
        const float k2raw = 2.f * rawu;
        int qi_ = qi - 4 * hi; asm volatile("" : "+v"(qi_));
#pragma unroll
        for (int r = 0; r < 16; ++r) { const int c = (r & 3) + 8 * (r >> 2); const int d0_ = c - qi_, d1_ = c + 32 - qi_;
            p0[r] -= k2raw * (float)(d0_ > 0 ? d0_ : 0); p1[r] -= k2raw * (float)(d1_ > 0 ? d1_ : 0); }
    }
    const float lane_raw = rawu * (float)(4 * hi), d32raw = 32.f * rawu;
    float pm0 = p0[0], pm1 = p1[0];
#pragma unroll
    for (int r = 1; r < 16; ++r) { pm0 = fmaxf(pm0, p0[r]); pm1 = fmaxf(pm1, p1[r]); }
    float pmax = fmaxf(pm0, pm1 + d32raw) + lane_raw;
    { auto rr = __builtin_amdgcn_permlane32_swap(__float_as_uint(pmax), __float_as_uint(pmax), false, false);
      pmax = fmaxf(__uint_as_float(rr[0]), __uint_as_float(rr[1])); }
    float mn, alpha;
    if (__all((pmax - m_reg) * SCALE <= THR)) { mn = m_reg; alpha = 1.f; }
    else { mn = fmaxf(m_reg, pmax); alpha = __builtin_amdgcn_exp2f((m_reg - mn) * C2); m_reg = mn; }
    const float mnL0 = (lane_raw - mn) * C2, mnL1 = mnL0 + 32.f * sl2;
#pragma unroll
    for (int r = 0; r < 16; ++r) { p0[r] = __builtin_amdgcn_exp2f(fmaf(p0[r], C2, mnL0)); p1[r] = __builtin_amdgcn_exp2f(fmaf(p1[r], C2, mnL1)); }
    if (__any(alpha < 1.f)) {
        if (hi == 0) al_l[r32] = alpha;
        LDS_WAIT();
#pragma unroll
        for (int r = 0; r < 16; ++r) { const float a = al_l[crow(r, hi)];
#pragma unroll
            for (int d = 0; d < 8; ++d) o[d][r] *= a; }
    }
    float ps = 0.f;
#pragma unroll
    for (int r = 0; r < 16; ++r) ps += p0[r] + p1[r];
    { auto rr = __builtin_amdgcn_permlane32_swap(__float_as_uint(ps), __float_as_uint(ps), false, false);
      ps = __uint_as_float(rr[0]) + __uint_as_float(rr[1]); }
    l_reg = l_reg * alpha + ps;
#define PK4(P, B_, OUT) do { unsigned a0 = cvt_pk_bf16(P[B_+0], P[B_+1]), a1 = cvt_pk_bf16(P[B_+2], P[B_+3]); \
        unsigned b0 = cvt_pk_bf16(P[B_+4], P[B_+5]), b1 = cvt_pk_bf16(P[B_+6], P[B_+7]); \
        auto r0 = __builtin_amdgcn_permlane32_swap(a0, b0, false, false); auto r1 = __builtin_amdgcn_permlane32_swap(a1, b1, false, false); \
        u32x4 w = {r0[0], r1[0], r0[1], r1[1]}; OUT = __builtin_bit_cast(bf16x8, w); } while (0)
    PK4(p0, 0, pa[0]); PK4(p0, 8, pa[1]); PK4(p1, 0, pa[2]); PK4(p1, 8, pa[3]);
#undef PK4
}

__device__ __forceinline__ void norms_phase(Frame& F, const bf16_t* proj, float* nrm) {
    const int gw = F.vcu * NWAVES + F.wave, NGW = F.G * NWAVES, lane = F.lane;
    for (int idx = gw; idx < 2 * 32 * 256; idx += NGW) {
        const int tensor = idx >> 13, stream = (idx >> 8) & 31, grp = idx & 255;
        const u32x4* rp = (const u32x4*)(proj + (tensor ? DK0 : 0) + ((size_t)stream * SEQ + grp * 64 + lane) * 128);
        float ss = 0.f;
#pragma unroll
        for (int q = 0; q < 16; ++q) { const u32x4 v = rp[q];
#pragma unroll
            for (int e = 0; e < 4; ++e) { const float lo = bf_lo(v[e]), hi = bf_hi(v[e]); ss += lo * lo + hi * hi; } }
        float n = sqrtf(ss) * 1.001f;
#pragma unroll
        for (int o = 1; o < 64; o <<= 1) n = fmaxf(n, __shfl_xor(n, o));
        if (lane == 0) nrm[idx] = n;
    }
}

__device__ __forceinline__ void attn_item(LAS unsigned char* lds, const bf16_t* proj, const float* nrm, bf16_t* oout, int b, int h, int sub, int qb, int tid, int wid, int lane) {
    const int r32 = lane & 31, hi = lane >> 5;
    const float slope = __builtin_amdgcn_exp2f(-(float)(h + 1));
    const float sl2 = slope * 1.4426950408889634f, rawu = sl2 / C2;
    LAS float* ws = (LAS float*)(lds + SCR_OFF) + wid * 64; LAS float* li_l = ws; LAS float* al_l = ws + 32;
    const size_t tokq = (size_t)b * SEQ + (size_t)qb * 256 + wid * 32;
    const bf16_t* kbase = proj + DK0 + dq_off(b, 0, h, sub);
    const bf16_t* vbase = proj + dv_off(b, 0, h);
    int j_lo;
    { const int stream = (b * 8 + h) * 2 + sub; const float* qn = nrm + stream * 256; const float* kn = nrm + 8192 + stream * 256;
      const float Qn = fmaxf(fmaxf(qn[4 * qb], qn[4 * qb + 1]), fmaxf(qn[4 * qb + 2], qn[4 * qb + 3]));
      const float Kd = fmaxf(fmaxf(kn[4 * qb], kn[4 * qb + 1]), fmaxf(kn[4 * qb + 2], kn[4 * qb + 3]));
      int cand = 4 * qb;
      for (int jj = lane; jj < 4 * qb; jj += 64) { const float dmin = (float)(256 * qb - (64 * jj + 63)); const bool skip = slope * dmin > 110.f + SCALE * Qn * (kn[jj] + Kd); if (!skip) cand = cand < jj ? cand : jj; }
#pragma unroll
      for (int o = 1; o < 64; o <<= 1) { const int v = __shfl_xor(cand, o); cand = v < cand ? v : cand; }
      j_lo = __builtin_amdgcn_readfirstlane(cand); }
    bf16x8 qr[8];
#pragma unroll
    for (int d0 = 0; d0 < 8; ++d0) qr[d0] = *(const bf16x8*)(proj + dq_off(b, qb * 256 + wid * 32 + r32, h, sub) + d0 * 16 + hi * 8);
    const float sh64 = 64.f * rawu;
    const int qi = 32 * (wid & 1) + r32;
    const unsigned vb0 = (unsigned)(uintptr_t)(lds + V_OFF) + (unsigned)v_rd_base(lane);
    float m_reg = -1e30f, l_reg = 0.f;
    f32x16 o[8];
#pragma unroll
    for (int d = 0; d < 8; ++d)
#pragma unroll
        for (int r = 0; r < 16; ++r) o[d][r] = 0.f;
    const int NT = 4 * qb + 4, myNT = 4 * qb + (wid >> 1) + 1;
    constexpr size_t KSTEP = 64 * 128, VSTEP = 64 * 256;
    const bool late = wid >= 4;
    stage_tile(lds, j_lo & 1, j_lo % 3, kbase + (size_t)j_lo * KSTEP, vbase + (size_t)j_lo * VSTEP, tid, wid);
    VM_WAIT(); WG_BAR();
    if (!late) {
        int vs = j_lo % 3;
        for (int j = j_lo; j < NT; ++j) {
            const int vsn = vs == 2 ? 0 : vs + 1;
            if (j + 1 < NT) stage_tile(lds, (j + 1) & 1, vsn, kbase + (size_t)(j + 1) * KSTEP, vbase + (size_t)(j + 1) * VSTEP, tid, wid);
            if (j < myNT) { if (j > j_lo) m_reg -= sh64;
                bf16x8 pa[4];
                qk_softmax(lds + K_OFF + (j & 1) * SHM_K, r32, hi, al_l, qr, o, pa, m_reg, l_reg, rawu, sl2, j == myNT - 1, qi);
                pv_tile(o, vb0 + (unsigned)(vs * SHM_V), pa); }
            VM_WAIT(); WG_BAR();
            vs = vsn;
        }
    } else {
        bf16x8 pa[4];
        int vs = j_lo % 3, vsp = vs;
        for (int j = j_lo; j < NT; ++j) {
            const int vsn = vs == 2 ? 0 : vs + 1;
            if (j + 1 < NT) stage_tile(lds, (j + 1) & 1, vsn, kbase + (size_t)(j + 1) * KSTEP, vbase + (size_t)(j + 1) * VSTEP, tid, wid);
            if (j > j_lo && j - 1 < myNT) pv_tile(o, vb0 + (unsigned)(vsp * SHM_V), pa);
            if (j < myNT) { if (j > j_lo) m_reg -= sh64;
                qk_softmax(lds + K_OFF + (j & 1) * SHM_K, r32, hi, al_l, qr, o, pa, m_reg, l_reg, rawu, sl2, j == myNT - 1, qi); }
            VM_WAIT(); WG_BAR();
            vsp = vs; vs = vsn;
        }
        if (myNT == NT) pv_tile(o, vb0 + (unsigned)(vsp * SHM_V), pa);
    }
    if (hi == 0) li_l[r32] = l_reg;
    LDS_WAIT();
    char* Ow = (char*)(oout + tokq * D + h * 256);
    const unsigned lofs = (unsigned)(hi * 4 * D + r32) * 2u;
#pragma unroll
    for (int r = 0; r < 16; ++r) { const float rl = __builtin_amdgcn_rcpf(li_l[crow(r, hi)]);
#pragma unroll
        for (int d0 = 0; d0 < 8; ++d0) { const float v = o[d0][r] * rl; const float vn = __shfl_xor(v, 1);
            if ((r32 & 1) == 0) *(unsigned*)(Ow + (lofs + (unsigned)((((r & 3) + 8 * (r >> 2)) * D + d0 * 32) * 2))) = cvt_pk_bf16(v, vn); } }
    WG_BAR();
}

struct TailConv { const float* wg; const float* wu; const float* wd; bf16_t* gu; bf16_t* dt; };
__device__ __forceinline__ void attn_phase(Frame& F, const bf16_t* proj, const float* nrm, unsigned* queue, bf16_t* o1, bf16_t* o2, const TailConv tc) {
    LAS int* qw = (LAS int*)(F.lds + SCR_OFF + 8 * 256);
    for (;;) {
        if (F.tid == 0) *qw = (int)__hip_atomic_fetch_add(queue, 1u, __ATOMIC_RELAXED, __HIP_MEMORY_SCOPE_AGENT);
        WG_BAR();
        const int I = __builtin_amdgcn_readfirstlane(*qw);
        if (I >= 2048 + 512) break;
        if (I >= 2048) { conv_moe(F, tc.wg, tc.wu, tc.wd, tc.gu, tc.dt, I - 2048, 512); WG_BAR(); continue; }
        const int qb = 63 - (I >> 5), r = I & 31, h = 7 - (r >> 2), b = (r >> 1) & 1, sub = r & 1;
        attn_item(F.lds, proj, nrm, sub ? o2 : o1, b, h, sub, qb, F.tid, F.wave, F.lane);
    }
}
}

__device__ __forceinline__ const void* karg(int i) { int j = i; asm volatile("" : "+s"(j)); return ((const void* const __attribute__((address_space(4)))*)__builtin_amdgcn_kernarg_segment_ptr())[j]; }
__global__ void __launch_bounds__(NWAVES * 64, 2) hybrid_fwd(Args args) {
    extern __shared__ __attribute__((aligned(16))) unsigned char lds_raw[];
    Frame F;
    F.lds = (LAS unsigned char*)lds_raw;
    F.tid = threadIdx.x; F.lane = F.tid & 63; F.wave = __builtin_amdgcn_readfirstlane(F.tid >> 6);
    F.G = gridDim.x; { const int bx = blockIdx.x; F.vcu = (F.G % 8 == 0) ? (bx % 8) * (F.G / 8) + bx / 8 : bx; }
#define ws ((unsigned char*)karg(22))
#define ctl ((unsigned*)(ws + WS_CTL))
    for (int u = F.tid; u < (LDS_BYTES - LDSCTL_OFF) / 4; u += NWAVES * 64) ((LAS unsigned*)(F.lds + LDSCTL_OFF))[u] = 0u;
    __syncthreads();
    ((LAS int*)(F.lds + TIDS_OFF))[F.tid] = F.tid;
    __syncthreads();
    volatile LAS unsigned* MISC = (volatile LAS unsigned*)(F.lds + MISC_OFF);
    XcdBarrier bar = xcd_barrier_post(ctl + CW_BAR, MISC + 8);
#define GRID_BAR() do { XcdBarrier bb_ = bar; unsigned x_ = bar.x; unsigned long long bp_ = (unsigned long long)bar.bar; asm volatile("" : "+s"(x_), "+s"(bp_)); bb_.x = x_; bb_.bar = (unsigned*)bp_; xcd_barrier(bb_, TID_RELOAD() == 0); } while (0)
#define TID_RELOAD() (F.wave * 64 + lane_id_volatile())
#ifdef ONLY_PHASE
#define PHON(n) ((n) == ONLY_PHASE)
#elif DIAG
#define PHON(n) ((n) <= args.upto)
#else
#define PHON(n) 1
#endif

#define x_in ((const float*)(karg(0)))
#define norm_mix ((const float*)(karg(1)))
#define norm_ffn ((const float*)(karg(2)))
#define gla_w_in ((const float*)(karg(3)))
#define gla_wgu ((const float*)(karg(4)))
#define gla_bg ((const float*)(karg(5)))
#define gla_norm ((const float*)(karg(6)))
#define gla_w_out ((const float*)(karg(7)))
#define diff_w_in ((const float*)(karg(8)))
#define lq1 ((const float*)(karg(9)))
#define lk1 ((const float*)(karg(10)))
#define lq2 ((const float*)(karg(11)))
#define lk2 ((const float*)(karg(12)))
#define diff_subln ((const float*)(karg(13)))
#define diff_w_out ((const float*)(karg(14)))
#define moe_wgrp ((const float*)(karg(15)))
#define moe_wexp ((const float*)(karg(16)))
#define moe_wg ((const float*)(karg(17)))
#define moe_wu ((const float*)(karg(18)))
#define moe_wd ((const float*)(karg(19)))
#define final_norm ((const float*)(karg(20)))
#define xres ((float*)(karg(21)))
#define gz ((float*)((float*)(ws + WS_GZ)))
#define tok_e ((int*)((int*)(ws + WS_TOKE)))
#define tok_p ((int*)((int*)(ws + WS_TOKP)))
#define tok_w ((float*)((float*)(ws + WS_TOKW)))
#define slot_of ((int*)((int*)(ws + WS_SLOT)))
#define slot_tok ((int*)(ws + WS_STOK))
#define adec ((float*)((float*)(ws + WS_ADEC)))
#define pcum ((float*)((float*)(ws + WS_PCUM)))
#define sfin ((bf16_t*)((bf16_t*)(ws + WS_SFIN)))
#define wp_gz ((float*)((float*)(ws + WS_WPGZ)))
#define wp_r0 ((float*)((float*)(ws + WS_WPR0)))
#define wp_r1 ((float*)((float*)(ws + WS_WPR1)))
#define wgi ((bf16_t*)((bf16_t*)(ws + WS_WGI)))
#define wgo ((bf16_t*)((bf16_t*)(ws + WS_WGO)))
#define wdi ((bf16_t*)((bf16_t*)(ws + WS_WDI)))
#define wdo ((bf16_t*)((bf16_t*)(ws + WS_WDO)))
#define wmoe_gu ((bf16_t*)((bf16_t*)(ws + WS_WMOE)))
#define wmoe_d ((bf16_t*)((bf16_t*)(ws + WS_WMOE_D)))
#define hn ((bf16_t*)((bf16_t*)(ws + WS_HN)))
#define proj ((bf16_t*)((bf16_t*)(ws + WS_PROJ)))
#define buf1 ((bf16_t*)((bf16_t*)(ws + WS_BUF1)))
#define buf2 ((bf16_t*)((bf16_t*)(ws + WS_BUF2)))
#define ag ((bf16_t*)((bf16_t*)(ws + WS_AG)))
#define ob ((bf16_t*)((bf16_t*)(ws + WS_OB)))
#define hh ((bf16_t*)((bf16_t*)(ws + WS_H)))
    const LAS int* pst = (const LAS int*)(F.lds + TAB_OFF);

    _Pragma("unroll") for (int rep_ = 0; rep_ < (REP_PHASE == 0 ? 2 : 1); ++rep_) if (PHON(0)) { if (rep_) GRID_BAR(); Frame P = F; P.tid = TID_RELOAD(); P.lane = P.tid & 63;
    conv_plain(P, gla_w_in, D, PROJW, GLA_INW, wgi);
    conv_plain(P, gla_w_out, D, D, D, wgo);
    pack_proj(P, wp_gz, 1, norm_mix, gla_w_in, GLA_INW, PROJW, 16, nullptr, 0, 0);
    pack_proj(P, wp_r0, 3, norm_ffn, moe_wgrp, 4, 0, 4, moe_wexp, 32, 32);
    pack_proj(P, wp_r1, 3, norm_ffn + D, moe_wgrp + (size_t)D * 4, 4, 0, 4, moe_wexp + (size_t)D * 32, 32, 32);
    }
    GRID_BAR();
    _Pragma("unroll") for (int rep_ = 0; rep_ < (REP_PHASE == 1 ? 2 : 1); ++rep_) if (PHON(1)) { if (rep_) GRID_BAR(); Frame P = F; P.tid = TID_RELOAD(); P.lane = P.tid & 63;
    phase_norm_gz(P, x_in, norm_mix, wp_gz, hn, gz);
    }
    GRID_BAR();
    _Pragma("unroll") for (int rep_ = 0; rep_ < (REP_PHASE == 2 ? 2 : 1); ++rep_) if (PHON(2)) { if (rep_) GRID_BAR(); Frame P = F; P.tid = TID_RELOAD(); P.lane = P.tid & 63;
    { pg8::Gemm g{hn, wgi, T, PROJW, D}; pg8::StaticOrder S; S.init(T, PROJW, P.G, (int)blockIdx.x); pg8::EpiHeads<0> E{proj};
      pg8::gemm_phase<pg8::EpiHeads<0>, pg8::StaticOrder>(P.lds, g, S, E, P.tid); }
    }
    GRID_BAR();
    _Pragma("unroll") for (int rep_ = 0; rep_ < (REP_PHASE == 3 ? 2 : 1); ++rep_) if (PHON(3)) { if (rep_) GRID_BAR(); Frame P = F; P.tid = TID_RELOAD(); P.lane = P.tid & 63;
    phase_gla_gate(P, gz, gla_wgu, gla_bg, proj, buf1, adec);
    }
    GRID_BAR();
    _Pragma("unroll") for (int rep_ = 0; rep_ < (REP_PHASE == 4 ? 2 : 1); ++rep_) if (PHON(4)) { if (rep_) GRID_BAR(); Frame P = F; P.tid = TID_RELOAD(); P.lane = P.tid & 63;
    if (P.G == 256) { if ((P.vcu & 1) == 0) phase_gla_scan(P, P.vcu >> 1, proj, buf1, adec, buf2, sfin, ctl + CW_PROBE); else { gla_pcum(P, adec, pcum, P.vcu >> 1, 128); conv_moe(P, moe_wg, moe_wu, moe_wd, wmoe_gu, wmoe_d, P.vcu >> 1, 128);
            conv_plain<true>(P, diff_w_in, D, PROJW, PROJW, wdi, P.vcu >> 1, 128); conv_plain<true>(P, diff_w_out, D, D, D, wdo, P.vcu >> 1, 128); } }
    else { for (int it = P.vcu; it < 128; it += P.G) phase_gla_scan(P, it, proj, buf1, adec, buf2, sfin); gla_pcum(P, adec, pcum, P.vcu, P.G); conv_moe(P, moe_wg, moe_wu, moe_wd, wmoe_gu, wmoe_d); conv_plain<true>(P, diff_w_in, D, PROJW, PROJW, wdi); conv_plain<true>(P, diff_w_out, D, D, D, wdo); }
    GRID_BAR();
    phase_gla_qp(P, proj, pcum, hn);
    GRID_BAR();
    { pg8::Gemm g{hn, sfin, 8 * (SEQ / 2), 512, 256}; pg8::FixOrder S; S.init(8 * (SEQ / 2), 512, P.G, (int)blockIdx.x); pg8::EpiAddO E{buf2};
      pg8::gemm_phase<pg8::EpiAddO, pg8::FixOrder>(P.lds, g, S, E, P.tid); }
    }
    GRID_BAR();
    _Pragma("unroll") for (int rep_ = 0; rep_ < (REP_PHASE == 5 ? 2 : 1); ++rep_) if (PHON(5)) { if (rep_) GRID_BAR(); Frame P = F; P.tid = TID_RELOAD(); P.lane = P.tid & 63;
    phase_gla_gnorm(P, buf2, proj, gla_norm, hn);
    }
    GRID_BAR();
    _Pragma("unroll") for (int rep_ = 0; rep_ < (REP_PHASE == 6 ? 2 : 1); ++rep_) if (PHON(6)) { if (rep_) GRID_BAR(); Frame P = F; P.tid = TID_RELOAD(); P.lane = P.tid & 63;
    { pg8::Gemm g{hn, wgo, T, D, D}; pg8::StaticOrder S; S.init(T, D, P.G, (int)blockIdx.x); pg8::EpiResF32 E{x_in, xres, D};
      pg8::gemm_phase<pg8::EpiResF32, pg8::StaticOrder>(P.lds, g, S, E, P.tid); }
    }
    GRID_BAR();
    _Pragma("unroll") for (int rep_ = 0; rep_ < (REP_PHASE == 7 ? 2 : 1); ++rep_) if (PHON(7)) { if (rep_) GRID_BAR(); Frame P = F; P.tid = TID_RELOAD(); P.lane = P.tid & 63;
    phase_norm_route(P, xres, norm_ffn, wp_r0, hn, tok_e, tok_p, tok_w, ctl + CW_CNT0);
    }
    GRID_BAR();
    _Pragma("unroll") for (int rep_ = 0; rep_ < (REP_PHASE == 8 ? 2 : 1); ++rep_) if (PHON(8)) { if (rep_) GRID_BAR(); Frame P = F; P.tid = TID_RELOAD(); P.lane = P.tid & 63;
    moe_tables(P, ctl + CW_CNT0);
    phase_moe_slots(P, tok_e, tok_p, ctl + CW_CNT0, slot_of, slot_tok);
    }
    GRID_BAR();
    _Pragma("unroll") for (int rep_ = 0; rep_ < (REP_PHASE == 9 ? 2 : 1); ++rep_) if (PHON(9)) { if (rep_) GRID_BAR(); Frame P = F; P.tid = TID_RELOAD(); P.lane = P.tid & 63;
    { const int Mr = pst[33] * 256; pg8::Gemm g{hn, wmoe_gu, Mr, 1024, D}; pg8::MoeOrder S; S.init(Mr, 1024, P.G, (int)blockIdx.x); S.te = pst + 36; S.estride = (size_t)1024 * D; S.stok = slot_tok; pg8::EpiSiluMul E{(unsigned char*)hh};
      pg8::gemm_phase<pg8::EpiSiluMul, pg8::MoeOrder, true, true>(P.lds, g, S, E, P.tid); }
    }
    GRID_BAR();
    _Pragma("unroll") for (int rep_ = 0; rep_ < (REP_PHASE == 10 ? 2 : 1); ++rep_) if (PHON(10)) { if (rep_) GRID_BAR(); Frame P = F; P.tid = TID_RELOAD(); P.lane = P.tid & 63;
    { const int Mr = pst[33] * 256; pg8::Gemm g{hh, wmoe_d, Mr, D, DFF}; pg8::MoeOrder S; S.init(Mr, D, P.G, (int)blockIdx.x); S.te = pst + 36; S.estride = (size_t)D * DFF; S.stok = slot_tok; pg8::EpiBf16 E{ob, D};
      pg8::gemm_phase<pg8::EpiBf16, pg8::MoeOrder, false, true>(P.lds, g, S, E, P.tid); }
    }
    GRID_BAR();
    _Pragma("unroll") for (int rep_ = 0; rep_ < (REP_PHASE == 11 ? 2 : 1); ++rep_) if (PHON(11)) { if (rep_) GRID_BAR(); Frame P = F; P.tid = TID_RELOAD(); P.lane = P.tid & 63;
    phase_moe_combine<0>(P, xres, ob, slot_of, tok_w, norm_mix + D, hn);
    }
    GRID_BAR();
    _Pragma("unroll") for (int rep_ = 0; rep_ < (REP_PHASE == 12 ? 2 : 1); ++rep_) if (PHON(12)) { if (rep_) GRID_BAR(); Frame P = F; P.tid = TID_RELOAD(); P.lane = P.tid & 63;
    { pg8::Gemm g{hn, wdi, T, PROJW, D}; pg8::StaticOrder S; S.init(T, PROJW, P.G, (int)blockIdx.x); pg8::EpiHeads<1> E{proj};
      pg8::gemm_phase<pg8::EpiHeads<1>, pg8::StaticOrder, false, true>(P.lds, g, S, E, P.tid); }
    GRID_BAR();
    att::norms_phase(P, proj, (float*)(ws + WS_NRM));
    }
    GRID_BAR();
    _Pragma("unroll") for (int rep_ = 0; rep_ < (REP_PHASE == 13 ? 2 : 1); ++rep_) if (PHON(13)) { if (rep_) GRID_BAR(); Frame P = F; P.tid = TID_RELOAD(); P.lane = P.tid & 63;
    att::attn_phase(P, proj, (const float*)(ws + WS_NRM), ctl + CW_QUEUE, buf1, buf2, att::TailConv{moe_wg + (size_t)NEXP * D * DFF, moe_wu + (size_t)NEXP * D * DFF, moe_wd + (size_t)NEXP * DFF * D, (bf16_t*)(ws + WS_WMOE1), (bf16_t*)(ws + WS_WMOE1_D)});
    }
    GRID_BAR();
    _Pragma("unroll") for (int rep_ = 0; rep_ < (REP_PHASE == 14 ? 2 : 1); ++rep_) if (PHON(14)) { if (rep_) GRID_BAR(); Frame P = F; P.tid = TID_RELOAD(); P.lane = P.tid & 63;
    phase_subln(P, buf1, buf2, lq1, lk1, lq2, lk2, diff_subln, hn);
    }
    GRID_BAR();
    _Pragma("unroll") for (int rep_ = 0; rep_ < (REP_PHASE == 15 ? 2 : 1); ++rep_) if (PHON(15)) { if (rep_) GRID_BAR(); Frame P = F; P.tid = TID_RELOAD(); P.lane = P.tid & 63;
    { pg8::Gemm g{hn, wdo, T, D, D}; pg8::StaticOrder S; S.init(T, D, P.G, (int)blockIdx.x); pg8::EpiResF32 E{xres, xres, D};
      pg8::gemm_phase<pg8::EpiResF32, pg8::StaticOrder, false, true>(P.lds, g, S, E, P.tid); }
    }
    GRID_BAR();
    _Pragma("unroll") for (int rep_ = 0; rep_ < (REP_PHASE == 16 ? 2 : 1); ++rep_) if (PHON(16)) { if (rep_) GRID_BAR(); Frame P = F; P.tid = TID_RELOAD(); P.lane = P.tid & 63;
    phase_norm_route(P, xres, norm_ffn + D, wp_r1, hn, tok_e, tok_p, tok_w, ctl + CW_CNT1);
    }
    GRID_BAR();
    _Pragma("unroll") for (int rep_ = 0; rep_ < (REP_PHASE == 17 ? 2 : 1); ++rep_) if (PHON(17)) { if (rep_) GRID_BAR(); Frame P = F; P.tid = TID_RELOAD(); P.lane = P.tid & 63;
    moe_tables(P, ctl + CW_CNT1);
    phase_moe_slots(P, tok_e, tok_p, ctl + CW_CNT1, slot_of, slot_tok);
    }
    GRID_BAR();
    _Pragma("unroll") for (int rep_ = 0; rep_ < (REP_PHASE == 18 ? 2 : 1); ++rep_) if (PHON(18)) { if (rep_) GRID_BAR(); Frame P = F; P.tid = TID_RELOAD(); P.lane = P.tid & 63;
    { const int Mr = pst[33] * 256; pg8::Gemm g{hn, (bf16_t*)(ws + WS_WMOE1), Mr, 1024, D}; pg8::MoeOrder S; S.init(Mr, 1024, P.G, (int)blockIdx.x); S.te = pst + 36; S.estride = (size_t)1024 * D; S.stok = slot_tok; pg8::EpiSiluMul E{(unsigned char*)hh};
      pg8::gemm_phase<pg8::EpiSiluMul, pg8::MoeOrder, true, true>(P.lds, g, S, E, P.tid); }
    }
    GRID_BAR();
    _Pragma("unroll") for (int rep_ = 0; rep_ < (REP_PHASE == 19 ? 2 : 1); ++rep_) if (PHON(19)) { if (rep_) GRID_BAR(); Frame P = F; P.tid = TID_RELOAD(); P.lane = P.tid & 63;
    { const int Mr = pst[33] * 256; pg8::Gemm g{hh, (bf16_t*)(ws + WS_WMOE1_D), Mr, D, DFF}; pg8::MoeOrder S; S.init(Mr, D, P.G, (int)blockIdx.x); S.te = pst + 36; S.estride = (size_t)D * DFF; S.stok = slot_tok; pg8::EpiBf16 E{ob, D};
      pg8::gemm_phase<pg8::EpiBf16, pg8::MoeOrder, false, true>(P.lds, g, S, E, P.tid); }
    }
    GRID_BAR();
    _Pragma("unroll") for (int rep_ = 0; rep_ < (REP_PHASE == 20 ? 2 : 1); ++rep_) if (PHON(20)) { if (rep_) GRID_BAR(); Frame P = F; P.tid = TID_RELOAD(); P.lane = P.tid & 63;
    phase_moe_combine<1>(P, xres, ob, slot_of, tok_w, final_norm, hn);
    }
#if PROBE
    { GRID_BAR(); const float c = sqrtf(0.1f * __uint_as_float(xb_ld(ctl + CW_PROBE)));
      for (size_t i = (size_t)blockIdx.x * 512 + F.tid; i < (size_t)T * D; i += (size_t)gridDim.x * 512) xres[i] = c; }
#endif
}

#undef x_in
#undef norm_mix
#undef norm_ffn
#undef gla_w_in
#undef gla_wgu
#undef gla_bg
#undef gla_norm
#undef gla_w_out
#undef diff_w_in
#undef lq1
#undef lk1
#undef lq2
#undef lk2
#undef diff_subln
#undef diff_w_out
#undef moe_wgrp
#undef moe_wexp
#undef moe_wg
#undef moe_wu
#undef moe_wd
#undef final_norm
#undef xres
#undef gz
#undef tok_e
#undef tok_p
#undef tok_w
#undef slot_of
#undef slot_tok
#undef ws
#undef ctl
#undef adec
#undef pcum
#undef sfin
#undef wp_gz
#undef wp_r0
#undef wp_r1
#undef wgi
#undef wgo
#undef wdi
#undef wdo
#undef wmoe_gu
#undef wmoe_d
#undef hn
#undef proj
#undef buf1
#undef buf2
#undef ag
#undef ob
#undef hh
#if DIAG
constexpr size_t WS_DIAG = WS_END;
constexpr int NSAVE = 64;
__device__ inline unsigned hsh(unsigned x) { x ^= x >> 16; x *= 0x7feb352dU; x ^= x >> 15; x *= 0x846ca68bU; x ^= x >> 16; return x; }
__device__ inline void rep(unsigned* w, double got, double ref, double scale) { double e = fabs(got - ref) / (fabs(ref) + scale); float ef = (float)e; if (!(ef == ef) || ef > 1e30f) ef = 1e30f; atomicMax(w, __float_as_uint(ef)); }
__device__ inline double bfd(bf16_t v) { return (double)bf2f(v); }
#define GTID (blockIdx.x * blockDim.x + threadIdx.x)
#define GSTR (gridDim.x * blockDim.x)

__global__ void ck_weights(const float* gla_w_in, const float* gla_w_out, const float* diff_w_in, const float* diff_w_out, const bf16_t* wgi, const bf16_t* wgo, const bf16_t* wdi, const bf16_t* wdo,
                           const float* norm_mix, const float* norm_ffn, const float* wgrp, const float* wexp, const float* wp_gz, const float* wp_r0, const float* wp_r1, unsigned* w) {
    for (unsigned i = GTID; i < 65536u; i += GSTR) { const unsigned r = hsh(i * 3u + 1u), r2 = hsh(i * 7u + 5u);
        const int n = r % 6144u, k = r2 % 2048u, n2 = n % 2048;
        rep(w, bfd(wgi[(size_t)n * D + k]), gla_w_in[(size_t)k * GLA_INW + n], 0.02); rep(w, bfd(wdi[(size_t)n * D + k]), diff_w_in[(size_t)k * PROJW + n], 0.02);
        rep(w, bfd(wgo[(size_t)n2 * D + k]), gla_w_out[(size_t)k * D + n2], 0.02); rep(w, bfd(wdo[(size_t)n2 * D + k]), diff_w_out[(size_t)k * D + n2], 0.02);
        const int s = r % 128u, ln = (r >> 7) % 64u, e4 = (r >> 13) & 3, kk = 16 * s + 4 * (ln >> 4) + e4, col = ln & 15, nt = (r >> 15) % 3u, col3 = 16 * nt + col;
        rep(w, wp_gz[(s * 64 + ln) * 4 + e4], (double)norm_mix[kk] * gla_w_in[(size_t)kk * GLA_INW + PROJW + col], 0.02);
        for (int L = 0; L < 2; ++L) { const float* gr = wgrp + (size_t)L * D * 4; const float* ex = wexp + (size_t)L * D * 32; const float* nf = norm_ffn + L * D;
            const double ref = col3 < 4 ? gr[kk * 4 + col3] : (col3 < 36 ? ex[kk * 32 + col3 - 4] : 0.0);
            rep(w, (L ? wp_r1 : wp_r0)[((s * 3 + nt) * 64 + ln) * 4 + e4], (double)nf[kk] * ref, 0.02); } }
}
__global__ void ck_moew(const float* wg, const float* wu, const float* wd, const bf16_t* GU, const bf16_t* DT, unsigned* w) {
    for (unsigned i = GTID; i < 65536u; i += GSTR) { const unsigned r = hsh(i * 5u + 2u), r2 = hsh(i * 11u + 3u);
        const int e = r % 32u, f = (r >> 5) % 512u, k = r2 % 2048u, n2 = (r2 >> 11) % 2048u, rowg = 256 * (f >> 7) + (f & 127);
        rep(w, bfd(GU[((size_t)e * 1024 + rowg) * D + k]), wg[((size_t)e * D + k) * DFF + f], 0.02); rep(w, bfd(GU[((size_t)e * 1024 + rowg + 128) * D + k]), wu[((size_t)e * D + k) * DFF + f], 0.02);
        rep(w, bfd(DT[((size_t)e * D + n2) * DFF + f]), wd[((size_t)e * DFF + f) * D + n2], 0.05); }
}
__global__ void ck_norm(const float* x, const float* gain, const bf16_t* hn, unsigned* w) {
    for (unsigned i = GTID; i < 4096u; i += GSTR) { const unsigned r = hsh(i * 13u + 7u); const int t = r % (unsigned)T, j = (r >> 15) % 2048u;
        double ss = 0; for (int k = 0; k < D; ++k) { const double v = x[(size_t)t * D + k]; ss += v * v; }
        const double rstd = 1.0 / sqrt(ss / D + 1e-6); rep(w, bfd(hn[(size_t)t * D + j]), x[(size_t)t * D + j] * rstd * gain[j], 1.0); }
}
__global__ void ck_gz(const float* x, const float* gain, const float* gla_w_in, const float* gz, unsigned* w) {
    for (unsigned i = GTID; i < 4096u; i += GSTR) { const unsigned r = hsh(i * 17u + 9u); const int t = r % (unsigned)T, c = (r >> 15) % 16u;
        double ss = 0, dot = 0; for (int k = 0; k < D; ++k) { const double v = x[(size_t)t * D + k]; ss += v * v; dot += v * gain[k] * gla_w_in[(size_t)k * GLA_INW + PROJW + c]; }
        rep(w, gz[(size_t)t * 16 + c], dot / sqrt(ss / D + 1e-6), 1.0); }
}
__global__ void ck_gemm(const bf16_t* A, const bf16_t* Bt, const bf16_t* C, int M, int N, int K, int ldc, double scale, unsigned* w) {
    for (unsigned i = GTID; i < 16384u; i += GSTR) { const unsigned r = hsh(i * 19u + 11u), r2 = hsh(i * 23u + 1u); const int m = r % (unsigned)M, n = r2 % (unsigned)N;
        double s = 0; for (int k = 0; k < K; ++k) s += bfd(A[(size_t)m * K + k]) * bfd(Bt[(size_t)n * K + k]);
        rep(w, bfd(C[(size_t)m * ldc + n]), s, scale); }
}
__global__ void ck_proj(const bf16_t* A, const bf16_t* Bt, const bf16_t* proj, int layer, unsigned* w) {
    for (unsigned i = GTID; i < 16384u; i += GSTR) { const unsigned r = hsh(i * 19u + 11u), r2 = hsh(i * 23u + 1u); const int m = r % (unsigned)T, n = r2 % (unsigned)PROJW, b = m >> 14, t = m & (SEQ - 1);
        double s = 0; for (int k = 0; k < D; ++k) s += bfd(A[(size_t)m * D + k]) * bfd(Bt[(size_t)n * D + k]);
        size_t off;
        if (layer == 0) { if (n < 1024) off = gq_off(b, t, n >> 8) + (n & 255); else if (n < 2048) off = GK0 + gq_off(b, t, (n - 1024) >> 8) + (n & 255); else if (n < 4096) off = gv_off(b, t, (n - 2048) >> 9) + (n & 511); else off = GR0 + (size_t)m * 2048 + (n - 4096); }
        else { if (n < 2048) off = dq_off(b, t, n >> 8, (n >> 7) & 1) + (n & 127); else if (n < 4096) off = DK0 + dq_off(b, t, (n - 2048) >> 8, (n >> 7) & 1) + (n & 127); else off = dv_off(b, t, (n - 4096) >> 8) + (n & 255); }
        rep(w, bfd(proj[off]), s, 1.0); }
}
__device__ inline int srow(int i) { return (int)(hsh(i * 29u + 13u) % (unsigned)T); }
__global__ void ck_save(const float* x, float* save) { for (unsigned i = GTID; i < (unsigned)NSAVE * D; i += GSTR) save[i] = x[(size_t)srow(i / D) * D + (i % D)]; }
__global__ void ck_gemm_res(const bf16_t* A, const bf16_t* Bt, const float* base, int saved, const float* out, unsigned* w) {
    for (unsigned i = GTID; i < (unsigned)NSAVE * 64u; i += GSTR) { const int si = i / 64, t = srow(si), n = hsh(i * 31u + 5u) % 2048u;
        double s = 0; for (int k = 0; k < D; ++k) s += bfd(A[(size_t)t * D + k]) * bfd(Bt[(size_t)n * D + k]);
        const double b = saved ? base[(size_t)si * D + n] : base[(size_t)t * D + n];
        rep(w, out[(size_t)t * D + n], b + s, 1.0); }
}
__global__ void ck_gate(const float* gz, const float* wgu, const float* bg, const bf16_t* proj, const bf16_t* kdT, const float* adec, unsigned* w) {
    for (unsigned i = GTID; i < 4096u; i += GSTR) { const unsigned r = hsh(i * 37u + 3u); const int bc = r % 512u, j = (r >> 9) % 1024u, tq = (r >> 19) % 64u;
        double run = 0, ct = 0;
        for (int t = 0; t < 64; ++t) { double z = bg[j]; for (int q = 0; q < 16; ++q) z += (double)gz[((size_t)bc * 64 + t) * 16 + q] * wgu[q * 1024 + j];
            const double ls = fmin(z, 0.0) - log1p(exp(-fabs(z))); run += ls / 16.0; if (t == tq) ct = run; }
        rep(w, adec[(size_t)bc * 1024 + j], exp(run), 1.0);
        rep(w, bfd(kdT[((size_t)bc * 1024 + j) * 64 + tq]), bfd(proj[GK0 + gq_off(bc >> 8, (bc & 255) * 64 + tq, j >> 8) + (j & 255)]) * exp(run - ct), 1.0); }
}
__global__ void ck_scan(const bf16_t* proj, const bf16_t* kdT, const float* adec, const bf16_t* o, unsigned* w) {
    const int wv = GTID / 64, lane = threadIdx.x & 63, nw = GSTR / 64;
    const int cl[8] = {0, 1, 3, 17, 100, 255, 2, 64};
    for (int s = wv; s < 96; s += nw) { const unsigned r = hsh(s * 41u + 17u); const int b = r & 1, c = cl[s % 8], tl = (r >> 1) % 64u, h = (r >> 7) % 4u, vc = (r >> 9) % 512u;
        float S[4] = {0.f, 0.f, 0.f, 0.f};
        for (int cc = 0; cc <= c; ++cc) { const size_t bc = (size_t)b * NCH + cc;
            for (int q = 0; q < 4; ++q) { const int kr = h * 256 + lane * 4 + q; float a = 0.f;
                for (int t = 0; t < 64; ++t) a += bf2f(kdT[(bc * 1024 + kr) * 64 + t]) * bf2f(proj[gv_off(b, cc * 64 + t, h) + vc]);
                S[q] = adec[bc * 1024 + kr] * S[q] + a; } }
        float part = 0.f; const size_t tok = (size_t)b * SEQ + c * 64 + tl;
        for (int q = 0; q < 4; ++q) part += bf2f(proj[gq_off(b, c * 64 + tl, h) + lane * 4 + q]) * S[q];
        for (int of = 1; of < 64; of <<= 1) part += __shfl_xor(part, of);
        if (lane == 0) rep(w, bfd(o[tok * D + h * 512 + vc]), part / 16.0, 2.0); }
}
__global__ void ck_gnorm(const bf16_t* o, const bf16_t* proj, const float* gn, const bf16_t* y, unsigned* w) {
    for (unsigned i = GTID; i < 8192u; i += GSTR) { const unsigned r = hsh(i * 43u + 19u); const int t = r % (unsigned)T, h = (r >> 15) % 4u, j = (r >> 17) % 512u;
        double ss = 0; for (int k = 0; k < 512; ++k) { const double v = bfd(o[(size_t)t * D + h * 512 + k]); ss += v * v; }
        const double rr = bfd(proj[GR0 + (size_t)t * 2048 + h * 512 + j]);
        rep(w, bfd(y[(size_t)t * D + h * 512 + j]), bfd(o[(size_t)t * D + h * 512 + j]) / sqrt(ss / 512 + 1e-6) * gn[j] * rr / (1.0 + exp(-rr)), 1.0); }
}
__global__ void ck_route(const float* x, const float* gain, const float* wgrp, const float* wexp, const int* tok_e, const int* tok_p, const float* tok_w, const unsigned* cnt, unsigned* w) {
    for (unsigned i = GTID; i < 512u; i += GSTR) { const int t = hsh(i * 47u + 23u) % (unsigned)T;
        double ss = 0; for (int k = 0; k < D; ++k) { const double v = x[(size_t)t * D + k]; ss += v * v; }
        const double rstd = 1.0 / sqrt(ss / D + 1e-6);
        double gl[4] = {0, 0, 0, 0};
        for (int k = 0; k < D; ++k) { const double v = x[(size_t)t * D + k] * rstd * gain[k]; for (int q = 0; q < 4; ++q) gl[q] += v * wgrp[k * 4 + q]; }
        int gi = 0; for (int q = 1; q < 4; ++q) if (gl[q] > gl[gi]) gi = q;
        double gs = 0; for (int q = 0; q < 4; ++q) gs += exp(gl[q] - gl[gi]);
        double el[8] = {0, 0, 0, 0, 0, 0, 0, 0};
        for (int k = 0; k < D; ++k) { const double v = x[(size_t)t * D + k] * rstd * gain[k]; for (int q = 0; q < 8; ++q) el[q] += v * wexp[k * 32 + gi * 8 + q]; }
        int i1 = 0; for (int q = 1; q < 8; ++q) if (el[q] > el[i1]) i1 = q;
        int i2 = (i1 == 0) ? 1 : 0; for (int q = 0; q < 8; ++q) if (q != i1 && el[q] > el[i2]) i2 = q;
        const double eb = exp(el[i2] - el[i1]);
        const int e1 = tok_e[2 * t], e2 = tok_e[2 * t + 1];
        double third = -1e30; for (int q = 0; q < 8; ++q) if (q != i1 && q != i2 && el[q] > third) third = el[q];
        const bool tie = (el[i2] - third) < 1e-4 || (el[i1] - el[i2]) < 1e-4;
        if (!tie) { rep(w, e1, gi * 8 + i1, 1.0); rep(w, e2, gi * 8 + i2, 1.0);
            rep(w, tok_w[2 * t], 1.0 / gs / (1.0 + eb), 0.3); rep(w, tok_w[2 * t + 1], eb / gs / (1.0 + eb), 0.3); }
        if ((unsigned)tok_p[2 * t] >= cnt[64 * (e1 & 31)] || (unsigned)tok_p[2 * t + 1] >= cnt[64 * (e2 & 31)]) rep(w, 9.0, 0.0, 1.0); }
}
__global__ void ck_gather(const int* tok_e, const int* tok_p, const int* slot_of, const unsigned* cnt, const bf16_t* hn, const int* ag  , unsigned* w) {
    for (unsigned i = GTID; i < 8192u; i += GSTR) { const unsigned r = hsh(i * 53u + 29u); const int a = r % (2u * T), k = (r >> 16) % 2048u, e = tok_e[a] & 31;
        int ps = 0; for (int q = 0; q < e; ++q) ps += ((int)cnt[64 * q] + 255) & ~255;
        const int slot = slot_of[a];
        rep(w, slot, ps + tok_p[a], 1.0);
        if (slot >= 0 && slot < MAX_TILES * 256) rep(w, (double)ag[slot], (double)(a >> 1), 1.0); (void)hn; (void)k; }
}
__global__ void ck_moe1(const int* tok_e, const int* slot_of, const bf16_t* ag, const float* wg, const float* wu, const bf16_t* hh, unsigned* w) {
    for (unsigned i = GTID; i < 8192u; i += GSTR) { const unsigned r = hsh(i * 59u + 31u); const int a = r % (2u * T), f = (r >> 16) % 512u, e = tok_e[a] & 31, slot = slot_of[a];
        if (slot < 0 || slot >= MAX_TILES * 256) { rep(w, 9.0, 0.0, 1.0); continue; }
        double g = 0, u = 0; for (int k = 0; k < D; ++k) { const double v = bfd(ag[(size_t)(a >> 1) * D + k]); g += v * wg[((size_t)e * D + k) * DFF + f]; u += v * wu[((size_t)e * D + k) * DFF + f]; }
        rep(w, bfd(hh[(size_t)slot * DFF + f]), g / (1.0 + exp(-g)) * u, 0.5); }
}
__global__ void ck_moe2(const int* tok_e, const int* slot_of, const bf16_t* hh, const float* wd, const bf16_t* ob, unsigned* w) {
    for (unsigned i = GTID; i < 8192u; i += GSTR) { const unsigned r = hsh(i * 61u + 37u); const int a = r % (2u * T), n = (r >> 16) % 2048u, e = tok_e[a] & 31, slot = slot_of[a];
        if (slot < 0 || slot >= MAX_TILES * 256) { rep(w, 9.0, 0.0, 1.0); continue; }
        double s = 0; for (int f = 0; f < DFF; ++f) s += bfd(hh[(size_t)slot * DFF + f]) * wd[((size_t)e * DFF + f) * D + n];
        rep(w, bfd(ob[(size_t)slot * D + n]), s, 0.3); }
}
__global__ void ck_combine(const float* save, const bf16_t* ob, const int* slot_of, const float* tok_w, const float* gain, const float* x, const bf16_t* hn, int mode, unsigned* w) {
    for (unsigned i = GTID; i < (unsigned)NSAVE * 32u; i += GSTR) { const int si = i / 32, t = srow(si), j = hsh(i * 67u + 41u) % 2048u;
        const int s0 = slot_of[2 * t], s1 = slot_of[2 * t + 1]; const double w0 = tok_w[2 * t], w1 = tok_w[2 * t + 1];
        double ss = 0, xj = 0; for (int k = 0; k < D; ++k) { const double v = save[(size_t)si * D + k] + w0 * bfd(ob[(size_t)s0 * D + k]) + w1 * bfd(ob[(size_t)s1 * D + k]); ss += v * v; if (k == j) xj = v; }
        const double y = xj / sqrt(ss / D + 1e-6) * gain[j];
        if (mode == 0) { rep(w, x[(size_t)t * D + j], xj, 1.0); rep(w, bfd(hn[(size_t)t * D + j]), y, 1.0); } else rep(w, x[(size_t)t * D + j], y, 1.0); }
}
__global__ void ck_attn(const bf16_t* proj, const bf16_t* o1, const bf16_t* o2, unsigned* w) {
    const int wv = GTID / 64, lane = threadIdx.x & 63, nw = GSTR / 64;
    const int tl[12] = {0, 1, 63, 64, 100, 255, 256, 1000, 4095, 8191, 16320, 16383};
    for (int s = wv; s < 96; s += nw) { const unsigned r = hsh(s * 71u + 43u); const int b = r & 1, h = (r >> 1) % 8u, sub = (r >> 4) & 1, t = tl[s % 12], dv0 = (r >> 5) % 253u;
        const double slope = exp2(-(double)(h + 1)); const int kend = 64 * (t / 64 + 1);
        const bf16_t* qp = proj + dq_off(b, t, h, sub);
        double mx = -1e300;
        for (int j = lane; j < kend; j += 64) { const bf16_t* kp = proj + DK0 + dq_off(b, j, h, sub); double d = 0; for (int q = 0; q < 128; ++q) d += bfd(qp[q]) * bfd(kp[q]);
            const double sc = d * 0.08838834764831845 - slope * fabs((double)(t - j)); if (sc > mx) mx = sc; }
        for (int of = 1; of < 64; of <<= 1) { const double o_ = __shfl_xor(mx, of); if (o_ > mx) mx = o_; }
        double l = 0, acc[4] = {0, 0, 0, 0};
        for (int j = lane; j < kend; j += 64) { const bf16_t* kp = proj + DK0 + dq_off(b, j, h, sub); double d = 0; for (int q = 0; q < 128; ++q) d += bfd(qp[q]) * bfd(kp[q]);
            const double p = exp(d * 0.08838834764831845 - slope * fabs((double)(t - j)) - mx); l += p;
            const bf16_t* vp = proj + dv_off(b, j, h) + dv0; for (int q = 0; q < 4; ++q) acc[q] += p * bfd(vp[q]); }
        for (int of = 1; of < 64; of <<= 1) { l += __shfl_xor(l, of); for (int q = 0; q < 4; ++q) acc[q] += __shfl_xor(acc[q], of); }
        if (lane == 0) for (int q = 0; q < 4; ++q) rep(w, bfd((sub ? o2 : o1)[((size_t)b * SEQ + t) * D + h * 256 + dv0 + q]), acc[q] / l, 0.2); }
}
__global__ void ck_subln(const bf16_t* o1, const bf16_t* o2, const float* lq1, const float* lk1, const float* lq2, const float* lk2, const float* sg, const bf16_t* y, unsigned* w) {
    double d1 = 0, d2 = 0; for (int k = 0; k < 128; ++k) { d1 += (double)lq1[k] * lk1[k]; d2 += (double)lq2[k] * lk2[k]; }
    const double li = 0.8 - 0.6 * exp(-0.3), lam = exp(d1) - exp(d2) + li;
    for (unsigned i = GTID; i < 8192u; i += GSTR) { const unsigned r = hsh(i * 73u + 47u); const int t = r % (unsigned)T, h = (r >> 15) % 8u, j = (r >> 18) % 256u;
        double ss = 0, dj = 0; for (int k = 0; k < 256; ++k) { const double v = bfd(o1[(size_t)t * D + h * 256 + k]) - lam * bfd(o2[(size_t)t * D + h * 256 + k]); ss += v * v; if (k == j) dj = v; }
        rep(w, bfd(y[(size_t)t * D + h * 256 + j]), dj / sqrt(ss / 256 + 1e-6) * sg[j] * (1.0 - li), 1.0); }
}
__global__ void ck_final(const unsigned* words, int nst, float* out, int n) {
    int val = 0;
    for (int s = 0; s < nst; ++s) { const float e = __uint_as_float(words[s]); if (e >= 0.03125f) { val = 4 * s + (e < 0.25f ? 1 : (e < 4.f ? 2 : 3)); break; } }
    const float c = sqrtf(0.1f * (float)val);
    for (int i = GTID; i < n; i += GSTR) out[i] = c;
}
#endif

extern "C" void kernel_launch(void* const* d_in, const int* in_sizes, int n_in, void* d_out, int out_size, void* d_ws, size_t ws_size, hipStream_t stream) {
    static int grid = 0;
    if (grid == 0) {
        if (n_in != 21 || out_size != T * D || ws_size < WS_END + 2 * MiB) { fprintf(stderr, "kernel_launch: unexpected shapes (n_in %d out %d ws %zu)\n", n_in, out_size, ws_size); grid = -1; return; }
        if (hipFuncSetAttribute((const void*)hybrid_fwd, hipFuncAttributeMaxDynamicSharedMemorySize, LDS_BYTES) != hipSuccess) { fprintf(stderr, "kernel_launch: hipFuncSetAttribute failed\n"); grid = -1; return; }
        int dev = 0, cus = 0, per_cu = 0;
        (void)hipGetDevice(&dev); (void)hipDeviceGetAttribute(&cus, hipDeviceAttributeMultiprocessorCount, dev);
        if (hipOccupancyMaxActiveBlocksPerMultiprocessor(&per_cu, (const void*)hybrid_fwd, NWAVES * 64, LDS_BYTES) != hipSuccess || per_cu < 1) fprintf(stderr, "kernel_launch: occupancy query says %d\n", per_cu);
        (void)hipGetLastError();
        grid = cus > 0 ? cus : 256;
    }
    if (grid < 0) return;
    Args a{};
    for (int i = 0; i < 21; ++i) a.in[i] = (const float*)d_in[i];
    a.out = (float*)d_out; a.ws = (unsigned char*)d_ws; a.upto = 99; a.pad1 = 0;
#if !DIAG
    (void)hipMemsetAsync((char*)d_ws + WS_CTL, 0, CTL_ZERO_BYTES, stream);
    hipLaunchKernelGGL(hybrid_fwd, dim3(grid), dim3(NWAVES * 64), LDS_BYTES, stream, a);
#else
    {
        unsigned char* ws = (unsigned char*)d_ws; const float* const* in = a.in;
        unsigned* words = (unsigned*)(ws + WS_DIAG); float* save = (float*)(ws + WS_DIAG + 65536);
        (void)hipMemsetAsync(words, 0, 65536, stream);
        float* gz = (float*)(ws + WS_GZ); int* tok_e = (int*)(ws + WS_TOKE); int* tok_p = (int*)(ws + WS_TOKP); float* tok_w = (float*)(ws + WS_TOKW); int* slot_of = (int*)(ws + WS_SLOT);
        float* adec = (float*)(ws + WS_ADEC); float* wp_gz = (float*)(ws + WS_WPGZ); float* wp_r0 = (float*)(ws + WS_WPR0); float* wp_r1 = (float*)(ws + WS_WPR1);
        bf16_t* wgi = (bf16_t*)(ws + WS_WGI); bf16_t* wgo = (bf16_t*)(ws + WS_WGO); bf16_t* wdi = (bf16_t*)(ws + WS_WDI); bf16_t* wdo = (bf16_t*)(ws + WS_WDO);
        bf16_t* gu = (bf16_t*)(ws + WS_WMOE); bf16_t* dt = (bf16_t*)(ws + WS_WMOE_D);
        bf16_t* hn = (bf16_t*)(ws + WS_HN); bf16_t* proj = (bf16_t*)(ws + WS_PROJ); bf16_t* buf1 = (bf16_t*)(ws + WS_BUF1); bf16_t* buf2 = (bf16_t*)(ws + WS_BUF2);
        bf16_t* ag = (bf16_t*)(ws + WS_AG); bf16_t* ob = (bf16_t*)(ws + WS_OB); bf16_t* hh = (bf16_t*)(ws + WS_H);
        unsigned* ctl = (unsigned*)(ws + WS_CTL); float* xres = (float*)d_out;
        const size_t L1W = (size_t)NEXP * D * DFF;
        for (int st = 0; st <= 20; ++st) {
            (void)hipMemsetAsync((char*)d_ws + WS_CTL, 0, CTL_ZERO_BYTES, stream);
            a.upto = st;
            hipLaunchKernelGGL(hybrid_fwd, dim3(grid), dim3(NWAVES * 64), LDS_BYTES, stream, a);
            unsigned* w = words + st;
            switch (st) {
            case 0: ck_weights<<<256, 256, 0, stream>>>(in[3], in[7], in[8], in[14], wgi, wgo, wdi, wdo, in[1], in[2], in[15], in[16], wp_gz, wp_r0, wp_r1, w); break;
            case 1: ck_norm<<<64, 64, 0, stream>>>(in[0], in[1], hn, w); ck_gz<<<64, 64, 0, stream>>>(in[0], in[1], in[3], gz, w); break;
            case 2: ck_proj<<<256, 64, 0, stream>>>(hn, wgi, proj, 0, w); break;
            case 3: ck_gate<<<64, 64, 0, stream>>>(gz, in[4], in[5], proj, buf1, adec, w); break;
            case 4: ck_scan<<<96, 64, 0, stream>>>(proj, buf1, adec, buf2, w); ck_moew<<<256, 256, 0, stream>>>(in[17], in[18], in[19], gu, dt, w); break;
            case 5: ck_gnorm<<<128, 64, 0, stream>>>(buf2, proj, in[6], hn, w); break;
            case 6: ck_gemm_res<<<64, 64, 0, stream>>>(hn, wgo, in[0], 0, xres, w); break;
            case 7: ck_norm<<<64, 64, 0, stream>>>(xres, in[2], hn, w); ck_route<<<8, 64, 0, stream>>>(xres, in[2], in[15], in[16], tok_e, tok_p, tok_w, ctl + CW_CNT0, w); break;
            case 8: ck_gather<<<128, 64, 0, stream>>>(tok_e, tok_p, slot_of, ctl + CW_CNT0, hn, (const int*)(ws + WS_STOK), w); break;
            case 9: ck_moe1<<<128, 64, 0, stream>>>(tok_e, slot_of, hn, in[17], in[18], hh, w); break;
            case 10: ck_moe2<<<128, 64, 0, stream>>>(tok_e, slot_of, hh, in[19], ob, w); ck_save<<<64, 256, 0, stream>>>(xres, save); break;
            case 11: ck_combine<<<32, 64, 0, stream>>>(save, ob, slot_of, tok_w, in[1] + D, xres, hn, 0, w); ck_moew<<<256, 256, 0, stream>>>(in[17] + L1W, in[18] + L1W, in[19] + L1W, gu, dt, w); break;
            case 12: ck_proj<<<256, 64, 0, stream>>>(hn, wdi, proj, 1, w); break;
            case 13: ck_attn<<<96, 64, 0, stream>>>(proj, buf1, buf2, w); break;
            case 14: ck_subln<<<128, 64, 0, stream>>>(buf1, buf2, in[9], in[10], in[11], in[12], in[13], hn, w); ck_save<<<64, 256, 0, stream>>>(xres, save); break;
            case 15: ck_gemm_res<<<64, 64, 0, stream>>>(hn, wdo, save, 1, xres, w); break;
            case 16: ck_norm<<<64, 64, 0, stream>>>(xres, in[2] + D, hn, w); ck_route<<<8, 64, 0, stream>>>(xres, in[2] + D, in[15] + (size_t)D * 4, in[16] + (size_t)D * 32, tok_e, tok_p, tok_w, ctl + CW_CNT1, w); break;
            case 17: ck_gather<<<128, 64, 0, stream>>>(tok_e, tok_p, slot_of, ctl + CW_CNT1, hn, (const int*)(ws + WS_STOK), w); break;
            case 18: ck_moe1<<<128, 64, 0, stream>>>(tok_e, slot_of, hn, in[17] + L1W, in[18] + L1W, hh, w); break;
            case 19: ck_moe2<<<128, 64, 0, stream>>>(tok_e, slot_of, hh, in[19] + L1W, ob, w); ck_save<<<64, 256, 0, stream>>>(xres, save); break;
            case 20: ck_combine<<<32, 64, 0, stream>>>(save, ob, slot_of, tok_w, in[20], xres, hn, 1, w); break;
            }
        }
        ck_final<<<1024, 256, 0, stream>>>(words, 21, (float*)d_out, out_size);
    }
#endif
}
```

```cpp
#ifndef DIAG
#define DIAG 0
#endif
#ifndef PROBE
#define PROBE 0
#endif
#ifndef REP_PHASE
#define REP_PHASE -1
#endif
#include <hip/hip_runtime.h>
#include <cstdio>
#include <cstdint>

#define LAS __attribute__((address_space(3)))
#define GAS __attribute__((address_space(1)))
typedef unsigned short bf16_t;
typedef short bf16x8 __attribute__((ext_vector_type(8)));
typedef short s16x4 __attribute__((ext_vector_type(4)));
typedef float f32x4 __attribute__((ext_vector_type(4)));
typedef float f32x2 __attribute__((ext_vector_type(2)));
typedef float f32x16 __attribute__((ext_vector_type(16)));
typedef unsigned u32x4 __attribute__((ext_vector_type(4)));
typedef unsigned u32x2 __attribute__((ext_vector_type(2)));

constexpr int D = 2048, SEQ = 16384, NBATCH = 2, T = NBATCH * SEQ, CHUNK = 64, NCH = SEQ / CHUNK;
constexpr int GLA_H = 4, GLA_DK = 256, GLA_DV = 512, GLA_DKT = 1024, GLA_INW = 6160, PROJW = 6144;
constexpr int DIFF_H = 8;
constexpr int NEXP = 32, DFF = 512;
constexpr float RMS_EPS = 1e-6f;
constexpr float LAMBDA_INIT = 0.35550906759f;
constexpr int MAX_TILES = 288;

constexpr size_t MiB = 1u << 20;
constexpr size_t WS_CTL = 0, CTL_ZERO_BYTES = 1 * MiB;
constexpr size_t WS_GZ = 2 * MiB;
constexpr size_t WS_TOKE = 4 * MiB;
constexpr size_t WS_TOKP = WS_TOKE + 256 * 1024;
constexpr size_t WS_TOKW = WS_TOKP + 256 * 1024;
constexpr size_t WS_SLOT = WS_TOKW + 256 * 1024;
constexpr size_t WS_STOK = 5 * MiB;
constexpr size_t WS_ADEC = 8 * MiB;
constexpr size_t WS_WPGZ = 10 * MiB;
constexpr size_t WS_WPR0 = 10 * MiB + 256 * 1024;
constexpr size_t WS_WPR1 = 11 * MiB;
constexpr size_t WS_NRM = 12 * MiB;
constexpr size_t WS_PCUM = 13 * MiB;
constexpr size_t WS_SFIN = 14 * MiB;
constexpr size_t WS_WGI = 16 * MiB, WS_WGO = 40 * MiB, WS_WDI = 48 * MiB, WS_WDO = 72 * MiB;
constexpr size_t WS_WMOE = 80 * MiB;
constexpr size_t WS_WMOE_D = WS_WMOE + 128 * MiB;
constexpr size_t WS_WMOE1 = WS_WMOE + 64 * MiB, WS_WMOE1_D = WS_WMOE + 160 * MiB;
constexpr size_t WS_HN = 272 * MiB;
constexpr size_t WS_PROJ = 400 * MiB;
constexpr size_t WS_BUF1 = 784 * MiB;
constexpr size_t WS_BUF2 = 912 * MiB;
constexpr size_t WS_AG = 400 * MiB;
constexpr size_t WS_OB = 688 * MiB;
constexpr size_t WS_H = 976 * MiB;
constexpr size_t WS_END = 1048 * MiB;
constexpr int CW_BAR = 4096;
constexpr int CW_PROBE = 8320;
constexpr int CW_QUEUE = 8192;
constexpr int CW_CNT0 = 16384, CW_CNT1 = 16384 + 32 * 64;


constexpr size_t GK0 = (size_t)T * 1024, GV0 = (size_t)T * 2048, GR0 = (size_t)T * 4096;
constexpr size_t DK0 = (size_t)T * 2048, DV0 = (size_t)T * 4096;
__host__ __device__ __forceinline__ size_t gq_off(int b, int t, int h) { return ((size_t)(b * 4 + h) * SEQ + t) * 256; }
__host__ __device__ __forceinline__ size_t gv_off(int b, int t, int h) { return GV0 + ((size_t)(b * 4 + h) * SEQ + t) * 512; }
__host__ __device__ __forceinline__ size_t dq_off(int b, int t, int h, int sub) { return ((size_t)((b * 8 + h) * 2 + sub) * SEQ + t) * 128; }
__host__ __device__ __forceinline__ size_t dv_off(int b, int t, int h) { return DV0 + ((size_t)(b * 8 + h) * SEQ + t) * 256; }

constexpr int RING_BYTES = 131072;
constexpr int LDSCTL_OFF = RING_BYTES;
constexpr int MISC_OFF = LDSCTL_OFF + 320;
constexpr int TIDS_OFF = LDSCTL_OFF + 8192;
constexpr int TAB_OFF = LDSCTL_OFF + 1024;
constexpr int LDS_BYTES = 147456;
constexpr int NWAVES = 8;

typedef __bf16 bf16x2_t __attribute__((ext_vector_type(2)));
__device__ __forceinline__ unsigned cvt_pk_bf16(float lo, float hi) { const f32x2 v = {lo, hi}; return __builtin_bit_cast(unsigned, __builtin_convertvector(v, bf16x2_t)); }
__device__ __forceinline__ unsigned cvt4_fp8(float a, float b, float c, float d) { int v = __builtin_amdgcn_cvt_pk_fp8_f32(a, b, 0, false); return (unsigned)__builtin_amdgcn_cvt_pk_fp8_f32(c, d, v, true); }
constexpr float W8_SCALE = 64.f;
__device__ __forceinline__ float bf_lo(unsigned w) { return __uint_as_float(w << 16); }
__device__ __forceinline__ float bf_hi(unsigned w) { return __uint_as_float(w & 0xffff0000u); }
__device__ __forceinline__ float bf2f(bf16_t b) { return __uint_as_float(((unsigned)b) << 16); }
__device__ __forceinline__ float wave_sum(float v) {
#pragma unroll
    for (int o = 1; o < 64; o <<= 1) v += __shfl_xor(v, o);
    return v;
}
__device__ __forceinline__ int lane_id() { return (int)__builtin_amdgcn_mbcnt_hi(~0u, __builtin_amdgcn_mbcnt_lo(~0u, 0u)); }
__device__ __forceinline__ int lane_id_volatile() { int l; asm volatile("v_mbcnt_lo_u32_b32 %0, -1, 0\n\tv_mbcnt_hi_u32_b32 %0, -1, %0" : "=v"(l)); return l; }
__device__ __forceinline__ int opq(int v) { asm volatile("" : "+v"(v)); return v; }
#define LDS_WAIT() asm volatile("s_waitcnt lgkmcnt(0)" ::: "memory")
#define VM_WAIT() asm volatile("s_waitcnt vmcnt(0)" ::: "memory")
#define WG_BAR() do { asm volatile("s_waitcnt lgkmcnt(0)" ::: "memory"); __builtin_amdgcn_s_barrier(); asm volatile("" ::: "memory"); } while (0)

namespace pg8 {
constexpr int BM = 256, BK = 64, HALF = 128, HTB = HALF * BK * 2, STAGE_BYTES = 8 * HTB, NXCD = 8, WGM = 8;
__host__ __device__ __forceinline__ int lds_byte(int r, int c) { const int st = (r >> 4) * 2 + (c >> 5), rr = r & 15, cc = c & 31, ob = rr * 64 + cc * 2; return st * 1024 + (ob ^ (((ob >> 9) & 1) << 5)); }
__host__ __device__ __forceinline__ void stage_rc(int b, int& R, int& C) { const int st = b / 1024, sb = b % 1024, swz = sb ^ (((sb >> 9) & 1) << 5); R = (st >> 1) * 16 + swz / 64; C = (st & 1) * 32 + (swz % 64) / 2; }
__host__ __device__ __forceinline__ int perm32(int rho) { const int n = rho >> 4, i = rho & 15; return 8 * (i >> 2) + 4 * n + (i & 3); }

struct Unit { int pm, pn; };
struct Gemm { const bf16_t* A; const bf16_t* Bt; int M, N, K; };

struct StaticOrder {
    int nM, nN, nwg, G, c;
    __device__ void init(int M, int N, int G_, int c_) { nM = M / BM; nN = N / BM; nwg = nM * nN; G = G_; c = c_; }
    __device__ bool next(int i, Unit& u) const {
        const long L = (long)i * G + c; if (L >= nwg) return false;
        int wgid = (int)L; { const int q = nwg / NXCD, r = nwg % NXCD, xcd = wgid % NXCD, off = wgid / NXCD; wgid = (xcd < r ? xcd * (q + 1) : r * (q + 1) + (xcd - r) * q) + off; }
        const int nig = WGM * nN, gid = wgid / nig, fm = gid * WGM, gsz = (nM - fm) < WGM ? (nM - fm) : WGM;
        u.pm = fm + ((wgid % nig) % gsz); u.pn = (wgid % nig) / gsz; return true;
    }
    __device__ __forceinline__ size_t bofs(const Unit&) const { return 0; }
};
struct MoeOrder : StaticOrder {
    const LAS int* te; size_t estride; const int* stok;
    __device__ __forceinline__ size_t bofs(const Unit& u) const { return (size_t)te[u.pm] * estride; }
    __device__ __forceinline__ int arow(int pm, int r) const { const int t = stok[pm * BM + r]; return t < 0 ? 0 : t; }
};

struct EpiBf16 {
    static constexpr bool PERM = true;
    bf16_t* O; int ldc;
    __device__ __forceinline__ void operator()(const f32x4 (&acc)[2][2][4][2], const Unit& u, int wr, int wc, int fr, int fq) const {
        const int row0 = u.pm * BM + wr * 64 + fr, col0 = u.pn * BM + wc * 32 + 8 * fq;
#pragma unroll
        for (int ai = 0; ai < 2; ++ai)
#pragma unroll
            for (int m = 0; m < 4; ++m) { bf16_t* rowp = O + (size_t)(row0 + ai * HALF + m * 16) * ldc + col0;
#pragma unroll
                for (int bj = 0; bj < 2; ++bj) { const f32x4 v0 = acc[ai][bj][m][0], v1 = acc[ai][bj][m][1];
                    u32x4 w; w.x = cvt_pk_bf16(v0[0], v0[1]); w.y = cvt_pk_bf16(v0[2], v0[3]); w.z = cvt_pk_bf16(v1[0], v1[1]); w.w = cvt_pk_bf16(v1[2], v1[3]);
                    *(u32x4*)(rowp + bj * HALF) = w; } }
    }
};
template <int LAYER> struct EpiHeads {
    static constexpr bool PERM = true;
    bf16_t* O;
    __device__ __forceinline__ void operator()(const f32x4 (&acc)[2][2][4][2], const Unit& u, int wr, int wc, int fr, int fq) const {
        const int pn = u.pn, lc = wc * 32 + 8 * fq;
#pragma unroll
        for (int ai = 0; ai < 2; ++ai)
#pragma unroll
            for (int m = 0; m < 4; ++m) { const int row = u.pm * BM + ai * HALF + wr * 64 + m * 16 + fr, b = row >> 14, t = row & (SEQ - 1);
#pragma unroll
                for (int bj = 0; bj < 2; ++bj) { size_t off;
                    if (LAYER == 0) { if (pn < 4) off = gq_off(b, t, pn) + bj * 128 + lc; else if (pn < 8) off = GK0 + gq_off(b, t, pn - 4) + bj * 128 + lc;
                                      else if (pn < 16) off = gv_off(b, t, (pn - 8) >> 1) + ((pn - 8) & 1) * 256 + bj * 128 + lc; else off = GR0 + (size_t)row * 2048 + (pn - 16) * 256 + bj * 128 + lc; }
                    else { if (pn < 8) off = dq_off(b, t, pn, bj) + lc; else if (pn < 16) off = DK0 + dq_off(b, t, pn - 8, bj) + lc; else off = dv_off(b, t, pn - 16) + bj * 128 + lc; }
                    const f32x4 v0 = acc[ai][bj][m][0], v1 = acc[ai][bj][m][1];
                    u32x4 w; w.x = cvt_pk_bf16(v0[0], v0[1]); w.y = cvt_pk_bf16(v0[2], v0[3]); w.z = cvt_pk_bf16(v1[0], v1[1]); w.w = cvt_pk_bf16(v1[2], v1[3]);
                    *(u32x4*)(O + off) = w; } }
    }
};
struct FixOrder : StaticOrder {
    __device__ __forceinline__ size_t bofs(const Unit& u) const { return (size_t)(u.pm >> 5) * (512 * 256 * 2); }
};
struct EpiAddO {
    static constexpr bool PERM = true;
    bf16_t* O;
    __device__ __forceinline__ void operator()(const f32x4 (&acc)[2][2][4][2], const Unit& u, int wr, int wc, int fr, int fq) const {
#pragma unroll
        for (int ai = 0; ai < 2; ++ai)
#pragma unroll
            for (int m = 0; m < 4; ++m) { const int row = u.pm * BM + ai * HALF + wr * 64 + m * 16 + fr, bhh = row >> 13, t = row & 8191;
                bf16_t* rowp = O + ((size_t)(bhh >> 2) * SEQ + SEQ / 2 + t) * D + (bhh & 3) * 512 + u.pn * BM + wc * 32 + 8 * fq;
#pragma unroll
                for (int bj = 0; bj < 2; ++bj) { const u32x4 old = *(const u32x4*)(rowp + bj * HALF); const f32x4 v0 = acc[ai][bj][m][0] * 0.0625f, v1 = acc[ai][bj][m][1] * 0.0625f;
                    u32x4 w; w.x = cvt_pk_bf16(bf_lo(old.x) + v0[0], bf_hi(old.x) + v0[1]); w.y = cvt_pk_bf16(bf_lo(old.y) + v0[2], bf_hi(old.y) + v0[3]);
                    w.z = cvt_pk_bf16(bf_lo(old.z) + v1[0], bf_hi(old.z) + v1[1]); w.w = cvt_pk_bf16(bf_lo(old.w) + v1[2], bf_hi(old.w) + v1[3]);
                    *(u32x4*)(rowp + bj * HALF) = w; } }
    }
};
struct EpiResF32 {
    static constexpr bool PERM = false;
    const float* base; float* C; int ldc;
    __device__ __forceinline__ void operator()(const f32x4 (&acc)[2][2][4][2], const Unit& u, int wr, int wc, int fr, int fq) const {
        const int row0 = u.pm * BM + wr * 64 + fr, col0 = u.pn * BM + wc * 32 + 4 * fq;
#pragma unroll
        for (int ai = 0; ai < 2; ++ai)
#pragma unroll
            for (int m = 0; m < 4; ++m) { const size_t off = (size_t)(row0 + ai * HALF + m * 16) * ldc + col0;
#pragma unroll
                for (int bj = 0; bj < 2; ++bj)
#pragma unroll
                    for (int n = 0; n < 2; ++n) { const f32x4 bs = *(const f32x4*)(base + off + bj * HALF + n * 16); *(f32x4*)(C + off + bj * HALF + n * 16) = bs + acc[ai][bj][m][n]; }
                asm volatile("" ::: "memory"); }
    }
};
struct EpiSiluMul {
    static constexpr bool PERM = true;
    unsigned char* Hh;
    __device__ __forceinline__ void operator()(const f32x4 (&acc)[2][2][4][2], const Unit& u, int wr, int wc, int fr, int fq) const {
        const int row0 = u.pm * BM + wr * 64 + fr, col0 = u.pn * HALF + wc * 32 + 8 * fq;
#pragma unroll
        for (int ai = 0; ai < 2; ++ai)
#pragma unroll
            for (int m = 0; m < 4; ++m) { unsigned char* rowp = Hh + (size_t)(row0 + ai * HALF + m * 16) * DFF + col0;
                float hv[8];
#pragma unroll
                for (int n = 0; n < 2; ++n)
#pragma unroll
                    for (int j = 0; j < 4; ++j) { const float g = acc[ai][0][m][n][j], up = acc[ai][1][m][n][j];
                        const float sg = g * __builtin_amdgcn_rcpf(1.0f + __builtin_amdgcn_exp2f(-1.4426950408889634f * g)); hv[n * 4 + j] = sg * up; }
                u32x2 w; w.x = cvt4_fp8(hv[0], hv[1], hv[2], hv[3]); w.y = cvt4_fp8(hv[4], hv[5], hv[6], hv[7]);
                *(u32x2*)rowp = w; }
    }
};

typedef int v8i32 __attribute__((ext_vector_type(8)));
typedef int v4i32 __attribute__((ext_vector_type(4)));
template <class Epi, class Sched, bool GATHER = false, bool FP8 = false>
__device__ __forceinline__ void gemm_phase(LAS unsigned char* lds, const Gemm g, const Sched& S, const Epi& E, int tid_in) {
    const int tid = opq(tid_in), wid = __builtin_amdgcn_readfirstlane(tid >> 6), lane = tid & 63, wr = wid >> 2, wc = wid & 3, fr = lane & 15, fq = lane >> 4;
    const int K = g.K, RP = FP8 ? K : 2 * K  , nt = RP / (BK * 2);
    unsigned voffA[2], voffB[2];
#pragma unroll
    for (int i = 0; i < 2; ++i) { int R, C; stage_rc(tid * 16 + i * 8192, R, C); const int Rb = Epi::PERM ? ((R & ~31) + perm32(R & 31)) : R;
        voffA[i] = (unsigned)(R * RP + 2 * C); voffB[i] = (unsigned)(Rb * RP + 2 * C); }
    const unsigned kstep = (unsigned)(BK * 2);
    const unsigned hstep = (unsigned)HALF * (unsigned)RP;
    const size_t tstep = 2 * (size_t)hstep;
    const unsigned ldsw = (unsigned)wid * 1024u;
    const int aoff = lds_byte(wr * 64 + fr, fq * 8), boff = lds_byte(wc * 32 + fr, fq * 8);
    const LAS unsigned char* ldsB = lds + 4 * HTB + boff;
#define PG8_SA(b, h) (((b) * 2 + (h)) * HTB)
#define PG8_SB(b, h) ((4 + (b) * 2 + (h)) * HTB)
#define PG8_STAGE(bufoff, gbase, voff) do { const unsigned long long gv_ = (unsigned long long)(gbase); \
        const unsigned glo_ = (unsigned)__builtin_amdgcn_readfirstlane((unsigned)gv_), ghi_ = (unsigned)__builtin_amdgcn_readfirstlane((unsigned)(gv_ >> 32)); const char* gb_ = (const char*)(((unsigned long long)ghi_ << 32) | (unsigned long long)glo_);     \
        _Pragma("unroll") for (int _i = 0; _i < 2; ++_i) \
        __builtin_amdgcn_global_load_lds((const unsigned*)(gb_ + (voff)[_i]), (LAS unsigned*)(lds + (bufoff) + ldsw + _i * 8192), 16, 0, 0); } while (0)
#define PG8_STAGE_A(bufoff, nx, koff, h) do { if constexpr (GATHER) { unsigned vs_[2]; _Pragma("unroll") for (int _i = 0; _i < 2; ++_i) vs_[_i] = (nx) ? vAn[h][_i] : vAc[h][_i]; \
            PG8_STAGE(bufoff, (const char*)g.A + (koff), vs_); } \
        else { PG8_STAGE(bufoff, ((nx) ? nA : cA) + (koff) + (h) * hstep, voffA); } } while (0)
#define PG8_LD8(off) __builtin_shufflevector(*(const LAS v4i32*)(lds + (off)), *(const LAS v4i32*)(lds + (off) + 1024), 0, 1, 2, 3, 4, 5, 6, 7)
#define PG8_LDA(dst, b, h) do { if constexpr (FP8) { _Pragma("unroll") for (int m = 0; m < 4; ++m) dst##8[m] = PG8_LD8(PG8_SA(b, h) + aoff + m * 2048); } \
        else { _Pragma("unroll") for (int m = 0; m < 4; ++m) _Pragma("unroll") for (int k = 0; k < 2; ++k) dst[m][k] = *(const LAS bf16x8*)(lds + PG8_SA(b, h) + aoff + m * 2048 + k * 1024); } } while (0)
#define PG8_LD8B(off) __builtin_shufflevector(*(const LAS v4i32*)(ldsB + (off)), *(const LAS v4i32*)(ldsB + (off) + 1024), 0, 1, 2, 3, 4, 5, 6, 7)
#define PG8_LDB(dst, b, h) do { if constexpr (FP8) { _Pragma("unroll") for (int n = 0; n < 2; ++n) dst##8[n] = PG8_LD8B(PG8_SA(b, h) + n * 2048); }     \
        else { _Pragma("unroll") for (int n = 0; n < 2; ++n) _Pragma("unroll") for (int k = 0; k < 2; ++k) dst[n][k] = *(const LAS bf16x8*)(lds + PG8_SB(b, h) + boff + n * 2048 + k * 1024); } } while (0)
#define PG8_MMA(ai, bj, At, Bt) do { __builtin_amdgcn_s_setprio(1); if constexpr (FP8) { _Pragma("unroll") for (int m = 0; m < 4; ++m) _Pragma("unroll") for (int n = 0; n < 2; ++n) \
              \
            asm volatile("v_mfma_scale_f32_16x16x128_f8f6f4 %0, %1, %2, %0, %3, %3 op_sel:[0,1,0] op_sel_hi:[0,0,0]" : "+v"(acc[ai][bj][m][n]) : "v"(Bt##8[n]), "v"(At##8[m]), "v"(scl8)); } \
        else { _Pragma("unroll") for (int m = 0; m < 4; ++m) _Pragma("unroll") for (int n = 0; n < 2; ++n) _Pragma("unroll") for (int k = 0; k < 2; ++k) \
            acc[ai][bj][m][n] = __builtin_amdgcn_mfma_f32_16x16x32_bf16(Bt[n][k], At[m][k], acc[ai][bj][m][n], 0, 0, 0); } __builtin_amdgcn_s_setprio(0); } while (0)
#define PG8_WAIT_V(n) asm volatile("s_waitcnt vmcnt(" #n ")" ::: "memory")
#define PG8_WAIT_L(n) asm volatile("s_waitcnt lgkmcnt(" #n ")" ::: "memory")
#define PG8_BAR __builtin_amdgcn_s_barrier()
#define PG8_SCHED __builtin_amdgcn_sched_barrier(0)
#define PG8_ROWOFFS(V, U) do { if constexpr (GATHER) { const int t_ = opq(wid * 64 + lane_id());     \
        _Pragma("unroll") for (int i_ = 0; i_ < 2; ++i_) { int R_, C_; stage_rc(t_ * 16 + i_ * 8192, R_, C_); \
        _Pragma("unroll") for (int h_ = 0; h_ < 2; ++h_) V[h_][i_] = (unsigned)S.arow((U).pm, h_ * HALF + R_) * (unsigned)RP + 2u * (unsigned)C_; } } } while (0)
    Unit cur, nxt; int ui = 0;
    if (!S.next(0, cur)) return;
    f32x4 acc[2][2][4][2];
#pragma unroll
    for (int a = 0; a < 2; ++a)
#pragma unroll
        for (int b = 0; b < 2; ++b)
#pragma unroll
            for (int m = 0; m < 4; ++m)
#pragma unroll
                for (int n = 0; n < 2; ++n) acc[a][b][m][n] = (f32x4){0.f, 0.f, 0.f, 0.f};
    const unsigned scl8 = 0x7f797f79u;
    bf16x8 At[4][2], B0[2][2], B1[2][2]; v8i32 At8[4], B08[2], B18[2];
    unsigned vAc[2][2] = {{0u, 0u}, {0u, 0u}}, vAn[2][2] = {{0u, 0u}, {0u, 0u}};
    const char* cA = (const char*)g.A + (GATHER ? (size_t)0 : (size_t)cur.pm * tstep); const char* nA = cA; const char* cB = (const char*)g.Bt + S.bofs(cur) + (size_t)cur.pn * tstep;
    PG8_ROWOFFS(vAc, cur);
    PG8_STAGE(PG8_SB(0, 0), cB, voffB); PG8_STAGE(PG8_SB(0, 1), cB + hstep, voffB); PG8_STAGE_A(PG8_SA(0, 0), false, 0u, 0); PG8_STAGE_A(PG8_SA(0, 1), false, 0u, 1);
    if (wr == 1) PG8_BAR;
    PG8_WAIT_V(2); PG8_BAR;
    PG8_STAGE(PG8_SB(1, 0), cB + kstep, voffB); PG8_STAGE_A(PG8_SA(1, 0), false, kstep, 0); PG8_STAGE(PG8_SB(1, 1), cB + hstep + kstep, voffB);
    PG8_WAIT_V(6); PG8_BAR;
    for (;;) {
        const bool has_next = S.next(ui + 1, nxt);
        nA = (has_next && !GATHER) ? (const char*)g.A + (size_t)nxt.pm * tstep : cA; const char* nB = has_next ? (const char*)g.Bt + S.bofs(nxt) + (size_t)nxt.pn * tstep : cB;

        for (int t = 0; t < nt; t += 2) {
            const bool last = (t == nt - 2);
            if constexpr (GATHER) { if (last) {
                if (has_next) PG8_ROWOFFS(vAn, nxt); else { _Pragma("unroll") for (int h_ = 0; h_ < 2; ++h_) _Pragma("unroll") for (int i_ = 0; i_ < 2; ++i_) vAn[h_][i_] = vAc[h_][i_]; } } }
            const unsigned k1 = (unsigned)(t + 1) * kstep, k2 = last ? 0u : (unsigned)(t + 2) * kstep, k3 = k2 + kstep;
            const char* b2 = last ? nB : cB + k2; const char* b3 = b2 + kstep;
            PG8_LDB(B0, 0, 0); PG8_LDB(B1, 0, 1); PG8_SCHED; PG8_LDA(At, 0, 0); PG8_STAGE_A(PG8_SA(1, 1), false, k1, 1);
            PG8_WAIT_V(8); PG8_WAIT_L(0); PG8_BAR; PG8_MMA(0, 0, At, B0); PG8_MMA(0, 1, At, B1); PG8_BAR; PG8_SCHED;
            PG8_LDA(At, 0, 1); PG8_STAGE(PG8_SB(0, 0), b2, voffB); PG8_STAGE(PG8_SB(0, 1), b2 + hstep, voffB); PG8_STAGE_A(PG8_SA(0, 0), last, k2, 0);
            PG8_WAIT_V(8); PG8_WAIT_L(0); PG8_BAR; PG8_MMA(1, 0, At, B0); PG8_MMA(1, 1, At, B1); PG8_BAR; PG8_SCHED;
            PG8_LDB(B0, 1, 0); PG8_LDB(B1, 1, 1); PG8_SCHED; PG8_LDA(At, 1, 0); PG8_STAGE_A(PG8_SA(0, 1), last, k2, 1);
            PG8_WAIT_V(8); PG8_WAIT_L(0); PG8_BAR; PG8_MMA(0, 0, At, B0); PG8_MMA(0, 1, At, B1); PG8_BAR; PG8_SCHED;
            PG8_LDA(At, 1, 1); PG8_STAGE(PG8_SB(1, 0), b3, voffB); PG8_STAGE(PG8_SB(1, 1), b3 + hstep, voffB); PG8_STAGE_A(PG8_SA(1, 0), last, k3, 0);
            PG8_WAIT_V(8); PG8_WAIT_L(0); PG8_BAR; PG8_MMA(1, 0, At, B0); PG8_MMA(1, 1, At, B1); PG8_BAR; PG8_SCHED;
        }
        if (wr == 0) PG8_BAR;
        E(acc, cur, wr, wc, fr, fq);
        if (!has_next) break;
#pragma unroll
        for (int a = 0; a < 2; ++a)
#pragma unroll
            for (int b = 0; b < 2; ++b)
#pragma unroll
                for (int m = 0; m < 4; ++m)
#pragma unroll
                    for (int n = 0; n < 2; ++n) acc[a][b][m][n] = (f32x4){0.f, 0.f, 0.f, 0.f};
        cur = nxt; cA = nA; cB = nB; ++ui;
        if constexpr (GATHER) { _Pragma("unroll") for (int h_ = 0; h_ < 2; ++h_) _Pragma("unroll") for (int i_ = 0; i_ < 2; ++i_) vAc[h_][i_] = vAn[h_][i_]; }
        if (wr == 1) PG8_BAR;
    }
    PG8_WAIT_V(0);
    PG8_BAR;
#undef PG8_SA
#undef PG8_SB
#undef PG8_STAGE
#undef PG8_STAGE_A
#undef PG8_ROWOFFS
#undef PG8_LDA
#undef PG8_LDB
#undef PG8_MMA
#undef PG8_LD8
#undef PG8_LD8B
#undef PG8_WAIT_V
#undef PG8_WAIT_L
#undef PG8_BAR
#undef PG8_SCHED
}
}

#define XB_TMO      128
#define XB_XCNT(j)  (256  + 64 * (j))
#define XB_XSUB(j)  (1280 + 64 * (j))
#define XB_XGEN(j)  (2304 + 64 * (j))
#define XB_TOP      3328
#define XB_TOPGEN   3392
#define XCD_BAR_WORDS 3456
#define XB_SPIN_CAP (1u << 18)
__device__ __forceinline__ unsigned xb_ld(unsigned* p)              { return __hip_atomic_load(p, __ATOMIC_RELAXED, __HIP_MEMORY_SCOPE_AGENT); }
__device__ __forceinline__ unsigned xb_add(unsigned* p, unsigned v) { return __hip_atomic_fetch_add(p, v, __ATOMIC_RELAXED, __HIP_MEMORY_SCOPE_AGENT); }
__device__ __forceinline__ unsigned xb_xcc_id() { return (unsigned)__builtin_amdgcn_s_getreg((3 << 11) | 20) & 0xFu; }
#define XB_SPIN(cond, bar) do { unsigned _sp = 0; while (cond) { __builtin_amdgcn_s_sleep(1); \
    if ((++_sp & 255u) == 0u) { if (xb_ld(&(bar)[XB_TMO])) break; if (_sp > XB_SPIN_CAP) { atomicAdd(&(bar)[XB_TMO], 1u); break; } } } } while (0)
struct XcdBarrier { unsigned* bar; unsigned x; volatile LAS unsigned* st; int wave; };
__device__ __forceinline__ XcdBarrier xcd_barrier_post(unsigned* bar, volatile LAS unsigned* st) {
    XcdBarrier b; b.bar = bar; b.x = xb_xcc_id(); b.st = st; b.wave = __builtin_amdgcn_readfirstlane((int)threadIdx.x >> 6);
    if (threadIdx.x == 0) (void)xb_add(&bar[XB_XCNT(b.x)], 1u);
    return b;
}
__device__ __forceinline__ void xcd_barrier_complete(unsigned* bar, unsigned x, unsigned& nloc, unsigned& nx) {
    const unsigned G = gridDim.x * gridDim.y * gridDim.z;
    unsigned sum, cnt, mine, sp = 0u;
    for (;;) {
        sum = 0u; cnt = 0u; mine = 0u;
#pragma unroll
        for (unsigned j = 0; j < 16; ++j) { const unsigned c = xb_ld(&bar[XB_XCNT(j)]); sum += c; cnt += (c > 0u) ? 1u : 0u; mine = (j == x) ? c : mine; }
        if (sum == G) break;
        __builtin_amdgcn_s_sleep(1);
        if ((++sp & 255u) == 0u) { if (xb_ld(&bar[XB_TMO])) break; if (sp > XB_SPIN_CAP) { atomicAdd(&bar[XB_TMO], 1u); break; } }
    }
    nloc = mine > 0u ? mine : 1u; nx = cnt > 0u ? cnt : 1u;
}
__device__ __forceinline__ void xcd_barrier(const XcdBarrier& b, bool leader  ) {
    asm volatile("s_waitcnt vmcnt(0)" ::: "memory");
    __syncthreads();
    if (leader) {
        unsigned* bar = b.bar;
        __builtin_amdgcn_s_waitcnt(0);
        unsigned nloc = b.st[0], nx = b.st[1];
        if (nloc == 0u) { xcd_barrier_complete(bar, b.x, nloc, nx); b.st[0] = nloc; b.st[1] = nx; }
        const unsigned old = xb_add(&bar[XB_XSUB(b.x)], 1u);
        const unsigned gen = old / nloc;
        if (old + 1u == (gen + 1u) * nloc) {
            __builtin_amdgcn_fence(__ATOMIC_RELEASE, "agent");
            asm volatile("s_waitcnt vmcnt(0)" ::: "memory");
            const unsigned og = xb_add(&bar[XB_TOP], 1u);
            const unsigned tg = og / nx;
            if (og + 1u == (tg + 1u) * nx) xb_add(&bar[XB_TOPGEN], 1u);
            else XB_SPIN(xb_ld(&bar[XB_TOPGEN]) == tg, bar);
            __builtin_amdgcn_fence(__ATOMIC_ACQUIRE, "agent");
            xb_add(&bar[XB_XGEN(b.x)], 1u);
            asm volatile("s_waitcnt vmcnt(0)" ::: "memory");
        } else {
            XB_SPIN(xb_ld(&bar[XB_XGEN(b.x)]) == gen, bar);
            __builtin_amdgcn_fence(__ATOMIC_ACQUIRE, "agent");
            asm volatile("s_waitcnt vmcnt(0)" ::: "memory");
        }
    }
    __syncthreads();
}

struct Frame {
    LAS unsigned char* lds;
    int tid, lane, wave, vcu, G;
};
struct Args {
    const float* in[21]; float* out; unsigned char* ws; int upto, pad1;
};

template <bool FP8 = false>
__device__ __forceinline__ void transpose_item(const float* W, int ldw, int k0, int n0, bf16_t* WT, int ldk, int drow0, LAS float* scr, int lane) {
    float tv[32];
    const float* wp_ = W + (size_t)(k0 + (lane >> 5)) * ldw + n0 + (lane & 31);
#pragma unroll
    for (int i = 0; i < 32; ++i) tv[i] = wp_[(size_t)(2 * i) * ldw];
#pragma unroll
    for (int i = 0; i < 32; ++i) scr[(2 * i + (lane >> 5)) * 33 + (lane & 31)] = tv[i];
    LDS_WAIT(); asm volatile("" ::: "memory");
    const int c = lane & 7;
#pragma unroll
    for (int j = 0; j < 4; ++j) { const int n = (lane >> 3) + 8 * j; const LAS float* s = scr + (8 * c) * 33 + n;
        if constexpr (FP8) { u32x2 o; o.x = cvt4_fp8(s[0 * 33] * W8_SCALE, s[1 * 33] * W8_SCALE, s[2 * 33] * W8_SCALE, s[3 * 33] * W8_SCALE); o.y = cvt4_fp8(s[4 * 33] * W8_SCALE, s[5 * 33] * W8_SCALE, s[6 * 33] * W8_SCALE, s[7 * 33] * W8_SCALE);
            *(u32x2*)((unsigned char*)WT + (size_t)(drow0 + n) * ldk + k0 + 8 * c) = o; }
        else { u32x4 o; o.x = cvt_pk_bf16(s[0 * 33], s[1 * 33]); o.y = cvt_pk_bf16(s[2 * 33], s[3 * 33]); o.z = cvt_pk_bf16(s[4 * 33], s[5 * 33]); o.w = cvt_pk_bf16(s[6 * 33], s[7 * 33]);
            *(u32x4*)(WT + (size_t)(drow0 + n) * ldk + k0 + 8 * c) = o; } }
    LDS_WAIT(); asm volatile("" ::: "memory");
}
template <bool FP8 = false>
__device__ __forceinline__ void conv_plain(Frame& F, const float* W, int K, int N, int ldw, bf16_t* WT, int rank = -1, int nrank = 0) {
    LAS float* scr = (LAS float*)(F.lds + F.wave * 16384);
    const int gw = (rank < 0 ? F.vcu : rank) * NWAVES + F.wave, NGW = (rank < 0 ? F.G : nrank) * NWAVES, nblk = N / 32, nit = (K / 64) * nblk;
    for (int it = gw; it < nit; it += NGW) { const int kb = it / nblk, nb = it % nblk; transpose_item<FP8>(W, ldw, 64 * kb, 32 * nb, WT, K, 32 * nb, scr, F.lane); }
}
__device__ __forceinline__ void conv_moe(Frame& F, const float* wg, const float* wu, const float* wd, bf16_t* GU, bf16_t* DT, int rank = -1, int nrank = 0) {
    LAS float* scr = (LAS float*)(F.lds + F.wave * 16384);
    const int gw = (rank < 0 ? F.vcu : rank) * NWAVES + F.wave, NGW = (rank < 0 ? F.G : nrank) * NWAVES;
    constexpr int PER_E = 1536, NIT = NEXP * PER_E;
    for (int it = gw; it < NIT; it += NGW) {
        const int e = it / PER_E; int r = it % PER_E;
        if (r < 1024) { const int up = r >> 9; r &= 511; const int kb = r >> 4, nb = r & 15, n0 = 32 * nb;
            const int drow = 256 * (n0 >> 7) + 128 * up + (n0 & 127);
            transpose_item<true>((up ? wu : wg) + (size_t)e * D * DFF, DFF, 64 * kb, n0, (bf16_t*)((unsigned char*)GU + (size_t)e * 1024 * D), D, drow, scr, F.lane); }
        else { r -= 1024; const int kb = r >> 6, nb = r & 63;
            transpose_item<true>(wd + (size_t)e * DFF * D, D, 64 * kb, 32 * nb, (bf16_t*)((unsigned char*)DT + (size_t)e * D * DFF), DFF, 32 * nb, scr, F.lane); }
    }
}
__device__ __forceinline__ void pack_proj(Frame& F, float* Wp, int NT, const float* gain, const float* Wa, int lda, int ca0, int na, const float* Wb, int ldb, int nb) {
    const int total = 128 * NT * 256;
    for (int idx = (F.vcu * NWAVES * 64) + F.tid; idx < total; idx += F.G * NWAVES * 64) {
        const int e = idx & 3, ln = (idx >> 2) & 63, rest = idx >> 8, nt = rest % NT, s = rest / NT;
        const int k = 16 * s + 4 * (ln >> 4) + e, col = 16 * nt + (ln & 15);
        float v = 0.f;
        if (col < na) v = Wa[(size_t)k * lda + ca0 + col]; else if (col < na + nb) v = Wb[(size_t)k * ldb + (col - na)];
        Wp[idx] = v * gain[k];
    }
}

template <int NT>
__device__ __forceinline__ float wave_proj16(LAS unsigned char* lds, const float* xin, int tok0, const float* Wp, int tid, int wid, int lane, f32x4 (&acc)[NT]) {
    const int tr = lane & 15, kq = lane >> 4;
    const f32x4* xp = (const f32x4*)(xin + (size_t)(tok0 + tr) * D) + kq;
    constexpr int CH = 16 * NT * 1024;
    const char* wsrc = (const char*)Wp + tid * 16;
    float ssq = 0.f;
#pragma unroll
    for (int n = 0; n < NT; ++n) acc[n] = (f32x4){0.f, 0.f, 0.f, 0.f};
    f32x4 X[16];
#define NP_DMA(c, buf) do { _Pragma("unroll") for (int r = 0; r < 2 * NT; ++r) \
        __builtin_amdgcn_global_load_lds((const unsigned*)(wsrc + (size_t)(c) * CH + r * 8192), (LAS unsigned*)(lds + (buf) * CH + r * 8192 + wid * 1024), 16, 0, 0); } while (0)
#define NP_CHUNK(c, buf, more) do { \
        asm volatile("s_waitcnt vmcnt(16)" ::: "memory"); WG_BAR(); \
        if (more) NP_DMA((c) + 1, 1 - (buf)); \
        asm volatile("" ::: "memory");     \
        const f32x4* xn_ = xp + 64 * ((c) + 1); \
        _Pragma("unroll") for (int s = 0; s < 16; ++s) { const f32x4 xv = X[s]; if (more) X[s] = xn_[4 * s]; \
            ssq += (xv[0] * xv[0] + xv[1] * xv[1]) + (xv[2] * xv[2] + xv[3] * xv[3]); \
            _Pragma("unroll") for (int n = 0; n < NT; ++n) { const f32x4 wv = *(const LAS f32x4*)(lds + (buf) * CH + ((s * NT + n) * 64 + lane) * 16); \
                _Pragma("unroll") for (int e = 0; e < 4; ++e) acc[n] = __builtin_amdgcn_mfma_f32_16x16x4f32(xv[e], wv[e], acc[n], 0, 0, 0); } } } while (0)
    NP_DMA(0, 0);
    asm volatile("" ::: "memory");
#pragma unroll
    for (int s = 0; s < 16; ++s) X[s] = xp[4 * s];
    for (int c = 0; c < 6; c += 2) { NP_CHUNK(c, 0, true); NP_CHUNK(c + 1, 1, true); }
    NP_CHUNK(6, 0, true); NP_CHUNK(7, 1, false);
    WG_BAR();
#undef NP_DMA
#undef NP_CHUNK
    ssq += __shfl_xor(ssq, 16); ssq += __shfl_xor(ssq, 32);
    return 1.0f / sqrtf(ssq * (1.0f / D) + RMS_EPS);
}
template <bool FP8 = false>
__device__ __forceinline__ void wave_write_hn16(const float* xin, int tok0, float rstd, const float* gain, bf16_t* hn, int lane) {
    f32x4 g4[8];
#pragma unroll
    for (int j = 0; j < 8; ++j) g4[j] = ((const f32x4*)gain)[lane + 64 * j];
    for (int i = 0; i < 16; i += 2) {
        const float r0 = __shfl(rstd, i), r1 = __shfl(rstd, i + 1);
        const f32x4* x0 = (const f32x4*)(xin + (size_t)(tok0 + i) * D); const f32x4* x1 = x0 + D / 4;
        u32x2* o0 = (u32x2*)(hn + (size_t)(tok0 + i) * D); u32x2* o1 = o0 + D / 4;
        unsigned* p0 = (unsigned*)((unsigned char*)hn + (size_t)(tok0 + i) * D); unsigned* p1 = p0 + D / 4;
        f32x4 a[8], c[8];
#pragma unroll
        for (int j = 0; j < 8; ++j) { a[j] = x0[lane + 64 * j]; c[j] = x1[lane + 64 * j]; }
#pragma unroll
        for (int j = 0; j < 8; ++j) { const f32x4 v = a[j] * r0 * g4[j], u = c[j] * r1 * g4[j];
            if constexpr (FP8) { p0[lane + 64 * j] = cvt4_fp8(v[0], v[1], v[2], v[3]); p1[lane + 64 * j] = cvt4_fp8(u[0], u[1], u[2], u[3]); }
            else { u32x2 w; w.x = cvt_pk_bf16(v[0], v[1]); w.y = cvt_pk_bf16(v[2], v[3]); o0[lane + 64 * j] = w;
                u32x2 z; z.x = cvt_pk_bf16(u[0], u[1]); z.y = cvt_pk_bf16(u[2], u[3]); o1[lane + 64 * j] = z; } }
    }
}

__device__ __forceinline__ void phase_norm_gz(Frame& F, const float* xin, const float* gain, const float* Wp, bf16_t* hn, float* gz) {
    for (int tile = F.vcu; tile < T / 128; tile += F.G) {
        const int tok0 = tile * 128 + F.wave * 16;
        f32x4 acc[1];
        const float rstd = wave_proj16<1>(F.lds, xin, tok0, Wp, F.tid, F.wave, F.lane, acc);
        const int j = F.lane & 15, q4 = F.lane >> 4;
#pragma unroll
        for (int r = 0; r < 4; ++r) { const float rr = __shfl(rstd, 4 * q4 + r); gz[(size_t)(tok0 + 4 * q4 + r) * 16 + j] = acc[0][r] * rr; }
        wave_write_hn16(xin, tok0, rstd, gain, hn, F.lane);
    }
}
__device__ __forceinline__ void phase_norm_route(Frame& F, const float* xin, const float* gain, const float* Wp, bf16_t* hn, int* tok_e, int* tok_p, float* tok_w, unsigned* cnt) {
    LAS float* lg = (LAS float*)(F.lds + 98304 + F.wave * 3072);
    for (int tile = F.vcu; tile < T / 128; tile += F.G) {
        const int tok0 = tile * 128 + F.wave * 16;
        f32x4 acc[3];
        const float rstd = wave_proj16<3>(F.lds, xin, tok0, Wp, F.tid, F.wave, F.lane, acc);
        const int j = F.lane & 15, q4 = F.lane >> 4;
#pragma unroll
        for (int r = 0; r < 4; ++r) { const float rr = __shfl(rstd, 4 * q4 + r);
#pragma unroll
            for (int n = 0; n < 3; ++n) lg[(4 * q4 + r) * 48 + 16 * n + j] = acc[n][r] * rr; }
        LDS_WAIT(); asm volatile("" ::: "memory");
        if (F.lane < 16) {
            const LAS float* l = lg + F.lane * 48;
            float gm = l[0]; int gi = 0;
#pragma unroll
            for (int q = 1; q < 4; ++q) { const float v = l[q]; if (v > gm) { gm = v; gi = q; } }
            float gs = 0.f;
#pragma unroll
            for (int q = 0; q < 4; ++q) gs += __expf(l[q] - gm);
            const float gw = 1.0f / gs;
            const LAS float* se = l + 4 + 8 * gi;
            float m1 = se[0]; int i1 = 0;
#pragma unroll
            for (int q = 1; q < 8; ++q) { const float v = se[q]; if (v > m1) { m1 = v; i1 = q; } }
            float m2 = -3.0e38f; int i2 = 0;
#pragma unroll
            for (int q = 0; q < 8; ++q) { const float v = se[q]; if (q != i1 && v > m2) { m2 = v; i2 = q; } }
            const float eb = __expf(m2 - m1), inv = 1.0f / (1.0f + eb);
            const int t = tok0 + F.lane, e1 = gi * 8 + i1, e2 = gi * 8 + i2;
            const unsigned p1 = __hip_atomic_fetch_add(cnt + 64 * e1, 1u, __ATOMIC_RELAXED, __HIP_MEMORY_SCOPE_AGENT);
            const unsigned p2 = __hip_atomic_fetch_add(cnt + 64 * e2, 1u, __ATOMIC_RELAXED, __HIP_MEMORY_SCOPE_AGENT);
            tok_e[2 * t] = e1; tok_e[2 * t + 1] = e2; tok_p[2 * t] = (int)p1; tok_p[2 * t + 1] = (int)p2;
            tok_w[2 * t] = gw * inv; tok_w[2 * t + 1] = gw * eb * inv;
        }
        wave_write_hn16<true>(xin, tok0, rstd, gain, hn, F.lane);
        LDS_WAIT(); asm volatile("" ::: "memory");
    }
}

__device__ __forceinline__ void phase_gla_gate(Frame& F, const float* gz, const float* wgu, const float* bgate, const bf16_t* proj, bf16_t* kdT, float* adec) {
    LAS f32x4* gzs = (LAS f32x4*)F.lds;
    for (int u = F.vcu; u < NBATCH * NCH * 2; u += F.G) {
        const int half = u & 1, bc = u >> 1;
        const int tok0 = bc * 64, j = half * 512 + F.tid;
        if (F.tid < 256) gzs[F.tid] = ((const f32x4*)(gz + (size_t)tok0 * 16))[F.tid];
        float wg[16];
#pragma unroll
        for (int r = 0; r < 16; ++r) wg[r] = wgu[r * GLA_DKT + j];
        const float bg = bgate[j];
        WG_BAR();
        float cum[64]; float run = 0.f;
#pragma unroll
        for (int t = 0; t < 64; ++t) {
            float z = bg;
#pragma unroll
            for (int r4 = 0; r4 < 4; ++r4) { const f32x4 g4 = gzs[t * 4 + r4]; z += g4[0] * wg[4 * r4] + g4[1] * wg[4 * r4 + 1] + g4[2] * wg[4 * r4 + 2] + g4[3] * wg[4 * r4 + 3]; }
            const float ls = fminf(z, 0.f) - __logf(1.0f + __expf(-fabsf(z)));
            run += ls * (1.0f / 16.0f); cum[t] = run;
        }
        adec[(size_t)bc * GLA_DKT + j] = __expf(run);
        const bf16_t* kp = proj + GK0 + gq_off(bc >> 8, (bc & 255) * 64, j >> 8) + (j & 255);
        u32x4* dst = (u32x4*)(kdT + ((size_t)bc * GLA_DKT + j) * 64);
#pragma unroll
        for (int t8 = 0; t8 < 8; ++t8) {
            float kd[8];
#pragma unroll
            for (int q = 0; q < 8; ++q) { const int t = t8 * 8 + q; kd[q] = bf2f(kp[(size_t)t * 256]) * __expf(run - cum[t]); }
            u32x4 w; w.x = cvt_pk_bf16(kd[0], kd[1]); w.y = cvt_pk_bf16(kd[2], kd[3]); w.z = cvt_pk_bf16(kd[4], kd[5]); w.w = cvt_pk_bf16(kd[6], kd[7]);
            dst[t8] = w;
        }
        WG_BAR();
    }
}

constexpr int SCAN_VROW = 144, SCAN_SROW = 528, SCAN_VBUF = 64 * SCAN_VROW, SCAN_SBUF = 64 * SCAN_SROW;
__device__ __forceinline__ void phase_gla_scan(Frame& F, int it, const bf16_t* proj, const bf16_t* kdT, const float* adec, bf16_t* oout, bf16_t* sfin, unsigned* probe = nullptr) {
    const int lane = F.lane, w = F.wave, fr = lane & 15, kq = lane >> 4, tid = F.tid;
    LAS unsigned char* vbuf = F.lds;
    LAS unsigned char* sbuf = F.lds + 2 * SCAN_VBUF;
    const int bh = it >> 4, seg = (it >> 3) & 1, b = bh >> 2, h = bh & 3, sl = it & 7, mt = w & 3, ntp = w >> 2, c0 = seg * (NCH / 2);
    const size_t tokb = (size_t)b * SEQ;
    f32x4 st[2][4];
#pragma unroll
    for (int i = 0; i < 2; ++i)
#pragma unroll
        for (int n = 0; n < 4; ++n) st[i][n] = (f32x4){0.f, 0.f, 0.f, 0.f};
    bf16x8 ka0[2][2], ka1[2][2], q0[8], q1[8]; f32x4 dc0[2], dc1[2]; u32x4 vr0, vr1;
#define CL(c) ((c) < NCH ? (c) : NCH - 1)
#define LOAD_KA(KA, DC, c) do { const size_t bc_ = (size_t)b * NCH + CL(c); \
        _Pragma("unroll") for (int i = 0; i < 2; ++i) { \
            _Pragma("unroll") for (int s = 0; s < 2; ++s) KA[i][s] = *(const bf16x8*)(kdT + ((bc_ * GLA_DKT + h * 256 + 32 * w + 16 * i + fr) * 64 + 32 * s + 8 * kq)); \
            DC[i] = *(const f32x4*)(adec + bc_ * GLA_DKT + h * 256 + 32 * w + 16 * i + 4 * kq); } } while (0)
#define LOAD_V(VR, c) do { VR = *(const u32x4*)(proj + gv_off(b, CL(c) * 64 + (tid >> 3), h) + 64 * sl + 8 * (tid & 7)); } while (0)
#define LOAD_Q(Q, c) do { const bf16_t* qp_ = proj + gq_off(b, CL(c) * 64 + 16 * mt + fr, h) + 8 * kq; \
        _Pragma("unroll") for (int s = 0; s < 8; ++s) Q[s] = *(const bf16x8*)(qp_ + 32 * s); } while (0)
#define STORE_V(VR, buf) do { *(LAS u32x4*)(vbuf + (buf) * SCAN_VBUF + (tid >> 3) * SCAN_VROW + (tid & 7) * 16) = VR; } while (0)
#if PROBE
    unsigned long long pacc[3] = {0ull, 0ull, 0ull}; unsigned long long pmark;
#define PMARK(k) do { const unsigned long long n_ = __builtin_amdgcn_s_memtime(); pacc[k] += n_ - pmark; pmark = n_; } while (0)
#define PSTART() do { pmark = __builtin_amdgcn_s_memtime(); } while (0)
#else
#define PMARK(k) do { } while (0)
#define PSTART() do { } while (0)
#endif
#define SCAN_STEP(KA, DC, VN, VM, QC, QN, c) do { \
        PSTART(); \
        const unsigned vb_ = (unsigned)(uintptr_t)(vbuf + ((c) & 1) * SCAN_VBUF) + (unsigned)((8 * kq + ((lane & 15) >> 2)) * SCAN_VROW + 8 * (lane & 3)); \
        s16x4 tv[4][4];     \
        asm volatile("ds_read_b64_tr_b16 %0, %16 offset:0\n\tds_read_b64_tr_b16 %1, %16 offset:576\n\tds_read_b64_tr_b16 %2, %16 offset:4608\n\tds_read_b64_tr_b16 %3, %16 offset:5184\n\t" \
                     "ds_read_b64_tr_b16 %4, %16 offset:32\n\tds_read_b64_tr_b16 %5, %16 offset:608\n\tds_read_b64_tr_b16 %6, %16 offset:4640\n\tds_read_b64_tr_b16 %7, %16 offset:5216\n\t" \
                     "ds_read_b64_tr_b16 %8, %16 offset:64\n\tds_read_b64_tr_b16 %9, %16 offset:640\n\tds_read_b64_tr_b16 %10, %16 offset:4672\n\tds_read_b64_tr_b16 %11, %16 offset:5248\n\t" \
                     "ds_read_b64_tr_b16 %12, %16 offset:96\n\tds_read_b64_tr_b16 %13, %16 offset:672\n\tds_read_b64_tr_b16 %14, %16 offset:4704\n\tds_read_b64_tr_b16 %15, %16 offset:5280\n\ts_waitcnt lgkmcnt(0)" \
                     : "=&v"(tv[0][0]), "=&v"(tv[0][1]), "=&v"(tv[0][2]), "=&v"(tv[0][3]), "=&v"(tv[1][0]), "=&v"(tv[1][1]), "=&v"(tv[1][2]), "=&v"(tv[1][3]), \
                       "=&v"(tv[2][0]), "=&v"(tv[2][1]), "=&v"(tv[2][2]), "=&v"(tv[2][3]), "=&v"(tv[3][0]), "=&v"(tv[3][1]), "=&v"(tv[3][2]), "=&v"(tv[3][3]) : "v"(vb_) : "memory"); \
        _Pragma("unroll") for (int n = 0; n < 4; ++n) { \
            const bf16x8 vf0 = (bf16x8){tv[n][0][0], tv[n][0][1], tv[n][0][2], tv[n][0][3], tv[n][1][0], tv[n][1][1], tv[n][1][2], tv[n][1][3]}; \
            const bf16x8 vf1 = (bf16x8){tv[n][2][0], tv[n][2][1], tv[n][2][2], tv[n][2][3], tv[n][3][0], tv[n][3][1], tv[n][3][2], tv[n][3][3]}; \
            _Pragma("unroll") for (int i = 0; i < 2; ++i) { \
                st[i][n] = st[i][n] * DC[i]; \
                st[i][n] = __builtin_amdgcn_mfma_f32_16x16x32_bf16(KA[i][0], vf0, st[i][n], 0, 0, 0); \
                st[i][n] = __builtin_amdgcn_mfma_f32_16x16x32_bf16(KA[i][1], vf1, st[i][n], 0, 0, 0); } } \
        LOAD_KA(KA, DC, (c) + 2); \
        PMARK(0); \
        { LAS unsigned char* sb_ = sbuf + ((c) & 1) * SCAN_SBUF + fr * SCAN_SROW + (32 * w + 4 * kq) * 2; \
          _Pragma("unroll") for (int i = 0; i < 2; ++i) _Pragma("unroll") for (int n = 0; n < 4; ++n) { \
              u32x2 pk; pk.x = cvt_pk_bf16(st[i][n][0], st[i][n][1]); pk.y = cvt_pk_bf16(st[i][n][2], st[i][n][3]); \
              *(LAS u32x2*)(sb_ + n * 16 * SCAN_SROW + i * 32) = pk; } } \
        STORE_V(VN, ((c) + 1) & 1); \
        LOAD_V(VN, (c) + 3); \
        WG_BAR(); \
        PMARK(1); \
        { f32x4 a0 = (f32x4){0.f, 0.f, 0.f, 0.f}, a1 = a0; \
          const LAS unsigned char* sr_ = sbuf + ((c) & 1) * SCAN_SBUF + (32 * ntp + fr) * SCAN_SROW + 16 * kq; \
          _Pragma("unroll") for (int hb = 0; hb < 2; ++hb) { bf16x8 bb[4][2];     \
              _Pragma("unroll") for (int s = 0; s < 4; ++s) { bb[s][0] = *(const LAS bf16x8*)(sr_ + 64 * (4 * hb + s)); bb[s][1] = *(const LAS bf16x8*)(sr_ + 16 * SCAN_SROW + 64 * (4 * hb + s)); } \
              asm volatile("s_waitcnt lgkmcnt(0)" ::: "memory"); __builtin_amdgcn_sched_barrier(0); \
              _Pragma("unroll") for (int s = 0; s < 4; ++s) { \
                  a0 = __builtin_amdgcn_mfma_f32_16x16x32_bf16(QC[4 * hb + s], bb[s][0], a0, 0, 0, 0); \
                  a1 = __builtin_amdgcn_mfma_f32_16x16x32_bf16(QC[4 * hb + s], bb[s][1], a1, 0, 0, 0); } } \
          bf16_t* op_ = oout + (tokb + (size_t)(c) * 64 + 16 * mt + 4 * kq) * D + h * 512 + 64 * sl + 32 * ntp + fr; \
          _Pragma("unroll") for (int r = 0; r < 4; ++r) { \
              const float x0 = a0[r] * 0.0625f, x1 = a1[r] * 0.0625f, y0 = __shfl_xor(x0, 1), y1 = __shfl_xor(x1, 1); \
              if ((fr & 1) == 0) { *(unsigned*)(op_ + (size_t)r * D) = cvt_pk_bf16(x0, y0); *(unsigned*)(op_ + (size_t)r * D + 16) = cvt_pk_bf16(x1, y1); } } } \
        LOAD_Q(QC, (c) + 2); \
        PMARK(2); \
    } while (0)
    LOAD_KA(ka0, dc0, c0); LOAD_KA(ka1, dc1, c0 + 1); LOAD_V(vr0, c0); LOAD_V(vr1, c0 + 1); LOAD_Q(q0, c0); LOAD_Q(q1, c0 + 1);
    STORE_V(vr0, 0); LOAD_V(vr0, c0 + 2);
    WG_BAR();
#if PROBE
    const unsigned long long pt0 = __builtin_amdgcn_s_memtime(), pr0 = __builtin_amdgcn_s_memrealtime();
#endif
    for (int c = c0; c < c0 + NCH / 2; c += 2) {
        SCAN_STEP(ka0, dc0, vr1, vr0, q0, q1, c);
        SCAN_STEP(ka1, dc1, vr0, vr1, q1, q0, c + 1);
    }
    if (seg == 0) {
#pragma unroll
        for (int i = 0; i < 2; ++i)
#pragma unroll
            for (int n = 0; n < 4; ++n) { u32x2 pk; pk.x = cvt_pk_bf16(st[i][n][0], st[i][n][1]); pk.y = cvt_pk_bf16(st[i][n][2], st[i][n][3]);
                *(u32x2*)(sfin + ((size_t)(bh * 512 + 64 * sl + 16 * n + fr)) * 256 + 32 * w + 16 * i + 4 * kq) = pk; }
    }
    WG_BAR();
#if PROBE
    if (probe && it == 0 && tid == 0) { const unsigned long long dt = __builtin_amdgcn_s_memtime() - pt0, dr = __builtin_amdgcn_s_memrealtime() - pr0;
        const float val = floorf(2.f * log2f((PROBE == 1) ? (float)dt / 256.f : (PROBE == 2) ? (float)dr * 10.f / 256.f : (float)pacc[PROBE - 3] / 256.f));
        __hip_atomic_store(probe, __float_as_uint(val), __ATOMIC_RELAXED, __HIP_MEMORY_SCOPE_AGENT); }
#endif
#undef CL
#undef LOAD_KA
#undef LOAD_V
#undef LOAD_Q
#undef STORE_V
#undef SCAN_STEP
}

__device__ __forceinline__ void gla_pcum(Frame& F, const float* adec, float* pcum, int rank, int nrank) {
    for (int idx = rank * (NWAVES * 64) + F.tid; idx < NBATCH * GLA_DKT; idx += nrank * NWAVES * 64) { const int b = idx >> 10, j = idx & 1023;
        const float* ap = adec + ((size_t)(b * NCH + NCH / 2)) * GLA_DKT + j; float* pp = pcum + (size_t)(b * (NCH / 2)) * GLA_DKT + j; float pr = 1.f;
#pragma unroll 16
        for (int cc = 0; cc < NCH / 2; ++cc) { pr *= ap[(size_t)cc * GLA_DKT]; pp[(size_t)cc * GLA_DKT] = pr; } }
}
__device__ __forceinline__ void phase_gla_qp(Frame& F, const bf16_t* proj, const float* pcum, bf16_t* qp) {
    const int gw = F.vcu * NWAVES + F.wave, NGW = F.G * NWAVES, lane = F.lane;
    for (int r = gw; r < NBATCH * (SEQ / 2); r += NGW) { const int b = r >> 13, t = r & 8191;
        u32x2 qv[4]; f32x4 pv[4];
#pragma unroll
        for (int h = 0; h < 4; ++h) { qv[h] = *(const u32x2*)(proj + gq_off(b, SEQ / 2 + t, h) + 4 * lane); pv[h] = *(const f32x4*)(pcum + ((size_t)(b * (NCH / 2) + (t >> 6)) * GLA_DKT + h * 256 + 4 * lane)); }
#pragma unroll
        for (int h = 0; h < 4; ++h) { u32x2 w; w.x = cvt_pk_bf16(bf_lo(qv[h].x) * pv[h][0], bf_hi(qv[h].x) * pv[h][1]); w.y = cvt_pk_bf16(bf_lo(qv[h].y) * pv[h][2], bf_hi(qv[h].y) * pv[h][3]);
            *(u32x2*)(qp + ((size_t)((b * 4 + h) * (SEQ / 2) + t)) * 256 + 4 * lane) = w; }
    }
}
__device__ __forceinline__ void phase_gla_gnorm(Frame& F, const bf16_t* o, const bf16_t* proj, const float* gn, bf16_t* y) {
    const int gw = F.vcu * NWAVES + F.wave, NGW = F.G * NWAVES, lane = F.lane;
    const f32x4 g0 = ((const f32x4*)gn)[2 * lane], g1 = ((const f32x4*)gn)[2 * lane + 1];
    for (int tok = gw; tok < T; tok += NGW) {
        u32x4 ov[4], rv[4];
#pragma unroll
        for (int h = 0; h < 4; ++h) { ov[h] = *(const u32x4*)(o + (size_t)tok * D + h * 512 + 8 * lane); rv[h] = *(const u32x4*)(proj + GR0 + (size_t)tok * 2048 + h * 512 + 8 * lane); }
        float ss[4];
#pragma unroll
        for (int h = 0; h < 4; ++h) { float s = 0.f;
#pragma unroll
            for (int q = 0; q < 4; ++q) { const float lo = bf_lo(ov[h][q]), hi = bf_hi(ov[h][q]); s += lo * lo + hi * hi; }
            ss[h] = s; }
#pragma unroll
        for (int of = 1; of < 64; of <<= 1) {
#pragma unroll
            for (int h = 0; h < 4; ++h) ss[h] += __shfl_xor(ss[h], of); }
#pragma unroll
        for (int h = 0; h < 4; ++h) { const float rstd = 1.0f / sqrtf(ss[h] * (1.0f / 512.0f) + RMS_EPS);
            float yv[8];
#pragma unroll
            for (int q = 0; q < 4; ++q) { const float a0 = bf_lo(ov[h][q]), a1 = bf_hi(ov[h][q]), r0 = bf_lo(rv[h][q]), r1 = bf_hi(rv[h][q]);
                const float gA = q < 2 ? g0[2 * q] : g1[2 * q - 4], gB = q < 2 ? g0[2 * q + 1] : g1[2 * q - 3];
                yv[2 * q] = a0 * rstd * gA * (r0 / (1.0f + __expf(-r0))); yv[2 * q + 1] = a1 * rstd * gB * (r1 / (1.0f + __expf(-r1))); }
            u32x4 w; w.x = cvt_pk_bf16(yv[0], yv[1]); w.y = cvt_pk_bf16(yv[2], yv[3]); w.z = cvt_pk_bf16(yv[4], yv[5]); w.w = cvt_pk_bf16(yv[6], yv[7]);
            *(u32x4*)(y + (size_t)tok * D + h * 512 + 8 * lane) = w; }
    }
}

__device__ __forceinline__ void moe_tables(Frame& F, unsigned* cnt) {
    LAS int* pst = (LAS int*)(F.lds + TAB_OFF);
    LAS int* te = pst + 36;
    if (F.wave == 0) {
        const int e = F.lane & 31;
        const int c = (int)xb_ld(cnt + 64 * e);
        const int ntile = (c + 255) >> 8;
        int incl = ntile;
#pragma unroll
        for (int o = 1; o < 32; o <<= 1) { const int v = __shfl_up(incl, o); if ((F.lane & 31) >= o) incl += v; }
        const int excl = incl - ntile;
        if (F.lane < 32) { pst[e] = excl << 8; for (int q = 0; q < ntile; ++q) te[excl + q] = e; }
        if (F.lane == 31) { pst[32] = incl << 8; pst[33] = incl; }
    }
    WG_BAR();
}
__device__ __forceinline__ void phase_moe_slots(Frame& F, const int* tok_e, const int* tok_p, unsigned* cnt, int* slot_of, int* slot_tok) {
    const LAS int* pst = (const LAS int*)(F.lds + TAB_OFF);
    for (int e = F.vcu; e < NEXP; e += F.G) { const int c = (int)xb_ld(cnt + 64 * e), lo = pst[e] + c, hi = pst[e] + (((c + 255) >> 8) << 8);
        for (int s = lo + F.tid; s < hi; s += NWAVES * 64) slot_tok[s] = -1; }
    for (int a = F.vcu * NWAVES * 64 + F.tid; a < 2 * T; a += F.G * NWAVES * 64) { const int slot = pst[tok_e[a]] + tok_p[a]; slot_of[a] = slot; slot_tok[slot] = a >> 1; }
}
__device__ __forceinline__ void phase_moe_copy8(Frame& F, const int* tok_e, const int* tok_p, const unsigned char* hn8, unsigned char* ag8) {
    const LAS int* pst = (const LAS int*)(F.lds + TAB_OFF);
    const int gw = F.vcu * NWAVES + F.wave, NGW = F.G * NWAVES, lane = F.lane;
    for (int t = gw; t < T; t += NGW) {
        const int s0 = pst[tok_e[2 * t]] + tok_p[2 * t], s1 = pst[tok_e[2 * t + 1]] + tok_p[2 * t + 1];
        const u32x4* src = (const u32x4*)(hn8 + (size_t)t * D); const u32x4 v0 = src[lane], v1 = src[lane + 64];
        u32x4* d0 = (u32x4*)(ag8 + (size_t)s0 * D); u32x4* d1 = (u32x4*)(ag8 + (size_t)s1 * D);
        d0[lane] = v0; d0[lane + 64] = v1; d1[lane] = v0; d1[lane + 64] = v1;
    }
}
template <int MODE>
__device__ __forceinline__ void phase_moe_combine(Frame& F, float* x, const bf16_t* ob, const int* slot_of, const float* tok_w, const float* gain, bf16_t* hn) {
    const int gw = F.vcu * NWAVES + F.wave, NGW = F.G * NWAVES, lane = F.lane;
    f32x4 g4[8];
#pragma unroll
    for (int j = 0; j < 8; ++j) g4[j] = ((const f32x4*)gain)[lane + 64 * j];
    for (int t = gw; t < T; t += NGW) {
        const int s0 = slot_of[2 * t], s1 = slot_of[2 * t + 1]; const float w0 = tok_w[2 * t], w1 = tok_w[2 * t + 1];
        f32x4* xr = (f32x4*)(x + (size_t)t * D);
        const u32x2* a = (const u32x2*)(ob + (size_t)s0 * D); const u32x2* b = (const u32x2*)(ob + (size_t)s1 * D);
        f32x4 v[8]; float ss = 0.f;
#pragma unroll
        for (int j = 0; j < 8; ++j) { const u32x2 av = a[lane + 64 * j], bv = b[lane + 64 * j]; f32x4 xv = xr[lane + 64 * j];
            xv[0] += w0 * bf_lo(av.x) + w1 * bf_lo(bv.x); xv[1] += w0 * bf_hi(av.x) + w1 * bf_hi(bv.x);
            xv[2] += w0 * bf_lo(av.y) + w1 * bf_lo(bv.y); xv[3] += w0 * bf_hi(av.y) + w1 * bf_hi(bv.y);
            v[j] = xv; ss += (xv[0] * xv[0] + xv[1] * xv[1]) + (xv[2] * xv[2] + xv[3] * xv[3]); }
        const float rstd = 1.0f / sqrtf(wave_sum(ss) * (1.0f / D) + RMS_EPS);
        if (MODE == 0) {
            unsigned* orow = (unsigned*)((unsigned char*)hn + (size_t)t * D);
#pragma unroll
            for (int j = 0; j < 8; ++j) { xr[lane + 64 * j] = v[j]; const f32x4 y = v[j] * rstd * g4[j]; orow[lane + 64 * j] = cvt4_fp8(y[0], y[1], y[2], y[3]); }
        } else {
#pragma unroll
            for (int j = 0; j < 8; ++j) xr[lane + 64 * j] = v[j] * rstd * g4[j];
        }
    }
}

__device__ __forceinline__ void phase_subln(Frame& F, const bf16_t* o1, const bf16_t* o2, const float* lq1, const float* lk1, const float* lq2, const float* lk2, const float* sg, bf16_t* y) {
    const int gw = F.vcu * NWAVES + F.wave, NGW = F.G * NWAVES, lane = F.lane;
    const float d1 = wave_sum(lq1[lane] * lk1[lane] + lq1[lane + 64] * lk1[lane + 64]);
    const float d2 = wave_sum(lq2[lane] * lk2[lane] + lq2[lane + 64] * lk2[lane + 64]);
    const float lam = __expf(d1) - __expf(d2) + LAMBDA_INIT;
    const f32x4 g = ((const f32x4*)sg)[lane] * (1.0f - LAMBDA_INIT);
    for (int tok = gw; tok < T; tok += NGW) {
        u32x2 a[8], b[8];
#pragma unroll
        for (int h = 0; h < 8; ++h) { a[h] = *(const u32x2*)(o1 + (size_t)tok * D + h * 256 + 4 * lane); b[h] = *(const u32x2*)(o2 + (size_t)tok * D + h * 256 + 4 * lane); }
        f32x4 d[8]; float ss[8];
#pragma unroll
        for (int h = 0; h < 8; ++h) { d[h][0] = bf_lo(a[h].x) - lam * bf_lo(b[h].x); d[h][1] = bf_hi(a[h].x) - lam * bf_hi(b[h].x); d[h][2] = bf_lo(a[h].y) - lam * bf_lo(b[h].y); d[h][3] = bf_hi(a[h].y) - lam * bf_hi(b[h].y);
            ss[h] = (d[h][0] * d[h][0] + d[h][1] * d[h][1]) + (d[h][2] * d[h][2] + d[h][3] * d[h][3]); }
#pragma unroll
        for (int of = 1; of < 64; of <<= 1) {
#pragma unroll
            for (int h = 0; h < 8; ++h) ss[h] += __shfl_xor(ss[h], of); }
#pragma unroll
        for (int h = 0; h < 8; ++h) { const float rstd = 1.0f / sqrtf(ss[h] * (1.0f / 256.0f) + RMS_EPS); const f32x4 yv = d[h] * rstd * g;
            *(unsigned*)((unsigned char*)y + (size_t)tok * D + h * 256 + 4 * lane) = cvt4_fp8(yv[0], yv[1], yv[2], yv[3]); }
    }
}

namespace att {
constexpr int SHM_K = 64 * 128 * 2, SHM_V = 64 * 256 * 2;
constexpr int V_OFF = 0, K_OFF = 3 * SHM_V, SCR_OFF = RING_BYTES + 4096;
constexpr float SCALE = 0.08838834764831845f;
constexpr float C2 = 1.4426950408889634f * SCALE;
constexpr float THR = 8.f;
#define KSWZ(row, colB) ((row) * 256 + ((colB) ^ (((row) & 7) << 4)))
__device__ __forceinline__ int crow(int r, int hi) { return (r & 3) + 8 * (r >> 2) + 4 * hi; }
__device__ __forceinline__ int v_rd_base(int lane) { return ((lane & 3) << 3) | (((lane >> 2) & 3) << 6) | (((lane >> 4) & 1) << 5) | (((lane >> 5) & 1) << 8); }
constexpr int v_rd_off(int d0, int ks, int half) { return d0 * 512 + ks * 8192 + half * 4096; }

__device__ __forceinline__ void qkt(f32x16& p0, f32x16& p1, const LAS unsigned char* kslot, int r32, int hi, const bf16x8 (&qr)[8]) {
    const LAS unsigned char* kb[4];
#pragma unroll
    for (int dd = 0; dd < 4; ++dd) kb[dd] = kslot + KSWZ(r32, (dd * 16 + hi * 8) * 2);
#pragma unroll
    for (int d0 = 0; d0 < 8; ++d0) { const LAS unsigned char* a = kb[d0 & 3] + (d0 >> 2) * 128;
        const bf16x8 b0 = *(const LAS bf16x8*)a;
        const bf16x8 b1 = *(const LAS bf16x8*)(a + 32 * 256);
        p0 = __builtin_amdgcn_mfma_f32_32x32x16_bf16(b0, qr[d0], p0, 0, 0, 0);
        p1 = __builtin_amdgcn_mfma_f32_32x32x16_bf16(b1, qr[d0], p1, 0, 0, 0); }
}
__device__ __forceinline__ void pv_tile(f32x16 (&o)[8], unsigned vb, const bf16x8 (&pa)[4]) {
#define TRRD(dst, off) asm volatile("ds_read_b64_tr_b16 %0, %1 offset:%2" : "=&v"(dst) : "v"(vb), "i"(off) : "memory")
#define PV_RD(S, hb) do { constexpr int b_ = v_rd_off((hb) >> 1, 2 * ((hb) & 1), 0); TRRD(S[0], b_); TRRD(S[1], b_ + 4096); TRRD(S[2], b_ + 8192); TRRD(S[3], b_ + 12288); } while (0)
#define PV_MM(S, hb) do { \
        o[(hb) >> 1] = __builtin_amdgcn_mfma_f32_32x32x16_bf16(pa[2 * ((hb) & 1)], (bf16x8){S[0][0], S[0][1], S[0][2], S[0][3], S[1][0], S[1][1], S[1][2], S[1][3]}, o[(hb) >> 1], 0, 0, 0); \
        o[(hb) >> 1] = __builtin_amdgcn_mfma_f32_32x32x16_bf16(pa[2 * ((hb) & 1) + 1], (bf16x8){S[2][0], S[2][1], S[2][2], S[2][3], S[3][0], S[3][1], S[3][2], S[3][3]}, o[(hb) >> 1], 0, 0, 0); } while (0)
#define PV_STEP(SC, SN2, hb) do { PV_RD(SN2, (hb) + 2); asm volatile("s_waitcnt lgkmcnt(8)" ::: "memory"); __builtin_amdgcn_sched_barrier(0); PV_MM(SC, hb); } while (0)
    s16x4 f0[4], f1[4], f2[4];
    PV_RD(f0, 0); PV_RD(f1, 1);
    PV_STEP(f0, f2, 0); PV_STEP(f1, f0, 1); PV_STEP(f2, f1, 2); PV_STEP(f0, f2, 3); PV_STEP(f1, f0, 4); PV_STEP(f2, f1, 5); PV_STEP(f0, f2, 6); PV_STEP(f1, f0, 7);
    PV_STEP(f2, f1, 8); PV_STEP(f0, f2, 9); PV_STEP(f1, f0, 10); PV_STEP(f2, f1, 11); PV_STEP(f0, f2, 12); PV_STEP(f1, f0, 13);
    asm volatile("s_waitcnt lgkmcnt(4)" ::: "memory"); __builtin_amdgcn_sched_barrier(0); PV_MM(f2, 14);
    asm volatile("s_waitcnt lgkmcnt(0)" ::: "memory"); __builtin_amdgcn_sched_barrier(0); PV_MM(f0, 15);
#undef PV_STEP
#undef PV_MM
#undef PV_RD
#undef TRRD
}

__device__ __forceinline__ void stage_offsets(int tid, unsigned (&koff)[2], unsigned (&voff)[4]) {
#pragma unroll
    for (int i = 0; i < 2; ++i) { const int P = tid * 16 + i * 8192, row = P >> 8, ch = ((P & 255) >> 4) ^ (row & 7); koff[i] = (unsigned)(row * 128 + ch * 8) * 2u; }
#pragma unroll
    for (int i = 0; i < 4; ++i) { const int P = tid * 16 + i * 8192, st = P >> 9, kk = ((st >> 3) << 3) | ((P & 511) >> 6), cg = st & 7, cin = (P & 63) >> 1;
        const int key = (kk & ~0xC) | ((kk & 4) << 1) | ((kk & 8) >> 1); voff[i] = (unsigned)(key * 256 + cg * 32 + cin) * 2u; }
}
__device__ __forceinline__ const char* uniform_ptr(const void* p) {
    const unsigned long long v = (unsigned long long)p;
    const unsigned lo = __builtin_amdgcn_readfirstlane((unsigned)v), hi = __builtin_amdgcn_readfirstlane((unsigned)(v >> 32));
    return (const char*)(((unsigned long long)hi << 32) | lo);
}
__device__ __forceinline__ void stage_tile(LAS unsigned char* lds, int kslot, int vslot, const bf16_t* kj_, const bf16_t* vj_, int tid_, int wid) {
    const char* kj = uniform_ptr(kj_); const char* vj = uniform_ptr(vj_);
    int tid = tid_; asm volatile("" : "+v"(tid));
    unsigned koff[2], voff[4]; stage_offsets(tid, koff, voff);
    LAS unsigned char* kd = lds + K_OFF + kslot * SHM_K + wid * 1024; LAS unsigned char* vd = lds + V_OFF + vslot * SHM_V + wid * 1024;
#pragma unroll
    for (int i = 0; i < 2; ++i) __builtin_amdgcn_global_load_lds((const unsigned*)(kj + koff[i]), (LAS unsigned*)(kd + i * 8192), 16, 0, 0);
#pragma unroll
    for (int i = 0; i < 4; ++i) __builtin_amdgcn_global_load_lds((const unsigned*)(vj + voff[i]), (LAS unsigned*)(vd + i * 8192), 16, 0, 0);
}

__device__ __forceinline__ void qk_softmax(const LAS unsigned char* kslot, int r32, int hi, LAS float* al_l, const bf16x8 (&qr)[8], f32x16 (&o)[8], bf16x8 (&pa)[4],
                                           float& m_reg, float& l_reg, float rawu, float sl2, bool diag, int qi) {
    f32x16 p0, p1;
#pragma unroll
    for (int r = 0; r < 16; ++r) { p0[r] = 0.f; p1[r] = 0.f; }
    qkt(p0, p1, kslot, r32, hi, qr);
#pragma unroll
    for (int r = 0; r < 16; ++r) { const float cr = (float)((r & 3) + 8 * (r >> 2)); p0[r] = fmaf(cr, rawu, p0[r]); p1[r] = fmaf(cr, rawu, p1[r]); }
    if (diag) {
        const float k2raw = 2.f * rawu;
        int qi_ = qi - 4 * hi; asm volatile("" : "+v"(qi_));
#pragma unroll
        for (int r = 0; r < 16; ++r) { const int c = (r & 3) + 8 * (r >> 2); const int d0_ = c - qi_, d1_ = c + 32 - qi_;
            p0[r] -= k2raw * (float)(d0_ > 0 ? d0_ : 0); p1[r] -= k2raw * (float)(d1_ > 0 ? d1_ : 0); }
    }
    const float lane_raw = rawu * (float)(4 * hi), d32raw = 32.f * rawu;
    float pm0 = p0[0], pm1 = p1[0];
#pragma unroll
    for (int r = 1; r < 16; ++r) { pm0 = fmaxf(pm0, p0[r]); pm1 = fmaxf(pm1, p1[r]); }
    float pmax = fmaxf(pm0, pm1 + d32raw) + lane_raw;
    { auto rr = __builtin_amdgcn_permlane32_swap(__float_as_uint(pmax), __float_as_uint(pmax), false, false);
      pmax = fmaxf(__uint_as_float(rr[0]), __uint_as_float(rr[1])); }
    float mn, alpha;
    if (__all((pmax - m_reg) * SCALE <= THR)) { mn = m_reg; alpha = 1.f; }
    else { mn = fmaxf(m_reg, pmax); alpha = __builtin_amdgcn_exp2f((m_reg - mn) * C2); m_reg = mn; }
    const float mnL0 = (lane_raw - mn) * C2, mnL1 = mnL0 + 32.f * sl2;
#pragma unroll
    for (int r = 0; r < 16; ++r) { p0[r] = __builtin_amdgcn_exp2f(fmaf(p0[r], C2, mnL0)); p1[r] = __builtin_amdgcn_exp2f(fmaf(p1[r], C2, mnL1)); }
    if (__any(alpha < 1.f)) {
        if (hi == 0) al_l[r32] = alpha;
        LDS_WAIT();
#pragma unroll
        for (int r = 0; r < 16; ++r) { const float a = al_l[crow(r, hi)];
#pragma unroll
            for (int d = 0; d < 8; ++d) o[d][r] *= a; }
    }
    float ps = 0.f;
#pragma unroll
    for (int r = 0; r < 16; ++r) ps += p0[r] + p1[r];
    { auto rr = __builtin_amdgcn_permlane32_swap(__float_as_uint(ps), __float_as_uint(ps), false, false);
      ps = __uint_as_float(rr[0]) + __uint_as_float(rr[1]); }
    l_reg = l_reg * alpha + ps;
#define PK4(P, B_, OUT) do { unsigned a0 = cvt_pk_bf16(P[B_+0], P[B_+1]), a1 = cvt_pk_bf16(P[B_+2], P[B_+3]); \
        unsigned b0 = cvt_pk_bf16(P[B_+4], P[B_+5]), b1 = cvt_pk_bf16(P[B_+6], P[B_+7]); \
        auto r0 = __builtin_amdgcn_permlane32_swap(a0, b0, false, false); auto r1 = __builtin_amdgcn_permlane32_swap(a1, b1, false, false); \
        u32x4 w = {r0[0], r1[0], r0[1], r1[1]}; OUT = __builtin_bit_cast(bf16x8, w); } while (0)
    PK4(p0, 0, pa[0]); PK4(p0, 8, pa[1]); PK4(p1, 0, pa[2]); PK4(p1, 8, pa[3]);
#undef PK4
}

__device__ __forceinline__ void norms_phase(Frame& F, const bf16_t* proj, float* nrm) {
    const int gw = F.vcu * NWAVES + F.wave, NGW = F.G * NWAVES, lane = F.lane;
    for (int idx = gw; idx < 2 * 32 * 256; idx += NGW) {
        const int tensor = idx >> 13, stream = (idx >> 8) & 31, grp = idx & 255;
        const u32x4* rp = (const u32x4*)(proj + (tensor ? DK0 : 0) + ((size_t)stream * SEQ + grp * 64 + lane) * 128);
        float ss = 0.f;
#pragma unroll
        for (int q = 0; q < 16; ++q) { const u32x4 v = rp[q];
#pragma unroll
            for (int e = 0; e < 4; ++e) { const float lo = bf_lo(v[e]), hi = bf_hi(v[e]); ss += lo * lo + hi * hi; } }
        float n = sqrtf(ss) * 1.001f;
#pragma unroll
        for (int o = 1; o < 64; o <<= 1) n = fmaxf(n, __shfl_xor(n, o));
        if (lane == 0) nrm[idx] = n;
    }
}

__device__ __forceinline__ void attn_item(LAS unsigned char* lds, const bf16_t* proj, const float* nrm, bf16_t* oout, int b, int h, int sub, int qb, int tid, int wid, int lane) {
    const int r32 = lane & 31, hi = lane >> 5;
    const float slope = __builtin_amdgcn_exp2f(-(float)(h + 1));
    const float sl2 = slope * 1.4426950408889634f, rawu = sl2 / C2;
    LAS float* ws = (LAS float*)(lds + SCR_OFF) + wid * 64; LAS float* li_l = ws; LAS float* al_l = ws + 32;
    const size_t tokq = (size_t)b * SEQ + (size_t)qb * 256 + wid * 32;
    const bf16_t* kbase = proj + DK0 + dq_off(b, 0, h, sub);
    const bf16_t* vbase = proj + dv_off(b, 0, h);
    int j_lo;
    { const int stream = (b * 8 + h) * 2 + sub; const float* qn = nrm + stream * 256; const float* kn = nrm + 8192 + stream * 256;
      const float Qn = fmaxf(fmaxf(qn[4 * qb], qn[4 * qb + 1]), fmaxf(qn[4 * qb + 2], qn[4 * qb + 3]));
      const float Kd = fmaxf(fmaxf(kn[4 * qb], kn[4 * qb + 1]), fmaxf(kn[4 * qb + 2], kn[4 * qb + 3]));
      int cand = 4 * qb;
      for (int jj = lane; jj < 4 * qb; jj += 64) { const float dmin = (float)(256 * qb - (64 * jj + 63)); const bool skip = slope * dmin > 110.f + SCALE * Qn * (kn[jj] + Kd); if (!skip) cand = cand < jj ? cand : jj; }
#pragma unroll
      for (int o = 1; o < 64; o <<= 1) { const int v = __shfl_xor(cand, o); cand = v < cand ? v : cand; }
      j_lo = __builtin_amdgcn_readfirstlane(cand); }
    bf16x8 qr[8];
#pragma unroll
    for (int d0 = 0; d0 < 8; ++d0) qr[d0] = *(const bf16x8*)(proj + dq_off(b, qb * 256 + wid * 32 + r32, h, sub) + d0 * 16 + hi * 8);
    const float sh64 = 64.f * rawu;
    const int qi = 32 * (wid & 1) + r32;
    const unsigned vb0 = (unsigned)(uintptr_t)(lds + V_OFF) + (unsigned)v_rd_base(lane);
    float m_reg = -1e30f, l_reg = 0.f;
    f32x16 o[8];
#pragma unroll
    for (int d = 0; d < 8; ++d)
#pragma unroll
        for (int r = 0; r < 16; ++r) o[d][r] = 0.f;
    const int NT = 4 * qb + 4, myNT = 4 * qb + (wid >> 1) + 1;
    constexpr size_t KSTEP = 64 * 128, VSTEP = 64 * 256;
    const bool late = wid >= 4;
    stage_tile(lds, j_lo & 1, j_lo % 3, kbase + (size_t)j_lo * KSTEP, vbase + (size_t)j_lo * VSTEP, tid, wid);
    VM_WAIT(); WG_BAR();
    if (!late) {
        int vs = j_lo % 3;
        for (int j = j_lo; j < NT; ++j) {
            const int vsn = vs == 2 ? 0 : vs + 1;
            if (j + 1 < NT) stage_tile(lds, (j + 1) & 1, vsn, kbase + (size_t)(j + 1) * KSTEP, vbase + (size_t)(j + 1) * VSTEP, tid, wid);
            if (j < myNT) { if (j > j_lo) m_reg -= sh64;
                bf16x8 pa[4];
                qk_softmax(lds + K_OFF + (j & 1) * SHM_K, r32, hi, al_l, qr, o, pa, m_reg, l_reg, rawu, sl2, j == myNT - 1, qi);
                pv_tile(o, vb0 + (unsigned)(vs * SHM_V), pa); }
            VM_WAIT(); WG_BAR();
            vs = vsn;
        }
    } else {
        bf16x8 pa[4];
        int vs = j_lo % 3, vsp = vs;
        for (int j = j_lo; j < NT; ++j) {
            const int vsn = vs == 2 ? 0 : vs + 1;
            if (j + 1 < NT) stage_tile(lds, (j + 1) & 1, vsn, kbase + (size_t)(j + 1) * KSTEP, vbase + (size_t)(j + 1) * VSTEP, tid, wid);
            if (j > j_lo && j - 1 < myNT) pv_tile(o, vb0 + (unsigned)(vsp * SHM_V), pa);
            if (j < myNT) { if (j > j_lo) m_reg -= sh64;
                qk_softmax(lds + K_OFF + (j & 1) * SHM_K, r32, hi, al_l, qr, o, pa, m_reg, l_reg, rawu, sl2, j == myNT - 1, qi); }
            VM_WAIT(); WG_BAR();
            vsp = vs; vs = vsn;
        }
        if (myNT == NT) pv_tile(o, vb0 + (unsigned)(vsp * SHM_V), pa);
    }
    if (hi == 0) li_l[r32] = l_reg;
    LDS_WAIT();
    char* Ow = (char*)(oout + tokq * D + h * 256);
    const unsigned lofs = (unsigned)(hi * 4 * D + r32) * 2u;
#pragma unroll
    for (int r = 0; r < 16; ++r) { const float rl = __builtin_amdgcn_rcpf(li_l[crow(r, hi)]);
#pragma unroll
        for (int d0 = 0; d0 < 8; ++d0) { const float v = o[d0][r] * rl; const float vn = __shfl_xor(v, 1);
            if ((r32 & 1) == 0) *(unsigned*)(Ow + (lofs + (unsigned)((((r & 3) + 8 * (r >> 2)) * D + d0 * 32) * 2))) = cvt_pk_bf16(v, vn); } }
    WG_BAR();
}

struct TailConv { const float* wg; const float* wu; const float* wd; bf16_t* gu; bf16_t* dt; };
__device__ __forceinline__ void attn_phase(Frame& F, const bf16_t* proj, const float* nrm, unsigned* queue, bf16_t* o1, bf16_t* o2, const TailConv tc) {
    LAS int* qw = (LAS int*)(F.lds + SCR_OFF + 8 * 256);
    for (;;) {
        if (F.tid == 0) *qw = (int)__hip_atomic_fetch_add(queue, 1u, __ATOMIC_RELAXED, __HIP_MEMORY_SCOPE_AGENT);
        WG_BAR();
        const int I = __builtin_amdgcn_readfirstlane(*qw);
        if (I >= 2048 + 512) break;
        if (I >= 2048) { conv_moe(F, tc.wg, tc.wu, tc.wd, tc.gu, tc.dt, I - 2048, 512); WG_BAR(); continue; }
        const int qb = 63 - (I >> 5), r = I & 31, h = 7 - (r >> 2), b = (r >> 1) & 1, sub = r & 1;
        attn_item(F.lds, proj, nrm, sub ? o2 : o1, b, h, sub, qb, F.tid, F.wave, F.lane);
    }
}
}

__device__ __forceinline__ const void* karg(int i) { int j = i; asm volatile("" : "+s"(j)); return ((const void* const __attribute__((address_space(4)))*)__builtin_amdgcn_kernarg_segment_ptr())[j]; }
__global__ void __launch_bounds__(NWAVES * 64, 2) hybrid_fwd(Args args) {
    extern __shared__ __attribute__((aligned(16))) unsigned char lds_raw[];
    Frame F;
    F.lds = (LAS unsigned char*)lds_raw;
    F.tid = threadIdx.x; F.lane = F.tid & 63; F.wave = __builtin_amdgcn_readfirstlane(F.tid >> 6);
    F.G = gridDim.x; { const int bx = blockIdx.x; F.vcu = (F.G % 8 == 0) ? (bx % 8) * (F.G / 8) + bx / 8 : bx; }
#define ws ((unsigned char*)karg(22))
#define ctl ((unsigned*)(ws + WS_CTL))
    for (int u = F.tid; u < (LDS_BYTES - LDSCTL_OFF) / 4; u += NWAVES * 64) ((LAS unsigned*)(F.lds + LDSCTL_OFF))[u] = 0u;
    __syncthreads();
    ((LAS int*)(F.lds + TIDS_OFF))[F.tid] = F.tid;
    __syncthreads();
    volatile LAS unsigned* MISC = (volatile LAS unsigned*)(F.lds + MISC_OFF);
    XcdBarrier bar = xcd_barrier_post(ctl + CW_BAR, MISC + 8);
#define GRID_BAR() do { XcdBarrier bb_ = bar; unsigned x_ = bar.x; unsigned long long bp_ = (unsigned long long)bar.bar; asm volatile("" : "+s"(x_), "+s"(bp_)); bb_.x = x_; bb_.bar = (unsigned*)bp_; xcd_barrier(bb_, TID_RELOAD() == 0); } while (0)
#define TID_RELOAD() (F.wave * 64 + lane_id_volatile())
#ifdef ONLY_PHASE
#define PHON(n) ((n) == ONLY_PHASE)
#elif DIAG
#define PHON(n) ((n) <= args.upto)
#else
#define PHON(n) 1
#endif

#define x_in ((const float*)(karg(0)))
#define norm_mix ((const float*)(karg(1)))
#define norm_ffn ((const float*)(karg(2)))
#define gla_w_in ((const float*)(karg(3)))
#define gla_wgu ((const float*)(karg(4)))
#define gla_bg ((const float*)(karg(5)))
#define gla_norm ((const float*)(karg(6)))
#define gla_w_out ((const float*)(karg(7)))
#define diff_w_in ((const float*)(karg(8)))
#define lq1 ((const float*)(karg(9)))
#define lk1 ((const float*)(karg(10)))
#define lq2 ((const float*)(karg(11)))
#define lk2 ((const float*)(karg(12)))
#define diff_subln ((const float*)(karg(13)))
#define diff_w_out ((const float*)(karg(14)))
#define moe_wgrp ((const float*)(karg(15)))
#define moe_wexp ((const float*)(karg(16)))
#define moe_wg ((const float*)(karg(17)))
#define moe_wu ((const float*)(karg(18)))
#define moe_wd ((const float*)(karg(19)))
#define final_norm ((const float*)(karg(20)))
#define xres ((float*)(karg(21)))
#define gz ((float*)((float*)(ws + WS_GZ)))
#define tok_e ((int*)((int*)(ws + WS_TOKE)))
#define tok_p ((int*)((int*)(ws + WS_TOKP)))
#define tok_w ((float*)((float*)(ws + WS_TOKW)))
#define slot_of ((int*)((int*)(ws + WS_SLOT)))
#define slot_tok ((int*)(ws + WS_STOK))
#define adec ((float*)((float*)(ws + WS_ADEC)))
#define pcum ((float*)((float*)(ws + WS_PCUM)))
#define sfin ((bf16_t*)((bf16_t*)(ws + WS_SFIN)))
#define wp_gz ((float*)((float*)(ws + WS_WPGZ)))
#define wp_r0 ((float*)((float*)(ws + WS_WPR0)))
#define wp_r1 ((float*)((float*)(ws + WS_WPR1)))
#define wgi ((bf16_t*)((bf16_t*)(ws + WS_WGI)))
#define wgo ((bf16_t*)((bf16_t*)(ws + WS_WGO)))
#define wdi ((bf16_t*)((bf16_t*)(ws + WS_WDI)))
#define wdo ((bf16_t*)((bf16_t*)(ws + WS_WDO)))
#define wmoe_gu ((bf16_t*)((bf16_t*)(ws + WS_WMOE)))
#define wmoe_d ((bf16_t*)((bf16_t*)(ws + WS_WMOE_D)))
#define hn ((bf16_t*)((bf16_t*)(ws + WS_HN)))
#define proj ((bf16_t*)((bf16_t*)(ws + WS_PROJ)))
#define buf1 ((bf16_t*)((bf16_t*)(ws + WS_BUF1)))
#define buf2 ((bf16_t*)((bf16_t*)(ws + WS_BUF2)))
#define ag ((bf16_t*)((bf16_t*)(ws + WS_AG)))
#define ob ((bf16_t*)((bf16_t*)(ws + WS_OB)))
#define hh ((bf16_t*)((bf16_t*)(ws + WS_H)))
    const LAS int* pst = (const LAS int*)(F.lds + TAB_OFF);

    _Pragma("unroll") for (int rep_ = 0; rep_ < (REP_PHASE == 0 ? 2 : 1); ++rep_) if (PHON(0)) { if (rep_) GRID_BAR(); Frame P = F; P.tid = TID_RELOAD(); P.lane = P.tid & 63;
    conv_plain(P, gla_w_in, D, PROJW, GLA_INW, wgi);
    conv_plain(P, gla_w_out, D, D, D, wgo);
    pack_proj(P, wp_gz, 1, norm_mix, gla_w_in, GLA_INW, PROJW, 16, nullptr, 0, 0);
    pack_proj(P, wp_r0, 3, norm_ffn, moe_wgrp, 4, 0, 4, moe_wexp, 32, 32);
    pack_proj(P, wp_r1, 3, norm_ffn + D, moe_wgrp + (size_t)D * 4, 4, 0, 4, moe_wexp + (size_t)D * 32, 32, 32);
    }
    GRID_BAR();
    _Pragma("unroll") for (int rep_ = 0; rep_ < (REP_PHASE == 1 ? 2 : 1); ++rep_) if (PHON(1)) { if (rep_) GRID_BAR(); Frame P = F; P.tid = TID_RELOAD(); P.lane = P.tid & 63;
    phase_norm_gz(P, x_in, norm_mix, wp_gz, hn, gz);
    }
    GRID_BAR();
    _Pragma("unroll") for (int rep_ = 0; rep_ < (REP_PHASE == 2 ? 2 : 1); ++rep_) if (PHON(2)) { if (rep_) GRID_BAR(); Frame P = F; P.tid = TID_RELOAD(); P.lane = P.tid & 63;
    { pg8::Gemm g{hn, wgi, T, PROJW, D}; pg8::StaticOrder S; S.init(T, PROJW, P.G, (int)blockIdx.x); pg8::EpiHeads<0> E{proj};
      pg8::gemm_phase<pg8::EpiHeads<0>, pg8::StaticOrder>(P.lds, g, S, E, P.tid); }
    }
    GRID_BAR();
    _Pragma("unroll") for (int rep_ = 0; rep_ < (REP_PHASE == 3 ? 2 : 1); ++rep_) if (PHON(3)) { if (rep_) GRID_BAR(); Frame P = F; P.tid = TID_RELOAD(); P.lane = P.tid & 63;
    phase_gla_gate(P, gz, gla_wgu, gla_bg, proj, buf1, adec);
    }
    GRID_BAR();
    _Pragma("unroll") for (int rep_ = 0; rep_ < (REP_PHASE == 4 ? 2 : 1); ++rep_) if (PHON(4)) { if (rep_) GRID_BAR(); Frame P = F; P.tid = TID_RELOAD(); P.lane = P.tid & 63;
    if (P.G == 256) { if ((P.vcu & 1) == 0) phase_gla_scan(P, P.vcu >> 1, proj, buf1, adec, buf2, sfin, ctl + CW_PROBE); else { gla_pcum(P, adec, pcum, P.vcu >> 1, 128); conv_moe(P, moe_wg, moe_wu, moe_wd, wmoe_gu, wmoe_d, P.vcu >> 1, 128);
            conv_plain<true>(P, diff_w_in, D, PROJW, PROJW, wdi, P.vcu >> 1, 128); conv_plain<true>(P, diff_w_out, D, D, D, wdo, P.vcu >> 1, 128); } }
    else { for (int it = P.vcu; it < 128; it += P.G) phase_gla_scan(P, it, proj, buf1, adec, buf2, sfin); gla_pcum(P, adec, pcum, P.vcu, P.G); conv_moe(P, moe_wg, moe_wu, moe_wd, wmoe_gu, wmoe_d); conv_plain<true>(P, diff_w_in, D, PROJW, PROJW, wdi); conv_plain<true>(P, diff_w_out, D, D, D, wdo); }
    GRID_BAR();
    phase_gla_qp(P, proj, pcum, hn);
    GRID_BAR();
    { pg8::Gemm g{hn, sfin, 8 * (SEQ / 2), 512, 256}; pg8::FixOrder S; S.init(8 * (SEQ / 2), 512, P.G, (int)blockIdx.x); pg8::EpiAddO E{buf2};
      pg8::gemm_phase<pg8::EpiAddO, pg8::FixOrder>(P.lds, g, S, E, P.tid); }
    }
    GRID_BAR();
    _Pragma("unroll") for (int rep_ = 0; rep_ < (REP_PHASE == 5 ? 2 : 1); ++rep_) if (PHON(5)) { if (rep_) GRID_BAR(); Frame P = F; P.tid = TID_RELOAD(); P.lane = P.tid & 63;
    phase_gla_gnorm(P, buf2, proj, gla_norm, hn);
    }
    GRID_BAR();
    _Pragma("unroll") for (int rep_ = 0; rep_ < (REP_PHASE == 6 ? 2 : 1); ++rep_) if (PHON(6)) { if (rep_) GRID_BAR(); Frame P = F; P.tid = TID_RELOAD(); P.lane = P.tid & 63;
    { pg8::Gemm g{hn, wgo, T, D, D}; pg8::StaticOrder S; S.init(T, D, P.G, (int)blockIdx.x); pg8::EpiResF32 E{x_in, xres, D};
      pg8::gemm_phase<pg8::EpiResF32, pg8::StaticOrder>(P.lds, g, S, E, P.tid); }
    }
    GRID_BAR();
    _Pragma("unroll") for (int rep_ = 0; rep_ < (REP_PHASE == 7 ? 2 : 1); ++rep_) if (PHON(7)) { if (rep_) GRID_BAR(); Frame P = F; P.tid = TID_RELOAD(); P.lane = P.tid & 63;
    phase_norm_route(P, xres, norm_ffn, wp_r0, hn, tok_e, tok_p, tok_w, ctl + CW_CNT0);
    }
    GRID_BAR();
    _Pragma("unroll") for (int rep_ = 0; rep_ < (REP_PHASE == 8 ? 2 : 1); ++rep_) if (PHON(8)) { if (rep_) GRID_BAR(); Frame P = F; P.tid = TID_RELOAD(); P.lane = P.tid & 63;
    moe_tables(P, ctl + CW_CNT0);
    phase_moe_slots(P, tok_e, tok_p, ctl + CW_CNT0, slot_of, slot_tok);
    }
    GRID_BAR();
    _Pragma("unroll") for (int rep_ = 0; rep_ < (REP_PHASE == 9 ? 2 : 1); ++rep_) if (PHON(9)) { if (rep_) GRID_BAR(); Frame P = F; P.tid = TID_RELOAD(); P.lane = P.tid & 63;
    { const int Mr = pst[33] * 256; pg8::Gemm g{hn, wmoe_gu, Mr, 1024, D}; pg8::MoeOrder S; S.init(Mr, 1024, P.G, (int)blockIdx.x); S.te = pst + 36; S.estride = (size_t)1024 * D; S.stok = slot_tok; pg8::EpiSiluMul E{(unsigned char*)hh};
      pg8::gemm_phase<pg8::EpiSiluMul, pg8::MoeOrder, true, true>(P.lds, g, S, E, P.tid); }
    }
    GRID_BAR();
    _Pragma("unroll") for (int rep_ = 0; rep_ < (REP_PHASE == 10 ? 2 : 1); ++rep_) if (PHON(10)) { if (rep_) GRID_BAR(); Frame P = F; P.tid = TID_RELOAD(); P.lane = P.tid & 63;
    { const int Mr = pst[33] * 256; pg8::Gemm g{hh, wmoe_d, Mr, D, DFF}; pg8::MoeOrder S; S.init(Mr, D, P.G, (int)blockIdx.x); S.te = pst + 36; S.estride = (size_t)D * DFF; S.stok = slot_tok; pg8::EpiBf16 E{ob, D};
      pg8::gemm_phase<pg8::EpiBf16, pg8::MoeOrder, false, true>(P.lds, g, S, E, P.tid); }
    }
    GRID_BAR();
    _Pragma("unroll") for (int rep_ = 0; rep_ < (REP_PHASE == 11 ? 2 : 1); ++rep_) if (PHON(11)) { if (rep_) GRID_BAR(); Frame P = F; P.tid = TID_RELOAD(); P.lane = P.tid & 63;
    phase_moe_combine<0>(P, xres, ob, slot_of, tok_w, norm_mix + D, hn);
    }
    GRID_BAR();
    _Pragma("unroll") for (int rep_ = 0; rep_ < (REP_PHASE == 12 ? 2 : 1); ++rep_) if (PHON(12)) { if (rep_) GRID_BAR(); Frame P = F; P.tid = TID_RELOAD(); P.lane = P.tid & 63;
    { pg8::Gemm g{hn, wdi, T, PROJW, D}; pg8::StaticOrder S; S.init(T, PROJW, P.G, (int)blockIdx.x); pg8::EpiHeads<1> E{proj};
      pg8::gemm_phase<pg8::EpiHeads<1>, pg8::StaticOrder, false, true>(P.lds, g, S, E, P.tid); }
    GRID_BAR();
    att::norms_phase(P, proj, (float*)(ws + WS_NRM));
    }
    GRID_BAR();
    _Pragma("unroll") for (int rep_ = 0; rep_ < (REP_PHASE == 13 ? 2 : 1); ++rep_) if (PHON(13)) { if (rep_) GRID_BAR(); Frame P = F; P.tid = TID_RELOAD(); P.lane = P.tid & 63;
    att::attn_phase(P, proj, (const float*)(ws + WS_NRM), ctl + CW_QUEUE, buf1, buf2, att::TailConv{moe_wg + (size_t)NEXP * D * DFF, moe_wu + (size_t)NEXP * D * DFF, moe_wd + (size_t)NEXP * DFF * D, (bf16_t*)(ws + WS_WMOE1), (bf16_t*)(ws + WS_WMOE1_D)});
    }
    GRID_BAR();
    _Pragma("unroll") for (int rep_ = 0; rep_ < (REP_PHASE == 14 ? 2 : 1); ++rep_) if (PHON(14)) { if (rep_) GRID_BAR(); Frame P = F; P.tid = TID_RELOAD(); P.lane = P.tid & 63;
    phase_subln(P, buf1, buf2, lq1, lk1, lq2, lk2, diff_subln, hn);
    }
    GRID_BAR();
    _Pragma("unroll") for (int rep_ = 0; rep_ < (REP_PHASE == 15 ? 2 : 1); ++rep_) if (PHON(15)) { if (rep_) GRID_BAR(); Frame P = F; P.tid = TID_RELOAD(); P.lane = P.tid & 63;
    { pg8::Gemm g{hn, wdo, T, D, D}; pg8::StaticOrder S; S.init(T, D, P.G, (int)blockIdx.x); pg8::EpiResF32 E{xres, xres, D};
      pg8::gemm_phase<pg8::EpiResF32, pg8::StaticOrder, false, true>(P.lds, g, S, E, P.tid); }
    }
    GRID_BAR();
    _Pragma("unroll") for (int rep_ = 0; rep_ < (REP_PHASE == 16 ? 2 : 1); ++rep_) if (PHON(16)) { if (rep_) GRID_BAR(); Frame P = F; P.tid = TID_RELOAD(); P.lane = P.tid & 63;
    phase_norm_route(P, xres, norm_ffn + D, wp_r1, hn, tok_e, tok_p, tok_w, ctl + CW_CNT1);
    }
    GRID_BAR();
    _Pragma("unroll") for (int rep_ = 0; rep_ < (REP_PHASE == 17 ? 2 : 1); ++rep_) if (PHON(17)) { if (rep_) GRID_BAR(); Frame P = F; P.tid = TID_RELOAD(); P.lane = P.tid & 63;
    moe_tables(P, ctl + CW_CNT1);
    phase_moe_slots(P, tok_e, tok_p, ctl + CW_CNT1, slot_of, slot_tok);
    }
    GRID_BAR();
    _Pragma("unroll") for (int rep_ = 0; rep_ < (REP_PHASE == 18 ? 2 : 1); ++rep_) if (PHON(18)) { if (rep_) GRID_BAR(); Frame P = F; P.tid = TID_RELOAD(); P.lane = P.tid & 63;
    { const int Mr = pst[33] * 256; pg8::Gemm g{hn, (bf16_t*)(ws + WS_WMOE1), Mr, 1024, D}; pg8::MoeOrder S; S.init(Mr, 1024, P.G, (int)blockIdx.x); S.te = pst + 36; S.estride = (size_t)1024 * D; S.stok = slot_tok; pg8::EpiSiluMul E{(unsigned char*)hh};
      pg8::gemm_phase<pg8::EpiSiluMul, pg8::MoeOrder, true, true>(P.lds, g, S, E, P.tid); }
    }
    GRID_BAR();
    _Pragma("unroll") for (int rep_ = 0; rep_ < (REP_PHASE == 19 ? 2 : 1); ++rep_) if (PHON(19)) { if (rep_) GRID_BAR(); Frame P = F; P.tid = TID_RELOAD(); P.lane = P.tid & 63;
    { const int Mr = pst[33] * 256; pg8::Gemm g{hh, (bf16_t*)(ws + WS_WMOE1_D), Mr, D, DFF}; pg8::MoeOrder S; S.init(Mr, D, P.G, (int)blockIdx.x); S.te = pst + 36; S.estride = (size_t)D * DFF; S.stok = slot_tok; pg8::EpiBf16 E{ob, D};
      pg8::gemm_phase<pg8::EpiBf16, pg8::MoeOrder, false, true>(P.lds, g, S, E, P.tid); }
    }
    GRID_BAR();
    _Pragma("unroll") for (int rep_ = 0; rep_ < (REP_PHASE == 20 ? 2 : 1); ++rep_) if (PHON(20)) { if (rep_) GRID_BAR(); Frame P = F; P.tid = TID_RELOAD(); P.lane = P.tid & 63;
    phase_moe_combine<1>(P, xres, ob, slot_of, tok_w, final_norm, hn);
    }
#if PROBE
    { GRID_BAR(); const float c = sqrtf(0.1f * __uint_as_float(xb_ld(ctl + CW_PROBE)));
      for (size_t i = (size_t)blockIdx.x * 512 + F.tid; i < (size_t)T * D; i += (size_t)gridDim.x * 512) xres[i] = c; }
#endif
}

#undef x_in
#undef norm_mix
#undef norm_ffn
#undef gla_w_in
#undef gla_wgu
#undef gla_bg
#undef gla_norm
#undef gla_w_out
#undef diff_w_in
#undef lq1
#undef lk1
#undef lq2
#undef lk2
#undef diff_subln
#undef diff_w_out
#undef moe_wgrp
#undef moe_wexp
#undef moe_wg
#undef moe_wu
#undef moe_wd
#undef final_norm
#undef xres
#undef gz
#undef tok_e
#undef tok_p
#undef tok_w
#undef slot_of
#undef slot_tok
#undef ws
#undef ctl
#undef adec
#undef pcum
#undef sfin
#undef wp_gz
#undef wp_r0
#undef wp_r1
#undef wgi
#undef wgo
#undef wdi
#undef wdo
#undef wmoe_gu
#undef wmoe_d
#undef hn
#undef proj
#undef buf1
#undef buf2
#undef ag
#undef ob
#undef hh
#if DIAG
constexpr size_t WS_DIAG = WS_END;
constexpr int NSAVE = 64;
__device__ inline unsigned hsh(unsigned x) { x ^= x >> 16; x *= 0x7feb352dU; x ^= x >> 15; x *= 0x846ca68bU; x ^= x >> 16; return x; }
__device__ inline void rep(unsigned* w, double got, double ref, double scale) { double e = fabs(got - ref) / (fabs(ref) + scale); float ef = (float)e; if (!(ef == ef) || ef > 1e30f) ef = 1e30f; atomicMax(w, __float_as_uint(ef)); }
__device__ inline double bfd(bf16_t v) { return (double)bf2f(v); }
#define GTID (blockIdx.x * blockDim.x + threadIdx.x)
#define GSTR (gridDim.x * blockDim.x)

__global__ void ck_weights(const float* gla_w_in, const float* gla_w_out, const float* diff_w_in, const float* diff_w_out, const bf16_t* wgi, const bf16_t* wgo, const bf16_t* wdi, const bf16_t* wdo,
                           const float* norm_mix, const float* norm_ffn, const float* wgrp, const float* wexp, const float* wp_gz, const float* wp_r0, const float* wp_r1, unsigned* w) {
    for (unsigned i = GTID; i < 65536u; i += GSTR) { const unsigned r = hsh(i * 3u + 1u), r2 = hsh(i * 7u + 5u);
        const int n = r % 6144u, k = r2 % 2048u, n2 = n % 2048;
        rep(w, bfd(wgi[(size_t)n * D + k]), gla_w_in[(size_t)k * GLA_INW + n], 0.02); rep(w, bfd(wdi[(size_t)n * D + k]), diff_w_in[(size_t)k * PROJW + n], 0.02);
        rep(w, bfd(wgo[(size_t)n2 * D + k]), gla_w_out[(size_t)k * D + n2], 0.02); rep(w, bfd(wdo[(size_t)n2 * D + k]), diff_w_out[(size_t)k * D + n2], 0.02);
        const int s = r % 128u, ln = (r >> 7) % 64u, e4 = (r >> 13) & 3, kk = 16 * s + 4 * (ln >> 4) + e4, col = ln & 15, nt = (r >> 15) % 3u, col3 = 16 * nt + col;
        rep(w, wp_gz[(s * 64 + ln) * 4 + e4], (double)norm_mix[kk] * gla_w_in[(size_t)kk * GLA_INW + PROJW + col], 0.02);
        for (int L = 0; L < 2; ++L) { const float* gr = wgrp + (size_t)L * D * 4; const float* ex = wexp + (size_t)L * D * 32; const float* nf = norm_ffn + L * D;
            const double ref = col3 < 4 ? gr[kk * 4 + col3] : (col3 < 36 ? ex[kk * 32 + col3 - 4] : 0.0);
            rep(w, (L ? wp_r1 : wp_r0)[((s * 3 + nt) * 64 + ln) * 4 + e4], (double)nf[kk] * ref, 0.02); } }
}
__global__ void ck_moew(const float* wg, const float* wu, const float* wd, const bf16_t* GU, const bf16_t* DT, unsigned* w) {
    for (unsigned i = GTID; i < 65536u; i += GSTR) { const unsigned r = hsh(i * 5u + 2u), r2 = hsh(i * 11u + 3u);
        const int e = r % 32u, f = (r >> 5) % 512u, k = r2 % 2048u, n2 = (r2 >> 11) % 2048u, rowg = 256 * (f >> 7) + (f & 127);
        rep(w, bfd(GU[((size_t)e * 1024 + rowg) * D + k]), wg[((size_t)e * D + k) * DFF + f], 0.02); rep(w, bfd(GU[((size_t)e * 1024 + rowg + 128) * D + k]), wu[((size_t)e * D + k) * DFF + f], 0.02);
        rep(w, bfd(DT[((size_t)e * D + n2) * DFF + f]), wd[((size_t)e * DFF + f) * D + n2], 0.05); }
}
__global__ void ck_norm(const float* x, const float* gain, const bf16_t* hn, unsigned* w) {
    for (unsigned i = GTID; i < 4096u; i += GSTR) { const unsigned r = hsh(i * 13u + 7u); const int t = r % (unsigned)T, j = (r >> 15) % 2048u;
        double ss = 0; for (int k = 0; k < D; ++k) { const double v = x[(size_t)t * D + k]; ss += v * v; }
        const double rstd = 1.0 / sqrt(ss / D + 1e-6); rep(w, bfd(hn[(size_t)t * D + j]), x[(size_t)t * D + j] * rstd * gain[j], 1.0); }
}
__global__ void ck_gz(const float* x, const float* gain, const float* gla_w_in, const float* gz, unsigned* w) {
    for (unsigned i = GTID; i < 4096u; i += GSTR) { const unsigned r = hsh(i * 17u + 9u); const int t = r % (unsigned)T, c = (r >> 15) % 16u;
        double ss = 0, dot = 0; for (int k = 0; k < D; ++k) { const double v = x[(size_t)t * D + k]; ss += v * v; dot += v * gain[k] * gla_w_in[(size_t)k * GLA_INW + PROJW + c]; }
        rep(w, gz[(size_t)t * 16 + c], dot / sqrt(ss / D + 1e-6), 1.0); }
}
__global__ void ck_gemm(const bf16_t* A, const bf16_t* Bt, const bf16_t* C, int M, int N, int K, int ldc, double scale, unsigned* w) {
    for (unsigned i = GTID; i < 16384u; i += GSTR) { const unsigned r = hsh(i * 19u + 11u), r2 = hsh(i * 23u + 1u); const int m = r % (unsigned)M, n = r2 % (unsigned)N;
        double s = 0; for (int k = 0; k < K; ++k) s += bfd(A[(size_t)m * K + k]) * bfd(Bt[(size_t)n * K + k]);
        rep(w, bfd(C[(size_t)m * ldc + n]), s, scale); }
}
__global__ void ck_proj(const bf16_t* A, const bf16_t* Bt, const bf16_t* proj, int layer, unsigned* w) {
    for (unsigned i = GTID; i < 16384u; i += GSTR) { const unsigned r = hsh(i * 19u + 11u), r2 = hsh(i * 23u + 1u); const int m = r % (unsigned)T, n = r2 % (unsigned)PROJW, b = m >> 14, t = m & (SEQ - 1);
        double s = 0; for (int k = 0; k < D; ++k) s += bfd(A[(size_t)m * D + k]) * bfd(Bt[(size_t)n * D + k]);
        size_t off;
        if (layer == 0) { if (n < 1024) off = gq_off(b, t, n >> 8) + (n & 255); else if (n < 2048) off = GK0 + gq_off(b, t, (n - 1024) >> 8) + (n & 255); else if (n < 4096) off = gv_off(b, t, (n - 2048) >> 9) + (n & 511); else off = GR0 + (size_t)m * 2048 + (n - 4096); }
        else { if (n < 2048) off = dq_off(b, t, n >> 8, (n >> 7) & 1) + (n & 127); else if (n < 4096) off = DK0 + dq_off(b, t, (n - 2048) >> 8, (n >> 7) & 1) + (n & 127); else off = dv_off(b, t, (n - 4096) >> 8) + (n & 255); }
        rep(w, bfd(proj[off]), s, 1.0); }
}
__device__ inline int srow(int i) { return (int)(hsh(i * 29u + 13u) % (unsigned)T); }
__global__ void ck_save(const float* x, float* save) { for (unsigned i = GTID; i < (unsigned)NSAVE * D; i += GSTR) save[i] = x[(size_t)srow(i / D) * D + (i % D)]; }
__global__ void ck_gemm_res(const bf16_t* A, const bf16_t* Bt, const float* base, int saved, const float* out, unsigned* w) {
    for (unsigned i = GTID; i < (unsigned)NSAVE * 64u; i += GSTR) { const int si = i / 64, t = srow(si), n = hsh(i * 31u + 5u) % 2048u;
        double s = 0; for (int k = 0; k < D; ++k) s += bfd(A[(size_t)t * D + k]) * bfd(Bt[(size_t)n * D + k]);
        const double b = saved ? base[(size_t)si * D + n] : base[(size_t)t * D + n];
        rep(w, out[(size_t)t * D + n], b + s, 1.0); }
}
__global__ void ck_gate(const float* gz, const float* wgu, const float* bg, const bf16_t* proj, const bf16_t* kdT, const float* adec, unsigned* w) {
    for (unsigned i = GTID; i < 4096u; i += GSTR) { const unsigned r = hsh(i * 37u + 3u); const int bc = r % 512u, j = (r >> 9) % 1024u, tq = (r >> 19) % 64u;
        double run = 0, ct = 0;
        for (int t = 0; t < 64; ++t) { double z = bg[j]; for (int q = 0; q < 16; ++q) z += (double)gz[((size_t)bc * 64 + t) * 16 + q] * wgu[q * 1024 + j];
            const double ls = fmin(z, 0.0) - log1p(exp(-fabs(z))); run += ls / 16.0; if (t == tq) ct = run; }
        rep(w, adec[(size_t)bc * 1024 + j], exp(run), 1.0);
        rep(w, bfd(kdT[((size_t)bc * 1024 + j) * 64 + tq]), bfd(proj[GK0 + gq_off(bc >> 8, (bc & 255) * 64 + tq, j >> 8) + (j & 255)]) * exp(run - ct), 1.0); }
}
__global__ void ck_scan(const bf16_t* proj, const bf16_t* kdT, const float* adec, const bf16_t* o, unsigned* w) {
    const int wv = GTID / 64, lane = threadIdx.x & 63, nw = GSTR / 64;
    const int cl[8] = {0, 1, 3, 17, 100, 255, 2, 64};
    for (int s = wv; s < 96; s += nw) { const unsigned r = hsh(s * 41u + 17u); const int b = r & 1, c = cl[s % 8], tl = (r >> 1) % 64u, h = (r >> 7) % 4u, vc = (r >> 9) % 512u;
        float S[4] = {0.f, 0.f, 0.f, 0.f};
        for (int cc = 0; cc <= c; ++cc) { const size_t bc = (size_t)b * NCH + cc;
            for (int q = 0; q < 4; ++q) { const int kr = h * 256 + lane * 4 + q; float a = 0.f;
                for (int t = 0; t < 64; ++t) a += bf2f(kdT[(bc * 1024 + kr) * 64 + t]) * bf2f(proj[gv_off(b, cc * 64 + t, h) + vc]);
                S[q] = adec[bc * 1024 + kr] * S[q] + a; } }
        float part = 0.f; const size_t tok = (size_t)b * SEQ + c * 64 + tl;
        for (int q = 0; q < 4; ++q) part += bf2f(proj[gq_off(b, c * 64 + tl, h) + lane * 4 + q]) * S[q];
        for (int of = 1; of < 64; of <<= 1) part += __shfl_xor(part, of);
        if (lane == 0) rep(w, bfd(o[tok * D + h * 512 + vc]), part / 16.0, 2.0); }
}
__global__ void ck_gnorm(const bf16_t* o, const bf16_t* proj, const float* gn, const bf16_t* y, unsigned* w) {
    for (unsigned i = GTID; i < 8192u; i += GSTR) { const unsigned r = hsh(i * 43u + 19u); const int t = r % (unsigned)T, h = (r >> 15) % 4u, j = (r >> 17) % 512u;
        double ss = 0; for (int k = 0; k < 512; ++k) { const double v = bfd(o[(size_t)t * D + h * 512 + k]); ss += v * v; }
        const double rr = bfd(proj[GR0 + (size_t)t * 2048 + h * 512 + j]);
        rep(w, bfd(y[(size_t)t * D + h * 512 + j]), bfd(o[(size_t)t * D + h * 512 + j]) / sqrt(ss / 512 + 1e-6) * gn[j] * rr / (1.0 + exp(-rr)), 1.0); }
}
__global__ void ck_route(const float* x, const float* gain, const float* wgrp, const float* wexp, const int* tok_e, const int* tok_p, const float* tok_w, const unsigned* cnt, unsigned* w) {
    for (unsigned i = GTID; i < 512u; i += GSTR) { const int t = hsh(i * 47u + 23u) % (unsigned)T;
        double ss = 0; for (int k = 0; k < D; ++k) { const double v = x[(size_t)t * D + k]; ss += v * v; }
        const double rstd = 1.0 / sqrt(ss / D + 1e-6);
        double gl[4] = {0, 0, 0, 0};
        for (int k = 0; k < D; ++k) { const double v = x[(size_t)t * D + k] * rstd * gain[k]; for (int q = 0; q < 4; ++q) gl[q] += v * wgrp[k * 4 + q]; }
        int gi = 0; for (int q = 1; q < 4; ++q) if (gl[q] > gl[gi]) gi = q;
        double gs = 0; for (int q = 0; q < 4; ++q) gs += exp(gl[q] - gl[gi]);
        double el[8] = {0, 0, 0, 0, 0, 0, 0, 0};
        for (int k = 0; k < D; ++k) { const double v = x[(size_t)t * D + k] * rstd * gain[k]; for (int q = 0; q < 8; ++q) el[q] += v * wexp[k * 32 + gi * 8 + q]; }
        int i1 = 0; for (int q = 1; q < 8; ++q) if (el[q] > el[i1]) i1 = q;
        int i2 = (i1 == 0) ? 1 : 0; for (int q = 0; q < 8; ++q) if (q != i1 && el[q] > el[i2]) i2 = q;
        const double eb = exp(el[i2] - el[i1]);
        const int e1 = tok_e[2 * t], e2 = tok_e[2 * t + 1];
        double third = -1e30; for (int q = 0; q < 8; ++q) if (q != i1 && q != i2 && el[q] > third) third = el[q];
        const bool tie = (el[i2] - third) < 1e-4 || (el[i1] - el[i2]) < 1e-4;
        if (!tie) { rep(w, e1, gi * 8 + i1, 1.0); rep(w, e2, gi * 8 + i2, 1.0);
            rep(w, tok_w[2 * t], 1.0 / gs / (1.0 + eb), 0.3); rep(w, tok_w[2 * t + 1], eb / gs / (1.0 + eb), 0.3); }
        if ((unsigned)tok_p[2 * t] >= cnt[64 * (e1 & 31)] || (unsigned)tok_p[2 * t + 1] >= cnt[64 * (e2 & 31)]) rep(w, 9.0, 0.0, 1.0); }
}
__global__ void ck_gather(const int* tok_e, const int* tok_p, const int* slot_of, const unsigned* cnt, const bf16_t* hn, const int* ag  , unsigned* w) {
    for (unsigned i = GTID; i < 8192u; i += GSTR) { const unsigned r = hsh(i * 53u + 29u); const int a = r % (2u * T), k = (r >> 16) % 2048u, e = tok_e[a] & 31;
        int ps = 0; for (int q = 0; q < e; ++q) ps += ((int)cnt[64 * q] + 255) & ~255;
        const int slot = slot_of[a];
        rep(w, slot, ps + tok_p[a], 1.0);
        if (slot >= 0 && slot < MAX_TILES * 256) rep(w, (double)ag[slot], (double)(a >> 1), 1.0); (void)hn; (void)k; }
}
__global__ void ck_moe1(const int* tok_e, const int* slot_of, const bf16_t* ag, const float* wg, const float* wu, const bf16_t* hh, unsigned* w) {
    for (unsigned i = GTID; i < 8192u; i += GSTR) { const unsigned r = hsh(i * 59u + 31u); const int a = r % (2u * T), f = (r >> 16) % 512u, e = tok_e[a] & 31, slot = slot_of[a];
        if (slot < 0 || slot >= MAX_TILES * 256) { rep(w, 9.0, 0.0, 1.0); continue; }
        double g = 0, u = 0; for (int k = 0; k < D; ++k) { const double v = bfd(ag[(size_t)(a >> 1) * D + k]); g += v * wg[((size_t)e * D + k) * DFF + f]; u += v * wu[((size_t)e * D + k) * DFF + f]; }
        rep(w, bfd(hh[(size_t)slot * DFF + f]), g / (1.0 + exp(-g)) * u, 0.5); }
}
__global__ void ck_moe2(const int* tok_e, const int* slot_of, const bf16_t* hh, const float* wd, const bf16_t* ob, unsigned* w) {
    for (unsigned i = GTID; i < 8192u; i += GSTR) { const unsigned r = hsh(i * 61u + 37u); const int a = r % (2u * T), n = (r >> 16) % 2048u, e = tok_e[a] & 31, slot = slot_of[a];
        if (slot < 0 || slot >= MAX_TILES * 256) { rep(w, 9.0, 0.0, 1.0); continue; }
        double s = 0; for (int f = 0; f < DFF; ++f) s += bfd(hh[(size_t)slot * DFF + f]) * wd[((size_t)e * DFF + f) * D + n];
        rep(w, bfd(ob[(size_t)slot * D + n]), s, 0.3); }
}
__global__ void ck_combine(const float* save, const bf16_t* ob, const int* slot_of, const float* tok_w, const float* gain, const float* x, const bf16_t* hn, int mode, unsigned* w) {
    for (unsigned i = GTID; i < (unsigned)NSAVE * 32u; i += GSTR) { const int si = i / 32, t = srow(si), j = hsh(i * 67u + 41u) % 2048u;
        const int s0 = slot_of[2 * t], s1 = slot_of[2 * t + 1]; const double w0 = tok_w[2 * t], w1 = tok_w[2 * t + 1];
        double ss = 0, xj = 0; for (int k = 0; k < D; ++k) { const double v = save[(size_t)si * D + k] + w0 * bfd(ob[(size_t)s0 * D + k]) + w1 * bfd(ob[(size_t)s1 * D + k]); ss += v * v; if (k == j) xj = v; }
        const double y = xj / sqrt(ss / D + 1e-6) * gain[j];
        if (mode == 0) { rep(w, x[(size_t)t * D + j], xj, 1.0); rep(w, bfd(hn[(size_t)t * D + j]), y, 1.0); } else rep(w, x[(size_t)t * D + j], y, 1.0); }
}
__global__ void ck_attn(const bf16_t* proj, const bf16_t* o1, const bf16_t* o2, unsigned* w) {
    const int wv = GTID / 64, lane = threadIdx.x & 63, nw = GSTR / 64;
    const int tl[12] = {0, 1, 63, 64, 100, 255, 256, 1000, 4095, 8191, 16320, 16383};
    for (int s = wv; s < 96; s += nw) { const unsigned r = hsh(s * 71u + 43u); const int b = r & 1, h = (r >> 1) % 8u, sub = (r >> 4) & 1, t = tl[s % 12], dv0 = (r >> 5) % 253u;
        const double slope = exp2(-(double)(h + 1)); const int kend = 64 * (t / 64 + 1);
        const bf16_t* qp = proj + dq_off(b, t, h, sub);
        double mx = -1e300;
        for (int j = lane; j < kend; j += 64) { const bf16_t* kp = proj + DK0 + dq_off(b, j, h, sub); double d = 0; for (int q = 0; q < 128; ++q) d += bfd(qp[q]) * bfd(kp[q]);
            const double sc = d * 0.08838834764831845 - slope * fabs((double)(t - j)); if (sc > mx) mx = sc; }
        for (int of = 1; of < 64; of <<= 1) { const double o_ = __shfl_xor(mx, of); if (o_ > mx) mx = o_; }
        double l = 0, acc[4] = {0, 0, 0, 0};
        for (int j = lane; j < kend; j += 64) { const bf16_t* kp = proj + DK0 + dq_off(b, j, h, sub); double d = 0; for (int q = 0; q < 128; ++q) d += bfd(qp[q]) * bfd(kp[q]);
            const double p = exp(d * 0.08838834764831845 - slope * fabs((double)(t - j)) - mx); l += p;
            const bf16_t* vp = proj + dv_off(b, j, h) + dv0; for (int q = 0; q < 4; ++q) acc[q] += p * bfd(vp[q]); }
        for (int of = 1; of < 64; of <<= 1) { l += __shfl_xor(l, of); for (int q = 0; q < 4; ++q) acc[q] += __shfl_xor(acc[q], of); }
        if (lane == 0) for (int q = 0; q < 4; ++q) rep(w, bfd((sub ? o2 : o1)[((size_t)b * SEQ + t) * D + h * 256 + dv0 + q]), acc[q] / l, 0.2); }
}
__global__ void ck_subln(const bf16_t* o1, const bf16_t* o2, const float* lq1, const float* lk1, const float* lq2, const float* lk2, const float* sg, const bf16_t* y, unsigned* w) {
    double d1 = 0, d2 = 0; for (int k = 0; k < 128; ++k) { d1 += (double)lq1[k] * lk1[k]; d2 += (double)lq2[k] * lk2[k]; }
    const double li = 0.8 - 0.6 * exp(-0.3), lam = exp(d1) - exp(d2) + li;
    for (unsigned i = GTID; i < 8192u; i += GSTR) { const unsigned r = hsh(i * 73u + 47u); const int t = r % (unsigned)T, h = (r >> 15) % 8u, j = (r >> 18) % 256u;
        double ss = 0, dj = 0; for (int k = 0; k < 256; ++k) { const double v = bfd(o1[(size_t)t * D + h * 256 + k]) - lam * bfd(o2[(size_t)t * D + h * 256 + k]); ss += v * v; if (k == j) dj = v; }
        rep(w, bfd(y[(size_t)t * D + h * 256 + j]), dj / sqrt(ss / 256 + 1e-6) * sg[j] * (1.0 - li), 1.0); }
}
__global__ void ck_final(const unsigned* words, int nst, float* out, int n) {
    int val = 0;
    for (int s = 0; s < nst; ++s) { const float e = __uint_as_float(words[s]); if (e >= 0.03125f) { val = 4 * s + (e < 0.25f ? 1 : (e < 4.f ? 2 : 3)); break; } }
    const float c = sqrtf(0.1f * (float)val);
    for (int i = GTID; i < n; i += GSTR) out[i] = c;
}
#endif

extern "C" void kernel_launch(void* const* d_in, const int* in_sizes, int n_in, void* d_out, int out_size, void* d_ws, size_t ws_size, hipStream_t stream) {
    static int grid = 0;
    if (grid == 0) {
        if (n_in != 21 || out_size != T * D || ws_size < WS_END + 2 * MiB) { fprintf(stderr, "kernel_launch: unexpected shapes (n_in %d out %d ws %zu)\n", n_in, out_size, ws_size); grid = -1; return; }
        if (hipFuncSetAttribute((const void*)hybrid_fwd, hipFuncAttributeMaxDynamicSharedMemorySize, LDS_BYTES) != hipSuccess) { fprintf(stderr, "kernel_launch: hipFuncSetAttribute failed\n"); grid = -1; return; }
        int dev = 0, cus = 0, per_cu = 0;
        (void)hipGetDevice(&dev); (void)hipDeviceGetAttribute(&cus, hipDeviceAttributeMultiprocessorCount, dev);
        if (hipOccupancyMaxActiveBlocksPerMultiprocessor(&per_cu, (const void*)hybrid_fwd, NWAVES * 64, LDS_BYTES) != hipSuccess || per_cu < 1) fprintf(stderr, "kernel_launch: occupancy query says %d\n", per_cu);
        (void)hipGetLastError();
        grid = cus > 0 ? cus : 256;
    }
    if (grid < 0) return;
    Args a{};
    for (int i = 0; i < 21; ++i) a.in[i] = (const float*)d_in[i];
    a.out = (float*)d_out; a.ws = (unsigned char*)d_ws; a.upto = 99; a.pad1 = 0;
#if !DIAG
    (void)hipMemsetAsync((char*)d_ws + WS_CTL, 0, CTL_ZERO_BYTES, stream);
    hipLaunchKernelGGL(hybrid_fwd, dim3(grid), dim3(NWAVES * 64), LDS_BYTES, stream, a);
#else
    {
        unsigned char* ws = (unsigned char*)d_ws; const float* const* in = a.in;
        unsigned* words = (unsigned*)(ws + WS_DIAG); float* save = (float*)(ws + WS_DIAG + 65536);
        (void)hipMemsetAsync(words, 0, 65536, stream);
        float* gz = (float*)(ws + WS_GZ); int* tok_e = (int*)(ws + WS_TOKE); int* tok_p = (int*)(ws + WS_TOKP); float* tok_w = (float*)(ws + WS_TOKW); int* slot_of = (int*)(ws + WS_SLOT);
        float* adec = (float*)(ws + WS_ADEC); float* wp_gz = (float*)(ws + WS_WPGZ); float* wp_r0 = (float*)(ws + WS_WPR0); float* wp_r1 = (float*)(ws + WS_WPR1);
        bf16_t* wgi = (bf16_t*)(ws + WS_WGI); bf16_t* wgo = (bf16_t*)(ws + WS_WGO); bf16_t* wdi = (bf16_t*)(ws + WS_WDI); bf16_t* wdo = (bf16_t*)(ws + WS_WDO);
        bf16_t* gu = (bf16_t*)(ws + WS_WMOE); bf16_t* dt = (bf16_t*)(ws + WS_WMOE_D);
        bf16_t* hn = (bf16_t*)(ws + WS_HN); bf16_t* proj = (bf16_t*)(ws + WS_PROJ); bf16_t* buf1 = (bf16_t*)(ws + WS_BUF1); bf16_t* buf2 = (bf16_t*)(ws + WS_BUF2);
        bf16_t* ag = (bf16_t*)(ws + WS_AG); bf16_t* ob = (bf16_t*)(ws + WS_OB); bf16_t* hh = (bf16_t*)(ws + WS_H);
        unsigned* ctl = (unsigned*)(ws + WS_CTL); float* xres = (float*)d_out;
        const size_t L1W = (size_t)NEXP * D * DFF;
        for (int st = 0; st <= 20; ++st) {
            (void)hipMemsetAsync((char*)d_ws + WS_CTL, 0, CTL_ZERO_BYTES, stream);
            a.upto = st;
            hipLaunchKernelGGL(hybrid_fwd, dim3(grid), dim3(NWAVES * 64), LDS_BYTES, stream, a);
            unsigned* w = words + st;
            switch (st) {
            case 0: ck_weights<<<256, 256, 0, stream>>>(in[3], in[7], in[8], in[14], wgi, wgo, wdi, wdo, in[1], in[2], in[15], in[16], wp_gz, wp_r0, wp_r1, w); break;
            case 1: ck_norm<<<64, 64, 0, stream>>>(in[0], in[1], hn, w); ck_gz<<<64, 64, 0, stream>>>(in[0], in[1], in[3], gz, w); break;
            case 2: ck_proj<<<256, 64, 0, stream>>>(hn, wgi, proj, 0, w); break;
            case 3: ck_gate<<<64, 64, 0, stream>>>(gz, in[4], in[5], proj, buf1, adec, w); break;
            case 4: ck_scan<<<96, 64, 0, stream>>>(proj, buf1, adec, buf2, w); ck_moew<<<256, 256, 0, stream>>>(in[17], in[18], in[19], gu, dt, w); break;
            case 5: ck_gnorm<<<128, 64, 0, stream>>>(buf2, proj, in[6], hn, w); break;
            case 6: ck_gemm_res<<<64, 64, 0, stream>>>(hn, wgo, in[0], 0, xres, w); break;
            case 7: ck_norm<<<64, 64, 0, stream>>>(xres, in[2], hn, w); ck_route<<<8, 64, 0, stream>>>(xres, in[2], in[15], in[16], tok_e, tok_p, tok_w, ctl + CW_CNT0, w); break;
            case 8: ck_gather<<<128, 64, 0, stream>>>(tok_e, tok_p, slot_of, ctl + CW_CNT0, hn, (const int*)(ws + WS_STOK), w); break;
            case 9: ck_moe1<<<128, 64, 0, stream>>>(tok_e, slot_of, hn, in[17], in[18], hh, w); break;
            case 10: ck_moe2<<<128, 64, 0, stream>>>(tok_e, slot_of, hh, in[19], ob, w); ck_save<<<64, 256, 0, stream>>>(xres, save); break;
            case 11: ck_combine<<<32, 64, 0, stream>>>(save, ob, slot_of, tok_w, in[1] + D, xres, hn, 0, w); ck_moew<<<256, 256, 0, stream>>>(in[17] + L1W, in[18] + L1W, in[19] + L1W, gu, dt, w); break;
            case 12: ck_proj<<<256, 64, 0, stream>>>(hn, wdi, proj, 1, w); break;
            case 13: ck_attn<<<96, 64, 0, stream>>>(proj, buf1, buf2, w); break;
            case 14: ck_subln<<<128, 64, 0, stream>>>(buf1, buf2, in[9], in[10], in[11], in[12], in[13], hn, w); ck_save<<<64, 256, 0, stream>>>(xres, save); break;
            case 15: ck_gemm_res<<<64, 64, 0, stream>>>(hn, wdo, save, 1, xres, w); break;
            case 16: ck_norm<<<64, 64, 0, stream>>>(xres, in[2] + D, hn, w); ck_route<<<8, 64, 0, stream>>>(xres, in[2] + D, in[15] + (size_t)D * 4, in[16] + (size_t)D * 32, tok_e, tok_p, tok_w, ctl + CW_CNT1, w); break;
            case 17: ck_gather<<<128, 64, 0, stream>>>(tok_e, tok_p, slot_of, ctl + CW_CNT1, hn, (const int*)(ws + WS_STOK), w); break;
            case 18: ck_moe1<<<128, 64, 0, stream>>>(tok_e, slot_of, hn, in[17] + L1W, in[18] + L1W, hh, w); break;
            case 19: ck_moe2<<<128, 64, 0, stream>>>(tok_e, slot_of, hh, in[19] + L1W, ob, w); ck_save<<<64, 256, 0, stream>>>(xres, save); break;
            case 20: ck_combine<<<32, 64, 0, stream>>>(save, ob, slot_of, tok_w, in[20], xres, hn, 1, w); break;
            }
        }
        ck_final<<<1024, 256, 0, stream>>>(words, 21, (float*)d_out, out_size);
    }
#endif
}
```

```cpp
#ifndef REP_PHASE
#define REP_PHASE -1
#endif
#include <hip/hip_runtime.h>
#include <cstdio>
#include <cstdint>

#define LAS __attribute__((address_space(3)))
#define GAS __attribute__((address_space(1)))
typedef unsigned short bf16_t;
typedef short bf16x8 __attribute__((ext_vector_type(8)));
typedef short s16x4 __attribute__((ext_vector_type(4)));
typedef float f32x4 __attribute__((ext_vector_type(4)));
typedef float f32x2 __attribute__((ext_vector_type(2)));
typedef float f32x16 __attribute__((ext_vector_type(16)));
typedef unsigned u32x4 __attribute__((ext_vector_type(4)));
typedef unsigned u32x2 __attribute__((ext_vector_type(2)));

constexpr int D = 2048, SEQ = 16384, NBATCH = 2, T = NBATCH * SEQ, CHUNK = 64, NCH = SEQ / CHUNK;
constexpr int GLA_H = 4, GLA_DK = 256, GLA_DV = 512, GLA_DKT = 1024, GLA_INW = 6160, PROJW = 6144;
constexpr int DIFF_H = 8;
constexpr int NEXP = 32, DFF = 512;
constexpr float RMS_EPS = 1e-6f;
constexpr float LAMBDA_INIT = 0.35550906759f;
constexpr int MAX_TILES = 288;

constexpr size_t MiB = 1u << 20;
constexpr size_t WS_CTL = 0, CTL_ZERO_BYTES = 1 * MiB;
constexpr size_t WS_GZ = 2 * MiB;
constexpr size_t WS_TOKE = 4 * MiB;
constexpr size_t WS_TOKP = WS_TOKE + 256 * 1024;
constexpr size_t WS_TOKW = WS_TOKP + 256 * 1024;
constexpr size_t WS_SLOT = WS_TOKW + 256 * 1024;
constexpr size_t WS_STOK = 5 * MiB;
constexpr size_t WS_ADEC = 8 * MiB;
constexpr size_t WS_WPGZ = 10 * MiB;
constexpr size_t WS_WPR0 = 10 * MiB + 256 * 1024;
constexpr size_t WS_WPR1 = 11 * MiB;
constexpr size_t WS_NRM = 12 * MiB;
constexpr size_t WS_PCUM = 13 * MiB;
constexpr size_t WS_SFIN = 14 * MiB;
constexpr size_t WS_WGI = 16 * MiB, WS_WGO = 40 * MiB, WS_WDI = 48 * MiB, WS_WDO = 72 * MiB;
constexpr size_t WS_WMOE = 80 * MiB;
constexpr size_t WS_WMOE_D = WS_WMOE + 128 * MiB;
constexpr size_t WS_WMOE1 = WS_WMOE + 64 * MiB, WS_WMOE1_D = WS_WMOE + 160 * MiB;
constexpr size_t WS_HN = 272 * MiB;
constexpr size_t WS_PROJ = 400 * MiB;
constexpr size_t WS_BUF1 = 784 * MiB;
constexpr size_t WS_BUF2 = 912 * MiB;
constexpr size_t WS_AG = 400 * MiB;
constexpr size_t WS_OB = 688 * MiB;
constexpr size_t WS_H = 976 * MiB;
constexpr size_t WS_END = 1048 * MiB;
constexpr int CW_BAR = 4096;
constexpr int CW_QUEUE = 8192;
constexpr int CW_CNT0 = 16384, CW_CNT1 = 16384 + 32 * 64;


constexpr size_t GK0 = (size_t)T * 1024, GV0 = (size_t)T * 2048, GR0 = (size_t)T * 4096;
constexpr size_t DK0 = (size_t)T * 2048, DV0 = (size_t)T * 4096;
__host__ __device__ __forceinline__ size_t gq_off(int b, int t, int h) { return ((size_t)(b * 4 + h) * SEQ + t) * 256; }
__host__ __device__ __forceinline__ size_t gv_off(int b, int t, int h) { return GV0 + ((size_t)(b * 4 + h) * SEQ + t) * 512; }
__host__ __device__ __forceinline__ size_t dq_off(int b, int t, int h, int sub) { return ((size_t)((b * 8 + h) * 2 + sub) * SEQ + t) * 128; }
__host__ __device__ __forceinline__ size_t dv_off(int b, int t, int h) { return DV0 + ((size_t)(b * 8 + h) * SEQ + t) * 256; }

constexpr int RING_BYTES = 131072;
constexpr int LDSCTL_OFF = RING_BYTES;
constexpr int MISC_OFF = LDSCTL_OFF + 320;
constexpr int TIDS_OFF = LDSCTL_OFF + 8192;
constexpr int TAB_OFF = LDSCTL_OFF + 1024;
constexpr int LDS_BYTES = 147456;
constexpr int NWAVES = 8;

typedef __bf16 bf16x2_t __attribute__((ext_vector_type(2)));
__device__ __forceinline__ unsigned cvt_pk_bf16(float lo, float hi) { const f32x2 v = {lo, hi}; return __builtin_bit_cast(unsigned, __builtin_convertvector(v, bf16x2_t)); }
__device__ __forceinline__ unsigned cvt4_fp8(float a, float b, float c, float d) { int v = __builtin_amdgcn_cvt_pk_fp8_f32(a, b, 0, false); return (unsigned)__builtin_amdgcn_cvt_pk_fp8_f32(c, d, v, true); }
constexpr float W8_SCALE = 64.f;
__device__ __forceinline__ float bf_lo(unsigned w) { return __uint_as_float(w << 16); }
__device__ __forceinline__ float bf_hi(unsigned w) { return __uint_as_float(w & 0xffff0000u); }
__device__ __forceinline__ float bf2f(bf16_t b) { return __uint_as_float(((unsigned)b) << 16); }
__device__ __forceinline__ float wave_sum(float v) {
#pragma unroll
    for (int o = 1; o < 64; o <<= 1) v += __shfl_xor(v, o);
    return v;
}
__device__ __forceinline__ int lane_id() { return (int)__builtin_amdgcn_mbcnt_hi(~0u, __builtin_amdgcn_mbcnt_lo(~0u, 0u)); }
__device__ __forceinline__ int lane_id_volatile() { int l; asm volatile("v_mbcnt_lo_u32_b32 %0, -1, 0\n\tv_mbcnt_hi_u32_b32 %0, -1, %0" : "=v"(l)); return l; }
__device__ __forceinline__ int opq(int v) { asm volatile("" : "+v"(v)); return v; }
#define LDS_WAIT() asm volatile("s_waitcnt lgkmcnt(0)" ::: "memory")
#define VM_WAIT() asm volatile("s_waitcnt vmcnt(0)" ::: "memory")
#define WG_BAR() do { asm volatile("s_waitcnt lgkmcnt(0)" ::: "memory"); __builtin_amdgcn_s_barrier(); asm volatile("" ::: "memory"); } while (0)

namespace pg8 {
constexpr int BM = 256, BK = 64, HALF = 128, HTB = HALF * BK * 2, STAGE_BYTES = 8 * HTB, NXCD = 8, WGM = 8;
__host__ __device__ __forceinline__ int lds_byte(int r, int c) { const int st = (r >> 4) * 2 + (c >> 5), rr = r & 15, cc = c & 31, ob = rr * 64 + cc * 2; return st * 1024 + (ob ^ (((ob >> 9) & 1) << 5)); }
__host__ __device__ __forceinline__ void stage_rc(int b, int& R, int& C) { const int st = b / 1024, sb = b % 1024, swz = sb ^ (((sb >> 9) & 1) << 5); R = (st >> 1) * 16 + swz / 64; C = (st & 1) * 32 + (swz % 64) / 2; }
__host__ __device__ __forceinline__ int perm32(int rho) { const int n = rho >> 4, i = rho & 15; return 8 * (i >> 2) + 4 * n + (i & 3); }

struct Unit { int pm, pn; };
struct Gemm { const bf16_t* A; const bf16_t* Bt; int M, N, K; };

struct StaticOrder {
    int nM, nN, nwg, G, c;
    __device__ void init(int M, int N, int G_, int c_) { nM = M / BM; nN = N / BM; nwg = nM * nN; G = G_; c = c_; }
    __device__ bool next(int i, Unit& u) const {
        const long L = (long)i * G + c; if (L >= nwg) return false;
        int wgid = (int)L; { const int q = nwg / NXCD, r = nwg % NXCD, xcd = wgid % NXCD, off = wgid / NXCD; wgid = (xcd < r ? xcd * (q + 1) : r * (q + 1) + (xcd - r) * q) + off; }
        const int nig = WGM * nN, gid = wgid / nig, fm = gid * WGM, gsz = (nM - fm) < WGM ? (nM - fm) : WGM;
        u.pm = fm + ((wgid % nig) % gsz); u.pn = (wgid % nig) / gsz; return true;
    }
    __device__ __forceinline__ size_t bofs(const Unit&) const { return 0; }
};
struct MoeOrder : StaticOrder {
    const LAS int* te; size_t estride; const int* stok;
    __device__ __forceinline__ size_t bofs(const Unit& u) const { return (size_t)te[u.pm] * estride; }
    __device__ __forceinline__ int arow(int pm, int r) const { const int t = stok[pm * BM + r]; return t < 0 ? 0 : t; }
};

struct EpiBf16 {
    static constexpr bool PERM = true;
    bf16_t* O; int ldc;
    __device__ __forceinline__ void operator()(const f32x4 (&acc)[2][2][4][2], const Unit& u, int wr, int wc, int fr, int fq) const {
        const int row0 = u.pm * BM + wr * 64 + fr, col0 = u.pn * BM + wc * 32 + 8 * fq;
#pragma unroll
        for (int ai = 0; ai < 2; ++ai)
#pragma unroll
            for (int m = 0; m < 4; ++m) { bf16_t* rowp = O + (size_t)(row0 + ai * HALF + m * 16) * ldc + col0;
#pragma unroll
                for (int bj = 0; bj < 2; ++bj) { const f32x4 v0 = acc[ai][bj][m][0], v1 = acc[ai][bj][m][1];
                    u32x4 w; w.x = cvt_pk_bf16(v0[0], v0[1]); w.y = cvt_pk_bf16(v0[2], v0[3]); w.z = cvt_pk_bf16(v1[0], v1[1]); w.w = cvt_pk_bf16(v1[2], v1[3]);
                    *(u32x4*)(rowp + bj * HALF) = w; } }
    }
};
template <int LAYER> struct EpiHeads {
    static constexpr bool PERM = true;
    bf16_t* O;
    __device__ __forceinline__ void operator()(const f32x4 (&acc)[2][2][4][2], const Unit& u, int wr, int wc, int fr, int fq) const {
        const int pn = u.pn, lc = wc * 32 + 8 * fq;
#pragma unroll
        for (int ai = 0; ai < 2; ++ai)
#pragma unroll
            for (int m = 0; m < 4; ++m) { const int row = u.pm * BM + ai * HALF + wr * 64 + m * 16 + fr, b = row >> 14, t = row & (SEQ - 1);
#pragma unroll
                for (int bj = 0; bj < 2; ++bj) { size_t off;
                    if (LAYER == 0) { if (pn < 4) off = gq_off(b, t, pn) + bj * 128 + lc; else if (pn < 8) off = GK0 + gq_off(b, t, pn - 4) + bj * 128 + lc;
                                      else if (pn < 16) off = gv_off(b, t, (pn - 8) >> 1) + ((pn - 8) & 1) * 256 + bj * 128 + lc; else off = GR0 + (size_t)row * 2048 + (pn - 16) * 256 + bj * 128 + lc; }
                    else { if (pn < 8) off = dq_off(b, t, pn, bj) + lc; else if (pn < 16) off = DK0 + dq_off(b, t, pn - 8, bj) + lc; else off = dv_off(b, t, pn - 16) + bj * 128 + lc; }
                    const f32x4 v0 = acc[ai][bj][m][0], v1 = acc[ai][bj][m][1];
                    u32x4 w; w.x = cvt_pk_bf16(v0[0], v0[1]); w.y = cvt_pk_bf16(v0[2], v0[3]); w.z = cvt_pk_bf16(v1[0], v1[1]); w.w = cvt_pk_bf16(v1[2], v1[3]);
                    *(u32x4*)(O + off) = w; } }
    }
};
struct FixOrder : StaticOrder {
    __device__ __forceinline__ size_t bofs(const Unit& u) const { return (size_t)(u.pm >> 5) * (512 * 256 * 2); }
};
struct EpiAddO {
    static constexpr bool PERM = true;
    bf16_t* O;
    __device__ __forceinline__ void operator()(const f32x4 (&acc)[2][2][4][2], const Unit& u, int wr, int wc, int fr, int fq) const {
#pragma unroll
        for (int ai = 0; ai < 2; ++ai)
#pragma unroll
            for (int m = 0; m < 4; ++m) { const int row = u.pm * BM + ai * HALF + wr * 64 + m * 16 + fr, bhh = row >> 13, t = row & 8191;
                bf16_t* rowp = O + ((size_t)(bhh >> 2) * SEQ + SEQ / 2 + t) * D + (bhh & 3) * 512 + u.pn * BM + wc * 32 + 8 * fq;
#pragma unroll
                for (int bj = 0; bj < 2; ++bj) { const u32x4 old = *(const u32x4*)(rowp + bj * HALF); const f32x4 v0 = acc[ai][bj][m][0] * 0.0625f, v1 = acc[ai][bj][m][1] * 0.0625f;
                    u32x4 w; w.x = cvt_pk_bf16(bf_lo(old.x) + v0[0], bf_hi(old.x) + v0[1]); w.y = cvt_pk_bf16(bf_lo(old.y) + v0[2], bf_hi(old.y) + v0[3]);
                    w.z = cvt_pk_bf16(bf_lo(old.z) + v1[0], bf_hi(old.z) + v1[1]); w.w = cvt_pk_bf16(bf_lo(old.w) + v1[2], bf_hi(old.w) + v1[3]);
                    *(u32x4*)(rowp + bj * HALF) = w; } }
    }
};
struct EpiResF32 {
    static constexpr bool PERM = false;
    const float* base; float* C; int ldc;
    __device__ __forceinline__ void operator()(const f32x4 (&acc)[2][2][4][2], const Unit& u, int wr, int wc, int fr, int fq) const {
        const int row0 = u.pm * BM + wr * 64 + fr, col0 = u.pn * BM + wc * 32 + 4 * fq;
#pragma unroll
        for (int ai = 0; ai < 2; ++ai)
#pragma unroll
            for (int m = 0; m < 4; ++m) { const size_t off = (size_t)(row0 + ai * HALF + m * 16) * ldc + col0;
#pragma unroll
                for (int bj = 0; bj < 2; ++bj)
#pragma unroll
                    for (int n = 0; n < 2; ++n) { const f32x4 bs = *(const f32x4*)(base + off + bj * HALF + n * 16); *(f32x4*)(C + off + bj * HALF + n * 16) = bs + acc[ai][bj][m][n]; }
                asm volatile("" ::: "memory"); }
    }
};
struct EpiSiluMul {
    static constexpr bool PERM = true;
    unsigned char* Hh;
    __device__ __forceinline__ void operator()(const f32x4 (&acc)[2][2][4][2], const Unit& u, int wr, int wc, int fr, int fq) const {
        const int row0 = u.pm * BM + wr * 64 + fr, col0 = u.pn * HALF + wc * 32 + 8 * fq;
#pragma unroll
        for (int ai = 0; ai < 2; ++ai)
#pragma unroll
            for (int m = 0; m < 4; ++m) { unsigned char* rowp = Hh + (size_t)(row0 + ai * HALF + m * 16) * DFF + col0;
                float hv[8];
#pragma unroll
                for (int n = 0; n < 2; ++n)
#pragma unroll
                    for (int j = 0; j < 4; ++j) { const float g = acc[ai][0][m][n][j], up = acc[ai][1][m][n][j];
                        const float sg = g * __builtin_amdgcn_rcpf(1.0f + __builtin_amdgcn_exp2f(-1.4426950408889634f * g)); hv[n * 4 + j] = sg * up; }
                u32x2 w; w.x = cvt4_fp8(hv[0], hv[1], hv[2], hv[3]); w.y = cvt4_fp8(hv[4], hv[5], hv[6], hv[7]);
                *(u32x2*)rowp = w; }
    }
};

typedef int v8i32 __attribute__((ext_vector_type(8)));
typedef int v4i32 __attribute__((ext_vector_type(4)));
template <class Epi, class Sched, bool GATHER = false, bool FP8 = false>
__device__ __forceinline__ void gemm_phase(LAS unsigned char* lds, const Gemm g, const Sched& S, const Epi& E, int tid_in) {
    const int tid = opq(tid_in), wid = __builtin_amdgcn_readfirstlane(tid >> 6), lane = tid & 63, wr = wid >> 2, wc = wid & 3, fr = lane & 15, fq = lane >> 4;
    const int K = g.K, RP = FP8 ? K : 2 * K  , nt = RP / (BK * 2);
    unsigned voffA[2], voffB[2];
#pragma unroll
    for (int i = 0; i < 2; ++i) { int R, C; stage_rc(tid * 16 + i * 8192, R, C); const int Rb = Epi::PERM ? ((R & ~31) + perm32(R & 31)) : R;
        voffA[i] = (unsigned)(R * RP + 2 * C); voffB[i] = (unsigned)(Rb * RP + 2 * C); }
    const unsigned kstep = (unsigned)(BK * 2);
    const unsigned hstep = (unsigned)HALF * (unsigned)RP;
    const size_t tstep = 2 * (size_t)hstep;
    const unsigned ldsw = (unsigned)wid * 1024u;
    const int aoff = lds_byte(wr * 64 + fr, fq * 8), boff = lds_byte(wc * 32 + fr, fq * 8);
    const LAS unsigned char* ldsB = lds + 4 * HTB + boff;
#define PG8_SA(b, h) (((b) * 2 + (h)) * HTB)
#define PG8_SB(b, h) ((4 + (b) * 2 + (h)) * HTB)
#define PG8_STAGE(bufoff, gbase, voff) do { const unsigned long long gv_ = (unsigned long long)(gbase); \
        const unsigned glo_ = (unsigned)__builtin_amdgcn_readfirstlane((unsigned)gv_), ghi_ = (unsigned)__builtin_amdgcn_readfirstlane((unsigned)(gv_ >> 32)); const char* gb_ = (const char*)(((unsigned long long)ghi_ << 32) | (unsigned long long)glo_);     \
        _Pragma("unroll") for (int _i = 0; _i < 2; ++_i) \
        __builtin_amdgcn_global_load_lds((const unsigned*)(gb_ + (voff)[_i]), (LAS unsigned*)(lds + (bufoff) + ldsw + _i * 8192), 16, 0, 0); } while (0)
#define PG8_STAGE_A(bufoff, nx, koff, h) do { if constexpr (GATHER) { unsigned vs_[2]; _Pragma("unroll") for (int _i = 0; _i < 2; ++_i) vs_[_i] = (nx) ? vAn[h][_i] : vAc[h][_i]; \
            PG8_STAGE(bufoff, (const char*)g.A + (koff), vs_); } \
        else { PG8_STAGE(bufoff, ((nx) ? nA : cA) + (koff) + (h) * hstep, voffA); } } while (0)
#define PG8_LD8(off) __builtin_shufflevector(*(const LAS v4i32*)(lds + (off)), *(const LAS v4i32*)(lds + (off) + 1024), 0, 1, 2, 3, 4, 5, 6, 7)
#define PG8_LDA(dst, b, h) do { if constexpr (FP8) { _Pragma("unroll") for (int m = 0; m < 4; ++m) dst##8[m] = PG8_LD8(PG8_SA(b, h) + aoff + m * 2048); } \
        else { _Pragma("unroll") for (int m = 0; m < 4; ++m) _Pragma("unroll") for (int k = 0; k < 2; ++k) dst[m][k] = *(const LAS bf16x8*)(lds + PG8_SA(b, h) + aoff + m * 2048 + k * 1024); } } while (0)
#define PG8_LD8B(off) __builtin_shufflevector(*(const LAS v4i32*)(ldsB + (off)), *(const LAS v4i32*)(ldsB + (off) + 1024), 0, 1, 2, 3, 4, 5, 6, 7)
#define PG8_LDB(dst, b, h) do { if constexpr (FP8) { _Pragma("unroll") for (int n = 0; n < 2; ++n) dst##8[n] = PG8_LD8B(PG8_SA(b, h) + n * 2048); }     \
        else { _Pragma("unroll") for (int n = 0; n < 2; ++n) _Pragma("unroll") for (int k = 0; k < 2; ++k) dst[n][k] = *(const LAS bf16x8*)(lds + PG8_SB(b, h) + boff + n * 2048 + k * 1024); } } while (0)
#define PG8_MMA(ai, bj, At, Bt) do { __builtin_amdgcn_s_setprio(1); if constexpr (FP8) { _Pragma("unroll") for (int m = 0; m < 4; ++m) _Pragma("unroll") for (int n = 0; n < 2; ++n) \
              \
            asm volatile("v_mfma_scale_f32_16x16x128_f8f6f4 %0, %1, %2, %0, %3, %3 op_sel:[0,1,0] op_sel_hi:[0,0,0]" : "+v"(acc[ai][bj][m][n]) : "v"(Bt##8[n]), "v"(At##8[m]), "v"(scl8)); } \
        else { _Pragma("unroll") for (int m = 0; m < 4; ++m) _Pragma("unroll") for (int n = 0; n < 2; ++n) _Pragma("unroll") for (int k = 0; k < 2; ++k) \
            acc[ai][bj][m][n] = __builtin_amdgcn_mfma_f32_16x16x32_bf16(Bt[n][k], At[m][k], acc[ai][bj][m][n], 0, 0, 0); } __builtin_amdgcn_s_setprio(0); } while (0)
#define PG8_WAIT_V(n) asm volatile("s_waitcnt vmcnt(" #n ")" ::: "memory")
#define PG8_WAIT_L(n) asm volatile("s_waitcnt lgkmcnt(" #n ")" ::: "memory")
#define PG8_BAR __builtin_amdgcn_s_barrier()
#define PG8_SCHED __builtin_amdgcn_sched_barrier(0)
#define PG8_ROWOFFS(V, U) do { if constexpr (GATHER) { const int t_ = opq(wid * 64 + lane_id());     \
        _Pragma("unroll") for (int i_ = 0; i_ < 2; ++i_) { int R_, C_; stage_rc(t_ * 16 + i_ * 8192, R_, C_); \
        _Pragma("unroll") for (int h_ = 0; h_ < 2; ++h_) V[h_][i_] = (unsigned)S.arow((U).pm, h_ * HALF + R_) * (unsigned)RP + 2u * (unsigned)C_; } } } while (0)
    Unit cur, nxt; int ui = 0;
    if (!S.next(0, cur)) return;
    f32x4 acc[2][2][4][2];
#pragma unroll
    for (int a = 0; a < 2; ++a)
#pragma unroll
        for (int b = 0; b < 2; ++b)
#pragma unroll
            for (int m = 0; m < 4; ++m)
#pragma unroll
                for (int n = 0; n < 2; ++n) acc[a][b][m][n] = (f32x4){0.f, 0.f, 0.f, 0.f};
    const unsigned scl8 = 0x7f797f79u;
    bf16x8 At[4][2], B0[2][2], B1[2][2]; v8i32 At8[4], B08[2], B18[2];
    unsigned vAc[2][2] = {{0u, 0u}, {0u, 0u}}, vAn[2][2] = {{0u, 0u}, {0u, 0u}};
    const char* cA = (const char*)g.A + (GATHER ? (size_t)0 : (size_t)cur.pm * tstep); const char* nA = cA; const char* cB = (const char*)g.Bt + S.bofs(cur) + (size_t)cur.pn * tstep;
    PG8_ROWOFFS(vAc, cur);
    PG8_STAGE(PG8_SB(0, 0), cB, voffB); PG8_STAGE(PG8_SB(0, 1), cB + hstep, voffB); PG8_STAGE_A(PG8_SA(0, 0), false, 0u, 0); PG8_STAGE_A(PG8_SA(0, 1), false, 0u, 1);
    if (wr == 1) PG8_BAR;
    PG8_WAIT_V(2); PG8_BAR;
    PG8_STAGE(PG8_SB(1, 0), cB + kstep, voffB); PG8_STAGE_A(PG8_SA(1, 0), false, kstep, 0); PG8_STAGE(PG8_SB(1, 1), cB + hstep + kstep, voffB);
    PG8_WAIT_V(6); PG8_BAR;
    for (;;) {
        const bool has_next = S.next(ui + 1, nxt);
        nA = (has_next && !GATHER) ? (const char*)g.A + (size_t)nxt.pm * tstep : cA; const char* nB = has_next ? (const char*)g.Bt + S.bofs(nxt) + (size_t)nxt.pn * tstep : cB;

        for (int t = 0; t < nt; t += 2) {
            const bool last = (t == nt - 2);
            if constexpr (GATHER) { if (last) {
                if (has_next) PG8_ROWOFFS(vAn, nxt); else { _Pragma("unroll") for (int h_ = 0; h_ < 2; ++h_) _Pragma("unroll") for (int i_ = 0; i_ < 2; ++i_) vAn[h_][i_] = vAc[h_][i_]; } } }
            const unsigned k1 = (unsigned)(t + 1) * kstep, k2 = last ? 0u : (unsigned)(t + 2) * kstep, k3 = k2 + kstep;
            const char* b2 = last ? nB : cB + k2; const char* b3 = b2 + kstep;
            PG8_LDB(B0, 0, 0); PG8_LDB(B1, 0, 1); PG8_SCHED; PG8_LDA(At, 0, 0); PG8_STAGE_A(PG8_SA(1, 1), false, k1, 1);
            PG8_WAIT_V(8); PG8_WAIT_L(0); PG8_BAR; PG8_MMA(0, 0, At, B0); PG8_MMA(0, 1, At, B1); PG8_BAR; PG8_SCHED;
            PG8_LDA(At, 0, 1); PG8_STAGE(PG8_SB(0, 0), b2, voffB); PG8_STAGE(PG8_SB(0, 1), b2 + hstep, voffB); PG8_STAGE_A(PG8_SA(0, 0), last, k2, 0);
            PG8_WAIT_V(8); PG8_WAIT_L(0); PG8_BAR; PG8_MMA(1, 0, At, B0); PG8_MMA(1, 1, At, B1); PG8_BAR; PG8_SCHED;
            PG8_LDB(B0, 1, 0); PG8_LDB(B1, 1, 1); PG8_SCHED; PG8_LDA(At, 1, 0); PG8_STAGE_A(PG8_SA(0, 1), last, k2, 1);
            PG8_WAIT_V(8); PG8_WAIT_L(0); PG8_BAR; PG8_MMA(0, 0, At, B0); PG8_MMA(0, 1, At, B1); PG8_BAR; PG8_SCHED;
            PG8_LDA(At, 1, 1); PG8_STAGE(PG8_SB(1, 0), b3, voffB); PG8_STAGE(PG8_SB(1, 1), b3 + hstep, voffB); PG8_STAGE_A(PG8_SA(1, 0), last, k3, 0);
            PG8_WAIT_V(8); PG8_WAIT_L(0); PG8_BAR; PG8_MMA(1, 0, At, B0); PG8_MMA(1, 1, At, B1); PG8_BAR; PG8_SCHED;
        }
        if (wr == 0) PG8_BAR;
        E(acc, cur, wr, wc, fr, fq);
        if (!has_next) break;
#pragma unroll
        for (int a = 0; a < 2; ++a)
#pragma unroll
            for (int b = 0; b < 2; ++b)
#pragma unroll
                for (int m = 0; m < 4; ++m)
#pragma unroll
                    for (int n = 0; n < 2; ++n) acc[a][b][m][n] = (f32x4){0.f, 0.f, 0.f, 0.f};
        cur = nxt; cA = nA; cB = nB; ++ui;
        if constexpr (GATHER) { _Pragma("unroll") for (int h_ = 0; h_ < 2; ++h_) _Pragma("unroll") for (int i_ = 0; i_ < 2; ++i_) vAc[h_][i_] = vAn[h_][i_]; }
        if (wr == 1) PG8_BAR;
    }
    PG8_WAIT_V(0);
    PG8_BAR;
#undef PG8_SA
#undef PG8_SB
#undef PG8_STAGE
#undef PG8_STAGE_A
#undef PG8_ROWOFFS
#undef PG8_LDA
#undef PG8_LDB
#undef PG8_MMA
#undef PG8_LD8
#undef PG8_LD8B
#undef PG8_WAIT_V
#undef PG8_WAIT_L
#undef PG8_BAR
#undef PG8_SCHED
}
}

#define XB_TMO      128
#define XB_XCNT(j)  (256  + 64 * (j))
#define XB_XSUB(j)  (1280 + 64 * (j))
#define XB_XGEN(j)  (2304 + 64 * (j))
#define XB_TOP      3328
#define XB_TOPGEN   3392
#define XCD_BAR_WORDS 3456
#define XB_SPIN_CAP (1u << 18)
__device__ __forceinline__ unsigned xb_ld(unsigned* p)              { return __hip_atomic_load(p, __ATOMIC_RELAXED, __HIP_MEMORY_SCOPE_AGENT); }
__device__ __forceinline__ unsigned xb_add(unsigned* p, unsigned v) { return __hip_atomic_fetch_add(p, v, __ATOMIC_RELAXED, __HIP_MEMORY_SCOPE_AGENT); }
__device__ __forceinline__ unsigned xb_xcc_id() { return (unsigned)__builtin_amdgcn_s_getreg((3 << 11) | 20) & 0xFu; }
#define XB_SPIN(cond, bar) do { unsigned _sp = 0; while (cond) { __builtin_amdgcn_s_sleep(1); \
    if ((++_sp & 255u) == 0u) { if (xb_ld(&(bar)[XB_TMO])) break; if (_sp > XB_SPIN_CAP) { atomicAdd(&(bar)[XB_TMO], 1u); break; } } } } while (0)
struct XcdBarrier { unsigned* bar; unsigned x; volatile LAS unsigned* st; int wave; };
__device__ __forceinline__ XcdBarrier xcd_barrier_post(unsigned* bar, volatile LAS unsigned* st) {
    XcdBarrier b; b.bar = bar; b.x = xb_xcc_id(); b.st = st; b.wave = __builtin_amdgcn_readfirstlane((int)threadIdx.x >> 6);
    if (threadIdx.x == 0) (void)xb_add(&bar[XB_XCNT(b.x)], 1u);
    return b;
}
__device__ __forceinline__ void xcd_barrier_complete(unsigned* bar, unsigned x, unsigned& nloc, unsigned& nx) {
    const unsigned G = gridDim.x * gridDim.y * gridDim.z;
    unsigned sum, cnt, mine, sp = 0u;
    for (;;) {
        sum = 0u; cnt = 0u; mine = 0u;
#pragma unroll
        for (unsigned j = 0; j < 16; ++j) { const unsigned c = xb_ld(&bar[XB_XCNT(j)]); sum += c; cnt += (c > 0u) ? 1u : 0u; mine = (j == x) ? c : mine; }
        if (sum == G) break;
        __builtin_amdgcn_s_sleep(1);
        if ((++sp & 255u) == 0u) { if (xb_ld(&bar[XB_TMO])) break; if (sp > XB_SPIN_CAP) { atomicAdd(&bar[XB_TMO], 1u); break; } }
    }
    nloc = mine > 0u ? mine : 1u; nx = cnt > 0u ? cnt : 1u;
}
__device__ __forceinline__ void xcd_barrier(const XcdBarrier& b, bool leader  ) {
    asm volatile("s_waitcnt vmcnt(0)" ::: "memory");
    __syncthreads();
    if (leader) {
        unsigned* bar = b.bar;
        __builtin_amdgcn_s_waitcnt(0);
        unsigned nloc = b.st[0], nx = b.st[1];
        if (nloc == 0u) { xcd_barrier_complete(bar, b.x, nloc, nx); b.st[0] = nloc; b.st[1] = nx; }
        const unsigned old = xb_add(&bar[XB_XSUB(b.x)], 1u);
        const unsigned gen = old / nloc;
        if (old + 1u == (gen + 1u) * nloc) {
            __builtin_amdgcn_fence(__ATOMIC_RELEASE, "agent");
            asm volatile("s_waitcnt vmcnt(0)" ::: "memory");
            const unsigned og = xb_add(&bar[XB_TOP], 1u);
            const unsigned tg = og / nx;
            if (og + 1u == (tg + 1u) * nx) xb_add(&bar[XB_TOPGEN], 1u);
            else XB_SPIN(xb_ld(&bar[XB_TOPGEN]) == tg, bar);
            __builtin_amdgcn_fence(__ATOMIC_ACQUIRE, "agent");
            xb_add(&bar[XB_XGEN(b.x)], 1u);
            asm volatile("s_waitcnt vmcnt(0)" ::: "memory");
        } else {
            XB_SPIN(xb_ld(&bar[XB_XGEN(b.x)]) == gen, bar);
            __builtin_amdgcn_fence(__ATOMIC_ACQUIRE, "agent");
            asm volatile("s_waitcnt vmcnt(0)" ::: "memory");
        }
    }
    __syncthreads();
}

struct Frame {
    LAS unsigned char* lds;
    int tid, lane, wave, vcu, G;
};
struct Args {
    const float* in[21]; float* out; unsigned char* ws; int pad0, pad1;
};

template <bool FP8 = false>
__device__ __forceinline__ void transpose_item(const float* W, int ldw, int k0, int n0, bf16_t* WT, int ldk, int drow0, LAS float* scr, int lane) {
    float tv[32];
    const float* wp_ = W + (size_t)(k0 + (lane >> 5)) * ldw + n0 + (lane & 31);
#pragma unroll
    for (int i = 0; i < 32; ++i) tv[i] = wp_[(size_t)(2 * i) * ldw];
#pragma unroll
    for (int i = 0; i < 32; ++i) scr[(2 * i + (lane >> 5)) * 33 + (lane & 31)] = tv[i];
    LDS_WAIT(); asm volatile("" ::: "memory");
    const int c = lane & 7;
#pragma unroll
    for (int j = 0; j < 4; ++j) { const int n = (lane >> 3) + 8 * j; const LAS float* s = scr + (8 * c) * 33 + n;
        if constexpr (FP8) { u32x2 o; o.x = cvt4_fp8(s[0 * 33] * W8_SCALE, s[1 * 33] * W8_SCALE, s[2 * 33] * W8_SCALE, s[3 * 33] * W8_SCALE); o.y = cvt4_fp8(s[4 * 33] * W8_SCALE, s[5 * 33] * W8_SCALE, s[6 * 33] * W8_SCALE, s[7 * 33] * W8_SCALE);
            *(u32x2*)((unsigned char*)WT + (size_t)(drow0 + n) * ldk + k0 + 8 * c) = o; }
        else { u32x4 o; o.x = cvt_pk_bf16(s[0 * 33], s[1 * 33]); o.y = cvt_pk_bf16(s[2 * 33], s[3 * 33]); o.z = cvt_pk_bf16(s[4 * 33], s[5 * 33]); o.w = cvt_pk_bf16(s[6 * 33], s[7 * 33]);
            *(u32x4*)(WT + (size_t)(drow0 + n) * ldk + k0 + 8 * c) = o; } }
    LDS_WAIT(); asm volatile("" ::: "memory");
}
template <bool FP8 = false>
__device__ __forceinline__ void conv_plain(Frame& F, const float* W, int K, int N, int ldw, bf16_t* WT, int rank = -1, int nrank = 0) {
    LAS float* scr = (LAS float*)(F.lds + F.wave * 16384);
    const int gw = (rank < 0 ? F.vcu : rank) * NWAVES + F.wave, NGW = (rank < 0 ? F.G : nrank) * NWAVES, nblk = N / 32, nit = (K / 64) * nblk;
    for (int it = gw; it < nit; it += NGW) { const int kb = it / nblk, nb = it % nblk; transpose_item<FP8>(W, ldw, 64 * kb, 32 * nb, WT, K, 32 * nb, scr, F.lane); }
}
__device__ __forceinline__ void conv_moe(Frame& F, const float* wg, const float* wu, const float* wd, bf16_t* GU, bf16_t* DT, int rank = -1, int nrank = 0) {
    LAS float* scr = (LAS float*)(F.lds + F.wave * 16384);
    const int gw = (rank < 0 ? F.vcu : rank) * NWAVES + F.wave, NGW = (rank < 0 ? F.G : nrank) * NWAVES;
    constexpr int PER_E = 1536, NIT = NEXP * PER_E;
    for (int it = gw; it < NIT; it += NGW) {
        const int e = it / PER_E; int r = it % PER_E;
        if (r < 1024) { const int up = r >> 9; r &= 511; const int kb = r >> 4, nb = r & 15, n0 = 32 * nb;
            const int drow = 256 * (n0 >> 7) + 128 * up + (n0 & 127);
            transpose_item<true>((up ? wu : wg) + (size_t)e * D * DFF, DFF, 64 * kb, n0, (bf16_t*)((unsigned char*)GU + (size_t)e * 1024 * D), D, drow, scr, F.lane); }
        else { r -= 1024; const int kb = r >> 6, nb = r & 63;
            transpose_item<true>(wd + (size_t)e * DFF * D, D, 64 * kb, 32 * nb, (bf16_t*)((unsigned char*)DT + (size_t)e * D * DFF), DFF, 32 * nb, scr, F.lane); }
    }
}
__device__ __forceinline__ void pack_proj(Frame& F, float* Wp, int NT, const float* gain, const float* Wa, int lda, int ca0, int na, const float* Wb, int ldb, int nb) {
    const int total = 128 * NT * 256;
    for (int idx = (F.vcu * NWAVES * 64) + F.tid; idx < total; idx += F.G * NWAVES * 64) {
        const int e = idx & 3, ln = (idx >> 2) & 63, rest = idx >> 8, nt = rest % NT, s = rest / NT;
        const int k = 16 * s + 4 * (ln >> 4) + e, col = 16 * nt + (ln & 15);
        float v = 0.f;
        if (col < na) v = Wa[(size_t)k * lda + ca0 + col]; else if (col < na + nb) v = Wb[(size_t)k * ldb + (col - na)];
        Wp[idx] = v * gain[k];
    }
}

template <int NT>
__device__ __forceinline__ float wave_proj16(LAS unsigned char* lds, const float* xin, int tok0, const float* Wp, int tid, int wid, int lane, f32x4 (&acc)[NT]) {
    const int tr = lane & 15, kq = lane >> 4;
    const f32x4* xp = (const f32x4*)(xin + (size_t)(tok0 + tr) * D) + kq;
    constexpr int CH = 16 * NT * 1024;
    const char* wsrc = (const char*)Wp + tid * 16;
    float ssq = 0.f;
#pragma unroll
    for (int n = 0; n < NT; ++n) acc[n] = (f32x4){0.f, 0.f, 0.f, 0.f};
    f32x4 X[16];
#define NP_DMA(c, buf) do { _Pragma("unroll") for (int r = 0; r < 2 * NT; ++r) \
        __builtin_amdgcn_global_load_lds((const unsigned*)(wsrc + (size_t)(c) * CH + r * 8192), (LAS unsigned*)(lds + (buf) * CH + r * 8192 + wid * 1024), 16, 0, 0); } while (0)
#define NP_CHUNK(c, buf, more) do { \
        asm volatile("s_waitcnt vmcnt(16)" ::: "memory"); WG_BAR(); \
        if (more) NP_DMA((c) + 1, 1 - (buf)); \
        asm volatile("" ::: "memory");     \
        const f32x4* xn_ = xp + 64 * ((c) + 1); \
        _Pragma("unroll") for (int s = 0; s < 16; ++s) { const f32x4 xv = X[s]; if (more) X[s] = xn_[4 * s]; \
            ssq += (xv[0] * xv[0] + xv[1] * xv[1]) + (xv[2] * xv[2] + xv[3] * xv[3]); \
            _Pragma("unroll") for (int n = 0; n < NT; ++n) { const f32x4 wv = *(const LAS f32x4*)(lds + (buf) * CH + ((s * NT + n) * 64 + lane) * 16); \
                _Pragma("unroll") for (int e = 0; e < 4; ++e) acc[n] = __builtin_amdgcn_mfma_f32_16x16x4f32(xv[e], wv[e], acc[n], 0, 0, 0); } } } while (0)
    NP_DMA(0, 0);
    asm volatile("" ::: "memory");
#pragma unroll
    for (int s = 0; s < 16; ++s) X[s] = xp[4 * s];
    for (int c = 0; c < 6; c += 2) { NP_CHUNK(c, 0, true); NP_CHUNK(c + 1, 1, true); }
    NP_CHUNK(6, 0, true); NP_CHUNK(7, 1, false);
    WG_BAR();
#undef NP_DMA
#undef NP_CHUNK
    ssq += __shfl_xor(ssq, 16); ssq += __shfl_xor(ssq, 32);
    return 1.0f / sqrtf(ssq * (1.0f / D) + RMS_EPS);
}
template <bool FP8 = false>
__device__ __forceinline__ void wave_write_hn16(const float* xin, int tok0, float rstd, const float* gain, bf16_t* hn, int lane) {
    f32x4 g4[8];
#pragma unroll
    for (int j = 0; j < 8; ++j) g4[j] = ((const f32x4*)gain)[lane + 64 * j];
    for (int i = 0; i < 16; i += 2) {
        const float r0 = __shfl(rstd, i), r1 = __shfl(rstd, i + 1);
        const f32x4* x0 = (const f32x4*)(xin + (size_t)(tok0 + i) * D); const f32x4* x1 = x0 + D / 4;
        u32x2* o0 = (u32x2*)(hn + (size_t)(tok0 + i) * D); u32x2* o1 = o0 + D / 4;
        unsigned* p0 = (unsigned*)((unsigned char*)hn + (size_t)(tok0 + i) * D); unsigned* p1 = p0 + D / 4;
        f32x4 a[8], c[8];
#pragma unroll
        for (int j = 0; j < 8; ++j) { a[j] = x0[lane + 64 * j]; c[j] = x1[lane + 64 * j]; }
#pragma unroll
        for (int j = 0; j < 8; ++j) { const f32x4 v = a[j] * r0 * g4[j], u = c[j] * r1 * g4[j];
            if constexpr (FP8) { p0[lane + 64 * j] = cvt4_fp8(v[0], v[1], v[2], v[3]); p1[lane + 64 * j] = cvt4_fp8(u[0], u[1], u[2], u[3]); }
            else { u32x2 w; w.x = cvt_pk_bf16(v[0], v[1]); w.y = cvt_pk_bf16(v[2], v[3]); o0[lane + 64 * j] = w;
                u32x2 z; z.x = cvt_pk_bf16(u[0], u[1]); z.y = cvt_pk_bf16(u[2], u[3]); o1[lane + 64 * j] = z; } }
    }
}

__device__ __forceinline__ void phase_norm_gz(Frame& F, const float* xin, const float* gain, const float* Wp, bf16_t* hn, float* gz) {
    for (int tile = F.vcu; tile < T / 128; tile += F.G) {
        const int tok0 = tile * 128 + F.wave * 16;
        f32x4 acc[1];
        const float rstd = wave_proj16<1>(F.lds, xin, tok0, Wp, F.tid, F.wave, F.lane, acc);
        const int j = F.lane & 15, q4 = F.lane >> 4;
#pragma unroll
        for (int r = 0; r < 4; ++r) { const float rr = __shfl(rstd, 4 * q4 + r); gz[(size_t)(tok0 + 4 * q4 + r) * 16 + j] = acc[0][r] * rr; }
        wave_write_hn16(xin, tok0, rstd, gain, hn, F.lane);
    }
}
__device__ __forceinline__ void phase_norm_route(Frame& F, const float* xin, const float* gain, const float* Wp, bf16_t* hn, int* tok_e, int* tok_p, float* tok_w, unsigned* cnt) {
    LAS float* lg = (LAS float*)(F.lds + 98304 + F.wave * 3072);
    for (int tile = F.vcu; tile < T / 128; tile += F.G) {
        const int tok0 = tile * 128 + F.wave * 16;
        f32x4 acc[3];
        const float rstd = wave_proj16<3>(F.lds, xin, tok0, Wp, F.tid, F.wave, F.lane, acc);
        const int j = F.lane & 15, q4 = F.lane >> 4;
#pragma unroll
        for (int r = 0; r < 4; ++r) { const float rr = __shfl(rstd, 4 * q4 + r);
#pragma unroll
            for (int n = 0; n < 3; ++n) lg[(4 * q4 + r) * 48 + 16 * n + j] = acc[n][r] * rr; }
        LDS_WAIT(); asm volatile("" ::: "memory");
        if (F.lane < 16) {
            const LAS float* l = lg + F.lane * 48;
            float gm = l[0]; int gi = 0;
#pragma unroll
            for (int q = 1; q < 4; ++q) { const float v = l[q]; if (v > gm) { gm = v; gi = q; } }
            float gs = 0.f;
#pragma unroll
            for (int q = 0; q < 4; ++q) gs += __expf(l[q] - gm);
            const float gw = 1.0f / gs;
            const LAS float* se = l + 4 + 8 * gi;
            float m1 = se[0]; int i1 = 0;
#pragma unroll
            for (int q = 1; q < 8; ++q) { const float v = se[q]; if (v > m1) { m1 = v; i1 = q; } }
            float m2 = -3.0e38f; int i2 = 0;
#pragma unroll
            for (int q = 0; q < 8; ++q) { const float v = se[q]; if (q != i1 && v > m2) { m2 = v; i2 = q; } }
            const float eb = __expf(m2 - m1), inv = 1.0f / (1.0f + eb);
            const int t = tok0 + F.lane, e1 = gi * 8 + i1, e2 = gi * 8 + i2;
            const unsigned p1 = __hip_atomic_fetch_add(cnt + 64 * e1, 1u, __ATOMIC_RELAXED, __HIP_MEMORY_SCOPE_AGENT);
            const unsigned p2 = __hip_atomic_fetch_add(cnt + 64 * e2, 1u, __ATOMIC_RELAXED, __HIP_MEMORY_SCOPE_AGENT);
            tok_e[2 * t] = e1; tok_e[2 * t + 1] = e2; tok_p[2 * t] = (int)p1; tok_p[2 * t + 1] = (int)p2;
            tok_w[2 * t] = gw * inv; tok_w[2 * t + 1] = gw * eb * inv;
        }
        wave_write_hn16<true>(xin, tok0, rstd, gain, hn, F.lane);
        LDS_WAIT(); asm volatile("" ::: "memory");
    }
}

__device__ __forceinline__ void phase_gla_gate(Frame& F, const float* gz, const float* wgu, const float* bgate, const bf16_t* proj, bf16_t* kdT, float* adec) {
    LAS f32x4* gzs = (LAS f32x4*)F.lds;
    for (int u = F.vcu; u < NBATCH * NCH * 2; u += F.G) {
        const int half = u & 1, bc = u >> 1;
        const int tok0 = bc * 64, j = half * 512 + F.tid;
        if (F.tid < 256) gzs[F.tid] = ((const f32x4*)(gz + (size_t)tok0 * 16))[F.tid];
        float wg[16];
#pragma unroll
        for (int r = 0; r < 16; ++r) wg[r] = wgu[r * GLA_DKT + j];
        const float bg = bgate[j];
        WG_BAR();
        float cum[64]; float run = 0.f;
#pragma unroll
        for (int t = 0; t < 64; ++t) {
            float z = bg;
#pragma unroll
            for (int r4 = 0; r4 < 4; ++r4) { const f32x4 g4 = gzs[t * 4 + r4]; z += g4[0] * wg[4 * r4] + g4[1] * wg[4 * r4 + 1] + g4[2] * wg[4 * r4 + 2] + g4[3] * wg[4 * r4 + 3]; }
            const float ls = fminf(z, 0.f) - __logf(1.0f + __expf(-fabsf(z)));
            run += ls * (1.0f / 16.0f); cum[t] = run;
        }
        adec[(size_t)bc * GLA_DKT + j] = __expf(run);
        const bf16_t* kp = proj + GK0 + gq_off(bc >> 8, (bc & 255) * 64, j >> 8) + (j & 255);
        u32x4* dst = (u32x4*)(kdT + ((size_t)bc * GLA_DKT + j) * 64);
#pragma unroll
        for (int t8 = 0; t8 < 8; ++t8) {
            float kd[8];
#pragma unroll
            for (int q = 0; q < 8; ++q) { const int t = t8 * 8 + q; kd[q] = bf2f(kp[(size_t)t * 256]) * __expf(run - cum[t]); }
            u32x4 w; w.x = cvt_pk_bf16(kd[0], kd[1]); w.y = cvt_pk_bf16(kd[2], kd[3]); w.z = cvt_pk_bf16(kd[4], kd[5]); w.w = cvt_pk_bf16(kd[6], kd[7]);
            dst[t8] = w;
        }
        WG_BAR();
    }
}

constexpr int SCAN_VROW = 144, SCAN_SROW = 528, SCAN_VBUF = 64 * SCAN_VROW, SCAN_SBUF = 64 * SCAN_SROW;
__device__ __forceinline__ void phase_gla_scan(Frame& F, int it, const bf16_t* proj, const bf16_t* kdT, const float* adec, bf16_t* oout, bf16_t* sfin) {
    const int lane = F.lane, w = F.wave, fr = lane & 15, kq = lane >> 4, tid = F.tid;
    LAS unsigned char* vbuf = F.lds;
    LAS unsigned char* sbuf = F.lds + 2 * SCAN_VBUF;
    const int bh = it >> 4, seg = (it >> 3) & 1, b = bh >> 2, h = bh & 3, sl = it & 7, mt = w & 3, ntp = w >> 2, c0 = seg * (NCH / 2);
    const size_t tokb = (size_t)b * SEQ;
    f32x4 st[2][4];
#pragma unroll
    for (int i = 0; i < 2; ++i)
#pragma unroll
        for (int n = 0; n < 4; ++n) st[i][n] = (f32x4){0.f, 0.f, 0.f, 0.f};
    bf16x8 ka0[2][2], ka1[2][2], q0[8], q1[8]; f32x4 dc0[2], dc1[2]; u32x4 vr0, vr1;
#define CL(c) ((c) < NCH ? (c) : NCH - 1)
#define LOAD_KA(KA, DC, c) do { const size_t bc_ = (size_t)b * NCH + CL(c); \
        _Pragma("unroll") for (int i = 0; i < 2; ++i) { \
            _Pragma("unroll") for (int s = 0; s < 2; ++s) KA[i][s] = *(const bf16x8*)(kdT + ((bc_ * GLA_DKT + h * 256 + 32 * w + 16 * i + fr) * 64 + 32 * s + 8 * kq)); \
            DC[i] = *(const f32x4*)(adec + bc_ * GLA_DKT + h * 256 + 32 * w + 16 * i + 4 * kq); } } while (0)
#define LOAD_V(VR, c) do { VR = *(const u32x4*)(proj + gv_off(b, CL(c) * 64 + (tid >> 3), h) + 64 * sl + 8 * (tid & 7)); } while (0)
#define LOAD_Q(Q, c) do { const bf16_t* qp_ = proj + gq_off(b, CL(c) * 64 + 16 * mt + fr, h) + 8 * kq; \
        _Pragma("unroll") for (int s = 0; s < 8; ++s) Q[s] = *(const bf16x8*)(qp_ + 32 * s); } while (0)
#define STORE_V(VR, buf) do { *(LAS u32x4*)(vbuf + (buf) * SCAN_VBUF + (tid >> 3) * SCAN_VROW + (tid & 7) * 16) = VR; } while (0)
#define SCAN_STEP(KA, DC, VN, VM, QC, QN, c) do { \
        const unsigned vb_ = (unsigned)(uintptr_t)(vbuf + ((c) & 1) * SCAN_VBUF) + (unsigned)((8 * kq + ((lane & 15) >> 2)) * SCAN_VROW + 8 * (lane & 3)); \
        s16x4 tv[4][4];     \
        asm volatile("ds_read_b64_tr_b16 %0, %16 offset:0\n\tds_read_b64_tr_b16 %1, %16 offset:576\n\tds_read_b64_tr_b16 %2, %16 offset:4608\n\tds_read_b64_tr_b16 %3, %16 offset:5184\n\t" \
                     "ds_read_b64_tr_b16 %4, %16 offset:32\n\tds_read_b64_tr_b16 %5, %16 offset:608\n\tds_read_b64_tr_b16 %6, %16 offset:4640\n\tds_read_b64_tr_b16 %7, %16 offset:5216\n\t" \
                     "ds_read_b64_tr_b16 %8, %16 offset:64\n\tds_read_b64_tr_b16 %9, %16 offset:640\n\tds_read_b64_tr_b16 %10, %16 offset:4672\n\tds_read_b64_tr_b16 %11, %16 offset:5248\n\t" \
                     "ds_read_b64_tr_b16 %12, %16 offset:96\n\tds_read_b64_tr_b16 %13, %16 offset:672\n\tds_read_b64_tr_b16 %14, %16 offset:4704\n\tds_read_b64_tr_b16 %15, %16 offset:5280\n\ts_waitcnt lgkmcnt(0)" \
                     : "=&v"(tv[0][0]), "=&v"(tv[0][1]), "=&v"(tv[0][2]), "=&v"(tv[0][3]), "=&v"(tv[1][0]), "=&v"(tv[1][1]), "=&v"(tv[1][2]), "=&v"(tv[1][3]), \
                       "=&v"(tv[2][0]), "=&v"(tv[2][1]), "=&v"(tv[2][2]), "=&v"(tv[2][3]), "=&v"(tv[3][0]), "=&v"(tv[3][1]), "=&v"(tv[3][2]), "=&v"(tv[3][3]) : "v"(vb_) : "memory"); \
        _Pragma("unroll") for (int n = 0; n < 4; ++n) { \
            const bf16x8 vf0 = (bf16x8){tv[n][0][0], tv[n][0][1], tv[n][0][2], tv[n][0][3], tv[n][1][0], tv[n][1][1], tv[n][1][2], tv[n][1][3]}; \
            const bf16x8 vf1 = (bf16x8){tv[n][2][0], tv[n][2][1], tv[n][2][2], tv[n][2][3], tv[n][3][0], tv[n][3][1], tv[n][3][2], tv[n][3][3]}; \
            _Pragma("unroll") for (int i = 0; i < 2; ++i) { \
                st[i][n] = st[i][n] * DC[i]; \
                st[i][n] = __builtin_amdgcn_mfma_f32_16x16x32_bf16(KA[i][0], vf0, st[i][n], 0, 0, 0); \
                st[i][n] = __builtin_amdgcn_mfma_f32_16x16x32_bf16(KA[i][1], vf1, st[i][n], 0, 0, 0); } } \
        LOAD_KA(KA, DC, (c) + 2); \
        { LAS unsigned char* sb_ = sbuf + ((c) & 1) * SCAN_SBUF + fr * SCAN_SROW + (32 * w + 4 * kq) * 2; \
          _Pragma("unroll") for (int i = 0; i < 2; ++i) _Pragma("unroll") for (int n = 0; n < 4; ++n) { \
              u32x2 pk; pk.x = cvt_pk_bf16(st[i][n][0], st[i][n][1]); pk.y = cvt_pk_bf16(st[i][n][2], st[i][n][3]); \
              *(LAS u32x2*)(sb_ + n * 16 * SCAN_SROW + i * 32) = pk; } } \
        STORE_V(VN, ((c) + 1) & 1); \
        LOAD_V(VN, (c) + 3); \
        WG_BAR(); \
        { f32x4 a0 = (f32x4){0.f, 0.f, 0.f, 0.f}, a1 = a0; \
          const LAS unsigned char* sr_ = sbuf + ((c) & 1) * SCAN_SBUF + (32 * ntp + fr) * SCAN_SROW + 16 * kq; \
          _Pragma("unroll") for (int hb = 0; hb < 2; ++hb) { bf16x8 bb[4][2];     \
              _Pragma("unroll") for (int s = 0; s < 4; ++s) { bb[s][0] = *(const LAS bf16x8*)(sr_ + 64 * (4 * hb + s)); bb[s][1] = *(const LAS bf16x8*)(sr_ + 16 * SCAN_SROW + 64 * (4 * hb + s)); } \
              asm volatile("s_waitcnt lgkmcnt(0)" ::: "memory"); __builtin_amdgcn_sched_barrier(0); \
              _Pragma("unroll") for (int s = 0; s < 4; ++s) { \
                  a0 = __builtin_amdgcn_mfma_f32_16x16x32_bf16(QC[4 * hb + s], bb[s][0], a0, 0, 0, 0); \
                  a1 = __builtin_amdgcn_mfma_f32_16x16x32_bf16(QC[4 * hb + s], bb[s][1], a1, 0, 0, 0); } } \
          bf16_t* op_ = oout + (tokb + (size_t)(c) * 64 + 16 * mt + 4 * kq) * D + h * 512 + 64 * sl + 32 * ntp + fr; \
          _Pragma("unroll") for (int r = 0; r < 4; ++r) { \
              const float x0 = a0[r] * 0.0625f, x1 = a1[r] * 0.0625f, y0 = __shfl_xor(x0, 1), y1 = __shfl_xor(x1, 1); \
              if ((fr & 1) == 0) { *(unsigned*)(op_ + (size_t)r * D) = cvt_pk_bf16(x0, y0); *(unsigned*)(op_ + (size_t)r * D + 16) = cvt_pk_bf16(x1, y1); } } } \
        LOAD_Q(QC, (c) + 2); \
    } while (0)
    LOAD_KA(ka0, dc0, c0); LOAD_KA(ka1, dc1, c0 + 1); LOAD_V(vr0, c0); LOAD_V(vr1, c0 + 1); LOAD_Q(q0, c0); LOAD_Q(q1, c0 + 1);
    STORE_V(vr0, 0); LOAD_V(vr0, c0 + 2);
    WG_BAR();
    for (int c = c0; c < c0 + NCH / 2; c += 2) {
        SCAN_STEP(ka0, dc0, vr1, vr0, q0, q1, c);
        SCAN_STEP(ka1, dc1, vr0, vr1, q1, q0, c + 1);
    }
    if (seg == 0) {
#pragma unroll
        for (int i = 0; i < 2; ++i)
#pragma unroll
            for (int n = 0; n < 4; ++n) { u32x2 pk; pk.x = cvt_pk_bf16(st[i][n][0], st[i][n][1]); pk.y = cvt_pk_bf16(st[i][n][2], st[i][n][3]);
                *(u32x2*)(sfin + ((size_t)(bh * 512 + 64 * sl + 16 * n + fr)) * 256 + 32 * w + 16 * i + 4 * kq) = pk; }
    }
    WG_BAR();
#undef CL
#undef LOAD_KA
#undef LOAD_V
#undef LOAD_Q
#undef STORE_V
#undef SCAN_STEP
}

__device__ __forceinline__ void gla_pcum(Frame& F, const float* adec, float* pcum, int rank, int nrank) {
    for (int idx = rank * (NWAVES * 64) + F.tid; idx < NBATCH * GLA_DKT; idx += nrank * NWAVES * 64) { const int b = idx >> 10, j = idx & 1023;
        const float* ap = adec + ((size_t)(b * NCH + NCH / 2)) * GLA_DKT + j; float* pp = pcum + (size_t)(b * (NCH / 2)) * GLA_DKT + j; float pr = 1.f;
#pragma unroll 16
        for (int cc = 0; cc < NCH / 2; ++cc) { pr *= ap[(size_t)cc * GLA_DKT]; pp[(size_t)cc * GLA_DKT] = pr; } }
}
__device__ __forceinline__ void phase_gla_qp(Frame& F, const bf16_t* proj, const float* pcum, bf16_t* qp) {
    const int gw = F.vcu * NWAVES + F.wave, NGW = F.G * NWAVES, lane = F.lane;
    for (int r = gw; r < NBATCH * (SEQ / 2); r += NGW) { const int b = r >> 13, t = r & 8191;
        u32x2 qv[4]; f32x4 pv[4];
#pragma unroll
        for (int h = 0; h < 4; ++h) { qv[h] = *(const u32x2*)(proj + gq_off(b, SEQ / 2 + t, h) + 4 * lane); pv[h] = *(const f32x4*)(pcum + ((size_t)(b * (NCH / 2) + (t >> 6)) * GLA_DKT + h * 256 + 4 * lane)); }
#pragma unroll
        for (int h = 0; h < 4; ++h) { u32x2 w; w.x = cvt_pk_bf16(bf_lo(qv[h].x) * pv[h][0], bf_hi(qv[h].x) * pv[h][1]); w.y = cvt_pk_bf16(bf_lo(qv[h].y) * pv[h][2], bf_hi(qv[h].y) * pv[h][3]);
            *(u32x2*)(qp + ((size_t)((b * 4 + h) * (SEQ / 2) + t)) * 256 + 4 * lane) = w; }
    }
}
__device__ __forceinline__ void phase_gla_gnorm(Frame& F, const bf16_t* o, const bf16_t* proj, const float* gn, bf16_t* y) {
    const int gw = F.vcu * NWAVES + F.wave, NGW = F.G * NWAVES, lane = F.lane;
    const f32x4 g0 = ((const f32x4*)gn)[2 * lane], g1 = ((const f32x4*)gn)[2 * lane + 1];
    for (int tok = gw; tok < T; tok += NGW) {
        u32x4 ov[4], rv[4];
#pragma unroll
        for (int h = 0; h < 4; ++h) { ov[h] = *(const u32x4*)(o + (size_t)tok * D + h * 512 + 8 * lane); rv[h] = *(const u32x4*)(proj + GR0 + (size_t)tok * 2048 + h * 512 + 8 * lane); }
        float ss[4];
#pragma unroll
        for (int h = 0; h < 4; ++h) { float s = 0.f;
#pragma unroll
            for (int q = 0; q < 4; ++q) { const float lo = bf_lo(ov[h][q]), hi = bf_hi(ov[h][q]); s += lo * lo + hi * hi; }
            ss[h] = s; }
#pragma unroll
        for (int of = 1; of < 64; of <<= 1) {
#pragma unroll
            for (int h = 0; h < 4; ++h) ss[h] += __shfl_xor(ss[h], of); }
#pragma unroll
        for (int h = 0; h < 4; ++h) { const float rstd = 1.0f / sqrtf(ss[h] * (1.0f / 512.0f) + RMS_EPS);
            float yv[8];
#pragma unroll
            for (int q = 0; q < 4; ++q) { const float a0 = bf_lo(ov[h][q]), a1 = bf_hi(ov[h][q]), r0 = bf_lo(rv[h][q]), r1 = bf_hi(rv[h][q]);
                const float gA = q < 2 ? g0[2 * q] : g1[2 * q - 4], gB = q < 2 ? g0[2 * q + 1] : g1[2 * q - 3];
                yv[2 * q] = a0 * rstd * gA * (r0 / (1.0f + __expf(-r0))); yv[2 * q + 1] = a1 * rstd * gB * (r1 / (1.0f + __expf(-r1))); }
            u32x4 w; w.x = cvt_pk_bf16(yv[0], yv[1]); w.y = cvt_pk_bf16(yv[2], yv[3]); w.z = cvt_pk_bf16(yv[4], yv[5]); w.w = cvt_pk_bf16(yv[6], yv[7]);
            *(u32x4*)(y + (size_t)tok * D + h * 512 + 8 * lane) = w; }
    }
}

__device__ __forceinline__ void moe_tables(Frame& F, unsigned* cnt) {
    LAS int* pst = (LAS int*)(F.lds + TAB_OFF);
    LAS int* te = pst + 36;
    if (F.wave == 0) {
        const int e = F.lane & 31;
        const int c = (int)xb_ld(cnt + 64 * e);
        const int ntile = (c + 255) >> 8;
        int incl = ntile;
#pragma unroll
        for (int o = 1; o < 32; o <<= 1) { const int v = __shfl_up(incl, o); if ((F.lane & 31) >= o) incl += v; }
        const int excl = incl - ntile;
        if (F.lane < 32) { pst[e] = excl << 8; for (int q = 0; q < ntile; ++q) te[excl + q] = e; }
        if (F.lane == 31) { pst[32] = incl << 8; pst[33] = incl; }
    }
    WG_BAR();
}
__device__ __forceinline__ void phase_moe_slots(Frame& F, const int* tok_e, const int* tok_p, unsigned* cnt, int* slot_of, int* slot_tok) {
    const LAS int* pst = (const LAS int*)(F.lds + TAB_OFF);
    for (int e = F.vcu; e < NEXP; e += F.G) { const int c = (int)xb_ld(cnt + 64 * e), lo = pst[e] + c, hi = pst[e] + (((c + 255) >> 8) << 8);
        for (int s = lo + F.tid; s < hi; s += NWAVES * 64) slot_tok[s] = -1; }
    for (int a = F.vcu * NWAVES * 64 + F.tid; a < 2 * T; a += F.G * NWAVES * 64) { const int slot = pst[tok_e[a]] + tok_p[a]; slot_of[a] = slot; slot_tok[slot] = a >> 1; }
}
__device__ __forceinline__ void phase_moe_copy8(Frame& F, const int* tok_e, const int* tok_p, const unsigned char* hn8, unsigned char* ag8) {
    const LAS int* pst = (const LAS int*)(F.lds + TAB_OFF);
    const int gw = F.vcu * NWAVES + F.wave, NGW = F.G * NWAVES, lane = F.lane;
    for (int t = gw; t < T; t += NGW) {
        const int s0 = pst[tok_e[2 * t]] + tok_p[2 * t], s1 = pst[tok_e[2 * t + 1]] + tok_p[2 * t + 1];
        const u32x4* src = (const u32x4*)(hn8 + (size_t)t * D); const u32x4 v0 = src[lane], v1 = src[lane + 64];
        u32x4* d0 = (u32x4*)(ag8 + (size_t)s0 * D); u32x4* d1 = (u32x4*)(ag8 + (size_t)s1 * D);
        d0[lane] = v0; d0[lane + 64] = v1; d1[lane] = v0; d1[lane + 64] = v1;
    }
}
template <int MODE>
__device__ __forceinline__ void phase_moe_combine(Frame& F, float* x, const bf16_t* ob, const int* slot_of, const float* tok_w, const float* gain, bf16_t* hn) {
    const int gw = F.vcu * NWAVES + F.wave, NGW = F.G * NWAVES, lane = F.lane;
    f32x4 g4[8];
#pragma unroll
    for (int j = 0; j < 8; ++j) g4[j] = ((const f32x4*)gain)[lane + 64 * j];
    for (int t = gw; t < T; t += NGW) {
        const int s0 = slot_of[2 * t], s1 = slot_of[2 * t + 1]; const float w0 = tok_w[2 * t], w1 = tok_w[2 * t + 1];
        f32x4* xr = (f32x4*)(x + (size_t)t * D);
        const u32x2* a = (const u32x2*)(ob + (size_t)s0 * D); const u32x2* b = (const u32x2*)(ob + (size_t)s1 * D);
        f32x4 v[8]; float ss = 0.f;
#pragma unroll
        for (int j = 0; j < 8; ++j) { const u32x2 av = a[lane + 64 * j], bv = b[lane + 64 * j]; f32x4 xv = xr[lane + 64 * j];
            xv[0] += w0 * bf_lo(av.x) + w1 * bf_lo(bv.x); xv[1] += w0 * bf_hi(av.x) + w1 * bf_hi(bv.x);
            xv[2] += w0 * bf_lo(av.y) + w1 * bf_lo(bv.y); xv[3] += w0 * bf_hi(av.y) + w1 * bf_hi(bv.y);
            v[j] = xv; ss += (xv[0] * xv[0] + xv[1] * xv[1]) + (xv[2] * xv[2] + xv[3] * xv[3]); }
        const float rstd = 1.0f / sqrtf(wave_sum(ss) * (1.0f / D) + RMS_EPS);
        if (MODE == 0) {
            unsigned* orow = (unsigned*)((unsigned char*)hn + (size_t)t * D);
#pragma unroll
            for (int j = 0; j < 8; ++j) { xr[lane + 64 * j] = v[j]; const f32x4 y = v[j] * rstd * g4[j]; orow[lane + 64 * j] = cvt4_fp8(y[0], y[1], y[2], y[3]); }
        } else {
#pragma unroll
            for (int j = 0; j < 8; ++j) xr[lane + 64 * j] = v[j] * rstd * g4[j];
        }
    }
}

__device__ __forceinline__ void phase_subln(Frame& F, const bf16_t* o1, const bf16_t* o2, const float* lq1, const float* lk1, const float* lq2, const float* lk2, const float* sg, bf16_t* y) {
    const int gw = F.vcu * NWAVES + F.wave, NGW = F.G * NWAVES, lane = F.lane;
    const float d1 = wave_sum(lq1[lane] * lk1[lane] + lq1[lane + 64] * lk1[lane + 64]);
    const float d2 = wave_sum(lq2[lane] * lk2[lane] + lq2[lane + 64] * lk2[lane + 64]);
    const float lam = __expf(d1) - __expf(d2) + LAMBDA_INIT;
    const f32x4 g = ((const f32x4*)sg)[lane] * (1.0f - LAMBDA_INIT);
    for (int tok = gw; tok < T; tok += NGW) {
        u32x2 a[8], b[8];
#pragma unroll
        for (int h = 0; h < 8; ++h) { a[h] = *(const u32x2*)(o1 + (size_t)tok * D + h * 256 + 4 * lane); b[h] = *(const u32x2*)(o2 + (size_t)tok * D + h * 256 + 4 * lane); }
        f32x4 d[8]; float ss[8];
#pragma unroll
        for (int h = 0; h < 8; ++h) { d[h][0] = bf_lo(a[h].x) - lam * bf_lo(b[h].x); d[h][1] = bf_hi(a[h].x) - lam * bf_hi(b[h].x); d[h][2] = bf_lo(a[h].y) - lam * bf_lo(b[h].y); d[h][3] = bf_hi(a[h].y) - lam * bf_hi(b[h].y);
            ss[h] = (d[h][0] * d[h][0] + d[h][1] * d[h][1]) + (d[h][2] * d[h][2] + d[h][3] * d[h][3]); }
#pragma unroll
        for (int of = 1; of < 64; of <<= 1) {
#pragma unroll
            for (int h = 0; h < 8; ++h) ss[h] += __shfl_xor(ss[h], of); }
#pragma unroll
        for (int h = 0; h < 8; ++h) { const float rstd = 1.0f / sqrtf(ss[h] * (1.0f / 256.0f) + RMS_EPS); const f32x4 yv = d[h] * rstd * g;
            *(unsigned*)((unsigned char*)y + (size_t)tok * D + h * 256 + 4 * lane) = cvt4_fp8(yv[0], yv[1], yv[2], yv[3]); }
    }
}

namespace att {
constexpr int SHM_K = 64 * 128 * 2, SHM_V = 64 * 256 * 2;
constexpr int V_OFF = 0, K_OFF = 3 * SHM_V, SCR_OFF = RING_BYTES + 4096;
constexpr float SCALE = 0.08838834764831845f;
constexpr float C2 = 1.4426950408889634f * SCALE;
constexpr float THR = 8.f;
#define KSWZ(row, colB) ((row) * 256 + ((colB) ^ (((row) & 7) << 4)))
__device__ __forceinline__ int crow(int r, int hi) { return (r & 3) + 8 * (r >> 2) + 4 * hi; }
__device__ __forceinline__ int v_rd_base(int lane) { return ((lane & 3) << 3) | (((lane >> 2) & 3) << 6) | (((lane >> 4) & 1) << 5) | (((lane >> 5) & 1) << 8); }
constexpr int v_rd_off(int d0, int ks, int half) { return d0 * 512 + ks * 8192 + half * 4096; }

__device__ __forceinline__ void qkt(f32x16& p0, f32x16& p1, const LAS unsigned char* kslot, int r32, int hi, const bf16x8 (&qr)[8]) {
    const LAS unsigned char* kb[4];
#pragma unroll
    for (int dd = 0; dd < 4; ++dd) kb[dd] = kslot + KSWZ(r32, (dd * 16 + hi * 8) * 2);
#pragma unroll
    for (int d0 = 0; d0 < 8; ++d0) { const LAS unsigned char* a = kb[d0 & 3] + (d0 >> 2) * 128;
        const bf16x8 b0 = *(const LAS bf16x8*)a;
        const bf16x8 b1 = *(const LAS bf16x8*)(a + 32 * 256);
        p0 = __builtin_amdgcn_mfma_f32_32x32x16_bf16(b0, qr[d0], p0, 0, 0, 0);
        p1 = __builtin_amdgcn_mfma_f32_32x32x16_bf16(b1, qr[d0], p1, 0, 0, 0); }
}
__device__ __forceinline__ void pv_tile(f32x16 (&o)[8], unsigned vb, const bf16x8 (&pa)[4]) {
#define TRRD(dst, off) asm volatile("ds_read_b64_tr_b16 %0, %1 offset:%2" : "=&v"(dst) : "v"(vb), "i"(off) : "memory")
#define PV_RD(S, hb) do { constexpr int b_ = v_rd_off((hb) >> 1, 2 * ((hb) & 1), 0); TRRD(S[0], b_); TRRD(S[1], b_ + 4096); TRRD(S[2], b_ + 8192); TRRD(S[3], b_ + 12288); } while (0)
#define PV_MM(S, hb) do { \
        o[(hb) >> 1] = __builtin_amdgcn_mfma_f32_32x32x16_bf16(pa[2 * ((hb) & 1)], (bf16x8){S[0][0], S[0][1], S[0][2], S[0][3], S[1][0], S[1][1], S[1][2], S[1][3]}, o[(hb) >> 1], 0, 0, 0); \
        o[(hb) >> 1] = __builtin_amdgcn_mfma_f32_32x32x16_bf16(pa[2 * ((hb) & 1) + 1], (bf16x8){S[2][0], S[2][1], S[2][2], S[2][3], S[3][0], S[3][1], S[3][2], S[3][3]}, o[(hb) >> 1], 0, 0, 0); } while (0)
#define PV_STEP(SC, SN2, hb) do { PV_RD(SN2, (hb) + 2); asm volatile("s_waitcnt lgkmcnt(8)" ::: "memory"); __builtin_amdgcn_sched_barrier(0); PV_MM(SC, hb); } while (0)
    s16x4 f0[4], f1[4], f2[4];
    PV_RD(f0, 0); PV_RD(f1, 1);
    PV_STEP(f0, f2, 0); PV_STEP(f1, f0, 1); PV_STEP(f2, f1, 2); PV_STEP(f0, f2, 3); PV_STEP(f1, f0, 4); PV_STEP(f2, f1, 5); PV_STEP(f0, f2, 6); PV_STEP(f1, f0, 7);
    PV_STEP(f2, f1, 8); PV_STEP(f0, f2, 9); PV_STEP(f1, f0, 10); PV_STEP(f2, f1, 11); PV_STEP(f0, f2, 12); PV_STEP(f1, f0, 13);
    asm volatile("s_waitcnt lgkmcnt(4)" ::: "memory"); __builtin_amdgcn_sched_barrier(0); PV_MM(f2, 14);
    asm volatile("s_waitcnt lgkmcnt(0)" ::: "memory"); __builtin_amdgcn_sched_barrier(0); PV_MM(f0, 15);
#undef PV_STEP
#undef PV_MM
#undef PV_RD
#undef TRRD
}

__device__ __forceinline__ void stage_offsets(int tid, unsigned (&koff)[2], unsigned (&voff)[4]) {
#pragma unroll
    for (int i = 0; i < 2; ++i) { const int P = tid * 16 + i * 8192, row = P >> 8, ch = ((P & 255) >> 4) ^ (row & 7); koff[i] = (unsigned)(row * 128 + ch * 8) * 2u; }
#pragma unroll
    for (int i = 0; i < 4; ++i) { const int P = tid * 16 + i * 8192, st = P >> 9, kk = ((st >> 3) << 3) | ((P & 511) >> 6), cg = st & 7, cin = (P & 63) >> 1;
        const int key = (kk & ~0xC) | ((kk & 4) << 1) | ((kk & 8) >> 1); voff[i] = (unsigned)(key * 256 + cg * 32 + cin) * 2u; }
}
__device__ __forceinline__ const char* uniform_ptr(const void* p) {
    const unsigned long long v = (unsigned long long)p;
    const unsigned lo = __builtin_amdgcn_readfirstlane((unsigned)v), hi = __builtin_amdgcn_readfirstlane((unsigned)(v >> 32));
    return (const char*)(((unsigned long long)hi << 32) | lo);
}
__device__ __forceinline__ void stage_tile(LAS unsigned char* lds, int kslot, int vslot, const bf16_t* kj_, const bf16_t* vj_, int tid_, int wid) {
    const char* kj = uniform_ptr(kj_); const char* vj = uniform_ptr(vj_);
    int tid = tid_; asm volatile("" : "+v"(tid));
    unsigned koff[2], voff[4]; stage_offsets(tid, koff, voff);
    LAS unsigned char* kd = lds + K_OFF + kslot * SHM_K + wid * 1024; LAS unsigned char* vd = lds + V_OFF + vslot * SHM_V + wid * 1024;
#pragma unroll
    for (int i = 0; i < 2; ++i) __builtin_amdgcn_global_load_lds((const unsigned*)(kj + koff[i]), (LAS unsigned*)(kd + i * 8192), 16, 0, 0);
#pragma unroll
    for (int i = 0; i < 4; ++i) __builtin_amdgcn_global_load_lds((const unsigned*)(vj + voff[i]), (LAS unsigned*)(vd + i * 8192), 16, 0, 0);
}

__device__ __forceinline__ void qk_softmax(const LAS unsigned char* kslot, int r32, int hi, LAS float* al_l, const bf16x8 (&qr)[8], f32x16 (&o)[8], bf16x8 (&pa)[4],
                                           float& m_reg, float& l_reg, float rawu, float sl2, bool diag, int qi) {
    f32x16 p0, p1;
#pragma unroll
    for (int r = 0; r < 16; ++r) { p0[r] = 0.f; p1[r] = 0.f; }
    qkt(p0, p1, kslot, r32, hi, qr);
#pragma unroll
    for (int r = 0; r < 16; ++r) { const float cr = (float)((r & 3) + 8 * (r >> 2)); p0[r] = fmaf(cr, rawu, p0[r]); p1[r] = fmaf(cr, rawu, p1[r]); }
    if (diag) {
        const float k2raw = 2.f * rawu;
        int qi_ = qi - 4 * hi; asm volatile("" : "+v"(qi_));
#pragma unroll
        for (int r = 0; r < 16; ++r) { const int c = (r & 3) + 8 * (r >> 2); const int d0_ = c - qi_, d1_ = c + 32 - qi_;
            p0[r] -= k2raw * (float)(d0_ > 0 ? d0_ : 0); p1[r] -= k2raw * (float)(d1_ > 0 ? d1_ : 0); }
    }
    const float lane_raw = rawu * (float)(4 * hi), d32raw = 32.f * rawu;
    float pm0 = p0[0], pm1 = p1[0];
#pragma unroll
    for (int r = 1; r < 16; ++r) { pm0 = fmaxf(pm0, p0[r]); pm1 = fmaxf(pm1, p1[r]); }
    float pmax = fmaxf(pm0, pm1 + d32raw) + lane_raw;
    { auto rr = __builtin_amdgcn_permlane32_swap(__float_as_uint(pmax), __float_as_uint(pmax), false, false);
      pmax = fmaxf(__uint_as_float(rr[0]), __uint_as_float(rr[1])); }
    float mn, alpha;
    if (__all((pmax - m_reg) * SCALE <= THR)) { mn = m_reg; alpha = 1.f; }
    else { mn = fmaxf(m_reg, pmax); alpha = __builtin_amdgcn_exp2f((m_reg - mn) * C2); m_reg = mn; }
    const float mnL0 = (lane_raw - mn) * C2, mnL1 = mnL0 + 32.f * sl2;
#pragma unroll
    for (int r = 0; r < 16; ++r) { p0[r] = __builtin_amdgcn_exp2f(fmaf(p0[r], C2, mnL0)); p1[r] = __builtin_amdgcn_exp2f(fmaf(p1[r], C2, mnL1)); }
    if (__any(alpha < 1.f)) {
        if (hi == 0) al_l[r32] = alpha;
        LDS_WAIT();
#pragma unroll
        for (int r = 0; r < 16; ++r) { const float a = al_l[crow(r, hi)];
#pragma unroll
            for (int d = 0; d < 8; ++d) o[d][r] *= a; }
    }
    float ps = 0.f;
#pragma unroll
    for (int r = 0; r < 16; ++r) ps += p0[r] + p1[r];
    { auto rr = __builtin_amdgcn_permlane32_swap(__float_as_uint(ps), __float_as_uint(ps), false, false);
      ps = __uint_as_float(rr[0]) + __uint_as_float(rr[1]); }
    l_reg = l_reg * alpha + ps;
#define PK4(P, B_, OUT) do { unsigned a0 = cvt_pk_bf16(P[B_+0], P[B_+1]), a1 = cvt_pk_bf16(P[B_+2], P[B_+3]); \
        unsigned b0 = cvt_pk_bf16(P[B_+4], P[B_+5]), b1 = cvt_pk_bf16(P[B_+6], P[B_+7]); \
        auto r0 = __builtin_amdgcn_permlane32_swap(a0, b0, false, false); auto r1 = __builtin_amdgcn_permlane32_swap(a1, b1, false, false); \
        u32x4 w = {r0[0], r1[0], r0[1], r1[1]}; OUT = __builtin_bit_cast(bf16x8, w); } while (0)
    PK4(p0, 0, pa[0]); PK4(p0, 8, pa[1]); PK4(p1, 0, pa[2]); PK4(p1, 8, pa[3]);
#undef PK4
}

__device__ __forceinline__ void norms_phase(Frame& F, const bf16_t* proj, float* nrm) {
    const int gw = F.vcu * NWAVES + F.wave, NGW = F.G * NWAVES, lane = F.lane;
    for (int idx = gw; idx < 2 * 32 * 256; idx += NGW) {
        const int tensor = idx >> 13, stream = (idx >> 8) & 31, grp = idx & 255;
        const u32x4* rp = (const u32x4*)(proj + (tensor ? DK0 : 0) + ((size_t)stream * SEQ + grp * 64 + lane) * 128);
        float ss = 0.f;
#pragma unroll
        for (int q = 0; q < 16; ++q) { const u32x4 v = rp[q];
#pragma unroll
            for (int e = 0; e < 4; ++e) { const float lo = bf_lo(v[e]), hi = bf_hi(v[e]); ss += lo * lo + hi * hi; } }
        float n = sqrtf(ss) * 1.001f;
#pragma unroll
        for (int o = 1; o < 64; o <<= 1) n = fmaxf(n, __shfl_xor(n, o));
        if (lane == 0) nrm[idx] = n;
    }
}

__device__ __forceinline__ void attn_item(LAS unsigned char* lds, const bf16_t* proj, const float* nrm, bf16_t* oout, int b, int h, int sub, int qb, int tid, int wid, int lane) {
    const int r32 = lane & 31, hi = lane >> 5;
    const float slope = __builtin_amdgcn_exp2f(-(float)(h + 1));
    const float sl2 = slope * 1.4426950408889634f, rawu = sl2 / C2;
    LAS float* ws = (LAS float*)(lds + SCR_OFF) + wid * 64; LAS float* li_l = ws; LAS float* al_l = ws + 32;
    const size_t tokq = (size_t)b * SEQ + (size_t)qb * 256 + wid * 32;
    const bf16_t* kbase = proj + DK0 + dq_off(b, 0, h, sub);
    const bf16_t* vbase = proj + dv_off(b, 0, h);
    int j_lo;
    { const int stream = (b * 8 + h) * 2 + sub; const float* qn = nrm + stream * 256; const float* kn = nrm + 8192 + stream * 256;
      const float Qn = fmaxf(fmaxf(qn[4 * qb], qn[4 * qb + 1]), fmaxf(qn[4 * qb + 2], qn[4 * qb + 3]));
      const float Kd = fmaxf(fmaxf(kn[4 * qb], kn[4 * qb + 1]), fmaxf(kn[4 * qb + 2], kn[4 * qb + 3]));
      int cand = 4 * qb;
      for (int jj = lane; jj < 4 * qb; jj += 64) { const float dmin = (float)(256 * qb - (64 * jj + 63)); const bool skip = slope * dmin > 110.f + SCALE * Qn * (kn[jj] + Kd); if (!skip) cand = cand < jj ? cand : jj; }
#pragma unroll
      for (int o = 1; o < 64; o <<= 1) { const int v = __shfl_xor(cand, o); cand = v < cand ? v : cand; }
      j_lo = __builtin_amdgcn_readfirstlane(cand); }
    bf16x8 qr[8];
#pragma unroll
    for (int d0 = 0; d0 < 8; ++d0) qr[d0] = *(const bf16x8*)(proj + dq_off(b, qb * 256 + wid * 32 + r32, h, sub) + d0 * 16 + hi * 8);
    const float sh64 = 64.f * rawu;
    const int qi = 32 * (wid & 1) + r32;
    const unsigned vb0 = (unsigned)(uintptr_t)(lds + V_OFF) + (unsigned)v_rd_base(lane);
    float m_reg = -1e30f, l_reg = 0.f;
    f32x16 o[8];
#pragma unroll
    for (int d = 0; d < 8; ++d)
#pragma unroll
        for (int r = 0; r < 16; ++r) o[d][r] = 0.f;
    const int NT = 4 * qb + 4, myNT = 4 * qb + (wid >> 1) + 1;
    constexpr size_t KSTEP = 64 * 128, VSTEP = 64 * 256;
    const bool late = wid >= 4;
    stage_tile(lds, j_lo & 1, j_lo % 3, kbase + (size_t)j_lo * KSTEP, vbase + (size_t)j_lo * VSTEP, tid, wid);
    VM_WAIT(); WG_BAR();
    if (!late) {
        int vs = j_lo % 3;
        for (int j = j_lo; j < NT; ++j) {
            const int vsn = vs == 2 ? 0 : vs + 1;
            if (j + 1 < NT) stage_tile(lds, (j + 1) & 1, vsn, kbase + (size_t)(j + 1) * KSTEP, vbase + (size_t)(j + 1) * VSTEP, tid, wid);
            if (j < myNT) { if (j > j_lo) m_reg -= sh64;
                bf16x8 pa[4];
                qk_softmax(lds + K_OFF + (j & 1) * SHM_K, r32, hi, al_l, qr, o, pa, m_reg, l_reg, rawu, sl2, j == myNT - 1, qi);
                pv_tile(o, vb0 + (unsigned)(vs * SHM_V), pa); }
            VM_WAIT(); WG_BAR();
            vs = vsn;
        }
    } else {
        bf16x8 pa[4];
        int vs = j_lo % 3, vsp = vs;
        for (int j = j_lo; j < NT; ++j) {
            const int vsn = vs == 2 ? 0 : vs + 1;
            if (j + 1 < NT) stage_tile(lds, (j + 1) & 1, vsn, kbase + (size_t)(j + 1) * KSTEP, vbase + (size_t)(j + 1) * VSTEP, tid, wid);
            if (j > j_lo && j - 1 < myNT) pv_tile(o, vb0 + (unsigned)(vsp * SHM_V), pa);
            if (j < myNT) { if (j > j_lo) m_reg -= sh64;
                qk_softmax(lds + K_OFF + (j & 1) * SHM_K, r32, hi, al_l, qr, o, pa, m_reg, l_reg, rawu, sl2, j == myNT - 1, qi); }
            VM_WAIT(); WG_BAR();
            vsp = vs; vs = vsn;
        }
        if (myNT == NT) pv_tile(o, vb0 + (unsigned)(vsp * SHM_V), pa);
    }
    if (hi == 0) li_l[r32] = l_reg;
    LDS_WAIT();
    char* Ow = (char*)(oout + tokq * D + h * 256);
    const unsigned lofs = (unsigned)(hi * 4 * D + r32) * 2u;
#pragma unroll
    for (int r = 0; r < 16; ++r) { const float rl = __builtin_amdgcn_rcpf(li_l[crow(r, hi)]);
#pragma unroll
        for (int d0 = 0; d0 < 8; ++d0) { const float v = o[d0][r] * rl; const float vn = __shfl_xor(v, 1);
            if ((r32 & 1) == 0) *(unsigned*)(Ow + (lofs + (unsigned)((((r & 3) + 8 * (r >> 2)) * D + d0 * 32) * 2))) = cvt_pk_bf16(v, vn); } }
    WG_BAR();
}

struct TailConv { const float* wg; const float* wu; const float* wd; bf16_t* gu; bf16_t* dt; };
__device__ __forceinline__ void attn_phase(Frame& F, const bf16_t* proj, const float* nrm, unsigned* queue, bf16_t* o1, bf16_t* o2, const TailConv tc) {
    LAS int* qw = (LAS int*)(F.lds + SCR_OFF + 8 * 256);
    for (;;) {
        if (F.tid == 0) *qw = (int)__hip_atomic_fetch_add(queue, 1u, __ATOMIC_RELAXED, __HIP_MEMORY_SCOPE_AGENT);
        WG_BAR();
        const int I = __builtin_amdgcn_readfirstlane(*qw);
        if (I >= 2048 + 512) break;
        if (I >= 2048) { conv_moe(F, tc.wg, tc.wu, tc.wd, tc.gu, tc.dt, I - 2048, 512); WG_BAR(); continue; }
        const int qb = 63 - (I >> 5), r = I & 31, h = 7 - (r >> 2), b = (r >> 1) & 1, sub = r & 1;
        attn_item(F.lds, proj, nrm, sub ? o2 : o1, b, h, sub, qb, F.tid, F.wave, F.lane);
    }
}
}

__device__ __forceinline__ const void* karg(int i) { int j = i; asm volatile("" : "+s"(j)); return ((const void* const __attribute__((address_space(4)))*)__builtin_amdgcn_kernarg_segment_ptr())[j]; }
__global__ void __launch_bounds__(NWAVES * 64, 2) hybrid_fwd(Args args) {
    extern __shared__ __attribute__((aligned(16))) unsigned char lds_raw[];
    Frame F;
    F.lds = (LAS unsigned char*)lds_raw;
    F.tid = threadIdx.x; F.lane = F.tid & 63; F.wave = __builtin_amdgcn_readfirstlane(F.tid >> 6);
    F.G = gridDim.x; { const int bx = blockIdx.x; F.vcu = (F.G % 8 == 0) ? (bx % 8) * (F.G / 8) + bx / 8 : bx; }
#define ws ((unsigned char*)karg(22))
#define ctl ((unsigned*)(ws + WS_CTL))
    for (int u = F.tid; u < (LDS_BYTES - LDSCTL_OFF) / 4; u += NWAVES * 64) ((LAS unsigned*)(F.lds + LDSCTL_OFF))[u] = 0u;
    __syncthreads();
    ((LAS int*)(F.lds + TIDS_OFF))[F.tid] = F.tid;
    __syncthreads();
    volatile LAS unsigned* MISC = (volatile LAS unsigned*)(F.lds + MISC_OFF);
    XcdBarrier bar = xcd_barrier_post(ctl + CW_BAR, MISC + 8);
#define GRID_BAR() do { XcdBarrier bb_ = bar; unsigned x_ = bar.x; unsigned long long bp_ = (unsigned long long)bar.bar; asm volatile("" : "+s"(x_), "+s"(bp_)); bb_.x = x_; bb_.bar = (unsigned*)bp_; xcd_barrier(bb_, TID_RELOAD() == 0); } while (0)
#define TID_RELOAD() (F.wave * 64 + lane_id_volatile())
#ifdef ONLY_PHASE
#define PHON(n) ((n) == ONLY_PHASE)
#else
#define PHON(n) 1
#endif

#define x_in ((const float*)(karg(0)))
#define norm_mix ((const float*)(karg(1)))
#define norm_ffn ((const float*)(karg(2)))
#define gla_w_in ((const float*)(karg(3)))
#define gla_wgu ((const float*)(karg(4)))
#define gla_bg ((const float*)(karg(5)))
#define gla_norm ((const float*)(karg(6)))
#define gla_w_out ((const float*)(karg(7)))
#define diff_w_in ((const float*)(karg(8)))
#define lq1 ((const float*)(karg(9)))
#define lk1 ((const float*)(karg(10)))
#define lq2 ((const float*)(karg(11)))
#define lk2 ((const float*)(karg(12)))
#define diff_subln ((const float*)(karg(13)))
#define diff_w_out ((const float*)(karg(14)))
#define moe_wgrp ((const float*)(karg(15)))
#define moe_wexp ((const float*)(karg(16)))
#define moe_wg ((const float*)(karg(17)))
#define moe_wu ((const float*)(karg(18)))
#define moe_wd ((const float*)(karg(19)))
#define final_norm ((const float*)(karg(20)))
#define xres ((float*)(karg(21)))
#define gz ((float*)((float*)(ws + WS_GZ)))
#define tok_e ((int*)((int*)(ws + WS_TOKE)))
#define tok_p ((int*)((int*)(ws + WS_TOKP)))
#define tok_w ((float*)((float*)(ws + WS_TOKW)))
#define slot_of ((int*)((int*)(ws + WS_SLOT)))
#define slot_tok ((int*)(ws + WS_STOK))
#define adec ((float*)((float*)(ws + WS_ADEC)))
#define pcum ((float*)((float*)(ws + WS_PCUM)))
#define sfin ((bf16_t*)((bf16_t*)(ws + WS_SFIN)))
#define wp_gz ((float*)((float*)(ws + WS_WPGZ)))
#define wp_r0 ((float*)((float*)(ws + WS_WPR0)))
#define wp_r1 ((float*)((float*)(ws + WS_WPR1)))
#define wgi ((bf16_t*)((bf16_t*)(ws + WS_WGI)))
#define wgo ((bf16_t*)((bf16_t*)(ws + WS_WGO)))
#define wdi ((bf16_t*)((bf16_t*)(ws + WS_WDI)))
#define wdo ((bf16_t*)((bf16_t*)(ws + WS_WDO)))
#define wmoe_gu ((bf16_t*)((bf16_t*)(ws + WS_WMOE)))
#define wmoe_d ((bf16_t*)((bf16_t*)(ws + WS_WMOE_D)))
#define hn ((bf16_t*)((bf16_t*)(ws + WS_HN)))
#define proj ((bf16_t*)((bf16_t*)(ws + WS_PROJ)))
#define buf1 ((bf16_t*)((bf16_t*)(ws + WS_BUF1)))
#define buf2 ((bf16_t*)((bf16_t*)(ws + WS_BUF2)))
#define ag ((bf16_t*)((bf16_t*)(ws + WS_AG)))
#define ob ((bf16_t*)((bf16_t*)(ws + WS_OB)))
#define hh ((bf16_t*)((bf16_t*)(ws + WS_H)))
    const LAS int* pst = (const LAS int*)(F.lds + TAB_OFF);

    _Pragma("unroll") for (int rep_ = 0; rep_ < (REP_PHASE == 0 ? 2 : 1); ++rep_) if (PHON(0)) { if (rep_) GRID_BAR(); Frame P = F; P.tid = TID_RELOAD(); P.lane = P.tid & 63;
    conv_plain(P, gla_w_in, D, PROJW, GLA_INW, wgi);
    conv_plain(P, gla_w_out, D, D, D, wgo);
    pack_proj(P, wp_gz, 1, norm_mix, gla_w_in, GLA_INW, PROJW, 16, nullptr, 0, 0);
    pack_proj(P, wp_r0, 3, norm_ffn, moe_wgrp, 4, 0, 4, moe_wexp, 32, 32);
    pack_proj(P, wp_r1, 3, norm_ffn + D, moe_wgrp + (size_t)D * 4, 4, 0, 4, moe_wexp + (size_t)D * 32, 32, 32);
    }
    GRID_BAR();
    _Pragma("unroll") for (int rep_ = 0; rep_ < (REP_PHASE == 1 ? 2 : 1); ++rep_) if (PHON(1)) { if (rep_) GRID_BAR(); Frame P = F; P.tid = TID_RELOAD(); P.lane = P.tid & 63;
    phase_norm_gz(P, x_in, norm_mix, wp_gz, hn, gz);
    }
    GRID_BAR();
    _Pragma("unroll") for (int rep_ = 0; rep_ < (REP_PHASE == 2 ? 2 : 1); ++rep_) if (PHON(2)) { if (rep_) GRID_BAR(); Frame P = F; P.tid = TID_RELOAD(); P.lane = P.tid & 63;
    { pg8::Gemm g{hn, wgi, T, PROJW, D}; pg8::StaticOrder S; S.init(T, PROJW, P.G, (int)blockIdx.x); pg8::EpiHeads<0> E{proj};
      pg8::gemm_phase<pg8::EpiHeads<0>, pg8::StaticOrder>(P.lds, g, S, E, P.tid); }
    }
    GRID_BAR();
    _Pragma("unroll") for (int rep_ = 0; rep_ < (REP_PHASE == 3 ? 2 : 1); ++rep_) if (PHON(3)) { if (rep_) GRID_BAR(); Frame P = F; P.tid = TID_RELOAD(); P.lane = P.tid & 63;
    phase_gla_gate(P, gz, gla_wgu, gla_bg, proj, buf1, adec);
    }
    GRID_BAR();
    _Pragma("unroll") for (int rep_ = 0; rep_ < (REP_PHASE == 4 ? 2 : 1); ++rep_) if (PHON(4)) { if (rep_) GRID_BAR(); Frame P = F; P.tid = TID_RELOAD(); P.lane = P.tid & 63;
    if (P.G == 256) { if ((P.vcu & 1) == 0) phase_gla_scan(P, P.vcu >> 1, proj, buf1, adec, buf2, sfin); else { gla_pcum(P, adec, pcum, P.vcu >> 1, 128); conv_moe(P, moe_wg, moe_wu, moe_wd, wmoe_gu, wmoe_d, P.vcu >> 1, 128);
            conv_plain<true>(P, diff_w_in, D, PROJW, PROJW, wdi, P.vcu >> 1, 128); conv_plain<true>(P, diff_w_out, D, D, D, wdo, P.vcu >> 1, 128); } }
    else { for (int it = P.vcu; it < 128; it += P.G) phase_gla_scan(P, it, proj, buf1, adec, buf2, sfin); gla_pcum(P, adec, pcum, P.vcu, P.G); conv_moe(P, moe_wg, moe_wu, moe_wd, wmoe_gu, wmoe_d); conv_plain<true>(P, diff_w_in, D, PROJW, PROJW, wdi); conv_plain<true>(P, diff_w_out, D, D, D, wdo); }
    GRID_BAR();
    phase_gla_qp(P, proj, pcum, hn);
    GRID_BAR();
    { pg8::Gemm g{hn, sfin, 8 * (SEQ / 2), 512, 256}; pg8::FixOrder S; S.init(8 * (SEQ / 2), 512, P.G, (int)blockIdx.x); pg8::EpiAddO E{buf2};
      pg8::gemm_phase<pg8::EpiAddO, pg8::FixOrder>(P.lds, g, S, E, P.tid); }
    }
    GRID_BAR();
    _Pragma("unroll") for (int rep_ = 0; rep_ < (REP_PHASE == 5 ? 2 : 1); ++rep_) if (PHON(5)) { if (rep_) GRID_BAR(); Frame P = F; P.tid = TID_RELOAD(); P.lane = P.tid & 63;
    phase_gla_gnorm(P, buf2, proj, gla_norm, hn);
    }
    GRID_BAR();
    _Pragma("unroll") for (int rep_ = 0; rep_ < (REP_PHASE == 6 ? 2 : 1); ++rep_) if (PHON(6)) { if (rep_) GRID_BAR(); Frame P = F; P.tid = TID_RELOAD(); P.lane = P.tid & 63;
    { pg8::Gemm g{hn, wgo, T, D, D}; pg8::StaticOrder S; S.init(T, D, P.G, (int)blockIdx.x); pg8::EpiResF32 E{x_in, xres, D};
      pg8::gemm_phase<pg8::EpiResF32, pg8::StaticOrder>(P.lds, g, S, E, P.tid); }
    }
    GRID_BAR();
    _Pragma("unroll") for (int rep_ = 0; rep_ < (REP_PHASE == 7 ? 2 : 1); ++rep_) if (PHON(7)) { if (rep_) GRID_BAR(); Frame P = F; P.tid = TID_RELOAD(); P.lane = P.tid & 63;
    phase_norm_route(P, xres, norm_ffn, wp_r0, hn, tok_e, tok_p, tok_w, ctl + CW_CNT0);
    }
    GRID_BAR();
    _Pragma("unroll") for (int rep_ = 0; rep_ < (REP_PHASE == 8 ? 2 : 1); ++rep_) if (PHON(8)) { if (rep_) GRID_BAR(); Frame P = F; P.tid = TID_RELOAD(); P.lane = P.tid & 63;
    moe_tables(P, ctl + CW_CNT0);
    phase_moe_slots(P, tok_e, tok_p, ctl + CW_CNT0, slot_of, slot_tok);
    }
    GRID_BAR();
    _Pragma("unroll") for (int rep_ = 0; rep_ < (REP_PHASE == 9 ? 2 : 1); ++rep_) if (PHON(9)) { if (rep_) GRID_BAR(); Frame P = F; P.tid = TID_RELOAD(); P.lane = P.tid & 63;
    { const int Mr = pst[33] * 256; pg8::Gemm g{hn, wmoe_gu, Mr, 1024, D}; pg8::MoeOrder S; S.init(Mr, 1024, P.G, (int)blockIdx.x); S.te = pst + 36; S.estride = (size_t)1024 * D; S.stok = slot_tok; pg8::EpiSiluMul E{(unsigned char*)hh};
      pg8::gemm_phase<pg8::EpiSiluMul, pg8::MoeOrder, true, true>(P.lds, g, S, E, P.tid); }
    }
    GRID_BAR();
    _Pragma("unroll") for (int rep_ = 0; rep_ < (REP_PHASE == 10 ? 2 : 1); ++rep_) if (PHON(10)) { if (rep_) GRID_BAR(); Frame P = F; P.tid = TID_RELOAD(); P.lane = P.tid & 63;
    { const int Mr = pst[33] * 256; pg8::Gemm g{hh, wmoe_d, Mr, D, DFF}; pg8::MoeOrder S; S.init(Mr, D, P.G, (int)blockIdx.x); S.te = pst + 36; S.estride = (size_t)D * DFF; S.stok = slot_tok; pg8::EpiBf16 E{ob, D};
      pg8::gemm_phase<pg8::EpiBf16, pg8::MoeOrder, false, true>(P.lds, g, S, E, P.tid); }
    }
    GRID_BAR();
    _Pragma("unroll") for (int rep_ = 0; rep_ < (REP_PHASE == 11 ? 2 : 1); ++rep_) if (PHON(11)) { if (rep_) GRID_BAR(); Frame P = F; P.tid = TID_RELOAD(); P.lane = P.tid & 63;
    phase_moe_combine<0>(P, xres, ob, slot_of, tok_w, norm_mix + D, hn);
    }
    GRID_BAR();
    _Pragma("unroll") for (int rep_ = 0; rep_ < (REP_PHASE == 12 ? 2 : 1); ++rep_) if (PHON(12)) { if (rep_) GRID_BAR(); Frame P = F; P.tid = TID_RELOAD(); P.lane = P.tid & 63;
    { pg8::Gemm g{hn, wdi, T, PROJW, D}; pg8::StaticOrder S; S.init(T, PROJW, P.G, (int)blockIdx.x); pg8::EpiHeads<1> E{proj};
      pg8::gemm_phase<pg8::EpiHeads<1>, pg8::StaticOrder, false, true>(P.lds, g, S, E, P.tid); }
    GRID_BAR();
    att::norms_phase(P, proj, (float*)(ws + WS_NRM));
    }
    GRID_BAR();
    _Pragma("unroll") for (int rep_ = 0; rep_ < (REP_PHASE == 13 ? 2 : 1); ++rep_) if (PHON(13)) { if (rep_) GRID_BAR(); Frame P = F; P.tid = TID_RELOAD(); P.lane = P.tid & 63;
    att::attn_phase(P, proj, (const float*)(ws + WS_NRM), ctl + CW_QUEUE, buf1, buf2, att::TailConv{moe_wg + (size_t)NEXP * D * DFF, moe_wu + (size_t)NEXP * D * DFF, moe_wd + (size_t)NEXP * DFF * D, (bf16_t*)(ws + WS_WMOE1), (bf16_t*)(ws + WS_WMOE1_D)});
    }
    GRID_BAR();
    _Pragma("unroll") for (int rep_ = 0; rep_ < (REP_PHASE == 14 ? 2 : 1); ++rep_) if (PHON(14)) { if (rep_) GRID_BAR(); Frame P = F; P.tid = TID_RELOAD(); P.lane = P.tid & 63;
    phase_subln(P, buf1, buf2, lq1, lk1, lq2, lk2, diff_subln, hn);
    }
    GRID_BAR();
    _Pragma("unroll") for (int rep_ = 0; rep_ < (REP_PHASE == 15 ? 2 : 1); ++rep_) if (PHON(15)) { if (rep_) GRID_BAR(); Frame P = F; P.tid = TID_RELOAD(); P.lane = P.tid & 63;
    { pg8::Gemm g{hn, wdo, T, D, D}; pg8::StaticOrder S; S.init(T, D, P.G, (int)blockIdx.x); pg8::EpiResF32 E{xres, xres, D};
      pg8::gemm_phase<pg8::EpiResF32, pg8::StaticOrder, false, true>(P.lds, g, S, E, P.tid); }
    }
    GRID_BAR();
    _Pragma("unroll") for (int rep_ = 0; rep_ < (REP_PHASE == 16 ? 2 : 1); ++rep_) if (PHON(16)) { if (rep_) GRID_BAR(); Frame P = F; P.tid = TID_RELOAD(); P.lane = P.tid & 63;
    phase_norm_route(P, xres, norm_ffn + D, wp_r1, hn, tok_e, tok_p, tok_w, ctl + CW_CNT1);
    }
    GRID_BAR();
    _Pragma("unroll") for (int rep_ = 0; rep_ < (REP_PHASE == 17 ? 2 : 1); ++rep_) if (PHON(17)) { if (rep_) GRID_BAR(); Frame P = F; P.tid = TID_RELOAD(); P.lane = P.tid & 63;
    moe_tables(P, ctl + CW_CNT1);
    phase_moe_slots(P, tok_e, tok_p, ctl + CW_CNT1, slot_of, slot_tok);
    }
    GRID_BAR();
    _Pragma("unroll") for (int rep_ = 0; rep_ < (REP_PHASE == 18 ? 2 : 1); ++rep_) if (PHON(18)) { if (rep_) GRID_BAR(); Frame P = F; P.tid = TID_RELOAD(); P.lane = P.tid & 63;
    { const int Mr = pst[33] * 256; pg8::Gemm g{hn, (bf16_t*)(ws + WS_WMOE1), Mr, 1024, D}; pg8::MoeOrder S; S.init(Mr, 1024, P.G, (int)blockIdx.x); S.te = pst + 36; S.estride = (size_t)1024 * D; S.stok = slot_tok; pg8::EpiSiluMul E{(unsigned char*)hh};
      pg8::gemm_phase<pg8::EpiSiluMul, pg8::MoeOrder, true, true>(P.lds, g, S, E, P.tid); }
    }
    GRID_BAR();
    _Pragma("unroll") for (int rep_ = 0; rep_ < (REP_PHASE == 19 ? 2 : 1); ++rep_) if (PHON(19)) { if (rep_) GRID_BAR(); Frame P = F; P.tid = TID_RELOAD(); P.lane = P.tid & 63;
    { const int Mr = pst[33] * 256; pg8::Gemm g{hh, (bf16_t*)(ws + WS_WMOE1_D), Mr, D, DFF}; pg8::MoeOrder S; S.init(Mr, D, P.G, (int)blockIdx.x); S.te = pst + 36; S.estride = (size_t)D * DFF; S.stok = slot_tok; pg8::EpiBf16 E{ob, D};
      pg8::gemm_phase<pg8::EpiBf16, pg8::MoeOrder, false, true>(P.lds, g, S, E, P.tid); }
    }
    GRID_BAR();
    _Pragma("unroll") for (int rep_ = 0; rep_ < (REP_PHASE == 20 ? 2 : 1); ++rep_) if (PHON(20)) { if (rep_) GRID_BAR(); Frame P = F; P.tid = TID_RELOAD(); P.lane = P.tid & 63;
    phase_moe_combine<1>(P, xres, ob, slot_of, tok_w, final_norm, hn);
    }
}

#undef x_in
#undef norm_mix
#undef norm_ffn
#undef gla_w_in
#undef gla_wgu
#undef gla_bg
#undef gla_norm
#undef gla_w_out
#undef diff_w_in
#undef lq1
#undef lk1
#undef lq2
#undef lk2
#undef diff_subln
#undef diff_w_out
#undef moe_wgrp
#undef moe_wexp
#undef moe_wg
#undef moe_wu
#undef moe_wd
#undef final_norm
#undef xres
#undef gz
#undef tok_e
#undef tok_p
#undef tok_w
#undef slot_of
#undef slot_tok
#undef ws
#undef ctl
#undef adec
#undef pcum
#undef sfin
#undef wp_gz
#undef wp_r0
#undef wp_r1
#undef wgi
#undef wgo
#undef wdi
#undef wdo
#undef wmoe_gu
#undef wmoe_d
#undef hn
#undef proj
#undef buf1
#undef buf2
#undef ag
#undef ob
#undef hh

extern "C" void kernel_launch(void* const* d_in, const int* in_sizes, int n_in, void* d_out, int out_size, void* d_ws, size_t ws_size, hipStream_t stream) {
    static int grid = 0;
    if (grid == 0) {
        if (n_in != 21 || out_size != T * D || ws_size < WS_END) { fprintf(stderr, "kernel_launch: unexpected shapes (n_in %d out %d ws %zu)\n", n_in, out_size, ws_size); grid = -1; return; }
        if (hipFuncSetAttribute((const void*)hybrid_fwd, hipFuncAttributeMaxDynamicSharedMemorySize, LDS_BYTES) != hipSuccess) { fprintf(stderr, "kernel_launch: hipFuncSetAttribute failed\n"); grid = -1; return; }
        int dev = 0, cus = 0, per_cu = 0;
        (void)hipGetDevice(&dev); (void)hipDeviceGetAttribute(&cus, hipDeviceAttributeMultiprocessorCount, dev);
        if (hipOccupancyMaxActiveBlocksPerMultiprocessor(&per_cu, (const void*)hybrid_fwd, NWAVES * 64, LDS_BYTES) != hipSuccess || per_cu < 1) fprintf(stderr, "kernel_launch: occupancy query says %d\n", per_cu);
        (void)hipGetLastError();
        grid = cus > 0 ? cus : 256;
    }
    if (grid < 0) return;
    Args a{};
    for (int i = 0; i < 21; ++i) a.in[i] = (const float*)d_in[i];
    a.out = (float*)d_out; a.ws = (unsigned char*)d_ws; a.pad0 = 0; a.pad1 = 0;
    (void)hipMemsetAsync((char*)d_ws + WS_CTL, 0, CTL_ZERO_BYTES, stream);
    hipLaunchKernelGGL(hybrid_fwd, dim3(grid), dim3(NWAVES * 64), LDS_BYTES, stream, a);
}
```

```cpp
#ifndef REP_PHASE
#define REP_PHASE -1
#endif
#include <hip/hip_runtime.h>
#include <cstdio>
#include <cstdint>

#define LAS __attribute__((address_space(3)))
#define GAS __attribute__((address_space(1)))
typedef unsigned short bf16_t;
typedef short bf16x8 __attribute__((ext_vector_type(8)));
typedef short s16x4 __attribute__((ext_vector_type(4)));
typedef float f32x4 __attribute__((ext_vector_type(4)));
typedef float f32x2 __attribute__((ext_vector_type(2)));
typedef float f32x16 __attribute__((ext_vector_type(16)));
typedef unsigned u32x4 __attribute__((ext_vector_type(4)));
typedef unsigned u32x2 __attribute__((ext_vector_type(2)));
typedef int v8i32 __attribute__((ext_vector_type(8)));
typedef int v4i32 __attribute__((ext_vector_type(4)));

constexpr int D = 2048, SEQ = 16384, NBATCH = 2, T = NBATCH * SEQ, CHUNK = 64, NCH = SEQ / CHUNK;
constexpr int GLA_H = 4, GLA_DK = 256, GLA_DV = 512, GLA_DKT = 1024, GLA_INW = 6160, PROJW = 6144;
constexpr int DIFF_H = 8;
constexpr int NEXP = 32, DFF = 512;
constexpr float RMS_EPS = 1e-6f;
constexpr float LAMBDA_INIT = 0.35550906759f;
constexpr int MAX_TILES = 288;

constexpr size_t MiB = 1u << 20;
constexpr size_t WS_CTL = 0, CTL_ZERO_BYTES = 1 * MiB;
constexpr size_t WS_GZ = 2 * MiB;
constexpr size_t WS_TOKE = 4 * MiB;
constexpr size_t WS_TOKP = WS_TOKE + 256 * 1024;
constexpr size_t WS_TOKW = WS_TOKP + 256 * 1024;
constexpr size_t WS_SLOT = WS_TOKW + 256 * 1024;
constexpr size_t WS_STOK = 5 * MiB;
constexpr size_t WS_ADEC = 8 * MiB;
constexpr size_t WS_WPGZ = 10 * MiB;
constexpr size_t WS_WPR0 = 10 * MiB + 256 * 1024;
constexpr size_t WS_WPR1 = 11 * MiB;
constexpr size_t WS_NRM = 12 * MiB;
constexpr size_t WS_PCUM = 13 * MiB;
constexpr size_t WS_SFIN = 14 * MiB;
constexpr size_t WS_WGI = 16 * MiB, WS_WGO = 40 * MiB, WS_WDI = 48 * MiB, WS_WDO = 72 * MiB;
constexpr size_t WS_WMOE = 80 * MiB;
constexpr size_t WS_WMOE_D = WS_WMOE + 128 * MiB;
constexpr size_t WS_WMOE1 = WS_WMOE + 64 * MiB, WS_WMOE1_D = WS_WMOE + 160 * MiB;
constexpr size_t WS_HN = 272 * MiB;
constexpr size_t WS_PROJ = 400 * MiB;
constexpr size_t WS_BUF1 = 784 * MiB;
constexpr size_t WS_BUF2 = 912 * MiB;
constexpr size_t WS_AG = 400 * MiB;
constexpr size_t WS_OB = 688 * MiB;
constexpr size_t WS_H = 976 * MiB;
constexpr size_t WS_END = 1048 * MiB;
constexpr int CW_BAR = 4096;
constexpr int CW_QUEUE = 8192;
constexpr int CW_CNT0 = 16384, CW_CNT1 = 16384 + 32 * 64;


constexpr size_t GK0 = (size_t)T * 1024, GV0 = (size_t)T * 2048, GR0 = (size_t)T * 4096;
constexpr size_t DK0 = (size_t)T * 2048, DV0 = (size_t)T * 4096;
__host__ __device__ __forceinline__ size_t gq_off(int b, int t, int h) { return ((size_t)(b * 4 + h) * SEQ + t) * 256; }
__host__ __device__ __forceinline__ size_t gv_off(int b, int t, int h) { return GV0 + ((size_t)(b * 4 + h) * SEQ + t) * 512; }
__host__ __device__ __forceinline__ size_t dq_off(int b, int t, int h, int sub) { return ((size_t)((b * 8 + h) * 2 + sub) * SEQ + t) * 128; }
__host__ __device__ __forceinline__ size_t dv_off(int b, int t, int h) { return DV0 + ((size_t)(b * 8 + h) * SEQ + t) * 256; }

constexpr int RING_BYTES = 131072;
constexpr int LDSCTL_OFF = RING_BYTES;
constexpr int MISC_OFF = LDSCTL_OFF + 320;
constexpr int TIDS_OFF = LDSCTL_OFF + 8192;
constexpr int TAB_OFF = LDSCTL_OFF + 1024;
constexpr int LDS_BYTES = 147456;
constexpr int NWAVES = 8;

typedef __bf16 bf16x2_t __attribute__((ext_vector_type(2)));
__device__ __forceinline__ unsigned cvt_pk_bf16(float lo, float hi) { const f32x2 v = {lo, hi}; return __builtin_bit_cast(unsigned, __builtin_convertvector(v, bf16x2_t)); }
__device__ __forceinline__ unsigned cvt4_fp8(float a, float b, float c, float d) { int v = __builtin_amdgcn_cvt_pk_fp8_f32(a, b, 0, false); return (unsigned)__builtin_amdgcn_cvt_pk_fp8_f32(c, d, v, true); }
constexpr float W8_SCALE = 64.f;
__device__ __forceinline__ float bf_lo(unsigned w) { return __uint_as_float(w << 16); }
__device__ __forceinline__ float bf_hi(unsigned w) { return __uint_as_float(w & 0xffff0000u); }
__device__ __forceinline__ float bf2f(bf16_t b) { return __uint_as_float(((unsigned)b) << 16); }
__device__ __forceinline__ float wave_sum(float v) {
#pragma unroll
    for (int o = 1; o < 64; o <<= 1) v += __shfl_xor(v, o);
    return v;
}
__device__ __forceinline__ int lane_id() { return (int)__builtin_amdgcn_mbcnt_hi(~0u, __builtin_amdgcn_mbcnt_lo(~0u, 0u)); }
__device__ __forceinline__ int lane_id_volatile() { int l; asm volatile("v_mbcnt_lo_u32_b32 %0, -1, 0\n\tv_mbcnt_hi_u32_b32 %0, -1, %0" : "=v"(l)); return l; }
__device__ __forceinline__ int opq(int v) { asm volatile("" : "+v"(v)); return v; }
#define LDS_WAIT() asm volatile("s_waitcnt lgkmcnt(0)" ::: "memory")
#define VM_WAIT() asm volatile("s_waitcnt vmcnt(0)" ::: "memory")
#define WG_BAR() do { asm volatile("s_waitcnt lgkmcnt(0)" ::: "memory"); __builtin_amdgcn_s_barrier(); asm volatile("" ::: "memory"); } while (0)

namespace pg8 {
constexpr int BM = 256, BK = 64, HALF = 128, HTB = HALF * BK * 2, STAGE_BYTES = 8 * HTB, NXCD = 8, WGM = 8;
__host__ __device__ __forceinline__ int lds_byte(int r, int c) { const int st = (r >> 4) * 2 + (c >> 5), rr = r & 15, cc = c & 31, ob = rr * 64 + cc * 2; return st * 1024 + (ob ^ (((ob >> 9) & 1) << 5)); }
__host__ __device__ __forceinline__ void stage_rc(int b, int& R, int& C) { const int st = b / 1024, sb = b % 1024, swz = sb ^ (((sb >> 9) & 1) << 5); R = (st >> 1) * 16 + swz / 64; C = (st & 1) * 32 + (swz % 64) / 2; }
__host__ __device__ __forceinline__ int perm32(int rho) { const int n = rho >> 4, i = rho & 15; return 8 * (i >> 2) + 4 * n + (i & 3); }

struct Unit { int pm, pn; };
struct Gemm { const bf16_t* A; const bf16_t* Bt; int M, N, K; };

struct StaticOrder {
    int nM, nN, nwg, G, c;
    __device__ void init(int M, int N, int G_, int c_) { nM = M / BM; nN = N / BM; nwg = nM * nN; G = G_; c = c_; }
    __device__ bool next(int i, Unit& u) const {
        const long L = (long)i * G + c; if (L >= nwg) return false;
        int wgid = (int)L; { const int q = nwg / NXCD, r = nwg % NXCD, xcd = wgid % NXCD, off = wgid / NXCD; wgid = (xcd < r ? xcd * (q + 1) : r * (q + 1) + (xcd - r) * q) + off; }
        const int nig = WGM * nN, gid = wgid / nig, fm = gid * WGM, gsz = (nM - fm) < WGM ? (nM - fm) : WGM;
        u.pm = fm + ((wgid % nig) % gsz); u.pn = (wgid % nig) / gsz; return true;
    }
    __device__ __forceinline__ size_t bofs(const Unit&) const { return 0; }
};
struct MoeOrder : StaticOrder {
    const LAS int* te; size_t estride; const int* stok;
    __device__ __forceinline__ size_t bofs(const Unit& u) const { return (size_t)te[u.pm] * estride; }
    __device__ __forceinline__ int arow(int pm, int r) const { const int t = stok[pm * BM + r]; return t < 0 ? 0 : t; }
};

struct EpiBf16 {
    static constexpr bool PERM = true;
    bf16_t* O; int ldc;
    __device__ __forceinline__ void operator()(const f32x4 (&acc)[2][2][4][2], const Unit& u, int wr, int wc, int fr, int fq) const {
        const int row0 = u.pm * BM + wr * 64 + fr, col0 = u.pn * BM + wc * 32 + 8 * fq;
#pragma unroll
        for (int ai = 0; ai < 2; ++ai)
#pragma unroll
            for (int m = 0; m < 4; ++m) { bf16_t* rowp = O + (size_t)(row0 + ai * HALF + m * 16) * ldc + col0;
#pragma unroll
                for (int bj = 0; bj < 2; ++bj) { const f32x4 v0 = acc[ai][bj][m][0], v1 = acc[ai][bj][m][1];
                    u32x4 w; w.x = cvt_pk_bf16(v0[0], v0[1]); w.y = cvt_pk_bf16(v0[2], v0[3]); w.z = cvt_pk_bf16(v1[0], v1[1]); w.w = cvt_pk_bf16(v1[2], v1[3]);
                    *(u32x4*)(rowp + bj * HALF) = w; } }
    }
};
template <int LAYER> struct EpiHeads {
    static constexpr bool PERM = true;
    bf16_t* O;
    __device__ __forceinline__ void operator()(const f32x4 (&acc)[2][2][4][2], const Unit& u, int wr, int wc, int fr, int fq) const {
        const int pn = u.pn, lc = wc * 32 + 8 * fq;
#pragma unroll
        for (int ai = 0; ai < 2; ++ai)
#pragma unroll
            for (int m = 0; m < 4; ++m) { const int row = u.pm * BM + ai * HALF + wr * 64 + m * 16 + fr, b = row >> 14, t = row & (SEQ - 1);
#pragma unroll
                for (int bj = 0; bj < 2; ++bj) { size_t off;
                    if (LAYER == 0) { if (pn < 4) off = gq_off(b, t, pn) + bj * 128 + lc; else if (pn < 8) off = GK0 + gq_off(b, t, pn - 4) + bj * 128 + lc;
                                      else if (pn < 16) off = gv_off(b, t, (pn - 8) >> 1) + ((pn - 8) & 1) * 256 + bj * 128 + lc; else off = GR0 + (size_t)row * 2048 + (pn - 16) * 256 + bj * 128 + lc; }
                    else { if (pn < 8) off = dq_off(b, t, pn, bj) + lc; else if (pn < 16) off = DK0 + dq_off(b, t, pn - 8, bj) + lc; else off = dv_off(b, t, pn - 16) + bj * 128 + lc; }
                    const f32x4 v0 = acc[ai][bj][m][0], v1 = acc[ai][bj][m][1];
                    if (LAYER == 1 && pn < 16) {
                        u32x2 w8; w8.x = cvt4_fp8(v0[0], v0[1], v0[2], v0[3]); w8.y = cvt4_fp8(v1[0], v1[1], v1[2], v1[3]); *(u32x2*)((unsigned char*)O + off) = w8; continue; }
                    u32x4 w; w.x = cvt_pk_bf16(v0[0], v0[1]); w.y = cvt_pk_bf16(v0[2], v0[3]); w.z = cvt_pk_bf16(v1[0], v1[1]); w.w = cvt_pk_bf16(v1[2], v1[3]);
                    *(u32x4*)(O + off) = w; } }
    }
};
struct FixOrder : StaticOrder {
    __device__ __forceinline__ size_t bofs(const Unit& u) const { return (size_t)(u.pm >> 5) * (512 * 256 * 2); }
};
struct EpiAddO {
    static constexpr bool PERM = true;
    bf16_t* O;
    __device__ __forceinline__ void operator()(const f32x4 (&acc)[2][2][4][2], const Unit& u, int wr, int wc, int fr, int fq) const {
#pragma unroll
        for (int ai = 0; ai < 2; ++ai)
#pragma unroll
            for (int m = 0; m < 4; ++m) { const int row = u.pm * BM + ai * HALF + wr * 64 + m * 16 + fr, bhh = row >> 13, t = row & 8191;
                bf16_t* rowp = O + ((size_t)(bhh >> 2) * SEQ + SEQ / 2 + t) * D + (bhh & 3) * 512 + u.pn * BM + wc * 32 + 8 * fq;
#pragma unroll
                for (int bj = 0; bj < 2; ++bj) { const u32x4 old = *(const u32x4*)(rowp + bj * HALF); const f32x4 v0 = acc[ai][bj][m][0] * 0.0625f, v1 = acc[ai][bj][m][1] * 0.0625f;
                    u32x4 w; w.x = cvt_pk_bf16(bf_lo(old.x) + v0[0], bf_hi(old.x) + v0[1]); w.y = cvt_pk_bf16(bf_lo(old.y) + v0[2], bf_hi(old.y) + v0[3]);
                    w.z = cvt_pk_bf16(bf_lo(old.z) + v1[0], bf_hi(old.z) + v1[1]); w.w = cvt_pk_bf16(bf_lo(old.w) + v1[2], bf_hi(old.w) + v1[3]);
                    *(u32x4*)(rowp + bj * HALF) = w; } }
    }
};
struct EpiResF32 {
    static constexpr bool PERM = false;
    const float* base; float* C; int ldc;
    __device__ __forceinline__ void operator()(const f32x4 (&acc)[2][2][4][2], const Unit& u, int wr, int wc, int fr, int fq) const {
        const int row0 = u.pm * BM + wr * 64 + fr, col0 = u.pn * BM + wc * 32 + 4 * fq;
#pragma unroll
        for (int ai = 0; ai < 2; ++ai)
#pragma unroll
            for (int m = 0; m < 4; ++m) { const size_t off = (size_t)(row0 + ai * HALF + m * 16) * ldc + col0;
#pragma unroll
                for (int bj = 0; bj < 2; ++bj)
#pragma unroll
                    for (int n = 0; n < 2; ++n) { const f32x4 bs = *(const f32x4*)(base + off + bj * HALF + n * 16); *(f32x4*)(C + off + bj * HALF + n * 16) = bs + acc[ai][bj][m][n]; }
                asm volatile("" ::: "memory"); }
    }
};
struct EpiSiluMul {
    static constexpr bool PERM = true;
    unsigned char* Hh;
    __device__ __forceinline__ void operator()(const f32x4 (&acc)[2][2][4][2], const Unit& u, int wr, int wc, int fr, int fq) const {
        const int row0 = u.pm * BM + wr * 64 + fr, col0 = u.pn * HALF + wc * 32 + 8 * fq;
#pragma unroll
        for (int ai = 0; ai < 2; ++ai)
#pragma unroll
            for (int m = 0; m < 4; ++m) { unsigned char* rowp = Hh + (size_t)(row0 + ai * HALF + m * 16) * DFF + col0;
                float hv[8];
#pragma unroll
                for (int n = 0; n < 2; ++n)
#pragma unroll
                    for (int j = 0; j < 4; ++j) { const float g = acc[ai][0][m][n][j], up = acc[ai][1][m][n][j];
                        const float sg = g * __builtin_amdgcn_rcpf(1.0f + __builtin_amdgcn_exp2f(-1.4426950408889634f * g)); hv[n * 4 + j] = sg * up; }
                u32x2 w; w.x = cvt4_fp8(hv[0], hv[1], hv[2], hv[3]); w.y = cvt4_fp8(hv[4], hv[5], hv[6], hv[7]);
                *(u32x2*)rowp = w; }
    }
};

template <class Epi, class Sched, bool GATHER = false, bool FP8 = false>
__device__ __forceinline__ void gemm_phase(LAS unsigned char* lds, const Gemm g, const Sched& S, const Epi& E, int tid_in) {
    const int tid = opq(tid_in), wid = __builtin_amdgcn_readfirstlane(tid >> 6), lane = tid & 63, wr = wid >> 2, wc = wid & 3, fr = lane & 15, fq = lane >> 4;
    const int K = g.K, RP = FP8 ? K : 2 * K  , nt = RP / (BK * 2);
    unsigned voffA[2], voffB[2];
#pragma unroll
    for (int i = 0; i < 2; ++i) { int R, C; stage_rc(tid * 16 + i * 8192, R, C); const int Rb = Epi::PERM ? ((R & ~31) + perm32(R & 31)) : R;
        voffA[i] = (unsigned)(R * RP + 2 * C); voffB[i] = (unsigned)(Rb * RP + 2 * C); }
    const unsigned kstep = (unsigned)(BK * 2);
    const unsigned hstep = (unsigned)HALF * (unsigned)RP;
    const size_t tstep = 2 * (size_t)hstep;
    const unsigned ldsw = (unsigned)wid * 1024u;
    const int aoff = lds_byte(wr * 64 + fr, fq * 8), boff = lds_byte(wc * 32 + fr, fq * 8);
    const LAS unsigned char* ldsB = lds + 4 * HTB + boff;
#define PG8_SA(b, h) (((b) * 2 + (h)) * HTB)
#define PG8_SB(b, h) ((4 + (b) * 2 + (h)) * HTB)
#define PG8_STAGE(bufoff, gbase, voff) do { const unsigned long long gv_ = (unsigned long long)(gbase); \
        const unsigned glo_ = (unsigned)__builtin_amdgcn_readfirstlane((unsigned)gv_), ghi_ = (unsigned)__builtin_amdgcn_readfirstlane((unsigned)(gv_ >> 32)); const char* gb_ = (const char*)(((unsigned long long)ghi_ << 32) | (unsigned long long)glo_);     \
        _Pragma("unroll") for (int _i = 0; _i < 2; ++_i) \
        __builtin_amdgcn_global_load_lds((const unsigned*)(gb_ + (voff)[_i]), (LAS unsigned*)(lds + (bufoff) + ldsw + _i * 8192), 16, 0, 0); } while (0)
#define PG8_STAGE_A(bufoff, nx, koff, h) do { if constexpr (GATHER) { unsigned vs_[2]; _Pragma("unroll") for (int _i = 0; _i < 2; ++_i) vs_[_i] = (nx) ? vAn[h][_i] : vAc[h][_i]; \
            PG8_STAGE(bufoff, (const char*)g.A + (koff), vs_); } \
        else { PG8_STAGE(bufoff, ((nx) ? nA : cA) + (koff) + (h) * hstep, voffA); } } while (0)
#define PG8_LD8(off) __builtin_shufflevector(*(const LAS v4i32*)(lds + (off)), *(const LAS v4i32*)(lds + (off) + 1024), 0, 1, 2, 3, 4, 5, 6, 7)
#define PG8_LDA(dst, b, h) do { if constexpr (FP8) { _Pragma("unroll") for (int m = 0; m < 4; ++m) dst##8[m] = PG8_LD8(PG8_SA(b, h) + aoff + m * 2048); } \
        else { _Pragma("unroll") for (int m = 0; m < 4; ++m) _Pragma("unroll") for (int k = 0; k < 2; ++k) dst[m][k] = *(const LAS bf16x8*)(lds + PG8_SA(b, h) + aoff + m * 2048 + k * 1024); } } while (0)
#define PG8_LD8B(off) __builtin_shufflevector(*(const LAS v4i32*)(ldsB + (off)), *(const LAS v4i32*)(ldsB + (off) + 1024), 0, 1, 2, 3, 4, 5, 6, 7)
#define PG8_LDB(dst, b, h) do { if constexpr (FP8) { _Pragma("unroll") for (int n = 0; n < 2; ++n) dst##8[n] = PG8_LD8B(PG8_SA(b, h) + n * 2048); }     \
        else { _Pragma("unroll") for (int n = 0; n < 2; ++n) _Pragma("unroll") for (int k = 0; k < 2; ++k) dst[n][k] = *(const LAS bf16x8*)(lds + PG8_SB(b, h) + boff + n * 2048 + k * 1024); } } while (0)
#define PG8_MMA(ai, bj, At, Bt) do { __builtin_amdgcn_s_setprio(1); if constexpr (FP8) { _Pragma("unroll") for (int m = 0; m < 4; ++m) _Pragma("unroll") for (int n = 0; n < 2; ++n) \
              \
            asm volatile("v_mfma_scale_f32_16x16x128_f8f6f4 %0, %1, %2, %0, %3, %3 op_sel:[0,1,0] op_sel_hi:[0,0,0]" : "+v"(acc[ai][bj][m][n]) : "v"(Bt##8[n]), "v"(At##8[m]), "v"(scl8)); } \
        else { _Pragma("unroll") for (int m = 0; m < 4; ++m) _Pragma("unroll") for (int n = 0; n < 2; ++n) _Pragma("unroll") for (int k = 0; k < 2; ++k) \
            acc[ai][bj][m][n] = __builtin_amdgcn_mfma_f32_16x16x32_bf16(Bt[n][k], At[m][k], acc[ai][bj][m][n], 0, 0, 0); } __builtin_amdgcn_s_setprio(0); } while (0)
#define PG8_WAIT_V(n) asm volatile("s_waitcnt vmcnt(" #n ")" ::: "memory")
#define PG8_WAIT_L(n) asm volatile("s_waitcnt lgkmcnt(" #n ")" ::: "memory")
#define PG8_BAR __builtin_amdgcn_s_barrier()
#define PG8_SCHED __builtin_amdgcn_sched_barrier(0)
#define PG8_ROWOFFS(V, U) do { if constexpr (GATHER) { const int t_ = opq(wid * 64 + lane_id());     \
        _Pragma("unroll") for (int i_ = 0; i_ < 2; ++i_) { int R_, C_; stage_rc(t_ * 16 + i_ * 8192, R_, C_); \
        _Pragma("unroll") for (int h_ = 0; h_ < 2; ++h_) V[h_][i_] = (unsigned)S.arow((U).pm, h_ * HALF + R_) * (unsigned)RP + 2u * (unsigned)C_; } } } while (0)
    Unit cur, nxt; int ui = 0;
    if (!S.next(0, cur)) return;
    f32x4 acc[2][2][4][2];
#pragma unroll
    for (int a = 0; a < 2; ++a)
#pragma unroll
        for (int b = 0; b < 2; ++b)
#pragma unroll
            for (int m = 0; m < 4; ++m)
#pragma unroll
                for (int n = 0; n < 2; ++n) acc[a][b][m][n] = (f32x4){0.f, 0.f, 0.f, 0.f};
    const unsigned scl8 = 0x7f797f79u;
    bf16x8 At[4][2], B0[2][2], B1[2][2]; v8i32 At8[4], B08[2], B18[2];
    unsigned vAc[2][2] = {{0u, 0u}, {0u, 0u}}, vAn[2][2] = {{0u, 0u}, {0u, 0u}};
    const char* cA = (const char*)g.A + (GATHER ? (size_t)0 : (size_t)cur.pm * tstep); const char* nA = cA; const char* cB = (const char*)g.Bt + S.bofs(cur) + (size_t)cur.pn * tstep;
    PG8_ROWOFFS(vAc, cur);
    PG8_STAGE(PG8_SB(0, 0), cB, voffB); PG8_STAGE(PG8_SB(0, 1), cB + hstep, voffB); PG8_STAGE_A(PG8_SA(0, 0), false, 0u, 0); PG8_STAGE_A(PG8_SA(0, 1), false, 0u, 1);
    if (wr == 1) PG8_BAR;
    PG8_WAIT_V(2); PG8_BAR;
    PG8_STAGE(PG8_SB(1, 0), cB + kstep, voffB); PG8_STAGE_A(PG8_SA(1, 0), false, kstep, 0); PG8_STAGE(PG8_SB(1, 1), cB + hstep + kstep, voffB);
    PG8_WAIT_V(6); PG8_BAR;
    for (;;) {
        const bool has_next = S.next(ui + 1, nxt);
        nA = (has_next && !GATHER) ? (const char*)g.A + (size_t)nxt.pm * tstep : cA; const char* nB = has_next ? (const char*)g.Bt + S.bofs(nxt) + (size_t)nxt.pn * tstep : cB;

        for (int t = 0; t < nt; t += 2) {
            const bool last = (t == nt - 2);
            if constexpr (GATHER) { if (last) {
                if (has_next) PG8_ROWOFFS(vAn, nxt); else { _Pragma("unroll") for (int h_ = 0; h_ < 2; ++h_) _Pragma("unroll") for (int i_ = 0; i_ < 2; ++i_) vAn[h_][i_] = vAc[h_][i_]; } } }
            const unsigned k1 = (unsigned)(t + 1) * kstep, k2 = last ? 0u : (unsigned)(t + 2) * kstep, k3 = k2 + kstep;
            const char* b2 = last ? nB : cB + k2; const char* b3 = b2 + kstep;
            PG8_LDB(B0, 0, 0); PG8_LDB(B1, 0, 1); PG8_SCHED; PG8_LDA(At, 0, 0); PG8_STAGE_A(PG8_SA(1, 1), false, k1, 1);
            PG8_WAIT_V(8); PG8_WAIT_L(0); PG8_BAR; PG8_MMA(0, 0, At, B0); PG8_MMA(0, 1, At, B1); PG8_BAR; PG8_SCHED;
            PG8_LDA(At, 0, 1); PG8_STAGE(PG8_SB(0, 0), b2, voffB); PG8_STAGE(PG8_SB(0, 1), b2 + hstep, voffB); PG8_STAGE_A(PG8_SA(0, 0), last, k2, 0);
            PG8_WAIT_V(8); PG8_WAIT_L(0); PG8_BAR; PG8_MMA(1, 0, At, B0); PG8_MMA(1, 1, At, B1); PG8_BAR; PG8_SCHED;
            PG8_LDB(B0, 1, 0); PG8_LDB(B1, 1, 1); PG8_SCHED; PG8_LDA(At, 1, 0); PG8_STAGE_A(PG8_SA(0, 1), last, k2, 1);
            PG8_WAIT_V(8); PG8_WAIT_L(0); PG8_BAR; PG8_MMA(0, 0, At, B0); PG8_MMA(0, 1, At, B1); PG8_BAR; PG8_SCHED;
            PG8_LDA(At, 1, 1); PG8_STAGE(PG8_SB(1, 0), b3, voffB); PG8_STAGE(PG8_SB(1, 1), b3 + hstep, voffB); PG8_STAGE_A(PG8_SA(1, 0), last, k3, 0);
            PG8_WAIT_V(8); PG8_WAIT_L(0); PG8_BAR; PG8_MMA(1, 0, At, B0); PG8_MMA(1, 1, At, B1); PG8_BAR; PG8_SCHED;
        }
        if (wr == 0) PG8_BAR;
        E(acc, cur, wr, wc, fr, fq);
        if (!has_next) break;
#pragma unroll
        for (int a = 0; a < 2; ++a)
#pragma unroll
            for (int b = 0; b < 2; ++b)
#pragma unroll
                for (int m = 0; m < 4; ++m)
#pragma unroll
                    for (int n = 0; n < 2; ++n) acc[a][b][m][n] = (f32x4){0.f, 0.f, 0.f, 0.f};
        cur = nxt; cA = nA; cB = nB; ++ui;
        if constexpr (GATHER) { _Pragma("unroll") for (int h_ = 0; h_ < 2; ++h_) _Pragma("unroll") for (int i_ = 0; i_ < 2; ++i_) vAc[h_][i_] = vAn[h_][i_]; }
        if (wr == 1) PG8_BAR;
    }
    PG8_WAIT_V(0);
    PG8_BAR;
#undef PG8_SA
#undef PG8_SB
#undef PG8_STAGE
#undef PG8_STAGE_A
#undef PG8_ROWOFFS
#undef PG8_LDA
#undef PG8_LDB
#undef PG8_MMA
#undef PG8_LD8
#undef PG8_LD8B
#undef PG8_WAIT_V
#undef PG8_WAIT_L
#undef PG8_BAR
#undef PG8_SCHED
}
}

#define XB_TMO      128
#define XB_XCNT(j)  (256  + 64 * (j))
#define XB_XSUB(j)  (1280 + 64 * (j))
#define XB_XGEN(j)  (2304 + 64 * (j))
#define XB_TOP      3328
#define XB_TOPGEN   3392
#define XCD_BAR_WORDS 3456
#define XB_SPIN_CAP (1u << 18)
__device__ __forceinline__ unsigned xb_ld(unsigned* p)              { return __hip_atomic_load(p, __ATOMIC_RELAXED, __HIP_MEMORY_SCOPE_AGENT); }
__device__ __forceinline__ unsigned xb_add(unsigned* p, unsigned v) { return __hip_atomic_fetch_add(p, v, __ATOMIC_RELAXED, __HIP_MEMORY_SCOPE_AGENT); }
__device__ __forceinline__ unsigned xb_xcc_id() { return (unsigned)__builtin_amdgcn_s_getreg((3 << 11) | 20) & 0xFu; }
#define XB_SPIN(cond, bar) do { unsigned _sp = 0; while (cond) { __builtin_amdgcn_s_sleep(1); \
    if ((++_sp & 255u) == 0u) { if (xb_ld(&(bar)[XB_TMO])) break; if (_sp > XB_SPIN_CAP) { atomicAdd(&(bar)[XB_TMO], 1u); break; } } } } while (0)
struct XcdBarrier { unsigned* bar; unsigned x; volatile LAS unsigned* st; int wave; };
__device__ __forceinline__ XcdBarrier xcd_barrier_post(unsigned* bar, volatile LAS unsigned* st) {
    XcdBarrier b; b.bar = bar; b.x = xb_xcc_id(); b.st = st; b.wave = __builtin_amdgcn_readfirstlane((int)threadIdx.x >> 6);
    if (threadIdx.x == 0) (void)xb_add(&bar[XB_XCNT(b.x)], 1u);
    return b;
}
__device__ __forceinline__ void xcd_barrier_complete(unsigned* bar, unsigned x, unsigned& nloc, unsigned& nx) {
    const unsigned G = gridDim.x * gridDim.y * gridDim.z;
    unsigned sum, cnt, mine, sp = 0u;
    for (;;) {
        sum = 0u; cnt = 0u; mine = 0u;
#pragma unroll
        for (unsigned j = 0; j < 16; ++j) { const unsigned c = xb_ld(&bar[XB_XCNT(j)]); sum += c; cnt += (c > 0u) ? 1u : 0u; mine = (j == x) ? c : mine; }
        if (sum == G) break;
        __builtin_amdgcn_s_sleep(1);
        if ((++sp & 255u) == 0u) { if (xb_ld(&bar[XB_TMO])) break; if (sp > XB_SPIN_CAP) { atomicAdd(&bar[XB_TMO], 1u); break; } }
    }
    nloc = mine > 0u ? mine : 1u; nx = cnt > 0u ? cnt : 1u;
}
__device__ __forceinline__ void xcd_barrier(const XcdBarrier& b, bool leader  ) {
    asm volatile("s_waitcnt vmcnt(0)" ::: "memory");
    __syncthreads();
    if (leader) {
        unsigned* bar = b.bar;
        __builtin_amdgcn_s_waitcnt(0);
        unsigned nloc = b.st[0], nx = b.st[1];
        if (nloc == 0u) { xcd_barrier_complete(bar, b.x, nloc, nx); b.st[0] = nloc; b.st[1] = nx; }
        const unsigned old = xb_add(&bar[XB_XSUB(b.x)], 1u);
        const unsigned gen = old / nloc;
        if (old + 1u == (gen + 1u) * nloc) {
            __builtin_amdgcn_fence(__ATOMIC_RELEASE, "agent");
            asm volatile("s_waitcnt vmcnt(0)" ::: "memory");
            const unsigned og = xb_add(&bar[XB_TOP], 1u);
            const unsigned tg = og / nx;
            if (og + 1u == (tg + 1u) * nx) xb_add(&bar[XB_TOPGEN], 1u);
            else XB_SPIN(xb_ld(&bar[XB_TOPGEN]) == tg, bar);
            __builtin_amdgcn_fence(__ATOMIC_ACQUIRE, "agent");
            xb_add(&bar[XB_XGEN(b.x)], 1u);
            asm volatile("s_waitcnt vmcnt(0)" ::: "memory");
        } else {
            XB_SPIN(xb_ld(&bar[XB_XGEN(b.x)]) == gen, bar);
            __builtin_amdgcn_fence(__ATOMIC_ACQUIRE, "agent");
            asm volatile("s_waitcnt vmcnt(0)" ::: "memory");
        }
    }
    __syncthreads();
}

struct Frame {
    LAS unsigned char* lds;
    int tid, lane, wave, vcu, G;
};
struct Args {
    const float* in[21]; float* out; unsigned char* ws; int pad0, pad1;
};

template <bool FP8 = false>
__device__ __forceinline__ void transpose_item(const float* W, int ldw, int k0, int n0, bf16_t* WT, int ldk, int drow0, LAS float* scr, int lane) {
    float tv[32];
    const float* wp_ = W + (size_t)(k0 + (lane >> 5)) * ldw + n0 + (lane & 31);
#pragma unroll
    for (int i = 0; i < 32; ++i) tv[i] = wp_[(size_t)(2 * i) * ldw];
#pragma unroll
    for (int i = 0; i < 32; ++i) scr[(2 * i + (lane >> 5)) * 33 + (lane & 31)] = tv[i];
    LDS_WAIT(); asm volatile("" ::: "memory");
    const int c = lane & 7;
#pragma unroll
    for (int j = 0; j < 4; ++j) { const int n = (lane >> 3) + 8 * j; const LAS float* s = scr + (8 * c) * 33 + n;
        if constexpr (FP8) { u32x2 o; o.x = cvt4_fp8(s[0 * 33] * W8_SCALE, s[1 * 33] * W8_SCALE, s[2 * 33] * W8_SCALE, s[3 * 33] * W8_SCALE); o.y = cvt4_fp8(s[4 * 33] * W8_SCALE, s[5 * 33] * W8_SCALE, s[6 * 33] * W8_SCALE, s[7 * 33] * W8_SCALE);
            *(u32x2*)((unsigned char*)WT + (size_t)(drow0 + n) * ldk + k0 + 8 * c) = o; }
        else { u32x4 o; o.x = cvt_pk_bf16(s[0 * 33], s[1 * 33]); o.y = cvt_pk_bf16(s[2 * 33], s[3 * 33]); o.z = cvt_pk_bf16(s[4 * 33], s[5 * 33]); o.w = cvt_pk_bf16(s[6 * 33], s[7 * 33]);
            *(u32x4*)(WT + (size_t)(drow0 + n) * ldk + k0 + 8 * c) = o; } }
    LDS_WAIT(); asm volatile("" ::: "memory");
}
template <bool FP8 = false>
__device__ __forceinline__ void conv_plain(Frame& F, const float* W, int K, int N, int ldw, bf16_t* WT, int rank = -1, int nrank = 0) {
    LAS float* scr = (LAS float*)(F.lds + F.wave * 16384);
    const int gw = (rank < 0 ? F.vcu : rank) * NWAVES + F.wave, NGW = (rank < 0 ? F.G : nrank) * NWAVES, nblk = N / 32, nit = (K / 64) * nblk;
    for (int it = gw; it < nit; it += NGW) { const int kb = it / nblk, nb = it % nblk; transpose_item<FP8>(W, ldw, 64 * kb, 32 * nb, WT, K, 32 * nb, scr, F.lane); }
}
__device__ __forceinline__ void conv_moe(Frame& F, const float* wg, const float* wu, const float* wd, bf16_t* GU, bf16_t* DT, int rank = -1, int nrank = 0) {
    LAS float* scr = (LAS float*)(F.lds + F.wave * 16384);
    const int gw = (rank < 0 ? F.vcu : rank) * NWAVES + F.wave, NGW = (rank < 0 ? F.G : nrank) * NWAVES;
    constexpr int PER_E = 1536, NIT = NEXP * PER_E;
    for (int it = gw; it < NIT; it += NGW) {
        const int e = it / PER_E; int r = it % PER_E;
        if (r < 1024) { const int up = r >> 9; r &= 511; const int kb = r >> 4, nb = r & 15, n0 = 32 * nb;
            const int drow = 256 * (n0 >> 7) + 128 * up + (n0 & 127);
            transpose_item<true>((up ? wu : wg) + (size_t)e * D * DFF, DFF, 64 * kb, n0, (bf16_t*)((unsigned char*)GU + (size_t)e * 1024 * D), D, drow, scr, F.lane); }
        else { r -= 1024; const int kb = r >> 6, nb = r & 63;
            transpose_item<true>(wd + (size_t)e * DFF * D, D, 64 * kb, 32 * nb, (bf16_t*)((unsigned char*)DT + (size_t)e * D * DFF), DFF, 32 * nb, scr, F.lane); }
    }
}
__device__ __forceinline__ void pack_proj(Frame& F, float* Wp, int NT, const float* gain, const float* Wa, int lda, int ca0, int na, const float* Wb, int ldb, int nb) {
    const int total = 128 * NT * 256;
    for (int idx = (F.vcu * NWAVES * 64) + F.tid; idx < total; idx += F.G * NWAVES * 64) {
        const int e = idx & 3, ln = (idx >> 2) & 63, rest = idx >> 8, nt = rest % NT, s = rest / NT;
        const int k = 16 * s + 4 * (ln >> 4) + e, col = 16 * nt + (ln & 15);
        float v = 0.f;
        if (col < na) v = Wa[(size_t)k * lda + ca0 + col]; else if (col < na + nb) v = Wb[(size_t)k * ldb + (col - na)];
        Wp[idx] = v * gain[k];
    }
}

template <int NT>
__device__ __forceinline__ float wave_proj16(LAS unsigned char* lds, const float* xin, int tok0, const float* Wp, int tid, int wid, int lane, f32x4 (&acc)[NT]) {
    const int tr = lane & 15, kq = lane >> 4;
    const f32x4* xp = (const f32x4*)(xin + (size_t)(tok0 + tr) * D) + kq;
    constexpr int CH = 16 * NT * 1024;
    const char* wsrc = (const char*)Wp + tid * 16;
    float ssq = 0.f;
#pragma unroll
    for (int n = 0; n < NT; ++n) acc[n] = (f32x4){0.f, 0.f, 0.f, 0.f};
    f32x4 X[16];
#define NP_DMA(c, buf) do { _Pragma("unroll") for (int r = 0; r < 2 * NT; ++r) \
        __builtin_amdgcn_global_load_lds((const unsigned*)(wsrc + (size_t)(c) * CH + r * 8192), (LAS unsigned*)(lds + (buf) * CH + r * 8192 + wid * 1024), 16, 0, 0); } while (0)
#define NP_CHUNK(c, buf, more) do { \
        asm volatile("s_waitcnt vmcnt(16)" ::: "memory"); WG_BAR(); \
        if (more) NP_DMA((c) + 1, 1 - (buf)); \
        asm volatile("" ::: "memory");     \
        const f32x4* xn_ = xp + 64 * ((c) + 1); \
        _Pragma("unroll") for (int s = 0; s < 16; ++s) { const f32x4 xv = X[s]; if (more) X[s] = xn_[4 * s]; \
            ssq += (xv[0] * xv[0] + xv[1] * xv[1]) + (xv[2] * xv[2] + xv[3] * xv[3]); \
            _Pragma("unroll") for (int n = 0; n < NT; ++n) { const f32x4 wv = *(const LAS f32x4*)(lds + (buf) * CH + ((s * NT + n) * 64 + lane) * 16); \
                _Pragma("unroll") for (int e = 0; e < 4; ++e) acc[n] = __builtin_amdgcn_mfma_f32_16x16x4f32(xv[e], wv[e], acc[n], 0, 0, 0); } } } while (0)
    NP_DMA(0, 0);
    asm volatile("" ::: "memory");
#pragma unroll
    for (int s = 0; s < 16; ++s) X[s] = xp[4 * s];
    for (int c = 0; c < 6; c += 2) { NP_CHUNK(c, 0, true); NP_CHUNK(c + 1, 1, true); }
    NP_CHUNK(6, 0, true); NP_CHUNK(7, 1, false);
    WG_BAR();
#undef NP_DMA
#undef NP_CHUNK
    ssq += __shfl_xor(ssq, 16); ssq += __shfl_xor(ssq, 32);
    return 1.0f / sqrtf(ssq * (1.0f / D) + RMS_EPS);
}
template <bool FP8 = false>
__device__ __forceinline__ void wave_write_hn16(const float* xin, int tok0, float rstd, const float* gain, bf16_t* hn, int lane) {
    f32x4 g4[8];
#pragma unroll
    for (int j = 0; j < 8; ++j) g4[j] = ((const f32x4*)gain)[lane + 64 * j];
    for (int i = 0; i < 16; i += 2) {
        const float r0 = __shfl(rstd, i), r1 = __shfl(rstd, i + 1);
        const f32x4* x0 = (const f32x4*)(xin + (size_t)(tok0 + i) * D); const f32x4* x1 = x0 + D / 4;
        u32x2* o0 = (u32x2*)(hn + (size_t)(tok0 + i) * D); u32x2* o1 = o0 + D / 4;
        unsigned* p0 = (unsigned*)((unsigned char*)hn + (size_t)(tok0 + i) * D); unsigned* p1 = p0 + D / 4;
        f32x4 a[8], c[8];
#pragma unroll
        for (int j = 0; j < 8; ++j) { a[j] = x0[lane + 64 * j]; c[j] = x1[lane + 64 * j]; }
#pragma unroll
        for (int j = 0; j < 8; ++j) { const f32x4 v = a[j] * r0 * g4[j], u = c[j] * r1 * g4[j];
            if constexpr (FP8) { p0[lane + 64 * j] = cvt4_fp8(v[0], v[1], v[2], v[3]); p1[lane + 64 * j] = cvt4_fp8(u[0], u[1], u[2], u[3]); }
            else { u32x2 w; w.x = cvt_pk_bf16(v[0], v[1]); w.y = cvt_pk_bf16(v[2], v[3]); o0[lane + 64 * j] = w;
                u32x2 z; z.x = cvt_pk_bf16(u[0], u[1]); z.y = cvt_pk_bf16(u[2], u[3]); o1[lane + 64 * j] = z; } }
    }
}

__device__ __forceinline__ void phase_norm_gz(Frame& F, const float* xin, const float* gain, const float* Wp, bf16_t* hn, float* gz) {
    for (int tile = F.vcu; tile < T / 128; tile += F.G) {
        const int tok0 = tile * 128 + F.wave * 16;
        f32x4 acc[1];
        const float rstd = wave_proj16<1>(F.lds, xin, tok0, Wp, F.tid, F.wave, F.lane, acc);
        const int j = F.lane & 15, q4 = F.lane >> 4;
#pragma unroll
        for (int r = 0; r < 4; ++r) { const float rr = __shfl(rstd, 4 * q4 + r); gz[(size_t)(tok0 + 4 * q4 + r) * 16 + j] = acc[0][r] * rr; }
        wave_write_hn16(xin, tok0, rstd, gain, hn, F.lane);
    }
}
__device__ __forceinline__ void phase_norm_route(Frame& F, const float* xin, const float* gain, const float* Wp, bf16_t* hn, int* tok_e, int* tok_p, float* tok_w, unsigned* cnt) {
    LAS float* lg = (LAS float*)(F.lds + 98304 + F.wave * 3072);
    for (int tile = F.vcu; tile < T / 128; tile += F.G) {
        const int tok0 = tile * 128 + F.wave * 16;
        f32x4 acc[3];
        const float rstd = wave_proj16<3>(F.lds, xin, tok0, Wp, F.tid, F.wave, F.lane, acc);
        const int j = F.lane & 15, q4 = F.lane >> 4;
#pragma unroll
        for (int r = 0; r < 4; ++r) { const float rr = __shfl(rstd, 4 * q4 + r);
#pragma unroll
            for (int n = 0; n < 3; ++n) lg[(4 * q4 + r) * 48 + 16 * n + j] = acc[n][r] * rr; }
        LDS_WAIT(); asm volatile("" ::: "memory");
        if (F.lane < 16) {
            const LAS float* l = lg + F.lane * 48;
            float gm = l[0]; int gi = 0;
#pragma unroll
            for (int q = 1; q < 4; ++q) { const float v = l[q]; if (v > gm) { gm = v; gi = q; } }
            float gs = 0.f;
#pragma unroll
            for (int q = 0; q < 4; ++q) gs += __expf(l[q] - gm);
            const float gw = 1.0f / gs;
            const LAS float* se = l + 4 + 8 * gi;
            float m1 = se[0]; int i1 = 0;
#pragma unroll
            for (int q = 1; q < 8; ++q) { const float v = se[q]; if (v > m1) { m1 = v; i1 = q; } }
            float m2 = -3.0e38f; int i2 = 0;
#pragma unroll
            for (int q = 0; q < 8; ++q) { const float v = se[q]; if (q != i1 && v > m2) { m2 = v; i2 = q; } }
            const float eb = __expf(m2 - m1), inv = 1.0f / (1.0f + eb);
            const int t = tok0 + F.lane, e1 = gi * 8 + i1, e2 = gi * 8 + i2;
            const unsigned p1 = __hip_atomic_fetch_add(cnt + 64 * e1, 1u, __ATOMIC_RELAXED, __HIP_MEMORY_SCOPE_AGENT);
            const unsigned p2 = __hip_atomic_fetch_add(cnt + 64 * e2, 1u, __ATOMIC_RELAXED, __HIP_MEMORY_SCOPE_AGENT);
            tok_e[2 * t] = e1; tok_e[2 * t + 1] = e2; tok_p[2 * t] = (int)p1; tok_p[2 * t + 1] = (int)p2;
            tok_w[2 * t] = gw * inv; tok_w[2 * t + 1] = gw * eb * inv;
        }
        wave_write_hn16<true>(xin, tok0, rstd, gain, hn, F.lane);
        LDS_WAIT(); asm volatile("" ::: "memory");
    }
}

__device__ __forceinline__ void phase_gla_gate(Frame& F, const float* gz, const float* wgu, const float* bgate, const bf16_t* proj, bf16_t* kdT, float* adec) {
    LAS f32x4* gzs = (LAS f32x4*)F.lds;
    for (int u = F.vcu; u < NBATCH * NCH * 2; u += F.G) {
        const int half = u & 1, bc = u >> 1;
        const int tok0 = bc * 64, j = half * 512 + F.tid;
        if (F.tid < 256) gzs[F.tid] = ((const f32x4*)(gz + (size_t)tok0 * 16))[F.tid];
        float wg[16];
#pragma unroll
        for (int r = 0; r < 16; ++r) wg[r] = wgu[r * GLA_DKT + j];
        const float bg = bgate[j];
        WG_BAR();
        float cum[64]; float run = 0.f;
#pragma unroll
        for (int t = 0; t < 64; ++t) {
            float z = bg;
#pragma unroll
            for (int r4 = 0; r4 < 4; ++r4) { const f32x4 g4 = gzs[t * 4 + r4]; z += g4[0] * wg[4 * r4] + g4[1] * wg[4 * r4 + 1] + g4[2] * wg[4 * r4 + 2] + g4[3] * wg[4 * r4 + 3]; }
            const float ls = fminf(z, 0.f) - __logf(1.0f + __expf(-fabsf(z)));
            run += ls * (1.0f / 16.0f); cum[t] = run;
        }
        adec[(size_t)bc * GLA_DKT + j] = __expf(run);
        const bf16_t* kp = proj + GK0 + gq_off(bc >> 8, (bc & 255) * 64, j >> 8) + (j & 255);
        u32x4* dst = (u32x4*)(kdT + ((size_t)bc * GLA_DKT + j) * 64);
#pragma unroll
        for (int t8 = 0; t8 < 8; ++t8) {
            float kd[8];
#pragma unroll
            for (int q = 0; q < 8; ++q) { const int t = t8 * 8 + q; kd[q] = bf2f(kp[(size_t)t * 256]) * __expf(run - cum[t]); }
            u32x4 w; w.x = cvt_pk_bf16(kd[0], kd[1]); w.y = cvt_pk_bf16(kd[2], kd[3]); w.z = cvt_pk_bf16(kd[4], kd[5]); w.w = cvt_pk_bf16(kd[6], kd[7]);
            dst[t8] = w;
        }
        WG_BAR();
    }
}

constexpr int SCAN_VROW = 144, SCAN_SROW = 528, SCAN_VBUF = 64 * SCAN_VROW, SCAN_SBUF = 64 * SCAN_SROW;
__device__ __forceinline__ void phase_gla_scan(Frame& F, int it, const bf16_t* proj, const bf16_t* kdT, const float* adec, bf16_t* oout, bf16_t* sfin) {
    const int lane = F.lane, w = F.wave, fr = lane & 15, kq = lane >> 4, tid = F.tid;
    LAS unsigned char* vbuf = F.lds;
    LAS unsigned char* sbuf = F.lds + 2 * SCAN_VBUF;
    const int bh = it >> 4, seg = (it >> 3) & 1, b = bh >> 2, h = bh & 3, sl = it & 7, mt = w & 3, ntp = w >> 2, c0 = seg * (NCH / 2);
    const size_t tokb = (size_t)b * SEQ;
    f32x4 st[2][4];
#pragma unroll
    for (int i = 0; i < 2; ++i)
#pragma unroll
        for (int n = 0; n < 4; ++n) st[i][n] = (f32x4){0.f, 0.f, 0.f, 0.f};
    bf16x8 ka0[2][2], ka1[2][2], q0[8], q1[8]; f32x4 dc0[2], dc1[2]; u32x4 vr0, vr1;
#define CL(c) ((c) < NCH ? (c) : NCH - 1)
#define LOAD_KA(KA, DC, c) do { const size_t bc_ = (size_t)b * NCH + CL(c); \
        _Pragma("unroll") for (int i = 0; i < 2; ++i) { \
            _Pragma("unroll") for (int s = 0; s < 2; ++s) KA[i][s] = *(const bf16x8*)(kdT + ((bc_ * GLA_DKT + h * 256 + 32 * w + 16 * i + fr) * 64 + 32 * s + 8 * kq)); \
            DC[i] = *(const f32x4*)(adec + bc_ * GLA_DKT + h * 256 + 32 * w + 16 * i + 4 * kq); } } while (0)
#define LOAD_V(VR, c) do { VR = *(const u32x4*)(proj + gv_off(b, CL(c) * 64 + (tid >> 3), h) + 64 * sl + 8 * (tid & 7)); } while (0)
#define LOAD_Q(Q, c) do { const bf16_t* qp_ = proj + gq_off(b, CL(c) * 64 + 16 * mt + fr, h) + 8 * kq; \
        _Pragma("unroll") for (int s = 0; s < 8; ++s) Q[s] = *(const bf16x8*)(qp_ + 32 * s); } while (0)
#define STORE_V(VR, buf) do { *(LAS u32x4*)(vbuf + (buf) * SCAN_VBUF + (tid >> 3) * SCAN_VROW + (tid & 7) * 16) = VR; } while (0)
#define SCAN_STEP(KA, DC, VN, VM, QC, QN, c) do { \
        const unsigned vb_ = (unsigned)(uintptr_t)(vbuf + ((c) & 1) * SCAN_VBUF) + (unsigned)((8 * kq + ((lane & 15) >> 2)) * SCAN_VROW + 8 * (lane & 3)); \
        s16x4 tv[4][4];     \
        asm volatile("ds_read_b64_tr_b16 %0, %16 offset:0\n\tds_read_b64_tr_b16 %1, %16 offset:576\n\tds_read_b64_tr_b16 %2, %16 offset:4608\n\tds_read_b64_tr_b16 %3, %16 offset:5184\n\t" \
                     "ds_read_b64_tr_b16 %4, %16 offset:32\n\tds_read_b64_tr_b16 %5, %16 offset:608\n\tds_read_b64_tr_b16 %6, %16 offset:4640\n\tds_read_b64_tr_b16 %7, %16 offset:5216\n\t" \
                     "ds_read_b64_tr_b16 %8, %16 offset:64\n\tds_read_b64_tr_b16 %9, %16 offset:640\n\tds_read_b64_tr_b16 %10, %16 offset:4672\n\tds_read_b64_tr_b16 %11, %16 offset:5248\n\t" \
                     "ds_read_b64_tr_b16 %12, %16 offset:96\n\tds_read_b64_tr_b16 %13, %16 offset:672\n\tds_read_b64_tr_b16 %14, %16 offset:4704\n\tds_read_b64_tr_b16 %15, %16 offset:5280\n\ts_waitcnt lgkmcnt(0)" \
                     : "=&v"(tv[0][0]), "=&v"(tv[0][1]), "=&v"(tv[0][2]), "=&v"(tv[0][3]), "=&v"(tv[1][0]), "=&v"(tv[1][1]), "=&v"(tv[1][2]), "=&v"(tv[1][3]), \
                       "=&v"(tv[2][0]), "=&v"(tv[2][1]), "=&v"(tv[2][2]), "=&v"(tv[2][3]), "=&v"(tv[3][0]), "=&v"(tv[3][1]), "=&v"(tv[3][2]), "=&v"(tv[3][3]) : "v"(vb_) : "memory"); \
        _Pragma("unroll") for (int n = 0; n < 4; ++n) { \
            const bf16x8 vf0 = (bf16x8){tv[n][0][0], tv[n][0][1], tv[n][0][2], tv[n][0][3], tv[n][1][0], tv[n][1][1], tv[n][1][2], tv[n][1][3]}; \
            const bf16x8 vf1 = (bf16x8){tv[n][2][0], tv[n][2][1], tv[n][2][2], tv[n][2][3], tv[n][3][0], tv[n][3][1], tv[n][3][2], tv[n][3][3]}; \
            _Pragma("unroll") for (int i = 0; i < 2; ++i) { \
                st[i][n] = st[i][n] * DC[i]; \
                st[i][n] = __builtin_amdgcn_mfma_f32_16x16x32_bf16(KA[i][0], vf0, st[i][n], 0, 0, 0); \
                st[i][n] = __builtin_amdgcn_mfma_f32_16x16x32_bf16(KA[i][1], vf1, st[i][n], 0, 0, 0); } } \
        LOAD_KA(KA, DC, (c) + 2); \
        { LAS unsigned char* sb_ = sbuf + ((c) & 1) * SCAN_SBUF + fr * SCAN_SROW + (32 * w + 4 * kq) * 2; \
          _Pragma("unroll") for (int i = 0; i < 2; ++i) _Pragma("unroll") for (int n = 0; n < 4; ++n) { \
              u32x2 pk; pk.x = cvt_pk_bf16(st[i][n][0], st[i][n][1]); pk.y = cvt_pk_bf16(st[i][n][2], st[i][n][3]); \
              *(LAS u32x2*)(sb_ + n * 16 * SCAN_SROW + i * 32) = pk; } } \
        STORE_V(VN, ((c) + 1) & 1); \
        LOAD_V(VN, (c) + 3); \
        WG_BAR(); \
        { f32x4 a0 = (f32x4){0.f, 0.f, 0.f, 0.f}, a1 = a0; \
          const LAS unsigned char* sr_ = sbuf + ((c) & 1) * SCAN_SBUF + (32 * ntp + fr) * SCAN_SROW + 16 * kq; \
          _Pragma("unroll") for (int hb = 0; hb < 2; ++hb) { bf16x8 bb[4][2];     \
              _Pragma("unroll") for (int s = 0; s < 4; ++s) { bb[s][0] = *(const LAS bf16x8*)(sr_ + 64 * (4 * hb + s)); bb[s][1] = *(const LAS bf16x8*)(sr_ + 16 * SCAN_SROW + 64 * (4 * hb + s)); } \
              asm volatile("s_waitcnt lgkmcnt(0)" ::: "memory"); __builtin_amdgcn_sched_barrier(0); \
              _Pragma("unroll") for (int s = 0; s < 4; ++s) { \
                  a0 = __builtin_amdgcn_mfma_f32_16x16x32_bf16(QC[4 * hb + s], bb[s][0], a0, 0, 0, 0); \
                  a1 = __builtin_amdgcn_mfma_f32_16x16x32_bf16(QC[4 * hb + s], bb[s][1], a1, 0, 0, 0); } } \
          bf16_t* op_ = oout + (tokb + (size_t)(c) * 64 + 16 * mt + 4 * kq) * D + h * 512 + 64 * sl + 32 * ntp + fr; \
          _Pragma("unroll") for (int r = 0; r < 4; ++r) { \
              const float x0 = a0[r] * 0.0625f, x1 = a1[r] * 0.0625f, y0 = __shfl_xor(x0, 1), y1 = __shfl_xor(x1, 1); \
              if ((fr & 1) == 0) { *(unsigned*)(op_ + (size_t)r * D) = cvt_pk_bf16(x0, y0); *(unsigned*)(op_ + (size_t)r * D + 16) = cvt_pk_bf16(x1, y1); } } } \
        LOAD_Q(QC, (c) + 2); \
    } while (0)
    LOAD_KA(ka0, dc0, c0); LOAD_KA(ka1, dc1, c0 + 1); LOAD_V(vr0, c0); LOAD_V(vr1, c0 + 1); LOAD_Q(q0, c0); LOAD_Q(q1, c0 + 1);
    STORE_V(vr0, 0); LOAD_V(vr0, c0 + 2);
    WG_BAR();
    for (int c = c0; c < c0 + NCH / 2; c += 2) {
        SCAN_STEP(ka0, dc0, vr1, vr0, q0, q1, c);
        SCAN_STEP(ka1, dc1, vr0, vr1, q1, q0, c + 1);
    }
    if (seg == 0) {
#pragma unroll
        for (int i = 0; i < 2; ++i)
#pragma unroll
            for (int n = 0; n < 4; ++n) { u32x2 pk; pk.x = cvt_pk_bf16(st[i][n][0], st[i][n][1]); pk.y = cvt_pk_bf16(st[i][n][2], st[i][n][3]);
                *(u32x2*)(sfin + ((size_t)(bh * 512 + 64 * sl + 16 * n + fr)) * 256 + 32 * w + 16 * i + 4 * kq) = pk; }
    }
    WG_BAR();
#undef CL
#undef LOAD_KA
#undef LOAD_V
#undef LOAD_Q
#undef STORE_V
#undef SCAN_STEP
}

__device__ __forceinline__ void gla_pcum(Frame& F, const float* adec, float* pcum, int rank, int nrank) {
    for (int idx = rank * (NWAVES * 64) + F.tid; idx < NBATCH * GLA_DKT; idx += nrank * NWAVES * 64) { const int b = idx >> 10, j = idx & 1023;
        const float* ap = adec + ((size_t)(b * NCH + NCH / 2)) * GLA_DKT + j; float* pp = pcum + (size_t)(b * (NCH / 2)) * GLA_DKT + j; float pr = 1.f;
#pragma unroll 16
        for (int cc = 0; cc < NCH / 2; ++cc) { pr *= ap[(size_t)cc * GLA_DKT]; pp[(size_t)cc * GLA_DKT] = pr; } }
}
__device__ __forceinline__ void phase_gla_qp(Frame& F, const bf16_t* proj, const float* pcum, bf16_t* qp) {
    const int gw = F.vcu * NWAVES + F.wave, NGW = F.G * NWAVES, lane = F.lane;
    for (int r = gw; r < NBATCH * (SEQ / 2); r += NGW) { const int b = r >> 13, t = r & 8191;
        u32x2 qv[4]; f32x4 pv[4];
#pragma unroll
        for (int h = 0; h < 4; ++h) { qv[h] = *(const u32x2*)(proj + gq_off(b, SEQ / 2 + t, h) + 4 * lane); pv[h] = *(const f32x4*)(pcum + ((size_t)(b * (NCH / 2) + (t >> 6)) * GLA_DKT + h * 256 + 4 * lane)); }
#pragma unroll
        for (int h = 0; h < 4; ++h) { u32x2 w; w.x = cvt_pk_bf16(bf_lo(qv[h].x) * pv[h][0], bf_hi(qv[h].x) * pv[h][1]); w.y = cvt_pk_bf16(bf_lo(qv[h].y) * pv[h][2], bf_hi(qv[h].y) * pv[h][3]);
            *(u32x2*)(qp + ((size_t)((b * 4 + h) * (SEQ / 2) + t)) * 256 + 4 * lane) = w; }
    }
}
__device__ __forceinline__ void phase_gla_gnorm(Frame& F, const bf16_t* o, const bf16_t* proj, const float* gn, bf16_t* y) {
    const int gw = F.vcu * NWAVES + F.wave, NGW = F.G * NWAVES, lane = F.lane;
    const f32x4 g0 = ((const f32x4*)gn)[2 * lane], g1 = ((const f32x4*)gn)[2 * lane + 1];
    for (int tok = gw; tok < T; tok += NGW) {
        u32x4 ov[4], rv[4];
#pragma unroll
        for (int h = 0; h < 4; ++h) { ov[h] = *(const u32x4*)(o + (size_t)tok * D + h * 512 + 8 * lane); rv[h] = *(const u32x4*)(proj + GR0 + (size_t)tok * 2048 + h * 512 + 8 * lane); }
        float ss[4];
#pragma unroll
        for (int h = 0; h < 4; ++h) { float s = 0.f;
#pragma unroll
            for (int q = 0; q < 4; ++q) { const float lo = bf_lo(ov[h][q]), hi = bf_hi(ov[h][q]); s += lo * lo + hi * hi; }
            ss[h] = s; }
#pragma unroll
        for (int of = 1; of < 64; of <<= 1) {
#pragma unroll
            for (int h = 0; h < 4; ++h) ss[h] += __shfl_xor(ss[h], of); }
#pragma unroll
        for (int h = 0; h < 4; ++h) { const float rstd = 1.0f / sqrtf(ss[h] * (1.0f / 512.0f) + RMS_EPS);
            float yv[8];
#pragma unroll
            for (int q = 0; q < 4; ++q) { const float a0 = bf_lo(ov[h][q]), a1 = bf_hi(ov[h][q]), r0 = bf_lo(rv[h][q]), r1 = bf_hi(rv[h][q]);
                const float gA = q < 2 ? g0[2 * q] : g1[2 * q - 4], gB = q < 2 ? g0[2 * q + 1] : g1[2 * q - 3];
                yv[2 * q] = a0 * rstd * gA * (r0 / (1.0f + __expf(-r0))); yv[2 * q + 1] = a1 * rstd * gB * (r1 / (1.0f + __expf(-r1))); }
            u32x4 w; w.x = cvt_pk_bf16(yv[0], yv[1]); w.y = cvt_pk_bf16(yv[2], yv[3]); w.z = cvt_pk_bf16(yv[4], yv[5]); w.w = cvt_pk_bf16(yv[6], yv[7]);
            *(u32x4*)(y + (size_t)tok * D + h * 512 + 8 * lane) = w; }
    }
}

__device__ __forceinline__ void moe_tables(Frame& F, unsigned* cnt) {
    LAS int* pst = (LAS int*)(F.lds + TAB_OFF);
    LAS int* te = pst + 36;
    if (F.wave == 0) {
        const int e = F.lane & 31;
        const int c = (int)xb_ld(cnt + 64 * e);
        const int ntile = (c + 255) >> 8;
        int incl = ntile;
#pragma unroll
        for (int o = 1; o < 32; o <<= 1) { const int v = __shfl_up(incl, o); if ((F.lane & 31) >= o) incl += v; }
        const int excl = incl - ntile;
        if (F.lane < 32) { pst[e] = excl << 8; for (int q = 0; q < ntile; ++q) te[excl + q] = e; }
        if (F.lane == 31) { pst[32] = incl << 8; pst[33] = incl; }
    }
    WG_BAR();
}
__device__ __forceinline__ void phase_moe_slots(Frame& F, const int* tok_e, const int* tok_p, unsigned* cnt, int* slot_of, int* slot_tok) {
    const LAS int* pst = (const LAS int*)(F.lds + TAB_OFF);
    for (int e = F.vcu; e < NEXP; e += F.G) { const int c = (int)xb_ld(cnt + 64 * e), lo = pst[e] + c, hi = pst[e] + (((c + 255) >> 8) << 8);
        for (int s = lo + F.tid; s < hi; s += NWAVES * 64) slot_tok[s] = -1; }
    for (int a = F.vcu * NWAVES * 64 + F.tid; a < 2 * T; a += F.G * NWAVES * 64) { const int slot = pst[tok_e[a]] + tok_p[a]; slot_of[a] = slot; slot_tok[slot] = a >> 1; }
}
__device__ __forceinline__ void phase_moe_copy8(Frame& F, const int* tok_e, const int* tok_p, const unsigned char* hn8, unsigned char* ag8) {
    const LAS int* pst = (const LAS int*)(F.lds + TAB_OFF);
    const int gw = F.vcu * NWAVES + F.wave, NGW = F.G * NWAVES, lane = F.lane;
    for (int t = gw; t < T; t += NGW) {
        const int s0 = pst[tok_e[2 * t]] + tok_p[2 * t], s1 = pst[tok_e[2 * t + 1]] + tok_p[2 * t + 1];
        const u32x4* src = (const u32x4*)(hn8 + (size_t)t * D); const u32x4 v0 = src[lane], v1 = src[lane + 64];
        u32x4* d0 = (u32x4*)(ag8 + (size_t)s0 * D); u32x4* d1 = (u32x4*)(ag8 + (size_t)s1 * D);
        d0[lane] = v0; d0[lane + 64] = v1; d1[lane] = v0; d1[lane + 64] = v1;
    }
}
template <int MODE>
__device__ __forceinline__ void phase_moe_combine(Frame& F, float* x, const bf16_t* ob, const int* slot_of, const float* tok_w, const float* gain, bf16_t* hn) {
    const int gw = F.vcu * NWAVES + F.wave, NGW = F.G * NWAVES, lane = F.lane;
    f32x4 g4[8];
#pragma unroll
    for (int j = 0; j < 8; ++j) g4[j] = ((const f32x4*)gain)[lane + 64 * j];
    for (int t = gw; t < T; t += NGW) {
        const int s0 = slot_of[2 * t], s1 = slot_of[2 * t + 1]; const float w0 = tok_w[2 * t], w1 = tok_w[2 * t + 1];
        f32x4* xr = (f32x4*)(x + (size_t)t * D);
        const u32x2* a = (const u32x2*)(ob + (size_t)s0 * D); const u32x2* b = (const u32x2*)(ob + (size_t)s1 * D);
        f32x4 v[8]; float ss = 0.f;
#pragma unroll
        for (int j = 0; j < 8; ++j) { const u32x2 av = a[lane + 64 * j], bv = b[lane + 64 * j]; f32x4 xv = xr[lane + 64 * j];
            xv[0] += w0 * bf_lo(av.x) + w1 * bf_lo(bv.x); xv[1] += w0 * bf_hi(av.x) + w1 * bf_hi(bv.x);
            xv[2] += w0 * bf_lo(av.y) + w1 * bf_lo(bv.y); xv[3] += w0 * bf_hi(av.y) + w1 * bf_hi(bv.y);
            v[j] = xv; ss += (xv[0] * xv[0] + xv[1] * xv[1]) + (xv[2] * xv[2] + xv[3] * xv[3]); }
        const float rstd = 1.0f / sqrtf(wave_sum(ss) * (1.0f / D) + RMS_EPS);
        if (MODE == 0) {
            unsigned* orow = (unsigned*)((unsigned char*)hn + (size_t)t * D);
#pragma unroll
            for (int j = 0; j < 8; ++j) { xr[lane + 64 * j] = v[j]; const f32x4 y = v[j] * rstd * g4[j]; orow[lane + 64 * j] = cvt4_fp8(y[0], y[1], y[2], y[3]); }
        } else {
#pragma unroll
            for (int j = 0; j < 8; ++j) xr[lane + 64 * j] = v[j] * rstd * g4[j];
        }
    }
}

__device__ __forceinline__ void phase_subln(Frame& F, const bf16_t* o1, const bf16_t* o2, const float* lq1, const float* lk1, const float* lq2, const float* lk2, const float* sg, bf16_t* y) {
    const int gw = F.vcu * NWAVES + F.wave, NGW = F.G * NWAVES, lane = F.lane;
    const float d1 = wave_sum(lq1[lane] * lk1[lane] + lq1[lane + 64] * lk1[lane + 64]);
    const float d2 = wave_sum(lq2[lane] * lk2[lane] + lq2[lane + 64] * lk2[lane + 64]);
    const float lam = __expf(d1) - __expf(d2) + LAMBDA_INIT;
    const f32x4 g = ((const f32x4*)sg)[lane] * (1.0f - LAMBDA_INIT);
    for (int tok = gw; tok < T; tok += NGW) {
        u32x2 a[8], b[8];
#pragma unroll
        for (int h = 0; h < 8; ++h) { a[h] = *(const u32x2*)(o1 + (size_t)tok * D + h * 256 + 4 * lane); b[h] = *(const u32x2*)(o2 + (size_t)tok * D + h * 256 + 4 * lane); }
        f32x4 d[8]; float ss[8];
#pragma unroll
        for (int h = 0; h < 8; ++h) { d[h][0] = bf_lo(a[h].x) - lam * bf_lo(b[h].x); d[h][1] = bf_hi(a[h].x) - lam * bf_hi(b[h].x); d[h][2] = bf_lo(a[h].y) - lam * bf_lo(b[h].y); d[h][3] = bf_hi(a[h].y) - lam * bf_hi(b[h].y);
            ss[h] = (d[h][0] * d[h][0] + d[h][1] * d[h][1]) + (d[h][2] * d[h][2] + d[h][3] * d[h][3]); }
#pragma unroll
        for (int of = 1; of < 64; of <<= 1) {
#pragma unroll
            for (int h = 0; h < 8; ++h) ss[h] += __shfl_xor(ss[h], of); }
#pragma unroll
        for (int h = 0; h < 8; ++h) { const float rstd = 1.0f / sqrtf(ss[h] * (1.0f / 256.0f) + RMS_EPS); const f32x4 yv = d[h] * rstd * g;
            *(unsigned*)((unsigned char*)y + (size_t)tok * D + h * 256 + 4 * lane) = cvt4_fp8(yv[0], yv[1], yv[2], yv[3]); }
    }
}

namespace att {
constexpr int SHM_K = 64 * 128, SHM_V = 64 * 256 * 2;
constexpr int V_OFF = 0, K_OFF = 3 * SHM_V, SCR_OFF = RING_BYTES + 4096;
constexpr float SCALE = 0.08838834764831845f;
constexpr float C2 = 1.4426950408889634f * SCALE;
constexpr float THR = 8.f;
#define KSWZ(row, colB) ((row) * 256 + ((colB) ^ (((row) & 7) << 4)))
__device__ __forceinline__ int crow(int r, int hi) { return (r & 3) + 8 * (r >> 2) + 4 * hi; }
__device__ __forceinline__ int v_rd_base(int lane) { return ((lane & 3) << 3) | (((lane >> 2) & 3) << 6) | (((lane >> 4) & 1) << 5) | (((lane >> 5) & 1) << 8); }
constexpr int v_rd_off(int d0, int ks, int half) { return d0 * 512 + ks * 8192 + half * 4096; }

__device__ __forceinline__ void qkt(f32x16& p0, f32x16& p1, const LAS unsigned char* kslot, int r32, int hi, const v8i32 (&qf)[2]) {
#pragma unroll
    for (int s = 0; s < 2; ++s) { const int c0 = 4 * s + 2 * hi, sw = r32 & 7;
        const LAS unsigned char* ra = kslot + r32 * 128;
        const v4i32 a0 = *(const LAS v4i32*)(ra + ((c0 ^ sw) << 4)), a1 = *(const LAS v4i32*)(ra + (((c0 + 1) ^ sw) << 4));
        const v4i32 b0 = *(const LAS v4i32*)(ra + 32 * 128 + ((c0 ^ sw) << 4)), b1 = *(const LAS v4i32*)(ra + 32 * 128 + (((c0 + 1) ^ sw) << 4));
        const v8i32 ka = __builtin_shufflevector(a0, a1, 0, 1, 2, 3, 4, 5, 6, 7), kb = __builtin_shufflevector(b0, b1, 0, 1, 2, 3, 4, 5, 6, 7);
        p0 = __builtin_amdgcn_mfma_scale_f32_32x32x64_f8f6f4(ka, qf[s], p0, 0, 0, 0, 0x7f7f7f7f, 0, 0x7f7f7f7f);
        p1 = __builtin_amdgcn_mfma_scale_f32_32x32x64_f8f6f4(kb, qf[s], p1, 0, 0, 0, 0x7f7f7f7f, 0, 0x7f7f7f7f); }
}
__device__ __forceinline__ void pv_tile(f32x16 (&o)[8], unsigned vb, const bf16x8 (&pa)[4]) {
#define TRRD(dst, off) asm volatile("ds_read_b64_tr_b16 %0, %1 offset:%2" : "=&v"(dst) : "v"(vb), "i"(off) : "memory")
#define PV_RD(S, hb) do { constexpr int b_ = v_rd_off((hb) >> 1, 2 * ((hb) & 1), 0); TRRD(S[0], b_); TRRD(S[1], b_ + 4096); TRRD(S[2], b_ + 8192); TRRD(S[3], b_ + 12288); } while (0)
#define PV_MM(S, hb) do { \
        o[(hb) >> 1] = __builtin_amdgcn_mfma_f32_32x32x16_bf16(pa[2 * ((hb) & 1)], (bf16x8){S[0][0], S[0][1], S[0][2], S[0][3], S[1][0], S[1][1], S[1][2], S[1][3]}, o[(hb) >> 1], 0, 0, 0); \
        o[(hb) >> 1] = __builtin_amdgcn_mfma_f32_32x32x16_bf16(pa[2 * ((hb) & 1) + 1], (bf16x8){S[2][0], S[2][1], S[2][2], S[2][3], S[3][0], S[3][1], S[3][2], S[3][3]}, o[(hb) >> 1], 0, 0, 0); } while (0)
#define PV_STEP(SC, SN2, hb) do { PV_RD(SN2, (hb) + 2); asm volatile("s_waitcnt lgkmcnt(8)" ::: "memory"); __builtin_amdgcn_sched_barrier(0); PV_MM(SC, hb); } while (0)
    s16x4 f0[4], f1[4], f2[4];
    PV_RD(f0, 0); PV_RD(f1, 1);
    PV_STEP(f0, f2, 0); PV_STEP(f1, f0, 1); PV_STEP(f2, f1, 2); PV_STEP(f0, f2, 3); PV_STEP(f1, f0, 4); PV_STEP(f2, f1, 5); PV_STEP(f0, f2, 6); PV_STEP(f1, f0, 7);
    PV_STEP(f2, f1, 8); PV_STEP(f0, f2, 9); PV_STEP(f1, f0, 10); PV_STEP(f2, f1, 11); PV_STEP(f0, f2, 12); PV_STEP(f1, f0, 13);
    asm volatile("s_waitcnt lgkmcnt(4)" ::: "memory"); __builtin_amdgcn_sched_barrier(0); PV_MM(f2, 14);
    asm volatile("s_waitcnt lgkmcnt(0)" ::: "memory"); __builtin_amdgcn_sched_barrier(0); PV_MM(f0, 15);
#undef PV_STEP
#undef PV_MM
#undef PV_RD
#undef TRRD
}

__device__ __forceinline__ void stage_offsets(int tid, unsigned& koff, unsigned (&voff)[4]) {
    { const int P = tid * 16, row = P >> 7, ch = ((P & 127) >> 4) ^ (row & 7); koff = (unsigned)(row * 128 + ch * 16); }
#pragma unroll
    for (int i = 0; i < 4; ++i) { const int P = tid * 16 + i * 8192, st = P >> 9, kk = ((st >> 3) << 3) | ((P & 511) >> 6), cg = st & 7, cin = (P & 63) >> 1;
        const int key = (kk & ~0xC) | ((kk & 4) << 1) | ((kk & 8) >> 1); voff[i] = (unsigned)(key * 256 + cg * 32 + cin) * 2u; }
}
__device__ __forceinline__ const char* uniform_ptr(const void* p) {
    const unsigned long long v = (unsigned long long)p;
    const unsigned lo = __builtin_amdgcn_readfirstlane((unsigned)v), hi = __builtin_amdgcn_readfirstlane((unsigned)(v >> 32));
    return (const char*)(((unsigned long long)hi << 32) | lo);
}
__device__ __forceinline__ void stage_tile(LAS unsigned char* lds, int kslot, int vslot, const bf16_t* kj_, const bf16_t* vj_, int tid_, int wid) {
    const char* kj = uniform_ptr(kj_); const char* vj = uniform_ptr(vj_);
    int tid = tid_; asm volatile("" : "+v"(tid));
    unsigned koff, voff[4]; stage_offsets(tid, koff, voff);
    LAS unsigned char* kd = lds + K_OFF + kslot * SHM_K + wid * 1024; LAS unsigned char* vd = lds + V_OFF + vslot * SHM_V + wid * 1024;
    __builtin_amdgcn_global_load_lds((const unsigned*)(kj + koff), (LAS unsigned*)kd, 16, 0, 0);
#pragma unroll
    for (int i = 0; i < 4; ++i) __builtin_amdgcn_global_load_lds((const unsigned*)(vj + voff[i]), (LAS unsigned*)(vd + i * 8192), 16, 0, 0);
}

__device__ __forceinline__ void qk_softmax(const LAS unsigned char* kslot, int r32, int hi, LAS float* al_l, const v8i32 (&qf)[2], f32x16 (&o)[8], bf16x8 (&pa)[4],
                                           float& m_reg, float& l_reg, float rawu, float sl2, bool diag, int qi) {
    f32x16 p0, p1;
#pragma unroll
    for (int r = 0; r < 16; ++r) { p0[r] = 0.f; p1[r] = 0.f; }
    qkt(p0, p1, kslot, r32, hi, qf);
#pragma unroll
    for (int r = 0; r < 16; ++r) { const float cr = (float)((r & 3) + 8 * (r >> 2)); p0[r] = fmaf(cr, rawu, p0[r]); p1[r] = fmaf(cr, rawu, p1[r]); }
    if (diag) {
        const float k2raw = 2.f * rawu;
        int qi_ = qi - 4 * hi; asm volatile("" : "+v"(qi_));
#pragma unroll
        for (int r = 0; r < 16; ++r) { const int c = (r & 3) + 8 * (r >> 2); const int d0_ = c - qi_, d1_ = c + 32 - qi_;
            p0[r] -= k2raw * (float)(d0_ > 0 ? d0_ : 0); p1[r] -= k2raw * (float)(d1_ > 0 ? d1_ : 0); }
    }
    const float lane_raw = rawu * (float)(4 * hi), d32raw = 32.f * rawu;
    float pm0 = p0[0], pm1 = p1[0];
#pragma unroll
    for (int r = 1; r < 16; ++r) { pm0 = fmaxf(pm0, p0[r]); pm1 = fmaxf(pm1, p1[r]); }
    float pmax = fmaxf(pm0, pm1 + d32raw) + lane_raw;
    { auto rr = __builtin_amdgcn_permlane32_swap(__float_as_uint(pmax), __float_as_uint(pmax), false, false);
      pmax = fmaxf(__uint_as_float(rr[0]), __uint_as_float(rr[1])); }
    float mn, alpha;
    if (__all((pmax - m_reg) * SCALE <= THR)) { mn = m_reg; alpha = 1.f; }
    else { mn = fmaxf(m_reg, pmax); alpha = __builtin_amdgcn_exp2f((m_reg - mn) * C2); m_reg = mn; }
    const float mnL0 = (lane_raw - mn) * C2, mnL1 = mnL0 + 32.f * sl2;
#pragma unroll
    for (int r = 0; r < 16; ++r) { p0[r] = __builtin_amdgcn_exp2f(fmaf(p0[r], C2, mnL0)); p1[r] = __builtin_amdgcn_exp2f(fmaf(p1[r], C2, mnL1)); }
    if (__any(alpha < 1.f)) {
        if (hi == 0) al_l[r32] = alpha;
        LDS_WAIT();
#pragma unroll
        for (int r = 0; r < 16; ++r) { const float a = al_l[crow(r, hi)];
#pragma unroll
            for (int d = 0; d < 8; ++d) o[d][r] *= a; }
    }
    float ps = 0.f;
#pragma unroll
    for (int r = 0; r < 16; ++r) ps += p0[r] + p1[r];
    { auto rr = __builtin_amdgcn_permlane32_swap(__float_as_uint(ps), __float_as_uint(ps), false, false);
      ps = __uint_as_float(rr[0]) + __uint_as_float(rr[1]); }
    l_reg = l_reg * alpha + ps;
#define PK4(P, B_, OUT) do { unsigned a0 = cvt_pk_bf16(P[B_+0], P[B_+1]), a1 = cvt_pk_bf16(P[B_+2], P[B_+3]); \
        unsigned b0 = cvt_pk_bf16(P[B_+4], P[B_+5]), b1 = cvt_pk_bf16(P[B_+6], P[B_+7]); \
        auto r0 = __builtin_amdgcn_permlane32_swap(a0, b0, false, false); auto r1 = __builtin_amdgcn_permlane32_swap(a1, b1, false, false); \
        u32x4 w = {r0[0], r1[0], r0[1], r1[1]}; OUT = __builtin_bit_cast(bf16x8, w); } while (0)
    PK4(p0, 0, pa[0]); PK4(p0, 8, pa[1]); PK4(p1, 0, pa[2]); PK4(p1, 8, pa[3]);
#undef PK4
}

__device__ __forceinline__ void norms_phase(Frame& F, const bf16_t* proj, float* nrm) {
    const int gw = F.vcu * NWAVES + F.wave, NGW = F.G * NWAVES, lane = F.lane;
    for (int idx = gw; idx < 2 * 32 * 256; idx += NGW) {
        const int tensor = idx >> 13, stream = (idx >> 8) & 31, grp = idx & 255;
        const u32x4* rp = (const u32x4*)((const unsigned char*)proj + (tensor ? DK0 : 0) + ((size_t)stream * SEQ + grp * 64 + lane) * 128);
        float ss = 0.f;
#pragma unroll
        for (int q = 0; q < 8; ++q) { const u32x4 v = rp[q];
#pragma unroll
            for (int e = 0; e < 4; ++e) { const float a0 = __builtin_amdgcn_cvt_f32_fp8((int)v[e], 0), a1 = __builtin_amdgcn_cvt_f32_fp8((int)v[e], 1), a2 = __builtin_amdgcn_cvt_f32_fp8((int)v[e], 2), a3 = __builtin_amdgcn_cvt_f32_fp8((int)v[e], 3);
                ss += (a0 * a0 + a1 * a1) + (a2 * a2 + a3 * a3); } }
        float n = sqrtf(ss) * 1.001f;
#pragma unroll
        for (int o = 1; o < 64; o <<= 1) n = fmaxf(n, __shfl_xor(n, o));
        if (lane == 0) nrm[idx] = n;
    }
}

__device__ __forceinline__ void attn_item(LAS unsigned char* lds, const bf16_t* proj, const float* nrm, bf16_t* oout, int b, int h, int sub, int qb, int tid, int wid, int lane) {
    const int r32 = lane & 31, hi = lane >> 5;
    const float slope = __builtin_amdgcn_exp2f(-(float)(h + 1));
    const float sl2 = slope * 1.4426950408889634f, rawu = sl2 / C2;
    LAS float* ws = (LAS float*)(lds + SCR_OFF) + wid * 64; LAS float* li_l = ws; LAS float* al_l = ws + 32;
    const size_t tokq = (size_t)b * SEQ + (size_t)qb * 256 + wid * 32;
    const bf16_t* kbase = (const bf16_t*)((const unsigned char*)proj + DK0 + dq_off(b, 0, h, sub));
    const bf16_t* vbase = proj + dv_off(b, 0, h);
    int j_lo;
    { const int stream = (b * 8 + h) * 2 + sub; const float* qn = nrm + stream * 256; const float* kn = nrm + 8192 + stream * 256;
      const float Qn = fmaxf(fmaxf(qn[4 * qb], qn[4 * qb + 1]), fmaxf(qn[4 * qb + 2], qn[4 * qb + 3]));
      const float Kd = fmaxf(fmaxf(kn[4 * qb], kn[4 * qb + 1]), fmaxf(kn[4 * qb + 2], kn[4 * qb + 3]));
      int cand = 4 * qb;
      for (int jj = lane; jj < 4 * qb; jj += 64) { const float dmin = (float)(256 * qb - (64 * jj + 63)); const bool skip = slope * dmin > 110.f + SCALE * Qn * (kn[jj] + Kd); if (!skip) cand = cand < jj ? cand : jj; }
#pragma unroll
      for (int o = 1; o < 64; o <<= 1) { const int v = __shfl_xor(cand, o); cand = v < cand ? v : cand; }
      j_lo = __builtin_amdgcn_readfirstlane(cand); }
    v8i32 qf[2];
    { const unsigned char* qrow = (const unsigned char*)proj + dq_off(b, qb * 256 + wid * 32 + r32, h, sub) + 32 * hi;
#pragma unroll
      for (int s = 0; s < 2; ++s) { const v4i32 x0 = *(const v4i32*)(qrow + 64 * s), x1 = *(const v4i32*)(qrow + 64 * s + 16); qf[s] = __builtin_shufflevector(x0, x1, 0, 1, 2, 3, 4, 5, 6, 7); } }
    const float sh64 = 64.f * rawu;
    const int qi = 32 * (wid & 1) + r32;
    const unsigned vb0 = (unsigned)(uintptr_t)(lds + V_OFF) + (unsigned)v_rd_base(lane);
    float m_reg = -1e30f, l_reg = 0.f;
    f32x16 o[8];
#pragma unroll
    for (int d = 0; d < 8; ++d)
#pragma unroll
        for (int r = 0; r < 16; ++r) o[d][r] = 0.f;
    const int NT = 4 * qb + 4, myNT = 4 * qb + (wid >> 1) + 1;
    constexpr size_t KSTEP = 64 * 128 / 2, VSTEP = 64 * 256;
    const bool late = wid >= 4;
    stage_tile(lds, j_lo & 1, j_lo % 3, kbase + (size_t)j_lo * KSTEP, vbase + (size_t)j_lo * VSTEP, tid, wid);
    VM_WAIT(); WG_BAR();
    if (!late) {
        int vs = j_lo % 3;
        for (int j = j_lo; j < NT; ++j) {
            const int vsn = vs == 2 ? 0 : vs + 1;
            if (j + 1 < NT) stage_tile(lds, (j + 1) & 1, vsn, kbase + (size_t)(j + 1) * KSTEP, vbase + (size_t)(j + 1) * VSTEP, tid, wid);
            if (j < myNT) { if (j > j_lo) m_reg -= sh64;
                bf16x8 pa[4];
                qk_softmax(lds + K_OFF + (j & 1) * SHM_K, r32, hi, al_l, qf, o, pa, m_reg, l_reg, rawu, sl2, j == myNT - 1, qi);
                pv_tile(o, vb0 + (unsigned)(vs * SHM_V), pa); }
            VM_WAIT(); WG_BAR();
            vs = vsn;
        }
    } else {
        bf16x8 pa[4];
        int vs = j_lo % 3, vsp = vs;
        for (int j = j_lo; j < NT; ++j) {
            const int vsn = vs == 2 ? 0 : vs + 1;
            if (j + 1 < NT) stage_tile(lds, (j + 1) & 1, vsn, kbase + (size_t)(j + 1) * KSTEP, vbase + (size_t)(j + 1) * VSTEP, tid, wid);
            if (j > j_lo && j - 1 < myNT) pv_tile(o, vb0 + (unsigned)(vsp * SHM_V), pa);
            if (j < myNT) { if (j > j_lo) m_reg -= sh64;
                qk_softmax(lds + K_OFF + (j & 1) * SHM_K, r32, hi, al_l, qf, o, pa, m_reg, l_reg, rawu, sl2, j == myNT - 1, qi); }
            VM_WAIT(); WG_BAR();
            vsp = vs; vs = vsn;
        }
        if (myNT == NT) pv_tile(o, vb0 + (unsigned)(vsp * SHM_V), pa);
    }
    if (hi == 0) li_l[r32] = l_reg;
    LDS_WAIT();
    char* Ow = (char*)(oout + tokq * D + h * 256);
    const unsigned lofs = (unsigned)(hi * 4 * D + r32) * 2u;
#pragma unroll
    for (int r = 0; r < 16; ++r) { const float rl = __builtin_amdgcn_rcpf(li_l[crow(r, hi)]);
#pragma unroll
        for (int d0 = 0; d0 < 8; ++d0) { const float v = o[d0][r] * rl; const float vn = __shfl_xor(v, 1);
            if ((r32 & 1) == 0) *(unsigned*)(Ow + (lofs + (unsigned)((((r & 3) + 8 * (r >> 2)) * D + d0 * 32) * 2))) = cvt_pk_bf16(v, vn); } }
    WG_BAR();
}

struct TailConv { const float* wg; const float* wu; const float* wd; bf16_t* gu; bf16_t* dt; };
__device__ __forceinline__ void attn_phase(Frame& F, const bf16_t* proj, const float* nrm, unsigned* queue, bf16_t* o1, bf16_t* o2, const TailConv tc) {
    LAS int* qw = (LAS int*)(F.lds + SCR_OFF + 8 * 256);
    for (;;) {
        if (F.tid == 0) *qw = (int)__hip_atomic_fetch_add(queue, 1u, __ATOMIC_RELAXED, __HIP_MEMORY_SCOPE_AGENT);
        WG_BAR();
        const int I = __builtin_amdgcn_readfirstlane(*qw);
        if (I >= 2048 + 512) break;
        if (I >= 2048) { conv_moe(F, tc.wg, tc.wu, tc.wd, tc.gu, tc.dt, I - 2048, 512); WG_BAR(); continue; }
        const int qb = 63 - (I >> 5), r = I & 31, h = 7 - (r >> 2), b = (r >> 1) & 1, sub = r & 1;
        attn_item(F.lds, proj, nrm, sub ? o2 : o1, b, h, sub, qb, F.tid, F.wave, F.lane);
    }
}
}

__device__ __forceinline__ const void* karg(int i) { int j = i; asm volatile("" : "+s"(j)); return ((const void* const __attribute__((address_space(4)))*)__builtin_amdgcn_kernarg_segment_ptr())[j]; }
__global__ void __launch_bounds__(NWAVES * 64, 2) hybrid_fwd(Args args) {
    extern __shared__ __attribute__((aligned(16))) unsigned char lds_raw[];
    Frame F;
    F.lds = (LAS unsigned char*)lds_raw;
    F.tid = threadIdx.x; F.lane = F.tid & 63; F.wave = __builtin_amdgcn_readfirstlane(F.tid >> 6);
    F.G = gridDim.x; { const int bx = blockIdx.x; F.vcu = (F.G % 8 == 0) ? (bx % 8) * (F.G / 8) + bx / 8 : bx; }
#define ws ((unsigned char*)karg(22))
#define ctl ((unsigned*)(ws + WS_CTL))
    for (int u = F.tid; u < (LDS_BYTES - LDSCTL_OFF) / 4; u += NWAVES * 64) ((LAS unsigned*)(F.lds + LDSCTL_OFF))[u] = 0u;
    __syncthreads();
    ((LAS int*)(F.lds + TIDS_OFF))[F.tid] = F.tid;
    __syncthreads();
    volatile LAS unsigned* MISC = (volatile LAS unsigned*)(F.lds + MISC_OFF);
    XcdBarrier bar = xcd_barrier_post(ctl + CW_BAR, MISC + 8);
#define GRID_BAR() do { XcdBarrier bb_ = bar; unsigned x_ = bar.x; unsigned long long bp_ = (unsigned long long)bar.bar; asm volatile("" : "+s"(x_), "+s"(bp_)); bb_.x = x_; bb_.bar = (unsigned*)bp_; xcd_barrier(bb_, TID_RELOAD() == 0); } while (0)
#define TID_RELOAD() (F.wave * 64 + lane_id_volatile())
#ifdef ONLY_PHASE
#define PHON(n) ((n) == ONLY_PHASE)
#else
#define PHON(n) 1
#endif

#define x_in ((const float*)(karg(0)))
#define norm_mix ((const float*)(karg(1)))
#define norm_ffn ((const float*)(karg(2)))
#define gla_w_in ((const float*)(karg(3)))
#define gla_wgu ((const float*)(karg(4)))
#define gla_bg ((const float*)(karg(5)))
#define gla_norm ((const float*)(karg(6)))
#define gla_w_out ((const float*)(karg(7)))
#define diff_w_in ((const float*)(karg(8)))
#define lq1 ((const float*)(karg(9)))
#define lk1 ((const float*)(karg(10)))
#define lq2 ((const float*)(karg(11)))
#define lk2 ((const float*)(karg(12)))
#define diff_subln ((const float*)(karg(13)))
#define diff_w_out ((const float*)(karg(14)))
#define moe_wgrp ((const float*)(karg(15)))
#define moe_wexp ((const float*)(karg(16)))
#define moe_wg ((const float*)(karg(17)))
#define moe_wu ((const float*)(karg(18)))
#define moe_wd ((const float*)(karg(19)))
#define final_norm ((const float*)(karg(20)))
#define xres ((float*)(karg(21)))
#define gz ((float*)((float*)(ws + WS_GZ)))
#define tok_e ((int*)((int*)(ws + WS_TOKE)))
#define tok_p ((int*)((int*)(ws + WS_TOKP)))
#define tok_w ((float*)((float*)(ws + WS_TOKW)))
#define slot_of ((int*)((int*)(ws + WS_SLOT)))
#define slot_tok ((int*)(ws + WS_STOK))
#define adec ((float*)((float*)(ws + WS_ADEC)))
#define pcum ((float*)((float*)(ws + WS_PCUM)))
#define sfin ((bf16_t*)((bf16_t*)(ws + WS_SFIN)))
#define wp_gz ((float*)((float*)(ws + WS_WPGZ)))
#define wp_r0 ((float*)((float*)(ws + WS_WPR0)))
#define wp_r1 ((float*)((float*)(ws + WS_WPR1)))
#define wgi ((bf16_t*)((bf16_t*)(ws + WS_WGI)))
#define wgo ((bf16_t*)((bf16_t*)(ws + WS_WGO)))
#define wdi ((bf16_t*)((bf16_t*)(ws + WS_WDI)))
#define wdo ((bf16_t*)((bf16_t*)(ws + WS_WDO)))
#define wmoe_gu ((bf16_t*)((bf16_t*)(ws + WS_WMOE)))
#define wmoe_d ((bf16_t*)((bf16_t*)(ws + WS_WMOE_D)))
#define hn ((bf16_t*)((bf16_t*)(ws + WS_HN)))
#define proj ((bf16_t*)((bf16_t*)(ws + WS_PROJ)))
#define buf1 ((bf16_t*)((bf16_t*)(ws + WS_BUF1)))
#define buf2 ((bf16_t*)((bf16_t*)(ws + WS_BUF2)))
#define ag ((bf16_t*)((bf16_t*)(ws + WS_AG)))
#define ob ((bf16_t*)((bf16_t*)(ws + WS_OB)))
#define hh ((bf16_t*)((bf16_t*)(ws + WS_H)))
    const LAS int* pst = (const LAS int*)(F.lds + TAB_OFF);

    _Pragma("unroll") for (int rep_ = 0; rep_ < (REP_PHASE == 0 ? 2 : 1); ++rep_) if (PHON(0)) { if (rep_) GRID_BAR(); Frame P = F; P.tid = TID_RELOAD(); P.lane = P.tid & 63;
    conv_plain(P, gla_w_in, D, PROJW, GLA_INW, wgi);
    conv_plain(P, gla_w_out, D, D, D, wgo);
    pack_proj(P, wp_gz, 1, norm_mix, gla_w_in, GLA_INW, PROJW, 16, nullptr, 0, 0);
    pack_proj(P, wp_r0, 3, norm_ffn, moe_wgrp, 4, 0, 4, moe_wexp, 32, 32);
    pack_proj(P, wp_r1, 3, norm_ffn + D, moe_wgrp + (size_t)D * 4, 4, 0, 4, moe_wexp + (size_t)D * 32, 32, 32);
    }
    GRID_BAR();
    _Pragma("unroll") for (int rep_ = 0; rep_ < (REP_PHASE == 1 ? 2 : 1); ++rep_) if (PHON(1)) { if (rep_) GRID_BAR(); Frame P = F; P.tid = TID_RELOAD(); P.lane = P.tid & 63;
    phase_norm_gz(P, x_in, norm_mix, wp_gz, hn, gz);
    }
    GRID_BAR();
    _Pragma("unroll") for (int rep_ = 0; rep_ < (REP_PHASE == 2 ? 2 : 1); ++rep_) if (PHON(2)) { if (rep_) GRID_BAR(); Frame P = F; P.tid = TID_RELOAD(); P.lane = P.tid & 63;
    { pg8::Gemm g{hn, wgi, T, PROJW, D}; pg8::StaticOrder S; S.init(T, PROJW, P.G, (int)blockIdx.x); pg8::EpiHeads<0> E{proj};
      pg8::gemm_phase<pg8::EpiHeads<0>, pg8::StaticOrder>(P.lds, g, S, E, P.tid); }
    }
    GRID_BAR();
    _Pragma("unroll") for (int rep_ = 0; rep_ < (REP_PHASE == 3 ? 2 : 1); ++rep_) if (PHON(3)) { if (rep_) GRID_BAR(); Frame P = F; P.tid = TID_RELOAD(); P.lane = P.tid & 63;
    phase_gla_gate(P, gz, gla_wgu, gla_bg, proj, buf1, adec);
    }
    GRID_BAR();
    _Pragma("unroll") for (int rep_ = 0; rep_ < (REP_PHASE == 4 ? 2 : 1); ++rep_) if (PHON(4)) { if (rep_) GRID_BAR(); Frame P = F; P.tid = TID_RELOAD(); P.lane = P.tid & 63;
    if (P.G == 256) { if ((P.vcu & 1) == 0) phase_gla_scan(P, P.vcu >> 1, proj, buf1, adec, buf2, sfin); else { gla_pcum(P, adec, pcum, P.vcu >> 1, 128); conv_moe(P, moe_wg, moe_wu, moe_wd, wmoe_gu, wmoe_d, P.vcu >> 1, 128);
            conv_plain<true>(P, diff_w_in, D, PROJW, PROJW, wdi, P.vcu >> 1, 128); conv_plain<true>(P, diff_w_out, D, D, D, wdo, P.vcu >> 1, 128); } }
    else { for (int it = P.vcu; it < 128; it += P.G) phase_gla_scan(P, it, proj, buf1, adec, buf2, sfin); gla_pcum(P, adec, pcum, P.vcu, P.G); conv_moe(P, moe_wg, moe_wu, moe_wd, wmoe_gu, wmoe_d); conv_plain<true>(P, diff_w_in, D, PROJW, PROJW, wdi); conv_plain<true>(P, diff_w_out, D, D, D, wdo); }
    GRID_BAR();
    phase_gla_qp(P, proj, pcum, hn);
    GRID_BAR();
    { pg8::Gemm g{hn, sfin, 8 * (SEQ / 2), 512, 256}; pg8::FixOrder S; S.init(8 * (SEQ / 2), 512, P.G, (int)blockIdx.x); pg8::EpiAddO E{buf2};
      pg8::gemm_phase<pg8::EpiAddO, pg8::FixOrder>(P.lds, g, S, E, P.tid); }
    }
    GRID_BAR();
    _Pragma("unroll") for (int rep_ = 0; rep_ < (REP_PHASE == 5 ? 2 : 1); ++rep_) if (PHON(5)) { if (rep_) GRID_BAR(); Frame P = F; P.tid = TID_RELOAD(); P.lane = P.tid & 63;
    phase_gla_gnorm(P, buf2, proj, gla_norm, hn);
    }
    GRID_BAR();
    _Pragma("unroll") for (int rep_ = 0; rep_ < (REP_PHASE == 6 ? 2 : 1); ++rep_) if (PHON(6)) { if (rep_) GRID_BAR(); Frame P = F; P.tid = TID_RELOAD(); P.lane = P.tid & 63;
    { pg8::Gemm g{hn, wgo, T, D, D}; pg8::StaticOrder S; S.init(T, D, P.G, (int)blockIdx.x); pg8::EpiResF32 E{x_in, xres, D};
      pg8::gemm_phase<pg8::EpiResF32, pg8::StaticOrder>(P.lds, g, S, E, P.tid); }
    }
    GRID_BAR();
    _Pragma("unroll") for (int rep_ = 0; rep_ < (REP_PHASE == 7 ? 2 : 1); ++rep_) if (PHON(7)) { if (rep_) GRID_BAR(); Frame P = F; P.tid = TID_RELOAD(); P.lane = P.tid & 63;
    phase_norm_route(P, xres, norm_ffn, wp_r0, hn, tok_e, tok_p, tok_w, ctl + CW_CNT0);
    }
    GRID_BAR();
    _Pragma("unroll") for (int rep_ = 0; rep_ < (REP_PHASE == 8 ? 2 : 1); ++rep_) if (PHON(8)) { if (rep_) GRID_BAR(); Frame P = F; P.tid = TID_RELOAD(); P.lane = P.tid & 63;
    moe_tables(P, ctl + CW_CNT0);
    phase_moe_slots(P, tok_e, tok_p, ctl + CW_CNT0, slot_of, slot_tok);
    }
    GRID_BAR();
    _Pragma("unroll") for (int rep_ = 0; rep_ < (REP_PHASE == 9 ? 2 : 1); ++rep_) if (PHON(9)) { if (rep_) GRID_BAR(); Frame P = F; P.tid = TID_RELOAD(); P.lane = P.tid & 63;
    { const int Mr = pst[33] * 256; pg8::Gemm g{hn, wmoe_gu, Mr, 1024, D}; pg8::MoeOrder S; S.init(Mr, 1024, P.G, (int)blockIdx.x); S.te = pst + 36; S.estride = (size_t)1024 * D; S.stok = slot_tok; pg8::EpiSiluMul E{(unsigned char*)hh};
      pg8::gemm_phase<pg8::EpiSiluMul, pg8::MoeOrder, true, true>(P.lds, g, S, E, P.tid); }
    }
    GRID_BAR();
    _Pragma("unroll") for (int rep_ = 0; rep_ < (REP_PHASE == 10 ? 2 : 1); ++rep_) if (PHON(10)) { if (rep_) GRID_BAR(); Frame P = F; P.tid = TID_RELOAD(); P.lane = P.tid & 63;
    { const int Mr = pst[33] * 256; pg8::Gemm g{hh, wmoe_d, Mr, D, DFF}; pg8::MoeOrder S; S.init(Mr, D, P.G, (int)blockIdx.x); S.te = pst + 36; S.estride = (size_t)D * DFF; S.stok = slot_tok; pg8::EpiBf16 E{ob, D};
      pg8::gemm_phase<pg8::EpiBf16, pg8::MoeOrder, false, true>(P.lds, g, S, E, P.tid); }
    }
    GRID_BAR();
    _Pragma("unroll") for (int rep_ = 0; rep_ < (REP_PHASE == 11 ? 2 : 1); ++rep_) if (PHON(11)) { if (rep_) GRID_BAR(); Frame P = F; P.tid = TID_RELOAD(); P.lane = P.tid & 63;
    phase_moe_combine<0>(P, xres, ob, slot_of, tok_w, norm_mix + D, hn);
    }
    GRID_BAR();
    _Pragma("unroll") for (int rep_ = 0; rep_ < (REP_PHASE == 12 ? 2 : 1); ++rep_) if (PHON(12)) { if (rep_) GRID_BAR(); Frame P = F; P.tid = TID_RELOAD(); P.lane = P.tid & 63;
    { pg8::Gemm g{hn, wdi, T, PROJW, D}; pg8::StaticOrder S; S.init(T, PROJW, P.G, (int)blockIdx.x); pg8::EpiHeads<1> E{proj};
      pg8::gemm_phase<pg8::EpiHeads<1>, pg8::StaticOrder, false, true>(P.lds, g, S, E, P.tid); }
    GRID_BAR();
    att::norms_phase(P, proj, (float*)(ws + WS_NRM));
    }
    GRID_BAR();
    _Pragma("unroll") for (int rep_ = 0; rep_ < (REP_PHASE == 13 ? 2 : 1); ++rep_) if (PHON(13)) { if (rep_) GRID_BAR(); Frame P = F; P.tid = TID_RELOAD(); P.lane = P.tid & 63;
    att::attn_phase(P, proj, (const float*)(ws + WS_NRM), ctl + CW_QUEUE, buf1, buf2, att::TailConv{moe_wg + (size_t)NEXP * D * DFF, moe_wu + (size_t)NEXP * D * DFF, moe_wd + (size_t)NEXP * DFF * D, (bf16_t*)(ws + WS_WMOE1), (bf16_t*)(ws + WS_WMOE1_D)});
    }
    GRID_BAR();
    _Pragma("unroll") for (int rep_ = 0; rep_ < (REP_PHASE == 14 ? 2 : 1); ++rep_) if (PHON(14)) { if (rep_) GRID_BAR(); Frame P = F; P.tid = TID_RELOAD(); P.lane = P.tid & 63;
    phase_subln(P, buf1, buf2, lq1, lk1, lq2, lk2, diff_subln, hn);
    }
    GRID_BAR();
    _Pragma("unroll") for (int rep_ = 0; rep_ < (REP_PHASE == 15 ? 2 : 1); ++rep_) if (PHON(15)) { if (rep_) GRID_BAR(); Frame P = F; P.tid = TID_RELOAD(); P.lane = P.tid & 63;
    { pg8::Gemm g{hn, wdo, T, D, D}; pg8::StaticOrder S; S.init(T, D, P.G, (int)blockIdx.x); pg8::EpiResF32 E{xres, xres, D};
      pg8::gemm_phase<pg8::EpiResF32, pg8::StaticOrder, false, true>(P.lds, g, S, E, P.tid); }
    }
    GRID_BAR();
    _Pragma("unroll") for (int rep_ = 0; rep_ < (REP_PHASE == 16 ? 2 : 1); ++rep_) if (PHON(16)) { if (rep_) GRID_BAR(); Frame P = F; P.tid = TID_RELOAD(); P.lane = P.tid & 63;
    phase_norm_route(P, xres, norm_ffn + D, wp_r1, hn, tok_e, tok_p, tok_w, ctl + CW_CNT1);
    }
    GRID_BAR();
    _Pragma("unroll") for (int rep_ = 0; rep_ < (REP_PHASE == 17 ? 2 : 1); ++rep_) if (PHON(17)) { if (rep_) GRID_BAR(); Frame P = F; P.tid = TID_RELOAD(); P.lane = P.tid & 63;
    moe_tables(P, ctl + CW_CNT1);
    phase_moe_slots(P, tok_e, tok_p, ctl + CW_CNT1, slot_of, slot_tok);
    }
    GRID_BAR();
    _Pragma("unroll") for (int rep_ = 0; rep_ < (REP_PHASE == 18 ? 2 : 1); ++rep_) if (PHON(18)) { if (rep_) GRID_BAR(); Frame P = F; P.tid = TID_RELOAD(); P.lane = P.tid & 63;
    { const int Mr = pst[33] * 256; pg8::Gemm g{hn, (bf16_t*)(ws + WS_WMOE1), Mr, 1024, D}; pg8::MoeOrder S; S.init(Mr, 1024, P.G, (int)blockIdx.x); S.te = pst + 36; S.estride = (size_t)1024 * D; S.stok = slot_tok; pg8::EpiSiluMul E{(unsigned char*)hh};
      pg8::gemm_phase<pg8::EpiSiluMul, pg8::MoeOrder, true, true>(P.lds, g, S, E, P.tid); }
    }
    GRID_BAR();
    _Pragma("unroll") for (int rep_ = 0; rep_ < (REP_PHASE == 19 ? 2 : 1); ++rep_) if (PHON(19)) { if (rep_) GRID_BAR(); Frame P = F; P.tid = TID_RELOAD(); P.lane = P.tid & 63;
    { const int Mr = pst[33] * 256; pg8::Gemm g{hh, (bf16_t*)(ws + WS_WMOE1_D), Mr, D, DFF}; pg8::MoeOrder S; S.init(Mr, D, P.G, (int)blockIdx.x); S.te = pst + 36; S.estride = (size_t)D * DFF; S.stok = slot_tok; pg8::EpiBf16 E{ob, D};
      pg8::gemm_phase<pg8::EpiBf16, pg8::MoeOrder, false, true>(P.lds, g, S, E, P.tid); }
    }
    GRID_BAR();
    _Pragma("unroll") for (int rep_ = 0; rep_ < (REP_PHASE == 20 ? 2 : 1); ++rep_) if (PHON(20)) { if (rep_) GRID_BAR(); Frame P = F; P.tid = TID_RELOAD(); P.lane = P.tid & 63;
    phase_moe_combine<1>(P, xres, ob, slot_of, tok_w, final_norm, hn);
    }
}

#undef x_in
#undef norm_mix
#undef norm_ffn
#undef gla_w_in
#undef gla_wgu
#undef gla_bg
#undef gla_norm
#undef gla_w_out
#undef diff_w_in
#undef lq1
#undef lk1
#undef lq2
#undef lk2
#undef diff_subln
#undef diff_w_out
#undef moe_wgrp
#undef moe_wexp
#undef moe_wg
#undef moe_wu
#undef moe_wd
#undef final_norm
#undef xres
#undef gz
#undef tok_e
#undef tok_p
#undef tok_w
#undef slot_of
#undef slot_tok
#undef ws
#undef ctl
#undef adec
#undef pcum
#undef sfin
#undef wp_gz
#undef wp_r0
#undef wp_r1
#undef wgi
#undef wgo
#undef wdi
#undef wdo
#undef wmoe_gu
#undef wmoe_d
#undef hn
#undef proj
#undef buf1
#undef buf2
#undef ag
#undef ob
#undef hh

extern "C" void kernel_launch(void* const* d_in, const int* in_sizes, int n_in, void* d_out, int out_size, void* d_ws, size_t ws_size, hipStream_t stream) {
    static int grid = 0;
    if (grid == 0) {
        if (n_in != 21 || out_size != T * D || ws_size < WS_END) { fprintf(stderr, "kernel_launch: unexpected shapes (n_in %d out %d ws %zu)\n", n_in, out_size, ws_size); grid = -1; return; }
        if (hipFuncSetAttribute((const void*)hybrid_fwd, hipFuncAttributeMaxDynamicSharedMemorySize, LDS_BYTES) != hipSuccess) { fprintf(stderr, "kernel_launch: hipFuncSetAttribute failed\n"); grid = -1; return; }
        int dev = 0, cus = 0, per_cu = 0;
        (void)hipGetDevice(&dev); (void)hipDeviceGetAttribute(&cus, hipDeviceAttributeMultiprocessorCount, dev);
        if (hipOccupancyMaxActiveBlocksPerMultiprocessor(&per_cu, (const void*)hybrid_fwd, NWAVES * 64, LDS_BYTES) != hipSuccess || per_cu < 1) fprintf(stderr, "kernel_launch: occupancy query says %d\n", per_cu);
        (void)hipGetLastError();
        grid = cus > 0 ? cus : 256;
    }
    if (grid < 0) return;
    Args a{};
    for (int i = 0; i < 21; ++i) a.in[i] = (const float*)d_in[i];
    a.out = (float*)d_out; a.ws = (unsigned char*)d_ws; a.pad0 = 0; a.pad1 = 0;
    (void)hipMemsetAsync((char*)d_ws + WS_CTL, 0, CTL_ZERO_BYTES, stream);
    hipLaunchKernelGGL(hybrid_fwd, dim3(grid), dim3(NWAVES * 64), LDS_BYTES, stream, a);
}
```

```cpp
#ifndef REP_PHASE
#define REP_PHASE -1
#endif
#include <hip/hip_runtime.h>
#include <cstdio>
#include <cstdint>

#define LAS __attribute__((address_space(3)))
#define GAS __attribute__((address_space(1)))
typedef unsigned short bf16_t;
typedef short bf16x8 __attribute__((ext_vector_type(8)));
typedef short s16x4 __attribute__((ext_vector_type(4)));
typedef float f32x4 __attribute__((ext_vector_type(4)));
typedef float f32x2 __attribute__((ext_vector_type(2)));
typedef float f32x16 __attribute__((ext_vector_type(16)));
typedef unsigned u32x4 __attribute__((ext_vector_type(4)));
typedef unsigned u32x2 __attribute__((ext_vector_type(2)));
typedef int v8i32 __attribute__((ext_vector_type(8)));
typedef int v4i32 __attribute__((ext_vector_type(4)));

constexpr int D = 2048, SEQ = 16384, NBATCH = 2, T = NBATCH * SEQ, CHUNK = 64, NCH = SEQ / CHUNK;
constexpr int GLA_H = 4, GLA_DK = 256, GLA_DV = 512, GLA_DKT = 1024, GLA_INW = 6160, PROJW = 6144;
constexpr int DIFF_H = 8;
constexpr int NEXP = 32, DFF = 512;
constexpr float RMS_EPS = 1e-6f;
constexpr float LAMBDA_INIT = 0.35550906759f;
constexpr int MAX_TILES = 288;

constexpr size_t MiB = 1u << 20;
constexpr size_t WS_CTL = 0, CTL_ZERO_BYTES = 1 * MiB;
constexpr size_t WS_GZ = 2 * MiB;
constexpr size_t WS_TOKE = 4 * MiB;
constexpr size_t WS_TOKP = WS_TOKE + 256 * 1024;
constexpr size_t WS_TOKW = WS_TOKP + 256 * 1024;
constexpr size_t WS_SLOT = WS_TOKW + 256 * 1024;
constexpr size_t WS_STOK = 5 * MiB;
constexpr size_t WS_ADEC = 8 * MiB;
constexpr size_t WS_WPGZ = 10 * MiB;
constexpr size_t WS_WPR0 = 10 * MiB + 256 * 1024;
constexpr size_t WS_WPR1 = 11 * MiB;
constexpr size_t WS_NRM = 12 * MiB;
constexpr size_t WS_PCUM = 13 * MiB;
constexpr size_t WS_SFIN = 14 * MiB;
constexpr size_t WS_WGI = 16 * MiB, WS_WGO = 40 * MiB, WS_WDI = 48 * MiB, WS_WDO = 72 * MiB;
constexpr size_t WS_WMOE = 80 * MiB;
constexpr size_t WS_WMOE_D = WS_WMOE + 128 * MiB;
constexpr size_t WS_WMOE1 = WS_WMOE + 64 * MiB, WS_WMOE1_D = WS_WMOE + 160 * MiB;
constexpr size_t WS_HN = 272 * MiB;
constexpr size_t WS_PROJ = 400 * MiB;
constexpr size_t WS_BUF1 = 784 * MiB;
constexpr size_t WS_BUF2 = 912 * MiB;
constexpr size_t WS_AG = 400 * MiB;
constexpr size_t WS_OB = 688 * MiB;
constexpr size_t WS_H = 976 * MiB;
constexpr size_t WS_END = 1048 * MiB;
constexpr int CW_BAR = 4096;
constexpr int CW_QUEUE = 8192;
constexpr int CW_CNT0 = 16384, CW_CNT1 = 16384 + 32 * 64;


constexpr size_t GK0 = (size_t)T * 1024, GV0 = (size_t)T * 2048, GR0 = (size_t)T * 4096;
constexpr size_t DK0 = (size_t)T * 2048, DV0 = (size_t)T * 4096;
__host__ __device__ __forceinline__ size_t gq_off(int b, int t, int h) { return ((size_t)(b * 4 + h) * SEQ + t) * 256; }
__host__ __device__ __forceinline__ size_t gv_off(int b, int t, int h) { return GV0 + ((size_t)(b * 4 + h) * SEQ + t) * 512; }
__host__ __device__ __forceinline__ size_t dq_off(int b, int t, int h, int sub) { return ((size_t)((b * 8 + h) * 2 + sub) * SEQ + t) * 128; }
__host__ __device__ __forceinline__ size_t dv_off(int b, int t, int h) { return DV0 + ((size_t)(b * 8 + h) * SEQ + t) * 256; }

constexpr int RING_BYTES = 131072;
constexpr int LDSCTL_OFF = RING_BYTES;
constexpr int MISC_OFF = LDSCTL_OFF + 320;
constexpr int TIDS_OFF = LDSCTL_OFF + 8192;
constexpr int TAB_OFF = LDSCTL_OFF + 1024;
constexpr int LDS_BYTES = 147456;
constexpr int NWAVES = 8;

typedef __bf16 bf16x2_t __attribute__((ext_vector_type(2)));
__device__ __forceinline__ unsigned cvt_pk_bf16(float lo, float hi) { const f32x2 v = {lo, hi}; return __builtin_bit_cast(unsigned, __builtin_convertvector(v, bf16x2_t)); }
__device__ __forceinline__ unsigned cvt4_fp8(float a, float b, float c, float d) { int v = __builtin_amdgcn_cvt_pk_fp8_f32(a, b, 0, false); return (unsigned)__builtin_amdgcn_cvt_pk_fp8_f32(c, d, v, true); }
constexpr float W8_SCALE = 64.f;
__device__ __forceinline__ float bf_lo(unsigned w) { return __uint_as_float(w << 16); }
__device__ __forceinline__ float bf_hi(unsigned w) { return __uint_as_float(w & 0xffff0000u); }
__device__ __forceinline__ float bf2f(bf16_t b) { return __uint_as_float(((unsigned)b) << 16); }
__device__ __forceinline__ float wave_sum(float v) {
#pragma unroll
    for (int o = 1; o < 64; o <<= 1) v += __shfl_xor(v, o);
    return v;
}
__device__ __forceinline__ int lane_id() { return (int)__builtin_amdgcn_mbcnt_hi(~0u, __builtin_amdgcn_mbcnt_lo(~0u, 0u)); }
__device__ __forceinline__ int lane_id_volatile() { int l; asm volatile("v_mbcnt_lo_u32_b32 %0, -1, 0\n\tv_mbcnt_hi_u32_b32 %0, -1, %0" : "=v"(l)); return l; }
__device__ __forceinline__ int opq(int v) { asm volatile("" : "+v"(v)); return v; }
#define LDS_WAIT() asm volatile("s_waitcnt lgkmcnt(0)" ::: "memory")
#define VM_WAIT() asm volatile("s_waitcnt vmcnt(0)" ::: "memory")
#define WG_BAR() do { asm volatile("s_waitcnt lgkmcnt(0)" ::: "memory"); __builtin_amdgcn_s_barrier(); asm volatile("" ::: "memory"); } while (0)

namespace pg8 {
constexpr int BM = 256, BK = 64, HALF = 128, HTB = HALF * BK * 2, STAGE_BYTES = 8 * HTB, NXCD = 8, WGM = 8;
__host__ __device__ __forceinline__ int lds_byte(int r, int c) { const int st = (r >> 4) * 2 + (c >> 5), rr = r & 15, cc = c & 31, ob = rr * 64 + cc * 2; return st * 1024 + (ob ^ (((ob >> 9) & 1) << 5)); }
__host__ __device__ __forceinline__ void stage_rc(int b, int& R, int& C) { const int st = b / 1024, sb = b % 1024, swz = sb ^ (((sb >> 9) & 1) << 5); R = (st >> 1) * 16 + swz / 64; C = (st & 1) * 32 + (swz % 64) / 2; }
__host__ __device__ __forceinline__ int perm32(int rho) { const int n = rho >> 4, i = rho & 15; return 8 * (i >> 2) + 4 * n + (i & 3); }

struct Unit { int pm, pn; };
struct Gemm { const bf16_t* A; const bf16_t* Bt; int M, N, K; };

struct StaticOrder {
    int nM, nN, nwg, G, c;
    __device__ void init(int M, int N, int G_, int c_) { nM = M / BM; nN = N / BM; nwg = nM * nN; G = G_; c = c_; }
    __device__ bool next(int i, Unit& u) const {
        const long L = (long)i * G + c; if (L >= nwg) return false;
        int wgid = (int)L; { const int q = nwg / NXCD, r = nwg % NXCD, xcd = wgid % NXCD, off = wgid / NXCD; wgid = (xcd < r ? xcd * (q + 1) : r * (q + 1) + (xcd - r) * q) + off; }
        const int nig = WGM * nN, gid = wgid / nig, fm = gid * WGM, gsz = (nM - fm) < WGM ? (nM - fm) : WGM;
        u.pm = fm + ((wgid % nig) % gsz); u.pn = (wgid % nig) / gsz; return true;
    }
    __device__ __forceinline__ size_t bofs(const Unit&) const { return 0; }
};
struct MoeOrder : StaticOrder {
    const LAS int* te; size_t estride; const int* stok;
    __device__ __forceinline__ size_t bofs(const Unit& u) const { return (size_t)te[u.pm] * estride; }
    __device__ __forceinline__ int arow(int pm, int r) const { const int t = stok[pm * BM + r]; return t < 0 ? 0 : t; }
};

struct EpiBf16 {
    static constexpr bool PERM = true;
    bf16_t* O; int ldc;
    __device__ __forceinline__ void operator()(const f32x4 (&acc)[2][2][4][2], const Unit& u, int wr, int wc, int fr, int fq) const {
        const int row0 = u.pm * BM + wr * 64 + fr, col0 = u.pn * BM + wc * 32 + 8 * fq;
#pragma unroll
        for (int ai = 0; ai < 2; ++ai)
#pragma unroll
            for (int m = 0; m < 4; ++m) { bf16_t* rowp = O + (size_t)(row0 + ai * HALF + m * 16) * ldc + col0;
#pragma unroll
                for (int bj = 0; bj < 2; ++bj) { const f32x4 v0 = acc[ai][bj][m][0], v1 = acc[ai][bj][m][1];
                    u32x4 w; w.x = cvt_pk_bf16(v0[0], v0[1]); w.y = cvt_pk_bf16(v0[2], v0[3]); w.z = cvt_pk_bf16(v1[0], v1[1]); w.w = cvt_pk_bf16(v1[2], v1[3]);
                    *(u32x4*)(rowp + bj * HALF) = w; } }
    }
};
template <int LAYER> struct EpiHeads {
    static constexpr bool PERM = true;
    bf16_t* O;
    __device__ __forceinline__ void operator()(const f32x4 (&acc)[2][2][4][2], const Unit& u, int wr, int wc, int fr, int fq) const {
        const int pn = u.pn, lc = wc * 32 + 8 * fq;
#pragma unroll
        for (int ai = 0; ai < 2; ++ai)
#pragma unroll
            for (int m = 0; m < 4; ++m) { const int row = u.pm * BM + ai * HALF + wr * 64 + m * 16 + fr, b = row >> 14, t = row & (SEQ - 1);
#pragma unroll
                for (int bj = 0; bj < 2; ++bj) { size_t off;
                    if (LAYER == 0) { if (pn < 4) off = gq_off(b, t, pn) + bj * 128 + lc; else if (pn < 8) off = GK0 + gq_off(b, t, pn - 4) + bj * 128 + lc;
                                      else if (pn < 16) off = gv_off(b, t, (pn - 8) >> 1) + ((pn - 8) & 1) * 256 + bj * 128 + lc; else off = GR0 + (size_t)row * 2048 + (pn - 16) * 256 + bj * 128 + lc; }
                    else { if (pn < 8) off = dq_off(b, t, pn, bj) + lc; else if (pn < 16) off = DK0 + dq_off(b, t, pn - 8, bj) + lc; else off = dv_off(b, t, pn - 16) + bj * 128 + lc; }
                    const f32x4 v0 = acc[ai][bj][m][0], v1 = acc[ai][bj][m][1];
                    if (LAYER == 1 && pn < 16) {
                        u32x2 w8; w8.x = cvt4_fp8(v0[0], v0[1], v0[2], v0[3]); w8.y = cvt4_fp8(v1[0], v1[1], v1[2], v1[3]); *(u32x2*)((unsigned char*)O + off) = w8; continue; }
                    u32x4 w; w.x = cvt_pk_bf16(v0[0], v0[1]); w.y = cvt_pk_bf16(v0[2], v0[3]); w.z = cvt_pk_bf16(v1[0], v1[1]); w.w = cvt_pk_bf16(v1[2], v1[3]);
                    *(u32x4*)(O + off) = w; } }
    }
};
__host__ __device__ __forceinline__ size_t vt_off(int b, int h, int chunk) { return DV0 * 2 + ((size_t)((b * 8 + h) * (SEQ / 64) + chunk)) * 16384; }
struct EpiVT {
    static constexpr bool PERM = false;
    unsigned char* O;
    __device__ __forceinline__ void operator()(const f32x4 (&acc)[2][2][4][2], const Unit& u, int wr, int wc, int fr, int fq) const {
#pragma unroll
        for (int ai = 0; ai < 2; ++ai) { const int row0 = u.pm * BM + ai * HALF + wr * 64;
            unsigned char* tp = O + vt_off(row0 >> 14, u.pn, (row0 & (SEQ - 1)) >> 6) + (size_t)(wc * 32 + fr) * 64 + 32 * (fq & 1) + 4 * (fq >> 1);
#pragma unroll
            for (int m = 0; m < 4; ++m)
#pragma unroll
                for (int bj = 0; bj < 2; ++bj)
#pragma unroll
                    for (int n = 0; n < 2; ++n) { const f32x4 v = acc[ai][bj][m][n];
                        *(unsigned*)(tp + (bj * 128 + n * 16) * 64 + 16 * (m >> 1) + 8 * (m & 1)) = cvt4_fp8(v[0], v[1], v[2], v[3]); } }
    }
};
struct FixOrder : StaticOrder {
    __device__ __forceinline__ size_t bofs(const Unit& u) const { return (size_t)(u.pm >> 5) * (512 * 256 * 2); }
};
struct EpiAddO {
    static constexpr bool PERM = true;
    bf16_t* O;
    __device__ __forceinline__ void operator()(const f32x4 (&acc)[2][2][4][2], const Unit& u, int wr, int wc, int fr, int fq) const {
#pragma unroll
        for (int ai = 0; ai < 2; ++ai)
#pragma unroll
            for (int m = 0; m < 4; ++m) { const int row = u.pm * BM + ai * HALF + wr * 64 + m * 16 + fr, bhh = row >> 13, t = row & 8191;
                bf16_t* rowp = O + ((size_t)(bhh >> 2) * SEQ + SEQ / 2 + t) * D + (bhh & 3) * 512 + u.pn * BM + wc * 32 + 8 * fq;
#pragma unroll
                for (int bj = 0; bj < 2; ++bj) { const u32x4 old = *(const u32x4*)(rowp + bj * HALF); const f32x4 v0 = acc[ai][bj][m][0] * 0.0625f, v1 = acc[ai][bj][m][1] * 0.0625f;
                    u32x4 w; w.x = cvt_pk_bf16(bf_lo(old.x) + v0[0], bf_hi(old.x) + v0[1]); w.y = cvt_pk_bf16(bf_lo(old.y) + v0[2], bf_hi(old.y) + v0[3]);
                    w.z = cvt_pk_bf16(bf_lo(old.z) + v1[0], bf_hi(old.z) + v1[1]); w.w = cvt_pk_bf16(bf_lo(old.w) + v1[2], bf_hi(old.w) + v1[3]);
                    *(u32x4*)(rowp + bj * HALF) = w; } }
    }
};
struct EpiResF32 {
    static constexpr bool PERM = false;
    const float* base; float* C; int ldc;
    __device__ __forceinline__ void operator()(const f32x4 (&acc)[2][2][4][2], const Unit& u, int wr, int wc, int fr, int fq) const {
        const int row0 = u.pm * BM + wr * 64 + fr, col0 = u.pn * BM + wc * 32 + 4 * fq;
#pragma unroll
        for (int ai = 0; ai < 2; ++ai)
#pragma unroll
            for (int m = 0; m < 4; ++m) { const size_t off = (size_t)(row0 + ai * HALF + m * 16) * ldc + col0;
#pragma unroll
                for (int bj = 0; bj < 2; ++bj)
#pragma unroll
                    for (int n = 0; n < 2; ++n) { const f32x4 bs = *(const f32x4*)(base + off + bj * HALF + n * 16); *(f32x4*)(C + off + bj * HALF + n * 16) = bs + acc[ai][bj][m][n]; }
                asm volatile("" ::: "memory"); }
    }
};
struct EpiSiluMul {
    static constexpr bool PERM = true;
    unsigned char* Hh;
    __device__ __forceinline__ void operator()(const f32x4 (&acc)[2][2][4][2], const Unit& u, int wr, int wc, int fr, int fq) const {
        const int row0 = u.pm * BM + wr * 64 + fr, col0 = u.pn * HALF + wc * 32 + 8 * fq;
#pragma unroll
        for (int ai = 0; ai < 2; ++ai)
#pragma unroll
            for (int m = 0; m < 4; ++m) { unsigned char* rowp = Hh + (size_t)(row0 + ai * HALF + m * 16) * DFF + col0;
                float hv[8];
#pragma unroll
                for (int n = 0; n < 2; ++n)
#pragma unroll
                    for (int j = 0; j < 4; ++j) { const float g = acc[ai][0][m][n][j], up = acc[ai][1][m][n][j];
                        const float sg = g * __builtin_amdgcn_rcpf(1.0f + __builtin_amdgcn_exp2f(-1.4426950408889634f * g)); hv[n * 4 + j] = sg * up; }
                u32x2 w; w.x = cvt4_fp8(hv[0], hv[1], hv[2], hv[3]); w.y = cvt4_fp8(hv[4], hv[5], hv[6], hv[7]);
                *(u32x2*)rowp = w; }
    }
};

template <class Epi, class Sched, bool GATHER = false, bool FP8 = false, bool NTR = false>
__device__ __forceinline__ void gemm_phase(LAS unsigned char* lds, const Gemm g, const Sched& S, const Epi& E, int tid_in) {
    const int tid = opq(tid_in), wid = __builtin_amdgcn_readfirstlane(tid >> 6), lane = tid & 63, wr = wid >> 2, wc = wid & 3, fr = lane & 15, fq = lane >> 4;
    const int K = g.K, RP = FP8 ? K : 2 * K  , nt = RP / (BK * 2);
    unsigned voffA[2], voffB[2];
#pragma unroll
    for (int i = 0; i < 2; ++i) { int R, C; stage_rc(tid * 16 + i * 8192, R, C); const int Rb = Epi::PERM ? ((R & ~31) + perm32(R & 31)) : R;
        voffA[i] = (unsigned)(R * RP + 2 * C); voffB[i] = (unsigned)(Rb * RP + 2 * C); }
    const unsigned kstep = (unsigned)(BK * 2);
    const unsigned hstep = (unsigned)HALF * (unsigned)RP;
    const size_t tstep = 2 * (size_t)hstep;
    const unsigned ldsw = (unsigned)wid * 1024u;
    const int aoff = lds_byte(wr * 64 + fr, fq * 8), boff = lds_byte(wc * 32 + fr, fq * 8);
    const LAS unsigned char* ldsB = lds + 4 * HTB + boff;
#define PG8_SA(b, h) (((b) * 2 + (h)) * HTB)
#define PG8_SB(b, h) ((4 + (b) * 2 + (h)) * HTB)
#define PG8_STAGE(bufoff, gbase, voff) do { const unsigned long long gv_ = (unsigned long long)(gbase); \
        const unsigned glo_ = (unsigned)__builtin_amdgcn_readfirstlane((unsigned)gv_), ghi_ = (unsigned)__builtin_amdgcn_readfirstlane((unsigned)(gv_ >> 32)); const char* gb_ = (const char*)(((unsigned long long)ghi_ << 32) | (unsigned long long)glo_);     \
        _Pragma("unroll") for (int _i = 0; _i < 2; ++_i) \
        __builtin_amdgcn_global_load_lds((const unsigned*)(gb_ + (voff)[_i]), (LAS unsigned*)(lds + (bufoff) + ldsw + _i * 8192), 16, 0, 0); } while (0)
#define PG8_STAGE_A(bufoff, nx, koff, h) do { if constexpr (GATHER) { unsigned vs_[2]; _Pragma("unroll") for (int _i = 0; _i < 2; ++_i) vs_[_i] = (nx) ? vAn[h][_i] : vAc[h][_i]; \
            PG8_STAGE(bufoff, (const char*)g.A + (koff), vs_); } \
        else { PG8_STAGE(bufoff, ((nx) ? nA : cA) + (koff) + (h) * hstep, voffA); } } while (0)
#define PG8_LD8(off) __builtin_shufflevector(*(const LAS v4i32*)(lds + (off)), *(const LAS v4i32*)(lds + (off) + 1024), 0, 1, 2, 3, 4, 5, 6, 7)
#define PG8_LDA(dst, b, h) do { if constexpr (FP8) { _Pragma("unroll") for (int m = 0; m < 4; ++m) dst##8[m] = PG8_LD8(PG8_SA(b, h) + aoff + m * 2048); } \
        else { _Pragma("unroll") for (int m = 0; m < 4; ++m) _Pragma("unroll") for (int k = 0; k < 2; ++k) dst[m][k] = *(const LAS bf16x8*)(lds + PG8_SA(b, h) + aoff + m * 2048 + k * 1024); } } while (0)
#define PG8_LD8B(off) __builtin_shufflevector(*(const LAS v4i32*)(ldsB + (off)), *(const LAS v4i32*)(ldsB + (off) + 1024), 0, 1, 2, 3, 4, 5, 6, 7)
#define PG8_LDB(dst, b, h) do { if constexpr (FP8) { _Pragma("unroll") for (int n = 0; n < 2; ++n) dst##8[n] = PG8_LD8B(PG8_SA(b, h) + n * 2048); }     \
        else { _Pragma("unroll") for (int n = 0; n < 2; ++n) _Pragma("unroll") for (int k = 0; k < 2; ++k) dst[n][k] = *(const LAS bf16x8*)(lds + PG8_SB(b, h) + boff + n * 2048 + k * 1024); } } while (0)
#define PG8_MMA(ai, bj, At, Bt) do { __builtin_amdgcn_s_setprio(1); if constexpr (FP8) { _Pragma("unroll") for (int m = 0; m < 4; ++m) _Pragma("unroll") for (int n = 0; n < 2; ++n) \
              \
            { if constexpr (NTR) asm volatile("v_mfma_scale_f32_16x16x128_f8f6f4 %0, %1, %2, %0, %3, %3 op_sel:[1,0,0] op_sel_hi:[0,0,0]" : "+v"(acc[ai][bj][m][n]) : "v"(At##8[m]), "v"(Bt##8[n]), "v"(scl8)); \
              else asm volatile("v_mfma_scale_f32_16x16x128_f8f6f4 %0, %1, %2, %0, %3, %3 op_sel:[0,1,0] op_sel_hi:[0,0,0]" : "+v"(acc[ai][bj][m][n]) : "v"(Bt##8[n]), "v"(At##8[m]), "v"(scl8)); } } \
        else { _Pragma("unroll") for (int m = 0; m < 4; ++m) _Pragma("unroll") for (int n = 0; n < 2; ++n) _Pragma("unroll") for (int k = 0; k < 2; ++k) \
            acc[ai][bj][m][n] = __builtin_amdgcn_mfma_f32_16x16x32_bf16(Bt[n][k], At[m][k], acc[ai][bj][m][n], 0, 0, 0); } __builtin_amdgcn_s_setprio(0); } while (0)
#define PG8_WAIT_V(n) asm volatile("s_waitcnt vmcnt(" #n ")" ::: "memory")
#define PG8_WAIT_L(n) asm volatile("s_waitcnt lgkmcnt(" #n ")" ::: "memory")
#define PG8_BAR __builtin_amdgcn_s_barrier()
#define PG8_SCHED __builtin_amdgcn_sched_barrier(0)
#define PG8_ROWOFFS(V, U) do { if constexpr (GATHER) { const int t_ = opq(wid * 64 + lane_id());     \
        _Pragma("unroll") for (int i_ = 0; i_ < 2; ++i_) { int R_, C_; stage_rc(t_ * 16 + i_ * 8192, R_, C_); \
        _Pragma("unroll") for (int h_ = 0; h_ < 2; ++h_) V[h_][i_] = (unsigned)S.arow((U).pm, h_ * HALF + R_) * (unsigned)RP + 2u * (unsigned)C_; } } } while (0)
    Unit cur, nxt; int ui = 0;
    if (!S.next(0, cur)) return;
    f32x4 acc[2][2][4][2];
#pragma unroll
    for (int a = 0; a < 2; ++a)
#pragma unroll
        for (int b = 0; b < 2; ++b)
#pragma unroll
            for (int m = 0; m < 4; ++m)
#pragma unroll
                for (int n = 0; n < 2; ++n) acc[a][b][m][n] = (f32x4){0.f, 0.f, 0.f, 0.f};
    const unsigned scl8 = 0x7f797f79u;
    bf16x8 At[4][2], B0[2][2], B1[2][2]; v8i32 At8[4], B08[2], B18[2];
    unsigned vAc[2][2] = {{0u, 0u}, {0u, 0u}}, vAn[2][2] = {{0u, 0u}, {0u, 0u}};
    const char* cA = (const char*)g.A + (GATHER ? (size_t)0 : (size_t)cur.pm * tstep); const char* nA = cA; const char* cB = (const char*)g.Bt + S.bofs(cur) + (size_t)cur.pn * tstep;
    PG8_ROWOFFS(vAc, cur);
    PG8_STAGE(PG8_SB(0, 0), cB, voffB); PG8_STAGE(PG8_SB(0, 1), cB + hstep, voffB); PG8_STAGE_A(PG8_SA(0, 0), false, 0u, 0); PG8_STAGE_A(PG8_SA(0, 1), false, 0u, 1);
    if (wr == 1) PG8_BAR;
    PG8_WAIT_V(2); PG8_BAR;
    PG8_STAGE(PG8_SB(1, 0), cB + kstep, voffB); PG8_STAGE_A(PG8_SA(1, 0), false, kstep, 0); PG8_STAGE(PG8_SB(1, 1), cB + hstep + kstep, voffB);
    PG8_WAIT_V(6); PG8_BAR;
    for (;;) {
        const bool has_next = S.next(ui + 1, nxt);
        nA = (has_next && !GATHER) ? (const char*)g.A + (size_t)nxt.pm * tstep : cA; const char* nB = has_next ? (const char*)g.Bt + S.bofs(nxt) + (size_t)nxt.pn * tstep : cB;

        for (int t = 0; t < nt; t += 2) {
            const bool last = (t == nt - 2);
            if constexpr (GATHER) { if (last) {
                if (has_next) PG8_ROWOFFS(vAn, nxt); else { _Pragma("unroll") for (int h_ = 0; h_ < 2; ++h_) _Pragma("unroll") for (int i_ = 0; i_ < 2; ++i_) vAn[h_][i_] = vAc[h_][i_]; } } }
            const unsigned k1 = (unsigned)(t + 1) * kstep, k2 = last ? 0u : (unsigned)(t + 2) * kstep, k3 = k2 + kstep;
            const char* b2 = last ? nB : cB + k2; const char* b3 = b2 + kstep;
            PG8_LDB(B0, 0, 0); PG8_LDB(B1, 0, 1); PG8_SCHED; PG8_LDA(At, 0, 0); PG8_STAGE_A(PG8_SA(1, 1), false, k1, 1);
            PG8_WAIT_V(8); PG8_WAIT_L(0); PG8_BAR; PG8_MMA(0, 0, At, B0); PG8_MMA(0, 1, At, B1); PG8_BAR; PG8_SCHED;
            PG8_LDA(At, 0, 1); PG8_STAGE(PG8_SB(0, 0), b2, voffB); PG8_STAGE(PG8_SB(0, 1), b2 + hstep, voffB); PG8_STAGE_A(PG8_SA(0, 0), last, k2, 0);
            PG8_WAIT_V(8); PG8_WAIT_L(0); PG8_BAR; PG8_MMA(1, 0, At, B0); PG8_MMA(1, 1, At, B1); PG8_BAR; PG8_SCHED;
            PG8_LDB(B0, 1, 0); PG8_LDB(B1, 1, 1); PG8_SCHED; PG8_LDA(At, 1, 0); PG8_STAGE_A(PG8_SA(0, 1), last, k2, 1);
            PG8_WAIT_V(8); PG8_WAIT_L(0); PG8_BAR; PG8_MMA(0, 0, At, B0); PG8_MMA(0, 1, At, B1); PG8_BAR; PG8_SCHED;
            PG8_LDA(At, 1, 1); PG8_STAGE(PG8_SB(1, 0), b3, voffB); PG8_STAGE(PG8_SB(1, 1), b3 + hstep, voffB); PG8_STAGE_A(PG8_SA(1, 0), last, k3, 0);
            PG8_WAIT_V(8); PG8_WAIT_L(0); PG8_BAR; PG8_MMA(1, 0, At, B0); PG8_MMA(1, 1, At, B1); PG8_BAR; PG8_SCHED;
        }
        if (wr == 0) PG8_BAR;
        E(acc, cur, wr, wc, fr, fq);
        if (!has_next) break;
#pragma unroll
        for (int a = 0; a < 2; ++a)
#pragma unroll
            for (int b = 0; b < 2; ++b)
#pragma unroll
                for (int m = 0; m < 4; ++m)
#pragma unroll
                    for (int n = 0; n < 2; ++n) acc[a][b][m][n] = (f32x4){0.f, 0.f, 0.f, 0.f};
        cur = nxt; cA = nA; cB = nB; ++ui;
        if constexpr (GATHER) { _Pragma("unroll") for (int h_ = 0; h_ < 2; ++h_) _Pragma("unroll") for (int i_ = 0; i_ < 2; ++i_) vAc[h_][i_] = vAn[h_][i_]; }
        if (wr == 1) PG8_BAR;
    }
    PG8_WAIT_V(0);
    PG8_BAR;
#undef PG8_SA
#undef PG8_SB
#undef PG8_STAGE
#undef PG8_STAGE_A
#undef PG8_ROWOFFS
#undef PG8_LDA
#undef PG8_LDB
#undef PG8_MMA
#undef PG8_LD8
#undef PG8_LD8B
#undef PG8_WAIT_V
#undef PG8_WAIT_L
#undef PG8_BAR
#undef PG8_SCHED
}
}

#define XB_TMO      128
#define XB_XCNT(j)  (256  + 64 * (j))
#define XB_XSUB(j)  (1280 + 64 * (j))
#define XB_XGEN(j)  (2304 + 64 * (j))
#define XB_TOP      3328
#define XB_TOPGEN   3392
#define XCD_BAR_WORDS 3456
#define XB_SPIN_CAP (1u << 18)
__device__ __forceinline__ unsigned xb_ld(unsigned* p)              { return __hip_atomic_load(p, __ATOMIC_RELAXED, __HIP_MEMORY_SCOPE_AGENT); }
__device__ __forceinline__ unsigned xb_add(unsigned* p, unsigned v) { return __hip_atomic_fetch_add(p, v, __ATOMIC_RELAXED, __HIP_MEMORY_SCOPE_AGENT); }
__device__ __forceinline__ unsigned xb_xcc_id() { return (unsigned)__builtin_amdgcn_s_getreg((3 << 11) | 20) & 0xFu; }
#define XB_SPIN(cond, bar) do { unsigned _sp = 0; while (cond) { __builtin_amdgcn_s_sleep(1); \
    if ((++_sp & 255u) == 0u) { if (xb_ld(&(bar)[XB_TMO])) break; if (_sp > XB_SPIN_CAP) { atomicAdd(&(bar)[XB_TMO], 1u); break; } } } } while (0)
struct XcdBarrier { unsigned* bar; unsigned x; volatile LAS unsigned* st; int wave; };
__device__ __forceinline__ XcdBarrier xcd_barrier_post(unsigned* bar, volatile LAS unsigned* st) {
    XcdBarrier b; b.bar = bar; b.x = xb_xcc_id(); b.st = st; b.wave = __builtin_amdgcn_readfirstlane((int)threadIdx.x >> 6);
    if (threadIdx.x == 0) (void)xb_add(&bar[XB_XCNT(b.x)], 1u);
    return b;
}
__device__ __forceinline__ void xcd_barrier_complete(unsigned* bar, unsigned x, unsigned& nloc, unsigned& nx) {
    const unsigned G = gridDim.x * gridDim.y * gridDim.z;
    unsigned sum, cnt, mine, sp = 0u;
    for (;;) {
        sum = 0u; cnt = 0u; mine = 0u;
#pragma unroll
        for (unsigned j = 0; j < 16; ++j) { const unsigned c = xb_ld(&bar[XB_XCNT(j)]); sum += c; cnt += (c > 0u) ? 1u : 0u; mine = (j == x) ? c : mine; }
        if (sum == G) break;
        __builtin_amdgcn_s_sleep(1);
        if ((++sp & 255u) == 0u) { if (xb_ld(&bar[XB_TMO])) break; if (sp > XB_SPIN_CAP) { atomicAdd(&bar[XB_TMO], 1u); break; } }
    }
    nloc = mine > 0u ? mine : 1u; nx = cnt > 0u ? cnt : 1u;
}
__device__ __forceinline__ void xcd_barrier(const XcdBarrier& b, bool leader  ) {
    asm volatile("s_waitcnt vmcnt(0)" ::: "memory");
    __syncthreads();
    if (leader) {
        unsigned* bar = b.bar;
        __builtin_amdgcn_s_waitcnt(0);
        unsigned nloc = b.st[0], nx = b.st[1];
        if (nloc == 0u) { xcd_barrier_complete(bar, b.x, nloc, nx); b.st[0] = nloc; b.st[1] = nx; }
        const unsigned old = xb_add(&bar[XB_XSUB(b.x)], 1u);
        const unsigned gen = old / nloc;
        if (old + 1u == (gen + 1u) * nloc) {
            __builtin_amdgcn_fence(__ATOMIC_RELEASE, "agent");
            asm volatile("s_waitcnt vmcnt(0)" ::: "memory");
            const unsigned og = xb_add(&bar[XB_TOP], 1u);
            const unsigned tg = og / nx;
            if (og + 1u == (tg + 1u) * nx) xb_add(&bar[XB_TOPGEN], 1u);
            else XB_SPIN(xb_ld(&bar[XB_TOPGEN]) == tg, bar);
            __builtin_amdgcn_fence(__ATOMIC_ACQUIRE, "agent");
            xb_add(&bar[XB_XGEN(b.x)], 1u);
            asm volatile("s_waitcnt vmcnt(0)" ::: "memory");
        } else {
            XB_SPIN(xb_ld(&bar[XB_XGEN(b.x)]) == gen, bar);
            __builtin_amdgcn_fence(__ATOMIC_ACQUIRE, "agent");
            asm volatile("s_waitcnt vmcnt(0)" ::: "memory");
        }
    }
    __syncthreads();
}

struct Frame {
    LAS unsigned char* lds;
    int tid, lane, wave, vcu, G;
};
struct Args {
    const float* in[21]; float* out; unsigned char* ws; int pad0, pad1;
};

template <bool FP8 = false>
__device__ __forceinline__ void transpose_item(const float* W, int ldw, int k0, int n0, bf16_t* WT, int ldk, int drow0, LAS float* scr, int lane) {
    float tv[32];
    const float* wp_ = W + (size_t)(k0 + (lane >> 5)) * ldw + n0 + (lane & 31);
#pragma unroll
    for (int i = 0; i < 32; ++i) tv[i] = wp_[(size_t)(2 * i) * ldw];
#pragma unroll
    for (int i = 0; i < 32; ++i) scr[(2 * i + (lane >> 5)) * 33 + (lane & 31)] = tv[i];
    LDS_WAIT(); asm volatile("" ::: "memory");
    const int c = lane & 7;
#pragma unroll
    for (int j = 0; j < 4; ++j) { const int n = (lane >> 3) + 8 * j; const LAS float* s = scr + (8 * c) * 33 + n;
        if constexpr (FP8) { u32x2 o; o.x = cvt4_fp8(s[0 * 33] * W8_SCALE, s[1 * 33] * W8_SCALE, s[2 * 33] * W8_SCALE, s[3 * 33] * W8_SCALE); o.y = cvt4_fp8(s[4 * 33] * W8_SCALE, s[5 * 33] * W8_SCALE, s[6 * 33] * W8_SCALE, s[7 * 33] * W8_SCALE);
            *(u32x2*)((unsigned char*)WT + (size_t)(drow0 + n) * ldk + k0 + 8 * c) = o; }
        else { u32x4 o; o.x = cvt_pk_bf16(s[0 * 33], s[1 * 33]); o.y = cvt_pk_bf16(s[2 * 33], s[3 * 33]); o.z = cvt_pk_bf16(s[4 * 33], s[5 * 33]); o.w = cvt_pk_bf16(s[6 * 33], s[7 * 33]);
            *(u32x4*)(WT + (size_t)(drow0 + n) * ldk + k0 + 8 * c) = o; } }
    LDS_WAIT(); asm volatile("" ::: "memory");
}
template <bool FP8 = false>
__device__ __forceinline__ void conv_plain(Frame& F, const float* W, int K, int N, int ldw, bf16_t* WT, int rank = -1, int nrank = 0) {
    LAS float* scr = (LAS float*)(F.lds + F.wave * 16384);
    const int gw = (rank < 0 ? F.vcu : rank) * NWAVES + F.wave, NGW = (rank < 0 ? F.G : nrank) * NWAVES, nblk = N / 32, nit = (K / 64) * nblk;
    for (int it = gw; it < nit; it += NGW) { const int kb = it / nblk, nb = it % nblk; transpose_item<FP8>(W, ldw, 64 * kb, 32 * nb, WT, K, 32 * nb, scr, F.lane); }
}
__device__ __forceinline__ void conv_moe(Frame& F, const float* wg, const float* wu, const float* wd, bf16_t* GU, bf16_t* DT, int rank = -1, int nrank = 0) {
    LAS float* scr = (LAS float*)(F.lds + F.wave * 16384);
    const int gw = (rank < 0 ? F.vcu : rank) * NWAVES + F.wave, NGW = (rank < 0 ? F.G : nrank) * NWAVES;
    constexpr int PER_E = 1536, NIT = NEXP * PER_E;
    for (int it = gw; it < NIT; it += NGW) {
        const int e = it / PER_E; int r = it % PER_E;
        if (r < 1024) { const int up = r >> 9; r &= 511; const int kb = r >> 4, nb = r & 15, n0 = 32 * nb;
            const int drow = 256 * (n0 >> 7) + 128 * up + (n0 & 127);
            transpose_item<true>((up ? wu : wg) + (size_t)e * D * DFF, DFF, 64 * kb, n0, (bf16_t*)((unsigned char*)GU + (size_t)e * 1024 * D), D, drow, scr, F.lane); }
        else { r -= 1024; const int kb = r >> 6, nb = r & 63;
            transpose_item<true>(wd + (size_t)e * DFF * D, D, 64 * kb, 32 * nb, (bf16_t*)((unsigned char*)DT + (size_t)e * D * DFF), DFF, 32 * nb, scr, F.lane); }
    }
}
__device__ __forceinline__ void pack_proj(Frame& F, float* Wp, int NT, const float* gain, const float* Wa, int lda, int ca0, int na, const float* Wb, int ldb, int nb) {
    const int total = 128 * NT * 256;
    for (int idx = (F.vcu * NWAVES * 64) + F.tid; idx < total; idx += F.G * NWAVES * 64) {
        const int e = idx & 3, ln = (idx >> 2) & 63, rest = idx >> 8, nt = rest % NT, s = rest / NT;
        const int k = 16 * s + 4 * (ln >> 4) + e, col = 16 * nt + (ln & 15);
        float v = 0.f;
        if (col < na) v = Wa[(size_t)k * lda + ca0 + col]; else if (col < na + nb) v = Wb[(size_t)k * ldb + (col - na)];
        Wp[idx] = v * gain[k];
    }
}

template <int NT>
__device__ __forceinline__ float wave_proj16(LAS unsigned char* lds, const float* xin, int tok0, const float* Wp, int tid, int wid, int lane, f32x4 (&acc)[NT]) {
    const int tr = lane & 15, kq = lane >> 4;
    const f32x4* xp = (const f32x4*)(xin + (size_t)(tok0 + tr) * D) + kq;
    constexpr int CH = 16 * NT * 1024;
    const char* wsrc = (const char*)Wp + tid * 16;
    float ssq = 0.f;
#pragma unroll
    for (int n = 0; n < NT; ++n) acc[n] = (f32x4){0.f, 0.f, 0.f, 0.f};
    f32x4 X[16];
#define NP_DMA(c, buf) do { _Pragma("unroll") for (int r = 0; r < 2 * NT; ++r) \
        __builtin_amdgcn_global_load_lds((const unsigned*)(wsrc + (size_t)(c) * CH + r * 8192), (LAS unsigned*)(lds + (buf) * CH + r * 8192 + wid * 1024), 16, 0, 0); } while (0)
#define NP_CHUNK(c, buf, more) do { \
        asm volatile("s_waitcnt vmcnt(16)" ::: "memory"); WG_BAR(); \
        if (more) NP_DMA((c) + 1, 1 - (buf)); \
        asm volatile("" ::: "memory");     \
        const f32x4* xn_ = xp + 64 * ((c) + 1); \
        _Pragma("unroll") for (int s = 0; s < 16; ++s) { const f32x4 xv = X[s]; if (more) X[s] = xn_[4 * s]; \
            ssq += (xv[0] * xv[0] + xv[1] * xv[1]) + (xv[2] * xv[2] + xv[3] * xv[3]); \
            _Pragma("unroll") for (int n = 0; n < NT; ++n) { const f32x4 wv = *(const LAS f32x4*)(lds + (buf) * CH + ((s * NT + n) * 64 + lane) * 16); \
                _Pragma("unroll") for (int e = 0; e < 4; ++e) acc[n] = __builtin_amdgcn_mfma_f32_16x16x4f32(xv[e], wv[e], acc[n], 0, 0, 0); } } } while (0)
    NP_DMA(0, 0);
    asm volatile("" ::: "memory");
#pragma unroll
    for (int s = 0; s < 16; ++s) X[s] = xp[4 * s];
    for (int c = 0; c < 6; c += 2) { NP_CHUNK(c, 0, true); NP_CHUNK(c + 1, 1, true); }
    NP_CHUNK(6, 0, true); NP_CHUNK(7, 1, false);
    WG_BAR();
#undef NP_DMA
#undef NP_CHUNK
    ssq += __shfl_xor(ssq, 16); ssq += __shfl_xor(ssq, 32);
    return 1.0f / sqrtf(ssq * (1.0f / D) + RMS_EPS);
}
template <bool FP8 = false>
__device__ __forceinline__ void wave_write_hn16(const float* xin, int tok0, float rstd, const float* gain, bf16_t* hn, int lane) {
    f32x4 g4[8];
#pragma unroll
    for (int j = 0; j < 8; ++j) g4[j] = ((const f32x4*)gain)[lane + 64 * j];
    for (int i = 0; i < 16; i += 2) {
        const float r0 = __shfl(rstd, i), r1 = __shfl(rstd, i + 1);
        const f32x4* x0 = (const f32x4*)(xin + (size_t)(tok0 + i) * D); const f32x4* x1 = x0 + D / 4;
        u32x2* o0 = (u32x2*)(hn + (size_t)(tok0 + i) * D); u32x2* o1 = o0 + D / 4;
        unsigned* p0 = (unsigned*)((unsigned char*)hn + (size_t)(tok0 + i) * D); unsigned* p1 = p0 + D / 4;
        f32x4 a[8], c[8];
#pragma unroll
        for (int j = 0; j < 8; ++j) { a[j] = x0[lane + 64 * j]; c[j] = x1[lane + 64 * j]; }
#pragma unroll
        for (int j = 0; j < 8; ++j) { const f32x4 v = a[j] * r0 * g4[j], u = c[j] * r1 * g4[j];
            if constexpr (FP8) { p0[lane + 64 * j] = cvt4_fp8(v[0], v[1], v[2], v[3]); p1[lane + 64 * j] = cvt4_fp8(u[0], u[1], u[2], u[3]); }
            else { u32x2 w; w.x = cvt_pk_bf16(v[0], v[1]); w.y = cvt_pk_bf16(v[2], v[3]); o0[lane + 64 * j] = w;
                u32x2 z; z.x = cvt_pk_bf16(u[0], u[1]); z.y = cvt_pk_bf16(u[2], u[3]); o1[lane + 64 * j] = z; } }
    }
}

__device__ __forceinline__ void phase_norm_gz(Frame& F, const float* xin, const float* gain, const float* Wp, bf16_t* hn, float* gz) {
    for (int tile = F.vcu; tile < T / 128; tile += F.G) {
        const int tok0 = tile * 128 + F.wave * 16;
        f32x4 acc[1];
        const float rstd = wave_proj16<1>(F.lds, xin, tok0, Wp, F.tid, F.wave, F.lane, acc);
        const int j = F.lane & 15, q4 = F.lane >> 4;
#pragma unroll
        for (int r = 0; r < 4; ++r) { const float rr = __shfl(rstd, 4 * q4 + r); gz[(size_t)(tok0 + 4 * q4 + r) * 16 + j] = acc[0][r] * rr; }
        wave_write_hn16(xin, tok0, rstd, gain, hn, F.lane);
    }
}
__device__ __forceinline__ void phase_norm_route(Frame& F, const float* xin, const float* gain, const float* Wp, bf16_t* hn, int* tok_e, int* tok_p, float* tok_w, unsigned* cnt) {
    LAS float* lg = (LAS float*)(F.lds + 98304 + F.wave * 3072);
    for (int tile = F.vcu; tile < T / 128; tile += F.G) {
        const int tok0 = tile * 128 + F.wave * 16;
        f32x4 acc[3];
        const float rstd = wave_proj16<3>(F.lds, xin, tok0, Wp, F.tid, F.wave, F.lane, acc);
        const int j = F.lane & 15, q4 = F.lane >> 4;
#pragma unroll
        for (int r = 0; r < 4; ++r) { const float rr = __shfl(rstd, 4 * q4 + r);
#pragma unroll
            for (int n = 0; n < 3; ++n) lg[(4 * q4 + r) * 48 + 16 * n + j] = acc[n][r] * rr; }
        LDS_WAIT(); asm volatile("" ::: "memory");
        if (F.lane < 16) {
            const LAS float* l = lg + F.lane * 48;
            float gm = l[0]; int gi = 0;
#pragma unroll
            for (int q = 1; q < 4; ++q) { const float v = l[q]; if (v > gm) { gm = v; gi = q; } }
            float gs = 0.f;
#pragma unroll
            for (int q = 0; q < 4; ++q) gs += __expf(l[q] - gm);
            const float gw = 1.0f / gs;
            const LAS float* se = l + 4 + 8 * gi;
            float m1 = se[0]; int i1 = 0;
#pragma unroll
            for (int q = 1; q < 8; ++q) { const float v = se[q]; if (v > m1) { m1 = v; i1 = q; } }
            float m2 = -3.0e38f; int i2 = 0;
#pragma unroll
            for (int q = 0; q < 8; ++q) { const float v = se[q]; if (q != i1 && v > m2) { m2 = v; i2 = q; } }
            const float eb = __expf(m2 - m1), inv = 1.0f / (1.0f + eb);
            const int t = tok0 + F.lane, e1 = gi * 8 + i1, e2 = gi * 8 + i2;
            const unsigned p1 = __hip_atomic_fetch_add(cnt + 64 * e1, 1u, __ATOMIC_RELAXED, __HIP_MEMORY_SCOPE_AGENT);
            const unsigned p2 = __hip_atomic_fetch_add(cnt + 64 * e2, 1u, __ATOMIC_RELAXED, __HIP_MEMORY_SCOPE_AGENT);
            tok_e[2 * t] = e1; tok_e[2 * t + 1] = e2; tok_p[2 * t] = (int)p1; tok_p[2 * t + 1] = (int)p2;
            tok_w[2 * t] = gw * inv; tok_w[2 * t + 1] = gw * eb * inv;
        }
        wave_write_hn16<true>(xin, tok0, rstd, gain, hn, F.lane);
        LDS_WAIT(); asm volatile("" ::: "memory");
    }
}

__device__ __forceinline__ void phase_gla_gate(Frame& F, const float* gz, const float* wgu, const float* bgate, const bf16_t* proj, bf16_t* kdT, float* adec) {
    LAS f32x4* gzs = (LAS f32x4*)F.lds;
    for (int u = F.vcu; u < NBATCH * NCH * 2; u += F.G) {
        const int half = u & 1, bc = u >> 1;
        const int tok0 = bc * 64, j = half * 512 + F.tid;
        if (F.tid < 256) gzs[F.tid] = ((const f32x4*)(gz + (size_t)tok0 * 16))[F.tid];
        float wg[16];
#pragma unroll
        for (int r = 0; r < 16; ++r) wg[r] = wgu[r * GLA_DKT + j];
        const float bg = bgate[j];
        WG_BAR();
        float cum[64]; float run = 0.f;
#pragma unroll
        for (int t = 0; t < 64; ++t) {
            float z = bg;
#pragma unroll
            for (int r4 = 0; r4 < 4; ++r4) { const f32x4 g4 = gzs[t * 4 + r4]; z += g4[0] * wg[4 * r4] + g4[1] * wg[4 * r4 + 1] + g4[2] * wg[4 * r4 + 2] + g4[3] * wg[4 * r4 + 3]; }
            const float ls = fminf(z, 0.f) - __logf(1.0f + __expf(-fabsf(z)));
            run += ls * (1.0f / 16.0f); cum[t] = run;
        }
        adec[(size_t)bc * GLA_DKT + j] = __expf(run);
        const bf16_t* kp = proj + GK0 + gq_off(bc >> 8, (bc & 255) * 64, j >> 8) + (j & 255);
        u32x4* dst = (u32x4*)(kdT + ((size_t)bc * GLA_DKT + j) * 64);
#pragma unroll
        for (int t8 = 0; t8 < 8; ++t8) {
            float kd[8];
#pragma unroll
            for (int q = 0; q < 8; ++q) { const int t = t8 * 8 + q; kd[q] = bf2f(kp[(size_t)t * 256]) * __expf(run - cum[t]); }
            u32x4 w; w.x = cvt_pk_bf16(kd[0], kd[1]); w.y = cvt_pk_bf16(kd[2], kd[3]); w.z = cvt_pk_bf16(kd[4], kd[5]); w.w = cvt_pk_bf16(kd[6], kd[7]);
            dst[t8] = w;
        }
        WG_BAR();
    }
}

constexpr int SCAN_VROW = 144, SCAN_SROW = 528, SCAN_VBUF = 64 * SCAN_VROW, SCAN_SBUF = 64 * SCAN_SROW;
__device__ __forceinline__ void phase_gla_scan(Frame& F, int it, const bf16_t* proj, const bf16_t* kdT, const float* adec, bf16_t* oout, bf16_t* sfin) {
    const int lane = F.lane, w = F.wave, fr = lane & 15, kq = lane >> 4, tid = F.tid;
    LAS unsigned char* vbuf = F.lds;
    LAS unsigned char* sbuf = F.lds + 2 * SCAN_VBUF;
    const int bh = it >> 4, seg = (it >> 3) & 1, b = bh >> 2, h = bh & 3, sl = it & 7, mt = w & 3, ntp = w >> 2, c0 = seg * (NCH / 2);
    const size_t tokb = (size_t)b * SEQ;
    f32x4 st[2][4];
#pragma unroll
    for (int i = 0; i < 2; ++i)
#pragma unroll
        for (int n = 0; n < 4; ++n) st[i][n] = (f32x4){0.f, 0.f, 0.f, 0.f};
    bf16x8 ka0[2][2], ka1[2][2], q0[8], q1[8]; f32x4 dc0[2], dc1[2]; u32x4 vr0, vr1;
#define CL(c) ((c) < NCH ? (c) : NCH - 1)
#define LOAD_KA(KA, DC, c) do { const size_t bc_ = (size_t)b * NCH + CL(c); \
        _Pragma("unroll") for (int i = 0; i < 2; ++i) { \
            _Pragma("unroll") for (int s = 0; s < 2; ++s) KA[i][s] = *(const bf16x8*)(kdT + ((bc_ * GLA_DKT + h * 256 + 32 * w + 16 * i + fr) * 64 + 32 * s + 8 * kq)); \
            DC[i] = *(const f32x4*)(adec + bc_ * GLA_DKT + h * 256 + 32 * w + 16 * i + 4 * kq); } } while (0)
#define LOAD_V(VR, c) do { VR = *(const u32x4*)(proj + gv_off(b, CL(c) * 64 + (tid >> 3), h) + 64 * sl + 8 * (tid & 7)); } while (0)
#define LOAD_Q(Q, c) do { const bf16_t* qp_ = proj + gq_off(b, CL(c) * 64 + 16 * mt + fr, h) + 8 * kq; \
        _Pragma("unroll") for (int s = 0; s < 8; ++s) Q[s] = *(const bf16x8*)(qp_ + 32 * s); } while (0)
#define STORE_V(VR, buf) do { *(LAS u32x4*)(vbuf + (buf) * SCAN_VBUF + (tid >> 3) * SCAN_VROW + (tid & 7) * 16) = VR; } while (0)
#define SCAN_STEP(KA, DC, VN, VM, QC, QN, c) do { \
        const unsigned vb_ = (unsigned)(uintptr_t)(vbuf + ((c) & 1) * SCAN_VBUF) + (unsigned)((8 * kq + ((lane & 15) >> 2)) * SCAN_VROW + 8 * (lane & 3)); \
        s16x4 tv[4][4];     \
        asm volatile("ds_read_b64_tr_b16 %0, %16 offset:0\n\tds_read_b64_tr_b16 %1, %16 offset:576\n\tds_read_b64_tr_b16 %2, %16 offset:4608\n\tds_read_b64_tr_b16 %3, %16 offset:5184\n\t" \
                     "ds_read_b64_tr_b16 %4, %16 offset:32\n\tds_read_b64_tr_b16 %5, %16 offset:608\n\tds_read_b64_tr_b16 %6, %16 offset:4640\n\tds_read_b64_tr_b16 %7, %16 offset:5216\n\t" \
                     "ds_read_b64_tr_b16 %8, %16 offset:64\n\tds_read_b64_tr_b16 %9, %16 offset:640\n\tds_read_b64_tr_b16 %10, %16 offset:4672\n\tds_read_b64_tr_b16 %11, %16 offset:5248\n\t" \
                     "ds_read_b64_tr_b16 %12, %16 offset:96\n\tds_read_b64_tr_b16 %13, %16 offset:672\n\tds_read_b64_tr_b16 %14, %16 offset:4704\n\tds_read_b64_tr_b16 %15, %16 offset:5280\n\ts_waitcnt lgkmcnt(0)" \
                     : "=&v"(tv[0][0]), "=&v"(tv[0][1]), "=&v"(tv[0][2]), "=&v"(tv[0][3]), "=&v"(tv[1][0]), "=&v"(tv[1][1]), "=&v"(tv[1][2]), "=&v"(tv[1][3]), \
                       "=&v"(tv[2][0]), "=&v"(tv[2][1]), "=&v"(tv[2][2]), "=&v"(tv[2][3]), "=&v"(tv[3][0]), "=&v"(tv[3][1]), "=&v"(tv[3][2]), "=&v"(tv[3][3]) : "v"(vb_) : "memory"); \
        _Pragma("unroll") for (int n = 0; n < 4; ++n) { \
            const bf16x8 vf0 = (bf16x8){tv[n][0][0], tv[n][0][1], tv[n][0][2], tv[n][0][3], tv[n][1][0], tv[n][1][1], tv[n][1][2], tv[n][1][3]}; \
            const bf16x8 vf1 = (bf16x8){tv[n][2][0], tv[n][2][1], tv[n][2][2], tv[n][2][3], tv[n][3][0], tv[n][3][1], tv[n][3][2], tv[n][3][3]}; \
            _Pragma("unroll") for (int i = 0; i < 2; ++i) { \
                st[i][n] = st[i][n] * DC[i]; \
                st[i][n] = __builtin_amdgcn_mfma_f32_16x16x32_bf16(KA[i][0], vf0, st[i][n], 0, 0, 0); \
                st[i][n] = __builtin_amdgcn_mfma_f32_16x16x32_bf16(KA[i][1], vf1, st[i][n], 0, 0, 0); } } \
        LOAD_KA(KA, DC, (c) + 2); \
        { LAS unsigned char* sb_ = sbuf + ((c) & 1) * SCAN_SBUF + fr * SCAN_SROW + (32 * w + 4 * kq) * 2; \
          _Pragma("unroll") for (int i = 0; i < 2; ++i) _Pragma("unroll") for (int n = 0; n < 4; ++n) { \
              u32x2 pk; pk.x = cvt_pk_bf16(st[i][n][0], st[i][n][1]); pk.y = cvt_pk_bf16(st[i][n][2], st[i][n][3]); \
              *(LAS u32x2*)(sb_ + n * 16 * SCAN_SROW + i * 32) = pk; } } \
        STORE_V(VN, ((c) + 1) & 1); \
        LOAD_V(VN, (c) + 3); \
        WG_BAR(); \
        { f32x4 a0 = (f32x4){0.f, 0.f, 0.f, 0.f}, a1 = a0; \
          const LAS unsigned char* sr_ = sbuf + ((c) & 1) * SCAN_SBUF + (32 * ntp + fr) * SCAN_SROW + 16 * kq; \
          _Pragma("unroll") for (int hb = 0; hb < 2; ++hb) { bf16x8 bb[4][2];     \
              _Pragma("unroll") for (int s = 0; s < 4; ++s) { bb[s][0] = *(const LAS bf16x8*)(sr_ + 64 * (4 * hb + s)); bb[s][1] = *(const LAS bf16x8*)(sr_ + 16 * SCAN_SROW + 64 * (4 * hb + s)); } \
              asm volatile("s_waitcnt lgkmcnt(0)" ::: "memory"); __builtin_amdgcn_sched_barrier(0); \
              _Pragma("unroll") for (int s = 0; s < 4; ++s) { \
                  a0 = __builtin_amdgcn_mfma_f32_16x16x32_bf16(QC[4 * hb + s], bb[s][0], a0, 0, 0, 0); \
                  a1 = __builtin_amdgcn_mfma_f32_16x16x32_bf16(QC[4 * hb + s], bb[s][1], a1, 0, 0, 0); } } \
          bf16_t* op_ = oout + (tokb + (size_t)(c) * 64 + 16 * mt + 4 * kq) * D + h * 512 + 64 * sl + 32 * ntp + fr; \
          _Pragma("unroll") for (int r = 0; r < 4; ++r) { \
              const float x0 = a0[r] * 0.0625f, x1 = a1[r] * 0.0625f, y0 = __shfl_xor(x0, 1), y1 = __shfl_xor(x1, 1); \
              if ((fr & 1) == 0) { *(unsigned*)(op_ + (size_t)r * D) = cvt_pk_bf16(x0, y0); *(unsigned*)(op_ + (size_t)r * D + 16) = cvt_pk_bf16(x1, y1); } } } \
        LOAD_Q(QC, (c) + 2); \
    } while (0)
    LOAD_KA(ka0, dc0, c0); LOAD_KA(ka1, dc1, c0 + 1); LOAD_V(vr0, c0); LOAD_V(vr1, c0 + 1); LOAD_Q(q0, c0); LOAD_Q(q1, c0 + 1);
    STORE_V(vr0, 0); LOAD_V(vr0, c0 + 2);
    WG_BAR();
    for (int c = c0; c < c0 + NCH / 2; c += 2) {
        SCAN_STEP(ka0, dc0, vr1, vr0, q0, q1, c);
        SCAN_STEP(ka1, dc1, vr0, vr1, q1, q0, c + 1);
    }
    if (seg == 0) {
#pragma unroll
        for (int i = 0; i < 2; ++i)
#pragma unroll
            for (int n = 0; n < 4; ++n) { u32x2 pk; pk.x = cvt_pk_bf16(st[i][n][0], st[i][n][1]); pk.y = cvt_pk_bf16(st[i][n][2], st[i][n][3]);
                *(u32x2*)(sfin + ((size_t)(bh * 512 + 64 * sl + 16 * n + fr)) * 256 + 32 * w + 16 * i + 4 * kq) = pk; }
    }
    WG_BAR();
#undef CL
#undef LOAD_KA
#undef LOAD_V
#undef LOAD_Q
#undef STORE_V
#undef SCAN_STEP
}

__device__ __forceinline__ void gla_pcum(Frame& F, const float* adec, float* pcum, int rank, int nrank) {
    for (int idx = rank * (NWAVES * 64) + F.tid; idx < NBATCH * GLA_DKT; idx += nrank * NWAVES * 64) { const int b = idx >> 10, j = idx & 1023;
        const float* ap = adec + ((size_t)(b * NCH + NCH / 2)) * GLA_DKT + j; float* pp = pcum + (size_t)(b * (NCH / 2)) * GLA_DKT + j; float pr = 1.f;
#pragma unroll 16
        for (int cc = 0; cc < NCH / 2; ++cc) { pr *= ap[(size_t)cc * GLA_DKT]; pp[(size_t)cc * GLA_DKT] = pr; } }
}
__device__ __forceinline__ void phase_gla_qp(Frame& F, const bf16_t* proj, const float* pcum, bf16_t* qp) {
    const int gw = F.vcu * NWAVES + F.wave, NGW = F.G * NWAVES, lane = F.lane;
    for (int r = gw; r < NBATCH * (SEQ / 2); r += NGW) { const int b = r >> 13, t = r & 8191;
        u32x2 qv[4]; f32x4 pv[4];
#pragma unroll
        for (int h = 0; h < 4; ++h) { qv[h] = *(const u32x2*)(proj + gq_off(b, SEQ / 2 + t, h) + 4 * lane); pv[h] = *(const f32x4*)(pcum + ((size_t)(b * (NCH / 2) + (t >> 6)) * GLA_DKT + h * 256 + 4 * lane)); }
#pragma unroll
        for (int h = 0; h < 4; ++h) { u32x2 w; w.x = cvt_pk_bf16(bf_lo(qv[h].x) * pv[h][0], bf_hi(qv[h].x) * pv[h][1]); w.y = cvt_pk_bf16(bf_lo(qv[h].y) * pv[h][2], bf_hi(qv[h].y) * pv[h][3]);
            *(u32x2*)(qp + ((size_t)((b * 4 + h) * (SEQ / 2) + t)) * 256 + 4 * lane) = w; }
    }
}
__device__ __forceinline__ void phase_gla_gnorm(Frame& F, const bf16_t* o, const bf16_t* proj, const float* gn, bf16_t* y) {
    const int gw = F.vcu * NWAVES + F.wave, NGW = F.G * NWAVES, lane = F.lane;
    const f32x4 g0 = ((const f32x4*)gn)[2 * lane], g1 = ((const f32x4*)gn)[2 * lane + 1];
    for (int tok = gw; tok < T; tok += NGW) {
        u32x4 ov[4], rv[4];
#pragma unroll
        for (int h = 0; h < 4; ++h) { ov[h] = *(const u32x4*)(o + (size_t)tok * D + h * 512 + 8 * lane); rv[h] = *(const u32x4*)(proj + GR0 + (size_t)tok * 2048 + h * 512 + 8 * lane); }
        float ss[4];
#pragma unroll
        for (int h = 0; h < 4; ++h) { float s = 0.f;
#pragma unroll
            for (int q = 0; q < 4; ++q) { const float lo = bf_lo(ov[h][q]), hi = bf_hi(ov[h][q]); s += lo * lo + hi * hi; }
            ss[h] = s; }
#pragma unroll
        for (int of = 1; of < 64; of <<= 1) {
#pragma unroll
            for (int h = 0; h < 4; ++h) ss[h] += __shfl_xor(ss[h], of); }
#pragma unroll
        for (int h = 0; h < 4; ++h) { const float rstd = 1.0f / sqrtf(ss[h] * (1.0f / 512.0f) + RMS_EPS);
            float yv[8];
#pragma unroll
            for (int q = 0; q < 4; ++q) { const float a0 = bf_lo(ov[h][q]), a1 = bf_hi(ov[h][q]), r0 = bf_lo(rv[h][q]), r1 = bf_hi(rv[h][q]);
                const float gA = q < 2 ? g0[2 * q] : g1[2 * q - 4], gB = q < 2 ? g0[2 * q + 1] : g1[2 * q - 3];
                yv[2 * q] = a0 * rstd * gA * (r0 / (1.0f + __expf(-r0))); yv[2 * q + 1] = a1 * rstd * gB * (r1 / (1.0f + __expf(-r1))); }
            u32x4 w; w.x = cvt_pk_bf16(yv[0], yv[1]); w.y = cvt_pk_bf16(yv[2], yv[3]); w.z = cvt_pk_bf16(yv[4], yv[5]); w.w = cvt_pk_bf16(yv[6], yv[7]);
            *(u32x4*)(y + (size_t)tok * D + h * 512 + 8 * lane) = w; }
    }
}

__device__ __forceinline__ void moe_tables(Frame& F, unsigned* cnt) {
    LAS int* pst = (LAS int*)(F.lds + TAB_OFF);
    LAS int* te = pst + 36;
    if (F.wave == 0) {
        const int e = F.lane & 31;
        const int c = (int)xb_ld(cnt + 64 * e);
        const int ntile = (c + 255) >> 8;
        int incl = ntile;
#pragma unroll
        for (int o = 1; o < 32; o <<= 1) { const int v = __shfl_up(incl, o); if ((F.lane & 31) >= o) incl += v; }
        const int excl = incl - ntile;
        if (F.lane < 32) { pst[e] = excl << 8; for (int q = 0; q < ntile; ++q) te[excl + q] = e; }
        if (F.lane == 31) { pst[32] = incl << 8; pst[33] = incl; }
    }
    WG_BAR();
}
__device__ __forceinline__ void phase_moe_slots(Frame& F, const int* tok_e, const int* tok_p, unsigned* cnt, int* slot_of, int* slot_tok) {
    const LAS int* pst = (const LAS int*)(F.lds + TAB_OFF);
    for (int e = F.vcu; e < NEXP; e += F.G) { const int c = (int)xb_ld(cnt + 64 * e), lo = pst[e] + c, hi = pst[e] + (((c + 255) >> 8) << 8);
        for (int s = lo + F.tid; s < hi; s += NWAVES * 64) slot_tok[s] = -1; }
    for (int a = F.vcu * NWAVES * 64 + F.tid; a < 2 * T; a += F.G * NWAVES * 64) { const int slot = pst[tok_e[a]] + tok_p[a]; slot_of[a] = slot; slot_tok[slot] = a >> 1; }
}
__device__ __forceinline__ void phase_moe_copy8(Frame& F, const int* tok_e, const int* tok_p, const unsigned char* hn8, unsigned char* ag8) {
    const LAS int* pst = (const LAS int*)(F.lds + TAB_OFF);
    const int gw = F.vcu * NWAVES + F.wave, NGW = F.G * NWAVES, lane = F.lane;
    for (int t = gw; t < T; t += NGW) {
        const int s0 = pst[tok_e[2 * t]] + tok_p[2 * t], s1 = pst[tok_e[2 * t + 1]] + tok_p[2 * t + 1];
        const u32x4* src = (const u32x4*)(hn8 + (size_t)t * D); const u32x4 v0 = src[lane], v1 = src[lane + 64];
        u32x4* d0 = (u32x4*)(ag8 + (size_t)s0 * D); u32x4* d1 = (u32x4*)(ag8 + (size_t)s1 * D);
        d0[lane] = v0; d0[lane + 64] = v1; d1[lane] = v0; d1[lane + 64] = v1;
    }
}
template <int MODE>
__device__ __forceinline__ void phase_moe_combine(Frame& F, float* x, const bf16_t* ob, const int* slot_of, const float* tok_w, const float* gain, bf16_t* hn) {
    const int gw = F.vcu * NWAVES + F.wave, NGW = F.G * NWAVES, lane = F.lane;
    f32x4 g4[8];
#pragma unroll
    for (int j = 0; j < 8; ++j) g4[j] = ((const f32x4*)gain)[lane + 64 * j];
    for (int t = gw; t < T; t += NGW) {
        const int s0 = slot_of[2 * t], s1 = slot_of[2 * t + 1]; const float w0 = tok_w[2 * t], w1 = tok_w[2 * t + 1];
        f32x4* xr = (f32x4*)(x + (size_t)t * D);
        const u32x2* a = (const u32x2*)(ob + (size_t)s0 * D); const u32x2* b = (const u32x2*)(ob + (size_t)s1 * D);
        f32x4 v[8]; float ss = 0.f;
#pragma unroll
        for (int j = 0; j < 8; ++j) { const u32x2 av = a[lane + 64 * j], bv = b[lane + 64 * j]; f32x4 xv = xr[lane + 64 * j];
            xv[0] += w0 * bf_lo(av.x) + w1 * bf_lo(bv.x); xv[1] += w0 * bf_hi(av.x) + w1 * bf_hi(bv.x);
            xv[2] += w0 * bf_lo(av.y) + w1 * bf_lo(bv.y); xv[3] += w0 * bf_hi(av.y) + w1 * bf_hi(bv.y);
            v[j] = xv; ss += (xv[0] * xv[0] + xv[1] * xv[1]) + (xv[2] * xv[2] + xv[3] * xv[3]); }
        const float rstd = 1.0f / sqrtf(wave_sum(ss) * (1.0f / D) + RMS_EPS);
        if (MODE == 0) {
            unsigned* orow = (unsigned*)((unsigned char*)hn + (size_t)t * D);
#pragma unroll
            for (int j = 0; j < 8; ++j) { xr[lane + 64 * j] = v[j]; const f32x4 y = v[j] * rstd * g4[j]; orow[lane + 64 * j] = cvt4_fp8(y[0], y[1], y[2], y[3]); }
        } else {
#pragma unroll
            for (int j = 0; j < 8; ++j) xr[lane + 64 * j] = v[j] * rstd * g4[j];
        }
    }
}

__device__ __forceinline__ void phase_subln(Frame& F, const bf16_t* o1, const bf16_t* o2, const float* lq1, const float* lk1, const float* lq2, const float* lk2, const float* sg, bf16_t* y) {
    const int gw = F.vcu * NWAVES + F.wave, NGW = F.G * NWAVES, lane = F.lane;
    const float d1 = wave_sum(lq1[lane] * lk1[lane] + lq1[lane + 64] * lk1[lane + 64]);
    const float d2 = wave_sum(lq2[lane] * lk2[lane] + lq2[lane + 64] * lk2[lane + 64]);
    const float lam = __expf(d1) - __expf(d2) + LAMBDA_INIT;
    const f32x4 g = ((const f32x4*)sg)[lane] * (1.0f - LAMBDA_INIT);
    for (int tok = gw; tok < T; tok += NGW) {
        u32x2 a[8], b[8];
#pragma unroll
        for (int h = 0; h < 8; ++h) { a[h] = *(const u32x2*)(o1 + (size_t)tok * D + h * 256 + 4 * lane); b[h] = *(const u32x2*)(o2 + (size_t)tok * D + h * 256 + 4 * lane); }
        f32x4 d[8]; float ss[8];
#pragma unroll
        for (int h = 0; h < 8; ++h) { d[h][0] = bf_lo(a[h].x) - lam * bf_lo(b[h].x); d[h][1] = bf_hi(a[h].x) - lam * bf_hi(b[h].x); d[h][2] = bf_lo(a[h].y) - lam * bf_lo(b[h].y); d[h][3] = bf_hi(a[h].y) - lam * bf_hi(b[h].y);
            ss[h] = (d[h][0] * d[h][0] + d[h][1] * d[h][1]) + (d[h][2] * d[h][2] + d[h][3] * d[h][3]); }
#pragma unroll
        for (int of = 1; of < 64; of <<= 1) {
#pragma unroll
            for (int h = 0; h < 8; ++h) ss[h] += __shfl_xor(ss[h], of); }
#pragma unroll
        for (int h = 0; h < 8; ++h) { const float rstd = 1.0f / sqrtf(ss[h] * (1.0f / 256.0f) + RMS_EPS); const f32x4 yv = d[h] * rstd * g;
            *(unsigned*)((unsigned char*)y + (size_t)tok * D + h * 256 + 4 * lane) = cvt4_fp8(yv[0], yv[1], yv[2], yv[3]); }
    }
}

namespace att {
constexpr int SHM_K = 64 * 128, SHM_V = 256 * 64;
constexpr int V_OFF = 0, K_OFF = 3 * SHM_V, SCR_OFF = RING_BYTES + 4096;
constexpr float SCALE = 0.08838834764831845f;
constexpr float C2 = 1.4426950408889634f * SCALE;
constexpr float THR = 8.f;
__device__ __forceinline__ int crow(int r, int hi) { return (r & 3) + 8 * (r >> 2) + 4 * hi; }

__device__ __forceinline__ void qkt(f32x16& p0, f32x16& p1, const LAS unsigned char* kslot, int r32, int hi, const v8i32 (&qf)[2]) {
#pragma unroll
    for (int s = 0; s < 2; ++s) { const int c0 = 4 * s + 2 * hi, sw = r32 & 7;
        const LAS unsigned char* ra = kslot + r32 * 128;
        const v4i32 a0 = *(const LAS v4i32*)(ra + ((c0 ^ sw) << 4)), a1 = *(const LAS v4i32*)(ra + (((c0 + 1) ^ sw) << 4));
        const v4i32 b0 = *(const LAS v4i32*)(ra + 32 * 128 + ((c0 ^ sw) << 4)), b1 = *(const LAS v4i32*)(ra + 32 * 128 + (((c0 + 1) ^ sw) << 4));
        const v8i32 ka = __builtin_shufflevector(a0, a1, 0, 1, 2, 3, 4, 5, 6, 7), kb = __builtin_shufflevector(b0, b1, 0, 1, 2, 3, 4, 5, 6, 7);
        p0 = __builtin_amdgcn_mfma_scale_f32_32x32x64_f8f6f4(ka, qf[s], p0, 0, 0, 0, 0x7f7f7f7f, 0, 0x7f7f7f7f);
        p1 = __builtin_amdgcn_mfma_scale_f32_32x32x64_f8f6f4(kb, qf[s], p1, 0, 0, 0, 0x7f7f7f7f, 0, 0x7f7f7f7f); }
}
__device__ __forceinline__ void pv_tile(f32x16 (&o)[8], const LAS unsigned char* va, const v8i32& pa, int scl) {
    const LAS unsigned char* vb = (const LAS unsigned char*)((unsigned)(uintptr_t)va ^ 16u);
#define PV_RD(S, d0) do { S[0] = *(const LAS v4i32*)(va + (d0) * 2048); S[1] = *(const LAS v4i32*)(vb + (d0) * 2048); } while (0)
#define PV_MM(S, d0) do { __builtin_amdgcn_sched_barrier(0); \
        o[d0] = __builtin_amdgcn_mfma_scale_f32_32x32x64_f8f6f4(pa, __builtin_shufflevector(S[0], S[1], 0, 1, 2, 3, 4, 5, 6, 7), o[d0], 0, 0, 0, scl, 0, 0x7f7f7f7f); __builtin_amdgcn_sched_barrier(0); } while (0)
    v4i32 f0[2], f1[2], f2[2];
    PV_RD(f0, 0); PV_RD(f1, 1);
    PV_RD(f2, 2); PV_MM(f0, 0); PV_RD(f0, 3); PV_MM(f1, 1); PV_RD(f1, 4); PV_MM(f2, 2); PV_RD(f2, 5); PV_MM(f0, 3); PV_RD(f0, 6); PV_MM(f1, 4); PV_RD(f1, 7); PV_MM(f2, 5);
    PV_MM(f0, 6); PV_MM(f1, 7);
#undef PV_MM
#undef PV_RD
}

__device__ __forceinline__ void stage_offsets(int tid, unsigned& koff, unsigned (&voff)[2]) {
    { const int P = tid * 16, row = P >> 7, ch = ((P & 127) >> 4) ^ (row & 7); koff = (unsigned)(row * 128 + ch * 16); }
#pragma unroll
    for (int i = 0; i < 2; ++i) { const int P = tid * 16 + i * 8192, row = P >> 6, ch = ((P & 63) >> 4) ^ ((row >> 2) & 3); voff[i] = (unsigned)(row * 64 + ch * 16); }
}
__device__ __forceinline__ const char* uniform_ptr(const void* p) {
    const unsigned long long v = (unsigned long long)p;
    const unsigned lo = __builtin_amdgcn_readfirstlane((unsigned)v), hi = __builtin_amdgcn_readfirstlane((unsigned)(v >> 32));
    return (const char*)(((unsigned long long)hi << 32) | lo);
}
__device__ __forceinline__ void stage_tile(LAS unsigned char* lds, int kslot, int vslot, const bf16_t* kj_, const bf16_t* vj_, int tid_, int wid) {
    const char* kj = uniform_ptr(kj_); const char* vj = uniform_ptr(vj_);
    int tid = tid_; asm volatile("" : "+v"(tid));
    unsigned koff, voff[2]; stage_offsets(tid, koff, voff);
    LAS unsigned char* kd = lds + K_OFF + kslot * SHM_K + wid * 1024; LAS unsigned char* vd = lds + V_OFF + vslot * SHM_V + wid * 1024;
    __builtin_amdgcn_global_load_lds((const unsigned*)(kj + koff), (LAS unsigned*)kd, 16, 0, 0);
#pragma unroll
    for (int i = 0; i < 2; ++i) __builtin_amdgcn_global_load_lds((const unsigned*)(vj + voff[i]), (LAS unsigned*)(vd + i * 8192), 16, 0, 0);
}

__device__ __forceinline__ void qk_softmax(const LAS unsigned char* kslot, int r32, int hi, LAS float* al_l, const v8i32 (&qf)[2], f32x16 (&o)[8], v8i32& pa, int& pscl,
                                           float& m_reg, float& l_reg, float rawu, float sl2, bool diag, int qi) {
    f32x16 p0, p1;
#pragma unroll
    for (int r = 0; r < 16; ++r) { p0[r] = 0.f; p1[r] = 0.f; }
    qkt(p0, p1, kslot, r32, hi, qf);
#pragma unroll
    for (int r = 0; r < 16; ++r) { const float cr = (float)((r & 3) + 8 * (r >> 2)); p0[r] = fmaf(cr, rawu, p0[r]); p1[r] = fmaf(cr, rawu, p1[r]); }
    if (diag) {
        const float k2raw = 2.f * rawu;
        int qi_ = qi - 4 * hi; asm volatile("" : "+v"(qi_));
#pragma unroll
        for (int r = 0; r < 16; ++r) { const int c = (r & 3) + 8 * (r >> 2); const int d0_ = c - qi_, d1_ = c + 32 - qi_;
            p0[r] -= k2raw * (float)(d0_ > 0 ? d0_ : 0); p1[r] -= k2raw * (float)(d1_ > 0 ? d1_ : 0); }
    }
    const float lane_raw = rawu * (float)(4 * hi), d32raw = 32.f * rawu;
    float pm0 = p0[0], pm1 = p1[0];
#pragma unroll
    for (int r = 1; r < 16; ++r) { pm0 = fmaxf(pm0, p0[r]); pm1 = fmaxf(pm1, p1[r]); }
    float pmax = fmaxf(pm0, pm1 + d32raw) + lane_raw;
    { auto rr = __builtin_amdgcn_permlane32_swap(__float_as_uint(pmax), __float_as_uint(pmax), false, false);
      pmax = fmaxf(__uint_as_float(rr[0]), __uint_as_float(rr[1])); }
    float mn, alpha;
    if (__all((pmax - m_reg) * SCALE <= THR)) { mn = m_reg; alpha = 1.f; }
    else { mn = fmaxf(m_reg, pmax); alpha = __builtin_amdgcn_exp2f((m_reg - mn) * C2); m_reg = mn; }
    const float ef = fminf(floorf(8.75f - (pmax - mn) * C2), 60.f);
    pscl = 127 - (int)ef;
    const float mnL0 = (lane_raw - mn) * C2 + ef, mnL1 = mnL0 + 32.f * sl2;
#pragma unroll
    for (int r = 0; r < 16; ++r) { p0[r] = __builtin_amdgcn_exp2f(fmaf(p0[r], C2, mnL0)); p1[r] = __builtin_amdgcn_exp2f(fmaf(p1[r], C2, mnL1)); }
    if (__any(alpha < 1.f)) {
        if (hi == 0) al_l[r32] = alpha;
        LDS_WAIT();
#pragma unroll
        for (int r = 0; r < 16; ++r) { const float a = al_l[crow(r, hi)];
#pragma unroll
            for (int d = 0; d < 8; ++d) o[d][r] *= a; }
    }
    float ps = 0.f;
#pragma unroll
    for (int r = 0; r < 16; ++r) ps += p0[r] + p1[r];
    { auto rr = __builtin_amdgcn_permlane32_swap(__float_as_uint(ps), __float_as_uint(ps), false, false);
      ps = __uint_as_float(rr[0]) + __uint_as_float(rr[1]); }
    l_reg = l_reg * alpha + ps * __builtin_amdgcn_exp2f(-ef);
#pragma unroll
    for (int g = 0; g < 4; ++g) { pa[g] = (int)cvt4_fp8(p0[4 * g], p0[4 * g + 1], p0[4 * g + 2], p0[4 * g + 3]); pa[4 + g] = (int)cvt4_fp8(p1[4 * g], p1[4 * g + 1], p1[4 * g + 2], p1[4 * g + 3]); }
}

__device__ __forceinline__ void norms_phase(Frame& F, const bf16_t* proj, float* nrm) {
    const int gw = F.vcu * NWAVES + F.wave, NGW = F.G * NWAVES, lane = F.lane;
    for (int idx = gw; idx < 2 * 32 * 256; idx += NGW) {
        const int tensor = idx >> 13, stream = (idx >> 8) & 31, grp = idx & 255;
        const u32x4* rp = (const u32x4*)((const unsigned char*)proj + (tensor ? DK0 : 0) + ((size_t)stream * SEQ + grp * 64 + lane) * 128);
        float ss = 0.f;
#pragma unroll
        for (int q = 0; q < 8; ++q) { const u32x4 v = rp[q];
#pragma unroll
            for (int e = 0; e < 4; ++e) { const float a0 = __builtin_amdgcn_cvt_f32_fp8((int)v[e], 0), a1 = __builtin_amdgcn_cvt_f32_fp8((int)v[e], 1), a2 = __builtin_amdgcn_cvt_f32_fp8((int)v[e], 2), a3 = __builtin_amdgcn_cvt_f32_fp8((int)v[e], 3);
                ss += (a0 * a0 + a1 * a1) + (a2 * a2 + a3 * a3); } }
        float n = sqrtf(ss) * 1.001f;
#pragma unroll
        for (int o = 1; o < 64; o <<= 1) n = fmaxf(n, __shfl_xor(n, o));
        if (lane == 0) nrm[idx] = n;
    }
}

__device__ __forceinline__ void attn_item(LAS unsigned char* lds, const bf16_t* proj, const float* nrm, bf16_t* oout, int b, int h, int sub, int qb, int tid, int wid, int lane) {
    const int r32 = lane & 31, hi = lane >> 5;
    const float slope = __builtin_amdgcn_exp2f(-(float)(h + 1));
    const float sl2 = slope * 1.4426950408889634f, rawu = sl2 / C2;
    LAS float* ws = (LAS float*)(lds + SCR_OFF) + wid * 64; LAS float* li_l = ws; LAS float* al_l = ws + 32;
    const size_t tokq = (size_t)b * SEQ + (size_t)qb * 256 + wid * 32;
    const bf16_t* kbase = (const bf16_t*)((const unsigned char*)proj + DK0 + dq_off(b, 0, h, sub));
    const bf16_t* vbase = (const bf16_t*)((const unsigned char*)proj + pg8::vt_off(b, h, 0));
    int j_lo;
    { const int stream = (b * 8 + h) * 2 + sub; const float* qn = nrm + stream * 256; const float* kn = nrm + 8192 + stream * 256;
      const float Qn = fmaxf(fmaxf(qn[4 * qb], qn[4 * qb + 1]), fmaxf(qn[4 * qb + 2], qn[4 * qb + 3]));
      const float Kd = fmaxf(fmaxf(kn[4 * qb], kn[4 * qb + 1]), fmaxf(kn[4 * qb + 2], kn[4 * qb + 3]));
      int cand = 4 * qb;
      for (int jj = lane; jj < 4 * qb; jj += 64) { const float dmin = (float)(256 * qb - (64 * jj + 63)); const bool skip = slope * dmin > 110.f + SCALE * Qn * (kn[jj] + Kd); if (!skip) cand = cand < jj ? cand : jj; }
#pragma unroll
      for (int o = 1; o < 64; o <<= 1) { const int v = __shfl_xor(cand, o); cand = v < cand ? v : cand; }
      j_lo = __builtin_amdgcn_readfirstlane(cand); }
    v8i32 qf[2];
    { const unsigned char* qrow = (const unsigned char*)proj + dq_off(b, qb * 256 + wid * 32 + r32, h, sub) + 32 * hi;
#pragma unroll
      for (int s = 0; s < 2; ++s) { const v4i32 x0 = *(const v4i32*)(qrow + 64 * s), x1 = *(const v4i32*)(qrow + 64 * s + 16); qf[s] = __builtin_shufflevector(x0, x1, 0, 1, 2, 3, 4, 5, 6, 7); } }
    const float sh64 = 64.f * rawu;
    const int qi = 32 * (wid & 1) + r32;
    const LAS unsigned char* vb0 = lds + V_OFF + r32 * 64 + (((2 * hi) ^ ((r32 >> 2) & 3)) << 4);
    float m_reg = -1e30f, l_reg = 0.f;
    f32x16 o[8];
#pragma unroll
    for (int d = 0; d < 8; ++d)
#pragma unroll
        for (int r = 0; r < 16; ++r) o[d][r] = 0.f;
    const int NT = 4 * qb + 4, myNT = 4 * qb + (wid >> 1) + 1;
    constexpr size_t KSTEP = 64 * 128 / 2, VSTEP = 256 * 64 / 2;
    const bool late = wid >= 4;
    stage_tile(lds, j_lo & 1, j_lo % 3, kbase + (size_t)j_lo * KSTEP, vbase + (size_t)j_lo * VSTEP, tid, wid);
    VM_WAIT(); WG_BAR();
    if (!late) {
        int vs = j_lo % 3;
        for (int j = j_lo; j < NT; ++j) {
            const int vsn = vs == 2 ? 0 : vs + 1;
            if (j + 1 < NT) stage_tile(lds, (j + 1) & 1, vsn, kbase + (size_t)(j + 1) * KSTEP, vbase + (size_t)(j + 1) * VSTEP, tid, wid);
            if (j < myNT) { if (j > j_lo) m_reg -= sh64;
                v8i32 pa; int pscl;
                qk_softmax(lds + K_OFF + (j & 1) * SHM_K, r32, hi, al_l, qf, o, pa, pscl, m_reg, l_reg, rawu, sl2, j == myNT - 1, qi);
                pv_tile(o, vb0 + vs * SHM_V, pa, pscl); }
            VM_WAIT(); WG_BAR();
            vs = vsn;
        }
    } else {
        v8i32 pa; int pscl = 127;
#pragma unroll
        for (int g = 0; g < 8; ++g) pa[g] = 0;
        int vs = j_lo % 3, vsp = vs;
        for (int j = j_lo; j < NT; ++j) {
            const int vsn = vs == 2 ? 0 : vs + 1;
            if (j + 1 < NT) stage_tile(lds, (j + 1) & 1, vsn, kbase + (size_t)(j + 1) * KSTEP, vbase + (size_t)(j + 1) * VSTEP, tid, wid);
            if (j > j_lo && j - 1 < myNT) pv_tile(o, vb0 + vsp * SHM_V, pa, pscl);
            if (j < myNT) { if (j > j_lo) m_reg -= sh64;
                qk_softmax(lds + K_OFF + (j & 1) * SHM_K, r32, hi, al_l, qf, o, pa, pscl, m_reg, l_reg, rawu, sl2, j == myNT - 1, qi); }
            VM_WAIT(); WG_BAR();
            vsp = vs; vs = vsn;
        }
        if (myNT == NT) pv_tile(o, vb0 + vsp * SHM_V, pa, pscl);
    }
    if (hi == 0) li_l[r32] = l_reg;
    LDS_WAIT();
    char* Ow = (char*)(oout + tokq * D + h * 256);
    const unsigned lofs = (unsigned)(hi * 4 * D + r32) * 2u;
#pragma unroll
    for (int r = 0; r < 16; ++r) { const float rl = __builtin_amdgcn_rcpf(li_l[crow(r, hi)]);
#pragma unroll
        for (int d0 = 0; d0 < 8; ++d0) { const float v = o[d0][r] * rl; const float vn = __shfl_xor(v, 1);
            if ((r32 & 1) == 0) *(unsigned*)(Ow + (lofs + (unsigned)((((r & 3) + 8 * (r >> 2)) * D + d0 * 32) * 2))) = cvt_pk_bf16(v, vn); } }
    WG_BAR();
}

struct TailConv { const float* wg; const float* wu; const float* wd; bf16_t* gu; bf16_t* dt; };
__device__ __forceinline__ void attn_phase(Frame& F, const bf16_t* proj, const float* nrm, unsigned* queue, bf16_t* o1, bf16_t* o2, const TailConv tc) {
    LAS int* qw = (LAS int*)(F.lds + SCR_OFF + 8 * 256);
    for (;;) {
        if (F.tid == 0) *qw = (int)__hip_atomic_fetch_add(queue, 1u, __ATOMIC_RELAXED, __HIP_MEMORY_SCOPE_AGENT);
        WG_BAR();
        const int I = __builtin_amdgcn_readfirstlane(*qw);
        if (I >= 2048 + 512) break;
        if (I >= 2048) { conv_moe(F, tc.wg, tc.wu, tc.wd, tc.gu, tc.dt, I - 2048, 512); WG_BAR(); continue; }
        const int qb = 63 - (I >> 5), r = I & 31, h = 7 - (r >> 2), b = (r >> 1) & 1, sub = r & 1;
        attn_item(F.lds, proj, nrm, sub ? o2 : o1, b, h, sub, qb, F.tid, F.wave, F.lane);
    }
}
}

__device__ __forceinline__ const void* karg(int i) { int j = i; asm volatile("" : "+s"(j)); return ((const void* const __attribute__((address_space(4)))*)__builtin_amdgcn_kernarg_segment_ptr())[j]; }
__global__ void __launch_bounds__(NWAVES * 64, 2) hybrid_fwd(Args args) {
    extern __shared__ __attribute__((aligned(16))) unsigned char lds_raw[];
    Frame F;
    F.lds = (LAS unsigned char*)lds_raw;
    F.tid = threadIdx.x; F.lane = F.tid & 63; F.wave = __builtin_amdgcn_readfirstlane(F.tid >> 6);
    F.G = gridDim.x; { const int bx = blockIdx.x; F.vcu = (F.G % 8 == 0) ? (bx % 8) * (F.G / 8) + bx / 8 : bx; }
#define ws ((unsigned char*)karg(22))
#define ctl ((unsigned*)(ws + WS_CTL))
    for (int u = F.tid; u < (LDS_BYTES - LDSCTL_OFF) / 4; u += NWAVES * 64) ((LAS unsigned*)(F.lds + LDSCTL_OFF))[u] = 0u;
    __syncthreads();
    ((LAS int*)(F.lds + TIDS_OFF))[F.tid] = F.tid;
    __syncthreads();
    volatile LAS unsigned* MISC = (volatile LAS unsigned*)(F.lds + MISC_OFF);
    XcdBarrier bar = xcd_barrier_post(ctl + CW_BAR, MISC + 8);
#define GRID_BAR() do { XcdBarrier bb_ = bar; unsigned x_ = bar.x; unsigned long long bp_ = (unsigned long long)bar.bar; asm volatile("" : "+s"(x_), "+s"(bp_)); bb_.x = x_; bb_.bar = (unsigned*)bp_; xcd_barrier(bb_, TID_RELOAD() == 0); } while (0)
#define TID_RELOAD() (F.wave * 64 + lane_id_volatile())
#ifdef ONLY_PHASE
#define PHON(n) ((n) == ONLY_PHASE)
#else
#define PHON(n) 1
#endif

#define x_in ((const float*)(karg(0)))
#define norm_mix ((const float*)(karg(1)))
#define norm_ffn ((const float*)(karg(2)))
#define gla_w_in ((const float*)(karg(3)))
#define gla_wgu ((const float*)(karg(4)))
#define gla_bg ((const float*)(karg(5)))
#define gla_norm ((const float*)(karg(6)))
#define gla_w_out ((const float*)(karg(7)))
#define diff_w_in ((const float*)(karg(8)))
#define lq1 ((const float*)(karg(9)))
#define lk1 ((const float*)(karg(10)))
#define lq2 ((const float*)(karg(11)))
#define lk2 ((const float*)(karg(12)))
#define diff_subln ((const float*)(karg(13)))
#define diff_w_out ((const float*)(karg(14)))
#define moe_wgrp ((const float*)(karg(15)))
#define moe_wexp ((const float*)(karg(16)))
#define moe_wg ((const float*)(karg(17)))
#define moe_wu ((const float*)(karg(18)))
#define moe_wd ((const float*)(karg(19)))
#define final_norm ((const float*)(karg(20)))
#define xres ((float*)(karg(21)))
#define gz ((float*)((float*)(ws + WS_GZ)))
#define tok_e ((int*)((int*)(ws + WS_TOKE)))
#define tok_p ((int*)((int*)(ws + WS_TOKP)))
#define tok_w ((float*)((float*)(ws + WS_TOKW)))
#define slot_of ((int*)((int*)(ws + WS_SLOT)))
#define slot_tok ((int*)(ws + WS_STOK))
#define adec ((float*)((float*)(ws + WS_ADEC)))
#define pcum ((float*)((float*)(ws + WS_PCUM)))
#define sfin ((bf16_t*)((bf16_t*)(ws + WS_SFIN)))
#define wp_gz ((float*)((float*)(ws + WS_WPGZ)))
#define wp_r0 ((float*)((float*)(ws + WS_WPR0)))
#define wp_r1 ((float*)((float*)(ws + WS_WPR1)))
#define wgi ((bf16_t*)((bf16_t*)(ws + WS_WGI)))
#define wgo ((bf16_t*)((bf16_t*)(ws + WS_WGO)))
#define wdi ((bf16_t*)((bf16_t*)(ws + WS_WDI)))
#define wdo ((bf16_t*)((bf16_t*)(ws + WS_WDO)))
#define wmoe_gu ((bf16_t*)((bf16_t*)(ws + WS_WMOE)))
#define wmoe_d ((bf16_t*)((bf16_t*)(ws + WS_WMOE_D)))
#define hn ((bf16_t*)((bf16_t*)(ws + WS_HN)))
#define proj ((bf16_t*)((bf16_t*)(ws + WS_PROJ)))
#define buf1 ((bf16_t*)((bf16_t*)(ws + WS_BUF1)))
#define buf2 ((bf16_t*)((bf16_t*)(ws + WS_BUF2)))
#define ag ((bf16_t*)((bf16_t*)(ws + WS_AG)))
#define ob ((bf16_t*)((bf16_t*)(ws + WS_OB)))
#define hh ((bf16_t*)((bf16_t*)(ws + WS_H)))
    const LAS int* pst = (const LAS int*)(F.lds + TAB_OFF);

    _Pragma("unroll") for (int rep_ = 0; rep_ < (REP_PHASE == 0 ? 2 : 1); ++rep_) if (PHON(0)) { if (rep_) GRID_BAR(); Frame P = F; P.tid = TID_RELOAD(); P.lane = P.tid & 63;
    conv_plain(P, gla_w_in, D, PROJW, GLA_INW, wgi);
    conv_plain(P, gla_w_out, D, D, D, wgo);
    pack_proj(P, wp_gz, 1, norm_mix, gla_w_in, GLA_INW, PROJW, 16, nullptr, 0, 0);
    pack_proj(P, wp_r0, 3, norm_ffn, moe_wgrp, 4, 0, 4, moe_wexp, 32, 32);
    pack_proj(P, wp_r1, 3, norm_ffn + D, moe_wgrp + (size_t)D * 4, 4, 0, 4, moe_wexp + (size_t)D * 32, 32, 32);
    }
    GRID_BAR();
    _Pragma("unroll") for (int rep_ = 0; rep_ < (REP_PHASE == 1 ? 2 : 1); ++rep_) if (PHON(1)) { if (rep_) GRID_BAR(); Frame P = F; P.tid = TID_RELOAD(); P.lane = P.tid & 63;
    phase_norm_gz(P, x_in, norm_mix, wp_gz, hn, gz);
    }
    GRID_BAR();
    _Pragma("unroll") for (int rep_ = 0; rep_ < (REP_PHASE == 2 ? 2 : 1); ++rep_) if (PHON(2)) { if (rep_) GRID_BAR(); Frame P = F; P.tid = TID_RELOAD(); P.lane = P.tid & 63;
    { pg8::Gemm g{hn, wgi, T, PROJW, D}; pg8::StaticOrder S; S.init(T, PROJW, P.G, (int)blockIdx.x); pg8::EpiHeads<0> E{proj};
      pg8::gemm_phase<pg8::EpiHeads<0>, pg8::StaticOrder>(P.lds, g, S, E, P.tid); }
    }
    GRID_BAR();
    _Pragma("unroll") for (int rep_ = 0; rep_ < (REP_PHASE == 3 ? 2 : 1); ++rep_) if (PHON(3)) { if (rep_) GRID_BAR(); Frame P = F; P.tid = TID_RELOAD(); P.lane = P.tid & 63;
    phase_gla_gate(P, gz, gla_wgu, gla_bg, proj, buf1, adec);
    }
    GRID_BAR();
    _Pragma("unroll") for (int rep_ = 0; rep_ < (REP_PHASE == 4 ? 2 : 1); ++rep_) if (PHON(4)) { if (rep_) GRID_BAR(); Frame P = F; P.tid = TID_RELOAD(); P.lane = P.tid & 63;
    if (P.G == 256) { if ((P.vcu & 1) == 0) phase_gla_scan(P, P.vcu >> 1, proj, buf1, adec, buf2, sfin); else { gla_pcum(P, adec, pcum, P.vcu >> 1, 128); conv_moe(P, moe_wg, moe_wu, moe_wd, wmoe_gu, wmoe_d, P.vcu >> 1, 128);
            conv_plain<true>(P, diff_w_in, D, PROJW, PROJW, wdi, P.vcu >> 1, 128); conv_plain<true>(P, diff_w_out, D, D, D, wdo, P.vcu >> 1, 128); } }
    else { for (int it = P.vcu; it < 128; it += P.G) phase_gla_scan(P, it, proj, buf1, adec, buf2, sfin); gla_pcum(P, adec, pcum, P.vcu, P.G); conv_moe(P, moe_wg, moe_wu, moe_wd, wmoe_gu, wmoe_d); conv_plain<true>(P, diff_w_in, D, PROJW, PROJW, wdi); conv_plain<true>(P, diff_w_out, D, D, D, wdo); }
    GRID_BAR();
    phase_gla_qp(P, proj, pcum, hn);
    GRID_BAR();
    { pg8::Gemm g{hn, sfin, 8 * (SEQ / 2), 512, 256}; pg8::FixOrder S; S.init(8 * (SEQ / 2), 512, P.G, (int)blockIdx.x); pg8::EpiAddO E{buf2};
      pg8::gemm_phase<pg8::EpiAddO, pg8::FixOrder>(P.lds, g, S, E, P.tid); }
    }
    GRID_BAR();
    _Pragma("unroll") for (int rep_ = 0; rep_ < (REP_PHASE == 5 ? 2 : 1); ++rep_) if (PHON(5)) { if (rep_) GRID_BAR(); Frame P = F; P.tid = TID_RELOAD(); P.lane = P.tid & 63;
    phase_gla_gnorm(P, buf2, proj, gla_norm, hn);
    }
    GRID_BAR();
    _Pragma("unroll") for (int rep_ = 0; rep_ < (REP_PHASE == 6 ? 2 : 1); ++rep_) if (PHON(6)) { if (rep_) GRID_BAR(); Frame P = F; P.tid = TID_RELOAD(); P.lane = P.tid & 63;
    { pg8::Gemm g{hn, wgo, T, D, D}; pg8::StaticOrder S; S.init(T, D, P.G, (int)blockIdx.x); pg8::EpiResF32 E{x_in, xres, D};
      pg8::gemm_phase<pg8::EpiResF32, pg8::StaticOrder>(P.lds, g, S, E, P.tid); }
    }
    GRID_BAR();
    _Pragma("unroll") for (int rep_ = 0; rep_ < (REP_PHASE == 7 ? 2 : 1); ++rep_) if (PHON(7)) { if (rep_) GRID_BAR(); Frame P = F; P.tid = TID_RELOAD(); P.lane = P.tid & 63;
    phase_norm_route(P, xres, norm_ffn, wp_r0, hn, tok_e, tok_p, tok_w, ctl + CW_CNT0);
    }
    GRID_BAR();
    _Pragma("unroll") for (int rep_ = 0; rep_ < (REP_PHASE == 8 ? 2 : 1); ++rep_) if (PHON(8)) { if (rep_) GRID_BAR(); Frame P = F; P.tid = TID_RELOAD(); P.lane = P.tid & 63;
    moe_tables(P, ctl + CW_CNT0);
    phase_moe_slots(P, tok_e, tok_p, ctl + CW_CNT0, slot_of, slot_tok);
    }
    GRID_BAR();
    _Pragma("unroll") for (int rep_ = 0; rep_ < (REP_PHASE == 9 ? 2 : 1); ++rep_) if (PHON(9)) { if (rep_) GRID_BAR(); Frame P = F; P.tid = TID_RELOAD(); P.lane = P.tid & 63;
    { const int Mr = pst[33] * 256; pg8::Gemm g{hn, wmoe_gu, Mr, 1024, D}; pg8::MoeOrder S; S.init(Mr, 1024, P.G, (int)blockIdx.x); S.te = pst + 36; S.estride = (size_t)1024 * D; S.stok = slot_tok; pg8::EpiSiluMul E{(unsigned char*)hh};
      pg8::gemm_phase<pg8::EpiSiluMul, pg8::MoeOrder, true, true>(P.lds, g, S, E, P.tid); }
    }
    GRID_BAR();
    _Pragma("unroll") for (int rep_ = 0; rep_ < (REP_PHASE == 10 ? 2 : 1); ++rep_) if (PHON(10)) { if (rep_) GRID_BAR(); Frame P = F; P.tid = TID_RELOAD(); P.lane = P.tid & 63;
    { const int Mr = pst[33] * 256; pg8::Gemm g{hh, wmoe_d, Mr, D, DFF}; pg8::MoeOrder S; S.init(Mr, D, P.G, (int)blockIdx.x); S.te = pst + 36; S.estride = (size_t)D * DFF; S.stok = slot_tok; pg8::EpiBf16 E{ob, D};
      pg8::gemm_phase<pg8::EpiBf16, pg8::MoeOrder, false, true>(P.lds, g, S, E, P.tid); }
    }
    GRID_BAR();
    _Pragma("unroll") for (int rep_ = 0; rep_ < (REP_PHASE == 11 ? 2 : 1); ++rep_) if (PHON(11)) { if (rep_) GRID_BAR(); Frame P = F; P.tid = TID_RELOAD(); P.lane = P.tid & 63;
    phase_moe_combine<0>(P, xres, ob, slot_of, tok_w, norm_mix + D, hn);
    }
    GRID_BAR();
    _Pragma("unroll") for (int rep_ = 0; rep_ < (REP_PHASE == 12 ? 2 : 1); ++rep_) if (PHON(12)) { if (rep_) GRID_BAR(); Frame P = F; P.tid = TID_RELOAD(); P.lane = P.tid & 63;
    { pg8::Gemm g{hn, wdi, T, 4096, D}; pg8::StaticOrder S; S.init(T, 4096, P.G, (int)blockIdx.x); pg8::EpiHeads<1> E{proj};
      pg8::gemm_phase<pg8::EpiHeads<1>, pg8::StaticOrder, false, true>(P.lds, g, S, E, P.tid); }
    { pg8::Gemm g{hn, (const bf16_t*)((const unsigned char*)wdi + (size_t)4096 * D), T, 2048, D}; pg8::StaticOrder S; S.init(T, 2048, P.G, (int)blockIdx.x); pg8::EpiVT E{(unsigned char*)proj};
      pg8::gemm_phase<pg8::EpiVT, pg8::StaticOrder, false, true, true>(P.lds, g, S, E, P.tid); }
    GRID_BAR();
    att::norms_phase(P, proj, (float*)(ws + WS_NRM));
    }
    GRID_BAR();
    _Pragma("unroll") for (int rep_ = 0; rep_ < (REP_PHASE == 13 ? 2 : 1); ++rep_) if (PHON(13)) { if (rep_) GRID_BAR(); Frame P = F; P.tid = TID_RELOAD(); P.lane = P.tid & 63;
    att::attn_phase(P, proj, (const float*)(ws + WS_NRM), ctl + CW_QUEUE, buf1, buf2, att::TailConv{moe_wg + (size_t)NEXP * D * DFF, moe_wu + (size_t)NEXP * D * DFF, moe_wd + (size_t)NEXP * DFF * D, (bf16_t*)(ws + WS_WMOE1), (bf16_t*)(ws + WS_WMOE1_D)});
    }
    GRID_BAR();
    _Pragma("unroll") for (int rep_ = 0; rep_ < (REP_PHASE == 14 ? 2 : 1); ++rep_) if (PHON(14)) { if (rep_) GRID_BAR(); Frame P = F; P.tid = TID_RELOAD(); P.lane = P.tid & 63;
    phase_subln(P, buf1, buf2, lq1, lk1, lq2, lk2, diff_subln, hn);
    }
    GRID_BAR();
    _Pragma("unroll") for (int rep_ = 0; rep_ < (REP_PHASE == 15 ? 2 : 1); ++rep_) if (PHON(15)) { if (rep_) GRID_BAR(); Frame P = F; P.tid = TID_RELOAD(); P.lane = P.tid & 63;
    { pg8::Gemm g{hn, wdo, T, D, D}; pg8::StaticOrder S; S.init(T, D, P.G, (int)blockIdx.x); pg8::EpiResF32 E{xres, xres, D};
      pg8::gemm_phase<pg8::EpiResF32, pg8::StaticOrder, false, true>(P.lds, g, S, E, P.tid); }
    }
    GRID_BAR();
    _Pragma("unroll") for (int rep_ = 0; rep_ < (REP_PHASE == 16 ? 2 : 1); ++rep_) if (PHON(16)) { if (rep_) GRID_BAR(); Frame P = F; P.tid = TID_RELOAD(); P.lane = P.tid & 63;
    phase_norm_route(P, xres, norm_ffn + D, wp_r1, hn, tok_e, tok_p, tok_w, ctl + CW_CNT1);
    }
    GRID_BAR();
    _Pragma("unroll") for (int rep_ = 0; rep_ < (REP_PHASE == 17 ? 2 : 1); ++rep_) if (PHON(17)) { if (rep_) GRID_BAR(); Frame P = F; P.tid = TID_RELOAD(); P.lane = P.tid & 63;
    moe_tables(P, ctl + CW_CNT1);
    phase_moe_slots(P, tok_e, tok_p, ctl + CW_CNT1, slot_of, slot_tok);
    }
    GRID_BAR();
    _Pragma("unroll") for (int rep_ = 0; rep_ < (REP_PHASE == 18 ? 2 : 1); ++rep_) if (PHON(18)) { if (rep_) GRID_BAR(); Frame P = F; P.tid = TID_RELOAD(); P.lane = P.tid & 63;
    { const int Mr = pst[33] * 256; pg8::Gemm g{hn, (bf16_t*)(ws + WS_WMOE1), Mr, 1024, D}; pg8::MoeOrder S; S.init(Mr, 1024, P.G, (int)blockIdx.x); S.te = pst + 36; S.estride = (size_t)1024 * D; S.stok = slot_tok; pg8::EpiSiluMul E{(unsigned char*)hh};
      pg8::gemm_phase<pg8::EpiSiluMul, pg8::MoeOrder, true, true>(P.lds, g, S, E, P.tid); }
    }
    GRID_BAR();
    _Pragma("unroll") for (int rep_ = 0; rep_ < (REP_PHASE == 19 ? 2 : 1); ++rep_) if (PHON(19)) { if (rep_) GRID_BAR(); Frame P = F; P.tid = TID_RELOAD(); P.lane = P.tid & 63;
    { const int Mr = pst[33] * 256; pg8::Gemm g{hh, (bf16_t*)(ws + WS_WMOE1_D), Mr, D, DFF}; pg8::MoeOrder S; S.init(Mr, D, P.G, (int)blockIdx.x); S.te = pst + 36; S.estride = (size_t)D * DFF; S.stok = slot_tok; pg8::EpiBf16 E{ob, D};
      pg8::gemm_phase<pg8::EpiBf16, pg8::MoeOrder, false, true>(P.lds, g, S, E, P.tid); }
    }
    GRID_BAR();
    _Pragma("unroll") for (int rep_ = 0; rep_ < (REP_PHASE == 20 ? 2 : 1); ++rep_) if (PHON(20)) { if (rep_) GRID_BAR(); Frame P = F; P.tid = TID_RELOAD(); P.lane = P.tid & 63;
    phase_moe_combine<1>(P, xres, ob, slot_of, tok_w, final_norm, hn);
    }
}

#undef x_in
#undef norm_mix
#undef norm_ffn
#undef gla_w_in
#undef gla_wgu
#undef gla_bg
#undef gla_norm
#undef gla_w_out
#undef diff_w_in
#undef lq1
#undef lk1
#undef lq2
#undef lk2
#undef diff_subln
#undef diff_w_out
#undef moe_wgrp
#undef moe_wexp
#undef moe_wg
#undef moe_wu
#undef moe_wd
#undef final_norm
#undef xres
#undef gz
#undef tok_e
#undef tok_p
#undef tok_w
#undef slot_of
#undef slot_tok
#undef ws
#undef ctl
#undef adec
#undef pcum
#undef sfin
#undef wp_gz
#undef wp_r0
#undef wp_r1
#undef wgi
#undef wgo
#undef wdi
#undef wdo
#undef wmoe_gu
#undef wmoe_d
#undef hn
#undef proj
#undef buf1
#undef buf2
#undef ag
#undef ob
#undef hh

extern "C" void kernel_launch(void* const* d_in, const int* in_sizes, int n_in, void* d_out, int out_size, void* d_ws, size_t ws_size, hipStream_t stream) {
    static int grid = 0;
    if (grid == 0) {
        if (n_in != 21 || out_size != T * D || ws_size < WS_END) { fprintf(stderr, "kernel_launch: unexpected shapes (n_in %d out %d ws %zu)\n", n_in, out_size, ws_size); grid = -1; return; }
        if (hipFuncSetAttribute((const void*)hybrid_fwd, hipFuncAttributeMaxDynamicSharedMemorySize, LDS_BYTES) != hipSuccess) { fprintf(stderr, "kernel_launch: hipFuncSetAttribute failed\n"); grid = -1; return; }
        int dev = 0, cus = 0, per_cu = 0;
        (void)hipGetDevice(&dev); (void)hipDeviceGetAttribute(&cus, hipDeviceAttributeMultiprocessorCount, dev);
        if (hipOccupancyMaxActiveBlocksPerMultiprocessor(&per_cu, (const void*)hybrid_fwd, NWAVES * 64, LDS_BYTES) != hipSuccess || per_cu < 1) fprintf(stderr, "kernel_launch: occupancy query says %d\n", per_cu);
        (void)hipGetLastError();
        grid = cus > 0 ? cus : 256;
    }
    if (grid < 0) return;
    Args a{};
    for (int i = 0; i < 21; ++i) a.in[i] = (const float*)d_in[i];
    a.out = (float*)d_out; a.ws = (unsigned char*)d_ws; a.pad0 = 0; a.pad1 = 0;
    (void)hipMemsetAsync((char*)d_ws + WS_CTL, 0, CTL_ZERO_BYTES, stream);
    hipLaunchKernelGGL(hybrid_fwd, dim3(grid), dim3(NWAVES * 64), LDS_BYTES, stream, a);
}
```

```cpp
#ifndef REP_PHASE
#define REP_PHASE -1
#endif
#include <hip/hip_runtime.h>
#include <cstdio>
#include <cstdint>

#define LAS __attribute__((address_space(3)))
#define GAS __attribute__((address_space(1)))
typedef unsigned short bf16_t;
typedef short bf16x8 __attribute__((ext_vector_type(8)));
typedef short s16x4 __attribute__((ext_vector_type(4)));
typedef float f32x4 __attribute__((ext_vector_type(4)));
typedef float f32x2 __attribute__((ext_vector_type(2)));
typedef float f32x16 __attribute__((ext_vector_type(16)));
typedef unsigned u32x4 __attribute__((ext_vector_type(4)));
typedef unsigned u32x2 __attribute__((ext_vector_type(2)));
typedef int v8i32 __attribute__((ext_vector_type(8)));
typedef int v4i32 __attribute__((ext_vector_type(4)));

constexpr int D = 2048, SEQ = 16384, NBATCH = 2, T = NBATCH * SEQ, CHUNK = 64, NCH = SEQ / CHUNK;
constexpr int GLA_H = 4, GLA_DK = 256, GLA_DV = 512, GLA_DKT = 1024, GLA_INW = 6160, PROJW = 6144;
constexpr int DIFF_H = 8;
constexpr int NEXP = 32, DFF = 512;
constexpr float RMS_EPS = 1e-6f;
constexpr float LAMBDA_INIT = 0.35550906759f;
constexpr int MAX_TILES = 288;

constexpr size_t MiB = 1u << 20;
constexpr size_t WS_CTL = 0, CTL_ZERO_BYTES = 1 * MiB;
constexpr size_t WS_GZ = 2 * MiB;
constexpr size_t WS_TOKE = 4 * MiB;
constexpr size_t WS_TOKP = WS_TOKE + 256 * 1024;
constexpr size_t WS_TOKW = WS_TOKP + 256 * 1024;
constexpr size_t WS_SLOT = WS_TOKW + 256 * 1024;
constexpr size_t WS_STOK = 5 * MiB;
constexpr size_t WS_ADEC = 8 * MiB;
constexpr size_t WS_WPGZ = 10 * MiB;
constexpr size_t WS_WPR0 = 10 * MiB + 256 * 1024;
constexpr size_t WS_WPR1 = 11 * MiB;
constexpr size_t WS_NRM = 12 * MiB;
constexpr size_t WS_PCUM = 13 * MiB;
constexpr size_t WS_SFIN = 14 * MiB;
constexpr size_t WS_WGI = 16 * MiB, WS_WGO = 40 * MiB, WS_WDI = 48 * MiB, WS_WDO = 72 * MiB;
constexpr size_t WS_WMOE = 80 * MiB;
constexpr size_t WS_WMOE_D = WS_WMOE + 128 * MiB;
constexpr size_t WS_WMOE1 = WS_WMOE + 64 * MiB, WS_WMOE1_D = WS_WMOE + 160 * MiB;
constexpr size_t WS_HN = 272 * MiB;
constexpr size_t WS_PROJ = 400 * MiB;
constexpr size_t WS_BUF1 = 784 * MiB;
constexpr size_t WS_BUF2 = 912 * MiB;
constexpr size_t WS_AG = 400 * MiB;
constexpr size_t WS_OB = 688 * MiB;
constexpr size_t WS_H = 976 * MiB;
constexpr size_t WS_END = 1048 * MiB;
constexpr int CW_BAR = 4096;
constexpr int CW_QUEUE = 8192;
constexpr int CW_CNT0 = 16384, CW_CNT1 = 16384 + 32 * 64;


constexpr size_t GK0 = (size_t)T * 1024, GV0 = (size_t)T * 2048, GR0 = (size_t)T * 4096;
constexpr size_t DK0 = (size_t)T * 2048, DV0 = (size_t)T * 4096;
__host__ __device__ __forceinline__ size_t gq_off(int b, int t, int h) { return ((size_t)(b * 4 + h) * SEQ + t) * 256; }
__host__ __device__ __forceinline__ size_t gv_off(int b, int t, int h) { return GV0 + ((size_t)(b * 4 + h) * SEQ + t) * 512; }
__host__ __device__ __forceinline__ size_t dq_off(int b, int t, int h, int sub) { return ((size_t)((b * 8 + h) * 2 + sub) * SEQ + t) * 128; }
__host__ __device__ __forceinline__ size_t dv_off(int b, int t, int h) { return DV0 + ((size_t)(b * 8 + h) * SEQ + t) * 256; }

constexpr int RING_BYTES = 131072;
constexpr int LDSCTL_OFF = RING_BYTES;
constexpr int MISC_OFF = LDSCTL_OFF + 320;
constexpr int TIDS_OFF = LDSCTL_OFF + 8192;
constexpr int TAB_OFF = LDSCTL_OFF + 1024;
constexpr int LDS_BYTES = 147456;
constexpr int NWAVES = 8;

typedef __bf16 bf16x2_t __attribute__((ext_vector_type(2)));
__device__ __forceinline__ unsigned cvt_pk_bf16(float lo, float hi) { const f32x2 v = {lo, hi}; return __builtin_bit_cast(unsigned, __builtin_convertvector(v, bf16x2_t)); }
__device__ __forceinline__ unsigned cvt4_fp8(float a, float b, float c, float d) { int v = __builtin_amdgcn_cvt_pk_fp8_f32(a, b, 0, false); return (unsigned)__builtin_amdgcn_cvt_pk_fp8_f32(c, d, v, true); }
constexpr float W8_SCALE = 64.f;
__device__ __forceinline__ float bf_lo(unsigned w) { return __uint_as_float(w << 16); }
__device__ __forceinline__ float bf_hi(unsigned w) { return __uint_as_float(w & 0xffff0000u); }
__device__ __forceinline__ float bf2f(bf16_t b) { return __uint_as_float(((unsigned)b) << 16); }
__device__ __forceinline__ float wave_sum(float v) {
#pragma unroll
    for (int o = 1; o < 64; o <<= 1) v += __shfl_xor(v, o);
    return v;
}
__device__ __forceinline__ int lane_id() { return (int)__builtin_amdgcn_mbcnt_hi(~0u, __builtin_amdgcn_mbcnt_lo(~0u, 0u)); }
__device__ __forceinline__ int lane_id_volatile() { int l; asm volatile("v_mbcnt_lo_u32_b32 %0, -1, 0\n\tv_mbcnt_hi_u32_b32 %0, -1, %0" : "=v"(l)); return l; }
__device__ __forceinline__ int opq(int v) { asm volatile("" : "+v"(v)); return v; }
#define LDS_WAIT() asm volatile("s_waitcnt lgkmcnt(0)" ::: "memory")
#define VM_WAIT() asm volatile("s_waitcnt vmcnt(0)" ::: "memory")
#define SYNCTHREADS() do { __builtin_amdgcn_fence(__ATOMIC_RELEASE, "workgroup"); __builtin_amdgcn_s_barrier(); __builtin_amdgcn_fence(__ATOMIC_ACQUIRE, "workgroup"); } while (0)
#define WG_BAR() do { asm volatile("s_waitcnt lgkmcnt(0)" ::: "memory"); __builtin_amdgcn_s_barrier(); asm volatile("" ::: "memory"); } while (0)

namespace pg8 {
constexpr int BM = 256, BK = 64, HALF = 128, HTB = HALF * BK * 2, STAGE_BYTES = 8 * HTB, NXCD = 8, WGM = 8;
__host__ __device__ __forceinline__ int lds_byte(int r, int c) { const int st = (r >> 4) * 2 + (c >> 5), rr = r & 15, cc = c & 31, ob = rr * 64 + cc * 2; return st * 1024 + (ob ^ (((ob >> 9) & 1) << 5)); }
__host__ __device__ __forceinline__ void stage_rc(int b, int& R, int& C) { const int st = b / 1024, sb = b % 1024, swz = sb ^ (((sb >> 9) & 1) << 5); R = (st >> 1) * 16 + swz / 64; C = (st & 1) * 32 + (swz % 64) / 2; }
__host__ __device__ __forceinline__ int perm32(int rho) { const int n = rho >> 4, i = rho & 15; return 8 * (i >> 2) + 4 * n + (i & 3); }

struct Unit { int pm, pn; };
struct Gemm { const bf16_t* A; const bf16_t* Bt; int M, N, K; };

struct StaticOrder {
    int nM, nN, nwg, G, c;
    __device__ __forceinline__ void init(int M, int N, int G_, int c_) { nM = M / BM; nN = N / BM; nwg = nM * nN; G = G_; c = c_; }
    __device__ __forceinline__ bool next(int i, Unit& u) const {
        const long L = (long)i * G + c; if (L >= nwg) return false;
        int wgid = (int)L; { const int q = nwg / NXCD, r = nwg % NXCD, xcd = wgid % NXCD, off = wgid / NXCD; wgid = (xcd < r ? xcd * (q + 1) : r * (q + 1) + (xcd - r) * q) + off; }
        const int nig = WGM * nN, gid = wgid / nig, fm = gid * WGM, gsz = (nM - fm) < WGM ? (nM - fm) : WGM;
        u.pm = fm + ((wgid % nig) % gsz); u.pn = (wgid % nig) / gsz; return true;
    }
    __device__ __forceinline__ size_t bofs(const Unit&) const { return 0; }
};
struct MoeOrder : StaticOrder {
    const LAS int* te; size_t estride; const int* stok;
    __device__ __forceinline__ size_t bofs(const Unit& u) const { return (size_t)te[u.pm] * estride; }
    __device__ __forceinline__ int arow(int pm, int r) const { const int t = stok[pm * BM + r]; return t < 0 ? 0 : t; }
};

struct EpiBf16 {
    static constexpr bool PERM = true;
    bf16_t* O; int ldc;
    __device__ __forceinline__ void operator()(const f32x4 (&acc)[2][2][4][2], const Unit& u, int wr, int wc, int fr, int fq) const {
        const int row0 = u.pm * BM + wr * 64 + fr, col0 = u.pn * BM + wc * 32 + 8 * fq;
#pragma unroll
        for (int ai = 0; ai < 2; ++ai)
#pragma unroll
            for (int m = 0; m < 4; ++m) { bf16_t* rowp = O + (size_t)(row0 + ai * HALF + m * 16) * ldc + col0;
#pragma unroll
                for (int bj = 0; bj < 2; ++bj) { const f32x4 v0 = acc[ai][bj][m][0], v1 = acc[ai][bj][m][1];
                    u32x4 w; w.x = cvt_pk_bf16(v0[0], v0[1]); w.y = cvt_pk_bf16(v0[2], v0[3]); w.z = cvt_pk_bf16(v1[0], v1[1]); w.w = cvt_pk_bf16(v1[2], v1[3]);
                    *(u32x4*)(rowp + bj * HALF) = w; } }
    }
};
template <int LAYER> struct EpiHeads {
    static constexpr bool PERM = true;
    bf16_t* O;
    __device__ __forceinline__ void operator()(const f32x4 (&acc)[2][2][4][2], const Unit& u, int wr, int wc, int fr, int fq) const {
        const int pn = u.pn, lc = wc * 32 + 8 * fq;
#pragma unroll
        for (int ai = 0; ai < 2; ++ai)
#pragma unroll
            for (int m = 0; m < 4; ++m) { const int row = u.pm * BM + ai * HALF + wr * 64 + m * 16 + fr, b = row >> 14, t = row & (SEQ - 1);
#pragma unroll
                for (int bj = 0; bj < 2; ++bj) { size_t off;
                    if (LAYER == 0) { if (pn < 4) off = gq_off(b, t, pn) + bj * 128 + lc; else if (pn < 8) off = GK0 + gq_off(b, t, pn - 4) + bj * 128 + lc;
                                      else if (pn < 16) off = gv_off(b, t, (pn - 8) >> 1) + ((pn - 8) & 1) * 256 + bj * 128 + lc; else off = GR0 + (size_t)row * 2048 + (pn - 16) * 256 + bj * 128 + lc; }
                    else { if (pn < 8) off = dq_off(b, t, pn, bj) + lc; else if (pn < 16) off = DK0 + dq_off(b, t, pn - 8, bj) + lc; else off = dv_off(b, t, pn - 16) + bj * 128 + lc; }
                    const f32x4 v0 = acc[ai][bj][m][0], v1 = acc[ai][bj][m][1];
                    if (LAYER == 1 && pn < 16) {
                        u32x2 w8; w8.x = cvt4_fp8(v0[0], v0[1], v0[2], v0[3]); w8.y = cvt4_fp8(v1[0], v1[1], v1[2], v1[3]); *(u32x2*)((unsigned char*)O + off) = w8; continue; }
                    u32x4 w; w.x = cvt_pk_bf16(v0[0], v0[1]); w.y = cvt_pk_bf16(v0[2], v0[3]); w.z = cvt_pk_bf16(v1[0], v1[1]); w.w = cvt_pk_bf16(v1[2], v1[3]);
                    *(u32x4*)(O + off) = w; } }
    }
};
__host__ __device__ __forceinline__ size_t vt_off(int b, int h, int chunk) { return DV0 * 2 + ((size_t)((b * 8 + h) * (SEQ / 64) + chunk)) * 16384; }
struct EpiVT {
    static constexpr bool PERM = false;
    unsigned char* O;
    __device__ __forceinline__ void operator()(const f32x4 (&acc)[2][2][4][2], const Unit& u, int wr, int wc, int fr, int fq) const {
#pragma unroll
        for (int ai = 0; ai < 2; ++ai) { const int row0 = u.pm * BM + ai * HALF + wr * 64;
            unsigned char* tp = O + vt_off(row0 >> 14, u.pn, (row0 & (SEQ - 1)) >> 6) + (size_t)(wc * 32 + fr) * 64 + 32 * (fq & 1) + 4 * (fq >> 1);
#pragma unroll
            for (int m = 0; m < 4; ++m)
#pragma unroll
                for (int bj = 0; bj < 2; ++bj)
#pragma unroll
                    for (int n = 0; n < 2; ++n) { const f32x4 v = acc[ai][bj][m][n];
                        *(unsigned*)(tp + (bj * 128 + n * 16) * 64 + 16 * (m >> 1) + 8 * (m & 1)) = cvt4_fp8(v[0], v[1], v[2], v[3]); } }
    }
};
struct FixOrder : StaticOrder {
    __device__ __forceinline__ size_t bofs(const Unit& u) const { return (size_t)(u.pm >> 5) * (512 * 256 * 2); }
};
struct EpiAddO {
    static constexpr bool PERM = true;
    bf16_t* O;
    __device__ __forceinline__ void operator()(const f32x4 (&acc)[2][2][4][2], const Unit& u, int wr, int wc, int fr, int fq) const {
#pragma unroll
        for (int ai = 0; ai < 2; ++ai)
#pragma unroll
            for (int m = 0; m < 4; ++m) { const int row = u.pm * BM + ai * HALF + wr * 64 + m * 16 + fr, bhh = row >> 13, t = row & 8191;
                bf16_t* rowp = O + ((size_t)(bhh >> 2) * SEQ + SEQ / 2 + t) * D + (bhh & 3) * 512 + u.pn * BM + wc * 32 + 8 * fq;
#pragma unroll
                for (int bj = 0; bj < 2; ++bj) { const u32x4 old = *(const u32x4*)(rowp + bj * HALF); const f32x4 v0 = acc[ai][bj][m][0] * 0.0625f, v1 = acc[ai][bj][m][1] * 0.0625f;
                    u32x4 w; w.x = cvt_pk_bf16(bf_lo(old.x) + v0[0], bf_hi(old.x) + v0[1]); w.y = cvt_pk_bf16(bf_lo(old.y) + v0[2], bf_hi(old.y) + v0[3]);
                    w.z = cvt_pk_bf16(bf_lo(old.z) + v1[0], bf_hi(old.z) + v1[1]); w.w = cvt_pk_bf16(bf_lo(old.w) + v1[2], bf_hi(old.w) + v1[3]);
                    *(u32x4*)(rowp + bj * HALF) = w; } }
    }
};
struct EpiResF32 {
    static constexpr bool PERM = false;
    const float* base; float* C; int ldc;
    __device__ __forceinline__ void operator()(const f32x4 (&acc)[2][2][4][2], const Unit& u, int wr, int wc, int fr, int fq) const {
        const int row0 = u.pm * BM + wr * 64 + fr, col0 = u.pn * BM + wc * 32 + 4 * fq;
#pragma unroll
        for (int ai = 0; ai < 2; ++ai)
#pragma unroll
            for (int m = 0; m < 4; ++m) { const size_t off = (size_t)(row0 + ai * HALF + m * 16) * ldc + col0;
#pragma unroll
                for (int bj = 0; bj < 2; ++bj)
#pragma unroll
                    for (int n = 0; n < 2; ++n) { const f32x4 bs = *(const f32x4*)(base + off + bj * HALF + n * 16); *(f32x4*)(C + off + bj * HALF + n * 16) = bs + acc[ai][bj][m][n]; }
                asm volatile("" ::: "memory"); }
    }
};
struct EpiSiluMul {
    static constexpr bool PERM = true;
    unsigned char* Hh;
    __device__ __forceinline__ void operator()(const f32x4 (&acc)[2][2][4][2], const Unit& u, int wr, int wc, int fr, int fq) const {
        const int row0 = u.pm * BM + wr * 64 + fr, col0 = u.pn * HALF + wc * 32 + 8 * fq;
#pragma unroll
        for (int ai = 0; ai < 2; ++ai)
#pragma unroll
            for (int m = 0; m < 4; ++m) { unsigned char* rowp = Hh + (size_t)(row0 + ai * HALF + m * 16) * DFF + col0;
                float hv[8];
#pragma unroll
                for (int n = 0; n < 2; ++n)
#pragma unroll
                    for (int j = 0; j < 4; ++j) { const float g = acc[ai][0][m][n][j], up = acc[ai][1][m][n][j];
                        const float sg = g * __builtin_amdgcn_rcpf(1.0f + __builtin_amdgcn_exp2f(-1.4426950408889634f * g)); hv[n * 4 + j] = sg * up; }
                u32x2 w; w.x = cvt4_fp8(hv[0], hv[1], hv[2], hv[3]); w.y = cvt4_fp8(hv[4], hv[5], hv[6], hv[7]);
                *(u32x2*)rowp = w; }
    }
};

template <class Epi, class Sched, bool GATHER = false, bool FP8 = false, bool NTR = false>
__device__ __forceinline__ void gemm_phase(LAS unsigned char* lds, const Gemm g, const Sched& S, const Epi& E, int tid_in) {
    const int tid = opq(tid_in), wid = __builtin_amdgcn_readfirstlane(tid >> 6), lane = tid & 63, wr = wid >> 2, wc = wid & 3, fr = lane & 15, fq = lane >> 4;
    const int K = g.K, RP = FP8 ? K : 2 * K  , nt = RP / (BK * 2);
    unsigned voffA[2], voffB[2];
#pragma unroll
    for (int i = 0; i < 2; ++i) { int R, C; stage_rc(tid * 16 + i * 8192, R, C); const int Rb = Epi::PERM ? ((R & ~31) + perm32(R & 31)) : R;
        voffA[i] = (unsigned)(R * RP + 2 * C); voffB[i] = (unsigned)(Rb * RP + 2 * C); }
    const unsigned kstep = (unsigned)(BK * 2);
    const unsigned hstep = (unsigned)HALF * (unsigned)RP;
    const size_t tstep = 2 * (size_t)hstep;
    const unsigned ldsw = (unsigned)wid * 1024u;
    const int aoff = lds_byte(wr * 64 + fr, fq * 8), boff = lds_byte(wc * 32 + fr, fq * 8);
    const LAS unsigned char* ldsB = lds + 4 * HTB + boff;
#define PG8_SA(b, h) (((b) * 2 + (h)) * HTB)
#define PG8_SB(b, h) ((4 + (b) * 2 + (h)) * HTB)
#define PG8_STAGE(bufoff, gbase, voff) do { const unsigned long long gv_ = (unsigned long long)(gbase); \
        const unsigned glo_ = (unsigned)__builtin_amdgcn_readfirstlane((unsigned)gv_), ghi_ = (unsigned)__builtin_amdgcn_readfirstlane((unsigned)(gv_ >> 32)); const char* gb_ = (const char*)(((unsigned long long)ghi_ << 32) | (unsigned long long)glo_);     \
        _Pragma("unroll") for (int _i = 0; _i < 2; ++_i) \
        __builtin_amdgcn_global_load_lds((const unsigned*)(gb_ + (voff)[_i]), (LAS unsigned*)(lds + (bufoff) + ldsw + _i * 8192), 16, 0, 0); } while (0)
#define PG8_STAGE_A(bufoff, nx, koff, h) do { if constexpr (GATHER) { unsigned vs_[2]; _Pragma("unroll") for (int _i = 0; _i < 2; ++_i) vs_[_i] = (nx) ? vAn[h][_i] : vAc[h][_i]; \
            PG8_STAGE(bufoff, (const char*)g.A + (koff), vs_); } \
        else { PG8_STAGE(bufoff, ((nx) ? nA : cA) + (koff) + (h) * hstep, voffA); } } while (0)
#define PG8_LD8(off) __builtin_shufflevector(*(const LAS v4i32*)(lds + (off)), *(const LAS v4i32*)(lds + (off) + 1024), 0, 1, 2, 3, 4, 5, 6, 7)
#define PG8_LDA(dst, b, h) do { if constexpr (FP8) { _Pragma("unroll") for (int m = 0; m < 4; ++m) dst##8[m] = PG8_LD8(PG8_SA(b, h) + aoff + m * 2048); } \
        else { _Pragma("unroll") for (int m = 0; m < 4; ++m) _Pragma("unroll") for (int k = 0; k < 2; ++k) dst[m][k] = *(const LAS bf16x8*)(lds + PG8_SA(b, h) + aoff + m * 2048 + k * 1024); } } while (0)
#define PG8_LD8B(off) __builtin_shufflevector(*(const LAS v4i32*)(ldsB + (off)), *(const LAS v4i32*)(ldsB + (off) + 1024), 0, 1, 2, 3, 4, 5, 6, 7)
#define PG8_LDB(dst, b, h) do { if constexpr (FP8) { _Pragma("unroll") for (int n = 0; n < 2; ++n) dst##8[n] = PG8_LD8B(PG8_SA(b, h) + n * 2048); }     \
        else { _Pragma("unroll") for (int n = 0; n < 2; ++n) _Pragma("unroll") for (int k = 0; k < 2; ++k) dst[n][k] = *(const LAS bf16x8*)(lds + PG8_SB(b, h) + boff + n * 2048 + k * 1024); } } while (0)
#define PG8_MMA(ai, bj, At, Bt) do { __builtin_amdgcn_s_setprio(1); if constexpr (FP8) { _Pragma("unroll") for (int m = 0; m < 4; ++m) _Pragma("unroll") for (int n = 0; n < 2; ++n) \
              \
            { if constexpr (NTR) asm volatile("v_mfma_scale_f32_16x16x128_f8f6f4 %0, %1, %2, %0, %3, %3 op_sel:[1,0,0] op_sel_hi:[0,0,0]" : "+v"(acc[ai][bj][m][n]) : "v"(At##8[m]), "v"(Bt##8[n]), "v"(scl8)); \
              else asm volatile("v_mfma_scale_f32_16x16x128_f8f6f4 %0, %1, %2, %0, %3, %3 op_sel:[0,1,0] op_sel_hi:[0,0,0]" : "+v"(acc[ai][bj][m][n]) : "v"(Bt##8[n]), "v"(At##8[m]), "v"(scl8)); } } \
        else { _Pragma("unroll") for (int m = 0; m < 4; ++m) _Pragma("unroll") for (int n = 0; n < 2; ++n) _Pragma("unroll") for (int k = 0; k < 2; ++k) \
            acc[ai][bj][m][n] = __builtin_amdgcn_mfma_f32_16x16x32_bf16(Bt[n][k], At[m][k], acc[ai][bj][m][n], 0, 0, 0); } __builtin_amdgcn_s_setprio(0); } while (0)
#define PG8_WAIT_V(n) asm volatile("s_waitcnt vmcnt(" #n ")" ::: "memory")
#define PG8_WAIT_L(n) asm volatile("s_waitcnt lgkmcnt(" #n ")" ::: "memory")
#define PG8_BAR __builtin_amdgcn_s_barrier()
#define PG8_SCHED __builtin_amdgcn_sched_barrier(0)
#define PG8_ROWOFFS(V, U) do { if constexpr (GATHER) { const int t_ = opq(wid * 64 + lane_id());     \
        _Pragma("unroll") for (int i_ = 0; i_ < 2; ++i_) { int R_, C_; stage_rc(t_ * 16 + i_ * 8192, R_, C_); \
        _Pragma("unroll") for (int h_ = 0; h_ < 2; ++h_) V[h_][i_] = (unsigned)S.arow((U).pm, h_ * HALF + R_) * (unsigned)RP + 2u * (unsigned)C_; } } } while (0)
    Unit cur, nxt; int ui = 0;
    if (!S.next(0, cur)) return;
    f32x4 acc[2][2][4][2];
#pragma unroll
    for (int a = 0; a < 2; ++a)
#pragma unroll
        for (int b = 0; b < 2; ++b)
#pragma unroll
            for (int m = 0; m < 4; ++m)
#pragma unroll
                for (int n = 0; n < 2; ++n) acc[a][b][m][n] = (f32x4){0.f, 0.f, 0.f, 0.f};
    const unsigned scl8 = 0x7f797f79u;
    bf16x8 At[4][2], B0[2][2], B1[2][2]; v8i32 At8[4], B08[2], B18[2];
    unsigned vAc[2][2] = {{0u, 0u}, {0u, 0u}}, vAn[2][2] = {{0u, 0u}, {0u, 0u}};
    const char* cA = (const char*)g.A + (GATHER ? (size_t)0 : (size_t)cur.pm * tstep); const char* nA = cA; const char* cB = (const char*)g.Bt + S.bofs(cur) + (size_t)cur.pn * tstep;
    PG8_ROWOFFS(vAc, cur);
    PG8_STAGE(PG8_SB(0, 0), cB, voffB); PG8_STAGE(PG8_SB(0, 1), cB + hstep, voffB); PG8_STAGE_A(PG8_SA(0, 0), false, 0u, 0); PG8_STAGE_A(PG8_SA(0, 1), false, 0u, 1);
    if (wr == 1) PG8_BAR;
    PG8_WAIT_V(2); PG8_BAR;
    PG8_STAGE(PG8_SB(1, 0), cB + kstep, voffB); PG8_STAGE_A(PG8_SA(1, 0), false, kstep, 0); PG8_STAGE(PG8_SB(1, 1), cB + hstep + kstep, voffB);
    PG8_WAIT_V(6); PG8_BAR;
    for (;;) {
        const bool has_next = S.next(ui + 1, nxt);
        nA = (has_next && !GATHER) ? (const char*)g.A + (size_t)nxt.pm * tstep : cA; const char* nB = has_next ? (const char*)g.Bt + S.bofs(nxt) + (size_t)nxt.pn * tstep : cB;

        for (int t = 0; t < nt; t += 2) {
            const bool last = (t == nt - 2);
            if constexpr (GATHER) { if (last) {
                if (has_next) PG8_ROWOFFS(vAn, nxt); else { _Pragma("unroll") for (int h_ = 0; h_ < 2; ++h_) _Pragma("unroll") for (int i_ = 0; i_ < 2; ++i_) vAn[h_][i_] = vAc[h_][i_]; } } }
            const unsigned k1 = (unsigned)(t + 1) * kstep, k2 = last ? 0u : (unsigned)(t + 2) * kstep, k3 = k2 + kstep;
            const char* b2 = last ? nB : cB + k2; const char* b3 = b2 + kstep;
            PG8_LDB(B0, 0, 0); PG8_LDB(B1, 0, 1); PG8_SCHED; PG8_LDA(At, 0, 0); PG8_STAGE_A(PG8_SA(1, 1), false, k1, 1);
            PG8_WAIT_V(8); PG8_WAIT_L(0); PG8_BAR; PG8_MMA(0, 0, At, B0); PG8_MMA(0, 1, At, B1); PG8_BAR; PG8_SCHED;
            PG8_LDA(At, 0, 1); PG8_STAGE(PG8_SB(0, 0), b2, voffB); PG8_STAGE(PG8_SB(0, 1), b2 + hstep, voffB); PG8_STAGE_A(PG8_SA(0, 0), last, k2, 0);
            PG8_WAIT_V(8); PG8_WAIT_L(0); PG8_BAR; PG8_MMA(1, 0, At, B0); PG8_MMA(1, 1, At, B1); PG8_BAR; PG8_SCHED;
            PG8_LDB(B0, 1, 0); PG8_LDB(B1, 1, 1); PG8_SCHED; PG8_LDA(At, 1, 0); PG8_STAGE_A(PG8_SA(0, 1), last, k2, 1);
            PG8_WAIT_V(8); PG8_WAIT_L(0); PG8_BAR; PG8_MMA(0, 0, At, B0); PG8_MMA(0, 1, At, B1); PG8_BAR; PG8_SCHED;
            PG8_LDA(At, 1, 1); PG8_STAGE(PG8_SB(1, 0), b3, voffB); PG8_STAGE(PG8_SB(1, 1), b3 + hstep, voffB); PG8_STAGE_A(PG8_SA(1, 0), last, k3, 0);
            PG8_WAIT_V(8); PG8_WAIT_L(0); PG8_BAR; PG8_MMA(1, 0, At, B0); PG8_MMA(1, 1, At, B1); PG8_BAR; PG8_SCHED;
        }
        if (wr == 0) PG8_BAR;
        E(acc, cur, wr, wc, fr, fq);
        if (!has_next) break;
#pragma unroll
        for (int a = 0; a < 2; ++a)
#pragma unroll
            for (int b = 0; b < 2; ++b)
#pragma unroll
                for (int m = 0; m < 4; ++m)
#pragma unroll
                    for (int n = 0; n < 2; ++n) acc[a][b][m][n] = (f32x4){0.f, 0.f, 0.f, 0.f};
        cur = nxt; cA = nA; cB = nB; ++ui;
        if constexpr (GATHER) { _Pragma("unroll") for (int h_ = 0; h_ < 2; ++h_) _Pragma("unroll") for (int i_ = 0; i_ < 2; ++i_) vAc[h_][i_] = vAn[h_][i_]; }
        if (wr == 1) PG8_BAR;
    }
    PG8_WAIT_V(0);
    PG8_BAR;
#undef PG8_SA
#undef PG8_SB
#undef PG8_STAGE
#undef PG8_STAGE_A
#undef PG8_ROWOFFS
#undef PG8_LDA
#undef PG8_LDB
#undef PG8_MMA
#undef PG8_LD8
#undef PG8_LD8B
#undef PG8_WAIT_V
#undef PG8_WAIT_L
#undef PG8_BAR
#undef PG8_SCHED
}
}

#define XB_TMO      128
#define XB_XCNT(j)  (256  + 64 * (j))
#define XB_XSUB(j)  (1280 + 64 * (j))
#define XB_XGEN(j)  (2304 + 64 * (j))
#define XB_TOP      3328
#define XB_TOPGEN   3392
#define XCD_BAR_WORDS 3456
#define XB_SPIN_CAP (1u << 18)
__device__ __forceinline__ unsigned xb_ld(unsigned* p)              { return __hip_atomic_load(p, __ATOMIC_RELAXED, __HIP_MEMORY_SCOPE_AGENT); }
__device__ __forceinline__ unsigned xb_add(unsigned* p, unsigned v) { return __hip_atomic_fetch_add(p, v, __ATOMIC_RELAXED, __HIP_MEMORY_SCOPE_AGENT); }
__device__ __forceinline__ unsigned xb_xcc_id() { return (unsigned)__builtin_amdgcn_s_getreg((3 << 11) | 20) & 0xFu; }
#define XB_SPIN(cond, bar) do { unsigned _sp = 0; while (cond) { __builtin_amdgcn_s_sleep(1); \
    if ((++_sp & 255u) == 0u) { if (xb_ld(&(bar)[XB_TMO])) break; if (_sp > XB_SPIN_CAP) { atomicAdd(&(bar)[XB_TMO], 1u); break; } } } } while (0)
struct XcdBarrier { unsigned* bar; unsigned x; volatile LAS unsigned* st; int wave; };
__device__ __forceinline__ XcdBarrier xcd_barrier_post(unsigned* bar, volatile LAS unsigned* st) {
    XcdBarrier b; b.bar = bar; b.x = xb_xcc_id(); b.st = st; b.wave = __builtin_amdgcn_readfirstlane((int)threadIdx.x >> 6);
    if (threadIdx.x == 0) (void)xb_add(&bar[XB_XCNT(b.x)], 1u);
    return b;
}
__device__ __forceinline__ void xcd_barrier_complete(unsigned* bar, unsigned x, unsigned& nloc, unsigned& nx) {
    const unsigned G = gridDim.x * gridDim.y * gridDim.z;
    unsigned sum, cnt, mine, sp = 0u;
    for (;;) {
        sum = 0u; cnt = 0u; mine = 0u;
#pragma unroll
        for (unsigned j = 0; j < 16; ++j) { const unsigned c = xb_ld(&bar[XB_XCNT(j)]); sum += c; cnt += (c > 0u) ? 1u : 0u; mine = (j == x) ? c : mine; }
        if (sum == G) break;
        __builtin_amdgcn_s_sleep(1);
        if ((++sp & 255u) == 0u) { if (xb_ld(&bar[XB_TMO])) break; if (sp > XB_SPIN_CAP) { atomicAdd(&bar[XB_TMO], 1u); break; } }
    }
    nloc = mine > 0u ? mine : 1u; nx = cnt > 0u ? cnt : 1u;
}
__device__ __forceinline__ void xcd_barrier(const XcdBarrier& b, bool leader  ) {
    asm volatile("s_waitcnt vmcnt(0)" ::: "memory");
    SYNCTHREADS();
    if (leader) {
        unsigned* bar = b.bar;
        __builtin_amdgcn_s_waitcnt(0);
        unsigned nloc = b.st[0], nx = b.st[1];
        if (nloc == 0u) { xcd_barrier_complete(bar, b.x, nloc, nx); b.st[0] = nloc; b.st[1] = nx; }
        const unsigned old = xb_add(&bar[XB_XSUB(b.x)], 1u);
        const unsigned gen = old / nloc;
        if (old + 1u == (gen + 1u) * nloc) {
            __builtin_amdgcn_fence(__ATOMIC_RELEASE, "agent");
            asm volatile("s_waitcnt vmcnt(0)" ::: "memory");
            const unsigned og = xb_add(&bar[XB_TOP], 1u);
            const unsigned tg = og / nx;
            if (og + 1u == (tg + 1u) * nx) xb_add(&bar[XB_TOPGEN], 1u);
            else XB_SPIN(xb_ld(&bar[XB_TOPGEN]) == tg, bar);
            __builtin_amdgcn_fence(__ATOMIC_ACQUIRE, "agent");
            xb_add(&bar[XB_XGEN(b.x)], 1u);
            asm volatile("s_waitcnt vmcnt(0)" ::: "memory");
        } else {
            XB_SPIN(xb_ld(&bar[XB_XGEN(b.x)]) == gen, bar);
            __builtin_amdgcn_fence(__ATOMIC_ACQUIRE, "agent");
            asm volatile("s_waitcnt vmcnt(0)" ::: "memory");
        }
    }
    SYNCTHREADS();
}

struct Frame {
    LAS unsigned char* lds;
    int tid, lane, wave, vcu, G;
};
struct Args {
    const float* in[21]; float* out; unsigned char* ws; int pad0, pad1;
};

template <bool FP8 = false>
__device__ __forceinline__ void transpose_item(const float* W, int ldw, int k0, int n0, bf16_t* WT, int ldk, int drow0, LAS float* scr, int lane) {
    float tv[32];
    const float* wp_ = W + (size_t)(k0 + (lane >> 5)) * ldw + n0 + (lane & 31);
#pragma unroll
    for (int i = 0; i < 32; ++i) tv[i] = wp_[(size_t)(2 * i) * ldw];
#pragma unroll
    for (int i = 0; i < 32; ++i) scr[(2 * i + (lane >> 5)) * 33 + (lane & 31)] = tv[i];
    LDS_WAIT(); asm volatile("" ::: "memory");
    const int c = lane & 7;
#pragma unroll
    for (int j = 0; j < 4; ++j) { const int n = (lane >> 3) + 8 * j; const LAS float* s = scr + (8 * c) * 33 + n;
        if constexpr (FP8) { u32x2 o; o.x = cvt4_fp8(s[0 * 33] * W8_SCALE, s[1 * 33] * W8_SCALE, s[2 * 33] * W8_SCALE, s[3 * 33] * W8_SCALE); o.y = cvt4_fp8(s[4 * 33] * W8_SCALE, s[5 * 33] * W8_SCALE, s[6 * 33] * W8_SCALE, s[7 * 33] * W8_SCALE);
            *(u32x2*)((unsigned char*)WT + (size_t)(drow0 + n) * ldk + k0 + 8 * c) = o; }
        else { u32x4 o; o.x = cvt_pk_bf16(s[0 * 33], s[1 * 33]); o.y = cvt_pk_bf16(s[2 * 33], s[3 * 33]); o.z = cvt_pk_bf16(s[4 * 33], s[5 * 33]); o.w = cvt_pk_bf16(s[6 * 33], s[7 * 33]);
            *(u32x4*)(WT + (size_t)(drow0 + n) * ldk + k0 + 8 * c) = o; } }
    LDS_WAIT(); asm volatile("" ::: "memory");
}
template <bool FP8 = false>
__device__ __forceinline__ void conv_plain(Frame& F, const float* W, int K, int N, int ldw, bf16_t* WT, int rank = -1, int nrank = 0) {
    LAS float* scr = (LAS float*)(F.lds + F.wave * 16384);
    const int gw = (rank < 0 ? F.vcu : rank) * NWAVES + F.wave, NGW = (rank < 0 ? F.G : nrank) * NWAVES, nblk = N / 32, nit = (K / 64) * nblk;
    for (int it = gw; it < nit; it += NGW) { const int kb = it / nblk, nb = it % nblk; transpose_item<FP8>(W, ldw, 64 * kb, 32 * nb, WT, K, 32 * nb, scr, F.lane); }
}
__device__ __forceinline__ void conv_moe(Frame& F, const float* wg, const float* wu, const float* wd, bf16_t* GU, bf16_t* DT, int rank = -1, int nrank = 0) {
    LAS float* scr = (LAS float*)(F.lds + F.wave * 16384);
    const int gw = (rank < 0 ? F.vcu : rank) * NWAVES + F.wave, NGW = (rank < 0 ? F.G : nrank) * NWAVES;
    constexpr int PER_E = 1536, NIT = NEXP * PER_E;
    for (int it = gw; it < NIT; it += NGW) {
        const int e = it / PER_E; int r = it % PER_E;
        if (r < 1024) { const int up = r >> 9; r &= 511; const int kb = r >> 4, nb = r & 15, n0 = 32 * nb;
            const int drow = 256 * (n0 >> 7) + 128 * up + (n0 & 127);
            transpose_item<true>((up ? wu : wg) + (size_t)e * D * DFF, DFF, 64 * kb, n0, (bf16_t*)((unsigned char*)GU + (size_t)e * 1024 * D), D, drow, scr, F.lane); }
        else { r -= 1024; const int kb = r >> 6, nb = r & 63;
            transpose_item<true>(wd + (size_t)e * DFF * D, D, 64 * kb, 32 * nb, (bf16_t*)((unsigned char*)DT + (size_t)e * D * DFF), DFF, 32 * nb, scr, F.lane); }
    }
}
__device__ __forceinline__ void pack_proj(Frame& F, float* Wp, int NT, const float* gain, const float* Wa, int lda, int ca0, int na, const float* Wb, int ldb, int nb) {
    const int total = 128 * NT * 256;
    for (int idx = (F.vcu * NWAVES * 64) + F.tid; idx < total; idx += F.G * NWAVES * 64) {
        const int e = idx & 3, ln = (idx >> 2) & 63, rest = idx >> 8, nt = rest % NT, s = rest / NT;
        const int k = 16 * s + 4 * (ln >> 4) + e, col = 16 * nt + (ln & 15);
        float v = 0.f;
        if (col < na) v = Wa[(size_t)k * lda + ca0 + col]; else if (col < na + nb) v = Wb[(size_t)k * ldb + (col - na)];
        Wp[idx] = v * gain[k];
    }
}

template <int NT>
__device__ __forceinline__ float wave_proj16(LAS unsigned char* lds, const float* xin, int tok0, const float* Wp, int tid, int wid, int lane, f32x4 (&acc)[NT]) {
    const int tr = lane & 15, kq = lane >> 4;
    const f32x4* xp = (const f32x4*)(xin + (size_t)(tok0 + tr) * D) + kq;
    constexpr int CH = 16 * NT * 1024;
    const char* wsrc = (const char*)Wp + tid * 16;
    float ssq = 0.f;
#pragma unroll
    for (int n = 0; n < NT; ++n) acc[n] = (f32x4){0.f, 0.f, 0.f, 0.f};
    f32x4 X[16];
#define NP_DMA(c, buf) do { _Pragma("unroll") for (int r = 0; r < 2 * NT; ++r) \
        __builtin_amdgcn_global_load_lds((const unsigned*)(wsrc + (size_t)(c) * CH + r * 8192), (LAS unsigned*)(lds + (buf) * CH + r * 8192 + wid * 1024), 16, 0, 0); } while (0)
#define NP_CHUNK(c, buf, more) do { \
        asm volatile("s_waitcnt vmcnt(16)" ::: "memory"); WG_BAR(); \
        if (more) NP_DMA((c) + 1, 1 - (buf)); \
        asm volatile("" ::: "memory");     \
        const f32x4* xn_ = xp + 64 * ((c) + 1); \
        _Pragma("unroll") for (int s = 0; s < 16; ++s) { const f32x4 xv = X[s]; if (more) X[s] = xn_[4 * s]; \
            ssq += (xv[0] * xv[0] + xv[1] * xv[1]) + (xv[2] * xv[2] + xv[3] * xv[3]); \
            _Pragma("unroll") for (int n = 0; n < NT; ++n) { const f32x4 wv = *(const LAS f32x4*)(lds + (buf) * CH + ((s * NT + n) * 64 + lane) * 16); \
                _Pragma("unroll") for (int e = 0; e < 4; ++e) acc[n] = __builtin_amdgcn_mfma_f32_16x16x4f32(xv[e], wv[e], acc[n], 0, 0, 0); } } } while (0)
    NP_DMA(0, 0);
    asm volatile("" ::: "memory");
#pragma unroll
    for (int s = 0; s < 16; ++s) X[s] = xp[4 * s];
    for (int c = 0; c < 6; c += 2) { NP_CHUNK(c, 0, true); NP_CHUNK(c + 1, 1, true); }
    NP_CHUNK(6, 0, true); NP_CHUNK(7, 1, false);
    WG_BAR();
#undef NP_DMA
#undef NP_CHUNK
    ssq += __shfl_xor(ssq, 16); ssq += __shfl_xor(ssq, 32);
    return 1.0f / sqrtf(ssq * (1.0f / D) + RMS_EPS);
}
template <bool FP8 = false>
__device__ __forceinline__ void wave_write_hn16(const float* xin, int tok0, float rstd, const float* gain, bf16_t* hn, int lane) {
    f32x4 g4[8];
#pragma unroll
    for (int j = 0; j < 8; ++j) g4[j] = ((const f32x4*)gain)[lane + 64 * j];
    for (int i = 0; i < 16; i += 2) {
        const float r0 = __shfl(rstd, i), r1 = __shfl(rstd, i + 1);
        const f32x4* x0 = (const f32x4*)(xin + (size_t)(tok0 + i) * D); const f32x4* x1 = x0 + D / 4;
        u32x2* o0 = (u32x2*)(hn + (size_t)(tok0 + i) * D); u32x2* o1 = o0 + D / 4;
        unsigned* p0 = (unsigned*)((unsigned char*)hn + (size_t)(tok0 + i) * D); unsigned* p1 = p0 + D / 4;
        f32x4 a[8], c[8];
#pragma unroll
        for (int j = 0; j < 8; ++j) { a[j] = x0[lane + 64 * j]; c[j] = x1[lane + 64 * j]; }
#pragma unroll
        for (int j = 0; j < 8; ++j) { const f32x4 v = a[j] * r0 * g4[j], u = c[j] * r1 * g4[j];
            if constexpr (FP8) { p0[lane + 64 * j] = cvt4_fp8(v[0], v[1], v[2], v[3]); p1[lane + 64 * j] = cvt4_fp8(u[0], u[1], u[2], u[3]); }
            else { u32x2 w; w.x = cvt_pk_bf16(v[0], v[1]); w.y = cvt_pk_bf16(v[2], v[3]); o0[lane + 64 * j] = w;
                u32x2 z; z.x = cvt_pk_bf16(u[0], u[1]); z.y = cvt_pk_bf16(u[2], u[3]); o1[lane + 64 * j] = z; } }
    }
}

__device__ __forceinline__ void phase_norm_gz(Frame& F, const float* xin, const float* gain, const float* Wp, bf16_t* hn, float* gz) {
    for (int tile = F.vcu; tile < T / 128; tile += F.G) {
        const int tok0 = tile * 128 + F.wave * 16;
        f32x4 acc[1];
        const float rstd = wave_proj16<1>(F.lds, xin, tok0, Wp, F.tid, F.wave, F.lane, acc);
        const int j = F.lane & 15, q4 = F.lane >> 4;
#pragma unroll
        for (int r = 0; r < 4; ++r) { const float rr = __shfl(rstd, 4 * q4 + r); gz[(size_t)(tok0 + 4 * q4 + r) * 16 + j] = acc[0][r] * rr; }
        wave_write_hn16(xin, tok0, rstd, gain, hn, F.lane);
    }
}
__device__ __forceinline__ void phase_norm_route(Frame& F, const float* xin, const float* gain, const float* Wp, bf16_t* hn, int* tok_e, int* tok_p, float* tok_w, unsigned* cnt) {
    LAS float* lg = (LAS float*)(F.lds + 98304 + F.wave * 3072);
    for (int tile = F.vcu; tile < T / 128; tile += F.G) {
        const int tok0 = tile * 128 + F.wave * 16;
        f32x4 acc[3];
        const float rstd = wave_proj16<3>(F.lds, xin, tok0, Wp, F.tid, F.wave, F.lane, acc);
        const int j = F.lane & 15, q4 = F.lane >> 4;
#pragma unroll
        for (int r = 0; r < 4; ++r) { const float rr = __shfl(rstd, 4 * q4 + r);
#pragma unroll
            for (int n = 0; n < 3; ++n) lg[(4 * q4 + r) * 48 + 16 * n + j] = acc[n][r] * rr; }
        LDS_WAIT(); asm volatile("" ::: "memory");
        if (F.lane < 16) {
            const LAS float* l = lg + F.lane * 48;
            float gm = l[0]; int gi = 0;
#pragma unroll
            for (int q = 1; q < 4; ++q) { const float v = l[q]; if (v > gm) { gm = v; gi = q; } }
            float gs = 0.f;
#pragma unroll
            for (int q = 0; q < 4; ++q) gs += __expf(l[q] - gm);
            const float gw = 1.0f / gs;
            const LAS float* se = l + 4 + 8 * gi;
            float m1 = se[0]; int i1 = 0;
#pragma unroll
            for (int q = 1; q < 8; ++q) { const float v = se[q]; if (v > m1) { m1 = v; i1 = q; } }
            float m2 = -3.0e38f; int i2 = 0;
#pragma unroll
            for (int q = 0; q < 8; ++q) { const float v = se[q]; if (q != i1 && v > m2) { m2 = v; i2 = q; } }
            const float eb = __expf(m2 - m1), inv = 1.0f / (1.0f + eb);
            const int t = tok0 + F.lane, e1 = gi * 8 + i1, e2 = gi * 8 + i2;
            const unsigned p1 = __hip_atomic_fetch_add(cnt + 64 * e1, 1u, __ATOMIC_RELAXED, __HIP_MEMORY_SCOPE_AGENT);
            const unsigned p2 = __hip_atomic_fetch_add(cnt + 64 * e2, 1u, __ATOMIC_RELAXED, __HIP_MEMORY_SCOPE_AGENT);
            tok_e[2 * t] = e1; tok_e[2 * t + 1] = e2; tok_p[2 * t] = (int)p1; tok_p[2 * t + 1] = (int)p2;
            tok_w[2 * t] = gw * inv; tok_w[2 * t + 1] = gw * eb * inv;
        }
        wave_write_hn16<true>(xin, tok0, rstd, gain, hn, F.lane);
        LDS_WAIT(); asm volatile("" ::: "memory");
    }
}

__device__ __forceinline__ void phase_gla_gate(Frame& F, const float* gz, const float* wgu, const float* bgate, const bf16_t* proj, bf16_t* kdT, float* adec) {
    LAS f32x4* gzs = (LAS f32x4*)F.lds;
    for (int u = F.vcu; u < NBATCH * NCH * 2; u += F.G) {
        const int half = u & 1, bc = u >> 1;
        const int tok0 = bc * 64, j = half * 512 + F.tid;
        if (F.tid < 256) gzs[F.tid] = ((const f32x4*)(gz + (size_t)tok0 * 16))[F.tid];
        float wg[16];
#pragma unroll
        for (int r = 0; r < 16; ++r) wg[r] = wgu[r * GLA_DKT + j];
        const float bg = bgate[j];
        WG_BAR();
        float cum[64]; float run = 0.f;
#pragma unroll
        for (int t = 0; t < 64; ++t) {
            float z = bg;
#pragma unroll
            for (int r4 = 0; r4 < 4; ++r4) { const f32x4 g4 = gzs[t * 4 + r4]; z += g4[0] * wg[4 * r4] + g4[1] * wg[4 * r4 + 1] + g4[2] * wg[4 * r4 + 2] + g4[3] * wg[4 * r4 + 3]; }
            const float ls = fminf(z, 0.f) - __logf(1.0f + __expf(-fabsf(z)));
            run += ls * (1.0f / 16.0f); cum[t] = run;
        }
        adec[(size_t)bc * GLA_DKT + j] = __expf(run);
        const bf16_t* kp = proj + GK0 + gq_off(bc >> 8, (bc & 255) * 64, j >> 8) + (j & 255);
        u32x4* dst = (u32x4*)(kdT + ((size_t)bc * GLA_DKT + j) * 64);
#pragma unroll
        for (int t8 = 0; t8 < 8; ++t8) {
            float kd[8];
#pragma unroll
            for (int q = 0; q < 8; ++q) { const int t = t8 * 8 + q; kd[q] = bf2f(kp[(size_t)t * 256]) * __expf(run - cum[t]); }
            u32x4 w; w.x = cvt_pk_bf16(kd[0], kd[1]); w.y = cvt_pk_bf16(kd[2], kd[3]); w.z = cvt_pk_bf16(kd[4], kd[5]); w.w = cvt_pk_bf16(kd[6], kd[7]);
            dst[t8] = w;
        }
        WG_BAR();
    }
}

constexpr int SCAN_VROW = 144, SCAN_SROW = 528, SCAN_VBUF = 64 * SCAN_VROW, SCAN_SBUF = 64 * SCAN_SROW;
__device__ __forceinline__ void phase_gla_scan(Frame& F, int it, const bf16_t* proj, const bf16_t* kdT, const float* adec, bf16_t* oout, bf16_t* sfin) {
    const int lane = F.lane, w = F.wave, fr = lane & 15, kq = lane >> 4, tid = F.tid;
    LAS unsigned char* vbuf = F.lds;
    LAS unsigned char* sbuf = F.lds + 2 * SCAN_VBUF;
    const int bh = it >> 4, seg = (it >> 3) & 1, b = bh >> 2, h = bh & 3, sl = it & 7, mt = w & 3, ntp = w >> 2, c0 = seg * (NCH / 2);
    const size_t tokb = (size_t)b * SEQ;
    f32x4 st[2][4];
#pragma unroll
    for (int i = 0; i < 2; ++i)
#pragma unroll
        for (int n = 0; n < 4; ++n) st[i][n] = (f32x4){0.f, 0.f, 0.f, 0.f};
    bf16x8 ka0[2][2], ka1[2][2], q0[8], q1[8]; f32x4 dc0[2], dc1[2]; u32x4 vr0, vr1;
#define CL(c) ((c) < NCH ? (c) : NCH - 1)
#define LOAD_KA(KA, DC, c) do { const size_t bc_ = (size_t)b * NCH + CL(c); \
        _Pragma("unroll") for (int i = 0; i < 2; ++i) { \
            _Pragma("unroll") for (int s = 0; s < 2; ++s) KA[i][s] = *(const bf16x8*)(kdT + ((bc_ * GLA_DKT + h * 256 + 32 * w + 16 * i + fr) * 64 + 32 * s + 8 * kq)); \
            DC[i] = *(const f32x4*)(adec + bc_ * GLA_DKT + h * 256 + 32 * w + 16 * i + 4 * kq); } } while (0)
#define LOAD_V(VR, c) do { VR = *(const u32x4*)(proj + gv_off(b, CL(c) * 64 + (tid >> 3), h) + 64 * sl + 8 * (tid & 7)); } while (0)
#define LOAD_Q(Q, c) do { const bf16_t* qp_ = proj + gq_off(b, CL(c) * 64 + 16 * mt + fr, h) + 8 * kq; \
        _Pragma("unroll") for (int s = 0; s < 8; ++s) Q[s] = *(const bf16x8*)(qp_ + 32 * s); } while (0)
#define STORE_V(VR, buf) do { *(LAS u32x4*)(vbuf + (buf) * SCAN_VBUF + (tid >> 3) * SCAN_VROW + (tid & 7) * 16) = VR; } while (0)
#define SCAN_STEP(KA, DC, VN, VM, QC, QN, c) do { \
        const unsigned vb_ = (unsigned)(uintptr_t)(vbuf + ((c) & 1) * SCAN_VBUF) + (unsigned)((8 * kq + ((lane & 15) >> 2)) * SCAN_VROW + 8 * (lane & 3)); \
        s16x4 tv[4][4];     \
        asm volatile("ds_read_b64_tr_b16 %0, %16 offset:0\n\tds_read_b64_tr_b16 %1, %16 offset:576\n\tds_read_b64_tr_b16 %2, %16 offset:4608\n\tds_read_b64_tr_b16 %3, %16 offset:5184\n\t" \
                     "ds_read_b64_tr_b16 %4, %16 offset:32\n\tds_read_b64_tr_b16 %5, %16 offset:608\n\tds_read_b64_tr_b16 %6, %16 offset:4640\n\tds_read_b64_tr_b16 %7, %16 offset:5216\n\t" \
                     "ds_read_b64_tr_b16 %8, %16 offset:64\n\tds_read_b64_tr_b16 %9, %16 offset:640\n\tds_read_b64_tr_b16 %10, %16 offset:4672\n\tds_read_b64_tr_b16 %11, %16 offset:5248\n\t" \
                     "ds_read_b64_tr_b16 %12, %16 offset:96\n\tds_read_b64_tr_b16 %13, %16 offset:672\n\tds_read_b64_tr_b16 %14, %16 offset:4704\n\tds_read_b64_tr_b16 %15, %16 offset:5280\n\ts_waitcnt lgkmcnt(0)" \
                     : "=&v"(tv[0][0]), "=&v"(tv[0][1]), "=&v"(tv[0][2]), "=&v"(tv[0][3]), "=&v"(tv[1][0]), "=&v"(tv[1][1]), "=&v"(tv[1][2]), "=&v"(tv[1][3]), \
                       "=&v"(tv[2][0]), "=&v"(tv[2][1]), "=&v"(tv[2][2]), "=&v"(tv[2][3]), "=&v"(tv[3][0]), "=&v"(tv[3][1]), "=&v"(tv[3][2]), "=&v"(tv[3][3]) : "v"(vb_) : "memory"); \
        _Pragma("unroll") for (int n = 0; n < 4; ++n) { \
            const bf16x8 vf0 = (bf16x8){tv[n][0][0], tv[n][0][1], tv[n][0][2], tv[n][0][3], tv[n][1][0], tv[n][1][1], tv[n][1][2], tv[n][1][3]}; \
            const bf16x8 vf1 = (bf16x8){tv[n][2][0], tv[n][2][1], tv[n][2][2], tv[n][2][3], tv[n][3][0], tv[n][3][1], tv[n][3][2], tv[n][3][3]}; \
            _Pragma("unroll") for (int i = 0; i < 2; ++i) { \
                st[i][n] = st[i][n] * DC[i]; \
                st[i][n] = __builtin_amdgcn_mfma_f32_16x16x32_bf16(KA[i][0], vf0, st[i][n], 0, 0, 0); \
                st[i][n] = __builtin_amdgcn_mfma_f32_16x16x32_bf16(KA[i][1], vf1, st[i][n], 0, 0, 0); } } \
        LOAD_KA(KA, DC, (c) + 2); \
        { LAS unsigned char* sb_ = sbuf + ((c) & 1) * SCAN_SBUF + fr * SCAN_SROW + (32 * w + 4 * kq) * 2; \
          _Pragma("unroll") for (int i = 0; i < 2; ++i) _Pragma("unroll") for (int n = 0; n < 4; ++n) { \
              u32x2 pk; pk.x = cvt_pk_bf16(st[i][n][0], st[i][n][1]); pk.y = cvt_pk_bf16(st[i][n][2], st[i][n][3]); \
              *(LAS u32x2*)(sb_ + n * 16 * SCAN_SROW + i * 32) = pk; } } \
        STORE_V(VN, ((c) + 1) & 1); \
        LOAD_V(VN, (c) + 3); \
        WG_BAR(); \
        { f32x4 a0 = (f32x4){0.f, 0.f, 0.f, 0.f}, a1 = a0; \
          const LAS unsigned char* sr_ = sbuf + ((c) & 1) * SCAN_SBUF + (32 * ntp + fr) * SCAN_SROW + 16 * kq; \
          _Pragma("unroll") for (int hb = 0; hb < 2; ++hb) { bf16x8 bb[4][2];     \
              _Pragma("unroll") for (int s = 0; s < 4; ++s) { bb[s][0] = *(const LAS bf16x8*)(sr_ + 64 * (4 * hb + s)); bb[s][1] = *(const LAS bf16x8*)(sr_ + 16 * SCAN_SROW + 64 * (4 * hb + s)); } \
              asm volatile("s_waitcnt lgkmcnt(0)" ::: "memory"); __builtin_amdgcn_sched_barrier(0); \
              _Pragma("unroll") for (int s = 0; s < 4; ++s) { \
                  a0 = __builtin_amdgcn_mfma_f32_16x16x32_bf16(QC[4 * hb + s], bb[s][0], a0, 0, 0, 0); \
                  a1 = __builtin_amdgcn_mfma_f32_16x16x32_bf16(QC[4 * hb + s], bb[s][1], a1, 0, 0, 0); } } \
          bf16_t* op_ = oout + (tokb + (size_t)(c) * 64 + 16 * mt + 4 * kq) * D + h * 512 + 64 * sl + 32 * ntp + fr; \
          _Pragma("unroll") for (int r = 0; r < 4; ++r) { \
              const float x0 = a0[r] * 0.0625f, x1 = a1[r] * 0.0625f, y0 = __shfl_xor(x0, 1), y1 = __shfl_xor(x1, 1); \
              if ((fr & 1) == 0) { *(unsigned*)(op_ + (size_t)r * D) = cvt_pk_bf16(x0, y0); *(unsigned*)(op_ + (size_t)r * D + 16) = cvt_pk_bf16(x1, y1); } } } \
        LOAD_Q(QC, (c) + 2); \
    } while (0)
    LOAD_KA(ka0, dc0, c0); LOAD_KA(ka1, dc1, c0 + 1); LOAD_V(vr0, c0); LOAD_V(vr1, c0 + 1); LOAD_Q(q0, c0); LOAD_Q(q1, c0 + 1);
    STORE_V(vr0, 0); LOAD_V(vr0, c0 + 2);
    WG_BAR();
    for (int c = c0; c < c0 + NCH / 2; c += 2) {
        SCAN_STEP(ka0, dc0, vr1, vr0, q0, q1, c);
        SCAN_STEP(ka1, dc1, vr0, vr1, q1, q0, c + 1);
    }
    if (seg == 0) {
#pragma unroll
        for (int i = 0; i < 2; ++i)
#pragma unroll
            for (int n = 0; n < 4; ++n) { u32x2 pk; pk.x = cvt_pk_bf16(st[i][n][0], st[i][n][1]); pk.y = cvt_pk_bf16(st[i][n][2], st[i][n][3]);
                *(u32x2*)(sfin + ((size_t)(bh * 512 + 64 * sl + 16 * n + fr)) * 256 + 32 * w + 16 * i + 4 * kq) = pk; }
    }
    WG_BAR();
#undef CL
#undef LOAD_KA
#undef LOAD_V
#undef LOAD_Q
#undef STORE_V
#undef SCAN_STEP
}

__device__ __forceinline__ void gla_pcum(Frame& F, const float* adec, float* pcum, int rank, int nrank) {
    for (int idx = rank * (NWAVES * 64) + F.tid; idx < NBATCH * GLA_DKT; idx += nrank * NWAVES * 64) { const int b = idx >> 10, j = idx & 1023;
        const float* ap = adec + ((size_t)(b * NCH + NCH / 2)) * GLA_DKT + j; float* pp = pcum + (size_t)(b * (NCH / 2)) * GLA_DKT + j; float pr = 1.f;
#pragma unroll 16
        for (int cc = 0; cc < NCH / 2; ++cc) { pr *= ap[(size_t)cc * GLA_DKT]; pp[(size_t)cc * GLA_DKT] = pr; } }
}
__device__ __forceinline__ void phase_gla_qp(Frame& F, const bf16_t* proj, const float* pcum, bf16_t* qp) {
    const int gw = F.vcu * NWAVES + F.wave, NGW = F.G * NWAVES, lane = F.lane;
    for (int r = gw; r < NBATCH * (SEQ / 2); r += NGW) { const int b = r >> 13, t = r & 8191;
        u32x2 qv[4]; f32x4 pv[4];
#pragma unroll
        for (int h = 0; h < 4; ++h) { qv[h] = *(const u32x2*)(proj + gq_off(b, SEQ / 2 + t, h) + 4 * lane); pv[h] = *(const f32x4*)(pcum + ((size_t)(b * (NCH / 2) + (t >> 6)) * GLA_DKT + h * 256 + 4 * lane)); }
#pragma unroll
        for (int h = 0; h < 4; ++h) { u32x2 w; w.x = cvt_pk_bf16(bf_lo(qv[h].x) * pv[h][0], bf_hi(qv[h].x) * pv[h][1]); w.y = cvt_pk_bf16(bf_lo(qv[h].y) * pv[h][2], bf_hi(qv[h].y) * pv[h][3]);
            *(u32x2*)(qp + ((size_t)((b * 4 + h) * (SEQ / 2) + t)) * 256 + 4 * lane) = w; }
    }
}
__device__ __forceinline__ void phase_gla_gnorm(Frame& F, const bf16_t* o, const bf16_t* proj, const float* gn, bf16_t* y) {
    const int gw = F.vcu * NWAVES + F.wave, NGW = F.G * NWAVES, lane = F.lane;
    const f32x4 g0 = ((const f32x4*)gn)[2 * lane], g1 = ((const f32x4*)gn)[2 * lane + 1];
    for (int tok = gw; tok < T; tok += NGW) {
        u32x4 ov[4], rv[4];
#pragma unroll
        for (int h = 0; h < 4; ++h) { ov[h] = *(const u32x4*)(o + (size_t)tok * D + h * 512 + 8 * lane); rv[h] = *(const u32x4*)(proj + GR0 + (size_t)tok * 2048 + h * 512 + 8 * lane); }
        float ss[4];
#pragma unroll
        for (int h = 0; h < 4; ++h) { float s = 0.f;
#pragma unroll
            for (int q = 0; q < 4; ++q) { const float lo = bf_lo(ov[h][q]), hi = bf_hi(ov[h][q]); s += lo * lo + hi * hi; }
            ss[h] = s; }
#pragma unroll
        for (int of = 1; of < 64; of <<= 1) {
#pragma unroll
            for (int h = 0; h < 4; ++h) ss[h] += __shfl_xor(ss[h], of); }
#pragma unroll
        for (int h = 0; h < 4; ++h) { const float rstd = 1.0f / sqrtf(ss[h] * (1.0f / 512.0f) + RMS_EPS);
            float yv[8];
#pragma unroll
            for (int q = 0; q < 4; ++q) { const float a0 = bf_lo(ov[h][q]), a1 = bf_hi(ov[h][q]), r0 = bf_lo(rv[h][q]), r1 = bf_hi(rv[h][q]);
                const float gA = q < 2 ? g0[2 * q] : g1[2 * q - 4], gB = q < 2 ? g0[2 * q + 1] : g1[2 * q - 3];
                yv[2 * q] = a0 * rstd * gA * (r0 / (1.0f + __expf(-r0))); yv[2 * q + 1] = a1 * rstd * gB * (r1 / (1.0f + __expf(-r1))); }
            u32x4 w; w.x = cvt_pk_bf16(yv[0], yv[1]); w.y = cvt_pk_bf16(yv[2], yv[3]); w.z = cvt_pk_bf16(yv[4], yv[5]); w.w = cvt_pk_bf16(yv[6], yv[7]);
            *(u32x4*)(y + (size_t)tok * D + h * 512 + 8 * lane) = w; }
    }
}

__device__ __forceinline__ void moe_tables(Frame& F, unsigned* cnt) {
    LAS int* pst = (LAS int*)(F.lds + TAB_OFF);
    LAS int* te = pst + 36;
    if (F.wave == 0) {
        const int e = F.lane & 31;
        const int c = (int)xb_ld(cnt + 64 * e);
        const int ntile = (c + 255) >> 8;
        int incl = ntile;
#pragma unroll
        for (int o = 1; o < 32; o <<= 1) { const int v = __shfl_up(incl, o); if ((F.lane & 31) >= o) incl += v; }
        const int excl = incl - ntile;
        if (F.lane < 32) { pst[e] = excl << 8; for (int q = 0; q < ntile; ++q) te[excl + q] = e; }
        if (F.lane == 31) { pst[32] = incl << 8; pst[33] = incl; }
    }
    WG_BAR();
}
__device__ __forceinline__ void phase_moe_slots(Frame& F, const int* tok_e, const int* tok_p, unsigned* cnt, int* slot_of, int* slot_tok) {
    const LAS int* pst = (const LAS int*)(F.lds + TAB_OFF);
    for (int e = F.vcu; e < NEXP; e += F.G) { const int c = (int)xb_ld(cnt + 64 * e), lo = pst[e] + c, hi = pst[e] + (((c + 255) >> 8) << 8);
        for (int s = lo + F.tid; s < hi; s += NWAVES * 64) slot_tok[s] = -1; }
    for (int a = F.vcu * NWAVES * 64 + F.tid; a < 2 * T; a += F.G * NWAVES * 64) { const int slot = pst[tok_e[a]] + tok_p[a]; slot_of[a] = slot; slot_tok[slot] = a >> 1; }
}
__device__ __forceinline__ void phase_moe_copy8(Frame& F, const int* tok_e, const int* tok_p, const unsigned char* hn8, unsigned char* ag8) {
    const LAS int* pst = (const LAS int*)(F.lds + TAB_OFF);
    const int gw = F.vcu * NWAVES + F.wave, NGW = F.G * NWAVES, lane = F.lane;
    for (int t = gw; t < T; t += NGW) {
        const int s0 = pst[tok_e[2 * t]] + tok_p[2 * t], s1 = pst[tok_e[2 * t + 1]] + tok_p[2 * t + 1];
        const u32x4* src = (const u32x4*)(hn8 + (size_t)t * D); const u32x4 v0 = src[lane], v1 = src[lane + 64];
        u32x4* d0 = (u32x4*)(ag8 + (size_t)s0 * D); u32x4* d1 = (u32x4*)(ag8 + (size_t)s1 * D);
        d0[lane] = v0; d0[lane + 64] = v1; d1[lane] = v0; d1[lane + 64] = v1;
    }
}
template <int MODE>
__device__ __forceinline__ void phase_moe_combine(Frame& F, float* x, const bf16_t* ob, const int* slot_of, const float* tok_w, const float* gain, bf16_t* hn) {
    const int gw = F.vcu * NWAVES + F.wave, NGW = F.G * NWAVES, lane = F.lane;
    f32x4 g4[8];
#pragma unroll
    for (int j = 0; j < 8; ++j) g4[j] = ((const f32x4*)gain)[lane + 64 * j];
    for (int t = gw; t < T; t += NGW) {
        const int s0 = slot_of[2 * t], s1 = slot_of[2 * t + 1]; const float w0 = tok_w[2 * t], w1 = tok_w[2 * t + 1];
        f32x4* xr = (f32x4*)(x + (size_t)t * D);
        const u32x2* a = (const u32x2*)(ob + (size_t)s0 * D); const u32x2* b = (const u32x2*)(ob + (size_t)s1 * D);
        f32x4 v[8]; float ss = 0.f;
#pragma unroll
        for (int j = 0; j < 8; ++j) { const u32x2 av = a[lane + 64 * j], bv = b[lane + 64 * j]; f32x4 xv = xr[lane + 64 * j];
            xv[0] += w0 * bf_lo(av.x) + w1 * bf_lo(bv.x); xv[1] += w0 * bf_hi(av.x) + w1 * bf_hi(bv.x);
            xv[2] += w0 * bf_lo(av.y) + w1 * bf_lo(bv.y); xv[3] += w0 * bf_hi(av.y) + w1 * bf_hi(bv.y);
            v[j] = xv; ss += (xv[0] * xv[0] + xv[1] * xv[1]) + (xv[2] * xv[2] + xv[3] * xv[3]); }
        const float rstd = 1.0f / sqrtf(wave_sum(ss) * (1.0f / D) + RMS_EPS);
        if (MODE == 0) {
            unsigned* orow = (unsigned*)((unsigned char*)hn + (size_t)t * D);
#pragma unroll
            for (int j = 0; j < 8; ++j) { xr[lane + 64 * j] = v[j]; const f32x4 y = v[j] * rstd * g4[j]; orow[lane + 64 * j] = cvt4_fp8(y[0], y[1], y[2], y[3]); }
        } else {
#pragma unroll
            for (int j = 0; j < 8; ++j) xr[lane + 64 * j] = v[j] * rstd * g4[j];
        }
    }
}

__device__ __forceinline__ void phase_subln(Frame& F, const bf16_t* o1, const bf16_t* o2, const float* lq1, const float* lk1, const float* lq2, const float* lk2, const float* sg, bf16_t* y) {
    const int gw = F.vcu * NWAVES + F.wave, NGW = F.G * NWAVES, lane = F.lane;
    const float d1 = wave_sum(lq1[lane] * lk1[lane] + lq1[lane + 64] * lk1[lane + 64]);
    const float d2 = wave_sum(lq2[lane] * lk2[lane] + lq2[lane + 64] * lk2[lane + 64]);
    const float lam = __expf(d1) - __expf(d2) + LAMBDA_INIT;
    const f32x4 g = ((const f32x4*)sg)[lane] * (1.0f - LAMBDA_INIT);
    for (int tok = gw; tok < T; tok += NGW) {
        u32x2 a[8], b[8];
#pragma unroll
        for (int h = 0; h < 8; ++h) { a[h] = *(const u32x2*)(o1 + (size_t)tok * D + h * 256 + 4 * lane); b[h] = *(const u32x2*)(o2 + (size_t)tok * D + h * 256 + 4 * lane); }
        f32x4 d[8]; float ss[8];
#pragma unroll
        for (int h = 0; h < 8; ++h) { d[h][0] = bf_lo(a[h].x) - lam * bf_lo(b[h].x); d[h][1] = bf_hi(a[h].x) - lam * bf_hi(b[h].x); d[h][2] = bf_lo(a[h].y) - lam * bf_lo(b[h].y); d[h][3] = bf_hi(a[h].y) - lam * bf_hi(b[h].y);
            ss[h] = (d[h][0] * d[h][0] + d[h][1] * d[h][1]) + (d[h][2] * d[h][2] + d[h][3] * d[h][3]); }
#pragma unroll
        for (int of = 1; of < 64; of <<= 1) {
#pragma unroll
            for (int h = 0; h < 8; ++h) ss[h] += __shfl_xor(ss[h], of); }
#pragma unroll
        for (int h = 0; h < 8; ++h) { const float rstd = 1.0f / sqrtf(ss[h] * (1.0f / 256.0f) + RMS_EPS); const f32x4 yv = d[h] * rstd * g;
            *(unsigned*)((unsigned char*)y + (size_t)tok * D + h * 256 + 4 * lane) = cvt4_fp8(yv[0], yv[1], yv[2], yv[3]); }
    }
}

namespace att {
constexpr int SHM_K = 64 * 128, SHM_V = 256 * 64;
constexpr int V_OFF = 0, K_OFF = 3 * SHM_V, SCR_OFF = RING_BYTES + 4096;
constexpr float SCALE = 0.08838834764831845f;
constexpr float C2 = 1.4426950408889634f * SCALE;
constexpr float THR = 8.f;
__device__ __forceinline__ int crow(int r, int hi) { return (r & 3) + 8 * (r >> 2) + 4 * hi; }

__device__ __forceinline__ void qkt(f32x16& p0, f32x16& p1, const LAS unsigned char* kslot, int r32, int hi, const v8i32 (&qf)[2]) {
#pragma unroll
    for (int s = 0; s < 2; ++s) { const int c0 = 4 * s + 2 * hi, sw = r32 & 7;
        const LAS unsigned char* ra = kslot + r32 * 128;
        const v4i32 a0 = *(const LAS v4i32*)(ra + ((c0 ^ sw) << 4)), a1 = *(const LAS v4i32*)(ra + (((c0 + 1) ^ sw) << 4));
        const v4i32 b0 = *(const LAS v4i32*)(ra + 32 * 128 + ((c0 ^ sw) << 4)), b1 = *(const LAS v4i32*)(ra + 32 * 128 + (((c0 + 1) ^ sw) << 4));
        const v8i32 ka = __builtin_shufflevector(a0, a1, 0, 1, 2, 3, 4, 5, 6, 7), kb = __builtin_shufflevector(b0, b1, 0, 1, 2, 3, 4, 5, 6, 7);
        p0 = __builtin_amdgcn_mfma_scale_f32_32x32x64_f8f6f4(ka, qf[s], p0, 0, 0, 0, 0x7f7f7f7f, 0, 0x7f7f7f7f);
        p1 = __builtin_amdgcn_mfma_scale_f32_32x32x64_f8f6f4(kb, qf[s], p1, 0, 0, 0, 0x7f7f7f7f, 0, 0x7f7f7f7f); }
}
__device__ __forceinline__ void pv_tile(f32x16 (&o)[8], const LAS unsigned char* va, const v8i32& pa, int scl) {
    const LAS unsigned char* vb = (const LAS unsigned char*)((unsigned)(uintptr_t)va ^ 16u);
#define PV_RD(S, d0) do { S[0] = *(const LAS v4i32*)(va + (d0) * 2048); S[1] = *(const LAS v4i32*)(vb + (d0) * 2048); } while (0)
#define PV_MM(S, d0) do { __builtin_amdgcn_sched_barrier(0); \
        o[d0] = __builtin_amdgcn_mfma_scale_f32_32x32x64_f8f6f4(pa, __builtin_shufflevector(S[0], S[1], 0, 1, 2, 3, 4, 5, 6, 7), o[d0], 0, 0, 0, scl, 0, 0x7f7f7f7f); __builtin_amdgcn_sched_barrier(0); } while (0)
    v4i32 f0[2], f1[2], f2[2];
    PV_RD(f0, 0); PV_RD(f1, 1);
    PV_RD(f2, 2); PV_MM(f0, 0); PV_RD(f0, 3); PV_MM(f1, 1); PV_RD(f1, 4); PV_MM(f2, 2); PV_RD(f2, 5); PV_MM(f0, 3); PV_RD(f0, 6); PV_MM(f1, 4); PV_RD(f1, 7); PV_MM(f2, 5);
    PV_MM(f0, 6); PV_MM(f1, 7);
#undef PV_MM
#undef PV_RD
}

__device__ __forceinline__ void stage_offsets(int tid, unsigned& koff, unsigned (&voff)[2]) {
    { const int P = tid * 16, row = P >> 7, ch = ((P & 127) >> 4) ^ (row & 7); koff = (unsigned)(row * 128 + ch * 16); }
#pragma unroll
    for (int i = 0; i < 2; ++i) { const int P = tid * 16 + i * 8192, row = P >> 6, ch = ((P & 63) >> 4) ^ ((row >> 2) & 3); voff[i] = (unsigned)(row * 64 + ch * 16); }
}
__device__ __forceinline__ const char* uniform_ptr(const void* p) {
    const unsigned long long v = (unsigned long long)p;
    const unsigned lo = __builtin_amdgcn_readfirstlane((unsigned)v), hi = __builtin_amdgcn_readfirstlane((unsigned)(v >> 32));
    return (const char*)(((unsigned long long)hi << 32) | lo);
}
__device__ __forceinline__ void stage_tile(LAS unsigned char* lds, int kslot, int vslot, const bf16_t* kj_, const bf16_t* vj_, int tid_, int wid) {
    const char* kj = uniform_ptr(kj_); const char* vj = uniform_ptr(vj_);
    int tid = tid_; asm volatile("" : "+v"(tid));
    unsigned koff, voff[2]; stage_offsets(tid, koff, voff);
    LAS unsigned char* kd = lds + K_OFF + kslot * SHM_K + wid * 1024; LAS unsigned char* vd = lds + V_OFF + vslot * SHM_V + wid * 1024;
    __builtin_amdgcn_global_load_lds((const unsigned*)(kj + koff), (LAS unsigned*)kd, 16, 0, 0);
#pragma unroll
    for (int i = 0; i < 2; ++i) __builtin_amdgcn_global_load_lds((const unsigned*)(vj + voff[i]), (LAS unsigned*)(vd + i * 8192), 16, 0, 0);
}

__device__ __forceinline__ void qk_softmax(const LAS unsigned char* kslot, int r32, int hi, LAS float* al_l, const v8i32 (&qf)[2], f32x16 (&o)[8], v8i32& pa, int& pscl,
                                           float& m_reg, float& l_reg, float rawu, float sl2, bool diag, int qi) {
    f32x16 p0, p1;
#pragma unroll
    for (int r = 0; r < 16; ++r) { p0[r] = 0.f; p1[r] = 0.f; }
    qkt(p0, p1, kslot, r32, hi, qf);
#pragma unroll
    for (int r = 0; r < 16; ++r) { const float cr = (float)((r & 3) + 8 * (r >> 2)); p0[r] = fmaf(cr, rawu, p0[r]); p1[r] = fmaf(cr, rawu, p1[r]); }
    if (diag) {
        const float k2raw = 2.f * rawu;
        int qi_ = qi - 4 * hi; asm volatile("" : "+v"(qi_));
#pragma unroll
        for (int r = 0; r < 16; ++r) { const int c = (r & 3) + 8 * (r >> 2); const int d0_ = c - qi_, d1_ = c + 32 - qi_;
            p0[r] -= k2raw * (float)(d0_ > 0 ? d0_ : 0); p1[r] -= k2raw * (float)(d1_ > 0 ? d1_ : 0); }
    }
    const float lane_raw = rawu * (float)(4 * hi), d32raw = 32.f * rawu;
    float pm0 = p0[0], pm1 = p1[0];
#pragma unroll
    for (int r = 1; r < 16; ++r) { pm0 = fmaxf(pm0, p0[r]); pm1 = fmaxf(pm1, p1[r]); }
    float pmax = fmaxf(pm0, pm1 + d32raw) + lane_raw;
    { auto rr = __builtin_amdgcn_permlane32_swap(__float_as_uint(pmax), __float_as_uint(pmax), false, false);
      pmax = fmaxf(__uint_as_float(rr[0]), __uint_as_float(rr[1])); }
    float mn, alpha;
    if (__all((pmax - m_reg) * SCALE <= THR)) { mn = m_reg; alpha = 1.f; }
    else { mn = fmaxf(m_reg, pmax); alpha = __builtin_amdgcn_exp2f((m_reg - mn) * C2); m_reg = mn; }
    const float ef = fminf(floorf(8.75f - (pmax - mn) * C2), 60.f);
    pscl = 127 - (int)ef;
    const float mnL0 = (lane_raw - mn) * C2 + ef, mnL1 = mnL0 + 32.f * sl2;
#pragma unroll
    for (int r = 0; r < 16; ++r) { p0[r] = __builtin_amdgcn_exp2f(fmaf(p0[r], C2, mnL0)); p1[r] = __builtin_amdgcn_exp2f(fmaf(p1[r], C2, mnL1)); }
    if (__any(alpha < 1.f)) {
        if (hi == 0) al_l[r32] = alpha;
        LDS_WAIT();
#pragma unroll
        for (int r = 0; r < 16; ++r) { const float a = al_l[crow(r, hi)];
#pragma unroll
            for (int d = 0; d < 8; ++d) o[d][r] *= a; }
    }
    float ps = 0.f;
#pragma unroll
    for (int r = 0; r < 16; ++r) ps += p0[r] + p1[r];
    { auto rr = __builtin_amdgcn_permlane32_swap(__float_as_uint(ps), __float_as_uint(ps), false, false);
      ps = __uint_as_float(rr[0]) + __uint_as_float(rr[1]); }
    l_reg = l_reg * alpha + ps * __builtin_amdgcn_exp2f(-ef);
#pragma unroll
    for (int g = 0; g < 4; ++g) {
        pa[g] = __builtin_amdgcn_cvt_pk_fp8_f32(p0[4 * g + 2], p0[4 * g + 3], __builtin_amdgcn_cvt_pk_fp8_f32(p0[4 * g], p0[4 * g + 1], (int)__float_as_uint(p0[4 * g]), false), true);
        pa[4 + g] = __builtin_amdgcn_cvt_pk_fp8_f32(p1[4 * g + 2], p1[4 * g + 3], __builtin_amdgcn_cvt_pk_fp8_f32(p1[4 * g], p1[4 * g + 1], (int)__float_as_uint(p1[4 * g]), false), true); }
}

__device__ __forceinline__ void norms_phase(Frame& F, const bf16_t* proj, float* nrm) {
    const int gw = F.vcu * NWAVES + F.wave, NGW = F.G * NWAVES, lane = F.lane;
    for (int idx = gw; idx < 2 * 32 * 256; idx += NGW) {
        const int tensor = idx >> 13, stream = (idx >> 8) & 31, grp = idx & 255;
        const u32x4* rp = (const u32x4*)((const unsigned char*)proj + (tensor ? DK0 : 0) + ((size_t)stream * SEQ + grp * 64 + lane) * 128);
        float ss = 0.f;
#pragma unroll
        for (int q = 0; q < 8; ++q) { const u32x4 v = rp[q];
#pragma unroll
            for (int e = 0; e < 4; ++e) { const float a0 = __builtin_amdgcn_cvt_f32_fp8((int)v[e], 0), a1 = __builtin_amdgcn_cvt_f32_fp8((int)v[e], 1), a2 = __builtin_amdgcn_cvt_f32_fp8((int)v[e], 2), a3 = __builtin_amdgcn_cvt_f32_fp8((int)v[e], 3);
                ss += (a0 * a0 + a1 * a1) + (a2 * a2 + a3 * a3); } }
        float n = sqrtf(ss) * 1.001f;
#pragma unroll
        for (int o = 1; o < 64; o <<= 1) n = fmaxf(n, __shfl_xor(n, o));
        if (lane == 0) nrm[idx] = n;
    }
}

__device__ __forceinline__ void attn_item(LAS unsigned char* lds, const bf16_t* proj, const float* nrm, bf16_t* oout, int b, int h, int sub, int qb, int tid, int wid, int lane) {
    const int r32 = lane & 31, hi = lane >> 5;
    const float slope = __builtin_amdgcn_exp2f(-(float)(h + 1));
    const float sl2 = slope * 1.4426950408889634f, rawu = sl2 / C2;
    LAS float* ws = (LAS float*)(lds + SCR_OFF) + wid * 64; LAS float* li_l = ws; LAS float* al_l = ws + 32;
    const size_t tokq = (size_t)b * SEQ + (size_t)qb * 256 + wid * 32;
    const bf16_t* kbase = (const bf16_t*)((const unsigned char*)proj + DK0 + dq_off(b, 0, h, sub));
    const bf16_t* vbase = (const bf16_t*)((const unsigned char*)proj + pg8::vt_off(b, h, 0));
    int j_lo;
    { const int stream = (b * 8 + h) * 2 + sub; const float* qn = nrm + stream * 256; const float* kn = nrm + 8192 + stream * 256;
      const float Qn = fmaxf(fmaxf(qn[4 * qb], qn[4 * qb + 1]), fmaxf(qn[4 * qb + 2], qn[4 * qb + 3]));
      const float Kd = fmaxf(fmaxf(kn[4 * qb], kn[4 * qb + 1]), fmaxf(kn[4 * qb + 2], kn[4 * qb + 3]));
      int cand = 4 * qb;
      for (int jj = lane; jj < 4 * qb; jj += 64) { const float dmin = (float)(256 * qb - (64 * jj + 63)); const bool skip = slope * dmin > 110.f + SCALE * Qn * (kn[jj] + Kd); if (!skip) cand = cand < jj ? cand : jj; }
#pragma unroll
      for (int o = 1; o < 64; o <<= 1) { const int v = __shfl_xor(cand, o); cand = v < cand ? v : cand; }
      j_lo = __builtin_amdgcn_readfirstlane(cand); }
    v8i32 qf[2];
    { const unsigned char* qrow = (const unsigned char*)proj + dq_off(b, qb * 256 + wid * 32 + r32, h, sub) + 32 * hi;
#pragma unroll
      for (int s = 0; s < 2; ++s) { const v4i32 x0 = *(const v4i32*)(qrow + 64 * s), x1 = *(const v4i32*)(qrow + 64 * s + 16); qf[s] = __builtin_shufflevector(x0, x1, 0, 1, 2, 3, 4, 5, 6, 7); } }
    const float sh64 = 64.f * rawu;
    const int qi = 32 * (wid & 1) + r32;
    const LAS unsigned char* vb0 = lds + V_OFF + r32 * 64 + (((2 * hi) ^ ((r32 >> 2) & 3)) << 4);
    float m_reg = -1e30f, l_reg = 0.f;
    f32x16 o[8];
#pragma unroll
    for (int d = 0; d < 8; ++d)
#pragma unroll
        for (int r = 0; r < 16; ++r) o[d][r] = 0.f;
    const int NT = 4 * qb + 4, myNT = 4 * qb + (wid >> 1) + 1;
    constexpr size_t KSTEP = 64 * 128 / 2, VSTEP = 256 * 64 / 2;
    const bool late = wid >= 4;
    stage_tile(lds, j_lo & 1, j_lo % 3, kbase + (size_t)j_lo * KSTEP, vbase + (size_t)j_lo * VSTEP, tid, wid);
    VM_WAIT(); WG_BAR();
    if (!late) {
        int vs = j_lo % 3;
        for (int j = j_lo; j < NT; ++j) {
            const int vsn = vs == 2 ? 0 : vs + 1;
            if (j + 1 < NT) stage_tile(lds, (j + 1) & 1, vsn, kbase + (size_t)(j + 1) * KSTEP, vbase + (size_t)(j + 1) * VSTEP, tid, wid);
            if (j < myNT) { if (j > j_lo) m_reg -= sh64;
                v8i32 pa; int pscl;
                qk_softmax(lds + K_OFF + (j & 1) * SHM_K, r32, hi, al_l, qf, o, pa, pscl, m_reg, l_reg, rawu, sl2, j == myNT - 1, qi);
                pv_tile(o, vb0 + vs * SHM_V, pa, pscl); }
            VM_WAIT(); WG_BAR();
            vs = vsn;
        }
    } else {
        v8i32 pa; int pscl = 127;
#pragma unroll
        for (int g = 0; g < 8; ++g) pa[g] = 0;
        int vs = j_lo % 3, vsp = vs;
        for (int j = j_lo; j < NT; ++j) {
            const int vsn = vs == 2 ? 0 : vs + 1;
            if (j + 1 < NT) stage_tile(lds, (j + 1) & 1, vsn, kbase + (size_t)(j + 1) * KSTEP, vbase + (size_t)(j + 1) * VSTEP, tid, wid);
            if (j > j_lo && j - 1 < myNT) pv_tile(o, vb0 + vsp * SHM_V, pa, pscl);
            if (j < myNT) { if (j > j_lo) m_reg -= sh64;
                qk_softmax(lds + K_OFF + (j & 1) * SHM_K, r32, hi, al_l, qf, o, pa, pscl, m_reg, l_reg, rawu, sl2, j == myNT - 1, qi); }
            VM_WAIT(); WG_BAR();
            vsp = vs; vs = vsn;
        }
        if (myNT == NT) pv_tile(o, vb0 + vsp * SHM_V, pa, pscl);
    }
    if (hi == 0) li_l[r32] = l_reg;
    LDS_WAIT();
    char* Ow = (char*)(oout + tokq * D + h * 256);
    const unsigned lofs = (unsigned)(hi * 4 * D + r32) * 2u;
#pragma unroll
    for (int r = 0; r < 16; ++r) { const float rl = __builtin_amdgcn_rcpf(li_l[crow(r, hi)]);
#pragma unroll
        for (int d0 = 0; d0 < 8; ++d0) { const float v = o[d0][r] * rl; const float vn = __shfl_xor(v, 1);
            if ((r32 & 1) == 0) *(unsigned*)(Ow + (lofs + (unsigned)((((r & 3) + 8 * (r >> 2)) * D + d0 * 32) * 2))) = cvt_pk_bf16(v, vn); } }
    WG_BAR();
}

struct TailConv { const float* wg; const float* wu; const float* wd; bf16_t* gu; bf16_t* dt; };
__device__ __forceinline__ void attn_phase(Frame& F, const bf16_t* proj, const float* nrm, unsigned* queue, bf16_t* o1, bf16_t* o2, const TailConv tc) {
    LAS int* qw = (LAS int*)(F.lds + SCR_OFF + 8 * 256);
    for (;;) {
        if (F.tid == 0) *qw = (int)__hip_atomic_fetch_add(queue, 1u, __ATOMIC_RELAXED, __HIP_MEMORY_SCOPE_AGENT);
        WG_BAR();
        const int I = __builtin_amdgcn_readfirstlane(*qw);
        if (I >= 2048 + 512) break;
        if (I >= 2048) { conv_moe(F, tc.wg, tc.wu, tc.wd, tc.gu, tc.dt, I - 2048, 512); WG_BAR(); continue; }
        const int qb = 63 - (I >> 5), r = I & 31, h = 7 - (r >> 2), b = (r >> 1) & 1, sub = r & 1;
        attn_item(F.lds, proj, nrm, sub ? o2 : o1, b, h, sub, qb, F.tid, F.wave, F.lane);
    }
}
}

__device__ __forceinline__ const void* karg(int i) { int j = i; asm volatile("" : "+s"(j)); return ((const void* const __attribute__((address_space(4)))*)__builtin_amdgcn_kernarg_segment_ptr())[j]; }
#if defined(__HIP_DEVICE_COMPILE__)
#define NO_PK_F32 __attribute__((target("no-packed-fp32-ops")))
#else
#define NO_PK_F32
#endif
__global__ void __launch_bounds__(NWAVES * 64, 2) NO_PK_F32 hybrid_fwd(Args args) {
    extern __shared__ __attribute__((aligned(16))) unsigned char lds_raw[];
    Frame F;
    F.lds = (LAS unsigned char*)lds_raw;
    F.tid = threadIdx.x; F.lane = F.tid & 63; F.wave = __builtin_amdgcn_readfirstlane(F.tid >> 6);
    F.G = gridDim.x; { const int bx = blockIdx.x; F.vcu = (F.G % 8 == 0) ? (bx % 8) * (F.G / 8) + bx / 8 : bx; }
#define ws ((unsigned char*)karg(22))
#define ctl ((unsigned*)(ws + WS_CTL))
    for (int u = F.tid; u < (LDS_BYTES - LDSCTL_OFF) / 4; u += NWAVES * 64) ((LAS unsigned*)(F.lds + LDSCTL_OFF))[u] = 0u;
    SYNCTHREADS();
    ((LAS int*)(F.lds + TIDS_OFF))[F.tid] = F.tid;
    SYNCTHREADS();
    volatile LAS unsigned* MISC = (volatile LAS unsigned*)(F.lds + MISC_OFF);
    XcdBarrier bar = xcd_barrier_post(ctl + CW_BAR, MISC + 8);
#define GRID_BAR() do { XcdBarrier bb_ = bar; unsigned x_ = bar.x; unsigned long long bp_ = (unsigned long long)bar.bar; asm volatile("" : "+s"(x_), "+s"(bp_)); bb_.x = x_; bb_.bar = (unsigned*)bp_; xcd_barrier(bb_, TID_RELOAD() == 0); } while (0)
#define TID_RELOAD() (F.wave * 64 + lane_id_volatile())
#ifdef ONLY_PHASE
#define PHON(n) ((n) == ONLY_PHASE)
#else
#define PHON(n) 1
#endif

#define x_in ((const float*)(karg(0)))
#define norm_mix ((const float*)(karg(1)))
#define norm_ffn ((const float*)(karg(2)))
#define gla_w_in ((const float*)(karg(3)))
#define gla_wgu ((const float*)(karg(4)))
#define gla_bg ((const float*)(karg(5)))
#define gla_norm ((const float*)(karg(6)))
#define gla_w_out ((const float*)(karg(7)))
#define diff_w_in ((const float*)(karg(8)))
#define lq1 ((const float*)(karg(9)))
#define lk1 ((const float*)(karg(10)))
#define lq2 ((const float*)(karg(11)))
#define lk2 ((const float*)(karg(12)))
#define diff_subln ((const float*)(karg(13)))
#define diff_w_out ((const float*)(karg(14)))
#define moe_wgrp ((const float*)(karg(15)))
#define moe_wexp ((const float*)(karg(16)))
#define moe_wg ((const float*)(karg(17)))
#define moe_wu ((const float*)(karg(18)))
#define moe_wd ((const float*)(karg(19)))
#define final_norm ((const float*)(karg(20)))
#define xres ((float*)(karg(21)))
#define gz ((float*)((float*)(ws + WS_GZ)))
#define tok_e ((int*)((int*)(ws + WS_TOKE)))
#define tok_p ((int*)((int*)(ws + WS_TOKP)))
#define tok_w ((float*)((float*)(ws + WS_TOKW)))
#define slot_of ((int*)((int*)(ws + WS_SLOT)))
#define slot_tok ((int*)(ws + WS_STOK))
#define adec ((float*)((float*)(ws + WS_ADEC)))
#define pcum ((float*)((float*)(ws + WS_PCUM)))
#define sfin ((bf16_t*)((bf16_t*)(ws + WS_SFIN)))
#define wp_gz ((float*)((float*)(ws + WS_WPGZ)))
#define wp_r0 ((float*)((float*)(ws + WS_WPR0)))
#define wp_r1 ((float*)((float*)(ws + WS_WPR1)))
#define wgi ((bf16_t*)((bf16_t*)(ws + WS_WGI)))
#define wgo ((bf16_t*)((bf16_t*)(ws + WS_WGO)))
#define wdi ((bf16_t*)((bf16_t*)(ws + WS_WDI)))
#define wdo ((bf16_t*)((bf16_t*)(ws + WS_WDO)))
#define wmoe_gu ((bf16_t*)((bf16_t*)(ws + WS_WMOE)))
#define wmoe_d ((bf16_t*)((bf16_t*)(ws + WS_WMOE_D)))
#define hn ((bf16_t*)((bf16_t*)(ws + WS_HN)))
#define proj ((bf16_t*)((bf16_t*)(ws + WS_PROJ)))
#define buf1 ((bf16_t*)((bf16_t*)(ws + WS_BUF1)))
#define buf2 ((bf16_t*)((bf16_t*)(ws + WS_BUF2)))
#define ag ((bf16_t*)((bf16_t*)(ws + WS_AG)))
#define ob ((bf16_t*)((bf16_t*)(ws + WS_OB)))
#define hh ((bf16_t*)((bf16_t*)(ws + WS_H)))
    const LAS int* pst = (const LAS int*)(F.lds + TAB_OFF);

    _Pragma("unroll") for (int rep_ = 0; rep_ < (REP_PHASE == 0 ? 2 : 1); ++rep_) if (PHON(0)) { if (rep_) GRID_BAR(); Frame P = F; P.tid = TID_RELOAD(); P.lane = P.tid & 63;
    conv_plain(P, gla_w_in, D, PROJW, GLA_INW, wgi);
    conv_plain(P, gla_w_out, D, D, D, wgo);
    pack_proj(P, wp_gz, 1, norm_mix, gla_w_in, GLA_INW, PROJW, 16, nullptr, 0, 0);
    pack_proj(P, wp_r0, 3, norm_ffn, moe_wgrp, 4, 0, 4, moe_wexp, 32, 32);
    pack_proj(P, wp_r1, 3, norm_ffn + D, moe_wgrp + (size_t)D * 4, 4, 0, 4, moe_wexp + (size_t)D * 32, 32, 32);
    }
    GRID_BAR();
    _Pragma("unroll") for (int rep_ = 0; rep_ < (REP_PHASE == 1 ? 2 : 1); ++rep_) if (PHON(1)) { if (rep_) GRID_BAR(); Frame P = F; P.tid = TID_RELOAD(); P.lane = P.tid & 63;
    phase_norm_gz(P, x_in, norm_mix, wp_gz, hn, gz);
    }
    GRID_BAR();
    _Pragma("unroll") for (int rep_ = 0; rep_ < (REP_PHASE == 2 ? 2 : 1); ++rep_) if (PHON(2)) { if (rep_) GRID_BAR(); Frame P = F; P.tid = TID_RELOAD(); P.lane = P.tid & 63;
    { pg8::Gemm g{hn, wgi, T, PROJW, D}; pg8::StaticOrder S; S.init(T, PROJW, P.G, (int)blockIdx.x); pg8::EpiHeads<0> E{proj};
      pg8::gemm_phase<pg8::EpiHeads<0>, pg8::StaticOrder>(P.lds, g, S, E, P.tid); }
    }
    GRID_BAR();
    _Pragma("unroll") for (int rep_ = 0; rep_ < (REP_PHASE == 3 ? 2 : 1); ++rep_) if (PHON(3)) { if (rep_) GRID_BAR(); Frame P = F; P.tid = TID_RELOAD(); P.lane = P.tid & 63;
    phase_gla_gate(P, gz, gla_wgu, gla_bg, proj, buf1, adec);
    }
    GRID_BAR();
    _Pragma("unroll") for (int rep_ = 0; rep_ < (REP_PHASE == 4 ? 2 : 1); ++rep_) if (PHON(4)) { if (rep_) GRID_BAR(); Frame P = F; P.tid = TID_RELOAD(); P.lane = P.tid & 63;
    if (P.G == 256) { if ((P.vcu & 1) == 0) phase_gla_scan(P, P.vcu >> 1, proj, buf1, adec, buf2, sfin); else { gla_pcum(P, adec, pcum, P.vcu >> 1, 128); conv_moe(P, moe_wg, moe_wu, moe_wd, wmoe_gu, wmoe_d, P.vcu >> 1, 128);
            conv_plain<true>(P, diff_w_in, D, PROJW, PROJW, wdi, P.vcu >> 1, 128); conv_plain<true>(P, diff_w_out, D, D, D, wdo, P.vcu >> 1, 128); } }
    else { for (int it = P.vcu; it < 128; it += P.G) phase_gla_scan(P, it, proj, buf1, adec, buf2, sfin); gla_pcum(P, adec, pcum, P.vcu, P.G); conv_moe(P, moe_wg, moe_wu, moe_wd, wmoe_gu, wmoe_d); conv_plain<true>(P, diff_w_in, D, PROJW, PROJW, wdi); conv_plain<true>(P, diff_w_out, D, D, D, wdo); }
    GRID_BAR();
    phase_gla_qp(P, proj, pcum, hn);
    GRID_BAR();
    { pg8::Gemm g{hn, sfin, 8 * (SEQ / 2), 512, 256}; pg8::FixOrder S; S.init(8 * (SEQ / 2), 512, P.G, (int)blockIdx.x); pg8::EpiAddO E{buf2};
      pg8::gemm_phase<pg8::EpiAddO, pg8::FixOrder>(P.lds, g, S, E, P.tid); }
    }
    GRID_BAR();
    _Pragma("unroll") for (int rep_ = 0; rep_ < (REP_PHASE == 5 ? 2 : 1); ++rep_) if (PHON(5)) { if (rep_) GRID_BAR(); Frame P = F; P.tid = TID_RELOAD(); P.lane = P.tid & 63;
    phase_gla_gnorm(P, buf2, proj, gla_norm, hn);
    }
    GRID_BAR();
    _Pragma("unroll") for (int rep_ = 0; rep_ < (REP_PHASE == 6 ? 2 : 1); ++rep_) if (PHON(6)) { if (rep_) GRID_BAR(); Frame P = F; P.tid = TID_RELOAD(); P.lane = P.tid & 63;
    { pg8::Gemm g{hn, wgo, T, D, D}; pg8::StaticOrder S; S.init(T, D, P.G, (int)blockIdx.x); pg8::EpiResF32 E{x_in, xres, D};
      pg8::gemm_phase<pg8::EpiResF32, pg8::StaticOrder>(P.lds, g, S, E, P.tid); }
    }
    GRID_BAR();
    _Pragma("unroll") for (int rep_ = 0; rep_ < (REP_PHASE == 7 ? 2 : 1); ++rep_) if (PHON(7)) { if (rep_) GRID_BAR(); Frame P = F; P.tid = TID_RELOAD(); P.lane = P.tid & 63;
    phase_norm_route(P, xres, norm_ffn, wp_r0, hn, tok_e, tok_p, tok_w, ctl + CW_CNT0);
    }
    GRID_BAR();
    _Pragma("unroll") for (int rep_ = 0; rep_ < (REP_PHASE == 8 ? 2 : 1); ++rep_) if (PHON(8)) { if (rep_) GRID_BAR(); Frame P = F; P.tid = TID_RELOAD(); P.lane = P.tid & 63;
    moe_tables(P, ctl + CW_CNT0);
    phase_moe_slots(P, tok_e, tok_p, ctl + CW_CNT0, slot_of, slot_tok);
    }
    GRID_BAR();
    _Pragma("unroll") for (int rep_ = 0; rep_ < (REP_PHASE == 9 ? 2 : 1); ++rep_) if (PHON(9)) { if (rep_) GRID_BAR(); Frame P = F; P.tid = TID_RELOAD(); P.lane = P.tid & 63;
    { const int Mr = pst[33] * 256; pg8::Gemm g{hn, wmoe_gu, Mr, 1024, D}; pg8::MoeOrder S; S.init(Mr, 1024, P.G, (int)blockIdx.x); S.te = pst + 36; S.estride = (size_t)1024 * D; S.stok = slot_tok; pg8::EpiSiluMul E{(unsigned char*)hh};
      pg8::gemm_phase<pg8::EpiSiluMul, pg8::MoeOrder, true, true>(P.lds, g, S, E, P.tid); }
    }
    GRID_BAR();
    _Pragma("unroll") for (int rep_ = 0; rep_ < (REP_PHASE == 10 ? 2 : 1); ++rep_) if (PHON(10)) { if (rep_) GRID_BAR(); Frame P = F; P.tid = TID_RELOAD(); P.lane = P.tid & 63;
    { const int Mr = pst[33] * 256; pg8::Gemm g{hh, wmoe_d, Mr, D, DFF}; pg8::MoeOrder S; S.init(Mr, D, P.G, (int)blockIdx.x); S.te = pst + 36; S.estride = (size_t)D * DFF; S.stok = slot_tok; pg8::EpiBf16 E{ob, D};
      pg8::gemm_phase<pg8::EpiBf16, pg8::MoeOrder, false, true>(P.lds, g, S, E, P.tid); }
    }
    GRID_BAR();
    _Pragma("unroll") for (int rep_ = 0; rep_ < (REP_PHASE == 11 ? 2 : 1); ++rep_) if (PHON(11)) { if (rep_) GRID_BAR(); Frame P = F; P.tid = TID_RELOAD(); P.lane = P.tid & 63;
    phase_moe_combine<0>(P, xres, ob, slot_of, tok_w, norm_mix + D, hn);
    }
    GRID_BAR();
    _Pragma("unroll") for (int rep_ = 0; rep_ < (REP_PHASE == 12 ? 2 : 1); ++rep_) if (PHON(12)) { if (rep_) GRID_BAR(); Frame P = F; P.tid = TID_RELOAD(); P.lane = P.tid & 63;
    { pg8::Gemm g{hn, wdi, T, 4096, D}; pg8::StaticOrder S; S.init(T, 4096, P.G, (int)blockIdx.x); pg8::EpiHeads<1> E{proj};
      pg8::gemm_phase<pg8::EpiHeads<1>, pg8::StaticOrder, false, true>(P.lds, g, S, E, P.tid); }
    { pg8::Gemm g{hn, (const bf16_t*)((const unsigned char*)wdi + (size_t)4096 * D), T, 2048, D}; pg8::StaticOrder S; S.init(T, 2048, P.G, (int)blockIdx.x); pg8::EpiVT E{(unsigned char*)proj};
      pg8::gemm_phase<pg8::EpiVT, pg8::StaticOrder, false, true, true>(P.lds, g, S, E, P.tid); }
    GRID_BAR();
    att::norms_phase(P, proj, (float*)(ws + WS_NRM));
    }
    GRID_BAR();
    _Pragma("unroll") for (int rep_ = 0; rep_ < (REP_PHASE == 13 ? 2 : 1); ++rep_) if (PHON(13)) { if (rep_) GRID_BAR(); Frame P = F; P.tid = TID_RELOAD(); P.lane = P.tid & 63;
    att::attn_phase(P, proj, (const float*)(ws + WS_NRM), ctl + CW_QUEUE, buf1, buf2, att::TailConv{moe_wg + (size_t)NEXP * D * DFF, moe_wu + (size_t)NEXP * D * DFF, moe_wd + (size_t)NEXP * DFF * D, (bf16_t*)(ws + WS_WMOE1), (bf16_t*)(ws + WS_WMOE1_D)});
    }
    GRID_BAR();
    _Pragma("unroll") for (int rep_ = 0; rep_ < (REP_PHASE == 14 ? 2 : 1); ++rep_) if (PHON(14)) { if (rep_) GRID_BAR(); Frame P = F; P.tid = TID_RELOAD(); P.lane = P.tid & 63;
    phase_subln(P, buf1, buf2, lq1, lk1, lq2, lk2, diff_subln, hn);
    }
    GRID_BAR();
    _Pragma("unroll") for (int rep_ = 0; rep_ < (REP_PHASE == 15 ? 2 : 1); ++rep_) if (PHON(15)) { if (rep_) GRID_BAR(); Frame P = F; P.tid = TID_RELOAD(); P.lane = P.tid & 63;
    { pg8::Gemm g{hn, wdo, T, D, D}; pg8::StaticOrder S; S.init(T, D, P.G, (int)blockIdx.x); pg8::EpiResF32 E{xres, xres, D};
      pg8::gemm_phase<pg8::EpiResF32, pg8::StaticOrder, false, true>(P.lds, g, S, E, P.tid); }
    }
    GRID_BAR();
    _Pragma("unroll") for (int rep_ = 0; rep_ < (REP_PHASE == 16 ? 2 : 1); ++rep_) if (PHON(16)) { if (rep_) GRID_BAR(); Frame P = F; P.tid = TID_RELOAD(); P.lane = P.tid & 63;
    phase_norm_route(P, xres, norm_ffn + D, wp_r1, hn, tok_e, tok_p, tok_w, ctl + CW_CNT1);
    }
    GRID_BAR();
    _Pragma("unroll") for (int rep_ = 0; rep_ < (REP_PHASE == 17 ? 2 : 1); ++rep_) if (PHON(17)) { if (rep_) GRID_BAR(); Frame P = F; P.tid = TID_RELOAD(); P.lane = P.tid & 63;
    moe_tables(P, ctl + CW_CNT1);
    phase_moe_slots(P, tok_e, tok_p, ctl + CW_CNT1, slot_of, slot_tok);
    }
    GRID_BAR();
    _Pragma("unroll") for (int rep_ = 0; rep_ < (REP_PHASE == 18 ? 2 : 1); ++rep_) if (PHON(18)) { if (rep_) GRID_BAR(); Frame P = F; P.tid = TID_RELOAD(); P.lane = P.tid & 63;
    { const int Mr = pst[33] * 256; pg8::Gemm g{hn, (bf16_t*)(ws + WS_WMOE1), Mr, 1024, D}; pg8::MoeOrder S; S.init(Mr, 1024, P.G, (int)blockIdx.x); S.te = pst + 36; S.estride = (size_t)1024 * D; S.stok = slot_tok; pg8::EpiSiluMul E{(unsigned char*)hh};
      pg8::gemm_phase<pg8::EpiSiluMul, pg8::MoeOrder, true, true>(P.lds, g, S, E, P.tid); }
    }
    GRID_BAR();
    _Pragma("unroll") for (int rep_ = 0; rep_ < (REP_PHASE == 19 ? 2 : 1); ++rep_) if (PHON(19)) { if (rep_) GRID_BAR(); Frame P = F; P.tid = TID_RELOAD(); P.lane = P.tid & 63;
    { const int Mr = pst[33] * 256; pg8::Gemm g{hh, (bf16_t*)(ws + WS_WMOE1_D), Mr, D, DFF}; pg8::MoeOrder S; S.init(Mr, D, P.G, (int)blockIdx.x); S.te = pst + 36; S.estride = (size_t)D * DFF; S.stok = slot_tok; pg8::EpiBf16 E{ob, D};
      pg8::gemm_phase<pg8::EpiBf16, pg8::MoeOrder, false, true>(P.lds, g, S, E, P.tid); }
    }
    GRID_BAR();
    _Pragma("unroll") for (int rep_ = 0; rep_ < (REP_PHASE == 20 ? 2 : 1); ++rep_) if (PHON(20)) { if (rep_) GRID_BAR(); Frame P = F; P.tid = TID_RELOAD(); P.lane = P.tid & 63;
    phase_moe_combine<1>(P, xres, ob, slot_of, tok_w, final_norm, hn);
    }
}

#undef x_in
#undef norm_mix
#undef norm_ffn
#undef gla_w_in
#undef gla_wgu
#undef gla_bg
#undef gla_norm
#undef gla_w_out
#undef diff_w_in
#undef lq1
#undef lk1
#undef lq2
#undef lk2
#undef diff_subln
#undef diff_w_out
#undef moe_wgrp
#undef moe_wexp
#undef moe_wg
#undef moe_wu
#undef moe_wd
#undef final_norm
#undef xres
#undef gz
#undef tok_e
#undef tok_p
#undef tok_w
#undef slot_of
#undef slot_tok
#undef ws
#undef ctl
#undef adec
#undef pcum
#undef sfin
#undef wp_gz
#undef wp_r0
#undef wp_r1
#undef wgi
#undef wgo
#undef wdi
#undef wdo
#undef wmoe_gu
#undef wmoe_d
#undef hn
#undef proj
#undef buf1
#undef buf2
#undef ag
#undef ob
#undef hh

extern "C" void kernel_launch(void* const* d_in, const int* in_sizes, int n_in, void* d_out, int out_size, void* d_ws, size_t ws_size, hipStream_t stream) {
    static int grid = 0;
    if (grid == 0) {
        if (n_in != 21 || out_size != T * D || ws_size < WS_END) { fprintf(stderr, "kernel_launch: unexpected shapes (n_in %d out %d ws %zu)\n", n_in, out_size, ws_size); grid = -1; return; }
        if (hipFuncSetAttribute((const void*)hybrid_fwd, hipFuncAttributeMaxDynamicSharedMemorySize, LDS_BYTES) != hipSuccess) { fprintf(stderr, "kernel_launch: hipFuncSetAttribute failed\n"); grid = -1; return; }
        int dev = 0, cus = 0, per_cu = 0;
        (void)hipGetDevice(&dev); (void)hipDeviceGetAttribute(&cus, hipDeviceAttributeMultiprocessorCount, dev);
        if (hipOccupancyMaxActiveBlocksPerMultiprocessor(&per_cu, (const void*)hybrid_fwd, NWAVES * 64, LDS_BYTES) != hipSuccess || per_cu < 1) fprintf(stderr, "kernel_launch: occupancy query says %d\n", per_cu);
        (void)hipGetLastError();
        grid = cus > 0 ? cus : 256;
    }
    if (grid < 0) return;
    Args a{};
    for (int i = 0; i < 21; ++i) a.in[i] = (const float*)d_in[i];
    a.out = (float*)d_out; a.ws = (unsigned char*)d_ws; a.pad0 = 0; a.pad1 = 0;
    (void)hipMemsetAsync((char*)d_ws + WS_CTL, 0, CTL_ZERO_BYTES, stream);
    hipLaunchKernelGGL(hybrid_fwd, dim3(grid), dim3(NWAVES * 64), LDS_BYTES, stream, a);
}
```

```cpp
#ifndef REP_PHASE
#define REP_PHASE -1
#endif
#include <hip/hip_runtime.h>
#include <cstdio>
#include <cstdint>

#define LAS __attribute__((address_space(3)))
#define GAS __attribute__((address_space(1)))
typedef unsigned short bf16_t;
typedef short bf16x8 __attribute__((ext_vector_type(8)));
typedef short s16x4 __attribute__((ext_vector_type(4)));
typedef float f32x4 __attribute__((ext_vector_type(4)));
typedef float f32x2 __attribute__((ext_vector_type(2)));
typedef float f32x16 __attribute__((ext_vector_type(16)));
typedef unsigned u32x4 __attribute__((ext_vector_type(4)));
typedef unsigned u32x2 __attribute__((ext_vector_type(2)));
typedef int v8i32 __attribute__((ext_vector_type(8)));
typedef int v4i32 __attribute__((ext_vector_type(4)));

constexpr int D = 2048, SEQ = 16384, NBATCH = 2, T = NBATCH * SEQ, CHUNK = 64, NCH = SEQ / CHUNK;
constexpr int GLA_H = 4, GLA_DK = 256, GLA_DV = 512, GLA_DKT = 1024, GLA_INW = 6160, PROJW = 6144;
constexpr int DIFF_H = 8;
constexpr int NEXP = 32, DFF = 512;
constexpr float RMS_EPS = 1e-6f;
constexpr float LAMBDA_INIT = 0.35550906759f;
constexpr int MAX_TILES = 288;

constexpr int L1_EARLY = 16;
constexpr size_t MiB = 1u << 20;
constexpr size_t WS_CTL = 0, CTL_ZERO_BYTES = 1 * MiB;
constexpr size_t WS_GZ = 2 * MiB;
constexpr size_t WS_TOKE = 4 * MiB;
constexpr size_t WS_TOKP = WS_TOKE + 256 * 1024;
constexpr size_t WS_TOKW = WS_TOKP + 256 * 1024;
constexpr size_t WS_SLOT = WS_TOKW + 256 * 1024;
constexpr size_t WS_STOK = 5 * MiB;
constexpr size_t WS_ADEC = 8 * MiB;
constexpr size_t WS_WPGZ = 10 * MiB;
constexpr size_t WS_WPR0 = 10 * MiB + 256 * 1024;
constexpr size_t WS_WPR1 = 11 * MiB;
constexpr size_t WS_NRM = 12 * MiB;
constexpr size_t WS_PCUM = 13 * MiB;
constexpr size_t WS_SFIN = 14 * MiB;
constexpr size_t WS_WGI = 16 * MiB, WS_WGO = 40 * MiB, WS_WDI = 48 * MiB, WS_WDO = 72 * MiB;
constexpr size_t WS_WMOE = 80 * MiB;
constexpr size_t WS_WMOE_D = WS_WMOE + 128 * MiB;
constexpr size_t WS_WMOE1 = WS_WMOE + 64 * MiB, WS_WMOE1_D = WS_WMOE + 160 * MiB;
constexpr size_t WS_HN = 272 * MiB;
constexpr size_t WS_PROJ = 400 * MiB;
constexpr size_t WS_BUF1 = 784 * MiB;
constexpr size_t WS_BUF2 = 912 * MiB;
constexpr size_t WS_XRES = 528 * MiB;
constexpr size_t WS_AG = 400 * MiB;
constexpr size_t WS_OB = 688 * MiB;
constexpr size_t WS_H = 976 * MiB;
constexpr size_t WS_END = 1048 * MiB;
constexpr int CW_BAR = 4096;
constexpr int CW_QUEUE = 8192;
constexpr int CW_CNT0 = 16384, CW_CNT1 = 16384 + 32 * 64;


constexpr size_t GK0 = (size_t)T * 1024, GV0 = (size_t)T * 2048, GR0 = (size_t)T * 4096;
constexpr size_t DK0 = (size_t)T * 2048, DV0 = (size_t)T * 4096;
__host__ __device__ __forceinline__ size_t gq_off(int b, int t, int h) { return ((size_t)(b * 4 + h) * SEQ + t) * 256; }
__host__ __device__ __forceinline__ size_t gv_off(int b, int t, int h) { return GV0 + ((size_t)(b * 4 + h) * SEQ + t) * 512; }
__host__ __device__ __forceinline__ size_t dq_off(int b, int t, int h, int sub) { return ((size_t)((b * 8 + h) * 2 + sub) * SEQ + t) * 128; }
__host__ __device__ __forceinline__ size_t dv_off(int b, int t, int h) { return DV0 + ((size_t)(b * 8 + h) * SEQ + t) * 256; }

constexpr int RING_BYTES = 131072;
constexpr int LDSCTL_OFF = RING_BYTES;
constexpr int MISC_OFF = LDSCTL_OFF + 320;
constexpr int TIDS_OFF = LDSCTL_OFF + 8192;
constexpr int TAB_OFF = LDSCTL_OFF + 1024;
constexpr int LDS_BYTES = 147456;
constexpr int NWAVES = 8;

typedef __bf16 bf16x2_t __attribute__((ext_vector_type(2)));
__device__ __forceinline__ unsigned cvt_pk_bf16(float lo, float hi) { const f32x2 v = {lo, hi}; return __builtin_bit_cast(unsigned, __builtin_convertvector(v, bf16x2_t)); }
__device__ __forceinline__ unsigned cvt4_fp8(float a, float b, float c, float d) { int v = __builtin_amdgcn_cvt_pk_fp8_f32(a, b, 0, false); return (unsigned)__builtin_amdgcn_cvt_pk_fp8_f32(c, d, v, true); }
constexpr float W8_SCALE = 64.f;
__device__ __forceinline__ float bf_lo(unsigned w) { return __uint_as_float(w << 16); }
__device__ __forceinline__ float bf_hi(unsigned w) { return __uint_as_float(w & 0xffff0000u); }
__device__ __forceinline__ f32x4 bf4_expand(u32x2 w) { return (f32x4){bf_lo(w.x), bf_hi(w.x), bf_lo(w.y), bf_hi(w.y)}; }
template <bool B16> struct XRow { typedef f32x4 T; static __device__ __forceinline__ f32x4 get(const f32x4& v) { return v; } };
template <> struct XRow<true> { typedef u32x2 T; static __device__ __forceinline__ f32x4 get(const u32x2& v) { return bf4_expand(v); } };
__device__ __forceinline__ float bf2f(bf16_t b) { return __uint_as_float(((unsigned)b) << 16); }
__device__ __forceinline__ float wave_sum(float v) {
#pragma unroll
    for (int o = 1; o < 64; o <<= 1) v += __shfl_xor(v, o);
    return v;
}
__device__ __forceinline__ int lane_id() { return (int)__builtin_amdgcn_mbcnt_hi(~0u, __builtin_amdgcn_mbcnt_lo(~0u, 0u)); }
__device__ __forceinline__ int lane_id_volatile() { int l; asm volatile("v_mbcnt_lo_u32_b32 %0, -1, 0\n\tv_mbcnt_hi_u32_b32 %0, -1, %0" : "=v"(l)); return l; }
__device__ __forceinline__ int opq(int v) { asm volatile("" : "+v"(v)); return v; }
#define LDS_WAIT() asm volatile("s_waitcnt lgkmcnt(0)" ::: "memory")
#define VM_WAIT() asm volatile("s_waitcnt vmcnt(0)" ::: "memory")
#define SYNCTHREADS() do { __builtin_amdgcn_fence(__ATOMIC_RELEASE, "workgroup"); __builtin_amdgcn_s_barrier(); __builtin_amdgcn_fence(__ATOMIC_ACQUIRE, "workgroup"); } while (0)
#define WG_BAR() do { asm volatile("s_waitcnt lgkmcnt(0)" ::: "memory"); __builtin_amdgcn_s_barrier(); asm volatile("" ::: "memory"); } while (0)

namespace pg8 {
constexpr int BM = 256, BK = 64, HALF = 128, HTB = HALF * BK * 2, STAGE_BYTES = 8 * HTB, NXCD = 8, WGM = 8;
__host__ __device__ __forceinline__ int lds_byte(int r, int c) { const int st = (r >> 4) * 2 + (c >> 5), rr = r & 15, cc = c & 31, ob = rr * 64 + cc * 2; return st * 1024 + (ob ^ (((ob >> 9) & 1) << 5)); }
__host__ __device__ __forceinline__ void stage_rc(int b, int& R, int& C) { const int st = b / 1024, sb = b % 1024, swz = sb ^ (((sb >> 9) & 1) << 5); R = (st >> 1) * 16 + swz / 64; C = (st & 1) * 32 + (swz % 64) / 2; }
__host__ __device__ __forceinline__ int perm32(int rho) { const int n = rho >> 4, i = rho & 15; return 8 * (i >> 2) + 4 * n + (i & 3); }

struct Unit { int pm, pn; };
struct Gemm { const bf16_t* A; const bf16_t* Bt; int M, N, K; };

struct StaticOrder {
    int nM, nN, nwg, G, c;
    __device__ __forceinline__ void init(int M, int N, int G_, int c_) { nM = M / BM; nN = N / BM; nwg = nM * nN; G = G_; c = c_; }
    __device__ __forceinline__ bool next(int i, Unit& u) const {
        const long L = (long)i * G + c; if (L >= nwg) return false;
        int wgid = (int)L; { const int q = nwg / NXCD, r = nwg % NXCD, xcd = wgid % NXCD, off = wgid / NXCD; wgid = (xcd < r ? xcd * (q + 1) : r * (q + 1) + (xcd - r) * q) + off; }
        const int nig = WGM * nN, gid = wgid / nig, fm = gid * WGM, gsz = (nM - fm) < WGM ? (nM - fm) : WGM;
        u.pm = fm + ((wgid % nig) % gsz); u.pn = (wgid % nig) / gsz; return true;
    }
    __device__ __forceinline__ size_t bofs(const Unit&) const { return 0; }
};
struct MoeOrder : StaticOrder {
    const LAS int* te; size_t estride; const int* stok;
    __device__ __forceinline__ size_t bofs(const Unit& u) const { return (size_t)te[u.pm] * estride; }
    __device__ __forceinline__ int arow(int pm, int r) const { const int t = stok[pm * BM + r]; return t < 0 ? 0 : t; }
};

struct EpiBf16 {
    static constexpr bool PERM = true;
    bf16_t* O; int ldc;
    __device__ __forceinline__ void operator()(const f32x4 (&acc)[2][2][4][2], const Unit& u, int wr, int wc, int fr, int fq) const {
        const int row0 = u.pm * BM + wr * 64 + fr, col0 = u.pn * BM + wc * 32 + 8 * fq;
#pragma unroll
        for (int ai = 0; ai < 2; ++ai)
#pragma unroll
            for (int m = 0; m < 4; ++m) { bf16_t* rowp = O + (size_t)(row0 + ai * HALF + m * 16) * ldc + col0;
#pragma unroll
                for (int bj = 0; bj < 2; ++bj) { const f32x4 v0 = acc[ai][bj][m][0], v1 = acc[ai][bj][m][1];
                    u32x4 w; w.x = cvt_pk_bf16(v0[0], v0[1]); w.y = cvt_pk_bf16(v0[2], v0[3]); w.z = cvt_pk_bf16(v1[0], v1[1]); w.w = cvt_pk_bf16(v1[2], v1[3]);
                    *(u32x4*)(rowp + bj * HALF) = w; } }
    }
};
struct EpiF8x8 {
    static constexpr bool PERM = true;
    unsigned char* O; int ldc;
    __device__ __forceinline__ void operator()(const f32x4 (&acc)[2][2][4][2], const Unit& u, int wr, int wc, int fr, int fq) const {
        const int row0 = u.pm * BM + wr * 64 + fr, col0 = u.pn * BM + wc * 32 + 8 * fq;
#pragma unroll
        for (int ai = 0; ai < 2; ++ai)
#pragma unroll
            for (int m = 0; m < 4; ++m) { unsigned char* rowp = O + (size_t)(row0 + ai * HALF + m * 16) * ldc + col0;
#pragma unroll
                for (int bj = 0; bj < 2; ++bj) { const f32x4 v0 = acc[ai][bj][m][0] * 8.f, v1 = acc[ai][bj][m][1] * 8.f;
                    u32x2 w; w.x = cvt4_fp8(v0[0], v0[1], v0[2], v0[3]); w.y = cvt4_fp8(v1[0], v1[1], v1[2], v1[3]);
                    *(u32x2*)(rowp + bj * HALF) = w; } }
    }
};
template <int LAYER> struct EpiHeads {
    static constexpr bool PERM = true;
    bf16_t* O; const float* rstd;
    __device__ __forceinline__ void operator()(const f32x4 (&acc)[2][2][4][2], const Unit& u, int wr, int wc, int fr, int fq) const {
        const int pn = u.pn, lc = wc * 32 + 8 * fq;
#pragma unroll
        for (int ai = 0; ai < 2; ++ai)
#pragma unroll
            for (int m = 0; m < 4; ++m) { const int row = u.pm * BM + ai * HALF + wr * 64 + m * 16 + fr, b = row >> 14, t = row & (SEQ - 1);
#pragma unroll
                for (int bj = 0; bj < 2; ++bj) { size_t off;
                    if (LAYER == 0) { if (pn < 4) off = gq_off(b, t, pn) + bj * 128 + lc; else if (pn < 8) off = GK0 + gq_off(b, t, pn - 4) + bj * 128 + lc;
                                      else if (pn < 16) off = gv_off(b, t, (pn - 8) >> 1) + ((pn - 8) & 1) * 256 + bj * 128 + lc; else off = GR0 + (size_t)row * 2048 + (pn - 16) * 256 + bj * 128 + lc; }
                    else { if (pn < 8) off = dq_off(b, t, pn, bj) + lc; else if (pn < 16) off = DK0 + dq_off(b, t, pn - 8, bj) + lc; else off = dv_off(b, t, pn - 16) + bj * 128 + lc; }
                    f32x4 v0 = acc[ai][bj][m][0], v1 = acc[ai][bj][m][1];
                    if (LAYER == 0) { const float rs = rstd[row]; v0 *= rs; v1 *= rs; }
                    if (LAYER == 1 && pn < 16) {
                        u32x2 w8; w8.x = cvt4_fp8(v0[0], v0[1], v0[2], v0[3]); w8.y = cvt4_fp8(v1[0], v1[1], v1[2], v1[3]); *(u32x2*)((unsigned char*)O + off) = w8; continue; }
                    u32x4 w; w.x = cvt_pk_bf16(v0[0], v0[1]); w.y = cvt_pk_bf16(v0[2], v0[3]); w.z = cvt_pk_bf16(v1[0], v1[1]); w.w = cvt_pk_bf16(v1[2], v1[3]);
                    *(u32x4*)(O + off) = w; } }
    }
};
__host__ __device__ __forceinline__ size_t vt_off(int b, int h, int chunk) { return DV0 * 2 + ((size_t)((b * 8 + h) * (SEQ / 64) + chunk)) * 16384; }
struct EpiVT {
    static constexpr bool PERM = false;
    unsigned char* O;
    __device__ __forceinline__ void operator()(const f32x4 (&acc)[2][2][4][2], const Unit& u, int wr, int wc, int fr, int fq) const {
#pragma unroll
        for (int ai = 0; ai < 2; ++ai) { const int row0 = u.pm * BM + ai * HALF + wr * 64;
            unsigned char* tp = O + vt_off(row0 >> 14, u.pn, (row0 & (SEQ - 1)) >> 6) + (size_t)(wc * 32 + fr) * 64 + 32 * (fq & 1) + 4 * (fq >> 1);
#pragma unroll
            for (int m = 0; m < 4; ++m)
#pragma unroll
                for (int bj = 0; bj < 2; ++bj)
#pragma unroll
                    for (int n = 0; n < 2; ++n) { const f32x4 v = acc[ai][bj][m][n];
                        *(unsigned*)(tp + (bj * 128 + n * 16) * 64 + 16 * (m >> 1) + 8 * (m & 1)) = cvt4_fp8(v[0], v[1], v[2], v[3]); } }
    }
};
struct FixOrder : StaticOrder {
    __device__ __forceinline__ size_t bofs(const Unit& u) const { return (size_t)(u.pm >> 5) * (512 * 256 * 2); }
};
struct EpiAddO {
    static constexpr bool PERM = true;
    bf16_t* O;
    __device__ __forceinline__ void operator()(const f32x4 (&acc)[2][2][4][2], const Unit& u, int wr, int wc, int fr, int fq) const {
#pragma unroll
        for (int ai = 0; ai < 2; ++ai)
#pragma unroll
            for (int m = 0; m < 4; ++m) { const int row = u.pm * BM + ai * HALF + wr * 64 + m * 16 + fr, bhh = row >> 13, t = row & 8191;
                bf16_t* rowp = O + ((size_t)(bhh >> 2) * SEQ + SEQ / 2 + t) * D + (bhh & 3) * 512 + u.pn * BM + wc * 32 + 8 * fq;
#pragma unroll
                for (int bj = 0; bj < 2; ++bj) { const u32x4 old = *(const u32x4*)(rowp + bj * HALF); const f32x4 v0 = acc[ai][bj][m][0] * 0.0625f, v1 = acc[ai][bj][m][1] * 0.0625f;
                    u32x4 w; w.x = cvt_pk_bf16(bf_lo(old.x) + v0[0], bf_hi(old.x) + v0[1]); w.y = cvt_pk_bf16(bf_lo(old.y) + v0[2], bf_hi(old.y) + v0[3]);
                    w.z = cvt_pk_bf16(bf_lo(old.z) + v1[0], bf_hi(old.z) + v1[1]); w.w = cvt_pk_bf16(bf_lo(old.w) + v1[2], bf_hi(old.w) + v1[3]);
                    *(u32x4*)(rowp + bj * HALF) = w; } }
    }
};
template <bool BASE16> struct EpiRes16 {
    static constexpr bool PERM = true;
    const void* base; bf16_t* C; int ldc;
    __device__ __forceinline__ void operator()(const f32x4 (&acc)[2][2][4][2], const Unit& u, int wr, int wc, int fr, int fq) const {
        const int row0 = u.pm * BM + wr * 64 + fr, col0 = u.pn * BM + wc * 32 + 8 * fq;
#pragma unroll
        for (int ai = 0; ai < 2; ++ai)
#pragma unroll
            for (int m = 0; m < 4; ++m) { const size_t off = (size_t)(row0 + ai * HALF + m * 16) * ldc + col0;
#pragma unroll
                for (int bj = 0; bj < 2; ++bj) { f32x4 v0 = acc[ai][bj][m][0], v1 = acc[ai][bj][m][1];
                    if constexpr (BASE16) { const u32x4 bs = *(const u32x4*)((const bf16_t*)base + off + bj * HALF);
                        v0 += (f32x4){bf_lo(bs.x), bf_hi(bs.x), bf_lo(bs.y), bf_hi(bs.y)}; v1 += (f32x4){bf_lo(bs.z), bf_hi(bs.z), bf_lo(bs.w), bf_hi(bs.w)}; }
                    else { const f32x4* bp = (const f32x4*)((const float*)base + off + bj * HALF); v0 += bp[0]; v1 += bp[1]; }
                    u32x4 w; w.x = cvt_pk_bf16(v0[0], v0[1]); w.y = cvt_pk_bf16(v0[2], v0[3]); w.z = cvt_pk_bf16(v1[0], v1[1]); w.w = cvt_pk_bf16(v1[2], v1[3]);
                    *(u32x4*)(C + off + bj * HALF) = w; }
                asm volatile("" ::: "memory"); }
    }
};
struct EpiSiluMul {
    static constexpr bool PERM = true;
    unsigned char* Hh;
    __device__ __forceinline__ void operator()(const f32x4 (&acc)[2][2][4][2], const Unit& u, int wr, int wc, int fr, int fq) const {
        const int row0 = u.pm * BM + wr * 64 + fr, col0 = u.pn * HALF + wc * 32 + 8 * fq;
#pragma unroll
        for (int ai = 0; ai < 2; ++ai)
#pragma unroll
            for (int m = 0; m < 4; ++m) { unsigned char* rowp = Hh + (size_t)(row0 + ai * HALF + m * 16) * DFF + col0;
                float hv[8];
#pragma unroll
                for (int n = 0; n < 2; ++n)
#pragma unroll
                    for (int j = 0; j < 4; ++j) { const float g = acc[ai][0][m][n][j], up = acc[ai][1][m][n][j];
                        const float sg = g * __builtin_amdgcn_rcpf(1.0f + __builtin_amdgcn_exp2f(-1.4426950408889634f * g)); hv[n * 4 + j] = sg * up; }
                u32x2 w; w.x = cvt4_fp8(hv[0], hv[1], hv[2], hv[3]); w.y = cvt4_fp8(hv[4], hv[5], hv[6], hv[7]);
                *(u32x2*)rowp = w; }
    }
};

template <class Epi, class Sched, bool GATHER = false, bool FP8 = false, bool NTR = false>
__device__ __forceinline__ void gemm_phase(LAS unsigned char* lds, const Gemm g, const Sched& S, const Epi& E, int tid_in) {
    const int tid = opq(tid_in), wid = __builtin_amdgcn_readfirstlane(tid >> 6), lane = tid & 63, wr = wid >> 2, wc = wid & 3, fr = lane & 15, fq = lane >> 4;
    const int K = g.K, RP = FP8 ? K : 2 * K  , nt = RP / (BK * 2);
    unsigned voffA[2], voffB[2];
#pragma unroll
    for (int i = 0; i < 2; ++i) { int R, C; stage_rc(tid * 16 + i * 8192, R, C); const int Rb = Epi::PERM ? ((R & ~31) + perm32(R & 31)) : R;
        voffA[i] = (unsigned)(R * RP + 2 * C); voffB[i] = (unsigned)(Rb * RP + 2 * C); }
    const unsigned kstep = (unsigned)(BK * 2);
    const unsigned hstep = (unsigned)HALF * (unsigned)RP;
    const size_t tstep = 2 * (size_t)hstep;
    const unsigned ldsw = (unsigned)wid * 1024u;
    const int aoff = lds_byte(wr * 64 + fr, fq * 8), boff = lds_byte(wc * 32 + fr, fq * 8);
    const LAS unsigned char* ldsB = lds + 4 * HTB + boff;
#define PG8_SA(b, h) (((b) * 2 + (h)) * HTB)
#define PG8_SB(b, h) ((4 + (b) * 2 + (h)) * HTB)
#define PG8_STAGE(bufoff, gbase, voff) do { const unsigned long long gv_ = (unsigned long long)(gbase); \
        const unsigned glo_ = (unsigned)__builtin_amdgcn_readfirstlane((unsigned)gv_), ghi_ = (unsigned)__builtin_amdgcn_readfirstlane((unsigned)(gv_ >> 32)); const char* gb_ = (const char*)(((unsigned long long)ghi_ << 32) | (unsigned long long)glo_);     \
        _Pragma("unroll") for (int _i = 0; _i < 2; ++_i) \
        __builtin_amdgcn_global_load_lds((const unsigned*)(gb_ + (voff)[_i]), (LAS unsigned*)(lds + (bufoff) + ldsw + _i * 8192), 16, 0, 0); } while (0)
#define PG8_STAGE_A(bufoff, nx, koff, h) do { if constexpr (GATHER) { unsigned vs_[2]; _Pragma("unroll") for (int _i = 0; _i < 2; ++_i) vs_[_i] = (nx) ? vAn[h][_i] : vAc[h][_i]; \
            PG8_STAGE(bufoff, (const char*)g.A + (koff), vs_); } \
        else { PG8_STAGE(bufoff, ((nx) ? nA : cA) + (koff) + (h) * hstep, voffA); } } while (0)
#define PG8_LD8(off) __builtin_shufflevector(*(const LAS v4i32*)(lds + (off)), *(const LAS v4i32*)(lds + (off) + 1024), 0, 1, 2, 3, 4, 5, 6, 7)
#define PG8_LDA(dst, b, h) do { if constexpr (FP8) { _Pragma("unroll") for (int m = 0; m < 4; ++m) dst##8[m] = PG8_LD8(PG8_SA(b, h) + aoff + m * 2048); } \
        else { _Pragma("unroll") for (int m = 0; m < 4; ++m) _Pragma("unroll") for (int k = 0; k < 2; ++k) dst[m][k] = *(const LAS bf16x8*)(lds + PG8_SA(b, h) + aoff + m * 2048 + k * 1024); } } while (0)
#define PG8_LD8B(off) __builtin_shufflevector(*(const LAS v4i32*)(ldsB + (off)), *(const LAS v4i32*)(ldsB + (off) + 1024), 0, 1, 2, 3, 4, 5, 6, 7)
#define PG8_LDB(dst, b, h) do { if constexpr (FP8) { _Pragma("unroll") for (int n = 0; n < 2; ++n) dst##8[n] = PG8_LD8B(PG8_SA(b, h) + n * 2048); }     \
        else { _Pragma("unroll") for (int n = 0; n < 2; ++n) _Pragma("unroll") for (int k = 0; k < 2; ++k) dst[n][k] = *(const LAS bf16x8*)(lds + PG8_SB(b, h) + boff + n * 2048 + k * 1024); } } while (0)
#define PG8_MMA(ai, bj, At, Bt) do { __builtin_amdgcn_s_setprio(1); if constexpr (FP8) { _Pragma("unroll") for (int m = 0; m < 4; ++m) _Pragma("unroll") for (int n = 0; n < 2; ++n) \
              \
            { if constexpr (NTR) asm volatile("v_mfma_scale_f32_16x16x128_f8f6f4 %0, %1, %2, %0, %3, %3 op_sel:[1,0,0] op_sel_hi:[0,0,0]" : "+v"(acc[ai][bj][m][n]) : "v"(At##8[m]), "v"(Bt##8[n]), "v"(scl8)); \
              else asm volatile("v_mfma_scale_f32_16x16x128_f8f6f4 %0, %1, %2, %0, %3, %3 op_sel:[0,1,0] op_sel_hi:[0,0,0]" : "+v"(acc[ai][bj][m][n]) : "v"(Bt##8[n]), "v"(At##8[m]), "v"(scl8)); } } \
        else { _Pragma("unroll") for (int m = 0; m < 4; ++m) _Pragma("unroll") for (int n = 0; n < 2; ++n) _Pragma("unroll") for (int k = 0; k < 2; ++k) \
            acc[ai][bj][m][n] = __builtin_amdgcn_mfma_f32_16x16x32_bf16(Bt[n][k], At[m][k], acc[ai][bj][m][n], 0, 0, 0); } __builtin_amdgcn_s_setprio(0); } while (0)
#define PG8_WAIT_V(n) asm volatile("s_waitcnt vmcnt(" #n ")" ::: "memory")
#define PG8_WAIT_L(n) asm volatile("s_waitcnt lgkmcnt(" #n ")" ::: "memory")
#define PG8_BAR __builtin_amdgcn_s_barrier()
#define PG8_SCHED __builtin_amdgcn_sched_barrier(0)
#define PG8_ROWOFFS(V, U) do { if constexpr (GATHER) { const int t_ = opq(wid * 64 + lane_id());     \
        _Pragma("unroll") for (int i_ = 0; i_ < 2; ++i_) { int R_, C_; stage_rc(t_ * 16 + i_ * 8192, R_, C_); \
        _Pragma("unroll") for (int h_ = 0; h_ < 2; ++h_) V[h_][i_] = (unsigned)S.arow((U).pm, h_ * HALF + R_) * (unsigned)RP + 2u * (unsigned)C_; } } } while (0)
    Unit cur, nxt; int ui = 0;
    if (!S.next(0, cur)) return;
    f32x4 acc[2][2][4][2];
#pragma unroll
    for (int a = 0; a < 2; ++a)
#pragma unroll
        for (int b = 0; b < 2; ++b)
#pragma unroll
            for (int m = 0; m < 4; ++m)
#pragma unroll
                for (int n = 0; n < 2; ++n) acc[a][b][m][n] = (f32x4){0.f, 0.f, 0.f, 0.f};
    const unsigned scl8 = 0x7f797f79u;
    bf16x8 At[4][2], B0[2][2], B1[2][2]; v8i32 At8[4], B08[2], B18[2];
    unsigned vAc[2][2] = {{0u, 0u}, {0u, 0u}}, vAn[2][2] = {{0u, 0u}, {0u, 0u}};
    const char* cA = (const char*)g.A + (GATHER ? (size_t)0 : (size_t)cur.pm * tstep); const char* nA = cA; const char* cB = (const char*)g.Bt + S.bofs(cur) + (size_t)cur.pn * tstep;
    PG8_ROWOFFS(vAc, cur);
    PG8_STAGE(PG8_SB(0, 0), cB, voffB); PG8_STAGE(PG8_SB(0, 1), cB + hstep, voffB); PG8_STAGE_A(PG8_SA(0, 0), false, 0u, 0); PG8_STAGE_A(PG8_SA(0, 1), false, 0u, 1);
    if (wr == 1) PG8_BAR;
    PG8_WAIT_V(2); PG8_BAR;
    PG8_STAGE(PG8_SB(1, 0), cB + kstep, voffB); PG8_STAGE_A(PG8_SA(1, 0), false, kstep, 0); PG8_STAGE(PG8_SB(1, 1), cB + hstep + kstep, voffB);
    PG8_WAIT_V(6); PG8_BAR;
    for (;;) {
        const bool has_next = S.next(ui + 1, nxt);
        nA = (has_next && !GATHER) ? (const char*)g.A + (size_t)nxt.pm * tstep : cA; const char* nB = has_next ? (const char*)g.Bt + S.bofs(nxt) + (size_t)nxt.pn * tstep : cB;

        for (int t = 0; t < nt; t += 2) {
            const bool last = (t == nt - 2);
            if constexpr (GATHER) { if (last) {
                if (has_next) PG8_ROWOFFS(vAn, nxt); else { _Pragma("unroll") for (int h_ = 0; h_ < 2; ++h_) _Pragma("unroll") for (int i_ = 0; i_ < 2; ++i_) vAn[h_][i_] = vAc[h_][i_]; } } }
            const unsigned k1 = (unsigned)(t + 1) * kstep, k2 = last ? 0u : (unsigned)(t + 2) * kstep, k3 = k2 + kstep;
            const char* b2 = last ? nB : cB + k2; const char* b3 = b2 + kstep;
            PG8_LDB(B0, 0, 0); PG8_LDB(B1, 0, 1); PG8_SCHED; PG8_LDA(At, 0, 0); PG8_STAGE_A(PG8_SA(1, 1), false, k1, 1);
            PG8_WAIT_V(8); PG8_WAIT_L(0); PG8_BAR; PG8_MMA(0, 0, At, B0); PG8_MMA(0, 1, At, B1); PG8_BAR; PG8_SCHED;
            PG8_LDA(At, 0, 1); PG8_STAGE(PG8_SB(0, 0), b2, voffB); PG8_STAGE(PG8_SB(0, 1), b2 + hstep, voffB); PG8_STAGE_A(PG8_SA(0, 0), last, k2, 0);
            PG8_WAIT_V(8); PG8_WAIT_L(0); PG8_BAR; PG8_MMA(1, 0, At, B0); PG8_MMA(1, 1, At, B1); PG8_BAR; PG8_SCHED;
            PG8_LDB(B0, 1, 0); PG8_LDB(B1, 1, 1); PG8_SCHED; PG8_LDA(At, 1, 0); PG8_STAGE_A(PG8_SA(0, 1), last, k2, 1);
            PG8_WAIT_V(8); PG8_WAIT_L(0); PG8_BAR; PG8_MMA(0, 0, At, B0); PG8_MMA(0, 1, At, B1); PG8_BAR; PG8_SCHED;
            PG8_LDA(At, 1, 1); PG8_STAGE(PG8_SB(1, 0), b3, voffB); PG8_STAGE(PG8_SB(1, 1), b3 + hstep, voffB); PG8_STAGE_A(PG8_SA(1, 0), last, k3, 0);
            PG8_WAIT_V(8); PG8_WAIT_L(0); PG8_BAR; PG8_MMA(1, 0, At, B0); PG8_MMA(1, 1, At, B1); PG8_BAR; PG8_SCHED;
        }
        if (wr == 0) PG8_BAR;
        E(acc, cur, wr, wc, fr, fq);
        if (!has_next) break;
#pragma unroll
        for (int a = 0; a < 2; ++a)
#pragma unroll
            for (int b = 0; b < 2; ++b)
#pragma unroll
                for (int m = 0; m < 4; ++m)
#pragma unroll
                    for (int n = 0; n < 2; ++n) acc[a][b][m][n] = (f32x4){0.f, 0.f, 0.f, 0.f};
        cur = nxt; cA = nA; cB = nB; ++ui;
        if constexpr (GATHER) { _Pragma("unroll") for (int h_ = 0; h_ < 2; ++h_) _Pragma("unroll") for (int i_ = 0; i_ < 2; ++i_) vAc[h_][i_] = vAn[h_][i_]; }
        if (wr == 1) PG8_BAR;
    }
    PG8_WAIT_V(0);
    PG8_BAR;
#undef PG8_SA
#undef PG8_SB
#undef PG8_STAGE
#undef PG8_STAGE_A
#undef PG8_ROWOFFS
#undef PG8_LDA
#undef PG8_LDB
#undef PG8_MMA
#undef PG8_LD8
#undef PG8_LD8B
#undef PG8_WAIT_V
#undef PG8_WAIT_L
#undef PG8_BAR
#undef PG8_SCHED
}
}

#define XB_TMO      128
#define XB_XCNT(j)  (256  + 64 * (j))
#define XB_XSUB(j)  (1280 + 64 * (j))
#define XB_XGEN(j)  (2304 + 64 * (j))
#define XB_TOP      3328
#define XB_TOPGEN   3392
#define XCD_BAR_WORDS 3456
#define XB_SPIN_CAP (1u << 18)
__device__ __forceinline__ unsigned xb_ld(unsigned* p)              { return __hip_atomic_load(p, __ATOMIC_RELAXED, __HIP_MEMORY_SCOPE_AGENT); }
__device__ __forceinline__ unsigned xb_add(unsigned* p, unsigned v) { return __hip_atomic_fetch_add(p, v, __ATOMIC_RELAXED, __HIP_MEMORY_SCOPE_AGENT); }
__device__ __forceinline__ unsigned xb_xcc_id() { return (unsigned)__builtin_amdgcn_s_getreg((3 << 11) | 20) & 0xFu; }
#define XB_SPIN(cond, bar) do { unsigned _sp = 0; while (cond) { __builtin_amdgcn_s_sleep(1); \
    if ((++_sp & 255u) == 0u) { if (xb_ld(&(bar)[XB_TMO])) break; if (_sp > XB_SPIN_CAP) { atomicAdd(&(bar)[XB_TMO], 1u); break; } } } } while (0)
struct XcdBarrier { unsigned* bar; unsigned x; volatile LAS unsigned* st; int wave; };
__device__ __forceinline__ XcdBarrier xcd_barrier_post(unsigned* bar, volatile LAS unsigned* st) {
    XcdBarrier b; b.bar = bar; b.x = xb_xcc_id(); b.st = st; b.wave = __builtin_amdgcn_readfirstlane((int)threadIdx.x >> 6);
    if (threadIdx.x == 0) (void)xb_add(&bar[XB_XCNT(b.x)], 1u);
    return b;
}
__device__ __forceinline__ void xcd_barrier_complete(unsigned* bar, unsigned x, unsigned& nloc, unsigned& nx) {
    const unsigned G = gridDim.x * gridDim.y * gridDim.z;
    unsigned sum, cnt, mine, sp = 0u;
    for (;;) {
        sum = 0u; cnt = 0u; mine = 0u;
#pragma unroll
        for (unsigned j = 0; j < 16; ++j) { const unsigned c = xb_ld(&bar[XB_XCNT(j)]); sum += c; cnt += (c > 0u) ? 1u : 0u; mine = (j == x) ? c : mine; }
        if (sum == G) break;
        __builtin_amdgcn_s_sleep(1);
        if ((++sp & 255u) == 0u) { if (xb_ld(&bar[XB_TMO])) break; if (sp > XB_SPIN_CAP) { atomicAdd(&bar[XB_TMO], 1u); break; } }
    }
    nloc = mine > 0u ? mine : 1u; nx = cnt > 0u ? cnt : 1u;
}
__device__ __forceinline__ void xcd_barrier(const XcdBarrier& b, bool leader  ) {
    asm volatile("s_waitcnt vmcnt(0)" ::: "memory");
    SYNCTHREADS();
    if (leader) {
        unsigned* bar = b.bar;
        __builtin_amdgcn_s_waitcnt(0);
        unsigned nloc = b.st[0], nx = b.st[1];
        if (nloc == 0u) { xcd_barrier_complete(bar, b.x, nloc, nx); b.st[0] = nloc; b.st[1] = nx; }
        const unsigned old = xb_add(&bar[XB_XSUB(b.x)], 1u);
        const unsigned gen = old / nloc;
        if (old + 1u == (gen + 1u) * nloc) {
            __builtin_amdgcn_fence(__ATOMIC_RELEASE, "agent");
            asm volatile("s_waitcnt vmcnt(0)" ::: "memory");
            const unsigned og = xb_add(&bar[XB_TOP], 1u);
            const unsigned tg = og / nx;
            if (og + 1u == (tg + 1u) * nx) xb_add(&bar[XB_TOPGEN], 1u);
            else XB_SPIN(xb_ld(&bar[XB_TOPGEN]) == tg, bar);
            __builtin_amdgcn_fence(__ATOMIC_ACQUIRE, "agent");
            xb_add(&bar[XB_XGEN(b.x)], 1u);
            asm volatile("s_waitcnt vmcnt(0)" ::: "memory");
        } else {
            XB_SPIN(xb_ld(&bar[XB_XGEN(b.x)]) == gen, bar);
            __builtin_amdgcn_fence(__ATOMIC_ACQUIRE, "agent");
            asm volatile("s_waitcnt vmcnt(0)" ::: "memory");
        }
    }
    SYNCTHREADS();
}

struct Frame {
    LAS unsigned char* lds;
    int tid, lane, wave, vcu, G;
};
struct Args {
    const float* in[21]; float* out; unsigned char* ws; int pad0, pad1;
};

struct TrItem { const float* src; unsigned char* dst; int ldw, ldk; const float* gk; };
__device__ __forceinline__ void tr_load(const TrItem& t, int lane, float (&tv)[32]) {
    const float* wp_ = t.src + (size_t)(lane >> 5) * t.ldw + (lane & 31);
#pragma unroll
    for (int i = 0; i < 32; ++i) tv[i] = wp_[(size_t)(2 * i) * t.ldw];
}
template <bool FP8>
__device__ __forceinline__ void tr_store(const TrItem& t, const float (&tv)[32], LAS float* scr, int lane) {
#pragma unroll
    for (int i = 0; i < 32; ++i) scr[(2 * i + (lane >> 5)) * 33 + (lane & 31)] = tv[i];
    LDS_WAIT(); asm volatile("" ::: "memory");
    const int c = lane & 7;
#pragma unroll
    for (int j = 0; j < 4; ++j) { const int n = (lane >> 3) + 8 * j; const LAS float* s = scr + (8 * c) * 33 + n;
        if constexpr (FP8) { u32x2 o; o.x = cvt4_fp8(s[0 * 33] * W8_SCALE, s[1 * 33] * W8_SCALE, s[2 * 33] * W8_SCALE, s[3 * 33] * W8_SCALE); o.y = cvt4_fp8(s[4 * 33] * W8_SCALE, s[5 * 33] * W8_SCALE, s[6 * 33] * W8_SCALE, s[7 * 33] * W8_SCALE);
            *(u32x2*)(t.dst + (size_t)n * t.ldk + 8 * c) = o; }
        else { f32x4 ga = {1.f, 1.f, 1.f, 1.f}, gb = ga; if (t.gk) { ga = *(const f32x4*)(t.gk + 8 * c); gb = *(const f32x4*)(t.gk + 8 * c + 4); }
            u32x4 o; o.x = cvt_pk_bf16(s[0 * 33] * ga[0], s[1 * 33] * ga[1]); o.y = cvt_pk_bf16(s[2 * 33] * ga[2], s[3 * 33] * ga[3]); o.z = cvt_pk_bf16(s[4 * 33] * gb[0], s[5 * 33] * gb[1]); o.w = cvt_pk_bf16(s[6 * 33] * gb[2], s[7 * 33] * gb[3]);
            *(u32x4*)(t.dst + ((size_t)n * t.ldk + 8 * c) * 2) = o; } }
    LDS_WAIT(); asm volatile("" ::: "memory");
}
#define TR_PIPELINE(FP8_, DECODE) do { if (gw < nit) { float tv_[32]; TrItem cur_ = DECODE(gw); tr_load(cur_, F.lane, tv_); \
        for (int it = gw; it < nit; it += NGW) { const int itn_ = it + NGW < nit ? it + NGW : it;     \
            float tn_[32]; const TrItem nxt_ = DECODE(itn_); tr_load(nxt_, F.lane, tn_); \
            tr_store<FP8_>(cur_, tv_, scr, F.lane); cur_ = nxt_; \
            _Pragma("unroll") for (int i_ = 0; i_ < 32; ++i_) tv_[i_] = tn_[i_]; } } } while (0)
template <bool FP8 = false>
__device__ __forceinline__ void conv_plain(Frame& F, const float* W, int K, int N, int ldw, bf16_t* WT, int rank = -1, int nrank = 0, const float* gain = nullptr) {
    LAS float* scr = (LAS float*)(F.lds + F.wave * 16384);
    const int gw = (rank < 0 ? F.vcu : rank) * NWAVES + F.wave, NGW = (rank < 0 ? F.G : nrank) * NWAVES, nblk = N / 32, nit = (K / 64) * nblk;
    auto decode = [&](int it) -> TrItem { const int kb = it / nblk, nb = it % nblk;
        return TrItem{W + (size_t)(64 * kb) * ldw + 32 * nb, (unsigned char*)WT + ((size_t)(32 * nb) * K + 64 * kb) * (FP8 ? 1 : 2), ldw, K, gain ? gain + 64 * kb : nullptr}; };
    TR_PIPELINE(FP8, decode);
}
__device__ __forceinline__ void conv_moe(Frame& F, const float* wg, const float* wu, const float* wd, bf16_t* GU, bf16_t* DT, int rank = -1, int nrank = 0, int e0 = 0, int ne = NEXP) {
    LAS float* scr = (LAS float*)(F.lds + F.wave * 16384);
    const int gw = (rank < 0 ? F.vcu : rank) * NWAVES + F.wave, NGW = (rank < 0 ? F.G : nrank) * NWAVES;
    constexpr int PER_E = 1536; const int nit = ne * PER_E;
    auto decode = [&](int it) -> TrItem { const int e = e0 + it / PER_E; int r = it % PER_E;
        if (r < 1024) { const int up = r >> 9; r &= 511; const int kb = r >> 4, nb = r & 15, n0 = 32 * nb;
            const int drow = 256 * (n0 >> 7) + 128 * up + (n0 & 127);
            return TrItem{(up ? wu : wg) + (size_t)e * D * DFF + (size_t)(64 * kb) * DFF + n0, (unsigned char*)GU + (size_t)e * 1024 * D + (size_t)drow * D + 64 * kb, DFF, D, nullptr}; }
        r -= 1024; const int kb = r >> 6, nb = r & 63;
        return TrItem{wd + (size_t)e * DFF * D + (size_t)(64 * kb) * D + 32 * nb, (unsigned char*)DT + (size_t)e * D * DFF + (size_t)(32 * nb) * DFF + 64 * kb, D, DFF, nullptr}; };
    TR_PIPELINE(true, decode);
}
__device__ __forceinline__ void pack_proj(Frame& F, float* Wp, int NT, const float* gain, const float* Wa, int lda, int ca0, int na, const float* Wb, int ldb, int nb) {
    const int total = 128 * NT * 256;
    for (int idx = (F.vcu * NWAVES * 64) + F.tid; idx < total; idx += F.G * NWAVES * 64) {
        const int e = idx & 3, ln = (idx >> 2) & 63, rest = idx >> 8, nt = rest % NT, s = rest / NT;
        const int k = 32 * (s >> 1) + 8 * (ln >> 4) + 4 * (s & 1) + e, col = 16 * nt + (ln & 15);
        float v = 0.f;
        if (col < na) v = Wa[(size_t)k * lda + ca0 + col]; else if (col < na + nb) v = Wb[(size_t)k * ldb + (col - na)];
        Wp[idx] = v * gain[k];
    }
}

__device__ __forceinline__ void pack_proj16(Frame& F, bf16_t* Wp, int NT, const float* gain, const float* Wa, int lda, int ca0, int na, const float* Wb, int ldb, int nb) {
    const int total = 64 * NT * 64 * 8;
    for (int idx = (F.vcu * NWAVES * 64) + F.tid; idx < total; idx += F.G * NWAVES * 64) {
        const int j = idx & 7, ln = (idx >> 3) & 63, rest = idx >> 9, nt = rest % NT, s = rest / NT;
        const int k = 32 * s + 8 * (ln >> 4) + j, col = 16 * nt + (ln & 15);
        float v = 0.f;
        if (col < na) v = Wa[(size_t)k * lda + ca0 + col]; else if (col < na + nb) v = Wb[(size_t)k * ldb + (col - na)];
        v *= gain[k];
        const unsigned hi = cvt_pk_bf16(v, 0.f) & 0xffffu; const float rem = v - __uint_as_float(hi << 16); const unsigned lo = cvt_pk_bf16(rem, 0.f) & 0xffffu;
        const size_t base = ((size_t)((s * NT + nt) * 2) * 64 + ln) * 8 + j;
        Wp[base] = (bf16_t)hi; Wp[base + 64 * 8] = (bf16_t)lo;
    }
}
template <int NT>
__device__ __forceinline__ float wave_proj16b(LAS unsigned char* lds, const bf16_t* xin, int tok0, const bf16_t* Wp, int tid, int wid, int lane, f32x4 (&acc)[NT]) {
    static_assert(NT == 3, "chunk = 24 KiB = 3 DMA instructions per thread");
    const int tr = lane & 15, kq = lane >> 4;
    const u32x4* xp = (const u32x4*)(xin + (size_t)(tok0 + tr) * D) + kq;
    constexpr int CH = 4 * NT * 2 * 1024;
    const char* wsrc = (const char*)Wp + tid * 16;
    float ssq = 0.f;
#pragma unroll
    for (int n = 0; n < NT; ++n) acc[n] = (f32x4){0.f, 0.f, 0.f, 0.f};
    u32x4 X[4];
#define NB_DMA(c, buf) do { _Pragma("unroll") for (int r = 0; r < 3; ++r) \
        __builtin_amdgcn_global_load_lds((const unsigned*)(wsrc + (size_t)(c) * CH + r * 8192), (LAS unsigned*)(lds + (buf) * CH + r * 8192 + wid * 1024), 16, 0, 0); } while (0)
#define NB_CHUNK(c, buf, more) do { \
        asm volatile("s_waitcnt vmcnt(4)" ::: "memory"); WG_BAR(); \
        if (more) NB_DMA((c) + 1, 1 - (buf)); \
        asm volatile("" ::: "memory"); \
        const u32x4* xn_ = xp + 16 * ((c) + 1); \
        _Pragma("unroll") for (int s = 0; s < 4; ++s) { const u32x4 xw = X[s]; if (more) X[s] = xn_[4 * s]; \
            _Pragma("unroll") for (int q = 0; q < 4; ++q) { const float a_ = bf_lo(xw[q]), b_ = bf_hi(xw[q]); ssq += a_ * a_ + b_ * b_; } \
            const bf16x8 xa = __builtin_bit_cast(bf16x8, xw); \
            _Pragma("unroll") for (int n = 0; n < NT; ++n) _Pragma("unroll") for (int pc = 0; pc < 2; ++pc) { \
                const bf16x8 wv = *(const LAS bf16x8*)(lds + (buf) * CH + (((s * NT + n) * 2 + pc) * 64 + lane) * 16); \
                acc[n] = __builtin_amdgcn_mfma_f32_16x16x32_bf16(xa, wv, acc[n], 0, 0, 0); } } } while (0)
    NB_DMA(0, 0);
    asm volatile("" ::: "memory");
#pragma unroll
    for (int s = 0; s < 4; ++s) X[s] = xp[4 * s];
    for (int c = 0; c < 14; c += 2) { NB_CHUNK(c, 0, true); NB_CHUNK(c + 1, 1, true); }
    NB_CHUNK(14, 0, true); NB_CHUNK(15, 1, false);
    WG_BAR();
#undef NB_DMA
#undef NB_CHUNK
    ssq += __shfl_xor(ssq, 16); ssq += __shfl_xor(ssq, 32);
    return 1.0f / sqrtf(ssq * (1.0f / D) + RMS_EPS);
}
template <int NT, bool XB16 = false>
__device__ __forceinline__ float wave_proj16(LAS unsigned char* lds, const void* xin, int tok0, const float* Wp, int tid, int wid, int lane, f32x4 (&acc)[NT], bf16_t* xb16) {
    typedef typename XRow<XB16>::T XT;
    const int tr = lane & 15, kq = lane >> 4;
    const XT* xp = (const XT*)xin + (size_t)(tok0 + tr) * (D / 4) + 2 * kq;
    u32x4* hb = (u32x4*)(xb16 + (size_t)(tok0 + tr) * D) + kq;
    constexpr int CH = 16 * NT * 1024;
    const char* wsrc = (const char*)Wp + tid * 16;
    float ssq = 0.f;
#pragma unroll
    for (int n = 0; n < NT; ++n) acc[n] = (f32x4){0.f, 0.f, 0.f, 0.f};
    XT X[16];
#define NP_DMA(c, buf) do { _Pragma("unroll") for (int r = 0; r < 2 * NT; ++r) \
        __builtin_amdgcn_global_load_lds((const unsigned*)(wsrc + (size_t)(c) * CH + r * 8192), (LAS unsigned*)(lds + (buf) * CH + r * 8192 + wid * 1024), 16, 0, 0); } while (0)
#define NP_CHUNK(c, buf, more) do { \
        asm volatile("s_waitcnt vmcnt(16)" ::: "memory"); WG_BAR(); \
        if (more) NP_DMA((c) + 1, 1 - (buf)); \
        asm volatile("" ::: "memory");     \
        const XT* xn_ = xp + 64 * ((c) + 1); \
        _Pragma("unroll") for (int s = 0; s < 16; ++s) { const f32x4 xv = XRow<XB16>::get(X[s]); \
            if (s & 1) { const f32x4 xl_ = XRow<XB16>::get(X[s - 1]); u32x4 w_; w_.x = cvt_pk_bf16(xl_[0], xl_[1]); w_.y = cvt_pk_bf16(xl_[2], xl_[3]); w_.z = cvt_pk_bf16(xv[0], xv[1]); w_.w = cvt_pk_bf16(xv[2], xv[3]); \
                hb[32 * (c) + 4 * (s >> 1)] = w_; if (more) { X[s - 1] = xn_[8 * (s >> 1)]; X[s] = xn_[8 * (s >> 1) + 1]; } } \
            ssq += (xv[0] * xv[0] + xv[1] * xv[1]) + (xv[2] * xv[2] + xv[3] * xv[3]); \
            _Pragma("unroll") for (int n = 0; n < NT; ++n) { const f32x4 wv = *(const LAS f32x4*)(lds + (buf) * CH + ((s * NT + n) * 64 + lane) * 16); \
                _Pragma("unroll") for (int e = 0; e < 4; ++e) acc[n] = __builtin_amdgcn_mfma_f32_16x16x4f32(xv[e], wv[e], acc[n], 0, 0, 0); } } } while (0)
    NP_DMA(0, 0);
    asm volatile("" ::: "memory");
#pragma unroll
    for (int s = 0; s < 16; ++s) X[s] = xp[8 * (s >> 1) + (s & 1)];
    for (int c = 0; c < 6; c += 2) { NP_CHUNK(c, 0, true); NP_CHUNK(c + 1, 1, true); }
    NP_CHUNK(6, 0, true); NP_CHUNK(7, 1, false);
    WG_BAR();
#undef NP_DMA
#undef NP_CHUNK
    ssq += __shfl_xor(ssq, 16); ssq += __shfl_xor(ssq, 32);
    return 1.0f / sqrtf(ssq * (1.0f / D) + RMS_EPS);
}
template <bool FP8 = false, bool XB16 = false>
__device__ __forceinline__ void wave_write_hn16(const void* xin, int tok0, float rstd, const float* gain, bf16_t* hn, int lane) {
    typedef typename XRow<XB16>::T XT;
    f32x4 g4[8];
#pragma unroll
    for (int j = 0; j < 8; ++j) g4[j] = ((const f32x4*)gain)[lane + 64 * j];
    for (int i = 0; i < 16; i += 2) {
        const float r0 = __shfl(rstd, i), r1 = __shfl(rstd, i + 1);
        const XT* x0 = (const XT*)xin + (size_t)(tok0 + i) * (D / 4); const XT* x1 = x0 + D / 4;
        u32x2* o0 = (u32x2*)(hn + (size_t)(tok0 + i) * D); u32x2* o1 = o0 + D / 4;
        unsigned* p0 = (unsigned*)((unsigned char*)hn + (size_t)(tok0 + i) * D); unsigned* p1 = p0 + D / 4;
        XT a[8], c[8];
#pragma unroll
        for (int j = 0; j < 8; ++j) { a[j] = x0[lane + 64 * j]; c[j] = x1[lane + 64 * j]; }
#pragma unroll
        for (int j = 0; j < 8; ++j) { const f32x4 v = XRow<XB16>::get(a[j]) * r0 * g4[j], u = XRow<XB16>::get(c[j]) * r1 * g4[j];
            if constexpr (FP8) { p0[lane + 64 * j] = cvt4_fp8(v[0], v[1], v[2], v[3]); p1[lane + 64 * j] = cvt4_fp8(u[0], u[1], u[2], u[3]); }
            else { u32x2 w; w.x = cvt_pk_bf16(v[0], v[1]); w.y = cvt_pk_bf16(v[2], v[3]); o0[lane + 64 * j] = w;
                u32x2 z; z.x = cvt_pk_bf16(u[0], u[1]); z.y = cvt_pk_bf16(u[2], u[3]); o1[lane + 64 * j] = z; } }
    }
}

__device__ __forceinline__ void phase_norm_gz(Frame& F, const float* xin, const float* Wp, bf16_t* hn, float* gz, float* rstd_tab) {
    for (int tile = F.vcu; tile < T / 128; tile += F.G) {
        const int tok0 = tile * 128 + F.wave * 16;
        f32x4 acc[1];
        const float rstd = wave_proj16<1>(F.lds, xin, tok0, Wp, F.tid, F.wave, F.lane, acc, hn);
        if (F.lane < 16) rstd_tab[tok0 + F.lane] = rstd;
        const int j = F.lane & 15, q4 = F.lane >> 4;
#pragma unroll
        for (int r = 0; r < 4; ++r) { const float rr = __shfl(rstd, 4 * q4 + r); gz[(size_t)(tok0 + 4 * q4 + r) * 16 + j] = acc[0][r] * rr; }
    }
}
__device__ __forceinline__ void phase_norm_route(Frame& F, const bf16_t* xin, const float* gain, const float* Wp, bf16_t* hn, int* tok_e, int* tok_p, float* tok_w, unsigned* cnt) {
    LAS float* lg = (LAS float*)(F.lds + 98304 + F.wave * 3072);
    for (int tile = F.vcu; tile < T / 128; tile += F.G) {
        const int tok0 = tile * 128 + F.wave * 16;
        f32x4 acc[3];
        const float rstd = wave_proj16b<3>(F.lds, xin, tok0, (const bf16_t*)Wp, F.tid, F.wave, F.lane, acc);
        const int j = F.lane & 15, q4 = F.lane >> 4;
#pragma unroll
        for (int r = 0; r < 4; ++r) { const float rr = __shfl(rstd, 4 * q4 + r);
#pragma unroll
            for (int n = 0; n < 3; ++n) lg[(4 * q4 + r) * 48 + 16 * n + j] = acc[n][r] * rr; }
        LDS_WAIT(); asm volatile("" ::: "memory");
        if (F.lane < 16) {
            const LAS float* l = lg + F.lane * 48;
            float gm = l[0]; int gi = 0;
#pragma unroll
            for (int q = 1; q < 4; ++q) { const float v = l[q]; if (v > gm) { gm = v; gi = q; } }
            float gs = 0.f;
#pragma unroll
            for (int q = 0; q < 4; ++q) gs += __expf(l[q] - gm);
            const float gw = 1.0f / gs;
            const LAS float* se = l + 4 + 8 * gi;
            float m1 = se[0]; int i1 = 0;
#pragma unroll
            for (int q = 1; q < 8; ++q) { const float v = se[q]; if (v > m1) { m1 = v; i1 = q; } }
            float m2 = -3.0e38f; int i2 = 0;
#pragma unroll
            for (int q = 0; q < 8; ++q) { const float v = se[q]; if (q != i1 && v > m2) { m2 = v; i2 = q; } }
            const float eb = __expf(m2 - m1), inv = 1.0f / (1.0f + eb);
            const int t = tok0 + F.lane, e1 = gi * 8 + i1, e2 = gi * 8 + i2;
            const unsigned p1 = __hip_atomic_fetch_add(cnt + 64 * e1, 1u, __ATOMIC_RELAXED, __HIP_MEMORY_SCOPE_AGENT);
            const unsigned p2 = __hip_atomic_fetch_add(cnt + 64 * e2, 1u, __ATOMIC_RELAXED, __HIP_MEMORY_SCOPE_AGENT);
            tok_e[2 * t] = e1; tok_e[2 * t + 1] = e2; tok_p[2 * t] = (int)p1; tok_p[2 * t + 1] = (int)p2;
            tok_w[2 * t] = gw * inv; tok_w[2 * t + 1] = gw * eb * inv;
        }
        wave_write_hn16<true, true>(xin, tok0, rstd, gain, hn, F.lane);
        LDS_WAIT(); asm volatile("" ::: "memory");
    }
}

__device__ __forceinline__ void phase_gla_gate(Frame& F, const float* gz, const float* wgu, const float* bgate, const bf16_t* proj, bf16_t* kdT, float* adec) {
    LAS f32x4* gzs = (LAS f32x4*)F.lds;
    for (int u = F.vcu; u < NBATCH * NCH * 2; u += F.G) {
        const int half = u & 1, bc = u >> 1;
        const int tok0 = bc * 64, j = half * 512 + F.tid;
        if (F.tid < 256) gzs[F.tid] = ((const f32x4*)(gz + (size_t)tok0 * 16))[F.tid];
        float wg[16];
#pragma unroll
        for (int r = 0; r < 16; ++r) wg[r] = wgu[r * GLA_DKT + j];
        const float bg = bgate[j];
        WG_BAR();
        float cum[64]; float run = 0.f;
#pragma unroll
        for (int t = 0; t < 64; ++t) {
            float z = bg;
#pragma unroll
            for (int r4 = 0; r4 < 4; ++r4) { const f32x4 g4 = gzs[t * 4 + r4]; z += g4[0] * wg[4 * r4] + g4[1] * wg[4 * r4 + 1] + g4[2] * wg[4 * r4 + 2] + g4[3] * wg[4 * r4 + 3]; }
            const float ls = fminf(z, 0.f) - __logf(1.0f + __expf(-fabsf(z)));
            run += ls * (1.0f / 16.0f); cum[t] = run;
        }
        adec[(size_t)bc * GLA_DKT + j] = __expf(run);
        const bf16_t* kp = proj + GK0 + gq_off(bc >> 8, (bc & 255) * 64, j >> 8) + (j & 255);
        u32x4* dst = (u32x4*)(kdT + ((size_t)bc * GLA_DKT + j) * 64);
#pragma unroll
        for (int t8 = 0; t8 < 8; ++t8) {
            float kd[8];
#pragma unroll
            for (int q = 0; q < 8; ++q) { const int t = t8 * 8 + q; kd[q] = bf2f(kp[(size_t)t * 256]) * __expf(run - cum[t]); }
            u32x4 w; w.x = cvt_pk_bf16(kd[0], kd[1]); w.y = cvt_pk_bf16(kd[2], kd[3]); w.z = cvt_pk_bf16(kd[4], kd[5]); w.w = cvt_pk_bf16(kd[6], kd[7]);
            dst[t8] = w;
        }
        WG_BAR();
    }
}

constexpr int SCAN_VROW = 144, SCAN_SROW = 528, SCAN_VBUF = 64 * SCAN_VROW, SCAN_SBUF = 64 * SCAN_SROW;
__device__ __forceinline__ void phase_gla_scan(Frame& F, int it, const bf16_t* proj, const bf16_t* kdT, const float* adec, bf16_t* oout, bf16_t* sfin) {
    const int lane = F.lane, w = F.wave, fr = lane & 15, kq = lane >> 4, tid = F.tid;
    LAS unsigned char* vbuf = F.lds;
    LAS unsigned char* sbuf = F.lds + 2 * SCAN_VBUF;
    const int bh = it >> 4, seg = (it >> 3) & 1, b = bh >> 2, h = bh & 3, sl = it & 7, mt = w & 3, ntp = w >> 2, c0 = seg * (NCH / 2);
    const size_t tokb = (size_t)b * SEQ;
    f32x4 st[2][4];
#pragma unroll
    for (int i = 0; i < 2; ++i)
#pragma unroll
        for (int n = 0; n < 4; ++n) st[i][n] = (f32x4){0.f, 0.f, 0.f, 0.f};
    bf16x8 ka0[2][2], ka1[2][2], q0[8], q1[8]; f32x4 dc0[2], dc1[2]; u32x4 vr0, vr1;
#define CL(c) ((c) < NCH ? (c) : NCH - 1)
#define LOAD_KA(KA, DC, c) do { const size_t bc_ = (size_t)b * NCH + CL(c); \
        _Pragma("unroll") for (int i = 0; i < 2; ++i) { \
            _Pragma("unroll") for (int s = 0; s < 2; ++s) KA[i][s] = *(const bf16x8*)(kdT + ((bc_ * GLA_DKT + h * 256 + 32 * w + 16 * i + fr) * 64 + 32 * s + 8 * kq)); \
            DC[i] = *(const f32x4*)(adec + bc_ * GLA_DKT + h * 256 + 32 * w + 16 * i + 4 * kq); } } while (0)
#define LOAD_V(VR, c) do { VR = *(const u32x4*)(proj + gv_off(b, CL(c) * 64 + (tid >> 3), h) + 64 * sl + 8 * (tid & 7)); } while (0)
#define LOAD_Q(Q, c) do { const bf16_t* qp_ = proj + gq_off(b, CL(c) * 64 + 16 * mt + fr, h) + 8 * kq; \
        _Pragma("unroll") for (int s = 0; s < 8; ++s) Q[s] = *(const bf16x8*)(qp_ + 32 * s); } while (0)
#define STORE_V(VR, buf) do { *(LAS u32x4*)(vbuf + (buf) * SCAN_VBUF + (tid >> 3) * SCAN_VROW + (tid & 7) * 16) = VR; } while (0)
#define SCAN_STEP(KA, DC, VN, VM, QC, QN, c) do { \
        const unsigned vb_ = (unsigned)(uintptr_t)(vbuf + ((c) & 1) * SCAN_VBUF) + (unsigned)((8 * kq + ((lane & 15) >> 2)) * SCAN_VROW + 8 * (lane & 3)); \
        s16x4 tv[4][4];     \
        asm volatile("ds_read_b64_tr_b16 %0, %16 offset:0\n\tds_read_b64_tr_b16 %1, %16 offset:576\n\tds_read_b64_tr_b16 %2, %16 offset:4608\n\tds_read_b64_tr_b16 %3, %16 offset:5184\n\t" \
                     "ds_read_b64_tr_b16 %4, %16 offset:32\n\tds_read_b64_tr_b16 %5, %16 offset:608\n\tds_read_b64_tr_b16 %6, %16 offset:4640\n\tds_read_b64_tr_b16 %7, %16 offset:5216\n\t" \
                     "ds_read_b64_tr_b16 %8, %16 offset:64\n\tds_read_b64_tr_b16 %9, %16 offset:640\n\tds_read_b64_tr_b16 %10, %16 offset:4672\n\tds_read_b64_tr_b16 %11, %16 offset:5248\n\t" \
                     "ds_read_b64_tr_b16 %12, %16 offset:96\n\tds_read_b64_tr_b16 %13, %16 offset:672\n\tds_read_b64_tr_b16 %14, %16 offset:4704\n\tds_read_b64_tr_b16 %15, %16 offset:5280\n\ts_waitcnt lgkmcnt(0)" \
                     : "=&v"(tv[0][0]), "=&v"(tv[0][1]), "=&v"(tv[0][2]), "=&v"(tv[0][3]), "=&v"(tv[1][0]), "=&v"(tv[1][1]), "=&v"(tv[1][2]), "=&v"(tv[1][3]), \
                       "=&v"(tv[2][0]), "=&v"(tv[2][1]), "=&v"(tv[2][2]), "=&v"(tv[2][3]), "=&v"(tv[3][0]), "=&v"(tv[3][1]), "=&v"(tv[3][2]), "=&v"(tv[3][3]) : "v"(vb_) : "memory"); \
        _Pragma("unroll") for (int n = 0; n < 4; ++n) { \
            const bf16x8 vf0 = (bf16x8){tv[n][0][0], tv[n][0][1], tv[n][0][2], tv[n][0][3], tv[n][1][0], tv[n][1][1], tv[n][1][2], tv[n][1][3]}; \
            const bf16x8 vf1 = (bf16x8){tv[n][2][0], tv[n][2][1], tv[n][2][2], tv[n][2][3], tv[n][3][0], tv[n][3][1], tv[n][3][2], tv[n][3][3]}; \
            _Pragma("unroll") for (int i = 0; i < 2; ++i) { \
                st[i][n] = st[i][n] * DC[i]; \
                st[i][n] = __builtin_amdgcn_mfma_f32_16x16x32_bf16(KA[i][0], vf0, st[i][n], 0, 0, 0); \
                st[i][n] = __builtin_amdgcn_mfma_f32_16x16x32_bf16(KA[i][1], vf1, st[i][n], 0, 0, 0); } } \
        LOAD_KA(KA, DC, (c) + 2); \
        { LAS unsigned char* sb_ = sbuf + ((c) & 1) * SCAN_SBUF + fr * SCAN_SROW + (32 * w + 4 * kq) * 2; \
          _Pragma("unroll") for (int i = 0; i < 2; ++i) _Pragma("unroll") for (int n = 0; n < 4; ++n) { \
              u32x2 pk; pk.x = cvt_pk_bf16(st[i][n][0], st[i][n][1]); pk.y = cvt_pk_bf16(st[i][n][2], st[i][n][3]); \
              *(LAS u32x2*)(sb_ + n * 16 * SCAN_SROW + i * 32) = pk; } } \
        STORE_V(VN, ((c) + 1) & 1); \
        LOAD_V(VN, (c) + 3); \
        WG_BAR(); \
        { f32x4 a0 = (f32x4){0.f, 0.f, 0.f, 0.f}, a1 = a0; \
          const LAS unsigned char* sr_ = sbuf + ((c) & 1) * SCAN_SBUF + (32 * ntp + fr) * SCAN_SROW + 16 * kq; \
          _Pragma("unroll") for (int hb = 0; hb < 2; ++hb) { bf16x8 bb[4][2];     \
              _Pragma("unroll") for (int s = 0; s < 4; ++s) { bb[s][0] = *(const LAS bf16x8*)(sr_ + 64 * (4 * hb + s)); bb[s][1] = *(const LAS bf16x8*)(sr_ + 16 * SCAN_SROW + 64 * (4 * hb + s)); } \
              asm volatile("s_waitcnt lgkmcnt(0)" ::: "memory"); __builtin_amdgcn_sched_barrier(0); \
              _Pragma("unroll") for (int s = 0; s < 4; ++s) { \
                  a0 = __builtin_amdgcn_mfma_f32_16x16x32_bf16(QC[4 * hb + s], bb[s][0], a0, 0, 0, 0); \
                  a1 = __builtin_amdgcn_mfma_f32_16x16x32_bf16(QC[4 * hb + s], bb[s][1], a1, 0, 0, 0); } } \
          bf16_t* op_ = oout + (tokb + (size_t)(c) * 64 + 16 * mt + 4 * kq) * D + h * 512 + 64 * sl + 32 * ntp + fr; \
          _Pragma("unroll") for (int r = 0; r < 4; ++r) { \
              const float x0 = a0[r] * 0.0625f, x1 = a1[r] * 0.0625f, y0 = __shfl_xor(x0, 1), y1 = __shfl_xor(x1, 1); \
              if ((fr & 1) == 0) { *(unsigned*)(op_ + (size_t)r * D) = cvt_pk_bf16(x0, y0); *(unsigned*)(op_ + (size_t)r * D + 16) = cvt_pk_bf16(x1, y1); } } } \
        LOAD_Q(QC, (c) + 2); \
    } while (0)
    LOAD_KA(ka0, dc0, c0); LOAD_KA(ka1, dc1, c0 + 1); LOAD_V(vr0, c0); LOAD_V(vr1, c0 + 1); LOAD_Q(q0, c0); LOAD_Q(q1, c0 + 1);
    STORE_V(vr0, 0); LOAD_V(vr0, c0 + 2);
    WG_BAR();
    for (int c = c0; c < c0 + NCH / 2; c += 2) {
        SCAN_STEP(ka0, dc0, vr1, vr0, q0, q1, c);
        SCAN_STEP(ka1, dc1, vr0, vr1, q1, q0, c + 1);
    }
    if (seg == 0) {
#pragma unroll
        for (int i = 0; i < 2; ++i)
#pragma unroll
            for (int n = 0; n < 4; ++n) { u32x2 pk; pk.x = cvt_pk_bf16(st[i][n][0], st[i][n][1]); pk.y = cvt_pk_bf16(st[i][n][2], st[i][n][3]);
                *(u32x2*)(sfin + ((size_t)(bh * 512 + 64 * sl + 16 * n + fr)) * 256 + 32 * w + 16 * i + 4 * kq) = pk; }
    }
    WG_BAR();
#undef CL
#undef LOAD_KA
#undef LOAD_V
#undef LOAD_Q
#undef STORE_V
#undef SCAN_STEP
}

__device__ __forceinline__ void gla_pcum(Frame& F, const float* adec, float* pcum, int rank, int nrank) {
    for (int idx = rank * (NWAVES * 64) + F.tid; idx < NBATCH * GLA_DKT; idx += nrank * NWAVES * 64) { const int b = idx >> 10, j = idx & 1023;
        const float* ap = adec + ((size_t)(b * NCH + NCH / 2)) * GLA_DKT + j; float* pp = pcum + (size_t)(b * (NCH / 2)) * GLA_DKT + j; float pr = 1.f;
#pragma unroll 16
        for (int cc = 0; cc < NCH / 2; ++cc) { pr *= ap[(size_t)cc * GLA_DKT]; pp[(size_t)cc * GLA_DKT] = pr; } }
}
__device__ __forceinline__ void phase_gla_qp(Frame& F, const bf16_t* proj, const float* pcum, bf16_t* qp) {
    const int gw = F.vcu * NWAVES + F.wave, NGW = F.G * NWAVES, lane = F.lane;
    for (int r = gw; r < NBATCH * (SEQ / 2); r += NGW) { const int b = r >> 13, t = r & 8191;
        u32x2 qv[4]; f32x4 pv[4];
#pragma unroll
        for (int h = 0; h < 4; ++h) { qv[h] = *(const u32x2*)(proj + gq_off(b, SEQ / 2 + t, h) + 4 * lane); pv[h] = *(const f32x4*)(pcum + ((size_t)(b * (NCH / 2) + (t >> 6)) * GLA_DKT + h * 256 + 4 * lane)); }
#pragma unroll
        for (int h = 0; h < 4; ++h) { u32x2 w; w.x = cvt_pk_bf16(bf_lo(qv[h].x) * pv[h][0], bf_hi(qv[h].x) * pv[h][1]); w.y = cvt_pk_bf16(bf_lo(qv[h].y) * pv[h][2], bf_hi(qv[h].y) * pv[h][3]);
            *(u32x2*)(qp + ((size_t)((b * 4 + h) * (SEQ / 2) + t)) * 256 + 4 * lane) = w; }
    }
}
__device__ __forceinline__ void phase_gla_gnorm(Frame& F, const bf16_t* o, const bf16_t* proj, const float* gn, bf16_t* y) {
    const int gw = F.vcu * NWAVES + F.wave, NGW = F.G * NWAVES, lane = F.lane;
    const f32x4 g0 = ((const f32x4*)gn)[2 * lane], g1 = ((const f32x4*)gn)[2 * lane + 1];
    for (int tok = gw; tok < T; tok += NGW) {
        u32x4 ov[4], rv[4];
#pragma unroll
        for (int h = 0; h < 4; ++h) { ov[h] = *(const u32x4*)(o + (size_t)tok * D + h * 512 + 8 * lane); rv[h] = *(const u32x4*)(proj + GR0 + (size_t)tok * 2048 + h * 512 + 8 * lane); }
        float ss[4];
#pragma unroll
        for (int h = 0; h < 4; ++h) { float s = 0.f;
#pragma unroll
            for (int q = 0; q < 4; ++q) { const float lo = bf_lo(ov[h][q]), hi = bf_hi(ov[h][q]); s += lo * lo + hi * hi; }
            ss[h] = s; }
#pragma unroll
        for (int of = 1; of < 64; of <<= 1) {
#pragma unroll
            for (int h = 0; h < 4; ++h) ss[h] += __shfl_xor(ss[h], of); }
#pragma unroll
        for (int h = 0; h < 4; ++h) { const float rstd = 1.0f / sqrtf(ss[h] * (1.0f / 512.0f) + RMS_EPS);
            float yv[8];
#pragma unroll
            for (int q = 0; q < 4; ++q) { const float a0 = bf_lo(ov[h][q]), a1 = bf_hi(ov[h][q]), r0 = bf_lo(rv[h][q]), r1 = bf_hi(rv[h][q]);
                const float gA = q < 2 ? g0[2 * q] : g1[2 * q - 4], gB = q < 2 ? g0[2 * q + 1] : g1[2 * q - 3];
                yv[2 * q] = a0 * rstd * gA * (r0 / (1.0f + __expf(-r0))); yv[2 * q + 1] = a1 * rstd * gB * (r1 / (1.0f + __expf(-r1))); }
            u32x4 w; w.x = cvt_pk_bf16(yv[0], yv[1]); w.y = cvt_pk_bf16(yv[2], yv[3]); w.z = cvt_pk_bf16(yv[4], yv[5]); w.w = cvt_pk_bf16(yv[6], yv[7]);
            *(u32x4*)(y + (size_t)tok * D + h * 512 + 8 * lane) = w; }
    }
}

__device__ __forceinline__ void moe_tables(Frame& F, unsigned* cnt) {
    LAS int* pst = (LAS int*)(F.lds + TAB_OFF);
    LAS int* te = pst + 36;
    if (F.wave == 0) {
        const int e = F.lane & 31;
        const int c = (int)xb_ld(cnt + 64 * e);
        const int ntile = (c + 255) >> 8;
        int incl = ntile;
#pragma unroll
        for (int o = 1; o < 32; o <<= 1) { const int v = __shfl_up(incl, o); if ((F.lane & 31) >= o) incl += v; }
        const int excl = incl - ntile;
        if (F.lane < 32) { pst[e] = excl << 8; for (int q = 0; q < ntile; ++q) te[excl + q] = e; }
        if (F.lane == 31) { pst[32] = incl << 8; pst[33] = incl; }
    }
    WG_BAR();
}
__device__ __forceinline__ void phase_moe_slots(Frame& F, const int* tok_e, const int* tok_p, unsigned* cnt, int* slot_of, int* slot_tok) {
    const LAS int* pst = (const LAS int*)(F.lds + TAB_OFF);
    for (int e = F.vcu; e < NEXP; e += F.G) { const int c = (int)xb_ld(cnt + 64 * e), lo = pst[e] + c, hi = pst[e] + (((c + 255) >> 8) << 8);
        for (int s = lo + F.tid; s < hi; s += NWAVES * 64) slot_tok[s] = -1; }
    for (int a = F.vcu * NWAVES * 64 + F.tid; a < 2 * T; a += F.G * NWAVES * 64) { const int slot = pst[tok_e[a]] + tok_p[a]; slot_of[a] = slot; slot_tok[slot] = a >> 1; }
}
__device__ __forceinline__ void phase_moe_copy8(Frame& F, const int* tok_e, const int* tok_p, const unsigned char* hn8, unsigned char* ag8) {
    const LAS int* pst = (const LAS int*)(F.lds + TAB_OFF);
    const int gw = F.vcu * NWAVES + F.wave, NGW = F.G * NWAVES, lane = F.lane;
    for (int t = gw; t < T; t += NGW) {
        const int s0 = pst[tok_e[2 * t]] + tok_p[2 * t], s1 = pst[tok_e[2 * t + 1]] + tok_p[2 * t + 1];
        const u32x4* src = (const u32x4*)(hn8 + (size_t)t * D); const u32x4 v0 = src[lane], v1 = src[lane + 64];
        u32x4* d0 = (u32x4*)(ag8 + (size_t)s0 * D); u32x4* d1 = (u32x4*)(ag8 + (size_t)s1 * D);
        d0[lane] = v0; d0[lane + 64] = v1; d1[lane] = v0; d1[lane + 64] = v1;
    }
}
template <int MODE>
__device__ __forceinline__ void phase_moe_combine(Frame& F, bf16_t* x, float* out, const bf16_t* ob, const int* slot_of, const float* tok_w, const float* gain, bf16_t* hn) {
    const int gw = F.vcu * NWAVES + F.wave, NGW = F.G * NWAVES, lane = F.lane;
    f32x4 g4[8];
#pragma unroll
    for (int j = 0; j < 8; ++j) g4[j] = ((const f32x4*)gain)[lane + 64 * j];
    for (int t = gw; t < T; t += NGW) {
        const int s0 = slot_of[2 * t], s1 = slot_of[2 * t + 1]; const float w0 = tok_w[2 * t] * 0.125f, w1 = tok_w[2 * t + 1] * 0.125f;
        u32x2* xr = (u32x2*)(x + (size_t)t * D);
        const unsigned* a = (const unsigned*)((const unsigned char*)ob + (size_t)s0 * D); const unsigned* b = (const unsigned*)((const unsigned char*)ob + (size_t)s1 * D);
        f32x4 v[8]; float ss = 0.f;
#pragma unroll
        for (int j = 0; j < 8; ++j) { const int av = (int)a[lane + 64 * j], bv = (int)b[lane + 64 * j]; f32x4 xv = bf4_expand(xr[lane + 64 * j]);
            xv[0] += w0 * __builtin_amdgcn_cvt_f32_fp8(av, 0) + w1 * __builtin_amdgcn_cvt_f32_fp8(bv, 0); xv[1] += w0 * __builtin_amdgcn_cvt_f32_fp8(av, 1) + w1 * __builtin_amdgcn_cvt_f32_fp8(bv, 1);
            xv[2] += w0 * __builtin_amdgcn_cvt_f32_fp8(av, 2) + w1 * __builtin_amdgcn_cvt_f32_fp8(bv, 2); xv[3] += w0 * __builtin_amdgcn_cvt_f32_fp8(av, 3) + w1 * __builtin_amdgcn_cvt_f32_fp8(bv, 3);
            v[j] = xv; ss += (xv[0] * xv[0] + xv[1] * xv[1]) + (xv[2] * xv[2] + xv[3] * xv[3]); }
        const float rstd = 1.0f / sqrtf(wave_sum(ss) * (1.0f / D) + RMS_EPS);
        if (MODE == 0) {
            unsigned* orow = (unsigned*)((unsigned char*)hn + (size_t)t * D);
#pragma unroll
            for (int j = 0; j < 8; ++j) { u32x2 w; w.x = cvt_pk_bf16(v[j][0], v[j][1]); w.y = cvt_pk_bf16(v[j][2], v[j][3]); xr[lane + 64 * j] = w;
                const f32x4 y = v[j] * rstd * g4[j]; orow[lane + 64 * j] = cvt4_fp8(y[0], y[1], y[2], y[3]); }
        } else {
            f32x4* orow = (f32x4*)(out + (size_t)t * D);
#pragma unroll
            for (int j = 0; j < 8; ++j) orow[lane + 64 * j] = v[j] * rstd * g4[j];
        }
    }
}

__device__ __forceinline__ void phase_subln(Frame& F, const bf16_t* o1, const bf16_t* o2, const float* lq1, const float* lk1, const float* lq2, const float* lk2, const float* sg, bf16_t* y) {
    const int gw = F.vcu * NWAVES + F.wave, NGW = F.G * NWAVES, lane = F.lane;
    const float d1 = wave_sum(lq1[lane] * lk1[lane] + lq1[lane + 64] * lk1[lane + 64]);
    const float d2 = wave_sum(lq2[lane] * lk2[lane] + lq2[lane + 64] * lk2[lane + 64]);
    const float lam = __expf(d1) - __expf(d2) + LAMBDA_INIT;
    const f32x4 g = ((const f32x4*)sg)[lane] * (1.0f - LAMBDA_INIT);
    for (int tok = gw; tok < T; tok += NGW) {
        u32x2 a[8], b[8];
#pragma unroll
        for (int h = 0; h < 8; ++h) { a[h] = *(const u32x2*)(o1 + (size_t)tok * D + h * 256 + 4 * lane); b[h] = *(const u32x2*)(o2 + (size_t)tok * D + h * 256 + 4 * lane); }
        f32x4 d[8]; float ss[8];
#pragma unroll
        for (int h = 0; h < 8; ++h) { d[h][0] = bf_lo(a[h].x) - lam * bf_lo(b[h].x); d[h][1] = bf_hi(a[h].x) - lam * bf_hi(b[h].x); d[h][2] = bf_lo(a[h].y) - lam * bf_lo(b[h].y); d[h][3] = bf_hi(a[h].y) - lam * bf_hi(b[h].y);
            ss[h] = (d[h][0] * d[h][0] + d[h][1] * d[h][1]) + (d[h][2] * d[h][2] + d[h][3] * d[h][3]); }
#pragma unroll
        for (int of = 1; of < 64; of <<= 1) {
#pragma unroll
            for (int h = 0; h < 8; ++h) ss[h] += __shfl_xor(ss[h], of); }
#pragma unroll
        for (int h = 0; h < 8; ++h) { const float rstd = 1.0f / sqrtf(ss[h] * (1.0f / 256.0f) + RMS_EPS); const f32x4 yv = d[h] * rstd * g;
            *(unsigned*)((unsigned char*)y + (size_t)tok * D + h * 256 + 4 * lane) = cvt4_fp8(yv[0], yv[1], yv[2], yv[3]); }
    }
}

namespace att {
constexpr int SHM_K = 64 * 128, SHM_V = 256 * 64;
constexpr int NSLOT = 5, V_OFF = 0, K_OFF = NSLOT * SHM_V, SCR_OFF = RING_BYTES + 4096;
static_assert(K_OFF + NSLOT * SHM_K <= RING_BYTES, "attention slots");
constexpr float SCALE = 0.08838834764831845f;
constexpr float C2 = 1.4426950408889634f * SCALE;
constexpr float THR = 40.f;
__device__ __forceinline__ int crow(int r, int hi) { return (r & 3) + 8 * (r >> 2) + 4 * hi; }

__device__ __forceinline__ void qkt(f32x16& p0, f32x16& p1, const LAS unsigned char* kslot, int r32, int hi, const v8i32 (&qf)[2], const f32x16& bias) {
    const int sw = (r32 >> 1) & 7;
    const LAS unsigned char* ra = kslot + r32 * 128;
#pragma unroll
    for (int s = 0; s < 2; ++s) { const int c0 = 4 * s + 2 * hi;
        const v4i32 a0 = *(const LAS v4i32*)(ra + ((c0 ^ sw) << 4)), a1 = *(const LAS v4i32*)(ra + (((c0 + 1) ^ sw) << 4));
        const v4i32 b0 = *(const LAS v4i32*)(ra + 32 * 128 + ((c0 ^ sw) << 4)), b1 = *(const LAS v4i32*)(ra + 32 * 128 + (((c0 + 1) ^ sw) << 4));
        const v8i32 ka = __builtin_shufflevector(a0, a1, 0, 1, 2, 3, 4, 5, 6, 7), kb = __builtin_shufflevector(b0, b1, 0, 1, 2, 3, 4, 5, 6, 7);
        if (s == 0) {
            p0 = __builtin_amdgcn_mfma_scale_f32_32x32x64_f8f6f4(ka, qf[s], bias, 0, 0, 0, 0x7f7f7f7f, 0, 0x7f7f7f7f);
            p1 = __builtin_amdgcn_mfma_scale_f32_32x32x64_f8f6f4(kb, qf[s], bias, 0, 0, 0, 0x7f7f7f7f, 0, 0x7f7f7f7f);
            __builtin_amdgcn_sched_barrier(0); }
        else {
            p0 = __builtin_amdgcn_mfma_scale_f32_32x32x64_f8f6f4(ka, qf[s], p0, 0, 0, 0, 0x7f7f7f7f, 0, 0x7f7f7f7f);
            p1 = __builtin_amdgcn_mfma_scale_f32_32x32x64_f8f6f4(kb, qf[s], p1, 0, 0, 0, 0x7f7f7f7f, 0, 0x7f7f7f7f); } }
}
__device__ __forceinline__ void pv_tile(f32x16 (&o)[8], const LAS unsigned char* va, const v8i32& pa, int scl) {
    const LAS unsigned char* vb = (const LAS unsigned char*)((unsigned)(uintptr_t)va ^ 16u);
#define PV_RD(S, d0) do { S[0] = *(const LAS v4i32*)(va + (d0) * 2048); S[1] = *(const LAS v4i32*)(vb + (d0) * 2048); } while (0)
#define PV_MM(S, d0) do { __builtin_amdgcn_sched_barrier(0); \
        o[d0] = __builtin_amdgcn_mfma_scale_f32_32x32x64_f8f6f4(pa, __builtin_shufflevector(S[0], S[1], 0, 1, 2, 3, 4, 5, 6, 7), o[d0], 0, 0, 0, scl, 0, 0x7f7f7f7f); __builtin_amdgcn_sched_barrier(0); } while (0)
    v4i32 f0[2], f1[2];
    PV_RD(f0, 0);
    PV_RD(f1, 1); PV_MM(f0, 0); PV_RD(f0, 2); PV_MM(f1, 1); PV_RD(f1, 3); PV_MM(f0, 2); PV_RD(f0, 4); PV_MM(f1, 3); PV_RD(f1, 5); PV_MM(f0, 4); PV_RD(f0, 6); PV_MM(f1, 5); PV_RD(f1, 7); PV_MM(f0, 6);
    PV_MM(f1, 7);
#undef PV_MM
#undef PV_RD
}

__device__ __forceinline__ void stage_offsets(int tid, unsigned& koff, unsigned (&voff)[2]) {
    { const int P = tid * 16, row = P >> 7, ch = ((P & 127) >> 4) ^ ((row >> 1) & 7); koff = (unsigned)(row * 128 + ch * 16); }
#pragma unroll
    for (int i = 0; i < 2; ++i) { const int P = tid * 16 + i * 8192, row = P >> 6, ch = ((P & 63) >> 4) ^ ((row >> 2) & 3); voff[i] = (unsigned)(row * 64 + ch * 16); }
}
__device__ __forceinline__ const char* uniform_ptr(const void* p) {
    const unsigned long long v = (unsigned long long)p;
    const unsigned lo = __builtin_amdgcn_readfirstlane((unsigned)v), hi = __builtin_amdgcn_readfirstlane((unsigned)(v >> 32));
    return (const char*)(((unsigned long long)hi << 32) | lo);
}
__device__ __forceinline__ void stage_tile(LAS unsigned char* lds, int slot, const bf16_t* kj_, const bf16_t* vj_, int tid_, int wid) {
    const char* kj = uniform_ptr(kj_); const char* vj = uniform_ptr(vj_);
    int tid = tid_; asm volatile("" : "+v"(tid));
    unsigned koff, voff[2]; stage_offsets(tid, koff, voff);
    LAS unsigned char* kd = lds + K_OFF + slot * SHM_K + wid * 1024; LAS unsigned char* vd = lds + V_OFF + slot * SHM_V + wid * 1024;
    __builtin_amdgcn_global_load_lds((const unsigned*)(kj + koff), (LAS unsigned*)kd, 16, 0, 0);
#pragma unroll
    for (int i = 0; i < 2; ++i) __builtin_amdgcn_global_load_lds((const unsigned*)(vj + voff[i]), (LAS unsigned*)(vd + i * 8192), 16, 0, 0);
}

__device__ __forceinline__ void qk_softmax(const LAS unsigned char* kslot, int r32, int hi, LAS float* al_l, const v8i32 (&qf)[2], const f32x16& bias, f32x16 (&o)[8], v8i32& pa, int& pscl,
                                           float& m_reg, float& l_reg, float rawu, float sl2, bool diag, int qi) {
    f32x16 p0, p1;
    qkt(p0, p1, kslot, r32, hi, qf, bias);
    if (diag) {
        const float k2raw = 2.f * rawu;
        int qi_ = qi - 4 * hi; asm volatile("" : "+v"(qi_));
#pragma unroll
        for (int r = 0; r < 16; ++r) { const int c = (r & 3) + 8 * (r >> 2); const int d0_ = c - qi_, d1_ = c + 32 - qi_;
            p0[r] -= k2raw * (float)(d0_ > 0 ? d0_ : 0); p1[r] -= k2raw * (float)(d1_ > 0 ? d1_ : 0); }
    }
    const float lane_raw = rawu * (float)(4 * hi), d32raw = 32.f * rawu;
    float pm0 = p0[0], pm1 = p1[0];
#pragma unroll
    for (int r = 1; r < 16; ++r) { pm0 = fmaxf(pm0, p0[r]); pm1 = fmaxf(pm1, p1[r]); }
    float pmax = fmaxf(pm0, pm1 + d32raw) + lane_raw;
    { auto rr = __builtin_amdgcn_permlane32_swap(__float_as_uint(pmax), __float_as_uint(pmax), false, false);
      pmax = fmaxf(__uint_as_float(rr[0]), __uint_as_float(rr[1])); }
    float mn, alpha;
    if (__all((pmax - m_reg) * SCALE <= THR)) { mn = m_reg; alpha = 1.f; }
    else { mn = fmaxf(m_reg, pmax); alpha = __builtin_amdgcn_exp2f((m_reg - mn) * C2); m_reg = mn; }
    const float ef = fminf(floorf(8.75f - (pmax - mn) * C2), 60.f);
    pscl = 127 - (int)ef;
    const float mnL0 = (lane_raw - mn) * C2 + ef, mnL1 = mnL0 + 32.f * sl2;
#pragma unroll
    for (int r = 0; r < 16; ++r) { p0[r] = __builtin_amdgcn_exp2f(fmaf(p0[r], C2, mnL0)); p1[r] = __builtin_amdgcn_exp2f(fmaf(p1[r], C2, mnL1)); }
    if (__any(alpha < 1.f)) {
        if (hi == 0) al_l[r32] = alpha;
        LDS_WAIT();
#pragma unroll
        for (int r = 0; r < 16; ++r) { const float a = al_l[crow(r, hi)];
#pragma unroll
            for (int d = 0; d < 8; ++d) o[d][r] *= a; }
    }
    float ps = 0.f;
#pragma unroll
    for (int r = 0; r < 16; ++r) ps += p0[r] + p1[r];
    { auto rr = __builtin_amdgcn_permlane32_swap(__float_as_uint(ps), __float_as_uint(ps), false, false);
      ps = __uint_as_float(rr[0]) + __uint_as_float(rr[1]); }
    l_reg = l_reg * alpha + ps * __builtin_amdgcn_exp2f(-ef);
#pragma unroll
    for (int g = 0; g < 4; ++g) {
        pa[g] = __builtin_amdgcn_cvt_pk_fp8_f32(p0[4 * g + 2], p0[4 * g + 3], __builtin_amdgcn_cvt_pk_fp8_f32(p0[4 * g], p0[4 * g + 1], (int)__float_as_uint(p0[4 * g]), false), true);
        pa[4 + g] = __builtin_amdgcn_cvt_pk_fp8_f32(p1[4 * g + 2], p1[4 * g + 3], __builtin_amdgcn_cvt_pk_fp8_f32(p1[4 * g], p1[4 * g + 1], (int)__float_as_uint(p1[4 * g]), false), true); }
}

__device__ __forceinline__ void norms_phase(Frame& F, const bf16_t* proj, float* nrm) {
    const int gw = F.vcu * NWAVES + F.wave, NGW = F.G * NWAVES, lane = F.lane;
    for (int idx = gw; idx < 2 * 32 * 256; idx += NGW) {
        const int tensor = idx >> 13, stream = (idx >> 8) & 31, grp = idx & 255;
        const u32x4* rp = (const u32x4*)((const unsigned char*)proj + (tensor ? DK0 : 0) + ((size_t)stream * SEQ + grp * 64 + lane) * 128);
        float ss = 0.f;
#pragma unroll
        for (int q = 0; q < 8; ++q) { const u32x4 v = rp[q];
#pragma unroll
            for (int e = 0; e < 4; ++e) { const float a0 = __builtin_amdgcn_cvt_f32_fp8((int)v[e], 0), a1 = __builtin_amdgcn_cvt_f32_fp8((int)v[e], 1), a2 = __builtin_amdgcn_cvt_f32_fp8((int)v[e], 2), a3 = __builtin_amdgcn_cvt_f32_fp8((int)v[e], 3);
                ss += (a0 * a0 + a1 * a1) + (a2 * a2 + a3 * a3); } }
        float n = sqrtf(ss) * 1.001f;
#pragma unroll
        for (int o = 1; o < 64; o <<= 1) n = fmaxf(n, __shfl_xor(n, o));
        if (lane == 0) nrm[idx] = n;
    }
}

__device__ __forceinline__ void attn_item(LAS unsigned char* lds, const bf16_t* proj, const float* nrm, bf16_t* oout, int b, int h, int sub, int qb, int tid, int wid, int lane, unsigned* queue, LAS int* qnext) {
    asm volatile("" : "+v"(lane));
    const int r32 = lane & 31, hi = lane >> 5;
    const float slope = __builtin_amdgcn_exp2f(-(float)(h + 1));
    const float sl2 = slope * 1.4426950408889634f, rawu = sl2 / C2;
    LAS float* ws = (LAS float*)(lds + SCR_OFF) + wid * 64; LAS float* li_l = ws; LAS float* al_l = ws + 32;
    const size_t tokq = (size_t)b * SEQ + (size_t)qb * 256 + wid * 32;
    const bf16_t* kbase = (const bf16_t*)((const unsigned char*)proj + DK0 + dq_off(b, 0, h, sub));
    const bf16_t* vbase = (const bf16_t*)((const unsigned char*)proj + pg8::vt_off(b, h, 0));
    int j_lo;
    { const int stream = (b * 8 + h) * 2 + sub; const float* qn = nrm + stream * 256; const float* kn = nrm + 8192 + stream * 256;
      const float Qn = fmaxf(fmaxf(qn[4 * qb], qn[4 * qb + 1]), fmaxf(qn[4 * qb + 2], qn[4 * qb + 3]));
      const float Kd = fmaxf(fmaxf(kn[4 * qb], kn[4 * qb + 1]), fmaxf(kn[4 * qb + 2], kn[4 * qb + 3]));
      int cand = 4 * qb;
      float kv[4];
#pragma unroll
      for (int u = 0; u < 4; ++u) { const int jj = lane + 64 * u; kv[u] = kn[jj < 4 * qb ? jj : 0]; }
#pragma unroll
      for (int u = 0; u < 4; ++u) { const int jj = lane + 64 * u; const float dmin = (float)(256 * qb - (64 * jj + 63)); const bool skip = slope * dmin > 110.f + SCALE * Qn * (kv[u] + Kd); if (jj < 4 * qb && !skip) cand = cand < jj ? cand : jj; }
#pragma unroll
      for (int o = 1; o < 64; o <<= 1) { const int v = __builtin_amdgcn_ds_bpermute((lane ^ o) << 2, cand); cand = v < cand ? v : cand; }
      j_lo = __builtin_amdgcn_readfirstlane(cand); }
    v8i32 qf[2];
    { const unsigned char* qrow = (const unsigned char*)proj + dq_off(b, qb * 256 + wid * 32 + r32, h, sub) + 32 * hi;
#pragma unroll
      for (int s = 0; s < 2; ++s) { const v4i32 x0 = *(const v4i32*)(qrow + 64 * s), x1 = *(const v4i32*)(qrow + 64 * s + 16); qf[s] = __builtin_shufflevector(x0, x1, 0, 1, 2, 3, 4, 5, 6, 7); } }
    const float sh64 = 64.f * rawu;
    f32x16 bias;
#pragma unroll
    for (int r = 0; r < 16; ++r) bias[r] = (float)((r & 3) + 8 * (r >> 2)) * rawu;
    const int qi = 32 * (wid & 1) + r32;
    const LAS unsigned char* vb0 = lds + V_OFF + r32 * 64 + (((2 * hi) ^ ((r32 >> 2) & 3)) << 4);
    float m_reg = -1e30f, l_reg = 0.f;
    f32x16 o[8];
#pragma unroll
    for (int d = 0; d < 8; ++d)
#pragma unroll
        for (int r = 0; r < 16; ++r) o[d][r] = 0.f;
    const int NT = 4 * qb + 4, myNT = 4 * qb + (wid >> 1) + 1;
    constexpr size_t KSTEP = 64 * 128 / 2, VSTEP = 256 * 64 / 2;
    const bool late = wid >= 4;
#define ATT_STAGE(jj, sl) stage_tile(lds, sl, kbase + (size_t)(jj) * KSTEP, vbase + (size_t)(jj) * VSTEP, tid, wid)
#define ATT_NEXT(s_) ((s_) == NSLOT - 1 ? 0 : (s_) + 1)
#define ATT_WAIT(j_) do { const int rem_ = NT - 2 - (j_); if (rem_ >= 2) asm volatile("s_waitcnt vmcnt(6)" ::: "memory"); else if (rem_ == 1) asm volatile("s_waitcnt vmcnt(3)" ::: "memory"); \
        else asm volatile("s_waitcnt vmcnt(0)" ::: "memory"); WG_BAR(); } while (0)
    int s0 = j_lo % NSLOT;
    { const int s1 = ATT_NEXT(s0), s2 = ATT_NEXT(s1); ATT_STAGE(j_lo, s0); ATT_STAGE(j_lo + 1, s1); ATT_STAGE(j_lo + 2, s2); }
    asm volatile("s_waitcnt vmcnt(6)" ::: "memory"); WG_BAR();
    if (!late) {
        for (int j = j_lo; j < NT; ++j) {
            const int s1 = ATT_NEXT(s0);
            if (j + 3 < NT) { const int s3 = ATT_NEXT(ATT_NEXT(s1)); ATT_STAGE(j + 3, s3); }
            if (j < myNT) { if (j > j_lo) m_reg -= sh64;
                v8i32 pa; int pscl;
                qk_softmax(lds + K_OFF + s0 * SHM_K, r32, hi, al_l, qf, bias, o, pa, pscl, m_reg, l_reg, rawu, sl2, j == myNT - 1, qi);
                pv_tile(o, vb0 + s0 * SHM_V, pa, pscl); }
            ATT_WAIT(j);
            s0 = s1;
        }
    } else {
        v8i32 pa; int pscl = 127;
#pragma unroll
        for (int g = 0; g < 8; ++g) pa[g] = 0;
        int sp = s0;
        for (int j = j_lo; j < NT; ++j) {
            const int s1 = ATT_NEXT(s0);
            if (j + 3 < NT) { const int s3 = ATT_NEXT(ATT_NEXT(s1)); ATT_STAGE(j + 3, s3); }
            if (j > j_lo && j - 1 < myNT) pv_tile(o, vb0 + sp * SHM_V, pa, pscl);
            if (j < myNT) { if (j > j_lo) m_reg -= sh64;
                qk_softmax(lds + K_OFF + s0 * SHM_K, r32, hi, al_l, qf, bias, o, pa, pscl, m_reg, l_reg, rawu, sl2, j == myNT - 1, qi); }
            ATT_WAIT(j);
            sp = s0; s0 = s1;
        }
        if (myNT == NT) pv_tile(o, vb0 + sp * SHM_V, pa, pscl);
    }
#undef ATT_WAIT
#undef ATT_NEXT
#undef ATT_STAGE
    int jn_ = 0; if (tid == 0) jn_ = (int)__hip_atomic_fetch_add(queue, 1u, __ATOMIC_RELAXED, __HIP_MEMORY_SCOPE_AGENT);
    if (hi == 0) li_l[r32] = l_reg;
    LDS_WAIT();
    char* Ow = (char*)(oout + tokq * D + h * 256);
    const unsigned lofs = (unsigned)(hi * 4 * D + r32) * 2u;
#pragma unroll
    for (int r = 0; r < 16; ++r) { const float rl = __builtin_amdgcn_rcpf(li_l[crow(r, hi)]);
#pragma unroll
        for (int d0 = 0; d0 < 8; ++d0) { const float v = o[d0][r] * rl; const float vn = __uint_as_float((unsigned)__builtin_amdgcn_ds_bpermute((lane ^ 1) << 2, (int)__float_as_uint(v)));
            if ((r32 & 1) == 0) *(unsigned*)(Ow + (lofs + (unsigned)((((r & 3) + 8 * (r >> 2)) * D + d0 * 32) * 2))) = cvt_pk_bf16(v, vn); } }
    if (tid == 0) *qnext = jn_;
    WG_BAR();
}

struct TailConv { const float* wg; const float* wu; const float* wd; bf16_t* gu; bf16_t* dt; };
__device__ __forceinline__ void attn_phase(Frame& F, const bf16_t* proj, const float* nrm, unsigned* queue, bf16_t* o1, bf16_t* o2, const TailConv tc) {
    LAS int* qw = (LAS int*)(F.lds + SCR_OFF + 8 * 256);
    if (F.tid == 0) qw[0] = (int)__hip_atomic_fetch_add(queue, 1u, __ATOMIC_RELAXED, __HIP_MEMORY_SCOPE_AGENT);
    WG_BAR();
    for (int n = 0;; ++n) {
        const int J = __builtin_amdgcn_readfirstlane(qw[n & 1]);
        if (J >= 2048 + 512) break;
        const int grp = J / 5, rr = J - 5 * grp;
        if (rr == 4) { int jn_ = 0; if (F.tid == 0) jn_ = (int)__hip_atomic_fetch_add(queue, 1u, __ATOMIC_RELAXED, __HIP_MEMORY_SCOPE_AGENT);
            conv_moe(F, tc.wg, tc.wu, tc.wd, tc.gu, tc.dt, grp, 512, L1_EARLY, NEXP - L1_EARLY); if (F.tid == 0) qw[(n + 1) & 1] = jn_; WG_BAR(); continue; }
        const int I = 4 * grp + rr;
        const int qb = 63 - (I >> 5), r = I & 31, h = 7 - (r >> 2), b = (r >> 1) & 1, sub = r & 1;
        attn_item(F.lds, proj, nrm, sub ? o2 : o1, b, h, sub, qb, F.tid, F.wave, F.lane, queue, qw + ((n + 1) & 1));
    }
}
}

__device__ __forceinline__ const void* karg(int i) { int j = i; asm volatile("" : "+s"(j)); return ((const void* const __attribute__((address_space(4)))*)__builtin_amdgcn_kernarg_segment_ptr())[j]; }
#if defined(__HIP_DEVICE_COMPILE__)
#define NO_PK_F32 __attribute__((target("no-packed-fp32-ops")))
#else
#define NO_PK_F32
#endif
__global__ void __launch_bounds__(NWAVES * 64, 2) NO_PK_F32 hybrid_fwd(Args args) {
    extern __shared__ __attribute__((aligned(16))) unsigned char lds_raw[];
    Frame F;
    F.lds = (LAS unsigned char*)lds_raw;
    F.tid = threadIdx.x; F.lane = F.tid & 63; F.wave = __builtin_amdgcn_readfirstlane(F.tid >> 6);
    F.G = gridDim.x; { const int bx = blockIdx.x; F.vcu = (F.G % 8 == 0) ? (bx % 8) * (F.G / 8) + bx / 8 : bx; }
#define ws ((unsigned char*)karg(22))
#define ctl ((unsigned*)(ws + WS_CTL))
    for (int u = F.tid; u < (LDS_BYTES - LDSCTL_OFF) / 4; u += NWAVES * 64) ((LAS unsigned*)(F.lds + LDSCTL_OFF))[u] = 0u;
    SYNCTHREADS();
    ((LAS int*)(F.lds + TIDS_OFF))[F.tid] = F.tid;
    SYNCTHREADS();
    volatile LAS unsigned* MISC = (volatile LAS unsigned*)(F.lds + MISC_OFF);
    XcdBarrier bar = xcd_barrier_post(ctl + CW_BAR, MISC + 8);
#define GRID_BAR() do { XcdBarrier bb_ = bar; unsigned x_ = bar.x; unsigned long long bp_ = (unsigned long long)bar.bar; asm volatile("" : "+s"(x_), "+s"(bp_)); bb_.x = x_; bb_.bar = (unsigned*)bp_; xcd_barrier(bb_, TID_RELOAD() == 0); } while (0)
#define TID_RELOAD() (F.wave * 64 + lane_id_volatile())
#ifdef ONLY_PHASE
#define PHON(n) ((n) == ONLY_PHASE)
#else
#define PHON(n) 1
#endif

#define x_in ((const float*)(karg(0)))
#define norm_mix ((const float*)(karg(1)))
#define norm_ffn ((const float*)(karg(2)))
#define gla_w_in ((const float*)(karg(3)))
#define gla_wgu ((const float*)(karg(4)))
#define gla_bg ((const float*)(karg(5)))
#define gla_norm ((const float*)(karg(6)))
#define gla_w_out ((const float*)(karg(7)))
#define diff_w_in ((const float*)(karg(8)))
#define lq1 ((const float*)(karg(9)))
#define lk1 ((const float*)(karg(10)))
#define lq2 ((const float*)(karg(11)))
#define lk2 ((const float*)(karg(12)))
#define diff_subln ((const float*)(karg(13)))
#define diff_w_out ((const float*)(karg(14)))
#define moe_wgrp ((const float*)(karg(15)))
#define moe_wexp ((const float*)(karg(16)))
#define moe_wg ((const float*)(karg(17)))
#define moe_wu ((const float*)(karg(18)))
#define moe_wd ((const float*)(karg(19)))
#define final_norm ((const float*)(karg(20)))
#define xres ((bf16_t*)(ws + WS_XRES))
#define gz ((float*)((float*)(ws + WS_GZ)))
#define tok_e ((int*)((int*)(ws + WS_TOKE)))
#define tok_p ((int*)((int*)(ws + WS_TOKP)))
#define tok_w ((float*)((float*)(ws + WS_TOKW)))
#define slot_of ((int*)((int*)(ws + WS_SLOT)))
#define slot_tok ((int*)(ws + WS_STOK))
#define adec ((float*)((float*)(ws + WS_ADEC)))
#define pcum ((float*)((float*)(ws + WS_PCUM)))
#define sfin ((bf16_t*)((bf16_t*)(ws + WS_SFIN)))
#define wp_gz ((float*)((float*)(ws + WS_WPGZ)))
#define wp_r0 ((float*)((float*)(ws + WS_WPR0)))
#define wp_r1 ((float*)((float*)(ws + WS_WPR1)))
#define wgi ((bf16_t*)((bf16_t*)(ws + WS_WGI)))
#define wgo ((bf16_t*)((bf16_t*)(ws + WS_WGO)))
#define wdi ((bf16_t*)((bf16_t*)(ws + WS_WDI)))
#define wdo ((bf16_t*)((bf16_t*)(ws + WS_WDO)))
#define wmoe_gu ((bf16_t*)((bf16_t*)(ws + WS_WMOE)))
#define wmoe_d ((bf16_t*)((bf16_t*)(ws + WS_WMOE_D)))
#define hn ((bf16_t*)((bf16_t*)(ws + WS_HN)))
#define proj ((bf16_t*)((bf16_t*)(ws + WS_PROJ)))
#define buf1 ((bf16_t*)((bf16_t*)(ws + WS_BUF1)))
#define buf2 ((bf16_t*)((bf16_t*)(ws + WS_BUF2)))
#define ag ((bf16_t*)((bf16_t*)(ws + WS_AG)))
#define ob ((bf16_t*)((bf16_t*)(ws + WS_OB)))
#define hh ((bf16_t*)((bf16_t*)(ws + WS_H)))
    const LAS int* pst = (const LAS int*)(F.lds + TAB_OFF);

    _Pragma("unroll") for (int rep_ = 0; rep_ < (REP_PHASE == 0 ? 2 : 1); ++rep_) if (PHON(0)) { if (rep_) GRID_BAR(); Frame P = F; P.tid = TID_RELOAD(); P.lane = P.tid & 63;
    conv_plain(P, gla_w_in, D, PROJW, GLA_INW, wgi, -1, 0, norm_mix);
    conv_plain(P, gla_w_out, D, D, D, wgo);
    pack_proj(P, wp_gz, 1, norm_mix, gla_w_in, GLA_INW, PROJW, 16, nullptr, 0, 0);
    pack_proj16(P, (bf16_t*)wp_r0, 3, norm_ffn, moe_wgrp, 4, 0, 4, moe_wexp, 32, 32);
    pack_proj16(P, (bf16_t*)wp_r1, 3, norm_ffn + D, moe_wgrp + (size_t)D * 4, 4, 0, 4, moe_wexp + (size_t)D * 32, 32, 32);
    }
    GRID_BAR();
    _Pragma("unroll") for (int rep_ = 0; rep_ < (REP_PHASE == 1 ? 2 : 1); ++rep_) if (PHON(1)) { if (rep_) GRID_BAR(); Frame P = F; P.tid = TID_RELOAD(); P.lane = P.tid & 63;
    phase_norm_gz(P, x_in, wp_gz, hn, gz, (float*)(ws + WS_PCUM));
    }
    GRID_BAR();
    _Pragma("unroll") for (int rep_ = 0; rep_ < (REP_PHASE == 2 ? 2 : 1); ++rep_) if (PHON(2)) { if (rep_) GRID_BAR(); Frame P = F; P.tid = TID_RELOAD(); P.lane = P.tid & 63;
    { pg8::Gemm g{hn, wgi, T, PROJW, D}; pg8::StaticOrder S; S.init(T, PROJW, P.G, (int)blockIdx.x); pg8::EpiHeads<0> E{proj, (const float*)(ws + WS_PCUM)};
      pg8::gemm_phase<pg8::EpiHeads<0>, pg8::StaticOrder>(P.lds, g, S, E, P.tid); }
    }
    GRID_BAR();
    _Pragma("unroll") for (int rep_ = 0; rep_ < (REP_PHASE == 3 ? 2 : 1); ++rep_) if (PHON(3)) { if (rep_) GRID_BAR(); Frame P = F; P.tid = TID_RELOAD(); P.lane = P.tid & 63;
    phase_gla_gate(P, gz, gla_wgu, gla_bg, proj, buf1, adec);
    }
    GRID_BAR();
    _Pragma("unroll") for (int rep_ = 0; rep_ < (REP_PHASE == 4 ? 2 : 1); ++rep_) if (PHON(4)) { if (rep_) GRID_BAR(); Frame P = F; P.tid = TID_RELOAD(); P.lane = P.tid & 63;
    if (P.G == 256) { if ((P.vcu & 1) == 0) phase_gla_scan(P, P.vcu >> 1, proj, buf1, adec, buf2, sfin); else { gla_pcum(P, adec, pcum, P.vcu >> 1, 128); conv_moe(P, moe_wg, moe_wu, moe_wd, wmoe_gu, wmoe_d, P.vcu >> 1, 128);
            conv_moe(P, moe_wg + (size_t)NEXP * D * DFF, moe_wu + (size_t)NEXP * D * DFF, moe_wd + (size_t)NEXP * DFF * D, (bf16_t*)(ws + WS_WMOE1), (bf16_t*)(ws + WS_WMOE1_D), P.vcu >> 1, 128, 0, L1_EARLY);
            conv_plain<true>(P, diff_w_in, D, PROJW, PROJW, wdi, P.vcu >> 1, 128); conv_plain<true>(P, diff_w_out, D, D, D, wdo, P.vcu >> 1, 128); } }
    else { for (int it = P.vcu; it < 128; it += P.G) phase_gla_scan(P, it, proj, buf1, adec, buf2, sfin); gla_pcum(P, adec, pcum, P.vcu, P.G); conv_moe(P, moe_wg, moe_wu, moe_wd, wmoe_gu, wmoe_d); conv_moe(P, moe_wg + (size_t)NEXP * D * DFF, moe_wu + (size_t)NEXP * D * DFF, moe_wd + (size_t)NEXP * DFF * D, (bf16_t*)(ws + WS_WMOE1), (bf16_t*)(ws + WS_WMOE1_D), -1, 0, 0, L1_EARLY); conv_plain<true>(P, diff_w_in, D, PROJW, PROJW, wdi); conv_plain<true>(P, diff_w_out, D, D, D, wdo); }
    GRID_BAR();
    phase_gla_qp(P, proj, pcum, buf1);
    GRID_BAR();
    { pg8::Gemm g{buf1, sfin, 8 * (SEQ / 2), 512, 256}; pg8::FixOrder S; S.init(8 * (SEQ / 2), 512, P.G, (int)blockIdx.x); pg8::EpiAddO E{buf2};
      pg8::gemm_phase<pg8::EpiAddO, pg8::FixOrder>(P.lds, g, S, E, P.tid); }
    }
    GRID_BAR();
    _Pragma("unroll") for (int rep_ = 0; rep_ < (REP_PHASE == 5 ? 2 : 1); ++rep_) if (PHON(5)) { if (rep_) GRID_BAR(); Frame P = F; P.tid = TID_RELOAD(); P.lane = P.tid & 63;
    phase_gla_gnorm(P, buf2, proj, gla_norm, buf1);
    }
    GRID_BAR();
    _Pragma("unroll") for (int rep_ = 0; rep_ < (REP_PHASE == 6 ? 2 : 1); ++rep_) if (PHON(6)) { if (rep_) GRID_BAR(); Frame P = F; P.tid = TID_RELOAD(); P.lane = P.tid & 63;
    { pg8::Gemm g{buf1, wgo, T, D, D}; pg8::StaticOrder S; S.init(T, D, P.G, (int)blockIdx.x); pg8::EpiRes16<true> E{hn, xres, D};
      pg8::gemm_phase<pg8::EpiRes16<true>, pg8::StaticOrder>(P.lds, g, S, E, P.tid); }
    }
    GRID_BAR();
    _Pragma("unroll") for (int rep_ = 0; rep_ < (REP_PHASE == 7 ? 2 : 1); ++rep_) if (PHON(7)) { if (rep_) GRID_BAR(); Frame P = F; P.tid = TID_RELOAD(); P.lane = P.tid & 63;
    phase_norm_route(P, xres, norm_ffn, wp_r0, hn, tok_e, tok_p, tok_w, ctl + CW_CNT0);
    }
    GRID_BAR();
    _Pragma("unroll") for (int rep_ = 0; rep_ < (REP_PHASE == 8 ? 2 : 1); ++rep_) if (PHON(8)) { if (rep_) GRID_BAR(); Frame P = F; P.tid = TID_RELOAD(); P.lane = P.tid & 63;
    moe_tables(P, ctl + CW_CNT0);
    phase_moe_slots(P, tok_e, tok_p, ctl + CW_CNT0, slot_of, slot_tok);
    }
    GRID_BAR();
    _Pragma("unroll") for (int rep_ = 0; rep_ < (REP_PHASE == 9 ? 2 : 1); ++rep_) if (PHON(9)) { if (rep_) GRID_BAR(); Frame P = F; P.tid = TID_RELOAD(); P.lane = P.tid & 63;
    { const int Mr = pst[33] * 256; pg8::Gemm g{hn, wmoe_gu, Mr, 1024, D}; pg8::MoeOrder S; S.init(Mr, 1024, P.G, (int)blockIdx.x); S.te = pst + 36; S.estride = (size_t)1024 * D; S.stok = slot_tok; pg8::EpiSiluMul E{(unsigned char*)hh};
      pg8::gemm_phase<pg8::EpiSiluMul, pg8::MoeOrder, true, true>(P.lds, g, S, E, P.tid); }
    }
    GRID_BAR();
    _Pragma("unroll") for (int rep_ = 0; rep_ < (REP_PHASE == 10 ? 2 : 1); ++rep_) if (PHON(10)) { if (rep_) GRID_BAR(); Frame P = F; P.tid = TID_RELOAD(); P.lane = P.tid & 63;
    { const int Mr = pst[33] * 256; pg8::Gemm g{hh, wmoe_d, Mr, D, DFF}; pg8::MoeOrder S; S.init(Mr, D, P.G, (int)blockIdx.x); S.te = pst + 36; S.estride = (size_t)D * DFF; S.stok = slot_tok; pg8::EpiF8x8 E{(unsigned char*)ob, D};
      pg8::gemm_phase<pg8::EpiF8x8, pg8::MoeOrder, false, true>(P.lds, g, S, E, P.tid); }
    }
    GRID_BAR();
    _Pragma("unroll") for (int rep_ = 0; rep_ < (REP_PHASE == 11 ? 2 : 1); ++rep_) if (PHON(11)) { if (rep_) GRID_BAR(); Frame P = F; P.tid = TID_RELOAD(); P.lane = P.tid & 63;
    phase_moe_combine<0>(P, xres, nullptr, ob, slot_of, tok_w, norm_mix + D, hn);
    }
    GRID_BAR();
    _Pragma("unroll") for (int rep_ = 0; rep_ < (REP_PHASE == 12 ? 2 : 1); ++rep_) if (PHON(12)) { if (rep_) GRID_BAR(); Frame P = F; P.tid = TID_RELOAD(); P.lane = P.tid & 63;
    { pg8::Gemm g{hn, wdi, T, 4096, D}; pg8::StaticOrder S; S.init(T, 4096, P.G, (int)blockIdx.x); pg8::EpiHeads<1> E{proj, nullptr};
      pg8::gemm_phase<pg8::EpiHeads<1>, pg8::StaticOrder, false, true>(P.lds, g, S, E, P.tid); }
    { pg8::Gemm g{hn, (const bf16_t*)((const unsigned char*)wdi + (size_t)4096 * D), T, 2048, D}; pg8::StaticOrder S; S.init(T, 2048, P.G, (int)blockIdx.x); pg8::EpiVT E{(unsigned char*)proj};
      pg8::gemm_phase<pg8::EpiVT, pg8::StaticOrder, false, true, true>(P.lds, g, S, E, P.tid); }
    GRID_BAR();
    att::norms_phase(P, proj, (float*)(ws + WS_NRM));
    }
    GRID_BAR();
    _Pragma("unroll") for (int rep_ = 0; rep_ < (REP_PHASE == 13 ? 2 : 1); ++rep_) if (PHON(13)) { if (rep_) GRID_BAR(); Frame P = F; P.tid = TID_RELOAD(); P.lane = P.tid & 63;
    att::attn_phase(P, proj, (const float*)(ws + WS_NRM), ctl + CW_QUEUE + 64 * rep_, buf1, buf2, att::TailConv{moe_wg + (size_t)NEXP * D * DFF, moe_wu + (size_t)NEXP * D * DFF, moe_wd + (size_t)NEXP * DFF * D, (bf16_t*)(ws + WS_WMOE1), (bf16_t*)(ws + WS_WMOE1_D)});
    }
    GRID_BAR();
    _Pragma("unroll") for (int rep_ = 0; rep_ < (REP_PHASE == 14 ? 2 : 1); ++rep_) if (PHON(14)) { if (rep_) GRID_BAR(); Frame P = F; P.tid = TID_RELOAD(); P.lane = P.tid & 63;
    phase_subln(P, buf1, buf2, lq1, lk1, lq2, lk2, diff_subln, hn);
    }
    GRID_BAR();
    _Pragma("unroll") for (int rep_ = 0; rep_ < (REP_PHASE == 15 ? 2 : 1); ++rep_) if (PHON(15)) { if (rep_) GRID_BAR(); Frame P = F; P.tid = TID_RELOAD(); P.lane = P.tid & 63;
    { pg8::Gemm g{hn, wdo, T, D, D}; pg8::StaticOrder S; S.init(T, D, P.G, (int)blockIdx.x); pg8::EpiRes16<true> E{xres, xres, D};
      pg8::gemm_phase<pg8::EpiRes16<true>, pg8::StaticOrder, false, true>(P.lds, g, S, E, P.tid); }
    }
    GRID_BAR();
    _Pragma("unroll") for (int rep_ = 0; rep_ < (REP_PHASE == 16 ? 2 : 1); ++rep_) if (PHON(16)) { if (rep_) GRID_BAR(); Frame P = F; P.tid = TID_RELOAD(); P.lane = P.tid & 63;
    phase_norm_route(P, xres, norm_ffn + D, wp_r1, hn, tok_e, tok_p, tok_w, ctl + CW_CNT1);
    }
    GRID_BAR();
    _Pragma("unroll") for (int rep_ = 0; rep_ < (REP_PHASE == 17 ? 2 : 1); ++rep_) if (PHON(17)) { if (rep_) GRID_BAR(); Frame P = F; P.tid = TID_RELOAD(); P.lane = P.tid & 63;
    moe_tables(P, ctl + CW_CNT1);
    phase_moe_slots(P, tok_e, tok_p, ctl + CW_CNT1, slot_of, slot_tok);
    }
    GRID_BAR();
    _Pragma("unroll") for (int rep_ = 0; rep_ < (REP_PHASE == 18 ? 2 : 1); ++rep_) if (PHON(18)) { if (rep_) GRID_BAR(); Frame P = F; P.tid = TID_RELOAD(); P.lane = P.tid & 63;
    { const int Mr = pst[33] * 256; pg8::Gemm g{hn, (bf16_t*)(ws + WS_WMOE1), Mr, 1024, D}; pg8::MoeOrder S; S.init(Mr, 1024, P.G, (int)blockIdx.x); S.te = pst + 36; S.estride = (size_t)1024 * D; S.stok = slot_tok; pg8::EpiSiluMul E{(unsigned char*)hh};
      pg8::gemm_phase<pg8::EpiSiluMul, pg8::MoeOrder, true, true>(P.lds, g, S, E, P.tid); }
    }
    GRID_BAR();
    _Pragma("unroll") for (int rep_ = 0; rep_ < (REP_PHASE == 19 ? 2 : 1); ++rep_) if (PHON(19)) { if (rep_) GRID_BAR(); Frame P = F; P.tid = TID_RELOAD(); P.lane = P.tid & 63;
    { const int Mr = pst[33] * 256; pg8::Gemm g{hh, (bf16_t*)(ws + WS_WMOE1_D), Mr, D, DFF}; pg8::MoeOrder S; S.init(Mr, D, P.G, (int)blockIdx.x); S.te = pst + 36; S.estride = (size_t)D * DFF; S.stok = slot_tok; pg8::EpiF8x8 E{(unsigned char*)ob, D};
      pg8::gemm_phase<pg8::EpiF8x8, pg8::MoeOrder, false, true>(P.lds, g, S, E, P.tid); }
    }
    GRID_BAR();
    _Pragma("unroll") for (int rep_ = 0; rep_ < (REP_PHASE == 20 ? 2 : 1); ++rep_) if (PHON(20)) { if (rep_) GRID_BAR(); Frame P = F; P.tid = TID_RELOAD(); P.lane = P.tid & 63;
    phase_moe_combine<1>(P, xres, (float*)(karg(21)), ob, slot_of, tok_w, final_norm, hn);
    }
}

#undef x_in
#undef norm_mix
#undef norm_ffn
#undef gla_w_in
#undef gla_wgu
#undef gla_bg
#undef gla_norm
#undef gla_w_out
#undef diff_w_in
#undef lq1
#undef lk1
#undef lq2
#undef lk2
#undef diff_subln
#undef diff_w_out
#undef moe_wgrp
#undef moe_wexp
#undef moe_wg
#undef moe_wu
#undef moe_wd
#undef final_norm
#undef xres
#undef gz
#undef tok_e
#undef tok_p
#undef tok_w
#undef slot_of
#undef slot_tok
#undef ws
#undef ctl
#undef adec
#undef pcum
#undef sfin
#undef wp_gz
#undef wp_r0
#undef wp_r1
#undef wgi
#undef wgo
#undef wdi
#undef wdo
#undef wmoe_gu
#undef wmoe_d
#undef hn
#undef proj
#undef buf1
#undef buf2
#undef ag
#undef ob
#undef hh

extern "C" void kernel_launch(void* const* d_in, const int* in_sizes, int n_in, void* d_out, int out_size, void* d_ws, size_t ws_size, hipStream_t stream) {
    static int grid = 0;
    if (grid == 0) {
        if (n_in != 21 || out_size != T * D || ws_size < WS_END) { fprintf(stderr, "kernel_launch: unexpected shapes (n_in %d out %d ws %zu)\n", n_in, out_size, ws_size); grid = -1; return; }
        if (hipFuncSetAttribute((const void*)hybrid_fwd, hipFuncAttributeMaxDynamicSharedMemorySize, LDS_BYTES) != hipSuccess) { fprintf(stderr, "kernel_launch: hipFuncSetAttribute failed\n"); grid = -1; return; }
        int dev = 0, cus = 0, per_cu = 0;
        (void)hipGetDevice(&dev); (void)hipDeviceGetAttribute(&cus, hipDeviceAttributeMultiprocessorCount, dev);
        if (hipOccupancyMaxActiveBlocksPerMultiprocessor(&per_cu, (const void*)hybrid_fwd, NWAVES * 64, LDS_BYTES) != hipSuccess || per_cu < 1) fprintf(stderr, "kernel_launch: occupancy query says %d\n", per_cu);
        (void)hipGetLastError();
        grid = cus > 0 ? cus : 256;
    }
    if (grid < 0) return;
    Args a{};
    for (int i = 0; i < 21; ++i) a.in[i] = (const float*)d_in[i];
    a.out = (float*)d_out; a.ws = (unsigned char*)d_ws; a.pad0 = 0; a.pad1 = 0;
    (void)hipMemsetAsync((char*)d_ws + WS_CTL, 0, CTL_ZERO_BYTES, stream);
    hipLaunchKernelGGL(hybrid_fwd, dim3(grid), dim3(NWAVES * 64), LDS_BYTES, stream, a);
}
```

```cpp
#ifndef REP_PHASE
#define REP_PHASE -1
#endif
#include <hip/hip_runtime.h>
#include <cstdio>
#include <cstdint>

#define LAS __attribute__((address_space(3)))
#define GAS __attribute__((address_space(1)))
typedef unsigned short bf16_t;
typedef short bf16x8 __attribute__((ext_vector_type(8)));
typedef short s16x4 __attribute__((ext_vector_type(4)));
typedef float f32x4 __attribute__((ext_vector_type(4)));
typedef float f32x2 __attribute__((ext_vector_type(2)));
typedef float f32x16 __attribute__((ext_vector_type(16)));
typedef unsigned u32x4 __attribute__((ext_vector_type(4)));
typedef unsigned u32x2 __attribute__((ext_vector_type(2)));
typedef int v8i32 __attribute__((ext_vector_type(8)));
typedef int v4i32 __attribute__((ext_vector_type(4)));

constexpr int D = 2048, SEQ = 16384, NBATCH = 2, T = NBATCH * SEQ, CHUNK = 64, NCH = SEQ / CHUNK;
constexpr int GLA_H = 4, GLA_DK = 256, GLA_DV = 512, GLA_DKT = 1024, GLA_INW = 6160, PROJW = 6144;
constexpr int DIFF_H = 8;
constexpr int NEXP = 32, DFF = 512;
constexpr float RMS_EPS = 1e-6f;
constexpr float LAMBDA_INIT = 0.35550906759f;
constexpr int MAX_TILES = 288;

constexpr int L1_EARLY = 16;
constexpr size_t MiB = 1u << 20;
constexpr size_t WS_CTL = 0, CTL_ZERO_BYTES = 1 * MiB;
constexpr size_t WS_GZ = 2 * MiB;
constexpr size_t WS_TOKE = 4 * MiB;
constexpr size_t WS_TOKP = WS_TOKE + 256 * 1024;
constexpr size_t WS_TOKW = WS_TOKP + 256 * 1024;
constexpr size_t WS_SLOT = WS_TOKW + 256 * 1024;
constexpr size_t WS_STOK = 5 * MiB;
constexpr size_t WS_ADEC = 8 * MiB;
constexpr size_t WS_WPGZ = 10 * MiB;
constexpr size_t WS_WPR0 = 10 * MiB + 256 * 1024;
constexpr size_t WS_WPR1 = 11 * MiB;
constexpr size_t WS_NRM = 12 * MiB;
constexpr size_t WS_PCUM = 13 * MiB;
constexpr size_t WS_SFIN = 14 * MiB;
constexpr size_t WS_WGI = 16 * MiB, WS_WGO = 40 * MiB, WS_WDI = 48 * MiB, WS_WDO = 72 * MiB;
constexpr size_t WS_WMOE = 80 * MiB;
constexpr size_t WS_WMOE_D = WS_WMOE + 128 * MiB;
constexpr size_t WS_WMOE1 = WS_WMOE + 64 * MiB, WS_WMOE1_D = WS_WMOE + 160 * MiB;
constexpr size_t WS_HN = 272 * MiB;
constexpr size_t WS_PROJ = 400 * MiB;
constexpr size_t WS_BUF1 = 784 * MiB;
constexpr size_t WS_BUF2 = 912 * MiB;
constexpr size_t WS_XRES = 528 * MiB;
constexpr size_t WS_AG = 400 * MiB;
constexpr size_t WS_OB = 688 * MiB;
constexpr size_t WS_H = 976 * MiB;
constexpr size_t WS_END = 1048 * MiB;
constexpr int CW_BAR = 4096;
constexpr int CW_QUEUE = 8192;
constexpr int CW_CNT0 = 16384, CW_CNT1 = 16384 + 32 * 64;


constexpr size_t GK0 = (size_t)T * 1024, GV0 = (size_t)T * 2048, GR0 = (size_t)T * 4096;
constexpr size_t DK0 = (size_t)T * 2048, DV0 = (size_t)T * 4096;
__host__ __device__ __forceinline__ size_t gq_off(int b, int t, int h) { return ((size_t)(b * 4 + h) * SEQ + t) * 256; }
__host__ __device__ __forceinline__ size_t gv_off(int b, int t, int h) { return GV0 + ((size_t)(b * 4 + h) * SEQ + t) * 512; }
__host__ __device__ __forceinline__ size_t dq_off(int b, int t, int h, int sub) { return ((size_t)((b * 8 + h) * 2 + sub) * SEQ + t) * 128; }
__host__ __device__ __forceinline__ size_t dv_off(int b, int t, int h) { return DV0 + ((size_t)(b * 8 + h) * SEQ + t) * 256; }

constexpr int RING_BYTES = 131072;
constexpr int LDSCTL_OFF = RING_BYTES;
constexpr int MISC_OFF = LDSCTL_OFF + 320;
constexpr int TIDS_OFF = LDSCTL_OFF + 8192;
constexpr int TAB_OFF = LDSCTL_OFF + 1024;
constexpr int LDS_BYTES = 147456;
constexpr int NWAVES = 8;

typedef __bf16 bf16x2_t __attribute__((ext_vector_type(2)));
__device__ __forceinline__ unsigned cvt_pk_bf16(float lo, float hi) { const f32x2 v = {lo, hi}; return __builtin_bit_cast(unsigned, __builtin_convertvector(v, bf16x2_t)); }
__device__ __forceinline__ unsigned cvt4_fp8(float a, float b, float c, float d) { int v = __builtin_amdgcn_cvt_pk_fp8_f32(a, b, 0, false); return (unsigned)__builtin_amdgcn_cvt_pk_fp8_f32(c, d, v, true); }
constexpr float W8_SCALE = 64.f;
__device__ __forceinline__ float bf_lo(unsigned w) { return __uint_as_float(w << 16); }
__device__ __forceinline__ float bf_hi(unsigned w) { return __uint_as_float(w & 0xffff0000u); }
__device__ __forceinline__ f32x4 bf4_expand(u32x2 w) { return (f32x4){bf_lo(w.x), bf_hi(w.x), bf_lo(w.y), bf_hi(w.y)}; }
template <bool B16> struct XRow { typedef f32x4 T; static __device__ __forceinline__ f32x4 get(const f32x4& v) { return v; } };
template <> struct XRow<true> { typedef u32x2 T; static __device__ __forceinline__ f32x4 get(const u32x2& v) { return bf4_expand(v); } };
__device__ __forceinline__ float bf2f(bf16_t b) { return __uint_as_float(((unsigned)b) << 16); }
__device__ __forceinline__ float wave_sum(float v) {
#pragma unroll
    for (int o = 1; o < 64; o <<= 1) v += __shfl_xor(v, o);
    return v;
}
__device__ __forceinline__ int lane_id() { return (int)__builtin_amdgcn_mbcnt_hi(~0u, __builtin_amdgcn_mbcnt_lo(~0u, 0u)); }
__device__ __forceinline__ int lane_id_volatile() { int l; asm volatile("v_mbcnt_lo_u32_b32 %0, -1, 0\n\tv_mbcnt_hi_u32_b32 %0, -1, %0" : "=v"(l)); return l; }
__device__ __forceinline__ int opq(int v) { asm volatile("" : "+v"(v)); return v; }
#define LDS_WAIT() asm volatile("s_waitcnt lgkmcnt(0)" ::: "memory")
#define VM_WAIT() asm volatile("s_waitcnt vmcnt(0)" ::: "memory")
#define SYNCTHREADS() do { __builtin_amdgcn_fence(__ATOMIC_RELEASE, "workgroup"); __builtin_amdgcn_s_barrier(); __builtin_amdgcn_fence(__ATOMIC_ACQUIRE, "workgroup"); } while (0)
#define WG_BAR() do { asm volatile("s_waitcnt lgkmcnt(0)" ::: "memory"); __builtin_amdgcn_s_barrier(); asm volatile("" ::: "memory"); } while (0)

namespace pg8 {
constexpr int BM = 256, BK = 64, HALF = 128, HTB = HALF * BK * 2, STAGE_BYTES = 8 * HTB, NXCD = 8, WGM = 8;
__host__ __device__ __forceinline__ int lds_byte(int r, int c) { const int st = (r >> 4) * 2 + (c >> 5), rr = r & 15, cc = c & 31, ob = rr * 64 + cc * 2; return st * 1024 + (ob ^ (((ob >> 9) & 1) << 5)); }
__host__ __device__ __forceinline__ void stage_rc(int b, int& R, int& C) { const int st = b / 1024, sb = b % 1024, swz = sb ^ (((sb >> 9) & 1) << 5); R = (st >> 1) * 16 + swz / 64; C = (st & 1) * 32 + (swz % 64) / 2; }
__host__ __device__ __forceinline__ int perm32(int rho) { const int n = rho >> 4, i = rho & 15; return 8 * (i >> 2) + 4 * n + (i & 3); }

struct Unit { int pm, pn; };
struct Gemm { const bf16_t* A; const bf16_t* Bt; int M, N, K; };

struct StaticOrder {
    int nM, nN, nwg, G, c;
    __device__ __forceinline__ void init(int M, int N, int G_, int c_) { nM = M / BM; nN = N / BM; nwg = nM * nN; G = G_; c = c_; }
    __device__ __forceinline__ bool next(int i, Unit& u) const {
        const long L = (long)i * G + c; if (L >= nwg) return false;
        int wgid = (int)L; { const int q = nwg / NXCD, r = nwg % NXCD, xcd = wgid % NXCD, off = wgid / NXCD; wgid = (xcd < r ? xcd * (q + 1) : r * (q + 1) + (xcd - r) * q) + off; }
        const int nig = WGM * nN, gid = wgid / nig, fm = gid * WGM, gsz = (nM - fm) < WGM ? (nM - fm) : WGM;
        u.pm = fm + ((wgid % nig) % gsz); u.pn = (wgid % nig) / gsz; return true;
    }
    __device__ __forceinline__ size_t bofs(const Unit&) const { return 0; }
};
struct MoeOrder : StaticOrder {
    const LAS int* te; size_t estride; const int* stok;
    __device__ __forceinline__ size_t bofs(const Unit& u) const { return (size_t)te[u.pm] * estride; }
    __device__ __forceinline__ int arow(int pm, int r) const { const int t = stok[pm * BM + r]; return t < 0 ? 0 : t; }
};

struct EpiBf16 {
    static constexpr bool PERM = true;
    bf16_t* O; int ldc;
    __device__ __forceinline__ void operator()(const f32x4 (&acc)[2][2][4][2], const Unit& u, int wr, int wc, int fr, int fq) const {
        const int row0 = u.pm * BM + wr * 64 + fr, col0 = u.pn * BM + wc * 32 + 8 * fq;
#pragma unroll
        for (int ai = 0; ai < 2; ++ai)
#pragma unroll
            for (int m = 0; m < 4; ++m) { bf16_t* rowp = O + (size_t)(row0 + ai * HALF + m * 16) * ldc + col0;
#pragma unroll
                for (int bj = 0; bj < 2; ++bj) { const f32x4 v0 = acc[ai][bj][m][0], v1 = acc[ai][bj][m][1];
                    u32x4 w; w.x = cvt_pk_bf16(v0[0], v0[1]); w.y = cvt_pk_bf16(v0[2], v0[3]); w.z = cvt_pk_bf16(v1[0], v1[1]); w.w = cvt_pk_bf16(v1[2], v1[3]);
                    *(u32x4*)(rowp + bj * HALF) = w; } }
    }
};
struct EpiF8x8 {
    static constexpr bool PERM = true;
    unsigned char* O; int ldc;
    __device__ __forceinline__ void operator()(const f32x4 (&acc)[2][2][4][2], const Unit& u, int wr, int wc, int fr, int fq) const {
        const int row0 = u.pm * BM + wr * 64 + fr, col0 = u.pn * BM + wc * 32 + 8 * fq;
#pragma unroll
        for (int ai = 0; ai < 2; ++ai)
#pragma unroll
            for (int m = 0; m < 4; ++m) { unsigned char* rowp = O + (size_t)(row0 + ai * HALF + m * 16) * ldc + col0;
#pragma unroll
                for (int bj = 0; bj < 2; ++bj) { const f32x4 v0 = acc[ai][bj][m][0] * 8.f, v1 = acc[ai][bj][m][1] * 8.f;
                    u32x2 w; w.x = cvt4_fp8(v0[0], v0[1], v0[2], v0[3]); w.y = cvt4_fp8(v1[0], v1[1], v1[2], v1[3]);
                    *(u32x2*)(rowp + bj * HALF) = w; } }
    }
};
template <int LAYER> struct EpiHeads {
    static constexpr bool PERM = true;
    bf16_t* O; const float* rstd;
    __device__ __forceinline__ void operator()(const f32x4 (&acc)[2][2][4][2], const Unit& u, int wr, int wc, int fr, int fq) const {
        const int pn = u.pn, lc = wc * 32 + 8 * fq;
#pragma unroll
        for (int ai = 0; ai < 2; ++ai)
#pragma unroll
            for (int m = 0; m < 4; ++m) { const int row = u.pm * BM + ai * HALF + wr * 64 + m * 16 + fr, b = row >> 14, t = row & (SEQ - 1);
#pragma unroll
                for (int bj = 0; bj < 2; ++bj) { size_t off;
                    if (LAYER == 0) { if (pn < 4) off = gq_off(b, t, pn) + bj * 128 + lc; else if (pn < 8) off = GK0 + gq_off(b, t, pn - 4) + bj * 128 + lc;
                                      else if (pn < 16) off = gv_off(b, t, (pn - 8) >> 1) + ((pn - 8) & 1) * 256 + bj * 128 + lc; else off = GR0 + (size_t)row * 2048 + (pn - 16) * 256 + bj * 128 + lc; }
                    else { if (pn < 8) off = dq_off(b, t, pn, bj) + lc; else if (pn < 16) off = DK0 + dq_off(b, t, pn - 8, bj) + lc; else off = dv_off(b, t, pn - 16) + bj * 128 + lc; }
                    f32x4 v0 = acc[ai][bj][m][0], v1 = acc[ai][bj][m][1];
                    if (LAYER == 0) { const float rs = rstd[row]; v0 *= rs; v1 *= rs; }
                    if (LAYER == 1 && pn < 16) {
                        u32x2 w8; w8.x = cvt4_fp8(v0[0], v0[1], v0[2], v0[3]); w8.y = cvt4_fp8(v1[0], v1[1], v1[2], v1[3]); *(u32x2*)((unsigned char*)O + off) = w8; continue; }
                    u32x4 w; w.x = cvt_pk_bf16(v0[0], v0[1]); w.y = cvt_pk_bf16(v0[2], v0[3]); w.z = cvt_pk_bf16(v1[0], v1[1]); w.w = cvt_pk_bf16(v1[2], v1[3]);
                    *(u32x4*)(O + off) = w; } }
    }
};
__host__ __device__ __forceinline__ size_t vt_off(int b, int h, int chunk) { return DV0 * 2 + ((size_t)((b * 8 + h) * (SEQ / 64) + chunk)) * 16384; }
struct EpiVT {
    static constexpr bool PERM = false;
    unsigned char* O;
    __device__ __forceinline__ void operator()(const f32x4 (&acc)[2][2][4][2], const Unit& u, int wr, int wc, int fr, int fq) const {
#pragma unroll
        for (int ai = 0; ai < 2; ++ai) { const int row0 = u.pm * BM + ai * HALF + wr * 64;
            unsigned char* tp = O + vt_off(row0 >> 14, u.pn, (row0 & (SEQ - 1)) >> 6) + (size_t)(wc * 32 + fr) * 64 + 32 * (fq & 1) + 4 * (fq >> 1);
#pragma unroll
            for (int m = 0; m < 4; ++m)
#pragma unroll
                for (int bj = 0; bj < 2; ++bj)
#pragma unroll
                    for (int n = 0; n < 2; ++n) { const f32x4 v = acc[ai][bj][m][n];
                        *(unsigned*)(tp + (bj * 128 + n * 16) * 64 + 16 * (m >> 1) + 8 * (m & 1)) = cvt4_fp8(v[0], v[1], v[2], v[3]); } }
    }
};
struct FixOrder : StaticOrder {
    __device__ __forceinline__ size_t bofs(const Unit& u) const { return (size_t)(u.pm >> 5) * (512 * 256 * 2); }
};
struct EpiAddO {
    static constexpr bool PERM = true;
    bf16_t* O;
    __device__ __forceinline__ void operator()(const f32x4 (&acc)[2][2][4][2], const Unit& u, int wr, int wc, int fr, int fq) const {
#pragma unroll
        for (int ai = 0; ai < 2; ++ai)
#pragma unroll
            for (int m = 0; m < 4; ++m) { const int row = u.pm * BM + ai * HALF + wr * 64 + m * 16 + fr, bhh = row >> 13, t = row & 8191;
                bf16_t* rowp = O + ((size_t)(bhh >> 2) * SEQ + SEQ / 2 + t) * D + (bhh & 3) * 512 + u.pn * BM + wc * 32 + 8 * fq;
#pragma unroll
                for (int bj = 0; bj < 2; ++bj) { const u32x4 old = *(const u32x4*)(rowp + bj * HALF); const f32x4 v0 = acc[ai][bj][m][0] * 0.0625f, v1 = acc[ai][bj][m][1] * 0.0625f;
                    u32x4 w; w.x = cvt_pk_bf16(bf_lo(old.x) + v0[0], bf_hi(old.x) + v0[1]); w.y = cvt_pk_bf16(bf_lo(old.y) + v0[2], bf_hi(old.y) + v0[3]);
                    w.z = cvt_pk_bf16(bf_lo(old.z) + v1[0], bf_hi(old.z) + v1[1]); w.w = cvt_pk_bf16(bf_lo(old.w) + v1[2], bf_hi(old.w) + v1[3]);
                    *(u32x4*)(rowp + bj * HALF) = w; } }
    }
};
template <bool BASE16> struct EpiRes16 {
    static constexpr bool PERM = true;
    const void* base; bf16_t* C; int ldc;
    __device__ __forceinline__ void operator()(const f32x4 (&acc)[2][2][4][2], const Unit& u, int wr, int wc, int fr, int fq) const {
        const int row0 = u.pm * BM + wr * 64 + fr, col0 = u.pn * BM + wc * 32 + 8 * fq;
#pragma unroll
        for (int ai = 0; ai < 2; ++ai)
#pragma unroll
            for (int m = 0; m < 4; ++m) { const size_t off = (size_t)(row0 + ai * HALF + m * 16) * ldc + col0;
#pragma unroll
                for (int bj = 0; bj < 2; ++bj) { f32x4 v0 = acc[ai][bj][m][0], v1 = acc[ai][bj][m][1];
                    if constexpr (BASE16) { const u32x4 bs = *(const u32x4*)((const bf16_t*)base + off + bj * HALF);
                        v0 += (f32x4){bf_lo(bs.x), bf_hi(bs.x), bf_lo(bs.y), bf_hi(bs.y)}; v1 += (f32x4){bf_lo(bs.z), bf_hi(bs.z), bf_lo(bs.w), bf_hi(bs.w)}; }
                    else { const f32x4* bp = (const f32x4*)((const float*)base + off + bj * HALF); v0 += bp[0]; v1 += bp[1]; }
                    u32x4 w; w.x = cvt_pk_bf16(v0[0], v0[1]); w.y = cvt_pk_bf16(v0[2], v0[3]); w.z = cvt_pk_bf16(v1[0], v1[1]); w.w = cvt_pk_bf16(v1[2], v1[3]);
                    *(u32x4*)(C + off + bj * HALF) = w; }
                asm volatile("" ::: "memory"); }
    }
};
struct EpiSiluMul {
    static constexpr bool PERM = true;
    unsigned char* Hh;
    __device__ __forceinline__ void operator()(const f32x4 (&acc)[2][2][4][2], const Unit& u, int wr, int wc, int fr, int fq) const {
        const int row0 = u.pm * BM + wr * 64 + fr, col0 = u.pn * HALF + wc * 32 + 8 * fq;
#pragma unroll
        for (int ai = 0; ai < 2; ++ai)
#pragma unroll
            for (int m = 0; m < 4; ++m) { unsigned char* rowp = Hh + (size_t)(row0 + ai * HALF + m * 16) * DFF + col0;
                float hv[8];
#pragma unroll
                for (int n = 0; n < 2; ++n)
#pragma unroll
                    for (int j = 0; j < 4; ++j) { const float g = acc[ai][0][m][n][j], up = acc[ai][1][m][n][j];
                        const float sg = g * __builtin_amdgcn_rcpf(1.0f + __builtin_amdgcn_exp2f(-1.4426950408889634f * g)); hv[n * 4 + j] = sg * up; }
                u32x2 w; w.x = cvt4_fp8(hv[0], hv[1], hv[2], hv[3]); w.y = cvt4_fp8(hv[4], hv[5], hv[6], hv[7]);
                *(u32x2*)rowp = w; }
    }
};

template <class Epi, class Sched, bool GATHER = false, bool FP8 = false, bool NTR = false>
__device__ __forceinline__ void gemm_phase(LAS unsigned char* lds, const Gemm g, const Sched& S, const Epi& E, int tid_in) {
    const int tid = opq(tid_in), wid = __builtin_amdgcn_readfirstlane(tid >> 6), lane = tid & 63, wr = wid >> 2, wc = wid & 3, fr = lane & 15, fq = lane >> 4;
    const int K = g.K, RP = FP8 ? K : 2 * K  , nt = RP / (BK * 2);
    unsigned voffA[2], voffB[2];
#pragma unroll
    for (int i = 0; i < 2; ++i) { int R, C; stage_rc(tid * 16 + i * 8192, R, C); const int Rb = Epi::PERM ? ((R & ~31) + perm32(R & 31)) : R;
        voffA[i] = (unsigned)(R * RP + 2 * C); voffB[i] = (unsigned)(Rb * RP + 2 * C); }
    const unsigned kstep = (unsigned)(BK * 2);
    const unsigned hstep = (unsigned)HALF * (unsigned)RP;
    const size_t tstep = 2 * (size_t)hstep;
    const unsigned ldsw = (unsigned)wid * 1024u;
    const int aoff = lds_byte(wr * 64 + fr, fq * 8), boff = lds_byte(wc * 32 + fr, fq * 8);
    const LAS unsigned char* ldsB = lds + 4 * HTB + boff;
#define PG8_SA(b, h) (((b) * 2 + (h)) * HTB)
#define PG8_SB(b, h) ((4 + (b) * 2 + (h)) * HTB)
#define PG8_STAGE(bufoff, gbase, voff) do { const unsigned long long gv_ = (unsigned long long)(gbase); \
        const unsigned glo_ = (unsigned)__builtin_amdgcn_readfirstlane((unsigned)gv_), ghi_ = (unsigned)__builtin_amdgcn_readfirstlane((unsigned)(gv_ >> 32)); const char* gb_ = (const char*)(((unsigned long long)ghi_ << 32) | (unsigned long long)glo_);     \
        _Pragma("unroll") for (int _i = 0; _i < 2; ++_i) \
        __builtin_amdgcn_global_load_lds((const unsigned*)(gb_ + (voff)[_i]), (LAS unsigned*)(lds + (bufoff) + ldsw + _i * 8192), 16, 0, 0); } while (0)
#define PG8_STAGE_A(bufoff, nx, koff, h) do { if constexpr (GATHER) { unsigned vs_[2]; _Pragma("unroll") for (int _i = 0; _i < 2; ++_i) vs_[_i] = (nx) ? vAn[h][_i] : vAc[h][_i]; \
            PG8_STAGE(bufoff, (const char*)g.A + (koff), vs_); } \
        else { PG8_STAGE(bufoff, ((nx) ? nA : cA) + (koff) + (h) * hstep, voffA); } } while (0)
#define PG8_LD8(off) __builtin_shufflevector(*(const LAS v4i32*)(lds + (off)), *(const LAS v4i32*)(lds + (off) + 1024), 0, 1, 2, 3, 4, 5, 6, 7)
#define PG8_LDA(dst, b, h) do { if constexpr (FP8) { _Pragma("unroll") for (int m = 0; m < 4; ++m) dst##8[m] = PG8_LD8(PG8_SA(b, h) + aoff + m * 2048); } \
        else { _Pragma("unroll") for (int m = 0; m < 4; ++m) _Pragma("unroll") for (int k = 0; k < 2; ++k) dst[m][k] = *(const LAS bf16x8*)(lds + PG8_SA(b, h) + aoff + m * 2048 + k * 1024); } } while (0)
#define PG8_LD8B(off) __builtin_shufflevector(*(const LAS v4i32*)(ldsB + (off)), *(const LAS v4i32*)(ldsB + (off) + 1024), 0, 1, 2, 3, 4, 5, 6, 7)
#define PG8_LDB(dst, b, h) do { if constexpr (FP8) { _Pragma("unroll") for (int n = 0; n < 2; ++n) dst##8[n] = PG8_LD8B(PG8_SA(b, h) + n * 2048); }     \
        else { _Pragma("unroll") for (int n = 0; n < 2; ++n) _Pragma("unroll") for (int k = 0; k < 2; ++k) dst[n][k] = *(const LAS bf16x8*)(lds + PG8_SB(b, h) + boff + n * 2048 + k * 1024); } } while (0)
#define PG8_MMA(ai, bj, At, Bt) do { __builtin_amdgcn_s_setprio(1); if constexpr (FP8) { _Pragma("unroll") for (int m = 0; m < 4; ++m) _Pragma("unroll") for (int n = 0; n < 2; ++n) \
              \
            { if constexpr (NTR) asm volatile("v_mfma_scale_f32_16x16x128_f8f6f4 %0, %1, %2, %0, %3, %3 op_sel:[1,0,0] op_sel_hi:[0,0,0]" : "+v"(acc[ai][bj][m][n]) : "v"(At##8[m]), "v"(Bt##8[n]), "v"(scl8)); \
              else asm volatile("v_mfma_scale_f32_16x16x128_f8f6f4 %0, %1, %2, %0, %3, %3 op_sel:[0,1,0] op_sel_hi:[0,0,0]" : "+v"(acc[ai][bj][m][n]) : "v"(Bt##8[n]), "v"(At##8[m]), "v"(scl8)); } } \
        else { _Pragma("unroll") for (int m = 0; m < 4; ++m) _Pragma("unroll") for (int n = 0; n < 2; ++n) _Pragma("unroll") for (int k = 0; k < 2; ++k) \
            acc[ai][bj][m][n] = __builtin_amdgcn_mfma_f32_16x16x32_bf16(Bt[n][k], At[m][k], acc[ai][bj][m][n], 0, 0, 0); } __builtin_amdgcn_s_setprio(0); } while (0)
#define PG8_WAIT_V(n) asm volatile("s_waitcnt vmcnt(" #n ")" ::: "memory")
#define PG8_WAIT_L(n) asm volatile("s_waitcnt lgkmcnt(" #n ")" ::: "memory")
#define PG8_BAR __builtin_amdgcn_s_barrier()
#define PG8_SCHED __builtin_amdgcn_sched_barrier(0)
#define PG8_ROWOFFS(V, U) do { if constexpr (GATHER) { const int t_ = opq(wid * 64 + lane_id());     \
        _Pragma("unroll") for (int i_ = 0; i_ < 2; ++i_) { int R_, C_; stage_rc(t_ * 16 + i_ * 8192, R_, C_); \
        _Pragma("unroll") for (int h_ = 0; h_ < 2; ++h_) V[h_][i_] = (unsigned)S.arow((U).pm, h_ * HALF + R_) * (unsigned)RP + 2u * (unsigned)C_; } } } while (0)
    Unit cur, nxt; int ui = 0;
    if (!S.next(0, cur)) return;
    f32x4 acc[2][2][4][2];
#pragma unroll
    for (int a = 0; a < 2; ++a)
#pragma unroll
        for (int b = 0; b < 2; ++b)
#pragma unroll
            for (int m = 0; m < 4; ++m)
#pragma unroll
                for (int n = 0; n < 2; ++n) acc[a][b][m][n] = (f32x4){0.f, 0.f, 0.f, 0.f};
    const unsigned scl8 = 0x7f797f79u;
    bf16x8 At[4][2], B0[2][2], B1[2][2]; v8i32 At8[4], B08[2], B18[2];
    unsigned vAc[2][2] = {{0u, 0u}, {0u, 0u}}, vAn[2][2] = {{0u, 0u}, {0u, 0u}};
    const char* cA = (const char*)g.A + (GATHER ? (size_t)0 : (size_t)cur.pm * tstep); const char* nA = cA; const char* cB = (const char*)g.Bt + S.bofs(cur) + (size_t)cur.pn * tstep;
    PG8_ROWOFFS(vAc, cur);
    PG8_STAGE(PG8_SB(0, 0), cB, voffB); PG8_STAGE(PG8_SB(0, 1), cB + hstep, voffB); PG8_STAGE_A(PG8_SA(0, 0), false, 0u, 0); PG8_STAGE_A(PG8_SA(0, 1), false, 0u, 1);
    if (wr == 1) PG8_BAR;
    PG8_WAIT_V(2); PG8_BAR;
    PG8_STAGE(PG8_SB(1, 0), cB + kstep, voffB); PG8_STAGE_A(PG8_SA(1, 0), false, kstep, 0); PG8_STAGE(PG8_SB(1, 1), cB + hstep + kstep, voffB);
    PG8_WAIT_V(6); PG8_BAR;
    for (;;) {
        const bool has_next = S.next(ui + 1, nxt);
        nA = (has_next && !GATHER) ? (const char*)g.A + (size_t)nxt.pm * tstep : cA; const char* nB = has_next ? (const char*)g.Bt + S.bofs(nxt) + (size_t)nxt.pn * tstep : cB;

        asm volatile(".p2align 8");
        for (int t = 0; t < nt; t += 2) {
            const bool last = (t == nt - 2);
            if constexpr (GATHER) { if (last) {
                if (has_next) PG8_ROWOFFS(vAn, nxt); else { _Pragma("unroll") for (int h_ = 0; h_ < 2; ++h_) _Pragma("unroll") for (int i_ = 0; i_ < 2; ++i_) vAn[h_][i_] = vAc[h_][i_]; } } }
            const unsigned k1 = (unsigned)(t + 1) * kstep, k2 = last ? 0u : (unsigned)(t + 2) * kstep, k3 = k2 + kstep;
            const char* b2 = last ? nB : cB + k2; const char* b3 = b2 + kstep;
            PG8_LDB(B0, 0, 0); PG8_LDB(B1, 0, 1); PG8_SCHED; PG8_LDA(At, 0, 0); PG8_STAGE_A(PG8_SA(1, 1), false, k1, 1);
            PG8_WAIT_V(8); PG8_WAIT_L(0); PG8_BAR; PG8_MMA(0, 0, At, B0); PG8_MMA(0, 1, At, B1); PG8_BAR; PG8_SCHED;
            PG8_LDA(At, 0, 1); PG8_STAGE(PG8_SB(0, 0), b2, voffB); PG8_STAGE(PG8_SB(0, 1), b2 + hstep, voffB); PG8_STAGE_A(PG8_SA(0, 0), last, k2, 0);
            PG8_WAIT_V(8); PG8_WAIT_L(0); PG8_BAR; PG8_MMA(1, 0, At, B0); PG8_MMA(1, 1, At, B1); PG8_BAR; PG8_SCHED;
            PG8_LDB(B0, 1, 0); PG8_LDB(B1, 1, 1); PG8_SCHED; PG8_LDA(At, 1, 0); PG8_STAGE_A(PG8_SA(0, 1), last, k2, 1);
            PG8_WAIT_V(8); PG8_WAIT_L(0); PG8_BAR; PG8_MMA(0, 0, At, B0); PG8_MMA(0, 1, At, B1); PG8_BAR; PG8_SCHED;
            PG8_LDA(At, 1, 1); PG8_STAGE(PG8_SB(1, 0), b3, voffB); PG8_STAGE(PG8_SB(1, 1), b3 + hstep, voffB); PG8_STAGE_A(PG8_SA(1, 0), last, k3, 0);
            PG8_WAIT_V(8); PG8_WAIT_L(0); PG8_BAR; PG8_MMA(1, 0, At, B0); PG8_MMA(1, 1, At, B1); PG8_BAR; PG8_SCHED;
        }
        if (wr == 0) PG8_BAR;
        E(acc, cur, wr, wc, fr, fq);
        if (!has_next) break;
#pragma unroll
        for (int a = 0; a < 2; ++a)
#pragma unroll
            for (int b = 0; b < 2; ++b)
#pragma unroll
                for (int m = 0; m < 4; ++m)
#pragma unroll
                    for (int n = 0; n < 2; ++n) acc[a][b][m][n] = (f32x4){0.f, 0.f, 0.f, 0.f};
        cur = nxt; cA = nA; cB = nB; ++ui;
        if constexpr (GATHER) { _Pragma("unroll") for (int h_ = 0; h_ < 2; ++h_) _Pragma("unroll") for (int i_ = 0; i_ < 2; ++i_) vAc[h_][i_] = vAn[h_][i_]; }
        if (wr == 1) PG8_BAR;
    }
    PG8_WAIT_V(0);
    PG8_BAR;
#undef PG8_SA
#undef PG8_SB
#undef PG8_STAGE
#undef PG8_STAGE_A
#undef PG8_ROWOFFS
#undef PG8_LDA
#undef PG8_LDB
#undef PG8_MMA
#undef PG8_LD8
#undef PG8_LD8B
#undef PG8_WAIT_V
#undef PG8_WAIT_L
#undef PG8_BAR
#undef PG8_SCHED
}
}

#define XB_TMO      128
#define XB_XCNT(j)  (256  + 64 * (j))
#define XB_XSUB(j)  (1280 + 64 * (j))
#define XB_XGEN(j)  (2304 + 64 * (j))
#define XB_TOP      3328
#define XB_TOPGEN   3392
#define XCD_BAR_WORDS 3456
#define XB_SPIN_CAP (1u << 18)
__device__ __forceinline__ unsigned xb_ld(unsigned* p)              { return __hip_atomic_load(p, __ATOMIC_RELAXED, __HIP_MEMORY_SCOPE_AGENT); }
__device__ __forceinline__ unsigned xb_add(unsigned* p, unsigned v) { return __hip_atomic_fetch_add(p, v, __ATOMIC_RELAXED, __HIP_MEMORY_SCOPE_AGENT); }
__device__ __forceinline__ unsigned xb_xcc_id() { return (unsigned)__builtin_amdgcn_s_getreg((3 << 11) | 20) & 0xFu; }
#define XB_SPIN(cond, bar) do { unsigned _sp = 0; while (cond) { __builtin_amdgcn_s_sleep(1); \
    if ((++_sp & 255u) == 0u) { if (xb_ld(&(bar)[XB_TMO])) break; if (_sp > XB_SPIN_CAP) { atomicAdd(&(bar)[XB_TMO], 1u); break; } } } } while (0)
struct XcdBarrier { unsigned* bar; unsigned x; volatile LAS unsigned* st; int wave; };
__device__ __forceinline__ XcdBarrier xcd_barrier_post(unsigned* bar, volatile LAS unsigned* st) {
    XcdBarrier b; b.bar = bar; b.x = xb_xcc_id(); b.st = st; b.wave = __builtin_amdgcn_readfirstlane((int)threadIdx.x >> 6);
    if (threadIdx.x == 0) (void)xb_add(&bar[XB_XCNT(b.x)], 1u);
    return b;
}
__device__ __forceinline__ void xcd_barrier_complete(unsigned* bar, unsigned x, unsigned& nloc, unsigned& nx) {
    const unsigned G = gridDim.x * gridDim.y * gridDim.z;
    unsigned sum, cnt, mine, sp = 0u;
    for (;;) {
        sum = 0u; cnt = 0u; mine = 0u;
#pragma unroll
        for (unsigned j = 0; j < 16; ++j) { const unsigned c = xb_ld(&bar[XB_XCNT(j)]); sum += c; cnt += (c > 0u) ? 1u : 0u; mine = (j == x) ? c : mine; }
        if (sum == G) break;
        __builtin_amdgcn_s_sleep(1);
        if ((++sp & 255u) == 0u) { if (xb_ld(&bar[XB_TMO])) break; if (sp > XB_SPIN_CAP) { atomicAdd(&bar[XB_TMO], 1u); break; } }
    }
    nloc = mine > 0u ? mine : 1u; nx = cnt > 0u ? cnt : 1u;
}
__device__ __forceinline__ void xcd_barrier(const XcdBarrier& b, bool leader  ) {
    asm volatile("s_waitcnt vmcnt(0)" ::: "memory");
    SYNCTHREADS();
    if (leader) {
        unsigned* bar = b.bar;
        __builtin_amdgcn_s_waitcnt(0);
        unsigned nloc = b.st[0], nx = b.st[1];
        if (nloc == 0u) { xcd_barrier_complete(bar, b.x, nloc, nx); b.st[0] = nloc; b.st[1] = nx; }
        const unsigned old = xb_add(&bar[XB_XSUB(b.x)], 1u);
        const unsigned gen = old / nloc;
        if (old + 1u == (gen + 1u) * nloc) {
            __builtin_amdgcn_fence(__ATOMIC_RELEASE, "agent");
            asm volatile("s_waitcnt vmcnt(0)" ::: "memory");
            const unsigned og = xb_add(&bar[XB_TOP], 1u);
            const unsigned tg = og / nx;
            if (og + 1u == (tg + 1u) * nx) xb_add(&bar[XB_TOPGEN], 1u);
            else XB_SPIN(xb_ld(&bar[XB_TOPGEN]) == tg, bar);
            __builtin_amdgcn_fence(__ATOMIC_ACQUIRE, "agent");
            xb_add(&bar[XB_XGEN(b.x)], 1u);
            asm volatile("s_waitcnt vmcnt(0)" ::: "memory");
        } else {
            XB_SPIN(xb_ld(&bar[XB_XGEN(b.x)]) == gen, bar);
            __builtin_amdgcn_fence(__ATOMIC_ACQUIRE, "agent");
            asm volatile("s_waitcnt vmcnt(0)" ::: "memory");
        }
    }
    SYNCTHREADS();
}

struct Frame {
    LAS unsigned char* lds;
    int tid, lane, wave, vcu, G;
};
struct Args {
    const float* in[21]; float* out; unsigned char* ws; int pad0, pad1;
};

struct TrItem { const float* src; unsigned char* dst; int ldw, ldk; const float* gk; };
__device__ __forceinline__ void tr_load(const TrItem& t, int lane, float (&tv)[32]) {
    const float* wp_ = t.src + (size_t)(lane >> 5) * t.ldw + (lane & 31);
#pragma unroll
    for (int i = 0; i < 32; ++i) tv[i] = wp_[(size_t)(2 * i) * t.ldw];
}
template <bool FP8>
__device__ __forceinline__ void tr_store(const TrItem& t, const float (&tv)[32], LAS float* scr, int lane) {
#pragma unroll
    for (int i = 0; i < 32; ++i) scr[(2 * i + (lane >> 5)) * 33 + (lane & 31)] = tv[i];
    LDS_WAIT(); asm volatile("" ::: "memory");
    const int c = lane & 7;
#pragma unroll
    for (int j = 0; j < 4; ++j) { const int n = (lane >> 3) + 8 * j; const LAS float* s = scr + (8 * c) * 33 + n;
        if constexpr (FP8) { u32x2 o; o.x = cvt4_fp8(s[0 * 33] * W8_SCALE, s[1 * 33] * W8_SCALE, s[2 * 33] * W8_SCALE, s[3 * 33] * W8_SCALE); o.y = cvt4_fp8(s[4 * 33] * W8_SCALE, s[5 * 33] * W8_SCALE, s[6 * 33] * W8_SCALE, s[7 * 33] * W8_SCALE);
            *(u32x2*)(t.dst + (size_t)n * t.ldk + 8 * c) = o; }
        else { f32x4 ga = {1.f, 1.f, 1.f, 1.f}, gb = ga; if (t.gk) { ga = *(const f32x4*)(t.gk + 8 * c); gb = *(const f32x4*)(t.gk + 8 * c + 4); }
            u32x4 o; o.x = cvt_pk_bf16(s[0 * 33] * ga[0], s[1 * 33] * ga[1]); o.y = cvt_pk_bf16(s[2 * 33] * ga[2], s[3 * 33] * ga[3]); o.z = cvt_pk_bf16(s[4 * 33] * gb[0], s[5 * 33] * gb[1]); o.w = cvt_pk_bf16(s[6 * 33] * gb[2], s[7 * 33] * gb[3]);
            *(u32x4*)(t.dst + ((size_t)n * t.ldk + 8 * c) * 2) = o; } }
    LDS_WAIT(); asm volatile("" ::: "memory");
}
#define TR_PIPELINE(FP8_, DECODE) do { if (gw < nit) { float tv_[32]; TrItem cur_ = DECODE(gw); tr_load(cur_, F.lane, tv_); \
        for (int it = gw; it < nit; it += NGW) { const int itn_ = it + NGW < nit ? it + NGW : it;     \
            float tn_[32]; const TrItem nxt_ = DECODE(itn_); tr_load(nxt_, F.lane, tn_); \
            tr_store<FP8_>(cur_, tv_, scr, F.lane); cur_ = nxt_; \
            _Pragma("unroll") for (int i_ = 0; i_ < 32; ++i_) tv_[i_] = tn_[i_]; } } } while (0)
template <bool FP8 = false>
__device__ __forceinline__ void conv_plain(Frame& F, const float* W, int K, int N, int ldw, bf16_t* WT, int rank = -1, int nrank = 0, const float* gain = nullptr) {
    LAS float* scr = (LAS float*)(F.lds + F.wave * 16384);
    const int gw = (rank < 0 ? F.vcu : rank) * NWAVES + F.wave, NGW = (rank < 0 ? F.G : nrank) * NWAVES, nblk = N / 32, nit = (K / 64) * nblk;
    auto decode = [&](int it) -> TrItem { const int kb = it / nblk, nb = it % nblk;
        return TrItem{W + (size_t)(64 * kb) * ldw + 32 * nb, (unsigned char*)WT + ((size_t)(32 * nb) * K + 64 * kb) * (FP8 ? 1 : 2), ldw, K, gain ? gain + 64 * kb : nullptr}; };
    TR_PIPELINE(FP8, decode);
}
__device__ __forceinline__ void conv_moe(Frame& F, const float* wg, const float* wu, const float* wd, bf16_t* GU, bf16_t* DT, int rank = -1, int nrank = 0, int e0 = 0, int ne = NEXP) {
    LAS float* scr = (LAS float*)(F.lds + F.wave * 16384);
    const int gw = (rank < 0 ? F.vcu : rank) * NWAVES + F.wave, NGW = (rank < 0 ? F.G : nrank) * NWAVES;
    constexpr int PER_E = 1536; const int nit = ne * PER_E;
    auto decode = [&](int it) -> TrItem { const int e = e0 + it / PER_E; int r = it % PER_E;
        if (r < 1024) { const int up = r >> 9; r &= 511; const int kb = r >> 4, nb = r & 15, n0 = 32 * nb;
            const int drow = 256 * (n0 >> 7) + 128 * up + (n0 & 127);
            return TrItem{(up ? wu : wg) + (size_t)e * D * DFF + (size_t)(64 * kb) * DFF + n0, (unsigned char*)GU + (size_t)e * 1024 * D + (size_t)drow * D + 64 * kb, DFF, D, nullptr}; }
        r -= 1024; const int kb = r >> 6, nb = r & 63;
        return TrItem{wd + (size_t)e * DFF * D + (size_t)(64 * kb) * D + 32 * nb, (unsigned char*)DT + (size_t)e * D * DFF + (size_t)(32 * nb) * DFF + 64 * kb, D, DFF, nullptr}; };
    TR_PIPELINE(true, decode);
}
__device__ __forceinline__ void pack_proj(Frame& F, float* Wp, int NT, const float* gain, const float* Wa, int lda, int ca0, int na, const float* Wb, int ldb, int nb) {
    const int total = 128 * NT * 256;
    for (int idx = (F.vcu * NWAVES * 64) + F.tid; idx < total; idx += F.G * NWAVES * 64) {
        const int e = idx & 3, ln = (idx >> 2) & 63, rest = idx >> 8, nt = rest % NT, s = rest / NT;
        const int k = 32 * (s >> 1) + 8 * (ln >> 4) + 4 * (s & 1) + e, col = 16 * nt + (ln & 15);
        float v = 0.f;
        if (col < na) v = Wa[(size_t)k * lda + ca0 + col]; else if (col < na + nb) v = Wb[(size_t)k * ldb + (col - na)];
        Wp[idx] = v * gain[k];
    }
}

__device__ __forceinline__ void pack_proj16(Frame& F, bf16_t* Wp, int NT, const float* gain, const float* Wa, int lda, int ca0, int na, const float* Wb, int ldb, int nb) {
    const int total = 64 * NT * 64 * 8;
    for (int idx = (F.vcu * NWAVES * 64) + F.tid; idx < total; idx += F.G * NWAVES * 64) {
        const int j = idx & 7, ln = (idx >> 3) & 63, rest = idx >> 9, nt = rest % NT, s = rest / NT;
        const int k = 32 * s + 8 * (ln >> 4) + j, col = 16 * nt + (ln & 15);
        float v = 0.f;
        if (col < na) v = Wa[(size_t)k * lda + ca0 + col]; else if (col < na + nb) v = Wb[(size_t)k * ldb + (col - na)];
        v *= gain[k];
        const unsigned hi = cvt_pk_bf16(v, 0.f) & 0xffffu; const float rem = v - __uint_as_float(hi << 16); const unsigned lo = cvt_pk_bf16(rem, 0.f) & 0xffffu;
        const size_t base = ((size_t)((s * NT + nt) * 2) * 64 + ln) * 8 + j;
        Wp[base] = (bf16_t)hi; Wp[base + 64 * 8] = (bf16_t)lo;
    }
}
template <int NT>
__device__ __forceinline__ float wave_proj16b(LAS unsigned char* lds, const bf16_t* xin, int tok0, const bf16_t* Wp, int tid, int wid, int lane, f32x4 (&acc)[NT]) {
    static_assert(NT == 3, "chunk = 24 KiB = 3 DMA instructions per thread");
    const int tr = lane & 15, kq = lane >> 4;
    const u32x4* xp = (const u32x4*)(xin + (size_t)(tok0 + tr) * D) + kq;
    constexpr int CH = 4 * NT * 2 * 1024;
    const char* wsrc = (const char*)Wp + tid * 16;
    float ssq = 0.f;
#pragma unroll
    for (int n = 0; n < NT; ++n) acc[n] = (f32x4){0.f, 0.f, 0.f, 0.f};
    u32x4 X[4];
#define NB_DMA(c, buf) do { _Pragma("unroll") for (int r = 0; r < 3; ++r) \
        __builtin_amdgcn_global_load_lds((const unsigned*)(wsrc + (size_t)(c) * CH + r * 8192), (LAS unsigned*)(lds + (buf) * CH + r * 8192 + wid * 1024), 16, 0, 0); } while (0)
#define NB_CHUNK(c, buf, more) do { \
        asm volatile("s_waitcnt vmcnt(4)" ::: "memory"); WG_BAR(); \
        if (more) NB_DMA((c) + 1, 1 - (buf)); \
        asm volatile("" ::: "memory"); \
        const u32x4* xn_ = xp + 16 * ((c) + 1); \
        _Pragma("unroll") for (int s = 0; s < 4; ++s) { const u32x4 xw = X[s]; if (more) X[s] = xn_[4 * s]; \
            _Pragma("unroll") for (int q = 0; q < 4; ++q) { const float a_ = bf_lo(xw[q]), b_ = bf_hi(xw[q]); ssq += a_ * a_ + b_ * b_; } \
            const bf16x8 xa = __builtin_bit_cast(bf16x8, xw); \
            _Pragma("unroll") for (int n = 0; n < NT; ++n) _Pragma("unroll") for (int pc = 0; pc < 2; ++pc) { \
                const bf16x8 wv = *(const LAS bf16x8*)(lds + (buf) * CH + (((s * NT + n) * 2 + pc) * 64 + lane) * 16); \
                acc[n] = __builtin_amdgcn_mfma_f32_16x16x32_bf16(xa, wv, acc[n], 0, 0, 0); } } } while (0)
    NB_DMA(0, 0);
    asm volatile("" ::: "memory");
#pragma unroll
    for (int s = 0; s < 4; ++s) X[s] = xp[4 * s];
    for (int c = 0; c < 14; c += 2) { NB_CHUNK(c, 0, true); NB_CHUNK(c + 1, 1, true); }
    NB_CHUNK(14, 0, true); NB_CHUNK(15, 1, false);
    WG_BAR();
#undef NB_DMA
#undef NB_CHUNK
    ssq += __shfl_xor(ssq, 16); ssq += __shfl_xor(ssq, 32);
    return 1.0f / sqrtf(ssq * (1.0f / D) + RMS_EPS);
}
template <int NT, bool XB16 = false>
__device__ __forceinline__ float wave_proj16(LAS unsigned char* lds, const void* xin, int tok0, const float* Wp, int tid, int wid, int lane, f32x4 (&acc)[NT], bf16_t* xb16) {
    typedef typename XRow<XB16>::T XT;
    const int tr = lane & 15, kq = lane >> 4;
    const XT* xp = (const XT*)xin + (size_t)(tok0 + tr) * (D / 4) + 2 * kq;
    u32x4* hb = (u32x4*)(xb16 + (size_t)(tok0 + tr) * D) + kq;
    constexpr int CH = 16 * NT * 1024;
    const char* wsrc = (const char*)Wp + tid * 16;
    float ssq = 0.f;
#pragma unroll
    for (int n = 0; n < NT; ++n) acc[n] = (f32x4){0.f, 0.f, 0.f, 0.f};
    XT X[16];
#define NP_DMA(c, buf) do { _Pragma("unroll") for (int r = 0; r < 2 * NT; ++r) \
        __builtin_amdgcn_global_load_lds((const unsigned*)(wsrc + (size_t)(c) * CH + r * 8192), (LAS unsigned*)(lds + (buf) * CH + r * 8192 + wid * 1024), 16, 0, 0); } while (0)
#define NP_CHUNK(c, buf, more) do { \
        asm volatile("s_waitcnt vmcnt(16)" ::: "memory"); WG_BAR(); \
        if (more) NP_DMA((c) + 1, 1 - (buf)); \
        asm volatile("" ::: "memory");     \
        const XT* xn_ = xp + 64 * ((c) + 1); \
        _Pragma("unroll") for (int s = 0; s < 16; ++s) { const f32x4 xv = XRow<XB16>::get(X[s]); \
            if (s & 1) { const f32x4 xl_ = XRow<XB16>::get(X[s - 1]); u32x4 w_; w_.x = cvt_pk_bf16(xl_[0], xl_[1]); w_.y = cvt_pk_bf16(xl_[2], xl_[3]); w_.z = cvt_pk_bf16(xv[0], xv[1]); w_.w = cvt_pk_bf16(xv[2], xv[3]); \
                hb[32 * (c) + 4 * (s >> 1)] = w_; if (more) { X[s - 1] = xn_[8 * (s >> 1)]; X[s] = xn_[8 * (s >> 1) + 1]; } } \
            ssq += (xv[0] * xv[0] + xv[1] * xv[1]) + (xv[2] * xv[2] + xv[3] * xv[3]); \
            _Pragma("unroll") for (int n = 0; n < NT; ++n) { const f32x4 wv = *(const LAS f32x4*)(lds + (buf) * CH + ((s * NT + n) * 64 + lane) * 16); \
                _Pragma("unroll") for (int e = 0; e < 4; ++e) acc[n] = __builtin_amdgcn_mfma_f32_16x16x4f32(xv[e], wv[e], acc[n], 0, 0, 0); } } } while (0)
    NP_DMA(0, 0);
    asm volatile("" ::: "memory");
#pragma unroll
    for (int s = 0; s < 16; ++s) X[s] = xp[8 * (s >> 1) + (s & 1)];
    for (int c = 0; c < 6; c += 2) { NP_CHUNK(c, 0, true); NP_CHUNK(c + 1, 1, true); }
    NP_CHUNK(6, 0, true); NP_CHUNK(7, 1, false);
    WG_BAR();
#undef NP_DMA
#undef NP_CHUNK
    ssq += __shfl_xor(ssq, 16); ssq += __shfl_xor(ssq, 32);
    return 1.0f / sqrtf(ssq * (1.0f / D) + RMS_EPS);
}
template <bool FP8 = false, bool XB16 = false>
__device__ __forceinline__ void wave_write_hn16(const void* xin, int tok0, float rstd, const float* gain, bf16_t* hn, int lane) {
    typedef typename XRow<XB16>::T XT;
    f32x4 g4[8];
#pragma unroll
    for (int j = 0; j < 8; ++j) g4[j] = ((const f32x4*)gain)[lane + 64 * j];
    for (int i = 0; i < 16; i += 2) {
        const float r0 = __shfl(rstd, i), r1 = __shfl(rstd, i + 1);
        const XT* x0 = (const XT*)xin + (size_t)(tok0 + i) * (D / 4); const XT* x1 = x0 + D / 4;
        u32x2* o0 = (u32x2*)(hn + (size_t)(tok0 + i) * D); u32x2* o1 = o0 + D / 4;
        unsigned* p0 = (unsigned*)((unsigned char*)hn + (size_t)(tok0 + i) * D); unsigned* p1 = p0 + D / 4;
        XT a[8], c[8];
#pragma unroll
        for (int j = 0; j < 8; ++j) { a[j] = x0[lane + 64 * j]; c[j] = x1[lane + 64 * j]; }
#pragma unroll
        for (int j = 0; j < 8; ++j) { const f32x4 v = XRow<XB16>::get(a[j]) * r0 * g4[j], u = XRow<XB16>::get(c[j]) * r1 * g4[j];
            if constexpr (FP8) { p0[lane + 64 * j] = cvt4_fp8(v[0], v[1], v[2], v[3]); p1[lane + 64 * j] = cvt4_fp8(u[0], u[1], u[2], u[3]); }
            else { u32x2 w; w.x = cvt_pk_bf16(v[0], v[1]); w.y = cvt_pk_bf16(v[2], v[3]); o0[lane + 64 * j] = w;
                u32x2 z; z.x = cvt_pk_bf16(u[0], u[1]); z.y = cvt_pk_bf16(u[2], u[3]); o1[lane + 64 * j] = z; } }
    }
}

__device__ __forceinline__ void phase_norm_gz(Frame& F, const float* xin, const float* Wp, bf16_t* hn, float* gz, float* rstd_tab) {
    for (int tile = F.vcu; tile < T / 128; tile += F.G) {
        const int tok0 = tile * 128 + F.wave * 16;
        f32x4 acc[1];
        const float rstd = wave_proj16<1>(F.lds, xin, tok0, Wp, F.tid, F.wave, F.lane, acc, hn);
        if (F.lane < 16) rstd_tab[tok0 + F.lane] = rstd;
        const int j = F.lane & 15, q4 = F.lane >> 4;
#pragma unroll
        for (int r = 0; r < 4; ++r) { const float rr = __shfl(rstd, 4 * q4 + r); gz[(size_t)(tok0 + 4 * q4 + r) * 16 + j] = acc[0][r] * rr; }
    }
}
__device__ __forceinline__ void phase_norm_route(Frame& F, const bf16_t* xin, const float* gain, const float* Wp, bf16_t* hn, int* tok_e, int* tok_p, float* tok_w, unsigned* cnt) {
    LAS float* lg = (LAS float*)(F.lds + 98304 + F.wave * 3072);
    for (int tile = F.vcu; tile < T / 128; tile += F.G) {
        const int tok0 = tile * 128 + F.wave * 16;
        f32x4 acc[3];
        const float rstd = wave_proj16b<3>(F.lds, xin, tok0, (const bf16_t*)Wp, F.tid, F.wave, F.lane, acc);
        const int j = F.lane & 15, q4 = F.lane >> 4;
#pragma unroll
        for (int r = 0; r < 4; ++r) { const float rr = __shfl(rstd, 4 * q4 + r);
#pragma unroll
            for (int n = 0; n < 3; ++n) lg[(4 * q4 + r) * 48 + 16 * n + j] = acc[n][r] * rr; }
        LDS_WAIT(); asm volatile("" ::: "memory");
        if (F.lane < 16) {
            const LAS float* l = lg + F.lane * 48;
            float gm = l[0]; int gi = 0;
#pragma unroll
            for (int q = 1; q < 4; ++q) { const float v = l[q]; if (v > gm) { gm = v; gi = q; } }
            float gs = 0.f;
#pragma unroll
            for (int q = 0; q < 4; ++q) gs += __expf(l[q] - gm);
            const float gw = 1.0f / gs;
            const LAS float* se = l + 4 + 8 * gi;
            float m1 = se[0]; int i1 = 0;
#pragma unroll
            for (int q = 1; q < 8; ++q) { const float v = se[q]; if (v > m1) { m1 = v; i1 = q; } }
            float m2 = -3.0e38f; int i2 = 0;
#pragma unroll
            for (int q = 0; q < 8; ++q) { const float v = se[q]; if (q != i1 && v > m2) { m2 = v; i2 = q; } }
            const float eb = __expf(m2 - m1), inv = 1.0f / (1.0f + eb);
            const int t = tok0 + F.lane, e1 = gi * 8 + i1, e2 = gi * 8 + i2;
            const unsigned p1 = __hip_atomic_fetch_add(cnt + 64 * e1, 1u, __ATOMIC_RELAXED, __HIP_MEMORY_SCOPE_AGENT);
            const unsigned p2 = __hip_atomic_fetch_add(cnt + 64 * e2, 1u, __ATOMIC_RELAXED, __HIP_MEMORY_SCOPE_AGENT);
            tok_e[2 * t] = e1; tok_e[2 * t + 1] = e2; tok_p[2 * t] = (int)p1; tok_p[2 * t + 1] = (int)p2;
            tok_w[2 * t] = gw * inv; tok_w[2 * t + 1] = gw * eb * inv;
        }
        wave_write_hn16<true, true>(xin, tok0, rstd, gain, hn, F.lane);
        LDS_WAIT(); asm volatile("" ::: "memory");
    }
}

__device__ __forceinline__ void phase_gla_gate(Frame& F, const float* gz, const float* wgu, const float* bgate, const bf16_t* proj, bf16_t* kdT, float* adec) {
    LAS f32x4* gzs = (LAS f32x4*)F.lds;
    for (int u = F.vcu; u < NBATCH * NCH * 2; u += F.G) {
        const int half = u & 1, bc = u >> 1;
        const int tok0 = bc * 64, j = half * 512 + F.tid;
        if (F.tid < 256) gzs[F.tid] = ((const f32x4*)(gz + (size_t)tok0 * 16))[F.tid];
        float wg[16];
#pragma unroll
        for (int r = 0; r < 16; ++r) wg[r] = wgu[r * GLA_DKT + j];
        const float bg = bgate[j];
        WG_BAR();
        float cum[64]; float run = 0.f;
#pragma unroll
        for (int t = 0; t < 64; ++t) {
            float z = bg;
#pragma unroll
            for (int r4 = 0; r4 < 4; ++r4) { const f32x4 g4 = gzs[t * 4 + r4]; z += g4[0] * wg[4 * r4] + g4[1] * wg[4 * r4 + 1] + g4[2] * wg[4 * r4 + 2] + g4[3] * wg[4 * r4 + 3]; }
            const float ls = fminf(z, 0.f) - __logf(1.0f + __expf(-fabsf(z)));
            run += ls * (1.0f / 16.0f); cum[t] = run;
        }
        adec[(size_t)bc * GLA_DKT + j] = __expf(run);
        const bf16_t* kp = proj + GK0 + gq_off(bc >> 8, (bc & 255) * 64, j >> 8) + (j & 255);
        u32x4* dst = (u32x4*)(kdT + ((size_t)bc * GLA_DKT + j) * 64);
#pragma unroll
        for (int t8 = 0; t8 < 8; ++t8) {
            float kd[8];
#pragma unroll
            for (int q = 0; q < 8; ++q) { const int t = t8 * 8 + q; kd[q] = bf2f(kp[(size_t)t * 256]) * __expf(run - cum[t]); }
            u32x4 w; w.x = cvt_pk_bf16(kd[0], kd[1]); w.y = cvt_pk_bf16(kd[2], kd[3]); w.z = cvt_pk_bf16(kd[4], kd[5]); w.w = cvt_pk_bf16(kd[6], kd[7]);
            dst[t8] = w;
        }
        WG_BAR();
    }
}

constexpr int SCAN_VROW = 144, SCAN_SROW = 528, SCAN_VBUF = 64 * SCAN_VROW, SCAN_SBUF = 64 * SCAN_SROW;
__device__ __forceinline__ void phase_gla_scan(Frame& F, int it, const bf16_t* proj, const bf16_t* kdT, const float* adec, bf16_t* oout, bf16_t* sfin) {
    const int lane = F.lane, w = F.wave, fr = lane & 15, kq = lane >> 4, tid = F.tid;
    LAS unsigned char* vbuf = F.lds;
    LAS unsigned char* sbuf = F.lds + 2 * SCAN_VBUF;
    const int bh = it >> 4, seg = (it >> 3) & 1, b = bh >> 2, h = bh & 3, sl = it & 7, mt = w & 3, ntp = w >> 2, c0 = seg * (NCH / 2);
    const size_t tokb = (size_t)b * SEQ;
    f32x4 st[2][4];
#pragma unroll
    for (int i = 0; i < 2; ++i)
#pragma unroll
        for (int n = 0; n < 4; ++n) st[i][n] = (f32x4){0.f, 0.f, 0.f, 0.f};
    bf16x8 ka0[2][2], ka1[2][2], q0[8], q1[8]; f32x4 dc0[2], dc1[2]; u32x4 vr0, vr1;
#define CL(c) ((c) < NCH ? (c) : NCH - 1)
#define LOAD_KA(KA, DC, c) do { const size_t bc_ = (size_t)b * NCH + CL(c); \
        _Pragma("unroll") for (int i = 0; i < 2; ++i) { \
            _Pragma("unroll") for (int s = 0; s < 2; ++s) KA[i][s] = *(const bf16x8*)(kdT + ((bc_ * GLA_DKT + h * 256 + 32 * w + 16 * i + fr) * 64 + 32 * s + 8 * kq)); \
            DC[i] = *(const f32x4*)(adec + bc_ * GLA_DKT + h * 256 + 32 * w + 16 * i + 4 * kq); } } while (0)
#define LOAD_V(VR, c) do { VR = *(const u32x4*)(proj + gv_off(b, CL(c) * 64 + (tid >> 3), h) + 64 * sl + 8 * (tid & 7)); } while (0)
#define LOAD_Q(Q, c) do { const bf16_t* qp_ = proj + gq_off(b, CL(c) * 64 + 16 * mt + fr, h) + 8 * kq; \
        _Pragma("unroll") for (int s = 0; s < 8; ++s) Q[s] = *(const bf16x8*)(qp_ + 32 * s); } while (0)
#define STORE_V(VR, buf) do { *(LAS u32x4*)(vbuf + (buf) * SCAN_VBUF + (tid >> 3) * SCAN_VROW + (tid & 7) * 16) = VR; } while (0)
#define SCAN_STEP(KA, DC, VN, VM, QC, QN, c) do { \
        const unsigned vb_ = (unsigned)(uintptr_t)(vbuf + ((c) & 1) * SCAN_VBUF) + (unsigned)((8 * kq + ((lane & 15) >> 2)) * SCAN_VROW + 8 * (lane & 3)); \
        s16x4 tv[4][4];     \
        asm volatile("ds_read_b64_tr_b16 %0, %16 offset:0\n\tds_read_b64_tr_b16 %1, %16 offset:576\n\tds_read_b64_tr_b16 %2, %16 offset:4608\n\tds_read_b64_tr_b16 %3, %16 offset:5184\n\t" \
                     "ds_read_b64_tr_b16 %4, %16 offset:32\n\tds_read_b64_tr_b16 %5, %16 offset:608\n\tds_read_b64_tr_b16 %6, %16 offset:4640\n\tds_read_b64_tr_b16 %7, %16 offset:5216\n\t" \
                     "ds_read_b64_tr_b16 %8, %16 offset:64\n\tds_read_b64_tr_b16 %9, %16 offset:640\n\tds_read_b64_tr_b16 %10, %16 offset:4672\n\tds_read_b64_tr_b16 %11, %16 offset:5248\n\t" \
                     "ds_read_b64_tr_b16 %12, %16 offset:96\n\tds_read_b64_tr_b16 %13, %16 offset:672\n\tds_read_b64_tr_b16 %14, %16 offset:4704\n\tds_read_b64_tr_b16 %15, %16 offset:5280\n\ts_waitcnt lgkmcnt(0)" \
                     : "=&v"(tv[0][0]), "=&v"(tv[0][1]), "=&v"(tv[0][2]), "=&v"(tv[0][3]), "=&v"(tv[1][0]), "=&v"(tv[1][1]), "=&v"(tv[1][2]), "=&v"(tv[1][3]), \
                       "=&v"(tv[2][0]), "=&v"(tv[2][1]), "=&v"(tv[2][2]), "=&v"(tv[2][3]), "=&v"(tv[3][0]), "=&v"(tv[3][1]), "=&v"(tv[3][2]), "=&v"(tv[3][3]) : "v"(vb_) : "memory"); \
        _Pragma("unroll") for (int n = 0; n < 4; ++n) { \
            const bf16x8 vf0 = (bf16x8){tv[n][0][0], tv[n][0][1], tv[n][0][2], tv[n][0][3], tv[n][1][0], tv[n][1][1], tv[n][1][2], tv[n][1][3]}; \
            const bf16x8 vf1 = (bf16x8){tv[n][2][0], tv[n][2][1], tv[n][2][2], tv[n][2][3], tv[n][3][0], tv[n][3][1], tv[n][3][2], tv[n][3][3]}; \
            _Pragma("unroll") for (int i = 0; i < 2; ++i) { \
                st[i][n] = st[i][n] * DC[i]; \
                st[i][n] = __builtin_amdgcn_mfma_f32_16x16x32_bf16(KA[i][0], vf0, st[i][n], 0, 0, 0); \
                st[i][n] = __builtin_amdgcn_mfma_f32_16x16x32_bf16(KA[i][1], vf1, st[i][n], 0, 0, 0); } } \
        LOAD_KA(KA, DC, (c) + 2); \
        { LAS unsigned char* sb_ = sbuf + ((c) & 1) * SCAN_SBUF + fr * SCAN_SROW + (32 * w + 4 * kq) * 2; \
          _Pragma("unroll") for (int i = 0; i < 2; ++i) _Pragma("unroll") for (int n = 0; n < 4; ++n) { \
              u32x2 pk; pk.x = cvt_pk_bf16(st[i][n][0], st[i][n][1]); pk.y = cvt_pk_bf16(st[i][n][2], st[i][n][3]); \
              *(LAS u32x2*)(sb_ + n * 16 * SCAN_SROW + i * 32) = pk; } } \
        STORE_V(VN, ((c) + 1) & 1); \
        LOAD_V(VN, (c) + 3); \
        WG_BAR(); \
        { f32x4 a0 = (f32x4){0.f, 0.f, 0.f, 0.f}, a1 = a0; \
          const LAS unsigned char* sr_ = sbuf + ((c) & 1) * SCAN_SBUF + (32 * ntp + fr) * SCAN_SROW + 16 * kq; \
          _Pragma("unroll") for (int hb = 0; hb < 2; ++hb) { bf16x8 bb[4][2];     \
              _Pragma("unroll") for (int s = 0; s < 4; ++s) { bb[s][0] = *(const LAS bf16x8*)(sr_ + 64 * (4 * hb + s)); bb[s][1] = *(const LAS bf16x8*)(sr_ + 16 * SCAN_SROW + 64 * (4 * hb + s)); } \
              asm volatile("s_waitcnt lgkmcnt(0)" ::: "memory"); __builtin_amdgcn_sched_barrier(0); \
              _Pragma("unroll") for (int s = 0; s < 4; ++s) { \
                  a0 = __builtin_amdgcn_mfma_f32_16x16x32_bf16(QC[4 * hb + s], bb[s][0], a0, 0, 0, 0); \
                  a1 = __builtin_amdgcn_mfma_f32_16x16x32_bf16(QC[4 * hb + s], bb[s][1], a1, 0, 0, 0); } } \
          bf16_t* op_ = oout + (tokb + (size_t)(c) * 64 + 16 * mt + 4 * kq) * D + h * 512 + 64 * sl + 32 * ntp + fr; \
          _Pragma("unroll") for (int r = 0; r < 4; ++r) { \
              const float x0 = a0[r] * 0.0625f, x1 = a1[r] * 0.0625f, y0 = __shfl_xor(x0, 1), y1 = __shfl_xor(x1, 1); \
              if ((fr & 1) == 0) { *(unsigned*)(op_ + (size_t)r * D) = cvt_pk_bf16(x0, y0); *(unsigned*)(op_ + (size_t)r * D + 16) = cvt_pk_bf16(x1, y1); } } } \
        LOAD_Q(QC, (c) + 2); \
    } while (0)
    LOAD_KA(ka0, dc0, c0); LOAD_KA(ka1, dc1, c0 + 1); LOAD_V(vr0, c0); LOAD_V(vr1, c0 + 1); LOAD_Q(q0, c0); LOAD_Q(q1, c0 + 1);
    STORE_V(vr0, 0); LOAD_V(vr0, c0 + 2);
    WG_BAR();
    for (int c = c0; c < c0 + NCH / 2; c += 2) {
        SCAN_STEP(ka0, dc0, vr1, vr0, q0, q1, c);
        SCAN_STEP(ka1, dc1, vr0, vr1, q1, q0, c + 1);
    }
    if (seg == 0) {
#pragma unroll
        for (int i = 0; i < 2; ++i)
#pragma unroll
            for (int n = 0; n < 4; ++n) { u32x2 pk; pk.x = cvt_pk_bf16(st[i][n][0], st[i][n][1]); pk.y = cvt_pk_bf16(st[i][n][2], st[i][n][3]);
                *(u32x2*)(sfin + ((size_t)(bh * 512 + 64 * sl + 16 * n + fr)) * 256 + 32 * w + 16 * i + 4 * kq) = pk; }
    }
    WG_BAR();
#undef CL
#undef LOAD_KA
#undef LOAD_V
#undef LOAD_Q
#undef STORE_V
#undef SCAN_STEP
}

__device__ __forceinline__ void gla_pcum(Frame& F, const float* adec, float* pcum, int rank, int nrank) {
    for (int idx = rank * (NWAVES * 64) + F.tid; idx < NBATCH * GLA_DKT; idx += nrank * NWAVES * 64) { const int b = idx >> 10, j = idx & 1023;
        const float* ap = adec + ((size_t)(b * NCH + NCH / 2)) * GLA_DKT + j; float* pp = pcum + (size_t)(b * (NCH / 2)) * GLA_DKT + j; float pr = 1.f;
#pragma unroll 16
        for (int cc = 0; cc < NCH / 2; ++cc) { pr *= ap[(size_t)cc * GLA_DKT]; pp[(size_t)cc * GLA_DKT] = pr; } }
}
__device__ __forceinline__ void phase_gla_qp(Frame& F, const bf16_t* proj, const float* pcum, bf16_t* qp) {
    const int gw = F.vcu * NWAVES + F.wave, NGW = F.G * NWAVES, lane = F.lane;
    for (int r = gw; r < NBATCH * (SEQ / 2); r += NGW) { const int b = r >> 13, t = r & 8191;
        u32x2 qv[4]; f32x4 pv[4];
#pragma unroll
        for (int h = 0; h < 4; ++h) { qv[h] = *(const u32x2*)(proj + gq_off(b, SEQ / 2 + t, h) + 4 * lane); pv[h] = *(const f32x4*)(pcum + ((size_t)(b * (NCH / 2) + (t >> 6)) * GLA_DKT + h * 256 + 4 * lane)); }
#pragma unroll
        for (int h = 0; h < 4; ++h) { u32x2 w; w.x = cvt_pk_bf16(bf_lo(qv[h].x) * pv[h][0], bf_hi(qv[h].x) * pv[h][1]); w.y = cvt_pk_bf16(bf_lo(qv[h].y) * pv[h][2], bf_hi(qv[h].y) * pv[h][3]);
            *(u32x2*)(qp + ((size_t)((b * 4 + h) * (SEQ / 2) + t)) * 256 + 4 * lane) = w; }
    }
}
__device__ __forceinline__ void phase_gla_gnorm(Frame& F, const bf16_t* o, const bf16_t* proj, const float* gn, bf16_t* y) {
    const int gw = F.vcu * NWAVES + F.wave, NGW = F.G * NWAVES, lane = F.lane;
    const f32x4 g0 = ((const f32x4*)gn)[2 * lane], g1 = ((const f32x4*)gn)[2 * lane + 1];
    for (int tok = gw; tok < T; tok += NGW) {
        u32x4 ov[4], rv[4];
#pragma unroll
        for (int h = 0; h < 4; ++h) { ov[h] = *(const u32x4*)(o + (size_t)tok * D + h * 512 + 8 * lane); rv[h] = *(const u32x4*)(proj + GR0 + (size_t)tok * 2048 + h * 512 + 8 * lane); }
        float ss[4];
#pragma unroll
        for (int h = 0; h < 4; ++h) { float s = 0.f;
#pragma unroll
            for (int q = 0; q < 4; ++q) { const float lo = bf_lo(ov[h][q]), hi = bf_hi(ov[h][q]); s += lo * lo + hi * hi; }
            ss[h] = s; }
#pragma unroll
        for (int of = 1; of < 64; of <<= 1) {
#pragma unroll
            for (int h = 0; h < 4; ++h) ss[h] += __shfl_xor(ss[h], of); }
#pragma unroll
        for (int h = 0; h < 4; ++h) { const float rstd = 1.0f / sqrtf(ss[h] * (1.0f / 512.0f) + RMS_EPS);
            float yv[8];
#pragma unroll
            for (int q = 0; q < 4; ++q) { const float a0 = bf_lo(ov[h][q]), a1 = bf_hi(ov[h][q]), r0 = bf_lo(rv[h][q]), r1 = bf_hi(rv[h][q]);
                const float gA = q < 2 ? g0[2 * q] : g1[2 * q - 4], gB = q < 2 ? g0[2 * q + 1] : g1[2 * q - 3];
                yv[2 * q] = a0 * rstd * gA * (r0 / (1.0f + __expf(-r0))); yv[2 * q + 1] = a1 * rstd * gB * (r1 / (1.0f + __expf(-r1))); }
            u32x4 w; w.x = cvt_pk_bf16(yv[0], yv[1]); w.y = cvt_pk_bf16(yv[2], yv[3]); w.z = cvt_pk_bf16(yv[4], yv[5]); w.w = cvt_pk_bf16(yv[6], yv[7]);
            *(u32x4*)(y + (size_t)tok * D + h * 512 + 8 * lane) = w; }
    }
}

__device__ __forceinline__ void moe_tables(Frame& F, unsigned* cnt) {
    LAS int* pst = (LAS int*)(F.lds + TAB_OFF);
    LAS int* te = pst + 36;
    if (F.wave == 0) {
        const int e = F.lane & 31;
        const int c = (int)xb_ld(cnt + 64 * e);
        const int ntile = (c + 255) >> 8;
        int incl = ntile;
#pragma unroll
        for (int o = 1; o < 32; o <<= 1) { const int v = __shfl_up(incl, o); if ((F.lane & 31) >= o) incl += v; }
        const int excl = incl - ntile;
        if (F.lane < 32) { pst[e] = excl << 8; for (int q = 0; q < ntile; ++q) te[excl + q] = e; }
        if (F.lane == 31) { pst[32] = incl << 8; pst[33] = incl; }
    }
    WG_BAR();
}
__device__ __forceinline__ void phase_moe_slots(Frame& F, const int* tok_e, const int* tok_p, unsigned* cnt, int* slot_of, int* slot_tok) {
    const LAS int* pst = (const LAS int*)(F.lds + TAB_OFF);
    for (int e = F.vcu; e < NEXP; e += F.G) { const int c = (int)xb_ld(cnt + 64 * e), lo = pst[e] + c, hi = pst[e] + (((c + 255) >> 8) << 8);
        for (int s = lo + F.tid; s < hi; s += NWAVES * 64) slot_tok[s] = -1; }
    for (int a = F.vcu * NWAVES * 64 + F.tid; a < 2 * T; a += F.G * NWAVES * 64) { const int slot = pst[tok_e[a]] + tok_p[a]; slot_of[a] = slot; slot_tok[slot] = a >> 1; }
}
__device__ __forceinline__ void phase_moe_copy8(Frame& F, const int* tok_e, const int* tok_p, const unsigned char* hn8, unsigned char* ag8) {
    const LAS int* pst = (const LAS int*)(F.lds + TAB_OFF);
    const int gw = F.vcu * NWAVES + F.wave, NGW = F.G * NWAVES, lane = F.lane;
    for (int t = gw; t < T; t += NGW) {
        const int s0 = pst[tok_e[2 * t]] + tok_p[2 * t], s1 = pst[tok_e[2 * t + 1]] + tok_p[2 * t + 1];
        const u32x4* src = (const u32x4*)(hn8 + (size_t)t * D); const u32x4 v0 = src[lane], v1 = src[lane + 64];
        u32x4* d0 = (u32x4*)(ag8 + (size_t)s0 * D); u32x4* d1 = (u32x4*)(ag8 + (size_t)s1 * D);
        d0[lane] = v0; d0[lane + 64] = v1; d1[lane] = v0; d1[lane + 64] = v1;
    }
}
template <int MODE>
__device__ __forceinline__ void phase_moe_combine(Frame& F, bf16_t* x, float* out, const bf16_t* ob, const int* slot_of, const float* tok_w, const float* gain, bf16_t* hn) {
    const int gw = F.vcu * NWAVES + F.wave, NGW = F.G * NWAVES, lane = F.lane;
    f32x4 g4[8];
#pragma unroll
    for (int j = 0; j < 8; ++j) g4[j] = ((const f32x4*)gain)[lane + 64 * j];
    for (int t = gw; t < T; t += NGW) {
        const int s0 = slot_of[2 * t], s1 = slot_of[2 * t + 1]; const float w0 = tok_w[2 * t] * 0.125f, w1 = tok_w[2 * t + 1] * 0.125f;
        u32x2* xr = (u32x2*)(x + (size_t)t * D);
        const unsigned* a = (const unsigned*)((const unsigned char*)ob + (size_t)s0 * D); const unsigned* b = (const unsigned*)((const unsigned char*)ob + (size_t)s1 * D);
        f32x4 v[8]; float ss = 0.f;
#pragma unroll
        for (int j = 0; j < 8; ++j) { const int av = (int)a[lane + 64 * j], bv = (int)b[lane + 64 * j]; f32x4 xv = bf4_expand(xr[lane + 64 * j]);
            xv[0] += w0 * __builtin_amdgcn_cvt_f32_fp8(av, 0) + w1 * __builtin_amdgcn_cvt_f32_fp8(bv, 0); xv[1] += w0 * __builtin_amdgcn_cvt_f32_fp8(av, 1) + w1 * __builtin_amdgcn_cvt_f32_fp8(bv, 1);
            xv[2] += w0 * __builtin_amdgcn_cvt_f32_fp8(av, 2) + w1 * __builtin_amdgcn_cvt_f32_fp8(bv, 2); xv[3] += w0 * __builtin_amdgcn_cvt_f32_fp8(av, 3) + w1 * __builtin_amdgcn_cvt_f32_fp8(bv, 3);
            v[j] = xv; ss += (xv[0] * xv[0] + xv[1] * xv[1]) + (xv[2] * xv[2] + xv[3] * xv[3]); }
        const float rstd = 1.0f / sqrtf(wave_sum(ss) * (1.0f / D) + RMS_EPS);
        if (MODE == 0) {
            unsigned* orow = (unsigned*)((unsigned char*)hn + (size_t)t * D);
#pragma unroll
            for (int j = 0; j < 8; ++j) { u32x2 w; w.x = cvt_pk_bf16(v[j][0], v[j][1]); w.y = cvt_pk_bf16(v[j][2], v[j][3]); xr[lane + 64 * j] = w;
                const f32x4 y = v[j] * rstd * g4[j]; orow[lane + 64 * j] = cvt4_fp8(y[0], y[1], y[2], y[3]); }
        } else {
            f32x4* orow = (f32x4*)(out + (size_t)t * D);
#pragma unroll
            for (int j = 0; j < 8; ++j) orow[lane + 64 * j] = v[j] * rstd * g4[j];
        }
    }
}

__device__ __forceinline__ void phase_subln(Frame& F, const bf16_t* o1, const bf16_t* o2, const float* lq1, const float* lk1, const float* lq2, const float* lk2, const float* sg, bf16_t* y) {
    const int gw = F.vcu * NWAVES + F.wave, NGW = F.G * NWAVES, lane = F.lane;
    const float d1 = wave_sum(lq1[lane] * lk1[lane] + lq1[lane + 64] * lk1[lane + 64]);
    const float d2 = wave_sum(lq2[lane] * lk2[lane] + lq2[lane + 64] * lk2[lane + 64]);
    const float lam = __expf(d1) - __expf(d2) + LAMBDA_INIT;
    const f32x4 g = ((const f32x4*)sg)[lane] * (1.0f - LAMBDA_INIT);
    for (int tok = gw; tok < T; tok += NGW) {
        u32x2 a[8], b[8];
#pragma unroll
        for (int h = 0; h < 8; ++h) { a[h] = *(const u32x2*)(o1 + (size_t)tok * D + h * 256 + 4 * lane); b[h] = *(const u32x2*)(o2 + (size_t)tok * D + h * 256 + 4 * lane); }
        f32x4 d[8]; float ss[8];
#pragma unroll
        for (int h = 0; h < 8; ++h) { d[h][0] = bf_lo(a[h].x) - lam * bf_lo(b[h].x); d[h][1] = bf_hi(a[h].x) - lam * bf_hi(b[h].x); d[h][2] = bf_lo(a[h].y) - lam * bf_lo(b[h].y); d[h][3] = bf_hi(a[h].y) - lam * bf_hi(b[h].y);
            ss[h] = (d[h][0] * d[h][0] + d[h][1] * d[h][1]) + (d[h][2] * d[h][2] + d[h][3] * d[h][3]); }
#pragma unroll
        for (int of = 1; of < 64; of <<= 1) {
#pragma unroll
            for (int h = 0; h < 8; ++h) ss[h] += __shfl_xor(ss[h], of); }
#pragma unroll
        for (int h = 0; h < 8; ++h) { const float rstd = 1.0f / sqrtf(ss[h] * (1.0f / 256.0f) + RMS_EPS); const f32x4 yv = d[h] * rstd * g;
            *(unsigned*)((unsigned char*)y + (size_t)tok * D + h * 256 + 4 * lane) = cvt4_fp8(yv[0], yv[1], yv[2], yv[3]); }
    }
}

namespace att {
constexpr int SHM_K = 64 * 128, SHM_V = 256 * 64;
constexpr int NSLOT = 5, V_OFF = 0, K_OFF = NSLOT * SHM_V, SCR_OFF = RING_BYTES + 4096;
static_assert(K_OFF + NSLOT * SHM_K <= RING_BYTES, "attention slots");
constexpr float SCALE = 0.08838834764831845f;
constexpr float C2 = 1.4426950408889634f * SCALE;
constexpr float THR = 40.f;
__device__ __forceinline__ int crow(int r, int hi) { return (r & 3) + 8 * (r >> 2) + 4 * hi; }

__device__ __forceinline__ void qkt(f32x16& p0, f32x16& p1, const LAS unsigned char* kslot, int r32, int hi, const v8i32 (&qf)[2], const f32x16& bias) {
    const int sw = (r32 >> 1) & 7;
    const LAS unsigned char* ra = kslot + r32 * 128;
#pragma unroll
    for (int s = 0; s < 2; ++s) { const int c0 = 4 * s + 2 * hi;
        const v4i32 a0 = *(const LAS v4i32*)(ra + ((c0 ^ sw) << 4)), a1 = *(const LAS v4i32*)(ra + (((c0 + 1) ^ sw) << 4));
        const v4i32 b0 = *(const LAS v4i32*)(ra + 32 * 128 + ((c0 ^ sw) << 4)), b1 = *(const LAS v4i32*)(ra + 32 * 128 + (((c0 + 1) ^ sw) << 4));
        const v8i32 ka = __builtin_shufflevector(a0, a1, 0, 1, 2, 3, 4, 5, 6, 7), kb = __builtin_shufflevector(b0, b1, 0, 1, 2, 3, 4, 5, 6, 7);
        if (s == 0) {
            p0 = __builtin_amdgcn_mfma_scale_f32_32x32x64_f8f6f4(ka, qf[s], bias, 0, 0, 0, 0x7f7f7f7f, 0, 0x7f7f7f7f);
            p1 = __builtin_amdgcn_mfma_scale_f32_32x32x64_f8f6f4(kb, qf[s], bias, 0, 0, 0, 0x7f7f7f7f, 0, 0x7f7f7f7f);
            __builtin_amdgcn_sched_barrier(0); }
        else {
            p0 = __builtin_amdgcn_mfma_scale_f32_32x32x64_f8f6f4(ka, qf[s], p0, 0, 0, 0, 0x7f7f7f7f, 0, 0x7f7f7f7f);
            p1 = __builtin_amdgcn_mfma_scale_f32_32x32x64_f8f6f4(kb, qf[s], p1, 0, 0, 0, 0x7f7f7f7f, 0, 0x7f7f7f7f); } }
}
__device__ __forceinline__ void pv_tile(f32x16 (&o)[8], const LAS unsigned char* va, const v8i32& pa, int scl) {
    const LAS unsigned char* vb = (const LAS unsigned char*)((unsigned)(uintptr_t)va ^ 16u);
#define PV_RD(S, d0) do { S[0] = *(const LAS v4i32*)(va + (d0) * 2048); S[1] = *(const LAS v4i32*)(vb + (d0) * 2048); } while (0)
#define PV_MM(S, d0) do { __builtin_amdgcn_sched_barrier(0); \
        o[d0] = __builtin_amdgcn_mfma_scale_f32_32x32x64_f8f6f4(pa, __builtin_shufflevector(S[0], S[1], 0, 1, 2, 3, 4, 5, 6, 7), o[d0], 0, 0, 0, scl, 0, 0x7f7f7f7f); __builtin_amdgcn_sched_barrier(0); } while (0)
    v4i32 f0[2], f1[2];
    PV_RD(f0, 0);
    PV_RD(f1, 1); PV_MM(f0, 0); PV_RD(f0, 2); PV_MM(f1, 1); PV_RD(f1, 3); PV_MM(f0, 2); PV_RD(f0, 4); PV_MM(f1, 3); PV_RD(f1, 5); PV_MM(f0, 4); PV_RD(f0, 6); PV_MM(f1, 5); PV_RD(f1, 7); PV_MM(f0, 6);
    PV_MM(f1, 7);
#undef PV_MM
#undef PV_RD
}

__device__ __forceinline__ void stage_offsets(int tid, unsigned& koff, unsigned (&voff)[2]) {
    { const int P = tid * 16, row = P >> 7, ch = ((P & 127) >> 4) ^ ((row >> 1) & 7); koff = (unsigned)(row * 128 + ch * 16); }
#pragma unroll
    for (int i = 0; i < 2; ++i) { const int P = tid * 16 + i * 8192, row = P >> 6, ch = ((P & 63) >> 4) ^ ((row >> 2) & 3); voff[i] = (unsigned)(row * 64 + ch * 16); }
}
__device__ __forceinline__ const char* uniform_ptr(const void* p) {
    const unsigned long long v = (unsigned long long)p;
    const unsigned lo = __builtin_amdgcn_readfirstlane((unsigned)v), hi = __builtin_amdgcn_readfirstlane((unsigned)(v >> 32));
    return (const char*)(((unsigned long long)hi << 32) | lo);
}
__device__ __forceinline__ void stage_tile(LAS unsigned char* lds, int slot, const bf16_t* kj_, const bf16_t* vj_, int tid_, int wid) {
    const char* kj = uniform_ptr(kj_); const char* vj = uniform_ptr(vj_);
    int tid = tid_; asm volatile("" : "+v"(tid));
    unsigned koff, voff[2]; stage_offsets(tid, koff, voff);
    LAS unsigned char* kd = lds + K_OFF + slot * SHM_K + wid * 1024; LAS unsigned char* vd = lds + V_OFF + slot * SHM_V + wid * 1024;
    __builtin_amdgcn_global_load_lds((const unsigned*)(kj + koff), (LAS unsigned*)kd, 16, 0, 0);
#pragma unroll
    for (int i = 0; i < 2; ++i) __builtin_amdgcn_global_load_lds((const unsigned*)(vj + voff[i]), (LAS unsigned*)(vd + i * 8192), 16, 0, 0);
}

__device__ __forceinline__ void qk_softmax(const LAS unsigned char* kslot, int r32, int hi, LAS float* al_l, const v8i32 (&qf)[2], const f32x16& bias, f32x16 (&o)[8], v8i32& pa, int& pscl,
                                           float& m_reg, float& l_reg, float rawu, float sl2, bool diag, int qi) {
    f32x16 p0, p1;
    qkt(p0, p1, kslot, r32, hi, qf, bias);
    if (diag) {
        const float k2raw = 2.f * rawu;
        int qi_ = qi - 4 * hi; asm volatile("" : "+v"(qi_));
#pragma unroll
        for (int r = 0; r < 16; ++r) { const int c = (r & 3) + 8 * (r >> 2); const int d0_ = c - qi_, d1_ = c + 32 - qi_;
            p0[r] -= k2raw * (float)(d0_ > 0 ? d0_ : 0); p1[r] -= k2raw * (float)(d1_ > 0 ? d1_ : 0); }
    }
    const float lane_raw = rawu * (float)(4 * hi), d32raw = 32.f * rawu;
    float pm0 = p0[0], pm1 = p1[0];
#pragma unroll
    for (int r = 1; r < 16; ++r) { pm0 = fmaxf(pm0, p0[r]); pm1 = fmaxf(pm1, p1[r]); }
    float pmax = fmaxf(pm0, pm1 + d32raw) + lane_raw;
    { auto rr = __builtin_amdgcn_permlane32_swap(__float_as_uint(pmax), __float_as_uint(pmax), false, false);
      pmax = fmaxf(__uint_as_float(rr[0]), __uint_as_float(rr[1])); }
    float mn, alpha;
    if (__all((pmax - m_reg) * SCALE <= THR)) { mn = m_reg; alpha = 1.f; }
    else { mn = fmaxf(m_reg, pmax); alpha = __builtin_amdgcn_exp2f((m_reg - mn) * C2); m_reg = mn; }
    const float ef = fminf(floorf(8.75f - (pmax - mn) * C2), 60.f);
    pscl = 127 - (int)ef;
    const float mnL0 = (lane_raw - mn) * C2 + ef, mnL1 = mnL0 + 32.f * sl2;
#pragma unroll
    for (int r = 0; r < 16; ++r) { p0[r] = __builtin_amdgcn_exp2f(fmaf(p0[r], C2, mnL0)); p1[r] = __builtin_amdgcn_exp2f(fmaf(p1[r], C2, mnL1)); }
    if (__any(alpha < 1.f)) {
        if (hi == 0) al_l[r32] = alpha;
        LDS_WAIT();
#pragma unroll
        for (int r = 0; r < 16; ++r) { const float a = al_l[crow(r, hi)];
#pragma unroll
            for (int d = 0; d < 8; ++d) o[d][r] *= a; }
    }
    float ps = 0.f;
#pragma unroll
    for (int r = 0; r < 16; ++r) ps += p0[r] + p1[r];
    { auto rr = __builtin_amdgcn_permlane32_swap(__float_as_uint(ps), __float_as_uint(ps), false, false);
      ps = __uint_as_float(rr[0]) + __uint_as_float(rr[1]); }
    l_reg = l_reg * alpha + ps * __builtin_amdgcn_exp2f(-ef);
#pragma unroll
    for (int g = 0; g < 4; ++g) {
        pa[g] = __builtin_amdgcn_cvt_pk_fp8_f32(p0[4 * g + 2], p0[4 * g + 3], __builtin_amdgcn_cvt_pk_fp8_f32(p0[4 * g], p0[4 * g + 1], (int)__float_as_uint(p0[4 * g]), false), true);
        pa[4 + g] = __builtin_amdgcn_cvt_pk_fp8_f32(p1[4 * g + 2], p1[4 * g + 3], __builtin_amdgcn_cvt_pk_fp8_f32(p1[4 * g], p1[4 * g + 1], (int)__float_as_uint(p1[4 * g]), false), true); }
}

__device__ __forceinline__ void norms_phase(Frame& F, const bf16_t* proj, float* nrm) {
    const int gw = F.vcu * NWAVES + F.wave, NGW = F.G * NWAVES, lane = F.lane;
    for (int idx = gw; idx < 2 * 32 * 256; idx += NGW) {
        const int tensor = idx >> 13, stream = (idx >> 8) & 31, grp = idx & 255;
        const u32x4* rp = (const u32x4*)((const unsigned char*)proj + (tensor ? DK0 : 0) + ((size_t)stream * SEQ + grp * 64 + lane) * 128);
        float ss = 0.f;
#pragma unroll
        for (int q = 0; q < 8; ++q) { const u32x4 v = rp[q];
#pragma unroll
            for (int e = 0; e < 4; ++e) { const float a0 = __builtin_amdgcn_cvt_f32_fp8((int)v[e], 0), a1 = __builtin_amdgcn_cvt_f32_fp8((int)v[e], 1), a2 = __builtin_amdgcn_cvt_f32_fp8((int)v[e], 2), a3 = __builtin_amdgcn_cvt_f32_fp8((int)v[e], 3);
                ss += (a0 * a0 + a1 * a1) + (a2 * a2 + a3 * a3); } }
        float n = sqrtf(ss) * 1.001f;
#pragma unroll
        for (int o = 1; o < 64; o <<= 1) n = fmaxf(n, __shfl_xor(n, o));
        if (lane == 0) nrm[idx] = n;
    }
}

__device__ __forceinline__ void attn_item(LAS unsigned char* lds, const bf16_t* proj, const float* nrm, bf16_t* oout, int b, int h, int sub, int qb, int tid, int wid, int lane, unsigned* queue, LAS int* qnext) {
    asm volatile("" : "+v"(lane));
    const int r32 = lane & 31, hi = lane >> 5;
    const float slope = __builtin_amdgcn_exp2f(-(float)(h + 1));
    const float sl2 = slope * 1.4426950408889634f, rawu = sl2 / C2;
    LAS float* ws = (LAS float*)(lds + SCR_OFF) + wid * 64; LAS float* li_l = ws; LAS float* al_l = ws + 32;
    const size_t tokq = (size_t)b * SEQ + (size_t)qb * 256 + wid * 32;
    const bf16_t* kbase = (const bf16_t*)((const unsigned char*)proj + DK0 + dq_off(b, 0, h, sub));
    const bf16_t* vbase = (const bf16_t*)((const unsigned char*)proj + pg8::vt_off(b, h, 0));
    int j_lo;
    { const int stream = (b * 8 + h) * 2 + sub; const float* qn = nrm + stream * 256; const float* kn = nrm + 8192 + stream * 256;
      const float Qn = fmaxf(fmaxf(qn[4 * qb], qn[4 * qb + 1]), fmaxf(qn[4 * qb + 2], qn[4 * qb + 3]));
      const float Kd = fmaxf(fmaxf(kn[4 * qb], kn[4 * qb + 1]), fmaxf(kn[4 * qb + 2], kn[4 * qb + 3]));
      int cand = 4 * qb;
      for (int jj = lane; jj < 4 * qb; jj += 64) { const float dmin = (float)(256 * qb - (64 * jj + 63)); const bool skip = slope * dmin > 110.f + SCALE * Qn * (kn[jj] + Kd); if (!skip) cand = cand < jj ? cand : jj; }
#pragma unroll
      for (int o = 1; o < 64; o <<= 1) { const int v = __builtin_amdgcn_ds_bpermute((lane ^ o) << 2, cand); cand = v < cand ? v : cand; }
      j_lo = __builtin_amdgcn_readfirstlane(cand); }
    v8i32 qf[2];
    { const unsigned char* qrow = (const unsigned char*)proj + dq_off(b, qb * 256 + wid * 32 + r32, h, sub) + 32 * hi;
#pragma unroll
      for (int s = 0; s < 2; ++s) { const v4i32 x0 = *(const v4i32*)(qrow + 64 * s), x1 = *(const v4i32*)(qrow + 64 * s + 16); qf[s] = __builtin_shufflevector(x0, x1, 0, 1, 2, 3, 4, 5, 6, 7); } }
    const float sh64 = 64.f * rawu;
    f32x16 bias;
#pragma unroll
    for (int r = 0; r < 16; ++r) bias[r] = (float)((r & 3) + 8 * (r >> 2)) * rawu;
    const int qi = 32 * (wid & 1) + r32;
    const LAS unsigned char* vb0 = lds + V_OFF + r32 * 64 + (((2 * hi) ^ ((r32 >> 2) & 3)) << 4);
    float m_reg = -1e30f, l_reg = 0.f;
    f32x16 o[8];
#pragma unroll
    for (int d = 0; d < 8; ++d)
#pragma unroll
        for (int r = 0; r < 16; ++r) o[d][r] = 0.f;
    const int NT = 4 * qb + 4, myNT = 4 * qb + (wid >> 1) + 1;
    constexpr size_t KSTEP = 64 * 128 / 2, VSTEP = 256 * 64 / 2;
    const bool late = wid >= 4;
#define ATT_STAGE(jj, sl) stage_tile(lds, sl, kbase + (size_t)(jj) * KSTEP, vbase + (size_t)(jj) * VSTEP, tid, wid)
#define ATT_NEXT(s_) ((s_) == NSLOT - 1 ? 0 : (s_) + 1)
#define ATT_WAIT(j_) do { const int rem_ = NT - 2 - (j_); if (rem_ >= 2) asm volatile("s_waitcnt vmcnt(6)" ::: "memory"); else if (rem_ == 1) asm volatile("s_waitcnt vmcnt(3)" ::: "memory"); \
        else asm volatile("s_waitcnt vmcnt(0)" ::: "memory"); WG_BAR(); } while (0)
    int s0 = j_lo % NSLOT;
    { const int s1 = ATT_NEXT(s0), s2 = ATT_NEXT(s1); ATT_STAGE(j_lo, s0); ATT_STAGE(j_lo + 1, s1); ATT_STAGE(j_lo + 2, s2); }
    asm volatile("s_waitcnt vmcnt(6)" ::: "memory"); WG_BAR();
    if (!late) {
        asm volatile(".p2align 8");
        for (int j = j_lo; j < NT; ++j) {
            const int s1 = ATT_NEXT(s0);
            if (j + 3 < NT) { const int s3 = ATT_NEXT(ATT_NEXT(s1)); ATT_STAGE(j + 3, s3); }
            if (j < myNT) { if (j > j_lo) m_reg -= sh64;
                v8i32 pa; int pscl;
                qk_softmax(lds + K_OFF + s0 * SHM_K, r32, hi, al_l, qf, bias, o, pa, pscl, m_reg, l_reg, rawu, sl2, j == myNT - 1, qi);
                pv_tile(o, vb0 + s0 * SHM_V, pa, pscl); }
            ATT_WAIT(j);
            s0 = s1;
        }
    } else {
        v8i32 pa; int pscl = 127;
#pragma unroll
        for (int g = 0; g < 8; ++g) pa[g] = 0;
        int sp = s0;
        asm volatile(".p2align 8");
        for (int j = j_lo; j < NT; ++j) {
            const int s1 = ATT_NEXT(s0);
            if (j + 3 < NT) { const int s3 = ATT_NEXT(ATT_NEXT(s1)); ATT_STAGE(j + 3, s3); }
            if (j > j_lo && j - 1 < myNT) pv_tile(o, vb0 + sp * SHM_V, pa, pscl);
            if (j < myNT) { if (j > j_lo) m_reg -= sh64;
                qk_softmax(lds + K_OFF + s0 * SHM_K, r32, hi, al_l, qf, bias, o, pa, pscl, m_reg, l_reg, rawu, sl2, j == myNT - 1, qi); }
            ATT_WAIT(j);
            sp = s0; s0 = s1;
        }
        if (myNT == NT) pv_tile(o, vb0 + sp * SHM_V, pa, pscl);
    }
#undef ATT_WAIT
#undef ATT_NEXT
#undef ATT_STAGE
    int jn_ = 0; if (tid == 0) jn_ = (int)__hip_atomic_fetch_add(queue, 1u, __ATOMIC_RELAXED, __HIP_MEMORY_SCOPE_AGENT);
    if (hi == 0) li_l[r32] = l_reg;
    LDS_WAIT();
    char* Ow = (char*)(oout + tokq * D + h * 256);
    const unsigned lofs = (unsigned)(hi * 4 * D + r32) * 2u;
#pragma unroll
    for (int r = 0; r < 16; ++r) { const float rl = __builtin_amdgcn_rcpf(li_l[crow(r, hi)]);
#pragma unroll
        for (int d0 = 0; d0 < 8; ++d0) { const float v = o[d0][r] * rl; const float vn = __uint_as_float((unsigned)__builtin_amdgcn_ds_bpermute((lane ^ 1) << 2, (int)__float_as_uint(v)));
            if ((r32 & 1) == 0) *(unsigned*)(Ow + (lofs + (unsigned)((((r & 3) + 8 * (r >> 2)) * D + d0 * 32) * 2))) = cvt_pk_bf16(v, vn); } }
    if (tid == 0) *qnext = jn_;
    WG_BAR();
}

struct TailConv { const float* wg; const float* wu; const float* wd; bf16_t* gu; bf16_t* dt; };
__device__ __forceinline__ void attn_phase(Frame& F, const bf16_t* proj, const float* nrm, unsigned* queue, bf16_t* o1, bf16_t* o2, const TailConv tc) {
    LAS int* qw = (LAS int*)(F.lds + SCR_OFF + 8 * 256);
    if (F.tid == 0) qw[0] = (int)__hip_atomic_fetch_add(queue, 1u, __ATOMIC_RELAXED, __HIP_MEMORY_SCOPE_AGENT);
    WG_BAR();
    for (int n = 0;; ++n) {
        const int J = __builtin_amdgcn_readfirstlane(qw[n & 1]);
        if (J >= 2048 + 512) break;
        const int grp = J / 5, rr = J - 5 * grp;
        if (rr == 4) { int jn_ = 0; if (F.tid == 0) jn_ = (int)__hip_atomic_fetch_add(queue, 1u, __ATOMIC_RELAXED, __HIP_MEMORY_SCOPE_AGENT);
            conv_moe(F, tc.wg, tc.wu, tc.wd, tc.gu, tc.dt, grp, 512, L1_EARLY, NEXP - L1_EARLY); if (F.tid == 0) qw[(n + 1) & 1] = jn_; WG_BAR(); continue; }
        const int I = 4 * grp + rr;
        const int qb = 63 - (I >> 5), r = I & 31, h = 7 - (r >> 2), b = (r >> 1) & 1, sub = r & 1;
        attn_item(F.lds, proj, nrm, sub ? o2 : o1, b, h, sub, qb, F.tid, F.wave, F.lane, queue, qw + ((n + 1) & 1));
    }
}
}

__device__ __forceinline__ const void* karg(int i) { int j = i; asm volatile("" : "+s"(j)); return ((const void* const __attribute__((address_space(4)))*)__builtin_amdgcn_kernarg_segment_ptr())[j]; }
#if defined(__HIP_DEVICE_COMPILE__)
#define NO_PK_F32 __attribute__((target("no-packed-fp32-ops")))
#else
#define NO_PK_F32
#endif
__global__ void __launch_bounds__(NWAVES * 64, 2) NO_PK_F32 hybrid_fwd(Args args) {
    extern __shared__ __attribute__((aligned(16))) unsigned char lds_raw[];
    Frame F;
    F.lds = (LAS unsigned char*)lds_raw;
    F.tid = threadIdx.x; F.lane = F.tid & 63; F.wave = __builtin_amdgcn_readfirstlane(F.tid >> 6);
    F.G = gridDim.x; { const int bx = blockIdx.x; F.vcu = (F.G % 8 == 0) ? (bx % 8) * (F.G / 8) + bx / 8 : bx; }
#define ws ((unsigned char*)karg(22))
#define ctl ((unsigned*)(ws + WS_CTL))
    for (int u = F.tid; u < (LDS_BYTES - LDSCTL_OFF) / 4; u += NWAVES * 64) ((LAS unsigned*)(F.lds + LDSCTL_OFF))[u] = 0u;
    SYNCTHREADS();
    ((LAS int*)(F.lds + TIDS_OFF))[F.tid] = F.tid;
    SYNCTHREADS();
    volatile LAS unsigned* MISC = (volatile LAS unsigned*)(F.lds + MISC_OFF);
    XcdBarrier bar = xcd_barrier_post(ctl + CW_BAR, MISC + 8);
#define GRID_BAR() do { XcdBarrier bb_ = bar; unsigned x_ = bar.x; unsigned long long bp_ = (unsigned long long)bar.bar; asm volatile("" : "+s"(x_), "+s"(bp_)); bb_.x = x_; bb_.bar = (unsigned*)bp_; xcd_barrier(bb_, TID_RELOAD() == 0); } while (0)
#define TID_RELOAD() (F.wave * 64 + lane_id_volatile())
#ifdef ONLY_PHASE
#define PHON(n) ((n) == ONLY_PHASE)
#else
#define PHON(n) 1
#endif

#define x_in ((const float*)(karg(0)))
#define norm_mix ((const float*)(karg(1)))
#define norm_ffn ((const float*)(karg(2)))
#define gla_w_in ((const float*)(karg(3)))
#define gla_wgu ((const float*)(karg(4)))
#define gla_bg ((const float*)(karg(5)))
#define gla_norm ((const float*)(karg(6)))
#define gla_w_out ((const float*)(karg(7)))
#define diff_w_in ((const float*)(karg(8)))
#define lq1 ((const float*)(karg(9)))
#define lk1 ((const float*)(karg(10)))
#define lq2 ((const float*)(karg(11)))
#define lk2 ((const float*)(karg(12)))
#define diff_subln ((const float*)(karg(13)))
#define diff_w_out ((const float*)(karg(14)))
#define moe_wgrp ((const float*)(karg(15)))
#define moe_wexp ((const float*)(karg(16)))
#define moe_wg ((const float*)(karg(17)))
#define moe_wu ((const float*)(karg(18)))
#define moe_wd ((const float*)(karg(19)))
#define final_norm ((const float*)(karg(20)))
#define xres ((bf16_t*)(ws + WS_XRES))
#define gz ((float*)((float*)(ws + WS_GZ)))
#define tok_e ((int*)((int*)(ws + WS_TOKE)))
#define tok_p ((int*)((int*)(ws + WS_TOKP)))
#define tok_w ((float*)((float*)(ws + WS_TOKW)))
#define slot_of ((int*)((int*)(ws + WS_SLOT)))
#define slot_tok ((int*)(ws + WS_STOK))
#define adec ((float*)((float*)(ws + WS_ADEC)))
#define pcum ((float*)((float*)(ws + WS_PCUM)))
#define sfin ((bf16_t*)((bf16_t*)(ws + WS_SFIN)))
#define wp_gz ((float*)((float*)(ws + WS_WPGZ)))
#define wp_r0 ((float*)((float*)(ws + WS_WPR0)))
#define wp_r1 ((float*)((float*)(ws + WS_WPR1)))
#define wgi ((bf16_t*)((bf16_t*)(ws + WS_WGI)))
#define wgo ((bf16_t*)((bf16_t*)(ws + WS_WGO)))
#define wdi ((bf16_t*)((bf16_t*)(ws + WS_WDI)))
#define wdo ((bf16_t*)((bf16_t*)(ws + WS_WDO)))
#define wmoe_gu ((bf16_t*)((bf16_t*)(ws + WS_WMOE)))
#define wmoe_d ((bf16_t*)((bf16_t*)(ws + WS_WMOE_D)))
#define hn ((bf16_t*)((bf16_t*)(ws + WS_HN)))
#define proj ((bf16_t*)((bf16_t*)(ws + WS_PROJ)))
#define buf1 ((bf16_t*)((bf16_t*)(ws + WS_BUF1)))
#define buf2 ((bf16_t*)((bf16_t*)(ws + WS_BUF2)))
#define ag ((bf16_t*)((bf16_t*)(ws + WS_AG)))
#define ob ((bf16_t*)((bf16_t*)(ws + WS_OB)))
#define hh ((bf16_t*)((bf16_t*)(ws + WS_H)))
    const LAS int* pst = (const LAS int*)(F.lds + TAB_OFF);

    _Pragma("unroll") for (int rep_ = 0; rep_ < (REP_PHASE == 0 ? 2 : 1); ++rep_) if (PHON(0)) { if (rep_) GRID_BAR(); Frame P = F; P.tid = TID_RELOAD(); P.lane = P.tid & 63;
    conv_plain(P, gla_w_in, D, PROJW, GLA_INW, wgi, -1, 0, norm_mix);
    conv_plain(P, gla_w_out, D, D, D, wgo);
    pack_proj(P, wp_gz, 1, norm_mix, gla_w_in, GLA_INW, PROJW, 16, nullptr, 0, 0);
    pack_proj16(P, (bf16_t*)wp_r0, 3, norm_ffn, moe_wgrp, 4, 0, 4, moe_wexp, 32, 32);
    pack_proj16(P, (bf16_t*)wp_r1, 3, norm_ffn + D, moe_wgrp + (size_t)D * 4, 4, 0, 4, moe_wexp + (size_t)D * 32, 32, 32);
    }
    GRID_BAR();
    _Pragma("unroll") for (int rep_ = 0; rep_ < (REP_PHASE == 1 ? 2 : 1); ++rep_) if (PHON(1)) { if (rep_) GRID_BAR(); Frame P = F; P.tid = TID_RELOAD(); P.lane = P.tid & 63;
    phase_norm_gz(P, x_in, wp_gz, hn, gz, (float*)(ws + WS_PCUM));
    }
    GRID_BAR();
    _Pragma("unroll") for (int rep_ = 0; rep_ < (REP_PHASE == 2 ? 2 : 1); ++rep_) if (PHON(2)) { if (rep_) GRID_BAR(); Frame P = F; P.tid = TID_RELOAD(); P.lane = P.tid & 63;
    { pg8::Gemm g{hn, wgi, T, PROJW, D}; pg8::StaticOrder S; S.init(T, PROJW, P.G, (int)blockIdx.x); pg8::EpiHeads<0> E{proj, (const float*)(ws + WS_PCUM)};
      pg8::gemm_phase<pg8::EpiHeads<0>, pg8::StaticOrder>(P.lds, g, S, E, P.tid); }
    }
    GRID_BAR();
    _Pragma("unroll") for (int rep_ = 0; rep_ < (REP_PHASE == 3 ? 2 : 1); ++rep_) if (PHON(3)) { if (rep_) GRID_BAR(); Frame P = F; P.tid = TID_RELOAD(); P.lane = P.tid & 63;
    phase_gla_gate(P, gz, gla_wgu, gla_bg, proj, buf1, adec);
    }
    GRID_BAR();
    _Pragma("unroll") for (int rep_ = 0; rep_ < (REP_PHASE == 4 ? 2 : 1); ++rep_) if (PHON(4)) { if (rep_) GRID_BAR(); Frame P = F; P.tid = TID_RELOAD(); P.lane = P.tid & 63;
    if (P.G == 256) { if ((P.vcu & 1) == 0) phase_gla_scan(P, P.vcu >> 1, proj, buf1, adec, buf2, sfin); else { gla_pcum(P, adec, pcum, P.vcu >> 1, 128); conv_moe(P, moe_wg, moe_wu, moe_wd, wmoe_gu, wmoe_d, P.vcu >> 1, 128);
            conv_moe(P, moe_wg + (size_t)NEXP * D * DFF, moe_wu + (size_t)NEXP * D * DFF, moe_wd + (size_t)NEXP * DFF * D, (bf16_t*)(ws + WS_WMOE1), (bf16_t*)(ws + WS_WMOE1_D), P.vcu >> 1, 128, 0, L1_EARLY);
            conv_plain<true>(P, diff_w_in, D, PROJW, PROJW, wdi, P.vcu >> 1, 128); conv_plain<true>(P, diff_w_out, D, D, D, wdo, P.vcu >> 1, 128); } }
    else { for (int it = P.vcu; it < 128; it += P.G) phase_gla_scan(P, it, proj, buf1, adec, buf2, sfin); gla_pcum(P, adec, pcum, P.vcu, P.G); conv_moe(P, moe_wg, moe_wu, moe_wd, wmoe_gu, wmoe_d); conv_moe(P, moe_wg + (size_t)NEXP * D * DFF, moe_wu + (size_t)NEXP * D * DFF, moe_wd + (size_t)NEXP * DFF * D, (bf16_t*)(ws + WS_WMOE1), (bf16_t*)(ws + WS_WMOE1_D), -1, 0, 0, L1_EARLY); conv_plain<true>(P, diff_w_in, D, PROJW, PROJW, wdi); conv_plain<true>(P, diff_w_out, D, D, D, wdo); }
    GRID_BAR();
    phase_gla_qp(P, proj, pcum, buf1);
    GRID_BAR();
    { pg8::Gemm g{buf1, sfin, 8 * (SEQ / 2), 512, 256}; pg8::FixOrder S; S.init(8 * (SEQ / 2), 512, P.G, (int)blockIdx.x); pg8::EpiAddO E{buf2};
      pg8::gemm_phase<pg8::EpiAddO, pg8::FixOrder>(P.lds, g, S, E, P.tid); }
    }
    GRID_BAR();
    _Pragma("unroll") for (int rep_ = 0; rep_ < (REP_PHASE == 5 ? 2 : 1); ++rep_) if (PHON(5)) { if (rep_) GRID_BAR(); Frame P = F; P.tid = TID_RELOAD(); P.lane = P.tid & 63;
    phase_gla_gnorm(P, buf2, proj, gla_norm, buf1);
    }
    GRID_BAR();
    _Pragma("unroll") for (int rep_ = 0; rep_ < (REP_PHASE == 6 ? 2 : 1); ++rep_) if (PHON(6)) { if (rep_) GRID_BAR(); Frame P = F; P.tid = TID_RELOAD(); P.lane = P.tid & 63;
    { pg8::Gemm g{buf1, wgo, T, D, D}; pg8::StaticOrder S; S.init(T, D, P.G, (int)blockIdx.x); pg8::EpiRes16<true> E{hn, xres, D};
      pg8::gemm_phase<pg8::EpiRes16<true>, pg8::StaticOrder>(P.lds, g, S, E, P.tid); }
    }
    GRID_BAR();
    _Pragma("unroll") for (int rep_ = 0; rep_ < (REP_PHASE == 7 ? 2 : 1); ++rep_) if (PHON(7)) { if (rep_) GRID_BAR(); Frame P = F; P.tid = TID_RELOAD(); P.lane = P.tid & 63;
    phase_norm_route(P, xres, norm_ffn, wp_r0, hn, tok_e, tok_p, tok_w, ctl + CW_CNT0);
    }
    GRID_BAR();
    _Pragma("unroll") for (int rep_ = 0; rep_ < (REP_PHASE == 8 ? 2 : 1); ++rep_) if (PHON(8)) { if (rep_) GRID_BAR(); Frame P = F; P.tid = TID_RELOAD(); P.lane = P.tid & 63;
    moe_tables(P, ctl + CW_CNT0);
    phase_moe_slots(P, tok_e, tok_p, ctl + CW_CNT0, slot_of, slot_tok);
    }
    GRID_BAR();
    _Pragma("unroll") for (int rep_ = 0; rep_ < (REP_PHASE == 9 ? 2 : 1); ++rep_) if (PHON(9)) { if (rep_) GRID_BAR(); Frame P = F; P.tid = TID_RELOAD(); P.lane = P.tid & 63;
    { const int Mr = pst[33] * 256; pg8::Gemm g{hn, wmoe_gu, Mr, 1024, D}; pg8::MoeOrder S; S.init(Mr, 1024, P.G, (int)blockIdx.x); S.te = pst + 36; S.estride = (size_t)1024 * D; S.stok = slot_tok; pg8::EpiSiluMul E{(unsigned char*)hh};
      pg8::gemm_phase<pg8::EpiSiluMul, pg8::MoeOrder, true, true>(P.lds, g, S, E, P.tid); }
    }
    GRID_BAR();
    _Pragma("unroll") for (int rep_ = 0; rep_ < (REP_PHASE == 10 ? 2 : 1); ++rep_) if (PHON(10)) { if (rep_) GRID_BAR(); Frame P = F; P.tid = TID_RELOAD(); P.lane = P.tid & 63;
    { const int Mr = pst[33] * 256; pg8::Gemm g{hh, wmoe_d, Mr, D, DFF}; pg8::MoeOrder S; S.init(Mr, D, P.G, (int)blockIdx.x); S.te = pst + 36; S.estride = (size_t)D * DFF; S.stok = slot_tok; pg8::EpiF8x8 E{(unsigned char*)ob, D};
      pg8::gemm_phase<pg8::EpiF8x8, pg8::MoeOrder, false, true>(P.lds, g, S, E, P.tid); }
    }
    GRID_BAR();
    _Pragma("unroll") for (int rep_ = 0; rep_ < (REP_PHASE == 11 ? 2 : 1); ++rep_) if (PHON(11)) { if (rep_) GRID_BAR(); Frame P = F; P.tid = TID_RELOAD(); P.lane = P.tid & 63;
    phase_moe_combine<0>(P, xres, nullptr, ob, slot_of, tok_w, norm_mix + D, hn);
    }
    GRID_BAR();
    _Pragma("unroll") for (int rep_ = 0; rep_ < (REP_PHASE == 12 ? 2 : 1); ++rep_) if (PHON(12)) { if (rep_) GRID_BAR(); Frame P = F; P.tid = TID_RELOAD(); P.lane = P.tid & 63;
    { pg8::Gemm g{hn, wdi, T, 4096, D}; pg8::StaticOrder S; S.init(T, 4096, P.G, (int)blockIdx.x); pg8::EpiHeads<1> E{proj, nullptr};
      pg8::gemm_phase<pg8::EpiHeads<1>, pg8::StaticOrder, false, true>(P.lds, g, S, E, P.tid); }
    { pg8::Gemm g{hn, (const bf16_t*)((const unsigned char*)wdi + (size_t)4096 * D), T, 2048, D}; pg8::StaticOrder S; S.init(T, 2048, P.G, (int)blockIdx.x); pg8::EpiVT E{(unsigned char*)proj};
      pg8::gemm_phase<pg8::EpiVT, pg8::StaticOrder, false, true, true>(P.lds, g, S, E, P.tid); }
    GRID_BAR();
    att::norms_phase(P, proj, (float*)(ws + WS_NRM));
    }
    GRID_BAR();
    _Pragma("unroll") for (int rep_ = 0; rep_ < (REP_PHASE == 13 ? 2 : 1); ++rep_) if (PHON(13)) { if (rep_) GRID_BAR(); Frame P = F; P.tid = TID_RELOAD(); P.lane = P.tid & 63;
    att::attn_phase(P, proj, (const float*)(ws + WS_NRM), ctl + CW_QUEUE + 64 * rep_, buf1, buf2, att::TailConv{moe_wg + (size_t)NEXP * D * DFF, moe_wu + (size_t)NEXP * D * DFF, moe_wd + (size_t)NEXP * DFF * D, (bf16_t*)(ws + WS_WMOE1), (bf16_t*)(ws + WS_WMOE1_D)});
    }
    GRID_BAR();
    _Pragma("unroll") for (int rep_ = 0; rep_ < (REP_PHASE == 14 ? 2 : 1); ++rep_) if (PHON(14)) { if (rep_) GRID_BAR(); Frame P = F; P.tid = TID_RELOAD(); P.lane = P.tid & 63;
    phase_subln(P, buf1, buf2, lq1, lk1, lq2, lk2, diff_subln, hn);
    }
    GRID_BAR();
    _Pragma("unroll") for (int rep_ = 0; rep_ < (REP_PHASE == 15 ? 2 : 1); ++rep_) if (PHON(15)) { if (rep_) GRID_BAR(); Frame P = F; P.tid = TID_RELOAD(); P.lane = P.tid & 63;
    { pg8::Gemm g{hn, wdo, T, D, D}; pg8::StaticOrder S; S.init(T, D, P.G, (int)blockIdx.x); pg8::EpiRes16<true> E{xres, xres, D};
      pg8::gemm_phase<pg8::EpiRes16<true>, pg8::StaticOrder, false, true>(P.lds, g, S, E, P.tid); }
    }
    GRID_BAR();
    _Pragma("unroll") for (int rep_ = 0; rep_ < (REP_PHASE == 16 ? 2 : 1); ++rep_) if (PHON(16)) { if (rep_) GRID_BAR(); Frame P = F; P.tid = TID_RELOAD(); P.lane = P.tid & 63;
    phase_norm_route(P, xres, norm_ffn + D, wp_r1, hn, tok_e, tok_p, tok_w, ctl + CW_CNT1);
    }
    GRID_BAR();
    _Pragma("unroll") for (int rep_ = 0; rep_ < (REP_PHASE == 17 ? 2 : 1); ++rep_) if (PHON(17)) { if (rep_) GRID_BAR(); Frame P = F; P.tid = TID_RELOAD(); P.lane = P.tid & 63;
    moe_tables(P, ctl + CW_CNT1);
    phase_moe_slots(P, tok_e, tok_p, ctl + CW_CNT1, slot_of, slot_tok);
    }
    GRID_BAR();
    _Pragma("unroll") for (int rep_ = 0; rep_ < (REP_PHASE == 18 ? 2 : 1); ++rep_) if (PHON(18)) { if (rep_) GRID_BAR(); Frame P = F; P.tid = TID_RELOAD(); P.lane = P.tid & 63;
    { const int Mr = pst[33] * 256; pg8::Gemm g{hn, (bf16_t*)(ws + WS_WMOE1), Mr, 1024, D}; pg8::MoeOrder S; S.init(Mr, 1024, P.G, (int)blockIdx.x); S.te = pst + 36; S.estride = (size_t)1024 * D; S.stok = slot_tok; pg8::EpiSiluMul E{(unsigned char*)hh};
      pg8::gemm_phase<pg8::EpiSiluMul, pg8::MoeOrder, true, true>(P.lds, g, S, E, P.tid); }
    }
    GRID_BAR();
    _Pragma("unroll") for (int rep_ = 0; rep_ < (REP_PHASE == 19 ? 2 : 1); ++rep_) if (PHON(19)) { if (rep_) GRID_BAR(); Frame P = F; P.tid = TID_RELOAD(); P.lane = P.tid & 63;
    { const int Mr = pst[33] * 256; pg8::Gemm g{hh, (bf16_t*)(ws + WS_WMOE1_D), Mr, D, DFF}; pg8::MoeOrder S; S.init(Mr, D, P.G, (int)blockIdx.x); S.te = pst + 36; S.estride = (size_t)D * DFF; S.stok = slot_tok; pg8::EpiF8x8 E{(unsigned char*)ob, D};
      pg8::gemm_phase<pg8::EpiF8x8, pg8::MoeOrder, false, true>(P.lds, g, S, E, P.tid); }
    }
    GRID_BAR();
    _Pragma("unroll") for (int rep_ = 0; rep_ < (REP_PHASE == 20 ? 2 : 1); ++rep_) if (PHON(20)) { if (rep_) GRID_BAR(); Frame P = F; P.tid = TID_RELOAD(); P.lane = P.tid & 63;
    phase_moe_combine<1>(P, xres, (float*)(karg(21)), ob, slot_of, tok_w, final_norm, hn);
    }
}

#undef x_in
#undef norm_mix
#undef norm_ffn
#undef gla_w_in
#undef gla_wgu
#undef gla_bg
#undef gla_norm
#undef gla_w_out
#undef diff_w_in
#undef lq1
#undef lk1
#undef lq2
#undef lk2
#undef diff_subln
#undef diff_w_out
#undef moe_wgrp
#undef moe_wexp
#undef moe_wg
#undef moe_wu
#undef moe_wd
#undef final_norm
#undef xres
#undef gz
#undef tok_e
#undef tok_p
#undef tok_w
#undef slot_of
#undef slot_tok
#undef ws
#undef ctl
#undef adec
#undef pcum
#undef sfin
#undef wp_gz
#undef wp_r0
#undef wp_r1
#undef wgi
#undef wgo
#undef wdi
#undef wdo
#undef wmoe_gu
#undef wmoe_d
#undef hn
#undef proj
#undef buf1
#undef buf2
#undef ag
#undef ob
#undef hh

extern "C" void kernel_launch(void* const* d_in, const int* in_sizes, int n_in, void* d_out, int out_size, void* d_ws, size_t ws_size, hipStream_t stream) {
    static int grid = 0;
    if (grid == 0) {
        if (n_in != 21 || out_size != T * D || ws_size < WS_END) { fprintf(stderr, "kernel_launch: unexpected shapes (n_in %d out %d ws %zu)\n", n_in, out_size, ws_size); grid = -1; return; }
        if (hipFuncSetAttribute((const void*)hybrid_fwd, hipFuncAttributeMaxDynamicSharedMemorySize, LDS_BYTES) != hipSuccess) { fprintf(stderr, "kernel_launch: hipFuncSetAttribute failed\n"); grid = -1; return; }
        int dev = 0, cus = 0, per_cu = 0;
        (void)hipGetDevice(&dev); (void)hipDeviceGetAttribute(&cus, hipDeviceAttributeMultiprocessorCount, dev);
        if (hipOccupancyMaxActiveBlocksPerMultiprocessor(&per_cu, (const void*)hybrid_fwd, NWAVES * 64, LDS_BYTES) != hipSuccess || per_cu < 1) fprintf(stderr, "kernel_launch: occupancy query says %d\n", per_cu);
        (void)hipGetLastError();
        grid = cus > 0 ? cus : 256;
    }
    if (grid < 0) return;
    Args a{};
    for (int i = 0; i < 21; ++i) a.in[i] = (const float*)d_in[i];
    a.out = (float*)d_out; a.ws = (unsigned char*)d_ws; a.pad0 = 0; a.pad1 = 0;
    (void)hipMemsetAsync((char*)d_ws + WS_CTL, 0, CTL_ZERO_BYTES, stream);
    hipLaunchKernelGGL(hybrid_fwd, dim3(grid), dim3(NWAVES * 64), LDS_BYTES, stream, a);
}
```

```cpp
#ifndef REP_PHASE
#define REP_PHASE -1
#endif
#include <hip/hip_runtime.h>
#include <cstdio>
#include <cstdint>

#define LAS __attribute__((address_space(3)))
#define GAS __attribute__((address_space(1)))
typedef unsigned short bf16_t;
typedef short bf16x8 __attribute__((ext_vector_type(8)));
typedef short s16x4 __attribute__((ext_vector_type(4)));
typedef float f32x4 __attribute__((ext_vector_type(4)));
typedef float f32x2 __attribute__((ext_vector_type(2)));
typedef float f32x16 __attribute__((ext_vector_type(16)));
typedef unsigned u32x4 __attribute__((ext_vector_type(4)));
typedef unsigned u32x2 __attribute__((ext_vector_type(2)));
typedef int v8i32 __attribute__((ext_vector_type(8)));
typedef int v4i32 __attribute__((ext_vector_type(4)));

constexpr int D = 2048, SEQ = 16384, NBATCH = 2, T = NBATCH * SEQ, CHUNK = 64, NCH = SEQ / CHUNK;
constexpr int GLA_H = 4, GLA_DK = 256, GLA_DV = 512, GLA_DKT = 1024, GLA_INW = 6160, PROJW = 6144;
constexpr int DIFF_H = 8;
constexpr int NEXP = 32, DFF = 512;
constexpr float RMS_EPS = 1e-6f;
constexpr float LAMBDA_INIT = 0.35550906759f;
constexpr int MAX_TILES = 288;

constexpr int L1_EARLY = 20;
constexpr size_t MiB = 1u << 20;
constexpr size_t WS_CTL = 0, CTL_ZERO_BYTES = 1 * MiB;
constexpr size_t WS_GZ = 2 * MiB;
constexpr size_t WS_TOKE = 4 * MiB;
constexpr size_t WS_TOKP = WS_TOKE + 256 * 1024;
constexpr size_t WS_TOKW = WS_TOKP + 256 * 1024;
constexpr size_t WS_SLOT = WS_TOKW + 256 * 1024;
constexpr size_t WS_STOK = 5 * MiB;
constexpr size_t WS_ADEC = 8 * MiB;
constexpr size_t WS_WPGZ = 10 * MiB;
constexpr size_t WS_WPR0 = 10 * MiB + 256 * 1024;
constexpr size_t WS_WPR1 = 11 * MiB;
constexpr size_t WS_NRM = 12 * MiB;
constexpr size_t WS_PCUM = 13 * MiB;
constexpr size_t WS_SFIN = 14 * MiB;
constexpr size_t WS_WGI = 16 * MiB, WS_WGO = 40 * MiB, WS_WDI = 48 * MiB, WS_WDO = 72 * MiB;
constexpr size_t WS_WMOE = 80 * MiB;
constexpr size_t WS_WMOE_D = WS_WMOE + 128 * MiB;
constexpr size_t WS_WMOE1 = WS_WMOE + 64 * MiB, WS_WMOE1_D = WS_WMOE + 160 * MiB;
constexpr size_t WS_HN = 272 * MiB;
constexpr size_t WS_PROJ = 400 * MiB;
constexpr size_t WS_BUF1 = 784 * MiB;
constexpr size_t WS_BUF2 = 912 * MiB;
constexpr size_t WS_XRES = 528 * MiB;
constexpr size_t WS_AG = 400 * MiB;
constexpr size_t WS_OB = 688 * MiB;
constexpr size_t WS_H = 976 * MiB;
constexpr size_t WS_END = 1048 * MiB;
constexpr int CW_BAR = 4096;
constexpr int CW_QUEUE = 8192;
constexpr int CW_CNT0 = 16384, CW_CNT1 = 16384 + 32 * 64;


constexpr size_t GK0 = (size_t)T * 1024, GV0 = (size_t)T * 2048, GR0 = (size_t)T * 4096;
constexpr size_t DK0 = (size_t)T * 2048, DV0 = (size_t)T * 4096;
__host__ __device__ __forceinline__ size_t gq_off(int b, int t, int h) { return ((size_t)(b * 4 + h) * SEQ + t) * 256; }
__host__ __device__ __forceinline__ size_t gv_off(int b, int t, int h) { return GV0 + ((size_t)(b * 4 + h) * SEQ + t) * 512; }
__host__ __device__ __forceinline__ size_t dq_off(int b, int t, int h, int sub) { return ((size_t)((b * 8 + h) * 2 + sub) * SEQ + t) * 128; }
__host__ __device__ __forceinline__ size_t dv_off(int b, int t, int h) { return DV0 + ((size_t)(b * 8 + h) * SEQ + t) * 256; }

constexpr int RING_BYTES = 131072;
constexpr int LDSCTL_OFF = RING_BYTES;
constexpr int MISC_OFF = LDSCTL_OFF + 320;
constexpr int TIDS_OFF = LDSCTL_OFF + 8192;
constexpr int TAB_OFF = LDSCTL_OFF + 1024;
constexpr int LDS_BYTES = 147456;
constexpr int NWAVES = 8;

typedef __bf16 bf16x2_t __attribute__((ext_vector_type(2)));
__device__ __forceinline__ unsigned cvt_pk_bf16(float lo, float hi) { const f32x2 v = {lo, hi}; return __builtin_bit_cast(unsigned, __builtin_convertvector(v, bf16x2_t)); }
__device__ __forceinline__ unsigned cvt4_fp8(float a, float b, float c, float d) { int v = __builtin_amdgcn_cvt_pk_fp8_f32(a, b, 0, false); return (unsigned)__builtin_amdgcn_cvt_pk_fp8_f32(c, d, v, true); }
constexpr float W8_SCALE = 64.f;
__device__ __forceinline__ float bf_lo(unsigned w) { return __uint_as_float(w << 16); }
__device__ __forceinline__ float bf_hi(unsigned w) { return __uint_as_float(w & 0xffff0000u); }
__device__ __forceinline__ f32x4 bf4_expand(u32x2 w) { return (f32x4){bf_lo(w.x), bf_hi(w.x), bf_lo(w.y), bf_hi(w.y)}; }
template <bool B16> struct XRow { typedef f32x4 T; static __device__ __forceinline__ f32x4 get(const f32x4& v) { return v; } };
template <> struct XRow<true> { typedef u32x2 T; static __device__ __forceinline__ f32x4 get(const u32x2& v) { return bf4_expand(v); } };
__device__ __forceinline__ float bf2f(bf16_t b) { return __uint_as_float(((unsigned)b) << 16); }
__device__ __forceinline__ float wave_sum(float v) {
#pragma unroll
    for (int o = 1; o < 64; o <<= 1) v += __shfl_xor(v, o);
    return v;
}
__device__ __forceinline__ int lane_id() { return (int)__builtin_amdgcn_mbcnt_hi(~0u, __builtin_amdgcn_mbcnt_lo(~0u, 0u)); }
__device__ __forceinline__ int lane_id_volatile() { int l; asm volatile("v_mbcnt_lo_u32_b32 %0, -1, 0\n\tv_mbcnt_hi_u32_b32 %0, -1, %0" : "=v"(l)); return l; }
__device__ __forceinline__ int opq(int v) { asm volatile("" : "+v"(v)); return v; }
#define LDS_WAIT() asm volatile("s_waitcnt lgkmcnt(0)" ::: "memory")
#define VM_WAIT() asm volatile("s_waitcnt vmcnt(0)" ::: "memory")
#define SYNCTHREADS() do { __builtin_amdgcn_fence(__ATOMIC_RELEASE, "workgroup"); __builtin_amdgcn_s_barrier(); __builtin_amdgcn_fence(__ATOMIC_ACQUIRE, "workgroup"); } while (0)
#define WG_BAR() do { asm volatile("s_waitcnt lgkmcnt(0)" ::: "memory"); __builtin_amdgcn_s_barrier(); asm volatile("" ::: "memory"); } while (0)

namespace pg8 {
constexpr int BM = 256, BK = 64, HALF = 128, HTB = HALF * BK * 2, STAGE_BYTES = 8 * HTB, NXCD = 8, WGM = 8;
__host__ __device__ __forceinline__ int lds_byte(int r, int c) { const int st = (r >> 4) * 2 + (c >> 5), rr = r & 15, cc = c & 31, ob = rr * 64 + cc * 2; return st * 1024 + (ob ^ (((ob >> 9) & 1) << 5)); }
__host__ __device__ __forceinline__ void stage_rc(int b, int& R, int& C) { const int st = b / 1024, sb = b % 1024, swz = sb ^ (((sb >> 9) & 1) << 5); R = (st >> 1) * 16 + swz / 64; C = (st & 1) * 32 + (swz % 64) / 2; }
__host__ __device__ __forceinline__ int perm32(int rho) { const int n = rho >> 4, i = rho & 15; return 8 * (i >> 2) + 4 * n + (i & 3); }

struct Unit { int pm, pn; };
struct Gemm { const bf16_t* A; const bf16_t* Bt; int M, N, K; };

struct StaticOrder {
    int nM, nN, nwg, G, c;
    __device__ __forceinline__ void init(int M, int N, int G_, int c_) { nM = M / BM; nN = N / BM; nwg = nM * nN; G = G_; c = c_; }
    __device__ __forceinline__ bool next(int i, Unit& u) const {
        const long L = (long)i * G + c; if (L >= nwg) return false;
        int wgid = (int)L; { const int q = nwg / NXCD, r = nwg % NXCD, xcd = wgid % NXCD, off = wgid / NXCD; wgid = (xcd < r ? xcd * (q + 1) : r * (q + 1) + (xcd - r) * q) + off; }
        const int nig = WGM * nN, gid = wgid / nig, fm = gid * WGM, gsz = (nM - fm) < WGM ? (nM - fm) : WGM;
        u.pm = fm + ((wgid % nig) % gsz); u.pn = (wgid % nig) / gsz; return true;
    }
    __device__ __forceinline__ size_t bofs(const Unit&) const { return 0; }
};
struct MoeOrder : StaticOrder {
    const LAS int* te; size_t estride; const int* stok;
    __device__ __forceinline__ size_t bofs(const Unit& u) const { return (size_t)te[u.pm] * estride; }
    __device__ __forceinline__ int arow(int pm, int r) const { const int t = stok[pm * BM + r]; return t < 0 ? 0 : t; }
};

struct EpiBf16 {
    static constexpr bool PERM = true;
    bf16_t* O; int ldc;
    __device__ __forceinline__ void operator()(const f32x4 (&acc)[2][2][4][2], const Unit& u, int wr, int wc, int fr, int fq) const {
        const int row0 = u.pm * BM + wr * 64 + fr, col0 = u.pn * BM + wc * 32 + 8 * fq;
#pragma unroll
        for (int ai = 0; ai < 2; ++ai)
#pragma unroll
            for (int m = 0; m < 4; ++m) { bf16_t* rowp = O + (size_t)(row0 + ai * HALF + m * 16) * ldc + col0;
#pragma unroll
                for (int bj = 0; bj < 2; ++bj) { const f32x4 v0 = acc[ai][bj][m][0], v1 = acc[ai][bj][m][1];
                    u32x4 w; w.x = cvt_pk_bf16(v0[0], v0[1]); w.y = cvt_pk_bf16(v0[2], v0[3]); w.z = cvt_pk_bf16(v1[0], v1[1]); w.w = cvt_pk_bf16(v1[2], v1[3]);
                    *(u32x4*)(rowp + bj * HALF) = w; } }
    }
};
struct EpiF8x8 {
    static constexpr bool PERM = true;
    unsigned char* O; int ldc;
    __device__ __forceinline__ void operator()(const f32x4 (&acc)[2][2][4][2], const Unit& u, int wr, int wc, int fr, int fq) const {
        const int row0 = u.pm * BM + wr * 64 + fr, col0 = u.pn * BM + wc * 32 + 8 * fq;
#pragma unroll
        for (int ai = 0; ai < 2; ++ai)
#pragma unroll
            for (int m = 0; m < 4; ++m) { unsigned char* rowp = O + (size_t)(row0 + ai * HALF + m * 16) * ldc + col0;
#pragma unroll
                for (int bj = 0; bj < 2; ++bj) { const f32x4 v0 = acc[ai][bj][m][0] * 8.f, v1 = acc[ai][bj][m][1] * 8.f;
                    u32x2 w; w.x = cvt4_fp8(v0[0], v0[1], v0[2], v0[3]); w.y = cvt4_fp8(v1[0], v1[1], v1[2], v1[3]);
                    *(u32x2*)(rowp + bj * HALF) = w; } }
    }
};
template <int LAYER> struct EpiHeads {
    static constexpr bool PERM = true;
    bf16_t* O; const float* rstd;
    __device__ __forceinline__ void operator()(const f32x4 (&acc)[2][2][4][2], const Unit& u, int wr, int wc, int fr, int fq) const {
        const int pn = u.pn, lc = wc * 32 + 8 * fq;
#pragma unroll
        for (int ai = 0; ai < 2; ++ai)
#pragma unroll
            for (int m = 0; m < 4; ++m) { const int row = u.pm * BM + ai * HALF + wr * 64 + m * 16 + fr, b = row >> 14, t = row & (SEQ - 1);
#pragma unroll
                for (int bj = 0; bj < 2; ++bj) { size_t off;
                    if (LAYER == 0) { if (pn < 4) off = gq_off(b, t, pn) + bj * 128 + lc; else if (pn < 8) off = GK0 + gq_off(b, t, pn - 4) + bj * 128 + lc;
                                      else if (pn < 16) off = gv_off(b, t, (pn - 8) >> 1) + ((pn - 8) & 1) * 256 + bj * 128 + lc; else off = GR0 + (size_t)row * 2048 + (pn - 16) * 256 + bj * 128 + lc; }
                    else { if (pn < 8) off = dq_off(b, t, pn, bj) + lc; else if (pn < 16) off = DK0 + dq_off(b, t, pn - 8, bj) + lc; else off = dv_off(b, t, pn - 16) + bj * 128 + lc; }
                    f32x4 v0 = acc[ai][bj][m][0], v1 = acc[ai][bj][m][1];
                    if (LAYER == 0) { const float rs = rstd[row]; v0 *= rs; v1 *= rs; }
                    if (LAYER == 1 && pn < 16) {
                        u32x2 w8; w8.x = cvt4_fp8(v0[0], v0[1], v0[2], v0[3]); w8.y = cvt4_fp8(v1[0], v1[1], v1[2], v1[3]); *(u32x2*)((unsigned char*)O + off) = w8; continue; }
                    u32x4 w; w.x = cvt_pk_bf16(v0[0], v0[1]); w.y = cvt_pk_bf16(v0[2], v0[3]); w.z = cvt_pk_bf16(v1[0], v1[1]); w.w = cvt_pk_bf16(v1[2], v1[3]);
                    *(u32x4*)(O + off) = w; } }
    }
};
__host__ __device__ __forceinline__ size_t vt_off(int b, int h, int chunk) { return DV0 * 2 + ((size_t)((b * 8 + h) * (SEQ / 64) + chunk)) * 16384; }
struct EpiVT {
    static constexpr bool PERM = false;
    unsigned char* O;
    __device__ __forceinline__ void operator()(const f32x4 (&acc)[2][2][4][2], const Unit& u, int wr, int wc, int fr, int fq) const {
#pragma unroll
        for (int ai = 0; ai < 2; ++ai) { const int row0 = u.pm * BM + ai * HALF + wr * 64;
            unsigned char* tp = O + vt_off(row0 >> 14, u.pn, (row0 & (SEQ - 1)) >> 6) + (size_t)(wc * 32 + fr) * 64 + 32 * (fq & 1) + 4 * (fq >> 1);
#pragma unroll
            for (int m = 0; m < 4; ++m)
#pragma unroll
                for (int bj = 0; bj < 2; ++bj)
#pragma unroll
                    for (int n = 0; n < 2; ++n) { const f32x4 v = acc[ai][bj][m][n];
                        *(unsigned*)(tp + (bj * 128 + n * 16) * 64 + 16 * (m >> 1) + 8 * (m & 1)) = cvt4_fp8(v[0], v[1], v[2], v[3]); } }
    }
};
struct FixOrder : StaticOrder {
    __device__ __forceinline__ size_t bofs(const Unit& u) const { return (size_t)(u.pm >> 5) * (512 * 256 * 2); }
};
struct EpiAddO {
    static constexpr bool PERM = true;
    bf16_t* O;
    __device__ __forceinline__ void operator()(const f32x4 (&acc)[2][2][4][2], const Unit& u, int wr, int wc, int fr, int fq) const {
#pragma unroll
        for (int ai = 0; ai < 2; ++ai)
#pragma unroll
            for (int m = 0; m < 4; ++m) { const int row = u.pm * BM + ai * HALF + wr * 64 + m * 16 + fr, bhh = row >> 13, t = row & 8191;
                bf16_t* rowp = O + ((size_t)(bhh >> 2) * SEQ + SEQ / 2 + t) * D + (bhh & 3) * 512 + u.pn * BM + wc * 32 + 8 * fq;
#pragma unroll
                for (int bj = 0; bj < 2; ++bj) { const u32x4 old = *(const u32x4*)(rowp + bj * HALF); const f32x4 v0 = acc[ai][bj][m][0] * 0.0625f, v1 = acc[ai][bj][m][1] * 0.0625f;
                    u32x4 w; w.x = cvt_pk_bf16(bf_lo(old.x) + v0[0], bf_hi(old.x) + v0[1]); w.y = cvt_pk_bf16(bf_lo(old.y) + v0[2], bf_hi(old.y) + v0[3]);
                    w.z = cvt_pk_bf16(bf_lo(old.z) + v1[0], bf_hi(old.z) + v1[1]); w.w = cvt_pk_bf16(bf_lo(old.w) + v1[2], bf_hi(old.w) + v1[3]);
                    *(u32x4*)(rowp + bj * HALF) = w; } }
    }
};
template <bool BASE16> struct EpiRes16 {
    static constexpr bool PERM = true;
    const void* base; bf16_t* C; int ldc;
    __device__ __forceinline__ void operator()(const f32x4 (&acc)[2][2][4][2], const Unit& u, int wr, int wc, int fr, int fq) const {
        const int row0 = u.pm * BM + wr * 64 + fr, col0 = u.pn * BM + wc * 32 + 8 * fq;
#pragma unroll
        for (int ai = 0; ai < 2; ++ai)
#pragma unroll
            for (int m = 0; m < 4; ++m) { const size_t off = (size_t)(row0 + ai * HALF + m * 16) * ldc + col0;
#pragma unroll
                for (int bj = 0; bj < 2; ++bj) { f32x4 v0 = acc[ai][bj][m][0], v1 = acc[ai][bj][m][1];
                    if constexpr (BASE16) { const u32x4 bs = *(const u32x4*)((const bf16_t*)base + off + bj * HALF);
                        v0 += (f32x4){bf_lo(bs.x), bf_hi(bs.x), bf_lo(bs.y), bf_hi(bs.y)}; v1 += (f32x4){bf_lo(bs.z), bf_hi(bs.z), bf_lo(bs.w), bf_hi(bs.w)}; }
                    else { const f32x4* bp = (const f32x4*)((const float*)base + off + bj * HALF); v0 += bp[0]; v1 += bp[1]; }
                    u32x4 w; w.x = cvt_pk_bf16(v0[0], v0[1]); w.y = cvt_pk_bf16(v0[2], v0[3]); w.z = cvt_pk_bf16(v1[0], v1[1]); w.w = cvt_pk_bf16(v1[2], v1[3]);
                    *(u32x4*)(C + off + bj * HALF) = w; }
                asm volatile("" ::: "memory"); }
    }
};
struct EpiSiluMul {
    static constexpr bool PERM = true;
    unsigned char* Hh;
    __device__ __forceinline__ void operator()(const f32x4 (&acc)[2][2][4][2], const Unit& u, int wr, int wc, int fr, int fq) const {
        const int row0 = u.pm * BM + wr * 64 + fr, col0 = u.pn * HALF + wc * 32 + 8 * fq;
#pragma unroll
        for (int ai = 0; ai < 2; ++ai)
#pragma unroll
            for (int m = 0; m < 4; ++m) { unsigned char* rowp = Hh + (size_t)(row0 + ai * HALF + m * 16) * DFF + col0;
                float hv[8];
#pragma unroll
                for (int n = 0; n < 2; ++n)
#pragma unroll
                    for (int j = 0; j < 4; ++j) { const float g = acc[ai][0][m][n][j], up = acc[ai][1][m][n][j];
                        const float sg = g * __builtin_amdgcn_rcpf(1.0f + __builtin_amdgcn_exp2f(-1.4426950408889634f * g)); hv[n * 4 + j] = sg * up; }
                u32x2 w; w.x = cvt4_fp8(hv[0], hv[1], hv[2], hv[3]); w.y = cvt4_fp8(hv[4], hv[5], hv[6], hv[7]);
                *(u32x2*)rowp = w; }
    }
};

template <class Epi, class Sched, bool GATHER = false, bool FP8 = false, bool NTR = false>
__device__ __forceinline__ void gemm_phase(LAS unsigned char* lds, const Gemm g, const Sched& S, const Epi& E, int tid_in) {
    const int tid = opq(tid_in), wid = __builtin_amdgcn_readfirstlane(tid >> 6), lane = tid & 63, wr = wid >> 2, wc = wid & 3, fr = lane & 15, fq = lane >> 4;
    const int K = g.K, RP = FP8 ? K : 2 * K  , nt = RP / (BK * 2);
    unsigned voffA[2], voffB[2];
#pragma unroll
    for (int i = 0; i < 2; ++i) { int R, C; stage_rc(tid * 16 + i * 8192, R, C); const int Rb = Epi::PERM ? ((R & ~31) + perm32(R & 31)) : R;
        voffA[i] = (unsigned)(R * RP + 2 * C); voffB[i] = (unsigned)(Rb * RP + 2 * C); }
    const unsigned kstep = (unsigned)(BK * 2);
    const unsigned hstep = (unsigned)HALF * (unsigned)RP;
    const size_t tstep = 2 * (size_t)hstep;
    const unsigned ldsw = (unsigned)wid * 1024u;
    const int aoff = lds_byte(wr * 64 + fr, fq * 8), boff = lds_byte(wc * 32 + fr, fq * 8);
    const LAS unsigned char* ldsB = lds + 4 * HTB + boff;
#define PG8_SA(b, h) (((b) * 2 + (h)) * HTB)
#define PG8_SB(b, h) ((4 + (b) * 2 + (h)) * HTB)
#define PG8_STAGE(bufoff, gbase, voff) do { const unsigned long long gv_ = (unsigned long long)(gbase); \
        const unsigned glo_ = (unsigned)__builtin_amdgcn_readfirstlane((unsigned)gv_), ghi_ = (unsigned)__builtin_amdgcn_readfirstlane((unsigned)(gv_ >> 32)); const char* gb_ = (const char*)(((unsigned long long)ghi_ << 32) | (unsigned long long)glo_);     \
        _Pragma("unroll") for (int _i = 0; _i < 2; ++_i) \
        __builtin_amdgcn_global_load_lds((const unsigned*)(gb_ + (voff)[_i]), (LAS unsigned*)(lds + (bufoff) + ldsw + _i * 8192), 16, 0, 0); } while (0)
#define PG8_STAGE_A(bufoff, nx, koff, h) do { if constexpr (GATHER) { unsigned vs_[2]; _Pragma("unroll") for (int _i = 0; _i < 2; ++_i) vs_[_i] = (nx) ? vAn[h][_i] : vAc[h][_i]; \
            PG8_STAGE(bufoff, (const char*)g.A + (koff), vs_); } \
        else { PG8_STAGE(bufoff, ((nx) ? nA : cA) + (koff) + (h) * hstep, voffA); } } while (0)
#define PG8_LD8(off) __builtin_shufflevector(*(const LAS v4i32*)(lds + (off)), *(const LAS v4i32*)(lds + (off) + 1024), 0, 1, 2, 3, 4, 5, 6, 7)
#define PG8_LDA(dst, b, h) do { if constexpr (FP8) { _Pragma("unroll") for (int m = 0; m < 4; ++m) dst##8[m] = PG8_LD8(PG8_SA(b, h) + aoff + m * 2048); } \
        else { _Pragma("unroll") for (int m = 0; m < 4; ++m) _Pragma("unroll") for (int k = 0; k < 2; ++k) dst[m][k] = *(const LAS bf16x8*)(lds + PG8_SA(b, h) + aoff + m * 2048 + k * 1024); } } while (0)
#define PG8_LD8B(off) __builtin_shufflevector(*(const LAS v4i32*)(ldsB + (off)), *(const LAS v4i32*)(ldsB + (off) + 1024), 0, 1, 2, 3, 4, 5, 6, 7)
#define PG8_LDB(dst, b, h) do { if constexpr (FP8) { _Pragma("unroll") for (int n = 0; n < 2; ++n) dst##8[n] = PG8_LD8B(PG8_SA(b, h) + n * 2048); }     \
        else { _Pragma("unroll") for (int n = 0; n < 2; ++n) _Pragma("unroll") for (int k = 0; k < 2; ++k) dst[n][k] = *(const LAS bf16x8*)(lds + PG8_SB(b, h) + boff + n * 2048 + k * 1024); } } while (0)
#define PG8_MMA(ai, bj, At, Bt) do { __builtin_amdgcn_s_setprio(1); if constexpr (FP8) { _Pragma("unroll") for (int m = 0; m < 4; ++m) _Pragma("unroll") for (int n = 0; n < 2; ++n) \
              \
            { if constexpr (NTR) asm volatile("v_mfma_scale_f32_16x16x128_f8f6f4 %0, %1, %2, %0, %3, %3 op_sel:[1,0,0] op_sel_hi:[0,0,0]" : "+v"(acc[ai][bj][m][n]) : "v"(At##8[m]), "v"(Bt##8[n]), "v"(scl8)); \
              else asm volatile("v_mfma_scale_f32_16x16x128_f8f6f4 %0, %1, %2, %0, %3, %3 op_sel:[0,1,0] op_sel_hi:[0,0,0]" : "+v"(acc[ai][bj][m][n]) : "v"(Bt##8[n]), "v"(At##8[m]), "v"(scl8)); } } \
        else { _Pragma("unroll") for (int m = 0; m < 4; ++m) _Pragma("unroll") for (int n = 0; n < 2; ++n) _Pragma("unroll") for (int k = 0; k < 2; ++k) \
            acc[ai][bj][m][n] = __builtin_amdgcn_mfma_f32_16x16x32_bf16(Bt[n][k], At[m][k], acc[ai][bj][m][n], 0, 0, 0); } __builtin_amdgcn_s_setprio(0); } while (0)
#define PG8_WAIT_V(n) asm volatile("s_waitcnt vmcnt(" #n ")" ::: "memory")
#define PG8_WAIT_L(n) asm volatile("s_waitcnt lgkmcnt(" #n ")" ::: "memory")
#define PG8_BAR __builtin_amdgcn_s_barrier()
#define PG8_SCHED __builtin_amdgcn_sched_barrier(0)
#define PG8_ROWOFFS(V, U) do { if constexpr (GATHER) { const int t_ = opq(wid * 64 + lane_id());     \
        _Pragma("unroll") for (int i_ = 0; i_ < 2; ++i_) { int R_, C_; stage_rc(t_ * 16 + i_ * 8192, R_, C_); \
        _Pragma("unroll") for (int h_ = 0; h_ < 2; ++h_) V[h_][i_] = (unsigned)S.arow((U).pm, h_ * HALF + R_) * (unsigned)RP + 2u * (unsigned)C_; } } } while (0)
    Unit cur, nxt; int ui = 0;
    if (!S.next(0, cur)) return;
    f32x4 acc[2][2][4][2];
#pragma unroll
    for (int a = 0; a < 2; ++a)
#pragma unroll
        for (int b = 0; b < 2; ++b)
#pragma unroll
            for (int m = 0; m < 4; ++m)
#pragma unroll
                for (int n = 0; n < 2; ++n) acc[a][b][m][n] = (f32x4){0.f, 0.f, 0.f, 0.f};
    const unsigned scl8 = 0x7f797f79u;
    bf16x8 At[4][2], B0[2][2], B1[2][2]; v8i32 At8[4], B08[2], B18[2];
    unsigned vAc[2][2] = {{0u, 0u}, {0u, 0u}}, vAn[2][2] = {{0u, 0u}, {0u, 0u}};
    const char* cA = (const char*)g.A + (GATHER ? (size_t)0 : (size_t)cur.pm * tstep); const char* nA = cA; const char* cB = (const char*)g.Bt + S.bofs(cur) + (size_t)cur.pn * tstep;
    PG8_ROWOFFS(vAc, cur);
    PG8_STAGE(PG8_SB(0, 0), cB, voffB); PG8_STAGE(PG8_SB(0, 1), cB + hstep, voffB); PG8_STAGE_A(PG8_SA(0, 0), false, 0u, 0); PG8_STAGE_A(PG8_SA(0, 1), false, 0u, 1);
    if (wr == 1) PG8_BAR;
    PG8_WAIT_V(2); PG8_BAR;
    PG8_STAGE(PG8_SB(1, 0), cB + kstep, voffB); PG8_STAGE_A(PG8_SA(1, 0), false, kstep, 0); PG8_STAGE(PG8_SB(1, 1), cB + hstep + kstep, voffB);
    PG8_WAIT_V(6); PG8_BAR;
    for (;;) {
        const bool has_next = S.next(ui + 1, nxt);
        nA = (has_next && !GATHER) ? (const char*)g.A + (size_t)nxt.pm * tstep : cA; const char* nB = has_next ? (const char*)g.Bt + S.bofs(nxt) + (size_t)nxt.pn * tstep : cB;

        for (int t = 0; t < nt; t += 2) {
            const bool last = (t == nt - 2);
            if constexpr (GATHER) { if (last) {
                if (has_next) PG8_ROWOFFS(vAn, nxt); else { _Pragma("unroll") for (int h_ = 0; h_ < 2; ++h_) _Pragma("unroll") for (int i_ = 0; i_ < 2; ++i_) vAn[h_][i_] = vAc[h_][i_]; } } }
            const unsigned k1 = (unsigned)(t + 1) * kstep, k2 = last ? 0u : (unsigned)(t + 2) * kstep, k3 = k2 + kstep;
            const char* b2 = last ? nB : cB + k2; const char* b3 = b2 + kstep;
            PG8_LDB(B0, 0, 0); PG8_LDB(B1, 0, 1); PG8_SCHED; PG8_LDA(At, 0, 0); PG8_STAGE_A(PG8_SA(1, 1), false, k1, 1);
            PG8_WAIT_V(8); PG8_WAIT_L(0); PG8_BAR; PG8_MMA(0, 0, At, B0); PG8_MMA(0, 1, At, B1); PG8_BAR; PG8_SCHED;
            PG8_LDA(At, 0, 1); PG8_STAGE(PG8_SB(0, 0), b2, voffB); PG8_STAGE(PG8_SB(0, 1), b2 + hstep, voffB); PG8_STAGE_A(PG8_SA(0, 0), last, k2, 0);
            PG8_WAIT_V(8); PG8_WAIT_L(0); PG8_BAR; PG8_MMA(1, 0, At, B0); PG8_MMA(1, 1, At, B1); PG8_BAR; PG8_SCHED;
            PG8_LDB(B0, 1, 0); PG8_LDB(B1, 1, 1); PG8_SCHED; PG8_LDA(At, 1, 0); PG8_STAGE_A(PG8_SA(0, 1), last, k2, 1);
            PG8_WAIT_V(8); PG8_WAIT_L(0); PG8_BAR; PG8_MMA(0, 0, At, B0); PG8_MMA(0, 1, At, B1); PG8_BAR; PG8_SCHED;
            PG8_LDA(At, 1, 1); PG8_STAGE(PG8_SB(1, 0), b3, voffB); PG8_STAGE(PG8_SB(1, 1), b3 + hstep, voffB); PG8_STAGE_A(PG8_SA(1, 0), last, k3, 0);
            PG8_WAIT_V(8); PG8_WAIT_L(0); PG8_BAR; PG8_MMA(1, 0, At, B0); PG8_MMA(1, 1, At, B1); PG8_BAR; PG8_SCHED;
        }
        if (wr == 0) PG8_BAR;
        E(acc, cur, wr, wc, fr, fq);
        if (!has_next) break;
#pragma unroll
        for (int a = 0; a < 2; ++a)
#pragma unroll
            for (int b = 0; b < 2; ++b)
#pragma unroll
                for (int m = 0; m < 4; ++m)
#pragma unroll
                    for (int n = 0; n < 2; ++n) acc[a][b][m][n] = (f32x4){0.f, 0.f, 0.f, 0.f};
        cur = nxt; cA = nA; cB = nB; ++ui;
        if constexpr (GATHER) { _Pragma("unroll") for (int h_ = 0; h_ < 2; ++h_) _Pragma("unroll") for (int i_ = 0; i_ < 2; ++i_) vAc[h_][i_] = vAn[h_][i_]; }
        if (wr == 1) PG8_BAR;
    }
    PG8_WAIT_V(0);
    PG8_BAR;
#undef PG8_SA
#undef PG8_SB
#undef PG8_STAGE
#undef PG8_STAGE_A
#undef PG8_ROWOFFS
#undef PG8_LDA
#undef PG8_LDB
#undef PG8_MMA
#undef PG8_LD8
#undef PG8_LD8B
#undef PG8_WAIT_V
#undef PG8_WAIT_L
#undef PG8_BAR
#undef PG8_SCHED
}
}

#define XB_TMO      128
#define XB_XCNT(j)  (256  + 64 * (j))
#define XB_XSUB(j)  (1280 + 64 * (j))
#define XB_XGEN(j)  (2304 + 64 * (j))
#define XB_TOP      3328
#define XB_TOPGEN   3392
#define XCD_BAR_WORDS 3456
#define XB_SPIN_CAP (1u << 18)
__device__ __forceinline__ unsigned xb_ld(unsigned* p)              { return __hip_atomic_load(p, __ATOMIC_RELAXED, __HIP_MEMORY_SCOPE_AGENT); }
__device__ __forceinline__ unsigned xb_add(unsigned* p, unsigned v) { return __hip_atomic_fetch_add(p, v, __ATOMIC_RELAXED, __HIP_MEMORY_SCOPE_AGENT); }
__device__ __forceinline__ unsigned xb_xcc_id() { return (unsigned)__builtin_amdgcn_s_getreg((3 << 11) | 20) & 0xFu; }
#define XB_SPIN(cond, bar) do { unsigned _sp = 0; while (cond) { __builtin_amdgcn_s_sleep(1); \
    if ((++_sp & 255u) == 0u) { if (xb_ld(&(bar)[XB_TMO])) break; if (_sp > XB_SPIN_CAP) { atomicAdd(&(bar)[XB_TMO], 1u); break; } } } } while (0)
struct XcdBarrier { unsigned* bar; unsigned x; volatile LAS unsigned* st; int wave; };
__device__ __forceinline__ XcdBarrier xcd_barrier_post(unsigned* bar, volatile LAS unsigned* st) {
    XcdBarrier b; b.bar = bar; b.x = xb_xcc_id(); b.st = st; b.wave = __builtin_amdgcn_readfirstlane((int)threadIdx.x >> 6);
    if (threadIdx.x == 0) (void)xb_add(&bar[XB_XCNT(b.x)], 1u);
    return b;
}
__device__ __forceinline__ void xcd_barrier_complete(unsigned* bar, unsigned x, unsigned& nloc, unsigned& nx) {
    const unsigned G = gridDim.x * gridDim.y * gridDim.z;
    unsigned sum, cnt, mine, sp = 0u;
    for (;;) {
        sum = 0u; cnt = 0u; mine = 0u;
#pragma unroll
        for (unsigned j = 0; j < 16; ++j) { const unsigned c = xb_ld(&bar[XB_XCNT(j)]); sum += c; cnt += (c > 0u) ? 1u : 0u; mine = (j == x) ? c : mine; }
        if (sum == G) break;
        __builtin_amdgcn_s_sleep(1);
        if ((++sp & 255u) == 0u) { if (xb_ld(&bar[XB_TMO])) break; if (sp > XB_SPIN_CAP) { atomicAdd(&bar[XB_TMO], 1u); break; } }
    }
    nloc = mine > 0u ? mine : 1u; nx = cnt > 0u ? cnt : 1u;
}
__device__ __forceinline__ void xcd_barrier(const XcdBarrier& b, bool leader  ) {
    asm volatile("s_waitcnt vmcnt(0)" ::: "memory");
    SYNCTHREADS();
    if (leader) {
        unsigned* bar = b.bar;
        __builtin_amdgcn_s_waitcnt(0);
        unsigned nloc = b.st[0], nx = b.st[1];
        if (nloc == 0u) { xcd_barrier_complete(bar, b.x, nloc, nx); b.st[0] = nloc; b.st[1] = nx; }
        const unsigned old = xb_add(&bar[XB_XSUB(b.x)], 1u);
        const unsigned gen = old / nloc;
        if (old + 1u == (gen + 1u) * nloc) {
            __builtin_amdgcn_fence(__ATOMIC_RELEASE, "agent");
            asm volatile("s_waitcnt vmcnt(0)" ::: "memory");
            const unsigned og = xb_add(&bar[XB_TOP], 1u);
            const unsigned tg = og / nx;
            if (og + 1u == (tg + 1u) * nx) xb_add(&bar[XB_TOPGEN], 1u);
            else XB_SPIN(xb_ld(&bar[XB_TOPGEN]) == tg, bar);
            __builtin_amdgcn_fence(__ATOMIC_ACQUIRE, "agent");
            xb_add(&bar[XB_XGEN(b.x)], 1u);
            asm volatile("s_waitcnt vmcnt(0)" ::: "memory");
        } else {
            XB_SPIN(xb_ld(&bar[XB_XGEN(b.x)]) == gen, bar);
            __builtin_amdgcn_fence(__ATOMIC_ACQUIRE, "agent");
            asm volatile("s_waitcnt vmcnt(0)" ::: "memory");
        }
    }
    SYNCTHREADS();
}

struct Frame {
    LAS unsigned char* lds;
    int tid, lane, wave, vcu, G;
};
struct Args {
    const float* in[21]; float* out; unsigned char* ws; int pad0, pad1;
};

struct TrItem { const float* src; unsigned char* dst; int ldw, ldk; const float* gk; };
__device__ __forceinline__ void tr_load(const TrItem& t, int lane, float (&tv)[32]) {
    const float* wp_ = t.src + (size_t)(lane >> 5) * t.ldw + (lane & 31);
#pragma unroll
    for (int i = 0; i < 32; ++i) tv[i] = wp_[(size_t)(2 * i) * t.ldw];
}
template <bool FP8>
__device__ __forceinline__ void tr_store(const TrItem& t, const float (&tv)[32], LAS float* scr, int lane) {
#pragma unroll
    for (int i = 0; i < 32; ++i) scr[(2 * i + (lane >> 5)) * 33 + (lane & 31)] = tv[i];
    LDS_WAIT(); asm volatile("" ::: "memory");
    const int c = lane & 7;
#pragma unroll
    for (int j = 0; j < 4; ++j) { const int n = (lane >> 3) + 8 * j; const LAS float* s = scr + (8 * c) * 33 + n;
        if constexpr (FP8) { u32x2 o; o.x = cvt4_fp8(s[0 * 33] * W8_SCALE, s[1 * 33] * W8_SCALE, s[2 * 33] * W8_SCALE, s[3 * 33] * W8_SCALE); o.y = cvt4_fp8(s[4 * 33] * W8_SCALE, s[5 * 33] * W8_SCALE, s[6 * 33] * W8_SCALE, s[7 * 33] * W8_SCALE);
            *(u32x2*)(t.dst + (size_t)n * t.ldk + 8 * c) = o; }
        else { f32x4 ga = {1.f, 1.f, 1.f, 1.f}, gb = ga; if (t.gk) { ga = *(const f32x4*)(t.gk + 8 * c); gb = *(const f32x4*)(t.gk + 8 * c + 4); }
            u32x4 o; o.x = cvt_pk_bf16(s[0 * 33] * ga[0], s[1 * 33] * ga[1]); o.y = cvt_pk_bf16(s[2 * 33] * ga[2], s[3 * 33] * ga[3]); o.z = cvt_pk_bf16(s[4 * 33] * gb[0], s[5 * 33] * gb[1]); o.w = cvt_pk_bf16(s[6 * 33] * gb[2], s[7 * 33] * gb[3]);
            *(u32x4*)(t.dst + ((size_t)n * t.ldk + 8 * c) * 2) = o; } }
    LDS_WAIT(); asm volatile("" ::: "memory");
}
#define TR_PIPELINE(FP8_, DECODE) do { if (gw < nit) { float tv_[32]; TrItem cur_ = DECODE(gw); tr_load(cur_, F.lane, tv_); \
        for (int it = gw; it < nit; it += NGW) { const int itn_ = it + NGW < nit ? it + NGW : it;     \
            float tn_[32]; const TrItem nxt_ = DECODE(itn_); tr_load(nxt_, F.lane, tn_); \
            tr_store<FP8_>(cur_, tv_, scr, F.lane); cur_ = nxt_; \
            _Pragma("unroll") for (int i_ = 0; i_ < 32; ++i_) tv_[i_] = tn_[i_]; } } } while (0)
template <bool FP8 = false>
__device__ __forceinline__ void conv_plain(Frame& F, const float* W, int K, int N, int ldw, bf16_t* WT, int rank = -1, int nrank = 0, const float* gain = nullptr) {
    LAS float* scr = (LAS float*)(F.lds + F.wave * 16384);
    const int gw = (rank < 0 ? F.vcu : rank) * NWAVES + F.wave, NGW = (rank < 0 ? F.G : nrank) * NWAVES, nblk = N / 32, nit = (K / 64) * nblk;
    auto decode = [&](int it) -> TrItem { const int kb = it / nblk, nb = it % nblk;
        return TrItem{W + (size_t)(64 * kb) * ldw + 32 * nb, (unsigned char*)WT + ((size_t)(32 * nb) * K + 64 * kb) * (FP8 ? 1 : 2), ldw, K, gain ? gain + 64 * kb : nullptr}; };
    TR_PIPELINE(FP8, decode);
}
__device__ __forceinline__ void conv_moe(Frame& F, const float* wg, const float* wu, const float* wd, bf16_t* GU, bf16_t* DT, int rank = -1, int nrank = 0, int e0 = 0, int ne = NEXP) {
    LAS float* scr = (LAS float*)(F.lds + F.wave * 16384);
    const int gw = (rank < 0 ? F.vcu : rank) * NWAVES + F.wave, NGW = (rank < 0 ? F.G : nrank) * NWAVES;
    constexpr int PER_E = 1536; const int nit = ne * PER_E;
    auto decode = [&](int it) -> TrItem { const int e = e0 + it / PER_E; int r = it % PER_E;
        if (r < 1024) { const int up = r >> 9; r &= 511; const int kb = r >> 4, nb = r & 15, n0 = 32 * nb;
            const int drow = 256 * (n0 >> 7) + 128 * up + (n0 & 127);
            return TrItem{(up ? wu : wg) + (size_t)e * D * DFF + (size_t)(64 * kb) * DFF + n0, (unsigned char*)GU + (size_t)e * 1024 * D + (size_t)drow * D + 64 * kb, DFF, D, nullptr}; }
        r -= 1024; const int kb = r >> 6, nb = r & 63;
        return TrItem{wd + (size_t)e * DFF * D + (size_t)(64 * kb) * D + 32 * nb, (unsigned char*)DT + (size_t)e * D * DFF + (size_t)(32 * nb) * DFF + 64 * kb, D, DFF, nullptr}; };
    TR_PIPELINE(true, decode);
}
__device__ __forceinline__ void pack_proj(Frame& F, float* Wp, int NT, const float* gain, const float* Wa, int lda, int ca0, int na, const float* Wb, int ldb, int nb) {
    const int total = 128 * NT * 256;
    for (int idx = (F.vcu * NWAVES * 64) + F.tid; idx < total; idx += F.G * NWAVES * 64) {
        const int e = idx & 3, ln = (idx >> 2) & 63, rest = idx >> 8, nt = rest % NT, s = rest / NT;
        const int k = 32 * (s >> 1) + 8 * (ln >> 4) + 4 * (s & 1) + e, col = 16 * nt + (ln & 15);
        float v = 0.f;
        if (col < na) v = Wa[(size_t)k * lda + ca0 + col]; else if (col < na + nb) v = Wb[(size_t)k * ldb + (col - na)];
        Wp[idx] = v * gain[k];
    }
}

__device__ __forceinline__ void pack_proj16(Frame& F, bf16_t* Wp, int NT, const float* gain, const float* Wa, int lda, int ca0, int na, const float* Wb, int ldb, int nb) {
    const int total = 64 * NT * 64 * 8;
    for (int idx = (F.vcu * NWAVES * 64) + F.tid; idx < total; idx += F.G * NWAVES * 64) {
        const int j = idx & 7, ln = (idx >> 3) & 63, rest = idx >> 9, nt = rest % NT, s = rest / NT;
        const int k = 32 * s + 8 * (ln >> 4) + j, col = 16 * nt + (ln & 15);
        float v = 0.f;
        if (col < na) v = Wa[(size_t)k * lda + ca0 + col]; else if (col < na + nb) v = Wb[(size_t)k * ldb + (col - na)];
        v *= gain[k];
        const unsigned hi = cvt_pk_bf16(v, 0.f) & 0xffffu; const float rem = v - __uint_as_float(hi << 16); const unsigned lo = cvt_pk_bf16(rem, 0.f) & 0xffffu;
        const size_t base = ((size_t)((s * NT + nt) * 2) * 64 + ln) * 8 + j;
        Wp[base] = (bf16_t)hi; Wp[base + 64 * 8] = (bf16_t)lo;
    }
}
template <int NT>
__device__ __forceinline__ float wave_proj16b(LAS unsigned char* lds, const bf16_t* xin, int tok0, const bf16_t* Wp, int tid, int wid, int lane, f32x4 (&acc)[NT]) {
    static_assert(NT == 3, "chunk = 24 KiB = 3 DMA instructions per thread");
    const int tr = lane & 15, kq = lane >> 4;
    const u32x4* xp = (const u32x4*)(xin + (size_t)(tok0 + tr) * D) + kq;
    constexpr int CH = 4 * NT * 2 * 1024;
    const char* wsrc = (const char*)Wp + tid * 16;
    float ssq = 0.f;
#pragma unroll
    for (int n = 0; n < NT; ++n) acc[n] = (f32x4){0.f, 0.f, 0.f, 0.f};
    u32x4 X[4];
#define NB_DMA(c, buf) do { _Pragma("unroll") for (int r = 0; r < 3; ++r) \
        __builtin_amdgcn_global_load_lds((const unsigned*)(wsrc + (size_t)(c) * CH + r * 8192), (LAS unsigned*)(lds + (buf) * CH + r * 8192 + wid * 1024), 16, 0, 0); } while (0)
#define NB_CHUNK(c, buf, more) do { \
        asm volatile("s_waitcnt vmcnt(4)" ::: "memory"); WG_BAR(); \
        if (more) NB_DMA((c) + 1, 1 - (buf)); \
        asm volatile("" ::: "memory"); \
        const u32x4* xn_ = xp + 16 * ((c) + 1); \
        _Pragma("unroll") for (int s = 0; s < 4; ++s) { const u32x4 xw = X[s]; if (more) X[s] = xn_[4 * s]; \
            _Pragma("unroll") for (int q = 0; q < 4; ++q) { const float a_ = bf_lo(xw[q]), b_ = bf_hi(xw[q]); ssq += a_ * a_ + b_ * b_; } \
            const bf16x8 xa = __builtin_bit_cast(bf16x8, xw); \
            _Pragma("unroll") for (int n = 0; n < NT; ++n) _Pragma("unroll") for (int pc = 0; pc < 2; ++pc) { \
                const bf16x8 wv = *(const LAS bf16x8*)(lds + (buf) * CH + (((s * NT + n) * 2 + pc) * 64 + lane) * 16); \
                acc[n] = __builtin_amdgcn_mfma_f32_16x16x32_bf16(xa, wv, acc[n], 0, 0, 0); } } } while (0)
    NB_DMA(0, 0);
    asm volatile("" ::: "memory");
#pragma unroll
    for (int s = 0; s < 4; ++s) X[s] = xp[4 * s];
    for (int c = 0; c < 14; c += 2) { NB_CHUNK(c, 0, true); NB_CHUNK(c + 1, 1, true); }
    NB_CHUNK(14, 0, true); NB_CHUNK(15, 1, false);
    WG_BAR();
#undef NB_DMA
#undef NB_CHUNK
    ssq += __shfl_xor(ssq, 16); ssq += __shfl_xor(ssq, 32);
    return 1.0f / sqrtf(ssq * (1.0f / D) + RMS_EPS);
}
template <int NT, bool XB16 = false>
__device__ __forceinline__ float wave_proj16(LAS unsigned char* lds, const void* xin, int tok0, const float* Wp, int tid, int wid, int lane, f32x4 (&acc)[NT], bf16_t* xb16) {
    typedef typename XRow<XB16>::T XT;
    const int tr = lane & 15, kq = lane >> 4;
    const XT* xp = (const XT*)xin + (size_t)(tok0 + tr) * (D / 4) + 2 * kq;
    u32x4* hb = (u32x4*)(xb16 + (size_t)(tok0 + tr) * D) + kq;
    constexpr int CH = 16 * NT * 1024;
    const char* wsrc = (const char*)Wp + tid * 16;
    float ssq = 0.f;
#pragma unroll
    for (int n = 0; n < NT; ++n) acc[n] = (f32x4){0.f, 0.f, 0.f, 0.f};
    XT X[16];
#define NP_DMA(c, buf) do { _Pragma("unroll") for (int r = 0; r < 2 * NT; ++r) \
        __builtin_amdgcn_global_load_lds((const unsigned*)(wsrc + (size_t)(c) * CH + r * 8192), (LAS unsigned*)(lds + (buf) * CH + r * 8192 + wid * 1024), 16, 0, 0); } while (0)
#define NP_CHUNK(c, buf, more) do { \
        asm volatile("s_waitcnt vmcnt(16)" ::: "memory"); WG_BAR(); \
        if (more) NP_DMA((c) + 1, 1 - (buf)); \
        asm volatile("" ::: "memory");     \
        const XT* xn_ = xp + 64 * ((c) + 1); \
        _Pragma("unroll") for (int s = 0; s < 16; ++s) { const f32x4 xv = XRow<XB16>::get(X[s]); \
            if (s & 1) { const f32x4 xl_ = XRow<XB16>::get(X[s - 1]); u32x4 w_; w_.x = cvt_pk_bf16(xl_[0], xl_[1]); w_.y = cvt_pk_bf16(xl_[2], xl_[3]); w_.z = cvt_pk_bf16(xv[0], xv[1]); w_.w = cvt_pk_bf16(xv[2], xv[3]); \
                hb[32 * (c) + 4 * (s >> 1)] = w_; if (more) { X[s - 1] = xn_[8 * (s >> 1)]; X[s] = xn_[8 * (s >> 1) + 1]; } } \
            ssq += (xv[0] * xv[0] + xv[1] * xv[1]) + (xv[2] * xv[2] + xv[3] * xv[3]); \
            _Pragma("unroll") for (int n = 0; n < NT; ++n) { const f32x4 wv = *(const LAS f32x4*)(lds + (buf) * CH + ((s * NT + n) * 64 + lane) * 16); \
                _Pragma("unroll") for (int e = 0; e < 4; ++e) acc[n] = __builtin_amdgcn_mfma_f32_16x16x4f32(xv[e], wv[e], acc[n], 0, 0, 0); } } } while (0)
    NP_DMA(0, 0);
    asm volatile("" ::: "memory");
#pragma unroll
    for (int s = 0; s < 16; ++s) X[s] = xp[8 * (s >> 1) + (s & 1)];
    for (int c = 0; c < 6; c += 2) { NP_CHUNK(c, 0, true); NP_CHUNK(c + 1, 1, true); }
    NP_CHUNK(6, 0, true); NP_CHUNK(7, 1, false);
    WG_BAR();
#undef NP_DMA
#undef NP_CHUNK
    ssq += __shfl_xor(ssq, 16); ssq += __shfl_xor(ssq, 32);
    return 1.0f / sqrtf(ssq * (1.0f / D) + RMS_EPS);
}
template <bool FP8 = false, bool XB16 = false>
__device__ __forceinline__ void wave_write_hn16(const void* xin, int tok0, float rstd, const float* gain, bf16_t* hn, int lane) {
    typedef typename XRow<XB16>::T XT;
    f32x4 g4[8];
#pragma unroll
    for (int j = 0; j < 8; ++j) g4[j] = ((const f32x4*)gain)[lane + 64 * j];
    for (int i = 0; i < 16; i += 2) {
        const float r0 = __shfl(rstd, i), r1 = __shfl(rstd, i + 1);
        const XT* x0 = (const XT*)xin + (size_t)(tok0 + i) * (D / 4); const XT* x1 = x0 + D / 4;
        u32x2* o0 = (u32x2*)(hn + (size_t)(tok0 + i) * D); u32x2* o1 = o0 + D / 4;
        unsigned* p0 = (unsigned*)((unsigned char*)hn + (size_t)(tok0 + i) * D); unsigned* p1 = p0 + D / 4;
        XT a[8], c[8];
#pragma unroll
        for (int j = 0; j < 8; ++j) { a[j] = x0[lane + 64 * j]; c[j] = x1[lane + 64 * j]; }
#pragma unroll
        for (int j = 0; j < 8; ++j) { const f32x4 v = XRow<XB16>::get(a[j]) * r0 * g4[j], u = XRow<XB16>::get(c[j]) * r1 * g4[j];
            if constexpr (FP8) { p0[lane + 64 * j] = cvt4_fp8(v[0], v[1], v[2], v[3]); p1[lane + 64 * j] = cvt4_fp8(u[0], u[1], u[2], u[3]); }
            else { u32x2 w; w.x = cvt_pk_bf16(v[0], v[1]); w.y = cvt_pk_bf16(v[2], v[3]); o0[lane + 64 * j] = w;
                u32x2 z; z.x = cvt_pk_bf16(u[0], u[1]); z.y = cvt_pk_bf16(u[2], u[3]); o1[lane + 64 * j] = z; } }
    }
}

__device__ __forceinline__ void phase_norm_gz(Frame& F, const float* xin, const float* Wp, bf16_t* hn, float* gz, float* rstd_tab) {
    for (int tile = F.vcu; tile < T / 128; tile += F.G) {
        const int tok0 = tile * 128 + F.wave * 16;
        f32x4 acc[1];
        const float rstd = wave_proj16<1>(F.lds, xin, tok0, Wp, F.tid, F.wave, F.lane, acc, hn);
        if (F.lane < 16) rstd_tab[tok0 + F.lane] = rstd;
        const int j = F.lane & 15, q4 = F.lane >> 4;
#pragma unroll
        for (int r = 0; r < 4; ++r) { const float rr = __shfl(rstd, 4 * q4 + r); gz[(size_t)(tok0 + 4 * q4 + r) * 16 + j] = acc[0][r] * rr; }
    }
}
__device__ __forceinline__ void phase_norm_route(Frame& F, const bf16_t* xin, const float* gain, const float* Wp, bf16_t* hn, int* tok_e, int* tok_p, float* tok_w, unsigned* cnt) {
    LAS float* lg = (LAS float*)(F.lds + 98304 + F.wave * 3072);
    for (int tile = F.vcu; tile < T / 128; tile += F.G) {
        const int tok0 = tile * 128 + F.wave * 16;
        f32x4 acc[3];
        const float rstd = wave_proj16b<3>(F.lds, xin, tok0, (const bf16_t*)Wp, F.tid, F.wave, F.lane, acc);
        const int j = F.lane & 15, q4 = F.lane >> 4;
#pragma unroll
        for (int r = 0; r < 4; ++r) { const float rr = __shfl(rstd, 4 * q4 + r);
#pragma unroll
            for (int n = 0; n < 3; ++n) lg[(4 * q4 + r) * 48 + 16 * n + j] = acc[n][r] * rr; }
        LDS_WAIT(); asm volatile("" ::: "memory");
        if (F.lane < 16) {
            const LAS float* l = lg + F.lane * 48;
            float gm = l[0]; int gi = 0;
#pragma unroll
            for (int q = 1; q < 4; ++q) { const float v = l[q]; if (v > gm) { gm = v; gi = q; } }
            float gs = 0.f;
#pragma unroll
            for (int q = 0; q < 4; ++q) gs += __expf(l[q] - gm);
            const float gw = 1.0f / gs;
            const LAS float* se = l + 4 + 8 * gi;
            float m1 = se[0]; int i1 = 0;
#pragma unroll
            for (int q = 1; q < 8; ++q) { const float v = se[q]; if (v > m1) { m1 = v; i1 = q; } }
            float m2 = -3.0e38f; int i2 = 0;
#pragma unroll
            for (int q = 0; q < 8; ++q) { const float v = se[q]; if (q != i1 && v > m2) { m2 = v; i2 = q; } }
            const float eb = __expf(m2 - m1), inv = 1.0f / (1.0f + eb);
            const int t = tok0 + F.lane, e1 = gi * 8 + i1, e2 = gi * 8 + i2;
            const unsigned p1 = __hip_atomic_fetch_add(cnt + 64 * e1, 1u, __ATOMIC_RELAXED, __HIP_MEMORY_SCOPE_AGENT);
            const unsigned p2 = __hip_atomic_fetch_add(cnt + 64 * e2, 1u, __ATOMIC_RELAXED, __HIP_MEMORY_SCOPE_AGENT);
            tok_e[2 * t] = e1; tok_e[2 * t + 1] = e2; tok_p[2 * t] = (int)p1; tok_p[2 * t + 1] = (int)p2;
            tok_w[2 * t] = gw * inv; tok_w[2 * t + 1] = gw * eb * inv;
        }
        wave_write_hn16<true, true>(xin, tok0, rstd, gain, hn, F.lane);
        LDS_WAIT(); asm volatile("" ::: "memory");
    }
}

__device__ __forceinline__ void phase_gla_gate(Frame& F, const float* gz, const float* wgu, const float* bgate, const bf16_t* proj, bf16_t* kdT, float* adec) {
    LAS f32x4* gzs = (LAS f32x4*)F.lds;
    for (int u = F.vcu; u < NBATCH * NCH * 2; u += F.G) {
        const int half = u & 1, bc = u >> 1;
        const int tok0 = bc * 64, j = half * 512 + F.tid;
        if (F.tid < 256) gzs[F.tid] = ((const f32x4*)(gz + (size_t)tok0 * 16))[F.tid];
        float wg[16];
#pragma unroll
        for (int r = 0; r < 16; ++r) wg[r] = wgu[r * GLA_DKT + j];
        const float bg = bgate[j];
        WG_BAR();
        float cum[64]; float run = 0.f;
#pragma unroll
        for (int t = 0; t < 64; ++t) {
            float z = bg;
#pragma unroll
            for (int r4 = 0; r4 < 4; ++r4) { const f32x4 g4 = gzs[t * 4 + r4]; z += g4[0] * wg[4 * r4] + g4[1] * wg[4 * r4 + 1] + g4[2] * wg[4 * r4 + 2] + g4[3] * wg[4 * r4 + 3]; }
            const float ls = fminf(z, 0.f) - __logf(1.0f + __expf(-fabsf(z)));
            run += ls * (1.0f / 16.0f); cum[t] = run;
        }
        adec[(size_t)bc * GLA_DKT + j] = __expf(run);
        const bf16_t* kp = proj + GK0 + gq_off(bc >> 8, (bc & 255) * 64, j >> 8) + (j & 255);
        u32x4* dst = (u32x4*)(kdT + ((size_t)bc * GLA_DKT + j) * 64);
#pragma unroll
        for (int t8 = 0; t8 < 8; ++t8) {
            float kd[8];
#pragma unroll
            for (int q = 0; q < 8; ++q) { const int t = t8 * 8 + q; kd[q] = bf2f(kp[(size_t)t * 256]) * __expf(run - cum[t]); }
            u32x4 w; w.x = cvt_pk_bf16(kd[0], kd[1]); w.y = cvt_pk_bf16(kd[2], kd[3]); w.z = cvt_pk_bf16(kd[4], kd[5]); w.w = cvt_pk_bf16(kd[6], kd[7]);
            dst[t8] = w;
        }
        WG_BAR();
    }
}

constexpr int SCAN_VROW = 144, SCAN_SROW = 528, SCAN_VBUF = 64 * SCAN_VROW, SCAN_SBUF = 64 * SCAN_SROW;
__device__ __forceinline__ void phase_gla_scan(Frame& F, int it, const bf16_t* proj, const bf16_t* kdT, const float* adec, bf16_t* oout, bf16_t* sfin) {
    const int lane = F.lane, w = F.wave, fr = lane & 15, kq = lane >> 4, tid = F.tid;
    LAS unsigned char* vbuf = F.lds;
    LAS unsigned char* sbuf = F.lds + 2 * SCAN_VBUF;
    const int bh = it >> 4, seg = (it >> 3) & 1, b = bh >> 2, h = bh & 3, sl = it & 7, mt = w & 3, ntp = w >> 2, c0 = seg * (NCH / 2);
    const size_t tokb = (size_t)b * SEQ;
    f32x4 st[2][4];
#pragma unroll
    for (int i = 0; i < 2; ++i)
#pragma unroll
        for (int n = 0; n < 4; ++n) st[i][n] = (f32x4){0.f, 0.f, 0.f, 0.f};
    bf16x8 ka0[2][2], ka1[2][2], q0[8], q1[8]; f32x4 dc0[2], dc1[2]; u32x4 vr0, vr1;
#define CL(c) ((c) < NCH ? (c) : NCH - 1)
#define LOAD_KA(KA, DC, c) do { const size_t bc_ = (size_t)b * NCH + CL(c); \
        _Pragma("unroll") for (int i = 0; i < 2; ++i) { \
            _Pragma("unroll") for (int s = 0; s < 2; ++s) KA[i][s] = *(const bf16x8*)(kdT + ((bc_ * GLA_DKT + h * 256 + 32 * w + 16 * i + fr) * 64 + 32 * s + 8 * kq)); \
            DC[i] = *(const f32x4*)(adec + bc_ * GLA_DKT + h * 256 + 32 * w + 16 * i + 4 * kq); } } while (0)
#define LOAD_V(VR, c) do { VR = *(const u32x4*)(proj + gv_off(b, CL(c) * 64 + (tid >> 3), h) + 64 * sl + 8 * (tid & 7)); } while (0)
#define LOAD_Q(Q, c) do { const bf16_t* qp_ = proj + gq_off(b, CL(c) * 64 + 16 * mt + fr, h) + 8 * kq; \
        _Pragma("unroll") for (int s = 0; s < 8; ++s) Q[s] = *(const bf16x8*)(qp_ + 32 * s); } while (0)
#define STORE_V(VR, buf) do { *(LAS u32x4*)(vbuf + (buf) * SCAN_VBUF + (tid >> 3) * SCAN_VROW + (tid & 7) * 16) = VR; } while (0)
#define SCAN_STEP(KA, DC, VN, VM, QC, QN, c) do { \
        const unsigned vb_ = (unsigned)(uintptr_t)(vbuf + ((c) & 1) * SCAN_VBUF) + (unsigned)((8 * kq + ((lane & 15) >> 2)) * SCAN_VROW + 8 * (lane & 3)); \
        s16x4 tv[4][4];     \
        asm volatile("ds_read_b64_tr_b16 %0, %16 offset:0\n\tds_read_b64_tr_b16 %1, %16 offset:576\n\tds_read_b64_tr_b16 %2, %16 offset:4608\n\tds_read_b64_tr_b16 %3, %16 offset:5184\n\t" \
                     "ds_read_b64_tr_b16 %4, %16 offset:32\n\tds_read_b64_tr_b16 %5, %16 offset:608\n\tds_read_b64_tr_b16 %6, %16 offset:4640\n\tds_read_b64_tr_b16 %7, %16 offset:5216\n\t" \
                     "ds_read_b64_tr_b16 %8, %16 offset:64\n\tds_read_b64_tr_b16 %9, %16 offset:640\n\tds_read_b64_tr_b16 %10, %16 offset:4672\n\tds_read_b64_tr_b16 %11, %16 offset:5248\n\t" \
                     "ds_read_b64_tr_b16 %12, %16 offset:96\n\tds_read_b64_tr_b16 %13, %16 offset:672\n\tds_read_b64_tr_b16 %14, %16 offset:4704\n\tds_read_b64_tr_b16 %15, %16 offset:5280\n\ts_waitcnt lgkmcnt(0)" \
                     : "=&v"(tv[0][0]), "=&v"(tv[0][1]), "=&v"(tv[0][2]), "=&v"(tv[0][3]), "=&v"(tv[1][0]), "=&v"(tv[1][1]), "=&v"(tv[1][2]), "=&v"(tv[1][3]), \
                       "=&v"(tv[2][0]), "=&v"(tv[2][1]), "=&v"(tv[2][2]), "=&v"(tv[2][3]), "=&v"(tv[3][0]), "=&v"(tv[3][1]), "=&v"(tv[3][2]), "=&v"(tv[3][3]) : "v"(vb_) : "memory"); \
        _Pragma("unroll") for (int n = 0; n < 4; ++n) { \
            const bf16x8 vf0 = (bf16x8){tv[n][0][0], tv[n][0][1], tv[n][0][2], tv[n][0][3], tv[n][1][0], tv[n][1][1], tv[n][1][2], tv[n][1][3]}; \
            const bf16x8 vf1 = (bf16x8){tv[n][2][0], tv[n][2][1], tv[n][2][2], tv[n][2][3], tv[n][3][0], tv[n][3][1], tv[n][3][2], tv[n][3][3]}; \
            _Pragma("unroll") for (int i = 0; i < 2; ++i) { \
                st[i][n] = st[i][n] * DC[i]; \
                st[i][n] = __builtin_amdgcn_mfma_f32_16x16x32_bf16(KA[i][0], vf0, st[i][n], 0, 0, 0); \
                st[i][n] = __builtin_amdgcn_mfma_f32_16x16x32_bf16(KA[i][1], vf1, st[i][n], 0, 0, 0); } } \
        LOAD_KA(KA, DC, (c) + 2); \
        { LAS unsigned char* sb_ = sbuf + ((c) & 1) * SCAN_SBUF + fr * SCAN_SROW + (32 * w + 4 * kq) * 2; \
          _Pragma("unroll") for (int i = 0; i < 2; ++i) _Pragma("unroll") for (int n = 0; n < 4; ++n) { \
              u32x2 pk; pk.x = cvt_pk_bf16(st[i][n][0], st[i][n][1]); pk.y = cvt_pk_bf16(st[i][n][2], st[i][n][3]); \
              *(LAS u32x2*)(sb_ + n * 16 * SCAN_SROW + i * 32) = pk; } } \
        STORE_V(VN, ((c) + 1) & 1); \
        LOAD_V(VN, (c) + 3); \
        WG_BAR(); \
        { f32x4 a0 = (f32x4){0.f, 0.f, 0.f, 0.f}, a1 = a0; \
          const LAS unsigned char* sr_ = sbuf + ((c) & 1) * SCAN_SBUF + (32 * ntp + fr) * SCAN_SROW + 16 * kq; \
          _Pragma("unroll") for (int hb = 0; hb < 2; ++hb) { bf16x8 bb[4][2];     \
              _Pragma("unroll") for (int s = 0; s < 4; ++s) { bb[s][0] = *(const LAS bf16x8*)(sr_ + 64 * (4 * hb + s)); bb[s][1] = *(const LAS bf16x8*)(sr_ + 16 * SCAN_SROW + 64 * (4 * hb + s)); } \
              asm volatile("s_waitcnt lgkmcnt(0)" ::: "memory"); __builtin_amdgcn_sched_barrier(0); \
              _Pragma("unroll") for (int s = 0; s < 4; ++s) { \
                  a0 = __builtin_amdgcn_mfma_f32_16x16x32_bf16(QC[4 * hb + s], bb[s][0], a0, 0, 0, 0); \
                  a1 = __builtin_amdgcn_mfma_f32_16x16x32_bf16(QC[4 * hb + s], bb[s][1], a1, 0, 0, 0); } } \
          bf16_t* op_ = oout + (tokb + (size_t)(c) * 64 + 16 * mt + 4 * kq) * D + h * 512 + 64 * sl + 32 * ntp + fr; \
          _Pragma("unroll") for (int r = 0; r < 4; ++r) { \
              const float x0 = a0[r] * 0.0625f, x1 = a1[r] * 0.0625f, y0 = __shfl_xor(x0, 1), y1 = __shfl_xor(x1, 1); \
              if ((fr & 1) == 0) { *(unsigned*)(op_ + (size_t)r * D) = cvt_pk_bf16(x0, y0); *(unsigned*)(op_ + (size_t)r * D + 16) = cvt_pk_bf16(x1, y1); } } } \
        LOAD_Q(QC, (c) + 2); \
    } while (0)
    LOAD_KA(ka0, dc0, c0); LOAD_KA(ka1, dc1, c0 + 1); LOAD_V(vr0, c0); LOAD_V(vr1, c0 + 1); LOAD_Q(q0, c0); LOAD_Q(q1, c0 + 1);
    STORE_V(vr0, 0); LOAD_V(vr0, c0 + 2);
    WG_BAR();
    for (int c = c0; c < c0 + NCH / 2; c += 2) {
        SCAN_STEP(ka0, dc0, vr1, vr0, q0, q1, c);
        SCAN_STEP(ka1, dc1, vr0, vr1, q1, q0, c + 1);
    }
    if (seg == 0) {
#pragma unroll
        for (int i = 0; i < 2; ++i)
#pragma unroll
            for (int n = 0; n < 4; ++n) { u32x2 pk; pk.x = cvt_pk_bf16(st[i][n][0], st[i][n][1]); pk.y = cvt_pk_bf16(st[i][n][2], st[i][n][3]);
                *(u32x2*)(sfin + ((size_t)(bh * 512 + 64 * sl + 16 * n + fr)) * 256 + 32 * w + 16 * i + 4 * kq) = pk; }
    }
    WG_BAR();
#undef CL
#undef LOAD_KA
#undef LOAD_V
#undef LOAD_Q
#undef STORE_V
#undef SCAN_STEP
}

__device__ __forceinline__ void gla_pcum(Frame& F, const float* adec, float* pcum, int rank, int nrank) {
    for (int idx = rank * (NWAVES * 64) + F.tid; idx < NBATCH * GLA_DKT; idx += nrank * NWAVES * 64) { const int b = idx >> 10, j = idx & 1023;
        const float* ap = adec + ((size_t)(b * NCH + NCH / 2)) * GLA_DKT + j; float* pp = pcum + (size_t)(b * (NCH / 2)) * GLA_DKT + j; float pr = 1.f;
#pragma unroll 16
        for (int cc = 0; cc < NCH / 2; ++cc) { pr *= ap[(size_t)cc * GLA_DKT]; pp[(size_t)cc * GLA_DKT] = pr; } }
}
__device__ __forceinline__ void phase_gla_qp(Frame& F, const bf16_t* proj, const float* pcum, bf16_t* qp) {
    const int gw = F.vcu * NWAVES + F.wave, NGW = F.G * NWAVES, lane = F.lane;
    for (int r = gw; r < NBATCH * (SEQ / 2); r += NGW) { const int b = r >> 13, t = r & 8191;
        u32x2 qv[4]; f32x4 pv[4];
#pragma unroll
        for (int h = 0; h < 4; ++h) { qv[h] = *(const u32x2*)(proj + gq_off(b, SEQ / 2 + t, h) + 4 * lane); pv[h] = *(const f32x4*)(pcum + ((size_t)(b * (NCH / 2) + (t >> 6)) * GLA_DKT + h * 256 + 4 * lane)); }
#pragma unroll
        for (int h = 0; h < 4; ++h) { u32x2 w; w.x = cvt_pk_bf16(bf_lo(qv[h].x) * pv[h][0], bf_hi(qv[h].x) * pv[h][1]); w.y = cvt_pk_bf16(bf_lo(qv[h].y) * pv[h][2], bf_hi(qv[h].y) * pv[h][3]);
            *(u32x2*)(qp + ((size_t)((b * 4 + h) * (SEQ / 2) + t)) * 256 + 4 * lane) = w; }
    }
}
__device__ __forceinline__ void phase_gla_gnorm(Frame& F, const bf16_t* o, const bf16_t* proj, const float* gn, bf16_t* y) {
    const int gw = F.vcu * NWAVES + F.wave, NGW = F.G * NWAVES, lane = F.lane;
    const f32x4 g0 = ((const f32x4*)gn)[2 * lane], g1 = ((const f32x4*)gn)[2 * lane + 1];
    for (int tok = gw; tok < T; tok += NGW) {
        u32x4 ov[4], rv[4];
#pragma unroll
        for (int h = 0; h < 4; ++h) { ov[h] = *(const u32x4*)(o + (size_t)tok * D + h * 512 + 8 * lane); rv[h] = *(const u32x4*)(proj + GR0 + (size_t)tok * 2048 + h * 512 + 8 * lane); }
        float ss[4];
#pragma unroll
        for (int h = 0; h < 4; ++h) { float s = 0.f;
#pragma unroll
            for (int q = 0; q < 4; ++q) { const float lo = bf_lo(ov[h][q]), hi = bf_hi(ov[h][q]); s += lo * lo + hi * hi; }
            ss[h] = s; }
#pragma unroll
        for (int of = 1; of < 64; of <<= 1) {
#pragma unroll
            for (int h = 0; h < 4; ++h) ss[h] += __shfl_xor(ss[h], of); }
#pragma unroll
        for (int h = 0; h < 4; ++h) { const float rstd = 1.0f / sqrtf(ss[h] * (1.0f / 512.0f) + RMS_EPS);
            float yv[8];
#pragma unroll
            for (int q = 0; q < 4; ++q) { const float a0 = bf_lo(ov[h][q]), a1 = bf_hi(ov[h][q]), r0 = bf_lo(rv[h][q]), r1 = bf_hi(rv[h][q]);
                const float gA = q < 2 ? g0[2 * q] : g1[2 * q - 4], gB = q < 2 ? g0[2 * q + 1] : g1[2 * q - 3];
                yv[2 * q] = a0 * rstd * gA * (r0 / (1.0f + __expf(-r0))); yv[2 * q + 1] = a1 * rstd * gB * (r1 / (1.0f + __expf(-r1))); }
            u32x4 w; w.x = cvt_pk_bf16(yv[0], yv[1]); w.y = cvt_pk_bf16(yv[2], yv[3]); w.z = cvt_pk_bf16(yv[4], yv[5]); w.w = cvt_pk_bf16(yv[6], yv[7]);
            *(u32x4*)(y + (size_t)tok * D + h * 512 + 8 * lane) = w; }
    }
}

__device__ __forceinline__ void moe_tables(Frame& F, unsigned* cnt) {
    LAS int* pst = (LAS int*)(F.lds + TAB_OFF);
    LAS int* te = pst + 36;
    if (F.wave == 0) {
        const int e = F.lane & 31;
        const int c = (int)xb_ld(cnt + 64 * e);
        const int ntile = (c + 255) >> 8;
        int incl = ntile;
#pragma unroll
        for (int o = 1; o < 32; o <<= 1) { const int v = __shfl_up(incl, o); if ((F.lane & 31) >= o) incl += v; }
        const int excl = incl - ntile;
        if (F.lane < 32) { pst[e] = excl << 8; for (int q = 0; q < ntile; ++q) te[excl + q] = e; }
        if (F.lane == 31) { pst[32] = incl << 8; pst[33] = incl; }
    }
    WG_BAR();
}
__device__ __forceinline__ void phase_moe_slots(Frame& F, const int* tok_e, const int* tok_p, unsigned* cnt, int* slot_of, int* slot_tok) {
    const LAS int* pst = (const LAS int*)(F.lds + TAB_OFF);
    for (int e = F.vcu; e < NEXP; e += F.G) { const int c = (int)xb_ld(cnt + 64 * e), lo = pst[e] + c, hi = pst[e] + (((c + 255) >> 8) << 8);
        for (int s = lo + F.tid; s < hi; s += NWAVES * 64) slot_tok[s] = -1; }
    for (int a = F.vcu * NWAVES * 64 + F.tid; a < 2 * T; a += F.G * NWAVES * 64) { const int slot = pst[tok_e[a]] + tok_p[a]; slot_of[a] = slot; slot_tok[slot] = a >> 1; }
}
__device__ __forceinline__ void phase_moe_copy8(Frame& F, const int* tok_e, const int* tok_p, const unsigned char* hn8, unsigned char* ag8) {
    const LAS int* pst = (const LAS int*)(F.lds + TAB_OFF);
    const int gw = F.vcu * NWAVES + F.wave, NGW = F.G * NWAVES, lane = F.lane;
    for (int t = gw; t < T; t += NGW) {
        const int s0 = pst[tok_e[2 * t]] + tok_p[2 * t], s1 = pst[tok_e[2 * t + 1]] + tok_p[2 * t + 1];
        const u32x4* src = (const u32x4*)(hn8 + (size_t)t * D); const u32x4 v0 = src[lane], v1 = src[lane + 64];
        u32x4* d0 = (u32x4*)(ag8 + (size_t)s0 * D); u32x4* d1 = (u32x4*)(ag8 + (size_t)s1 * D);
        d0[lane] = v0; d0[lane + 64] = v1; d1[lane] = v0; d1[lane + 64] = v1;
    }
}
template <int MODE>
__device__ __forceinline__ void phase_moe_combine(Frame& F, bf16_t* x, float* out, const bf16_t* ob, const int* slot_of, const float* tok_w, const float* gain, bf16_t* hn) {
    const int gw = F.vcu * NWAVES + F.wave, NGW = F.G * NWAVES, lane = F.lane;
    f32x4 g4[8];
#pragma unroll
    for (int j = 0; j < 8; ++j) g4[j] = ((const f32x4*)gain)[lane + 64 * j];
    for (int t = gw; t < T; t += NGW) {
        const int s0 = slot_of[2 * t], s1 = slot_of[2 * t + 1]; const float w0 = tok_w[2 * t] * 0.125f, w1 = tok_w[2 * t + 1] * 0.125f;
        u32x2* xr = (u32x2*)(x + (size_t)t * D);
        const unsigned* a = (const unsigned*)((const unsigned char*)ob + (size_t)s0 * D); const unsigned* b = (const unsigned*)((const unsigned char*)ob + (size_t)s1 * D);
        f32x4 v[8]; float ss = 0.f;
#pragma unroll
        for (int j = 0; j < 8; ++j) { const int av = (int)a[lane + 64 * j], bv = (int)b[lane + 64 * j]; f32x4 xv = bf4_expand(xr[lane + 64 * j]);
            xv[0] += w0 * __builtin_amdgcn_cvt_f32_fp8(av, 0) + w1 * __builtin_amdgcn_cvt_f32_fp8(bv, 0); xv[1] += w0 * __builtin_amdgcn_cvt_f32_fp8(av, 1) + w1 * __builtin_amdgcn_cvt_f32_fp8(bv, 1);
            xv[2] += w0 * __builtin_amdgcn_cvt_f32_fp8(av, 2) + w1 * __builtin_amdgcn_cvt_f32_fp8(bv, 2); xv[3] += w0 * __builtin_amdgcn_cvt_f32_fp8(av, 3) + w1 * __builtin_amdgcn_cvt_f32_fp8(bv, 3);
            v[j] = xv; ss += (xv[0] * xv[0] + xv[1] * xv[1]) + (xv[2] * xv[2] + xv[3] * xv[3]); }
        const float rstd = 1.0f / sqrtf(wave_sum(ss) * (1.0f / D) + RMS_EPS);
        if (MODE == 0) {
            unsigned* orow = (unsigned*)((unsigned char*)hn + (size_t)t * D);
#pragma unroll
            for (int j = 0; j < 8; ++j) { u32x2 w; w.x = cvt_pk_bf16(v[j][0], v[j][1]); w.y = cvt_pk_bf16(v[j][2], v[j][3]); xr[lane + 64 * j] = w;
                const f32x4 y = v[j] * rstd * g4[j]; orow[lane + 64 * j] = cvt4_fp8(y[0], y[1], y[2], y[3]); }
        } else {
            f32x4* orow = (f32x4*)(out + (size_t)t * D);
#pragma unroll
            for (int j = 0; j < 8; ++j) orow[lane + 64 * j] = v[j] * rstd * g4[j];
        }
    }
}

__device__ __forceinline__ void phase_subln(Frame& F, const bf16_t* o1, const bf16_t* o2, const float* lq1, const float* lk1, const float* lq2, const float* lk2, const float* sg, bf16_t* y) {
    const int gw = F.vcu * NWAVES + F.wave, NGW = F.G * NWAVES, lane = F.lane;
    const float d1 = wave_sum(lq1[lane] * lk1[lane] + lq1[lane + 64] * lk1[lane + 64]);
    const float d2 = wave_sum(lq2[lane] * lk2[lane] + lq2[lane + 64] * lk2[lane + 64]);
    const float lam = __expf(d1) - __expf(d2) + LAMBDA_INIT;
    const f32x4 g = ((const f32x4*)sg)[lane] * (1.0f - LAMBDA_INIT);
    for (int tok = gw; tok < T; tok += NGW) {
        u32x2 a[8], b[8];
#pragma unroll
        for (int h = 0; h < 8; ++h) { a[h] = *(const u32x2*)(o1 + (size_t)tok * D + h * 256 + 4 * lane); b[h] = *(const u32x2*)(o2 + (size_t)tok * D + h * 256 + 4 * lane); }
        f32x4 d[8]; float ss[8];
#pragma unroll
        for (int h = 0; h < 8; ++h) { d[h][0] = bf_lo(a[h].x) - lam * bf_lo(b[h].x); d[h][1] = bf_hi(a[h].x) - lam * bf_hi(b[h].x); d[h][2] = bf_lo(a[h].y) - lam * bf_lo(b[h].y); d[h][3] = bf_hi(a[h].y) - lam * bf_hi(b[h].y);
            ss[h] = (d[h][0] * d[h][0] + d[h][1] * d[h][1]) + (d[h][2] * d[h][2] + d[h][3] * d[h][3]); }
#pragma unroll
        for (int of = 1; of < 64; of <<= 1) {
#pragma unroll
            for (int h = 0; h < 8; ++h) ss[h] += __shfl_xor(ss[h], of); }
#pragma unroll
        for (int h = 0; h < 8; ++h) { const float rstd = 1.0f / sqrtf(ss[h] * (1.0f / 256.0f) + RMS_EPS); const f32x4 yv = d[h] * rstd * g;
            *(unsigned*)((unsigned char*)y + (size_t)tok * D + h * 256 + 4 * lane) = cvt4_fp8(yv[0], yv[1], yv[2], yv[3]); }
    }
}

namespace att {
constexpr int SHM_K = 64 * 128, SHM_V = 256 * 64;
constexpr int NSLOT = 5, V_OFF = 0, K_OFF = NSLOT * SHM_V, SCR_OFF = RING_BYTES + 4096;
static_assert(K_OFF + NSLOT * SHM_K <= RING_BYTES, "attention slots");
constexpr float SCALE = 0.08838834764831845f;
constexpr float C2 = 1.4426950408889634f * SCALE;
constexpr float THR = 40.f;
__device__ __forceinline__ int crow(int r, int hi) { return (r & 3) + 8 * (r >> 2) + 4 * hi; }

__device__ __forceinline__ void qkt(f32x16& p0, f32x16& p1, const LAS unsigned char* kslot, int r32, int hi, const v8i32 (&qf)[2], const f32x16& bias) {
    const int sw = (r32 >> 1) & 7;
    const LAS unsigned char* ra = kslot + r32 * 128;
#pragma unroll
    for (int s = 0; s < 2; ++s) { const int c0 = 4 * s + 2 * hi;
        const v4i32 a0 = *(const LAS v4i32*)(ra + ((c0 ^ sw) << 4)), a1 = *(const LAS v4i32*)(ra + (((c0 + 1) ^ sw) << 4));
        const v4i32 b0 = *(const LAS v4i32*)(ra + 32 * 128 + ((c0 ^ sw) << 4)), b1 = *(const LAS v4i32*)(ra + 32 * 128 + (((c0 + 1) ^ sw) << 4));
        const v8i32 ka = __builtin_shufflevector(a0, a1, 0, 1, 2, 3, 4, 5, 6, 7), kb = __builtin_shufflevector(b0, b1, 0, 1, 2, 3, 4, 5, 6, 7);
        if (s == 0) {
            p0 = __builtin_amdgcn_mfma_scale_f32_32x32x64_f8f6f4(ka, qf[s], bias, 0, 0, 0, 0x7f7f7f7f, 0, 0x7f7f7f7f);
            p1 = __builtin_amdgcn_mfma_scale_f32_32x32x64_f8f6f4(kb, qf[s], bias, 0, 0, 0, 0x7f7f7f7f, 0, 0x7f7f7f7f);
            __builtin_amdgcn_sched_barrier(0); }
        else {
            p0 = __builtin_amdgcn_mfma_scale_f32_32x32x64_f8f6f4(ka, qf[s], p0, 0, 0, 0, 0x7f7f7f7f, 0, 0x7f7f7f7f);
            p1 = __builtin_amdgcn_mfma_scale_f32_32x32x64_f8f6f4(kb, qf[s], p1, 0, 0, 0, 0x7f7f7f7f, 0, 0x7f7f7f7f); } }
}
__device__ __forceinline__ void pv_tile(f32x16 (&o)[8], const LAS unsigned char* va, const v8i32& pa, int scl) {
    const LAS unsigned char* vb = (const LAS unsigned char*)((unsigned)(uintptr_t)va ^ 16u);
#define PV_RD(S, d0) do { S[0] = *(const LAS v4i32*)(va + (d0) * 2048); S[1] = *(const LAS v4i32*)(vb + (d0) * 2048); } while (0)
#define PV_MM(S, d0) do { __builtin_amdgcn_sched_barrier(0); \
        o[d0] = __builtin_amdgcn_mfma_scale_f32_32x32x64_f8f6f4(pa, __builtin_shufflevector(S[0], S[1], 0, 1, 2, 3, 4, 5, 6, 7), o[d0], 0, 0, 0, scl, 0, 0x7f7f7f7f); __builtin_amdgcn_sched_barrier(0); } while (0)
    v4i32 f0[2], f1[2];
    PV_RD(f0, 0);
    PV_RD(f1, 1); PV_MM(f0, 0); PV_RD(f0, 2); PV_MM(f1, 1); PV_RD(f1, 3); PV_MM(f0, 2); PV_RD(f0, 4); PV_MM(f1, 3); PV_RD(f1, 5); PV_MM(f0, 4); PV_RD(f0, 6); PV_MM(f1, 5); PV_RD(f1, 7); PV_MM(f0, 6);
    PV_MM(f1, 7);
#undef PV_MM
#undef PV_RD
}

__device__ __forceinline__ void stage_offsets(int tid, unsigned& koff, unsigned (&voff)[2]) {
    { const int P = tid * 16, row = P >> 7, ch = ((P & 127) >> 4) ^ ((row >> 1) & 7); koff = (unsigned)(row * 128 + ch * 16); }
#pragma unroll
    for (int i = 0; i < 2; ++i) { const int P = tid * 16 + i * 8192, row = P >> 6, ch = ((P & 63) >> 4) ^ ((row >> 2) & 3); voff[i] = (unsigned)(row * 64 + ch * 16); }
}
__device__ __forceinline__ const char* uniform_ptr(const void* p) {
    const unsigned long long v = (unsigned long long)p;
    const unsigned lo = __builtin_amdgcn_readfirstlane((unsigned)v), hi = __builtin_amdgcn_readfirstlane((unsigned)(v >> 32));
    return (const char*)(((unsigned long long)hi << 32) | lo);
}
__device__ __forceinline__ void stage_tile(LAS unsigned char* lds, int slot, const bf16_t* kj_, const bf16_t* vj_, int tid_, int wid) {
    const char* kj = uniform_ptr(kj_); const char* vj = uniform_ptr(vj_);
    int tid = tid_; asm volatile("" : "+v"(tid));
    unsigned koff, voff[2]; stage_offsets(tid, koff, voff);
    LAS unsigned char* kd = lds + K_OFF + slot * SHM_K + wid * 1024; LAS unsigned char* vd = lds + V_OFF + slot * SHM_V + wid * 1024;
    __builtin_amdgcn_global_load_lds((const unsigned*)(kj + koff), (LAS unsigned*)kd, 16, 0, 0);
#pragma unroll
    for (int i = 0; i < 2; ++i) __builtin_amdgcn_global_load_lds((const unsigned*)(vj + voff[i]), (LAS unsigned*)(vd + i * 8192), 16, 0, 0);
}

__device__ __forceinline__ void qk_softmax(const LAS unsigned char* kslot, int r32, int hi, LAS float* al_l, const v8i32 (&qf)[2], const f32x16& bias, f32x16 (&o)[8], v8i32& pa, int& pscl,
                                           float& m_reg, float& l_reg, float rawu, float sl2, bool diag, int qi) {
    f32x16 p0, p1;
    qkt(p0, p1, kslot, r32, hi, qf, bias);
    if (diag) {
        const float k2raw = 2.f * rawu;
        int qi_ = qi - 4 * hi; asm volatile("" : "+v"(qi_));
#pragma unroll
        for (int r = 0; r < 16; ++r) { const int c = (r & 3) + 8 * (r >> 2); const int d0_ = c - qi_, d1_ = c + 32 - qi_;
            p0[r] -= k2raw * (float)(d0_ > 0 ? d0_ : 0); p1[r] -= k2raw * (float)(d1_ > 0 ? d1_ : 0); }
    }
    const float lane_raw = rawu * (float)(4 * hi), d32raw = 32.f * rawu;
    float pm0 = p0[0], pm1 = p1[0];
#pragma unroll
    for (int r = 1; r < 16; ++r) { pm0 = fmaxf(pm0, p0[r]); pm1 = fmaxf(pm1, p1[r]); }
    float pmax = fmaxf(pm0, pm1 + d32raw) + lane_raw;
    { auto rr = __builtin_amdgcn_permlane32_swap(__float_as_uint(pmax), __float_as_uint(pmax), false, false);
      pmax = fmaxf(__uint_as_float(rr[0]), __uint_as_float(rr[1])); }
    float mn, alpha;
    if (__all((pmax - m_reg) * SCALE <= THR)) { mn = m_reg; alpha = 1.f; }
    else { mn = fmaxf(m_reg, pmax); alpha = __builtin_amdgcn_exp2f((m_reg - mn) * C2); m_reg = mn; }
    const float ef = fminf(floorf(8.75f - (pmax - mn) * C2), 60.f);
    pscl = 127 - (int)ef;
    const float mnL0 = (lane_raw - mn) * C2 + ef, mnL1 = mnL0 + 32.f * sl2;
#pragma unroll
    for (int r = 0; r < 16; ++r) { p0[r] = __builtin_amdgcn_exp2f(fmaf(p0[r], C2, mnL0)); p1[r] = __builtin_amdgcn_exp2f(fmaf(p1[r], C2, mnL1)); }
    if (__any(alpha < 1.f)) {
        if (hi == 0) al_l[r32] = alpha;
        LDS_WAIT();
#pragma unroll
        for (int r = 0; r < 16; ++r) { const float a = al_l[crow(r, hi)];
#pragma unroll
            for (int d = 0; d < 8; ++d) o[d][r] *= a; }
    }
    float ps = 0.f;
#pragma unroll
    for (int r = 0; r < 16; ++r) ps += p0[r] + p1[r];
    { auto rr = __builtin_amdgcn_permlane32_swap(__float_as_uint(ps), __float_as_uint(ps), false, false);
      ps = __uint_as_float(rr[0]) + __uint_as_float(rr[1]); }
    l_reg = l_reg * alpha + ps * __builtin_amdgcn_exp2f(-ef);
#pragma unroll
    for (int g = 0; g < 4; ++g) {
        pa[g] = __builtin_amdgcn_cvt_pk_fp8_f32(p0[4 * g + 2], p0[4 * g + 3], __builtin_amdgcn_cvt_pk_fp8_f32(p0[4 * g], p0[4 * g + 1], (int)__float_as_uint(p0[4 * g]), false), true);
        pa[4 + g] = __builtin_amdgcn_cvt_pk_fp8_f32(p1[4 * g + 2], p1[4 * g + 3], __builtin_amdgcn_cvt_pk_fp8_f32(p1[4 * g], p1[4 * g + 1], (int)__float_as_uint(p1[4 * g]), false), true); }
}

__device__ __forceinline__ void norms_phase(Frame& F, const bf16_t* proj, float* nrm) {
    const int gw = F.vcu * NWAVES + F.wave, NGW = F.G * NWAVES, lane = F.lane;
    for (int idx = gw; idx < 2 * 32 * 256; idx += NGW) {
        const int tensor = idx >> 13, stream = (idx >> 8) & 31, grp = idx & 255;
        const u32x4* rp = (const u32x4*)((const unsigned char*)proj + (tensor ? DK0 : 0) + ((size_t)stream * SEQ + grp * 64 + lane) * 128);
        float ss = 0.f;
#pragma unroll
        for (int q = 0; q < 8; ++q) { const u32x4 v = rp[q];
#pragma unroll
            for (int e = 0; e < 4; ++e) { const float a0 = __builtin_amdgcn_cvt_f32_fp8((int)v[e], 0), a1 = __builtin_amdgcn_cvt_f32_fp8((int)v[e], 1), a2 = __builtin_amdgcn_cvt_f32_fp8((int)v[e], 2), a3 = __builtin_amdgcn_cvt_f32_fp8((int)v[e], 3);
                ss += (a0 * a0 + a1 * a1) + (a2 * a2 + a3 * a3); } }
        float n = sqrtf(ss) * 1.001f;
#pragma unroll
        for (int o = 1; o < 64; o <<= 1) n = fmaxf(n, __shfl_xor(n, o));
        if (lane == 0) nrm[idx] = n;
    }
}

__device__ __forceinline__ void attn_item(LAS unsigned char* lds, const bf16_t* proj, const float* nrm, bf16_t* oout, int b, int h, int sub, int qb, int tid, int wid, int lane, unsigned* queue, LAS int* qnext) {
    asm volatile("" : "+v"(lane));
    const int r32 = lane & 31, hi = lane >> 5;
    const float slope = __builtin_amdgcn_exp2f(-(float)(h + 1));
    const float sl2 = slope * 1.4426950408889634f, rawu = sl2 / C2;
    LAS float* ws = (LAS float*)(lds + SCR_OFF) + wid * 64; LAS float* li_l = ws; LAS float* al_l = ws + 32;
    const size_t tokq = (size_t)b * SEQ + (size_t)qb * 256 + wid * 32;
    const bf16_t* kbase = (const bf16_t*)((const unsigned char*)proj + DK0 + dq_off(b, 0, h, sub));
    const bf16_t* vbase = (const bf16_t*)((const unsigned char*)proj + pg8::vt_off(b, h, 0));
    int j_lo;
    { const int stream = (b * 8 + h) * 2 + sub; const float* qn = nrm + stream * 256; const float* kn = nrm + 8192 + stream * 256;
      const float Qn = fmaxf(fmaxf(qn[4 * qb], qn[4 * qb + 1]), fmaxf(qn[4 * qb + 2], qn[4 * qb + 3]));
      const float Kd = fmaxf(fmaxf(kn[4 * qb], kn[4 * qb + 1]), fmaxf(kn[4 * qb + 2], kn[4 * qb + 3]));
      int cand = 4 * qb;
      for (int jj = lane; jj < 4 * qb; jj += 64) { const float dmin = (float)(256 * qb - (64 * jj + 63)); const bool skip = slope * dmin > 110.f + SCALE * Qn * (kn[jj] + Kd); if (!skip) cand = cand < jj ? cand : jj; }
#pragma unroll
      for (int o = 1; o < 64; o <<= 1) { const int v = __builtin_amdgcn_ds_bpermute((lane ^ o) << 2, cand); cand = v < cand ? v : cand; }
      j_lo = __builtin_amdgcn_readfirstlane(cand); }
    v8i32 qf[2];
    { const unsigned char* qrow = (const unsigned char*)proj + dq_off(b, qb * 256 + wid * 32 + r32, h, sub) + 32 * hi;
#pragma unroll
      for (int s = 0; s < 2; ++s) { const v4i32 x0 = *(const v4i32*)(qrow + 64 * s), x1 = *(const v4i32*)(qrow + 64 * s + 16); qf[s] = __builtin_shufflevector(x0, x1, 0, 1, 2, 3, 4, 5, 6, 7); } }
    const float sh64 = 64.f * rawu;
    f32x16 bias;
#pragma unroll
    for (int r = 0; r < 16; ++r) bias[r] = (float)((r & 3) + 8 * (r >> 2)) * rawu;
    const int qi = 32 * (wid & 1) + r32;
    const LAS unsigned char* vb0 = lds + V_OFF + r32 * 64 + (((2 * hi) ^ ((r32 >> 2) & 3)) << 4);
    float m_reg = -1e30f, l_reg = 0.f;
    f32x16 o[8];
#pragma unroll
    for (int d = 0; d < 8; ++d)
#pragma unroll
        for (int r = 0; r < 16; ++r) o[d][r] = 0.f;
    const int NT = 4 * qb + 4, myNT = 4 * qb + (wid >> 1) + 1;
    constexpr size_t KSTEP = 64 * 128 / 2, VSTEP = 256 * 64 / 2;
    const bool late = wid >= 4;
#define ATT_STAGE(jj, sl) stage_tile(lds, sl, kbase + (size_t)(jj) * KSTEP, vbase + (size_t)(jj) * VSTEP, tid, wid)
#define ATT_NEXT(s_) ((s_) == NSLOT - 1 ? 0 : (s_) + 1)
#define ATT_WAIT(j_) do { const int rem_ = NT - 2 - (j_); if (rem_ >= 2) asm volatile("s_waitcnt vmcnt(6)" ::: "memory"); else if (rem_ == 1) asm volatile("s_waitcnt vmcnt(3)" ::: "memory"); \
        else asm volatile("s_waitcnt vmcnt(0)" ::: "memory"); WG_BAR(); } while (0)
    int s0 = j_lo % NSLOT;
    { const int s1 = ATT_NEXT(s0), s2 = ATT_NEXT(s1); ATT_STAGE(j_lo, s0); ATT_STAGE(j_lo + 1, s1); ATT_STAGE(j_lo + 2, s2); }
    asm volatile("s_waitcnt vmcnt(6)" ::: "memory"); WG_BAR();
    if (!late) {
        for (int j = j_lo; j < NT; ++j) {
            const int s1 = ATT_NEXT(s0);
            if (j + 3 < NT) { const int s3 = ATT_NEXT(ATT_NEXT(s1)); ATT_STAGE(j + 3, s3); }
            if (j < myNT) { if (j > j_lo) m_reg -= sh64;
                v8i32 pa; int pscl;
                qk_softmax(lds + K_OFF + s0 * SHM_K, r32, hi, al_l, qf, bias, o, pa, pscl, m_reg, l_reg, rawu, sl2, j == myNT - 1, qi);
                pv_tile(o, vb0 + s0 * SHM_V, pa, pscl); }
            ATT_WAIT(j);
            s0 = s1;
        }
    } else {
        v8i32 pa; int pscl = 127;
#pragma unroll
        for (int g = 0; g < 8; ++g) pa[g] = 0;
        int sp = s0;
        for (int j = j_lo; j < NT; ++j) {
            const int s1 = ATT_NEXT(s0);
            if (j + 3 < NT) { const int s3 = ATT_NEXT(ATT_NEXT(s1)); ATT_STAGE(j + 3, s3); }
            if (j > j_lo && j - 1 < myNT) pv_tile(o, vb0 + sp * SHM_V, pa, pscl);
            if (j < myNT) { if (j > j_lo) m_reg -= sh64;
                qk_softmax(lds + K_OFF + s0 * SHM_K, r32, hi, al_l, qf, bias, o, pa, pscl, m_reg, l_reg, rawu, sl2, j == myNT - 1, qi); }
            ATT_WAIT(j);
            sp = s0; s0 = s1;
        }
        if (myNT == NT) pv_tile(o, vb0 + sp * SHM_V, pa, pscl);
    }
#undef ATT_WAIT
#undef ATT_NEXT
#undef ATT_STAGE
    int jn_ = 0; if (tid == 0) jn_ = (int)__hip_atomic_fetch_add(queue, 1u, __ATOMIC_RELAXED, __HIP_MEMORY_SCOPE_AGENT);
    if (hi == 0) li_l[r32] = l_reg;
    LDS_WAIT();
    char* Ow = (char*)(oout + tokq * D + h * 256);
    const unsigned lofs = (unsigned)(hi * 4 * D + r32) * 2u;
#pragma unroll
    for (int r = 0; r < 16; ++r) { const float rl = __builtin_amdgcn_rcpf(li_l[crow(r, hi)]);
#pragma unroll
        for (int d0 = 0; d0 < 8; ++d0) { const float v = o[d0][r] * rl; const float vn = __uint_as_float((unsigned)__builtin_amdgcn_ds_bpermute((lane ^ 1) << 2, (int)__float_as_uint(v)));
            if ((r32 & 1) == 0) *(unsigned*)(Ow + (lofs + (unsigned)((((r & 3) + 8 * (r >> 2)) * D + d0 * 32) * 2))) = cvt_pk_bf16(v, vn); } }
    if (tid == 0) *qnext = jn_;
    WG_BAR();
}

struct TailConv { const float* wg; const float* wu; const float* wd; bf16_t* gu; bf16_t* dt; };
__device__ __forceinline__ void attn_phase(Frame& F, const bf16_t* proj, const float* nrm, unsigned* queue, bf16_t* o1, bf16_t* o2, const TailConv tc) {
    LAS int* qw = (LAS int*)(F.lds + SCR_OFF + 8 * 256);
    if (F.tid == 0) qw[0] = (int)__hip_atomic_fetch_add(queue, 1u, __ATOMIC_RELAXED, __HIP_MEMORY_SCOPE_AGENT);
    WG_BAR();
    for (int n = 0;; ++n) {
        const int J = __builtin_amdgcn_readfirstlane(qw[n & 1]);
        if (J >= 2048 + 512) break;
        const int grp = J / 5, rr = J - 5 * grp;
        if (rr == 4) { int jn_ = 0; if (F.tid == 0) jn_ = (int)__hip_atomic_fetch_add(queue, 1u, __ATOMIC_RELAXED, __HIP_MEMORY_SCOPE_AGENT);
            conv_moe(F, tc.wg, tc.wu, tc.wd, tc.gu, tc.dt, grp, 512, L1_EARLY, NEXP - L1_EARLY); if (F.tid == 0) qw[(n + 1) & 1] = jn_; WG_BAR(); continue; }
        const int I = 4 * grp + rr;
        const int qb = 63 - (I >> 5), r = I & 31, h = 7 - (r >> 2), b = (r >> 1) & 1, sub = r & 1;
        attn_item(F.lds, proj, nrm, sub ? o2 : o1, b, h, sub, qb, F.tid, F.wave, F.lane, queue, qw + ((n + 1) & 1));
    }
}
}

__device__ __forceinline__ const void* karg(int i) { int j = i; asm volatile("" : "+s"(j)); return ((const void* const __attribute__((address_space(4)))*)__builtin_amdgcn_kernarg_segment_ptr())[j]; }
#if defined(__HIP_DEVICE_COMPILE__)
#define NO_PK_F32 __attribute__((target("no-packed-fp32-ops")))
#else
#define NO_PK_F32
#endif
__global__ void __launch_bounds__(NWAVES * 64, 2) NO_PK_F32 hybrid_fwd(Args args) {
    extern __shared__ __attribute__((aligned(16))) unsigned char lds_raw[];
    Frame F;
    F.lds = (LAS unsigned char*)lds_raw;
    F.tid = threadIdx.x; F.lane = F.tid & 63; F.wave = __builtin_amdgcn_readfirstlane(F.tid >> 6);
    F.G = gridDim.x; { const int bx = blockIdx.x; F.vcu = (F.G % 8 == 0) ? (bx % 8) * (F.G / 8) + bx / 8 : bx; }
#define ws ((unsigned char*)karg(22))
#define ctl ((unsigned*)(ws + WS_CTL))
    for (int u = F.tid; u < (LDS_BYTES - LDSCTL_OFF) / 4; u += NWAVES * 64) ((LAS unsigned*)(F.lds + LDSCTL_OFF))[u] = 0u;
    SYNCTHREADS();
    ((LAS int*)(F.lds + TIDS_OFF))[F.tid] = F.tid;
    SYNCTHREADS();
    volatile LAS unsigned* MISC = (volatile LAS unsigned*)(F.lds + MISC_OFF);
    XcdBarrier bar = xcd_barrier_post(ctl + CW_BAR, MISC + 8);
#define GRID_BAR() do { XcdBarrier bb_ = bar; unsigned x_ = bar.x; unsigned long long bp_ = (unsigned long long)bar.bar; asm volatile("" : "+s"(x_), "+s"(bp_)); bb_.x = x_; bb_.bar = (unsigned*)bp_; xcd_barrier(bb_, TID_RELOAD() == 0); } while (0)
#define TID_RELOAD() (F.wave * 64 + lane_id_volatile())
#ifdef ONLY_PHASE
#define PHON(n) ((n) == ONLY_PHASE)
#else
#define PHON(n) 1
#endif

#define x_in ((const float*)(karg(0)))
#define norm_mix ((const float*)(karg(1)))
#define norm_ffn ((const float*)(karg(2)))
#define gla_w_in ((const float*)(karg(3)))
#define gla_wgu ((const float*)(karg(4)))
#define gla_bg ((const float*)(karg(5)))
#define gla_norm ((const float*)(karg(6)))
#define gla_w_out ((const float*)(karg(7)))
#define diff_w_in ((const float*)(karg(8)))
#define lq1 ((const float*)(karg(9)))
#define lk1 ((const float*)(karg(10)))
#define lq2 ((const float*)(karg(11)))
#define lk2 ((const float*)(karg(12)))
#define diff_subln ((const float*)(karg(13)))
#define diff_w_out ((const float*)(karg(14)))
#define moe_wgrp ((const float*)(karg(15)))
#define moe_wexp ((const float*)(karg(16)))
#define moe_wg ((const float*)(karg(17)))
#define moe_wu ((const float*)(karg(18)))
#define moe_wd ((const float*)(karg(19)))
#define final_norm ((const float*)(karg(20)))
#define xres ((bf16_t*)(ws + WS_XRES))
#define gz ((float*)((float*)(ws + WS_GZ)))
#define tok_e ((int*)((int*)(ws + WS_TOKE)))
#define tok_p ((int*)((int*)(ws + WS_TOKP)))
#define tok_w ((float*)((float*)(ws + WS_TOKW)))
#define slot_of ((int*)((int*)(ws + WS_SLOT)))
#define slot_tok ((int*)(ws + WS_STOK))
#define adec ((float*)((float*)(ws + WS_ADEC)))
#define pcum ((float*)((float*)(ws + WS_PCUM)))
#define sfin ((bf16_t*)((bf16_t*)(ws + WS_SFIN)))
#define wp_gz ((float*)((float*)(ws + WS_WPGZ)))
#define wp_r0 ((float*)((float*)(ws + WS_WPR0)))
#define wp_r1 ((float*)((float*)(ws + WS_WPR1)))
#define wgi ((bf16_t*)((bf16_t*)(ws + WS_WGI)))
#define wgo ((bf16_t*)((bf16_t*)(ws + WS_WGO)))
#define wdi ((bf16_t*)((bf16_t*)(ws + WS_WDI)))
#define wdo ((bf16_t*)((bf16_t*)(ws + WS_WDO)))
#define wmoe_gu ((bf16_t*)((bf16_t*)(ws + WS_WMOE)))
#define wmoe_d ((bf16_t*)((bf16_t*)(ws + WS_WMOE_D)))
#define hn ((bf16_t*)((bf16_t*)(ws + WS_HN)))
#define proj ((bf16_t*)((bf16_t*)(ws + WS_PROJ)))
#define buf1 ((bf16_t*)((bf16_t*)(ws + WS_BUF1)))
#define buf2 ((bf16_t*)((bf16_t*)(ws + WS_BUF2)))
#define ag ((bf16_t*)((bf16_t*)(ws + WS_AG)))
#define ob ((bf16_t*)((bf16_t*)(ws + WS_OB)))
#define hh ((bf16_t*)((bf16_t*)(ws + WS_H)))
    const LAS int* pst = (const LAS int*)(F.lds + TAB_OFF);

    _Pragma("unroll") for (int rep_ = 0; rep_ < (REP_PHASE == 0 ? 2 : 1); ++rep_) if (PHON(0)) { if (rep_) GRID_BAR(); Frame P = F; P.tid = TID_RELOAD(); P.lane = P.tid & 63;
    conv_plain(P, gla_w_in, D, PROJW, GLA_INW, wgi, -1, 0, norm_mix);
    conv_plain(P, gla_w_out, D, D, D, wgo);
    pack_proj(P, wp_gz, 1, norm_mix, gla_w_in, GLA_INW, PROJW, 16, nullptr, 0, 0);
    pack_proj16(P, (bf16_t*)wp_r0, 3, norm_ffn, moe_wgrp, 4, 0, 4, moe_wexp, 32, 32);
    pack_proj16(P, (bf16_t*)wp_r1, 3, norm_ffn + D, moe_wgrp + (size_t)D * 4, 4, 0, 4, moe_wexp + (size_t)D * 32, 32, 32);
    }
    GRID_BAR();
    _Pragma("unroll") for (int rep_ = 0; rep_ < (REP_PHASE == 1 ? 2 : 1); ++rep_) if (PHON(1)) { if (rep_) GRID_BAR(); Frame P = F; P.tid = TID_RELOAD(); P.lane = P.tid & 63;
    phase_norm_gz(P, x_in, wp_gz, hn, gz, (float*)(ws + WS_PCUM));
    }
    GRID_BAR();
    _Pragma("unroll") for (int rep_ = 0; rep_ < (REP_PHASE == 2 ? 2 : 1); ++rep_) if (PHON(2)) { if (rep_) GRID_BAR(); Frame P = F; P.tid = TID_RELOAD(); P.lane = P.tid & 63;
    { pg8::Gemm g{hn, wgi, T, PROJW, D}; pg8::StaticOrder S; S.init(T, PROJW, P.G, (int)blockIdx.x); pg8::EpiHeads<0> E{proj, (const float*)(ws + WS_PCUM)};
      pg8::gemm_phase<pg8::EpiHeads<0>, pg8::StaticOrder>(P.lds, g, S, E, P.tid); }
    }
    GRID_BAR();
    _Pragma("unroll") for (int rep_ = 0; rep_ < (REP_PHASE == 3 ? 2 : 1); ++rep_) if (PHON(3)) { if (rep_) GRID_BAR(); Frame P = F; P.tid = TID_RELOAD(); P.lane = P.tid & 63;
    phase_gla_gate(P, gz, gla_wgu, gla_bg, proj, buf1, adec);
    }
    GRID_BAR();
    _Pragma("unroll") for (int rep_ = 0; rep_ < (REP_PHASE == 4 ? 2 : 1); ++rep_) if (PHON(4)) { if (rep_) GRID_BAR(); Frame P = F; P.tid = TID_RELOAD(); P.lane = P.tid & 63;
    if (P.G == 256) { if ((P.vcu & 1) == 0) phase_gla_scan(P, P.vcu >> 1, proj, buf1, adec, buf2, sfin); else { gla_pcum(P, adec, pcum, P.vcu >> 1, 128); conv_moe(P, moe_wg, moe_wu, moe_wd, wmoe_gu, wmoe_d, P.vcu >> 1, 128);
            conv_moe(P, moe_wg + (size_t)NEXP * D * DFF, moe_wu + (size_t)NEXP * D * DFF, moe_wd + (size_t)NEXP * DFF * D, (bf16_t*)(ws + WS_WMOE1), (bf16_t*)(ws + WS_WMOE1_D), P.vcu >> 1, 128, 0, L1_EARLY);
            conv_plain<true>(P, diff_w_in, D, PROJW, PROJW, wdi, P.vcu >> 1, 128); conv_plain<true>(P, diff_w_out, D, D, D, wdo, P.vcu >> 1, 128); } }
    else { for (int it = P.vcu; it < 128; it += P.G) phase_gla_scan(P, it, proj, buf1, adec, buf2, sfin); gla_pcum(P, adec, pcum, P.vcu, P.G); conv_moe(P, moe_wg, moe_wu, moe_wd, wmoe_gu, wmoe_d); conv_moe(P, moe_wg + (size_t)NEXP * D * DFF, moe_wu + (size_t)NEXP * D * DFF, moe_wd + (size_t)NEXP * DFF * D, (bf16_t*)(ws + WS_WMOE1), (bf16_t*)(ws + WS_WMOE1_D), -1, 0, 0, L1_EARLY); conv_plain<true>(P, diff_w_in, D, PROJW, PROJW, wdi); conv_plain<true>(P, diff_w_out, D, D, D, wdo); }
    GRID_BAR();
    phase_gla_qp(P, proj, pcum, buf1);
    GRID_BAR();
    { pg8::Gemm g{buf1, sfin, 8 * (SEQ / 2), 512, 256}; pg8::FixOrder S; S.init(8 * (SEQ / 2), 512, P.G, (int)blockIdx.x); pg8::EpiAddO E{buf2};
      pg8::gemm_phase<pg8::EpiAddO, pg8::FixOrder>(P.lds, g, S, E, P.tid); }
    }
    GRID_BAR();
    _Pragma("unroll") for (int rep_ = 0; rep_ < (REP_PHASE == 5 ? 2 : 1); ++rep_) if (PHON(5)) { if (rep_) GRID_BAR(); Frame P = F; P.tid = TID_RELOAD(); P.lane = P.tid & 63;
    phase_gla_gnorm(P, buf2, proj, gla_norm, buf1);
    }
    GRID_BAR();
    _Pragma("unroll") for (int rep_ = 0; rep_ < (REP_PHASE == 6 ? 2 : 1); ++rep_) if (PHON(6)) { if (rep_) GRID_BAR(); Frame P = F; P.tid = TID_RELOAD(); P.lane = P.tid & 63;
    { pg8::Gemm g{buf1, wgo, T, D, D}; pg8::StaticOrder S; S.init(T, D, P.G, (int)blockIdx.x); pg8::EpiRes16<true> E{hn, xres, D};
      pg8::gemm_phase<pg8::EpiRes16<true>, pg8::StaticOrder>(P.lds, g, S, E, P.tid); }
    }
    GRID_BAR();
    _Pragma("unroll") for (int rep_ = 0; rep_ < (REP_PHASE == 7 ? 2 : 1); ++rep_) if (PHON(7)) { if (rep_) GRID_BAR(); Frame P = F; P.tid = TID_RELOAD(); P.lane = P.tid & 63;
    phase_norm_route(P, xres, norm_ffn, wp_r0, hn, tok_e, tok_p, tok_w, ctl + CW_CNT0);
    }
    GRID_BAR();
    _Pragma("unroll") for (int rep_ = 0; rep_ < (REP_PHASE == 8 ? 2 : 1); ++rep_) if (PHON(8)) { if (rep_) GRID_BAR(); Frame P = F; P.tid = TID_RELOAD(); P.lane = P.tid & 63;
    moe_tables(P, ctl + CW_CNT0);
    phase_moe_slots(P, tok_e, tok_p, ctl + CW_CNT0, slot_of, slot_tok);
    }
    GRID_BAR();
    _Pragma("unroll") for (int rep_ = 0; rep_ < (REP_PHASE == 9 ? 2 : 1); ++rep_) if (PHON(9)) { if (rep_) GRID_BAR(); Frame P = F; P.tid = TID_RELOAD(); P.lane = P.tid & 63;
    { const int Mr = pst[33] * 256; pg8::Gemm g{hn, wmoe_gu, Mr, 1024, D}; pg8::MoeOrder S; S.init(Mr, 1024, P.G, (int)blockIdx.x); S.te = pst + 36; S.estride = (size_t)1024 * D; S.stok = slot_tok; pg8::EpiSiluMul E{(unsigned char*)hh};
      pg8::gemm_phase<pg8::EpiSiluMul, pg8::MoeOrder, true, true>(P.lds, g, S, E, P.tid); }
    }
    GRID_BAR();
    _Pragma("unroll") for (int rep_ = 0; rep_ < (REP_PHASE == 10 ? 2 : 1); ++rep_) if (PHON(10)) { if (rep_) GRID_BAR(); Frame P = F; P.tid = TID_RELOAD(); P.lane = P.tid & 63;
    { const int Mr = pst[33] * 256; pg8::Gemm g{hh, wmoe_d, Mr, D, DFF}; pg8::MoeOrder S; S.init(Mr, D, P.G, (int)blockIdx.x); S.te = pst + 36; S.estride = (size_t)D * DFF; S.stok = slot_tok; pg8::EpiF8x8 E{(unsigned char*)ob, D};
      pg8::gemm_phase<pg8::EpiF8x8, pg8::MoeOrder, false, true>(P.lds, g, S, E, P.tid); }
    }
    GRID_BAR();
    _Pragma("unroll") for (int rep_ = 0; rep_ < (REP_PHASE == 11 ? 2 : 1); ++rep_) if (PHON(11)) { if (rep_) GRID_BAR(); Frame P = F; P.tid = TID_RELOAD(); P.lane = P.tid & 63;
    phase_moe_combine<0>(P, xres, nullptr, ob, slot_of, tok_w, norm_mix + D, hn);
    }
    GRID_BAR();
    _Pragma("unroll") for (int rep_ = 0; rep_ < (REP_PHASE == 12 ? 2 : 1); ++rep_) if (PHON(12)) { if (rep_) GRID_BAR(); Frame P = F; P.tid = TID_RELOAD(); P.lane = P.tid & 63;
    { pg8::Gemm g{hn, wdi, T, 4096, D}; pg8::StaticOrder S; S.init(T, 4096, P.G, (int)blockIdx.x); pg8::EpiHeads<1> E{proj, nullptr};
      pg8::gemm_phase<pg8::EpiHeads<1>, pg8::StaticOrder, false, true>(P.lds, g, S, E, P.tid); }
    { pg8::Gemm g{hn, (const bf16_t*)((const unsigned char*)wdi + (size_t)4096 * D), T, 2048, D}; pg8::StaticOrder S; S.init(T, 2048, P.G, (int)blockIdx.x); pg8::EpiVT E{(unsigned char*)proj};
      pg8::gemm_phase<pg8::EpiVT, pg8::StaticOrder, false, true, true>(P.lds, g, S, E, P.tid); }
    GRID_BAR();
    att::norms_phase(P, proj, (float*)(ws + WS_NRM));
    }
    GRID_BAR();
    _Pragma("unroll") for (int rep_ = 0; rep_ < (REP_PHASE == 13 ? 2 : 1); ++rep_) if (PHON(13)) { if (rep_) GRID_BAR(); Frame P = F; P.tid = TID_RELOAD(); P.lane = P.tid & 63;
    att::attn_phase(P, proj, (const float*)(ws + WS_NRM), ctl + CW_QUEUE + 64 * rep_, buf1, buf2, att::TailConv{moe_wg + (size_t)NEXP * D * DFF, moe_wu + (size_t)NEXP * D * DFF, moe_wd + (size_t)NEXP * DFF * D, (bf16_t*)(ws + WS_WMOE1), (bf16_t*)(ws + WS_WMOE1_D)});
    }
    GRID_BAR();
    _Pragma("unroll") for (int rep_ = 0; rep_ < (REP_PHASE == 14 ? 2 : 1); ++rep_) if (PHON(14)) { if (rep_) GRID_BAR(); Frame P = F; P.tid = TID_RELOAD(); P.lane = P.tid & 63;
    phase_subln(P, buf1, buf2, lq1, lk1, lq2, lk2, diff_subln, hn);
    }
    GRID_BAR();
    _Pragma("unroll") for (int rep_ = 0; rep_ < (REP_PHASE == 15 ? 2 : 1); ++rep_) if (PHON(15)) { if (rep_) GRID_BAR(); Frame P = F; P.tid = TID_RELOAD(); P.lane = P.tid & 63;
    { pg8::Gemm g{hn, wdo, T, D, D}; pg8::StaticOrder S; S.init(T, D, P.G, (int)blockIdx.x); pg8::EpiRes16<true> E{xres, xres, D};
      pg8::gemm_phase<pg8::EpiRes16<true>, pg8::StaticOrder, false, true>(P.lds, g, S, E, P.tid); }
    }
    GRID_BAR();
    _Pragma("unroll") for (int rep_ = 0; rep_ < (REP_PHASE == 16 ? 2 : 1); ++rep_) if (PHON(16)) { if (rep_) GRID_BAR(); Frame P = F; P.tid = TID_RELOAD(); P.lane = P.tid & 63;
    phase_norm_route(P, xres, norm_ffn + D, wp_r1, hn, tok_e, tok_p, tok_w, ctl + CW_CNT1);
    }
    GRID_BAR();
    _Pragma("unroll") for (int rep_ = 0; rep_ < (REP_PHASE == 17 ? 2 : 1); ++rep_) if (PHON(17)) { if (rep_) GRID_BAR(); Frame P = F; P.tid = TID_RELOAD(); P.lane = P.tid & 63;
    moe_tables(P, ctl + CW_CNT1);
    phase_moe_slots(P, tok_e, tok_p, ctl + CW_CNT1, slot_of, slot_tok);
    }
    GRID_BAR();
    _Pragma("unroll") for (int rep_ = 0; rep_ < (REP_PHASE == 18 ? 2 : 1); ++rep_) if (PHON(18)) { if (rep_) GRID_BAR(); Frame P = F; P.tid = TID_RELOAD(); P.lane = P.tid & 63;
    { const int Mr = pst[33] * 256; pg8::Gemm g{hn, (bf16_t*)(ws + WS_WMOE1), Mr, 1024, D}; pg8::MoeOrder S; S.init(Mr, 1024, P.G, (int)blockIdx.x); S.te = pst + 36; S.estride = (size_t)1024 * D; S.stok = slot_tok; pg8::EpiSiluMul E{(unsigned char*)hh};
      pg8::gemm_phase<pg8::EpiSiluMul, pg8::MoeOrder, true, true>(P.lds, g, S, E, P.tid); }
    }
    GRID_BAR();
    _Pragma("unroll") for (int rep_ = 0; rep_ < (REP_PHASE == 19 ? 2 : 1); ++rep_) if (PHON(19)) { if (rep_) GRID_BAR(); Frame P = F; P.tid = TID_RELOAD(); P.lane = P.tid & 63;
    { const int Mr = pst[33] * 256; pg8::Gemm g{hh, (bf16_t*)(ws + WS_WMOE1_D), Mr, D, DFF}; pg8::MoeOrder S; S.init(Mr, D, P.G, (int)blockIdx.x); S.te = pst + 36; S.estride = (size_t)D * DFF; S.stok = slot_tok; pg8::EpiF8x8 E{(unsigned char*)ob, D};
      pg8::gemm_phase<pg8::EpiF8x8, pg8::MoeOrder, false, true>(P.lds, g, S, E, P.tid); }
    }
    GRID_BAR();
    _Pragma("unroll") for (int rep_ = 0; rep_ < (REP_PHASE == 20 ? 2 : 1); ++rep_) if (PHON(20)) { if (rep_) GRID_BAR(); Frame P = F; P.tid = TID_RELOAD(); P.lane = P.tid & 63;
    phase_moe_combine<1>(P, xres, (float*)(karg(21)), ob, slot_of, tok_w, final_norm, hn);
    }
}

#undef x_in
#undef norm_mix
#undef norm_ffn
#undef gla_w_in
#undef gla_wgu
#undef gla_bg
#undef gla_norm
#undef gla_w_out
#undef diff_w_in
#undef lq1
#undef lk1
#undef lq2
#undef lk2
#undef diff_subln
#undef diff_w_out
#undef moe_wgrp
#undef moe_wexp
#undef moe_wg
#undef moe_wu
#undef moe_wd
#undef final_norm
#undef xres
#undef gz
#undef tok_e
#undef tok_p
#undef tok_w
#undef slot_of
#undef slot_tok
#undef ws
#undef ctl
#undef adec
#undef pcum
#undef sfin
#undef wp_gz
#undef wp_r0
#undef wp_r1
#undef wgi
#undef wgo
#undef wdi
#undef wdo
#undef wmoe_gu
#undef wmoe_d
#undef hn
#undef proj
#undef buf1
#undef buf2
#undef ag
#undef ob
#undef hh

extern "C" void kernel_launch(void* const* d_in, const int* in_sizes, int n_in, void* d_out, int out_size, void* d_ws, size_t ws_size, hipStream_t stream) {
    static int grid = 0;
    if (grid == 0) {
        if (n_in != 21 || out_size != T * D || ws_size < WS_END) { fprintf(stderr, "kernel_launch: unexpected shapes (n_in %d out %d ws %zu)\n", n_in, out_size, ws_size); grid = -1; return; }
        if (hipFuncSetAttribute((const void*)hybrid_fwd, hipFuncAttributeMaxDynamicSharedMemorySize, LDS_BYTES) != hipSuccess) { fprintf(stderr, "kernel_launch: hipFuncSetAttribute failed\n"); grid = -1; return; }
        int dev = 0, cus = 0, per_cu = 0;
        (void)hipGetDevice(&dev); (void)hipDeviceGetAttribute(&cus, hipDeviceAttributeMultiprocessorCount, dev);
        if (hipOccupancyMaxActiveBlocksPerMultiprocessor(&per_cu, (const void*)hybrid_fwd, NWAVES * 64, LDS_BYTES) != hipSuccess || per_cu < 1) fprintf(stderr, "kernel_launch: occupancy query says %d\n", per_cu);
        (void)hipGetLastError();
        grid = cus > 0 ? cus : 256;
    }
    if (grid < 0) return;
    Args a{};
    for (int i = 0; i < 21; ++i) a.in[i] = (const float*)d_in[i];
    a.out = (float*)d_out; a.ws = (unsigned char*)d_ws; a.pad0 = 0; a.pad1 = 0;
    (void)hipMemsetAsync((char*)d_ws + WS_CTL, 0, CTL_ZERO_BYTES, stream);
    hipLaunchKernelGGL(hybrid_fwd, dim3(grid), dim3(NWAVES * 64), LDS_BYTES, stream, a);
}
```

```cpp
#ifndef REP_PHASE
#define REP_PHASE -1
#endif
#include <hip/hip_runtime.h>
#include <cstdio>
#include <cstdint>

#define LAS __attribute__((address_space(3)))
#define GAS __attribute__((address_space(1)))
typedef unsigned short bf16_t;
typedef short bf16x8 __attribute__((ext_vector_type(8)));
typedef short s16x4 __attribute__((ext_vector_type(4)));
typedef float f32x4 __attribute__((ext_vector_type(4)));
typedef float f32x2 __attribute__((ext_vector_type(2)));
typedef float f32x16 __attribute__((ext_vector_type(16)));
typedef unsigned u32x4 __attribute__((ext_vector_type(4)));
typedef unsigned u32x2 __attribute__((ext_vector_type(2)));
typedef int v8i32 __attribute__((ext_vector_type(8)));
typedef int v4i32 __attribute__((ext_vector_type(4)));

constexpr int D = 2048, SEQ = 16384, NBATCH = 2, T = NBATCH * SEQ, CHUNK = 64, NCH = SEQ / CHUNK;
constexpr int GLA_H = 4, GLA_DK = 256, GLA_DV = 512, GLA_DKT = 1024, GLA_INW = 6160, PROJW = 6144;
constexpr int DIFF_H = 8;
constexpr int NEXP = 32, DFF = 512;
constexpr float RMS_EPS = 1e-6f;
constexpr float LAMBDA_INIT = 0.35550906759f;
constexpr int MAX_TILES = 288;

constexpr int L1_EARLY = 20;
constexpr size_t MiB = 1u << 20;
constexpr size_t WS_CTL = 0, CTL_ZERO_BYTES = 1 * MiB;
constexpr size_t WS_GZ = 2 * MiB;
constexpr size_t WS_TOKE = 4 * MiB;
constexpr size_t WS_TOKP = WS_TOKE + 256 * 1024;
constexpr size_t WS_TOKW = WS_TOKP + 256 * 1024;
constexpr size_t WS_SLOT = WS_TOKW + 256 * 1024;
constexpr size_t WS_STOK = 5 * MiB;
constexpr size_t WS_ADEC = 8 * MiB;
constexpr size_t WS_WPGZ = 10 * MiB;
constexpr size_t WS_WPR0 = 10 * MiB + 256 * 1024;
constexpr size_t WS_WPR1 = 11 * MiB;
constexpr size_t WS_NRM = 12 * MiB;
constexpr size_t WS_PCUM = 13 * MiB;
constexpr size_t WS_SFIN = 14 * MiB;
constexpr size_t WS_WGI = 16 * MiB, WS_WGO = 40 * MiB, WS_WDI = 48 * MiB, WS_WDO = 72 * MiB;
constexpr size_t WS_WMOE = 80 * MiB;
constexpr size_t WS_WMOE_D = WS_WMOE + 128 * MiB;
constexpr size_t WS_WMOE1 = WS_WMOE + 64 * MiB, WS_WMOE1_D = WS_WMOE + 160 * MiB;
constexpr size_t WS_HN = 272 * MiB;
constexpr size_t WS_PROJ = 400 * MiB;
constexpr size_t WS_BUF1 = 784 * MiB;
constexpr size_t WS_BUF2 = 912 * MiB;
constexpr size_t WS_XRES = 528 * MiB;
constexpr size_t WS_AG = 400 * MiB;
constexpr size_t WS_OB = 688 * MiB;
constexpr size_t WS_H = 976 * MiB;
constexpr size_t WS_END = 1048 * MiB;
constexpr int CW_BAR = 4096;
constexpr int CW_QUEUE = 8192;
constexpr int CW_CNT0 = 16384, CW_CNT1 = 16384 + 32 * 64;


constexpr size_t GK0 = (size_t)T * 1024, GV0 = (size_t)T * 2048, GR0 = (size_t)T * 4096;
constexpr size_t DK0 = (size_t)T * 2048, DV0 = (size_t)T * 4096;
__host__ __device__ __forceinline__ size_t gq_off(int b, int t, int h) { return ((size_t)(b * 4 + h) * SEQ + t) * 256; }
__host__ __device__ __forceinline__ size_t gv_off(int b, int t, int h) { return GV0 + ((size_t)(b * 4 + h) * SEQ + t) * 512; }
__host__ __device__ __forceinline__ size_t dq_off(int b, int t, int h, int sub) { return ((size_t)((b * 8 + h) * 2 + sub) * SEQ + t) * 128; }
__host__ __device__ __forceinline__ size_t dv_off(int b, int t, int h) { return DV0 + ((size_t)(b * 8 + h) * SEQ + t) * 256; }

constexpr int RING_BYTES = 131072;
constexpr int LDSCTL_OFF = RING_BYTES;
constexpr int MISC_OFF = LDSCTL_OFF + 320;
constexpr int TIDS_OFF = LDSCTL_OFF + 8192;
constexpr int TAB_OFF = LDSCTL_OFF + 1024;
constexpr int LDS_BYTES = 147456;
constexpr int NWAVES = 8;

typedef __bf16 bf16x2_t __attribute__((ext_vector_type(2)));
__device__ __forceinline__ unsigned cvt_pk_bf16(float lo, float hi) { const f32x2 v = {lo, hi}; return __builtin_bit_cast(unsigned, __builtin_convertvector(v, bf16x2_t)); }
__device__ __forceinline__ unsigned cvt4_fp8(float a, float b, float c, float d) { int v = __builtin_amdgcn_cvt_pk_fp8_f32(a, b, 0, false); return (unsigned)__builtin_amdgcn_cvt_pk_fp8_f32(c, d, v, true); }
constexpr float W8_SCALE = 64.f;
__device__ __forceinline__ float bf_lo(unsigned w) { return __uint_as_float(w << 16); }
__device__ __forceinline__ float bf_hi(unsigned w) { return __uint_as_float(w & 0xffff0000u); }
__device__ __forceinline__ f32x4 bf4_expand(u32x2 w) { return (f32x4){bf_lo(w.x), bf_hi(w.x), bf_lo(w.y), bf_hi(w.y)}; }
template <bool B16> struct XRow { typedef f32x4 T; static __device__ __forceinline__ f32x4 get(const f32x4& v) { return v; } };
template <> struct XRow<true> { typedef u32x2 T; static __device__ __forceinline__ f32x4 get(const u32x2& v) { return bf4_expand(v); } };
__device__ __forceinline__ float bf2f(bf16_t b) { return __uint_as_float(((unsigned)b) << 16); }
__device__ __forceinline__ float wave_sum(float v) {
#pragma unroll
    for (int o = 1; o < 64; o <<= 1) v += __shfl_xor(v, o);
    return v;
}
__device__ __forceinline__ int lane_id() { return (int)__builtin_amdgcn_mbcnt_hi(~0u, __builtin_amdgcn_mbcnt_lo(~0u, 0u)); }
__device__ __forceinline__ int lane_id_volatile() { int l; asm volatile("v_mbcnt_lo_u32_b32 %0, -1, 0\n\tv_mbcnt_hi_u32_b32 %0, -1, %0" : "=v"(l)); return l; }
__device__ __forceinline__ int opq(int v) { asm volatile("" : "+v"(v)); return v; }
#define LDS_WAIT() asm volatile("s_waitcnt lgkmcnt(0)" ::: "memory")
#define VM_WAIT() asm volatile("s_waitcnt vmcnt(0)" ::: "memory")
#define SYNCTHREADS() do { __builtin_amdgcn_fence(__ATOMIC_RELEASE, "workgroup"); __builtin_amdgcn_s_barrier(); __builtin_amdgcn_fence(__ATOMIC_ACQUIRE, "workgroup"); } while (0)
#define WG_BAR() do { asm volatile("s_waitcnt lgkmcnt(0)" ::: "memory"); __builtin_amdgcn_s_barrier(); asm volatile("" ::: "memory"); } while (0)

namespace pg8 {
constexpr int BM = 256, BK = 64, HALF = 128, HTB = HALF * BK * 2, STAGE_BYTES = 8 * HTB, NXCD = 8, WGM = 8;
__host__ __device__ __forceinline__ int lds_byte(int r, int c) { const int st = (r >> 4) * 2 + (c >> 5), rr = r & 15, cc = c & 31, ob = rr * 64 + cc * 2; return st * 1024 + (ob ^ (((ob >> 9) & 1) << 5)); }
__host__ __device__ __forceinline__ void stage_rc(int b, int& R, int& C) { const int st = b / 1024, sb = b % 1024, swz = sb ^ (((sb >> 9) & 1) << 5); R = (st >> 1) * 16 + swz / 64; C = (st & 1) * 32 + (swz % 64) / 2; }
__host__ __device__ __forceinline__ int perm32(int rho) { const int n = rho >> 4, i = rho & 15; return 8 * (i >> 2) + 4 * n + (i & 3); }

struct Unit { int pm, pn; };
struct Gemm { const bf16_t* A; const bf16_t* Bt; int M, N, K; };

struct StaticOrder {
    int nM, nN, nwg, G, c;
    __device__ __forceinline__ void init(int M, int N, int G_, int c_) { nM = M / BM; nN = N / BM; nwg = nM * nN; G = G_; c = c_; }
    __device__ __forceinline__ bool next(int i, Unit& u) const {
        const long L = (long)i * G + c; if (L >= nwg) return false;
        int wgid = (int)L; { const int q = nwg / NXCD, r = nwg % NXCD, xcd = wgid % NXCD, off = wgid / NXCD; wgid = (xcd < r ? xcd * (q + 1) : r * (q + 1) + (xcd - r) * q) + off; }
        const int nig = WGM * nN, gid = wgid / nig, fm = gid * WGM, gsz = (nM - fm) < WGM ? (nM - fm) : WGM;
        u.pm = fm + ((wgid % nig) % gsz); u.pn = (wgid % nig) / gsz; return true;
    }
    __device__ __forceinline__ size_t bofs(const Unit&) const { return 0; }
};
struct MoeOrder : StaticOrder {
    const LAS int* te; size_t estride; const int* stok;
    __device__ __forceinline__ size_t bofs(const Unit& u) const { return (size_t)te[u.pm] * estride; }
    __device__ __forceinline__ int arow(int pm, int r) const { const int t = stok[pm * BM + r]; return t < 0 ? 0 : t; }
};

struct EpiBf16 {
    static constexpr bool PERM = true;
    bf16_t* O; int ldc;
    __device__ __forceinline__ void operator()(const f32x4 (&acc)[2][2][4][2], const Unit& u, int wr, int wc, int fr, int fq) const {
        const int row0 = u.pm * BM + wr * 64 + fr, col0 = u.pn * BM + wc * 32 + 8 * fq;
#pragma unroll
        for (int ai = 0; ai < 2; ++ai)
#pragma unroll
            for (int m = 0; m < 4; ++m) { bf16_t* rowp = O + (size_t)(row0 + ai * HALF + m * 16) * ldc + col0;
#pragma unroll
                for (int bj = 0; bj < 2; ++bj) { const f32x4 v0 = acc[ai][bj][m][0], v1 = acc[ai][bj][m][1];
                    u32x4 w; w.x = cvt_pk_bf16(v0[0], v0[1]); w.y = cvt_pk_bf16(v0[2], v0[3]); w.z = cvt_pk_bf16(v1[0], v1[1]); w.w = cvt_pk_bf16(v1[2], v1[3]);
                    *(u32x4*)(rowp + bj * HALF) = w; } }
    }
};
struct EpiF8x8 {
    static constexpr bool PERM = true;
    unsigned char* O; int ldc;
    __device__ __forceinline__ void operator()(const f32x4 (&acc)[2][2][4][2], const Unit& u, int wr, int wc, int fr, int fq) const {
        const int row0 = u.pm * BM + wr * 64 + fr, col0 = u.pn * BM + wc * 32 + 8 * fq;
#pragma unroll
        for (int ai = 0; ai < 2; ++ai)
#pragma unroll
            for (int m = 0; m < 4; ++m) { unsigned char* rowp = O + (size_t)(row0 + ai * HALF + m * 16) * ldc + col0;
#pragma unroll
                for (int bj = 0; bj < 2; ++bj) { const f32x4 v0 = acc[ai][bj][m][0] * 8.f, v1 = acc[ai][bj][m][1] * 8.f;
                    u32x2 w; w.x = cvt4_fp8(v0[0], v0[1], v0[2], v0[3]); w.y = cvt4_fp8(v1[0], v1[1], v1[2], v1[3]);
                    *(u32x2*)(rowp + bj * HALF) = w; } }
    }
};
template <int LAYER> struct EpiHeads {
    static constexpr bool PERM = true;
    bf16_t* O; const float* rstd;
    __device__ __forceinline__ void operator()(const f32x4 (&acc)[2][2][4][2], const Unit& u, int wr, int wc, int fr, int fq) const {
        const int pn = u.pn, lc = wc * 32 + 8 * fq;
#pragma unroll
        for (int ai = 0; ai < 2; ++ai)
#pragma unroll
            for (int m = 0; m < 4; ++m) { const int row = u.pm * BM + ai * HALF + wr * 64 + m * 16 + fr, b = row >> 14, t = row & (SEQ - 1);
#pragma unroll
                for (int bj = 0; bj < 2; ++bj) { size_t off;
                    if (LAYER == 0) { if (pn < 4) off = gq_off(b, t, pn) + bj * 128 + lc; else if (pn < 8) off = GK0 + gq_off(b, t, pn - 4) + bj * 128 + lc;
                                      else if (pn < 16) off = gv_off(b, t, (pn - 8) >> 1) + ((pn - 8) & 1) * 256 + bj * 128 + lc; else off = GR0 + (size_t)row * 2048 + (pn - 16) * 256 + bj * 128 + lc; }
                    else { if (pn < 8) off = dq_off(b, t, pn, bj) + lc; else if (pn < 16) off = DK0 + dq_off(b, t, pn - 8, bj) + lc; else off = dv_off(b, t, pn - 16) + bj * 128 + lc; }
                    f32x4 v0 = acc[ai][bj][m][0], v1 = acc[ai][bj][m][1];
                    if (LAYER == 0) { const float rs = rstd[row]; v0 *= rs; v1 *= rs; }
                    if (LAYER == 1 && pn < 16) {
                        u32x2 w8; w8.x = cvt4_fp8(v0[0], v0[1], v0[2], v0[3]); w8.y = cvt4_fp8(v1[0], v1[1], v1[2], v1[3]); *(u32x2*)((unsigned char*)O + off) = w8; continue; }
                    u32x4 w; w.x = cvt_pk_bf16(v0[0], v0[1]); w.y = cvt_pk_bf16(v0[2], v0[3]); w.z = cvt_pk_bf16(v1[0], v1[1]); w.w = cvt_pk_bf16(v1[2], v1[3]);
                    *(u32x4*)(O + off) = w; } }
    }
};
__host__ __device__ __forceinline__ size_t vt_off(int b, int h, int chunk) { return DV0 * 2 + ((size_t)((b * 8 + h) * (SEQ / 64) + chunk)) * 16384; }
struct EpiVT {
    static constexpr bool PERM = false;
    unsigned char* O;
    __device__ __forceinline__ void operator()(const f32x4 (&acc)[2][2][4][2], const Unit& u, int wr, int wc, int fr, int fq) const {
#pragma unroll
        for (int ai = 0; ai < 2; ++ai) { const int row0 = u.pm * BM + ai * HALF + wr * 64;
            unsigned char* tp = O + vt_off(row0 >> 14, u.pn, (row0 & (SEQ - 1)) >> 6) + (size_t)(wc * 32 + fr) * 64 + 32 * (fq & 1) + 4 * (fq >> 1);
#pragma unroll
            for (int m = 0; m < 4; ++m)
#pragma unroll
                for (int bj = 0; bj < 2; ++bj)
#pragma unroll
                    for (int n = 0; n < 2; ++n) { const f32x4 v = acc[ai][bj][m][n];
                        *(unsigned*)(tp + (bj * 128 + n * 16) * 64 + 16 * (m >> 1) + 8 * (m & 1)) = cvt4_fp8(v[0], v[1], v[2], v[3]); } }
    }
};
struct FixOrder : StaticOrder {
    __device__ __forceinline__ size_t bofs(const Unit& u) const { return (size_t)(u.pm >> 5) * (512 * 256 * 2); }
};
struct EpiAddO {
    static constexpr bool PERM = true;
    bf16_t* O;
    __device__ __forceinline__ void operator()(const f32x4 (&acc)[2][2][4][2], const Unit& u, int wr, int wc, int fr, int fq) const {
#pragma unroll
        for (int ai = 0; ai < 2; ++ai)
#pragma unroll
            for (int m = 0; m < 4; ++m) { const int row = u.pm * BM + ai * HALF + wr * 64 + m * 16 + fr, bhh = row >> 13, t = row & 8191;
                bf16_t* rowp = O + ((size_t)(bhh >> 2) * SEQ + SEQ / 2 + t) * D + (bhh & 3) * 512 + u.pn * BM + wc * 32 + 8 * fq;
#pragma unroll
                for (int bj = 0; bj < 2; ++bj) { const u32x4 old = *(const u32x4*)(rowp + bj * HALF); const f32x4 v0 = acc[ai][bj][m][0] * 0.0625f, v1 = acc[ai][bj][m][1] * 0.0625f;
                    u32x4 w; w.x = cvt_pk_bf16(bf_lo(old.x) + v0[0], bf_hi(old.x) + v0[1]); w.y = cvt_pk_bf16(bf_lo(old.y) + v0[2], bf_hi(old.y) + v0[3]);
                    w.z = cvt_pk_bf16(bf_lo(old.z) + v1[0], bf_hi(old.z) + v1[1]); w.w = cvt_pk_bf16(bf_lo(old.w) + v1[2], bf_hi(old.w) + v1[3]);
                    *(u32x4*)(rowp + bj * HALF) = w; } }
    }
};
template <bool BASE16> struct EpiRes16 {
    static constexpr bool PERM = true;
    const void* base; bf16_t* C; int ldc;
    __device__ __forceinline__ void operator()(const f32x4 (&acc)[2][2][4][2], const Unit& u, int wr, int wc, int fr, int fq) const {
        const int row0 = u.pm * BM + wr * 64 + fr, col0 = u.pn * BM + wc * 32 + 8 * fq;
#pragma unroll
        for (int ai = 0; ai < 2; ++ai)
#pragma unroll
            for (int m = 0; m < 4; ++m) { const size_t off = (size_t)(row0 + ai * HALF + m * 16) * ldc + col0;
#pragma unroll
                for (int bj = 0; bj < 2; ++bj) { f32x4 v0 = acc[ai][bj][m][0], v1 = acc[ai][bj][m][1];
                    if constexpr (BASE16) { const u32x4 bs = *(const u32x4*)((const bf16_t*)base + off + bj * HALF);
                        v0 += (f32x4){bf_lo(bs.x), bf_hi(bs.x), bf_lo(bs.y), bf_hi(bs.y)}; v1 += (f32x4){bf_lo(bs.z), bf_hi(bs.z), bf_lo(bs.w), bf_hi(bs.w)}; }
                    else { const f32x4* bp = (const f32x4*)((const float*)base + off + bj * HALF); v0 += bp[0]; v1 += bp[1]; }
                    u32x4 w; w.x = cvt_pk_bf16(v0[0], v0[1]); w.y = cvt_pk_bf16(v0[2], v0[3]); w.z = cvt_pk_bf16(v1[0], v1[1]); w.w = cvt_pk_bf16(v1[2], v1[3]);
                    *(u32x4*)(C + off + bj * HALF) = w; }
                asm volatile("" ::: "memory"); }
    }
};
struct EpiSiluMul {
    static constexpr bool PERM = true;
    unsigned char* Hh;
    __device__ __forceinline__ void operator()(const f32x4 (&acc)[2][2][4][2], const Unit& u, int wr, int wc, int fr, int fq) const {
        const int row0 = u.pm * BM + wr * 64 + fr, col0 = u.pn * HALF + wc * 32 + 8 * fq;
#pragma unroll
        for (int ai = 0; ai < 2; ++ai)
#pragma unroll
            for (int m = 0; m < 4; ++m) { unsigned char* rowp = Hh + (size_t)(row0 + ai * HALF + m * 16) * DFF + col0;
                float hv[8];
#pragma unroll
                for (int n = 0; n < 2; ++n)
#pragma unroll
                    for (int j = 0; j < 4; ++j) { const float g = acc[ai][0][m][n][j], up = acc[ai][1][m][n][j];
                        const float sg = g * __builtin_amdgcn_rcpf(1.0f + __builtin_amdgcn_exp2f(-1.4426950408889634f * g)); hv[n * 4 + j] = sg * up; }
                u32x2 w; w.x = cvt4_fp8(hv[0], hv[1], hv[2], hv[3]); w.y = cvt4_fp8(hv[4], hv[5], hv[6], hv[7]);
                *(u32x2*)rowp = w; }
    }
};

template <class Epi, class Sched, bool GATHER = false, bool FP8 = false, bool NTR = false>
__device__ __forceinline__ void gemm_phase(LAS unsigned char* lds, const Gemm g, const Sched& S, const Epi& E, int tid_in) {
    const int tid = opq(tid_in), wid = __builtin_amdgcn_readfirstlane(tid >> 6), lane = tid & 63, wr = wid >> 2, wc = wid & 3, fr = lane & 15, fq = lane >> 4;
    const int K = g.K, RP = FP8 ? K : 2 * K  , nt = RP / (BK * 2);
    unsigned voffA[2], voffB[2];
#pragma unroll
    for (int i = 0; i < 2; ++i) { int R, C; stage_rc(tid * 16 + i * 8192, R, C); const int Rb = Epi::PERM ? ((R & ~31) + perm32(R & 31)) : R;
        voffA[i] = (unsigned)(R * RP + 2 * C); voffB[i] = (unsigned)(Rb * RP + 2 * C); }
    const unsigned kstep = (unsigned)(BK * 2);
    const unsigned hstep = (unsigned)HALF * (unsigned)RP;
    const size_t tstep = 2 * (size_t)hstep;
    const unsigned ldsw = (unsigned)wid * 1024u;
    const int aoff = lds_byte(wr * 64 + fr, fq * 8), boff = lds_byte(wc * 32 + fr, fq * 8);
    const LAS unsigned char* ldsB = lds + 4 * HTB + boff;
#define PG8_SA(b, h) (((b) * 2 + (h)) * HTB)
#define PG8_SB(b, h) ((4 + (b) * 2 + (h)) * HTB)
#define PG8_STAGE(bufoff, gbase, voff) do { const unsigned long long gv_ = (unsigned long long)(gbase); \
        const unsigned glo_ = (unsigned)__builtin_amdgcn_readfirstlane((unsigned)gv_), ghi_ = (unsigned)__builtin_amdgcn_readfirstlane((unsigned)(gv_ >> 32)); const char* gb_ = (const char*)(((unsigned long long)ghi_ << 32) | (unsigned long long)glo_);     \
        _Pragma("unroll") for (int _i = 0; _i < 2; ++_i) \
        __builtin_amdgcn_global_load_lds((const unsigned*)(gb_ + (voff)[_i]), (LAS unsigned*)(lds + (bufoff) + ldsw + _i * 8192), 16, 0, 0); } while (0)
#define PG8_STAGE_A(bufoff, nx, koff, h) do { if constexpr (GATHER) { unsigned vs_[2]; _Pragma("unroll") for (int _i = 0; _i < 2; ++_i) vs_[_i] = (nx) ? vAn[h][_i] : vAc[h][_i]; \
            PG8_STAGE(bufoff, (const char*)g.A + (koff), vs_); } \
        else { PG8_STAGE(bufoff, ((nx) ? nA : cA) + (koff) + (h) * hstep, voffA); } } while (0)
#define PG8_LD8(off) __builtin_shufflevector(*(const LAS v4i32*)(lds + (off)), *(const LAS v4i32*)(lds + (off) + 1024), 0, 1, 2, 3, 4, 5, 6, 7)
#define PG8_LDA(dst, b, h) do { if constexpr (FP8) { _Pragma("unroll") for (int m = 0; m < 4; ++m) dst##8[m] = PG8_LD8(PG8_SA(b, h) + aoff + m * 2048); } \
        else { _Pragma("unroll") for (int m = 0; m < 4; ++m) _Pragma("unroll") for (int k = 0; k < 2; ++k) dst[m][k] = *(const LAS bf16x8*)(lds + PG8_SA(b, h) + aoff + m * 2048 + k * 1024); } } while (0)
#define PG8_LD8B(off) __builtin_shufflevector(*(const LAS v4i32*)(ldsB + (off)), *(const LAS v4i32*)(ldsB + (off) + 1024), 0, 1, 2, 3, 4, 5, 6, 7)
#define PG8_LDB(dst, b, h) do { if constexpr (FP8) { _Pragma("unroll") for (int n = 0; n < 2; ++n) dst##8[n] = PG8_LD8B(PG8_SA(b, h) + n * 2048); }     \
        else { _Pragma("unroll") for (int n = 0; n < 2; ++n) _Pragma("unroll") for (int k = 0; k < 2; ++k) dst[n][k] = *(const LAS bf16x8*)(lds + PG8_SB(b, h) + boff + n * 2048 + k * 1024); } } while (0)
#define PG8_MMA(ai, bj, At, Bt) do { __builtin_amdgcn_s_setprio(1); if constexpr (FP8) { _Pragma("unroll") for (int m = 0; m < 4; ++m) _Pragma("unroll") for (int n = 0; n < 2; ++n) \
              \
            { if constexpr (NTR) asm volatile("v_mfma_scale_f32_16x16x128_f8f6f4 %0, %1, %2, %0, %3, %3 op_sel:[1,0,0] op_sel_hi:[0,0,0]" : "+v"(acc[ai][bj][m][n]) : "v"(At##8[m]), "v"(Bt##8[n]), "v"(scl8)); \
              else asm volatile("v_mfma_scale_f32_16x16x128_f8f6f4 %0, %1, %2, %0, %3, %3 op_sel:[0,1,0] op_sel_hi:[0,0,0]" : "+v"(acc[ai][bj][m][n]) : "v"(Bt##8[n]), "v"(At##8[m]), "v"(scl8)); } } \
        else { _Pragma("unroll") for (int m = 0; m < 4; ++m) _Pragma("unroll") for (int n = 0; n < 2; ++n) _Pragma("unroll") for (int k = 0; k < 2; ++k) \
            acc[ai][bj][m][n] = __builtin_amdgcn_mfma_f32_16x16x32_bf16(Bt[n][k], At[m][k], acc[ai][bj][m][n], 0, 0, 0); } __builtin_amdgcn_s_setprio(0); } while (0)
#define PG8_WAIT_V(n) asm volatile("s_waitcnt vmcnt(" #n ")" ::: "memory")
#define PG8_WAIT_L(n) asm volatile("s_waitcnt lgkmcnt(" #n ")" ::: "memory")
#define PG8_BAR __builtin_amdgcn_s_barrier()
#define PG8_SCHED __builtin_amdgcn_sched_barrier(0)
#define PG8_ROWOFFS(V, U) do { if constexpr (GATHER) { const int t_ = opq(wid * 64 + lane_id());     \
        _Pragma("unroll") for (int i_ = 0; i_ < 2; ++i_) { int R_, C_; stage_rc(t_ * 16 + i_ * 8192, R_, C_); \
        _Pragma("unroll") for (int h_ = 0; h_ < 2; ++h_) V[h_][i_] = (unsigned)S.arow((U).pm, h_ * HALF + R_) * (unsigned)RP + 2u * (unsigned)C_; } } } while (0)
    Unit cur, nxt; int ui = 0;
    if (!S.next(0, cur)) return;
    f32x4 acc[2][2][4][2];
#pragma unroll
    for (int a = 0; a < 2; ++a)
#pragma unroll
        for (int b = 0; b < 2; ++b)
#pragma unroll
            for (int m = 0; m < 4; ++m)
#pragma unroll
                for (int n = 0; n < 2; ++n) acc[a][b][m][n] = (f32x4){0.f, 0.f, 0.f, 0.f};
    const unsigned scl8 = 0x7f797f79u;
    bf16x8 At[4][2], B0[2][2], B1[2][2]; v8i32 At8[4], B08[2], B18[2];
    unsigned vAc[2][2] = {{0u, 0u}, {0u, 0u}}, vAn[2][2] = {{0u, 0u}, {0u, 0u}};
    const char* cA = (const char*)g.A + (GATHER ? (size_t)0 : (size_t)cur.pm * tstep); const char* nA = cA; const char* cB = (const char*)g.Bt + S.bofs(cur) + (size_t)cur.pn * tstep;
    PG8_ROWOFFS(vAc, cur);
    PG8_STAGE(PG8_SB(0, 0), cB, voffB); PG8_STAGE(PG8_SB(0, 1), cB + hstep, voffB); PG8_STAGE_A(PG8_SA(0, 0), false, 0u, 0); PG8_STAGE_A(PG8_SA(0, 1), false, 0u, 1);
    if (wr == 1) PG8_BAR;
    PG8_WAIT_V(2); PG8_BAR;
    PG8_STAGE(PG8_SB(1, 0), cB + kstep, voffB); PG8_STAGE_A(PG8_SA(1, 0), false, kstep, 0); PG8_STAGE(PG8_SB(1, 1), cB + hstep + kstep, voffB);
    PG8_WAIT_V(6); PG8_BAR;
    for (;;) {
        const bool has_next = S.next(ui + 1, nxt);
        nA = (has_next && !GATHER) ? (const char*)g.A + (size_t)nxt.pm * tstep : cA; const char* nB = has_next ? (const char*)g.Bt + S.bofs(nxt) + (size_t)nxt.pn * tstep : cB;

        for (int t = 0; t < nt; t += 2) {
            const bool last = (t == nt - 2);
            if constexpr (GATHER) { if (last) {
                if (has_next) PG8_ROWOFFS(vAn, nxt); else { _Pragma("unroll") for (int h_ = 0; h_ < 2; ++h_) _Pragma("unroll") for (int i_ = 0; i_ < 2; ++i_) vAn[h_][i_] = vAc[h_][i_]; } } }
            const unsigned k1 = (unsigned)(t + 1) * kstep, k2 = last ? 0u : (unsigned)(t + 2) * kstep, k3 = k2 + kstep;
            const char* b2 = last ? nB : cB + k2; const char* b3 = b2 + kstep;
            PG8_LDB(B0, 0, 0); PG8_LDB(B1, 0, 1); PG8_SCHED; PG8_LDA(At, 0, 0); PG8_STAGE_A(PG8_SA(1, 1), false, k1, 1);
            PG8_WAIT_V(8); PG8_WAIT_L(0); PG8_BAR; PG8_MMA(0, 0, At, B0); PG8_MMA(0, 1, At, B1); PG8_BAR; PG8_SCHED;
            PG8_LDA(At, 0, 1); PG8_STAGE(PG8_SB(0, 0), b2, voffB); PG8_STAGE(PG8_SB(0, 1), b2 + hstep, voffB); PG8_STAGE_A(PG8_SA(0, 0), last, k2, 0);
            PG8_WAIT_V(8); PG8_WAIT_L(0); PG8_BAR; PG8_MMA(1, 0, At, B0); PG8_MMA(1, 1, At, B1); PG8_BAR; PG8_SCHED;
            PG8_LDB(B0, 1, 0); PG8_LDB(B1, 1, 1); PG8_SCHED; PG8_LDA(At, 1, 0); PG8_STAGE_A(PG8_SA(0, 1), last, k2, 1);
            PG8_WAIT_V(8); PG8_WAIT_L(0); PG8_BAR; PG8_MMA(0, 0, At, B0); PG8_MMA(0, 1, At, B1); PG8_BAR; PG8_SCHED;
            PG8_LDA(At, 1, 1); PG8_STAGE(PG8_SB(1, 0), b3, voffB); PG8_STAGE(PG8_SB(1, 1), b3 + hstep, voffB); PG8_STAGE_A(PG8_SA(1, 0), last, k3, 0);
            PG8_WAIT_V(8); PG8_WAIT_L(0); PG8_BAR; PG8_MMA(1, 0, At, B0); PG8_MMA(1, 1, At, B1); PG8_BAR; PG8_SCHED;
        }
        if (wr == 0) PG8_BAR;
        E(acc, cur, wr, wc, fr, fq);
        if (!has_next) break;
#pragma unroll
        for (int a = 0; a < 2; ++a)
#pragma unroll
            for (int b = 0; b < 2; ++b)
#pragma unroll
                for (int m = 0; m < 4; ++m)
#pragma unroll
                    for (int n = 0; n < 2; ++n) acc[a][b][m][n] = (f32x4){0.f, 0.f, 0.f, 0.f};
        cur = nxt; cA = nA; cB = nB; ++ui;
        if constexpr (GATHER) { _Pragma("unroll") for (int h_ = 0; h_ < 2; ++h_) _Pragma("unroll") for (int i_ = 0; i_ < 2; ++i_) vAc[h_][i_] = vAn[h_][i_]; }
        if (wr == 1) PG8_BAR;
    }
    PG8_WAIT_V(0);
    PG8_BAR;
#undef PG8_SA
#undef PG8_SB
#undef PG8_STAGE
#undef PG8_STAGE_A
#undef PG8_ROWOFFS
#undef PG8_LDA
#undef PG8_LDB
#undef PG8_MMA
#undef PG8_LD8
#undef PG8_LD8B
#undef PG8_WAIT_V
#undef PG8_WAIT_L
#undef PG8_BAR
#undef PG8_SCHED
}
}

#define XB_TMO      128
#define XB_XCNT(j)  (256  + 64 * (j))
#define XB_XSUB(j)  (1280 + 64 * (j))
#define XB_XGEN(j)  (2304 + 64 * (j))
#define XB_TOP      3328
#define XB_TOPGEN   3392
#define XCD_BAR_WORDS 3456
#define XB_SPIN_CAP (1u << 18)
__device__ __forceinline__ unsigned xb_ld(unsigned* p)              { return __hip_atomic_load(p, __ATOMIC_RELAXED, __HIP_MEMORY_SCOPE_AGENT); }
__device__ __forceinline__ unsigned xb_add(unsigned* p, unsigned v) { return __hip_atomic_fetch_add(p, v, __ATOMIC_RELAXED, __HIP_MEMORY_SCOPE_AGENT); }
__device__ __forceinline__ unsigned xb_xcc_id() { return (unsigned)__builtin_amdgcn_s_getreg((3 << 11) | 20) & 0xFu; }
#define XB_SPIN(cond, bar) do { unsigned _sp = 0; while (cond) { __builtin_amdgcn_s_sleep(1); \
    if ((++_sp & 255u) == 0u) { if (xb_ld(&(bar)[XB_TMO])) break; if (_sp > XB_SPIN_CAP) { atomicAdd(&(bar)[XB_TMO], 1u); break; } } } } while (0)
struct XcdBarrier { unsigned* bar; unsigned x; volatile LAS unsigned* st; int wave; };
__device__ __forceinline__ XcdBarrier xcd_barrier_post(unsigned* bar, volatile LAS unsigned* st) {
    XcdBarrier b; b.bar = bar; b.x = xb_xcc_id(); b.st = st; b.wave = __builtin_amdgcn_readfirstlane((int)threadIdx.x >> 6);
    if (threadIdx.x == 0) (void)xb_add(&bar[XB_XCNT(b.x)], 1u);
    return b;
}
__device__ __forceinline__ void xcd_barrier_complete(unsigned* bar, unsigned x, unsigned& nloc, unsigned& nx) {
    const unsigned G = gridDim.x * gridDim.y * gridDim.z;
    unsigned sum, cnt, mine, sp = 0u;
    for (;;) {
        sum = 0u; cnt = 0u; mine = 0u;
#pragma unroll
        for (unsigned j = 0; j < 16; ++j) { const unsigned c = xb_ld(&bar[XB_XCNT(j)]); sum += c; cnt += (c > 0u) ? 1u : 0u; mine = (j == x) ? c : mine; }
        if (sum == G) break;
        __builtin_amdgcn_s_sleep(1);
        if ((++sp & 255u) == 0u) { if (xb_ld(&bar[XB_TMO])) break; if (sp > XB_SPIN_CAP) { atomicAdd(&bar[XB_TMO], 1u); break; } }
    }
    nloc = mine > 0u ? mine : 1u; nx = cnt > 0u ? cnt : 1u;
}
__device__ __forceinline__ void xcd_barrier(const XcdBarrier& b, bool leader  ) {
    asm volatile("s_waitcnt vmcnt(0)" ::: "memory");
    SYNCTHREADS();
    if (leader) {
        unsigned* bar = b.bar;
        __builtin_amdgcn_s_waitcnt(0);
        unsigned nloc = b.st[0], nx = b.st[1];
        if (nloc == 0u) { xcd_barrier_complete(bar, b.x, nloc, nx); b.st[0] = nloc; b.st[1] = nx; }
        const unsigned old = xb_add(&bar[XB_XSUB(b.x)], 1u);
        const unsigned gen = old / nloc;
        if (old + 1u == (gen + 1u) * nloc) {
            __builtin_amdgcn_fence(__ATOMIC_RELEASE, "agent");
            asm volatile("s_waitcnt vmcnt(0)" ::: "memory");
            const unsigned og = xb_add(&bar[XB_TOP], 1u);
            const unsigned tg = og / nx;
            if (og + 1u == (tg + 1u) * nx) xb_add(&bar[XB_TOPGEN], 1u);
            else XB_SPIN(xb_ld(&bar[XB_TOPGEN]) == tg, bar);
            __builtin_amdgcn_fence(__ATOMIC_ACQUIRE, "agent");
            xb_add(&bar[XB_XGEN(b.x)], 1u);
            asm volatile("s_waitcnt vmcnt(0)" ::: "memory");
        } else {
            XB_SPIN(xb_ld(&bar[XB_XGEN(b.x)]) == gen, bar);
            __builtin_amdgcn_fence(__ATOMIC_ACQUIRE, "agent");
            asm volatile("s_waitcnt vmcnt(0)" ::: "memory");
        }
    }
    SYNCTHREADS();
}

struct Frame {
    LAS unsigned char* lds;
    int tid, lane, wave, vcu, G;
};
struct Args {
    const float* in[21]; float* out; unsigned char* ws; int pad0, pad1;
};

struct TrItem { const float* src; unsigned char* dst; int ldw, ldk; const float* gk; };
__device__ __forceinline__ void tr_load(const TrItem& t, int lane, float (&tv)[32]) {
    const float* wp_ = t.src + (size_t)(lane >> 5) * t.ldw + (lane & 31);
#pragma unroll
    for (int i = 0; i < 32; ++i) tv[i] = wp_[(size_t)(2 * i) * t.ldw];
}
template <bool FP8>
__device__ __forceinline__ void tr_store(const TrItem& t, const float (&tv)[32], LAS float* scr, int lane) {
#pragma unroll
    for (int i = 0; i < 32; ++i) scr[(2 * i + (lane >> 5)) * 33 + (lane & 31)] = tv[i];
    LDS_WAIT(); asm volatile("" ::: "memory");
    const int c = lane & 7;
#pragma unroll
    for (int j = 0; j < 4; ++j) { const int n = (lane >> 3) + 8 * j; const LAS float* s = scr + (8 * c) * 33 + n;
        if constexpr (FP8) { u32x2 o; o.x = cvt4_fp8(s[0 * 33] * W8_SCALE, s[1 * 33] * W8_SCALE, s[2 * 33] * W8_SCALE, s[3 * 33] * W8_SCALE); o.y = cvt4_fp8(s[4 * 33] * W8_SCALE, s[5 * 33] * W8_SCALE, s[6 * 33] * W8_SCALE, s[7 * 33] * W8_SCALE);
            *(u32x2*)(t.dst + (size_t)n * t.ldk + 8 * c) = o; }
        else { f32x4 ga = {1.f, 1.f, 1.f, 1.f}, gb = ga; if (t.gk) { ga = *(const f32x4*)(t.gk + 8 * c); gb = *(const f32x4*)(t.gk + 8 * c + 4); }
            u32x4 o; o.x = cvt_pk_bf16(s[0 * 33] * ga[0], s[1 * 33] * ga[1]); o.y = cvt_pk_bf16(s[2 * 33] * ga[2], s[3 * 33] * ga[3]); o.z = cvt_pk_bf16(s[4 * 33] * gb[0], s[5 * 33] * gb[1]); o.w = cvt_pk_bf16(s[6 * 33] * gb[2], s[7 * 33] * gb[3]);
            *(u32x4*)(t.dst + ((size_t)n * t.ldk + 8 * c) * 2) = o; } }
    LDS_WAIT(); asm volatile("" ::: "memory");
}
#define TR_PIPELINE(FP8_, DECODE) do { if (gw < nit) { float tv_[32]; TrItem cur_ = DECODE(gw); tr_load(cur_, F.lane, tv_); \
        for (int it = gw; it < nit; it += NGW) { const int itn_ = it + NGW < nit ? it + NGW : it;     \
            float tn_[32]; const TrItem nxt_ = DECODE(itn_); tr_load(nxt_, F.lane, tn_); \
            tr_store<FP8_>(cur_, tv_, scr, F.lane); cur_ = nxt_; \
            _Pragma("unroll") for (int i_ = 0; i_ < 32; ++i_) tv_[i_] = tn_[i_]; } } } while (0)
template <bool FP8 = false>
__device__ __forceinline__ void conv_plain(Frame& F, const float* W, int K, int N, int ldw, bf16_t* WT, int rank = -1, int nrank = 0, const float* gain = nullptr) {
    LAS float* scr = (LAS float*)(F.lds + F.wave * 16384);
    const int gw = (rank < 0 ? F.vcu : rank) * NWAVES + F.wave, NGW = (rank < 0 ? F.G : nrank) * NWAVES, nblk = N / 32, nit = (K / 64) * nblk;
    auto decode = [&](int it) -> TrItem { const int kb = it / nblk, nb = it % nblk;
        return TrItem{W + (size_t)(64 * kb) * ldw + 32 * nb, (unsigned char*)WT + ((size_t)(32 * nb) * K + 64 * kb) * (FP8 ? 1 : 2), ldw, K, gain ? gain + 64 * kb : nullptr}; };
    TR_PIPELINE(FP8, decode);
}
__device__ __forceinline__ void conv_moe(Frame& F, const float* wg, const float* wu, const float* wd, bf16_t* GU, bf16_t* DT, int rank = -1, int nrank = 0, int e0 = 0, int ne = NEXP) {
    LAS float* scr = (LAS float*)(F.lds + F.wave * 16384);
    const int gw = (rank < 0 ? F.vcu : rank) * NWAVES + F.wave, NGW = (rank < 0 ? F.G : nrank) * NWAVES;
    constexpr int PER_E = 1536; const int nit = ne * PER_E;
    auto decode = [&](int it) -> TrItem { const int e = e0 + it / PER_E; int r = it % PER_E;
        if (r < 1024) { const int up = r >> 9; r &= 511; const int kb = r >> 4, nb = r & 15, n0 = 32 * nb;
            const int drow = 256 * (n0 >> 7) + 128 * up + (n0 & 127);
            return TrItem{(up ? wu : wg) + (size_t)e * D * DFF + (size_t)(64 * kb) * DFF + n0, (unsigned char*)GU + (size_t)e * 1024 * D + (size_t)drow * D + 64 * kb, DFF, D, nullptr}; }
        r -= 1024; const int kb = r >> 6, nb = r & 63;
        return TrItem{wd + (size_t)e * DFF * D + (size_t)(64 * kb) * D + 32 * nb, (unsigned char*)DT + (size_t)e * D * DFF + (size_t)(32 * nb) * DFF + 64 * kb, D, DFF, nullptr}; };
    TR_PIPELINE(true, decode);
}
__device__ __forceinline__ void pack_proj(Frame& F, float* Wp, int NT, const float* gain, const float* Wa, int lda, int ca0, int na, const float* Wb, int ldb, int nb) {
    const int total = 128 * NT * 256;
    for (int idx = (F.vcu * NWAVES * 64) + F.tid; idx < total; idx += F.G * NWAVES * 64) {
        const int e = idx & 3, ln = (idx >> 2) & 63, rest = idx >> 8, nt = rest % NT, s = rest / NT;
        const int k = 32 * (s >> 1) + 8 * (ln >> 4) + 4 * (s & 1) + e, col = 16 * nt + (ln & 15);
        float v = 0.f;
        if (col < na) v = Wa[(size_t)k * lda + ca0 + col]; else if (col < na + nb) v = Wb[(size_t)k * ldb + (col - na)];
        Wp[idx] = v * gain[k];
    }
}

__device__ __forceinline__ void pack_proj16(Frame& F, bf16_t* Wp, int NT, const float* gain, const float* Wa, int lda, int ca0, int na, const float* Wb, int ldb, int nb) {
    const int total = 64 * NT * 64 * 8;
    for (int idx = (F.vcu * NWAVES * 64) + F.tid; idx < total; idx += F.G * NWAVES * 64) {
        const int j = idx & 7, ln = (idx >> 3) & 63, rest = idx >> 9, nt = rest % NT, s = rest / NT;
        const int k = 32 * s + 8 * (ln >> 4) + j, col = 16 * nt + (ln & 15);
        float v = 0.f;
        if (col < na) v = Wa[(size_t)k * lda + ca0 + col]; else if (col < na + nb) v = Wb[(size_t)k * ldb + (col - na)];
        v *= gain[k];
        const unsigned hi = cvt_pk_bf16(v, 0.f) & 0xffffu; const float rem = v - __uint_as_float(hi << 16); const unsigned lo = cvt_pk_bf16(rem, 0.f) & 0xffffu;
        const size_t base = ((size_t)((s * NT + nt) * 2) * 64 + ln) * 8 + j;
        Wp[base] = (bf16_t)hi; Wp[base + 64 * 8] = (bf16_t)lo;
    }
}
template <int NT>
__device__ __forceinline__ float wave_proj16b(LAS unsigned char* lds, const bf16_t* xin, int tok0, const bf16_t* Wp, int tid, int wid, int lane, f32x4 (&acc)[NT]) {
    static_assert(NT == 3, "chunk = 24 KiB = 3 DMA instructions per thread");
    const int tr = lane & 15, kq = lane >> 4;
    const u32x4* xp = (const u32x4*)(xin + (size_t)(tok0 + tr) * D) + kq;
    constexpr int CH = 4 * NT * 2 * 1024;
    const char* wsrc = (const char*)Wp + tid * 16;
    float ssq = 0.f;
#pragma unroll
    for (int n = 0; n < NT; ++n) acc[n] = (f32x4){0.f, 0.f, 0.f, 0.f};
    u32x4 X[4];
#define NB_DMA(c, buf) do { _Pragma("unroll") for (int r = 0; r < 3; ++r) \
        __builtin_amdgcn_global_load_lds((const unsigned*)(wsrc + (size_t)(c) * CH + r * 8192), (LAS unsigned*)(lds + (buf) * CH + r * 8192 + wid * 1024), 16, 0, 0); } while (0)
#define NB_CHUNK(c, buf, more) do { \
        asm volatile("s_waitcnt vmcnt(4)" ::: "memory"); WG_BAR(); \
        if (more) NB_DMA((c) + 1, 1 - (buf)); \
        asm volatile("" ::: "memory"); \
        const u32x4* xn_ = xp + 16 * ((c) + 1); \
        _Pragma("unroll") for (int s = 0; s < 4; ++s) { const u32x4 xw = X[s]; if (more) X[s] = xn_[4 * s]; \
            _Pragma("unroll") for (int q = 0; q < 4; ++q) { const float a_ = bf_lo(xw[q]), b_ = bf_hi(xw[q]); ssq += a_ * a_ + b_ * b_; } \
            const bf16x8 xa = __builtin_bit_cast(bf16x8, xw); \
            _Pragma("unroll") for (int n = 0; n < NT; ++n) _Pragma("unroll") for (int pc = 0; pc < 2; ++pc) { \
                const bf16x8 wv = *(const LAS bf16x8*)(lds + (buf) * CH + (((s * NT + n) * 2 + pc) * 64 + lane) * 16); \
                acc[n] = __builtin_amdgcn_mfma_f32_16x16x32_bf16(xa, wv, acc[n], 0, 0, 0); } } } while (0)
    NB_DMA(0, 0);
    asm volatile("" ::: "memory");
#pragma unroll
    for (int s = 0; s < 4; ++s) X[s] = xp[4 * s];
    for (int c = 0; c < 14; c += 2) { NB_CHUNK(c, 0, true); NB_CHUNK(c + 1, 1, true); }
    NB_CHUNK(14, 0, true); NB_CHUNK(15, 1, false);
    WG_BAR();
#undef NB_DMA
#undef NB_CHUNK
    ssq += __shfl_xor(ssq, 16); ssq += __shfl_xor(ssq, 32);
    return 1.0f / sqrtf(ssq * (1.0f / D) + RMS_EPS);
}
template <int NT, bool XB16 = false>
__device__ __forceinline__ float wave_proj16(LAS unsigned char* lds, const void* xin, int tok0, const float* Wp, int tid, int wid, int lane, f32x4 (&acc)[NT], bf16_t* xb16) {
    typedef typename XRow<XB16>::T XT;
    const int tr = lane & 15, kq = lane >> 4;
    const XT* xp = (const XT*)xin + (size_t)(tok0 + tr) * (D / 4) + 2 * kq;
    u32x4* hb = (u32x4*)(xb16 + (size_t)(tok0 + tr) * D) + kq;
    constexpr int CH = 16 * NT * 1024;
    const char* wsrc = (const char*)Wp + tid * 16;
    float ssq = 0.f;
#pragma unroll
    for (int n = 0; n < NT; ++n) acc[n] = (f32x4){0.f, 0.f, 0.f, 0.f};
    XT X[16];
#define NP_DMA(c, buf) do { _Pragma("unroll") for (int r = 0; r < 2 * NT; ++r) \
        __builtin_amdgcn_global_load_lds((const unsigned*)(wsrc + (size_t)(c) * CH + r * 8192), (LAS unsigned*)(lds + (buf) * CH + r * 8192 + wid * 1024), 16, 0, 0); } while (0)
#define NP_CHUNK(c, buf, more) do { \
        asm volatile("s_waitcnt vmcnt(16)" ::: "memory"); WG_BAR(); \
        if (more) NP_DMA((c) + 1, 1 - (buf)); \
        asm volatile("" ::: "memory");     \
        const XT* xn_ = xp + 64 * ((c) + 1); \
        _Pragma("unroll") for (int s = 0; s < 16; ++s) { const f32x4 xv = XRow<XB16>::get(X[s]); \
            if (s & 1) { const f32x4 xl_ = XRow<XB16>::get(X[s - 1]); u32x4 w_; w_.x = cvt_pk_bf16(xl_[0], xl_[1]); w_.y = cvt_pk_bf16(xl_[2], xl_[3]); w_.z = cvt_pk_bf16(xv[0], xv[1]); w_.w = cvt_pk_bf16(xv[2], xv[3]); \
                hb[32 * (c) + 4 * (s >> 1)] = w_; if (more) { X[s - 1] = xn_[8 * (s >> 1)]; X[s] = xn_[8 * (s >> 1) + 1]; } } \
            ssq += (xv[0] * xv[0] + xv[1] * xv[1]) + (xv[2] * xv[2] + xv[3] * xv[3]); \
            _Pragma("unroll") for (int n = 0; n < NT; ++n) { const f32x4 wv = *(const LAS f32x4*)(lds + (buf) * CH + ((s * NT + n) * 64 + lane) * 16); \
                _Pragma("unroll") for (int e = 0; e < 4; ++e) acc[n] = __builtin_amdgcn_mfma_f32_16x16x4f32(xv[e], wv[e], acc[n], 0, 0, 0); } } } while (0)
    NP_DMA(0, 0);
    asm volatile("" ::: "memory");
#pragma unroll
    for (int s = 0; s < 16; ++s) X[s] = xp[8 * (s >> 1) + (s & 1)];
    for (int c = 0; c < 6; c += 2) { NP_CHUNK(c, 0, true); NP_CHUNK(c + 1, 1, true); }
    NP_CHUNK(6, 0, true); NP_CHUNK(7, 1, false);
    WG_BAR();
#undef NP_DMA
#undef NP_CHUNK
    ssq += __shfl_xor(ssq, 16); ssq += __shfl_xor(ssq, 32);
    return 1.0f / sqrtf(ssq * (1.0f / D) + RMS_EPS);
}
template <bool FP8 = false, bool XB16 = false>
__device__ __forceinline__ void wave_write_hn16(const void* xin, int tok0, float rstd, const float* gain, bf16_t* hn, int lane) {
    typedef typename XRow<XB16>::T XT;
    f32x4 g4[8];
#pragma unroll
    for (int j = 0; j < 8; ++j) g4[j] = ((const f32x4*)gain)[lane + 64 * j];
    for (int i = 0; i < 16; i += 2) {
        const float r0 = __shfl(rstd, i), r1 = __shfl(rstd, i + 1);
        const XT* x0 = (const XT*)xin + (size_t)(tok0 + i) * (D / 4); const XT* x1 = x0 + D / 4;
        u32x2* o0 = (u32x2*)(hn + (size_t)(tok0 + i) * D); u32x2* o1 = o0 + D / 4;
        unsigned* p0 = (unsigned*)((unsigned char*)hn + (size_t)(tok0 + i) * D); unsigned* p1 = p0 + D / 4;
        XT a[8], c[8];
#pragma unroll
        for (int j = 0; j < 8; ++j) { a[j] = x0[lane + 64 * j]; c[j] = x1[lane + 64 * j]; }
#pragma unroll
        for (int j = 0; j < 8; ++j) { const f32x4 v = XRow<XB16>::get(a[j]) * r0 * g4[j], u = XRow<XB16>::get(c[j]) * r1 * g4[j];
            if constexpr (FP8) { p0[lane + 64 * j] = cvt4_fp8(v[0], v[1], v[2], v[3]); p1[lane + 64 * j] = cvt4_fp8(u[0], u[1], u[2], u[3]); }
            else { u32x2 w; w.x = cvt_pk_bf16(v[0], v[1]); w.y = cvt_pk_bf16(v[2], v[3]); o0[lane + 64 * j] = w;
                u32x2 z; z.x = cvt_pk_bf16(u[0], u[1]); z.y = cvt_pk_bf16(u[2], u[3]); o1[lane + 64 * j] = z; } }
    }
}

__device__ __forceinline__ void phase_norm_gz(Frame& F, const float* xin, const float* Wp, bf16_t* hn, float* gz, float* rstd_tab) {
    for (int tile = F.vcu; tile < T / 128; tile += F.G) {
        const int tok0 = tile * 128 + F.wave * 16;
        f32x4 acc[1];
        const float rstd = wave_proj16<1>(F.lds, xin, tok0, Wp, F.tid, F.wave, F.lane, acc, hn);
        if (F.lane < 16) rstd_tab[tok0 + F.lane] = rstd;
        const int j = F.lane & 15, q4 = F.lane >> 4;
#pragma unroll
        for (int r = 0; r < 4; ++r) { const float rr = __shfl(rstd, 4 * q4 + r); gz[(size_t)(tok0 + 4 * q4 + r) * 16 + j] = acc[0][r] * rr; }
    }
}
__device__ __forceinline__ void phase_norm_route(Frame& F, const bf16_t* xin, const float* gain, const float* Wp, bf16_t* hn, int* tok_e, int* tok_p, float* tok_w, unsigned* cnt) {
    LAS float* lg = (LAS float*)(F.lds + 98304 + F.wave * 3072);
    for (int tile = F.vcu; tile < T / 128; tile += F.G) {
        const int tok0 = tile * 128 + F.wave * 16;
        f32x4 acc[3];
        const float rstd = wave_proj16b<3>(F.lds, xin, tok0, (const bf16_t*)Wp, F.tid, F.wave, F.lane, acc);
        const int j = F.lane & 15, q4 = F.lane >> 4;
#pragma unroll
        for (int r = 0; r < 4; ++r) { const float rr = __shfl(rstd, 4 * q4 + r);
#pragma unroll
            for (int n = 0; n < 3; ++n) lg[(4 * q4 + r) * 48 + 16 * n + j] = acc[n][r] * rr; }
        LDS_WAIT(); asm volatile("" ::: "memory");
        if (F.lane < 16) {
            const LAS float* l = lg + F.lane * 48;
            float gm = l[0]; int gi = 0;
#pragma unroll
            for (int q = 1; q < 4; ++q) { const float v = l[q]; if (v > gm) { gm = v; gi = q; } }
            float gs = 0.f;
#pragma unroll
            for (int q = 0; q < 4; ++q) gs += __expf(l[q] - gm);
            const float gw = 1.0f / gs;
            const LAS float* se = l + 4 + 8 * gi;
            float m1 = se[0]; int i1 = 0;
#pragma unroll
            for (int q = 1; q < 8; ++q) { const float v = se[q]; if (v > m1) { m1 = v; i1 = q; } }
            float m2 = -3.0e38f; int i2 = 0;
#pragma unroll
            for (int q = 0; q < 8; ++q) { const float v = se[q]; if (q != i1 && v > m2) { m2 = v; i2 = q; } }
            const float eb = __expf(m2 - m1), inv = 1.0f / (1.0f + eb);
            const int t = tok0 + F.lane, e1 = gi * 8 + i1, e2 = gi * 8 + i2;
            const unsigned p1 = __hip_atomic_fetch_add(cnt + 64 * e1, 1u, __ATOMIC_RELAXED, __HIP_MEMORY_SCOPE_AGENT);
            const unsigned p2 = __hip_atomic_fetch_add(cnt + 64 * e2, 1u, __ATOMIC_RELAXED, __HIP_MEMORY_SCOPE_AGENT);
            tok_e[2 * t] = e1; tok_e[2 * t + 1] = e2; tok_p[2 * t] = (int)p1; tok_p[2 * t + 1] = (int)p2;
            tok_w[2 * t] = gw * inv; tok_w[2 * t + 1] = gw * eb * inv;
        }
        wave_write_hn16<true, true>(xin, tok0, rstd, gain, hn, F.lane);
        LDS_WAIT(); asm volatile("" ::: "memory");
    }
}

__device__ __forceinline__ void phase_gla_gate(Frame& F, const float* gz, const float* wgu, const float* bgate, const bf16_t* proj, bf16_t* kdT, float* adec) {
    LAS f32x4* gzs = (LAS f32x4*)F.lds;
    for (int u = F.vcu; u < NBATCH * NCH * 2; u += F.G) {
        const int half = u & 1, bc = u >> 1;
        const int tok0 = bc * 64, j = half * 512 + F.tid;
        if (F.tid < 256) gzs[F.tid] = ((const f32x4*)(gz + (size_t)tok0 * 16))[F.tid];
        float wg[16];
#pragma unroll
        for (int r = 0; r < 16; ++r) wg[r] = wgu[r * GLA_DKT + j];
        const float bg = bgate[j];
        WG_BAR();
        float cum[64]; float run = 0.f;
#pragma unroll
        for (int t = 0; t < 64; ++t) {
            float z = bg;
#pragma unroll
            for (int r4 = 0; r4 < 4; ++r4) { const f32x4 g4 = gzs[t * 4 + r4]; z += g4[0] * wg[4 * r4] + g4[1] * wg[4 * r4 + 1] + g4[2] * wg[4 * r4 + 2] + g4[3] * wg[4 * r4 + 3]; }
            const float ls = fminf(z, 0.f) - __logf(1.0f + __expf(-fabsf(z)));
            run += ls * (1.0f / 16.0f); cum[t] = run;
        }
        adec[(size_t)bc * GLA_DKT + j] = __expf(run);
        const bf16_t* kp = proj + GK0 + gq_off(bc >> 8, (bc & 255) * 64, j >> 8) + (j & 255);
        u32x4* dst = (u32x4*)(kdT + ((size_t)bc * GLA_DKT + j) * 64);
#pragma unroll
        for (int t8 = 0; t8 < 8; ++t8) {
            float kd[8];
#pragma unroll
            for (int q = 0; q < 8; ++q) { const int t = t8 * 8 + q; kd[q] = bf2f(kp[(size_t)t * 256]) * __expf(run - cum[t]); }
            u32x4 w; w.x = cvt_pk_bf16(kd[0], kd[1]); w.y = cvt_pk_bf16(kd[2], kd[3]); w.z = cvt_pk_bf16(kd[4], kd[5]); w.w = cvt_pk_bf16(kd[6], kd[7]);
            dst[t8] = w;
        }
        WG_BAR();
    }
}

constexpr int SCAN_VROW = 144, SCAN_SROW = 528, SCAN_VBUF = 64 * SCAN_VROW, SCAN_SBUF = 64 * SCAN_SROW;
__device__ __forceinline__ void phase_gla_scan(Frame& F, int it, const bf16_t* proj, const bf16_t* kdT, const float* adec, bf16_t* oout, bf16_t* sfin) {
    const int lane = F.lane, w = F.wave, fr = lane & 15, kq = lane >> 4, tid = F.tid;
    LAS unsigned char* vbuf = F.lds;
    LAS unsigned char* sbuf = F.lds + 2 * SCAN_VBUF;
    const int bh = it >> 4, seg = (it >> 3) & 1, b = bh >> 2, h = bh & 3, sl = it & 7, mt = w & 3, ntp = w >> 2, c0 = seg * (NCH / 2);
    const size_t tokb = (size_t)b * SEQ;
    f32x4 st[2][4];
#pragma unroll
    for (int i = 0; i < 2; ++i)
#pragma unroll
        for (int n = 0; n < 4; ++n) st[i][n] = (f32x4){0.f, 0.f, 0.f, 0.f};
    bf16x8 ka0[2][2], ka1[2][2], q0[8], q1[8]; f32x4 dc0[2], dc1[2]; u32x4 vr0, vr1;
#define CL(c) ((c) < NCH ? (c) : NCH - 1)
#define LOAD_KA(KA, DC, c) do { const size_t bc_ = (size_t)b * NCH + CL(c); \
        _Pragma("unroll") for (int i = 0; i < 2; ++i) { \
            _Pragma("unroll") for (int s = 0; s < 2; ++s) KA[i][s] = *(const bf16x8*)(kdT + ((bc_ * GLA_DKT + h * 256 + 32 * w + 16 * i + fr) * 64 + 32 * s + 8 * kq)); \
            DC[i] = *(const f32x4*)(adec + bc_ * GLA_DKT + h * 256 + 32 * w + 16 * i + 4 * kq); } } while (0)
#define LOAD_V(VR, c) do { VR = *(const u32x4*)(proj + gv_off(b, CL(c) * 64 + (tid >> 3), h) + 64 * sl + 8 * (tid & 7)); } while (0)
#define LOAD_Q(Q, c) do { const bf16_t* qp_ = proj + gq_off(b, CL(c) * 64 + 16 * mt + fr, h) + 8 * kq; \
        _Pragma("unroll") for (int s = 0; s < 8; ++s) Q[s] = *(const bf16x8*)(qp_ + 32 * s); } while (0)
#define STORE_V(VR, buf) do { *(LAS u32x4*)(vbuf + (buf) * SCAN_VBUF + (tid >> 3) * SCAN_VROW + (tid & 7) * 16) = VR; } while (0)
#define SCAN_STEP(KA, DC, VN, VM, QC, QN, c) do { \
        const unsigned vb_ = (unsigned)(uintptr_t)(vbuf + ((c) & 1) * SCAN_VBUF) + (unsigned)((8 * kq + ((lane & 15) >> 2)) * SCAN_VROW + 8 * (lane & 3)); \
        s16x4 tv[4][4];     \
        asm volatile("ds_read_b64_tr_b16 %0, %16 offset:0\n\tds_read_b64_tr_b16 %1, %16 offset:576\n\tds_read_b64_tr_b16 %2, %16 offset:4608\n\tds_read_b64_tr_b16 %3, %16 offset:5184\n\t" \
                     "ds_read_b64_tr_b16 %4, %16 offset:32\n\tds_read_b64_tr_b16 %5, %16 offset:608\n\tds_read_b64_tr_b16 %6, %16 offset:4640\n\tds_read_b64_tr_b16 %7, %16 offset:5216\n\t" \
                     "ds_read_b64_tr_b16 %8, %16 offset:64\n\tds_read_b64_tr_b16 %9, %16 offset:640\n\tds_read_b64_tr_b16 %10, %16 offset:4672\n\tds_read_b64_tr_b16 %11, %16 offset:5248\n\t" \
                     "ds_read_b64_tr_b16 %12, %16 offset:96\n\tds_read_b64_tr_b16 %13, %16 offset:672\n\tds_read_b64_tr_b16 %14, %16 offset:4704\n\tds_read_b64_tr_b16 %15, %16 offset:5280\n\ts_waitcnt lgkmcnt(0)" \
                     : "=&v"(tv[0][0]), "=&v"(tv[0][1]), "=&v"(tv[0][2]), "=&v"(tv[0][3]), "=&v"(tv[1][0]), "=&v"(tv[1][1]), "=&v"(tv[1][2]), "=&v"(tv[1][3]), \
                       "=&v"(tv[2][0]), "=&v"(tv[2][1]), "=&v"(tv[2][2]), "=&v"(tv[2][3]), "=&v"(tv[3][0]), "=&v"(tv[3][1]), "=&v"(tv[3][2]), "=&v"(tv[3][3]) : "v"(vb_) : "memory"); \
        _Pragma("unroll") for (int n = 0; n < 4; ++n) { \
            const bf16x8 vf0 = (bf16x8){tv[n][0][0], tv[n][0][1], tv[n][0][2], tv[n][0][3], tv[n][1][0], tv[n][1][1], tv[n][1][2], tv[n][1][3]}; \
            const bf16x8 vf1 = (bf16x8){tv[n][2][0], tv[n][2][1], tv[n][2][2], tv[n][2][3], tv[n][3][0], tv[n][3][1], tv[n][3][2], tv[n][3][3]}; \
            _Pragma("unroll") for (int i = 0; i < 2; ++i) { \
                st[i][n] = st[i][n] * DC[i]; \
                st[i][n] = __builtin_amdgcn_mfma_f32_16x16x32_bf16(KA[i][0], vf0, st[i][n], 0, 0, 0); \
                st[i][n] = __builtin_amdgcn_mfma_f32_16x16x32_bf16(KA[i][1], vf1, st[i][n], 0, 0, 0); } } \
        LOAD_KA(KA, DC, (c) + 2); \
        { LAS unsigned char* sb_ = sbuf + ((c) & 1) * SCAN_SBUF + fr * SCAN_SROW + (32 * w + 4 * kq) * 2; \
          _Pragma("unroll") for (int i = 0; i < 2; ++i) _Pragma("unroll") for (int n = 0; n < 4; ++n) { \
              u32x2 pk; pk.x = cvt_pk_bf16(st[i][n][0], st[i][n][1]); pk.y = cvt_pk_bf16(st[i][n][2], st[i][n][3]); \
              *(LAS u32x2*)(sb_ + n * 16 * SCAN_SROW + i * 32) = pk; } } \
        STORE_V(VN, ((c) + 1) & 1); \
        LOAD_V(VN, (c) + 3); \
        WG_BAR(); \
        { f32x4 a0 = (f32x4){0.f, 0.f, 0.f, 0.f}, a1 = a0; \
          const LAS unsigned char* sr_ = sbuf + ((c) & 1) * SCAN_SBUF + (32 * ntp + fr) * SCAN_SROW + 16 * kq; \
          _Pragma("unroll") for (int hb = 0; hb < 2; ++hb) { bf16x8 bb[4][2];     \
              _Pragma("unroll") for (int s = 0; s < 4; ++s) { bb[s][0] = *(const LAS bf16x8*)(sr_ + 64 * (4 * hb + s)); bb[s][1] = *(const LAS bf16x8*)(sr_ + 16 * SCAN_SROW + 64 * (4 * hb + s)); } \
              asm volatile("s_waitcnt lgkmcnt(0)" ::: "memory"); __builtin_amdgcn_sched_barrier(0); \
              _Pragma("unroll") for (int s = 0; s < 4; ++s) { \
                  a0 = __builtin_amdgcn_mfma_f32_16x16x32_bf16(QC[4 * hb + s], bb[s][0], a0, 0, 0, 0); \
                  a1 = __builtin_amdgcn_mfma_f32_16x16x32_bf16(QC[4 * hb + s], bb[s][1], a1, 0, 0, 0); } } \
          bf16_t* op_ = oout + (tokb + (size_t)(c) * 64 + 16 * mt + 4 * kq) * D + h * 512 + 64 * sl + 32 * ntp + fr; \
          _Pragma("unroll") for (int r = 0; r < 4; ++r) { \
              const float x0 = a0[r] * 0.0625f, x1 = a1[r] * 0.0625f, y0 = __shfl_xor(x0, 1), y1 = __shfl_xor(x1, 1); \
              if ((fr & 1) == 0) { *(unsigned*)(op_ + (size_t)r * D) = cvt_pk_bf16(x0, y0); *(unsigned*)(op_ + (size_t)r * D + 16) = cvt_pk_bf16(x1, y1); } } } \
        LOAD_Q(QC, (c) + 2); \
    } while (0)
    LOAD_KA(ka0, dc0, c0); LOAD_KA(ka1, dc1, c0 + 1); LOAD_V(vr0, c0); LOAD_V(vr1, c0 + 1); LOAD_Q(q0, c0); LOAD_Q(q1, c0 + 1);
    STORE_V(vr0, 0); LOAD_V(vr0, c0 + 2);
    WG_BAR();
    for (int c = c0; c < c0 + NCH / 2; c += 2) {
        SCAN_STEP(ka0, dc0, vr1, vr0, q0, q1, c);
        SCAN_STEP(ka1, dc1, vr0, vr1, q1, q0, c + 1);
    }
    if (seg == 0) {
#pragma unroll
        for (int i = 0; i < 2; ++i)
#pragma unroll
            for (int n = 0; n < 4; ++n) { u32x2 pk; pk.x = cvt_pk_bf16(st[i][n][0], st[i][n][1]); pk.y = cvt_pk_bf16(st[i][n][2], st[i][n][3]);
                *(u32x2*)(sfin + ((size_t)(bh * 512 + 64 * sl + 16 * n + fr)) * 256 + 32 * w + 16 * i + 4 * kq) = pk; }
    }
    WG_BAR();
#undef CL
#undef LOAD_KA
#undef LOAD_V
#undef LOAD_Q
#undef STORE_V
#undef SCAN_STEP
}

__device__ __forceinline__ void gla_pcum(Frame& F, const float* adec, float* pcum, int rank, int nrank) {
    for (int idx = rank * (NWAVES * 64) + F.tid; idx < NBATCH * GLA_DKT; idx += nrank * NWAVES * 64) { const int b = idx >> 10, j = idx & 1023;
        const float* ap = adec + ((size_t)(b * NCH + NCH / 2)) * GLA_DKT + j; float* pp = pcum + (size_t)(b * (NCH / 2)) * GLA_DKT + j; float pr = 1.f;
#pragma unroll 16
        for (int cc = 0; cc < NCH / 2; ++cc) { pr *= ap[(size_t)cc * GLA_DKT]; pp[(size_t)cc * GLA_DKT] = pr; } }
}
__device__ __forceinline__ void phase_gla_qp(Frame& F, const bf16_t* proj, const float* pcum, bf16_t* qp) {
    const int gw = F.vcu * NWAVES + F.wave, NGW = F.G * NWAVES, lane = F.lane;
    for (int r = gw; r < NBATCH * (SEQ / 2); r += NGW) { const int b = r >> 13, t = r & 8191;
        u32x2 qv[4]; f32x4 pv[4];
#pragma unroll
        for (int h = 0; h < 4; ++h) { qv[h] = *(const u32x2*)(proj + gq_off(b, SEQ / 2 + t, h) + 4 * lane); pv[h] = *(const f32x4*)(pcum + ((size_t)(b * (NCH / 2) + (t >> 6)) * GLA_DKT + h * 256 + 4 * lane)); }
#pragma unroll
        for (int h = 0; h < 4; ++h) { u32x2 w; w.x = cvt_pk_bf16(bf_lo(qv[h].x) * pv[h][0], bf_hi(qv[h].x) * pv[h][1]); w.y = cvt_pk_bf16(bf_lo(qv[h].y) * pv[h][2], bf_hi(qv[h].y) * pv[h][3]);
            *(u32x2*)(qp + ((size_t)((b * 4 + h) * (SEQ / 2) + t)) * 256 + 4 * lane) = w; }
    }
}
__device__ __forceinline__ void phase_gla_gnorm(Frame& F, const bf16_t* o, const bf16_t* proj, const float* gn, bf16_t* y) {
    const int gw = F.vcu * NWAVES + F.wave, NGW = F.G * NWAVES, lane = F.lane;
    const f32x4 g0 = ((const f32x4*)gn)[2 * lane], g1 = ((const f32x4*)gn)[2 * lane + 1];
    for (int tok = gw; tok < T; tok += NGW) {
        u32x4 ov[4], rv[4];
#pragma unroll
        for (int h = 0; h < 4; ++h) { ov[h] = *(const u32x4*)(o + (size_t)tok * D + h * 512 + 8 * lane); rv[h] = *(const u32x4*)(proj + GR0 + (size_t)tok * 2048 + h * 512 + 8 * lane); }
        float ss[4];
#pragma unroll
        for (int h = 0; h < 4; ++h) { float s = 0.f;
#pragma unroll
            for (int q = 0; q < 4; ++q) { const float lo = bf_lo(ov[h][q]), hi = bf_hi(ov[h][q]); s += lo * lo + hi * hi; }
            ss[h] = s; }
#pragma unroll
        for (int of = 1; of < 64; of <<= 1) {
#pragma unroll
            for (int h = 0; h < 4; ++h) ss[h] += __shfl_xor(ss[h], of); }
#pragma unroll
        for (int h = 0; h < 4; ++h) { const float rstd = 1.0f / sqrtf(ss[h] * (1.0f / 512.0f) + RMS_EPS);
            float yv[8];
#pragma unroll
            for (int q = 0; q < 4; ++q) { const float a0 = bf_lo(ov[h][q]), a1 = bf_hi(ov[h][q]), r0 = bf_lo(rv[h][q]), r1 = bf_hi(rv[h][q]);
                const float gA = q < 2 ? g0[2 * q] : g1[2 * q - 4], gB = q < 2 ? g0[2 * q + 1] : g1[2 * q - 3];
                yv[2 * q] = a0 * rstd * gA * (r0 / (1.0f + __expf(-r0))); yv[2 * q + 1] = a1 * rstd * gB * (r1 / (1.0f + __expf(-r1))); }
            u32x4 w; w.x = cvt_pk_bf16(yv[0], yv[1]); w.y = cvt_pk_bf16(yv[2], yv[3]); w.z = cvt_pk_bf16(yv[4], yv[5]); w.w = cvt_pk_bf16(yv[6], yv[7]);
            *(u32x4*)(y + (size_t)tok * D + h * 512 + 8 * lane) = w; }
    }
}

__device__ __forceinline__ void moe_tables(Frame& F, unsigned* cnt) {
    LAS int* pst = (LAS int*)(F.lds + TAB_OFF);
    LAS int* te = pst + 36;
    if (F.wave == 0) {
        const int e = F.lane & 31;
        const int c = (int)xb_ld(cnt + 64 * e);
        const int ntile = (c + 255) >> 8;
        int incl = ntile;
#pragma unroll
        for (int o = 1; o < 32; o <<= 1) { const int v = __shfl_up(incl, o); if ((F.lane & 31) >= o) incl += v; }
        const int excl = incl - ntile;
        if (F.lane < 32) { pst[e] = excl << 8; for (int q = 0; q < ntile; ++q) te[excl + q] = e; }
        if (F.lane == 31) { pst[32] = incl << 8; pst[33] = incl; }
    }
    WG_BAR();
}
__device__ __forceinline__ void phase_moe_slots(Frame& F, const int* tok_e, const int* tok_p, unsigned* cnt, int* slot_of, int* slot_tok) {
    const LAS int* pst = (const LAS int*)(F.lds + TAB_OFF);
    for (int e = F.vcu; e < NEXP; e += F.G) { const int c = (int)xb_ld(cnt + 64 * e), lo = pst[e] + c, hi = pst[e] + (((c + 255) >> 8) << 8);
        for (int s = lo + F.tid; s < hi; s += NWAVES * 64) slot_tok[s] = -1; }
    for (int a = F.vcu * NWAVES * 64 + F.tid; a < 2 * T; a += F.G * NWAVES * 64) { const int slot = pst[tok_e[a]] + tok_p[a]; slot_of[a] = slot; slot_tok[slot] = a >> 1; }
}
__device__ __forceinline__ void phase_moe_copy8(Frame& F, const int* tok_e, const int* tok_p, const unsigned char* hn8, unsigned char* ag8) {
    const LAS int* pst = (const LAS int*)(F.lds + TAB_OFF);
    const int gw = F.vcu * NWAVES + F.wave, NGW = F.G * NWAVES, lane = F.lane;
    for (int t = gw; t < T; t += NGW) {
        const int s0 = pst[tok_e[2 * t]] + tok_p[2 * t], s1 = pst[tok_e[2 * t + 1]] + tok_p[2 * t + 1];
        const u32x4* src = (const u32x4*)(hn8 + (size_t)t * D); const u32x4 v0 = src[lane], v1 = src[lane + 64];
        u32x4* d0 = (u32x4*)(ag8 + (size_t)s0 * D); u32x4* d1 = (u32x4*)(ag8 + (size_t)s1 * D);
        d0[lane] = v0; d0[lane + 64] = v1; d1[lane] = v0; d1[lane + 64] = v1;
    }
}
template <int MODE>
__device__ __forceinline__ void phase_moe_combine(Frame& F, bf16_t* x, float* out, const bf16_t* ob, const int* slot_of, const float* tok_w, const float* gain, bf16_t* hn) {
    const int gw = F.vcu * NWAVES + F.wave, NGW = F.G * NWAVES, lane = F.lane;
    f32x4 g4[8];
#pragma unroll
    for (int j = 0; j < 8; ++j) g4[j] = ((const f32x4*)gain)[lane + 64 * j];
    for (int t = gw; t < T; t += NGW) {
        const int s0 = slot_of[2 * t], s1 = slot_of[2 * t + 1]; const float w0 = tok_w[2 * t] * 0.125f, w1 = tok_w[2 * t + 1] * 0.125f;
        u32x2* xr = (u32x2*)(x + (size_t)t * D);
        const unsigned* a = (const unsigned*)((const unsigned char*)ob + (size_t)s0 * D); const unsigned* b = (const unsigned*)((const unsigned char*)ob + (size_t)s1 * D);
        f32x4 v[8]; float ss = 0.f;
#pragma unroll
        for (int j = 0; j < 8; ++j) { const int av = (int)a[lane + 64 * j], bv = (int)b[lane + 64 * j]; f32x4 xv = bf4_expand(xr[lane + 64 * j]);
            xv[0] += w0 * __builtin_amdgcn_cvt_f32_fp8(av, 0) + w1 * __builtin_amdgcn_cvt_f32_fp8(bv, 0); xv[1] += w0 * __builtin_amdgcn_cvt_f32_fp8(av, 1) + w1 * __builtin_amdgcn_cvt_f32_fp8(bv, 1);
            xv[2] += w0 * __builtin_amdgcn_cvt_f32_fp8(av, 2) + w1 * __builtin_amdgcn_cvt_f32_fp8(bv, 2); xv[3] += w0 * __builtin_amdgcn_cvt_f32_fp8(av, 3) + w1 * __builtin_amdgcn_cvt_f32_fp8(bv, 3);
            v[j] = xv; ss += (xv[0] * xv[0] + xv[1] * xv[1]) + (xv[2] * xv[2] + xv[3] * xv[3]); }
        const float rstd = 1.0f / sqrtf(wave_sum(ss) * (1.0f / D) + RMS_EPS);
        if (MODE == 0) {
            unsigned* orow = (unsigned*)((unsigned char*)hn + (size_t)t * D);
#pragma unroll
            for (int j = 0; j < 8; ++j) { u32x2 w; w.x = cvt_pk_bf16(v[j][0], v[j][1]); w.y = cvt_pk_bf16(v[j][2], v[j][3]); xr[lane + 64 * j] = w;
                const f32x4 y = v[j] * rstd * g4[j]; orow[lane + 64 * j] = cvt4_fp8(y[0], y[1], y[2], y[3]); }
        } else {
            f32x4* orow = (f32x4*)(out + (size_t)t * D);
#pragma unroll
            for (int j = 0; j < 8; ++j) orow[lane + 64 * j] = v[j] * rstd * g4[j];
        }
    }
}

__device__ __forceinline__ void phase_subln(Frame& F, const bf16_t* o1, const bf16_t* o2, const float* lq1, const float* lk1, const float* lq2, const float* lk2, const float* sg, bf16_t* y) {
    const int gw = F.vcu * NWAVES + F.wave, NGW = F.G * NWAVES, lane = F.lane;
    const float d1 = wave_sum(lq1[lane] * lk1[lane] + lq1[lane + 64] * lk1[lane + 64]);
    const float d2 = wave_sum(lq2[lane] * lk2[lane] + lq2[lane + 64] * lk2[lane + 64]);
    const float lam = __expf(d1) - __expf(d2) + LAMBDA_INIT;
    const f32x4 g = ((const f32x4*)sg)[lane] * (1.0f - LAMBDA_INIT);
    for (int tok = gw; tok < T; tok += NGW) {
        u32x2 a[8], b[8];
#pragma unroll
        for (int h = 0; h < 8; ++h) { a[h] = *(const u32x2*)(o1 + (size_t)tok * D + h * 256 + 4 * lane); b[h] = *(const u32x2*)(o2 + (size_t)tok * D + h * 256 + 4 * lane); }
        f32x4 d[8]; float ss[8];
#pragma unroll
        for (int h = 0; h < 8; ++h) { d[h][0] = bf_lo(a[h].x) - lam * bf_lo(b[h].x); d[h][1] = bf_hi(a[h].x) - lam * bf_hi(b[h].x); d[h][2] = bf_lo(a[h].y) - lam * bf_lo(b[h].y); d[h][3] = bf_hi(a[h].y) - lam * bf_hi(b[h].y);
            ss[h] = (d[h][0] * d[h][0] + d[h][1] * d[h][1]) + (d[h][2] * d[h][2] + d[h][3] * d[h][3]); }
#pragma unroll
        for (int of = 1; of < 64; of <<= 1) {
#pragma unroll
            for (int h = 0; h < 8; ++h) ss[h] += __shfl_xor(ss[h], of); }
#pragma unroll
        for (int h = 0; h < 8; ++h) { const float rstd = 1.0f / sqrtf(ss[h] * (1.0f / 256.0f) + RMS_EPS); const f32x4 yv = d[h] * rstd * g;
            *(unsigned*)((unsigned char*)y + (size_t)tok * D + h * 256 + 4 * lane) = cvt4_fp8(yv[0], yv[1], yv[2], yv[3]); }
    }
}

namespace att {
constexpr int SHM_K = 64 * 128, SHM_V = 256 * 64;
constexpr int NSLOT = 5, V_OFF = 0, K_OFF = NSLOT * SHM_V, SCR_OFF = RING_BYTES + 4096;
static_assert(K_OFF + NSLOT * SHM_K <= RING_BYTES, "attention slots");
constexpr float SCALE = 0.08838834764831845f;
constexpr float C2 = 1.4426950408889634f * SCALE;
constexpr float THR = 64.f;
__device__ __forceinline__ int crow(int r, int hi) { return (r & 3) + 8 * (r >> 2) + 4 * hi; }

__device__ __forceinline__ void qkt(f32x16& p0, f32x16& p1, const LAS unsigned char* kslot, int r32, int hi, const v8i32 (&qf)[2], const f32x16& bias) {
    const int sw = (r32 >> 1) & 7;
    const LAS unsigned char* ra = kslot + r32 * 128;
#pragma unroll
    for (int s = 0; s < 2; ++s) { const int c0 = 4 * s + 2 * hi;
        const v4i32 a0 = *(const LAS v4i32*)(ra + ((c0 ^ sw) << 4)), a1 = *(const LAS v4i32*)(ra + (((c0 + 1) ^ sw) << 4));
        const v4i32 b0 = *(const LAS v4i32*)(ra + 32 * 128 + ((c0 ^ sw) << 4)), b1 = *(const LAS v4i32*)(ra + 32 * 128 + (((c0 + 1) ^ sw) << 4));
        const v8i32 ka = __builtin_shufflevector(a0, a1, 0, 1, 2, 3, 4, 5, 6, 7), kb = __builtin_shufflevector(b0, b1, 0, 1, 2, 3, 4, 5, 6, 7);
        if (s == 0) {
            p0 = __builtin_amdgcn_mfma_scale_f32_32x32x64_f8f6f4(ka, qf[s], bias, 0, 0, 0, 0x7f7f7f7f, 0, 0x7f7f7f7f);
            p1 = __builtin_amdgcn_mfma_scale_f32_32x32x64_f8f6f4(kb, qf[s], bias, 0, 0, 0, 0x7f7f7f7f, 0, 0x7f7f7f7f);
            __builtin_amdgcn_sched_barrier(0); }
        else {
            p0 = __builtin_amdgcn_mfma_scale_f32_32x32x64_f8f6f4(ka, qf[s], p0, 0, 0, 0, 0x7f7f7f7f, 0, 0x7f7f7f7f);
            p1 = __builtin_amdgcn_mfma_scale_f32_32x32x64_f8f6f4(kb, qf[s], p1, 0, 0, 0, 0x7f7f7f7f, 0, 0x7f7f7f7f); } }
}
__device__ __forceinline__ void pv_tile(f32x16 (&o)[8], const LAS unsigned char* va, const v8i32& pa, int scl) {
    const LAS unsigned char* vb = (const LAS unsigned char*)((unsigned)(uintptr_t)va ^ 16u);
#define PV_RD(S, d0) do { S[0] = *(const LAS v4i32*)(va + (d0) * 2048); S[1] = *(const LAS v4i32*)(vb + (d0) * 2048); } while (0)
#define PV_MM(S, d0) do { __builtin_amdgcn_sched_barrier(0); \
        o[d0] = __builtin_amdgcn_mfma_scale_f32_32x32x64_f8f6f4(pa, __builtin_shufflevector(S[0], S[1], 0, 1, 2, 3, 4, 5, 6, 7), o[d0], 0, 0, 0, scl, 0, 0x7f7f7f7f); __builtin_amdgcn_sched_barrier(0); } while (0)
    v4i32 f0[2], f1[2];
    PV_RD(f0, 0);
    PV_RD(f1, 1); PV_MM(f0, 0); PV_RD(f0, 2); PV_MM(f1, 1); PV_RD(f1, 3); PV_MM(f0, 2); PV_RD(f0, 4); PV_MM(f1, 3); PV_RD(f1, 5); PV_MM(f0, 4); PV_RD(f0, 6); PV_MM(f1, 5); PV_RD(f1, 7); PV_MM(f0, 6);
    PV_MM(f1, 7);
#undef PV_MM
#undef PV_RD
}

__device__ __forceinline__ void stage_offsets(int tid, unsigned& koff, unsigned (&voff)[2]) {
    { const int P = tid * 16, row = P >> 7, ch = ((P & 127) >> 4) ^ ((row >> 1) & 7); koff = (unsigned)(row * 128 + ch * 16); }
#pragma unroll
    for (int i = 0; i < 2; ++i) { const int P = tid * 16 + i * 8192, row = P >> 6, ch = ((P & 63) >> 4) ^ ((row >> 2) & 3); voff[i] = (unsigned)(row * 64 + ch * 16); }
}
__device__ __forceinline__ const char* uniform_ptr(const void* p) {
    const unsigned long long v = (unsigned long long)p;
    const unsigned lo = __builtin_amdgcn_readfirstlane((unsigned)v), hi = __builtin_amdgcn_readfirstlane((unsigned)(v >> 32));
    return (const char*)(((unsigned long long)hi << 32) | lo);
}
__device__ __forceinline__ void stage_tile(LAS unsigned char* lds, int slot, const bf16_t* kj_, const bf16_t* vj_, int tid_, int wid) {
    const char* kj = uniform_ptr(kj_); const char* vj = uniform_ptr(vj_);
    int tid = tid_; asm volatile("" : "+v"(tid));
    unsigned koff, voff[2]; stage_offsets(tid, koff, voff);
    LAS unsigned char* kd = lds + K_OFF + slot * SHM_K + wid * 1024; LAS unsigned char* vd = lds + V_OFF + slot * SHM_V + wid * 1024;
    __builtin_amdgcn_global_load_lds((const unsigned*)(kj + koff), (LAS unsigned*)kd, 16, 0, 0);
#pragma unroll
    for (int i = 0; i < 2; ++i) __builtin_amdgcn_global_load_lds((const unsigned*)(vj + voff[i]), (LAS unsigned*)(vd + i * 8192), 16, 0, 0);
}

__device__ __forceinline__ void qk_softmax(const LAS unsigned char* kslot, int r32, int hi, LAS float* al_l, const v8i32 (&qf)[2], const f32x16& bias, f32x16 (&o)[8], v8i32& pa, int& pscl,
                                           float& m_reg, float& l_reg, float rawu, float sl2, bool diag, int qi) {
    f32x16 p0, p1;
    qkt(p0, p1, kslot, r32, hi, qf, bias);
    if (diag) {
        const float k2raw = 2.f * rawu;
        int qi_ = qi - 4 * hi; asm volatile("" : "+v"(qi_));
#pragma unroll
        for (int r = 0; r < 16; ++r) { const int c = (r & 3) + 8 * (r >> 2); const int d0_ = c - qi_, d1_ = c + 32 - qi_;
            p0[r] -= k2raw * (float)(d0_ > 0 ? d0_ : 0); p1[r] -= k2raw * (float)(d1_ > 0 ? d1_ : 0); }
    }
    const float lane_raw = rawu * (float)(4 * hi), d32raw = 32.f * rawu;
    float pm0 = p0[0], pm1 = p1[0];
#pragma unroll
    for (int r = 1; r < 16; ++r) { pm0 = fmaxf(pm0, p0[r]); pm1 = fmaxf(pm1, p1[r]); }
    float pmax = fmaxf(pm0, pm1 + d32raw) + lane_raw;
    { auto rr = __builtin_amdgcn_permlane32_swap(__float_as_uint(pmax), __float_as_uint(pmax), false, false);
      pmax = fmaxf(__uint_as_float(rr[0]), __uint_as_float(rr[1])); }
    float mn, alpha;
    if (__all((pmax - m_reg) * SCALE <= THR)) { mn = m_reg; alpha = 1.f; }
    else { mn = fmaxf(m_reg, pmax); alpha = __builtin_amdgcn_exp2f((m_reg - mn) * C2); m_reg = mn; }
    const float ef = fminf(floorf(8.75f - (pmax - mn) * C2), 60.f);
    pscl = 127 - (int)ef;
    const float mnL0 = (lane_raw - mn) * C2 + ef, mnL1 = mnL0 + 32.f * sl2;
#pragma unroll
    for (int r = 0; r < 16; ++r) { p0[r] = __builtin_amdgcn_exp2f(fmaf(p0[r], C2, mnL0)); p1[r] = __builtin_amdgcn_exp2f(fmaf(p1[r], C2, mnL1)); }
    if (__any(alpha < 1.f)) {
        if (hi == 0) al_l[r32] = alpha;
        LDS_WAIT();
#pragma unroll
        for (int r = 0; r < 16; ++r) { const float a = al_l[crow(r, hi)];
#pragma unroll
            for (int d = 0; d < 8; ++d) o[d][r] *= a; }
    }
    float ps = 0.f;
#pragma unroll
    for (int r = 0; r < 16; ++r) ps += p0[r] + p1[r];
    { auto rr = __builtin_amdgcn_permlane32_swap(__float_as_uint(ps), __float_as_uint(ps), false, false);
      ps = __uint_as_float(rr[0]) + __uint_as_float(rr[1]); }
    l_reg = l_reg * alpha + ps * __builtin_amdgcn_exp2f(-ef);
#pragma unroll
    for (int g = 0; g < 4; ++g) {
        pa[g] = __builtin_amdgcn_cvt_pk_fp8_f32(p0[4 * g + 2], p0[4 * g + 3], __builtin_amdgcn_cvt_pk_fp8_f32(p0[4 * g], p0[4 * g + 1], (int)__float_as_uint(p0[4 * g]), false), true);
        pa[4 + g] = __builtin_amdgcn_cvt_pk_fp8_f32(p1[4 * g + 2], p1[4 * g + 3], __builtin_amdgcn_cvt_pk_fp8_f32(p1[4 * g], p1[4 * g + 1], (int)__float_as_uint(p1[4 * g]), false), true); }
}

__device__ __forceinline__ void norms_phase(Frame& F, const bf16_t* proj, float* nrm) {
    const int gw = F.vcu * NWAVES + F.wave, NGW = F.G * NWAVES, lane = F.lane;
    for (int idx = gw; idx < 2 * 32 * 256; idx += NGW) {
        const int tensor = idx >> 13, stream = (idx >> 8) & 31, grp = idx & 255;
        const u32x4* rp = (const u32x4*)((const unsigned char*)proj + (tensor ? DK0 : 0) + ((size_t)stream * SEQ + grp * 64 + lane) * 128);
        float ss = 0.f;
#pragma unroll
        for (int q = 0; q < 8; ++q) { const u32x4 v = rp[q];
#pragma unroll
            for (int e = 0; e < 4; ++e) { const float a0 = __builtin_amdgcn_cvt_f32_fp8((int)v[e], 0), a1 = __builtin_amdgcn_cvt_f32_fp8((int)v[e], 1), a2 = __builtin_amdgcn_cvt_f32_fp8((int)v[e], 2), a3 = __builtin_amdgcn_cvt_f32_fp8((int)v[e], 3);
                ss += (a0 * a0 + a1 * a1) + (a2 * a2 + a3 * a3); } }
        float n = sqrtf(ss) * 1.001f;
#pragma unroll
        for (int o = 1; o < 64; o <<= 1) n = fmaxf(n, __shfl_xor(n, o));
        if (lane == 0) nrm[idx] = n;
    }
}

__device__ __forceinline__ void attn_item(LAS unsigned char* lds, const bf16_t* proj, const float* nrm, bf16_t* oout, int b, int h, int sub, int qb, int tid, int wid, int lane, unsigned* queue, LAS int* qnext) {
    asm volatile("" : "+v"(lane));
    const int r32 = lane & 31, hi = lane >> 5;
    const float slope = __builtin_amdgcn_exp2f(-(float)(h + 1));
    const float sl2 = slope * 1.4426950408889634f, rawu = sl2 / C2;
    LAS float* ws = (LAS float*)(lds + SCR_OFF) + wid * 64; LAS float* li_l = ws; LAS float* al_l = ws + 32;
    const size_t tokq = (size_t)b * SEQ + (size_t)qb * 256 + wid * 32;
    const bf16_t* kbase = (const bf16_t*)((const unsigned char*)proj + DK0 + dq_off(b, 0, h, sub));
    const bf16_t* vbase = (const bf16_t*)((const unsigned char*)proj + pg8::vt_off(b, h, 0));
    int j_lo;
    { const int stream = (b * 8 + h) * 2 + sub; const float* qn = nrm + stream * 256; const float* kn = nrm + 8192 + stream * 256;
      const float Qn = fmaxf(fmaxf(qn[4 * qb], qn[4 * qb + 1]), fmaxf(qn[4 * qb + 2], qn[4 * qb + 3]));
      const float Kd = fmaxf(fmaxf(kn[4 * qb], kn[4 * qb + 1]), fmaxf(kn[4 * qb + 2], kn[4 * qb + 3]));
      int cand = 4 * qb;
      for (int jj = lane; jj < 4 * qb; jj += 64) { const float dmin = (float)(256 * qb - (64 * jj + 63)); const bool skip = slope * dmin > 110.f + SCALE * Qn * (kn[jj] + Kd); if (!skip) cand = cand < jj ? cand : jj; }
#pragma unroll
      for (int o = 1; o < 64; o <<= 1) { const int v = __builtin_amdgcn_ds_bpermute((lane ^ o) << 2, cand); cand = v < cand ? v : cand; }
      j_lo = __builtin_amdgcn_readfirstlane(cand); }
    v8i32 qf[2];
    { const unsigned char* qrow = (const unsigned char*)proj + dq_off(b, qb * 256 + wid * 32 + r32, h, sub) + 32 * hi;
#pragma unroll
      for (int s = 0; s < 2; ++s) { const v4i32 x0 = *(const v4i32*)(qrow + 64 * s), x1 = *(const v4i32*)(qrow + 64 * s + 16); qf[s] = __builtin_shufflevector(x0, x1, 0, 1, 2, 3, 4, 5, 6, 7); } }
    const float sh64 = 64.f * rawu;
    f32x16 bias;
#pragma unroll
    for (int r = 0; r < 16; ++r) bias[r] = (float)((r & 3) + 8 * (r >> 2)) * rawu;
    const int qi = 32 * (wid & 1) + r32;
    const LAS unsigned char* vb0 = lds + V_OFF + r32 * 64 + (((2 * hi) ^ ((r32 >> 2) & 3)) << 4);
    float m_reg = -1e30f, l_reg = 0.f;
    f32x16 o[8];
#pragma unroll
    for (int d = 0; d < 8; ++d)
#pragma unroll
        for (int r = 0; r < 16; ++r) o[d][r] = 0.f;
    const int NT = 4 * qb + 4, myNT = 4 * qb + (wid >> 1) + 1;
    constexpr size_t KSTEP = 64 * 128 / 2, VSTEP = 256 * 64 / 2;
    const bool late = wid >= 4;
#define ATT_STAGE(jj, sl) stage_tile(lds, sl, kbase + (size_t)(jj) * KSTEP, vbase + (size_t)(jj) * VSTEP, tid, wid)
#define ATT_NEXT(s_) ((s_) == NSLOT - 1 ? 0 : (s_) + 1)
#define ATT_WAIT(j_) do { const int rem_ = NT - 2 - (j_); if (rem_ >= 2) asm volatile("s_waitcnt vmcnt(6)" ::: "memory"); else if (rem_ == 1) asm volatile("s_waitcnt vmcnt(3)" ::: "memory"); \
        else asm volatile("s_waitcnt vmcnt(0)" ::: "memory"); WG_BAR(); } while (0)
    int s0 = j_lo % NSLOT;
    { const int s1 = ATT_NEXT(s0), s2 = ATT_NEXT(s1); ATT_STAGE(j_lo, s0); ATT_STAGE(j_lo + 1, s1); ATT_STAGE(j_lo + 2, s2); }
    asm volatile("s_waitcnt vmcnt(6)" ::: "memory"); WG_BAR();
    if (!late) {
        for (int j = j_lo; j < NT; ++j) {
            const int s1 = ATT_NEXT(s0);
            if (j + 3 < NT) { const int s3 = ATT_NEXT(ATT_NEXT(s1)); ATT_STAGE(j + 3, s3); }
            if (j < myNT) { if (j > j_lo) m_reg -= sh64;
                v8i32 pa; int pscl;
                qk_softmax(lds + K_OFF + s0 * SHM_K, r32, hi, al_l, qf, bias, o, pa, pscl, m_reg, l_reg, rawu, sl2, j == myNT - 1, qi);
                pv_tile(o, vb0 + s0 * SHM_V, pa, pscl); }
            ATT_WAIT(j);
            s0 = s1;
        }
    } else {
        v8i32 pa; int pscl = 127;
#pragma unroll
        for (int g = 0; g < 8; ++g) pa[g] = 0;
        int sp = s0;
        for (int j = j_lo; j < NT; ++j) {
            const int s1 = ATT_NEXT(s0);
            if (j + 3 < NT) { const int s3 = ATT_NEXT(ATT_NEXT(s1)); ATT_STAGE(j + 3, s3); }
            if (j > j_lo && j - 1 < myNT) pv_tile(o, vb0 + sp * SHM_V, pa, pscl);
            if (j < myNT) { if (j > j_lo) m_reg -= sh64;
                qk_softmax(lds + K_OFF + s0 * SHM_K, r32, hi, al_l, qf, bias, o, pa, pscl, m_reg, l_reg, rawu, sl2, j == myNT - 1, qi); }
            ATT_WAIT(j);
            sp = s0; s0 = s1;
        }
        if (myNT == NT) pv_tile(o, vb0 + sp * SHM_V, pa, pscl);
    }
#undef ATT_WAIT
#undef ATT_NEXT
#undef ATT_STAGE
    int jn_ = 0; if (tid == 0) jn_ = (int)__hip_atomic_fetch_add(queue, 1u, __ATOMIC_RELAXED, __HIP_MEMORY_SCOPE_AGENT);
    if (hi == 0) li_l[r32] = l_reg;
    LDS_WAIT();
    char* Ow = (char*)(oout + tokq * D + h * 256);
    const unsigned lofs = (unsigned)(hi * 4 * D + r32) * 2u;
#pragma unroll
    for (int r = 0; r < 16; ++r) { const float rl = __builtin_amdgcn_rcpf(li_l[crow(r, hi)]);
#pragma unroll
        for (int d0 = 0; d0 < 8; ++d0) { const float v = o[d0][r] * rl; const float vn = __uint_as_float((unsigned)__builtin_amdgcn_ds_bpermute((lane ^ 1) << 2, (int)__float_as_uint(v)));
            if ((r32 & 1) == 0) *(unsigned*)(Ow + (lofs + (unsigned)((((r & 3) + 8 * (r >> 2)) * D + d0 * 32) * 2))) = cvt_pk_bf16(v, vn); } }
    if (tid == 0) *qnext = jn_;
    WG_BAR();
}

struct TailConv { const float* wg; const float* wu; const float* wd; bf16_t* gu; bf16_t* dt; };
__device__ __forceinline__ void attn_phase(Frame& F, const bf16_t* proj, const float* nrm, unsigned* queue, bf16_t* o1, bf16_t* o2, const TailConv tc) {
    LAS int* qw = (LAS int*)(F.lds + SCR_OFF + 8 * 256);
    if (F.tid == 0) qw[0] = (int)__hip_atomic_fetch_add(queue, 1u, __ATOMIC_RELAXED, __HIP_MEMORY_SCOPE_AGENT);
    WG_BAR();
    for (int n = 0;; ++n) {
        const int J = __builtin_amdgcn_readfirstlane(qw[n & 1]);
        if (J >= 2048 + 512) break;
        const int grp = J / 5, rr = J - 5 * grp;
        if (rr == 4) { int jn_ = 0; if (F.tid == 0) jn_ = (int)__hip_atomic_fetch_add(queue, 1u, __ATOMIC_RELAXED, __HIP_MEMORY_SCOPE_AGENT);
            conv_moe(F, tc.wg, tc.wu, tc.wd, tc.gu, tc.dt, grp, 512, L1_EARLY, NEXP - L1_EARLY); if (F.tid == 0) qw[(n + 1) & 1] = jn_; WG_BAR(); continue; }
        const int I = 4 * grp + rr;
        const int qb = 63 - (I >> 5), r = I & 31, h = 7 - (r >> 2), b = (r >> 1) & 1, sub = r & 1;
        attn_item(F.lds, proj, nrm, sub ? o2 : o1, b, h, sub, qb, F.tid, F.wave, F.lane, queue, qw + ((n + 1) & 1));
    }
}
}

__device__ __forceinline__ const void* karg(int i) { int j = i; asm volatile("" : "+s"(j)); return ((const void* const __attribute__((address_space(4)))*)__builtin_amdgcn_kernarg_segment_ptr())[j]; }
#if defined(__HIP_DEVICE_COMPILE__)
#define NO_PK_F32 __attribute__((target("no-packed-fp32-ops")))
#else
#define NO_PK_F32
#endif
__global__ void __launch_bounds__(NWAVES * 64, 2) NO_PK_F32 hybrid_fwd(Args args) {
    extern __shared__ __attribute__((aligned(16))) unsigned char lds_raw[];
    Frame F;
    F.lds = (LAS unsigned char*)lds_raw;
    F.tid = threadIdx.x; F.lane = F.tid & 63; F.wave = __builtin_amdgcn_readfirstlane(F.tid >> 6);
    F.G = gridDim.x; { const int bx = blockIdx.x; F.vcu = (F.G % 8 == 0) ? (bx % 8) * (F.G / 8) + bx / 8 : bx; }
#define ws ((unsigned char*)karg(22))
#define ctl ((unsigned*)(ws + WS_CTL))
    for (int u = F.tid; u < (LDS_BYTES - LDSCTL_OFF) / 4; u += NWAVES * 64) ((LAS unsigned*)(F.lds + LDSCTL_OFF))[u] = 0u;
    SYNCTHREADS();
    ((LAS int*)(F.lds + TIDS_OFF))[F.tid] = F.tid;
    SYNCTHREADS();
    volatile LAS unsigned* MISC = (volatile LAS unsigned*)(F.lds + MISC_OFF);
    XcdBarrier bar = xcd_barrier_post(ctl + CW_BAR, MISC + 8);
#define GRID_BAR() do { XcdBarrier bb_ = bar; unsigned x_ = bar.x; unsigned long long bp_ = (unsigned long long)bar.bar; asm volatile("" : "+s"(x_), "+s"(bp_)); bb_.x = x_; bb_.bar = (unsigned*)bp_; xcd_barrier(bb_, TID_RELOAD() == 0); } while (0)
#define TID_RELOAD() (F.wave * 64 + lane_id_volatile())
#ifdef ONLY_PHASE
#define PHON(n) ((n) == ONLY_PHASE)
#else
#define PHON(n) 1
#endif

#define x_in ((const float*)(karg(0)))
#define norm_mix ((const float*)(karg(1)))
#define norm_ffn ((const float*)(karg(2)))
#define gla_w_in ((const float*)(karg(3)))
#define gla_wgu ((const float*)(karg(4)))
#define gla_bg ((const float*)(karg(5)))
#define gla_norm ((const float*)(karg(6)))
#define gla_w_out ((const float*)(karg(7)))
#define diff_w_in ((const float*)(karg(8)))
#define lq1 ((const float*)(karg(9)))
#define lk1 ((const float*)(karg(10)))
#define lq2 ((const float*)(karg(11)))
#define lk2 ((const float*)(karg(12)))
#define diff_subln ((const float*)(karg(13)))
#define diff_w_out ((const float*)(karg(14)))
#define moe_wgrp ((const float*)(karg(15)))
#define moe_wexp ((const float*)(karg(16)))
#define moe_wg ((const float*)(karg(17)))
#define moe_wu ((const float*)(karg(18)))
#define moe_wd ((const float*)(karg(19)))
#define final_norm ((const float*)(karg(20)))
#define xres ((bf16_t*)(ws + WS_XRES))
#define gz ((float*)((float*)(ws + WS_GZ)))
#define tok_e ((int*)((int*)(ws + WS_TOKE)))
#define tok_p ((int*)((int*)(ws + WS_TOKP)))
#define tok_w ((float*)((float*)(ws + WS_TOKW)))
#define slot_of ((int*)((int*)(ws + WS_SLOT)))
#define slot_tok ((int*)(ws + WS_STOK))
#define adec ((float*)((float*)(ws + WS_ADEC)))
#define pcum ((float*)((float*)(ws + WS_PCUM)))
#define sfin ((bf16_t*)((bf16_t*)(ws + WS_SFIN)))
#define wp_gz ((float*)((float*)(ws + WS_WPGZ)))
#define wp_r0 ((float*)((float*)(ws + WS_WPR0)))
#define wp_r1 ((float*)((float*)(ws + WS_WPR1)))
#define wgi ((bf16_t*)((bf16_t*)(ws + WS_WGI)))
#define wgo ((bf16_t*)((bf16_t*)(ws + WS_WGO)))
#define wdi ((bf16_t*)((bf16_t*)(ws + WS_WDI)))
#define wdo ((bf16_t*)((bf16_t*)(ws + WS_WDO)))
#define wmoe_gu ((bf16_t*)((bf16_t*)(ws + WS_WMOE)))
#define wmoe_d ((bf16_t*)((bf16_t*)(ws + WS_WMOE_D)))
#define hn ((bf16_t*)((bf16_t*)(ws + WS_HN)))
#define proj ((bf16_t*)((bf16_t*)(ws + WS_PROJ)))
#define buf1 ((bf16_t*)((bf16_t*)(ws + WS_BUF1)))
#define buf2 ((bf16_t*)((bf16_t*)(ws + WS_BUF2)))
#define ag ((bf16_t*)((bf16_t*)(ws + WS_AG)))
#define ob ((bf16_t*)((bf16_t*)(ws + WS_OB)))
#define hh ((bf16_t*)((bf16_t*)(ws + WS_H)))
    const LAS int* pst = (const LAS int*)(F.lds + TAB_OFF);

    _Pragma("unroll") for (int rep_ = 0; rep_ < (REP_PHASE == 0 ? 2 : 1); ++rep_) if (PHON(0)) { if (rep_) GRID_BAR(); Frame P = F; P.tid = TID_RELOAD(); P.lane = P.tid & 63;
    conv_plain(P, gla_w_in, D, PROJW, GLA_INW, wgi, -1, 0, norm_mix);
    conv_plain(P, gla_w_out, D, D, D, wgo);
    pack_proj(P, wp_gz, 1, norm_mix, gla_w_in, GLA_INW, PROJW, 16, nullptr, 0, 0);
    pack_proj16(P, (bf16_t*)wp_r0, 3, norm_ffn, moe_wgrp, 4, 0, 4, moe_wexp, 32, 32);
    pack_proj16(P, (bf16_t*)wp_r1, 3, norm_ffn + D, moe_wgrp + (size_t)D * 4, 4, 0, 4, moe_wexp + (size_t)D * 32, 32, 32);
    }
    GRID_BAR();
    _Pragma("unroll") for (int rep_ = 0; rep_ < (REP_PHASE == 1 ? 2 : 1); ++rep_) if (PHON(1)) { if (rep_) GRID_BAR(); Frame P = F; P.tid = TID_RELOAD(); P.lane = P.tid & 63;
    phase_norm_gz(P, x_in, wp_gz, hn, gz, (float*)(ws + WS_PCUM));
    }
    GRID_BAR();
    _Pragma("unroll") for (int rep_ = 0; rep_ < (REP_PHASE == 2 ? 2 : 1); ++rep_) if (PHON(2)) { if (rep_) GRID_BAR(); Frame P = F; P.tid = TID_RELOAD(); P.lane = P.tid & 63;
    { pg8::Gemm g{hn, wgi, T, PROJW, D}; pg8::StaticOrder S; S.init(T, PROJW, P.G, (int)blockIdx.x); pg8::EpiHeads<0> E{proj, (const float*)(ws + WS_PCUM)};
      pg8::gemm_phase<pg8::EpiHeads<0>, pg8::StaticOrder>(P.lds, g, S, E, P.tid); }
    }
    GRID_BAR();
    _Pragma("unroll") for (int rep_ = 0; rep_ < (REP_PHASE == 3 ? 2 : 1); ++rep_) if (PHON(3)) { if (rep_) GRID_BAR(); Frame P = F; P.tid = TID_RELOAD(); P.lane = P.tid & 63;
    phase_gla_gate(P, gz, gla_wgu, gla_bg, proj, buf1, adec);
    }
    GRID_BAR();
    _Pragma("unroll") for (int rep_ = 0; rep_ < (REP_PHASE == 4 ? 2 : 1); ++rep_) if (PHON(4)) { if (rep_) GRID_BAR(); Frame P = F; P.tid = TID_RELOAD(); P.lane = P.tid & 63;
    if (P.G == 256) { if ((P.vcu & 1) == 0) phase_gla_scan(P, P.vcu >> 1, proj, buf1, adec, buf2, sfin); else { gla_pcum(P, adec, pcum, P.vcu >> 1, 128); conv_moe(P, moe_wg, moe_wu, moe_wd, wmoe_gu, wmoe_d, P.vcu >> 1, 128);
            conv_moe(P, moe_wg + (size_t)NEXP * D * DFF, moe_wu + (size_t)NEXP * D * DFF, moe_wd + (size_t)NEXP * DFF * D, (bf16_t*)(ws + WS_WMOE1), (bf16_t*)(ws + WS_WMOE1_D), P.vcu >> 1, 128, 0, L1_EARLY);
            conv_plain<true>(P, diff_w_in, D, PROJW, PROJW, wdi, P.vcu >> 1, 128); conv_plain<true>(P, diff_w_out, D, D, D, wdo, P.vcu >> 1, 128); } }
    else { for (int it = P.vcu; it < 128; it += P.G) phase_gla_scan(P, it, proj, buf1, adec, buf2, sfin); gla_pcum(P, adec, pcum, P.vcu, P.G); conv_moe(P, moe_wg, moe_wu, moe_wd, wmoe_gu, wmoe_d); conv_moe(P, moe_wg + (size_t)NEXP * D * DFF, moe_wu + (size_t)NEXP * D * DFF, moe_wd + (size_t)NEXP * DFF * D, (bf16_t*)(ws + WS_WMOE1), (bf16_t*)(ws + WS_WMOE1_D), -1, 0, 0, L1_EARLY); conv_plain<true>(P, diff_w_in, D, PROJW, PROJW, wdi); conv_plain<true>(P, diff_w_out, D, D, D, wdo); }
    GRID_BAR();
    phase_gla_qp(P, proj, pcum, buf1);
    GRID_BAR();
    { pg8::Gemm g{buf1, sfin, 8 * (SEQ / 2), 512, 256}; pg8::FixOrder S; S.init(8 * (SEQ / 2), 512, P.G, (int)blockIdx.x); pg8::EpiAddO E{buf2};
      pg8::gemm_phase<pg8::EpiAddO, pg8::FixOrder>(P.lds, g, S, E, P.tid); }
    }
    GRID_BAR();
    _Pragma("unroll") for (int rep_ = 0; rep_ < (REP_PHASE == 5 ? 2 : 1); ++rep_) if (PHON(5)) { if (rep_) GRID_BAR(); Frame P = F; P.tid = TID_RELOAD(); P.lane = P.tid & 63;
    phase_gla_gnorm(P, buf2, proj, gla_norm, buf1);
    }
    GRID_BAR();
    _Pragma("unroll") for (int rep_ = 0; rep_ < (REP_PHASE == 6 ? 2 : 1); ++rep_) if (PHON(6)) { if (rep_) GRID_BAR(); Frame P = F; P.tid = TID_RELOAD(); P.lane = P.tid & 63;
    { pg8::Gemm g{buf1, wgo, T, D, D}; pg8::StaticOrder S; S.init(T, D, P.G, (int)blockIdx.x); pg8::EpiRes16<true> E{hn, xres, D};
      pg8::gemm_phase<pg8::EpiRes16<true>, pg8::StaticOrder>(P.lds, g, S, E, P.tid); }
    }
    GRID_BAR();
    _Pragma("unroll") for (int rep_ = 0; rep_ < (REP_PHASE == 7 ? 2 : 1); ++rep_) if (PHON(7)) { if (rep_) GRID_BAR(); Frame P = F; P.tid = TID_RELOAD(); P.lane = P.tid & 63;
    phase_norm_route(P, xres, norm_ffn, wp_r0, hn, tok_e, tok_p, tok_w, ctl + CW_CNT0);
    }
    GRID_BAR();
    _Pragma("unroll") for (int rep_ = 0; rep_ < (REP_PHASE == 8 ? 2 : 1); ++rep_) if (PHON(8)) { if (rep_) GRID_BAR(); Frame P = F; P.tid = TID_RELOAD(); P.lane = P.tid & 63;
    moe_tables(P, ctl + CW_CNT0);
    phase_moe_slots(P, tok_e, tok_p, ctl + CW_CNT0, slot_of, slot_tok);
    }
    GRID_BAR();
    _Pragma("unroll") for (int rep_ = 0; rep_ < (REP_PHASE == 9 ? 2 : 1); ++rep_) if (PHON(9)) { if (rep_) GRID_BAR(); Frame P = F; P.tid = TID_RELOAD(); P.lane = P.tid & 63;
    { const int Mr = pst[33] * 256; pg8::Gemm g{hn, wmoe_gu, Mr, 1024, D}; pg8::MoeOrder S; S.init(Mr, 1024, P.G, (int)blockIdx.x); S.te = pst + 36; S.estride = (size_t)1024 * D; S.stok = slot_tok; pg8::EpiSiluMul E{(unsigned char*)hh};
      pg8::gemm_phase<pg8::EpiSiluMul, pg8::MoeOrder, true, true>(P.lds, g, S, E, P.tid); }
    }
    GRID_BAR();
    _Pragma("unroll") for (int rep_ = 0; rep_ < (REP_PHASE == 10 ? 2 : 1); ++rep_) if (PHON(10)) { if (rep_) GRID_BAR(); Frame P = F; P.tid = TID_RELOAD(); P.lane = P.tid & 63;
    { const int Mr = pst[33] * 256; pg8::Gemm g{hh, wmoe_d, Mr, D, DFF}; pg8::MoeOrder S; S.init(Mr, D, P.G, (int)blockIdx.x); S.te = pst + 36; S.estride = (size_t)D * DFF; S.stok = slot_tok; pg8::EpiF8x8 E{(unsigned char*)ob, D};
      pg8::gemm_phase<pg8::EpiF8x8, pg8::MoeOrder, false, true>(P.lds, g, S, E, P.tid); }
    }
    GRID_BAR();
    _Pragma("unroll") for (int rep_ = 0; rep_ < (REP_PHASE == 11 ? 2 : 1); ++rep_) if (PHON(11)) { if (rep_) GRID_BAR(); Frame P = F; P.tid = TID_RELOAD(); P.lane = P.tid & 63;
    phase_moe_combine<0>(P, xres, nullptr, ob, slot_of, tok_w, norm_mix + D, hn);
    }
    GRID_BAR();
    _Pragma("unroll") for (int rep_ = 0; rep_ < (REP_PHASE == 12 ? 2 : 1); ++rep_) if (PHON(12)) { if (rep_) GRID_BAR(); Frame P = F; P.tid = TID_RELOAD(); P.lane = P.tid & 63;
    { pg8::Gemm g{hn, wdi, T, 4096, D}; pg8::StaticOrder S; S.init(T, 4096, P.G, (int)blockIdx.x); pg8::EpiHeads<1> E{proj, nullptr};
      pg8::gemm_phase<pg8::EpiHeads<1>, pg8::StaticOrder, false, true>(P.lds, g, S, E, P.tid); }
    { pg8::Gemm g{hn, (const bf16_t*)((const unsigned char*)wdi + (size_t)4096 * D), T, 2048, D}; pg8::StaticOrder S; S.init(T, 2048, P.G, (int)blockIdx.x); pg8::EpiVT E{(unsigned char*)proj};
      pg8::gemm_phase<pg8::EpiVT, pg8::StaticOrder, false, true, true>(P.lds, g, S, E, P.tid); }
    GRID_BAR();
    att::norms_phase(P, proj, (float*)(ws + WS_NRM));
    }
    GRID_BAR();
    _Pragma("unroll") for (int rep_ = 0; rep_ < (REP_PHASE == 13 ? 2 : 1); ++rep_) if (PHON(13)) { if (rep_) GRID_BAR(); Frame P = F; P.tid = TID_RELOAD(); P.lane = P.tid & 63;
    att::attn_phase(P, proj, (const float*)(ws + WS_NRM), ctl + CW_QUEUE + 64 * rep_, buf1, buf2, att::TailConv{moe_wg + (size_t)NEXP * D * DFF, moe_wu + (size_t)NEXP * D * DFF, moe_wd + (size_t)NEXP * DFF * D, (bf16_t*)(ws + WS_WMOE1), (bf16_t*)(ws + WS_WMOE1_D)});
    }
    GRID_BAR();
    _Pragma("unroll") for (int rep_ = 0; rep_ < (REP_PHASE == 14 ? 2 : 1); ++rep_) if (PHON(14)) { if (rep_) GRID_BAR(); Frame P = F; P.tid = TID_RELOAD(); P.lane = P.tid & 63;
    phase_subln(P, buf1, buf2, lq1, lk1, lq2, lk2, diff_subln, hn);
    }
    GRID_BAR();
    _Pragma("unroll") for (int rep_ = 0; rep_ < (REP_PHASE == 15 ? 2 : 1); ++rep_) if (PHON(15)) { if (rep_) GRID_BAR(); Frame P = F; P.tid = TID_RELOAD(); P.lane = P.tid & 63;
    { pg8::Gemm g{hn, wdo, T, D, D}; pg8::StaticOrder S; S.init(T, D, P.G, (int)blockIdx.x); pg8::EpiRes16<true> E{xres, xres, D};
      pg8::gemm_phase<pg8::EpiRes16<true>, pg8::StaticOrder, false, true>(P.lds, g, S, E, P.tid); }
    }
    GRID_BAR();
    _Pragma("unroll") for (int rep_ = 0; rep_ < (REP_PHASE == 16 ? 2 : 1); ++rep_) if (PHON(16)) { if (rep_) GRID_BAR(); Frame P = F; P.tid = TID_RELOAD(); P.lane = P.tid & 63;
    phase_norm_route(P, xres, norm_ffn + D, wp_r1, hn, tok_e, tok_p, tok_w, ctl + CW_CNT1);
    }
    GRID_BAR();
    _Pragma("unroll") for (int rep_ = 0; rep_ < (REP_PHASE == 17 ? 2 : 1); ++rep_) if (PHON(17)) { if (rep_) GRID_BAR(); Frame P = F; P.tid = TID_RELOAD(); P.lane = P.tid & 63;
    moe_tables(P, ctl + CW_CNT1);
    phase_moe_slots(P, tok_e, tok_p, ctl + CW_CNT1, slot_of, slot_tok);
    }
    GRID_BAR();
    _Pragma("unroll") for (int rep_ = 0; rep_ < (REP_PHASE == 18 ? 2 : 1); ++rep_) if (PHON(18)) { if (rep_) GRID_BAR(); Frame P = F; P.tid = TID_RELOAD(); P.lane = P.tid & 63;
    { const int Mr = pst[33] * 256; pg8::Gemm g{hn, (bf16_t*)(ws + WS_WMOE1), Mr, 1024, D}; pg8::MoeOrder S; S.init(Mr, 1024, P.G, (int)blockIdx.x); S.te = pst + 36; S.estride = (size_t)1024 * D; S.stok = slot_tok; pg8::EpiSiluMul E{(unsigned char*)hh};
      pg8::gemm_phase<pg8::EpiSiluMul, pg8::MoeOrder, true, true>(P.lds, g, S, E, P.tid); }
    }
    GRID_BAR();
    _Pragma("unroll") for (int rep_ = 0; rep_ < (REP_PHASE == 19 ? 2 : 1); ++rep_) if (PHON(19)) { if (rep_) GRID_BAR(); Frame P = F; P.tid = TID_RELOAD(); P.lane = P.tid & 63;
    { const int Mr = pst[33] * 256; pg8::Gemm g{hh, (bf16_t*)(ws + WS_WMOE1_D), Mr, D, DFF}; pg8::MoeOrder S; S.init(Mr, D, P.G, (int)blockIdx.x); S.te = pst + 36; S.estride = (size_t)D * DFF; S.stok = slot_tok; pg8::EpiF8x8 E{(unsigned char*)ob, D};
      pg8::gemm_phase<pg8::EpiF8x8, pg8::MoeOrder, false, true>(P.lds, g, S, E, P.tid); }
    }
    GRID_BAR();
    _Pragma("unroll") for (int rep_ = 0; rep_ < (REP_PHASE == 20 ? 2 : 1); ++rep_) if (PHON(20)) { if (rep_) GRID_BAR(); Frame P = F; P.tid = TID_RELOAD(); P.lane = P.tid & 63;
    phase_moe_combine<1>(P, xres, (float*)(karg(21)), ob, slot_of, tok_w, final_norm, hn);
    }
}

#undef x_in
#undef norm_mix
#undef norm_ffn
#undef gla_w_in
#undef gla_wgu
#undef gla_bg
#undef gla_norm
#undef gla_w_out
#undef diff_w_in
#undef lq1
#undef lk1
#undef lq2
#undef lk2
#undef diff_subln
#undef diff_w_out
#undef moe_wgrp
#undef moe_wexp
#undef moe_wg
#undef moe_wu
#undef moe_wd
#undef final_norm
#undef xres
#undef gz
#undef tok_e
#undef tok_p
#undef tok_w
#undef slot_of
#undef slot_tok
#undef ws
#undef ctl
#undef adec
#undef pcum
#undef sfin
#undef wp_gz
#undef wp_r0
#undef wp_r1
#undef wgi
#undef wgo
#undef wdi
#undef wdo
#undef wmoe_gu
#undef wmoe_d
#undef hn
#undef proj
#undef buf1
#undef buf2
#undef ag
#undef ob
#undef hh

extern "C" void kernel_launch(void* const* d_in, const int* in_sizes, int n_in, void* d_out, int out_size, void* d_ws, size_t ws_size, hipStream_t stream) {
    static int grid = 0;
    if (grid == 0) {
        if (n_in != 21 || out_size != T * D || ws_size < WS_END) { fprintf(stderr, "kernel_launch: unexpected shapes (n_in %d out %d ws %zu)\n", n_in, out_size, ws_size); grid = -1; return; }
        if (hipFuncSetAttribute((const void*)hybrid_fwd, hipFuncAttributeMaxDynamicSharedMemorySize, LDS_BYTES) != hipSuccess) { fprintf(stderr, "kernel_launch: hipFuncSetAttribute failed\n"); grid = -1; return; }
        int dev = 0, cus = 0, per_cu = 0;
        (void)hipGetDevice(&dev); (void)hipDeviceGetAttribute(&cus, hipDeviceAttributeMultiprocessorCount, dev);
        if (hipOccupancyMaxActiveBlocksPerMultiprocessor(&per_cu, (const void*)hybrid_fwd, NWAVES * 64, LDS_BYTES) != hipSuccess || per_cu < 1) fprintf(stderr, "kernel_launch: occupancy query says %d\n", per_cu);
        (void)hipGetLastError();
        grid = cus > 0 ? cus : 256;
    }
    if (grid < 0) return;
    Args a{};
    for (int i = 0; i < 21; ++i) a.in[i] = (const float*)d_in[i];
    a.out = (float*)d_out; a.ws = (unsigned char*)d_ws; a.pad0 = 0; a.pad1 = 0;
    (void)hipMemsetAsync((char*)d_ws + WS_CTL, 0, CTL_ZERO_BYTES, stream);
    hipLaunchKernelGGL(hybrid_fwd, dim3(grid), dim3(NWAVES * 64), LDS_BYTES, stream, a);
}
```

```cpp
#ifndef REP_PHASE
#define REP_PHASE -1
#endif
#include <hip/hip_runtime.h>
#include <cstdio>
#include <cstdint>

#define LAS __attribute__((address_space(3)))
#define GAS __attribute__((address_space(1)))
typedef unsigned short bf16_t;
typedef short bf16x8 __attribute__((ext_vector_type(8)));
typedef short s16x4 __attribute__((ext_vector_type(4)));
typedef float f32x4 __attribute__((ext_vector_type(4)));
typedef float f32x2 __attribute__((ext_vector_type(2)));
typedef float f32x16 __attribute__((ext_vector_type(16)));
typedef unsigned u32x4 __attribute__((ext_vector_type(4)));
typedef unsigned u32x2 __attribute__((ext_vector_type(2)));
typedef int v8i32 __attribute__((ext_vector_type(8)));
typedef int v4i32 __attribute__((ext_vector_type(4)));

constexpr int D = 2048, SEQ = 16384, NBATCH = 2, T = NBATCH * SEQ, CHUNK = 64, NCH = SEQ / CHUNK;
constexpr int GLA_H = 4, GLA_DK = 256, GLA_DV = 512, GLA_DKT = 1024, GLA_INW = 6160, PROJW = 6144;
constexpr int DIFF_H = 8;
constexpr int NEXP = 32, DFF = 512;
constexpr float RMS_EPS = 1e-6f;
constexpr float LAMBDA_INIT = 0.35550906759f;
constexpr int MAX_TILES = 288;

constexpr int L1_EARLY = 20;
constexpr size_t MiB = 1u << 20;
constexpr size_t WS_CTL = 0, CTL_ZERO_BYTES = 1 * MiB;
constexpr size_t WS_GZ = 2 * MiB;
constexpr size_t WS_TOKE = 4 * MiB;
constexpr size_t WS_TOKP = WS_TOKE + 256 * 1024;
constexpr size_t WS_TOKW = WS_TOKP + 256 * 1024;
constexpr size_t WS_SLOT = WS_TOKW + 256 * 1024;
constexpr size_t WS_STOK = 5 * MiB;
constexpr size_t WS_ADEC = 8 * MiB;
constexpr size_t WS_WPGZ = 10 * MiB;
constexpr size_t WS_WPR0 = 10 * MiB + 256 * 1024;
constexpr size_t WS_WPR1 = 11 * MiB;
constexpr size_t WS_NRM = 12 * MiB;
constexpr size_t WS_PCUM = 13 * MiB;
constexpr size_t WS_SFIN = 14 * MiB;
constexpr size_t WS_WGI = 16 * MiB, WS_WGO = 40 * MiB, WS_WDI = 48 * MiB, WS_WDO = 72 * MiB;
constexpr size_t WS_WMOE = 80 * MiB;
constexpr size_t WS_WMOE_D = WS_WMOE + 128 * MiB;
constexpr size_t WS_WMOE1 = WS_WMOE + 64 * MiB, WS_WMOE1_D = WS_WMOE + 160 * MiB;
constexpr size_t WS_HN = 272 * MiB;
constexpr size_t WS_PROJ = 400 * MiB;
constexpr size_t WS_BUF1 = 784 * MiB;
constexpr size_t WS_BUF2 = 912 * MiB;
constexpr size_t WS_XRES = 528 * MiB;
constexpr size_t WS_AG = 400 * MiB;
constexpr size_t WS_OB = 688 * MiB;
constexpr size_t WS_H = 976 * MiB;
constexpr size_t WS_END = 1048 * MiB;
constexpr int CW_BAR = 4096;
constexpr int CW_QUEUE = 8192;
constexpr int CW_CNT0 = 16384, CW_CNT1 = 16384 + 32 * 64;


constexpr size_t GK0 = (size_t)T * 1024, GV0 = (size_t)T * 2048, GR0 = (size_t)T * 4096;
constexpr size_t DK0 = (size_t)T * 2048, DV0 = (size_t)T * 4096;
__host__ __device__ __forceinline__ size_t gq_off(int b, int t, int h) { return ((size_t)(b * 4 + h) * SEQ + t) * 256; }
__host__ __device__ __forceinline__ size_t gv_off(int b, int t, int h) { return GV0 + ((size_t)(b * 4 + h) * SEQ + t) * 512; }
__host__ __device__ __forceinline__ size_t dq_off(int b, int t, int h, int sub) { return ((size_t)((b * 8 + h) * 2 + sub) * SEQ + t) * 128; }
__host__ __device__ __forceinline__ size_t dv_off(int b, int t, int h) { return DV0 + ((size_t)(b * 8 + h) * SEQ + t) * 256; }

constexpr int RING_BYTES = 131072;
constexpr int LDSCTL_OFF = RING_BYTES;
constexpr int MISC_OFF = LDSCTL_OFF + 320;
constexpr int TIDS_OFF = LDSCTL_OFF + 8192;
constexpr int TAB_OFF = LDSCTL_OFF + 1024;
constexpr int LDS_BYTES = 147456;
constexpr int NWAVES = 8;

typedef __bf16 bf16x2_t __attribute__((ext_vector_type(2)));
__device__ __forceinline__ unsigned cvt_pk_bf16(float lo, float hi) { const f32x2 v = {lo, hi}; return __builtin_bit_cast(unsigned, __builtin_convertvector(v, bf16x2_t)); }
__device__ __forceinline__ unsigned cvt4_fp8(float a, float b, float c, float d) { int v = __builtin_amdgcn_cvt_pk_fp8_f32(a, b, 0, false); return (unsigned)__builtin_amdgcn_cvt_pk_fp8_f32(c, d, v, true); }
constexpr float W8_SCALE = 64.f;
__device__ __forceinline__ float bf_lo(unsigned w) { return __uint_as_float(w << 16); }
__device__ __forceinline__ float bf_hi(unsigned w) { return __uint_as_float(w & 0xffff0000u); }
__device__ __forceinline__ f32x4 bf4_expand(u32x2 w) { return (f32x4){bf_lo(w.x), bf_hi(w.x), bf_lo(w.y), bf_hi(w.y)}; }
template <bool B16> struct XRow { typedef f32x4 T; static __device__ __forceinline__ f32x4 get(const f32x4& v) { return v; } };
template <> struct XRow<true> { typedef u32x2 T; static __device__ __forceinline__ f32x4 get(const u32x2& v) { return bf4_expand(v); } };
__device__ __forceinline__ float bf2f(bf16_t b) { return __uint_as_float(((unsigned)b) << 16); }
__device__ __forceinline__ float wave_sum(float v) {
#pragma unroll
    for (int o = 1; o < 64; o <<= 1) v += __shfl_xor(v, o);
    return v;
}
__device__ __forceinline__ int lane_id() { return (int)__builtin_amdgcn_mbcnt_hi(~0u, __builtin_amdgcn_mbcnt_lo(~0u, 0u)); }
__device__ __forceinline__ int lane_id_volatile() { int l; asm volatile("v_mbcnt_lo_u32_b32 %0, -1, 0\n\tv_mbcnt_hi_u32_b32 %0, -1, %0" : "=v"(l)); return l; }
__device__ __forceinline__ int opq(int v) { asm volatile("" : "+v"(v)); return v; }
#define LDS_WAIT() asm volatile("s_waitcnt lgkmcnt(0)" ::: "memory")
#define VM_WAIT() asm volatile("s_waitcnt vmcnt(0)" ::: "memory")
#define SYNCTHREADS() do { __builtin_amdgcn_fence(__ATOMIC_RELEASE, "workgroup"); __builtin_amdgcn_s_barrier(); __builtin_amdgcn_fence(__ATOMIC_ACQUIRE, "workgroup"); } while (0)
#define WG_BAR() do { asm volatile("s_waitcnt lgkmcnt(0)" ::: "memory"); __builtin_amdgcn_s_barrier(); asm volatile("" ::: "memory"); } while (0)

namespace pg8 {
constexpr int BM = 256, BK = 64, HALF = 128, HTB = HALF * BK * 2, STAGE_BYTES = 8 * HTB, NXCD = 8, WGM = 8;
__host__ __device__ __forceinline__ int lds_byte(int r, int c) { const int st = (r >> 4) * 2 + (c >> 5), rr = r & 15, cc = c & 31, ob = rr * 64 + cc * 2; return st * 1024 + (ob ^ (((ob >> 9) & 1) << 5)); }
__host__ __device__ __forceinline__ void stage_rc(int b, int& R, int& C) { const int st = b / 1024, sb = b % 1024, swz = sb ^ (((sb >> 9) & 1) << 5); R = (st >> 1) * 16 + swz / 64; C = (st & 1) * 32 + (swz % 64) / 2; }
__host__ __device__ __forceinline__ int perm32(int rho) { const int n = rho >> 4, i = rho & 15; return 8 * (i >> 2) + 4 * n + (i & 3); }

struct Unit { int pm, pn; };
struct Gemm { const bf16_t* A; const bf16_t* Bt; int M, N, K; };

struct StaticOrder {
    int nM, nN, nwg, G, c;
    __device__ __forceinline__ void init(int M, int N, int G_, int c_) { nM = M / BM; nN = N / BM; nwg = nM * nN; G = G_; c = c_; }
    __device__ __forceinline__ bool next(int i, Unit& u) const {
        const long L = (long)i * G + c; if (L >= nwg) return false;
        int wgid = (int)L; { const int q = nwg / NXCD, r = nwg % NXCD, xcd = wgid % NXCD, off = wgid / NXCD; wgid = (xcd < r ? xcd * (q + 1) : r * (q + 1) + (xcd - r) * q) + off; }
        const int nig = WGM * nN, gid = wgid / nig, fm = gid * WGM, gsz = (nM - fm) < WGM ? (nM - fm) : WGM;
        u.pm = fm + ((wgid % nig) % gsz); u.pn = (wgid % nig) / gsz; return true;
    }
    __device__ __forceinline__ size_t bofs(const Unit&) const { return 0; }
};
struct MoeOrder : StaticOrder {
    const LAS int* te; size_t estride; const int* stok;
    __device__ __forceinline__ size_t bofs(const Unit& u) const { return (size_t)te[u.pm] * estride; }
    __device__ __forceinline__ int arow(int pm, int r) const { const int t = stok[pm * BM + r]; return t < 0 ? 0 : t; }
};

struct EpiBf16 {
    static constexpr bool PERM = true;
    bf16_t* O; int ldc;
    __device__ __forceinline__ void operator()(const f32x4 (&acc)[2][2][4][2], const Unit& u, int wr, int wc, int fr, int fq) const {
        const int row0 = u.pm * BM + wr * 64 + fr, col0 = u.pn * BM + wc * 32 + 8 * fq;
#pragma unroll
        for (int ai = 0; ai < 2; ++ai)
#pragma unroll
            for (int m = 0; m < 4; ++m) { bf16_t* rowp = O + (size_t)(row0 + ai * HALF + m * 16) * ldc + col0;
#pragma unroll
                for (int bj = 0; bj < 2; ++bj) { const f32x4 v0 = acc[ai][bj][m][0], v1 = acc[ai][bj][m][1];
                    u32x4 w; w.x = cvt_pk_bf16(v0[0], v0[1]); w.y = cvt_pk_bf16(v0[2], v0[3]); w.z = cvt_pk_bf16(v1[0], v1[1]); w.w = cvt_pk_bf16(v1[2], v1[3]);
                    *(u32x4*)(rowp + bj * HALF) = w; } }
    }
};
struct EpiF8x8 {
    static constexpr bool PERM = true;
    unsigned char* O; int ldc;
    __device__ __forceinline__ void operator()(const f32x4 (&acc)[2][2][4][2], const Unit& u, int wr, int wc, int fr, int fq) const {
        const int row0 = u.pm * BM + wr * 64 + fr, col0 = u.pn * BM + wc * 32 + 8 * fq;
#pragma unroll
        for (int ai = 0; ai < 2; ++ai)
#pragma unroll
            for (int m = 0; m < 4; ++m) { unsigned char* rowp = O + (size_t)(row0 + ai * HALF + m * 16) * ldc + col0;
#pragma unroll
                for (int bj = 0; bj < 2; ++bj) { const f32x4 v0 = acc[ai][bj][m][0] * 8.f, v1 = acc[ai][bj][m][1] * 8.f;
                    u32x2 w; w.x = cvt4_fp8(v0[0], v0[1], v0[2], v0[3]); w.y = cvt4_fp8(v1[0], v1[1], v1[2], v1[3]);
                    *(u32x2*)(rowp + bj * HALF) = w; } }
    }
};
template <int LAYER> struct EpiHeads {
    static constexpr bool PERM = true;
    bf16_t* O; const float* rstd;
    __device__ __forceinline__ void operator()(const f32x4 (&acc)[2][2][4][2], const Unit& u, int wr, int wc, int fr, int fq) const {
        const int pn = u.pn, lc = wc * 32 + 8 * fq;
#pragma unroll
        for (int ai = 0; ai < 2; ++ai)
#pragma unroll
            for (int m = 0; m < 4; ++m) { const int row = u.pm * BM + ai * HALF + wr * 64 + m * 16 + fr, b = row >> 14, t = row & (SEQ - 1);
#pragma unroll
                for (int bj = 0; bj < 2; ++bj) { size_t off;
                    if (LAYER == 0) { if (pn < 4) off = gq_off(b, t, pn) + bj * 128 + lc; else if (pn < 8) off = GK0 + gq_off(b, t, pn - 4) + bj * 128 + lc;
                                      else if (pn < 16) off = gv_off(b, t, (pn - 8) >> 1) + ((pn - 8) & 1) * 256 + bj * 128 + lc; else off = GR0 + (size_t)row * 2048 + (pn - 16) * 256 + bj * 128 + lc; }
                    else { if (pn < 8) off = dq_off(b, t, pn, bj) + lc; else if (pn < 16) off = DK0 + dq_off(b, t, pn - 8, bj) + lc; else off = dv_off(b, t, pn - 16) + bj * 128 + lc; }
                    f32x4 v0 = acc[ai][bj][m][0], v1 = acc[ai][bj][m][1];
                    if (LAYER == 0) { const float rs = rstd[row]; v0 *= rs; v1 *= rs; }
                    if (LAYER == 1 && pn < 16) {
                        u32x2 w8; w8.x = cvt4_fp8(v0[0], v0[1], v0[2], v0[3]); w8.y = cvt4_fp8(v1[0], v1[1], v1[2], v1[3]); *(u32x2*)((unsigned char*)O + off) = w8; continue; }
                    u32x4 w; w.x = cvt_pk_bf16(v0[0], v0[1]); w.y = cvt_pk_bf16(v0[2], v0[3]); w.z = cvt_pk_bf16(v1[0], v1[1]); w.w = cvt_pk_bf16(v1[2], v1[3]);
                    *(u32x4*)(O + off) = w; } }
    }
};
__host__ __device__ __forceinline__ size_t vt_off(int b, int h, int chunk) { return DV0 * 2 + ((size_t)((b * 8 + h) * (SEQ / 64) + chunk)) * 16384; }
struct EpiVT {
    static constexpr bool PERM = false;
    unsigned char* O;
    __device__ __forceinline__ void operator()(const f32x4 (&acc)[2][2][4][2], const Unit& u, int wr, int wc, int fr, int fq) const {
#pragma unroll
        for (int ai = 0; ai < 2; ++ai) { const int row0 = u.pm * BM + ai * HALF + wr * 64;
            unsigned char* tp = O + vt_off(row0 >> 14, u.pn, (row0 & (SEQ - 1)) >> 6) + (size_t)(wc * 32 + fr) * 64 + 32 * (fq & 1) + 4 * (fq >> 1);
#pragma unroll
            for (int m = 0; m < 4; ++m)
#pragma unroll
                for (int bj = 0; bj < 2; ++bj)
#pragma unroll
                    for (int n = 0; n < 2; ++n) { const f32x4 v = acc[ai][bj][m][n];
                        *(unsigned*)(tp + (bj * 128 + n * 16) * 64 + 16 * (m >> 1) + 8 * (m & 1)) = cvt4_fp8(v[0], v[1], v[2], v[3]); } }
    }
};
struct FixOrder : StaticOrder {
    __device__ __forceinline__ size_t bofs(const Unit& u) const { return (size_t)(u.pm >> 5) * (512 * 256 * 2); }
};
struct EpiAddO {
    static constexpr bool PERM = true;
    bf16_t* O;
    __device__ __forceinline__ void operator()(const f32x4 (&acc)[2][2][4][2], const Unit& u, int wr, int wc, int fr, int fq) const {
#pragma unroll
        for (int ai = 0; ai < 2; ++ai)
#pragma unroll
            for (int m = 0; m < 4; ++m) { const int row = u.pm * BM + ai * HALF + wr * 64 + m * 16 + fr, bhh = row >> 13, t = row & 8191;
                bf16_t* rowp = O + ((size_t)(bhh >> 2) * SEQ + SEQ / 2 + t) * D + (bhh & 3) * 512 + u.pn * BM + wc * 32 + 8 * fq;
#pragma unroll
                for (int bj = 0; bj < 2; ++bj) { const u32x4 old = *(const u32x4*)(rowp + bj * HALF); const f32x4 v0 = acc[ai][bj][m][0] * 0.0625f, v1 = acc[ai][bj][m][1] * 0.0625f;
                    u32x4 w; w.x = cvt_pk_bf16(bf_lo(old.x) + v0[0], bf_hi(old.x) + v0[1]); w.y = cvt_pk_bf16(bf_lo(old.y) + v0[2], bf_hi(old.y) + v0[3]);
                    w.z = cvt_pk_bf16(bf_lo(old.z) + v1[0], bf_hi(old.z) + v1[1]); w.w = cvt_pk_bf16(bf_lo(old.w) + v1[2], bf_hi(old.w) + v1[3]);
                    *(u32x4*)(rowp + bj * HALF) = w; } }
    }
};
template <bool BASE16> struct EpiRes16 {
    static constexpr bool PERM = true;
    const void* base; bf16_t* C; int ldc;
    __device__ __forceinline__ void operator()(const f32x4 (&acc)[2][2][4][2], const Unit& u, int wr, int wc, int fr, int fq) const {
        const int row0 = u.pm * BM + wr * 64 + fr, col0 = u.pn * BM + wc * 32 + 8 * fq;
#pragma unroll
        for (int ai = 0; ai < 2; ++ai)
#pragma unroll
            for (int m = 0; m < 4; ++m) { const size_t off = (size_t)(row0 + ai * HALF + m * 16) * ldc + col0;
#pragma unroll
                for (int bj = 0; bj < 2; ++bj) { f32x4 v0 = acc[ai][bj][m][0], v1 = acc[ai][bj][m][1];
                    if constexpr (BASE16) { const u32x4 bs = *(const u32x4*)((const bf16_t*)base + off + bj * HALF);
                        v0 += (f32x4){bf_lo(bs.x), bf_hi(bs.x), bf_lo(bs.y), bf_hi(bs.y)}; v1 += (f32x4){bf_lo(bs.z), bf_hi(bs.z), bf_lo(bs.w), bf_hi(bs.w)}; }
                    else { const f32x4* bp = (const f32x4*)((const float*)base + off + bj * HALF); v0 += bp[0]; v1 += bp[1]; }
                    u32x4 w; w.x = cvt_pk_bf16(v0[0], v0[1]); w.y = cvt_pk_bf16(v0[2], v0[3]); w.z = cvt_pk_bf16(v1[0], v1[1]); w.w = cvt_pk_bf16(v1[2], v1[3]);
                    *(u32x4*)(C + off + bj * HALF) = w; }
                asm volatile("" ::: "memory"); }
    }
};
struct EpiSiluMul {
    static constexpr bool PERM = true;
    unsigned char* Hh;
    __device__ __forceinline__ void operator()(const f32x4 (&acc)[2][2][4][2], const Unit& u, int wr, int wc, int fr, int fq) const {
        const int row0 = u.pm * BM + wr * 64 + fr, col0 = u.pn * HALF + wc * 32 + 8 * fq;
#pragma unroll
        for (int ai = 0; ai < 2; ++ai)
#pragma unroll
            for (int m = 0; m < 4; ++m) { unsigned char* rowp = Hh + (size_t)(row0 + ai * HALF + m * 16) * DFF + col0;
                float hv[8];
#pragma unroll
                for (int n = 0; n < 2; ++n)
#pragma unroll
                    for (int j = 0; j < 4; ++j) { const float g = acc[ai][0][m][n][j], up = acc[ai][1][m][n][j];
                        const float sg = g * __builtin_amdgcn_rcpf(1.0f + __builtin_amdgcn_exp2f(-1.4426950408889634f * g)); hv[n * 4 + j] = sg * up; }
                u32x2 w; w.x = cvt4_fp8(hv[0], hv[1], hv[2], hv[3]); w.y = cvt4_fp8(hv[4], hv[5], hv[6], hv[7]);
                *(u32x2*)rowp = w; }
    }
};

template <class Epi, class Sched, bool GATHER = false, bool FP8 = false, bool NTR = false>
__device__ __forceinline__ void gemm_phase(LAS unsigned char* lds, const Gemm g, const Sched& S, const Epi& E, int tid_in) {
    const int tid = opq(tid_in), wid = __builtin_amdgcn_readfirstlane(tid >> 6), lane = tid & 63, wr = wid >> 2, wc = wid & 3, fr = lane & 15, fq = lane >> 4;
    const int K = g.K, RP = FP8 ? K : 2 * K  , nt = RP / (BK * 2);
    unsigned voffA[2], voffB[2];
#pragma unroll
    for (int i = 0; i < 2; ++i) { int R, C; stage_rc(tid * 16 + i * 8192, R, C); const int Rb = Epi::PERM ? ((R & ~31) + perm32(R & 31)) : R;
        voffA[i] = (unsigned)(R * RP + 2 * C); voffB[i] = (unsigned)(Rb * RP + 2 * C); }
    const unsigned kstep = (unsigned)(BK * 2);
    const unsigned hstep = (unsigned)HALF * (unsigned)RP;
    const size_t tstep = 2 * (size_t)hstep;
    const unsigned ldsw = (unsigned)wid * 1024u;
    const int aoff = lds_byte(wr * 64 + fr, fq * 8), boff = lds_byte(wc * 32 + fr, fq * 8);
    const LAS unsigned char* ldsB = lds + 4 * HTB + boff;
#define PG8_SA(b, h) (((b) * 2 + (h)) * HTB)
#define PG8_SB(b, h) ((4 + (b) * 2 + (h)) * HTB)
#define PG8_STAGE(bufoff, gbase, voff) do { const unsigned long long gv_ = (unsigned long long)(gbase); \
        const unsigned glo_ = (unsigned)__builtin_amdgcn_readfirstlane((unsigned)gv_), ghi_ = (unsigned)__builtin_amdgcn_readfirstlane((unsigned)(gv_ >> 32)); const char* gb_ = (const char*)(((unsigned long long)ghi_ << 32) | (unsigned long long)glo_);     \
        _Pragma("unroll") for (int _i = 0; _i < 2; ++_i) \
        __builtin_amdgcn_global_load_lds((const unsigned*)(gb_ + (voff)[_i]), (LAS unsigned*)(lds + (bufoff) + ldsw + _i * 8192), 16, 0, 0); } while (0)
#define PG8_STAGE_A(bufoff, nx, koff, h) do { if constexpr (GATHER) { unsigned vs_[2]; _Pragma("unroll") for (int _i = 0; _i < 2; ++_i) vs_[_i] = (nx) ? vAn[h][_i] : vAc[h][_i]; \
            PG8_STAGE(bufoff, (const char*)g.A + (koff), vs_); } \
        else { PG8_STAGE(bufoff, ((nx) ? nA : cA) + (koff) + (h) * hstep, voffA); } } while (0)
#define PG8_LD8(off) __builtin_shufflevector(*(const LAS v4i32*)(lds + (off)), *(const LAS v4i32*)(lds + (off) + 1024), 0, 1, 2, 3, 4, 5, 6, 7)
#define PG8_LDA(dst, b, h) do { if constexpr (FP8) { _Pragma("unroll") for (int m = 0; m < 4; ++m) dst##8[m] = PG8_LD8(PG8_SA(b, h) + aoff + m * 2048); } \
        else { _Pragma("unroll") for (int m = 0; m < 4; ++m) _Pragma("unroll") for (int k = 0; k < 2; ++k) dst[m][k] = *(const LAS bf16x8*)(lds + PG8_SA(b, h) + aoff + m * 2048 + k * 1024); } } while (0)
#define PG8_LD8B(off) __builtin_shufflevector(*(const LAS v4i32*)(ldsB + (off)), *(const LAS v4i32*)(ldsB + (off) + 1024), 0, 1, 2, 3, 4, 5, 6, 7)
#define PG8_LDB(dst, b, h) do { if constexpr (FP8) { _Pragma("unroll") for (int n = 0; n < 2; ++n) dst##8[n] = PG8_LD8B(PG8_SA(b, h) + n * 2048); }     \
        else { _Pragma("unroll") for (int n = 0; n < 2; ++n) _Pragma("unroll") for (int k = 0; k < 2; ++k) dst[n][k] = *(const LAS bf16x8*)(lds + PG8_SB(b, h) + boff + n * 2048 + k * 1024); } } while (0)
#define PG8_MMA(ai, bj, At, Bt) do { __builtin_amdgcn_s_setprio(1); if constexpr (FP8) { _Pragma("unroll") for (int m = 0; m < 4; ++m) _Pragma("unroll") for (int n = 0; n < 2; ++n) \
              \
            { if constexpr (NTR) asm volatile("v_mfma_scale_f32_16x16x128_f8f6f4 %0, %1, %2, %0, %3, %3 op_sel:[1,0,0] op_sel_hi:[0,0,0]" : "+v"(acc[ai][bj][m][n]) : "v"(At##8[m]), "v"(Bt##8[n]), "v"(scl8)); \
              else asm volatile("v_mfma_scale_f32_16x16x128_f8f6f4 %0, %1, %2, %0, %3, %3 op_sel:[0,1,0] op_sel_hi:[0,0,0]" : "+v"(acc[ai][bj][m][n]) : "v"(Bt##8[n]), "v"(At##8[m]), "v"(scl8)); } } \
        else { _Pragma("unroll") for (int m = 0; m < 4; ++m) _Pragma("unroll") for (int n = 0; n < 2; ++n) _Pragma("unroll") for (int k = 0; k < 2; ++k) \
            acc[ai][bj][m][n] = __builtin_amdgcn_mfma_f32_16x16x32_bf16(Bt[n][k], At[m][k], acc[ai][bj][m][n], 0, 0, 0); } __builtin_amdgcn_s_setprio(0); } while (0)
#define PG8_WAIT_V(n) asm volatile("s_waitcnt vmcnt(" #n ")" ::: "memory")
#define PG8_WAIT_L(n) asm volatile("s_waitcnt lgkmcnt(" #n ")" ::: "memory")
#define PG8_BAR __builtin_amdgcn_s_barrier()
#define PG8_SCHED __builtin_amdgcn_sched_barrier(0)
#define PG8_ROWOFFS(V, U) do { if constexpr (GATHER) { const int t_ = opq(wid * 64 + lane_id());     \
        _Pragma("unroll") for (int i_ = 0; i_ < 2; ++i_) { int R_, C_; stage_rc(t_ * 16 + i_ * 8192, R_, C_); \
        _Pragma("unroll") for (int h_ = 0; h_ < 2; ++h_) V[h_][i_] = (unsigned)S.arow((U).pm, h_ * HALF + R_) * (unsigned)RP + 2u * (unsigned)C_; } } } while (0)
    Unit cur, nxt; int ui = 0;
    if (!S.next(0, cur)) return;
    f32x4 acc[2][2][4][2];
#pragma unroll
    for (int a = 0; a < 2; ++a)
#pragma unroll
        for (int b = 0; b < 2; ++b)
#pragma unroll
            for (int m = 0; m < 4; ++m)
#pragma unroll
                for (int n = 0; n < 2; ++n) acc[a][b][m][n] = (f32x4){0.f, 0.f, 0.f, 0.f};
    const unsigned scl8 = 0x7f797f79u;
    bf16x8 At[4][2], B0[2][2], B1[2][2]; v8i32 At8[4], B08[2], B18[2];
    unsigned vAc[2][2] = {{0u, 0u}, {0u, 0u}}, vAn[2][2] = {{0u, 0u}, {0u, 0u}};
    const char* cA = (const char*)g.A + (GATHER ? (size_t)0 : (size_t)cur.pm * tstep); const char* nA = cA; const char* cB = (const char*)g.Bt + S.bofs(cur) + (size_t)cur.pn * tstep;
    PG8_ROWOFFS(vAc, cur);
    PG8_STAGE(PG8_SB(0, 0), cB, voffB); PG8_STAGE(PG8_SB(0, 1), cB + hstep, voffB); PG8_STAGE_A(PG8_SA(0, 0), false, 0u, 0); PG8_STAGE_A(PG8_SA(0, 1), false, 0u, 1);
    if (wr == 1) PG8_BAR;
    PG8_WAIT_V(2); PG8_BAR;
    PG8_STAGE(PG8_SB(1, 0), cB + kstep, voffB); PG8_STAGE_A(PG8_SA(1, 0), false, kstep, 0); PG8_STAGE(PG8_SB(1, 1), cB + hstep + kstep, voffB);
    PG8_WAIT_V(6); PG8_BAR;
    for (;;) {
        const bool has_next = S.next(ui + 1, nxt);
        nA = (has_next && !GATHER) ? (const char*)g.A + (size_t)nxt.pm * tstep : cA; const char* nB = has_next ? (const char*)g.Bt + S.bofs(nxt) + (size_t)nxt.pn * tstep : cB;

        for (int t = 0; t < nt; t += 2) {
            const bool last = (t == nt - 2);
            if constexpr (GATHER) { if (last) {
                if (has_next) PG8_ROWOFFS(vAn, nxt); else { _Pragma("unroll") for (int h_ = 0; h_ < 2; ++h_) _Pragma("unroll") for (int i_ = 0; i_ < 2; ++i_) vAn[h_][i_] = vAc[h_][i_]; } } }
            const unsigned k1 = (unsigned)(t + 1) * kstep, k2 = last ? 0u : (unsigned)(t + 2) * kstep, k3 = k2 + kstep;
            const char* b2 = last ? nB : cB + k2; const char* b3 = b2 + kstep;
            PG8_LDB(B0, 0, 0); PG8_LDB(B1, 0, 1); PG8_SCHED; PG8_LDA(At, 0, 0); PG8_STAGE_A(PG8_SA(1, 1), false, k1, 1);
            PG8_WAIT_V(8); PG8_WAIT_L(0); PG8_BAR; PG8_MMA(0, 0, At, B0); PG8_MMA(0, 1, At, B1); PG8_BAR; PG8_SCHED;
            PG8_LDA(At, 0, 1); PG8_STAGE(PG8_SB(0, 0), b2, voffB); PG8_STAGE(PG8_SB(0, 1), b2 + hstep, voffB); PG8_STAGE_A(PG8_SA(0, 0), last, k2, 0);
            PG8_WAIT_V(8); PG8_WAIT_L(0); PG8_BAR; PG8_MMA(1, 0, At, B0); PG8_MMA(1, 1, At, B1); PG8_BAR; PG8_SCHED;
            PG8_LDB(B0, 1, 0); PG8_LDB(B1, 1, 1); PG8_SCHED; PG8_LDA(At, 1, 0); PG8_STAGE_A(PG8_SA(0, 1), last, k2, 1);
            PG8_WAIT_V(8); PG8_WAIT_L(0); PG8_BAR; PG8_MMA(0, 0, At, B0); PG8_MMA(0, 1, At, B1); PG8_BAR; PG8_SCHED;
            PG8_LDA(At, 1, 1); PG8_STAGE(PG8_SB(1, 0), b3, voffB); PG8_STAGE(PG8_SB(1, 1), b3 + hstep, voffB); PG8_STAGE_A(PG8_SA(1, 0), last, k3, 0);
            PG8_WAIT_V(8); PG8_WAIT_L(0); PG8_BAR; PG8_MMA(1, 0, At, B0); PG8_MMA(1, 1, At, B1); PG8_BAR; PG8_SCHED;
        }
        if (wr == 0) PG8_BAR;
        E(acc, cur, wr, wc, fr, fq);
        if (!has_next) break;
#pragma unroll
        for (int a = 0; a < 2; ++a)
#pragma unroll
            for (int b = 0; b < 2; ++b)
#pragma unroll
                for (int m = 0; m < 4; ++m)
#pragma unroll
                    for (int n = 0; n < 2; ++n) acc[a][b][m][n] = (f32x4){0.f, 0.f, 0.f, 0.f};
        cur = nxt; cA = nA; cB = nB; ++ui;
        if constexpr (GATHER) { _Pragma("unroll") for (int h_ = 0; h_ < 2; ++h_) _Pragma("unroll") for (int i_ = 0; i_ < 2; ++i_) vAc[h_][i_] = vAn[h_][i_]; }
        if (wr == 1) PG8_BAR;
    }
    PG8_WAIT_V(0);
    PG8_BAR;
#undef PG8_SA
#undef PG8_SB
#undef PG8_STAGE
#undef PG8_STAGE_A
#undef PG8_ROWOFFS
#undef PG8_LDA
#undef PG8_LDB
#undef PG8_MMA
#undef PG8_LD8
#undef PG8_LD8B
#undef PG8_WAIT_V
#undef PG8_WAIT_L
#undef PG8_BAR
#undef PG8_SCHED
}
}

#define XB_TMO      128
#define XB_XCNT(j)  (256  + 64 * (j))
#define XB_XSUB(j)  (1280 + 64 * (j))
#define XB_XGEN(j)  (2304 + 64 * (j))
#define XB_TOP      3328
#define XB_TOPGEN   3392
#define XCD_BAR_WORDS 3456
#define XB_SPIN_CAP (1u << 18)
__device__ __forceinline__ unsigned xb_ld(unsigned* p)              { return __hip_atomic_load(p, __ATOMIC_RELAXED, __HIP_MEMORY_SCOPE_AGENT); }
__device__ __forceinline__ unsigned xb_add(unsigned* p, unsigned v) { return __hip_atomic_fetch_add(p, v, __ATOMIC_RELAXED, __HIP_MEMORY_SCOPE_AGENT); }
__device__ __forceinline__ unsigned xb_xcc_id() { return (unsigned)__builtin_amdgcn_s_getreg((3 << 11) | 20) & 0xFu; }
#define XB_SPIN(cond, bar) do { unsigned _sp = 0; while (cond) { __builtin_amdgcn_s_sleep(1); \
    if ((++_sp & 255u) == 0u) { if (xb_ld(&(bar)[XB_TMO])) break; if (_sp > XB_SPIN_CAP) { atomicAdd(&(bar)[XB_TMO], 1u); break; } } } } while (0)
struct XcdBarrier { unsigned* bar; unsigned x; volatile LAS unsigned* st; int wave; };
__device__ __forceinline__ XcdBarrier xcd_barrier_post(unsigned* bar, volatile LAS unsigned* st) {
    XcdBarrier b; b.bar = bar; b.x = xb_xcc_id(); b.st = st; b.wave = __builtin_amdgcn_readfirstlane((int)threadIdx.x >> 6);
    if (threadIdx.x == 0) (void)xb_add(&bar[XB_XCNT(b.x)], 1u);
    return b;
}
__device__ __forceinline__ void xcd_barrier_complete(unsigned* bar, unsigned x, unsigned& nloc, unsigned& nx) {
    const unsigned G = gridDim.x * gridDim.y * gridDim.z;
    unsigned sum, cnt, mine, sp = 0u;
    for (;;) {
        sum = 0u; cnt = 0u; mine = 0u;
#pragma unroll
        for (unsigned j = 0; j < 16; ++j) { const unsigned c = xb_ld(&bar[XB_XCNT(j)]); sum += c; cnt += (c > 0u) ? 1u : 0u; mine = (j == x) ? c : mine; }
        if (sum == G) break;
        __builtin_amdgcn_s_sleep(1);
        if ((++sp & 255u) == 0u) { if (xb_ld(&bar[XB_TMO])) break; if (sp > XB_SPIN_CAP) { atomicAdd(&bar[XB_TMO], 1u); break; } }
    }
    nloc = mine > 0u ? mine : 1u; nx = cnt > 0u ? cnt : 1u;
}
__device__ __forceinline__ void xcd_barrier(const XcdBarrier& b, bool leader  ) {
    asm volatile("s_waitcnt vmcnt(0)" ::: "memory");
    SYNCTHREADS();
    if (leader) {
        unsigned* bar = b.bar;
        __builtin_amdgcn_s_waitcnt(0);
        unsigned nloc = b.st[0], nx = b.st[1];
        if (nloc == 0u) { xcd_barrier_complete(bar, b.x, nloc, nx); b.st[0] = nloc; b.st[1] = nx; }
        const unsigned old = xb_add(&bar[XB_XSUB(b.x)], 1u);
        const unsigned gen = old / nloc;
        if (old + 1u == (gen + 1u) * nloc) {
            __builtin_amdgcn_fence(__ATOMIC_RELEASE, "agent");
            asm volatile("s_waitcnt vmcnt(0)" ::: "memory");
            const unsigned og = xb_add(&bar[XB_TOP], 1u);
            const unsigned tg = og / nx;
            if (og + 1u == (tg + 1u) * nx) xb_add(&bar[XB_TOPGEN], 1u);
            else XB_SPIN(xb_ld(&bar[XB_TOPGEN]) == tg, bar);
            __builtin_amdgcn_fence(__ATOMIC_ACQUIRE, "agent");
            xb_add(&bar[XB_XGEN(b.x)], 1u);
            asm volatile("s_waitcnt vmcnt(0)" ::: "memory");
        } else {
            XB_SPIN(xb_ld(&bar[XB_XGEN(b.x)]) == gen, bar);
            __builtin_amdgcn_fence(__ATOMIC_ACQUIRE, "agent");
            asm volatile("s_waitcnt vmcnt(0)" ::: "memory");
        }
    }
    SYNCTHREADS();
}

struct Frame {
    LAS unsigned char* lds;
    int tid, lane, wave, vcu, G;
};
struct Args {
    const float* in[21]; float* out; unsigned char* ws; int pad0, pad1;
};

struct TrItem { const float* src; unsigned char* dst; int ldw, ldk; const float* gk; };
__device__ __forceinline__ void tr_load(const TrItem& t, int lane, float (&tv)[32]) {
    const float* wp_ = t.src + (size_t)(lane >> 5) * t.ldw + (lane & 31);
#pragma unroll
    for (int i = 0; i < 32; ++i) tv[i] = wp_[(size_t)(2 * i) * t.ldw];
}
template <bool FP8>
__device__ __forceinline__ void tr_store(const TrItem& t, const float (&tv)[32], LAS float* scr, int lane) {
#pragma unroll
    for (int i = 0; i < 32; ++i) scr[(2 * i + (lane >> 5)) * 33 + (lane & 31)] = tv[i];
    LDS_WAIT(); asm volatile("" ::: "memory");
    const int c = lane & 7;
#pragma unroll
    for (int j = 0; j < 4; ++j) { const int n = (lane >> 3) + 8 * j; const LAS float* s = scr + (8 * c) * 33 + n;
        if constexpr (FP8) { u32x2 o; o.x = cvt4_fp8(s[0 * 33] * W8_SCALE, s[1 * 33] * W8_SCALE, s[2 * 33] * W8_SCALE, s[3 * 33] * W8_SCALE); o.y = cvt4_fp8(s[4 * 33] * W8_SCALE, s[5 * 33] * W8_SCALE, s[6 * 33] * W8_SCALE, s[7 * 33] * W8_SCALE);
            *(u32x2*)(t.dst + (size_t)n * t.ldk + 8 * c) = o; }
        else { f32x4 ga = {1.f, 1.f, 1.f, 1.f}, gb = ga; if (t.gk) { ga = *(const f32x4*)(t.gk + 8 * c); gb = *(const f32x4*)(t.gk + 8 * c + 4); }
            u32x4 o; o.x = cvt_pk_bf16(s[0 * 33] * ga[0], s[1 * 33] * ga[1]); o.y = cvt_pk_bf16(s[2 * 33] * ga[2], s[3 * 33] * ga[3]); o.z = cvt_pk_bf16(s[4 * 33] * gb[0], s[5 * 33] * gb[1]); o.w = cvt_pk_bf16(s[6 * 33] * gb[2], s[7 * 33] * gb[3]);
            *(u32x4*)(t.dst + ((size_t)n * t.ldk + 8 * c) * 2) = o; } }
    LDS_WAIT(); asm volatile("" ::: "memory");
}
#define TR_PIPELINE(FP8_, DECODE) do { if (gw < nit) { float tv_[32]; TrItem cur_ = DECODE(gw); tr_load(cur_, F.lane, tv_); \
        for (int it = gw; it < nit; it += NGW) { const int itn_ = it + NGW < nit ? it + NGW : it;     \
            float tn_[32]; const TrItem nxt_ = DECODE(itn_); tr_load(nxt_, F.lane, tn_); \
            tr_store<FP8_>(cur_, tv_, scr, F.lane); cur_ = nxt_; \
            _Pragma("unroll") for (int i_ = 0; i_ < 32; ++i_) tv_[i_] = tn_[i_]; } } } while (0)
template <bool FP8 = false>
__device__ __forceinline__ void conv_plain(Frame& F, const float* W, int K, int N, int ldw, bf16_t* WT, int rank = -1, int nrank = 0, const float* gain = nullptr) {
    LAS float* scr = (LAS float*)(F.lds + F.wave * 16384);
    const int gw = (rank < 0 ? F.vcu : rank) * NWAVES + F.wave, NGW = (rank < 0 ? F.G : nrank) * NWAVES, nblk = N / 32, nit = (K / 64) * nblk;
    auto decode = [&](int it) -> TrItem { const int kb = it / nblk, nb = it % nblk;
        return TrItem{W + (size_t)(64 * kb) * ldw + 32 * nb, (unsigned char*)WT + ((size_t)(32 * nb) * K + 64 * kb) * (FP8 ? 1 : 2), ldw, K, gain ? gain + 64 * kb : nullptr}; };
    TR_PIPELINE(FP8, decode);
}
__device__ __forceinline__ void conv_moe(Frame& F, const float* wg, const float* wu, const float* wd, bf16_t* GU, bf16_t* DT, int rank = -1, int nrank = 0, int e0 = 0, int ne = NEXP) {
    LAS float* scr = (LAS float*)(F.lds + F.wave * 16384);
    const int gw = (rank < 0 ? F.vcu : rank) * NWAVES + F.wave, NGW = (rank < 0 ? F.G : nrank) * NWAVES;
    constexpr int PER_E = 1536; const int nit = ne * PER_E;
    auto decode = [&](int it) -> TrItem { const int e = e0 + it / PER_E; int r = it % PER_E;
        if (r < 1024) { const int up = r >> 9; r &= 511; const int kb = r >> 4, nb = r & 15, n0 = 32 * nb;
            const int drow = 256 * (n0 >> 7) + 128 * up + (n0 & 127);
            return TrItem{(up ? wu : wg) + (size_t)e * D * DFF + (size_t)(64 * kb) * DFF + n0, (unsigned char*)GU + (size_t)e * 1024 * D + (size_t)drow * D + 64 * kb, DFF, D, nullptr}; }
        r -= 1024; const int kb = r >> 6, nb = r & 63;
        return TrItem{wd + (size_t)e * DFF * D + (size_t)(64 * kb) * D + 32 * nb, (unsigned char*)DT + (size_t)e * D * DFF + (size_t)(32 * nb) * DFF + 64 * kb, D, DFF, nullptr}; };
    TR_PIPELINE(true, decode);
}
__device__ __forceinline__ void pack_proj(Frame& F, float* Wp, int NT, const float* gain, const float* Wa, int lda, int ca0, int na, const float* Wb, int ldb, int nb) {
    const int total = 128 * NT * 256;
    for (int idx = (F.vcu * NWAVES * 64) + F.tid; idx < total; idx += F.G * NWAVES * 64) {
        const int e = idx & 3, ln = (idx >> 2) & 63, rest = idx >> 8, nt = rest % NT, s = rest / NT;
        const int k = 32 * (s >> 1) + 8 * (ln >> 4) + 4 * (s & 1) + e, col = 16 * nt + (ln & 15);
        float v = 0.f;
        if (col < na) v = Wa[(size_t)k * lda + ca0 + col]; else if (col < na + nb) v = Wb[(size_t)k * ldb + (col - na)];
        Wp[idx] = v * gain[k];
    }
}

__device__ __forceinline__ void pack_proj16(Frame& F, bf16_t* Wp, int NT, const float* gain, const float* Wa, int lda, int ca0, int na, const float* Wb, int ldb, int nb) {
    const int total = 64 * NT * 64 * 8;
    for (int idx = (F.vcu * NWAVES * 64) + F.tid; idx < total; idx += F.G * NWAVES * 64) {
        const int j = idx & 7, ln = (idx >> 3) & 63, rest = idx >> 9, nt = rest % NT, s = rest / NT;
        const int k = 32 * s + 8 * (ln >> 4) + j, col = 16 * nt + (ln & 15);
        float v = 0.f;
        if (col < na) v = Wa[(size_t)k * lda + ca0 + col]; else if (col < na + nb) v = Wb[(size_t)k * ldb + (col - na)];
        v *= gain[k];
        const unsigned hi = cvt_pk_bf16(v, 0.f) & 0xffffu; const float rem = v - __uint_as_float(hi << 16); const unsigned lo = cvt_pk_bf16(rem, 0.f) & 0xffffu;
        const size_t base = ((size_t)((s * NT + nt) * 2) * 64 + ln) * 8 + j;
        Wp[base] = (bf16_t)hi; Wp[base + 64 * 8] = (bf16_t)lo;
    }
}
template <int NT>
__device__ __forceinline__ float wave_proj16b(LAS unsigned char* lds, const bf16_t* xin, int tok0, const bf16_t* Wp, int tid, int wid, int lane, f32x4 (&acc)[NT]) {
    static_assert(NT == 3, "chunk = 24 KiB = 3 DMA instructions per thread");
    const int tr = lane & 15, kq = lane >> 4;
    const u32x4* xp = (const u32x4*)(xin + (size_t)(tok0 + tr) * D) + kq;
    constexpr int CH = 4 * NT * 2 * 1024;
    const char* wsrc = (const char*)Wp + tid * 16;
    float ssq = 0.f;
#pragma unroll
    for (int n = 0; n < NT; ++n) acc[n] = (f32x4){0.f, 0.f, 0.f, 0.f};
    u32x4 X[4];
#define NB_DMA(c, buf) do { _Pragma("unroll") for (int r = 0; r < 3; ++r) \
        __builtin_amdgcn_global_load_lds((const unsigned*)(wsrc + (size_t)(c) * CH + r * 8192), (LAS unsigned*)(lds + (buf) * CH + r * 8192 + wid * 1024), 16, 0, 0); } while (0)
#define NB_CHUNK(c, buf, more) do { \
        asm volatile("s_waitcnt vmcnt(4)" ::: "memory"); WG_BAR(); \
        if (more) NB_DMA((c) + 1, 1 - (buf)); \
        asm volatile("" ::: "memory"); \
        const u32x4* xn_ = xp + 16 * ((c) + 1); \
        _Pragma("unroll") for (int s = 0; s < 4; ++s) { const u32x4 xw = X[s]; if (more) X[s] = xn_[4 * s]; \
            _Pragma("unroll") for (int q = 0; q < 4; ++q) { const float a_ = bf_lo(xw[q]), b_ = bf_hi(xw[q]); ssq += a_ * a_ + b_ * b_; } \
            const bf16x8 xa = __builtin_bit_cast(bf16x8, xw); \
            _Pragma("unroll") for (int n = 0; n < NT; ++n) _Pragma("unroll") for (int pc = 0; pc < 2; ++pc) { \
                const bf16x8 wv = *(const LAS bf16x8*)(lds + (buf) * CH + (((s * NT + n) * 2 + pc) * 64 + lane) * 16); \
                acc[n] = __builtin_amdgcn_mfma_f32_16x16x32_bf16(xa, wv, acc[n], 0, 0, 0); } } } while (0)
    NB_DMA(0, 0);
    asm volatile("" ::: "memory");
#pragma unroll
    for (int s = 0; s < 4; ++s) X[s] = xp[4 * s];
    for (int c = 0; c < 14; c += 2) { NB_CHUNK(c, 0, true); NB_CHUNK(c + 1, 1, true); }
    NB_CHUNK(14, 0, true); NB_CHUNK(15, 1, false);
    WG_BAR();
#undef NB_DMA
#undef NB_CHUNK
    ssq += __shfl_xor(ssq, 16); ssq += __shfl_xor(ssq, 32);
    return 1.0f / sqrtf(ssq * (1.0f / D) + RMS_EPS);
}
template <int NT, bool XB16 = false>
__device__ __forceinline__ float wave_proj16(LAS unsigned char* lds, const void* xin, int tok0, const float* Wp, int tid, int wid, int lane, f32x4 (&acc)[NT], bf16_t* xb16) {
    typedef typename XRow<XB16>::T XT;
    const int tr = lane & 15, kq = lane >> 4;
    const XT* xp = (const XT*)xin + (size_t)(tok0 + tr) * (D / 4) + 2 * kq;
    u32x4* hb = (u32x4*)(xb16 + (size_t)(tok0 + tr) * D) + kq;
    constexpr int CH = 16 * NT * 1024;
    const char* wsrc = (const char*)Wp + tid * 16;
    float ssq = 0.f;
#pragma unroll
    for (int n = 0; n < NT; ++n) acc[n] = (f32x4){0.f, 0.f, 0.f, 0.f};
    XT X[16];
#define NP_DMA(c, buf) do { _Pragma("unroll") for (int r = 0; r < 2 * NT; ++r) \
        __builtin_amdgcn_global_load_lds((const unsigned*)(wsrc + (size_t)(c) * CH + r * 8192), (LAS unsigned*)(lds + (buf) * CH + r * 8192 + wid * 1024), 16, 0, 0); } while (0)
#define NP_CHUNK(c, buf, more) do { \
        asm volatile("s_waitcnt vmcnt(16)" ::: "memory"); WG_BAR(); \
        if (more) NP_DMA((c) + 1, 1 - (buf)); \
        asm volatile("" ::: "memory");     \
        const XT* xn_ = xp + 64 * ((c) + 1); \
        _Pragma("unroll") for (int s = 0; s < 16; ++s) { const f32x4 xv = XRow<XB16>::get(X[s]); \
            if (s & 1) { const f32x4 xl_ = XRow<XB16>::get(X[s - 1]); u32x4 w_; w_.x = cvt_pk_bf16(xl_[0], xl_[1]); w_.y = cvt_pk_bf16(xl_[2], xl_[3]); w_.z = cvt_pk_bf16(xv[0], xv[1]); w_.w = cvt_pk_bf16(xv[2], xv[3]); \
                hb[32 * (c) + 4 * (s >> 1)] = w_; if (more) { X[s - 1] = xn_[8 * (s >> 1)]; X[s] = xn_[8 * (s >> 1) + 1]; } } \
            ssq += (xv[0] * xv[0] + xv[1] * xv[1]) + (xv[2] * xv[2] + xv[3] * xv[3]); \
            _Pragma("unroll") for (int n = 0; n < NT; ++n) { const f32x4 wv = *(const LAS f32x4*)(lds + (buf) * CH + ((s * NT + n) * 64 + lane) * 16); \
                _Pragma("unroll") for (int e = 0; e < 4; ++e) acc[n] = __builtin_amdgcn_mfma_f32_16x16x4f32(xv[e], wv[e], acc[n], 0, 0, 0); } } } while (0)
    NP_DMA(0, 0);
    asm volatile("" ::: "memory");
#pragma unroll
    for (int s = 0; s < 16; ++s) X[s] = xp[8 * (s >> 1) + (s & 1)];
    for (int c = 0; c < 6; c += 2) { NP_CHUNK(c, 0, true); NP_CHUNK(c + 1, 1, true); }
    NP_CHUNK(6, 0, true); NP_CHUNK(7, 1, false);
    WG_BAR();
#undef NP_DMA
#undef NP_CHUNK
    ssq += __shfl_xor(ssq, 16); ssq += __shfl_xor(ssq, 32);
    return 1.0f / sqrtf(ssq * (1.0f / D) + RMS_EPS);
}
template <bool FP8 = false, bool XB16 = false>
__device__ __forceinline__ void wave_write_hn16(const void* xin, int tok0, float rstd, const float* gain, bf16_t* hn, int lane) {
    typedef typename XRow<XB16>::T XT;
    f32x4 g4[8];
#pragma unroll
    for (int j = 0; j < 8; ++j) g4[j] = ((const f32x4*)gain)[lane + 64 * j];
    for (int i = 0; i < 16; i += 2) {
        const float r0 = __shfl(rstd, i), r1 = __shfl(rstd, i + 1);
        const XT* x0 = (const XT*)xin + (size_t)(tok0 + i) * (D / 4); const XT* x1 = x0 + D / 4;
        u32x2* o0 = (u32x2*)(hn + (size_t)(tok0 + i) * D); u32x2* o1 = o0 + D / 4;
        unsigned* p0 = (unsigned*)((unsigned char*)hn + (size_t)(tok0 + i) * D); unsigned* p1 = p0 + D / 4;
        XT a[8], c[8];
#pragma unroll
        for (int j = 0; j < 8; ++j) { a[j] = x0[lane + 64 * j]; c[j] = x1[lane + 64 * j]; }
#pragma unroll
        for (int j = 0; j < 8; ++j) { const f32x4 v = XRow<XB16>::get(a[j]) * r0 * g4[j], u = XRow<XB16>::get(c[j]) * r1 * g4[j];
            if constexpr (FP8) { p0[lane + 64 * j] = cvt4_fp8(v[0], v[1], v[2], v[3]); p1[lane + 64 * j] = cvt4_fp8(u[0], u[1], u[2], u[3]); }
            else { u32x2 w; w.x = cvt_pk_bf16(v[0], v[1]); w.y = cvt_pk_bf16(v[2], v[3]); o0[lane + 64 * j] = w;
                u32x2 z; z.x = cvt_pk_bf16(u[0], u[1]); z.y = cvt_pk_bf16(u[2], u[3]); o1[lane + 64 * j] = z; } }
    }
}

__device__ __forceinline__ void phase_norm_gz(Frame& F, const float* xin, const float* Wp, bf16_t* hn, float* gz, float* rstd_tab) {
    for (int tile = F.vcu; tile < T / 128; tile += F.G) {
        const int tok0 = tile * 128 + F.wave * 16;
        f32x4 acc[1];
        const float rstd = wave_proj16<1>(F.lds, xin, tok0, Wp, F.tid, F.wave, F.lane, acc, hn);
        if (F.lane < 16) rstd_tab[tok0 + F.lane] = rstd;
        const int j = F.lane & 15, q4 = F.lane >> 4;
#pragma unroll
        for (int r = 0; r < 4; ++r) { const float rr = __shfl(rstd, 4 * q4 + r); gz[(size_t)(tok0 + 4 * q4 + r) * 16 + j] = acc[0][r] * rr; }
    }
}
__device__ __forceinline__ void phase_norm_route(Frame& F, const bf16_t* xin, const float* gain, const float* Wp, bf16_t* hn, int* tok_e, int* tok_p, float* tok_w, unsigned* cnt) {
    LAS float* lg = (LAS float*)(F.lds + 98304 + F.wave * 3072);
    for (int tile = F.vcu; tile < T / 128; tile += F.G) {
        const int tok0 = tile * 128 + F.wave * 16;
        f32x4 acc[3];
        const float rstd = wave_proj16b<3>(F.lds, xin, tok0, (const bf16_t*)Wp, F.tid, F.wave, F.lane, acc);
        const int j = F.lane & 15, q4 = F.lane >> 4;
#pragma unroll
        for (int r = 0; r < 4; ++r) { const float rr = __shfl(rstd, 4 * q4 + r);
#pragma unroll
            for (int n = 0; n < 3; ++n) lg[(4 * q4 + r) * 48 + 16 * n + j] = acc[n][r] * rr; }
        LDS_WAIT(); asm volatile("" ::: "memory");
        if (F.lane < 16) {
            const LAS float* l = lg + F.lane * 48;
            float gm = l[0]; int gi = 0;
#pragma unroll
            for (int q = 1; q < 4; ++q) { const float v = l[q]; if (v > gm) { gm = v; gi = q; } }
            float gs = 0.f;
#pragma unroll
            for (int q = 0; q < 4; ++q) gs += __expf(l[q] - gm);
            const float gw = 1.0f / gs;
            const LAS float* se = l + 4 + 8 * gi;
            float m1 = se[0]; int i1 = 0;
#pragma unroll
            for (int q = 1; q < 8; ++q) { const float v = se[q]; if (v > m1) { m1 = v; i1 = q; } }
            float m2 = -3.0e38f; int i2 = 0;
#pragma unroll
            for (int q = 0; q < 8; ++q) { const float v = se[q]; if (q != i1 && v > m2) { m2 = v; i2 = q; } }
            const float eb = __expf(m2 - m1), inv = 1.0f / (1.0f + eb);
            const int t = tok0 + F.lane, e1 = gi * 8 + i1, e2 = gi * 8 + i2;
            const unsigned p1 = __hip_atomic_fetch_add(cnt + 64 * e1, 1u, __ATOMIC_RELAXED, __HIP_MEMORY_SCOPE_AGENT);
            const unsigned p2 = __hip_atomic_fetch_add(cnt + 64 * e2, 1u, __ATOMIC_RELAXED, __HIP_MEMORY_SCOPE_AGENT);
            tok_e[2 * t] = e1; tok_e[2 * t + 1] = e2; tok_p[2 * t] = (int)p1; tok_p[2 * t + 1] = (int)p2;
            tok_w[2 * t] = gw * inv; tok_w[2 * t + 1] = gw * eb * inv;
        }
        wave_write_hn16<true, true>(xin, tok0, rstd, gain, hn, F.lane);
        LDS_WAIT(); asm volatile("" ::: "memory");
    }
}

__device__ __forceinline__ void phase_gla_gate(Frame& F, const float* gz, const float* wgu, const float* bgate, const bf16_t* proj, bf16_t* kdT, float* adec) {
    LAS f32x4* gzs = (LAS f32x4*)F.lds;
    for (int u = F.vcu; u < NBATCH * NCH * 2; u += F.G) {
        const int half = u & 1, bc = u >> 1;
        const int tok0 = bc * 64, j = half * 512 + F.tid;
        if (F.tid < 256) gzs[F.tid] = ((const f32x4*)(gz + (size_t)tok0 * 16))[F.tid];
        float wg[16];
#pragma unroll
        for (int r = 0; r < 16; ++r) wg[r] = wgu[r * GLA_DKT + j];
        const float bg = bgate[j];
        WG_BAR();
        float cum[64]; float run = 0.f;
#pragma unroll
        for (int t = 0; t < 64; ++t) {
            float z = bg;
#pragma unroll
            for (int r4 = 0; r4 < 4; ++r4) { const f32x4 g4 = gzs[t * 4 + r4]; z += g4[0] * wg[4 * r4] + g4[1] * wg[4 * r4 + 1] + g4[2] * wg[4 * r4 + 2] + g4[3] * wg[4 * r4 + 3]; }
            const float ls = fminf(z, 0.f) - __logf(1.0f + __expf(-fabsf(z)));
            run += ls * (1.0f / 16.0f); cum[t] = run;
        }
        adec[(size_t)bc * GLA_DKT + j] = __expf(run);
        const bf16_t* kp = proj + GK0 + gq_off(bc >> 8, (bc & 255) * 64, j >> 8) + (j & 255);
        u32x4* dst = (u32x4*)(kdT + ((size_t)bc * GLA_DKT + j) * 64);
#pragma unroll
        for (int t8 = 0; t8 < 8; ++t8) {
            float kd[8];
#pragma unroll
            for (int q = 0; q < 8; ++q) { const int t = t8 * 8 + q; kd[q] = bf2f(kp[(size_t)t * 256]) * __expf(run - cum[t]); }
            u32x4 w; w.x = cvt_pk_bf16(kd[0], kd[1]); w.y = cvt_pk_bf16(kd[2], kd[3]); w.z = cvt_pk_bf16(kd[4], kd[5]); w.w = cvt_pk_bf16(kd[6], kd[7]);
            dst[t8] = w;
        }
        WG_BAR();
    }
}

constexpr int SCAN_VROW = 144, SCAN_SROW = 528, SCAN_VBUF = 64 * SCAN_VROW, SCAN_SBUF = 64 * SCAN_SROW;
__device__ __forceinline__ void phase_gla_scan(Frame& F, int it, const bf16_t* proj, const bf16_t* kdT, const float* adec, bf16_t* oout, bf16_t* sfin) {
    const int lane = F.lane, w = F.wave, fr = lane & 15, kq = lane >> 4, tid = F.tid;
    LAS unsigned char* vbuf = F.lds;
    LAS unsigned char* sbuf = F.lds + 2 * SCAN_VBUF;
    const int bh = it >> 4, seg = (it >> 3) & 1, b = bh >> 2, h = bh & 3, sl = it & 7, mt = w & 3, ntp = w >> 2, c0 = seg * (NCH / 2);
    const size_t tokb = (size_t)b * SEQ;
    f32x4 st[2][4];
#pragma unroll
    for (int i = 0; i < 2; ++i)
#pragma unroll
        for (int n = 0; n < 4; ++n) st[i][n] = (f32x4){0.f, 0.f, 0.f, 0.f};
    bf16x8 ka0[2][2], ka1[2][2], q0[8], q1[8]; f32x4 dc0[2], dc1[2]; u32x4 vr0, vr1;
#define CL(c) ((c) < NCH ? (c) : NCH - 1)
#define LOAD_KA(KA, DC, c) do { const size_t bc_ = (size_t)b * NCH + CL(c); \
        _Pragma("unroll") for (int i = 0; i < 2; ++i) { \
            _Pragma("unroll") for (int s = 0; s < 2; ++s) KA[i][s] = *(const bf16x8*)(kdT + ((bc_ * GLA_DKT + h * 256 + 32 * w + 16 * i + fr) * 64 + 32 * s + 8 * kq)); \
            DC[i] = *(const f32x4*)(adec + bc_ * GLA_DKT + h * 256 + 32 * w + 16 * i + 4 * kq); } } while (0)
#define LOAD_V(VR, c) do { VR = *(const u32x4*)(proj + gv_off(b, CL(c) * 64 + (tid >> 3), h) + 64 * sl + 8 * (tid & 7)); } while (0)
#define LOAD_Q(Q, c) do { const bf16_t* qp_ = proj + gq_off(b, CL(c) * 64 + 16 * mt + fr, h) + 8 * kq; \
        _Pragma("unroll") for (int s = 0; s < 8; ++s) Q[s] = *(const bf16x8*)(qp_ + 32 * s); } while (0)
#define STORE_V(VR, buf) do { *(LAS u32x4*)(vbuf + (buf) * SCAN_VBUF + (tid >> 3) * SCAN_VROW + (tid & 7) * 16) = VR; } while (0)
#define SCAN_STEP(KA, DC, VN, VM, QC, QN, c) do { \
        const unsigned vb_ = (unsigned)(uintptr_t)(vbuf + ((c) & 1) * SCAN_VBUF) + (unsigned)((8 * kq + ((lane & 15) >> 2)) * SCAN_VROW + 8 * (lane & 3)); \
        s16x4 tv[4][4];     \
        asm volatile("ds_read_b64_tr_b16 %0, %16 offset:0\n\tds_read_b64_tr_b16 %1, %16 offset:576\n\tds_read_b64_tr_b16 %2, %16 offset:4608\n\tds_read_b64_tr_b16 %3, %16 offset:5184\n\t" \
                     "ds_read_b64_tr_b16 %4, %16 offset:32\n\tds_read_b64_tr_b16 %5, %16 offset:608\n\tds_read_b64_tr_b16 %6, %16 offset:4640\n\tds_read_b64_tr_b16 %7, %16 offset:5216\n\t" \
                     "ds_read_b64_tr_b16 %8, %16 offset:64\n\tds_read_b64_tr_b16 %9, %16 offset:640\n\tds_read_b64_tr_b16 %10, %16 offset:4672\n\tds_read_b64_tr_b16 %11, %16 offset:5248\n\t" \
                     "ds_read_b64_tr_b16 %12, %16 offset:96\n\tds_read_b64_tr_b16 %13, %16 offset:672\n\tds_read_b64_tr_b16 %14, %16 offset:4704\n\tds_read_b64_tr_b16 %15, %16 offset:5280\n\ts_waitcnt lgkmcnt(0)" \
                     : "=&v"(tv[0][0]), "=&v"(tv[0][1]), "=&v"(tv[0][2]), "=&v"(tv[0][3]), "=&v"(tv[1][0]), "=&v"(tv[1][1]), "=&v"(tv[1][2]), "=&v"(tv[1][3]), \
                       "=&v"(tv[2][0]), "=&v"(tv[2][1]), "=&v"(tv[2][2]), "=&v"(tv[2][3]), "=&v"(tv[3][0]), "=&v"(tv[3][1]), "=&v"(tv[3][2]), "=&v"(tv[3][3]) : "v"(vb_) : "memory"); \
        _Pragma("unroll") for (int n = 0; n < 4; ++n) { \
            const bf16x8 vf0 = (bf16x8){tv[n][0][0], tv[n][0][1], tv[n][0][2], tv[n][0][3], tv[n][1][0], tv[n][1][1], tv[n][1][2], tv[n][1][3]}; \
            const bf16x8 vf1 = (bf16x8){tv[n][2][0], tv[n][2][1], tv[n][2][2], tv[n][2][3], tv[n][3][0], tv[n][3][1], tv[n][3][2], tv[n][3][3]}; \
            _Pragma("unroll") for (int i = 0; i < 2; ++i) { \
                st[i][n] = st[i][n] * DC[i]; \
                st[i][n] = __builtin_amdgcn_mfma_f32_16x16x32_bf16(KA[i][0], vf0, st[i][n], 0, 0, 0); \
                st[i][n] = __builtin_amdgcn_mfma_f32_16x16x32_bf16(KA[i][1], vf1, st[i][n], 0, 0, 0); } } \
        LOAD_KA(KA, DC, (c) + 2); \
        { LAS unsigned char* sb_ = sbuf + ((c) & 1) * SCAN_SBUF + fr * SCAN_SROW + (32 * w + 4 * kq) * 2; \
          _Pragma("unroll") for (int i = 0; i < 2; ++i) _Pragma("unroll") for (int n = 0; n < 4; ++n) { \
              u32x2 pk; pk.x = cvt_pk_bf16(st[i][n][0], st[i][n][1]); pk.y = cvt_pk_bf16(st[i][n][2], st[i][n][3]); \
              *(LAS u32x2*)(sb_ + n * 16 * SCAN_SROW + i * 32) = pk; } } \
        STORE_V(VN, ((c) + 1) & 1); \
        LOAD_V(VN, (c) + 3); \
        WG_BAR(); \
        { f32x4 a0 = (f32x4){0.f, 0.f, 0.f, 0.f}, a1 = a0; \
          const LAS unsigned char* sr_ = sbuf + ((c) & 1) * SCAN_SBUF + (32 * ntp + fr) * SCAN_SROW + 16 * kq; \
          _Pragma("unroll") for (int hb = 0; hb < 2; ++hb) { bf16x8 bb[4][2];     \
              _Pragma("unroll") for (int s = 0; s < 4; ++s) { bb[s][0] = *(const LAS bf16x8*)(sr_ + 64 * (4 * hb + s)); bb[s][1] = *(const LAS bf16x8*)(sr_ + 16 * SCAN_SROW + 64 * (4 * hb + s)); } \
              asm volatile("s_waitcnt lgkmcnt(0)" ::: "memory"); __builtin_amdgcn_sched_barrier(0); \
              _Pragma("unroll") for (int s = 0; s < 4; ++s) { \
                  a0 = __builtin_amdgcn_mfma_f32_16x16x32_bf16(QC[4 * hb + s], bb[s][0], a0, 0, 0, 0); \
                  a1 = __builtin_amdgcn_mfma_f32_16x16x32_bf16(QC[4 * hb + s], bb[s][1], a1, 0, 0, 0); } } \
          bf16_t* op_ = oout + (tokb + (size_t)(c) * 64 + 16 * mt + 4 * kq) * D + h * 512 + 64 * sl + 32 * ntp + fr; \
          _Pragma("unroll") for (int r = 0; r < 4; ++r) { \
              const float x0 = a0[r] * 0.0625f, x1 = a1[r] * 0.0625f, y0 = __shfl_xor(x0, 1), y1 = __shfl_xor(x1, 1); \
              if ((fr & 1) == 0) { *(unsigned*)(op_ + (size_t)r * D) = cvt_pk_bf16(x0, y0); *(unsigned*)(op_ + (size_t)r * D + 16) = cvt_pk_bf16(x1, y1); } } } \
        LOAD_Q(QC, (c) + 2); \
    } while (0)
    LOAD_KA(ka0, dc0, c0); LOAD_KA(ka1, dc1, c0 + 1); LOAD_V(vr0, c0); LOAD_V(vr1, c0 + 1); LOAD_Q(q0, c0); LOAD_Q(q1, c0 + 1);
    STORE_V(vr0, 0); LOAD_V(vr0, c0 + 2);
    WG_BAR();
    for (int c = c0; c < c0 + NCH / 2; c += 2) {
        SCAN_STEP(ka0, dc0, vr1, vr0, q0, q1, c);
        SCAN_STEP(ka1, dc1, vr0, vr1, q1, q0, c + 1);
    }
    if (seg == 0) {
#pragma unroll
        for (int i = 0; i < 2; ++i)
#pragma unroll
            for (int n = 0; n < 4; ++n) { u32x2 pk; pk.x = cvt_pk_bf16(st[i][n][0], st[i][n][1]); pk.y = cvt_pk_bf16(st[i][n][2], st[i][n][3]);
                *(u32x2*)(sfin + ((size_t)(bh * 512 + 64 * sl + 16 * n + fr)) * 256 + 32 * w + 16 * i + 4 * kq) = pk; }
    }
    WG_BAR();
#undef CL
#undef LOAD_KA
#undef LOAD_V
#undef LOAD_Q
#undef STORE_V
#undef SCAN_STEP
}

__device__ __forceinline__ void gla_pcum(Frame& F, const float* adec, float* pcum, int rank, int nrank) {
    for (int idx = rank * (NWAVES * 64) + F.tid; idx < NBATCH * GLA_DKT; idx += nrank * NWAVES * 64) { const int b = idx >> 10, j = idx & 1023;
        const float* ap = adec + ((size_t)(b * NCH + NCH / 2)) * GLA_DKT + j; float* pp = pcum + (size_t)(b * (NCH / 2)) * GLA_DKT + j; float pr = 1.f;
#pragma unroll 16
        for (int cc = 0; cc < NCH / 2; ++cc) { pr *= ap[(size_t)cc * GLA_DKT]; pp[(size_t)cc * GLA_DKT] = pr; } }
}
__device__ __forceinline__ void phase_gla_qp(Frame& F, const bf16_t* proj, const float* pcum, bf16_t* qp) {
    const int gw = F.vcu * NWAVES + F.wave, NGW = F.G * NWAVES, lane = F.lane;
    for (int r = gw; r < NBATCH * (SEQ / 2); r += NGW) { const int b = r >> 13, t = r & 8191;
        u32x2 qv[4]; f32x4 pv[4];
#pragma unroll
        for (int h = 0; h < 4; ++h) { qv[h] = *(const u32x2*)(proj + gq_off(b, SEQ / 2 + t, h) + 4 * lane); pv[h] = *(const f32x4*)(pcum + ((size_t)(b * (NCH / 2) + (t >> 6)) * GLA_DKT + h * 256 + 4 * lane)); }
#pragma unroll
        for (int h = 0; h < 4; ++h) { u32x2 w; w.x = cvt_pk_bf16(bf_lo(qv[h].x) * pv[h][0], bf_hi(qv[h].x) * pv[h][1]); w.y = cvt_pk_bf16(bf_lo(qv[h].y) * pv[h][2], bf_hi(qv[h].y) * pv[h][3]);
            *(u32x2*)(qp + ((size_t)((b * 4 + h) * (SEQ / 2) + t)) * 256 + 4 * lane) = w; }
    }
}
__device__ __forceinline__ void phase_gla_gnorm(Frame& F, const bf16_t* o, const bf16_t* proj, const float* gn, bf16_t* y) {
    const int gw = F.vcu * NWAVES + F.wave, NGW = F.G * NWAVES, lane = F.lane;
    const f32x4 g0 = ((const f32x4*)gn)[2 * lane], g1 = ((const f32x4*)gn)[2 * lane + 1];
    for (int tok = gw; tok < T; tok += NGW) {
        u32x4 ov[4], rv[4];
#pragma unroll
        for (int h = 0; h < 4; ++h) { ov[h] = *(const u32x4*)(o + (size_t)tok * D + h * 512 + 8 * lane); rv[h] = *(const u32x4*)(proj + GR0 + (size_t)tok * 2048 + h * 512 + 8 * lane); }
        float ss[4];
#pragma unroll
        for (int h = 0; h < 4; ++h) { float s = 0.f;
#pragma unroll
            for (int q = 0; q < 4; ++q) { const float lo = bf_lo(ov[h][q]), hi = bf_hi(ov[h][q]); s += lo * lo + hi * hi; }
            ss[h] = s; }
#pragma unroll
        for (int of = 1; of < 64; of <<= 1) {
#pragma unroll
            for (int h = 0; h < 4; ++h) ss[h] += __shfl_xor(ss[h], of); }
#pragma unroll
        for (int h = 0; h < 4; ++h) { const float rstd = 1.0f / sqrtf(ss[h] * (1.0f / 512.0f) + RMS_EPS);
            float yv[8];
#pragma unroll
            for (int q = 0; q < 4; ++q) { const float a0 = bf_lo(ov[h][q]), a1 = bf_hi(ov[h][q]), r0 = bf_lo(rv[h][q]), r1 = bf_hi(rv[h][q]);
                const float gA = q < 2 ? g0[2 * q] : g1[2 * q - 4], gB = q < 2 ? g0[2 * q + 1] : g1[2 * q - 3];
                yv[2 * q] = a0 * rstd * gA * (r0 / (1.0f + __expf(-r0))); yv[2 * q + 1] = a1 * rstd * gB * (r1 / (1.0f + __expf(-r1))); }
            u32x4 w; w.x = cvt_pk_bf16(yv[0], yv[1]); w.y = cvt_pk_bf16(yv[2], yv[3]); w.z = cvt_pk_bf16(yv[4], yv[5]); w.w = cvt_pk_bf16(yv[6], yv[7]);
            *(u32x4*)(y + (size_t)tok * D + h * 512 + 8 * lane) = w; }
    }
}

__device__ __forceinline__ void moe_tables(Frame& F, unsigned* cnt) {
    LAS int* pst = (LAS int*)(F.lds + TAB_OFF);
    LAS int* te = pst + 36;
    if (F.wave == 0) {
        const int e = F.lane & 31;
        const int c = (int)xb_ld(cnt + 64 * e);
        const int ntile = (c + 255) >> 8;
        int incl = ntile;
#pragma unroll
        for (int o = 1; o < 32; o <<= 1) { const int v = __shfl_up(incl, o); if ((F.lane & 31) >= o) incl += v; }
        const int excl = incl - ntile;
        if (F.lane < 32) { pst[e] = excl << 8; for (int q = 0; q < ntile; ++q) te[excl + q] = e; }
        if (F.lane == 31) { pst[32] = incl << 8; pst[33] = incl; }
    }
    WG_BAR();
}
__device__ __forceinline__ void phase_moe_slots(Frame& F, const int* tok_e, const int* tok_p, unsigned* cnt, int* slot_of, int* slot_tok) {
    const LAS int* pst = (const LAS int*)(F.lds + TAB_OFF);
    for (int e = F.vcu; e < NEXP; e += F.G) { const int c = (int)xb_ld(cnt + 64 * e), lo = pst[e] + c, hi = pst[e] + (((c + 255) >> 8) << 8);
        for (int s = lo + F.tid; s < hi; s += NWAVES * 64) slot_tok[s] = -1; }
    for (int a = F.vcu * NWAVES * 64 + F.tid; a < 2 * T; a += F.G * NWAVES * 64) { const int slot = pst[tok_e[a]] + tok_p[a]; slot_of[a] = slot; slot_tok[slot] = a >> 1; }
}
__device__ __forceinline__ void phase_moe_copy8(Frame& F, const int* tok_e, const int* tok_p, const unsigned char* hn8, unsigned char* ag8) {
    const LAS int* pst = (const LAS int*)(F.lds + TAB_OFF);
    const int gw = F.vcu * NWAVES + F.wave, NGW = F.G * NWAVES, lane = F.lane;
    for (int t = gw; t < T; t += NGW) {
        const int s0 = pst[tok_e[2 * t]] + tok_p[2 * t], s1 = pst[tok_e[2 * t + 1]] + tok_p[2 * t + 1];
        const u32x4* src = (const u32x4*)(hn8 + (size_t)t * D); const u32x4 v0 = src[lane], v1 = src[lane + 64];
        u32x4* d0 = (u32x4*)(ag8 + (size_t)s0 * D); u32x4* d1 = (u32x4*)(ag8 + (size_t)s1 * D);
        d0[lane] = v0; d0[lane + 64] = v1; d1[lane] = v0; d1[lane + 64] = v1;
    }
}
template <int MODE>
__device__ __forceinline__ void phase_moe_combine(Frame& F, bf16_t* x, float* out, const bf16_t* ob, const int* slot_of, const float* tok_w, const float* gain, bf16_t* hn) {
    const int gw = F.vcu * NWAVES + F.wave, NGW = F.G * NWAVES, lane = F.lane;
    f32x4 g4[8];
#pragma unroll
    for (int j = 0; j < 8; ++j) g4[j] = ((const f32x4*)gain)[lane + 64 * j];
    for (int t = gw; t < T; t += NGW) {
        const int s0 = slot_of[2 * t], s1 = slot_of[2 * t + 1]; const float w0 = tok_w[2 * t] * 0.125f, w1 = tok_w[2 * t + 1] * 0.125f;
        u32x2* xr = (u32x2*)(x + (size_t)t * D);
        const unsigned* a = (const unsigned*)((const unsigned char*)ob + (size_t)s0 * D); const unsigned* b = (const unsigned*)((const unsigned char*)ob + (size_t)s1 * D);
        f32x4 v[8]; float ss = 0.f;
#pragma unroll
        for (int j = 0; j < 8; ++j) { const int av = (int)a[lane + 64 * j], bv = (int)b[lane + 64 * j]; f32x4 xv = bf4_expand(xr[lane + 64 * j]);
            xv[0] += w0 * __builtin_amdgcn_cvt_f32_fp8(av, 0) + w1 * __builtin_amdgcn_cvt_f32_fp8(bv, 0); xv[1] += w0 * __builtin_amdgcn_cvt_f32_fp8(av, 1) + w1 * __builtin_amdgcn_cvt_f32_fp8(bv, 1);
            xv[2] += w0 * __builtin_amdgcn_cvt_f32_fp8(av, 2) + w1 * __builtin_amdgcn_cvt_f32_fp8(bv, 2); xv[3] += w0 * __builtin_amdgcn_cvt_f32_fp8(av, 3) + w1 * __builtin_amdgcn_cvt_f32_fp8(bv, 3);
            v[j] = xv; ss += (xv[0] * xv[0] + xv[1] * xv[1]) + (xv[2] * xv[2] + xv[3] * xv[3]); }
        const float rstd = 1.0f / sqrtf(wave_sum(ss) * (1.0f / D) + RMS_EPS);
        if (MODE == 0) {
            unsigned* orow = (unsigned*)((unsigned char*)hn + (size_t)t * D);
#pragma unroll
            for (int j = 0; j < 8; ++j) { u32x2 w; w.x = cvt_pk_bf16(v[j][0], v[j][1]); w.y = cvt_pk_bf16(v[j][2], v[j][3]); xr[lane + 64 * j] = w;
                const f32x4 y = v[j] * rstd * g4[j]; orow[lane + 64 * j] = cvt4_fp8(y[0], y[1], y[2], y[3]); }
        } else {
            f32x4* orow = (f32x4*)(out + (size_t)t * D);
#pragma unroll
            for (int j = 0; j < 8; ++j) orow[lane + 64 * j] = v[j] * rstd * g4[j];
        }
    }
}

__device__ __forceinline__ void phase_subln(Frame& F, const bf16_t* o1, const bf16_t* o2, const float* lq1, const float* lk1, const float* lq2, const float* lk2, const float* sg, bf16_t* y) {
    const int gw = F.vcu * NWAVES + F.wave, NGW = F.G * NWAVES, lane = F.lane;
    const float d1 = wave_sum(lq1[lane] * lk1[lane] + lq1[lane + 64] * lk1[lane + 64]);
    const float d2 = wave_sum(lq2[lane] * lk2[lane] + lq2[lane + 64] * lk2[lane + 64]);
    const float lam = __expf(d1) - __expf(d2) + LAMBDA_INIT;
    const f32x4 g = ((const f32x4*)sg)[lane] * (1.0f - LAMBDA_INIT);
    for (int tok = gw; tok < T; tok += NGW) {
        u32x2 a[8], b[8];
#pragma unroll
        for (int h = 0; h < 8; ++h) { a[h] = *(const u32x2*)(o1 + (size_t)tok * D + h * 256 + 4 * lane); b[h] = *(const u32x2*)(o2 + (size_t)tok * D + h * 256 + 4 * lane); }
        f32x4 d[8]; float ss[8];
#pragma unroll
        for (int h = 0; h < 8; ++h) { d[h][0] = bf_lo(a[h].x) - lam * bf_lo(b[h].x); d[h][1] = bf_hi(a[h].x) - lam * bf_hi(b[h].x); d[h][2] = bf_lo(a[h].y) - lam * bf_lo(b[h].y); d[h][3] = bf_hi(a[h].y) - lam * bf_hi(b[h].y);
            ss[h] = (d[h][0] * d[h][0] + d[h][1] * d[h][1]) + (d[h][2] * d[h][2] + d[h][3] * d[h][3]); }
#pragma unroll
        for (int of = 1; of < 64; of <<= 1) {
#pragma unroll
            for (int h = 0; h < 8; ++h) ss[h] += __shfl_xor(ss[h], of); }
#pragma unroll
        for (int h = 0; h < 8; ++h) { const float rstd = 1.0f / sqrtf(ss[h] * (1.0f / 256.0f) + RMS_EPS); const f32x4 yv = d[h] * rstd * g;
            *(unsigned*)((unsigned char*)y + (size_t)tok * D + h * 256 + 4 * lane) = cvt4_fp8(yv[0], yv[1], yv[2], yv[3]); }
    }
}

namespace att {
constexpr int SHM_K = 64 * 128, SHM_V = 256 * 64;
constexpr int NSLOT = 5, V_OFF = 0, K_OFF = NSLOT * SHM_V, SCR_OFF = RING_BYTES + 4096;
static_assert(K_OFF + NSLOT * SHM_K <= RING_BYTES, "attention slots");
constexpr float SCALE = 0.08838834764831845f;
constexpr float C2 = 1.4426950408889634f * SCALE;
constexpr float THR = 64.f;
__device__ __forceinline__ int crow(int r, int hi) { return (r & 3) + 8 * (r >> 2) + 4 * hi; }

__device__ __forceinline__ void qkt(f32x16& p0, f32x16& p1, const LAS unsigned char* kslot, int r32, int hi, const v8i32 (&qf)[2], const f32x16& bias) {
    const int sw = (r32 >> 1) & 7;
    const LAS unsigned char* ra = kslot + r32 * 128;
#pragma unroll
    for (int s = 0; s < 2; ++s) { const int c0 = 4 * s + 2 * hi;
        const v4i32 a0 = *(const LAS v4i32*)(ra + ((c0 ^ sw) << 4)), a1 = *(const LAS v4i32*)(ra + (((c0 + 1) ^ sw) << 4));
        const v4i32 b0 = *(const LAS v4i32*)(ra + 32 * 128 + ((c0 ^ sw) << 4)), b1 = *(const LAS v4i32*)(ra + 32 * 128 + (((c0 + 1) ^ sw) << 4));
        const v8i32 ka = __builtin_shufflevector(a0, a1, 0, 1, 2, 3, 4, 5, 6, 7), kb = __builtin_shufflevector(b0, b1, 0, 1, 2, 3, 4, 5, 6, 7);
        if (s == 0) {
            p0 = __builtin_amdgcn_mfma_scale_f32_32x32x64_f8f6f4(ka, qf[s], bias, 0, 0, 0, 0x7f7f7f7f, 0, 0x7f7f7f7f);
            p1 = __builtin_amdgcn_mfma_scale_f32_32x32x64_f8f6f4(kb, qf[s], bias, 0, 0, 0, 0x7f7f7f7f, 0, 0x7f7f7f7f);
            __builtin_amdgcn_sched_barrier(0); }
        else {
            p0 = __builtin_amdgcn_mfma_scale_f32_32x32x64_f8f6f4(ka, qf[s], p0, 0, 0, 0, 0x7f7f7f7f, 0, 0x7f7f7f7f);
            p1 = __builtin_amdgcn_mfma_scale_f32_32x32x64_f8f6f4(kb, qf[s], p1, 0, 0, 0, 0x7f7f7f7f, 0, 0x7f7f7f7f); } }
}
__device__ __forceinline__ void pv_tile(f32x16 (&o)[8], const LAS unsigned char* va, const v8i32& pa, int scl) {
    const LAS unsigned char* vb = (const LAS unsigned char*)((unsigned)(uintptr_t)va ^ 16u);
#define PV_RD(S, d0) do { S[0] = *(const LAS v4i32*)(va + (d0) * 2048); S[1] = *(const LAS v4i32*)(vb + (d0) * 2048); } while (0)
#define PV_MM(S, d0) do { __builtin_amdgcn_sched_barrier(0); \
        o[d0] = __builtin_amdgcn_mfma_scale_f32_32x32x64_f8f6f4(pa, __builtin_shufflevector(S[0], S[1], 0, 1, 2, 3, 4, 5, 6, 7), o[d0], 0, 0, 0, scl, 0, 0x7f7f7f7f); __builtin_amdgcn_sched_barrier(0); } while (0)
    v4i32 f0[2], f1[2];
    PV_RD(f0, 0);
    PV_RD(f1, 1); PV_MM(f0, 0); PV_RD(f0, 2); PV_MM(f1, 1); PV_RD(f1, 3); PV_MM(f0, 2); PV_RD(f0, 4); PV_MM(f1, 3); PV_RD(f1, 5); PV_MM(f0, 4); PV_RD(f0, 6); PV_MM(f1, 5); PV_RD(f1, 7); PV_MM(f0, 6);
    PV_MM(f1, 7);
#undef PV_MM
#undef PV_RD
}

__device__ __forceinline__ void stage_offsets(int tid, unsigned& koff, unsigned (&voff)[2]) {
    { const int P = tid * 16, row = P >> 7, ch = ((P & 127) >> 4) ^ ((row >> 1) & 7); koff = (unsigned)(row * 128 + ch * 16); }
#pragma unroll
    for (int i = 0; i < 2; ++i) { const int P = tid * 16 + i * 8192, row = P >> 6, ch = ((P & 63) >> 4) ^ ((row >> 2) & 3); voff[i] = (unsigned)(row * 64 + ch * 16); }
}
__device__ __forceinline__ const char* uniform_ptr(const void* p) {
    const unsigned long long v = (unsigned long long)p;
    const unsigned lo = __builtin_amdgcn_readfirstlane((unsigned)v), hi = __builtin_amdgcn_readfirstlane((unsigned)(v >> 32));
    return (const char*)(((unsigned long long)hi << 32) | lo);
}
__device__ __forceinline__ void stage_tile(LAS unsigned char* lds, int slot, const bf16_t* kj_, const bf16_t* vj_, int tid_, int wid) {
    const char* kj = uniform_ptr(kj_); const char* vj = uniform_ptr(vj_);
    int tid = tid_; asm volatile("" : "+v"(tid));
    unsigned koff, voff[2]; stage_offsets(tid, koff, voff);
    LAS unsigned char* kd = lds + K_OFF + slot * SHM_K + wid * 1024; LAS unsigned char* vd = lds + V_OFF + slot * SHM_V + wid * 1024;
    __builtin_amdgcn_global_load_lds((const unsigned*)(kj + koff), (LAS unsigned*)kd, 16, 0, 0);
#pragma unroll
    for (int i = 0; i < 2; ++i) __builtin_amdgcn_global_load_lds((const unsigned*)(vj + voff[i]), (LAS unsigned*)(vd + i * 8192), 16, 0, 0);
}

__device__ __forceinline__ void qk_softmax(const LAS unsigned char* kslot, int r32, int hi, LAS float* al_l, const v8i32 (&qf)[2], const f32x16& bias, f32x16 (&o)[8], v8i32& pa, int& pscl,
                                           float& m_reg, float& l_reg, float rawu, float sl2, bool diag, int qi) {
    f32x16 p0, p1;
    qkt(p0, p1, kslot, r32, hi, qf, bias);
    if (diag) {
        const float k2raw = 2.f * rawu;
        int qi_ = qi - 4 * hi; asm volatile("" : "+v"(qi_));
#pragma unroll
        for (int r = 0; r < 16; ++r) { const int c = (r & 3) + 8 * (r >> 2); const int d0_ = c - qi_, d1_ = c + 32 - qi_;
            p0[r] -= k2raw * (float)(d0_ > 0 ? d0_ : 0); p1[r] -= k2raw * (float)(d1_ > 0 ? d1_ : 0); }
    }
    const float lane_raw = rawu * (float)(4 * hi), d32raw = 32.f * rawu;
    float pm0 = p0[0], pm1 = p1[0];
#pragma unroll
    for (int r = 1; r < 16; ++r) { pm0 = fmaxf(pm0, p0[r]); pm1 = fmaxf(pm1, p1[r]); }
    float pmax = fmaxf(pm0, pm1 + d32raw) + lane_raw;
    { auto rr = __builtin_amdgcn_permlane32_swap(__float_as_uint(pmax), __float_as_uint(pmax), false, false);
      pmax = fmaxf(__uint_as_float(rr[0]), __uint_as_float(rr[1])); }
    float mn, alpha;
    if (__all((pmax - m_reg) * SCALE <= THR)) { mn = m_reg; alpha = 1.f; }
    else { mn = fmaxf(m_reg, pmax); alpha = __builtin_amdgcn_exp2f((m_reg - mn) * C2); m_reg = mn; }
    const float ef = fminf(floorf(8.75f - (pmax - mn) * C2), 60.f);
    pscl = 127 - (int)ef;
    const float mnL0 = (lane_raw - mn) * C2 + ef, mnL1 = mnL0 + 32.f * sl2;
#pragma unroll
    for (int r = 0; r < 16; ++r) { p0[r] = __builtin_amdgcn_exp2f(fmaf(p0[r], C2, mnL0)); p1[r] = __builtin_amdgcn_exp2f(fmaf(p1[r], C2, mnL1)); }
    if (__any(alpha < 1.f)) {
        if (hi == 0) al_l[r32] = alpha;
        LDS_WAIT();
#pragma unroll
        for (int r = 0; r < 16; ++r) { const float a = al_l[crow(r, hi)];
#pragma unroll
            for (int d = 0; d < 8; ++d) o[d][r] *= a; }
    }
    float ps = 0.f;
#pragma unroll
    for (int r = 0; r < 16; ++r) ps += p0[r] + p1[r];
    { auto rr = __builtin_amdgcn_permlane32_swap(__float_as_uint(ps), __float_as_uint(ps), false, false);
      ps = __uint_as_float(rr[0]) + __uint_as_float(rr[1]); }
    l_reg = l_reg * alpha + ps * __builtin_amdgcn_exp2f(-ef);
#pragma unroll
    for (int g = 0; g < 4; ++g) {
        pa[g] = __builtin_amdgcn_cvt_pk_fp8_f32(p0[4 * g + 2], p0[4 * g + 3], __builtin_amdgcn_cvt_pk_fp8_f32(p0[4 * g], p0[4 * g + 1], (int)__float_as_uint(p0[4 * g]), false), true);
        pa[4 + g] = __builtin_amdgcn_cvt_pk_fp8_f32(p1[4 * g + 2], p1[4 * g + 3], __builtin_amdgcn_cvt_pk_fp8_f32(p1[4 * g], p1[4 * g + 1], (int)__float_as_uint(p1[4 * g]), false), true); }
}

__device__ __forceinline__ void norms_phase(Frame& F, const bf16_t* proj, float* nrm) {
    const int gw = F.vcu * NWAVES + F.wave, NGW = F.G * NWAVES, lane = F.lane;
    for (int idx = gw; idx < 2 * 32 * 256; idx += NGW) {
        const int tensor = idx >> 13, stream = (idx >> 8) & 31, grp = idx & 255;
        const u32x4* rp = (const u32x4*)((const unsigned char*)proj + (tensor ? DK0 : 0) + ((size_t)stream * SEQ + grp * 64 + lane) * 128);
        float ss = 0.f;
#pragma unroll
        for (int q = 0; q < 8; ++q) { const u32x4 v = rp[q];
#pragma unroll
            for (int e = 0; e < 4; ++e) { const float a0 = __builtin_amdgcn_cvt_f32_fp8((int)v[e], 0), a1 = __builtin_amdgcn_cvt_f32_fp8((int)v[e], 1), a2 = __builtin_amdgcn_cvt_f32_fp8((int)v[e], 2), a3 = __builtin_amdgcn_cvt_f32_fp8((int)v[e], 3);
                ss += (a0 * a0 + a1 * a1) + (a2 * a2 + a3 * a3); } }
        float n = sqrtf(ss) * 1.001f;
#pragma unroll
        for (int o = 1; o < 64; o <<= 1) n = fmaxf(n, __shfl_xor(n, o));
        if (lane == 0) nrm[idx] = n;
    }
}

__device__ __forceinline__ void attn_item(LAS unsigned char* lds, const bf16_t* proj, const float* nrm, bf16_t* oout, int b, int h, int sub, int qb, int tid, int wid, int lane, unsigned* queue, LAS int* qnext) {
    asm volatile("" : "+v"(lane));
    const int r32 = lane & 31, hi = lane >> 5;
    const float slope = __builtin_amdgcn_exp2f(-(float)(h + 1));
    const float sl2 = slope * 1.4426950408889634f, rawu = sl2 / C2;
    LAS float* ws = (LAS float*)(lds + SCR_OFF) + wid * 64; LAS float* li_l = ws; LAS float* al_l = ws + 32;
    const size_t tokq = (size_t)b * SEQ + (size_t)qb * 256 + wid * 32;
    const bf16_t* kbase = (const bf16_t*)((const unsigned char*)proj + DK0 + dq_off(b, 0, h, sub));
    const bf16_t* vbase = (const bf16_t*)((const unsigned char*)proj + pg8::vt_off(b, h, 0));
    int j_lo;
    { const int stream = (b * 8 + h) * 2 + sub; const float* qn = nrm + stream * 256; const float* kn = nrm + 8192 + stream * 256;
      const float Qn = fmaxf(fmaxf(qn[4 * qb], qn[4 * qb + 1]), fmaxf(qn[4 * qb + 2], qn[4 * qb + 3]));
      const float Kd = fmaxf(fmaxf(kn[4 * qb], kn[4 * qb + 1]), fmaxf(kn[4 * qb + 2], kn[4 * qb + 3]));
      int cand = 4 * qb;
      for (int jj = lane; jj < 4 * qb; jj += 64) { const float dmin = (float)(256 * qb - (64 * jj + 63)); const bool skip = slope * dmin > 110.f + SCALE * Qn * (kn[jj] + Kd); if (!skip) cand = cand < jj ? cand : jj; }
#pragma unroll
      for (int o = 1; o < 64; o <<= 1) { const int v = __builtin_amdgcn_ds_bpermute((lane ^ o) << 2, cand); cand = v < cand ? v : cand; }
      j_lo = __builtin_amdgcn_readfirstlane(cand); }
    v8i32 qf[2];
    { const unsigned char* qrow = (const unsigned char*)proj + dq_off(b, qb * 256 + wid * 32 + r32, h, sub) + 32 * hi;
#pragma unroll
      for (int s = 0; s < 2; ++s) { const v4i32 x0 = *(const v4i32*)(qrow + 64 * s), x1 = *(const v4i32*)(qrow + 64 * s + 16); qf[s] = __builtin_shufflevector(x0, x1, 0, 1, 2, 3, 4, 5, 6, 7); } }
    const float sh64 = 64.f * rawu;
    f32x16 bias;
#pragma unroll
    for (int r = 0; r < 16; ++r) bias[r] = (float)((r & 3) + 8 * (r >> 2)) * rawu;
    const int qi = 32 * (wid & 1) + r32;
    const LAS unsigned char* vb0 = lds + V_OFF + r32 * 64 + (((2 * hi) ^ ((r32 >> 2) & 3)) << 4);
    float m_reg = -1e30f, l_reg = 0.f;
    f32x16 o[8];
#pragma unroll
    for (int d = 0; d < 8; ++d)
#pragma unroll
        for (int r = 0; r < 16; ++r) o[d][r] = 0.f;
    const int NT = 4 * qb + 4, myNT = 4 * qb + (wid >> 1) + 1;
    constexpr size_t KSTEP = 64 * 128 / 2, VSTEP = 256 * 64 / 2;
    const bool late = wid >= 4;
#define ATT_STAGE(jj, sl) stage_tile(lds, sl, kbase + (size_t)(jj) * KSTEP, vbase + (size_t)(jj) * VSTEP, tid, wid)
#define ATT_NEXT(s_) ((s_) == NSLOT - 1 ? 0 : (s_) + 1)
#define ATT_WAIT(j_) do { const int rem_ = NT - 2 - (j_); if (rem_ >= 2) asm volatile("s_waitcnt vmcnt(6)" ::: "memory"); else if (rem_ == 1) asm volatile("s_waitcnt vmcnt(3)" ::: "memory"); \
        else asm volatile("s_waitcnt vmcnt(0)" ::: "memory"); WG_BAR(); } while (0)
    int s0 = j_lo % NSLOT;
    { const int s1 = ATT_NEXT(s0), s2 = ATT_NEXT(s1); ATT_STAGE(j_lo, s0); ATT_STAGE(j_lo + 1, s1); ATT_STAGE(j_lo + 2, s2); }
    asm volatile("s_waitcnt vmcnt(6)" ::: "memory"); WG_BAR();
    if (!late) {
        for (int j = j_lo; j < NT; ++j) {
            const int s1 = ATT_NEXT(s0);
            if (j + 3 < NT) { const int s3 = ATT_NEXT(ATT_NEXT(s1)); ATT_STAGE(j + 3, s3); }
            if (j < myNT) { if (j > j_lo) m_reg -= sh64;
                v8i32 pa; int pscl;
                qk_softmax(lds + K_OFF + s0 * SHM_K, r32, hi, al_l, qf, bias, o, pa, pscl, m_reg, l_reg, rawu, sl2, j == myNT - 1, qi);
                pv_tile(o, vb0 + s0 * SHM_V, pa, pscl); }
            ATT_WAIT(j);
            s0 = s1;
        }
    } else {
        v8i32 pa; int pscl = 127;
#pragma unroll
        for (int g = 0; g < 8; ++g) pa[g] = 0;
        int sp = s0;
        for (int j = j_lo; j < NT; ++j) {
            const int s1 = ATT_NEXT(s0);
            if (j + 3 < NT) { const int s3 = ATT_NEXT(ATT_NEXT(s1)); ATT_STAGE(j + 3, s3); }
            if (j > j_lo && j - 1 < myNT) pv_tile(o, vb0 + sp * SHM_V, pa, pscl);
            if (j < myNT) { if (j > j_lo) m_reg -= sh64;
                qk_softmax(lds + K_OFF + s0 * SHM_K, r32, hi, al_l, qf, bias, o, pa, pscl, m_reg, l_reg, rawu, sl2, j == myNT - 1, qi); }
            ATT_WAIT(j);
            sp = s0; s0 = s1;
        }
        if (myNT == NT) pv_tile(o, vb0 + sp * SHM_V, pa, pscl);
    }
#undef ATT_WAIT
#undef ATT_NEXT
#undef ATT_STAGE
    int jn_ = 0; if (tid == 0) jn_ = (int)__hip_atomic_fetch_add(queue, 1u, __ATOMIC_RELAXED, __HIP_MEMORY_SCOPE_AGENT);
    if (hi == 0) li_l[r32] = l_reg;
    LDS_WAIT();
    char* Ow = (char*)(oout + tokq * D + h * 256);
    const unsigned lofs = (unsigned)(hi * 4 * D + r32) * 2u;
#pragma unroll
    for (int r = 0; r < 16; ++r) { const float rl = __builtin_amdgcn_rcpf(li_l[crow(r, hi)]);
#pragma unroll
        for (int d0 = 0; d0 < 8; ++d0) { const float v = o[d0][r] * rl; const float vn = __uint_as_float((unsigned)__builtin_amdgcn_update_dpp(0, (int)__float_as_uint(v), 0xB1  , 0xf, 0xf, true));
            if ((r32 & 1) == 0) *(unsigned*)(Ow + (lofs + (unsigned)((((r & 3) + 8 * (r >> 2)) * D + d0 * 32) * 2))) = cvt_pk_bf16(v, vn); } }
    if (tid == 0) *qnext = jn_;
    WG_BAR();
}

struct TailConv { const float* wg; const float* wu; const float* wd; bf16_t* gu; bf16_t* dt; };
__device__ __forceinline__ void attn_phase(Frame& F, const bf16_t* proj, const float* nrm, unsigned* queue, bf16_t* o1, bf16_t* o2, const TailConv tc) {
    LAS int* qw = (LAS int*)(F.lds + SCR_OFF + 8 * 256);
    if (F.tid == 0) qw[0] = (int)__hip_atomic_fetch_add(queue, 1u, __ATOMIC_RELAXED, __HIP_MEMORY_SCOPE_AGENT);
    WG_BAR();
    for (int n = 0;; ++n) {
        const int J = __builtin_amdgcn_readfirstlane(qw[n & 1]);
        if (J >= 2048 + 512) break;
        const int grp = J / 5, rr = J - 5 * grp;
        if (rr == 4) { int jn_ = 0; if (F.tid == 0) jn_ = (int)__hip_atomic_fetch_add(queue, 1u, __ATOMIC_RELAXED, __HIP_MEMORY_SCOPE_AGENT);
            conv_moe(F, tc.wg, tc.wu, tc.wd, tc.gu, tc.dt, grp, 512, L1_EARLY, NEXP - L1_EARLY); if (F.tid == 0) qw[(n + 1) & 1] = jn_; WG_BAR(); continue; }
        const int I = 4 * grp + rr;
        const int qb = 63 - (I >> 5), r = I & 31, h = 7 - (r >> 2), b = (r >> 1) & 1, sub = r & 1;
        attn_item(F.lds, proj, nrm, sub ? o2 : o1, b, h, sub, qb, F.tid, F.wave, F.lane, queue, qw + ((n + 1) & 1));
    }
}
}

__device__ __forceinline__ const void* karg(int i) { int j = i; asm volatile("" : "+s"(j)); return ((const void* const __attribute__((address_space(4)))*)__builtin_amdgcn_kernarg_segment_ptr())[j]; }
#if defined(__HIP_DEVICE_COMPILE__)
#define NO_PK_F32 __attribute__((target("no-packed-fp32-ops")))
#else
#define NO_PK_F32
#endif
__global__ void __launch_bounds__(NWAVES * 64, 2) NO_PK_F32 hybrid_fwd(Args args) {
    extern __shared__ __attribute__((aligned(16))) unsigned char lds_raw[];
    Frame F;
    F.lds = (LAS unsigned char*)lds_raw;
    F.tid = threadIdx.x; F.lane = F.tid & 63; F.wave = __builtin_amdgcn_readfirstlane(F.tid >> 6);
    F.G = gridDim.x; { const int bx = blockIdx.x; F.vcu = (F.G % 8 == 0) ? (bx % 8) * (F.G / 8) + bx / 8 : bx; }
#define ws ((unsigned char*)karg(22))
#define ctl ((unsigned*)(ws + WS_CTL))
    for (int u = F.tid; u < (LDS_BYTES - LDSCTL_OFF) / 4; u += NWAVES * 64) ((LAS unsigned*)(F.lds + LDSCTL_OFF))[u] = 0u;
    SYNCTHREADS();
    ((LAS int*)(F.lds + TIDS_OFF))[F.tid] = F.tid;
    SYNCTHREADS();
    volatile LAS unsigned* MISC = (volatile LAS unsigned*)(F.lds + MISC_OFF);
    XcdBarrier bar = xcd_barrier_post(ctl + CW_BAR, MISC + 8);
#define GRID_BAR() do { XcdBarrier bb_ = bar; unsigned x_ = bar.x; unsigned long long bp_ = (unsigned long long)bar.bar; asm volatile("" : "+s"(x_), "+s"(bp_)); bb_.x = x_; bb_.bar = (unsigned*)bp_; xcd_barrier(bb_, TID_RELOAD() == 0); } while (0)
#define TID_RELOAD() (F.wave * 64 + lane_id_volatile())
#ifdef ONLY_PHASE
#define PHON(n) ((n) == ONLY_PHASE)
#else
#define PHON(n) 1
#endif

#define x_in ((const float*)(karg(0)))
#define norm_mix ((const float*)(karg(1)))
#define norm_ffn ((const float*)(karg(2)))
#define gla_w_in ((const float*)(karg(3)))
#define gla_wgu ((const float*)(karg(4)))
#define gla_bg ((const float*)(karg(5)))
#define gla_norm ((const float*)(karg(6)))
#define gla_w_out ((const float*)(karg(7)))
#define diff_w_in ((const float*)(karg(8)))
#define lq1 ((const float*)(karg(9)))
#define lk1 ((const float*)(karg(10)))
#define lq2 ((const float*)(karg(11)))
#define lk2 ((const float*)(karg(12)))
#define diff_subln ((const float*)(karg(13)))
#define diff_w_out ((const float*)(karg(14)))
#define moe_wgrp ((const float*)(karg(15)))
#define moe_wexp ((const float*)(karg(16)))
#define moe_wg ((const float*)(karg(17)))
#define moe_wu ((const float*)(karg(18)))
#define moe_wd ((const float*)(karg(19)))
#define final_norm ((const float*)(karg(20)))
#define xres ((bf16_t*)(ws + WS_XRES))
#define gz ((float*)((float*)(ws + WS_GZ)))
#define tok_e ((int*)((int*)(ws + WS_TOKE)))
#define tok_p ((int*)((int*)(ws + WS_TOKP)))
#define tok_w ((float*)((float*)(ws + WS_TOKW)))
#define slot_of ((int*)((int*)(ws + WS_SLOT)))
#define slot_tok ((int*)(ws + WS_STOK))
#define adec ((float*)((float*)(ws + WS_ADEC)))
#define pcum ((float*)((float*)(ws + WS_PCUM)))
#define sfin ((bf16_t*)((bf16_t*)(ws + WS_SFIN)))
#define wp_gz ((float*)((float*)(ws + WS_WPGZ)))
#define wp_r0 ((float*)((float*)(ws + WS_WPR0)))
#define wp_r1 ((float*)((float*)(ws + WS_WPR1)))
#define wgi ((bf16_t*)((bf16_t*)(ws + WS_WGI)))
#define wgo ((bf16_t*)((bf16_t*)(ws + WS_WGO)))
#define wdi ((bf16_t*)((bf16_t*)(ws + WS_WDI)))
#define wdo ((bf16_t*)((bf16_t*)(ws + WS_WDO)))
#define wmoe_gu ((bf16_t*)((bf16_t*)(ws + WS_WMOE)))
#define wmoe_d ((bf16_t*)((bf16_t*)(ws + WS_WMOE_D)))
#define hn ((bf16_t*)((bf16_t*)(ws + WS_HN)))
#define proj ((bf16_t*)((bf16_t*)(ws + WS_PROJ)))
#define buf1 ((bf16_t*)((bf16_t*)(ws + WS_BUF1)))
#define buf2 ((bf16_t*)((bf16_t*)(ws + WS_BUF2)))
#define ag ((bf16_t*)((bf16_t*)(ws + WS_AG)))
#define ob ((bf16_t*)((bf16_t*)(ws + WS_OB)))
#define hh ((bf16_t*)((bf16_t*)(ws + WS_H)))
    const LAS int* pst = (const LAS int*)(F.lds + TAB_OFF);

    _Pragma("unroll") for (int rep_ = 0; rep_ < (REP_PHASE == 0 ? 2 : 1); ++rep_) if (PHON(0)) { if (rep_) GRID_BAR(); Frame P = F; P.tid = TID_RELOAD(); P.lane = P.tid & 63;
    conv_plain(P, gla_w_in, D, PROJW, GLA_INW, wgi, -1, 0, norm_mix);
    conv_plain(P, gla_w_out, D, D, D, wgo);
    pack_proj(P, wp_gz, 1, norm_mix, gla_w_in, GLA_INW, PROJW, 16, nullptr, 0, 0);
    pack_proj16(P, (bf16_t*)wp_r0, 3, norm_ffn, moe_wgrp, 4, 0, 4, moe_wexp, 32, 32);
    pack_proj16(P, (bf16_t*)wp_r1, 3, norm_ffn + D, moe_wgrp + (size_t)D * 4, 4, 0, 4, moe_wexp + (size_t)D * 32, 32, 32);
    }
    GRID_BAR();
    _Pragma("unroll") for (int rep_ = 0; rep_ < (REP_PHASE == 1 ? 2 : 1); ++rep_) if (PHON(1)) { if (rep_) GRID_BAR(); Frame P = F; P.tid = TID_RELOAD(); P.lane = P.tid & 63;
    phase_norm_gz(P, x_in, wp_gz, hn, gz, (float*)(ws + WS_PCUM));
    }
    GRID_BAR();
    _Pragma("unroll") for (int rep_ = 0; rep_ < (REP_PHASE == 2 ? 2 : 1); ++rep_) if (PHON(2)) { if (rep_) GRID_BAR(); Frame P = F; P.tid = TID_RELOAD(); P.lane = P.tid & 63;
    { pg8::Gemm g{hn, wgi, T, PROJW, D}; pg8::StaticOrder S; S.init(T, PROJW, P.G, (int)blockIdx.x); pg8::EpiHeads<0> E{proj, (const float*)(ws + WS_PCUM)};
      pg8::gemm_phase<pg8::EpiHeads<0>, pg8::StaticOrder>(P.lds, g, S, E, P.tid); }
    }
    GRID_BAR();
    _Pragma("unroll") for (int rep_ = 0; rep_ < (REP_PHASE == 3 ? 2 : 1); ++rep_) if (PHON(3)) { if (rep_) GRID_BAR(); Frame P = F; P.tid = TID_RELOAD(); P.lane = P.tid & 63;
    phase_gla_gate(P, gz, gla_wgu, gla_bg, proj, buf1, adec);
    }
    GRID_BAR();
    _Pragma("unroll") for (int rep_ = 0; rep_ < (REP_PHASE == 4 ? 2 : 1); ++rep_) if (PHON(4)) { if (rep_) GRID_BAR(); Frame P = F; P.tid = TID_RELOAD(); P.lane = P.tid & 63;
    if (P.G == 256) { if ((P.vcu & 1) == 0) phase_gla_scan(P, P.vcu >> 1, proj, buf1, adec, buf2, sfin); else { gla_pcum(P, adec, pcum, P.vcu >> 1, 128); conv_moe(P, moe_wg, moe_wu, moe_wd, wmoe_gu, wmoe_d, P.vcu >> 1, 128);
            conv_moe(P, moe_wg + (size_t)NEXP * D * DFF, moe_wu + (size_t)NEXP * D * DFF, moe_wd + (size_t)NEXP * DFF * D, (bf16_t*)(ws + WS_WMOE1), (bf16_t*)(ws + WS_WMOE1_D), P.vcu >> 1, 128, 0, L1_EARLY);
            conv_plain<true>(P, diff_w_in, D, PROJW, PROJW, wdi, P.vcu >> 1, 128); conv_plain<true>(P, diff_w_out, D, D, D, wdo, P.vcu >> 1, 128); } }
    else { for (int it = P.vcu; it < 128; it += P.G) phase_gla_scan(P, it, proj, buf1, adec, buf2, sfin); gla_pcum(P, adec, pcum, P.vcu, P.G); conv_moe(P, moe_wg, moe_wu, moe_wd, wmoe_gu, wmoe_d); conv_moe(P, moe_wg + (size_t)NEXP * D * DFF, moe_wu + (size_t)NEXP * D * DFF, moe_wd + (size_t)NEXP * DFF * D, (bf16_t*)(ws + WS_WMOE1), (bf16_t*)(ws + WS_WMOE1_D), -1, 0, 0, L1_EARLY); conv_plain<true>(P, diff_w_in, D, PROJW, PROJW, wdi); conv_plain<true>(P, diff_w_out, D, D, D, wdo); }
    GRID_BAR();
    phase_gla_qp(P, proj, pcum, buf1);
    GRID_BAR();
    { pg8::Gemm g{buf1, sfin, 8 * (SEQ / 2), 512, 256}; pg8::FixOrder S; S.init(8 * (SEQ / 2), 512, P.G, (int)blockIdx.x); pg8::EpiAddO E{buf2};
      pg8::gemm_phase<pg8::EpiAddO, pg8::FixOrder>(P.lds, g, S, E, P.tid); }
    }
    GRID_BAR();
    _Pragma("unroll") for (int rep_ = 0; rep_ < (REP_PHASE == 5 ? 2 : 1); ++rep_) if (PHON(5)) { if (rep_) GRID_BAR(); Frame P = F; P.tid = TID_RELOAD(); P.lane = P.tid & 63;
    phase_gla_gnorm(P, buf2, proj, gla_norm, buf1);
    }
    GRID_BAR();
    _Pragma("unroll") for (int rep_ = 0; rep_ < (REP_PHASE == 6 ? 2 : 1); ++rep_) if (PHON(6)) { if (rep_) GRID_BAR(); Frame P = F; P.tid = TID_RELOAD(); P.lane = P.tid & 63;
    { pg8::Gemm g{buf1, wgo, T, D, D}; pg8::StaticOrder S; S.init(T, D, P.G, (int)blockIdx.x); pg8::EpiRes16<true> E{hn, xres, D};
      pg8::gemm_phase<pg8::EpiRes16<true>, pg8::StaticOrder>(P.lds, g, S, E, P.tid); }
    }
    GRID_BAR();
    _Pragma("unroll") for (int rep_ = 0; rep_ < (REP_PHASE == 7 ? 2 : 1); ++rep_) if (PHON(7)) { if (rep_) GRID_BAR(); Frame P = F; P.tid = TID_RELOAD(); P.lane = P.tid & 63;
    phase_norm_route(P, xres, norm_ffn, wp_r0, hn, tok_e, tok_p, tok_w, ctl + CW_CNT0);
    }
    GRID_BAR();
    _Pragma("unroll") for (int rep_ = 0; rep_ < (REP_PHASE == 8 ? 2 : 1); ++rep_) if (PHON(8)) { if (rep_) GRID_BAR(); Frame P = F; P.tid = TID_RELOAD(); P.lane = P.tid & 63;
    moe_tables(P, ctl + CW_CNT0);
    phase_moe_slots(P, tok_e, tok_p, ctl + CW_CNT0, slot_of, slot_tok);
    }
    GRID_BAR();
    _Pragma("unroll") for (int rep_ = 0; rep_ < (REP_PHASE == 9 ? 2 : 1); ++rep_) if (PHON(9)) { if (rep_) GRID_BAR(); Frame P = F; P.tid = TID_RELOAD(); P.lane = P.tid & 63;
    { const int Mr = pst[33] * 256; pg8::Gemm g{hn, wmoe_gu, Mr, 1024, D}; pg8::MoeOrder S; S.init(Mr, 1024, P.G, (int)blockIdx.x); S.te = pst + 36; S.estride = (size_t)1024 * D; S.stok = slot_tok; pg8::EpiSiluMul E{(unsigned char*)hh};
      pg8::gemm_phase<pg8::EpiSiluMul, pg8::MoeOrder, true, true>(P.lds, g, S, E, P.tid); }
    }
    GRID_BAR();
    _Pragma("unroll") for (int rep_ = 0; rep_ < (REP_PHASE == 10 ? 2 : 1); ++rep_) if (PHON(10)) { if (rep_) GRID_BAR(); Frame P = F; P.tid = TID_RELOAD(); P.lane = P.tid & 63;
    { const int Mr = pst[33] * 256; pg8::Gemm g{hh, wmoe_d, Mr, D, DFF}; pg8::MoeOrder S; S.init(Mr, D, P.G, (int)blockIdx.x); S.te = pst + 36; S.estride = (size_t)D * DFF; S.stok = slot_tok; pg8::EpiF8x8 E{(unsigned char*)ob, D};
      pg8::gemm_phase<pg8::EpiF8x8, pg8::MoeOrder, false, true>(P.lds, g, S, E, P.tid); }
    }
    GRID_BAR();
    _Pragma("unroll") for (int rep_ = 0; rep_ < (REP_PHASE == 11 ? 2 : 1); ++rep_) if (PHON(11)) { if (rep_) GRID_BAR(); Frame P = F; P.tid = TID_RELOAD(); P.lane = P.tid & 63;
    phase_moe_combine<0>(P, xres, nullptr, ob, slot_of, tok_w, norm_mix + D, hn);
    }
    GRID_BAR();
    _Pragma("unroll") for (int rep_ = 0; rep_ < (REP_PHASE == 12 ? 2 : 1); ++rep_) if (PHON(12)) { if (rep_) GRID_BAR(); Frame P = F; P.tid = TID_RELOAD(); P.lane = P.tid & 63;
    { pg8::Gemm g{hn, wdi, T, 4096, D}; pg8::StaticOrder S; S.init(T, 4096, P.G, (int)blockIdx.x); pg8::EpiHeads<1> E{proj, nullptr};
      pg8::gemm_phase<pg8::EpiHeads<1>, pg8::StaticOrder, false, true>(P.lds, g, S, E, P.tid); }
    { pg8::Gemm g{hn, (const bf16_t*)((const unsigned char*)wdi + (size_t)4096 * D), T, 2048, D}; pg8::StaticOrder S; S.init(T, 2048, P.G, (int)blockIdx.x); pg8::EpiVT E{(unsigned char*)proj};
      pg8::gemm_phase<pg8::EpiVT, pg8::StaticOrder, false, true, true>(P.lds, g, S, E, P.tid); }
    GRID_BAR();
    att::norms_phase(P, proj, (float*)(ws + WS_NRM));
    }
    GRID_BAR();
    _Pragma("unroll") for (int rep_ = 0; rep_ < (REP_PHASE == 13 ? 2 : 1); ++rep_) if (PHON(13)) { if (rep_) GRID_BAR(); Frame P = F; P.tid = TID_RELOAD(); P.lane = P.tid & 63;
    att::attn_phase(P, proj, (const float*)(ws + WS_NRM), ctl + CW_QUEUE + 64 * rep_, buf1, buf2, att::TailConv{moe_wg + (size_t)NEXP * D * DFF, moe_wu + (size_t)NEXP * D * DFF, moe_wd + (size_t)NEXP * DFF * D, (bf16_t*)(ws + WS_WMOE1), (bf16_t*)(ws + WS_WMOE1_D)});
    }
    GRID_BAR();
    _Pragma("unroll") for (int rep_ = 0; rep_ < (REP_PHASE == 14 ? 2 : 1); ++rep_) if (PHON(14)) { if (rep_) GRID_BAR(); Frame P = F; P.tid = TID_RELOAD(); P.lane = P.tid & 63;
    phase_subln(P, buf1, buf2, lq1, lk1, lq2, lk2, diff_subln, hn);
    }
    GRID_BAR();
    _Pragma("unroll") for (int rep_ = 0; rep_ < (REP_PHASE == 15 ? 2 : 1); ++rep_) if (PHON(15)) { if (rep_) GRID_BAR(); Frame P = F; P.tid = TID_RELOAD(); P.lane = P.tid & 63;
    { pg8::Gemm g{hn, wdo, T, D, D}; pg8::StaticOrder S; S.init(T, D, P.G, (int)blockIdx.x); pg8::EpiRes16<true> E{xres, xres, D};
      pg8::gemm_phase<pg8::EpiRes16<true>, pg8::StaticOrder, false, true>(P.lds, g, S, E, P.tid); }
    }
    GRID_BAR();
    _Pragma("unroll") for (int rep_ = 0; rep_ < (REP_PHASE == 16 ? 2 : 1); ++rep_) if (PHON(16)) { if (rep_) GRID_BAR(); Frame P = F; P.tid = TID_RELOAD(); P.lane = P.tid & 63;
    phase_norm_route(P, xres, norm_ffn + D, wp_r1, hn, tok_e, tok_p, tok_w, ctl + CW_CNT1);
    }
    GRID_BAR();
    _Pragma("unroll") for (int rep_ = 0; rep_ < (REP_PHASE == 17 ? 2 : 1); ++rep_) if (PHON(17)) { if (rep_) GRID_BAR(); Frame P = F; P.tid = TID_RELOAD(); P.lane = P.tid & 63;
    moe_tables(P, ctl + CW_CNT1);
    phase_moe_slots(P, tok_e, tok_p, ctl + CW_CNT1, slot_of, slot_tok);
    }
    GRID_BAR();
    _Pragma("unroll") for (int rep_ = 0; rep_ < (REP_PHASE == 18 ? 2 : 1); ++rep_) if (PHON(18)) { if (rep_) GRID_BAR(); Frame P = F; P.tid = TID_RELOAD(); P.lane = P.tid & 63;
    { const int Mr = pst[33] * 256; pg8::Gemm g{hn, (bf16_t*)(ws + WS_WMOE1), Mr, 1024, D}; pg8::MoeOrder S; S.init(Mr, 1024, P.G, (int)blockIdx.x); S.te = pst + 36; S.estride = (size_t)1024 * D; S.stok = slot_tok; pg8::EpiSiluMul E{(unsigned char*)hh};
      pg8::gemm_phase<pg8::EpiSiluMul, pg8::MoeOrder, true, true>(P.lds, g, S, E, P.tid); }
    }
    GRID_BAR();
    _Pragma("unroll") for (int rep_ = 0; rep_ < (REP_PHASE == 19 ? 2 : 1); ++rep_) if (PHON(19)) { if (rep_) GRID_BAR(); Frame P = F; P.tid = TID_RELOAD(); P.lane = P.tid & 63;
    { const int Mr = pst[33] * 256; pg8::Gemm g{hh, (bf16_t*)(ws + WS_WMOE1_D), Mr, D, DFF}; pg8::MoeOrder S; S.init(Mr, D, P.G, (int)blockIdx.x); S.te = pst + 36; S.estride = (size_t)D * DFF; S.stok = slot_tok; pg8::EpiF8x8 E{(unsigned char*)ob, D};
      pg8::gemm_phase<pg8::EpiF8x8, pg8::MoeOrder, false, true>(P.lds, g, S, E, P.tid); }
    }
    GRID_BAR();
    _Pragma("unroll") for (int rep_ = 0; rep_ < (REP_PHASE == 20 ? 2 : 1); ++rep_) if (PHON(20)) { if (rep_) GRID_BAR(); Frame P = F; P.tid = TID_RELOAD(); P.lane = P.tid & 63;
    phase_moe_combine<1>(P, xres, (float*)(karg(21)), ob, slot_of, tok_w, final_norm, hn);
    }
}

#undef x_in
#undef norm_mix
#undef norm_ffn
#undef gla_w_in
#undef gla_wgu
#undef gla_bg
#undef gla_norm
#undef gla_w_out
#undef diff_w_in
#undef lq1
#undef lk1
#undef lq2
#undef lk2
#undef diff_subln
#undef diff_w_out
#undef moe_wgrp
#undef moe_wexp
#undef moe_wg
#undef moe_wu
#undef moe_wd
#undef final_norm
#undef xres
#undef gz
#undef tok_e
#undef tok_p
#undef tok_w
#undef slot_of
#undef slot_tok
#undef ws
#undef ctl
#undef adec
#undef pcum
#undef sfin
#undef wp_gz
#undef wp_r0
#undef wp_r1
#undef wgi
#undef wgo
#undef wdi
#undef wdo
#undef wmoe_gu
#undef wmoe_d
#undef hn
#undef proj
#undef buf1
#undef buf2
#undef ag
#undef ob
#undef hh

extern "C" void kernel_launch(void* const* d_in, const int* in_sizes, int n_in, void* d_out, int out_size, void* d_ws, size_t ws_size, hipStream_t stream) {
    static int grid = 0;
    if (grid == 0) {
        if (n_in != 21 || out_size != T * D || ws_size < WS_END) { fprintf(stderr, "kernel_launch: unexpected shapes (n_in %d out %d ws %zu)\n", n_in, out_size, ws_size); grid = -1; return; }
        if (hipFuncSetAttribute((const void*)hybrid_fwd, hipFuncAttributeMaxDynamicSharedMemorySize, LDS_BYTES) != hipSuccess) { fprintf(stderr, "kernel_launch: hipFuncSetAttribute failed\n"); grid = -1; return; }
        int dev = 0, cus = 0, per_cu = 0;
        (void)hipGetDevice(&dev); (void)hipDeviceGetAttribute(&cus, hipDeviceAttributeMultiprocessorCount, dev);
        if (hipOccupancyMaxActiveBlocksPerMultiprocessor(&per_cu, (const void*)hybrid_fwd, NWAVES * 64, LDS_BYTES) != hipSuccess || per_cu < 1) fprintf(stderr, "kernel_launch: occupancy query says %d\n", per_cu);
        (void)hipGetLastError();
        grid = cus > 0 ? cus : 256;
    }
    if (grid < 0) return;
    Args a{};
    for (int i = 0; i < 21; ++i) a.in[i] = (const float*)d_in[i];
    a.out = (float*)d_out; a.ws = (unsigned char*)d_ws; a.pad0 = 0; a.pad1 = 0;
    (void)hipMemsetAsync((char*)d_ws + WS_CTL, 0, CTL_ZERO_BYTES, stream);
    hipLaunchKernelGGL(hybrid_fwd, dim3(grid), dim3(NWAVES * 64), LDS_BYTES, stream, a);
}
```
